# Optimizing an MI355X kernel written in HIP

```python
import jax
import jax.numpy as jnp
from jax import lax
import numpy as np

D_MODEL = 4096
BATCH = 1
SEQ = 8192
DEPTH = 1

HEAD_DIM = 128
ATTN_HEADS = D_MODEL // 256
ATTN_WIDTH = ATTN_HEADS * HEAD_DIM
Q_BLOCK = 128
LRU_WIDTH = D_MODEL // 2
LRU_GROUPS = 16
LRU_GROUP_DIM = LRU_WIDTH // LRU_GROUPS
CONV_WIDTH = 4
LRU_C = 8.0
PEER_HEADS = 8
PEER_N_KEYS = 128
PEER_N_EXPERTS = PEER_N_KEYS * PEER_N_KEYS
PEER_TOPK = 16
PEER_KEY_DIM = 256
PEER_HALF = PEER_KEY_DIM // 2
PEER_CHUNK = 64
N_MOD = 6
EPS = 1e-6

Q_END = ATTN_WIDTH
K_END = Q_END + ATTN_WIDTH
V_END = K_END + ATTN_WIDTH
F_END = V_END + ATTN_HEADS
LX_END = F_END + LRU_WIDTH
LY_END = LX_END + LRU_WIDTH
GA_END = LY_END + D_MODEL
IN_WIDTH = GA_END + D_MODEL

kernel_name = "hybrid_fox_rglru_peer_block"


def _rmsnorm(x, g):
    xf = x.astype(jnp.float32)
    y = xf * lax.rsqrt(jnp.mean(xf * xf, axis=-1, keepdims=True) + EPS)
    return (y * g.astype(jnp.float32)).astype(x.dtype)


def _forgetting_attention(q, k, v, log_f):
    B, S, H, Dh = q.shape
    nb = S // Q_BLOCK
    F = jnp.cumsum(log_f, axis=1)
    Fh = jnp.transpose(F, (0, 2, 1))
    kh = jnp.transpose(k, (0, 2, 1, 3))
    vh = jnp.transpose(v, (0, 2, 1, 3))
    qb = q.reshape(B, nb, Q_BLOCK, H, Dh).transpose(1, 0, 3, 2, 4)
    Fb = Fh.reshape(B, H, nb, Q_BLOCK).transpose(2, 0, 1, 3)
    k_pos = jnp.arange(S)
    scale = Dh ** -0.5

    def block(args):
        q_blk, f_blk, blk_idx = args
        s = jnp.einsum('bhqd,bhkd->bhqk', q_blk, kh).astype(jnp.float32) * scale
        s = s + f_blk[..., :, None] - Fh[:, :, None, :]
        q_pos = blk_idx * Q_BLOCK + jnp.arange(Q_BLOCK)
        s = jnp.where(q_pos[:, None] >= k_pos[None, :], s, -jnp.inf)
        p = jax.nn.softmax(s, axis=-1)
        return jnp.einsum('bhqk,bhkd->bhqd', p.astype(vh.dtype), vh)

    out = lax.map(block, (qb, Fb, jnp.arange(nb)))
    return out.transpose(1, 0, 3, 2, 4).reshape(B, S, H * Dh)


def _causal_conv(x, w, b):
    C = x.shape[-1]
    y = lax.conv_general_dilated(
        x, w[:, None, :].astype(x.dtype), window_strides=(1,),
        padding=[(CONV_WIDTH - 1, 0)], dimension_numbers=('NWC', 'WIO', 'NWC'),
        feature_group_count=C)
    return y + b


def _rg_lru(xc, w_a, b_a, w_x, b_x, lam):
    B, S, C = xc.shape
    xg = xc.reshape(B, S, LRU_GROUPS, LRU_GROUP_DIM)
    r_gate = jax.nn.sigmoid((jnp.einsum('bsgi,gij->bsgj', xg, w_a).reshape(B, S, C) + b_a).astype(jnp.float32))
    i_gate = jax.nn.sigmoid((jnp.einsum('bsgi,gij->bsgj', xg, w_x).reshape(B, S, C) + b_x).astype(jnp.float32))
    log_a = -LRU_C * r_gate * jax.nn.softplus(-lam.astype(jnp.float32))
    a = jnp.exp(log_a)
    b = jnp.sqrt(-jnp.expm1(2.0 * log_a)) * (i_gate * xc.astype(jnp.float32))

    def combine(left, right):
        a_l, b_l = left
        a_r, b_r = right
        return a_l * a_r, a_r * b_l + b_r

    _, h = lax.associative_scan(combine, (a, b), axis=1)
    return h.astype(xc.dtype)


def _peer(h, w_q, subkeys, u, v):
    B, S, D = h.shape
    q = jnp.einsum('bsd,dk->bsk', h, w_q).reshape(B, S, PEER_HEADS, 2, PEER_HALF)
    s = jnp.einsum('bshpd,hpnd->bshpn', q, subkeys).astype(jnp.float32)
    s_top, i_top = lax.top_k(s, PEER_TOPK)
    cand = s_top[..., 0, :, None] + s_top[..., 1, None, :]
    cand_idx = i_top[..., 0, :, None] * PEER_N_KEYS + i_top[..., 1, None, :]
    cand = cand.reshape(B, S, PEER_HEADS, PEER_TOPK * PEER_TOPK)
    cand_idx = cand_idx.reshape(B, S, PEER_HEADS, PEER_TOPK * PEER_TOPK)
    best, pos = lax.top_k(cand, PEER_TOPK)
    expert_idx = jnp.take_along_axis(cand_idx, pos, axis=-1)
    gate = jax.nn.softmax(best, axis=-1).astype(h.dtype)

    nc = (B * S) // PEER_CHUNK
    hc = h.reshape(nc, PEER_CHUNK, D)
    ic = expert_idx.reshape(nc, PEER_CHUNK, PEER_HEADS, PEER_TOPK)
    gc = gate.reshape(nc, PEER_CHUNK, PEER_HEADS, PEER_TOPK)

    def chunk(args):
        xt, idx, g = args
        u_sel = u[idx]
        act = jax.nn.gelu(jnp.einsum('td,thkd->thk', xt, u_sel), approximate=False)
        v_sel = v[idx]
        return jnp.einsum('thk,thkd->td', g * act, v_sel)

    out = lax.map(chunk, (hc, ic, gc))
    return out.reshape(B, S, D)


def setup_inputs(seed: int = 0) -> dict:
    key = jax.random.key(seed)
    ks = jax.random.split(key, 26)
    L = DEPTH

    def nrm(k, shape, s):
        return jax.random.normal(k, shape, jnp.float32) * s

    x = nrm(ks[0], (BATCH, SEQ, D_MODEL), 1.0)
    c = nrm(ks[1], (BATCH, D_MODEL), 1.0)
    w_ada = nrm(ks[2], (L, D_MODEL, N_MOD * D_MODEL), D_MODEL ** -0.5)
    b_ada = nrm(ks[3], (L, N_MOD * D_MODEL), 0.02)
    norm_mix_g = 1.0 + nrm(ks[4], (L, D_MODEL), 0.02)
    norm_ffn_g = 1.0 + nrm(ks[5], (L, D_MODEL), 0.02)
    w_in = nrm(ks[6], (L, D_MODEL, IN_WIDTH), D_MODEL ** -0.5)
    b_in = nrm(ks[7], (L, IN_WIDTH), 0.02)
    forget_bias = jax.random.uniform(ks[8], (L, ATTN_HEADS), jnp.float32, 1.0, 4.0)
    b_in = b_in.at[:, V_END:F_END].add(forget_bias)
    q_norm_g = 1.0 + nrm(ks[9], (L, HEAD_DIM), 0.02)
    k_norm_g = 1.0 + nrm(ks[10], (L, HEAD_DIM), 0.02)
    conv_w = nrm(ks[11], (L, CONV_WIDTH, LRU_WIDTH), CONV_WIDTH ** -0.5)
    conv_b = nrm(ks[12], (L, LRU_WIDTH), 0.02)
    lru_wa = nrm(ks[13], (L, LRU_GROUPS, LRU_GROUP_DIM, LRU_GROUP_DIM), LRU_GROUP_DIM ** -0.5)
    lru_ba = nrm(ks[14], (L, LRU_WIDTH), 0.02)
    lru_wx = nrm(ks[15], (L, LRU_GROUPS, LRU_GROUP_DIM, LRU_GROUP_DIM), LRU_GROUP_DIM ** -0.5)
    lru_bx = nrm(ks[16], (L, LRU_WIDTH), 0.02)
    a_c = jax.random.uniform(ks[17], (L, LRU_WIDTH), jnp.float32, 0.9, 0.999)
    sig = a_c ** (1.0 / LRU_C)
    lru_lambda = jnp.log(sig) - jnp.log1p(-sig)
    w_attn_o = nrm(ks[18], (L, ATTN_WIDTH, D_MODEL), ATTN_WIDTH ** -0.5)
    w_lru_o = nrm(ks[19], (L, LRU_WIDTH, D_MODEL), LRU_WIDTH ** -0.5)
    w_out = nrm(ks[20], (L, D_MODEL, D_MODEL), D_MODEL ** -0.5)
    peer_wq = nrm(ks[21], (L, D_MODEL, PEER_HEADS * PEER_KEY_DIM), D_MODEL ** -0.5)
    peer_subkeys = nrm(ks[22], (L, PEER_HEADS, 2, PEER_N_KEYS, PEER_HALF), PEER_HALF ** -0.5)
    peer_u = nrm(ks[23], (L, PEER_N_EXPERTS, D_MODEL), D_MODEL ** -0.5)
    peer_v = nrm(ks[24], (L, PEER_N_EXPERTS, D_MODEL), 0.5)
    return {"x": x, "c": c, "w_ada": w_ada, "b_ada": b_ada,
            "norm_mix_g": norm_mix_g, "norm_ffn_g": norm_ffn_g,
            "w_in": w_in, "b_in": b_in, "q_norm_g": q_norm_g, "k_norm_g": k_norm_g,
            "conv_w": conv_w, "conv_b": conv_b, "lru_wa": lru_wa, "lru_ba": lru_ba,
            "lru_wx": lru_wx, "lru_bx": lru_bx, "lru_lambda": lru_lambda,
            "w_attn_o": w_attn_o, "w_lru_o": w_lru_o, "w_out": w_out,
            "peer_wq": peer_wq, "peer_subkeys": peer_subkeys, "peer_u": peer_u, "peer_v": peer_v}


def reference(x, c, w_ada, b_ada, norm_mix_g, norm_ffn_g, w_in, b_in, q_norm_g, k_norm_g,
              conv_w, conv_b, lru_wa, lru_ba, lru_wx, lru_bx, lru_lambda,
              w_attn_o, w_lru_o, w_out, peer_wq, peer_subkeys, peer_u, peer_v):
    B, S, D = x.shape
    for l in range(DEPTH):
        mod = jnp.einsum('bd,de->be', jax.nn.silu(c), w_ada[l]) + b_ada[l]
        shift1, scale1, gate1, shift2, scale2, gate2 = jnp.split(mod[:, None, :], N_MOD, axis=-1)

        h = _rmsnorm(x, norm_mix_g[l]) * (1.0 + scale1) + shift1
        proj = jnp.einsum('bsd,de->bse', h, w_in[l]) + b_in[l]
        q, k, v, f_logit, lru_x, lru_y, g_attn, g_lru = jnp.split(
            proj, [Q_END, K_END, V_END, F_END, LX_END, LY_END, GA_END], axis=-1)

        q = _rmsnorm(q.reshape(B, S, ATTN_HEADS, HEAD_DIM), q_norm_g[l])
        k = _rmsnorm(k.reshape(B, S, ATTN_HEADS, HEAD_DIM), k_norm_g[l])
        v = v.reshape(B, S, ATTN_HEADS, HEAD_DIM)
        log_f = jax.nn.log_sigmoid(f_logit.astype(jnp.float32))
        attn = _forgetting_attention(q, k, v, log_f)

        xc = _causal_conv(lru_x, conv_w[l], conv_b[l])
        lru = _rg_lru(xc, lru_wa[l], lru_ba[l], lru_wx[l], lru_bx[l], lru_lambda[l])
        lru = lru * jax.nn.gelu(lru_y, approximate=False)

        merged = (jax.nn.sigmoid(g_attn) * jnp.einsum('bse,ed->bsd', attn, w_attn_o[l])
                  + jax.nn.sigmoid(g_lru) * jnp.einsum('bse,ed->bsd', lru, w_lru_o[l]))
        x = x + gate1 * jnp.einsum('bsd,de->bse', merged, w_out[l])

        h2 = _rmsnorm(x, norm_ffn_g[l]) * (1.0 + scale2) + shift2
        x = x + gate2 * _peer(h2, peer_wq[l], peer_subkeys[l], peer_u[l], peer_v[l])
    return x
```

```cpp
#include <hip/hip_runtime.h>
#include <cstdio>
#include <cstdint>
namespace pg8 {
#define PG8_LAS __attribute__((address_space(3)))
typedef unsigned short bf16_t;
typedef short bf16x8 __attribute__((ext_vector_type(8)));
typedef float f32x4 __attribute__((ext_vector_type(4)));
typedef unsigned u32x4 __attribute__((ext_vector_type(4)));
constexpr int BM = 256, BK = 64, HALF = 128, HTB = HALF * BK * 2  , STAGE_BYTES = 8 * HTB, NXCD = 8, WGM = 8;

__host__ __device__ __forceinline__ int lds_byte(int r, int c) { const int st = (r >> 4) * 2 + (c >> 5), rr = r & 15, cc = c & 31, ob = rr * 64 + cc * 2; return st * 1024 + (ob ^ (((ob >> 9) & 1) << 5)); }
__host__ __device__ __forceinline__ void stage_rc(int b, int& R, int& C) { const int st = b / 1024, sb = b % 1024, swz = sb ^ (((sb >> 9) & 1) << 5); R = (st >> 1) * 16 + swz / 64; C = (st & 1) * 32 + (swz % 64) / 2; }
__host__ __device__ __forceinline__ int perm32(int rho) { const int n = rho >> 4, i = rho & 15; return 8 * (i >> 2) + 4 * n + (i & 3); }

struct Unit { int pm, pn; };
struct Gemm { const bf16_t* A; const bf16_t* Bt; int M, N, K; };

struct StaticOrder {
    int nM, nN, nwg, G, c;
    __host__ __device__ void init(int M, int N, int G_, int c_) { nM = M / BM; nN = N / BM; nwg = nM * nN; G = G_; c = c_; }
    __host__ __device__ bool next(int i, Unit& u) const {
        const long L = (long)i * G + c; if (L >= nwg) return false;
        int wgid = (int)L; { const int q = nwg / NXCD, r = nwg % NXCD, xcd = wgid % NXCD, off = wgid / NXCD; wgid = (xcd < r ? xcd * (q + 1) : r * (q + 1) + (xcd - r) * q) + off; }
        const int nig = WGM * nN, gid = wgid / nig, fm = gid * WGM, gsz = (nM - fm) < WGM ? (nM - fm) : WGM;
        u.pm = fm + ((wgid % nig) % gsz); u.pn = (wgid % nig) / gsz; return true;
    }
    __device__ __forceinline__ void a_ready(const Unit&) const {}
    __device__ __forceinline__ void done(const Unit&) const {}
};

__device__ __forceinline__ unsigned cvt_pk_bf16(float lo, float hi) { unsigned r; asm volatile("v_cvt_pk_bf16_f32 %0, %1, %2" : "=v"(r) : "v"(lo), "v"(hi)); return r; }
typedef float f32x2 __attribute__((ext_vector_type(2)));
__device__ __forceinline__ f32x2 gelu_pk(f32x2 v) {
    const f32x2 av = __builtin_elementwise_abs(v), d = av * 0.2316418882f + 1.0f;
    f32x2 t; t.x = __builtin_amdgcn_rcpf(d.x); t.y = __builtin_amdgcn_rcpf(d.y);
    f32x2 q = t * 0.5307027145f + (-0.7265760135f); q = q * t + 0.7107068705f; q = q * t + (-0.142248368f); q = q * t + 0.127414796f; q = q * t;
    const f32x2 s = (v * v) * (-0.72134752044f);
    f32x2 e; e.x = __builtin_amdgcn_exp2f(s.x); e.y = __builtin_amdgcn_exp2f(s.y);
    const f32x2 m = v * (q * e), r = v - m;
    f32x2 o; o.x = v.x < 0.f ? m.x : r.x; o.y = v.y < 0.f ? m.y : r.y; return o;
}

template <int ACT  > struct EpiBf16 {
    static constexpr bool PERM = true, AFTER_DRAIN = false; static_assert(ACT == 0 || ACT == 1, "EpiBf16: ACT is 0 (none) or 1 (gelu_pk)");
    bf16_t* O; int ldc; const float* bias; int split_cols; size_t split_stride; float scale0;
    __device__ __forceinline__ void operator()(const f32x4 (&acc)[2][2][4][2], const Unit& u, int wr, int wc, int fr, int fq) const {
        const int row0 = u.pm * BM + wr * 64 + fr; int colt = u.pn * BM; bf16_t* base = O;
        float sc = 1.f; if (split_cols) { const int t = colt / split_cols; base += (size_t)t * split_stride; colt -= t * split_cols; if (t == 0) sc = scale0; }
        const int col0 = colt + wc * 32 + 8 * fq, bcol0 = u.pn * BM + wc * 32 + 8 * fq;
        f32x4 bv[2][2];
#pragma unroll
        for (int bj = 0; bj < 2; ++bj)
#pragma unroll
            for (int n = 0; n < 2; ++n) bv[bj][n] = bias ? *(const f32x4*)(bias + bcol0 + bj * HALF + 4 * n) : (f32x4){0.f, 0.f, 0.f, 0.f};
#pragma unroll
        for (int ai = 0; ai < 2; ++ai)
#pragma unroll
            for (int m = 0; m < 4; ++m) { bf16_t* rowp = base + (size_t)(row0 + ai * HALF + m * 16) * ldc + col0;
#pragma unroll
                for (int bj = 0; bj < 2; ++bj) { f32x4 v0 = acc[ai][bj][m][0] + bv[bj][0], v1 = acc[ai][bj][m][1] + bv[bj][1];
                    if (ACT == 1) { f32x2 a = gelu_pk((f32x2){v0[0], v0[1]}), b = gelu_pk((f32x2){v0[2], v0[3]}), c = gelu_pk((f32x2){v1[0], v1[1]}), d = gelu_pk((f32x2){v1[2], v1[3]});
                        v0 = (f32x4){a.x, a.y, b.x, b.y}; v1 = (f32x4){c.x, c.y, d.x, d.y}; }
                    v0 = v0 * sc; v1 = v1 * sc; u32x4 w; w.x = cvt_pk_bf16(v0[0], v0[1]); w.y = cvt_pk_bf16(v0[2], v0[3]); w.z = cvt_pk_bf16(v1[0], v1[1]); w.w = cvt_pk_bf16(v1[2], v1[3]);
                    *(u32x4*)(rowp + bj * HALF) = w; } }
    }
};
__device__ __forceinline__ f32x4 sigm4(f32x4 v) { f32x4 o;
#pragma unroll
    for (int j = 0; j < 4; ++j) o[j] = __builtin_amdgcn_rcpf(1.0f + __builtin_amdgcn_exp2f(-1.4426950408889634f * v[j]));
    return o; }
__device__ __forceinline__ f32x4 gelu4(f32x4 v) { const f32x2 a = gelu_pk((f32x2){v[0], v[1]}), b = gelu_pk((f32x2){v[2], v[3]}); return (f32x4){a.x, a.y, b.x, b.y}; }
__device__ __forceinline__ void unpack8(const u32x4 w, f32x4& lo, f32x4& hi) {
    lo = (f32x4){__uint_as_float(w.x << 16), __uint_as_float(w.x & 0xffff0000u), __uint_as_float(w.y << 16), __uint_as_float(w.y & 0xffff0000u)};
    hi = (f32x4){__uint_as_float(w.z << 16), __uint_as_float(w.z & 0xffff0000u), __uint_as_float(w.w << 16), __uint_as_float(w.w & 0xffff0000u)}; }
struct EpiIn {
    static constexpr bool PERM = true, AFTER_DRAIN = false;
    bf16_t* qkv; bf16_t* lx; bf16_t* gy; bf16_t* ga; bf16_t* gl; const float* bias;
    __device__ __forceinline__ void operator()(const f32x4 (&acc)[2][2][4][2], const Unit& u, int wr, int wc, int fr, int fq) const {
        const int pn = u.pn; bf16_t* base; int ldc, colt, act;
        if (pn < 24) { base = qkv + (size_t)(pn >> 3) * ((size_t)8192 * 2048); ldc = 2048; colt = (pn & 7) * 256; act = 0; }
        else if (pn < 32) { base = lx; ldc = 2048; colt = (pn - 24) * 256; act = 0; }
        else if (pn < 40) { base = gy; ldc = 2048; colt = (pn - 32) * 256; act = 1; }
        else if (pn < 56) { base = ga; ldc = 4096; colt = (pn - 40) * 256; act = 2; }
        else { base = gl; ldc = 4096; colt = (pn - 56) * 256; act = 2; }
        const int row0 = u.pm * BM + wr * 64 + fr, col0 = colt + wc * 32 + 8 * fq, bcol0 = pn * BM + wc * 32 + 8 * fq;
        f32x4 bv[2][2];
#pragma unroll
        for (int bj = 0; bj < 2; ++bj)
#pragma unroll
            for (int n = 0; n < 2; ++n) bv[bj][n] = *(const f32x4*)(bias + bcol0 + bj * HALF + 4 * n);
#pragma unroll
        for (int ai = 0; ai < 2; ++ai)
#pragma unroll
            for (int m = 0; m < 4; ++m) { bf16_t* rowp = base + (size_t)(row0 + ai * HALF + m * 16) * ldc + col0;
#pragma unroll
                for (int bj = 0; bj < 2; ++bj) { f32x4 v0 = acc[ai][bj][m][0] + bv[bj][0], v1 = acc[ai][bj][m][1] + bv[bj][1];
                    if (act == 1) { v0 = gelu4(v0); v1 = gelu4(v1); }
                    else if (act == 2) { v0 = sigm4(v0); v1 = sigm4(v1); }
                    u32x4 w; w.x = cvt_pk_bf16(v0[0], v0[1]); w.y = cvt_pk_bf16(v0[2], v0[3]); w.z = cvt_pk_bf16(v1[0], v1[1]); w.w = cvt_pk_bf16(v1[2], v1[3]);
                    *(u32x4*)(rowp + bj * HALF) = w; } }
    }
};
template <int MODE> struct EpiGate {
    static constexpr bool PERM = true, AFTER_DRAIN = false;
    bf16_t* O; const bf16_t* Gt; int ldc;
    __device__ __forceinline__ void operator()(const f32x4 (&acc)[2][2][4][2], const Unit& u, int wr, int wc, int fr, int fq) const {
        const int row0 = u.pm * BM + wr * 64 + fr, col0 = u.pn * BM + wc * 32 + 8 * fq;
#pragma unroll
        for (int ai = 0; ai < 2; ++ai)
#pragma unroll
            for (int m = 0; m < 4; ++m) { const size_t off = (size_t)(row0 + ai * HALF + m * 16) * ldc + col0;
#pragma unroll
                for (int bj = 0; bj < 2; ++bj) { f32x4 g0, g1; unpack8(*(const u32x4*)(Gt + off + bj * HALF), g0, g1);
                    f32x4 v0 = acc[ai][bj][m][0] * g0, v1 = acc[ai][bj][m][1] * g1;
                    if (MODE == 1) { f32x4 t0, t1; unpack8(*(const u32x4*)(O + off + bj * HALF), t0, t1); v0 += t0; v1 += t1; }
                    u32x4 w; w.x = cvt_pk_bf16(v0[0], v0[1]); w.y = cvt_pk_bf16(v0[2], v0[3]); w.z = cvt_pk_bf16(v1[0], v1[1]); w.w = cvt_pk_bf16(v1[2], v1[3]);
                    *(u32x4*)(O + off + bj * HALF) = w; } }
    }
};
struct EpiRes {
    static constexpr bool PERM = false, AFTER_DRAIN = false;
    const float* X; float* Out; const float* gate; int ldc;
    __device__ __forceinline__ void operator()(const f32x4 (&acc)[2][2][4][2], const Unit& u, int wr, int wc, int fr, int fq) const {
        const int row0 = u.pm * BM + wr * 64 + fr, col0 = u.pn * BM + wc * 32 + 4 * fq;
        f32x4 gv[2][2];
#pragma unroll
        for (int bj = 0; bj < 2; ++bj)
#pragma unroll
            for (int n = 0; n < 2; ++n) gv[bj][n] = *(const f32x4*)(gate + col0 + bj * HALF + n * 16);
#pragma unroll
        for (int ai = 0; ai < 2; ++ai)
#pragma unroll
            for (int m = 0; m < 4; ++m) { const size_t off = (size_t)(row0 + ai * HALF + m * 16) * ldc + col0;
#pragma unroll
                for (int bj = 0; bj < 2; ++bj)
#pragma unroll
                    for (int n = 0; n < 2; ++n) { const f32x4 xv = *(const f32x4*)(X + off + bj * HALF + n * 16);
                        *(f32x4*)(Out + off + bj * HALF + n * 16) = xv + gv[bj][n] * acc[ai][bj][m][n]; } }
    }
};
template <class Epi, class Sched, bool ALIGN_EPI = false, bool SP2 = false>
__device__ __forceinline__ void gemm_phase(PG8_LAS unsigned char* lds, const Gemm g, const Sched& S, const Epi& E) {
    const int tid = threadIdx.x, wid = __builtin_amdgcn_readfirstlane(tid >> 6), lane = tid & 63, wr = wid >> 2, wc = wid & 3, fr = lane & 15, fq = lane >> 4;
    const int K = g.K, nt = K / BK;
    unsigned voffA[2], voffB[2];
#pragma unroll
    for (int i = 0; i < 2; ++i) { int R, C; stage_rc(tid * 16 + i * 8192, R, C); const int Rb = Epi::PERM ? ((R & ~31) + perm32(R & 31)) : R;
        voffA[i] = (unsigned)(R * K + C) * 2u; voffB[i] = (unsigned)(Rb * K + C) * 2u; }
    const size_t kstep = (size_t)(BK * 2);
    const size_t hstep = (size_t)HALF * K * 2;
    const size_t tstep = 2 * hstep;
    const unsigned ldsw = (unsigned)wid * 1024u;
    const int aoff = lds_byte(wr * 64 + fr, fq * 8), boff = lds_byte(wc * 32 + fr, fq * 8);
#define PG8_SA(b, h) (((b) * 2 + (h)) * HTB)
#define PG8_SB(b, h) ((4 + (b) * 2 + (h)) * HTB)
#define PG8_STAGE(bufoff, gbase, voff) do { _Pragma("unroll") for (int _i = 0; _i < 2; ++_i) \
        __builtin_amdgcn_global_load_lds((const unsigned*)((const char*)(gbase) + (voff)[_i]), (PG8_LAS unsigned*)(lds + (bufoff) + ldsw + _i * 8192), 16, 0, 0); } while (0)
#define PG8_LDA(dst, b, h) do { _Pragma("unroll") for (int m = 0; m < 4; ++m) _Pragma("unroll") for (int k = 0; k < 2; ++k) dst[m][k] = *(const PG8_LAS bf16x8*)(lds + PG8_SA(b, h) + aoff + m * 2048 + k * 1024); } while (0)
#define PG8_LDB(dst, b, h) do { _Pragma("unroll") for (int n = 0; n < 2; ++n) _Pragma("unroll") for (int k = 0; k < 2; ++k) dst[n][k] = *(const PG8_LAS bf16x8*)(lds + PG8_SB(b, h) + boff + n * 2048 + k * 1024); } while (0)
#define PG8_MMA(ai, bj, At, Bt) do { __builtin_amdgcn_s_setprio(1); _Pragma("unroll") for (int m = 0; m < 4; ++m) _Pragma("unroll") for (int n = 0; n < 2; ++n) _Pragma("unroll") for (int k = 0; k < 2; ++k) \
        acc[ai][bj][m][n] = __builtin_amdgcn_mfma_f32_16x16x32_bf16(Bt[n][k], At[m][k], acc[ai][bj][m][n], 0, 0, 0); __builtin_amdgcn_s_setprio(0); } while (0)
#define PG8_WAIT_V(n) asm volatile("s_waitcnt vmcnt(" #n ")" ::: "memory")
#define PG8_WAIT_L(n) asm volatile("s_waitcnt lgkmcnt(" #n ")" ::: "memory")
#define PG8_BAR __builtin_amdgcn_s_barrier()
#define PG8_SCHED __builtin_amdgcn_sched_barrier(0)
    Unit cur, nxt; int ui = 0;
    if (!S.next(0, cur)) return;
    f32x4 acc[2][2][4][2];
#pragma unroll
    for (int a = 0; a < 2; ++a)
#pragma unroll
        for (int b = 0; b < 2; ++b)
#pragma unroll
            for (int m = 0; m < 4; ++m)
#pragma unroll
                for (int n = 0; n < 2; ++n) acc[a][b][m][n] = (f32x4){0.f, 0.f, 0.f, 0.f};
    bf16x8 At[4][2], B0[2][2], B1[2][2];
    const char* cA = (const char*)g.A + (size_t)cur.pm * tstep; const char* cB = (const char*)g.Bt + (size_t)cur.pn * tstep;
    S.a_ready(cur);
    if constexpr (SP2) {
        PG8_STAGE(PG8_SB(0, 0), cB, voffB); PG8_STAGE(PG8_SB(0, 1), cB + hstep, voffB); PG8_STAGE(PG8_SA(0, 0), cA, voffA); PG8_STAGE(PG8_SA(0, 1), cA + hstep, voffA);
        if (wr == 1) PG8_BAR;
        PG8_WAIT_V(2); PG8_BAR;
        PG8_STAGE(PG8_SB(1, 0), cB + kstep, voffB); PG8_STAGE(PG8_SA(1, 0), cA + kstep, voffA); PG8_STAGE(PG8_SB(1, 1), cB + hstep + kstep, voffB);
        PG8_WAIT_V(6); PG8_BAR;
    } else {
        PG8_STAGE(PG8_SB(0, 0), cB, voffB); PG8_STAGE(PG8_SA(0, 0), cA, voffA); PG8_STAGE(PG8_SB(0, 1), cB + hstep, voffB); PG8_STAGE(PG8_SA(0, 1), cA + hstep, voffA);
        if (wr == 1) PG8_BAR;
        PG8_WAIT_V(4); PG8_BAR;
        PG8_STAGE(PG8_SB(1, 0), cB + kstep, voffB); PG8_STAGE(PG8_SA(1, 0), cA + kstep, voffA); PG8_STAGE(PG8_SB(1, 1), cB + hstep + kstep, voffB);
        PG8_WAIT_V(6); PG8_BAR;
    }
    for (;;) {
        const bool has_next = S.next(ui + 1, nxt);
        const char* nA = has_next ? (const char*)g.A + (size_t)nxt.pm * tstep : cA; const char* nB = has_next ? (const char*)g.Bt + (size_t)nxt.pn * tstep : cB;
        for (int t = 0; t < nt; t += 2) {
            const bool last = (t == nt - 2);
            const char* a1 = cA + (size_t)(t + 1) * kstep;
            const char* a2 = last ? nA : cA + (size_t)(t + 2) * kstep; const char* b2 = last ? nB : cB + (size_t)(t + 2) * kstep;
            const char* a3 = a2 + kstep; const char* b3 = b2 + kstep;
            if (last && has_next) S.a_ready(nxt);
            if constexpr (SP2) {
            PG8_LDB(B0, 0, 0); PG8_LDB(B1, 0, 1); PG8_SCHED; PG8_LDA(At, 0, 0); PG8_STAGE(PG8_SA(1, 1), a1 + hstep, voffA);
            PG8_WAIT_V(8); PG8_WAIT_L(0); PG8_BAR; PG8_MMA(0, 0, At, B0); PG8_MMA(0, 1, At, B1); PG8_BAR; PG8_SCHED;
            PG8_LDA(At, 0, 1); PG8_STAGE(PG8_SB(0, 0), b2, voffB); PG8_STAGE(PG8_SB(0, 1), b2 + hstep, voffB); PG8_STAGE(PG8_SA(0, 0), a2, voffA);
            PG8_WAIT_V(8); PG8_WAIT_L(0); PG8_BAR; PG8_MMA(1, 0, At, B0); PG8_MMA(1, 1, At, B1); PG8_BAR; PG8_SCHED;
            PG8_LDB(B0, 1, 0); PG8_LDB(B1, 1, 1); PG8_SCHED; PG8_LDA(At, 1, 0); PG8_STAGE(PG8_SA(0, 1), a2 + hstep, voffA);
            PG8_WAIT_V(8); PG8_WAIT_L(0); PG8_BAR; PG8_MMA(0, 0, At, B0); PG8_MMA(0, 1, At, B1); PG8_BAR; PG8_SCHED;
            PG8_LDA(At, 1, 1); PG8_STAGE(PG8_SB(1, 0), b3, voffB); PG8_STAGE(PG8_SB(1, 1), b3 + hstep, voffB); PG8_STAGE(PG8_SA(1, 0), a3, voffA);
            PG8_WAIT_V(8); PG8_WAIT_L(0); PG8_BAR; PG8_MMA(1, 0, At, B0); PG8_MMA(1, 1, At, B1); PG8_BAR; PG8_SCHED;
            } else {
            PG8_LDB(B0, 0, 0); PG8_SCHED; PG8_LDA(At, 0, 0); PG8_STAGE(PG8_SA(1, 1), a1 + hstep, voffA);
            PG8_WAIT_L(8); PG8_BAR; PG8_WAIT_L(0); PG8_MMA(0, 0, At, B0); PG8_BAR; PG8_SCHED;
            PG8_LDB(B1, 0, 1); PG8_STAGE(PG8_SB(0, 0), b2, voffB);
            PG8_BAR; PG8_WAIT_L(0); PG8_MMA(0, 1, At, B1); PG8_BAR;
            PG8_LDA(At, 0, 1); PG8_STAGE(PG8_SA(0, 0), a2, voffA);
            PG8_BAR; PG8_WAIT_L(0); PG8_MMA(1, 0, At, B0); PG8_BAR; PG8_SCHED;
            PG8_STAGE(PG8_SB(0, 1), b2 + hstep, voffB);
            PG8_WAIT_V(6); PG8_BAR; PG8_MMA(1, 1, At, B1); PG8_BAR;
            PG8_LDB(B0, 1, 0); PG8_SCHED; PG8_LDA(At, 1, 0); PG8_STAGE(PG8_SA(0, 1), a2 + hstep, voffA);
            PG8_WAIT_L(8); PG8_BAR; PG8_WAIT_L(0); PG8_MMA(0, 0, At, B0); PG8_BAR; PG8_SCHED;
            PG8_LDB(B1, 1, 1); PG8_STAGE(PG8_SB(1, 0), b3, voffB);
            PG8_BAR; PG8_WAIT_L(0); PG8_MMA(0, 1, At, B1); PG8_BAR;
            PG8_LDA(At, 1, 1); PG8_STAGE(PG8_SA(1, 0), a3, voffA);
            PG8_BAR; PG8_WAIT_L(0); PG8_MMA(1, 0, At, B0); PG8_BAR; PG8_SCHED;
            PG8_STAGE(PG8_SB(1, 1), b3 + hstep, voffB);
            PG8_WAIT_V(6); PG8_BAR; PG8_MMA(1, 1, At, B1); PG8_BAR;
            }
        }
        if constexpr (ALIGN_EPI) { if (wr == 0) PG8_BAR; }
        if constexpr (!Epi::AFTER_DRAIN) { E(acc, cur, wr, wc, fr, fq); S.done(cur); }
        if (!has_next) break;
#pragma unroll
        for (int a = 0; a < 2; ++a)
#pragma unroll
            for (int b = 0; b < 2; ++b)
#pragma unroll
                for (int m = 0; m < 4; ++m)
#pragma unroll
                    for (int n = 0; n < 2; ++n) acc[a][b][m][n] = (f32x4){0.f, 0.f, 0.f, 0.f};
        cur = nxt; cA = nA; cB = nB; ++ui;
        if constexpr (ALIGN_EPI) { if (wr == 1) PG8_BAR; }
    }
    PG8_WAIT_V(0);
    if constexpr (!ALIGN_EPI) { if (wr == 0) PG8_BAR; }
    PG8_BAR;
    if constexpr (Epi::AFTER_DRAIN) { E.fused(acc, cur, wr, wc, fr, fq, lds, wid, lane); S.done(cur); }
#undef PG8_SA
#undef PG8_SB
#undef PG8_STAGE
#undef PG8_LDA
#undef PG8_LDB
#undef PG8_MMA
#undef PG8_WAIT_V
#undef PG8_WAIT_L
#undef PG8_BAR
#undef PG8_SCHED
}
}
namespace attn_body {
constexpr int D = 128, LD = 2048;
constexpr float THR = 8.f; constexpr bool WSKIP = false;
constexpr float SCALE = 0.08838834764831845f;
constexpr int NW = 8, QBLK = 32, KVBLK = 64, QB = NW * QBLK;
constexpr int SHM_V = KVBLK * D * 2, SHM_K = KVBLK * D * 2;
constexpr int LDS_BYTES = 2 * SHM_V + 2 * SHM_K + NW * 64 * 4;

typedef short bf16x8 __attribute__((ext_vector_type(8)));
typedef short s16x4 __attribute__((ext_vector_type(4)));
typedef float f32x16 __attribute__((ext_vector_type(16)));
typedef float f32x4 __attribute__((ext_vector_type(4)));
typedef unsigned u32x4 __attribute__((ext_vector_type(4)));
template <class A, class Bt> struct same_t { static constexpr bool v = false; };
template <class A> struct same_t<A, A> { static constexpr bool v = true; };

#define KSWZ(row, colB) ((row) * 256 + ((colB) ^ (((row) & 7) << 4)))
#define SBAR() __builtin_amdgcn_sched_barrier(0)
__device__ __forceinline__ int v_st(int k, int c) { const int kk = (k & ~0xC) | ((k & 4) << 1) | ((k & 8) >> 1); return ((kk >> 3) * 4 + (c >> 5)) * 512 + ((kk & 7) * 32 + (c & 31)) * 2; }
__device__ __forceinline__ int v_rd_base(int lane) { return ((lane & 3) << 3) | (((lane >> 2) & 3) << 6) | (((lane >> 4) & 1) << 5) | (((lane >> 5) & 1) << 8); }
constexpr int v_rd_off(int d0, int ks, int half) { return d0 * 512 + ks * 4096 + half * 2048; }
__device__ __forceinline__ int crow(int r, int hi) { return (r & 3) + 8 * (r >> 2) + 4 * hi; }
__device__ __forceinline__ unsigned cvtpk(float lo, float hi) {
    unsigned r; asm volatile("v_cvt_pk_bf16_f32 %0, %1, %2" : "=v"(r) : "v"(lo), "v"(hi)); return r;
}
__device__ __forceinline__ bf16x8 pack8(f32x4 a, f32x4 b) {
    u32x4 w = {cvtpk(a[0], a[1]), cvtpk(a[2], a[3]), cvtpk(b[0], b[1]), cvtpk(b[2], b[3])};
    return *reinterpret_cast<bf16x8*>(&w);
}
template <class T> __device__ __forceinline__ bf16x8 load8(const T* p) {
    if constexpr (same_t<T, float>::v) { return pack8(*(const f32x4*)p, *(const f32x4*)(p + 4)); }
    else { return *reinterpret_cast<const bf16x8*>(p); }
}
__device__ __forceinline__ void mask_tile(f32x16& p0, f32x16& p1, int dq, unsigned W) {
    const float NEG = -__builtin_inff();
#pragma unroll
    for (int r = 0; r < 16; ++r) {
        const int c = (r & 3) + 8 * (r >> 2);
        if ((unsigned)(dq - c) >= W) p0[r] = NEG;
        if ((unsigned)(dq - c - 32) >= W) p1[r] = NEG;
    }
}
__device__ __forceinline__ void partialSM(f32x16& p0, f32x16& p1, float& m_reg, float& mn, float& alpha) {
    float pmax = p0[0]; for (int r = 1; r < 16; ++r) pmax = fmaxf(pmax, p0[r]); for (int r = 0; r < 16; ++r) pmax = fmaxf(pmax, p1[r]);
    { auto rr = __builtin_amdgcn_permlane32_swap(__float_as_uint(pmax), __float_as_uint(pmax), false, false);
      pmax = fmaxf(__uint_as_float(rr[0]), __uint_as_float(rr[1])); }
    constexpr float C2 = 1.4426950408889634f * SCALE;
    if (__builtin_expect(__all((pmax - m_reg) * SCALE <= THR), 1)) { mn = m_reg; alpha = 1.f; }
    else { mn = fmaxf(m_reg, pmax); alpha = __builtin_amdgcn_exp2f((m_reg - mn) * C2); m_reg = mn; }
    const float mnL = -mn * C2;
    for (int r = 0; r < 16; ++r) p0[r] = fmaf(p0[r], C2, mnL); for (int r = 0; r < 16; ++r) p1[r] = fmaf(p1[r], C2, mnL);
    for (int r = 0; r < 16; ++r) p0[r] = __builtin_amdgcn_exp2f(p0[r]);
}
__device__ __forceinline__ void finishSM(f32x16& p0, f32x16& p1, float alpha, float& l_reg, bf16x8& pa0, bf16x8& pa1, bf16x8& pa2, bf16x8& pa3) {
    for (int r = 0; r < 16; ++r) p1[r] = __builtin_amdgcn_exp2f(p1[r]);
    float ps = 0; for (int r = 0; r < 16; ++r) ps += p0[r]; for (int r = 0; r < 16; ++r) ps += p1[r];
    { auto rr = __builtin_amdgcn_permlane32_swap(__float_as_uint(ps), __float_as_uint(ps), false, false);
      ps = __uint_as_float(rr[0]) + __uint_as_float(rr[1]); }
    l_reg = l_reg * alpha + ps;
#define PK4(P, B_, OUT) do { unsigned a0 = cvtpk(P[B_+0], P[B_+1]), a1 = cvtpk(P[B_+2], P[B_+3]);                          \
        unsigned b0 = cvtpk(P[B_+4], P[B_+5]), b1 = cvtpk(P[B_+6], P[B_+7]);                                             \
        auto r0 = __builtin_amdgcn_permlane32_swap(a0, b0, false, false); auto r1 = __builtin_amdgcn_permlane32_swap(a1, b1, false, false); \
        u32x4 w = {r0[0], r1[0], r0[1], r1[1]}; OUT = *reinterpret_cast<bf16x8*>(&w); } while (0)
    PK4(p0, 0, pa0); PK4(p0, 8, pa1); PK4(p1, 0, pa2); PK4(p1, 8, pa3);
#undef PK4
}
template <int KB, bool SK>
__device__ __forceinline__ void qkt(f32x16& p0, f32x16& p1, const char* K_lds, int r32, int hi, const bf16x8* qr, bool act, const float* bt) {
    if (SK && !act) { const float NEG = -__builtin_inff();
#pragma unroll
        for (int r = 0; r < 16; ++r) { p0[r] = NEG; p1[r] = NEG; } return; }
    { const f32x4 b0 = *(const f32x4*)(bt), b1 = *(const f32x4*)(bt + 8), b2 = *(const f32x4*)(bt + 16), b3 = *(const f32x4*)(bt + 24);
      const f32x4 c0 = *(const f32x4*)(bt + 32), c1 = *(const f32x4*)(bt + 40), c2 = *(const f32x4*)(bt + 48), c3 = *(const f32x4*)(bt + 56);
      p0 = (f32x16){b0[0], b0[1], b0[2], b0[3], b1[0], b1[1], b1[2], b1[3], b2[0], b2[1], b2[2], b2[3], b3[0], b3[1], b3[2], b3[3]};
      p1 = (f32x16){c0[0], c0[1], c0[2], c0[3], c1[0], c1[1], c1[2], c1[3], c2[0], c2[1], c2[2], c2[3], c3[0], c3[1], c3[2], c3[3]}; }
    const char* kb[4];
#pragma unroll
    for (int dd = 0; dd < 4; ++dd) kb[dd] = K_lds + KB * SHM_K + KSWZ(r32, (dd * 16 + hi * 8) * 2);
#pragma unroll
    for (int d0 = 0; d0 < 8; ++d0) { const char* a = kb[d0 & 3] + (d0 >> 2) * 128;
        bf16x8 b0 = *reinterpret_cast<const bf16x8*>(a);
        bf16x8 b1 = *reinterpret_cast<const bf16x8*>(a + 32 * 256);
        p0 = __builtin_amdgcn_mfma_f32_32x32x16_bf16(b0, qr[d0], p0, 0, 0, 0);
        p1 = __builtin_amdgcn_mfma_f32_32x32x16_bf16(b1, qr[d0], p1, 0, 0, 0); }
}
template <int VB, bool SK>
__device__ __forceinline__ void pv_tile(f32x16* o, int vb0, bf16x8 pa0, bf16x8 pa1, bf16x8 pa2, bf16x8 pa3, bool act) {
    if (SK && !act) return;
#define TRRD(dst, off) asm volatile("ds_read_b64_tr_b16 %0, %1 offset:%2" : "=&v"(dst) : "v"(vb0), "i"(off) : "memory")
#define PV_D0(d0) do { s16x4 l0, l1, l2, l3, h0, h1, h2, h3; constexpr int b_ = VB * SHM_V + v_rd_off(d0, 0, 0);     \
        TRRD(l0, b_); TRRD(h0, b_ + 2048); TRRD(l1, b_ + 4096); TRRD(h1, b_ + 6144); TRRD(l2, b_ + 8192); TRRD(h2, b_ + 10240); TRRD(l3, b_ + 12288); TRRD(h3, b_ + 14336); \
        asm volatile("s_waitcnt lgkmcnt(0)" ::: "memory"); SBAR();                 \
        o[d0] = __builtin_amdgcn_mfma_f32_32x32x16_bf16(pa0, (bf16x8){l0[0], l0[1], l0[2], l0[3], h0[0], h0[1], h0[2], h0[3]}, o[d0], 0, 0, 0);   \
        o[d0] = __builtin_amdgcn_mfma_f32_32x32x16_bf16(pa1, (bf16x8){l1[0], l1[1], l1[2], l1[3], h1[0], h1[1], h1[2], h1[3]}, o[d0], 0, 0, 0);   \
        o[d0] = __builtin_amdgcn_mfma_f32_32x32x16_bf16(pa2, (bf16x8){l2[0], l2[1], l2[2], l2[3], h2[0], h2[1], h2[2], h2[3]}, o[d0], 0, 0, 0);   \
        o[d0] = __builtin_amdgcn_mfma_f32_32x32x16_bf16(pa3, (bf16x8){l3[0], l3[1], l3[2], l3[3], h3[0], h3[1], h3[2], h3[3]}, o[d0], 0, 0, 0); } while (0)
    PV_D0(0); PV_D0(1); PV_D0(2); PV_D0(3);
#undef PV_D0
#undef TRRD
}


template <class TIn, class TOut> struct BlockRef { const TIn* Q; const TIn* K; const TIn* V; TOut* O; int P0; int jlo; };
#define ROW(p, k0, rr) ((p) + (size_t)((k0) + (rr)) * LD + sc)
#define VMW() asm volatile("s_waitcnt vmcnt(0)" ::: "memory")
#define SLOAD_H(Kp, Vp, k0) do { st_v0 = load8<TIn>(ROW(Vp, k0, sr)); st_v1 = load8<TIn>(ROW(Vp, k0, 32 + sr));              \
                         st_k0 = load8<TIn>(ROW(Kp, k0, sr)); st_k1 = load8<TIn>(ROW(Kp, k0, 32 + sr)); } while (0)
#define SWRITE_H(bf) do { *(bf16x8*)(V_lds + (bf) * SHM_V + vst0) = st_v0; *(bf16x8*)(V_lds + (bf) * SHM_V + vst1) = st_v1;   \
                          *(bf16x8*)(K_lds + (bf) * SHM_K + kws) = st_k0; *(bf16x8*)(K_lds + (bf) * SHM_K + kws + 32 * 256) = st_k1; } while (0)
template <class TIn, class TOut>
__device__ __forceinline__ void attn_unit(const BlockRef<TIn, TOut>& cur, int skv, char* lds) {
    const int tid = threadIdx.x, wid = __builtin_amdgcn_readfirstlane(tid >> 6), lane = tid & 63, r32 = lane & 31, hi = lane >> 5;
    const unsigned W = 0x40000000u;
    const int j_lo = cur.jlo;
    int j_hi = (cur.P0 + QB - 1) / KVBLK + 1; if (j_hi > skv / KVBLK) j_hi = skv / KVBLK;
    const int NT = j_hi - j_lo;
    const int qlo = cur.P0 + wid * QBLK, qm = qlo + r32 - 4 * hi;
    char* V_lds = lds; char* K_lds = lds + 2 * SHM_V;
    float* ws = (float*)(lds + 2 * SHM_V + 2 * SHM_K) + wid * 64; float* li_l = ws, * al_l = ws + 32;
    const float* bias_l = (const float*)(lds + LDS_BYTES) + 4 * hi;
    float m_reg = -1e30f, l_reg = 0; f32x16 o[4] = {};
    const int sr = tid >> 4, sc = (tid & 15) * 8, vst0 = v_st(sr, sc), vst1 = v_st(32 + sr, sc), kws = KSWZ(sr, sc * 2);
    const int vb0 = (int)(uintptr_t)V_lds + v_rd_base(lane);
    const TIn* Kh = cur.K; const TIn* Vh = cur.V;
    bf16x8 st_v0, st_v1, st_k0, st_k1; bf16x8 qr[8];
#define KBASE(t) ((j_lo + (t)) * KVBLK)
#define BT(t) (bias_l + (t) * KVBLK)
#define RESC(a) do { if (__any((a) < 1.f)) { if (hi == 0) al_l[r32] = (a); asm volatile("s_waitcnt lgkmcnt(0)" ::: "memory");              \
                     for (int d_ = 0; d_ < 4; ++d_) for (int r = 0; r < 16; ++r) o[d_][r] *= al_l[crow(r, hi)]; } } while (0)
#define MASKT(P0_, P1_, t) do { const int kb_ = KBASE(t); if (kb_ + KVBLK - 1 > qlo) mask_tile(P0_, P1_, qm - kb_, W); } while (0)
#pragma unroll
    for (int d0 = 0; d0 < 8; ++d0) qr[d0] = load8<TIn>(cur.Q + (size_t)(wid * QBLK + r32) * LD + d0 * 16 + hi * 8);
    SLOAD_H(Kh, Vh, KBASE(0)); VMW(); SWRITE_H(0); SBAR();
    if (NT > 1) SLOAD_H(Kh, Vh, KBASE(1));
    __syncthreads();
    f32x16 p0, p1; float mn, al; bf16x8 pa0, pa1, pa2, pa3;
#define TILE_STEP(t, BUF) do {                                                                                                 \
        SBAR(); qkt<BUF, false>(p0, p1, K_lds, r32, hi, qr, true, BT(t));                                                       \
        MASKT(p0, p1, (t)); partialSM(p0, p1, m_reg, mn, al); RESC(al);                                                          \
        finishSM(p0, p1, al, l_reg, pa0, pa1, pa2, pa3); SBAR();                                                                 \
        pv_tile<BUF, false>(o, vb0, pa0, pa1, pa2, pa3, true);                                                                    \
        if ((t) + 1 < NT) { VMW(); SWRITE_H(1 - (BUF)); SBAR(); if ((t) + 2 < NT) SLOAD_H(Kh, Vh, KBASE((t) + 2)); }              \
        __syncthreads(); } while (0)
    for (int t = 0; t < NT; t += 2) {
        TILE_STEP(t, 0);
        if (t + 1 < NT) TILE_STEP(t + 1, 1);
    }
    if (hi == 0) li_l[r32] = l_reg; asm volatile("s_waitcnt lgkmcnt(0)" ::: "memory");
    float rli[16];
#pragma unroll
    for (int r = 0; r < 16; ++r) rli[r] = __builtin_amdgcn_rcpf(li_l[crow(r, hi)]);
    TOut* Ow = cur.O + (size_t)(wid * QBLK) * LD;
#pragma unroll
    for (int r = 0; r < 16; ++r) { const int orow = crow(r, hi);
#pragma unroll
        for (int d0 = 0; d0 < 4; ++d0) { const float v = o[d0][r] * rli[r];
            const float vn = __shfl_xor(v, 1);
            if ((r32 & 1) == 0) *(unsigned*)(Ow + (size_t)orow * LD + d0 * 32 + r32) = cvtpk(v, vn); } }
    __syncthreads();
#undef TILE_STEP
#undef RESC
#undef KBASE
#undef BT
#undef MASKT
}
#undef ROW
#undef VMW
#undef SLOAD_H
#undef SWRITE_H
}
#define GAS __attribute__((address_space(1)))
#define LAS __attribute__((address_space(3)))
typedef unsigned short bf16;
typedef unsigned v4u __attribute__((ext_vector_type(4)));
typedef unsigned v2u __attribute__((ext_vector_type(2)));
typedef float f32x4 __attribute__((ext_vector_type(4)));
typedef float f32x2 __attribute__((ext_vector_type(2)));
typedef short bf16x8 __attribute__((ext_vector_type(8)));
typedef GAS unsigned gu32;
#define RLX_AGENT __ATOMIC_RELAXED, __HIP_MEMORY_SCOPE_AGENT

constexpr int S = 8192, DM = 4096, NH = 16, HD = 128, AW = 2048, LW = 2048, NG = 16, GD = 128;
constexpr int NIN = 18448, NINP = 18432;
constexpr int C_Q = 0, C_K = 2048, C_V = 4096, C_F = 6144, C_LX = 6160, C_LY = 8208, C_GA = 10256, C_GL = 14352;
constexpr int PEER_H = 8, PEER_NK = 128, PEER_K = 16, PEER_NE = 16384;
constexpr float EPS = 1e-6f;
constexpr size_t MiB = 1u << 20;
constexpr size_t WS_CTL = 0, CTL_ZERO_BYTES = 1 * MiB;
constexpr size_t WS_MOD = 512 * 1024;
constexpr size_t WS_WF = 2 * MiB;
constexpr size_t WS_LOGF = 3 * MiB;
constexpr size_t WS_FC = 4 * MiB;
constexpr size_t WS_AGGA = 5 * MiB, WS_AGGB = 6 * MiB;
constexpr size_t WS_BIASR = 7 * MiB;
constexpr size_t WS_WAT = 8 * MiB, WS_WXT = 9 * MiB;
constexpr size_t WS_SK = 10 * MiB;
constexpr size_t WS_IDX = 12 * MiB, WS_GATE = 16 * MiB;
constexpr size_t WS_WIN = 32 * MiB, WS_WAO = 176 * MiB, WS_WLO = 192 * MiB, WS_WOUT = 208 * MiB, WS_WPQ = 240 * MiB;
constexpr size_t WS_U = 256 * MiB, WS_V = 384 * MiB;
constexpr size_t WS_HA = 512 * MiB;
constexpr size_t WS_QKV = 576 * MiB;
constexpr size_t WS_LX = 672 * MiB, WS_GY = 704 * MiB, WS_GA = 736 * MiB, WS_GL = 800 * MiB;
constexpr size_t WS_ATT = 864 * MiB, WS_LR = 896 * MiB, WS_T1 = 928 * MiB, WS_MG = 992 * MiB, WS_Q2 = 1056 * MiB, WS_END = 1088 * MiB;
constexpr int CW_BAR = 4096;
constexpr int RING_BYTES = 131072;
constexpr int LDSCTL_OFF = RING_BYTES, MISC_OFF = LDSCTL_OFF + 320;
constexpr int LDS_BYTES = 147456;
constexpr int NWAVES = 8, NTHREADS = 512;

__device__ __forceinline__ unsigned f2bf(float f) { unsigned u = __builtin_bit_cast(unsigned, f); return (u + 0x7fffu + ((u >> 16) & 1u)) >> 16; }
__device__ __forceinline__ unsigned pk2(float lo, float hi) { return f2bf(lo) | (f2bf(hi) << 16); }
__device__ __forceinline__ float bflo(unsigned w) { return __uint_as_float(w << 16); }
__device__ __forceinline__ float bfhi(unsigned w) { return __uint_as_float(w & 0xffff0000u); }
__device__ __forceinline__ float bf2f(bf16 b) { return __uint_as_float((unsigned)b << 16); }
__device__ __forceinline__ float wave_sum(float v) {
#pragma unroll
    for (int o = 1; o < 64; o <<= 1) v += __shfl_xor(v, o);
    return v;
}
__device__ __forceinline__ float wave_max(float v) {
#pragma unroll
    for (int o = 1; o < 64; o <<= 1) v = fmaxf(v, __shfl_xor(v, o));
    return v;
}
__device__ __forceinline__ float sigmoidf_(float v) { return __builtin_amdgcn_rcpf(1.0f + __builtin_amdgcn_exp2f(-1.4426950408889634f * v)); }
__device__ __forceinline__ float gelu_erf(float v) { return 0.5f * v * (1.0f + erff(v * 0.70710678118654752f)); }
#define XB_TMO      128
#define XB_XCNT(j)  (256  + 64 * (j))
#define XB_XSUB(j)  (1280 + 64 * (j))
#define XB_XGEN(j)  (2304 + 64 * (j))
#define XB_TOP      3328
#define XB_TOPGEN   3392
#define XCD_BAR_WORDS 3456
#define XB_SPIN_CAP (1u << 18)

__device__ __forceinline__ unsigned xb_ld(unsigned* p)              { return __hip_atomic_load(p, __ATOMIC_RELAXED, __HIP_MEMORY_SCOPE_AGENT); }
__device__ __forceinline__ unsigned xb_add(unsigned* p, unsigned v) { return __hip_atomic_fetch_add(p, v, __ATOMIC_RELAXED, __HIP_MEMORY_SCOPE_AGENT); }
__device__ __forceinline__ unsigned xb_xcc_id() { return (unsigned)__builtin_amdgcn_s_getreg((3 << 11) | 20) & 0xFu; }
#define XB_SPIN(cond, bar) do { unsigned _sp = 0; while (cond) { __builtin_amdgcn_s_sleep(1); \
    if ((++_sp & 255u) == 0u) { if (xb_ld(&(bar)[XB_TMO])) break; if (_sp > XB_SPIN_CAP) { atomicAdd(&(bar)[XB_TMO], 1u); break; } } } } while (0)

struct XcdBarrier {
    unsigned* bar; unsigned x;
    volatile LAS unsigned* st;
};

__device__ __forceinline__ XcdBarrier xcd_barrier_post(unsigned* bar, volatile LAS unsigned* st) {
    XcdBarrier b; b.bar = bar; b.x = xb_xcc_id(); b.st = st;
    if (threadIdx.x == 0) (void)xb_add(&bar[XB_XCNT(b.x)], 1u);
    return b;
}
__device__ __forceinline__ void xcd_barrier_complete(unsigned* bar, unsigned x, unsigned& nloc, unsigned& nx) {
    const unsigned G = gridDim.x * gridDim.y * gridDim.z;
    unsigned sum, cnt, mine, sp = 0u;
    for (;;) {
        sum = 0u; cnt = 0u; mine = 0u;
#pragma unroll
        for (unsigned j = 0; j < 16; ++j) { const unsigned c = xb_ld(&bar[XB_XCNT(j)]); sum += c; cnt += (c > 0u) ? 1u : 0u; mine = (j == x) ? c : mine; }
        if (sum == G) break;
        __builtin_amdgcn_s_sleep(1);
        if ((++sp & 255u) == 0u) { if (xb_ld(&bar[XB_TMO])) break; if (sp > XB_SPIN_CAP) { atomicAdd(&bar[XB_TMO], 1u); break; } }
    }
    nloc = mine > 0u ? mine : 1u; nx = cnt > 0u ? cnt : 1u;
}

__device__ __forceinline__ void xcd_barrier(const XcdBarrier& b) {
    asm volatile("s_waitcnt vmcnt(0)" ::: "memory");
    __syncthreads();
    if (threadIdx.x == 0) {
        unsigned* bar = b.bar;
        __builtin_amdgcn_s_waitcnt(0);
        unsigned nloc = b.st[0], nx = b.st[1];
        if (nloc == 0u) { xcd_barrier_complete(bar, b.x, nloc, nx); b.st[0] = nloc; b.st[1] = nx; }
        const unsigned old = xb_add(&bar[XB_XSUB(b.x)], 1u);
        const unsigned gen = old / nloc;
        if (old + 1u == (gen + 1u) * nloc) {
            __builtin_amdgcn_fence(__ATOMIC_RELEASE, "agent");
            asm volatile("s_waitcnt vmcnt(0)" ::: "memory");
            const unsigned og = xb_add(&bar[XB_TOP], 1u);
            const unsigned tg = og / nx;
            if (og + 1u == (tg + 1u) * nx) xb_add(&bar[XB_TOPGEN], 1u);
            else XB_SPIN(xb_ld(&bar[XB_TOPGEN]) == tg, bar);
            __builtin_amdgcn_fence(__ATOMIC_ACQUIRE, "agent");
            xb_add(&bar[XB_XGEN(b.x)], 1u);
            asm volatile("s_waitcnt vmcnt(0)" ::: "memory");
        } else {
            XB_SPIN(xb_ld(&bar[XB_XGEN(b.x)]) == gen, bar);
            __builtin_amdgcn_fence(__ATOMIC_ACQUIRE, "agent");
            asm volatile("s_waitcnt vmcnt(0)" ::: "memory");
        }
    }
    __syncthreads();
}
struct Frame {
    LAS unsigned char* lds; volatile LAS unsigned* MISC; gu32* ctl;
    int tid, lane, wave, vcu, G;
    unsigned char* ws; float* out;
    const float *x, *c, *w_ada, *b_ada, *g_mix, *g_ffn, *w_in, *b_in, *qn_g, *kn_g, *conv_w, *conv_b, *lru_wa, *lru_ba, *lru_wx, *lru_bx, *lru_lam, *w_ao, *w_lo, *w_out, *pwq, *psk, *pu, *pv;
};
#define WSP(T, off) ((T*)(F.ws + (off)))
#define LDS_WAIT() asm volatile("s_waitcnt lgkmcnt(0)" ::: "memory")

__device__ __forceinline__ void transpose_item(const float* W, int ldw, int K, bf16* WT, LAS float* scr, int k0, int nsrc0, int ndst0, int lane) {
#pragma unroll 8
    for (int i = 0; i < 32; ++i) { const int kk = 2 * i + (lane >> 5); scr[kk * 33 + (lane & 31)] = W[(size_t)(k0 + kk) * ldw + nsrc0 + (lane & 31)]; }
    LDS_WAIT(); asm volatile("" ::: "memory");
    const int c = lane & 7;
#pragma unroll
    for (int j = 0; j < 4; ++j) { const int n = (lane >> 3) + 8 * j; const LAS float* s = scr + (8 * c) * 33 + n;
        v4u o; o.x = pk2(s[0 * 33], s[1 * 33]); o.y = pk2(s[2 * 33], s[3 * 33]); o.z = pk2(s[4 * 33], s[5 * 33]); o.w = pk2(s[6 * 33], s[7 * 33]);
        *(GAS v4u*)(WT + (size_t)(ndst0 + n) * K + k0 + 8 * c) = o; }
    LDS_WAIT(); asm volatile("" ::: "memory");
}
__device__ __forceinline__ void cvt_stream(const float* src, bf16* dst, size_t n8, size_t i0, size_t stride) {
    for (size_t i = i0; i < n8; i += stride) { const f32x4 a = ((const GAS f32x4*)src)[2 * i], b = ((const GAS f32x4*)src)[2 * i + 1];
        v4u o; o.x = pk2(a[0], a[1]); o.y = pk2(a[2], a[3]); o.z = pk2(b[0], b[1]); o.w = pk2(b[2], b[3]); ((GAS v4u*)dst)[i] = o; }
}
__device__ __forceinline__ void p0_prologue(Frame& F) {
    { LAS float* sc = (LAS float*)F.lds; LAS f32x4* red = (LAS f32x4*)(F.lds + 16384); float* MOD = WSP(float, WS_MOD);
      for (int cgi = blockIdx.x; cgi < 256; cgi += F.G) {
          for (int i = F.tid; i < DM; i += NTHREADS) { const float cv = F.c[i]; sc[i] = cv / (1.0f + __expf(-cv)); }
          __syncthreads();
          if (F.tid < 384) { const int cg = F.tid % 24, rg = F.tid / 24;
              const GAS f32x4* Wp = (const GAS f32x4*)F.w_ada + cgi * 24 + cg;
              f32x4 acc = {0.f, 0.f, 0.f, 0.f};
#pragma unroll 8
              for (int r = rg; r < DM; r += 16) acc += sc[r] * Wp[(size_t)r * 6144];
              red[rg * 24 + cg] = acc; }
          __syncthreads();
          if (F.tid < 24) { f32x4 s = red[F.tid];
#pragma unroll
              for (int rg = 1; rg < 16; ++rg) s += red[rg * 24 + F.tid];
              s += ((const GAS f32x4*)F.b_ada)[cgi * 24 + F.tid]; ((GAS f32x4*)MOD)[cgi * 24 + F.tid] = s; }
          __syncthreads();
      } }
    LAS float* scr = (LAS float*)(F.lds + F.wave * 16384);
    const int gw = F.vcu * NWAVES + F.wave, NGW = F.G * NWAVES;
    constexpr int I_IN = 64 * 576, I_AO = 32 * 128, I_LO = 32 * 128, I_OUT = 64 * 128, I_PQ = 64 * 64, I_WA = 16 * 2 * 4, I_WX = I_WA;
    constexpr int NITEMS = I_IN + I_AO + I_LO + I_OUT + I_PQ + I_WA + I_WX;
    for (int it = gw; it < NITEMS; it += NGW) {
        int r = it;
        if (r < I_IN) { const int kb = r / 576, nb = r % 576; transpose_item(F.w_in, NIN, DM, WSP(bf16, WS_WIN), scr, 64 * kb, 32 * nb + (nb >= 192 ? 16 : 0), 32 * nb, F.lane); continue; } r -= I_IN;
        if (r < I_AO) { const int kb = r / 128, nb = r % 128; transpose_item(F.w_ao, DM, AW, WSP(bf16, WS_WAO), scr, 64 * kb, 32 * nb, 32 * nb, F.lane); continue; } r -= I_AO;
        if (r < I_LO) { const int kb = r / 128, nb = r % 128; transpose_item(F.w_lo, DM, LW, WSP(bf16, WS_WLO), scr, 64 * kb, 32 * nb, 32 * nb, F.lane); continue; } r -= I_LO;
        if (r < I_OUT) { const int kb = r / 128, nb = r % 128; transpose_item(F.w_out, DM, DM, WSP(bf16, WS_WOUT), scr, 64 * kb, 32 * nb, 32 * nb, F.lane); continue; } r -= I_OUT;
        if (r < I_PQ) { const int kb = r / 64, nb = r % 64; transpose_item(F.pwq, 2048, DM, WSP(bf16, WS_WPQ), scr, 64 * kb, 32 * nb, 32 * nb, F.lane); continue; } r -= I_PQ;
        { const bool isx = r >= I_WA; if (isx) r -= I_WA; const int g = r >> 3, kb = (r >> 2) & 1, nb = r & 3;
          transpose_item((isx ? F.lru_wx : F.lru_wa) + (size_t)g * GD * GD, GD, GD, WSP(bf16, isx ? WS_WXT : WS_WAT) + (size_t)g * GD * GD, scr, 64 * kb, 32 * nb, 32 * nb, F.lane); }
    }
    const size_t gt = (size_t)F.vcu * NTHREADS + F.tid, NGT = (size_t)F.G * NTHREADS;
    cvt_stream(F.pu, WSP(bf16, WS_U), (size_t)PEER_NE * DM / 8, gt, NGT);
    cvt_stream(F.pv, WSP(bf16, WS_V), (size_t)PEER_NE * DM / 8, gt, NGT);
    cvt_stream(F.psk, WSP(bf16, WS_SK), (size_t)PEER_H * 2 * 128 * 128 / 8, gt, NGT);
    for (size_t i = gt; i < (size_t)DM * 16; i += NGT) WSP(float, WS_WF)[i] = F.w_in[(i >> 4) * NIN + C_F + (i & 15)];
    for (size_t i = gt; i < (size_t)NINP; i += NGT) WSP(float, WS_BIASR)[i] = F.b_in[i + (i >= (size_t)C_F ? 16 : 0)];
}

__device__ __forceinline__ void p1_norm_forget(Frame& F) {
    const int gw = F.vcu * NWAVES + F.wave, NGW = F.G * NWAVES; const float* MOD = WSP(float, WS_MOD); const float* WF = WSP(float, WS_WF); bf16* HA = WSP(bf16, WS_HA);
    for (int rg = gw; rg < S / 4; rg += NGW) {
        const int r0 = rg * 4; float rstd[4];
#pragma unroll
        for (int r = 0; r < 4; ++r) { const GAS f32x4* xr = (const GAS f32x4*)(F.x + (size_t)(r0 + r) * DM) + F.lane; float ss = 0.f;
#pragma unroll
            for (int j = 0; j < 16; ++j) { const f32x4 v = xr[64 * j]; ss += (v[0] * v[0] + v[1] * v[1]) + (v[2] * v[2] + v[3] * v[3]); }
            rstd[r] = 1.0f / sqrtf(wave_sum(ss) * (1.0f / DM) + EPS); }
        float acc[4][16];
#pragma unroll
        for (int r = 0; r < 4; ++r)
#pragma unroll
            for (int cc = 0; cc < 16; ++cc) acc[r][cc] = 0.f;
        for (int j = 0; j < 16; ++j) {
            const int i4 = F.lane + 64 * j;
            const f32x4 g = ((const GAS f32x4*)F.g_mix)[i4], scl = ((const GAS f32x4*)(MOD + 4096))[i4], sh = ((const GAS f32x4*)MOD)[i4];
            const f32x4 mul = g * (scl + 1.0f);
            f32x4 wf[4][4];
#pragma unroll
            for (int i = 0; i < 4; ++i)
#pragma unroll
                for (int q = 0; q < 4; ++q) wf[i][q] = ((const GAS f32x4*)(WF + (size_t)(4 * i4 + i) * 16))[q];
#pragma unroll
            for (int r = 0; r < 4; ++r) {
                const f32x4 xv = ((const GAS f32x4*)(F.x + (size_t)(r0 + r) * DM))[i4];
                const f32x4 hv = xv * rstd[r] * mul + sh;
                v2u o; o.x = pk2(hv[0], hv[1]); o.y = pk2(hv[2], hv[3]);
                ((GAS v2u*)(HA + (size_t)(r0 + r) * DM))[i4] = o;
#pragma unroll
                for (int i = 0; i < 4; ++i)
#pragma unroll
                    for (int q = 0; q < 4; ++q)
#pragma unroll
                        for (int e = 0; e < 4; ++e) acc[r][4 * q + e] += hv[i] * wf[i][q][e];
            }
        }
#pragma unroll
        for (int r = 0; r < 4; ++r)
#pragma unroll
            for (int cc = 0; cc < 16; ++cc) { const float tot = wave_sum(acc[r][cc]);
                if (F.lane == cc) { const float f = tot + F.b_in[C_F + cc]; WSP(float, WS_LOGF)[(size_t)(r0 + r) * 16 + cc] = fminf(f, 0.f) - log1pf(__expf(-fabsf(f))); } }
    }
}

__device__ __forceinline__ void p3_qknorm(Frame& F) {
    const int gw = F.vcu * NWAVES + F.wave, NGW = F.G * NWAVES; bf16* QK = WSP(bf16, WS_QKV);
    const int sub = F.lane & 15;
    f32x4 gq0 = ((const GAS f32x4*)F.qn_g)[2 * sub], gq1 = ((const GAS f32x4*)F.qn_g)[2 * sub + 1], gk0 = ((const GAS f32x4*)F.kn_g)[2 * sub], gk1 = ((const GAS f32x4*)F.kn_g)[2 * sub + 1];
    for (int it = gw; it < 2 * S * NH / 4; it += NGW) {
        const size_t unit = (size_t)it * 4 + (F.lane >> 4); const bool isk = unit >= (size_t)S * NH;
        GAS v4u* p = (GAS v4u*)(QK + unit * 128) + sub; const v4u w = *p;
        f32x4 a = {bflo(w.x), bfhi(w.x), bflo(w.y), bfhi(w.y)}, b = {bflo(w.z), bfhi(w.z), bflo(w.w), bfhi(w.w)};
        float ss = (a[0] * a[0] + a[1] * a[1]) + (a[2] * a[2] + a[3] * a[3]) + (b[0] * b[0] + b[1] * b[1]) + (b[2] * b[2] + b[3] * b[3]);
        ss += __shfl_xor(ss, 1); ss += __shfl_xor(ss, 2); ss += __shfl_xor(ss, 4); ss += __shfl_xor(ss, 8);
        const float rs = 1.0f / sqrtf(ss * (1.0f / HD) + EPS);
        a = a * rs * (isk ? gk0 : gq0); b = b * rs * (isk ? gk1 : gq1);
        v4u o; o.x = pk2(a[0], a[1]); o.y = pk2(a[2], a[3]); o.z = pk2(b[0], b[1]); o.w = pk2(b[2], b[3]); *p = o;
    }
}
__device__ __forceinline__ void p3_cumsum(Frame& F) {
    LAS float* wt = (LAS float*)F.lds;
    for (int h = blockIdx.x; h < NH; h += F.G) {
        const float* LF = WSP(float, WS_LOGF); float v[16]; float run = 0.f;
#pragma unroll
        for (int i = 0; i < 16; ++i) { run += LF[(size_t)(F.tid * 16 + i) * 16 + h]; v[i] = run; }
        float sc = run;
#pragma unroll
        for (int o = 1; o < 64; o <<= 1) { const float t = __shfl_up(sc, o); if (F.lane >= o) sc += t; }
        if (F.lane == 63) wt[F.wave] = sc;
        __syncthreads();
        float pre = sc - run;
        for (int w = 0; w < F.wave; ++w) pre += wt[w];
        float* Fo = WSP(float, WS_FC) + (size_t)h * S + F.tid * 16;
#pragma unroll
        for (int i = 0; i < 4; ++i) ((GAS f32x4*)Fo)[i] = (f32x4){v[4 * i] + pre, v[4 * i + 1] + pre, v[4 * i + 2] + pre, v[4 * i + 3] + pre};
        __syncthreads();
    }
}
constexpr int LRU_XCF = 0, LRU_XCB = 32768, LRU_AB = 49152, LRU_BB = 81920, LRU_QA = 114688, LRU_CAR = 118784;
template <int PASS> __device__ __forceinline__ void lru_unit(Frame& F, int c, int g) {
    LAS float* XCF = (LAS float*)(F.lds + LRU_XCF); LAS unsigned char* XCB = F.lds + LRU_XCB; LAS float* AB = (LAS float*)(F.lds + LRU_AB); LAS float* BB = (LAS float*)(F.lds + LRU_BB);
    LAS float* QA = (LAS float*)(F.lds + LRU_QA); LAS float* CAR = (LAS float*)(F.lds + LRU_CAR);
    const int t0 = 64 * c, ch0 = GD * g; const bf16* LX = WSP(bf16, WS_LX);
    { const int ch = F.tid & 127, tq = F.tid >> 7, gch = ch0 + ch;
      const float w0 = F.conv_w[gch], w1 = F.conv_w[LW + gch], w2 = F.conv_w[2 * LW + gch], w3 = F.conv_w[3 * LW + gch], cb = F.conv_b[gch];
      float xm3, xm2, xm1; { const int tb = t0 + 16 * tq;
          xm3 = tb - 3 >= 0 ? bf2f(LX[(size_t)(tb - 3) * LW + gch]) : 0.f; xm2 = tb - 2 >= 0 ? bf2f(LX[(size_t)(tb - 2) * LW + gch]) : 0.f; xm1 = tb - 1 >= 0 ? bf2f(LX[(size_t)(tb - 1) * LW + gch]) : 0.f; }
#pragma unroll
      for (int i = 0; i < 16; ++i) { const int t = 16 * tq + i; const float x0 = bf2f(LX[(size_t)(t0 + t) * LW + gch]);
          const float xc = w0 * xm3 + w1 * xm2 + w2 * xm1 + w3 * x0 + cb; xm3 = xm2; xm2 = xm1; xm1 = x0;
          XCF[t * 128 + ch] = xc; *(LAS bf16*)(XCB + t * 256 + ((ch * 2) ^ ((t & 7) << 4))) = (bf16)f2bf(xc); } }
    __syncthreads();
    { const int fr = F.lane & 15, fq = F.lane >> 4, j = 16 * F.wave + fr;
      const bf16* WA = WSP(bf16, WS_WAT) + (size_t)g * GD * GD + (size_t)j * GD + 8 * fq; const bf16* WX = WSP(bf16, WS_WXT) + (size_t)g * GD * GD + (size_t)j * GD + 8 * fq;
      bf16x8 ba[4], bx[4];
#pragma unroll
      for (int ks = 0; ks < 4; ++ks) { ba[ks] = *(const GAS bf16x8*)(WA + 32 * ks); bx[ks] = *(const GAS bf16x8*)(WX + 32 * ks); }
      const int gch = ch0 + j; const float bav = F.lru_ba[gch], bxv = F.lru_bx[gch], lam = F.lru_lam[gch];
      const float sp = (lam > 0.f ? 0.f : -lam) + log1pf(__expf(-fabsf(lam)));
#pragma unroll
      for (int mt = 0; mt < 4; ++mt) { f32x4 ar = {0.f, 0.f, 0.f, 0.f}, ax = {0.f, 0.f, 0.f, 0.f}; const int t = 16 * mt + fr;
#pragma unroll
          for (int ks = 0; ks < 4; ++ks) { const bf16x8 af = *(const LAS bf16x8*)(XCB + t * 256 + (((32 * ks + 8 * fq) * 2) ^ ((t & 7) << 4)));
              ar = __builtin_amdgcn_mfma_f32_16x16x32_bf16(af, ba[ks], ar, 0, 0, 0); ax = __builtin_amdgcn_mfma_f32_16x16x32_bf16(af, bx[ks], ax, 0, 0, 0); }
#pragma unroll
          for (int rg = 0; rg < 4; ++rg) { const int tt = 16 * mt + 4 * fq + rg; const float xcv = XCF[tt * 128 + j];
              const float rgt = sigmoidf_(ar[rg] + bav), igt = sigmoidf_(ax[rg] + bxv);
              const float log_a = -8.0f * rgt * sp; const float a = __expf(log_a); const float b = sqrtf(-expm1f(2.0f * log_a)) * (igt * xcv);
              AB[tt * 128 + j] = a; BB[tt * 128 + j] = b; } } }
    __syncthreads();
    const int ch = F.tid & 127, q = F.tid >> 7;
    { float A = 1.f, B = 0.f;
#pragma unroll
      for (int i = 0; i < 16; ++i) { const int t = 16 * q + i; const float a = AB[t * 128 + ch]; B = a * B + BB[t * 128 + ch]; A *= a; }
      QA[(q * 128 + ch) * 2] = A; QA[(q * 128 + ch) * 2 + 1] = B; }
    if (PASS == 1 && F.tid < 128) {
        const float* GA_ = WSP(float, WS_AGGA) + ch0 + F.tid; const float* GB_ = WSP(float, WS_AGGB) + ch0 + F.tid; float hcar = 0.f;
        for (int cc = 0; cc < c; ++cc) hcar = GA_[(size_t)cc * LW] * hcar + GB_[(size_t)cc * LW];
        CAR[F.tid] = hcar; }
    __syncthreads();
    if (PASS == 0) {
        if (F.tid < 128) { float A = 1.f, B = 0.f;
#pragma unroll
            for (int qq = 0; qq < 4; ++qq) { const float a = QA[(qq * 128 + F.tid) * 2], b = QA[(qq * 128 + F.tid) * 2 + 1]; B = a * B + b; A *= a; }
            WSP(float, WS_AGGA)[(size_t)c * LW + ch0 + F.tid] = A; WSP(float, WS_AGGB)[(size_t)c * LW + ch0 + F.tid] = B; }
    } else {
        float h = CAR[ch];
        for (int qq = 0; qq < q; ++qq) h = QA[(qq * 128 + ch) * 2] * h + QA[(qq * 128 + ch) * 2 + 1];
        const bf16* GY = WSP(bf16, WS_GY); bf16* LR = WSP(bf16, WS_LR);
#pragma unroll
        for (int i = 0; i < 16; ++i) { const int t = 16 * q + i; h = AB[t * 128 + ch] * h + BB[t * 128 + ch];
            const size_t o = (size_t)(t0 + t) * LW + ch0 + ch; LR[o] = (bf16)f2bf(h * bf2f(GY[o])); }
    }
    __syncthreads();
}
constexpr int ATT_BIAS_OFF = attn_body::LDS_BYTES;
typedef attn_body::BlockRef<bf16, bf16> ARef;
__device__ __forceinline__ int attn_jlo(const float* Fh, int qb, float TH, int lane) {
    const int t0 = qb * 256; const float f0 = Fh[t0];
    const int j0 = lane, j1 = lane + 64;
    const bool ok0 = (64 * j0 + 63 >= t0) || (f0 - Fh[64 * j0 + 63] >= -TH), ok1 = (64 * j1 + 63 >= t0) || (f0 - Fh[64 * j1 + 63] >= -TH);
    const unsigned long long m0 = __ballot(ok0), m1 = __ballot(ok1);
    return m0 ? (int)__builtin_ctzll(m0) : 64 + (int)__builtin_ctzll(m1);
}
__device__ __forceinline__ ARef attn_ref(Frame& F, int h, int qb, int jlo) {
    ARef r; const bf16* QK = WSP(bf16, WS_QKV);
    r.Q = QK + (size_t)(qb * 256) * AW + h * HD; r.K = QK + (size_t)S * AW + h * HD; r.V = QK + 2 * (size_t)S * AW + h * HD;
    r.O = WSP(bf16, WS_ATT) + (size_t)(qb * 256) * AW + h * HD; r.P0 = qb * 256; r.jlo = jlo; return r;
}
__device__ __forceinline__ void attn_fill_bias(Frame& F, int h, int qb, int jlo) {
    const float* Fh = WSP(float, WS_FC) + (size_t)h * S; LAS float* bl = (LAS float*)(F.lds + ATT_BIAS_OFF);
    const int k0 = jlo * 64, n = (qb + 1) * 256 - k0; const float fr = Fh[k0];
#pragma unroll 1
    for (int i = F.tid; i < n; i += NTHREADS) bl[i] = (fr - Fh[k0 + i]) * (1.0f / attn_body::SCALE);
}
#ifndef ATT_WINDOW
#define ATT_WINDOW 1
#endif
__device__ __forceinline__ void p4_attention(Frame& F, char* lds_generic) {
    float gq = fmaxf(fabsf(F.qn_g[F.lane]), fabsf(F.qn_g[F.lane + 64])), gk = fmaxf(fabsf(F.kn_g[F.lane]), fabsf(F.kn_g[F.lane + 64]));
    gq = wave_max(gq); gk = wave_max(gk);
    const float TH = 2.0f * (128.0f * gq * gk * attn_body::SCALE) + 40.0f;
    for (int L = blockIdx.x; L < NH * 16; L += F.G) {
        const int h = L >> 4, x = L & 15, qb0 = x, qb1 = 31 - x; const float* Fh = WSP(float, WS_FC) + (size_t)h * S;
        const int jl0 = ATT_WINDOW ? attn_jlo(Fh, qb0, TH, F.lane) : 0, jl1 = ATT_WINDOW ? attn_jlo(Fh, qb1, TH, F.lane) : 0;
        const ARef r0 = attn_ref(F, h, qb0, jl0), r1 = attn_ref(F, h, qb1, jl1);
        attn_fill_bias(F, h, qb0, jl0); __syncthreads();
        attn_body::attn_unit<bf16, bf16>(r0, S, lds_generic);
        attn_fill_bias(F, h, qb1, jl1); __syncthreads();
        attn_body::attn_unit<bf16, bf16>(r1, S, lds_generic);
        asm volatile("s_waitcnt vmcnt(0)" ::: "memory"); __syncthreads();
    }
}

__device__ __forceinline__ void p7_norm2(Frame& F) {
    const int gw = F.vcu * NWAVES + F.wave, NGW = F.G * NWAVES; const float* MOD = WSP(float, WS_MOD); bf16* HA = WSP(bf16, WS_HA);
    for (int m = gw; m < S; m += NGW) {
        const GAS f32x4* xr = (const GAS f32x4*)(F.out + (size_t)m * DM) + F.lane; f32x4 v[16]; float ss = 0.f;
#pragma unroll
        for (int j = 0; j < 16; ++j) { v[j] = xr[64 * j]; ss += (v[j][0] * v[j][0] + v[j][1] * v[j][1]) + (v[j][2] * v[j][2] + v[j][3] * v[j][3]); }
        const float rstd = 1.0f / sqrtf(wave_sum(ss) * (1.0f / DM) + EPS);
#pragma unroll
        for (int j = 0; j < 16; ++j) { const int i4 = F.lane + 64 * j;
            const f32x4 g = ((const GAS f32x4*)F.g_ffn)[i4], scl = ((const GAS f32x4*)(MOD + 16384))[i4], sh = ((const GAS f32x4*)(MOD + 12288))[i4];
            const f32x4 hv = v[j] * rstd * (g * (scl + 1.0f)) + sh;
            v2u o; o.x = pk2(hv[0], hv[1]); o.y = pk2(hv[2], hv[3]); ((GAS v2u*)(HA + (size_t)m * DM))[i4] = o; }
    }
}

constexpr float NEG_BIG = -3.0e38f;
__device__ __forceinline__ void p9_topk(Frame& F) {
    LAS float* SC = (LAS float*)F.lds;
    const bf16* Q2 = WSP(bf16, WS_Q2); const bf16* SK = WSP(bf16, WS_SK); int* IDX = WSP(int, WS_IDX); float* GATE = WSP(float, WS_GATE);
    const int fr = F.lane & 15, fq = F.lane >> 4;
    for (int u = blockIdx.x; u < (S / 64) * PEER_H; u += F.G) {
        const int tb = u >> 3, h = u & 7, t0 = 64 * tb;
        { const int p = F.wave >> 2, nb = F.wave & 3;
          bf16x8 b[2][4];
#pragma unroll
          for (int nt = 0; nt < 2; ++nt)
#pragma unroll
              for (int ks = 0; ks < 4; ++ks) b[nt][ks] = *(const GAS bf16x8*)(SK + ((size_t)((h * 2 + p) * 128 + 32 * nb + 16 * nt + fr)) * 128 + 32 * ks + 8 * fq);
#pragma unroll
          for (int mt = 0; mt < 4; ++mt) { f32x4 a0 = {0.f, 0.f, 0.f, 0.f}, a1 = {0.f, 0.f, 0.f, 0.f};
#pragma unroll
              for (int ks = 0; ks < 4; ++ks) { const bf16x8 af = *(const GAS bf16x8*)(Q2 + (size_t)(t0 + 16 * mt + fr) * 2048 + h * 256 + p * 128 + 32 * ks + 8 * fq);
                  a0 = __builtin_amdgcn_mfma_f32_16x16x32_bf16(af, b[0][ks], a0, 0, 0, 0); a1 = __builtin_amdgcn_mfma_f32_16x16x32_bf16(af, b[1][ks], a1, 0, 0, 0); }
#pragma unroll
              for (int rg = 0; rg < 4; ++rg) { const int tt = 16 * mt + 4 * fq + rg; SC[tt * 256 + p * 128 + 32 * nb + fr] = a0[rg]; SC[tt * 256 + p * 128 + 32 * nb + 16 + fr] = a1[rg]; } } }
        __syncthreads();
        for (int i = 0; i < 8; ++i) { const int tl = 8 * F.wave + i;
            float tv[2]; int ti[2];
#pragma unroll
            for (int p = 0; p < 2; ++p) { float v0 = SC[tl * 256 + p * 128 + F.lane], v1 = SC[tl * 256 + p * 128 + 64 + F.lane]; float rv = NEG_BIG; int ri = 0;
                for (int r = 0; r < 16; ++r) { const float m = fmaxf(v0, v1); const int mi = (v0 >= v1) ? F.lane : F.lane + 64; const float wm = wave_max(m);
                    const unsigned long long bal = __ballot(m == wm); const int src = (int)__builtin_ctzll(bal); const int ci = __shfl(mi, src);
                    if (F.lane == src) { if (mi == F.lane) v0 = NEG_BIG; else v1 = NEG_BIG; }
                    if (F.lane == r) { rv = wm; ri = ci; } }
                tv[p] = rv; ti[p] = ri; }
            const int ci_ = F.lane >> 2, jb = 4 * (F.lane & 3);
            const float s0 = __shfl(tv[0], ci_); const int i0 = __shfl(ti[0], ci_);
            float c0 = s0 + __shfl(tv[1], jb), c1 = s0 + __shfl(tv[1], jb + 1), c2 = s0 + __shfl(tv[1], jb + 2), c3 = s0 + __shfl(tv[1], jb + 3);
            const int e0 = i0 * 128 + __shfl(ti[1], jb), e1 = i0 * 128 + __shfl(ti[1], jb + 1), e2 = i0 * 128 + __shfl(ti[1], jb + 2), e3 = i0 * 128 + __shfl(ti[1], jb + 3);
            float gv = NEG_BIG; int ge = 0;
            for (int r = 0; r < 16; ++r) { const float m = fmaxf(fmaxf(c0, c1), fmaxf(c2, c3)); const int jj = (c0 == m) ? 0 : (c1 == m) ? 1 : (c2 == m) ? 2 : 3;
                const int me = jj == 0 ? e0 : jj == 1 ? e1 : jj == 2 ? e2 : e3; const float wm = wave_max(m);
                const unsigned long long bal = __ballot(m == wm); const int src = (int)__builtin_ctzll(bal); const int ce = __shfl(me, src);
                if (F.lane == src) { c0 = jj == 0 ? NEG_BIG : c0; c1 = jj == 1 ? NEG_BIG : c1; c2 = jj == 2 ? NEG_BIG : c2; c3 = jj == 3 ? NEG_BIG : c3; }
                if (F.lane == r) { gv = wm; ge = ce; } }
            const float mx = __shfl(gv, 0); const float ex = F.lane < 16 ? __expf(gv - mx) : 0.f; const float sm = wave_sum(ex);
            if (F.lane < 16) { const size_t o = (size_t)(t0 + tl) * 128 + h * 16 + F.lane; IDX[o] = ge; GATE[o] = ex / sm; }
        }
        __syncthreads();
    }
}

__device__ __forceinline__ float dot8(const v4u a, const v4u b) {
    return (bflo(a.x) * bflo(b.x) + bfhi(a.x) * bfhi(b.x)) + (bflo(a.y) * bflo(b.y) + bfhi(a.y) * bfhi(b.y)) + (bflo(a.z) * bflo(b.z) + bfhi(a.z) * bfhi(b.z)) + (bflo(a.w) * bflo(b.w) + bfhi(a.w) * bfhi(b.w));
}
__device__ __forceinline__ void p10_peer(Frame& F) {
    const int gw = F.vcu * NWAVES + F.wave, NGW = F.G * NWAVES; const float* MOD = WSP(float, WS_MOD);
    const bf16* H2 = WSP(bf16, WS_HA); const bf16* U = WSP(bf16, WS_U); const bf16* V = WSP(bf16, WS_V); const int* IDX = WSP(int, WS_IDX); const float* GATE = WSP(float, WS_GATE);
    for (int t = gw; t < S; t += NGW) {
        v4u hx[8];
#pragma unroll
        for (int c = 0; c < 8; ++c) hx[c] = *((const GAS v4u*)(H2 + (size_t)t * DM + c * 512) + F.lane);
        const int id0 = IDX[(size_t)t * 128 + F.lane], id1 = IDX[(size_t)t * 128 + 64 + F.lane];
        const float g0 = GATE[(size_t)t * 128 + F.lane], g1 = GATE[(size_t)t * 128 + 64 + F.lane];
        float w0 = 0.f, w1 = 0.f;
        for (int e = 0; e < 128; e += 2) {
            const int ea = __builtin_amdgcn_readlane(e < 64 ? id0 : id1, e & 63), eb = __builtin_amdgcn_readlane(e < 64 ? id0 : id1, (e + 1) & 63);
            const GAS v4u* ua = (const GAS v4u*)(U + (size_t)ea * DM) + F.lane; const GAS v4u* ub = (const GAS v4u*)(U + (size_t)eb * DM) + F.lane;
            v4u ra[8], rb[8];
#pragma unroll
            for (int c = 0; c < 8; ++c) { ra[c] = ua[64 * c]; rb[c] = ub[64 * c]; }
            float sa = 0.f, sb = 0.f;
#pragma unroll
            for (int c = 0; c < 8; ++c) { sa += dot8(ra[c], hx[c]); sb += dot8(rb[c], hx[c]); }
            sa = wave_sum(sa); sb = wave_sum(sb);
            const float aa = gelu_erf(sa), ab = gelu_erf(sb);
            if (e < 64) { if (F.lane == e) w0 = aa * g0; if (F.lane == e + 1) w0 = ab * g0; } else { if (F.lane == e - 64) w1 = aa * g1; if (F.lane == e - 63) w1 = ab * g1; }
        }
        float acc[64];
#pragma unroll
        for (int i = 0; i < 64; ++i) acc[i] = 0.f;
        for (int e = 0; e < 128; ++e) {
            const int ei = __builtin_amdgcn_readlane(e < 64 ? id0 : id1, e & 63);
            const float w = __uint_as_float(__builtin_amdgcn_readlane(__float_as_uint(e < 64 ? w0 : w1), e & 63));
            const GAS v4u* vp = (const GAS v4u*)(V + (size_t)ei * DM) + F.lane;
            v4u rv[8];
#pragma unroll
            for (int c = 0; c < 8; ++c) rv[c] = vp[64 * c];
#pragma unroll
            for (int c = 0; c < 8; ++c) { acc[8 * c + 0] += w * bflo(rv[c].x); acc[8 * c + 1] += w * bfhi(rv[c].x); acc[8 * c + 2] += w * bflo(rv[c].y); acc[8 * c + 3] += w * bfhi(rv[c].y);
                acc[8 * c + 4] += w * bflo(rv[c].z); acc[8 * c + 5] += w * bfhi(rv[c].z); acc[8 * c + 6] += w * bflo(rv[c].w); acc[8 * c + 7] += w * bfhi(rv[c].w); }
        }
#pragma unroll
        for (int c = 0; c < 8; ++c) { const int col = c * 512 + F.lane * 8; GAS f32x4* op = (GAS f32x4*)(F.out + (size_t)t * DM + col);
            const f32x4 ga = *(const GAS f32x4*)(MOD + 20480 + col), gb = *(const GAS f32x4*)(MOD + 20480 + col + 4);
            const f32x4 xa = op[0], xb = op[1];
            op[0] = xa + ga * (f32x4){acc[8 * c], acc[8 * c + 1], acc[8 * c + 2], acc[8 * c + 3]}; op[1] = xb + gb * (f32x4){acc[8 * c + 4], acc[8 * c + 5], acc[8 * c + 6], acc[8 * c + 7]}; }
    }
}
#ifndef MK_SINGLE
#define MK_SINGLE 1
#endif
constexpr int N_PHASES = 11;
struct Args { const float* in[24]; float* out; unsigned char* ws; int ph_lo, ph_hi; };
__global__ void __launch_bounds__(NTHREADS, 2) fwd_kernel(Args args) {
    extern __shared__ __attribute__((aligned(16))) unsigned char lds[];
    Frame F;
    F.lds = (LAS unsigned char*)lds; F.MISC = (volatile LAS unsigned*)(F.lds + MISC_OFF);
    F.tid = threadIdx.x; F.lane = F.tid & 63; F.wave = __builtin_amdgcn_readfirstlane(F.tid >> 6);
    F.G = gridDim.x; { const int bx = blockIdx.x; F.vcu = (F.G % 8 == 0) ? (bx % 8) * (F.G / 8) + bx / 8 : bx; }
    F.ws = args.ws; F.out = args.out; F.ctl = (gu32*)(args.ws + WS_CTL);
    F.x = args.in[0]; F.c = args.in[1]; F.w_ada = args.in[2]; F.b_ada = args.in[3]; F.g_mix = args.in[4]; F.g_ffn = args.in[5]; F.w_in = args.in[6]; F.b_in = args.in[7];
    F.qn_g = args.in[8]; F.kn_g = args.in[9]; F.conv_w = args.in[10]; F.conv_b = args.in[11]; F.lru_wa = args.in[12]; F.lru_ba = args.in[13]; F.lru_wx = args.in[14]; F.lru_bx = args.in[15];
    F.lru_lam = args.in[16]; F.w_ao = args.in[17]; F.w_lo = args.in[18]; F.w_out = args.in[19]; F.pwq = args.in[20]; F.psk = args.in[21]; F.pu = args.in[22]; F.pv = args.in[23];
    for (int u = F.tid; u < (LDS_BYTES - LDSCTL_OFF) / 4; u += NTHREADS) ((LAS unsigned*)(F.lds + LDSCTL_OFF))[u] = 0u;
    __syncthreads();
    const int lo = args.ph_lo, hi = args.ph_hi;
    XcdBarrier bar; bar.bar = (unsigned*)(F.ctl + CW_BAR); bar.x = 0; bar.st = nullptr;
    if (hi - lo > 1) bar = xcd_barrier_post((unsigned*)(F.ctl + CW_BAR), F.MISC + 8);
#ifndef PH_MASK
#define PH_MASK 0x7ff
#endif
#define IN(k) (((PH_MASK >> (k)) & 1) && lo <= (k) && (k) < hi)
#define SEAM(k) do { if (IN(k) && IN((k) + 1)) xcd_barrier(bar); } while (0)
    const int bid = (int)blockIdx.x;
    if (IN(0)) { p0_prologue(F); SEAM(0); }
    if (IN(1)) { p1_norm_forget(F); SEAM(1); }
    if (IN(2)) {
        pg8::Gemm g{WSP(bf16, WS_HA), WSP(bf16, WS_WIN), S, NINP, DM}; pg8::StaticOrder So; So.init(S, NINP, F.G, bid);
        pg8::EpiIn E{WSP(bf16, WS_QKV), WSP(bf16, WS_LX), WSP(bf16, WS_GY), WSP(bf16, WS_GA), WSP(bf16, WS_GL), WSP(float, WS_BIASR)};
        pg8::gemm_phase<pg8::EpiIn, pg8::StaticOrder, true, true>(F.lds, g, So, E);
        SEAM(2);
    }
    if (IN(3)) {
        p3_qknorm(F);
        __syncthreads();
        p3_cumsum(F);
        for (int u = bid; u < (S / 64) * NG; u += F.G) lru_unit<0>(F, u >> 4, u & 15);
        SEAM(3);
    }
    if (IN(4)) {
        p4_attention(F, (char*)lds);
        for (int u = bid; u < (S / 64) * NG; u += F.G) lru_unit<1>(F, u >> 4, u & 15);
        SEAM(4);
    }
    if (IN(5)) {
        { pg8::Gemm g{WSP(bf16, WS_ATT), WSP(bf16, WS_WAO), S, DM, AW}; pg8::StaticOrder So; So.init(S, DM, F.G, bid);
          pg8::EpiGate<0> E{WSP(bf16, WS_T1), WSP(bf16, WS_GA), DM};
          pg8::gemm_phase<pg8::EpiGate<0>, pg8::StaticOrder, true, true>(F.lds, g, So, E); }
        { pg8::Gemm g{WSP(bf16, WS_LR), WSP(bf16, WS_WLO), S, DM, LW}; pg8::StaticOrder So; So.init(S, DM, F.G, bid);
          pg8::EpiGate<1> E{WSP(bf16, WS_T1), WSP(bf16, WS_GL), DM};
          pg8::gemm_phase<pg8::EpiGate<1>, pg8::StaticOrder, true, true>(F.lds, g, So, E); }
        SEAM(5);
    }
    if (IN(6)) {
        pg8::Gemm g{WSP(bf16, WS_T1), WSP(bf16, WS_WOUT), S, DM, DM}; pg8::StaticOrder So; So.init(S, DM, F.G, bid);
        pg8::EpiRes E{F.x, F.out, WSP(float, WS_MOD) + 8192, DM};
        pg8::gemm_phase<pg8::EpiRes, pg8::StaticOrder, true, true>(F.lds, g, So, E);
        SEAM(6);
    }
    if (IN(7)) { p7_norm2(F); SEAM(7); }
    if (IN(8)) {
        pg8::Gemm g{WSP(bf16, WS_HA), WSP(bf16, WS_WPQ), S, 2048, DM}; pg8::StaticOrder So; So.init(S, 2048, F.G, bid);
        pg8::EpiBf16<0> E{WSP(bf16, WS_Q2), 2048, nullptr, 0, 0, 1.f};
        pg8::gemm_phase<pg8::EpiBf16<0>, pg8::StaticOrder, true, true>(F.lds, g, So, E);
        SEAM(8);
    }
    if (IN(9)) { p9_topk(F); SEAM(9); }
    if (IN(10)) { p10_peer(F); }
#undef IN
#undef SEAM
}

extern "C" void kernel_launch(void* const* d_in, const int* in_sizes, int n_in, void* d_out, int out_size, void* d_ws, size_t ws_size, hipStream_t stream) {
    static int grid = 0;
    if (grid == 0) {
        if (n_in != 24 || in_sizes[0] != S * DM || out_size != S * DM || ws_size < WS_END) { fprintf(stderr, "kernel_launch: unexpected shapes (n_in %d, in0 %d, out %d, ws %zu)\n", n_in, n_in > 0 ? in_sizes[0] : -1, out_size, ws_size); grid = -1; return; }
        int dev = 0, cus = 0, per_cu = 0;
        if (hipGetDevice(&dev) != hipSuccess || hipDeviceGetAttribute(&cus, hipDeviceAttributeMultiprocessorCount, dev) != hipSuccess) { grid = -1; return; }
        if (hipFuncSetAttribute((const void*)fwd_kernel, hipFuncAttributeMaxDynamicSharedMemorySize, LDS_BYTES) != hipSuccess) { fprintf(stderr, "kernel_launch: hipFuncSetAttribute failed\n"); grid = -1; return; }
        if (hipOccupancyMaxActiveBlocksPerMultiprocessor(&per_cu, (const void*)fwd_kernel, NTHREADS, LDS_BYTES) != hipSuccess || per_cu < 1) fprintf(stderr, "kernel_launch: occupancy query reports %d blocks per CU\n", per_cu);
        (void)hipGetLastError();
        grid = cus;
    }
    if (grid < 0) return;
    if (hipMemsetAsync((char*)d_ws + WS_CTL, 0, CTL_ZERO_BYTES, stream) != hipSuccess) return;
    Args a{};
    for (int i = 0; i < 24; ++i) a.in[i] = (const float*)d_in[i];
    a.out = (float*)d_out; a.ws = (unsigned char*)d_ws;
#if MK_SINGLE
    a.ph_lo = 0; a.ph_hi = N_PHASES;
    hipLaunchKernelGGL(fwd_kernel, dim3(grid), dim3(NTHREADS), LDS_BYTES, stream, a);
#else
    for (int p = 0; p < N_PHASES; ++p) { a.ph_lo = p; a.ph_hi = p + 1; hipLaunchKernelGGL(fwd_kernel, dim3(grid), dim3(NTHREADS), LDS_BYTES, stream, a); }
#endif
}
```

```cpp
#define REP_PHASE -1
#include <hip/hip_runtime.h>
#include <cstdio>
#include <cstdint>
namespace pg8 {
#define PG8_LAS __attribute__((address_space(3)))
typedef unsigned short bf16_t;
typedef short bf16x8 __attribute__((ext_vector_type(8)));
typedef float f32x4 __attribute__((ext_vector_type(4)));
typedef unsigned u32x4 __attribute__((ext_vector_type(4)));
constexpr int BM = 256, BK = 64, HALF = 128, HTB = HALF * BK * 2  , STAGE_BYTES = 8 * HTB, NXCD = 8, WGM = 8;

__host__ __device__ __forceinline__ int lds_byte(int r, int c) { const int st = (r >> 4) * 2 + (c >> 5), rr = r & 15, cc = c & 31, ob = rr * 64 + cc * 2; return st * 1024 + (ob ^ (((ob >> 9) & 1) << 5)); }
__host__ __device__ __forceinline__ void stage_rc(int b, int& R, int& C) { const int st = b / 1024, sb = b % 1024, swz = sb ^ (((sb >> 9) & 1) << 5); R = (st >> 1) * 16 + swz / 64; C = (st & 1) * 32 + (swz % 64) / 2; }
__host__ __device__ __forceinline__ int perm32(int rho) { const int n = rho >> 4, i = rho & 15; return 8 * (i >> 2) + 4 * n + (i & 3); }

struct Unit { int pm, pn; };
struct Gemm { const bf16_t* A; const bf16_t* Bt; int M, N, K; };

struct StaticOrder {
    int nM, nN, nwg, G, c;
    __host__ __device__ void init(int M, int N, int G_, int c_) { nM = M / BM; nN = N / BM; nwg = nM * nN; G = G_; c = c_; }
    __host__ __device__ bool next(int i, Unit& u) const {
        const long L = (long)i * G + c; if (L >= nwg) return false;
        int wgid = (int)L; { const int q = nwg / NXCD, r = nwg % NXCD, xcd = wgid % NXCD, off = wgid / NXCD; wgid = (xcd < r ? xcd * (q + 1) : r * (q + 1) + (xcd - r) * q) + off; }
        const int nig = WGM * nN, gid = wgid / nig, fm = gid * WGM, gsz = (nM - fm) < WGM ? (nM - fm) : WGM;
        u.pm = fm + ((wgid % nig) % gsz); u.pn = (wgid % nig) / gsz; return true;
    }
    __device__ __forceinline__ void a_ready(const Unit&) const {}
    __device__ __forceinline__ void done(const Unit&) const {}
};

__device__ __forceinline__ unsigned cvt_pk_bf16(float lo, float hi) { unsigned r; asm volatile("v_cvt_pk_bf16_f32 %0, %1, %2" : "=v"(r) : "v"(lo), "v"(hi)); return r; }
typedef float f32x2 __attribute__((ext_vector_type(2)));
__device__ __forceinline__ f32x2 gelu_pk(f32x2 v) {
    const f32x2 av = __builtin_elementwise_abs(v), d = av * 0.2316418882f + 1.0f;
    f32x2 t; t.x = __builtin_amdgcn_rcpf(d.x); t.y = __builtin_amdgcn_rcpf(d.y);
    f32x2 q = t * 0.5307027145f + (-0.7265760135f); q = q * t + 0.7107068705f; q = q * t + (-0.142248368f); q = q * t + 0.127414796f; q = q * t;
    const f32x2 s = (v * v) * (-0.72134752044f);
    f32x2 e; e.x = __builtin_amdgcn_exp2f(s.x); e.y = __builtin_amdgcn_exp2f(s.y);
    const f32x2 m = v * (q * e), r = v - m;
    f32x2 o; o.x = v.x < 0.f ? m.x : r.x; o.y = v.y < 0.f ? m.y : r.y; return o;
}

template <int ACT  > struct EpiBf16 {
    static constexpr bool PERM = true, AFTER_DRAIN = false; static_assert(ACT == 0 || ACT == 1, "EpiBf16: ACT is 0 (none) or 1 (gelu_pk)");
    bf16_t* O; int ldc; const float* bias; int split_cols; size_t split_stride; float scale0;
    __device__ __forceinline__ void operator()(const f32x4 (&acc)[2][2][4][2], const Unit& u, int wr, int wc, int fr, int fq) const {
        const int row0 = u.pm * BM + wr * 64 + fr; int colt = u.pn * BM; bf16_t* base = O;
        float sc = 1.f; if (split_cols) { const int t = colt / split_cols; base += (size_t)t * split_stride; colt -= t * split_cols; if (t == 0) sc = scale0; }
        const int col0 = colt + wc * 32 + 8 * fq, bcol0 = u.pn * BM + wc * 32 + 8 * fq;
        f32x4 bv[2][2];
#pragma unroll
        for (int bj = 0; bj < 2; ++bj)
#pragma unroll
            for (int n = 0; n < 2; ++n) bv[bj][n] = bias ? *(const f32x4*)(bias + bcol0 + bj * HALF + 4 * n) : (f32x4){0.f, 0.f, 0.f, 0.f};
#pragma unroll
        for (int ai = 0; ai < 2; ++ai)
#pragma unroll
            for (int m = 0; m < 4; ++m) { bf16_t* rowp = base + (size_t)(row0 + ai * HALF + m * 16) * ldc + col0;
#pragma unroll
                for (int bj = 0; bj < 2; ++bj) { f32x4 v0 = acc[ai][bj][m][0] + bv[bj][0], v1 = acc[ai][bj][m][1] + bv[bj][1];
                    if (ACT == 1) { f32x2 a = gelu_pk((f32x2){v0[0], v0[1]}), b = gelu_pk((f32x2){v0[2], v0[3]}), c = gelu_pk((f32x2){v1[0], v1[1]}), d = gelu_pk((f32x2){v1[2], v1[3]});
                        v0 = (f32x4){a.x, a.y, b.x, b.y}; v1 = (f32x4){c.x, c.y, d.x, d.y}; }
                    v0 = v0 * sc; v1 = v1 * sc; u32x4 w; w.x = cvt_pk_bf16(v0[0], v0[1]); w.y = cvt_pk_bf16(v0[2], v0[3]); w.z = cvt_pk_bf16(v1[0], v1[1]); w.w = cvt_pk_bf16(v1[2], v1[3]);
                    *(u32x4*)(rowp + bj * HALF) = w; } }
    }
};
__device__ __forceinline__ f32x4 sigm4(f32x4 v) { f32x4 o;
#pragma unroll
    for (int j = 0; j < 4; ++j) o[j] = __builtin_amdgcn_rcpf(1.0f + __builtin_amdgcn_exp2f(-1.4426950408889634f * v[j]));
    return o; }
__device__ __forceinline__ f32x4 gelu4(f32x4 v) { const f32x2 a = gelu_pk((f32x2){v[0], v[1]}), b = gelu_pk((f32x2){v[2], v[3]}); return (f32x4){a.x, a.y, b.x, b.y}; }
__device__ __forceinline__ void unpack8(const u32x4 w, f32x4& lo, f32x4& hi) {
    lo = (f32x4){__uint_as_float(w.x << 16), __uint_as_float(w.x & 0xffff0000u), __uint_as_float(w.y << 16), __uint_as_float(w.y & 0xffff0000u)};
    hi = (f32x4){__uint_as_float(w.z << 16), __uint_as_float(w.z & 0xffff0000u), __uint_as_float(w.w << 16), __uint_as_float(w.w & 0xffff0000u)}; }
struct EpiIn {
    static constexpr bool PERM = true, AFTER_DRAIN = false;
    bf16_t* qkv; bf16_t* lx; bf16_t* gy; bf16_t* ga; bf16_t* gl; const float* bias;
    __device__ __forceinline__ void operator()(const f32x4 (&acc)[2][2][4][2], const Unit& u, int wr, int wc, int fr, int fq) const {
        const int pn = u.pn; bf16_t* base; int ldc, colt, act;
        if (pn < 24) { base = qkv + (size_t)(pn >> 3) * ((size_t)8192 * 2048); ldc = 2048; colt = (pn & 7) * 256; act = 0; }
        else if (pn < 32) { base = lx; ldc = 2048; colt = (pn - 24) * 256; act = 0; }
        else if (pn < 40) { base = gy; ldc = 2048; colt = (pn - 32) * 256; act = 1; }
        else if (pn < 56) { base = ga; ldc = 4096; colt = (pn - 40) * 256; act = 2; }
        else { base = gl; ldc = 4096; colt = (pn - 56) * 256; act = 2; }
        const int row0 = u.pm * BM + wr * 64 + fr, col0 = colt + wc * 32 + 8 * fq, bcol0 = pn * BM + wc * 32 + 8 * fq;
        f32x4 bv[2][2];
#pragma unroll
        for (int bj = 0; bj < 2; ++bj)
#pragma unroll
            for (int n = 0; n < 2; ++n) bv[bj][n] = *(const f32x4*)(bias + bcol0 + bj * HALF + 4 * n);
#pragma unroll
        for (int ai = 0; ai < 2; ++ai)
#pragma unroll
            for (int m = 0; m < 4; ++m) { bf16_t* rowp = base + (size_t)(row0 + ai * HALF + m * 16) * ldc + col0;
#pragma unroll
                for (int bj = 0; bj < 2; ++bj) { f32x4 v0 = acc[ai][bj][m][0] + bv[bj][0], v1 = acc[ai][bj][m][1] + bv[bj][1];
                    if (act == 1) { v0 = gelu4(v0); v1 = gelu4(v1); }
                    else if (act == 2) { v0 = sigm4(v0); v1 = sigm4(v1); }
                    u32x4 w; w.x = cvt_pk_bf16(v0[0], v0[1]); w.y = cvt_pk_bf16(v0[2], v0[3]); w.z = cvt_pk_bf16(v1[0], v1[1]); w.w = cvt_pk_bf16(v1[2], v1[3]);
                    *(u32x4*)(rowp + bj * HALF) = w; } }
    }
};
template <int MODE> struct EpiGate {
    static constexpr bool PERM = true, AFTER_DRAIN = false;
    bf16_t* O; const bf16_t* Gt; int ldc;
    __device__ __forceinline__ void operator()(const f32x4 (&acc)[2][2][4][2], const Unit& u, int wr, int wc, int fr, int fq) const {
        const int row0 = u.pm * BM + wr * 64 + fr, col0 = u.pn * BM + wc * 32 + 8 * fq;
#pragma unroll
        for (int ai = 0; ai < 2; ++ai)
#pragma unroll
            for (int m = 0; m < 4; ++m) { const size_t off = (size_t)(row0 + ai * HALF + m * 16) * ldc + col0;
#pragma unroll
                for (int bj = 0; bj < 2; ++bj) { f32x4 g0, g1; unpack8(*(const u32x4*)(Gt + off + bj * HALF), g0, g1);
                    f32x4 v0 = acc[ai][bj][m][0] * g0, v1 = acc[ai][bj][m][1] * g1;
                    if (MODE == 1) { f32x4 t0, t1; unpack8(*(const u32x4*)(O + off + bj * HALF), t0, t1); v0 += t0; v1 += t1; }
                    u32x4 w; w.x = cvt_pk_bf16(v0[0], v0[1]); w.y = cvt_pk_bf16(v0[2], v0[3]); w.z = cvt_pk_bf16(v1[0], v1[1]); w.w = cvt_pk_bf16(v1[2], v1[3]);
                    *(u32x4*)(O + off + bj * HALF) = w; } }
    }
};
struct EpiRes {
    static constexpr bool PERM = false, AFTER_DRAIN = false;
    const float* X; float* Out; const float* gate; int ldc;
    __device__ __forceinline__ void operator()(const f32x4 (&acc)[2][2][4][2], const Unit& u, int wr, int wc, int fr, int fq) const {
        const int row0 = u.pm * BM + wr * 64 + fr, col0 = u.pn * BM + wc * 32 + 4 * fq;
        f32x4 gv[2][2];
#pragma unroll
        for (int bj = 0; bj < 2; ++bj)
#pragma unroll
            for (int n = 0; n < 2; ++n) gv[bj][n] = *(const f32x4*)(gate + col0 + bj * HALF + n * 16);
#pragma unroll
        for (int ai = 0; ai < 2; ++ai)
#pragma unroll
            for (int m = 0; m < 4; ++m) { const size_t off = (size_t)(row0 + ai * HALF + m * 16) * ldc + col0;
#pragma unroll
                for (int bj = 0; bj < 2; ++bj)
#pragma unroll
                    for (int n = 0; n < 2; ++n) { const f32x4 xv = *(const f32x4*)(X + off + bj * HALF + n * 16);
                        *(f32x4*)(Out + off + bj * HALF + n * 16) = xv + gv[bj][n] * acc[ai][bj][m][n]; } }
    }
};
template <class Epi, class Sched, bool ALIGN_EPI = false, bool SP2 = false>
__device__ __forceinline__ void gemm_phase(PG8_LAS unsigned char* lds, const Gemm g, const Sched& S, const Epi& E) {
    const int tid = threadIdx.x, wid = __builtin_amdgcn_readfirstlane(tid >> 6), lane = tid & 63, wr = wid >> 2, wc = wid & 3, fr = lane & 15, fq = lane >> 4;
    const int K = g.K, nt = K / BK;
    unsigned voffA[2], voffB[2];
#pragma unroll
    for (int i = 0; i < 2; ++i) { int R, C; stage_rc(tid * 16 + i * 8192, R, C); const int Rb = Epi::PERM ? ((R & ~31) + perm32(R & 31)) : R;
        voffA[i] = (unsigned)(R * K + C) * 2u; voffB[i] = (unsigned)(Rb * K + C) * 2u; }
    const size_t kstep = (size_t)(BK * 2);
    const size_t hstep = (size_t)HALF * K * 2;
    const size_t tstep = 2 * hstep;
    const unsigned ldsw = (unsigned)wid * 1024u;
    const int aoff = lds_byte(wr * 64 + fr, fq * 8), boff = lds_byte(wc * 32 + fr, fq * 8);
#define PG8_SA(b, h) (((b) * 2 + (h)) * HTB)
#define PG8_SB(b, h) ((4 + (b) * 2 + (h)) * HTB)
#define PG8_STAGE(bufoff, gbase, voff) do { _Pragma("unroll") for (int _i = 0; _i < 2; ++_i) \
        __builtin_amdgcn_global_load_lds((const unsigned*)((const char*)(gbase) + (voff)[_i]), (PG8_LAS unsigned*)(lds + (bufoff) + ldsw + _i * 8192), 16, 0, 0); } while (0)
#define PG8_LDA(dst, b, h) do { _Pragma("unroll") for (int m = 0; m < 4; ++m) _Pragma("unroll") for (int k = 0; k < 2; ++k) dst[m][k] = *(const PG8_LAS bf16x8*)(lds + PG8_SA(b, h) + aoff + m * 2048 + k * 1024); } while (0)
#define PG8_LDB(dst, b, h) do { _Pragma("unroll") for (int n = 0; n < 2; ++n) _Pragma("unroll") for (int k = 0; k < 2; ++k) dst[n][k] = *(const PG8_LAS bf16x8*)(lds + PG8_SB(b, h) + boff + n * 2048 + k * 1024); } while (0)
#define PG8_MMA(ai, bj, At, Bt) do { __builtin_amdgcn_s_setprio(1); _Pragma("unroll") for (int m = 0; m < 4; ++m) _Pragma("unroll") for (int n = 0; n < 2; ++n) _Pragma("unroll") for (int k = 0; k < 2; ++k) \
        acc[ai][bj][m][n] = __builtin_amdgcn_mfma_f32_16x16x32_bf16(Bt[n][k], At[m][k], acc[ai][bj][m][n], 0, 0, 0); __builtin_amdgcn_s_setprio(0); } while (0)
#define PG8_WAIT_V(n) asm volatile("s_waitcnt vmcnt(" #n ")" ::: "memory")
#define PG8_WAIT_L(n) asm volatile("s_waitcnt lgkmcnt(" #n ")" ::: "memory")
#define PG8_BAR __builtin_amdgcn_s_barrier()
#define PG8_SCHED __builtin_amdgcn_sched_barrier(0)
    Unit cur, nxt; int ui = 0;
    if (!S.next(0, cur)) return;
    f32x4 acc[2][2][4][2];
#pragma unroll
    for (int a = 0; a < 2; ++a)
#pragma unroll
        for (int b = 0; b < 2; ++b)
#pragma unroll
            for (int m = 0; m < 4; ++m)
#pragma unroll
                for (int n = 0; n < 2; ++n) acc[a][b][m][n] = (f32x4){0.f, 0.f, 0.f, 0.f};
    bf16x8 At[4][2], B0[2][2], B1[2][2];
    const char* cA = (const char*)g.A + (size_t)cur.pm * tstep; const char* cB = (const char*)g.Bt + (size_t)cur.pn * tstep;
    S.a_ready(cur);
    if constexpr (SP2) {
        PG8_STAGE(PG8_SB(0, 0), cB, voffB); PG8_STAGE(PG8_SB(0, 1), cB + hstep, voffB); PG8_STAGE(PG8_SA(0, 0), cA, voffA); PG8_STAGE(PG8_SA(0, 1), cA + hstep, voffA);
        if (wr == 1) PG8_BAR;
        PG8_WAIT_V(2); PG8_BAR;
        PG8_STAGE(PG8_SB(1, 0), cB + kstep, voffB); PG8_STAGE(PG8_SA(1, 0), cA + kstep, voffA); PG8_STAGE(PG8_SB(1, 1), cB + hstep + kstep, voffB);
        PG8_WAIT_V(6); PG8_BAR;
    } else {
        PG8_STAGE(PG8_SB(0, 0), cB, voffB); PG8_STAGE(PG8_SA(0, 0), cA, voffA); PG8_STAGE(PG8_SB(0, 1), cB + hstep, voffB); PG8_STAGE(PG8_SA(0, 1), cA + hstep, voffA);
        if (wr == 1) PG8_BAR;
        PG8_WAIT_V(4); PG8_BAR;
        PG8_STAGE(PG8_SB(1, 0), cB + kstep, voffB); PG8_STAGE(PG8_SA(1, 0), cA + kstep, voffA); PG8_STAGE(PG8_SB(1, 1), cB + hstep + kstep, voffB);
        PG8_WAIT_V(6); PG8_BAR;
    }
    for (;;) {
        const bool has_next = S.next(ui + 1, nxt);
        const char* nA = has_next ? (const char*)g.A + (size_t)nxt.pm * tstep : cA; const char* nB = has_next ? (const char*)g.Bt + (size_t)nxt.pn * tstep : cB;
        for (int t = 0; t < nt; t += 2) {
            const bool last = (t == nt - 2);
            const char* a1 = cA + (size_t)(t + 1) * kstep;
            const char* a2 = last ? nA : cA + (size_t)(t + 2) * kstep; const char* b2 = last ? nB : cB + (size_t)(t + 2) * kstep;
            const char* a3 = a2 + kstep; const char* b3 = b2 + kstep;
            if (last && has_next) S.a_ready(nxt);
            if constexpr (SP2) {
            PG8_LDB(B0, 0, 0); PG8_LDB(B1, 0, 1); PG8_SCHED; PG8_LDA(At, 0, 0); PG8_STAGE(PG8_SA(1, 1), a1 + hstep, voffA);
            PG8_WAIT_V(8); PG8_WAIT_L(0); PG8_BAR; PG8_MMA(0, 0, At, B0); PG8_MMA(0, 1, At, B1); PG8_BAR; PG8_SCHED;
            PG8_LDA(At, 0, 1); PG8_STAGE(PG8_SB(0, 0), b2, voffB); PG8_STAGE(PG8_SB(0, 1), b2 + hstep, voffB); PG8_STAGE(PG8_SA(0, 0), a2, voffA);
            PG8_WAIT_V(8); PG8_WAIT_L(0); PG8_BAR; PG8_MMA(1, 0, At, B0); PG8_MMA(1, 1, At, B1); PG8_BAR; PG8_SCHED;
            PG8_LDB(B0, 1, 0); PG8_LDB(B1, 1, 1); PG8_SCHED; PG8_LDA(At, 1, 0); PG8_STAGE(PG8_SA(0, 1), a2 + hstep, voffA);
            PG8_WAIT_V(8); PG8_WAIT_L(0); PG8_BAR; PG8_MMA(0, 0, At, B0); PG8_MMA(0, 1, At, B1); PG8_BAR; PG8_SCHED;
            PG8_LDA(At, 1, 1); PG8_STAGE(PG8_SB(1, 0), b3, voffB); PG8_STAGE(PG8_SB(1, 1), b3 + hstep, voffB); PG8_STAGE(PG8_SA(1, 0), a3, voffA);
            PG8_WAIT_V(8); PG8_WAIT_L(0); PG8_BAR; PG8_MMA(1, 0, At, B0); PG8_MMA(1, 1, At, B1); PG8_BAR; PG8_SCHED;
            } else {
            PG8_LDB(B0, 0, 0); PG8_SCHED; PG8_LDA(At, 0, 0); PG8_STAGE(PG8_SA(1, 1), a1 + hstep, voffA);
            PG8_WAIT_L(8); PG8_BAR; PG8_WAIT_L(0); PG8_MMA(0, 0, At, B0); PG8_BAR; PG8_SCHED;
            PG8_LDB(B1, 0, 1); PG8_STAGE(PG8_SB(0, 0), b2, voffB);
            PG8_BAR; PG8_WAIT_L(0); PG8_MMA(0, 1, At, B1); PG8_BAR;
            PG8_LDA(At, 0, 1); PG8_STAGE(PG8_SA(0, 0), a2, voffA);
            PG8_BAR; PG8_WAIT_L(0); PG8_MMA(1, 0, At, B0); PG8_BAR; PG8_SCHED;
            PG8_STAGE(PG8_SB(0, 1), b2 + hstep, voffB);
            PG8_WAIT_V(6); PG8_BAR; PG8_MMA(1, 1, At, B1); PG8_BAR;
            PG8_LDB(B0, 1, 0); PG8_SCHED; PG8_LDA(At, 1, 0); PG8_STAGE(PG8_SA(0, 1), a2 + hstep, voffA);
            PG8_WAIT_L(8); PG8_BAR; PG8_WAIT_L(0); PG8_MMA(0, 0, At, B0); PG8_BAR; PG8_SCHED;
            PG8_LDB(B1, 1, 1); PG8_STAGE(PG8_SB(1, 0), b3, voffB);
            PG8_BAR; PG8_WAIT_L(0); PG8_MMA(0, 1, At, B1); PG8_BAR;
            PG8_LDA(At, 1, 1); PG8_STAGE(PG8_SA(1, 0), a3, voffA);
            PG8_BAR; PG8_WAIT_L(0); PG8_MMA(1, 0, At, B0); PG8_BAR; PG8_SCHED;
            PG8_STAGE(PG8_SB(1, 1), b3 + hstep, voffB);
            PG8_WAIT_V(6); PG8_BAR; PG8_MMA(1, 1, At, B1); PG8_BAR;
            }
        }
        if constexpr (ALIGN_EPI) { if (wr == 0) PG8_BAR; }
        if constexpr (!Epi::AFTER_DRAIN) { E(acc, cur, wr, wc, fr, fq); S.done(cur); }
        if (!has_next) break;
#pragma unroll
        for (int a = 0; a < 2; ++a)
#pragma unroll
            for (int b = 0; b < 2; ++b)
#pragma unroll
                for (int m = 0; m < 4; ++m)
#pragma unroll
                    for (int n = 0; n < 2; ++n) acc[a][b][m][n] = (f32x4){0.f, 0.f, 0.f, 0.f};
        cur = nxt; cA = nA; cB = nB; ++ui;
        if constexpr (ALIGN_EPI) { if (wr == 1) PG8_BAR; }
    }
    PG8_WAIT_V(0);
    if constexpr (!ALIGN_EPI) { if (wr == 0) PG8_BAR; }
    PG8_BAR;
    if constexpr (Epi::AFTER_DRAIN) { E.fused(acc, cur, wr, wc, fr, fq, lds, wid, lane); S.done(cur); }
#undef PG8_SA
#undef PG8_SB
#undef PG8_STAGE
#undef PG8_LDA
#undef PG8_LDB
#undef PG8_MMA
#undef PG8_WAIT_V
#undef PG8_WAIT_L
#undef PG8_BAR
#undef PG8_SCHED
}
}
namespace attn_body {
constexpr int D = 128, LD = 2048;
constexpr float THR = 8.f; constexpr bool WSKIP = false;
constexpr float SCALE = 0.08838834764831845f;
constexpr int NW = 8, QBLK = 32, KVBLK = 64, QB = NW * QBLK;
constexpr int SHM_V = KVBLK * D * 2, SHM_K = KVBLK * D * 2;
constexpr int LDS_BYTES = 2 * SHM_V + 2 * SHM_K + NW * 64 * 4;

typedef short bf16x8 __attribute__((ext_vector_type(8)));
typedef short s16x4 __attribute__((ext_vector_type(4)));
typedef float f32x16 __attribute__((ext_vector_type(16)));
typedef float f32x4 __attribute__((ext_vector_type(4)));
typedef unsigned u32x4 __attribute__((ext_vector_type(4)));
template <class A, class Bt> struct same_t { static constexpr bool v = false; };
template <class A> struct same_t<A, A> { static constexpr bool v = true; };

#define KSWZ(row, colB) ((row) * 256 + ((colB) ^ (((row) & 7) << 4)))
#define SBAR() __builtin_amdgcn_sched_barrier(0)
__device__ __forceinline__ int v_st(int k, int c) { const int kk = (k & ~0xC) | ((k & 4) << 1) | ((k & 8) >> 1); return ((kk >> 3) * 4 + (c >> 5)) * 512 + ((kk & 7) * 32 + (c & 31)) * 2; }
__device__ __forceinline__ int v_rd_base(int lane) { return ((lane & 3) << 3) | (((lane >> 2) & 3) << 6) | (((lane >> 4) & 1) << 5) | (((lane >> 5) & 1) << 8); }
constexpr int v_rd_off(int d0, int ks, int half) { return d0 * 512 + ks * 4096 + half * 2048; }
__device__ __forceinline__ int crow(int r, int hi) { return (r & 3) + 8 * (r >> 2) + 4 * hi; }
__device__ __forceinline__ unsigned cvtpk(float lo, float hi) {
    unsigned r; asm volatile("v_cvt_pk_bf16_f32 %0, %1, %2" : "=v"(r) : "v"(lo), "v"(hi)); return r;
}
__device__ __forceinline__ bf16x8 pack8(f32x4 a, f32x4 b) {
    u32x4 w = {cvtpk(a[0], a[1]), cvtpk(a[2], a[3]), cvtpk(b[0], b[1]), cvtpk(b[2], b[3])};
    return *reinterpret_cast<bf16x8*>(&w);
}
template <class T> __device__ __forceinline__ bf16x8 load8(const T* p) {
    if constexpr (same_t<T, float>::v) { return pack8(*(const f32x4*)p, *(const f32x4*)(p + 4)); }
    else { return *reinterpret_cast<const bf16x8*>(p); }
}
__device__ __forceinline__ void mask_tile(f32x16& p0, f32x16& p1, int dq, unsigned W) {
    const float NEG = -__builtin_inff();
#pragma unroll
    for (int r = 0; r < 16; ++r) {
        const int c = (r & 3) + 8 * (r >> 2);
        if ((unsigned)(dq - c) >= W) p0[r] = NEG;
        if ((unsigned)(dq - c - 32) >= W) p1[r] = NEG;
    }
}
__device__ __forceinline__ void partialSM(f32x16& p0, f32x16& p1, float& m_reg, float& mn, float& alpha) {
    float pmax = p0[0]; for (int r = 1; r < 16; ++r) pmax = fmaxf(pmax, p0[r]); for (int r = 0; r < 16; ++r) pmax = fmaxf(pmax, p1[r]);
    { auto rr = __builtin_amdgcn_permlane32_swap(__float_as_uint(pmax), __float_as_uint(pmax), false, false);
      pmax = fmaxf(__uint_as_float(rr[0]), __uint_as_float(rr[1])); }
    constexpr float C2 = 1.4426950408889634f * SCALE;
    if (__builtin_expect(__all((pmax - m_reg) * SCALE <= THR), 1)) { mn = m_reg; alpha = 1.f; }
    else { mn = fmaxf(m_reg, pmax); alpha = __builtin_amdgcn_exp2f((m_reg - mn) * C2); m_reg = mn; }
    const float mnL = -mn * C2;
    for (int r = 0; r < 16; ++r) p0[r] = fmaf(p0[r], C2, mnL); for (int r = 0; r < 16; ++r) p1[r] = fmaf(p1[r], C2, mnL);
    for (int r = 0; r < 16; ++r) p0[r] = __builtin_amdgcn_exp2f(p0[r]);
}
__device__ __forceinline__ void finishSM(f32x16& p0, f32x16& p1, float alpha, float& l_reg, bf16x8& pa0, bf16x8& pa1, bf16x8& pa2, bf16x8& pa3) {
    for (int r = 0; r < 16; ++r) p1[r] = __builtin_amdgcn_exp2f(p1[r]);
    float ps = 0; for (int r = 0; r < 16; ++r) ps += p0[r]; for (int r = 0; r < 16; ++r) ps += p1[r];
    { auto rr = __builtin_amdgcn_permlane32_swap(__float_as_uint(ps), __float_as_uint(ps), false, false);
      ps = __uint_as_float(rr[0]) + __uint_as_float(rr[1]); }
    l_reg = l_reg * alpha + ps;
#define PK4(P, B_, OUT) do { unsigned a0 = cvtpk(P[B_+0], P[B_+1]), a1 = cvtpk(P[B_+2], P[B_+3]);                          \
        unsigned b0 = cvtpk(P[B_+4], P[B_+5]), b1 = cvtpk(P[B_+6], P[B_+7]);                                             \
        auto r0 = __builtin_amdgcn_permlane32_swap(a0, b0, false, false); auto r1 = __builtin_amdgcn_permlane32_swap(a1, b1, false, false); \
        u32x4 w = {r0[0], r1[0], r0[1], r1[1]}; OUT = *reinterpret_cast<bf16x8*>(&w); } while (0)
    PK4(p0, 0, pa0); PK4(p0, 8, pa1); PK4(p1, 0, pa2); PK4(p1, 8, pa3);
#undef PK4
}
template <int KB, bool SK>
__device__ __forceinline__ void qkt(f32x16& p0, f32x16& p1, const char* K_lds, int r32, int hi, const bf16x8* qr, bool act, const float* bt) {
    if (SK && !act) { const float NEG = -__builtin_inff();
#pragma unroll
        for (int r = 0; r < 16; ++r) { p0[r] = NEG; p1[r] = NEG; } return; }
    { const f32x4 b0 = *(const f32x4*)(bt), b1 = *(const f32x4*)(bt + 8), b2 = *(const f32x4*)(bt + 16), b3 = *(const f32x4*)(bt + 24);
      const f32x4 c0 = *(const f32x4*)(bt + 32), c1 = *(const f32x4*)(bt + 40), c2 = *(const f32x4*)(bt + 48), c3 = *(const f32x4*)(bt + 56);
      p0 = (f32x16){b0[0], b0[1], b0[2], b0[3], b1[0], b1[1], b1[2], b1[3], b2[0], b2[1], b2[2], b2[3], b3[0], b3[1], b3[2], b3[3]};
      p1 = (f32x16){c0[0], c0[1], c0[2], c0[3], c1[0], c1[1], c1[2], c1[3], c2[0], c2[1], c2[2], c2[3], c3[0], c3[1], c3[2], c3[3]}; }
    const char* kb[4];
#pragma unroll
    for (int dd = 0; dd < 4; ++dd) kb[dd] = K_lds + KB * SHM_K + KSWZ(r32, (dd * 16 + hi * 8) * 2);
#pragma unroll
    for (int d0 = 0; d0 < 8; ++d0) { const char* a = kb[d0 & 3] + (d0 >> 2) * 128;
        bf16x8 b0 = *reinterpret_cast<const bf16x8*>(a);
        bf16x8 b1 = *reinterpret_cast<const bf16x8*>(a + 32 * 256);
        p0 = __builtin_amdgcn_mfma_f32_32x32x16_bf16(b0, qr[d0], p0, 0, 0, 0);
        p1 = __builtin_amdgcn_mfma_f32_32x32x16_bf16(b1, qr[d0], p1, 0, 0, 0); }
}
template <int VB, bool SK>
__device__ __forceinline__ void pv_tile(f32x16* o, int vb0, bf16x8 pa0, bf16x8 pa1, bf16x8 pa2, bf16x8 pa3, bool act) {
    if (SK && !act) return;
#define TRRD(dst, off) asm volatile("ds_read_b64_tr_b16 %0, %1 offset:%2" : "=&v"(dst) : "v"(vb0), "i"(off) : "memory")
#define PV_D0(d0) do { s16x4 l0, l1, l2, l3, h0, h1, h2, h3; constexpr int b_ = VB * SHM_V + v_rd_off(d0, 0, 0);     \
        TRRD(l0, b_); TRRD(h0, b_ + 2048); TRRD(l1, b_ + 4096); TRRD(h1, b_ + 6144); TRRD(l2, b_ + 8192); TRRD(h2, b_ + 10240); TRRD(l3, b_ + 12288); TRRD(h3, b_ + 14336); \
        asm volatile("s_waitcnt lgkmcnt(0)" ::: "memory"); SBAR();                 \
        o[d0] = __builtin_amdgcn_mfma_f32_32x32x16_bf16(pa0, (bf16x8){l0[0], l0[1], l0[2], l0[3], h0[0], h0[1], h0[2], h0[3]}, o[d0], 0, 0, 0);   \
        o[d0] = __builtin_amdgcn_mfma_f32_32x32x16_bf16(pa1, (bf16x8){l1[0], l1[1], l1[2], l1[3], h1[0], h1[1], h1[2], h1[3]}, o[d0], 0, 0, 0);   \
        o[d0] = __builtin_amdgcn_mfma_f32_32x32x16_bf16(pa2, (bf16x8){l2[0], l2[1], l2[2], l2[3], h2[0], h2[1], h2[2], h2[3]}, o[d0], 0, 0, 0);   \
        o[d0] = __builtin_amdgcn_mfma_f32_32x32x16_bf16(pa3, (bf16x8){l3[0], l3[1], l3[2], l3[3], h3[0], h3[1], h3[2], h3[3]}, o[d0], 0, 0, 0); } while (0)
    PV_D0(0); PV_D0(1); PV_D0(2); PV_D0(3);
#undef PV_D0
#undef TRRD
}


template <class TIn, class TOut> struct BlockRef { const TIn* Q; const TIn* K; const TIn* V; TOut* O; int P0; int jlo; };
#define ROW(p, k0, rr) ((p) + (size_t)((k0) + (rr)) * LD + sc)
#define VMW() asm volatile("s_waitcnt vmcnt(0)" ::: "memory")
#define SLOAD_H(Kp, Vp, k0) do { st_v0 = load8<TIn>(ROW(Vp, k0, sr)); st_v1 = load8<TIn>(ROW(Vp, k0, 32 + sr));              \
                         st_k0 = load8<TIn>(ROW(Kp, k0, sr)); st_k1 = load8<TIn>(ROW(Kp, k0, 32 + sr)); } while (0)
#define SWRITE_H(bf) do { *(bf16x8*)(V_lds + (bf) * SHM_V + vst0) = st_v0; *(bf16x8*)(V_lds + (bf) * SHM_V + vst1) = st_v1;   \
                          *(bf16x8*)(K_lds + (bf) * SHM_K + kws) = st_k0; *(bf16x8*)(K_lds + (bf) * SHM_K + kws + 32 * 256) = st_k1; } while (0)
template <class TIn, class TOut>
__device__ __forceinline__ void attn_unit(const BlockRef<TIn, TOut>& cur, int skv, char* lds) {
    const int tid = threadIdx.x, wid = __builtin_amdgcn_readfirstlane(tid >> 6), lane = tid & 63, r32 = lane & 31, hi = lane >> 5;
    const unsigned W = 0x40000000u;
    const int j_lo = cur.jlo;
    int j_hi = (cur.P0 + QB - 1) / KVBLK + 1; if (j_hi > skv / KVBLK) j_hi = skv / KVBLK;
    const int NT = j_hi - j_lo;
    const int qlo = cur.P0 + wid * QBLK, qm = qlo + r32 - 4 * hi;
    char* V_lds = lds; char* K_lds = lds + 2 * SHM_V;
    float* ws = (float*)(lds + 2 * SHM_V + 2 * SHM_K) + wid * 64; float* li_l = ws, * al_l = ws + 32;
    const float* bias_l = (const float*)(lds + LDS_BYTES) + 4 * hi;
    float m_reg = -1e30f, l_reg = 0; f32x16 o[4] = {};
    const int sr = tid >> 4, sc = (tid & 15) * 8, vst0 = v_st(sr, sc), vst1 = v_st(32 + sr, sc), kws = KSWZ(sr, sc * 2);
    const int vb0 = (int)(uintptr_t)V_lds + v_rd_base(lane);
    const TIn* Kh = cur.K; const TIn* Vh = cur.V;
    bf16x8 st_v0, st_v1, st_k0, st_k1; bf16x8 qr[8];
#define KBASE(t) ((j_lo + (t)) * KVBLK)
#define BT(t) (bias_l + (t) * KVBLK)
#define RESC(a) do { if (__any((a) < 1.f)) { if (hi == 0) al_l[r32] = (a); asm volatile("s_waitcnt lgkmcnt(0)" ::: "memory");              \
                     for (int d_ = 0; d_ < 4; ++d_) for (int r = 0; r < 16; ++r) o[d_][r] *= al_l[crow(r, hi)]; } } while (0)
#define MASKT(P0_, P1_, t) do { const int kb_ = KBASE(t); if (kb_ + KVBLK - 1 > qlo) mask_tile(P0_, P1_, qm - kb_, W); } while (0)
#pragma unroll
    for (int d0 = 0; d0 < 8; ++d0) qr[d0] = load8<TIn>(cur.Q + (size_t)(wid * QBLK + r32) * LD + d0 * 16 + hi * 8);
    SLOAD_H(Kh, Vh, KBASE(0)); VMW(); SWRITE_H(0); SBAR();
    if (NT > 1) SLOAD_H(Kh, Vh, KBASE(1));
    __syncthreads();
    f32x16 p0, p1; float mn, al; bf16x8 pa0, pa1, pa2, pa3;
#define TILE_STEP(t, BUF) do {                                                                                                 \
        SBAR(); qkt<BUF, false>(p0, p1, K_lds, r32, hi, qr, true, BT(t));                                                       \
        MASKT(p0, p1, (t)); partialSM(p0, p1, m_reg, mn, al); RESC(al);                                                          \
        finishSM(p0, p1, al, l_reg, pa0, pa1, pa2, pa3); SBAR();                                                                 \
        pv_tile<BUF, false>(o, vb0, pa0, pa1, pa2, pa3, true);                                                                    \
        if ((t) + 1 < NT) { VMW(); SWRITE_H(1 - (BUF)); SBAR(); if ((t) + 2 < NT) SLOAD_H(Kh, Vh, KBASE((t) + 2)); }              \
        __syncthreads(); } while (0)
    for (int t = 0; t < NT; t += 2) {
        TILE_STEP(t, 0);
        if (t + 1 < NT) TILE_STEP(t + 1, 1);
    }
    if (hi == 0) li_l[r32] = l_reg; asm volatile("s_waitcnt lgkmcnt(0)" ::: "memory");
    float rli[16];
#pragma unroll
    for (int r = 0; r < 16; ++r) rli[r] = __builtin_amdgcn_rcpf(li_l[crow(r, hi)]);
    TOut* Ow = cur.O + (size_t)(wid * QBLK) * LD;
#pragma unroll
    for (int r = 0; r < 16; ++r) { const int orow = crow(r, hi);
#pragma unroll
        for (int d0 = 0; d0 < 4; ++d0) { const float v = o[d0][r] * rli[r];
            const float vn = __shfl_xor(v, 1);
            if ((r32 & 1) == 0) *(unsigned*)(Ow + (size_t)orow * LD + d0 * 32 + r32) = cvtpk(v, vn); } }
    __syncthreads();
#undef TILE_STEP
#undef RESC
#undef KBASE
#undef BT
#undef MASKT
}
#undef ROW
#undef VMW
#undef SLOAD_H
#undef SWRITE_H
}
#define GAS __attribute__((address_space(1)))
#define LAS __attribute__((address_space(3)))
typedef unsigned short bf16;
typedef unsigned v4u __attribute__((ext_vector_type(4)));
typedef unsigned v2u __attribute__((ext_vector_type(2)));
typedef float f32x4 __attribute__((ext_vector_type(4)));
typedef float f32x2 __attribute__((ext_vector_type(2)));
typedef short bf16x8 __attribute__((ext_vector_type(8)));
typedef GAS unsigned gu32;
#define RLX_AGENT __ATOMIC_RELAXED, __HIP_MEMORY_SCOPE_AGENT

constexpr int S = 8192, DM = 4096, NH = 16, HD = 128, AW = 2048, LW = 2048, NG = 16, GD = 128;
constexpr int NIN = 18448, NINP = 18432;
constexpr int C_Q = 0, C_K = 2048, C_V = 4096, C_F = 6144, C_LX = 6160, C_LY = 8208, C_GA = 10256, C_GL = 14352;
constexpr int PEER_H = 8, PEER_NK = 128, PEER_K = 16, PEER_NE = 16384;
constexpr float EPS = 1e-6f;
constexpr size_t MiB = 1u << 20;
constexpr size_t WS_CTL = 0, CTL_ZERO_BYTES = 1 * MiB;
constexpr size_t WS_MOD = 512 * 1024;
constexpr size_t WS_WF = 2 * MiB;
constexpr size_t WS_LOGF = 3 * MiB;
constexpr size_t WS_FC = 4 * MiB;
constexpr size_t WS_AGGA = 5 * MiB, WS_AGGB = 6 * MiB;
constexpr size_t WS_BIASR = 7 * MiB;
constexpr size_t WS_WAT = 8 * MiB, WS_WXT = 9 * MiB;
constexpr size_t WS_SK = 10 * MiB;
constexpr size_t WS_IDX = 12 * MiB, WS_GATE = 16 * MiB;
constexpr size_t WS_WIN = 32 * MiB, WS_WAO = 176 * MiB, WS_WLO = 192 * MiB, WS_WOUT = 208 * MiB, WS_WPQ = 240 * MiB;
constexpr size_t WS_U = 256 * MiB, WS_V = 384 * MiB;
constexpr size_t WS_HA = 512 * MiB;
constexpr size_t WS_QKV = 576 * MiB;
constexpr size_t WS_LX = 672 * MiB, WS_GY = 704 * MiB, WS_GA = 736 * MiB, WS_GL = 800 * MiB;
constexpr size_t WS_ATT = 864 * MiB, WS_LR = 896 * MiB, WS_T1 = 928 * MiB, WS_MG = 992 * MiB, WS_Q2 = 1056 * MiB, WS_X1 = 1088 * MiB, WS_END = 1216 * MiB;
constexpr int CW_BAR = 4096;
constexpr int RING_BYTES = 131072;
constexpr int LDSCTL_OFF = RING_BYTES, MISC_OFF = LDSCTL_OFF + 320;
constexpr int LDS_BYTES = 147456;
constexpr int NWAVES = 8, NTHREADS = 512;

__device__ __forceinline__ unsigned f2bf(float f) { unsigned u = __builtin_bit_cast(unsigned, f); return (u + 0x7fffu + ((u >> 16) & 1u)) >> 16; }
__device__ __forceinline__ unsigned pk2(float lo, float hi) { return f2bf(lo) | (f2bf(hi) << 16); }
__device__ __forceinline__ float bflo(unsigned w) { return __uint_as_float(w << 16); }
__device__ __forceinline__ float bfhi(unsigned w) { return __uint_as_float(w & 0xffff0000u); }
__device__ __forceinline__ float bf2f(bf16 b) { return __uint_as_float((unsigned)b << 16); }
__device__ __forceinline__ float wave_sum(float v) {
#pragma unroll
    for (int o = 1; o < 64; o <<= 1) v += __shfl_xor(v, o);
    return v;
}
__device__ __forceinline__ float wave_max(float v) {
#pragma unroll
    for (int o = 1; o < 64; o <<= 1) v = fmaxf(v, __shfl_xor(v, o));
    return v;
}
__device__ __forceinline__ float sigmoidf_(float v) { return __builtin_amdgcn_rcpf(1.0f + __builtin_amdgcn_exp2f(-1.4426950408889634f * v)); }
__device__ __forceinline__ float gelu_erf(float v) { return 0.5f * v * (1.0f + erff(v * 0.70710678118654752f)); }
#define XB_TMO      128
#define XB_XCNT(j)  (256  + 64 * (j))
#define XB_XSUB(j)  (1280 + 64 * (j))
#define XB_XGEN(j)  (2304 + 64 * (j))
#define XB_TOP      3328
#define XB_TOPGEN   3392
#define XCD_BAR_WORDS 3456
#define XB_SPIN_CAP (1u << 18)

__device__ __forceinline__ unsigned xb_ld(unsigned* p)              { return __hip_atomic_load(p, __ATOMIC_RELAXED, __HIP_MEMORY_SCOPE_AGENT); }
__device__ __forceinline__ unsigned xb_add(unsigned* p, unsigned v) { return __hip_atomic_fetch_add(p, v, __ATOMIC_RELAXED, __HIP_MEMORY_SCOPE_AGENT); }
__device__ __forceinline__ unsigned xb_xcc_id() { return (unsigned)__builtin_amdgcn_s_getreg((3 << 11) | 20) & 0xFu; }
#define XB_SPIN(cond, bar) do { unsigned _sp = 0; while (cond) { __builtin_amdgcn_s_sleep(1); \
    if ((++_sp & 255u) == 0u) { if (xb_ld(&(bar)[XB_TMO])) break; if (_sp > XB_SPIN_CAP) { atomicAdd(&(bar)[XB_TMO], 1u); break; } } } } while (0)

struct XcdBarrier {
    unsigned* bar; unsigned x;
    volatile LAS unsigned* st;
};

__device__ __forceinline__ XcdBarrier xcd_barrier_post(unsigned* bar, volatile LAS unsigned* st) {
    XcdBarrier b; b.bar = bar; b.x = xb_xcc_id(); b.st = st;
    if (threadIdx.x == 0) (void)xb_add(&bar[XB_XCNT(b.x)], 1u);
    return b;
}
__device__ __forceinline__ void xcd_barrier_complete(unsigned* bar, unsigned x, unsigned& nloc, unsigned& nx) {
    const unsigned G = gridDim.x * gridDim.y * gridDim.z;
    unsigned sum, cnt, mine, sp = 0u;
    for (;;) {
        sum = 0u; cnt = 0u; mine = 0u;
#pragma unroll
        for (unsigned j = 0; j < 16; ++j) { const unsigned c = xb_ld(&bar[XB_XCNT(j)]); sum += c; cnt += (c > 0u) ? 1u : 0u; mine = (j == x) ? c : mine; }
        if (sum == G) break;
        __builtin_amdgcn_s_sleep(1);
        if ((++sp & 255u) == 0u) { if (xb_ld(&bar[XB_TMO])) break; if (sp > XB_SPIN_CAP) { atomicAdd(&bar[XB_TMO], 1u); break; } }
    }
    nloc = mine > 0u ? mine : 1u; nx = cnt > 0u ? cnt : 1u;
}

__device__ __forceinline__ void xcd_barrier(const XcdBarrier& b) {
    asm volatile("s_waitcnt vmcnt(0)" ::: "memory");
    __syncthreads();
    if (threadIdx.x == 0) {
        unsigned* bar = b.bar;
        __builtin_amdgcn_s_waitcnt(0);
        unsigned nloc = b.st[0], nx = b.st[1];
        if (nloc == 0u) { xcd_barrier_complete(bar, b.x, nloc, nx); b.st[0] = nloc; b.st[1] = nx; }
        const unsigned old = xb_add(&bar[XB_XSUB(b.x)], 1u);
        const unsigned gen = old / nloc;
        if (old + 1u == (gen + 1u) * nloc) {
            __builtin_amdgcn_fence(__ATOMIC_RELEASE, "agent");
            asm volatile("s_waitcnt vmcnt(0)" ::: "memory");
            const unsigned og = xb_add(&bar[XB_TOP], 1u);
            const unsigned tg = og / nx;
            if (og + 1u == (tg + 1u) * nx) xb_add(&bar[XB_TOPGEN], 1u);
            else XB_SPIN(xb_ld(&bar[XB_TOPGEN]) == tg, bar);
            __builtin_amdgcn_fence(__ATOMIC_ACQUIRE, "agent");
            xb_add(&bar[XB_XGEN(b.x)], 1u);
            asm volatile("s_waitcnt vmcnt(0)" ::: "memory");
        } else {
            XB_SPIN(xb_ld(&bar[XB_XGEN(b.x)]) == gen, bar);
            __builtin_amdgcn_fence(__ATOMIC_ACQUIRE, "agent");
            asm volatile("s_waitcnt vmcnt(0)" ::: "memory");
        }
    }
    __syncthreads();
}
struct Frame {
    LAS unsigned char* lds; volatile LAS unsigned* MISC; gu32* ctl;
    int tid, lane, wave, vcu, G;
    unsigned char* ws; float* out;
    const float *x, *c, *w_ada, *b_ada, *g_mix, *g_ffn, *w_in, *b_in, *qn_g, *kn_g, *conv_w, *conv_b, *lru_wa, *lru_ba, *lru_wx, *lru_bx, *lru_lam, *w_ao, *w_lo, *w_out, *pwq, *psk, *pu, *pv;
};
#define WSP(T, off) ((T*)(F.ws + (off)))
#define LDS_WAIT() asm volatile("s_waitcnt lgkmcnt(0)" ::: "memory")

__device__ __forceinline__ void transpose_item(const float* W, int ldw, int K, bf16* WT, LAS float* scr, int k0, int nsrc0, int ndst0, int lane) {
#pragma unroll 8
    for (int i = 0; i < 32; ++i) { const int kk = 2 * i + (lane >> 5); scr[kk * 33 + (lane & 31)] = W[(size_t)(k0 + kk) * ldw + nsrc0 + (lane & 31)]; }
    LDS_WAIT(); asm volatile("" ::: "memory");
    const int c = lane & 7;
#pragma unroll
    for (int j = 0; j < 4; ++j) { const int n = (lane >> 3) + 8 * j; const LAS float* s = scr + (8 * c) * 33 + n;
        v4u o; o.x = pk2(s[0 * 33], s[1 * 33]); o.y = pk2(s[2 * 33], s[3 * 33]); o.z = pk2(s[4 * 33], s[5 * 33]); o.w = pk2(s[6 * 33], s[7 * 33]);
        *(GAS v4u*)(WT + (size_t)(ndst0 + n) * K + k0 + 8 * c) = o; }
    LDS_WAIT(); asm volatile("" ::: "memory");
}
__device__ __forceinline__ void cvt_stream(const float* src, bf16* dst, size_t n8, size_t i0, size_t stride) {
    for (size_t i = i0; i < n8; i += stride) { const f32x4 a = ((const GAS f32x4*)src)[2 * i], b = ((const GAS f32x4*)src)[2 * i + 1];
        v4u o; o.x = pk2(a[0], a[1]); o.y = pk2(a[2], a[3]); o.z = pk2(b[0], b[1]); o.w = pk2(b[2], b[3]); ((GAS v4u*)dst)[i] = o; }
}
__device__ __forceinline__ void cvt_stream_fp8(const float* src, unsigned char* dst, size_t n16, float scale, size_t i0, size_t stride) {
    for (size_t i = i0; i < n16; i += stride) { v4u o;
#pragma unroll
        for (int q = 0; q < 4; ++q) { const f32x4 a = ((const GAS f32x4*)src)[4 * i + q] * scale; int w = 0;
            w = __builtin_amdgcn_cvt_pk_fp8_f32(a[0], a[1], w, false); w = __builtin_amdgcn_cvt_pk_fp8_f32(a[2], a[3], w, true); o[q] = (unsigned)w; }
        ((GAS v4u*)dst)[i] = o; }
}
__device__ __forceinline__ void p0_prologue(Frame& F) {
    { LAS float* sc = (LAS float*)F.lds; LAS f32x4* red = (LAS f32x4*)(F.lds + 16384); float* MOD = WSP(float, WS_MOD);
      for (int cgi = blockIdx.x; cgi < 256; cgi += F.G) {
          for (int i = F.tid; i < DM; i += NTHREADS) { const float cv = F.c[i]; sc[i] = cv / (1.0f + __expf(-cv)); }
          __syncthreads();
          if (F.tid < 384) { const int cg = F.tid % 24, rg = F.tid / 24;
              const GAS f32x4* Wp = (const GAS f32x4*)F.w_ada + cgi * 24 + cg;
              f32x4 acc = {0.f, 0.f, 0.f, 0.f};
#pragma unroll 8
              for (int r = rg; r < DM; r += 16) acc += sc[r] * Wp[(size_t)r * 6144];
              red[rg * 24 + cg] = acc; }
          __syncthreads();
          if (F.tid < 24) { f32x4 s = red[F.tid];
#pragma unroll
              for (int rg = 1; rg < 16; ++rg) s += red[rg * 24 + F.tid];
              s += ((const GAS f32x4*)F.b_ada)[cgi * 24 + F.tid]; ((GAS f32x4*)MOD)[cgi * 24 + F.tid] = s; }
          __syncthreads();
      } }
    LAS float* scr = (LAS float*)(F.lds + F.wave * 16384);
    const int gw = F.vcu * NWAVES + F.wave, NGW = F.G * NWAVES;
    constexpr int I_IN = 64 * 576, I_AO = 32 * 128, I_LO = 32 * 128, I_OUT = 64 * 128, I_PQ = 64 * 64, I_WA = 16 * 2 * 4, I_WX = I_WA;
    constexpr int NITEMS = I_IN + I_AO + I_LO + I_OUT + I_PQ + I_WA + I_WX;
    for (int it = gw; it < NITEMS; it += NGW) {
        int r = it;
        if (r < I_IN) { const int kb = r / 576, nb = r % 576; transpose_item(F.w_in, NIN, DM, WSP(bf16, WS_WIN), scr, 64 * kb, 32 * nb + (nb >= 192 ? 16 : 0), 32 * nb, F.lane); continue; } r -= I_IN;
        if (r < I_AO) { const int kb = r / 128, nb = r % 128; transpose_item(F.w_ao, DM, AW, WSP(bf16, WS_WAO), scr, 64 * kb, 32 * nb, 32 * nb, F.lane); continue; } r -= I_AO;
        if (r < I_LO) { const int kb = r / 128, nb = r % 128; transpose_item(F.w_lo, DM, LW, WSP(bf16, WS_WLO), scr, 64 * kb, 32 * nb, 32 * nb, F.lane); continue; } r -= I_LO;
        if (r < I_OUT) { const int kb = r / 128, nb = r % 128; transpose_item(F.w_out, DM, DM, WSP(bf16, WS_WOUT), scr, 64 * kb, 32 * nb, 32 * nb, F.lane); continue; } r -= I_OUT;
        if (r < I_PQ) { const int kb = r / 64, nb = r % 64; transpose_item(F.pwq, 2048, DM, WSP(bf16, WS_WPQ), scr, 64 * kb, 32 * nb, 32 * nb, F.lane); continue; } r -= I_PQ;
        { const bool isx = r >= I_WA; if (isx) r -= I_WA; const int g = r >> 3, kb = (r >> 2) & 1, nb = r & 3;
          transpose_item((isx ? F.lru_wx : F.lru_wa) + (size_t)g * GD * GD, GD, GD, WSP(bf16, isx ? WS_WXT : WS_WAT) + (size_t)g * GD * GD, scr, 64 * kb, 32 * nb, 32 * nb, F.lane); }
    }
    const size_t gt = (size_t)F.vcu * NTHREADS + F.tid, NGT = (size_t)F.G * NTHREADS;
    cvt_stream_fp8(F.pu, WSP(unsigned char, WS_U), (size_t)PEER_NE * DM / 16, 256.0f, gt, NGT);
    cvt_stream_fp8(F.pv, WSP(unsigned char, WS_V), (size_t)PEER_NE * DM / 16, 8.0f, gt, NGT);
    cvt_stream(F.psk, WSP(bf16, WS_SK), (size_t)PEER_H * 2 * 128 * 128 / 8, gt, NGT);
    for (size_t i = gt; i < (size_t)DM * 16; i += NGT) WSP(float, WS_WF)[i] = F.w_in[(i >> 4) * NIN + C_F + (i & 15)];
    for (size_t i = gt; i < (size_t)NINP; i += NGT) WSP(float, WS_BIASR)[i] = F.b_in[i + (i >= (size_t)C_F ? 16 : 0)];
}

__device__ __forceinline__ void p1_norm_forget(Frame& F) {
    const int gw = F.vcu * NWAVES + F.wave, NGW = F.G * NWAVES; const float* MOD = WSP(float, WS_MOD); const float* WF = WSP(float, WS_WF); bf16* HA = WSP(bf16, WS_HA);
    for (int rg = gw; rg < S / 4; rg += NGW) {
        const int r0 = rg * 4; float rstd[4];
#pragma unroll
        for (int r = 0; r < 4; ++r) { const GAS f32x4* xr = (const GAS f32x4*)(F.x + (size_t)(r0 + r) * DM) + F.lane; float ss = 0.f;
#pragma unroll
            for (int j = 0; j < 16; ++j) { const f32x4 v = xr[64 * j]; ss += (v[0] * v[0] + v[1] * v[1]) + (v[2] * v[2] + v[3] * v[3]); }
            rstd[r] = 1.0f / sqrtf(wave_sum(ss) * (1.0f / DM) + EPS); }
        float acc[4][16];
#pragma unroll
        for (int r = 0; r < 4; ++r)
#pragma unroll
            for (int cc = 0; cc < 16; ++cc) acc[r][cc] = 0.f;
        for (int j = 0; j < 16; ++j) {
            const int i4 = F.lane + 64 * j;
            const f32x4 g = ((const GAS f32x4*)F.g_mix)[i4], scl = ((const GAS f32x4*)(MOD + 4096))[i4], sh = ((const GAS f32x4*)MOD)[i4];
            const f32x4 mul = g * (scl + 1.0f);
            f32x4 wf[4][4];
#pragma unroll
            for (int i = 0; i < 4; ++i)
#pragma unroll
                for (int q = 0; q < 4; ++q) wf[i][q] = ((const GAS f32x4*)(WF + (size_t)(4 * i4 + i) * 16))[q];
#pragma unroll
            for (int r = 0; r < 4; ++r) {
                const f32x4 xv = ((const GAS f32x4*)(F.x + (size_t)(r0 + r) * DM))[i4];
                const f32x4 hv = xv * rstd[r] * mul + sh;
                v2u o; o.x = pk2(hv[0], hv[1]); o.y = pk2(hv[2], hv[3]);
                ((GAS v2u*)(HA + (size_t)(r0 + r) * DM))[i4] = o;
#pragma unroll
                for (int i = 0; i < 4; ++i)
#pragma unroll
                    for (int q = 0; q < 4; ++q)
#pragma unroll
                        for (int e = 0; e < 4; ++e) acc[r][4 * q + e] += hv[i] * wf[i][q][e];
            }
        }
#pragma unroll
        for (int r = 0; r < 4; ++r)
#pragma unroll
            for (int cc = 0; cc < 16; ++cc) { const float tot = wave_sum(acc[r][cc]);
                if (F.lane == cc) { const float f = tot + F.b_in[C_F + cc]; WSP(float, WS_LOGF)[(size_t)(r0 + r) * 16 + cc] = fminf(f, 0.f) - log1pf(__expf(-fabsf(f))); } }
    }
}

__device__ __forceinline__ void p3_qknorm(Frame& F) {
    const int gw = F.vcu * NWAVES + F.wave, NGW = F.G * NWAVES; bf16* QK = WSP(bf16, WS_QKV);
    const int sub = F.lane & 15;
    f32x4 gq0 = ((const GAS f32x4*)F.qn_g)[2 * sub], gq1 = ((const GAS f32x4*)F.qn_g)[2 * sub + 1], gk0 = ((const GAS f32x4*)F.kn_g)[2 * sub], gk1 = ((const GAS f32x4*)F.kn_g)[2 * sub + 1];
    for (int it = gw; it < 2 * S * NH / 4; it += NGW) {
        const size_t unit = (size_t)it * 4 + (F.lane >> 4); const bool isk = unit >= (size_t)S * NH;
        GAS v4u* p = (GAS v4u*)(QK + unit * 128) + sub; const v4u w = *p;
        f32x4 a = {bflo(w.x), bfhi(w.x), bflo(w.y), bfhi(w.y)}, b = {bflo(w.z), bfhi(w.z), bflo(w.w), bfhi(w.w)};
        float ss = (a[0] * a[0] + a[1] * a[1]) + (a[2] * a[2] + a[3] * a[3]) + (b[0] * b[0] + b[1] * b[1]) + (b[2] * b[2] + b[3] * b[3]);
        ss += __shfl_xor(ss, 1); ss += __shfl_xor(ss, 2); ss += __shfl_xor(ss, 4); ss += __shfl_xor(ss, 8);
        const float rs = 1.0f / sqrtf(ss * (1.0f / HD) + EPS);
        a = a * rs * (isk ? gk0 : gq0); b = b * rs * (isk ? gk1 : gq1);
        v4u o; o.x = pk2(a[0], a[1]); o.y = pk2(a[2], a[3]); o.z = pk2(b[0], b[1]); o.w = pk2(b[2], b[3]); *p = o;
    }
}
__device__ __forceinline__ void p3_cumsum(Frame& F) {
    LAS float* wt = (LAS float*)F.lds;
    for (int h = blockIdx.x; h < NH; h += F.G) {
        const float* LF = WSP(float, WS_LOGF); float v[16]; float run = 0.f;
#pragma unroll
        for (int i = 0; i < 16; ++i) { run += LF[(size_t)(F.tid * 16 + i) * 16 + h]; v[i] = run; }
        float sc = run;
#pragma unroll
        for (int o = 1; o < 64; o <<= 1) { const float t = __shfl_up(sc, o); if (F.lane >= o) sc += t; }
        if (F.lane == 63) wt[F.wave] = sc;
        __syncthreads();
        float pre = sc - run;
        for (int w = 0; w < F.wave; ++w) pre += wt[w];
        float* Fo = WSP(float, WS_FC) + (size_t)h * S + F.tid * 16;
#pragma unroll
        for (int i = 0; i < 4; ++i) ((GAS f32x4*)Fo)[i] = (f32x4){v[4 * i] + pre, v[4 * i + 1] + pre, v[4 * i + 2] + pre, v[4 * i + 3] + pre};
        __syncthreads();
    }
}
constexpr int LRU_XCF = 0, LRU_XCB = 32768, LRU_AB = 49152, LRU_BB = 81920, LRU_QA = 114688, LRU_CAR = 118784;
template <int PASS> __device__ __forceinline__ void lru_unit(Frame& F, int c, int g) {
    LAS float* XCF = (LAS float*)(F.lds + LRU_XCF); LAS unsigned char* XCB = F.lds + LRU_XCB; LAS float* AB = (LAS float*)(F.lds + LRU_AB); LAS float* BB = (LAS float*)(F.lds + LRU_BB);
    LAS float* QA = (LAS float*)(F.lds + LRU_QA); LAS float* CAR = (LAS float*)(F.lds + LRU_CAR);
    const int t0 = 64 * c, ch0 = GD * g; const bf16* LX = WSP(bf16, WS_LX);
    { const int ch = F.tid & 127, tq = F.tid >> 7, gch = ch0 + ch;
      const float w0 = F.conv_w[gch], w1 = F.conv_w[LW + gch], w2 = F.conv_w[2 * LW + gch], w3 = F.conv_w[3 * LW + gch], cb = F.conv_b[gch];
      float xm3, xm2, xm1; { const int tb = t0 + 16 * tq;
          xm3 = tb - 3 >= 0 ? bf2f(LX[(size_t)(tb - 3) * LW + gch]) : 0.f; xm2 = tb - 2 >= 0 ? bf2f(LX[(size_t)(tb - 2) * LW + gch]) : 0.f; xm1 = tb - 1 >= 0 ? bf2f(LX[(size_t)(tb - 1) * LW + gch]) : 0.f; }
#pragma unroll
      for (int i = 0; i < 16; ++i) { const int t = 16 * tq + i; const float x0 = bf2f(LX[(size_t)(t0 + t) * LW + gch]);
          const float xc = w0 * xm3 + w1 * xm2 + w2 * xm1 + w3 * x0 + cb; xm3 = xm2; xm2 = xm1; xm1 = x0;
          XCF[t * 128 + ch] = xc; *(LAS bf16*)(XCB + t * 256 + ((ch * 2) ^ ((t & 7) << 4))) = (bf16)f2bf(xc); } }
    __syncthreads();
    { const int fr = F.lane & 15, fq = F.lane >> 4, j = 16 * F.wave + fr;
      const bf16* WA = WSP(bf16, WS_WAT) + (size_t)g * GD * GD + (size_t)j * GD + 8 * fq; const bf16* WX = WSP(bf16, WS_WXT) + (size_t)g * GD * GD + (size_t)j * GD + 8 * fq;
      bf16x8 ba[4], bx[4];
#pragma unroll
      for (int ks = 0; ks < 4; ++ks) { ba[ks] = *(const GAS bf16x8*)(WA + 32 * ks); bx[ks] = *(const GAS bf16x8*)(WX + 32 * ks); }
      const int gch = ch0 + j; const float bav = F.lru_ba[gch], bxv = F.lru_bx[gch], lam = F.lru_lam[gch];
      const float sp = (lam > 0.f ? 0.f : -lam) + log1pf(__expf(-fabsf(lam)));
#pragma unroll
      for (int mt = 0; mt < 4; ++mt) { f32x4 ar = {0.f, 0.f, 0.f, 0.f}, ax = {0.f, 0.f, 0.f, 0.f}; const int t = 16 * mt + fr;
#pragma unroll
          for (int ks = 0; ks < 4; ++ks) { const bf16x8 af = *(const LAS bf16x8*)(XCB + t * 256 + (((32 * ks + 8 * fq) * 2) ^ ((t & 7) << 4)));
              ar = __builtin_amdgcn_mfma_f32_16x16x32_bf16(af, ba[ks], ar, 0, 0, 0); ax = __builtin_amdgcn_mfma_f32_16x16x32_bf16(af, bx[ks], ax, 0, 0, 0); }
#pragma unroll
          for (int rg = 0; rg < 4; ++rg) { const int tt = 16 * mt + 4 * fq + rg; const float xcv = XCF[tt * 128 + j];
              const float rgt = sigmoidf_(ar[rg] + bav), igt = sigmoidf_(ax[rg] + bxv);
              const float log_a = -8.0f * rgt * sp; const float a = __expf(log_a); const float b = sqrtf(-expm1f(2.0f * log_a)) * (igt * xcv);
              AB[tt * 128 + j] = a; BB[tt * 128 + j] = b; } } }
    __syncthreads();
    const int ch = F.tid & 127, q = F.tid >> 7;
    { float A = 1.f, B = 0.f;
#pragma unroll
      for (int i = 0; i < 16; ++i) { const int t = 16 * q + i; const float a = AB[t * 128 + ch]; B = a * B + BB[t * 128 + ch]; A *= a; }
      QA[(q * 128 + ch) * 2] = A; QA[(q * 128 + ch) * 2 + 1] = B; }
    if (PASS == 1 && F.tid < 128) {
        const float* GA_ = WSP(float, WS_AGGA) + ch0 + F.tid; const float* GB_ = WSP(float, WS_AGGB) + ch0 + F.tid; float hcar = 0.f;
        for (int cc = 0; cc < c; ++cc) hcar = GA_[(size_t)cc * LW] * hcar + GB_[(size_t)cc * LW];
        CAR[F.tid] = hcar; }
    __syncthreads();
    if (PASS == 0) {
        if (F.tid < 128) { float A = 1.f, B = 0.f;
#pragma unroll
            for (int qq = 0; qq < 4; ++qq) { const float a = QA[(qq * 128 + F.tid) * 2], b = QA[(qq * 128 + F.tid) * 2 + 1]; B = a * B + b; A *= a; }
            WSP(float, WS_AGGA)[(size_t)c * LW + ch0 + F.tid] = A; WSP(float, WS_AGGB)[(size_t)c * LW + ch0 + F.tid] = B; }
    } else {
        float h = CAR[ch];
        for (int qq = 0; qq < q; ++qq) h = QA[(qq * 128 + ch) * 2] * h + QA[(qq * 128 + ch) * 2 + 1];
        const bf16* GY = WSP(bf16, WS_GY); bf16* LR = WSP(bf16, WS_LR);
#pragma unroll
        for (int i = 0; i < 16; ++i) { const int t = 16 * q + i; h = AB[t * 128 + ch] * h + BB[t * 128 + ch];
            const size_t o = (size_t)(t0 + t) * LW + ch0 + ch; LR[o] = (bf16)f2bf(h * bf2f(GY[o])); }
    }
    __syncthreads();
}
constexpr int ATT_BIAS_OFF = attn_body::LDS_BYTES;
typedef attn_body::BlockRef<bf16, bf16> ARef;
__device__ __forceinline__ int attn_jlo(const float* Fh, int qb, float TH, int lane) {
    const int t0 = qb * 256; const float f0 = Fh[t0];
    const int j0 = lane, j1 = lane + 64;
    const bool ok0 = (64 * j0 + 63 >= t0) || (f0 - Fh[64 * j0 + 63] >= -TH), ok1 = (64 * j1 + 63 >= t0) || (f0 - Fh[64 * j1 + 63] >= -TH);
    const unsigned long long m0 = __ballot(ok0), m1 = __ballot(ok1);
    return m0 ? (int)__builtin_ctzll(m0) : 64 + (int)__builtin_ctzll(m1);
}
__device__ __forceinline__ ARef attn_ref(Frame& F, int h, int qb, int jlo) {
    ARef r; const bf16* QK = WSP(bf16, WS_QKV);
    r.Q = QK + (size_t)(qb * 256) * AW + h * HD; r.K = QK + (size_t)S * AW + h * HD; r.V = QK + 2 * (size_t)S * AW + h * HD;
    r.O = WSP(bf16, WS_ATT) + (size_t)(qb * 256) * AW + h * HD; r.P0 = qb * 256; r.jlo = jlo; return r;
}
__device__ __forceinline__ void attn_fill_bias(Frame& F, int h, int qb, int jlo) {
    const float* Fh = WSP(float, WS_FC) + (size_t)h * S; LAS float* bl = (LAS float*)(F.lds + ATT_BIAS_OFF);
    const int k0 = jlo * 64, n = (qb + 1) * 256 - k0; const float fr = Fh[k0];
#pragma unroll 1
    for (int i = F.tid; i < n; i += NTHREADS) bl[i] = (fr - Fh[k0 + i]) * (1.0f / attn_body::SCALE);
}
#ifndef ATT_WINDOW
#define ATT_WINDOW 1
#endif
__device__ __forceinline__ void p4_attention(Frame& F, char* lds_generic) {
    float gq = fmaxf(fabsf(F.qn_g[F.lane]), fabsf(F.qn_g[F.lane + 64])), gk = fmaxf(fabsf(F.kn_g[F.lane]), fabsf(F.kn_g[F.lane + 64]));
    gq = wave_max(gq); gk = wave_max(gk);
    const float TH = 2.0f * (128.0f * gq * gk * attn_body::SCALE) + 40.0f;
    for (int L = blockIdx.x; L < NH * 16; L += F.G) {
        const int h = L >> 4, x = L & 15, qb0 = x, qb1 = 31 - x; const float* Fh = WSP(float, WS_FC) + (size_t)h * S;
        const int jl0 = ATT_WINDOW ? attn_jlo(Fh, qb0, TH, F.lane) : 0, jl1 = ATT_WINDOW ? attn_jlo(Fh, qb1, TH, F.lane) : 0;
        const ARef r0 = attn_ref(F, h, qb0, jl0), r1 = attn_ref(F, h, qb1, jl1);
        attn_fill_bias(F, h, qb0, jl0); __syncthreads();
        attn_body::attn_unit<bf16, bf16>(r0, S, lds_generic);
        attn_fill_bias(F, h, qb1, jl1); __syncthreads();
        attn_body::attn_unit<bf16, bf16>(r1, S, lds_generic);
        asm volatile("s_waitcnt vmcnt(0)" ::: "memory"); __syncthreads();
    }
}

__device__ __forceinline__ void p7_norm2(Frame& F) {
    const int gw = F.vcu * NWAVES + F.wave, NGW = F.G * NWAVES; const float* MOD = WSP(float, WS_MOD); bf16* HA = WSP(bf16, WS_HA);
    for (int m = gw; m < S; m += NGW) {
        const GAS f32x4* xr = (const GAS f32x4*)(WSP(float, WS_X1) + (size_t)m * DM) + F.lane; f32x4 v[16]; float ss = 0.f;
#pragma unroll
        for (int j = 0; j < 16; ++j) { v[j] = xr[64 * j]; ss += (v[j][0] * v[j][0] + v[j][1] * v[j][1]) + (v[j][2] * v[j][2] + v[j][3] * v[j][3]); }
        const float rstd = 1.0f / sqrtf(wave_sum(ss) * (1.0f / DM) + EPS);
#pragma unroll
        for (int j = 0; j < 16; ++j) { const int i4 = F.lane + 64 * j;
            const f32x4 g = ((const GAS f32x4*)F.g_ffn)[i4], scl = ((const GAS f32x4*)(MOD + 16384))[i4], sh = ((const GAS f32x4*)(MOD + 12288))[i4];
            const f32x4 hv = v[j] * rstd * (g * (scl + 1.0f)) + sh;
            v2u o; o.x = pk2(hv[0], hv[1]); o.y = pk2(hv[2], hv[3]); ((GAS v2u*)(HA + (size_t)m * DM))[i4] = o; }
    }
}

constexpr float NEG_BIG = -3.0e38f;
__device__ __forceinline__ void p9_topk(Frame& F) {
    LAS float* SC = (LAS float*)F.lds;
    const bf16* Q2 = WSP(bf16, WS_Q2); const bf16* SK = WSP(bf16, WS_SK); int* IDX = WSP(int, WS_IDX); float* GATE = WSP(float, WS_GATE);
    const int fr = F.lane & 15, fq = F.lane >> 4;
    for (int u = blockIdx.x; u < (S / 64) * PEER_H; u += F.G) {
        const int tb = u >> 3, h = u & 7, t0 = 64 * tb;
        { const int p = F.wave >> 2, nb = F.wave & 3;
          bf16x8 b[2][4];
#pragma unroll
          for (int nt = 0; nt < 2; ++nt)
#pragma unroll
              for (int ks = 0; ks < 4; ++ks) b[nt][ks] = *(const GAS bf16x8*)(SK + ((size_t)((h * 2 + p) * 128 + 32 * nb + 16 * nt + fr)) * 128 + 32 * ks + 8 * fq);
#pragma unroll
          for (int mt = 0; mt < 4; ++mt) { f32x4 a0 = {0.f, 0.f, 0.f, 0.f}, a1 = {0.f, 0.f, 0.f, 0.f};
#pragma unroll
              for (int ks = 0; ks < 4; ++ks) { const bf16x8 af = *(const GAS bf16x8*)(Q2 + (size_t)(t0 + 16 * mt + fr) * 2048 + h * 256 + p * 128 + 32 * ks + 8 * fq);
                  a0 = __builtin_amdgcn_mfma_f32_16x16x32_bf16(af, b[0][ks], a0, 0, 0, 0); a1 = __builtin_amdgcn_mfma_f32_16x16x32_bf16(af, b[1][ks], a1, 0, 0, 0); }
#pragma unroll
              for (int rg = 0; rg < 4; ++rg) { const int tt = 16 * mt + 4 * fq + rg; SC[tt * 256 + p * 128 + 32 * nb + fr] = a0[rg]; SC[tt * 256 + p * 128 + 32 * nb + 16 + fr] = a1[rg]; } } }
        __syncthreads();
        for (int i = 0; i < 8; ++i) { const int tl = 8 * F.wave + i;
            float tv[2]; int ti[2];
#pragma unroll
            for (int p = 0; p < 2; ++p) { float v0 = SC[tl * 256 + p * 128 + F.lane], v1 = SC[tl * 256 + p * 128 + 64 + F.lane]; float rv = NEG_BIG; int ri = 0;
                for (int r = 0; r < 16; ++r) { const float m = fmaxf(v0, v1); const int mi = (v0 >= v1) ? F.lane : F.lane + 64; const float wm = wave_max(m);
                    const unsigned long long bal = __ballot(m == wm); const int src = (int)__builtin_ctzll(bal); const int ci = __shfl(mi, src);
                    if (F.lane == src) { if (mi == F.lane) v0 = NEG_BIG; else v1 = NEG_BIG; }
                    if (F.lane == r) { rv = wm; ri = ci; } }
                tv[p] = rv; ti[p] = ri; }
            const int ci_ = F.lane >> 2, jb = 4 * (F.lane & 3);
            const float s0 = __shfl(tv[0], ci_); const int i0 = __shfl(ti[0], ci_);
            float c0 = s0 + __shfl(tv[1], jb), c1 = s0 + __shfl(tv[1], jb + 1), c2 = s0 + __shfl(tv[1], jb + 2), c3 = s0 + __shfl(tv[1], jb + 3);
            const int e0 = i0 * 128 + __shfl(ti[1], jb), e1 = i0 * 128 + __shfl(ti[1], jb + 1), e2 = i0 * 128 + __shfl(ti[1], jb + 2), e3 = i0 * 128 + __shfl(ti[1], jb + 3);
            float gv = NEG_BIG; int ge = 0;
            for (int r = 0; r < 16; ++r) { const float m = fmaxf(fmaxf(c0, c1), fmaxf(c2, c3)); const int jj = (c0 == m) ? 0 : (c1 == m) ? 1 : (c2 == m) ? 2 : 3;
                const int me = jj == 0 ? e0 : jj == 1 ? e1 : jj == 2 ? e2 : e3; const float wm = wave_max(m);
                const unsigned long long bal = __ballot(m == wm); const int src = (int)__builtin_ctzll(bal); const int ce = __shfl(me, src);
                if (F.lane == src) { c0 = jj == 0 ? NEG_BIG : c0; c1 = jj == 1 ? NEG_BIG : c1; c2 = jj == 2 ? NEG_BIG : c2; c3 = jj == 3 ? NEG_BIG : c3; }
                if (F.lane == r) { gv = wm; ge = ce; } }
            const float mx = __shfl(gv, 0); const float ex = F.lane < 16 ? __expf(gv - mx) : 0.f; const float sm = wave_sum(ex);
            if (F.lane < 16) { const size_t o = (size_t)(t0 + tl) * 128 + h * 16 + F.lane; IDX[o] = ge; GATE[o] = ex / sm; }
        }
        __syncthreads();
    }
}

constexpr float U_SCALE = 256.0f, V_SCALE = 8.0f;
__device__ __forceinline__ float gelu_as(float v) {
    const float av = fabsf(v), tt = __builtin_amdgcn_rcpf(av * 0.2316418882f + 1.0f);
    float q = tt * 0.5307027145f + (-0.7265760135f); q = q * tt + 0.7107068705f; q = q * tt + (-0.142248368f); q = q * tt + 0.127414796f; q = q * tt;
    const float m = v * (q * __builtin_amdgcn_exp2f((v * v) * (-0.72134752044f)));
    return v < 0.f ? m : v - m;
}
#define DOT4(w, h4) do { const f32x2 lo_ = __builtin_amdgcn_cvt_pk_f32_fp8((int)(w), false), hi_ = __builtin_amdgcn_cvt_pk_f32_fp8((int)(w), true); \
        sacc += (lo_.x * (h4)[0] + lo_.y * (h4)[1]) + (hi_.x * (h4)[2] + hi_.y * (h4)[3]); } while (0)
#define AXPY4(w, sc_, a4) do { const f32x2 lo_ = __builtin_amdgcn_cvt_pk_f32_fp8((int)(w), false), hi_ = __builtin_amdgcn_cvt_pk_f32_fp8((int)(w), true); \
        (a4)[0] += (sc_) * lo_.x; (a4)[1] += (sc_) * lo_.y; (a4)[2] += (sc_) * hi_.x; (a4)[3] += (sc_) * hi_.y; } while (0)
__device__ __forceinline__ void p10_peer(Frame& F) {
    const int gw = F.vcu * NWAVES + F.wave, NGW = F.G * NWAVES; const float* MOD = WSP(float, WS_MOD);
    const bf16* H2 = WSP(bf16, WS_HA); const unsigned char* U = WSP(unsigned char, WS_U); const unsigned char* V = WSP(unsigned char, WS_V); const int* IDX = WSP(int, WS_IDX); const float* GATE = WSP(float, WS_GATE);
#pragma unroll 1
    for (int t = gw; t < S; t += NGW) {
        const int id0 = IDX[(size_t)t * 128 + F.lane], id1 = IDX[(size_t)t * 128 + 64 + F.lane];
        const float g0 = GATE[(size_t)t * 128 + F.lane], g1 = GATE[(size_t)t * 128 + 64 + F.lane];
        float w0 = 0.f, w1 = 0.f;
        {   f32x4 hx[16];
#pragma unroll
            for (int c = 0; c < 4; ++c) { const GAS v4u* hp = (const GAS v4u*)(H2 + (size_t)t * DM + c * 1024 + F.lane * 16); const v4u a = hp[0], b = hp[1];
                hx[4 * c + 0] = (f32x4){bflo(a[0]), bfhi(a[0]), bflo(a[1]), bfhi(a[1])}; hx[4 * c + 1] = (f32x4){bflo(a[2]), bfhi(a[2]), bflo(a[3]), bfhi(a[3])};
                hx[4 * c + 2] = (f32x4){bflo(b[0]), bfhi(b[0]), bflo(b[1]), bfhi(b[1])}; hx[4 * c + 3] = (f32x4){bflo(b[2]), bfhi(b[2]), bflo(b[3]), bfhi(b[3])}; }
#pragma unroll 1
            for (int e = 0; e < 128; e += 2) {
                const int ea = __builtin_amdgcn_readlane(e < 64 ? id0 : id1, e & 63), eb = __builtin_amdgcn_readlane(e < 64 ? id0 : id1, (e + 1) & 63);
                const GAS v4u* ua = (const GAS v4u*)(U + (size_t)ea * DM) + F.lane; const GAS v4u* ub = (const GAS v4u*)(U + (size_t)eb * DM) + F.lane;
                v4u ra[4], rb[4];
#pragma unroll
                for (int c = 0; c < 4; ++c) { ra[c] = ua[64 * c]; rb[c] = ub[64 * c]; }
                float sa, sb;
                { float sacc = 0.f;
#pragma unroll
                  for (int c = 0; c < 4; ++c)
#pragma unroll
                      for (int k = 0; k < 4; ++k) DOT4(ra[c][k], hx[4 * c + k]);
                  sa = sacc; }
                { float sacc = 0.f;
#pragma unroll
                  for (int c = 0; c < 4; ++c)
#pragma unroll
                      for (int k = 0; k < 4; ++k) DOT4(rb[c][k], hx[4 * c + k]);
                  sb = sacc; }
                sa = wave_sum(sa); sb = wave_sum(sb);
                const float aa = gelu_as(sa * (1.0f / U_SCALE)) * (1.0f / V_SCALE), ab = gelu_as(sb * (1.0f / U_SCALE)) * (1.0f / V_SCALE);
                if (e < 64) { if (F.lane == e) w0 = aa * g0; if (F.lane == e + 1) w0 = ab * g0; } else { if (F.lane == e - 64) w1 = aa * g1; if (F.lane == e - 63) w1 = ab * g1; }
            } }
        f32x4 acc[16];
#pragma unroll
        for (int i = 0; i < 16; ++i) acc[i] = (f32x4){0.f, 0.f, 0.f, 0.f};
#pragma unroll 1
        for (int e = 0; e < 128; e += 2) {
            const int ea = __builtin_amdgcn_readlane(e < 64 ? id0 : id1, e & 63), eb = __builtin_amdgcn_readlane(e < 64 ? id0 : id1, (e + 1) & 63);
            const float wa = __uint_as_float(__builtin_amdgcn_readlane(__float_as_uint(e < 64 ? w0 : w1), e & 63)), wb = __uint_as_float(__builtin_amdgcn_readlane(__float_as_uint(e < 64 ? w0 : w1), (e + 1) & 63));
            const GAS v4u* va = (const GAS v4u*)(V + (size_t)ea * DM) + F.lane; const GAS v4u* vb = (const GAS v4u*)(V + (size_t)eb * DM) + F.lane;
            v4u ra[4], rb[4];
#pragma unroll
            for (int c = 0; c < 4; ++c) { ra[c] = va[64 * c]; rb[c] = vb[64 * c]; }
#pragma unroll
            for (int c = 0; c < 4; ++c)
#pragma unroll
                for (int k = 0; k < 4; ++k) { AXPY4(ra[c][k], wa, acc[4 * c + k]); AXPY4(rb[c][k], wb, acc[4 * c + k]); }
        }
#pragma unroll
        for (int c = 0; c < 4; ++c) { const int col = c * 1024 + F.lane * 16; GAS f32x4* op = (GAS f32x4*)(F.out + (size_t)t * DM + col);
            const GAS f32x4* xp = (const GAS f32x4*)(WSP(float, WS_X1) + (size_t)t * DM + col); const GAS f32x4* gp = (const GAS f32x4*)(MOD + 20480 + col);
#pragma unroll
            for (int q = 0; q < 4; ++q) op[q] = xp[q] + gp[q] * acc[4 * c + q]; }
    }
}
#undef DOT4
#undef AXPY4
#ifndef MK_SINGLE
#define MK_SINGLE 1
#endif
constexpr int N_PHASES = 11;
struct Args { const float* in[24]; float* out; unsigned char* ws; int ph_lo, ph_hi; };
__global__ void __launch_bounds__(NTHREADS, 2) fwd_kernel(Args args) {
    extern __shared__ __attribute__((aligned(16))) unsigned char lds[];
    Frame F;
    F.lds = (LAS unsigned char*)lds; F.MISC = (volatile LAS unsigned*)(F.lds + MISC_OFF);
    F.tid = threadIdx.x; F.lane = F.tid & 63; F.wave = __builtin_amdgcn_readfirstlane(F.tid >> 6);
    F.G = gridDim.x; { const int bx = blockIdx.x; F.vcu = (F.G % 8 == 0) ? (bx % 8) * (F.G / 8) + bx / 8 : bx; }
    F.ws = args.ws; F.out = args.out; F.ctl = (gu32*)(args.ws + WS_CTL);
    F.x = args.in[0]; F.c = args.in[1]; F.w_ada = args.in[2]; F.b_ada = args.in[3]; F.g_mix = args.in[4]; F.g_ffn = args.in[5]; F.w_in = args.in[6]; F.b_in = args.in[7];
    F.qn_g = args.in[8]; F.kn_g = args.in[9]; F.conv_w = args.in[10]; F.conv_b = args.in[11]; F.lru_wa = args.in[12]; F.lru_ba = args.in[13]; F.lru_wx = args.in[14]; F.lru_bx = args.in[15];
    F.lru_lam = args.in[16]; F.w_ao = args.in[17]; F.w_lo = args.in[18]; F.w_out = args.in[19]; F.pwq = args.in[20]; F.psk = args.in[21]; F.pu = args.in[22]; F.pv = args.in[23];
    for (int u = F.tid; u < (LDS_BYTES - LDSCTL_OFF) / 4; u += NTHREADS) ((LAS unsigned*)(F.lds + LDSCTL_OFF))[u] = 0u;
    __syncthreads();
    const int lo = args.ph_lo, hi = args.ph_hi;
    XcdBarrier bar; bar.bar = (unsigned*)(F.ctl + CW_BAR); bar.x = 0; bar.st = nullptr;
    if (hi - lo > 1) bar = xcd_barrier_post((unsigned*)(F.ctl + CW_BAR), F.MISC + 8);
#ifndef PH_MASK
#define PH_MASK 0x7ff
#endif
#define IN(k) (((PH_MASK >> (k)) & 1) && lo <= (k) && (k) < hi)
#define SEAM(k) do { if (IN(k) && IN((k) + 1)) xcd_barrier(bar); } while (0)
#ifndef REP_PHASE
#define REP_PHASE -1
#endif
#define REPEAT(k) _Pragma("unroll") for (int rep = 0; rep < ((REP_PHASE) == (k) ? 2 : 1); ++rep)
#define REPBAR(k) do { if ((REP_PHASE) == (k) && rep == 0) xcd_barrier(bar); } while (0)
    const int bid = (int)blockIdx.x;
    if (IN(0)) { REPEAT(0) { p0_prologue(F); REPBAR(0); } SEAM(0); }
    if (IN(1)) { REPEAT(1) { p1_norm_forget(F); REPBAR(1); } SEAM(1); }
    if (IN(2)) { REPEAT(2) {
        pg8::Gemm g{WSP(bf16, WS_HA), WSP(bf16, WS_WIN), S, NINP, DM}; pg8::StaticOrder So; So.init(S, NINP, F.G, bid);
        pg8::EpiIn E{WSP(bf16, WS_QKV), WSP(bf16, WS_LX), WSP(bf16, WS_GY), WSP(bf16, WS_GA), WSP(bf16, WS_GL), WSP(float, WS_BIASR)};
        pg8::gemm_phase<pg8::EpiIn, pg8::StaticOrder, true, true>(F.lds, g, So, E);
        REPBAR(2); }
        SEAM(2);
    }
    if (IN(3)) {
        p3_qknorm(F);
        __syncthreads();
        REPEAT(3) {
        p3_cumsum(F);
        for (int u = bid; u < (S / 64) * NG; u += F.G) lru_unit<0>(F, u >> 4, u & 15);
        REPBAR(3); }
        SEAM(3);
    }
    if (IN(4)) { REPEAT(4) {
        p4_attention(F, (char*)lds);
        for (int u = bid; u < (S / 64) * NG; u += F.G) lru_unit<1>(F, u >> 4, u & 15);
        REPBAR(4); }
        SEAM(4);
    }
    if (IN(5)) { REPEAT(5) {
        { pg8::Gemm g{WSP(bf16, WS_ATT), WSP(bf16, WS_WAO), S, DM, AW}; pg8::StaticOrder So; So.init(S, DM, F.G, bid);
          pg8::EpiGate<0> E{WSP(bf16, WS_T1), WSP(bf16, WS_GA), DM};
          pg8::gemm_phase<pg8::EpiGate<0>, pg8::StaticOrder, true, true>(F.lds, g, So, E); }
        { pg8::Gemm g{WSP(bf16, WS_LR), WSP(bf16, WS_WLO), S, DM, LW}; pg8::StaticOrder So; So.init(S, DM, F.G, bid);
          pg8::EpiGate<1> E{WSP(bf16, WS_T1), WSP(bf16, WS_GL), DM};
          pg8::gemm_phase<pg8::EpiGate<1>, pg8::StaticOrder, true, true>(F.lds, g, So, E); }
        REPBAR(5); }
        SEAM(5);
    }
    if (IN(6)) { REPEAT(6) {
        pg8::Gemm g{WSP(bf16, WS_T1), WSP(bf16, WS_WOUT), S, DM, DM}; pg8::StaticOrder So; So.init(S, DM, F.G, bid);
        pg8::EpiRes E{F.x, WSP(float, WS_X1), WSP(float, WS_MOD) + 8192, DM};
        pg8::gemm_phase<pg8::EpiRes, pg8::StaticOrder, true, true>(F.lds, g, So, E);
        REPBAR(6); }
        SEAM(6);
    }
    if (IN(7)) { REPEAT(7) { p7_norm2(F); REPBAR(7); } SEAM(7); }
    if (IN(8)) { REPEAT(8) {
        pg8::Gemm g{WSP(bf16, WS_HA), WSP(bf16, WS_WPQ), S, 2048, DM}; pg8::StaticOrder So; So.init(S, 2048, F.G, bid);
        pg8::EpiBf16<0> E{WSP(bf16, WS_Q2), 2048, nullptr, 0, 0, 1.f};
        pg8::gemm_phase<pg8::EpiBf16<0>, pg8::StaticOrder, true, true>(F.lds, g, So, E);
        REPBAR(8); }
        SEAM(8);
    }
    if (IN(9)) { REPEAT(9) { p9_topk(F); REPBAR(9); } SEAM(9); }
    if (IN(10)) { REPEAT(10) { p10_peer(F); REPBAR(10); } }
#undef IN
#undef SEAM
}

extern "C" void kernel_launch(void* const* d_in, const int* in_sizes, int n_in, void* d_out, int out_size, void* d_ws, size_t ws_size, hipStream_t stream) {
    static int grid = 0;
    if (grid == 0) {
        if (n_in != 24 || in_sizes[0] != S * DM || out_size != S * DM || ws_size < WS_END) { fprintf(stderr, "kernel_launch: unexpected shapes (n_in %d, in0 %d, out %d, ws %zu)\n", n_in, n_in > 0 ? in_sizes[0] : -1, out_size, ws_size); grid = -1; return; }
        int dev = 0, cus = 0, per_cu = 0;
        if (hipGetDevice(&dev) != hipSuccess || hipDeviceGetAttribute(&cus, hipDeviceAttributeMultiprocessorCount, dev) != hipSuccess) { grid = -1; return; }
        if (hipFuncSetAttribute((const void*)fwd_kernel, hipFuncAttributeMaxDynamicSharedMemorySize, LDS_BYTES) != hipSuccess) { fprintf(stderr, "kernel_launch: hipFuncSetAttribute failed\n"); grid = -1; return; }
        if (hipOccupancyMaxActiveBlocksPerMultiprocessor(&per_cu, (const void*)fwd_kernel, NTHREADS, LDS_BYTES) != hipSuccess || per_cu < 1) fprintf(stderr, "kernel_launch: occupancy query reports %d blocks per CU\n", per_cu);
        (void)hipGetLastError();
        grid = cus;
    }
    if (grid < 0) return;
    if (hipMemsetAsync((char*)d_ws + WS_CTL, 0, CTL_ZERO_BYTES, stream) != hipSuccess) return;
    Args a{};
    for (int i = 0; i < 24; ++i) a.in[i] = (const float*)d_in[i];
    a.out = (float*)d_out; a.ws = (unsigned char*)d_ws;
#if MK_SINGLE
    a.ph_lo = 0; a.ph_hi = N_PHASES;
    hipLaunchKernelGGL(fwd_kernel, dim3(grid), dim3(NTHREADS), LDS_BYTES, stream, a);
#else
    for (int p = 0; p < N_PHASES; ++p) { a.ph_lo = p; a.ph_hi = p + 1; hipLaunchKernelGGL(fwd_kernel, dim3(grid), dim3(NTHREADS), LDS_BYTES, stream, a); }
#endif
}
```

```cpp
#define REP_PHASE -1
#include <hip/hip_runtime.h>
#include <cstdio>
#include <cstdint>
namespace pg8 {
#define PG8_LAS __attribute__((address_space(3)))
typedef unsigned short bf16_t;
typedef short bf16x8 __attribute__((ext_vector_type(8)));
typedef float f32x4 __attribute__((ext_vector_type(4)));
typedef unsigned u32x4 __attribute__((ext_vector_type(4)));
constexpr int BM = 256, BK = 64, HALF = 128, HTB = HALF * BK * 2  , STAGE_BYTES = 8 * HTB, NXCD = 8, WGM = 8;

__host__ __device__ __forceinline__ int lds_byte(int r, int c) { const int st = (r >> 4) * 2 + (c >> 5), rr = r & 15, cc = c & 31, ob = rr * 64 + cc * 2; return st * 1024 + (ob ^ (((ob >> 9) & 1) << 5)); }
__host__ __device__ __forceinline__ void stage_rc(int b, int& R, int& C) { const int st = b / 1024, sb = b % 1024, swz = sb ^ (((sb >> 9) & 1) << 5); R = (st >> 1) * 16 + swz / 64; C = (st & 1) * 32 + (swz % 64) / 2; }
__host__ __device__ __forceinline__ int perm32(int rho) { const int n = rho >> 4, i = rho & 15; return 8 * (i >> 2) + 4 * n + (i & 3); }

struct Unit { int pm, pn; };
struct Gemm { const bf16_t* A; const bf16_t* Bt; int M, N, K; };

struct StaticOrder {
    int nM, nN, nwg, G, c;
    __host__ __device__ void init(int M, int N, int G_, int c_) { nM = M / BM; nN = N / BM; nwg = nM * nN; G = G_; c = c_; }
    __host__ __device__ bool next(int i, Unit& u) const {
        const long L = (long)i * G + c; if (L >= nwg) return false;
        int wgid = (int)L; { const int q = nwg / NXCD, r = nwg % NXCD, xcd = wgid % NXCD, off = wgid / NXCD; wgid = (xcd < r ? xcd * (q + 1) : r * (q + 1) + (xcd - r) * q) + off; }
        const int nig = WGM * nN, gid = wgid / nig, fm = gid * WGM, gsz = (nM - fm) < WGM ? (nM - fm) : WGM;
        u.pm = fm + ((wgid % nig) % gsz); u.pn = (wgid % nig) / gsz; return true;
    }
    __device__ __forceinline__ void a_ready(const Unit&) const {}
    __device__ __forceinline__ void done(const Unit&) const {}
};

__device__ __forceinline__ unsigned cvt_pk_bf16(float lo, float hi) { unsigned r; asm volatile("v_cvt_pk_bf16_f32 %0, %1, %2" : "=v"(r) : "v"(lo), "v"(hi)); return r; }
typedef float f32x2 __attribute__((ext_vector_type(2)));
__device__ __forceinline__ f32x2 gelu_pk(f32x2 v) {
    const f32x2 av = __builtin_elementwise_abs(v), d = av * 0.2316418882f + 1.0f;
    f32x2 t; t.x = __builtin_amdgcn_rcpf(d.x); t.y = __builtin_amdgcn_rcpf(d.y);
    f32x2 q = t * 0.5307027145f + (-0.7265760135f); q = q * t + 0.7107068705f; q = q * t + (-0.142248368f); q = q * t + 0.127414796f; q = q * t;
    const f32x2 s = (v * v) * (-0.72134752044f);
    f32x2 e; e.x = __builtin_amdgcn_exp2f(s.x); e.y = __builtin_amdgcn_exp2f(s.y);
    const f32x2 m = v * (q * e), r = v - m;
    f32x2 o; o.x = v.x < 0.f ? m.x : r.x; o.y = v.y < 0.f ? m.y : r.y; return o;
}

template <int ACT  > struct EpiBf16 {
    static constexpr bool PERM = true, AFTER_DRAIN = false; static_assert(ACT == 0 || ACT == 1, "EpiBf16: ACT is 0 (none) or 1 (gelu_pk)");
    bf16_t* O; int ldc; const float* bias; int split_cols; size_t split_stride; float scale0;
    __device__ __forceinline__ void operator()(const f32x4 (&acc)[2][2][4][2], const Unit& u, int wr, int wc, int fr, int fq) const {
        const int row0 = u.pm * BM + wr * 64 + fr; int colt = u.pn * BM; bf16_t* base = O;
        float sc = 1.f; if (split_cols) { const int t = colt / split_cols; base += (size_t)t * split_stride; colt -= t * split_cols; if (t == 0) sc = scale0; }
        const int col0 = colt + wc * 32 + 8 * fq, bcol0 = u.pn * BM + wc * 32 + 8 * fq;
        f32x4 bv[2][2];
#pragma unroll
        for (int bj = 0; bj < 2; ++bj)
#pragma unroll
            for (int n = 0; n < 2; ++n) bv[bj][n] = bias ? *(const f32x4*)(bias + bcol0 + bj * HALF + 4 * n) : (f32x4){0.f, 0.f, 0.f, 0.f};
#pragma unroll
        for (int ai = 0; ai < 2; ++ai)
#pragma unroll
            for (int m = 0; m < 4; ++m) { bf16_t* rowp = base + (size_t)(row0 + ai * HALF + m * 16) * ldc + col0;
#pragma unroll
                for (int bj = 0; bj < 2; ++bj) { f32x4 v0 = acc[ai][bj][m][0] + bv[bj][0], v1 = acc[ai][bj][m][1] + bv[bj][1];
                    if (ACT == 1) { f32x2 a = gelu_pk((f32x2){v0[0], v0[1]}), b = gelu_pk((f32x2){v0[2], v0[3]}), c = gelu_pk((f32x2){v1[0], v1[1]}), d = gelu_pk((f32x2){v1[2], v1[3]});
                        v0 = (f32x4){a.x, a.y, b.x, b.y}; v1 = (f32x4){c.x, c.y, d.x, d.y}; }
                    v0 = v0 * sc; v1 = v1 * sc; u32x4 w; w.x = cvt_pk_bf16(v0[0], v0[1]); w.y = cvt_pk_bf16(v0[2], v0[3]); w.z = cvt_pk_bf16(v1[0], v1[1]); w.w = cvt_pk_bf16(v1[2], v1[3]);
                    *(u32x4*)(rowp + bj * HALF) = w; } }
    }
};
__device__ __forceinline__ f32x4 sigm4(f32x4 v) { f32x4 o;
#pragma unroll
    for (int j = 0; j < 4; ++j) o[j] = __builtin_amdgcn_rcpf(1.0f + __builtin_amdgcn_exp2f(-1.4426950408889634f * v[j]));
    return o; }
__device__ __forceinline__ f32x4 gelu4(f32x4 v) { const f32x2 a = gelu_pk((f32x2){v[0], v[1]}), b = gelu_pk((f32x2){v[2], v[3]}); return (f32x4){a.x, a.y, b.x, b.y}; }
__device__ __forceinline__ void unpack8(const u32x4 w, f32x4& lo, f32x4& hi) {
    lo = (f32x4){__uint_as_float(w.x << 16), __uint_as_float(w.x & 0xffff0000u), __uint_as_float(w.y << 16), __uint_as_float(w.y & 0xffff0000u)};
    hi = (f32x4){__uint_as_float(w.z << 16), __uint_as_float(w.z & 0xffff0000u), __uint_as_float(w.w << 16), __uint_as_float(w.w & 0xffff0000u)}; }
struct EpiIn {
    static constexpr bool PERM = true, AFTER_DRAIN = false;
    bf16_t* qkv; bf16_t* lx; bf16_t* gy; bf16_t* ga; bf16_t* gl; const float* bias;
    __device__ __forceinline__ void operator()(const f32x4 (&acc)[2][2][4][2], const Unit& u, int wr, int wc, int fr, int fq) const {
        const int pn = u.pn; bf16_t* base; int ldc, colt, act;
        if (pn < 24) { base = qkv + (size_t)(pn >> 3) * ((size_t)8192 * 2048); ldc = 2048; colt = (pn & 7) * 256; act = 0; }
        else if (pn < 32) { base = lx; ldc = 2048; colt = (pn - 24) * 256; act = 0; }
        else if (pn < 40) { base = gy; ldc = 2048; colt = (pn - 32) * 256; act = 1; }
        else if (pn < 56) { base = ga; ldc = 4096; colt = (pn - 40) * 256; act = 2; }
        else { base = gl; ldc = 4096; colt = (pn - 56) * 256; act = 2; }
        const int row0 = u.pm * BM + wr * 64 + fr, col0 = colt + wc * 32 + 8 * fq, bcol0 = pn * BM + wc * 32 + 8 * fq;
        f32x4 bv[2][2];
#pragma unroll
        for (int bj = 0; bj < 2; ++bj)
#pragma unroll
            for (int n = 0; n < 2; ++n) bv[bj][n] = *(const f32x4*)(bias + bcol0 + bj * HALF + 4 * n);
#pragma unroll
        for (int ai = 0; ai < 2; ++ai)
#pragma unroll
            for (int m = 0; m < 4; ++m) { bf16_t* rowp = base + (size_t)(row0 + ai * HALF + m * 16) * ldc + col0;
#pragma unroll
                for (int bj = 0; bj < 2; ++bj) { f32x4 v0 = acc[ai][bj][m][0] + bv[bj][0], v1 = acc[ai][bj][m][1] + bv[bj][1];
                    if (act == 1) { v0 = gelu4(v0); v1 = gelu4(v1); }
                    else if (act == 2) { v0 = sigm4(v0); v1 = sigm4(v1); }
                    u32x4 w; w.x = cvt_pk_bf16(v0[0], v0[1]); w.y = cvt_pk_bf16(v0[2], v0[3]); w.z = cvt_pk_bf16(v1[0], v1[1]); w.w = cvt_pk_bf16(v1[2], v1[3]);
                    *(u32x4*)(rowp + bj * HALF) = w; } }
    }
};
template <int MODE> struct EpiGate {
    static constexpr bool PERM = true, AFTER_DRAIN = false;
    bf16_t* O; const bf16_t* Gt; int ldc;
    __device__ __forceinline__ void operator()(const f32x4 (&acc)[2][2][4][2], const Unit& u, int wr, int wc, int fr, int fq) const {
        const int row0 = u.pm * BM + wr * 64 + fr, col0 = u.pn * BM + wc * 32 + 8 * fq;
#pragma unroll
        for (int ai = 0; ai < 2; ++ai)
#pragma unroll
            for (int m = 0; m < 4; ++m) { const size_t off = (size_t)(row0 + ai * HALF + m * 16) * ldc + col0;
#pragma unroll
                for (int bj = 0; bj < 2; ++bj) { f32x4 g0, g1; unpack8(*(const u32x4*)(Gt + off + bj * HALF), g0, g1);
                    f32x4 v0 = acc[ai][bj][m][0] * g0, v1 = acc[ai][bj][m][1] * g1;
                    if (MODE == 1) { f32x4 t0, t1; unpack8(*(const u32x4*)(O + off + bj * HALF), t0, t1); v0 += t0; v1 += t1; }
                    u32x4 w; w.x = cvt_pk_bf16(v0[0], v0[1]); w.y = cvt_pk_bf16(v0[2], v0[3]); w.z = cvt_pk_bf16(v1[0], v1[1]); w.w = cvt_pk_bf16(v1[2], v1[3]);
                    *(u32x4*)(O + off + bj * HALF) = w; } }
    }
};
struct EpiRes {
    static constexpr bool PERM = false, AFTER_DRAIN = false;
    const float* X; float* Out; const float* gate; int ldc;
    __device__ __forceinline__ void operator()(const f32x4 (&acc)[2][2][4][2], const Unit& u, int wr, int wc, int fr, int fq) const {
        const int row0 = u.pm * BM + wr * 64 + fr, col0 = u.pn * BM + wc * 32 + 4 * fq;
        f32x4 gv[2][2];
#pragma unroll
        for (int bj = 0; bj < 2; ++bj)
#pragma unroll
            for (int n = 0; n < 2; ++n) gv[bj][n] = *(const f32x4*)(gate + col0 + bj * HALF + n * 16);
#pragma unroll
        for (int ai = 0; ai < 2; ++ai)
#pragma unroll
            for (int m = 0; m < 4; ++m) { const size_t off = (size_t)(row0 + ai * HALF + m * 16) * ldc + col0;
#pragma unroll
                for (int bj = 0; bj < 2; ++bj)
#pragma unroll
                    for (int n = 0; n < 2; ++n) { const f32x4 xv = *(const f32x4*)(X + off + bj * HALF + n * 16);
                        *(f32x4*)(Out + off + bj * HALF + n * 16) = xv + gv[bj][n] * acc[ai][bj][m][n]; } }
    }
};
template <class Epi, class Sched, bool ALIGN_EPI = false, bool SP2 = false>
__device__ __forceinline__ void gemm_phase(PG8_LAS unsigned char* lds, const Gemm g, const Sched& S, const Epi& E) {
    const int tid = threadIdx.x, wid = __builtin_amdgcn_readfirstlane(tid >> 6), lane = tid & 63, wr = wid >> 2, wc = wid & 3, fr = lane & 15, fq = lane >> 4;
    const int K = g.K, nt = K / BK;
    unsigned voffA[2], voffB[2];
#pragma unroll
    for (int i = 0; i < 2; ++i) { int R, C; stage_rc(tid * 16 + i * 8192, R, C); const int Rb = Epi::PERM ? ((R & ~31) + perm32(R & 31)) : R;
        voffA[i] = (unsigned)(R * K + C) * 2u; voffB[i] = (unsigned)(Rb * K + C) * 2u; }
    const size_t kstep = (size_t)(BK * 2);
    const size_t hstep = (size_t)HALF * K * 2;
    const size_t tstep = 2 * hstep;
    const unsigned ldsw = (unsigned)wid * 1024u;
    const int aoff = lds_byte(wr * 64 + fr, fq * 8), boff = lds_byte(wc * 32 + fr, fq * 8);
#define PG8_SA(b, h) (((b) * 2 + (h)) * HTB)
#define PG8_SB(b, h) ((4 + (b) * 2 + (h)) * HTB)
#define PG8_STAGE(bufoff, gbase, voff) do { _Pragma("unroll") for (int _i = 0; _i < 2; ++_i) \
        __builtin_amdgcn_global_load_lds((const unsigned*)((const char*)(gbase) + (voff)[_i]), (PG8_LAS unsigned*)(lds + (bufoff) + ldsw + _i * 8192), 16, 0, 0); } while (0)
#define PG8_LDA(dst, b, h) do { _Pragma("unroll") for (int m = 0; m < 4; ++m) _Pragma("unroll") for (int k = 0; k < 2; ++k) dst[m][k] = *(const PG8_LAS bf16x8*)(lds + PG8_SA(b, h) + aoff + m * 2048 + k * 1024); } while (0)
#define PG8_LDB(dst, b, h) do { _Pragma("unroll") for (int n = 0; n < 2; ++n) _Pragma("unroll") for (int k = 0; k < 2; ++k) dst[n][k] = *(const PG8_LAS bf16x8*)(lds + PG8_SB(b, h) + boff + n * 2048 + k * 1024); } while (0)
#define PG8_MMA(ai, bj, At, Bt) do { __builtin_amdgcn_s_setprio(1); _Pragma("unroll") for (int m = 0; m < 4; ++m) _Pragma("unroll") for (int n = 0; n < 2; ++n) _Pragma("unroll") for (int k = 0; k < 2; ++k) \
        acc[ai][bj][m][n] = __builtin_amdgcn_mfma_f32_16x16x32_bf16(Bt[n][k], At[m][k], acc[ai][bj][m][n], 0, 0, 0); __builtin_amdgcn_s_setprio(0); } while (0)
#define PG8_WAIT_V(n) asm volatile("s_waitcnt vmcnt(" #n ")" ::: "memory")
#define PG8_WAIT_L(n) asm volatile("s_waitcnt lgkmcnt(" #n ")" ::: "memory")
#define PG8_BAR __builtin_amdgcn_s_barrier()
#define PG8_SCHED __builtin_amdgcn_sched_barrier(0)
    Unit cur, nxt; int ui = 0;
    if (!S.next(0, cur)) return;
    f32x4 acc[2][2][4][2];
#pragma unroll
    for (int a = 0; a < 2; ++a)
#pragma unroll
        for (int b = 0; b < 2; ++b)
#pragma unroll
            for (int m = 0; m < 4; ++m)
#pragma unroll
                for (int n = 0; n < 2; ++n) acc[a][b][m][n] = (f32x4){0.f, 0.f, 0.f, 0.f};
    bf16x8 At[4][2], B0[2][2], B1[2][2];
    const char* cA = (const char*)g.A + (size_t)cur.pm * tstep; const char* cB = (const char*)g.Bt + (size_t)cur.pn * tstep;
    S.a_ready(cur);
    if constexpr (SP2) {
        PG8_STAGE(PG8_SB(0, 0), cB, voffB); PG8_STAGE(PG8_SB(0, 1), cB + hstep, voffB); PG8_STAGE(PG8_SA(0, 0), cA, voffA); PG8_STAGE(PG8_SA(0, 1), cA + hstep, voffA);
        if (wr == 1) PG8_BAR;
        PG8_WAIT_V(2); PG8_BAR;
        PG8_STAGE(PG8_SB(1, 0), cB + kstep, voffB); PG8_STAGE(PG8_SA(1, 0), cA + kstep, voffA); PG8_STAGE(PG8_SB(1, 1), cB + hstep + kstep, voffB);
        PG8_WAIT_V(6); PG8_BAR;
    } else {
        PG8_STAGE(PG8_SB(0, 0), cB, voffB); PG8_STAGE(PG8_SA(0, 0), cA, voffA); PG8_STAGE(PG8_SB(0, 1), cB + hstep, voffB); PG8_STAGE(PG8_SA(0, 1), cA + hstep, voffA);
        if (wr == 1) PG8_BAR;
        PG8_WAIT_V(4); PG8_BAR;
        PG8_STAGE(PG8_SB(1, 0), cB + kstep, voffB); PG8_STAGE(PG8_SA(1, 0), cA + kstep, voffA); PG8_STAGE(PG8_SB(1, 1), cB + hstep + kstep, voffB);
        PG8_WAIT_V(6); PG8_BAR;
    }
    for (;;) {
        const bool has_next = S.next(ui + 1, nxt);
        const char* nA = has_next ? (const char*)g.A + (size_t)nxt.pm * tstep : cA; const char* nB = has_next ? (const char*)g.Bt + (size_t)nxt.pn * tstep : cB;
        for (int t = 0; t < nt; t += 2) {
            const bool last = (t == nt - 2);
            const char* a1 = cA + (size_t)(t + 1) * kstep;
            const char* a2 = last ? nA : cA + (size_t)(t + 2) * kstep; const char* b2 = last ? nB : cB + (size_t)(t + 2) * kstep;
            const char* a3 = a2 + kstep; const char* b3 = b2 + kstep;
            if (last && has_next) S.a_ready(nxt);
            if constexpr (SP2) {
            PG8_LDB(B0, 0, 0); PG8_LDB(B1, 0, 1); PG8_SCHED; PG8_LDA(At, 0, 0); PG8_STAGE(PG8_SA(1, 1), a1 + hstep, voffA);
            PG8_WAIT_V(8); PG8_WAIT_L(0); PG8_BAR; PG8_MMA(0, 0, At, B0); PG8_MMA(0, 1, At, B1); PG8_BAR; PG8_SCHED;
            PG8_LDA(At, 0, 1); PG8_STAGE(PG8_SB(0, 0), b2, voffB); PG8_STAGE(PG8_SB(0, 1), b2 + hstep, voffB); PG8_STAGE(PG8_SA(0, 0), a2, voffA);
            PG8_WAIT_V(8); PG8_WAIT_L(0); PG8_BAR; PG8_MMA(1, 0, At, B0); PG8_MMA(1, 1, At, B1); PG8_BAR; PG8_SCHED;
            PG8_LDB(B0, 1, 0); PG8_LDB(B1, 1, 1); PG8_SCHED; PG8_LDA(At, 1, 0); PG8_STAGE(PG8_SA(0, 1), a2 + hstep, voffA);
            PG8_WAIT_V(8); PG8_WAIT_L(0); PG8_BAR; PG8_MMA(0, 0, At, B0); PG8_MMA(0, 1, At, B1); PG8_BAR; PG8_SCHED;
            PG8_LDA(At, 1, 1); PG8_STAGE(PG8_SB(1, 0), b3, voffB); PG8_STAGE(PG8_SB(1, 1), b3 + hstep, voffB); PG8_STAGE(PG8_SA(1, 0), a3, voffA);
            PG8_WAIT_V(8); PG8_WAIT_L(0); PG8_BAR; PG8_MMA(1, 0, At, B0); PG8_MMA(1, 1, At, B1); PG8_BAR; PG8_SCHED;
            } else {
            PG8_LDB(B0, 0, 0); PG8_SCHED; PG8_LDA(At, 0, 0); PG8_STAGE(PG8_SA(1, 1), a1 + hstep, voffA);
            PG8_WAIT_L(8); PG8_BAR; PG8_WAIT_L(0); PG8_MMA(0, 0, At, B0); PG8_BAR; PG8_SCHED;
            PG8_LDB(B1, 0, 1); PG8_STAGE(PG8_SB(0, 0), b2, voffB);
            PG8_BAR; PG8_WAIT_L(0); PG8_MMA(0, 1, At, B1); PG8_BAR;
            PG8_LDA(At, 0, 1); PG8_STAGE(PG8_SA(0, 0), a2, voffA);
            PG8_BAR; PG8_WAIT_L(0); PG8_MMA(1, 0, At, B0); PG8_BAR; PG8_SCHED;
            PG8_STAGE(PG8_SB(0, 1), b2 + hstep, voffB);
            PG8_WAIT_V(6); PG8_BAR; PG8_MMA(1, 1, At, B1); PG8_BAR;
            PG8_LDB(B0, 1, 0); PG8_SCHED; PG8_LDA(At, 1, 0); PG8_STAGE(PG8_SA(0, 1), a2 + hstep, voffA);
            PG8_WAIT_L(8); PG8_BAR; PG8_WAIT_L(0); PG8_MMA(0, 0, At, B0); PG8_BAR; PG8_SCHED;
            PG8_LDB(B1, 1, 1); PG8_STAGE(PG8_SB(1, 0), b3, voffB);
            PG8_BAR; PG8_WAIT_L(0); PG8_MMA(0, 1, At, B1); PG8_BAR;
            PG8_LDA(At, 1, 1); PG8_STAGE(PG8_SA(1, 0), a3, voffA);
            PG8_BAR; PG8_WAIT_L(0); PG8_MMA(1, 0, At, B0); PG8_BAR; PG8_SCHED;
            PG8_STAGE(PG8_SB(1, 1), b3 + hstep, voffB);
            PG8_WAIT_V(6); PG8_BAR; PG8_MMA(1, 1, At, B1); PG8_BAR;
            }
        }
        if constexpr (ALIGN_EPI) { if (wr == 0) PG8_BAR; }
        if constexpr (!Epi::AFTER_DRAIN) { E(acc, cur, wr, wc, fr, fq); S.done(cur); }
        if (!has_next) break;
#pragma unroll
        for (int a = 0; a < 2; ++a)
#pragma unroll
            for (int b = 0; b < 2; ++b)
#pragma unroll
                for (int m = 0; m < 4; ++m)
#pragma unroll
                    for (int n = 0; n < 2; ++n) acc[a][b][m][n] = (f32x4){0.f, 0.f, 0.f, 0.f};
        cur = nxt; cA = nA; cB = nB; ++ui;
        if constexpr (ALIGN_EPI) { if (wr == 1) PG8_BAR; }
    }
    PG8_WAIT_V(0);
    if constexpr (!ALIGN_EPI) { if (wr == 0) PG8_BAR; }
    PG8_BAR;
    if constexpr (Epi::AFTER_DRAIN) { E.fused(acc, cur, wr, wc, fr, fq, lds, wid, lane); S.done(cur); }
#undef PG8_SA
#undef PG8_SB
#undef PG8_STAGE
#undef PG8_LDA
#undef PG8_LDB
#undef PG8_MMA
#undef PG8_WAIT_V
#undef PG8_WAIT_L
#undef PG8_BAR
#undef PG8_SCHED
}
}
namespace attn_body {
constexpr int D = 128, LD = 2048;
constexpr float THR = 8.f; constexpr bool WSKIP = false;
constexpr float SCALE = 0.08838834764831845f;
constexpr int NW = 8, QBLK = 32, KVBLK = 64, QB = NW * QBLK;
constexpr int SHM_V = KVBLK * D * 2, SHM_K = KVBLK * D * 2;
constexpr int LDS_BYTES = 2 * SHM_V + 2 * SHM_K + NW * 64 * 4;

typedef short bf16x8 __attribute__((ext_vector_type(8)));
typedef short s16x4 __attribute__((ext_vector_type(4)));
typedef float f32x16 __attribute__((ext_vector_type(16)));
typedef float f32x4 __attribute__((ext_vector_type(4)));
typedef unsigned u32x4 __attribute__((ext_vector_type(4)));
template <class A, class Bt> struct same_t { static constexpr bool v = false; };
template <class A> struct same_t<A, A> { static constexpr bool v = true; };

#define KSWZ(row, colB) ((row) * 256 + ((colB) ^ (((row) & 7) << 4)))
#define SBAR() __builtin_amdgcn_sched_barrier(0)
__device__ __forceinline__ int v_st(int k, int c) { const int kk = (k & ~0xC) | ((k & 4) << 1) | ((k & 8) >> 1); return ((kk >> 3) * 4 + (c >> 5)) * 512 + ((kk & 7) * 32 + (c & 31)) * 2; }
__device__ __forceinline__ int v_rd_base(int lane) { return ((lane & 3) << 3) | (((lane >> 2) & 3) << 6) | (((lane >> 4) & 1) << 5) | (((lane >> 5) & 1) << 8); }
constexpr int v_rd_off(int d0, int ks, int half) { return d0 * 512 + ks * 4096 + half * 2048; }
__device__ __forceinline__ int crow(int r, int hi) { return (r & 3) + 8 * (r >> 2) + 4 * hi; }
__device__ __forceinline__ unsigned cvtpk(float lo, float hi) {
    unsigned r; asm volatile("v_cvt_pk_bf16_f32 %0, %1, %2" : "=v"(r) : "v"(lo), "v"(hi)); return r;
}
__device__ __forceinline__ bf16x8 pack8(f32x4 a, f32x4 b) {
    u32x4 w = {cvtpk(a[0], a[1]), cvtpk(a[2], a[3]), cvtpk(b[0], b[1]), cvtpk(b[2], b[3])};
    return *reinterpret_cast<bf16x8*>(&w);
}
template <class T> __device__ __forceinline__ bf16x8 load8(const T* p) {
    if constexpr (same_t<T, float>::v) { return pack8(*(const f32x4*)p, *(const f32x4*)(p + 4)); }
    else { return *reinterpret_cast<const bf16x8*>(p); }
}
__device__ __forceinline__ void mask_tile(f32x16& p0, f32x16& p1, int dq, unsigned W) {
    const float NEG = -__builtin_inff();
#pragma unroll
    for (int r = 0; r < 16; ++r) {
        const int c = (r & 3) + 8 * (r >> 2);
        if ((unsigned)(dq - c) >= W) p0[r] = NEG;
        if ((unsigned)(dq - c - 32) >= W) p1[r] = NEG;
    }
}
__device__ __forceinline__ void partialSM(f32x16& p0, f32x16& p1, float& m_reg, float& mn, float& alpha) {
    float pmax = p0[0]; for (int r = 1; r < 16; ++r) pmax = fmaxf(pmax, p0[r]); for (int r = 0; r < 16; ++r) pmax = fmaxf(pmax, p1[r]);
    { auto rr = __builtin_amdgcn_permlane32_swap(__float_as_uint(pmax), __float_as_uint(pmax), false, false);
      pmax = fmaxf(__uint_as_float(rr[0]), __uint_as_float(rr[1])); }
    constexpr float C2 = 1.4426950408889634f * SCALE;
    if (__builtin_expect(__all((pmax - m_reg) * SCALE <= THR), 1)) { mn = m_reg; alpha = 1.f; }
    else { mn = fmaxf(m_reg, pmax); alpha = __builtin_amdgcn_exp2f((m_reg - mn) * C2); m_reg = mn; }
    const float mnL = -mn * C2;
    for (int r = 0; r < 16; ++r) p0[r] = fmaf(p0[r], C2, mnL); for (int r = 0; r < 16; ++r) p1[r] = fmaf(p1[r], C2, mnL);
    for (int r = 0; r < 16; ++r) p0[r] = __builtin_amdgcn_exp2f(p0[r]);
}
__device__ __forceinline__ void finishSM(f32x16& p0, f32x16& p1, float alpha, float& l_reg, bf16x8& pa0, bf16x8& pa1, bf16x8& pa2, bf16x8& pa3) {
    for (int r = 0; r < 16; ++r) p1[r] = __builtin_amdgcn_exp2f(p1[r]);
    float ps = 0; for (int r = 0; r < 16; ++r) ps += p0[r]; for (int r = 0; r < 16; ++r) ps += p1[r];
    { auto rr = __builtin_amdgcn_permlane32_swap(__float_as_uint(ps), __float_as_uint(ps), false, false);
      ps = __uint_as_float(rr[0]) + __uint_as_float(rr[1]); }
    l_reg = l_reg * alpha + ps;
#define PK4(P, B_, OUT) do { unsigned a0 = cvtpk(P[B_+0], P[B_+1]), a1 = cvtpk(P[B_+2], P[B_+3]);                          \
        unsigned b0 = cvtpk(P[B_+4], P[B_+5]), b1 = cvtpk(P[B_+6], P[B_+7]);                                             \
        auto r0 = __builtin_amdgcn_permlane32_swap(a0, b0, false, false); auto r1 = __builtin_amdgcn_permlane32_swap(a1, b1, false, false); \
        u32x4 w = {r0[0], r1[0], r0[1], r1[1]}; OUT = *reinterpret_cast<bf16x8*>(&w); } while (0)
    PK4(p0, 0, pa0); PK4(p0, 8, pa1); PK4(p1, 0, pa2); PK4(p1, 8, pa3);
#undef PK4
}
template <int KB, bool SK>
__device__ __forceinline__ void qkt(f32x16& p0, f32x16& p1, const char* K_lds, int r32, int hi, const bf16x8* qr, bool act, const float* bt) {
    if (SK && !act) { const float NEG = -__builtin_inff();
#pragma unroll
        for (int r = 0; r < 16; ++r) { p0[r] = NEG; p1[r] = NEG; } return; }
    { const f32x4 b0 = *(const f32x4*)(bt), b1 = *(const f32x4*)(bt + 8), b2 = *(const f32x4*)(bt + 16), b3 = *(const f32x4*)(bt + 24);
      const f32x4 c0 = *(const f32x4*)(bt + 32), c1 = *(const f32x4*)(bt + 40), c2 = *(const f32x4*)(bt + 48), c3 = *(const f32x4*)(bt + 56);
      p0 = (f32x16){b0[0], b0[1], b0[2], b0[3], b1[0], b1[1], b1[2], b1[3], b2[0], b2[1], b2[2], b2[3], b3[0], b3[1], b3[2], b3[3]};
      p1 = (f32x16){c0[0], c0[1], c0[2], c0[3], c1[0], c1[1], c1[2], c1[3], c2[0], c2[1], c2[2], c2[3], c3[0], c3[1], c3[2], c3[3]}; }
    const char* kb[4];
#pragma unroll
    for (int dd = 0; dd < 4; ++dd) kb[dd] = K_lds + KB * SHM_K + KSWZ(r32, (dd * 16 + hi * 8) * 2);
#pragma unroll
    for (int d0 = 0; d0 < 8; ++d0) { const char* a = kb[d0 & 3] + (d0 >> 2) * 128;
        bf16x8 b0 = *reinterpret_cast<const bf16x8*>(a);
        bf16x8 b1 = *reinterpret_cast<const bf16x8*>(a + 32 * 256);
        p0 = __builtin_amdgcn_mfma_f32_32x32x16_bf16(b0, qr[d0], p0, 0, 0, 0);
        p1 = __builtin_amdgcn_mfma_f32_32x32x16_bf16(b1, qr[d0], p1, 0, 0, 0); }
}
template <int VB, bool SK>
__device__ __forceinline__ void pv_tile(f32x16* o, int vb0, bf16x8 pa0, bf16x8 pa1, bf16x8 pa2, bf16x8 pa3, bool act) {
    if (SK && !act) return;
#define TRRD(dst, off) asm volatile("ds_read_b64_tr_b16 %0, %1 offset:%2" : "=&v"(dst) : "v"(vb0), "i"(off) : "memory")
#define PV_D0(d0) do { s16x4 l0, l1, l2, l3, h0, h1, h2, h3; constexpr int b_ = VB * SHM_V + v_rd_off(d0, 0, 0);     \
        TRRD(l0, b_); TRRD(h0, b_ + 2048); TRRD(l1, b_ + 4096); TRRD(h1, b_ + 6144); TRRD(l2, b_ + 8192); TRRD(h2, b_ + 10240); TRRD(l3, b_ + 12288); TRRD(h3, b_ + 14336); \
        asm volatile("s_waitcnt lgkmcnt(0)" ::: "memory"); SBAR();                 \
        o[d0] = __builtin_amdgcn_mfma_f32_32x32x16_bf16(pa0, (bf16x8){l0[0], l0[1], l0[2], l0[3], h0[0], h0[1], h0[2], h0[3]}, o[d0], 0, 0, 0);   \
        o[d0] = __builtin_amdgcn_mfma_f32_32x32x16_bf16(pa1, (bf16x8){l1[0], l1[1], l1[2], l1[3], h1[0], h1[1], h1[2], h1[3]}, o[d0], 0, 0, 0);   \
        o[d0] = __builtin_amdgcn_mfma_f32_32x32x16_bf16(pa2, (bf16x8){l2[0], l2[1], l2[2], l2[3], h2[0], h2[1], h2[2], h2[3]}, o[d0], 0, 0, 0);   \
        o[d0] = __builtin_amdgcn_mfma_f32_32x32x16_bf16(pa3, (bf16x8){l3[0], l3[1], l3[2], l3[3], h3[0], h3[1], h3[2], h3[3]}, o[d0], 0, 0, 0); } while (0)
    PV_D0(0); PV_D0(1); PV_D0(2); PV_D0(3);
#undef PV_D0
#undef TRRD
}


template <class TIn, class TOut> struct BlockRef { const TIn* Q; const TIn* K; const TIn* V; TOut* O; int P0; int jlo; };
#define ROW(p, k0, rr) ((p) + (size_t)((k0) + (rr)) * LD + sc)
#define VMW() asm volatile("s_waitcnt vmcnt(0)" ::: "memory")
#define SLOAD_H(Kp, Vp, k0) do { st_v0 = load8<TIn>(ROW(Vp, k0, sr)); st_v1 = load8<TIn>(ROW(Vp, k0, 32 + sr));              \
                         st_k0 = load8<TIn>(ROW(Kp, k0, sr)); st_k1 = load8<TIn>(ROW(Kp, k0, 32 + sr)); } while (0)
#define SWRITE_H(bf) do { *(bf16x8*)(V_lds + (bf) * SHM_V + vst0) = st_v0; *(bf16x8*)(V_lds + (bf) * SHM_V + vst1) = st_v1;   \
                          *(bf16x8*)(K_lds + (bf) * SHM_K + kws) = st_k0; *(bf16x8*)(K_lds + (bf) * SHM_K + kws + 32 * 256) = st_k1; } while (0)
template <class TIn, class TOut>
__device__ __forceinline__ void attn_unit(const BlockRef<TIn, TOut>& cur, int skv, char* lds) {
    const int tid = threadIdx.x, wid = __builtin_amdgcn_readfirstlane(tid >> 6), lane = tid & 63, r32 = lane & 31, hi = lane >> 5;
    const unsigned W = 0x40000000u;
    const int j_lo = cur.jlo;
    int j_hi = (cur.P0 + QB - 1) / KVBLK + 1; if (j_hi > skv / KVBLK) j_hi = skv / KVBLK;
    const int NT = j_hi - j_lo;
    const int qlo = cur.P0 + wid * QBLK, qm = qlo + r32 - 4 * hi;
    char* V_lds = lds; char* K_lds = lds + 2 * SHM_V;
    float* ws = (float*)(lds + 2 * SHM_V + 2 * SHM_K) + wid * 64; float* li_l = ws, * al_l = ws + 32;
    const float* bias_l = (const float*)(lds + LDS_BYTES) + 4 * hi;
    float m_reg = -1e30f, l_reg = 0; f32x16 o[4] = {};
    const int sr = tid >> 4, sc = (tid & 15) * 8, vst0 = v_st(sr, sc), vst1 = v_st(32 + sr, sc), kws = KSWZ(sr, sc * 2);
    const int vb0 = (int)(uintptr_t)V_lds + v_rd_base(lane);
    const TIn* Kh = cur.K; const TIn* Vh = cur.V;
    bf16x8 st_v0, st_v1, st_k0, st_k1; bf16x8 qr[8];
#define KBASE(t) ((j_lo + (t)) * KVBLK)
#define BT(t) (bias_l + (t) * KVBLK)
#define RESC(a) do { if (__any((a) < 1.f)) { if (hi == 0) al_l[r32] = (a); asm volatile("s_waitcnt lgkmcnt(0)" ::: "memory");              \
                     for (int d_ = 0; d_ < 4; ++d_) for (int r = 0; r < 16; ++r) o[d_][r] *= al_l[crow(r, hi)]; } } while (0)
#define MASKT(P0_, P1_, t) do { const int kb_ = KBASE(t); if (kb_ + KVBLK - 1 > qlo) mask_tile(P0_, P1_, qm - kb_, W); } while (0)
#pragma unroll
    for (int d0 = 0; d0 < 8; ++d0) qr[d0] = load8<TIn>(cur.Q + (size_t)(wid * QBLK + r32) * LD + d0 * 16 + hi * 8);
    SLOAD_H(Kh, Vh, KBASE(0)); VMW(); SWRITE_H(0); SBAR();
    if (NT > 1) SLOAD_H(Kh, Vh, KBASE(1));
    __syncthreads();
    f32x16 p0, p1; float mn, al; bf16x8 pa0, pa1, pa2, pa3;
#define TILE_STEP(t, BUF) do {                                                                                                 \
        SBAR(); qkt<BUF, false>(p0, p1, K_lds, r32, hi, qr, true, BT(t));                                                       \
        MASKT(p0, p1, (t)); partialSM(p0, p1, m_reg, mn, al); RESC(al);                                                          \
        finishSM(p0, p1, al, l_reg, pa0, pa1, pa2, pa3); SBAR();                                                                 \
        pv_tile<BUF, false>(o, vb0, pa0, pa1, pa2, pa3, true);                                                                    \
        if ((t) + 1 < NT) { VMW(); SWRITE_H(1 - (BUF)); SBAR(); if ((t) + 2 < NT) SLOAD_H(Kh, Vh, KBASE((t) + 2)); }              \
        __syncthreads(); } while (0)
    for (int t = 0; t < NT; t += 2) {
        TILE_STEP(t, 0);
        if (t + 1 < NT) TILE_STEP(t + 1, 1);
    }
    if (hi == 0) li_l[r32] = l_reg; asm volatile("s_waitcnt lgkmcnt(0)" ::: "memory");
    float rli[16];
#pragma unroll
    for (int r = 0; r < 16; ++r) rli[r] = __builtin_amdgcn_rcpf(li_l[crow(r, hi)]);
    TOut* Ow = cur.O + (size_t)(wid * QBLK) * LD;
#pragma unroll
    for (int r = 0; r < 16; ++r) { const int orow = crow(r, hi);
#pragma unroll
        for (int d0 = 0; d0 < 4; ++d0) { const float v = o[d0][r] * rli[r];
            const float vn = __shfl_xor(v, 1);
            if ((r32 & 1) == 0) *(unsigned*)(Ow + (size_t)orow * LD + d0 * 32 + r32) = cvtpk(v, vn); } }
    __syncthreads();
#undef TILE_STEP
#undef RESC
#undef KBASE
#undef BT
#undef MASKT
}
#undef ROW
#undef VMW
#undef SLOAD_H
#undef SWRITE_H
}
#define GAS __attribute__((address_space(1)))
#define LAS __attribute__((address_space(3)))
typedef unsigned short bf16;
typedef unsigned v4u __attribute__((ext_vector_type(4)));
typedef unsigned v2u __attribute__((ext_vector_type(2)));
typedef float f32x4 __attribute__((ext_vector_type(4)));
typedef float f32x2 __attribute__((ext_vector_type(2)));
typedef short bf16x8 __attribute__((ext_vector_type(8)));
typedef GAS unsigned gu32;
#define RLX_AGENT __ATOMIC_RELAXED, __HIP_MEMORY_SCOPE_AGENT

constexpr int S = 8192, DM = 4096, NH = 16, HD = 128, AW = 2048, LW = 2048, NG = 16, GD = 128;
constexpr int NIN = 18448, NINP = 18432;
constexpr int C_Q = 0, C_K = 2048, C_V = 4096, C_F = 6144, C_LX = 6160, C_LY = 8208, C_GA = 10256, C_GL = 14352;
constexpr int PEER_H = 8, PEER_NK = 128, PEER_K = 16, PEER_NE = 16384;
constexpr float EPS = 1e-6f;
constexpr size_t MiB = 1u << 20;
constexpr size_t WS_CTL = 0, CTL_ZERO_BYTES = 1 * MiB;
constexpr size_t WS_MOD = 512 * 1024;
constexpr size_t WS_WF = 2 * MiB;
constexpr size_t WS_LOGF = 3 * MiB;
constexpr size_t WS_FC = 4 * MiB;
constexpr size_t WS_AGGA = 5 * MiB, WS_AGGB = 6 * MiB;
constexpr size_t WS_BIASR = 7 * MiB;
constexpr size_t WS_WAT = 8 * MiB, WS_WXT = 9 * MiB;
constexpr size_t WS_SK = 10 * MiB;
constexpr size_t WS_IDX = 12 * MiB, WS_GATE = 16 * MiB, WS_IDX2 = 20 * MiB, WS_GATE2 = 24 * MiB;
constexpr size_t WS_WIN = 32 * MiB, WS_WAO = 176 * MiB, WS_WLO = 192 * MiB, WS_WOUT = 208 * MiB, WS_WPQ = 240 * MiB;
constexpr size_t WS_U = 256 * MiB, WS_V = 384 * MiB;
constexpr size_t WS_HA = 512 * MiB;
constexpr size_t WS_QKV = 576 * MiB;
constexpr size_t WS_LX = 672 * MiB, WS_GY = 704 * MiB, WS_GA = 736 * MiB, WS_GL = 800 * MiB;
constexpr size_t WS_ATT = 864 * MiB, WS_LR = 896 * MiB, WS_T1 = 928 * MiB, WS_MG = 992 * MiB, WS_Q2 = 1056 * MiB, WS_X1 = 1088 * MiB, WS_END = 1216 * MiB;
constexpr int CW_BAR = 4096;
constexpr int RING_BYTES = 131072;
constexpr int LDSCTL_OFF = RING_BYTES, MISC_OFF = LDSCTL_OFF + 320;
constexpr int LDS_BYTES = 147456;
constexpr int NWAVES = 8, NTHREADS = 512;

__device__ __forceinline__ unsigned f2bf(float f) { unsigned u = __builtin_bit_cast(unsigned, f); return (u + 0x7fffu + ((u >> 16) & 1u)) >> 16; }
__device__ __forceinline__ unsigned pk2(float lo, float hi) { return f2bf(lo) | (f2bf(hi) << 16); }
__device__ __forceinline__ float bflo(unsigned w) { return __uint_as_float(w << 16); }
__device__ __forceinline__ float bfhi(unsigned w) { return __uint_as_float(w & 0xffff0000u); }
__device__ __forceinline__ float bf2f(bf16 b) { return __uint_as_float((unsigned)b << 16); }
__device__ __forceinline__ float wave_sum(float v) {
#pragma unroll
    for (int o = 1; o < 64; o <<= 1) v += __shfl_xor(v, o);
    return v;
}
__device__ __forceinline__ float wave_max(float v) {
#pragma unroll
    for (int o = 1; o < 64; o <<= 1) v = fmaxf(v, __shfl_xor(v, o));
    return v;
}
__device__ __forceinline__ float sigmoidf_(float v) { return __builtin_amdgcn_rcpf(1.0f + __builtin_amdgcn_exp2f(-1.4426950408889634f * v)); }
__device__ __forceinline__ float gelu_erf(float v) { return 0.5f * v * (1.0f + erff(v * 0.70710678118654752f)); }
#define XB_TMO      128
#define XB_XCNT(j)  (256  + 64 * (j))
#define XB_XSUB(j)  (1280 + 64 * (j))
#define XB_XGEN(j)  (2304 + 64 * (j))
#define XB_TOP      3328
#define XB_TOPGEN   3392
#define XCD_BAR_WORDS 3456
#define XB_SPIN_CAP (1u << 18)

__device__ __forceinline__ unsigned xb_ld(unsigned* p)              { return __hip_atomic_load(p, __ATOMIC_RELAXED, __HIP_MEMORY_SCOPE_AGENT); }
__device__ __forceinline__ unsigned xb_add(unsigned* p, unsigned v) { return __hip_atomic_fetch_add(p, v, __ATOMIC_RELAXED, __HIP_MEMORY_SCOPE_AGENT); }
__device__ __forceinline__ unsigned xb_xcc_id() { return (unsigned)__builtin_amdgcn_s_getreg((3 << 11) | 20) & 0xFu; }
#define XB_SPIN(cond, bar) do { unsigned _sp = 0; while (cond) { __builtin_amdgcn_s_sleep(1); \
    if ((++_sp & 255u) == 0u) { if (xb_ld(&(bar)[XB_TMO])) break; if (_sp > XB_SPIN_CAP) { atomicAdd(&(bar)[XB_TMO], 1u); break; } } } } while (0)

struct XcdBarrier {
    unsigned* bar; unsigned x;
    volatile LAS unsigned* st;
};

__device__ __forceinline__ XcdBarrier xcd_barrier_post(unsigned* bar, volatile LAS unsigned* st) {
    XcdBarrier b; b.bar = bar; b.x = xb_xcc_id(); b.st = st;
    if (threadIdx.x == 0) (void)xb_add(&bar[XB_XCNT(b.x)], 1u);
    return b;
}
__device__ __forceinline__ void xcd_barrier_complete(unsigned* bar, unsigned x, unsigned& nloc, unsigned& nx) {
    const unsigned G = gridDim.x * gridDim.y * gridDim.z;
    unsigned sum, cnt, mine, sp = 0u;
    for (;;) {
        sum = 0u; cnt = 0u; mine = 0u;
#pragma unroll
        for (unsigned j = 0; j < 16; ++j) { const unsigned c = xb_ld(&bar[XB_XCNT(j)]); sum += c; cnt += (c > 0u) ? 1u : 0u; mine = (j == x) ? c : mine; }
        if (sum == G) break;
        __builtin_amdgcn_s_sleep(1);
        if ((++sp & 255u) == 0u) { if (xb_ld(&bar[XB_TMO])) break; if (sp > XB_SPIN_CAP) { atomicAdd(&bar[XB_TMO], 1u); break; } }
    }
    nloc = mine > 0u ? mine : 1u; nx = cnt > 0u ? cnt : 1u;
}

__device__ __forceinline__ void xcd_barrier(const XcdBarrier& b) {
    asm volatile("s_waitcnt vmcnt(0)" ::: "memory");
    __syncthreads();
    if (threadIdx.x == 0) {
        unsigned* bar = b.bar;
        __builtin_amdgcn_s_waitcnt(0);
        unsigned nloc = b.st[0], nx = b.st[1];
        if (nloc == 0u) { xcd_barrier_complete(bar, b.x, nloc, nx); b.st[0] = nloc; b.st[1] = nx; }
        const unsigned old = xb_add(&bar[XB_XSUB(b.x)], 1u);
        const unsigned gen = old / nloc;
        if (old + 1u == (gen + 1u) * nloc) {
            __builtin_amdgcn_fence(__ATOMIC_RELEASE, "agent");
            asm volatile("s_waitcnt vmcnt(0)" ::: "memory");
            const unsigned og = xb_add(&bar[XB_TOP], 1u);
            const unsigned tg = og / nx;
            if (og + 1u == (tg + 1u) * nx) xb_add(&bar[XB_TOPGEN], 1u);
            else XB_SPIN(xb_ld(&bar[XB_TOPGEN]) == tg, bar);
            __builtin_amdgcn_fence(__ATOMIC_ACQUIRE, "agent");
            xb_add(&bar[XB_XGEN(b.x)], 1u);
            asm volatile("s_waitcnt vmcnt(0)" ::: "memory");
        } else {
            XB_SPIN(xb_ld(&bar[XB_XGEN(b.x)]) == gen, bar);
            __builtin_amdgcn_fence(__ATOMIC_ACQUIRE, "agent");
            asm volatile("s_waitcnt vmcnt(0)" ::: "memory");
        }
    }
    __syncthreads();
}
struct Args { const float* in[24]; float* out; unsigned char* ws; int ph_lo, ph_hi; };
struct Frame {
    LAS unsigned char* lds; volatile LAS unsigned* MISC; gu32* ctl;
    int tid, lane, wave, vcu, G;
    unsigned char* ws; float* out;
};
#define WSP(T, off) ((T*)(F.ws + (off)))
#define LDS_WAIT() asm volatile("s_waitcnt lgkmcnt(0)" ::: "memory")

__device__ __forceinline__ void transpose_item(const float* W, int ldw, int K, bf16* WT, LAS float* scr, int k0, int nsrc0, int ndst0, int lane) {
#pragma unroll 8
    for (int i = 0; i < 32; ++i) { const int kk = 2 * i + (lane >> 5); scr[kk * 33 + (lane & 31)] = W[(size_t)(k0 + kk) * ldw + nsrc0 + (lane & 31)]; }
    LDS_WAIT(); asm volatile("" ::: "memory");
    const int c = lane & 7;
#pragma unroll
    for (int j = 0; j < 4; ++j) { const int n = (lane >> 3) + 8 * j; const LAS float* s = scr + (8 * c) * 33 + n;
        v4u o; o.x = pk2(s[0 * 33], s[1 * 33]); o.y = pk2(s[2 * 33], s[3 * 33]); o.z = pk2(s[4 * 33], s[5 * 33]); o.w = pk2(s[6 * 33], s[7 * 33]);
        *(GAS v4u*)(WT + (size_t)(ndst0 + n) * K + k0 + 8 * c) = o; }
    LDS_WAIT(); asm volatile("" ::: "memory");
}
__device__ __forceinline__ void cvt_stream(const float* src, bf16* dst, size_t n8, size_t i0, size_t stride) {
    for (size_t i = i0; i < n8; i += stride) { const f32x4 a = ((const GAS f32x4*)src)[2 * i], b = ((const GAS f32x4*)src)[2 * i + 1];
        v4u o; o.x = pk2(a[0], a[1]); o.y = pk2(a[2], a[3]); o.z = pk2(b[0], b[1]); o.w = pk2(b[2], b[3]); ((GAS v4u*)dst)[i] = o; }
}
__device__ __forceinline__ void cvt_stream_fp8(const float* src, unsigned char* dst, size_t n16, float scale, size_t i0, size_t stride) {
    for (size_t i = i0; i < n16; i += stride) { v4u o;
#pragma unroll
        for (int q = 0; q < 4; ++q) { const f32x4 a = ((const GAS f32x4*)src)[4 * i + q] * scale; int w = 0;
            w = __builtin_amdgcn_cvt_pk_fp8_f32(a[0], a[1], w, false); w = __builtin_amdgcn_cvt_pk_fp8_f32(a[2], a[3], w, true); o[q] = (unsigned)w; }
        ((GAS v4u*)dst)[i] = o; }
}
__device__ __forceinline__ void p0_prologue(Frame& F, const Args& args) {
    { LAS float* sc = (LAS float*)F.lds; LAS f32x4* red = (LAS f32x4*)(F.lds + 16384); float* MOD = WSP(float, WS_MOD);
      for (int cgi = blockIdx.x; cgi < 256; cgi += F.G) {
          for (int i = F.tid; i < DM; i += NTHREADS) { const float cv = args.in[1][i]; sc[i] = cv / (1.0f + __expf(-cv)); }
          __syncthreads();
          if (F.tid < 384) { const int cg = F.tid % 24, rg = F.tid / 24;
              const GAS f32x4* Wp = (const GAS f32x4*)args.in[2] + cgi * 24 + cg;
              f32x4 acc = {0.f, 0.f, 0.f, 0.f};
#pragma unroll 8
              for (int r = rg; r < DM; r += 16) acc += sc[r] * Wp[(size_t)r * 6144];
              red[rg * 24 + cg] = acc; }
          __syncthreads();
          if (F.tid < 24) { f32x4 s = red[F.tid];
#pragma unroll
              for (int rg = 1; rg < 16; ++rg) s += red[rg * 24 + F.tid];
              s += ((const GAS f32x4*)args.in[3])[cgi * 24 + F.tid]; ((GAS f32x4*)MOD)[cgi * 24 + F.tid] = s; }
          __syncthreads();
      } }
    LAS float* scr = (LAS float*)(F.lds + F.wave * 16384);
    const int gw = F.vcu * NWAVES + F.wave, NGW = F.G * NWAVES;
    constexpr int I_IN = 64 * 576, I_AO = 32 * 128, I_LO = 32 * 128, I_OUT = 64 * 128, I_PQ = 64 * 64, I_WA = 16 * 2 * 4, I_WX = I_WA;
    constexpr int NITEMS = I_IN + I_AO + I_LO + I_OUT + I_PQ + I_WA + I_WX;
    for (int it = gw; it < NITEMS; it += NGW) {
        int r = it;
        if (r < I_IN) { const int kb = r / 576, nb = r % 576; transpose_item(args.in[6], NIN, DM, WSP(bf16, WS_WIN), scr, 64 * kb, 32 * nb + (nb >= 192 ? 16 : 0), 32 * nb, F.lane); continue; } r -= I_IN;
        if (r < I_AO) { const int kb = r / 128, nb = r % 128; transpose_item(args.in[17], DM, AW, WSP(bf16, WS_WAO), scr, 64 * kb, 32 * nb, 32 * nb, F.lane); continue; } r -= I_AO;
        if (r < I_LO) { const int kb = r / 128, nb = r % 128; transpose_item(args.in[18], DM, LW, WSP(bf16, WS_WLO), scr, 64 * kb, 32 * nb, 32 * nb, F.lane); continue; } r -= I_LO;
        if (r < I_OUT) { const int kb = r / 128, nb = r % 128; transpose_item(args.in[19], DM, DM, WSP(bf16, WS_WOUT), scr, 64 * kb, 32 * nb, 32 * nb, F.lane); continue; } r -= I_OUT;
        if (r < I_PQ) { const int kb = r / 64, nb = r % 64; transpose_item(args.in[20], 2048, DM, WSP(bf16, WS_WPQ), scr, 64 * kb, 32 * nb, 32 * nb, F.lane); continue; } r -= I_PQ;
        { const bool isx = r >= I_WA; if (isx) r -= I_WA; const int g = r >> 3, kb = (r >> 2) & 1, nb = r & 3;
          transpose_item((isx ? args.in[14] : args.in[12]) + (size_t)g * GD * GD, GD, GD, WSP(bf16, isx ? WS_WXT : WS_WAT) + (size_t)g * GD * GD, scr, 64 * kb, 32 * nb, 32 * nb, F.lane); }
    }
    const size_t gt = (size_t)F.vcu * NTHREADS + F.tid, NGT = (size_t)F.G * NTHREADS;
    cvt_stream_fp8(args.in[22], WSP(unsigned char, WS_U), (size_t)PEER_NE * DM / 16, 256.0f, gt, NGT);
    cvt_stream_fp8(args.in[23], WSP(unsigned char, WS_V), (size_t)PEER_NE * DM / 16, 8.0f, gt, NGT);
    cvt_stream(args.in[21], WSP(bf16, WS_SK), (size_t)PEER_H * 2 * 128 * 128 / 8, gt, NGT);
    for (size_t i = gt; i < (size_t)DM * 16; i += NGT) WSP(float, WS_WF)[i] = args.in[6][(i >> 4) * NIN + C_F + (i & 15)];
    for (size_t i = gt; i < (size_t)NINP; i += NGT) WSP(float, WS_BIASR)[i] = args.in[7][i + (i >= (size_t)C_F ? 16 : 0)];
}

__device__ __forceinline__ void p1_norm_forget(Frame& F, const Args& args) {
    const int gw = F.vcu * NWAVES + F.wave, NGW = F.G * NWAVES; const float* MOD = WSP(float, WS_MOD); const float* WF = WSP(float, WS_WF); bf16* HA = WSP(bf16, WS_HA);
    for (int rg = gw; rg < S / 4; rg += NGW) {
        const int r0 = rg * 4; float rstd[4];
#pragma unroll
        for (int r = 0; r < 4; ++r) { const GAS f32x4* xr = (const GAS f32x4*)(args.in[0] + (size_t)(r0 + r) * DM) + F.lane; float ss = 0.f;
#pragma unroll
            for (int j = 0; j < 16; ++j) { const f32x4 v = xr[64 * j]; ss += (v[0] * v[0] + v[1] * v[1]) + (v[2] * v[2] + v[3] * v[3]); }
            rstd[r] = 1.0f / sqrtf(wave_sum(ss) * (1.0f / DM) + EPS); }
        float acc[4][16];
#pragma unroll
        for (int r = 0; r < 4; ++r)
#pragma unroll
            for (int cc = 0; cc < 16; ++cc) acc[r][cc] = 0.f;
        for (int j = 0; j < 16; ++j) {
            const int i4 = F.lane + 64 * j;
            const f32x4 g = ((const GAS f32x4*)args.in[4])[i4], scl = ((const GAS f32x4*)(MOD + 4096))[i4], sh = ((const GAS f32x4*)MOD)[i4];
            const f32x4 mul = g * (scl + 1.0f);
            f32x4 wf[4][4];
#pragma unroll
            for (int i = 0; i < 4; ++i)
#pragma unroll
                for (int q = 0; q < 4; ++q) wf[i][q] = ((const GAS f32x4*)(WF + (size_t)(4 * i4 + i) * 16))[q];
#pragma unroll
            for (int r = 0; r < 4; ++r) {
                const f32x4 xv = ((const GAS f32x4*)(args.in[0] + (size_t)(r0 + r) * DM))[i4];
                const f32x4 hv = xv * rstd[r] * mul + sh;
                v2u o; o.x = pk2(hv[0], hv[1]); o.y = pk2(hv[2], hv[3]);
                ((GAS v2u*)(HA + (size_t)(r0 + r) * DM))[i4] = o;
#pragma unroll
                for (int i = 0; i < 4; ++i)
#pragma unroll
                    for (int q = 0; q < 4; ++q)
#pragma unroll
                        for (int e = 0; e < 4; ++e) acc[r][4 * q + e] += hv[i] * wf[i][q][e];
            }
        }
#pragma unroll
        for (int r = 0; r < 4; ++r)
#pragma unroll
            for (int cc = 0; cc < 16; ++cc) { const float tot = wave_sum(acc[r][cc]);
                if (F.lane == cc) { const float f = tot + args.in[7][C_F + cc]; WSP(float, WS_LOGF)[(size_t)(r0 + r) * 16 + cc] = fminf(f, 0.f) - log1pf(__expf(-fabsf(f))); } }
    }
}

__device__ __forceinline__ void p3_qknorm(Frame& F, const Args& args) {
    const int gw = F.vcu * NWAVES + F.wave, NGW = F.G * NWAVES; bf16* QK = WSP(bf16, WS_QKV);
    const int sub = F.lane & 15;
    f32x4 gq0 = ((const GAS f32x4*)args.in[8])[2 * sub], gq1 = ((const GAS f32x4*)args.in[8])[2 * sub + 1], gk0 = ((const GAS f32x4*)args.in[9])[2 * sub], gk1 = ((const GAS f32x4*)args.in[9])[2 * sub + 1];
    for (int it = gw; it < 2 * S * NH / 4; it += NGW) {
        const size_t unit = (size_t)it * 4 + (F.lane >> 4); const bool isk = unit >= (size_t)S * NH;
        GAS v4u* p = (GAS v4u*)(QK + unit * 128) + sub; const v4u w = *p;
        f32x4 a = {bflo(w.x), bfhi(w.x), bflo(w.y), bfhi(w.y)}, b = {bflo(w.z), bfhi(w.z), bflo(w.w), bfhi(w.w)};
        float ss = (a[0] * a[0] + a[1] * a[1]) + (a[2] * a[2] + a[3] * a[3]) + (b[0] * b[0] + b[1] * b[1]) + (b[2] * b[2] + b[3] * b[3]);
        ss += __shfl_xor(ss, 1); ss += __shfl_xor(ss, 2); ss += __shfl_xor(ss, 4); ss += __shfl_xor(ss, 8);
        const float rs = 1.0f / sqrtf(ss * (1.0f / HD) + EPS);
        a = a * rs * (isk ? gk0 : gq0); b = b * rs * (isk ? gk1 : gq1);
        v4u o; o.x = pk2(a[0], a[1]); o.y = pk2(a[2], a[3]); o.z = pk2(b[0], b[1]); o.w = pk2(b[2], b[3]); *p = o;
    }
}
__device__ __forceinline__ void p3_cumsum(Frame& F, const Args& args) {
    LAS float* wt = (LAS float*)F.lds;
    for (int h = blockIdx.x; h < NH; h += F.G) {
        const float* LF = WSP(float, WS_LOGF); float v[16]; float run = 0.f;
#pragma unroll
        for (int i = 0; i < 16; ++i) { run += LF[(size_t)(F.tid * 16 + i) * 16 + h]; v[i] = run; }
        float sc = run;
#pragma unroll
        for (int o = 1; o < 64; o <<= 1) { const float t = __shfl_up(sc, o); if (F.lane >= o) sc += t; }
        if (F.lane == 63) wt[F.wave] = sc;
        __syncthreads();
        float pre = sc - run;
        for (int w = 0; w < F.wave; ++w) pre += wt[w];
        float* Fo = WSP(float, WS_FC) + (size_t)h * S + F.tid * 16;
#pragma unroll
        for (int i = 0; i < 4; ++i) ((GAS f32x4*)Fo)[i] = (f32x4){v[4 * i] + pre, v[4 * i + 1] + pre, v[4 * i + 2] + pre, v[4 * i + 3] + pre};
        __syncthreads();
    }
}
constexpr int LRU_XCF = 0, LRU_XCB = 32768, LRU_AB = 49152, LRU_BB = 81920, LRU_QA = 114688, LRU_CAR = 118784;
template <int PASS> __device__ __forceinline__ void lru_unit(Frame& F, const Args& args, int c, int g) {
    LAS float* XCF = (LAS float*)(F.lds + LRU_XCF); LAS unsigned char* XCB = F.lds + LRU_XCB; LAS float* AB = (LAS float*)(F.lds + LRU_AB); LAS float* BB = (LAS float*)(F.lds + LRU_BB);
    LAS float* QA = (LAS float*)(F.lds + LRU_QA); LAS float* CAR = (LAS float*)(F.lds + LRU_CAR);
    const int t0 = 64 * c, ch0 = GD * g; const bf16* LX = WSP(bf16, WS_LX);
    { const int ch = F.tid & 127, tq = F.tid >> 7, gch = ch0 + ch;
      const float w0 = args.in[10][gch], w1 = args.in[10][LW + gch], w2 = args.in[10][2 * LW + gch], w3 = args.in[10][3 * LW + gch], cb = args.in[11][gch];
      float xm3, xm2, xm1; { const int tb = t0 + 16 * tq;
          xm3 = tb - 3 >= 0 ? bf2f(LX[(size_t)(tb - 3) * LW + gch]) : 0.f; xm2 = tb - 2 >= 0 ? bf2f(LX[(size_t)(tb - 2) * LW + gch]) : 0.f; xm1 = tb - 1 >= 0 ? bf2f(LX[(size_t)(tb - 1) * LW + gch]) : 0.f; }
#pragma unroll
      for (int i = 0; i < 16; ++i) { const int t = 16 * tq + i; const float x0 = bf2f(LX[(size_t)(t0 + t) * LW + gch]);
          const float xc = w0 * xm3 + w1 * xm2 + w2 * xm1 + w3 * x0 + cb; xm3 = xm2; xm2 = xm1; xm1 = x0;
          XCF[t * 128 + ch] = xc; *(LAS bf16*)(XCB + t * 256 + ((ch * 2) ^ ((t & 7) << 4))) = (bf16)f2bf(xc); } }
    __syncthreads();
    { const int fr = F.lane & 15, fq = F.lane >> 4, j = 16 * F.wave + fr;
      const bf16* WA = WSP(bf16, WS_WAT) + (size_t)g * GD * GD + (size_t)j * GD + 8 * fq; const bf16* WX = WSP(bf16, WS_WXT) + (size_t)g * GD * GD + (size_t)j * GD + 8 * fq;
      bf16x8 ba[4], bx[4];
#pragma unroll
      for (int ks = 0; ks < 4; ++ks) { ba[ks] = *(const GAS bf16x8*)(WA + 32 * ks); bx[ks] = *(const GAS bf16x8*)(WX + 32 * ks); }
      const int gch = ch0 + j; const float bav = args.in[13][gch], bxv = args.in[15][gch], lam = args.in[16][gch];
      const float sp = (lam > 0.f ? 0.f : -lam) + log1pf(__expf(-fabsf(lam)));
#pragma unroll
      for (int mt = 0; mt < 4; ++mt) { f32x4 ar = {0.f, 0.f, 0.f, 0.f}, ax = {0.f, 0.f, 0.f, 0.f}; const int t = 16 * mt + fr;
#pragma unroll
          for (int ks = 0; ks < 4; ++ks) { const bf16x8 af = *(const LAS bf16x8*)(XCB + t * 256 + (((32 * ks + 8 * fq) * 2) ^ ((t & 7) << 4)));
              ar = __builtin_amdgcn_mfma_f32_16x16x32_bf16(af, ba[ks], ar, 0, 0, 0); ax = __builtin_amdgcn_mfma_f32_16x16x32_bf16(af, bx[ks], ax, 0, 0, 0); }
#pragma unroll
          for (int rg = 0; rg < 4; ++rg) { const int tt = 16 * mt + 4 * fq + rg; const float xcv = XCF[tt * 128 + j];
              const float rgt = sigmoidf_(ar[rg] + bav), igt = sigmoidf_(ax[rg] + bxv);
              const float log_a = -8.0f * rgt * sp; const float a = __expf(log_a); const float b = sqrtf(-expm1f(2.0f * log_a)) * (igt * xcv);
              AB[tt * 128 + j] = a; BB[tt * 128 + j] = b; } } }
    __syncthreads();
    const int ch = F.tid & 127, q = F.tid >> 7;
    { float A = 1.f, B = 0.f;
#pragma unroll
      for (int i = 0; i < 16; ++i) { const int t = 16 * q + i; const float a = AB[t * 128 + ch]; B = a * B + BB[t * 128 + ch]; A *= a; }
      QA[(q * 128 + ch) * 2] = A; QA[(q * 128 + ch) * 2 + 1] = B; }
    if (PASS == 1 && F.tid < 128) {
        const float* GA_ = WSP(float, WS_AGGA) + ch0 + F.tid; const float* GB_ = WSP(float, WS_AGGB) + ch0 + F.tid; float hcar = 0.f;
        for (int cc = 0; cc < c; ++cc) hcar = GA_[(size_t)cc * LW] * hcar + GB_[(size_t)cc * LW];
        CAR[F.tid] = hcar; }
    __syncthreads();
    if (PASS == 0) {
        if (F.tid < 128) { float A = 1.f, B = 0.f;
#pragma unroll
            for (int qq = 0; qq < 4; ++qq) { const float a = QA[(qq * 128 + F.tid) * 2], b = QA[(qq * 128 + F.tid) * 2 + 1]; B = a * B + b; A *= a; }
            WSP(float, WS_AGGA)[(size_t)c * LW + ch0 + F.tid] = A; WSP(float, WS_AGGB)[(size_t)c * LW + ch0 + F.tid] = B; }
    } else {
        float h = CAR[ch];
        for (int qq = 0; qq < q; ++qq) h = QA[(qq * 128 + ch) * 2] * h + QA[(qq * 128 + ch) * 2 + 1];
        const bf16* GY = WSP(bf16, WS_GY); bf16* LR = WSP(bf16, WS_LR);
#pragma unroll
        for (int i = 0; i < 16; ++i) { const int t = 16 * q + i; h = AB[t * 128 + ch] * h + BB[t * 128 + ch];
            const size_t o = (size_t)(t0 + t) * LW + ch0 + ch; LR[o] = (bf16)f2bf(h * bf2f(GY[o])); }
    }
    __syncthreads();
}
constexpr int ATT_BIAS_OFF = attn_body::LDS_BYTES;
typedef attn_body::BlockRef<bf16, bf16> ARef;
__device__ __forceinline__ int attn_jlo(const float* Fh, int qb, float TH, int lane) {
    const int t0 = qb * 256; const float f0 = Fh[t0];
    const int j0 = lane, j1 = lane + 64;
    const bool ok0 = (64 * j0 + 63 >= t0) || (f0 - Fh[64 * j0 + 63] >= -TH), ok1 = (64 * j1 + 63 >= t0) || (f0 - Fh[64 * j1 + 63] >= -TH);
    const unsigned long long m0 = __ballot(ok0), m1 = __ballot(ok1);
    return m0 ? (int)__builtin_ctzll(m0) : 64 + (int)__builtin_ctzll(m1);
}
__device__ __forceinline__ ARef attn_ref(Frame& F, const Args& args, int h, int qb, int jlo) {
    ARef r; const bf16* QK = WSP(bf16, WS_QKV);
    r.Q = QK + (size_t)(qb * 256) * AW + h * HD; r.K = QK + (size_t)S * AW + h * HD; r.V = QK + 2 * (size_t)S * AW + h * HD;
    r.O = WSP(bf16, WS_ATT) + (size_t)(qb * 256) * AW + h * HD; r.P0 = qb * 256; r.jlo = jlo; return r;
}
__device__ __forceinline__ void attn_fill_bias(Frame& F, const Args& args, int h, int qb, int jlo) {
    const float* Fh = WSP(float, WS_FC) + (size_t)h * S; LAS float* bl = (LAS float*)(F.lds + ATT_BIAS_OFF);
    const int k0 = jlo * 64, n = (qb + 1) * 256 - k0; const float fr = Fh[k0];
#pragma unroll 1
    for (int i = F.tid; i < n; i += NTHREADS) bl[i] = (fr - Fh[k0 + i]) * (1.0f / attn_body::SCALE);
}
#ifndef ATT_WINDOW
#define ATT_WINDOW 1
#endif
__device__ __forceinline__ void p4_attention(Frame& F, const Args& args, char* lds_generic) {
    float gq = fmaxf(fabsf(args.in[8][F.lane]), fabsf(args.in[8][F.lane + 64])), gk = fmaxf(fabsf(args.in[9][F.lane]), fabsf(args.in[9][F.lane + 64]));
    gq = wave_max(gq); gk = wave_max(gk);
    const float TH = 2.0f * (128.0f * gq * gk * attn_body::SCALE) + 40.0f;
    for (int L = blockIdx.x; L < NH * 16; L += F.G) {
        const int h = L >> 4, x = L & 15, qb0 = x, qb1 = 31 - x; const float* Fh = WSP(float, WS_FC) + (size_t)h * S;
        const int jl0 = ATT_WINDOW ? attn_jlo(Fh, qb0, TH, F.lane) : 0, jl1 = ATT_WINDOW ? attn_jlo(Fh, qb1, TH, F.lane) : 0;
        const ARef r0 = attn_ref(F, args, h, qb0, jl0), r1 = attn_ref(F, args, h, qb1, jl1);
        attn_fill_bias(F, args, h, qb0, jl0); __syncthreads();
        attn_body::attn_unit<bf16, bf16>(r0, S, lds_generic);
        attn_fill_bias(F, args, h, qb1, jl1); __syncthreads();
        attn_body::attn_unit<bf16, bf16>(r1, S, lds_generic);
        asm volatile("s_waitcnt vmcnt(0)" ::: "memory"); __syncthreads();
    }
}

__device__ __forceinline__ void p7_norm2(Frame& F, const Args& args) {
    const int gw = F.vcu * NWAVES + F.wave, NGW = F.G * NWAVES; const float* MOD = WSP(float, WS_MOD); bf16* HA = WSP(bf16, WS_HA);
    for (int m = gw; m < S; m += NGW) {
        const GAS f32x4* xr = (const GAS f32x4*)(WSP(float, WS_X1) + (size_t)m * DM) + F.lane; f32x4 v[16]; float ss = 0.f;
#pragma unroll
        for (int j = 0; j < 16; ++j) { v[j] = xr[64 * j]; ss += (v[j][0] * v[j][0] + v[j][1] * v[j][1]) + (v[j][2] * v[j][2] + v[j][3] * v[j][3]); }
        const float rstd = 1.0f / sqrtf(wave_sum(ss) * (1.0f / DM) + EPS);
#pragma unroll
        for (int j = 0; j < 16; ++j) { const int i4 = F.lane + 64 * j;
            const f32x4 g = ((const GAS f32x4*)args.in[5])[i4], scl = ((const GAS f32x4*)(MOD + 16384))[i4], sh = ((const GAS f32x4*)(MOD + 12288))[i4];
            const f32x4 hv = v[j] * rstd * (g * (scl + 1.0f)) + sh;
            v2u o; o.x = pk2(hv[0], hv[1]); o.y = pk2(hv[2], hv[3]); ((GAS v2u*)(HA + (size_t)m * DM))[i4] = o; }
    }
}

template <int CTRL> __device__ __forceinline__ unsigned dppu(unsigned x) { return (unsigned)__builtin_amdgcn_update_dpp(0, (int)x, CTRL, 0xF, 0xF, true); }
__device__ __forceinline__ unsigned rowmax_u32(unsigned x) { x = max(x, dppu<0xB1>(x)); x = max(x, dppu<0x4E>(x)); x = max(x, dppu<0x141>(x)); x = max(x, dppu<0x140>(x)); return x; }
__device__ __forceinline__ float rowsum_f32(float x) { x += __uint_as_float(dppu<0xB1>(__float_as_uint(x))); x += __uint_as_float(dppu<0x4E>(__float_as_uint(x)));
    x += __uint_as_float(dppu<0x141>(__float_as_uint(x))); x += __uint_as_float(dppu<0x140>(__float_as_uint(x))); return x; }
__device__ __forceinline__ unsigned ordk(float f) { const unsigned u = __float_as_uint(f); return u ^ ((unsigned)((int)u >> 31) | 0x80000000u); }
__device__ __forceinline__ float deck(unsigned k) { return __uint_as_float((k & 0x80000000u) ? (k ^ 0x80000000u) : ~k); }
#define CE_(x, y) do { const unsigned hi_ = max(x, y), lo_ = min(x, y); x = hi_; y = lo_; } while (0)
__device__ __forceinline__ unsigned row_pop16(unsigned (&a)[8], int i) {
    unsigned res = 0u;
#pragma unroll
    for (int r = 0; r < 16; ++r) { const unsigned m = rowmax_u32(a[0]); const bool win = a[0] == m;
#pragma unroll
        for (int s = 0; s < 7; ++s) a[s] = win ? a[s + 1] : a[s];
        a[7] = win ? 0u : a[7]; res = (i == r) ? m : res; }
    return res;
}
__device__ __forceinline__ void p9_topk(Frame& F, const Args& args) {
    const bf16* Q2 = WSP(bf16, WS_Q2); const bf16* SK = WSP(bf16, WS_SK); int* IDX = WSP(int, WS_IDX); float* GATE = WSP(float, WS_GATE);
    const int gw = F.vcu * NWAVES + F.wave, NGW = F.G * NWAVES; const int i = F.lane & 15, q = F.lane >> 4;
    const unsigned qlo = (unsigned)(i * 2048 + 8 * q) * 2u, klo = (unsigned)(i * 128 + 8 * q) * 2u;
#pragma unroll 1
    for (int u = gw; u < (S / 16) * PEER_H; u += NGW) {
        const int t0 = 16 * (u >> 3), h = u & 7;
        unsigned R[2][4];
#pragma unroll
        for (int p = 0; p < 2; ++p) {
            bf16x8 af[4];
            const char* qb_ = (const char*)Q2 + ((size_t)t0 * 2048 + h * 256 + p * 128) * 2;
            const char* kb_ = (const char*)SK + (size_t)((h * 2 + p) * 128) * 256;
#pragma unroll
            for (int ks = 0; ks < 4; ++ks) af[ks] = *(const GAS bf16x8*)(qb_ + 64 * ks + qlo);
            f32x4 acc[8]; bf16x8 bc[4], bn[4];
#pragma unroll
            for (int ks = 0; ks < 4; ++ks) bc[ks] = *(const GAS bf16x8*)(kb_ + 64 * ks + klo);
#pragma unroll
            for (int nt = 0; nt < 8; ++nt) { acc[nt] = (f32x4){0.f, 0.f, 0.f, 0.f};
                if (nt < 7) {
#pragma unroll
                    for (int ks = 0; ks < 4; ++ks) bn[ks] = *(const GAS bf16x8*)(kb_ + 4096 * (nt + 1) + 64 * ks + klo); }
#pragma unroll
                for (int ks = 0; ks < 4; ++ks) acc[nt] = __builtin_amdgcn_mfma_f32_16x16x32_bf16(af[ks], bc[ks], acc[nt], 0, 0, 0);
#pragma unroll
                for (int ks = 0; ks < 4; ++ks) bc[ks] = bn[ks];
                __builtin_amdgcn_sched_barrier(0); }
#pragma unroll
            for (int r = 0; r < 4; ++r) { unsigned a[8];
#pragma unroll
                for (int nt = 0; nt < 8; ++nt) a[nt] = (ordk(acc[nt][r]) & ~0x7Fu) | (unsigned)(16 * nt + i);
                CE_(a[0], a[1]); CE_(a[2], a[3]); CE_(a[4], a[5]); CE_(a[6], a[7]); CE_(a[0], a[2]); CE_(a[1], a[3]); CE_(a[4], a[6]); CE_(a[5], a[7]); CE_(a[1], a[2]); CE_(a[5], a[6]);
                CE_(a[0], a[4]); CE_(a[1], a[5]); CE_(a[2], a[6]); CE_(a[3], a[7]); CE_(a[2], a[4]); CE_(a[3], a[5]); CE_(a[1], a[2]); CE_(a[3], a[4]); CE_(a[5], a[6]);
                R[p][r] = row_pop16(a, i); __builtin_amdgcn_sched_barrier(0); }
        }
#pragma unroll
        for (int r = 0; r < 4; ++r) {
            const unsigned R0 = R[0][r], R1 = R[1][r]; const float f0 = deck(R0 & ~0x7Fu), f1 = deck(R1 & ~0x7Fu); const int n0 = (int)(R0 & 0x7Fu), n1 = (int)(R1 & 0x7Fu);
            const unsigned f1u = __float_as_uint(f1); unsigned c[8];
#define CAND_(b, lim) do { const unsigned t_ = (ordk(f0 + __uint_as_float(dppu<0x150 + (b)>(f1u))) & ~0xFFu) | (unsigned)(255 - (i * 16 + (b))); c[b] = (i < (lim)) ? t_ : 0u; } while (0)
            CAND_(0, 16); CAND_(1, 8); CAND_(2, 5); CAND_(3, 4); CAND_(4, 3); CAND_(5, 2); CAND_(6, 2); CAND_(7, 2);
#undef CAND_
            { const float ex = __uint_as_float(dppu<0x150>(__float_as_uint(f0))) + f1; const unsigned exk = (ordk(ex) & ~0xFFu) | (unsigned)(255 - i); c[1] = (i >= 8) ? exk : c[1]; }
            CE_(c[0], c[1]);
            const unsigned G = row_pop16(c, i);
            const float val = deck(G & ~0xFFu); const int id = 255 - (int)(G & 0xFFu); const int rb = F.lane & 48;
            const int ea = __shfl(n0, rb + (id >> 4)), eb = __shfl(n1, rb + (id & 15));
            const float mx = __uint_as_float(dppu<0x150>(__float_as_uint(val))); const float ex = __expf(val - mx); const float sm = rowsum_f32(ex);
            const size_t o = (size_t)(t0 + 4 * q + r) * 128 + h * 16 + i; IDX[o] = ea * 128 + eb; GATE[o] = ex / sm; __builtin_amdgcn_sched_barrier(0);
        }
    }
}
#undef CE_

constexpr float U_SCALE = 256.0f, V_SCALE = 8.0f;
__device__ __forceinline__ float gelu_as(float v) {
    const float av = fabsf(v), tt = __builtin_amdgcn_rcpf(av * 0.2316418882f + 1.0f);
    float q = tt * 0.5307027145f + (-0.7265760135f); q = q * tt + 0.7107068705f; q = q * tt + (-0.142248368f); q = q * tt + 0.127414796f; q = q * tt;
    const float m = v * (q * __builtin_amdgcn_exp2f((v * v) * (-0.72134752044f)));
    return v < 0.f ? m : v - m;
}
#define DOT4(w, h4) do { const f32x2 lo_ = __builtin_amdgcn_cvt_pk_f32_fp8((int)(w), false), hi_ = __builtin_amdgcn_cvt_pk_f32_fp8((int)(w), true); \
        sacc += (lo_.x * (h4)[0] + lo_.y * (h4)[1]) + (hi_.x * (h4)[2] + hi_.y * (h4)[3]); } while (0)
#define AXPY4(w, sc_, a4) do { const f32x2 lo_ = __builtin_amdgcn_cvt_pk_f32_fp8((int)(w), false), hi_ = __builtin_amdgcn_cvt_pk_f32_fp8((int)(w), true); \
        (a4)[0] += (sc_) * lo_.x; (a4)[1] += (sc_) * lo_.y; (a4)[2] += (sc_) * hi_.x; (a4)[3] += (sc_) * hi_.y; } while (0)
__device__ __forceinline__ void p10_peer(Frame& F, const Args& args) {
    const int gw = F.vcu * NWAVES + F.wave, NGW = F.G * NWAVES; const float* MOD = WSP(float, WS_MOD);
    const bf16* H2 = WSP(bf16, WS_HA); const unsigned char* U = WSP(unsigned char, WS_U); const unsigned char* V = WSP(unsigned char, WS_V); const int* IDX = WSP(int, WS_IDX); const float* GATE = WSP(float, WS_GATE);
#pragma unroll 1
    for (int t = gw; t < S; t += NGW) {
        const int id0 = IDX[(size_t)t * 128 + F.lane], id1 = IDX[(size_t)t * 128 + 64 + F.lane];
        const float g0 = GATE[(size_t)t * 128 + F.lane], g1 = GATE[(size_t)t * 128 + 64 + F.lane];
        float w0 = 0.f, w1 = 0.f;
        {   f32x4 hx[16];
#pragma unroll
            for (int c = 0; c < 4; ++c) { const GAS v4u* hp = (const GAS v4u*)(H2 + (size_t)t * DM + c * 1024 + F.lane * 16); const v4u a = hp[0], b = hp[1];
                hx[4 * c + 0] = (f32x4){bflo(a[0]), bfhi(a[0]), bflo(a[1]), bfhi(a[1])}; hx[4 * c + 1] = (f32x4){bflo(a[2]), bfhi(a[2]), bflo(a[3]), bfhi(a[3])};
                hx[4 * c + 2] = (f32x4){bflo(b[0]), bfhi(b[0]), bflo(b[1]), bfhi(b[1])}; hx[4 * c + 3] = (f32x4){bflo(b[2]), bfhi(b[2]), bflo(b[3]), bfhi(b[3])}; }
#pragma unroll 1
            for (int e = 0; e < 128; e += 2) {
                const int ea = __builtin_amdgcn_readlane(e < 64 ? id0 : id1, e & 63), eb = __builtin_amdgcn_readlane(e < 64 ? id0 : id1, (e + 1) & 63);
                const GAS v4u* ua = (const GAS v4u*)(U + (size_t)ea * DM) + F.lane; const GAS v4u* ub = (const GAS v4u*)(U + (size_t)eb * DM) + F.lane;
                v4u ra[4], rb[4];
#pragma unroll
                for (int c = 0; c < 4; ++c) { ra[c] = ua[64 * c]; rb[c] = ub[64 * c]; }
                float sa, sb;
                { float sacc = 0.f;
#pragma unroll
                  for (int c = 0; c < 4; ++c)
#pragma unroll
                      for (int k = 0; k < 4; ++k) DOT4(ra[c][k], hx[4 * c + k]);
                  sa = sacc; }
                { float sacc = 0.f;
#pragma unroll
                  for (int c = 0; c < 4; ++c)
#pragma unroll
                      for (int k = 0; k < 4; ++k) DOT4(rb[c][k], hx[4 * c + k]);
                  sb = sacc; }
                sa = wave_sum(sa); sb = wave_sum(sb);
                const float aa = gelu_as(sa * (1.0f / U_SCALE)) * (1.0f / V_SCALE), ab = gelu_as(sb * (1.0f / U_SCALE)) * (1.0f / V_SCALE);
                if (e < 64) { if (F.lane == e) w0 = aa * g0; if (F.lane == e + 1) w0 = ab * g0; } else { if (F.lane == e - 64) w1 = aa * g1; if (F.lane == e - 63) w1 = ab * g1; }
            } }
        f32x4 acc[16];
#pragma unroll
        for (int i = 0; i < 16; ++i) acc[i] = (f32x4){0.f, 0.f, 0.f, 0.f};
#pragma unroll 1
        for (int e = 0; e < 128; e += 2) {
            const int ea = __builtin_amdgcn_readlane(e < 64 ? id0 : id1, e & 63), eb = __builtin_amdgcn_readlane(e < 64 ? id0 : id1, (e + 1) & 63);
            const float wa = __uint_as_float(__builtin_amdgcn_readlane(__float_as_uint(e < 64 ? w0 : w1), e & 63)), wb = __uint_as_float(__builtin_amdgcn_readlane(__float_as_uint(e < 64 ? w0 : w1), (e + 1) & 63));
            const GAS v4u* va = (const GAS v4u*)(V + (size_t)ea * DM) + F.lane; const GAS v4u* vb = (const GAS v4u*)(V + (size_t)eb * DM) + F.lane;
            v4u ra[4], rb[4];
#pragma unroll
            for (int c = 0; c < 4; ++c) { ra[c] = va[64 * c]; rb[c] = vb[64 * c]; }
#pragma unroll
            for (int c = 0; c < 4; ++c)
#pragma unroll
                for (int k = 0; k < 4; ++k) { AXPY4(ra[c][k], wa, acc[4 * c + k]); AXPY4(rb[c][k], wb, acc[4 * c + k]); }
        }
#pragma unroll
        for (int c = 0; c < 4; ++c) { const int col = c * 1024 + F.lane * 16; GAS f32x4* op = (GAS f32x4*)(F.out + (size_t)t * DM + col);
            const GAS f32x4* xp = (const GAS f32x4*)(WSP(float, WS_X1) + (size_t)t * DM + col); const GAS f32x4* gp = (const GAS f32x4*)(MOD + 20480 + col);
#pragma unroll
            for (int q = 0; q < 4; ++q) op[q] = xp[q] + gp[q] * acc[4 * c + q]; }
    }
}
#undef DOT4
#undef AXPY4
#ifndef MK_SINGLE
#define MK_SINGLE 1
#endif
constexpr int N_PHASES = 11;
__global__ void __launch_bounds__(NTHREADS, 2) fwd_kernel(Args args) {
    extern __shared__ __attribute__((aligned(16))) unsigned char lds[];
    Frame F;
    F.lds = (LAS unsigned char*)lds; F.MISC = (volatile LAS unsigned*)(F.lds + MISC_OFF);
    F.tid = threadIdx.x; F.lane = F.tid & 63; F.wave = __builtin_amdgcn_readfirstlane(F.tid >> 6);
    F.G = gridDim.x; { const int bx = blockIdx.x; F.vcu = (F.G % 8 == 0) ? (bx % 8) * (F.G / 8) + bx / 8 : bx; }
    F.ws = args.ws; F.out = args.out; F.ctl = (gu32*)(args.ws + WS_CTL);
    for (int u = F.tid; u < (LDS_BYTES - LDSCTL_OFF) / 4; u += NTHREADS) ((LAS unsigned*)(F.lds + LDSCTL_OFF))[u] = 0u;
    __syncthreads();
    const int lo = args.ph_lo, hi = args.ph_hi;
    XcdBarrier bar; bar.bar = (unsigned*)(F.ctl + CW_BAR); bar.x = 0; bar.st = nullptr;
    if (hi - lo > 1) bar = xcd_barrier_post((unsigned*)(F.ctl + CW_BAR), F.MISC + 8);
#ifndef PH_MASK
#define PH_MASK 0x7ff
#endif
#define IN(k) (((PH_MASK >> (k)) & 1) && lo <= (k) && (k) < hi)
#define SEAM(k) do { if (IN(k) && IN((k) + 1)) xcd_barrier(bar); } while (0)
#ifndef REP_PHASE
#define REP_PHASE -1
#endif
#define REPEAT(k) _Pragma("unroll") for (int rep = 0; rep < ((REP_PHASE) == (k) ? 2 : 1); ++rep)
#define REPBAR(k) do { if ((REP_PHASE) == (k) && rep == 0) xcd_barrier(bar); } while (0)
    const int bid = (int)blockIdx.x;
    if (IN(0)) { REPEAT(0) { p0_prologue(F, args); REPBAR(0); } SEAM(0); }
    if (IN(1)) { REPEAT(1) { p1_norm_forget(F, args); REPBAR(1); } SEAM(1); }
    if (IN(2)) { REPEAT(2) {
        pg8::Gemm g{WSP(bf16, WS_HA), WSP(bf16, WS_WIN), S, NINP, DM}; pg8::StaticOrder So; So.init(S, NINP, F.G, bid);
        pg8::EpiIn E{WSP(bf16, WS_QKV), WSP(bf16, WS_LX), WSP(bf16, WS_GY), WSP(bf16, WS_GA), WSP(bf16, WS_GL), WSP(float, WS_BIASR)};
        pg8::gemm_phase<pg8::EpiIn, pg8::StaticOrder, true, true>(F.lds, g, So, E);
        REPBAR(2); }
        SEAM(2);
    }
    if (IN(3)) {
        p3_qknorm(F, args);
        __syncthreads();
        REPEAT(3) {
        p3_cumsum(F, args);
        for (int u = bid; u < (S / 64) * NG; u += F.G) lru_unit<0>(F, args, u >> 4, u & 15);
        REPBAR(3); }
        SEAM(3);
    }
    if (IN(4)) { REPEAT(4) {
        p4_attention(F, args, (char*)lds);
        for (int u = bid; u < (S / 64) * NG; u += F.G) lru_unit<1>(F, args, u >> 4, u & 15);
        REPBAR(4); }
        SEAM(4);
    }
    if (IN(5)) { REPEAT(5) {
        { pg8::Gemm g{WSP(bf16, WS_ATT), WSP(bf16, WS_WAO), S, DM, AW}; pg8::StaticOrder So; So.init(S, DM, F.G, bid);
          pg8::EpiGate<0> E{WSP(bf16, WS_T1), WSP(bf16, WS_GA), DM};
          pg8::gemm_phase<pg8::EpiGate<0>, pg8::StaticOrder, true, true>(F.lds, g, So, E); }
        { pg8::Gemm g{WSP(bf16, WS_LR), WSP(bf16, WS_WLO), S, DM, LW}; pg8::StaticOrder So; So.init(S, DM, F.G, bid);
          pg8::EpiGate<1> E{WSP(bf16, WS_T1), WSP(bf16, WS_GL), DM};
          pg8::gemm_phase<pg8::EpiGate<1>, pg8::StaticOrder, true, true>(F.lds, g, So, E); }
        REPBAR(5); }
        SEAM(5);
    }
    if (IN(6)) { REPEAT(6) {
        pg8::Gemm g{WSP(bf16, WS_T1), WSP(bf16, WS_WOUT), S, DM, DM}; pg8::StaticOrder So; So.init(S, DM, F.G, bid);
        pg8::EpiRes E{args.in[0], WSP(float, WS_X1), WSP(float, WS_MOD) + 8192, DM};
        pg8::gemm_phase<pg8::EpiRes, pg8::StaticOrder, true, true>(F.lds, g, So, E);
        REPBAR(6); }
        SEAM(6);
    }
    if (IN(7)) { REPEAT(7) { p7_norm2(F, args); REPBAR(7); } SEAM(7); }
    if (IN(8)) { REPEAT(8) {
        pg8::Gemm g{WSP(bf16, WS_HA), WSP(bf16, WS_WPQ), S, 2048, DM}; pg8::StaticOrder So; So.init(S, 2048, F.G, bid);
        pg8::EpiBf16<0> E{WSP(bf16, WS_Q2), 2048, nullptr, 0, 0, 1.f};
        pg8::gemm_phase<pg8::EpiBf16<0>, pg8::StaticOrder, true, true>(F.lds, g, So, E);
        REPBAR(8); }
        SEAM(8);
    }
    if (IN(9)) { REPEAT(9) { p9_topk(F, args); REPBAR(9); } SEAM(9); }
    if (IN(10)) { REPEAT(10) { p10_peer(F, args); REPBAR(10); } }
#undef IN
#undef SEAM
}

extern "C" void kernel_launch(void* const* d_in, const int* in_sizes, int n_in, void* d_out, int out_size, void* d_ws, size_t ws_size, hipStream_t stream) {
    static int grid = 0;
    if (grid == 0) {
        if (n_in != 24 || in_sizes[0] != S * DM || out_size != S * DM || ws_size < WS_END) { fprintf(stderr, "kernel_launch: unexpected shapes (n_in %d, in0 %d, out %d, ws %zu)\n", n_in, n_in > 0 ? in_sizes[0] : -1, out_size, ws_size); grid = -1; return; }
        int dev = 0, cus = 0, per_cu = 0;
        if (hipGetDevice(&dev) != hipSuccess || hipDeviceGetAttribute(&cus, hipDeviceAttributeMultiprocessorCount, dev) != hipSuccess) { grid = -1; return; }
        if (hipFuncSetAttribute((const void*)fwd_kernel, hipFuncAttributeMaxDynamicSharedMemorySize, LDS_BYTES) != hipSuccess) { fprintf(stderr, "kernel_launch: hipFuncSetAttribute failed\n"); grid = -1; return; }
        if (hipOccupancyMaxActiveBlocksPerMultiprocessor(&per_cu, (const void*)fwd_kernel, NTHREADS, LDS_BYTES) != hipSuccess || per_cu < 1) fprintf(stderr, "kernel_launch: occupancy query reports %d blocks per CU\n", per_cu);
        (void)hipGetLastError();
        grid = cus;
    }
    if (grid < 0) return;
    if (hipMemsetAsync((char*)d_ws + WS_CTL, 0, CTL_ZERO_BYTES, stream) != hipSuccess) return;
    Args a{};
    for (int i = 0; i < 24; ++i) a.in[i] = (const float*)d_in[i];
    a.out = (float*)d_out; a.ws = (unsigned char*)d_ws;
#if MK_SINGLE
    a.ph_lo = 0; a.ph_hi = N_PHASES;
    hipLaunchKernelGGL(fwd_kernel, dim3(grid), dim3(NTHREADS), LDS_BYTES, stream, a);
#else
    for (int p = 0; p < N_PHASES; ++p) { a.ph_lo = p; a.ph_hi = p + 1; hipLaunchKernelGGL(fwd_kernel, dim3(grid), dim3(NTHREADS), LDS_BYTES, stream, a); }
#endif
}
```

```cpp
#define REP_PHASE -1
#include <hip/hip_runtime.h>
#include <cstdio>
#include <cstdint>
namespace pg8 {
#define PG8_LAS __attribute__((address_space(3)))
typedef unsigned short bf16_t;
typedef short bf16x8 __attribute__((ext_vector_type(8)));
typedef float f32x4 __attribute__((ext_vector_type(4)));
typedef unsigned u32x4 __attribute__((ext_vector_type(4)));
constexpr int BM = 256, BK = 64, HALF = 128, HTB = HALF * BK * 2  , STAGE_BYTES = 8 * HTB, NXCD = 8, WGM = 8;

__host__ __device__ __forceinline__ int lds_byte(int r, int c) { const int st = (r >> 4) * 2 + (c >> 5), rr = r & 15, cc = c & 31, ob = rr * 64 + cc * 2; return st * 1024 + (ob ^ (((ob >> 9) & 1) << 5)); }
__host__ __device__ __forceinline__ void stage_rc(int b, int& R, int& C) { const int st = b / 1024, sb = b % 1024, swz = sb ^ (((sb >> 9) & 1) << 5); R = (st >> 1) * 16 + swz / 64; C = (st & 1) * 32 + (swz % 64) / 2; }
__host__ __device__ __forceinline__ int perm32(int rho) { const int n = rho >> 4, i = rho & 15; return 8 * (i >> 2) + 4 * n + (i & 3); }

struct Unit { int pm, pn; };
struct Gemm { const bf16_t* A; const bf16_t* Bt; int M, N, K; };

struct StaticOrder {
    int nM, nN, nwg, G, c;
    __host__ __device__ void init(int M, int N, int G_, int c_) { nM = M / BM; nN = N / BM; nwg = nM * nN; G = G_; c = c_; }
    __host__ __device__ bool next(int i, Unit& u) const {
        const long L = (long)i * G + c; if (L >= nwg) return false;
        int wgid = (int)L; { const int q = nwg / NXCD, r = nwg % NXCD, xcd = wgid % NXCD, off = wgid / NXCD; wgid = (xcd < r ? xcd * (q + 1) : r * (q + 1) + (xcd - r) * q) + off; }
        const int nig = WGM * nN, gid = wgid / nig, fm = gid * WGM, gsz = (nM - fm) < WGM ? (nM - fm) : WGM;
        u.pm = fm + ((wgid % nig) % gsz); u.pn = (wgid % nig) / gsz; return true;
    }
    __device__ __forceinline__ void a_ready(const Unit&) const {}
    __device__ __forceinline__ void done(const Unit&) const {}
};

__device__ __forceinline__ unsigned cvt_pk_bf16(float lo, float hi) { unsigned r; asm volatile("v_cvt_pk_bf16_f32 %0, %1, %2" : "=v"(r) : "v"(lo), "v"(hi)); return r; }
typedef float f32x2 __attribute__((ext_vector_type(2)));
__device__ __forceinline__ f32x2 gelu_pk(f32x2 v) {
    const f32x2 av = __builtin_elementwise_abs(v), d = av * 0.2316418882f + 1.0f;
    f32x2 t; t.x = __builtin_amdgcn_rcpf(d.x); t.y = __builtin_amdgcn_rcpf(d.y);
    f32x2 q = t * 0.5307027145f + (-0.7265760135f); q = q * t + 0.7107068705f; q = q * t + (-0.142248368f); q = q * t + 0.127414796f; q = q * t;
    const f32x2 s = (v * v) * (-0.72134752044f);
    f32x2 e; e.x = __builtin_amdgcn_exp2f(s.x); e.y = __builtin_amdgcn_exp2f(s.y);
    const f32x2 m = v * (q * e), r = v - m;
    f32x2 o; o.x = v.x < 0.f ? m.x : r.x; o.y = v.y < 0.f ? m.y : r.y; return o;
}

template <int ACT  > struct EpiBf16 {
    static constexpr bool PERM = true, AFTER_DRAIN = false; static_assert(ACT == 0 || ACT == 1, "EpiBf16: ACT is 0 (none) or 1 (gelu_pk)");
    bf16_t* O; int ldc; const float* bias; int split_cols; size_t split_stride; float scale0;
    __device__ __forceinline__ void operator()(const f32x4 (&acc)[2][2][4][2], const Unit& u, int wr, int wc, int fr, int fq) const {
        const int row0 = u.pm * BM + wr * 64 + fr; int colt = u.pn * BM; bf16_t* base = O;
        float sc = 1.f; if (split_cols) { const int t = colt / split_cols; base += (size_t)t * split_stride; colt -= t * split_cols; if (t == 0) sc = scale0; }
        const int col0 = colt + wc * 32 + 8 * fq, bcol0 = u.pn * BM + wc * 32 + 8 * fq;
        f32x4 bv[2][2];
#pragma unroll
        for (int bj = 0; bj < 2; ++bj)
#pragma unroll
            for (int n = 0; n < 2; ++n) bv[bj][n] = bias ? *(const f32x4*)(bias + bcol0 + bj * HALF + 4 * n) : (f32x4){0.f, 0.f, 0.f, 0.f};
#pragma unroll
        for (int ai = 0; ai < 2; ++ai)
#pragma unroll
            for (int m = 0; m < 4; ++m) { bf16_t* rowp = base + (size_t)(row0 + ai * HALF + m * 16) * ldc + col0;
#pragma unroll
                for (int bj = 0; bj < 2; ++bj) { f32x4 v0 = acc[ai][bj][m][0] + bv[bj][0], v1 = acc[ai][bj][m][1] + bv[bj][1];
                    if (ACT == 1) { f32x2 a = gelu_pk((f32x2){v0[0], v0[1]}), b = gelu_pk((f32x2){v0[2], v0[3]}), c = gelu_pk((f32x2){v1[0], v1[1]}), d = gelu_pk((f32x2){v1[2], v1[3]});
                        v0 = (f32x4){a.x, a.y, b.x, b.y}; v1 = (f32x4){c.x, c.y, d.x, d.y}; }
                    v0 = v0 * sc; v1 = v1 * sc; u32x4 w; w.x = cvt_pk_bf16(v0[0], v0[1]); w.y = cvt_pk_bf16(v0[2], v0[3]); w.z = cvt_pk_bf16(v1[0], v1[1]); w.w = cvt_pk_bf16(v1[2], v1[3]);
                    *(u32x4*)(rowp + bj * HALF) = w; } }
    }
};
__device__ __forceinline__ f32x4 sigm4(f32x4 v) { f32x4 o;
#pragma unroll
    for (int j = 0; j < 4; ++j) o[j] = __builtin_amdgcn_rcpf(1.0f + __builtin_amdgcn_exp2f(-1.4426950408889634f * v[j]));
    return o; }
__device__ __forceinline__ f32x4 gelu4(f32x4 v) { const f32x2 a = gelu_pk((f32x2){v[0], v[1]}), b = gelu_pk((f32x2){v[2], v[3]}); return (f32x4){a.x, a.y, b.x, b.y}; }
__device__ __forceinline__ void unpack8(const u32x4 w, f32x4& lo, f32x4& hi) {
    lo = (f32x4){__uint_as_float(w.x << 16), __uint_as_float(w.x & 0xffff0000u), __uint_as_float(w.y << 16), __uint_as_float(w.y & 0xffff0000u)};
    hi = (f32x4){__uint_as_float(w.z << 16), __uint_as_float(w.z & 0xffff0000u), __uint_as_float(w.w << 16), __uint_as_float(w.w & 0xffff0000u)}; }
struct EpiIn {
    static constexpr bool PERM = true, AFTER_DRAIN = false;
    bf16_t* qkv; bf16_t* lx; bf16_t* gy; bf16_t* ga; bf16_t* gl; const float* bias;
    __device__ __forceinline__ void operator()(const f32x4 (&acc)[2][2][4][2], const Unit& u, int wr, int wc, int fr, int fq) const {
        const int pn = u.pn; bf16_t* base; int ldc, colt, act;
        if (pn < 24) { base = qkv + (size_t)(pn >> 3) * ((size_t)8192 * 2048); ldc = 2048; colt = (pn & 7) * 256; act = 0; }
        else if (pn < 32) { base = lx; ldc = 2048; colt = (pn - 24) * 256; act = 0; }
        else if (pn < 40) { base = gy; ldc = 2048; colt = (pn - 32) * 256; act = 1; }
        else if (pn < 56) { base = ga; ldc = 4096; colt = (pn - 40) * 256; act = 2; }
        else { base = gl; ldc = 4096; colt = (pn - 56) * 256; act = 2; }
        const int row0 = u.pm * BM + wr * 64 + fr, col0 = colt + wc * 32 + 8 * fq, bcol0 = pn * BM + wc * 32 + 8 * fq;
        f32x4 bv[2][2];
#pragma unroll
        for (int bj = 0; bj < 2; ++bj)
#pragma unroll
            for (int n = 0; n < 2; ++n) bv[bj][n] = *(const f32x4*)(bias + bcol0 + bj * HALF + 4 * n);
#pragma unroll
        for (int ai = 0; ai < 2; ++ai)
#pragma unroll
            for (int m = 0; m < 4; ++m) { bf16_t* rowp = base + (size_t)(row0 + ai * HALF + m * 16) * ldc + col0;
#pragma unroll
                for (int bj = 0; bj < 2; ++bj) { f32x4 v0 = acc[ai][bj][m][0] + bv[bj][0], v1 = acc[ai][bj][m][1] + bv[bj][1];
                    if (act == 1) { v0 = gelu4(v0); v1 = gelu4(v1); }
                    else if (act == 2) { v0 = sigm4(v0); v1 = sigm4(v1); }
                    u32x4 w; w.x = cvt_pk_bf16(v0[0], v0[1]); w.y = cvt_pk_bf16(v0[2], v0[3]); w.z = cvt_pk_bf16(v1[0], v1[1]); w.w = cvt_pk_bf16(v1[2], v1[3]);
                    *(u32x4*)(rowp + bj * HALF) = w; } }
    }
};
template <int MODE> struct EpiGate {
    static constexpr bool PERM = true, AFTER_DRAIN = false;
    bf16_t* O; const bf16_t* Gt; int ldc;
    __device__ __forceinline__ void operator()(const f32x4 (&acc)[2][2][4][2], const Unit& u, int wr, int wc, int fr, int fq) const {
        const int row0 = u.pm * BM + wr * 64 + fr, col0 = u.pn * BM + wc * 32 + 8 * fq;
#pragma unroll
        for (int ai = 0; ai < 2; ++ai)
#pragma unroll
            for (int m = 0; m < 4; ++m) { const size_t off = (size_t)(row0 + ai * HALF + m * 16) * ldc + col0;
#pragma unroll
                for (int bj = 0; bj < 2; ++bj) { f32x4 g0, g1; unpack8(*(const u32x4*)(Gt + off + bj * HALF), g0, g1);
                    f32x4 v0 = acc[ai][bj][m][0] * g0, v1 = acc[ai][bj][m][1] * g1;
                    if (MODE == 1) { f32x4 t0, t1; unpack8(*(const u32x4*)(O + off + bj * HALF), t0, t1); v0 += t0; v1 += t1; }
                    u32x4 w; w.x = cvt_pk_bf16(v0[0], v0[1]); w.y = cvt_pk_bf16(v0[2], v0[3]); w.z = cvt_pk_bf16(v1[0], v1[1]); w.w = cvt_pk_bf16(v1[2], v1[3]);
                    *(u32x4*)(O + off + bj * HALF) = w; } }
    }
};
struct EpiRes {
    static constexpr bool PERM = false, AFTER_DRAIN = false;
    const float* X; float* Out; const float* gate; int ldc;
    __device__ __forceinline__ void operator()(const f32x4 (&acc)[2][2][4][2], const Unit& u, int wr, int wc, int fr, int fq) const {
        const int row0 = u.pm * BM + wr * 64 + fr, col0 = u.pn * BM + wc * 32 + 4 * fq;
        f32x4 gv[2][2];
#pragma unroll
        for (int bj = 0; bj < 2; ++bj)
#pragma unroll
            for (int n = 0; n < 2; ++n) gv[bj][n] = *(const f32x4*)(gate + col0 + bj * HALF + n * 16);
#pragma unroll
        for (int ai = 0; ai < 2; ++ai)
#pragma unroll
            for (int m = 0; m < 4; ++m) { const size_t off = (size_t)(row0 + ai * HALF + m * 16) * ldc + col0;
#pragma unroll
                for (int bj = 0; bj < 2; ++bj)
#pragma unroll
                    for (int n = 0; n < 2; ++n) { const f32x4 xv = *(const f32x4*)(X + off + bj * HALF + n * 16);
                        *(f32x4*)(Out + off + bj * HALF + n * 16) = xv + gv[bj][n] * acc[ai][bj][m][n]; } }
    }
};
template <class Epi, class Sched, bool ALIGN_EPI = false, bool SP2 = false>
__device__ __forceinline__ void gemm_phase(PG8_LAS unsigned char* lds, const Gemm g, const Sched& S, const Epi& E) {
    const int tid = threadIdx.x, wid = __builtin_amdgcn_readfirstlane(tid >> 6), lane = tid & 63, wr = wid >> 2, wc = wid & 3, fr = lane & 15, fq = lane >> 4;
    const int K = g.K, nt = K / BK;
    unsigned voffA[2], voffB[2];
#pragma unroll
    for (int i = 0; i < 2; ++i) { int R, C; stage_rc(tid * 16 + i * 8192, R, C); const int Rb = Epi::PERM ? ((R & ~31) + perm32(R & 31)) : R;
        voffA[i] = (unsigned)(R * K + C) * 2u; voffB[i] = (unsigned)(Rb * K + C) * 2u; }
    const size_t kstep = (size_t)(BK * 2);
    const size_t hstep = (size_t)HALF * K * 2;
    const size_t tstep = 2 * hstep;
    const unsigned ldsw = (unsigned)wid * 1024u;
    const int aoff = lds_byte(wr * 64 + fr, fq * 8), boff = lds_byte(wc * 32 + fr, fq * 8);
#define PG8_SA(b, h) (((b) * 2 + (h)) * HTB)
#define PG8_SB(b, h) ((4 + (b) * 2 + (h)) * HTB)
#define PG8_STAGE(bufoff, gbase, voff) do { _Pragma("unroll") for (int _i = 0; _i < 2; ++_i) \
        __builtin_amdgcn_global_load_lds((const unsigned*)((const char*)(gbase) + (voff)[_i]), (PG8_LAS unsigned*)(lds + (bufoff) + ldsw + _i * 8192), 16, 0, 0); } while (0)
#define PG8_LDA(dst, b, h) do { _Pragma("unroll") for (int m = 0; m < 4; ++m) _Pragma("unroll") for (int k = 0; k < 2; ++k) dst[m][k] = *(const PG8_LAS bf16x8*)(lds + PG8_SA(b, h) + aoff + m * 2048 + k * 1024); } while (0)
#define PG8_LDB(dst, b, h) do { _Pragma("unroll") for (int n = 0; n < 2; ++n) _Pragma("unroll") for (int k = 0; k < 2; ++k) dst[n][k] = *(const PG8_LAS bf16x8*)(lds + PG8_SB(b, h) + boff + n * 2048 + k * 1024); } while (0)
#define PG8_MMA(ai, bj, At, Bt) do { __builtin_amdgcn_s_setprio(1); _Pragma("unroll") for (int m = 0; m < 4; ++m) _Pragma("unroll") for (int n = 0; n < 2; ++n) _Pragma("unroll") for (int k = 0; k < 2; ++k) \
        acc[ai][bj][m][n] = __builtin_amdgcn_mfma_f32_16x16x32_bf16(Bt[n][k], At[m][k], acc[ai][bj][m][n], 0, 0, 0); __builtin_amdgcn_s_setprio(0); } while (0)
#define PG8_WAIT_V(n) asm volatile("s_waitcnt vmcnt(" #n ")" ::: "memory")
#define PG8_WAIT_L(n) asm volatile("s_waitcnt lgkmcnt(" #n ")" ::: "memory")
#define PG8_BAR __builtin_amdgcn_s_barrier()
#define PG8_SCHED __builtin_amdgcn_sched_barrier(0)
    Unit cur, nxt; int ui = 0;
    if (!S.next(0, cur)) return;
    f32x4 acc[2][2][4][2];
#pragma unroll
    for (int a = 0; a < 2; ++a)
#pragma unroll
        for (int b = 0; b < 2; ++b)
#pragma unroll
            for (int m = 0; m < 4; ++m)
#pragma unroll
                for (int n = 0; n < 2; ++n) acc[a][b][m][n] = (f32x4){0.f, 0.f, 0.f, 0.f};
    bf16x8 At[4][2], B0[2][2], B1[2][2];
    const char* cA = (const char*)g.A + (size_t)cur.pm * tstep; const char* cB = (const char*)g.Bt + (size_t)cur.pn * tstep;
    S.a_ready(cur);
    if constexpr (SP2) {
        PG8_STAGE(PG8_SB(0, 0), cB, voffB); PG8_STAGE(PG8_SB(0, 1), cB + hstep, voffB); PG8_STAGE(PG8_SA(0, 0), cA, voffA); PG8_STAGE(PG8_SA(0, 1), cA + hstep, voffA);
        if (wr == 1) PG8_BAR;
        PG8_WAIT_V(2); PG8_BAR;
        PG8_STAGE(PG8_SB(1, 0), cB + kstep, voffB); PG8_STAGE(PG8_SA(1, 0), cA + kstep, voffA); PG8_STAGE(PG8_SB(1, 1), cB + hstep + kstep, voffB);
        PG8_WAIT_V(6); PG8_BAR;
    } else {
        PG8_STAGE(PG8_SB(0, 0), cB, voffB); PG8_STAGE(PG8_SA(0, 0), cA, voffA); PG8_STAGE(PG8_SB(0, 1), cB + hstep, voffB); PG8_STAGE(PG8_SA(0, 1), cA + hstep, voffA);
        if (wr == 1) PG8_BAR;
        PG8_WAIT_V(4); PG8_BAR;
        PG8_STAGE(PG8_SB(1, 0), cB + kstep, voffB); PG8_STAGE(PG8_SA(1, 0), cA + kstep, voffA); PG8_STAGE(PG8_SB(1, 1), cB + hstep + kstep, voffB);
        PG8_WAIT_V(6); PG8_BAR;
    }
    for (;;) {
        const bool has_next = S.next(ui + 1, nxt);
        const char* nA = has_next ? (const char*)g.A + (size_t)nxt.pm * tstep : cA; const char* nB = has_next ? (const char*)g.Bt + (size_t)nxt.pn * tstep : cB;
        for (int t = 0; t < nt; t += 2) {
            const bool last = (t == nt - 2);
            const char* a1 = cA + (size_t)(t + 1) * kstep;
            const char* a2 = last ? nA : cA + (size_t)(t + 2) * kstep; const char* b2 = last ? nB : cB + (size_t)(t + 2) * kstep;
            const char* a3 = a2 + kstep; const char* b3 = b2 + kstep;
            if (last && has_next) S.a_ready(nxt);
            if constexpr (SP2) {
            PG8_LDB(B0, 0, 0); PG8_LDB(B1, 0, 1); PG8_SCHED; PG8_LDA(At, 0, 0); PG8_STAGE(PG8_SA(1, 1), a1 + hstep, voffA);
            PG8_WAIT_V(8); PG8_WAIT_L(0); PG8_BAR; PG8_MMA(0, 0, At, B0); PG8_MMA(0, 1, At, B1); PG8_BAR; PG8_SCHED;
            PG8_LDA(At, 0, 1); PG8_STAGE(PG8_SB(0, 0), b2, voffB); PG8_STAGE(PG8_SB(0, 1), b2 + hstep, voffB); PG8_STAGE(PG8_SA(0, 0), a2, voffA);
            PG8_WAIT_V(8); PG8_WAIT_L(0); PG8_BAR; PG8_MMA(1, 0, At, B0); PG8_MMA(1, 1, At, B1); PG8_BAR; PG8_SCHED;
            PG8_LDB(B0, 1, 0); PG8_LDB(B1, 1, 1); PG8_SCHED; PG8_LDA(At, 1, 0); PG8_STAGE(PG8_SA(0, 1), a2 + hstep, voffA);
            PG8_WAIT_V(8); PG8_WAIT_L(0); PG8_BAR; PG8_MMA(0, 0, At, B0); PG8_MMA(0, 1, At, B1); PG8_BAR; PG8_SCHED;
            PG8_LDA(At, 1, 1); PG8_STAGE(PG8_SB(1, 0), b3, voffB); PG8_STAGE(PG8_SB(1, 1), b3 + hstep, voffB); PG8_STAGE(PG8_SA(1, 0), a3, voffA);
            PG8_WAIT_V(8); PG8_WAIT_L(0); PG8_BAR; PG8_MMA(1, 0, At, B0); PG8_MMA(1, 1, At, B1); PG8_BAR; PG8_SCHED;
            } else {
            PG8_LDB(B0, 0, 0); PG8_SCHED; PG8_LDA(At, 0, 0); PG8_STAGE(PG8_SA(1, 1), a1 + hstep, voffA);
            PG8_WAIT_L(8); PG8_BAR; PG8_WAIT_L(0); PG8_MMA(0, 0, At, B0); PG8_BAR; PG8_SCHED;
            PG8_LDB(B1, 0, 1); PG8_STAGE(PG8_SB(0, 0), b2, voffB);
            PG8_BAR; PG8_WAIT_L(0); PG8_MMA(0, 1, At, B1); PG8_BAR;
            PG8_LDA(At, 0, 1); PG8_STAGE(PG8_SA(0, 0), a2, voffA);
            PG8_BAR; PG8_WAIT_L(0); PG8_MMA(1, 0, At, B0); PG8_BAR; PG8_SCHED;
            PG8_STAGE(PG8_SB(0, 1), b2 + hstep, voffB);
            PG8_WAIT_V(6); PG8_BAR; PG8_MMA(1, 1, At, B1); PG8_BAR;
            PG8_LDB(B0, 1, 0); PG8_SCHED; PG8_LDA(At, 1, 0); PG8_STAGE(PG8_SA(0, 1), a2 + hstep, voffA);
            PG8_WAIT_L(8); PG8_BAR; PG8_WAIT_L(0); PG8_MMA(0, 0, At, B0); PG8_BAR; PG8_SCHED;
            PG8_LDB(B1, 1, 1); PG8_STAGE(PG8_SB(1, 0), b3, voffB);
            PG8_BAR; PG8_WAIT_L(0); PG8_MMA(0, 1, At, B1); PG8_BAR;
            PG8_LDA(At, 1, 1); PG8_STAGE(PG8_SA(1, 0), a3, voffA);
            PG8_BAR; PG8_WAIT_L(0); PG8_MMA(1, 0, At, B0); PG8_BAR; PG8_SCHED;
            PG8_STAGE(PG8_SB(1, 1), b3 + hstep, voffB);
            PG8_WAIT_V(6); PG8_BAR; PG8_MMA(1, 1, At, B1); PG8_BAR;
            }
        }
        if constexpr (ALIGN_EPI) { if (wr == 0) PG8_BAR; }
        if constexpr (!Epi::AFTER_DRAIN) { E(acc, cur, wr, wc, fr, fq); S.done(cur); }
        if (!has_next) break;
#pragma unroll
        for (int a = 0; a < 2; ++a)
#pragma unroll
            for (int b = 0; b < 2; ++b)
#pragma unroll
                for (int m = 0; m < 4; ++m)
#pragma unroll
                    for (int n = 0; n < 2; ++n) acc[a][b][m][n] = (f32x4){0.f, 0.f, 0.f, 0.f};
        cur = nxt; cA = nA; cB = nB; ++ui;
        if constexpr (ALIGN_EPI) { if (wr == 1) PG8_BAR; }
    }
    PG8_WAIT_V(0);
    if constexpr (!ALIGN_EPI) { if (wr == 0) PG8_BAR; }
    PG8_BAR;
    if constexpr (Epi::AFTER_DRAIN) { E.fused(acc, cur, wr, wc, fr, fq, lds, wid, lane); S.done(cur); }
#undef PG8_SA
#undef PG8_SB
#undef PG8_STAGE
#undef PG8_LDA
#undef PG8_LDB
#undef PG8_MMA
#undef PG8_WAIT_V
#undef PG8_WAIT_L
#undef PG8_BAR
#undef PG8_SCHED
}
}
namespace attn_body {
constexpr int D = 128, LD = 2048;
constexpr float THR = 8.f; constexpr bool WSKIP = false;
constexpr float SCALE = 0.08838834764831845f;
constexpr int NW = 8, QBLK = 32, KVBLK = 64, QB = NW * QBLK;
constexpr int SHM_V = KVBLK * D * 2, SHM_K = KVBLK * D * 2;
constexpr int LDS_BYTES = 2 * SHM_V + 2 * SHM_K + NW * 64 * 4;

typedef short bf16x8 __attribute__((ext_vector_type(8)));
typedef short s16x4 __attribute__((ext_vector_type(4)));
typedef float f32x16 __attribute__((ext_vector_type(16)));
typedef float f32x4 __attribute__((ext_vector_type(4)));
typedef unsigned u32x4 __attribute__((ext_vector_type(4)));
template <class A, class Bt> struct same_t { static constexpr bool v = false; };
template <class A> struct same_t<A, A> { static constexpr bool v = true; };

#define KSWZ(row, colB) ((row) * 256 + ((colB) ^ (((row) & 7) << 4)))
#define SBAR() __builtin_amdgcn_sched_barrier(0)
__device__ __forceinline__ int v_st(int k, int c) { const int kk = (k & ~0xC) | ((k & 4) << 1) | ((k & 8) >> 1); return ((kk >> 3) * 4 + (c >> 5)) * 512 + ((kk & 7) * 32 + (c & 31)) * 2; }
__device__ __forceinline__ int v_rd_base(int lane) { return ((lane & 3) << 3) | (((lane >> 2) & 3) << 6) | (((lane >> 4) & 1) << 5) | (((lane >> 5) & 1) << 8); }
constexpr int v_rd_off(int d0, int ks, int half) { return d0 * 512 + ks * 4096 + half * 2048; }
__device__ __forceinline__ int crow(int r, int hi) { return (r & 3) + 8 * (r >> 2) + 4 * hi; }
__device__ __forceinline__ unsigned cvtpk(float lo, float hi) {
    unsigned r; asm volatile("v_cvt_pk_bf16_f32 %0, %1, %2" : "=v"(r) : "v"(lo), "v"(hi)); return r;
}
__device__ __forceinline__ bf16x8 pack8(f32x4 a, f32x4 b) {
    u32x4 w = {cvtpk(a[0], a[1]), cvtpk(a[2], a[3]), cvtpk(b[0], b[1]), cvtpk(b[2], b[3])};
    return *reinterpret_cast<bf16x8*>(&w);
}
template <class T> __device__ __forceinline__ bf16x8 load8(const T* p) {
    if constexpr (same_t<T, float>::v) { return pack8(*(const f32x4*)p, *(const f32x4*)(p + 4)); }
    else { return *reinterpret_cast<const bf16x8*>(p); }
}
__device__ __forceinline__ void mask_tile(f32x16& p0, f32x16& p1, int dq, unsigned W) {
    const float NEG = -__builtin_inff();
#pragma unroll
    for (int r = 0; r < 16; ++r) {
        const int c = (r & 3) + 8 * (r >> 2);
        if ((unsigned)(dq - c) >= W) p0[r] = NEG;
        if ((unsigned)(dq - c - 32) >= W) p1[r] = NEG;
    }
}
__device__ __forceinline__ void partialSM(f32x16& p0, f32x16& p1, float& m_reg, float& mn, float& alpha) {
    float pmax = p0[0]; for (int r = 1; r < 16; ++r) pmax = fmaxf(pmax, p0[r]); for (int r = 0; r < 16; ++r) pmax = fmaxf(pmax, p1[r]);
    { auto rr = __builtin_amdgcn_permlane32_swap(__float_as_uint(pmax), __float_as_uint(pmax), false, false);
      pmax = fmaxf(__uint_as_float(rr[0]), __uint_as_float(rr[1])); }
    constexpr float C2 = 1.4426950408889634f * SCALE;
    if (__builtin_expect(__all((pmax - m_reg) * SCALE <= THR), 1)) { mn = m_reg; alpha = 1.f; }
    else { mn = fmaxf(m_reg, pmax); alpha = __builtin_amdgcn_exp2f((m_reg - mn) * C2); m_reg = mn; }
    const float mnL = -mn * C2;
    for (int r = 0; r < 16; ++r) p0[r] = fmaf(p0[r], C2, mnL); for (int r = 0; r < 16; ++r) p1[r] = fmaf(p1[r], C2, mnL);
    for (int r = 0; r < 16; ++r) p0[r] = __builtin_amdgcn_exp2f(p0[r]);
}
__device__ __forceinline__ void finishSM(f32x16& p0, f32x16& p1, float alpha, float& l_reg, bf16x8& pa0, bf16x8& pa1, bf16x8& pa2, bf16x8& pa3) {
    for (int r = 0; r < 16; ++r) p1[r] = __builtin_amdgcn_exp2f(p1[r]);
    float ps = 0; for (int r = 0; r < 16; ++r) ps += p0[r]; for (int r = 0; r < 16; ++r) ps += p1[r];
    { auto rr = __builtin_amdgcn_permlane32_swap(__float_as_uint(ps), __float_as_uint(ps), false, false);
      ps = __uint_as_float(rr[0]) + __uint_as_float(rr[1]); }
    l_reg = l_reg * alpha + ps;
#define PK4(P, B_, OUT) do { unsigned a0 = cvtpk(P[B_+0], P[B_+1]), a1 = cvtpk(P[B_+2], P[B_+3]);                          \
        unsigned b0 = cvtpk(P[B_+4], P[B_+5]), b1 = cvtpk(P[B_+6], P[B_+7]);                                             \
        auto r0 = __builtin_amdgcn_permlane32_swap(a0, b0, false, false); auto r1 = __builtin_amdgcn_permlane32_swap(a1, b1, false, false); \
        u32x4 w = {r0[0], r1[0], r0[1], r1[1]}; OUT = *reinterpret_cast<bf16x8*>(&w); } while (0)
    PK4(p0, 0, pa0); PK4(p0, 8, pa1); PK4(p1, 0, pa2); PK4(p1, 8, pa3);
#undef PK4
}
template <int KB, bool SK>
__device__ __forceinline__ void qkt(f32x16& p0, f32x16& p1, const char* K_lds, int r32, int hi, const bf16x8* qr, bool act, const float* bt) {
    if (SK && !act) { const float NEG = -__builtin_inff();
#pragma unroll
        for (int r = 0; r < 16; ++r) { p0[r] = NEG; p1[r] = NEG; } return; }
    { const f32x4 b0 = *(const f32x4*)(bt), b1 = *(const f32x4*)(bt + 8), b2 = *(const f32x4*)(bt + 16), b3 = *(const f32x4*)(bt + 24);
      const f32x4 c0 = *(const f32x4*)(bt + 32), c1 = *(const f32x4*)(bt + 40), c2 = *(const f32x4*)(bt + 48), c3 = *(const f32x4*)(bt + 56);
      p0 = (f32x16){b0[0], b0[1], b0[2], b0[3], b1[0], b1[1], b1[2], b1[3], b2[0], b2[1], b2[2], b2[3], b3[0], b3[1], b3[2], b3[3]};
      p1 = (f32x16){c0[0], c0[1], c0[2], c0[3], c1[0], c1[1], c1[2], c1[3], c2[0], c2[1], c2[2], c2[3], c3[0], c3[1], c3[2], c3[3]}; }
    const char* kb[4];
#pragma unroll
    for (int dd = 0; dd < 4; ++dd) kb[dd] = K_lds + KB * SHM_K + KSWZ(r32, (dd * 16 + hi * 8) * 2);
#pragma unroll
    for (int d0 = 0; d0 < 8; ++d0) { const char* a = kb[d0 & 3] + (d0 >> 2) * 128;
        bf16x8 b0 = *reinterpret_cast<const bf16x8*>(a);
        bf16x8 b1 = *reinterpret_cast<const bf16x8*>(a + 32 * 256);
        p0 = __builtin_amdgcn_mfma_f32_32x32x16_bf16(b0, qr[d0], p0, 0, 0, 0);
        p1 = __builtin_amdgcn_mfma_f32_32x32x16_bf16(b1, qr[d0], p1, 0, 0, 0); }
}
template <int VB, bool SK>
__device__ __forceinline__ void pv_tile(f32x16* o, int vb0, bf16x8 pa0, bf16x8 pa1, bf16x8 pa2, bf16x8 pa3, bool act) {
    if (SK && !act) return;
#define TRRD(dst, off) asm volatile("ds_read_b64_tr_b16 %0, %1 offset:%2" : "=&v"(dst) : "v"(vb0), "i"(off) : "memory")
#define PV_D0(d0) do { s16x4 l0, l1, l2, l3, h0, h1, h2, h3; constexpr int b_ = VB * SHM_V + v_rd_off(d0, 0, 0);     \
        TRRD(l0, b_); TRRD(h0, b_ + 2048); TRRD(l1, b_ + 4096); TRRD(h1, b_ + 6144); TRRD(l2, b_ + 8192); TRRD(h2, b_ + 10240); TRRD(l3, b_ + 12288); TRRD(h3, b_ + 14336); \
        asm volatile("s_waitcnt lgkmcnt(0)" ::: "memory"); SBAR();                 \
        o[d0] = __builtin_amdgcn_mfma_f32_32x32x16_bf16(pa0, (bf16x8){l0[0], l0[1], l0[2], l0[3], h0[0], h0[1], h0[2], h0[3]}, o[d0], 0, 0, 0);   \
        o[d0] = __builtin_amdgcn_mfma_f32_32x32x16_bf16(pa1, (bf16x8){l1[0], l1[1], l1[2], l1[3], h1[0], h1[1], h1[2], h1[3]}, o[d0], 0, 0, 0);   \
        o[d0] = __builtin_amdgcn_mfma_f32_32x32x16_bf16(pa2, (bf16x8){l2[0], l2[1], l2[2], l2[3], h2[0], h2[1], h2[2], h2[3]}, o[d0], 0, 0, 0);   \
        o[d0] = __builtin_amdgcn_mfma_f32_32x32x16_bf16(pa3, (bf16x8){l3[0], l3[1], l3[2], l3[3], h3[0], h3[1], h3[2], h3[3]}, o[d0], 0, 0, 0); } while (0)
    PV_D0(0); PV_D0(1); PV_D0(2); PV_D0(3);
#undef PV_D0
#undef TRRD
}


template <class TIn, class TOut> struct BlockRef { const TIn* Q; const TIn* K; const TIn* V; TOut* O; int P0; int jlo; };
#define ROW(p, k0, rr) ((p) + (size_t)((k0) + (rr)) * LD + sc)
#define VMW() asm volatile("s_waitcnt vmcnt(0)" ::: "memory")
#define SLOAD_H(Kp, Vp, k0) do { st_v0 = load8<TIn>(ROW(Vp, k0, sr)); st_v1 = load8<TIn>(ROW(Vp, k0, 32 + sr));              \
                         st_k0 = load8<TIn>(ROW(Kp, k0, sr)); st_k1 = load8<TIn>(ROW(Kp, k0, 32 + sr)); } while (0)
#define SWRITE_H(bf) do { *(bf16x8*)(V_lds + (bf) * SHM_V + vst0) = st_v0; *(bf16x8*)(V_lds + (bf) * SHM_V + vst1) = st_v1;   \
                          *(bf16x8*)(K_lds + (bf) * SHM_K + kws) = st_k0; *(bf16x8*)(K_lds + (bf) * SHM_K + kws + 32 * 256) = st_k1; } while (0)
template <class TIn, class TOut>
__device__ __forceinline__ void attn_unit(const BlockRef<TIn, TOut>& cur, int skv, char* lds) {
    const int tid = threadIdx.x, wid = __builtin_amdgcn_readfirstlane(tid >> 6), lane = tid & 63, r32 = lane & 31, hi = lane >> 5;
    const unsigned W = 0x40000000u;
    const int j_lo = cur.jlo;
    int j_hi = (cur.P0 + QB - 1) / KVBLK + 1; if (j_hi > skv / KVBLK) j_hi = skv / KVBLK;
    const int NT = j_hi - j_lo;
    const int qlo = cur.P0 + wid * QBLK, qm = qlo + r32 - 4 * hi;
    char* V_lds = lds; char* K_lds = lds + 2 * SHM_V;
    float* ws = (float*)(lds + 2 * SHM_V + 2 * SHM_K) + wid * 64; float* li_l = ws, * al_l = ws + 32;
    const float* bias_l = (const float*)(lds + LDS_BYTES) + 4 * hi;
    float m_reg = -1e30f, l_reg = 0; f32x16 o[4] = {};
    const int sr = tid >> 4, sc = (tid & 15) * 8, vst0 = v_st(sr, sc), vst1 = v_st(32 + sr, sc), kws = KSWZ(sr, sc * 2);
    const int vb0 = (int)(uintptr_t)V_lds + v_rd_base(lane);
    const TIn* Kh = cur.K; const TIn* Vh = cur.V;
    bf16x8 st_v0, st_v1, st_k0, st_k1; bf16x8 qr[8];
#define KBASE(t) ((j_lo + (t)) * KVBLK)
#define BT(t) (bias_l + (t) * KVBLK)
#define RESC(a) do { if (__any((a) < 1.f)) { if (hi == 0) al_l[r32] = (a); asm volatile("s_waitcnt lgkmcnt(0)" ::: "memory");              \
                     for (int d_ = 0; d_ < 4; ++d_) for (int r = 0; r < 16; ++r) o[d_][r] *= al_l[crow(r, hi)]; } } while (0)
#define MASKT(P0_, P1_, t) do { const int kb_ = KBASE(t); if (kb_ + KVBLK - 1 > qlo) mask_tile(P0_, P1_, qm - kb_, W); } while (0)
#pragma unroll
    for (int d0 = 0; d0 < 8; ++d0) qr[d0] = load8<TIn>(cur.Q + (size_t)(wid * QBLK + r32) * LD + d0 * 16 + hi * 8);
    SLOAD_H(Kh, Vh, KBASE(0)); VMW(); SWRITE_H(0); SBAR();
    if (NT > 1) SLOAD_H(Kh, Vh, KBASE(1));
    __syncthreads();
    f32x16 p0, p1; float mn, al; bf16x8 pa0, pa1, pa2, pa3;
#define TILE_STEP(t, BUF) do {                                                                                                 \
        SBAR(); qkt<BUF, false>(p0, p1, K_lds, r32, hi, qr, true, BT(t));                                                       \
        MASKT(p0, p1, (t)); partialSM(p0, p1, m_reg, mn, al); RESC(al);                                                          \
        finishSM(p0, p1, al, l_reg, pa0, pa1, pa2, pa3); SBAR();                                                                 \
        pv_tile<BUF, false>(o, vb0, pa0, pa1, pa2, pa3, true);                                                                    \
        if ((t) + 1 < NT) { VMW(); SWRITE_H(1 - (BUF)); SBAR(); if ((t) + 2 < NT) SLOAD_H(Kh, Vh, KBASE((t) + 2)); }              \
        __syncthreads(); } while (0)
    for (int t = 0; t < NT; t += 2) {
        TILE_STEP(t, 0);
        if (t + 1 < NT) TILE_STEP(t + 1, 1);
    }
    if (hi == 0) li_l[r32] = l_reg; asm volatile("s_waitcnt lgkmcnt(0)" ::: "memory");
    float rli[16];
#pragma unroll
    for (int r = 0; r < 16; ++r) rli[r] = __builtin_amdgcn_rcpf(li_l[crow(r, hi)]);
    TOut* Ow = cur.O + (size_t)(wid * QBLK) * LD;
#pragma unroll
    for (int r = 0; r < 16; ++r) { const int orow = crow(r, hi);
#pragma unroll
        for (int d0 = 0; d0 < 4; ++d0) { const float v = o[d0][r] * rli[r];
            const float vn = __shfl_xor(v, 1);
            if ((r32 & 1) == 0) *(unsigned*)(Ow + (size_t)orow * LD + d0 * 32 + r32) = cvtpk(v, vn); } }
    __syncthreads();
#undef TILE_STEP
#undef RESC
#undef KBASE
#undef BT
#undef MASKT
}
#undef ROW
#undef VMW
#undef SLOAD_H
#undef SWRITE_H
}
#define GAS __attribute__((address_space(1)))
#define LAS __attribute__((address_space(3)))
typedef unsigned short bf16;
typedef unsigned v4u __attribute__((ext_vector_type(4)));
typedef unsigned v2u __attribute__((ext_vector_type(2)));
typedef float f32x4 __attribute__((ext_vector_type(4)));
typedef float f32x2 __attribute__((ext_vector_type(2)));
typedef short bf16x8 __attribute__((ext_vector_type(8)));
typedef GAS unsigned gu32;
#define RLX_AGENT __ATOMIC_RELAXED, __HIP_MEMORY_SCOPE_AGENT

constexpr int S = 8192, DM = 4096, NH = 16, HD = 128, AW = 2048, LW = 2048, NG = 16, GD = 128;
constexpr int NIN = 18448, NINP = 18432;
constexpr int C_Q = 0, C_K = 2048, C_V = 4096, C_F = 6144, C_LX = 6160, C_LY = 8208, C_GA = 10256, C_GL = 14352;
constexpr int PEER_H = 8, PEER_NK = 128, PEER_K = 16, PEER_NE = 16384;
constexpr float EPS = 1e-6f;
constexpr size_t MiB = 1u << 20;
constexpr size_t WS_CTL = 0, CTL_ZERO_BYTES = 1 * MiB;
constexpr size_t WS_MOD = 512 * 1024;
constexpr size_t WS_WF = 2 * MiB;
constexpr size_t WS_LOGF = 3 * MiB;
constexpr size_t WS_FC = 4 * MiB;
constexpr size_t WS_AGGA = 5 * MiB, WS_AGGB = 6 * MiB;
constexpr size_t WS_BIASR = 7 * MiB;
constexpr size_t WS_WAT = 8 * MiB, WS_WXT = 9 * MiB;
constexpr size_t WS_SK = 10 * MiB, WS_RS = 11 * MiB, WS_RSU = 11 * MiB + 65536;
constexpr size_t WS_IDX = 12 * MiB, WS_GATE = 16 * MiB, WS_IDX2 = 20 * MiB, WS_GATE2 = 24 * MiB;
constexpr size_t WS_WIN = 32 * MiB, WS_WAO = 176 * MiB, WS_WLO = 192 * MiB, WS_WOUT = 208 * MiB, WS_WPQ = 240 * MiB;
constexpr size_t WS_U = 256 * MiB, WS_V = 384 * MiB;
constexpr size_t WS_HA = 512 * MiB;
constexpr size_t WS_QKV = 576 * MiB;
constexpr size_t WS_LX = 672 * MiB, WS_GY = 704 * MiB, WS_GA = 736 * MiB, WS_GL = 800 * MiB;
constexpr size_t WS_ATT = 864 * MiB, WS_LR = 896 * MiB, WS_T1 = 928 * MiB, WS_MG = 992 * MiB, WS_Q2 = 1056 * MiB, WS_X1 = 1088 * MiB, WS_END = 1216 * MiB;
constexpr int CW_BAR = 4096;
constexpr int RING_BYTES = 131072;
constexpr int LDSCTL_OFF = RING_BYTES, MISC_OFF = LDSCTL_OFF + 320;
constexpr int LDS_BYTES = 147456;
constexpr int NWAVES = 8, NTHREADS = 512;

__device__ __forceinline__ unsigned f2bf(float f) { unsigned u = __builtin_bit_cast(unsigned, f); return (u + 0x7fffu + ((u >> 16) & 1u)) >> 16; }
__device__ __forceinline__ unsigned pk2(float lo, float hi) { return f2bf(lo) | (f2bf(hi) << 16); }
__device__ __forceinline__ float bflo(unsigned w) { return __uint_as_float(w << 16); }
__device__ __forceinline__ float bfhi(unsigned w) { return __uint_as_float(w & 0xffff0000u); }
__device__ __forceinline__ float bf2f(bf16 b) { return __uint_as_float((unsigned)b << 16); }
__device__ __forceinline__ float wave_sum(float v) {
#pragma unroll
    for (int o = 1; o < 64; o <<= 1) v += __shfl_xor(v, o);
    return v;
}
__device__ __forceinline__ float wave_max(float v) {
#pragma unroll
    for (int o = 1; o < 64; o <<= 1) v = fmaxf(v, __shfl_xor(v, o));
    return v;
}
__device__ __forceinline__ float sigmoidf_(float v) { return __builtin_amdgcn_rcpf(1.0f + __builtin_amdgcn_exp2f(-1.4426950408889634f * v)); }
__device__ __forceinline__ float gelu_erf(float v) { return 0.5f * v * (1.0f + erff(v * 0.70710678118654752f)); }
#define XB_TMO      128
#define XB_XCNT(j)  (256  + 64 * (j))
#define XB_XSUB(j)  (1280 + 64 * (j))
#define XB_XGEN(j)  (2304 + 64 * (j))
#define XB_TOP      3328
#define XB_TOPGEN   3392
#define XCD_BAR_WORDS 3456
#define XB_SPIN_CAP (1u << 18)

__device__ __forceinline__ unsigned xb_ld(unsigned* p)              { return __hip_atomic_load(p, __ATOMIC_RELAXED, __HIP_MEMORY_SCOPE_AGENT); }
__device__ __forceinline__ unsigned xb_add(unsigned* p, unsigned v) { return __hip_atomic_fetch_add(p, v, __ATOMIC_RELAXED, __HIP_MEMORY_SCOPE_AGENT); }
__device__ __forceinline__ unsigned xb_xcc_id() { return (unsigned)__builtin_amdgcn_s_getreg((3 << 11) | 20) & 0xFu; }
#define XB_SPIN(cond, bar) do { unsigned _sp = 0; while (cond) { __builtin_amdgcn_s_sleep(1); \
    if ((++_sp & 255u) == 0u) { if (xb_ld(&(bar)[XB_TMO])) break; if (_sp > XB_SPIN_CAP) { atomicAdd(&(bar)[XB_TMO], 1u); break; } } } } while (0)

struct XcdBarrier {
    unsigned* bar; unsigned x;
    volatile LAS unsigned* st;
};

__device__ __forceinline__ XcdBarrier xcd_barrier_post(unsigned* bar, volatile LAS unsigned* st) {
    XcdBarrier b; b.bar = bar; b.x = xb_xcc_id(); b.st = st;
    if (threadIdx.x == 0) (void)xb_add(&bar[XB_XCNT(b.x)], 1u);
    return b;
}
__device__ __forceinline__ void xcd_barrier_complete(unsigned* bar, unsigned x, unsigned& nloc, unsigned& nx) {
    const unsigned G = gridDim.x * gridDim.y * gridDim.z;
    unsigned sum, cnt, mine, sp = 0u;
    for (;;) {
        sum = 0u; cnt = 0u; mine = 0u;
#pragma unroll
        for (unsigned j = 0; j < 16; ++j) { const unsigned c = xb_ld(&bar[XB_XCNT(j)]); sum += c; cnt += (c > 0u) ? 1u : 0u; mine = (j == x) ? c : mine; }
        if (sum == G) break;
        __builtin_amdgcn_s_sleep(1);
        if ((++sp & 255u) == 0u) { if (xb_ld(&bar[XB_TMO])) break; if (sp > XB_SPIN_CAP) { atomicAdd(&bar[XB_TMO], 1u); break; } }
    }
    nloc = mine > 0u ? mine : 1u; nx = cnt > 0u ? cnt : 1u;
}

__device__ __forceinline__ void xcd_barrier(const XcdBarrier& b) {
    asm volatile("s_waitcnt vmcnt(0)" ::: "memory");
    __syncthreads();
    if (threadIdx.x == 0) {
        unsigned* bar = b.bar;
        __builtin_amdgcn_s_waitcnt(0);
        unsigned nloc = b.st[0], nx = b.st[1];
        if (nloc == 0u) { xcd_barrier_complete(bar, b.x, nloc, nx); b.st[0] = nloc; b.st[1] = nx; }
        const unsigned old = xb_add(&bar[XB_XSUB(b.x)], 1u);
        const unsigned gen = old / nloc;
        if (old + 1u == (gen + 1u) * nloc) {
            __builtin_amdgcn_fence(__ATOMIC_RELEASE, "agent");
            asm volatile("s_waitcnt vmcnt(0)" ::: "memory");
            const unsigned og = xb_add(&bar[XB_TOP], 1u);
            const unsigned tg = og / nx;
            if (og + 1u == (tg + 1u) * nx) xb_add(&bar[XB_TOPGEN], 1u);
            else XB_SPIN(xb_ld(&bar[XB_TOPGEN]) == tg, bar);
            __builtin_amdgcn_fence(__ATOMIC_ACQUIRE, "agent");
            xb_add(&bar[XB_XGEN(b.x)], 1u);
            asm volatile("s_waitcnt vmcnt(0)" ::: "memory");
        } else {
            XB_SPIN(xb_ld(&bar[XB_XGEN(b.x)]) == gen, bar);
            __builtin_amdgcn_fence(__ATOMIC_ACQUIRE, "agent");
            asm volatile("s_waitcnt vmcnt(0)" ::: "memory");
        }
    }
    __syncthreads();
}
struct Args { const float* in[24]; float* out; unsigned char* ws; int ph_lo, ph_hi; };
struct Frame {
    LAS unsigned char* lds; volatile LAS unsigned* MISC; gu32* ctl;
    int tid, lane, wave, vcu, G;
    unsigned char* ws; float* out;
};
#define WSP(T, off) ((T*)(F.ws + (off)))
#define LDS_WAIT() asm volatile("s_waitcnt lgkmcnt(0)" ::: "memory")

__device__ __forceinline__ void transpose_item(const float* W, int ldw, int K, bf16* WT, LAS float* scr, int k0, int nsrc0, int ndst0, int lane) {
#pragma unroll 8
    for (int i = 0; i < 32; ++i) { const int kk = 2 * i + (lane >> 5); scr[kk * 33 + (lane & 31)] = W[(size_t)(k0 + kk) * ldw + nsrc0 + (lane & 31)]; }
    LDS_WAIT(); asm volatile("" ::: "memory");
    const int c = lane & 7;
#pragma unroll
    for (int j = 0; j < 4; ++j) { const int n = (lane >> 3) + 8 * j; const LAS float* s = scr + (8 * c) * 33 + n;
        v4u o; o.x = pk2(s[0 * 33], s[1 * 33]); o.y = pk2(s[2 * 33], s[3 * 33]); o.z = pk2(s[4 * 33], s[5 * 33]); o.w = pk2(s[6 * 33], s[7 * 33]);
        *(GAS v4u*)(WT + (size_t)(ndst0 + n) * K + k0 + 8 * c) = o; }
    LDS_WAIT(); asm volatile("" ::: "memory");
}
__device__ __forceinline__ void cvt_stream(const float* src, bf16* dst, size_t n8, size_t i0, size_t stride) {
    for (size_t i = i0; i < n8; i += stride) { const f32x4 a = ((const GAS f32x4*)src)[2 * i], b = ((const GAS f32x4*)src)[2 * i + 1];
        v4u o; o.x = pk2(a[0], a[1]); o.y = pk2(a[2], a[3]); o.z = pk2(b[0], b[1]); o.w = pk2(b[2], b[3]); ((GAS v4u*)dst)[i] = o; }
}
__device__ __forceinline__ void cvt_stream_fp8(const float* src, unsigned char* dst, size_t n16, float scale, size_t i0, size_t stride) {
    for (size_t i = i0; i < n16; i += stride) { v4u o;
#pragma unroll
        for (int q = 0; q < 4; ++q) { const f32x4 a = ((const GAS f32x4*)src)[4 * i + q] * scale; int w = 0;
            w = __builtin_amdgcn_cvt_pk_fp8_f32(a[0], a[1], w, false); w = __builtin_amdgcn_cvt_pk_fp8_f32(a[2], a[3], w, true); o[q] = (unsigned)w; }
        ((GAS v4u*)dst)[i] = o; }
}
__device__ __forceinline__ void cvt_table_fp4(Frame& F, const float* srcT, unsigned char* dstT, float* rsT, int gw, int NGW) {
    for (int row = gw; row < PEER_NE; row += NGW) {
        const GAS f32x4* src = (const GAS f32x4*)(srcT + (size_t)row * DM); f32x4 a[16]; float am = 0.f;
#pragma unroll
        for (int c = 0; c < 4; ++c)
#pragma unroll
            for (int q = 0; q < 4; ++q) { a[4 * c + q] = src[c * 256 + 4 * F.lane + q]; am = fmaxf(fmaxf(am, fmaxf(fabsf(a[4 * c + q][0]), fabsf(a[4 * c + q][1]))), fmaxf(fabsf(a[4 * c + q][2]), fabsf(a[4 * c + q][3]))); }
        am = wave_max(am); const float inv = am > 0.f ? 6.0f / am : 0.f;
#pragma unroll
        for (int c = 0; c < 4; ++c) { v2u o;
#pragma unroll
            for (int d = 0; d < 2; ++d) { unsigned w = 0u; const f32x4 x0 = a[4 * c + 2 * d] * inv, x1 = a[4 * c + 2 * d + 1] * inv;
                w = __builtin_amdgcn_cvt_scalef32_pk_fp4_f32(w, x0[0], x0[1], 1.0f, 0); w = __builtin_amdgcn_cvt_scalef32_pk_fp4_f32(w, x0[2], x0[3], 1.0f, 1);
                w = __builtin_amdgcn_cvt_scalef32_pk_fp4_f32(w, x1[0], x1[1], 1.0f, 2); w = __builtin_amdgcn_cvt_scalef32_pk_fp4_f32(w, x1[2], x1[3], 1.0f, 3); o[d] = w; }
            *((GAS v2u*)(dstT + (size_t)row * 2048 + c * 512) + F.lane) = o; }
        if (F.lane == 0) rsT[row] = am * (1.0f / 6.0f);
    }
}
__device__ __forceinline__ void p0_prologue(Frame& F, const Args& args) {
    { LAS float* sc = (LAS float*)F.lds; LAS f32x4* red = (LAS f32x4*)(F.lds + 16384); float* MOD = WSP(float, WS_MOD);
      for (int cgi = blockIdx.x; cgi < 256; cgi += F.G) {
          for (int i = F.tid; i < DM; i += NTHREADS) { const float cv = args.in[1][i]; sc[i] = cv / (1.0f + __expf(-cv)); }
          __syncthreads();
          if (F.tid < 384) { const int cg = F.tid % 24, rg = F.tid / 24;
              const GAS f32x4* Wp = (const GAS f32x4*)args.in[2] + cgi * 24 + cg;
              f32x4 acc = {0.f, 0.f, 0.f, 0.f};
#pragma unroll 8
              for (int r = rg; r < DM; r += 16) acc += sc[r] * Wp[(size_t)r * 6144];
              red[rg * 24 + cg] = acc; }
          __syncthreads();
          if (F.tid < 24) { f32x4 s = red[F.tid];
#pragma unroll
              for (int rg = 1; rg < 16; ++rg) s += red[rg * 24 + F.tid];
              s += ((const GAS f32x4*)args.in[3])[cgi * 24 + F.tid]; ((GAS f32x4*)MOD)[cgi * 24 + F.tid] = s; }
          __syncthreads();
      } }
    LAS float* scr = (LAS float*)(F.lds + F.wave * 16384);
    const int gw = F.vcu * NWAVES + F.wave, NGW = F.G * NWAVES;
    constexpr int I_IN = 64 * 576, I_AO = 32 * 128, I_LO = 32 * 128, I_OUT = 64 * 128, I_PQ = 64 * 64, I_WA = 16 * 2 * 4, I_WX = I_WA;
    constexpr int NITEMS = I_IN + I_AO + I_LO + I_OUT + I_PQ + I_WA + I_WX;
    for (int it = gw; it < NITEMS; it += NGW) {
        int r = it;
        if (r < I_IN) { const int kb = r / 576, nb = r % 576; transpose_item(args.in[6], NIN, DM, WSP(bf16, WS_WIN), scr, 64 * kb, 32 * nb + (nb >= 192 ? 16 : 0), 32 * nb, F.lane); continue; } r -= I_IN;
        if (r < I_AO) { const int kb = r / 128, nb = r % 128; transpose_item(args.in[17], DM, AW, WSP(bf16, WS_WAO), scr, 64 * kb, 32 * nb, 32 * nb, F.lane); continue; } r -= I_AO;
        if (r < I_LO) { const int kb = r / 128, nb = r % 128; transpose_item(args.in[18], DM, LW, WSP(bf16, WS_WLO), scr, 64 * kb, 32 * nb, 32 * nb, F.lane); continue; } r -= I_LO;
        if (r < I_OUT) { const int kb = r / 128, nb = r % 128; transpose_item(args.in[19], DM, DM, WSP(bf16, WS_WOUT), scr, 64 * kb, 32 * nb, 32 * nb, F.lane); continue; } r -= I_OUT;
        if (r < I_PQ) { const int kb = r / 64, nb = r % 64; transpose_item(args.in[20], 2048, DM, WSP(bf16, WS_WPQ), scr, 64 * kb, 32 * nb, 32 * nb, F.lane); continue; } r -= I_PQ;
        { const bool isx = r >= I_WA; if (isx) r -= I_WA; const int g = r >> 3, kb = (r >> 2) & 1, nb = r & 3;
          transpose_item((isx ? args.in[14] : args.in[12]) + (size_t)g * GD * GD, GD, GD, WSP(bf16, isx ? WS_WXT : WS_WAT) + (size_t)g * GD * GD, scr, 64 * kb, 32 * nb, 32 * nb, F.lane); }
    }
    const size_t gt = (size_t)F.vcu * NTHREADS + F.tid, NGT = (size_t)F.G * NTHREADS;
    cvt_table_fp4(F, args.in[23], WSP(unsigned char, WS_V), WSP(float, WS_RS), gw, NGW);
    cvt_table_fp4(F, args.in[22], WSP(unsigned char, WS_U), WSP(float, WS_RSU), gw, NGW);
    cvt_stream(args.in[21], WSP(bf16, WS_SK), (size_t)PEER_H * 2 * 128 * 128 / 8, gt, NGT);
    for (size_t i = gt; i < (size_t)DM * 16; i += NGT) WSP(float, WS_WF)[i] = args.in[6][(i >> 4) * NIN + C_F + (i & 15)];
    for (size_t i = gt; i < (size_t)NINP; i += NGT) WSP(float, WS_BIASR)[i] = args.in[7][i + (i >= (size_t)C_F ? 16 : 0)];
}

__device__ __forceinline__ void p1_norm_forget(Frame& F, const Args& args) {
    const int gw = F.vcu * NWAVES + F.wave, NGW = F.G * NWAVES; const float* MOD = WSP(float, WS_MOD); const float* WF = WSP(float, WS_WF); bf16* HA = WSP(bf16, WS_HA);
    for (int rg = gw; rg < S / 4; rg += NGW) {
        const int r0 = rg * 4; float rstd[4];
#pragma unroll
        for (int r = 0; r < 4; ++r) { const GAS f32x4* xr = (const GAS f32x4*)(args.in[0] + (size_t)(r0 + r) * DM) + F.lane; float ss = 0.f;
#pragma unroll
            for (int j = 0; j < 16; ++j) { const f32x4 v = xr[64 * j]; ss += (v[0] * v[0] + v[1] * v[1]) + (v[2] * v[2] + v[3] * v[3]); }
            rstd[r] = 1.0f / sqrtf(wave_sum(ss) * (1.0f / DM) + EPS); }
        float acc[4][16];
#pragma unroll
        for (int r = 0; r < 4; ++r)
#pragma unroll
            for (int cc = 0; cc < 16; ++cc) acc[r][cc] = 0.f;
        for (int j = 0; j < 16; ++j) {
            const int i4 = F.lane + 64 * j;
            const f32x4 g = ((const GAS f32x4*)args.in[4])[i4], scl = ((const GAS f32x4*)(MOD + 4096))[i4], sh = ((const GAS f32x4*)MOD)[i4];
            const f32x4 mul = g * (scl + 1.0f);
            f32x4 wf[4][4];
#pragma unroll
            for (int i = 0; i < 4; ++i)
#pragma unroll
                for (int q = 0; q < 4; ++q) wf[i][q] = ((const GAS f32x4*)(WF + (size_t)(4 * i4 + i) * 16))[q];
#pragma unroll
            for (int r = 0; r < 4; ++r) {
                const f32x4 xv = ((const GAS f32x4*)(args.in[0] + (size_t)(r0 + r) * DM))[i4];
                const f32x4 hv = xv * rstd[r] * mul + sh;
                v2u o; o.x = pk2(hv[0], hv[1]); o.y = pk2(hv[2], hv[3]);
                ((GAS v2u*)(HA + (size_t)(r0 + r) * DM))[i4] = o;
#pragma unroll
                for (int i = 0; i < 4; ++i)
#pragma unroll
                    for (int q = 0; q < 4; ++q)
#pragma unroll
                        for (int e = 0; e < 4; ++e) acc[r][4 * q + e] += hv[i] * wf[i][q][e];
            }
        }
#pragma unroll
        for (int r = 0; r < 4; ++r)
#pragma unroll
            for (int cc = 0; cc < 16; ++cc) { const float tot = wave_sum(acc[r][cc]);
                if (F.lane == cc) { const float f = tot + args.in[7][C_F + cc]; WSP(float, WS_LOGF)[(size_t)(r0 + r) * 16 + cc] = fminf(f, 0.f) - log1pf(__expf(-fabsf(f))); } }
    }
}

__device__ __forceinline__ void p3_qknorm(Frame& F, const Args& args) {
    const int gw = F.vcu * NWAVES + F.wave, NGW = F.G * NWAVES; bf16* QK = WSP(bf16, WS_QKV);
    const int sub = F.lane & 15;
    f32x4 gq0 = ((const GAS f32x4*)args.in[8])[2 * sub], gq1 = ((const GAS f32x4*)args.in[8])[2 * sub + 1], gk0 = ((const GAS f32x4*)args.in[9])[2 * sub], gk1 = ((const GAS f32x4*)args.in[9])[2 * sub + 1];
    for (int it = gw; it < 2 * S * NH / 4; it += NGW) {
        const size_t unit = (size_t)it * 4 + (F.lane >> 4); const bool isk = unit >= (size_t)S * NH;
        GAS v4u* p = (GAS v4u*)(QK + unit * 128) + sub; const v4u w = *p;
        f32x4 a = {bflo(w.x), bfhi(w.x), bflo(w.y), bfhi(w.y)}, b = {bflo(w.z), bfhi(w.z), bflo(w.w), bfhi(w.w)};
        float ss = (a[0] * a[0] + a[1] * a[1]) + (a[2] * a[2] + a[3] * a[3]) + (b[0] * b[0] + b[1] * b[1]) + (b[2] * b[2] + b[3] * b[3]);
        ss += __shfl_xor(ss, 1); ss += __shfl_xor(ss, 2); ss += __shfl_xor(ss, 4); ss += __shfl_xor(ss, 8);
        const float rs = 1.0f / sqrtf(ss * (1.0f / HD) + EPS);
        a = a * rs * (isk ? gk0 : gq0); b = b * rs * (isk ? gk1 : gq1);
        v4u o; o.x = pk2(a[0], a[1]); o.y = pk2(a[2], a[3]); o.z = pk2(b[0], b[1]); o.w = pk2(b[2], b[3]); *p = o;
    }
}
__device__ __forceinline__ void p3_cumsum(Frame& F, const Args& args) {
    LAS float* wt = (LAS float*)F.lds;
    for (int h = blockIdx.x; h < NH; h += F.G) {
        const float* LF = WSP(float, WS_LOGF); float v[16]; float run = 0.f;
#pragma unroll
        for (int i = 0; i < 16; ++i) { run += LF[(size_t)(F.tid * 16 + i) * 16 + h]; v[i] = run; }
        float sc = run;
#pragma unroll
        for (int o = 1; o < 64; o <<= 1) { const float t = __shfl_up(sc, o); if (F.lane >= o) sc += t; }
        if (F.lane == 63) wt[F.wave] = sc;
        __syncthreads();
        float pre = sc - run;
        for (int w = 0; w < F.wave; ++w) pre += wt[w];
        float* Fo = WSP(float, WS_FC) + (size_t)h * S + F.tid * 16;
#pragma unroll
        for (int i = 0; i < 4; ++i) ((GAS f32x4*)Fo)[i] = (f32x4){v[4 * i] + pre, v[4 * i + 1] + pre, v[4 * i + 2] + pre, v[4 * i + 3] + pre};
        __syncthreads();
    }
}
constexpr int LRU_XCF = 0, LRU_XCB = 32768, LRU_AB = 49152, LRU_BB = 81920, LRU_QA = 114688, LRU_CAR = 118784;
template <int PASS> __device__ __forceinline__ void lru_unit(Frame& F, const Args& args, int c, int g) {
    LAS float* XCF = (LAS float*)(F.lds + LRU_XCF); LAS unsigned char* XCB = F.lds + LRU_XCB; LAS float* AB = (LAS float*)(F.lds + LRU_AB); LAS float* BB = (LAS float*)(F.lds + LRU_BB);
    LAS float* QA = (LAS float*)(F.lds + LRU_QA); LAS float* CAR = (LAS float*)(F.lds + LRU_CAR);
    const int t0 = 64 * c, ch0 = GD * g; const bf16* LX = WSP(bf16, WS_LX);
    { const int ch = F.tid & 127, tq = F.tid >> 7, gch = ch0 + ch;
      const float w0 = args.in[10][gch], w1 = args.in[10][LW + gch], w2 = args.in[10][2 * LW + gch], w3 = args.in[10][3 * LW + gch], cb = args.in[11][gch];
      float xm3, xm2, xm1; { const int tb = t0 + 16 * tq;
          xm3 = tb - 3 >= 0 ? bf2f(LX[(size_t)(tb - 3) * LW + gch]) : 0.f; xm2 = tb - 2 >= 0 ? bf2f(LX[(size_t)(tb - 2) * LW + gch]) : 0.f; xm1 = tb - 1 >= 0 ? bf2f(LX[(size_t)(tb - 1) * LW + gch]) : 0.f; }
#pragma unroll
      for (int i = 0; i < 16; ++i) { const int t = 16 * tq + i; const float x0 = bf2f(LX[(size_t)(t0 + t) * LW + gch]);
          const float xc = w0 * xm3 + w1 * xm2 + w2 * xm1 + w3 * x0 + cb; xm3 = xm2; xm2 = xm1; xm1 = x0;
          XCF[t * 128 + ch] = xc; *(LAS bf16*)(XCB + t * 256 + ((ch * 2) ^ ((t & 7) << 4))) = (bf16)f2bf(xc); } }
    __syncthreads();
    { const int fr = F.lane & 15, fq = F.lane >> 4, j = 16 * F.wave + fr;
      const bf16* WA = WSP(bf16, WS_WAT) + (size_t)g * GD * GD + (size_t)j * GD + 8 * fq; const bf16* WX = WSP(bf16, WS_WXT) + (size_t)g * GD * GD + (size_t)j * GD + 8 * fq;
      bf16x8 ba[4], bx[4];
#pragma unroll
      for (int ks = 0; ks < 4; ++ks) { ba[ks] = *(const GAS bf16x8*)(WA + 32 * ks); bx[ks] = *(const GAS bf16x8*)(WX + 32 * ks); }
      const int gch = ch0 + j; const float bav = args.in[13][gch], bxv = args.in[15][gch], lam = args.in[16][gch];
      const float sp = (lam > 0.f ? 0.f : -lam) + log1pf(__expf(-fabsf(lam)));
#pragma unroll
      for (int mt = 0; mt < 4; ++mt) { f32x4 ar = {0.f, 0.f, 0.f, 0.f}, ax = {0.f, 0.f, 0.f, 0.f}; const int t = 16 * mt + fr;
#pragma unroll
          for (int ks = 0; ks < 4; ++ks) { const bf16x8 af = *(const LAS bf16x8*)(XCB + t * 256 + (((32 * ks + 8 * fq) * 2) ^ ((t & 7) << 4)));
              ar = __builtin_amdgcn_mfma_f32_16x16x32_bf16(af, ba[ks], ar, 0, 0, 0); ax = __builtin_amdgcn_mfma_f32_16x16x32_bf16(af, bx[ks], ax, 0, 0, 0); }
#pragma unroll
          for (int rg = 0; rg < 4; ++rg) { const int tt = 16 * mt + 4 * fq + rg; const float xcv = XCF[tt * 128 + j];
              const float rgt = sigmoidf_(ar[rg] + bav), igt = sigmoidf_(ax[rg] + bxv);
              const float log_a = -8.0f * rgt * sp; const float a = __expf(log_a); const float b = sqrtf(-expm1f(2.0f * log_a)) * (igt * xcv);
              AB[tt * 128 + j] = a; BB[tt * 128 + j] = b; } } }
    __syncthreads();
    const int ch = F.tid & 127, q = F.tid >> 7;
    { float A = 1.f, B = 0.f;
#pragma unroll
      for (int i = 0; i < 16; ++i) { const int t = 16 * q + i; const float a = AB[t * 128 + ch]; B = a * B + BB[t * 128 + ch]; A *= a; }
      QA[(q * 128 + ch) * 2] = A; QA[(q * 128 + ch) * 2 + 1] = B; }
    if (PASS == 1 && F.tid < 128) {
        const float* GA_ = WSP(float, WS_AGGA) + ch0 + F.tid; const float* GB_ = WSP(float, WS_AGGB) + ch0 + F.tid; float hcar = 0.f;
        for (int cc = 0; cc < c; ++cc) hcar = GA_[(size_t)cc * LW] * hcar + GB_[(size_t)cc * LW];
        CAR[F.tid] = hcar; }
    __syncthreads();
    if (PASS == 0) {
        if (F.tid < 128) { float A = 1.f, B = 0.f;
#pragma unroll
            for (int qq = 0; qq < 4; ++qq) { const float a = QA[(qq * 128 + F.tid) * 2], b = QA[(qq * 128 + F.tid) * 2 + 1]; B = a * B + b; A *= a; }
            WSP(float, WS_AGGA)[(size_t)c * LW + ch0 + F.tid] = A; WSP(float, WS_AGGB)[(size_t)c * LW + ch0 + F.tid] = B; }
    } else {
        float h = CAR[ch];
        for (int qq = 0; qq < q; ++qq) h = QA[(qq * 128 + ch) * 2] * h + QA[(qq * 128 + ch) * 2 + 1];
        const bf16* GY = WSP(bf16, WS_GY); bf16* LR = WSP(bf16, WS_LR);
#pragma unroll
        for (int i = 0; i < 16; ++i) { const int t = 16 * q + i; h = AB[t * 128 + ch] * h + BB[t * 128 + ch];
            const size_t o = (size_t)(t0 + t) * LW + ch0 + ch; LR[o] = (bf16)f2bf(h * bf2f(GY[o])); }
    }
    __syncthreads();
}
constexpr int ATT_BIAS_OFF = attn_body::LDS_BYTES;
typedef attn_body::BlockRef<bf16, bf16> ARef;
__device__ __forceinline__ int attn_jlo(const float* Fh, int qb, float TH, int lane) {
    const int t0 = qb * 256; const float f0 = Fh[t0];
    const int j0 = lane, j1 = lane + 64;
    const bool ok0 = (64 * j0 + 63 >= t0) || (f0 - Fh[64 * j0 + 63] >= -TH), ok1 = (64 * j1 + 63 >= t0) || (f0 - Fh[64 * j1 + 63] >= -TH);
    const unsigned long long m0 = __ballot(ok0), m1 = __ballot(ok1);
    return m0 ? (int)__builtin_ctzll(m0) : 64 + (int)__builtin_ctzll(m1);
}
__device__ __forceinline__ ARef attn_ref(Frame& F, const Args& args, int h, int qb, int jlo) {
    ARef r; const bf16* QK = WSP(bf16, WS_QKV);
    r.Q = QK + (size_t)(qb * 256) * AW + h * HD; r.K = QK + (size_t)S * AW + h * HD; r.V = QK + 2 * (size_t)S * AW + h * HD;
    r.O = WSP(bf16, WS_ATT) + (size_t)(qb * 256) * AW + h * HD; r.P0 = qb * 256; r.jlo = jlo; return r;
}
__device__ __forceinline__ void attn_fill_bias(Frame& F, const Args& args, int h, int qb, int jlo) {
    const float* Fh = WSP(float, WS_FC) + (size_t)h * S; LAS float* bl = (LAS float*)(F.lds + ATT_BIAS_OFF);
    const int k0 = jlo * 64, n = (qb + 1) * 256 - k0; const float fr = Fh[k0];
#pragma unroll 1
    for (int i = F.tid; i < n; i += NTHREADS) bl[i] = (fr - Fh[k0 + i]) * (1.0f / attn_body::SCALE);
}
#ifndef ATT_WINDOW
#define ATT_WINDOW 1
#endif
__device__ __forceinline__ void p4_attention(Frame& F, const Args& args, char* lds_generic) {
    float gq = fmaxf(fabsf(args.in[8][F.lane]), fabsf(args.in[8][F.lane + 64])), gk = fmaxf(fabsf(args.in[9][F.lane]), fabsf(args.in[9][F.lane + 64]));
    gq = wave_max(gq); gk = wave_max(gk);
    const float TH = 2.0f * (128.0f * gq * gk * attn_body::SCALE) + 40.0f;
    for (int L = blockIdx.x; L < NH * 16; L += F.G) {
        const int h = L >> 4, x = L & 15, qb0 = x, qb1 = 31 - x; const float* Fh = WSP(float, WS_FC) + (size_t)h * S;
        const int jl0 = ATT_WINDOW ? attn_jlo(Fh, qb0, TH, F.lane) : 0, jl1 = ATT_WINDOW ? attn_jlo(Fh, qb1, TH, F.lane) : 0;
        const ARef r0 = attn_ref(F, args, h, qb0, jl0), r1 = attn_ref(F, args, h, qb1, jl1);
        attn_fill_bias(F, args, h, qb0, jl0); __syncthreads();
        attn_body::attn_unit<bf16, bf16>(r0, S, lds_generic);
        attn_fill_bias(F, args, h, qb1, jl1); __syncthreads();
        attn_body::attn_unit<bf16, bf16>(r1, S, lds_generic);
        asm volatile("s_waitcnt vmcnt(0)" ::: "memory"); __syncthreads();
    }
}

__device__ __forceinline__ void p7_norm2(Frame& F, const Args& args) {
    const int gw = F.vcu * NWAVES + F.wave, NGW = F.G * NWAVES; const float* MOD = WSP(float, WS_MOD); bf16* HA = WSP(bf16, WS_HA);
    for (int m = gw; m < S; m += NGW) {
        const GAS f32x4* xr = (const GAS f32x4*)(WSP(float, WS_X1) + (size_t)m * DM) + F.lane; f32x4 v[16]; float ss = 0.f;
#pragma unroll
        for (int j = 0; j < 16; ++j) { v[j] = xr[64 * j]; ss += (v[j][0] * v[j][0] + v[j][1] * v[j][1]) + (v[j][2] * v[j][2] + v[j][3] * v[j][3]); }
        const float rstd = 1.0f / sqrtf(wave_sum(ss) * (1.0f / DM) + EPS);
#pragma unroll
        for (int j = 0; j < 16; ++j) { const int i4 = F.lane + 64 * j;
            const f32x4 g = ((const GAS f32x4*)args.in[5])[i4], scl = ((const GAS f32x4*)(MOD + 16384))[i4], sh = ((const GAS f32x4*)(MOD + 12288))[i4];
            const f32x4 hv = v[j] * rstd * (g * (scl + 1.0f)) + sh;
            v2u o; o.x = pk2(hv[0], hv[1]); o.y = pk2(hv[2], hv[3]); ((GAS v2u*)(HA + (size_t)m * DM))[i4] = o; }
    }
}

template <int CTRL> __device__ __forceinline__ unsigned dppu(unsigned x) { return (unsigned)__builtin_amdgcn_update_dpp(0, (int)x, CTRL, 0xF, 0xF, true); }
__device__ __forceinline__ unsigned rowmax_u32(unsigned x) { x = max(x, dppu<0xB1>(x)); x = max(x, dppu<0x4E>(x)); x = max(x, dppu<0x141>(x)); x = max(x, dppu<0x140>(x)); return x; }
__device__ __forceinline__ float rowsum_f32(float x) { x += __uint_as_float(dppu<0xB1>(__float_as_uint(x))); x += __uint_as_float(dppu<0x4E>(__float_as_uint(x)));
    x += __uint_as_float(dppu<0x141>(__float_as_uint(x))); x += __uint_as_float(dppu<0x140>(__float_as_uint(x))); return x; }
__device__ __forceinline__ unsigned ordk(float f) { const unsigned u = __float_as_uint(f); return u ^ ((unsigned)((int)u >> 31) | 0x80000000u); }
__device__ __forceinline__ float deck(unsigned k) { return __uint_as_float((k & 0x80000000u) ? (k ^ 0x80000000u) : ~k); }
#define CE_(x, y) do { const unsigned hi_ = max(x, y), lo_ = min(x, y); x = hi_; y = lo_; } while (0)
__device__ __forceinline__ unsigned row_pop16(unsigned (&a)[8], int i) {
    unsigned res = 0u;
#pragma unroll
    for (int r = 0; r < 16; ++r) { const unsigned m = rowmax_u32(a[0]); const bool win = a[0] == m;
#pragma unroll
        for (int s = 0; s < 7; ++s) a[s] = win ? a[s + 1] : a[s];
        a[7] = win ? 0u : a[7]; res = (i == r) ? m : res; }
    return res;
}
__device__ __forceinline__ void p9_topk(Frame& F, const Args& args) {
    const bf16* Q2 = WSP(bf16, WS_Q2); const bf16* SK = WSP(bf16, WS_SK); int* IDX = WSP(int, WS_IDX); float* GATE = WSP(float, WS_GATE);
    const int gw = F.vcu * NWAVES + F.wave, NGW = F.G * NWAVES; const int i = F.lane & 15, q = F.lane >> 4;
    const unsigned qlo = (unsigned)(i * 2048 + 8 * q) * 2u, klo = (unsigned)(i * 128 + 8 * q) * 2u;
#pragma unroll 1
    for (int u = gw; u < (S / 16) * PEER_H; u += NGW) {
        const int t0 = 16 * (u >> 3), h = u & 7;
        unsigned R[2][4];
#pragma unroll
        for (int p = 0; p < 2; ++p) {
            bf16x8 af[4];
            const char* qb_ = (const char*)Q2 + ((size_t)t0 * 2048 + h * 256 + p * 128) * 2;
            const char* kb_ = (const char*)SK + (size_t)((h * 2 + p) * 128) * 256;
#pragma unroll
            for (int ks = 0; ks < 4; ++ks) af[ks] = *(const GAS bf16x8*)(qb_ + 64 * ks + qlo);
            f32x4 acc[8]; bf16x8 bc[4], bn[4];
#pragma unroll
            for (int ks = 0; ks < 4; ++ks) bc[ks] = *(const GAS bf16x8*)(kb_ + 64 * ks + klo);
#pragma unroll
            for (int nt = 0; nt < 8; ++nt) { acc[nt] = (f32x4){0.f, 0.f, 0.f, 0.f};
                if (nt < 7) {
#pragma unroll
                    for (int ks = 0; ks < 4; ++ks) bn[ks] = *(const GAS bf16x8*)(kb_ + 4096 * (nt + 1) + 64 * ks + klo); }
#pragma unroll
                for (int ks = 0; ks < 4; ++ks) acc[nt] = __builtin_amdgcn_mfma_f32_16x16x32_bf16(af[ks], bc[ks], acc[nt], 0, 0, 0);
#pragma unroll
                for (int ks = 0; ks < 4; ++ks) bc[ks] = bn[ks];
                __builtin_amdgcn_sched_barrier(0); }
#pragma unroll
            for (int r = 0; r < 4; ++r) { unsigned a[8];
#pragma unroll
                for (int nt = 0; nt < 8; ++nt) a[nt] = (ordk(acc[nt][r]) & ~0x7Fu) | (unsigned)(16 * nt + i);
                CE_(a[0], a[1]); CE_(a[2], a[3]); CE_(a[4], a[5]); CE_(a[6], a[7]); CE_(a[0], a[2]); CE_(a[1], a[3]); CE_(a[4], a[6]); CE_(a[5], a[7]); CE_(a[1], a[2]); CE_(a[5], a[6]);
                CE_(a[0], a[4]); CE_(a[1], a[5]); CE_(a[2], a[6]); CE_(a[3], a[7]); CE_(a[2], a[4]); CE_(a[3], a[5]); CE_(a[1], a[2]); CE_(a[3], a[4]); CE_(a[5], a[6]);
                R[p][r] = row_pop16(a, i); __builtin_amdgcn_sched_barrier(0); }
        }
#pragma unroll
        for (int r = 0; r < 4; ++r) {
            const unsigned R0 = R[0][r], R1 = R[1][r]; const float f0 = deck(R0 & ~0x7Fu), f1 = deck(R1 & ~0x7Fu); const int n0 = (int)(R0 & 0x7Fu), n1 = (int)(R1 & 0x7Fu);
            const unsigned f1u = __float_as_uint(f1); unsigned c[8];
#define CAND_(b, lim) do { const unsigned t_ = (ordk(f0 + __uint_as_float(dppu<0x150 + (b)>(f1u))) & ~0xFFu) | (unsigned)(255 - (i * 16 + (b))); c[b] = (i < (lim)) ? t_ : 0u; } while (0)
            CAND_(0, 16); CAND_(1, 8); CAND_(2, 5); CAND_(3, 4); CAND_(4, 3); CAND_(5, 2); CAND_(6, 2); CAND_(7, 2);
#undef CAND_
            { const float ex = __uint_as_float(dppu<0x150>(__float_as_uint(f0))) + f1; const unsigned exk = (ordk(ex) & ~0xFFu) | (unsigned)(255 - i); c[1] = (i >= 8) ? exk : c[1]; }
            CE_(c[0], c[1]);
            const unsigned G = row_pop16(c, i);
            const float val = deck(G & ~0xFFu); const int id = 255 - (int)(G & 0xFFu); const int rb = F.lane & 48;
            const int ea = __shfl(n0, rb + (id >> 4)), eb = __shfl(n1, rb + (id & 15));
            const float mx = __uint_as_float(dppu<0x150>(__float_as_uint(val))); const float ex = __expf(val - mx); const float sm = rowsum_f32(ex);
            const size_t o = (size_t)(t0 + 4 * q + r) * 128 + h * 16 + i; IDX[o] = ea * 128 + eb; GATE[o] = ex / sm; __builtin_amdgcn_sched_barrier(0);
        }
    }
}
#undef CE_

constexpr float U_SCALE = 256.0f, V_SCALE = 1.0f;
#ifndef PEER_SORT
#define PEER_SORT 0
#endif
__device__ __forceinline__ float gelu_as(float v) {
    const float av = fabsf(v), tt = __builtin_amdgcn_rcpf(av * 0.2316418882f + 1.0f);
    float q = tt * 0.5307027145f + (-0.7265760135f); q = q * tt + 0.7107068705f; q = q * tt + (-0.142248368f); q = q * tt + 0.127414796f; q = q * tt;
    const float m = v * (q * __builtin_amdgcn_exp2f((v * v) * (-0.72134752044f)));
    return v < 0.f ? m : v - m;
}
__device__ __forceinline__ float wave_sum_dpp(float x) {
    x = rowsum_f32(x);
    return (__uint_as_float(__builtin_amdgcn_readlane(__float_as_uint(x), 0)) + __uint_as_float(__builtin_amdgcn_readlane(__float_as_uint(x), 16)))
         + (__uint_as_float(__builtin_amdgcn_readlane(__float_as_uint(x), 32)) + __uint_as_float(__builtin_amdgcn_readlane(__float_as_uint(x), 48)));
}
#define LOADROWS(T, ra_, rb_, ee) do { const int e2_ = (ee) & 127; const int ea_ = __builtin_amdgcn_readlane(e2_ < 64 ? id0 : id1, e2_ & 63), eb_ = __builtin_amdgcn_readlane(e2_ < 64 ? id0 : id1, (e2_ + 1) & 63); \
        const GAS v4u* pa_ = (const GAS v4u*)((T) + (size_t)ea_ * DM) + F.lane; const GAS v4u* pb_ = (const GAS v4u*)((T) + (size_t)eb_ * DM) + F.lane; \
        _Pragma("unroll") for (int c = 0; c < 4; ++c) { ra_[c] = pa_[64 * c]; rb_[c] = pb_[64 * c]; } } while (0)
#define UDOT(r_, out_) do { f32x2 s0_ = {0.f, 0.f}, s1_ = {0.f, 0.f}, s2_ = {0.f, 0.f}, s3_ = {0.f, 0.f}; \
        _Pragma("unroll") for (int c = 0; c < 4; ++c) _Pragma("unroll") for (int d = 0; d < 2; ++d) { \
            const f32x2 p0_ = __builtin_amdgcn_cvt_scalef32_pk_f32_fp4(r_[c][d], 1.0f, 0), p1_ = __builtin_amdgcn_cvt_scalef32_pk_f32_fp4(r_[c][d], 1.0f, 1), \
                        p2_ = __builtin_amdgcn_cvt_scalef32_pk_f32_fp4(r_[c][d], 1.0f, 2), p3_ = __builtin_amdgcn_cvt_scalef32_pk_f32_fp4(r_[c][d], 1.0f, 3); \
            s0_ = p0_ * hx[8 * c + 4 * d] + s0_; s1_ = p1_ * hx[8 * c + 4 * d + 1] + s1_; s2_ = p2_ * hx[8 * c + 4 * d + 2] + s2_; s3_ = p3_ * hx[8 * c + 4 * d + 3] + s3_; } \
        out_ = ((s0_.x + s0_.y) + (s1_.x + s1_.y)) + ((s2_.x + s2_.y) + (s3_.x + s3_.y)); } while (0)
#define UPAIR(ra_, rb_, ee) do { float sa_, sb_; UDOT(ra_, sa_); UDOT(rb_, sb_); sa_ = wave_sum_dpp(sa_); sb_ = wave_sum_dpp(sb_); \
        const int e2_ = (ee); const int ea_ = __builtin_amdgcn_readlane(e2_ < 64 ? id0 : id1, e2_ & 63), eb_ = __builtin_amdgcn_readlane(e2_ < 64 ? id0 : id1, (e2_ + 1) & 63); \
        const f32x2 a2_ = pg8::gelu_pk((f32x2){sa_ * RSU[ea_], sb_ * RSU[eb_]}); \
        if ((ee) < 64) { if (F.lane == (ee)) w0 = a2_.x * g0; if (F.lane == (ee) + 1) w0 = a2_.y * g0; } else { if (F.lane == (ee) - 64) w1 = a2_.x * g1; if (F.lane == (ee) - 63) w1 = a2_.y * g1; } } while (0)
#define LOADROWS4(T, ra_, rb_, ee) do { const int e2_ = (ee) & 127; const int ea_ = __builtin_amdgcn_readlane(e2_ < 64 ? id0 : id1, e2_ & 63), eb_ = __builtin_amdgcn_readlane(e2_ < 64 ? id0 : id1, (e2_ + 1) & 63); \
        const GAS v2u* pa_ = (const GAS v2u*)((T) + (size_t)ea_ * 2048) + F.lane; const GAS v2u* pb_ = (const GAS v2u*)((T) + (size_t)eb_ * 2048) + F.lane; \
        _Pragma("unroll") for (int c = 0; c < 4; ++c) { ra_[c] = pa_[64 * c]; rb_[c] = pb_[64 * c]; } } while (0)
#define VAXPY(r_, w_) do { const f32x2 w2_ = {w_, w_}; \
        _Pragma("unroll") for (int c = 0; c < 4; ++c) _Pragma("unroll") for (int d = 0; d < 2; ++d) { \
            const f32x2 p0_ = __builtin_amdgcn_cvt_scalef32_pk_f32_fp4(r_[c][d], 1.0f, 0), p1_ = __builtin_amdgcn_cvt_scalef32_pk_f32_fp4(r_[c][d], 1.0f, 1), \
                        p2_ = __builtin_amdgcn_cvt_scalef32_pk_f32_fp4(r_[c][d], 1.0f, 2), p3_ = __builtin_amdgcn_cvt_scalef32_pk_f32_fp4(r_[c][d], 1.0f, 3); \
            acc[8 * c + 4 * d] = p0_ * w2_ + acc[8 * c + 4 * d]; acc[8 * c + 4 * d + 1] = p1_ * w2_ + acc[8 * c + 4 * d + 1]; \
            acc[8 * c + 4 * d + 2] = p2_ * w2_ + acc[8 * c + 4 * d + 2]; acc[8 * c + 4 * d + 3] = p3_ * w2_ + acc[8 * c + 4 * d + 3]; } } while (0)
#define VPAIR(ra_, rb_, ee) do { const int e2_ = (ee); const int ea_ = __builtin_amdgcn_readlane(e2_ < 64 ? id0 : id1, e2_ & 63), eb_ = __builtin_amdgcn_readlane(e2_ < 64 ? id0 : id1, (e2_ + 1) & 63); \
        const float wa_ = __uint_as_float(__builtin_amdgcn_readlane(__float_as_uint((ee) < 64 ? w0 : w1), (ee) & 63)) * RS[ea_], wb_ = __uint_as_float(__builtin_amdgcn_readlane(__float_as_uint((ee) < 64 ? w0 : w1), ((ee) + 1) & 63)) * RS[eb_]; \
        VAXPY(ra_, wa_); VAXPY(rb_, wb_); } while (0)
template <int MODE> __device__ __forceinline__ void p10_peer(Frame& F, const Args& args) {
    const int gw = F.vcu * NWAVES + F.wave, NGW = F.G * NWAVES; const float* MOD = WSP(float, WS_MOD);
    const bf16* H2 = WSP(bf16, WS_HA); const unsigned char* U = WSP(unsigned char, WS_U); const unsigned char* V = WSP(unsigned char, WS_V); const int* IDX = WSP(int, WS_IDX); const float* GATE = WSP(float, WS_GATE); const float* RS = WSP(float, WS_RS); const float* RSU = WSP(float, WS_RSU);
#pragma unroll 1
    for (int t = gw; t < S; t += NGW) {
        const int id0 = IDX[(size_t)t * 128 + F.lane], id1 = IDX[(size_t)t * 128 + 64 + F.lane];
        const float g0 = GATE[(size_t)t * 128 + F.lane], g1 = GATE[(size_t)t * 128 + 64 + F.lane];
        float w0 = 0.f, w1 = 0.f;
        {   f32x2 hx[32];
#pragma unroll
            for (int c = 0; c < 4; ++c) { const GAS v4u* hp = (const GAS v4u*)(H2 + (size_t)t * DM + c * 1024 + F.lane * 16); const v4u a = hp[0], b = hp[1];
#pragma unroll
                for (int k = 0; k < 4; ++k) { hx[8 * c + k] = (f32x2){bflo(a[k]), bfhi(a[k])}; hx[8 * c + 4 + k] = (f32x2){bflo(b[k]), bfhi(b[k])}; } }
            v2u ra[4], rb[4], na[4], nb[4];
            if (MODE != 2) {
            LOADROWS4(U, ra, rb, 0);
#pragma unroll 1
            for (int e = 0; e < 128; e += 4) {
                LOADROWS4(U, na, nb, e + 2);
                if (MODE == 3) { unsigned x_ = 0; _Pragma("unroll") for (int c = 0; c < 4; ++c) _Pragma("unroll") for (int k = 0; k < 4; ++k) x_ ^= ra[c][k & 1] ^ rb[c][k & 1]; w0 += __uint_as_float(x_ & 1u); } else
                UPAIR(ra, rb, e);
                LOADROWS4(U, ra, rb, e + 4);
                if (MODE == 3) { unsigned x_ = 0; _Pragma("unroll") for (int c = 0; c < 4; ++c) _Pragma("unroll") for (int k = 0; k < 4; ++k) x_ ^= na[c][k & 1] ^ nb[c][k & 1]; w0 += __uint_as_float(x_ & 1u); } else
                UPAIR(na, nb, e + 2);
            } } }
        if (MODE == 1 || MODE == 3) { asm volatile("" :: "v"(w0), "v"(w1)); continue; }
        f32x2 acc[32];
#pragma unroll
        for (int j = 0; j < 32; ++j) acc[j] = (f32x2){0.f, 0.f};
        {   v2u ra[4], rb[4], na[4], nb[4];
            LOADROWS4(V, ra, rb, 0);
#pragma unroll 1
            for (int e = 0; e < 128; e += 4) {
                LOADROWS4(V, na, nb, e + 2);
                VPAIR(ra, rb, e);
                LOADROWS4(V, ra, rb, e + 4);
                VPAIR(na, nb, e + 2);
            } }
        if (MODE == 2) {
#pragma unroll
            for (int j = 0; j < 32; ++j) asm volatile("" :: "v"(acc[j]));
            continue; }
#pragma unroll
        for (int c = 0; c < 4; ++c) { const int col = c * 1024 + F.lane * 16; GAS f32x4* op = (GAS f32x4*)(F.out + (size_t)t * DM + col);
            const GAS f32x4* xp = (const GAS f32x4*)(WSP(float, WS_X1) + (size_t)t * DM + col); const GAS f32x4* gp = (const GAS f32x4*)(MOD + 20480 + col);
#pragma unroll
            for (int q = 0; q < 4; ++q) op[q] = xp[q] + gp[q] * (f32x4){acc[8 * c + 2 * q].x, acc[8 * c + 2 * q].y, acc[8 * c + 2 * q + 1].x, acc[8 * c + 2 * q + 1].y}; }
    }
}
#undef LOADROWS
#undef UDOT
#undef UPAIR
#undef VAXPY
#undef VPAIR
#undef LOADROWS4
#ifndef MK_SINGLE
#define MK_SINGLE 1
#endif
constexpr int N_PHASES = 11;
__global__ void __launch_bounds__(NTHREADS, 2) fwd_kernel(Args args) {
    extern __shared__ __attribute__((aligned(16))) unsigned char lds[];
    Frame F;
    F.lds = (LAS unsigned char*)lds; F.MISC = (volatile LAS unsigned*)(F.lds + MISC_OFF);
    F.tid = threadIdx.x; F.lane = F.tid & 63; F.wave = __builtin_amdgcn_readfirstlane(F.tid >> 6);
    F.G = gridDim.x; { const int bx = blockIdx.x; F.vcu = (F.G % 8 == 0) ? (bx % 8) * (F.G / 8) + bx / 8 : bx; }
    F.ws = args.ws; F.out = args.out; F.ctl = (gu32*)(args.ws + WS_CTL);
    for (int u = F.tid; u < (LDS_BYTES - LDSCTL_OFF) / 4; u += NTHREADS) ((LAS unsigned*)(F.lds + LDSCTL_OFF))[u] = 0u;
    __syncthreads();
    const int lo = args.ph_lo, hi = args.ph_hi;
    XcdBarrier bar; bar.bar = (unsigned*)(F.ctl + CW_BAR); bar.x = 0; bar.st = nullptr;
    if (hi - lo > 1) bar = xcd_barrier_post((unsigned*)(F.ctl + CW_BAR), F.MISC + 8);
#ifndef PH_MASK
#define PH_MASK 0x7ff
#endif
#define IN(k) (((PH_MASK >> (k)) & 1) && lo <= (k) && (k) < hi)
#define SEAM(k) do { if (IN(k) && IN((k) + 1)) xcd_barrier(bar); } while (0)
#ifndef REP_PHASE
#define REP_PHASE -1
#endif
#define REPEAT(k) _Pragma("unroll") for (int rep = 0; rep < ((REP_PHASE) == (k) ? 2 : 1); ++rep)
#define REPBAR(k) do { if ((REP_PHASE) == (k) && rep == 0) xcd_barrier(bar); } while (0)
    const int bid = (int)blockIdx.x;
    if (IN(0)) { REPEAT(0) { p0_prologue(F, args); REPBAR(0); } SEAM(0); }
    if (IN(1)) { REPEAT(1) { p1_norm_forget(F, args); REPBAR(1); } SEAM(1); }
    if (IN(2)) { REPEAT(2) {
        pg8::Gemm g{WSP(bf16, WS_HA), WSP(bf16, WS_WIN), S, NINP, DM}; pg8::StaticOrder So; So.init(S, NINP, F.G, bid);
        pg8::EpiIn E{WSP(bf16, WS_QKV), WSP(bf16, WS_LX), WSP(bf16, WS_GY), WSP(bf16, WS_GA), WSP(bf16, WS_GL), WSP(float, WS_BIASR)};
        pg8::gemm_phase<pg8::EpiIn, pg8::StaticOrder, true, true>(F.lds, g, So, E);
        REPBAR(2); }
        SEAM(2);
    }
    if (IN(3)) {
        p3_qknorm(F, args);
        __syncthreads();
        REPEAT(3) {
        p3_cumsum(F, args);
        for (int u = bid; u < (S / 64) * NG; u += F.G) lru_unit<0>(F, args, u >> 4, u & 15);
        REPBAR(3); }
        SEAM(3);
    }
    if (IN(4)) { REPEAT(4) {
        p4_attention(F, args, (char*)lds);
        for (int u = bid; u < (S / 64) * NG; u += F.G) lru_unit<1>(F, args, u >> 4, u & 15);
        REPBAR(4); }
        SEAM(4);
    }
    if (IN(5)) { REPEAT(5) {
        { pg8::Gemm g{WSP(bf16, WS_ATT), WSP(bf16, WS_WAO), S, DM, AW}; pg8::StaticOrder So; So.init(S, DM, F.G, bid);
          pg8::EpiGate<0> E{WSP(bf16, WS_T1), WSP(bf16, WS_GA), DM};
          pg8::gemm_phase<pg8::EpiGate<0>, pg8::StaticOrder, true, true>(F.lds, g, So, E); }
        { pg8::Gemm g{WSP(bf16, WS_LR), WSP(bf16, WS_WLO), S, DM, LW}; pg8::StaticOrder So; So.init(S, DM, F.G, bid);
          pg8::EpiGate<1> E{WSP(bf16, WS_T1), WSP(bf16, WS_GL), DM};
          pg8::gemm_phase<pg8::EpiGate<1>, pg8::StaticOrder, true, true>(F.lds, g, So, E); }
        REPBAR(5); }
        SEAM(5);
    }
    if (IN(6)) { REPEAT(6) {
        pg8::Gemm g{WSP(bf16, WS_T1), WSP(bf16, WS_WOUT), S, DM, DM}; pg8::StaticOrder So; So.init(S, DM, F.G, bid);
        pg8::EpiRes E{args.in[0], WSP(float, WS_X1), WSP(float, WS_MOD) + 8192, DM};
        pg8::gemm_phase<pg8::EpiRes, pg8::StaticOrder, true, true>(F.lds, g, So, E);
        REPBAR(6); }
        SEAM(6);
    }
    if (IN(7)) { REPEAT(7) { p7_norm2(F, args); REPBAR(7); } SEAM(7); }
    if (IN(8)) { REPEAT(8) {
        pg8::Gemm g{WSP(bf16, WS_HA), WSP(bf16, WS_WPQ), S, 2048, DM}; pg8::StaticOrder So; So.init(S, 2048, F.G, bid);
        pg8::EpiBf16<0> E{WSP(bf16, WS_Q2), 2048, nullptr, 0, 0, 1.f};
        pg8::gemm_phase<pg8::EpiBf16<0>, pg8::StaticOrder, true, true>(F.lds, g, So, E);
        REPBAR(8); }
        SEAM(8);
    }
    if (IN(9)) { REPEAT(9) { p9_topk(F, args); REPBAR(9); } SEAM(9); }
#ifndef P10_PROBE
#define P10_PROBE 0
#endif
    if (IN(10)) { if (P10_PROBE) { p10_peer<P10_PROBE>(F, args); xcd_barrier(bar); } REPEAT(10) { p10_peer<0>(F, args); REPBAR(10); } }
#undef IN
#undef SEAM
}

extern "C" void kernel_launch(void* const* d_in, const int* in_sizes, int n_in, void* d_out, int out_size, void* d_ws, size_t ws_size, hipStream_t stream) {
    static int grid = 0;
    if (grid == 0) {
        if (n_in != 24 || in_sizes[0] != S * DM || out_size != S * DM || ws_size < WS_END) { fprintf(stderr, "kernel_launch: unexpected shapes (n_in %d, in0 %d, out %d, ws %zu)\n", n_in, n_in > 0 ? in_sizes[0] : -1, out_size, ws_size); grid = -1; return; }
        int dev = 0, cus = 0, per_cu = 0;
        if (hipGetDevice(&dev) != hipSuccess || hipDeviceGetAttribute(&cus, hipDeviceAttributeMultiprocessorCount, dev) != hipSuccess) { grid = -1; return; }
        if (hipFuncSetAttribute((const void*)fwd_kernel, hipFuncAttributeMaxDynamicSharedMemorySize, LDS_BYTES) != hipSuccess) { fprintf(stderr, "kernel_launch: hipFuncSetAttribute failed\n"); grid = -1; return; }
        if (hipOccupancyMaxActiveBlocksPerMultiprocessor(&per_cu, (const void*)fwd_kernel, NTHREADS, LDS_BYTES) != hipSuccess || per_cu < 1) fprintf(stderr, "kernel_launch: occupancy query reports %d blocks per CU\n", per_cu);
        (void)hipGetLastError();
        grid = cus;
    }
    if (grid < 0) return;
    if (hipMemsetAsync((char*)d_ws + WS_CTL, 0, CTL_ZERO_BYTES, stream) != hipSuccess) return;
    Args a{};
    for (int i = 0; i < 24; ++i) a.in[i] = (const float*)d_in[i];
    a.out = (float*)d_out; a.ws = (unsigned char*)d_ws;
#if MK_SINGLE
    a.ph_lo = 0; a.ph_hi = N_PHASES;
    hipLaunchKernelGGL(fwd_kernel, dim3(grid), dim3(NTHREADS), LDS_BYTES, stream, a);
#else
    for (int p = 0; p < N_PHASES; ++p) { a.ph_lo = p; a.ph_hi = p + 1; hipLaunchKernelGGL(fwd_kernel, dim3(grid), dim3(NTHREADS), LDS_BYTES, stream, a); }
#endif
}
```

```cpp
#define REP_PHASE -1
#include <hip/hip_runtime.h>
#include <cstdio>
#include <cstdint>
namespace pg8 {
#define PG8_LAS __attribute__((address_space(3)))
typedef unsigned short bf16_t;
typedef short bf16x8 __attribute__((ext_vector_type(8)));
typedef float f32x4 __attribute__((ext_vector_type(4)));
typedef unsigned u32x4 __attribute__((ext_vector_type(4)));
constexpr int BM = 256, BK = 64, HALF = 128, HTB = HALF * BK * 2  , STAGE_BYTES = 8 * HTB, NXCD = 8, WGM = 8;

__host__ __device__ __forceinline__ int lds_byte(int r, int c) { const int st = (r >> 4) * 2 + (c >> 5), rr = r & 15, cc = c & 31, ob = rr * 64 + cc * 2; return st * 1024 + (ob ^ (((ob >> 9) & 1) << 5)); }
__host__ __device__ __forceinline__ void stage_rc(int b, int& R, int& C) { const int st = b / 1024, sb = b % 1024, swz = sb ^ (((sb >> 9) & 1) << 5); R = (st >> 1) * 16 + swz / 64; C = (st & 1) * 32 + (swz % 64) / 2; }
__host__ __device__ __forceinline__ int perm32(int rho) { const int n = rho >> 4, i = rho & 15; return 8 * (i >> 2) + 4 * n + (i & 3); }

struct Unit { int pm, pn; };
struct Gemm { const bf16_t* A; const bf16_t* Bt; int M, N, K; };

struct StaticOrder {
    int nM, nN, nwg, G, c;
    __host__ __device__ void init(int M, int N, int G_, int c_) { nM = M / BM; nN = N / BM; nwg = nM * nN; G = G_; c = c_; }
    __host__ __device__ bool next(int i, Unit& u) const {
        const long L = (long)i * G + c; if (L >= nwg) return false;
        int wgid = (int)L; { const int q = nwg / NXCD, r = nwg % NXCD, xcd = wgid % NXCD, off = wgid / NXCD; wgid = (xcd < r ? xcd * (q + 1) : r * (q + 1) + (xcd - r) * q) + off; }
        const int nig = WGM * nN, gid = wgid / nig, fm = gid * WGM, gsz = (nM - fm) < WGM ? (nM - fm) : WGM;
        u.pm = fm + ((wgid % nig) % gsz); u.pn = (wgid % nig) / gsz; return true;
    }
    __device__ __forceinline__ void a_ready(const Unit&) const {}
    __device__ __forceinline__ void done(const Unit&) const {}
};

__device__ __forceinline__ unsigned cvt_pk_bf16(float lo, float hi) { unsigned r; asm volatile("v_cvt_pk_bf16_f32 %0, %1, %2" : "=v"(r) : "v"(lo), "v"(hi)); return r; }
typedef float f32x2 __attribute__((ext_vector_type(2)));
__device__ __forceinline__ f32x2 gelu_pk(f32x2 v) {
    const f32x2 av = __builtin_elementwise_abs(v), d = av * 0.2316418882f + 1.0f;
    f32x2 t; t.x = __builtin_amdgcn_rcpf(d.x); t.y = __builtin_amdgcn_rcpf(d.y);
    f32x2 q = t * 0.5307027145f + (-0.7265760135f); q = q * t + 0.7107068705f; q = q * t + (-0.142248368f); q = q * t + 0.127414796f; q = q * t;
    const f32x2 s = (v * v) * (-0.72134752044f);
    f32x2 e; e.x = __builtin_amdgcn_exp2f(s.x); e.y = __builtin_amdgcn_exp2f(s.y);
    const f32x2 m = v * (q * e), r = v - m;
    f32x2 o; o.x = v.x < 0.f ? m.x : r.x; o.y = v.y < 0.f ? m.y : r.y; return o;
}

template <int ACT  > struct EpiBf16 {
    static constexpr bool PERM = true, AFTER_DRAIN = false; static_assert(ACT == 0 || ACT == 1, "EpiBf16: ACT is 0 (none) or 1 (gelu_pk)");
    bf16_t* O; int ldc; const float* bias; int split_cols; size_t split_stride; float scale0;
    __device__ __forceinline__ void operator()(const f32x4 (&acc)[2][2][4][2], const Unit& u, int wr, int wc, int fr, int fq) const {
        const int row0 = u.pm * BM + wr * 64 + fr; int colt = u.pn * BM; bf16_t* base = O;
        float sc = 1.f; if (split_cols) { const int t = colt / split_cols; base += (size_t)t * split_stride; colt -= t * split_cols; if (t == 0) sc = scale0; }
        const int col0 = colt + wc * 32 + 8 * fq, bcol0 = u.pn * BM + wc * 32 + 8 * fq;
        f32x4 bv[2][2];
#pragma unroll
        for (int bj = 0; bj < 2; ++bj)
#pragma unroll
            for (int n = 0; n < 2; ++n) bv[bj][n] = bias ? *(const f32x4*)(bias + bcol0 + bj * HALF + 4 * n) : (f32x4){0.f, 0.f, 0.f, 0.f};
#pragma unroll
        for (int ai = 0; ai < 2; ++ai)
#pragma unroll
            for (int m = 0; m < 4; ++m) { bf16_t* rowp = base + (size_t)(row0 + ai * HALF + m * 16) * ldc + col0;
#pragma unroll
                for (int bj = 0; bj < 2; ++bj) { f32x4 v0 = acc[ai][bj][m][0] + bv[bj][0], v1 = acc[ai][bj][m][1] + bv[bj][1];
                    if (ACT == 1) { f32x2 a = gelu_pk((f32x2){v0[0], v0[1]}), b = gelu_pk((f32x2){v0[2], v0[3]}), c = gelu_pk((f32x2){v1[0], v1[1]}), d = gelu_pk((f32x2){v1[2], v1[3]});
                        v0 = (f32x4){a.x, a.y, b.x, b.y}; v1 = (f32x4){c.x, c.y, d.x, d.y}; }
                    v0 = v0 * sc; v1 = v1 * sc; u32x4 w; w.x = cvt_pk_bf16(v0[0], v0[1]); w.y = cvt_pk_bf16(v0[2], v0[3]); w.z = cvt_pk_bf16(v1[0], v1[1]); w.w = cvt_pk_bf16(v1[2], v1[3]);
                    *(u32x4*)(rowp + bj * HALF) = w; } }
    }
};
__device__ __forceinline__ f32x4 sigm4(f32x4 v) { f32x4 o;
#pragma unroll
    for (int j = 0; j < 4; ++j) o[j] = __builtin_amdgcn_rcpf(1.0f + __builtin_amdgcn_exp2f(-1.4426950408889634f * v[j]));
    return o; }
__device__ __forceinline__ f32x4 gelu4(f32x4 v) { const f32x2 a = gelu_pk((f32x2){v[0], v[1]}), b = gelu_pk((f32x2){v[2], v[3]}); return (f32x4){a.x, a.y, b.x, b.y}; }
__device__ __forceinline__ void unpack8(const u32x4 w, f32x4& lo, f32x4& hi) {
    lo = (f32x4){__uint_as_float(w.x << 16), __uint_as_float(w.x & 0xffff0000u), __uint_as_float(w.y << 16), __uint_as_float(w.y & 0xffff0000u)};
    hi = (f32x4){__uint_as_float(w.z << 16), __uint_as_float(w.z & 0xffff0000u), __uint_as_float(w.w << 16), __uint_as_float(w.w & 0xffff0000u)}; }
struct EpiIn {
    static constexpr bool PERM = true, AFTER_DRAIN = false;
    bf16_t* qkv; bf16_t* lx; bf16_t* gy; bf16_t* ga; bf16_t* gl; const float* bias;
    __device__ __forceinline__ void operator()(const f32x4 (&acc)[2][2][4][2], const Unit& u, int wr, int wc, int fr, int fq) const {
        const int pn = u.pn; bf16_t* base; int ldc, colt, act;
        if (pn < 24) { base = qkv + (size_t)(pn >> 3) * ((size_t)8192 * 2048); ldc = 2048; colt = (pn & 7) * 256; act = 0; }
        else if (pn < 32) { base = lx; ldc = 2048; colt = (pn - 24) * 256; act = 0; }
        else if (pn < 40) { base = gy; ldc = 2048; colt = (pn - 32) * 256; act = 1; }
        else if (pn < 56) { base = ga; ldc = 4096; colt = (pn - 40) * 256; act = 2; }
        else { base = gl; ldc = 4096; colt = (pn - 56) * 256; act = 2; }
        const int row0 = u.pm * BM + wr * 64 + fr, col0 = colt + wc * 32 + 8 * fq, bcol0 = pn * BM + wc * 32 + 8 * fq;
        f32x4 bv[2][2];
#pragma unroll
        for (int bj = 0; bj < 2; ++bj)
#pragma unroll
            for (int n = 0; n < 2; ++n) bv[bj][n] = *(const f32x4*)(bias + bcol0 + bj * HALF + 4 * n);
#pragma unroll
        for (int ai = 0; ai < 2; ++ai)
#pragma unroll
            for (int m = 0; m < 4; ++m) { bf16_t* rowp = base + (size_t)(row0 + ai * HALF + m * 16) * ldc + col0;
#pragma unroll
                for (int bj = 0; bj < 2; ++bj) { f32x4 v0 = acc[ai][bj][m][0] + bv[bj][0], v1 = acc[ai][bj][m][1] + bv[bj][1];
                    if (act == 1) { v0 = gelu4(v0); v1 = gelu4(v1); }
                    else if (act == 2) { v0 = sigm4(v0); v1 = sigm4(v1); }
                    u32x4 w; w.x = cvt_pk_bf16(v0[0], v0[1]); w.y = cvt_pk_bf16(v0[2], v0[3]); w.z = cvt_pk_bf16(v1[0], v1[1]); w.w = cvt_pk_bf16(v1[2], v1[3]);
                    *(u32x4*)(rowp + bj * HALF) = w; } }
    }
};
template <int MODE> struct EpiGate {
    static constexpr bool PERM = true, AFTER_DRAIN = false;
    bf16_t* O; const bf16_t* Gt; int ldc;
    __device__ __forceinline__ void operator()(const f32x4 (&acc)[2][2][4][2], const Unit& u, int wr, int wc, int fr, int fq) const {
        const int row0 = u.pm * BM + wr * 64 + fr, col0 = u.pn * BM + wc * 32 + 8 * fq;
#pragma unroll
        for (int ai = 0; ai < 2; ++ai)
#pragma unroll
            for (int m = 0; m < 4; ++m) { const size_t off = (size_t)(row0 + ai * HALF + m * 16) * ldc + col0;
#pragma unroll
                for (int bj = 0; bj < 2; ++bj) { f32x4 g0, g1; unpack8(*(const u32x4*)(Gt + off + bj * HALF), g0, g1);
                    f32x4 v0 = acc[ai][bj][m][0] * g0, v1 = acc[ai][bj][m][1] * g1;
                    if (MODE == 1) { f32x4 t0, t1; unpack8(*(const u32x4*)(O + off + bj * HALF), t0, t1); v0 += t0; v1 += t1; }
                    u32x4 w; w.x = cvt_pk_bf16(v0[0], v0[1]); w.y = cvt_pk_bf16(v0[2], v0[3]); w.z = cvt_pk_bf16(v1[0], v1[1]); w.w = cvt_pk_bf16(v1[2], v1[3]);
                    *(u32x4*)(O + off + bj * HALF) = w; } }
    }
};
struct EpiRes {
    static constexpr bool PERM = false, AFTER_DRAIN = false;
    const float* X; float* Out; const float* gate; int ldc;
    __device__ __forceinline__ void operator()(const f32x4 (&acc)[2][2][4][2], const Unit& u, int wr, int wc, int fr, int fq) const {
        const int row0 = u.pm * BM + wr * 64 + fr, col0 = u.pn * BM + wc * 32 + 4 * fq;
        f32x4 gv[2][2];
#pragma unroll
        for (int bj = 0; bj < 2; ++bj)
#pragma unroll
            for (int n = 0; n < 2; ++n) gv[bj][n] = *(const f32x4*)(gate + col0 + bj * HALF + n * 16);
#pragma unroll
        for (int ai = 0; ai < 2; ++ai)
#pragma unroll
            for (int m = 0; m < 4; ++m) { const size_t off = (size_t)(row0 + ai * HALF + m * 16) * ldc + col0;
#pragma unroll
                for (int bj = 0; bj < 2; ++bj)
#pragma unroll
                    for (int n = 0; n < 2; ++n) { const f32x4 xv = *(const f32x4*)(X + off + bj * HALF + n * 16);
                        *(f32x4*)(Out + off + bj * HALF + n * 16) = xv + gv[bj][n] * acc[ai][bj][m][n]; } }
    }
};
template <class Epi, class Sched, bool ALIGN_EPI = false, bool SP2 = false>
__device__ __forceinline__ void gemm_phase(PG8_LAS unsigned char* lds, const Gemm g, const Sched& S, const Epi& E) {
    const int tid = threadIdx.x, wid = __builtin_amdgcn_readfirstlane(tid >> 6), lane = tid & 63, wr = wid >> 2, wc = wid & 3, fr = lane & 15, fq = lane >> 4;
    const int K = g.K, nt = K / BK;
    unsigned voffA[2], voffB[2];
#pragma unroll
    for (int i = 0; i < 2; ++i) { int R, C; stage_rc(tid * 16 + i * 8192, R, C); const int Rb = Epi::PERM ? ((R & ~31) + perm32(R & 31)) : R;
        voffA[i] = (unsigned)(R * K + C) * 2u; voffB[i] = (unsigned)(Rb * K + C) * 2u; }
    const size_t kstep = (size_t)(BK * 2);
    const size_t hstep = (size_t)HALF * K * 2;
    const size_t tstep = 2 * hstep;
    const unsigned ldsw = (unsigned)wid * 1024u;
    const int aoff = lds_byte(wr * 64 + fr, fq * 8), boff = lds_byte(wc * 32 + fr, fq * 8);
#define PG8_SA(b, h) (((b) * 2 + (h)) * HTB)
#define PG8_SB(b, h) ((4 + (b) * 2 + (h)) * HTB)
#define PG8_STAGE(bufoff, gbase, voff) do { _Pragma("unroll") for (int _i = 0; _i < 2; ++_i) \
        __builtin_amdgcn_global_load_lds((const unsigned*)((const char*)(gbase) + (voff)[_i]), (PG8_LAS unsigned*)(lds + (bufoff) + ldsw + _i * 8192), 16, 0, 0); } while (0)
#define PG8_LDA(dst, b, h) do { _Pragma("unroll") for (int m = 0; m < 4; ++m) _Pragma("unroll") for (int k = 0; k < 2; ++k) dst[m][k] = *(const PG8_LAS bf16x8*)(lds + PG8_SA(b, h) + aoff + m * 2048 + k * 1024); } while (0)
#define PG8_LDB(dst, b, h) do { _Pragma("unroll") for (int n = 0; n < 2; ++n) _Pragma("unroll") for (int k = 0; k < 2; ++k) dst[n][k] = *(const PG8_LAS bf16x8*)(lds + PG8_SB(b, h) + boff + n * 2048 + k * 1024); } while (0)
#define PG8_MMA(ai, bj, At, Bt) do { __builtin_amdgcn_s_setprio(1); _Pragma("unroll") for (int m = 0; m < 4; ++m) _Pragma("unroll") for (int n = 0; n < 2; ++n) _Pragma("unroll") for (int k = 0; k < 2; ++k) \
        acc[ai][bj][m][n] = __builtin_amdgcn_mfma_f32_16x16x32_bf16(Bt[n][k], At[m][k], acc[ai][bj][m][n], 0, 0, 0); __builtin_amdgcn_s_setprio(0); } while (0)
#define PG8_WAIT_V(n) asm volatile("s_waitcnt vmcnt(" #n ")" ::: "memory")
#define PG8_WAIT_L(n) asm volatile("s_waitcnt lgkmcnt(" #n ")" ::: "memory")
#define PG8_BAR __builtin_amdgcn_s_barrier()
#define PG8_SCHED __builtin_amdgcn_sched_barrier(0)
    Unit cur, nxt; int ui = 0;
    if (!S.next(0, cur)) return;
    f32x4 acc[2][2][4][2];
#pragma unroll
    for (int a = 0; a < 2; ++a)
#pragma unroll
        for (int b = 0; b < 2; ++b)
#pragma unroll
            for (int m = 0; m < 4; ++m)
#pragma unroll
                for (int n = 0; n < 2; ++n) acc[a][b][m][n] = (f32x4){0.f, 0.f, 0.f, 0.f};
    bf16x8 At[4][2], B0[2][2], B1[2][2];
    const char* cA = (const char*)g.A + (size_t)cur.pm * tstep; const char* cB = (const char*)g.Bt + (size_t)cur.pn * tstep;
    S.a_ready(cur);
    if constexpr (SP2) {
        PG8_STAGE(PG8_SB(0, 0), cB, voffB); PG8_STAGE(PG8_SB(0, 1), cB + hstep, voffB); PG8_STAGE(PG8_SA(0, 0), cA, voffA); PG8_STAGE(PG8_SA(0, 1), cA + hstep, voffA);
        if (wr == 1) PG8_BAR;
        PG8_WAIT_V(2); PG8_BAR;
        PG8_STAGE(PG8_SB(1, 0), cB + kstep, voffB); PG8_STAGE(PG8_SA(1, 0), cA + kstep, voffA); PG8_STAGE(PG8_SB(1, 1), cB + hstep + kstep, voffB);
        PG8_WAIT_V(6); PG8_BAR;
    } else {
        PG8_STAGE(PG8_SB(0, 0), cB, voffB); PG8_STAGE(PG8_SA(0, 0), cA, voffA); PG8_STAGE(PG8_SB(0, 1), cB + hstep, voffB); PG8_STAGE(PG8_SA(0, 1), cA + hstep, voffA);
        if (wr == 1) PG8_BAR;
        PG8_WAIT_V(4); PG8_BAR;
        PG8_STAGE(PG8_SB(1, 0), cB + kstep, voffB); PG8_STAGE(PG8_SA(1, 0), cA + kstep, voffA); PG8_STAGE(PG8_SB(1, 1), cB + hstep + kstep, voffB);
        PG8_WAIT_V(6); PG8_BAR;
    }
    for (;;) {
        const bool has_next = S.next(ui + 1, nxt);
        const char* nA = has_next ? (const char*)g.A + (size_t)nxt.pm * tstep : cA; const char* nB = has_next ? (const char*)g.Bt + (size_t)nxt.pn * tstep : cB;
        for (int t = 0; t < nt; t += 2) {
            const bool last = (t == nt - 2);
            const char* a1 = cA + (size_t)(t + 1) * kstep;
            const char* a2 = last ? nA : cA + (size_t)(t + 2) * kstep; const char* b2 = last ? nB : cB + (size_t)(t + 2) * kstep;
            const char* a3 = a2 + kstep; const char* b3 = b2 + kstep;
            if (last && has_next) S.a_ready(nxt);
            if constexpr (SP2) {
            PG8_LDB(B0, 0, 0); PG8_LDB(B1, 0, 1); PG8_SCHED; PG8_LDA(At, 0, 0); PG8_STAGE(PG8_SA(1, 1), a1 + hstep, voffA);
            PG8_WAIT_V(8); PG8_WAIT_L(0); PG8_BAR; PG8_MMA(0, 0, At, B0); PG8_MMA(0, 1, At, B1); PG8_BAR; PG8_SCHED;
            PG8_LDA(At, 0, 1); PG8_STAGE(PG8_SB(0, 0), b2, voffB); PG8_STAGE(PG8_SB(0, 1), b2 + hstep, voffB); PG8_STAGE(PG8_SA(0, 0), a2, voffA);
            PG8_WAIT_V(8); PG8_WAIT_L(0); PG8_BAR; PG8_MMA(1, 0, At, B0); PG8_MMA(1, 1, At, B1); PG8_BAR; PG8_SCHED;
            PG8_LDB(B0, 1, 0); PG8_LDB(B1, 1, 1); PG8_SCHED; PG8_LDA(At, 1, 0); PG8_STAGE(PG8_SA(0, 1), a2 + hstep, voffA);
            PG8_WAIT_V(8); PG8_WAIT_L(0); PG8_BAR; PG8_MMA(0, 0, At, B0); PG8_MMA(0, 1, At, B1); PG8_BAR; PG8_SCHED;
            PG8_LDA(At, 1, 1); PG8_STAGE(PG8_SB(1, 0), b3, voffB); PG8_STAGE(PG8_SB(1, 1), b3 + hstep, voffB); PG8_STAGE(PG8_SA(1, 0), a3, voffA);
            PG8_WAIT_V(8); PG8_WAIT_L(0); PG8_BAR; PG8_MMA(1, 0, At, B0); PG8_MMA(1, 1, At, B1); PG8_BAR; PG8_SCHED;
            } else {
            PG8_LDB(B0, 0, 0); PG8_SCHED; PG8_LDA(At, 0, 0); PG8_STAGE(PG8_SA(1, 1), a1 + hstep, voffA);
            PG8_WAIT_L(8); PG8_BAR; PG8_WAIT_L(0); PG8_MMA(0, 0, At, B0); PG8_BAR; PG8_SCHED;
            PG8_LDB(B1, 0, 1); PG8_STAGE(PG8_SB(0, 0), b2, voffB);
            PG8_BAR; PG8_WAIT_L(0); PG8_MMA(0, 1, At, B1); PG8_BAR;
            PG8_LDA(At, 0, 1); PG8_STAGE(PG8_SA(0, 0), a2, voffA);
            PG8_BAR; PG8_WAIT_L(0); PG8_MMA(1, 0, At, B0); PG8_BAR; PG8_SCHED;
            PG8_STAGE(PG8_SB(0, 1), b2 + hstep, voffB);
            PG8_WAIT_V(6); PG8_BAR; PG8_MMA(1, 1, At, B1); PG8_BAR;
            PG8_LDB(B0, 1, 0); PG8_SCHED; PG8_LDA(At, 1, 0); PG8_STAGE(PG8_SA(0, 1), a2 + hstep, voffA);
            PG8_WAIT_L(8); PG8_BAR; PG8_WAIT_L(0); PG8_MMA(0, 0, At, B0); PG8_BAR; PG8_SCHED;
            PG8_LDB(B1, 1, 1); PG8_STAGE(PG8_SB(1, 0), b3, voffB);
            PG8_BAR; PG8_WAIT_L(0); PG8_MMA(0, 1, At, B1); PG8_BAR;
            PG8_LDA(At, 1, 1); PG8_STAGE(PG8_SA(1, 0), a3, voffA);
            PG8_BAR; PG8_WAIT_L(0); PG8_MMA(1, 0, At, B0); PG8_BAR; PG8_SCHED;
            PG8_STAGE(PG8_SB(1, 1), b3 + hstep, voffB);
            PG8_WAIT_V(6); PG8_BAR; PG8_MMA(1, 1, At, B1); PG8_BAR;
            }
        }
        if constexpr (ALIGN_EPI) { if (wr == 0) PG8_BAR; }
        if constexpr (!Epi::AFTER_DRAIN) { E(acc, cur, wr, wc, fr, fq); S.done(cur); }
        if (!has_next) break;
#pragma unroll
        for (int a = 0; a < 2; ++a)
#pragma unroll
            for (int b = 0; b < 2; ++b)
#pragma unroll
                for (int m = 0; m < 4; ++m)
#pragma unroll
                    for (int n = 0; n < 2; ++n) acc[a][b][m][n] = (f32x4){0.f, 0.f, 0.f, 0.f};
        cur = nxt; cA = nA; cB = nB; ++ui;
        if constexpr (ALIGN_EPI) { if (wr == 1) PG8_BAR; }
    }
    PG8_WAIT_V(0);
    if constexpr (!ALIGN_EPI) { if (wr == 0) PG8_BAR; }
    PG8_BAR;
    if constexpr (Epi::AFTER_DRAIN) { E.fused(acc, cur, wr, wc, fr, fq, lds, wid, lane); S.done(cur); }
#undef PG8_SA
#undef PG8_SB
#undef PG8_STAGE
#undef PG8_LDA
#undef PG8_LDB
#undef PG8_MMA
#undef PG8_WAIT_V
#undef PG8_WAIT_L
#undef PG8_BAR
#undef PG8_SCHED
}
}
namespace attn_body {
constexpr int D = 128, LD = 2048;
constexpr float THR = 8.f; constexpr bool WSKIP = false;
constexpr float SCALE = 0.08838834764831845f;
constexpr int NW = 8, QBLK = 32, KVBLK = 64, QB = NW * QBLK;
constexpr int SHM_V = KVBLK * D * 2, SHM_K = KVBLK * D * 2;
constexpr int LDS_BYTES = 2 * SHM_V + 2 * SHM_K + NW * 64 * 4;

typedef short bf16x8 __attribute__((ext_vector_type(8)));
typedef short s16x4 __attribute__((ext_vector_type(4)));
typedef float f32x16 __attribute__((ext_vector_type(16)));
typedef float f32x4 __attribute__((ext_vector_type(4)));
typedef unsigned u32x4 __attribute__((ext_vector_type(4)));
template <class A, class Bt> struct same_t { static constexpr bool v = false; };
template <class A> struct same_t<A, A> { static constexpr bool v = true; };

#define KSWZ(row, colB) ((row) * 256 + ((colB) ^ (((row) & 7) << 4)))
#define SBAR() __builtin_amdgcn_sched_barrier(0)
__device__ __forceinline__ int v_st(int k, int c) { const int kk = (k & ~0xC) | ((k & 4) << 1) | ((k & 8) >> 1); return ((kk >> 3) * 4 + (c >> 5)) * 512 + ((kk & 7) * 32 + (c & 31)) * 2; }
__device__ __forceinline__ int v_rd_base(int lane) { return ((lane & 3) << 3) | (((lane >> 2) & 3) << 6) | (((lane >> 4) & 1) << 5) | (((lane >> 5) & 1) << 8); }
constexpr int v_rd_off(int d0, int ks, int half) { return d0 * 512 + ks * 4096 + half * 2048; }
__device__ __forceinline__ int crow(int r, int hi) { return (r & 3) + 8 * (r >> 2) + 4 * hi; }
__device__ __forceinline__ unsigned cvtpk(float lo, float hi) {
    unsigned r; asm volatile("v_cvt_pk_bf16_f32 %0, %1, %2" : "=v"(r) : "v"(lo), "v"(hi)); return r;
}
__device__ __forceinline__ bf16x8 pack8(f32x4 a, f32x4 b) {
    u32x4 w = {cvtpk(a[0], a[1]), cvtpk(a[2], a[3]), cvtpk(b[0], b[1]), cvtpk(b[2], b[3])};
    return *reinterpret_cast<bf16x8*>(&w);
}
template <class T> __device__ __forceinline__ bf16x8 load8(const T* p) {
    if constexpr (same_t<T, float>::v) { return pack8(*(const f32x4*)p, *(const f32x4*)(p + 4)); }
    else { return *reinterpret_cast<const bf16x8*>(p); }
}
__device__ __forceinline__ void mask_tile(f32x16& p0, f32x16& p1, int dq, unsigned W) {
    const float NEG = -__builtin_inff();
#pragma unroll
    for (int r = 0; r < 16; ++r) {
        const int c = (r & 3) + 8 * (r >> 2);
        if ((unsigned)(dq - c) >= W) p0[r] = NEG;
        if ((unsigned)(dq - c - 32) >= W) p1[r] = NEG;
    }
}
__device__ __forceinline__ void partialSM(f32x16& p0, f32x16& p1, float& m_reg, float& mn, float& alpha) {
    float pmax = p0[0]; for (int r = 1; r < 16; ++r) pmax = fmaxf(pmax, p0[r]); for (int r = 0; r < 16; ++r) pmax = fmaxf(pmax, p1[r]);
    { auto rr = __builtin_amdgcn_permlane32_swap(__float_as_uint(pmax), __float_as_uint(pmax), false, false);
      pmax = fmaxf(__uint_as_float(rr[0]), __uint_as_float(rr[1])); }
    constexpr float C2 = 1.4426950408889634f * SCALE;
    if (__builtin_expect(__all((pmax - m_reg) * SCALE <= THR), 1)) { mn = m_reg; alpha = 1.f; }
    else { mn = fmaxf(m_reg, pmax); alpha = __builtin_amdgcn_exp2f((m_reg - mn) * C2); m_reg = mn; }
    const float mnL = -mn * C2;
    for (int r = 0; r < 16; ++r) p0[r] = fmaf(p0[r], C2, mnL); for (int r = 0; r < 16; ++r) p1[r] = fmaf(p1[r], C2, mnL);
    for (int r = 0; r < 16; ++r) p0[r] = __builtin_amdgcn_exp2f(p0[r]);
}
__device__ __forceinline__ void finishSM(f32x16& p0, f32x16& p1, float alpha, float& l_reg, bf16x8& pa0, bf16x8& pa1, bf16x8& pa2, bf16x8& pa3) {
    for (int r = 0; r < 16; ++r) p1[r] = __builtin_amdgcn_exp2f(p1[r]);
    float ps = 0; for (int r = 0; r < 16; ++r) ps += p0[r]; for (int r = 0; r < 16; ++r) ps += p1[r];
    { auto rr = __builtin_amdgcn_permlane32_swap(__float_as_uint(ps), __float_as_uint(ps), false, false);
      ps = __uint_as_float(rr[0]) + __uint_as_float(rr[1]); }
    l_reg = l_reg * alpha + ps;
#define PK4(P, B_, OUT) do { unsigned a0 = cvtpk(P[B_+0], P[B_+1]), a1 = cvtpk(P[B_+2], P[B_+3]);                          \
        unsigned b0 = cvtpk(P[B_+4], P[B_+5]), b1 = cvtpk(P[B_+6], P[B_+7]);                                             \
        auto r0 = __builtin_amdgcn_permlane32_swap(a0, b0, false, false); auto r1 = __builtin_amdgcn_permlane32_swap(a1, b1, false, false); \
        u32x4 w = {r0[0], r1[0], r0[1], r1[1]}; OUT = *reinterpret_cast<bf16x8*>(&w); } while (0)
    PK4(p0, 0, pa0); PK4(p0, 8, pa1); PK4(p1, 0, pa2); PK4(p1, 8, pa3);
#undef PK4
}
template <int KB, bool SK>
__device__ __forceinline__ void qkt(f32x16& p0, f32x16& p1, const char* K_lds, int r32, int hi, const bf16x8* qr, bool act, const float* bt) {
    if (SK && !act) { const float NEG = -__builtin_inff();
#pragma unroll
        for (int r = 0; r < 16; ++r) { p0[r] = NEG; p1[r] = NEG; } return; }
    { const f32x4 b0 = *(const f32x4*)(bt), b1 = *(const f32x4*)(bt + 8), b2 = *(const f32x4*)(bt + 16), b3 = *(const f32x4*)(bt + 24);
      const f32x4 c0 = *(const f32x4*)(bt + 32), c1 = *(const f32x4*)(bt + 40), c2 = *(const f32x4*)(bt + 48), c3 = *(const f32x4*)(bt + 56);
      p0 = (f32x16){b0[0], b0[1], b0[2], b0[3], b1[0], b1[1], b1[2], b1[3], b2[0], b2[1], b2[2], b2[3], b3[0], b3[1], b3[2], b3[3]};
      p1 = (f32x16){c0[0], c0[1], c0[2], c0[3], c1[0], c1[1], c1[2], c1[3], c2[0], c2[1], c2[2], c2[3], c3[0], c3[1], c3[2], c3[3]}; }
    const char* kb[4];
#pragma unroll
    for (int dd = 0; dd < 4; ++dd) kb[dd] = K_lds + KB * SHM_K + KSWZ(r32, (dd * 16 + hi * 8) * 2);
#pragma unroll
    for (int d0 = 0; d0 < 8; ++d0) { const char* a = kb[d0 & 3] + (d0 >> 2) * 128;
        bf16x8 b0 = *reinterpret_cast<const bf16x8*>(a);
        bf16x8 b1 = *reinterpret_cast<const bf16x8*>(a + 32 * 256);
        p0 = __builtin_amdgcn_mfma_f32_32x32x16_bf16(b0, qr[d0], p0, 0, 0, 0);
        p1 = __builtin_amdgcn_mfma_f32_32x32x16_bf16(b1, qr[d0], p1, 0, 0, 0); }
}
template <int VB, bool SK>
__device__ __forceinline__ void pv_tile(f32x16* o, int vb0, bf16x8 pa0, bf16x8 pa1, bf16x8 pa2, bf16x8 pa3, bool act) {
    if (SK && !act) return;
#define TRRD(dst, off) asm volatile("ds_read_b64_tr_b16 %0, %1 offset:%2" : "=&v"(dst) : "v"(vb0), "i"(off) : "memory")
#define PV_D0(d0) do { s16x4 l0, l1, l2, l3, h0, h1, h2, h3; constexpr int b_ = VB * SHM_V + v_rd_off(d0, 0, 0);     \
        TRRD(l0, b_); TRRD(h0, b_ + 2048); TRRD(l1, b_ + 4096); TRRD(h1, b_ + 6144); TRRD(l2, b_ + 8192); TRRD(h2, b_ + 10240); TRRD(l3, b_ + 12288); TRRD(h3, b_ + 14336); \
        asm volatile("s_waitcnt lgkmcnt(0)" ::: "memory"); SBAR();                 \
        o[d0] = __builtin_amdgcn_mfma_f32_32x32x16_bf16(pa0, (bf16x8){l0[0], l0[1], l0[2], l0[3], h0[0], h0[1], h0[2], h0[3]}, o[d0], 0, 0, 0);   \
        o[d0] = __builtin_amdgcn_mfma_f32_32x32x16_bf16(pa1, (bf16x8){l1[0], l1[1], l1[2], l1[3], h1[0], h1[1], h1[2], h1[3]}, o[d0], 0, 0, 0);   \
        o[d0] = __builtin_amdgcn_mfma_f32_32x32x16_bf16(pa2, (bf16x8){l2[0], l2[1], l2[2], l2[3], h2[0], h2[1], h2[2], h2[3]}, o[d0], 0, 0, 0);   \
        o[d0] = __builtin_amdgcn_mfma_f32_32x32x16_bf16(pa3, (bf16x8){l3[0], l3[1], l3[2], l3[3], h3[0], h3[1], h3[2], h3[3]}, o[d0], 0, 0, 0); } while (0)
    PV_D0(0); PV_D0(1); PV_D0(2); PV_D0(3);
#undef PV_D0
#undef TRRD
}


template <class TIn, class TOut> struct BlockRef { const TIn* Q; const TIn* K; const TIn* V; TOut* O; int P0; int jlo; };
#define ROW(p, k0, rr) ((p) + (size_t)((k0) + (rr)) * LD + sc)
#define VMW() asm volatile("s_waitcnt vmcnt(0)" ::: "memory")
#define SLOAD_H(Kp, Vp, k0) do { st_v0 = load8<TIn>(ROW(Vp, k0, sr)); st_v1 = load8<TIn>(ROW(Vp, k0, 32 + sr));              \
                         st_k0 = load8<TIn>(ROW(Kp, k0, sr)); st_k1 = load8<TIn>(ROW(Kp, k0, 32 + sr)); } while (0)
#define SWRITE_H(bf) do { *(bf16x8*)(V_lds + (bf) * SHM_V + vst0) = st_v0; *(bf16x8*)(V_lds + (bf) * SHM_V + vst1) = st_v1;   \
                          *(bf16x8*)(K_lds + (bf) * SHM_K + kws) = st_k0; *(bf16x8*)(K_lds + (bf) * SHM_K + kws + 32 * 256) = st_k1; } while (0)
template <class TIn, class TOut>
__device__ __forceinline__ void attn_unit(const BlockRef<TIn, TOut>& cur, int skv, char* lds) {
    const int tid = threadIdx.x, wid = __builtin_amdgcn_readfirstlane(tid >> 6), lane = tid & 63, r32 = lane & 31, hi = lane >> 5;
    const unsigned W = 0x40000000u;
    const int j_lo = cur.jlo;
    int j_hi = (cur.P0 + QB - 1) / KVBLK + 1; if (j_hi > skv / KVBLK) j_hi = skv / KVBLK;
    const int NT = j_hi - j_lo;
    const int qlo = cur.P0 + wid * QBLK, qm = qlo + r32 - 4 * hi;
    char* V_lds = lds; char* K_lds = lds + 2 * SHM_V;
    float* ws = (float*)(lds + 2 * SHM_V + 2 * SHM_K) + wid * 64; float* li_l = ws, * al_l = ws + 32;
    const float* bias_l = (const float*)(lds + LDS_BYTES) + 4 * hi;
    float m_reg = -1e30f, l_reg = 0; f32x16 o[4] = {};
    const int sr = tid >> 4, sc = (tid & 15) * 8, vst0 = v_st(sr, sc), vst1 = v_st(32 + sr, sc), kws = KSWZ(sr, sc * 2);
    const int vb0 = (int)(uintptr_t)V_lds + v_rd_base(lane);
    const TIn* Kh = cur.K; const TIn* Vh = cur.V;
    bf16x8 st_v0, st_v1, st_k0, st_k1; bf16x8 qr[8];
#define KBASE(t) ((j_lo + (t)) * KVBLK)
#define BT(t) (bias_l + (t) * KVBLK)
#define RESC(a) do { if (__any((a) < 1.f)) { if (hi == 0) al_l[r32] = (a); asm volatile("s_waitcnt lgkmcnt(0)" ::: "memory");              \
                     for (int d_ = 0; d_ < 4; ++d_) for (int r = 0; r < 16; ++r) o[d_][r] *= al_l[crow(r, hi)]; } } while (0)
#define MASKT(P0_, P1_, t) do { const int kb_ = KBASE(t); if (kb_ + KVBLK - 1 > qlo) mask_tile(P0_, P1_, qm - kb_, W); } while (0)
#pragma unroll
    for (int d0 = 0; d0 < 8; ++d0) qr[d0] = load8<TIn>(cur.Q + (size_t)(wid * QBLK + r32) * LD + d0 * 16 + hi * 8);
    SLOAD_H(Kh, Vh, KBASE(0)); VMW(); SWRITE_H(0); SBAR();
    if (NT > 1) SLOAD_H(Kh, Vh, KBASE(1));
    __syncthreads();
    f32x16 p0, p1; float mn, al; bf16x8 pa0, pa1, pa2, pa3;
#define TILE_STEP(t, BUF) do {                                                                                                 \
        SBAR(); qkt<BUF, false>(p0, p1, K_lds, r32, hi, qr, true, BT(t));                                                       \
        MASKT(p0, p1, (t)); partialSM(p0, p1, m_reg, mn, al); RESC(al);                                                          \
        finishSM(p0, p1, al, l_reg, pa0, pa1, pa2, pa3); SBAR();                                                                 \
        pv_tile<BUF, false>(o, vb0, pa0, pa1, pa2, pa3, true);                                                                    \
        if ((t) + 1 < NT) { VMW(); SWRITE_H(1 - (BUF)); SBAR(); if ((t) + 2 < NT) SLOAD_H(Kh, Vh, KBASE((t) + 2)); }              \
        __syncthreads(); } while (0)
    for (int t = 0; t < NT; t += 2) {
        TILE_STEP(t, 0);
        if (t + 1 < NT) TILE_STEP(t + 1, 1);
    }
    if (hi == 0) li_l[r32] = l_reg; asm volatile("s_waitcnt lgkmcnt(0)" ::: "memory");
    float rli[16];
#pragma unroll
    for (int r = 0; r < 16; ++r) rli[r] = __builtin_amdgcn_rcpf(li_l[crow(r, hi)]);
    TOut* Ow = cur.O + (size_t)(wid * QBLK) * LD;
#pragma unroll
    for (int r = 0; r < 16; ++r) { const int orow = crow(r, hi);
#pragma unroll
        for (int d0 = 0; d0 < 4; ++d0) { const float v = o[d0][r] * rli[r];
            const float vn = __shfl_xor(v, 1);
            if ((r32 & 1) == 0) *(unsigned*)(Ow + (size_t)orow * LD + d0 * 32 + r32) = cvtpk(v, vn); } }
    __syncthreads();
#undef TILE_STEP
#undef RESC
#undef KBASE
#undef BT
#undef MASKT
}
#undef ROW
#undef VMW
#undef SLOAD_H
#undef SWRITE_H
}
#define GAS __attribute__((address_space(1)))
#define LAS __attribute__((address_space(3)))
typedef unsigned short bf16;
typedef unsigned v4u __attribute__((ext_vector_type(4)));
typedef unsigned v2u __attribute__((ext_vector_type(2)));
typedef float f32x4 __attribute__((ext_vector_type(4)));
typedef float f32x2 __attribute__((ext_vector_type(2)));
typedef short bf16x8 __attribute__((ext_vector_type(8)));
typedef GAS unsigned gu32;
#define RLX_AGENT __ATOMIC_RELAXED, __HIP_MEMORY_SCOPE_AGENT

constexpr int S = 8192, DM = 4096, NH = 16, HD = 128, AW = 2048, LW = 2048, NG = 16, GD = 128;
constexpr int NIN = 18448, NINP = 18432;
constexpr int C_Q = 0, C_K = 2048, C_V = 4096, C_F = 6144, C_LX = 6160, C_LY = 8208, C_GA = 10256, C_GL = 14352;
constexpr int PEER_H = 8, PEER_NK = 128, PEER_K = 16, PEER_NE = 16384;
constexpr float EPS = 1e-6f;
constexpr size_t MiB = 1u << 20;
constexpr size_t WS_CTL = 0, CTL_ZERO_BYTES = 1 * MiB;
constexpr size_t WS_MOD = 512 * 1024;
constexpr size_t WS_WF = 2 * MiB;
constexpr size_t WS_LOGF = 3 * MiB;
constexpr size_t WS_FC = 4 * MiB;
constexpr size_t WS_AGGA = 5 * MiB, WS_AGGB = 6 * MiB;
constexpr size_t WS_BIASR = 7 * MiB;
constexpr size_t WS_WAT = 8 * MiB, WS_WXT = 9 * MiB;
constexpr size_t WS_SK = 10 * MiB, WS_RS = 11 * MiB, WS_RSU = 11 * MiB + 65536;
constexpr size_t WS_IDX = 12 * MiB, WS_GATE = 16 * MiB, WS_IDX2 = 20 * MiB, WS_GATE2 = 24 * MiB;
constexpr size_t WS_WIN = 32 * MiB, WS_WAO = 176 * MiB, WS_WLO = 192 * MiB, WS_WOUT = 208 * MiB, WS_WPQ = 240 * MiB;
constexpr size_t WS_U = 256 * MiB, WS_V = 384 * MiB;
constexpr size_t WS_HA = 512 * MiB;
constexpr size_t WS_QKV = 576 * MiB;
constexpr size_t WS_LX = 672 * MiB, WS_GY = 704 * MiB, WS_GA = 736 * MiB, WS_GL = 800 * MiB;
constexpr size_t WS_ATT = 864 * MiB, WS_LR = 896 * MiB, WS_T1 = 928 * MiB, WS_MG = 992 * MiB, WS_Q2 = 1056 * MiB, WS_X1 = 1088 * MiB, WS_END = 1216 * MiB;
constexpr int CW_BAR = 4096;
constexpr int CW_QATT = 256;
constexpr int RING_BYTES = 131072;
constexpr int LDSCTL_OFF = RING_BYTES, MISC_OFF = LDSCTL_OFF + 320;
constexpr int LDS_BYTES = 151552;
constexpr int NWAVES = 8, NTHREADS = 512;

__device__ __forceinline__ unsigned f2bf(float f) { unsigned u = __builtin_bit_cast(unsigned, f); return (u + 0x7fffu + ((u >> 16) & 1u)) >> 16; }
__device__ __forceinline__ unsigned pk2(float lo, float hi) { return f2bf(lo) | (f2bf(hi) << 16); }
__device__ __forceinline__ float bflo(unsigned w) { return __uint_as_float(w << 16); }
__device__ __forceinline__ float bfhi(unsigned w) { return __uint_as_float(w & 0xffff0000u); }
__device__ __forceinline__ float bf2f(bf16 b) { return __uint_as_float((unsigned)b << 16); }
__device__ __forceinline__ float wave_sum(float v) {
#pragma unroll
    for (int o = 1; o < 64; o <<= 1) v += __shfl_xor(v, o);
    return v;
}
__device__ __forceinline__ float wave_max(float v) {
#pragma unroll
    for (int o = 1; o < 64; o <<= 1) v = fmaxf(v, __shfl_xor(v, o));
    return v;
}
__device__ __forceinline__ float sigmoidf_(float v) { return __builtin_amdgcn_rcpf(1.0f + __builtin_amdgcn_exp2f(-1.4426950408889634f * v)); }
__device__ __forceinline__ float gelu_erf(float v) { return 0.5f * v * (1.0f + erff(v * 0.70710678118654752f)); }
#define XB_TMO      128
#define XB_XCNT(j)  (256  + 64 * (j))
#define XB_XSUB(j)  (1280 + 64 * (j))
#define XB_XGEN(j)  (2304 + 64 * (j))
#define XB_TOP      3328
#define XB_TOPGEN   3392
#define XCD_BAR_WORDS 3456
#define XB_SPIN_CAP (1u << 18)

__device__ __forceinline__ unsigned xb_ld(unsigned* p)              { return __hip_atomic_load(p, __ATOMIC_RELAXED, __HIP_MEMORY_SCOPE_AGENT); }
__device__ __forceinline__ unsigned xb_add(unsigned* p, unsigned v) { return __hip_atomic_fetch_add(p, v, __ATOMIC_RELAXED, __HIP_MEMORY_SCOPE_AGENT); }
__device__ __forceinline__ unsigned xb_xcc_id() { return (unsigned)__builtin_amdgcn_s_getreg((3 << 11) | 20) & 0xFu; }
#define XB_SPIN(cond, bar) do { unsigned _sp = 0; while (cond) { __builtin_amdgcn_s_sleep(1); \
    if ((++_sp & 255u) == 0u) { if (xb_ld(&(bar)[XB_TMO])) break; if (_sp > XB_SPIN_CAP) { atomicAdd(&(bar)[XB_TMO], 1u); break; } } } } while (0)

struct XcdBarrier {
    unsigned* bar; unsigned x;
    volatile LAS unsigned* st;
};

__device__ __forceinline__ XcdBarrier xcd_barrier_post(unsigned* bar, volatile LAS unsigned* st) {
    XcdBarrier b; b.bar = bar; b.x = xb_xcc_id(); b.st = st;
    if (threadIdx.x == 0) (void)xb_add(&bar[XB_XCNT(b.x)], 1u);
    return b;
}
__device__ __forceinline__ void xcd_barrier_complete(unsigned* bar, unsigned x, unsigned& nloc, unsigned& nx) {
    const unsigned G = gridDim.x * gridDim.y * gridDim.z;
    unsigned sum, cnt, mine, sp = 0u;
    for (;;) {
        sum = 0u; cnt = 0u; mine = 0u;
#pragma unroll
        for (unsigned j = 0; j < 16; ++j) { const unsigned c = xb_ld(&bar[XB_XCNT(j)]); sum += c; cnt += (c > 0u) ? 1u : 0u; mine = (j == x) ? c : mine; }
        if (sum == G) break;
        __builtin_amdgcn_s_sleep(1);
        if ((++sp & 255u) == 0u) { if (xb_ld(&bar[XB_TMO])) break; if (sp > XB_SPIN_CAP) { atomicAdd(&bar[XB_TMO], 1u); break; } }
    }
    nloc = mine > 0u ? mine : 1u; nx = cnt > 0u ? cnt : 1u;
}

__device__ __forceinline__ void xcd_barrier(const XcdBarrier& b) {
    asm volatile("s_waitcnt vmcnt(0)" ::: "memory");
    __syncthreads();
    if (threadIdx.x == 0) {
        unsigned* bar = b.bar;
        __builtin_amdgcn_s_waitcnt(0);
        unsigned nloc = b.st[0], nx = b.st[1];
        if (nloc == 0u) { xcd_barrier_complete(bar, b.x, nloc, nx); b.st[0] = nloc; b.st[1] = nx; }
        const unsigned old = xb_add(&bar[XB_XSUB(b.x)], 1u);
        const unsigned gen = old / nloc;
        if (old + 1u == (gen + 1u) * nloc) {
            __builtin_amdgcn_fence(__ATOMIC_RELEASE, "agent");
            asm volatile("s_waitcnt vmcnt(0)" ::: "memory");
            const unsigned og = xb_add(&bar[XB_TOP], 1u);
            const unsigned tg = og / nx;
            if (og + 1u == (tg + 1u) * nx) xb_add(&bar[XB_TOPGEN], 1u);
            else XB_SPIN(xb_ld(&bar[XB_TOPGEN]) == tg, bar);
            __builtin_amdgcn_fence(__ATOMIC_ACQUIRE, "agent");
            xb_add(&bar[XB_XGEN(b.x)], 1u);
            asm volatile("s_waitcnt vmcnt(0)" ::: "memory");
        } else {
            XB_SPIN(xb_ld(&bar[XB_XGEN(b.x)]) == gen, bar);
            __builtin_amdgcn_fence(__ATOMIC_ACQUIRE, "agent");
            asm volatile("s_waitcnt vmcnt(0)" ::: "memory");
        }
    }
    __syncthreads();
}
struct Args { const float* in[24]; float* out; unsigned char* ws; int ph_lo, ph_hi, rep_att, rep_lru; };
struct Frame {
    LAS unsigned char* lds; volatile LAS unsigned* MISC; gu32* ctl;
    int tid, lane, wave, vcu, G;
    unsigned char* ws; float* out;
};
#define WSP(T, off) ((T*)(F.ws + (off)))
#define LDS_WAIT() asm volatile("s_waitcnt lgkmcnt(0)" ::: "memory")

__device__ __forceinline__ void transpose_item(const float* W, int ldw, int K, bf16* WT, LAS float* scr, int k0, int nsrc0, int ndst0, int lane) {
#pragma unroll 8
    for (int i = 0; i < 32; ++i) { const int kk = 2 * i + (lane >> 5); scr[kk * 33 + (lane & 31)] = W[(size_t)(k0 + kk) * ldw + nsrc0 + (lane & 31)]; }
    LDS_WAIT(); asm volatile("" ::: "memory");
    const int c = lane & 7;
#pragma unroll
    for (int j = 0; j < 4; ++j) { const int n = (lane >> 3) + 8 * j; const LAS float* s = scr + (8 * c) * 33 + n;
        v4u o; o.x = pk2(s[0 * 33], s[1 * 33]); o.y = pk2(s[2 * 33], s[3 * 33]); o.z = pk2(s[4 * 33], s[5 * 33]); o.w = pk2(s[6 * 33], s[7 * 33]);
        *(GAS v4u*)(WT + (size_t)(ndst0 + n) * K + k0 + 8 * c) = o; }
    LDS_WAIT(); asm volatile("" ::: "memory");
}
__device__ __forceinline__ void cvt_stream(const float* src, bf16* dst, size_t n8, size_t i0, size_t stride) {
    for (size_t i = i0; i < n8; i += stride) { const f32x4 a = ((const GAS f32x4*)src)[2 * i], b = ((const GAS f32x4*)src)[2 * i + 1];
        v4u o; o.x = pk2(a[0], a[1]); o.y = pk2(a[2], a[3]); o.z = pk2(b[0], b[1]); o.w = pk2(b[2], b[3]); ((GAS v4u*)dst)[i] = o; }
}
__device__ __forceinline__ void cvt_stream_fp8(const float* src, unsigned char* dst, size_t n16, float scale, size_t i0, size_t stride) {
    for (size_t i = i0; i < n16; i += stride) { v4u o;
#pragma unroll
        for (int q = 0; q < 4; ++q) { const f32x4 a = ((const GAS f32x4*)src)[4 * i + q] * scale; int w = 0;
            w = __builtin_amdgcn_cvt_pk_fp8_f32(a[0], a[1], w, false); w = __builtin_amdgcn_cvt_pk_fp8_f32(a[2], a[3], w, true); o[q] = (unsigned)w; }
        ((GAS v4u*)dst)[i] = o; }
}
__device__ __forceinline__ void cvt_table_fp4(Frame& F, const float* srcT, unsigned char* dstT, float* rsT, int gw, int NGW) {
    for (int row = gw; row < PEER_NE; row += NGW) {
        const GAS f32x4* src = (const GAS f32x4*)(srcT + (size_t)row * DM); f32x4 a[16]; float am = 0.f;
#pragma unroll
        for (int c = 0; c < 4; ++c)
#pragma unroll
            for (int q = 0; q < 4; ++q) { a[4 * c + q] = src[c * 256 + 4 * F.lane + q]; am = fmaxf(fmaxf(am, fmaxf(fabsf(a[4 * c + q][0]), fabsf(a[4 * c + q][1]))), fmaxf(fabsf(a[4 * c + q][2]), fabsf(a[4 * c + q][3]))); }
        am = wave_max(am); const float inv = am > 0.f ? 6.0f / am : 0.f;
#pragma unroll
        for (int c = 0; c < 4; ++c) { v2u o;
#pragma unroll
            for (int d = 0; d < 2; ++d) { unsigned w = 0u; const f32x4 x0 = a[4 * c + 2 * d] * inv, x1 = a[4 * c + 2 * d + 1] * inv;
                w = __builtin_amdgcn_cvt_scalef32_pk_fp4_f32(w, x0[0], x0[1], 1.0f, 0); w = __builtin_amdgcn_cvt_scalef32_pk_fp4_f32(w, x0[2], x0[3], 1.0f, 1);
                w = __builtin_amdgcn_cvt_scalef32_pk_fp4_f32(w, x1[0], x1[1], 1.0f, 2); w = __builtin_amdgcn_cvt_scalef32_pk_fp4_f32(w, x1[2], x1[3], 1.0f, 3); o[d] = w; }
            *((GAS v2u*)(dstT + (size_t)row * 2048 + c * 512) + F.lane) = o; }
        if (F.lane == 0) rsT[row] = am * (1.0f / 6.0f);
    }
}
__device__ __forceinline__ void p0_prologue(Frame& F, const Args& args) {
    { LAS float* sc = (LAS float*)F.lds; LAS f32x4* red = (LAS f32x4*)(F.lds + 16384); float* MOD = WSP(float, WS_MOD);
      for (int cgi = blockIdx.x; cgi < 256; cgi += F.G) {
          for (int i = F.tid; i < DM; i += NTHREADS) { const float cv = args.in[1][i]; sc[i] = cv / (1.0f + __expf(-cv)); }
          __syncthreads();
          if (F.tid < 384) { const int cg = F.tid % 24, rg = F.tid / 24;
              const GAS f32x4* Wp = (const GAS f32x4*)args.in[2] + cgi * 24 + cg;
              f32x4 acc = {0.f, 0.f, 0.f, 0.f};
#pragma unroll 8
              for (int r = rg; r < DM; r += 16) acc += sc[r] * Wp[(size_t)r * 6144];
              red[rg * 24 + cg] = acc; }
          __syncthreads();
          if (F.tid < 24) { f32x4 s = red[F.tid];
#pragma unroll
              for (int rg = 1; rg < 16; ++rg) s += red[rg * 24 + F.tid];
              s += ((const GAS f32x4*)args.in[3])[cgi * 24 + F.tid]; ((GAS f32x4*)MOD)[cgi * 24 + F.tid] = s; }
          __syncthreads();
      } }
    LAS float* scr = (LAS float*)(F.lds + F.wave * 16384);
    const int gw = F.vcu * NWAVES + F.wave, NGW = F.G * NWAVES;
    constexpr int I_IN = 64 * 576, I_AO = 32 * 128, I_LO = 32 * 128, I_OUT = 64 * 128, I_PQ = 64 * 64, I_WA = 16 * 2 * 4, I_WX = I_WA;
    constexpr int NITEMS = I_IN + I_AO + I_LO + I_OUT + I_PQ + I_WA + I_WX;
    for (int it = gw; it < NITEMS; it += NGW) {
        int r = it;
        if (r < I_IN) { const int kb = r / 576, nb = r % 576; transpose_item(args.in[6], NIN, DM, WSP(bf16, WS_WIN), scr, 64 * kb, 32 * nb + (nb >= 192 ? 16 : 0), 32 * nb, F.lane); continue; } r -= I_IN;
        if (r < I_AO) { const int kb = r / 128, nb = r % 128; transpose_item(args.in[17], DM, AW, WSP(bf16, WS_WAO), scr, 64 * kb, 32 * nb, 32 * nb, F.lane); continue; } r -= I_AO;
        if (r < I_LO) { const int kb = r / 128, nb = r % 128; transpose_item(args.in[18], DM, LW, WSP(bf16, WS_WLO), scr, 64 * kb, 32 * nb, 32 * nb, F.lane); continue; } r -= I_LO;
        if (r < I_OUT) { const int kb = r / 128, nb = r % 128; transpose_item(args.in[19], DM, DM, WSP(bf16, WS_WOUT), scr, 64 * kb, 32 * nb, 32 * nb, F.lane); continue; } r -= I_OUT;
        if (r < I_PQ) { const int kb = r / 64, nb = r % 64; transpose_item(args.in[20], 2048, DM, WSP(bf16, WS_WPQ), scr, 64 * kb, 32 * nb, 32 * nb, F.lane); continue; } r -= I_PQ;
        { const bool isx = r >= I_WA; if (isx) r -= I_WA; const int g = r >> 3, kb = (r >> 2) & 1, nb = r & 3;
          transpose_item((isx ? args.in[14] : args.in[12]) + (size_t)g * GD * GD, GD, GD, WSP(bf16, isx ? WS_WXT : WS_WAT) + (size_t)g * GD * GD, scr, 64 * kb, 32 * nb, 32 * nb, F.lane); }
    }
    const size_t gt = (size_t)F.vcu * NTHREADS + F.tid, NGT = (size_t)F.G * NTHREADS;
    cvt_table_fp4(F, args.in[23], WSP(unsigned char, WS_V), WSP(float, WS_RS), gw, NGW);
    cvt_table_fp4(F, args.in[22], WSP(unsigned char, WS_U), WSP(float, WS_RSU), gw, NGW);
    cvt_stream(args.in[21], WSP(bf16, WS_SK), (size_t)PEER_H * 2 * 128 * 128 / 8, gt, NGT);
    for (size_t i = gt; i < (size_t)DM * 16; i += NGT) WSP(float, WS_WF)[i] = args.in[6][(i >> 4) * NIN + C_F + (i & 15)];
    for (size_t i = gt; i < (size_t)NINP; i += NGT) WSP(float, WS_BIASR)[i] = args.in[7][i + (i >= (size_t)C_F ? 16 : 0)];
}

__device__ __forceinline__ void p1_norm_forget(Frame& F, const Args& args) {
    const int gw = F.vcu * NWAVES + F.wave, NGW = F.G * NWAVES; const float* MOD = WSP(float, WS_MOD); const float* WF = WSP(float, WS_WF); bf16* HA = WSP(bf16, WS_HA);
    for (int rg = gw; rg < S / 4; rg += NGW) {
        const int r0 = rg * 4; float rstd[4];
#pragma unroll
        for (int r = 0; r < 4; ++r) { const GAS f32x4* xr = (const GAS f32x4*)(args.in[0] + (size_t)(r0 + r) * DM) + F.lane; float ss = 0.f;
#pragma unroll
            for (int j = 0; j < 16; ++j) { const f32x4 v = xr[64 * j]; ss += (v[0] * v[0] + v[1] * v[1]) + (v[2] * v[2] + v[3] * v[3]); }
            rstd[r] = 1.0f / sqrtf(wave_sum(ss) * (1.0f / DM) + EPS); }
        float acc[4][16];
#pragma unroll
        for (int r = 0; r < 4; ++r)
#pragma unroll
            for (int cc = 0; cc < 16; ++cc) acc[r][cc] = 0.f;
        for (int j = 0; j < 16; ++j) {
            const int i4 = F.lane + 64 * j;
            const f32x4 g = ((const GAS f32x4*)args.in[4])[i4], scl = ((const GAS f32x4*)(MOD + 4096))[i4], sh = ((const GAS f32x4*)MOD)[i4];
            const f32x4 mul = g * (scl + 1.0f);
            f32x4 wf[4][4];
#pragma unroll
            for (int i = 0; i < 4; ++i)
#pragma unroll
                for (int q = 0; q < 4; ++q) wf[i][q] = ((const GAS f32x4*)(WF + (size_t)(4 * i4 + i) * 16))[q];
#pragma unroll
            for (int r = 0; r < 4; ++r) {
                const f32x4 xv = ((const GAS f32x4*)(args.in[0] + (size_t)(r0 + r) * DM))[i4];
                const f32x4 hv = xv * rstd[r] * mul + sh;
                v2u o; o.x = pk2(hv[0], hv[1]); o.y = pk2(hv[2], hv[3]);
                ((GAS v2u*)(HA + (size_t)(r0 + r) * DM))[i4] = o;
#pragma unroll
                for (int i = 0; i < 4; ++i)
#pragma unroll
                    for (int q = 0; q < 4; ++q)
#pragma unroll
                        for (int e = 0; e < 4; ++e) acc[r][4 * q + e] += hv[i] * wf[i][q][e];
            }
        }
#pragma unroll
        for (int r = 0; r < 4; ++r)
#pragma unroll
            for (int cc = 0; cc < 16; ++cc) { const float tot = wave_sum(acc[r][cc]);
                if (F.lane == cc) { const float f = tot + args.in[7][C_F + cc]; WSP(float, WS_LOGF)[(size_t)(r0 + r) * 16 + cc] = fminf(f, 0.f) - log1pf(__expf(-fabsf(f))); } }
    }
}

__device__ __forceinline__ void p3_qknorm(Frame& F, const Args& args) {
    const int gw = F.vcu * NWAVES + F.wave, NGW = F.G * NWAVES; bf16* QK = WSP(bf16, WS_QKV);
    const int sub = F.lane & 15;
    f32x4 gq0 = ((const GAS f32x4*)args.in[8])[2 * sub], gq1 = ((const GAS f32x4*)args.in[8])[2 * sub + 1], gk0 = ((const GAS f32x4*)args.in[9])[2 * sub], gk1 = ((const GAS f32x4*)args.in[9])[2 * sub + 1];
    for (int it = gw; it < 2 * S * NH / 4; it += NGW) {
        const size_t unit = (size_t)it * 4 + (F.lane >> 4); const bool isk = unit >= (size_t)S * NH;
        GAS v4u* p = (GAS v4u*)(QK + unit * 128) + sub; const v4u w = *p;
        f32x4 a = {bflo(w.x), bfhi(w.x), bflo(w.y), bfhi(w.y)}, b = {bflo(w.z), bfhi(w.z), bflo(w.w), bfhi(w.w)};
        float ss = (a[0] * a[0] + a[1] * a[1]) + (a[2] * a[2] + a[3] * a[3]) + (b[0] * b[0] + b[1] * b[1]) + (b[2] * b[2] + b[3] * b[3]);
        ss += __shfl_xor(ss, 1); ss += __shfl_xor(ss, 2); ss += __shfl_xor(ss, 4); ss += __shfl_xor(ss, 8);
        const float rs = 1.0f / sqrtf(ss * (1.0f / HD) + EPS);
        a = a * rs * (isk ? gk0 : gq0); b = b * rs * (isk ? gk1 : gq1);
        v4u o; o.x = pk2(a[0], a[1]); o.y = pk2(a[2], a[3]); o.z = pk2(b[0], b[1]); o.w = pk2(b[2], b[3]); *p = o;
    }
}
__device__ __forceinline__ void p3_cumsum(Frame& F, const Args& args) {
    LAS float* wt = (LAS float*)F.lds;
    for (int h = blockIdx.x; h < NH; h += F.G) {
        const float* LF = WSP(float, WS_LOGF); float v[16]; float run = 0.f;
#pragma unroll
        for (int i = 0; i < 16; ++i) { run += LF[(size_t)(F.tid * 16 + i) * 16 + h]; v[i] = run; }
        float sc = run;
#pragma unroll
        for (int o = 1; o < 64; o <<= 1) { const float t = __shfl_up(sc, o); if (F.lane >= o) sc += t; }
        if (F.lane == 63) wt[F.wave] = sc;
        __syncthreads();
        float pre = sc - run;
        for (int w = 0; w < F.wave; ++w) pre += wt[w];
        float* Fo = WSP(float, WS_FC) + (size_t)h * S + F.tid * 16;
#pragma unroll
        for (int i = 0; i < 4; ++i) ((GAS f32x4*)Fo)[i] = (f32x4){v[4 * i] + pre, v[4 * i + 1] + pre, v[4 * i + 2] + pre, v[4 * i + 3] + pre};
        __syncthreads();
    }
}
constexpr int LRU_XCF = 0, LRU_XCB = 32768, LRU_AB = 49152, LRU_BB = 81920, LRU_QA = 114688, LRU_CAR = 118784, LRU_XR = 133120;
template <int PASS> __device__ __forceinline__ void lru_chunk(Frame& F, const Args& args, int c, int g) {
    LAS float* XCF = (LAS float*)(F.lds + LRU_XCF); LAS unsigned char* XCB = F.lds + LRU_XCB; LAS float* AB = (LAS float*)(F.lds + LRU_AB); LAS float* BB = (LAS float*)(F.lds + LRU_BB);
    LAS float* QA = (LAS float*)(F.lds + LRU_QA); LAS float* CAR = (LAS float*)(F.lds + LRU_CAR); LAS bf16* XR = (LAS bf16*)(F.lds + LRU_XR);
    const int t0 = 64 * c, ch0 = GD * g; const bf16* LX = WSP(bf16, WS_LX);
    for (int p = F.tid; p < 67 * 16; p += NTHREADS) { const int r = p >> 4, cc = p & 15, tg = t0 - 3 + r; v4u v = {0u, 0u, 0u, 0u};
        if (tg >= 0) v = *(const GAS v4u*)(LX + (size_t)tg * LW + ch0 + cc * 8);
        *(LAS v4u*)(XR + r * 128 + cc * 8) = v; }
    __syncthreads();
    { const int ch = F.tid & 127, tq = F.tid >> 7, gch = ch0 + ch;
      const float w0 = args.in[10][gch], w1 = args.in[10][LW + gch], w2 = args.in[10][2 * LW + gch], w3 = args.in[10][3 * LW + gch], cb = args.in[11][gch];
      float xm3 = bf2f(XR[(16 * tq + 0) * 128 + ch]), xm2 = bf2f(XR[(16 * tq + 1) * 128 + ch]), xm1 = bf2f(XR[(16 * tq + 2) * 128 + ch]);
#pragma unroll
      for (int i = 0; i < 16; ++i) { const int t = 16 * tq + i; const float x0 = bf2f(XR[(t + 3) * 128 + ch]);
          const float xc = w0 * xm3 + w1 * xm2 + w2 * xm1 + w3 * x0 + cb; xm3 = xm2; xm2 = xm1; xm1 = x0;
          XCF[t * 128 + ch] = xc; *(LAS bf16*)(XCB + t * 256 + ((ch * 2) ^ ((t & 7) << 4))) = (bf16)f2bf(xc); } }
    __syncthreads();
    { const int fr = F.lane & 15, fq = F.lane >> 4, j = 16 * F.wave + fr;
      const bf16* WA = WSP(bf16, WS_WAT) + (size_t)g * GD * GD + (size_t)j * GD + 8 * fq; const bf16* WX = WSP(bf16, WS_WXT) + (size_t)g * GD * GD + (size_t)j * GD + 8 * fq;
      bf16x8 ba[4], bx[4];
#pragma unroll
      for (int ks = 0; ks < 4; ++ks) { ba[ks] = *(const GAS bf16x8*)(WA + 32 * ks); bx[ks] = *(const GAS bf16x8*)(WX + 32 * ks); }
      const int gch = ch0 + j; const float bav = args.in[13][gch], bxv = args.in[15][gch], lam = args.in[16][gch];
      const float sp8 = -8.0f * 1.4426950408889634f * ((lam > 0.f ? 0.f : -lam) + log1pf(__expf(-fabsf(lam))));
#pragma unroll
      for (int mt = 0; mt < 4; ++mt) { f32x4 ar = {0.f, 0.f, 0.f, 0.f}, ax = {0.f, 0.f, 0.f, 0.f}; const int t = 16 * mt + fr;
#pragma unroll
          for (int ks = 0; ks < 4; ++ks) { const bf16x8 af = *(const LAS bf16x8*)(XCB + t * 256 + (((32 * ks + 8 * fq) * 2) ^ ((t & 7) << 4)));
              ar = __builtin_amdgcn_mfma_f32_16x16x32_bf16(af, ba[ks], ar, 0, 0, 0); ax = __builtin_amdgcn_mfma_f32_16x16x32_bf16(af, bx[ks], ax, 0, 0, 0); }
#pragma unroll
          for (int rg = 0; rg < 4; ++rg) { const int tt = 16 * mt + 4 * fq + rg; const float xcv = XCF[tt * 128 + j];
              const float rgt = sigmoidf_(ar[rg] + bav), igt = sigmoidf_(ax[rg] + bxv);
              const float a = __builtin_amdgcn_exp2f(rgt * sp8); const float om = fmaxf((1.0f - a) * (1.0f + a), 0.f);
              const float b = __builtin_amdgcn_sqrtf(om) * (igt * xcv);
              AB[tt * 128 + j] = a; BB[tt * 128 + j] = b; } } }
    __syncthreads();
    const int ch = F.tid & 127, q = F.tid >> 7;
    { float A = 1.f, B = 0.f;
#pragma unroll
      for (int i = 0; i < 16; ++i) { const int t = 16 * q + i; const float a = AB[t * 128 + ch]; B = a * B + BB[t * 128 + ch]; A *= a; }
      QA[(q * 128 + ch) * 2] = A; QA[(q * 128 + ch) * 2 + 1] = B; }
    __syncthreads();
    if (PASS == 0) {
        if (F.tid < 128) { float A = 1.f, B = 0.f;
#pragma unroll
            for (int qq = 0; qq < 4; ++qq) { const float a = QA[(qq * 128 + F.tid) * 2], b = QA[(qq * 128 + F.tid) * 2 + 1]; B = a * B + b; A *= a; }
            WSP(float, WS_AGGA)[(size_t)c * LW + ch0 + F.tid] = A; WSP(float, WS_AGGB)[(size_t)c * LW + ch0 + F.tid] = B; }
    } else {
        float h = CAR[ch];
        for (int qq = 0; qq < q; ++qq) h = QA[(qq * 128 + ch) * 2] * h + QA[(qq * 128 + ch) * 2 + 1];
#pragma unroll
        for (int i = 0; i < 16; ++i) { const int t = 16 * q + i; h = AB[t * 128 + ch] * h + BB[t * 128 + ch]; XCF[t * 128 + ch] = h; }
        __syncthreads();
        if (F.tid < 128) { float hc = CAR[F.tid];
#pragma unroll
            for (int qq = 0; qq < 4; ++qq) hc = QA[(qq * 128 + F.tid) * 2] * hc + QA[(qq * 128 + F.tid) * 2 + 1];
            CAR[F.tid] = hc; }
        const bf16* GY = WSP(bf16, WS_GY); bf16* LR = WSP(bf16, WS_LR);
        for (int p = F.tid; p < 64 * 16; p += NTHREADS) { const int r = p >> 4, cc = p & 15; const size_t o = (size_t)(t0 + r) * LW + ch0 + cc * 8;
            const v4u gy = *(const GAS v4u*)(GY + o); const f32x4 h0 = *(const LAS f32x4*)(XCF + r * 128 + cc * 8), h1 = *(const LAS f32x4*)(XCF + r * 128 + cc * 8 + 4);
            v4u ov; ov.x = pk2(h0[0] * bflo(gy.x), h0[1] * bfhi(gy.x)); ov.y = pk2(h0[2] * bflo(gy.y), h0[3] * bfhi(gy.y)); ov.z = pk2(h1[0] * bflo(gy.z), h1[1] * bfhi(gy.z)); ov.w = pk2(h1[2] * bflo(gy.w), h1[3] * bfhi(gy.w));
            *(GAS v4u*)(LR + o) = ov; }
    }
    __syncthreads();
}
template <int PASS> __device__ __forceinline__ void lru_item(Frame& F, const Args& args, int w) {
    const int g = w & 15, c0 = (w >> 4) * 8; LAS float* CAR = (LAS float*)(F.lds + LRU_CAR); LAS float* QA = (LAS float*)(F.lds + LRU_QA);
    if (PASS == 1) {
        const int ch = F.tid & 127, q = F.tid >> 7, n = c0 / 4;
        const float* GA_ = WSP(float, WS_AGGA) + GD * g + ch; const float* GB_ = WSP(float, WS_AGGB) + GD * g + ch; float A = 1.f, B = 0.f;
#pragma unroll 4
        for (int cc = q * n; cc < (q + 1) * n; ++cc) { const float a = GA_[(size_t)cc * LW], b = GB_[(size_t)cc * LW]; B = a * B + b; A *= a; }
        QA[(q * 128 + ch) * 2] = A; QA[(q * 128 + ch) * 2 + 1] = B;
        __syncthreads();
        if (F.tid < 128) { float hc = 0.f;
#pragma unroll
            for (int qq = 0; qq < 4; ++qq) hc = QA[(qq * 128 + F.tid) * 2] * hc + QA[(qq * 128 + F.tid) * 2 + 1];
            CAR[F.tid] = hc; }
        __syncthreads();
    }
    for (int c = c0; c < c0 + 8; ++c) lru_chunk<PASS>(F, args, c, g);
}
constexpr int ATT_BIAS_OFF = attn_body::LDS_BYTES;
typedef attn_body::BlockRef<bf16, bf16> ARef;
__device__ __forceinline__ int attn_jlo(const float* Fh, int qb, float TH, int lane) {
    const int t0 = qb * 256; const float f0 = Fh[t0];
    const int j0 = lane, j1 = lane + 64;
    const bool ok0 = (64 * j0 + 63 >= t0) || (f0 - Fh[64 * j0 + 63] >= -TH), ok1 = (64 * j1 + 63 >= t0) || (f0 - Fh[64 * j1 + 63] >= -TH);
    const unsigned long long m0 = __ballot(ok0), m1 = __ballot(ok1);
    return m0 ? (int)__builtin_ctzll(m0) : 64 + (int)__builtin_ctzll(m1);
}
__device__ __forceinline__ ARef attn_ref(Frame& F, const Args& args, int h, int qb, int jlo) {
    ARef r; const bf16* QK = WSP(bf16, WS_QKV);
    r.Q = QK + (size_t)(qb * 256) * AW + h * HD; r.K = QK + (size_t)S * AW + h * HD; r.V = QK + 2 * (size_t)S * AW + h * HD;
    r.O = WSP(bf16, WS_ATT) + (size_t)(qb * 256) * AW + h * HD; r.P0 = qb * 256; r.jlo = jlo; return r;
}
__device__ __forceinline__ void attn_fill_bias(Frame& F, const Args& args, int h, int qb, int jlo) {
    const float* Fh = WSP(float, WS_FC) + (size_t)h * S; LAS float* bl = (LAS float*)(F.lds + ATT_BIAS_OFF);
    const int k0 = jlo * 64, n = (qb + 1) * 256 - k0; const float fr = Fh[k0];
#pragma unroll 1
    for (int i = F.tid; i < n; i += NTHREADS) bl[i] = (fr - Fh[k0 + i]) * (1.0f / attn_body::SCALE);
}
constexpr int ATT_SCHED_OFF = 104448;
__device__ __forceinline__ void p4_attention(Frame& F, const Args& args, char* lds_generic) {
    float gq = fmaxf(fabsf(args.in[8][F.lane]), fabsf(args.in[8][F.lane + 64])), gk = fmaxf(fabsf(args.in[9][F.lane]), fabsf(args.in[9][F.lane + 64]));
    gq = wave_max(gq); gk = wave_max(gk);
    const float TH = 2.0f * (128.0f * gq * gk * attn_body::SCALE) + 40.0f;
    LAS float* Fend = (LAS float*)(F.lds + ATT_SCHED_OFF); LAS int* cost = (LAS int*)(F.lds + ATT_SCHED_OFF + 8192); LAS int* jlo_t = cost + 512; LAS int* order = cost + 1024; LAS int* slot = cost + 1536;
    const float* Fc = WSP(float, WS_FC);
    for (int p = F.tid; p < NH * 128; p += NTHREADS) Fend[p] = Fc[(size_t)(p >> 7) * S + 64 * (p & 127) + 63];
    __syncthreads();
    { const int u = F.tid, h = u >> 5, qb = u & 31, t0 = qb * 256; const float f0 = Fc[(size_t)h * S + t0];
      int lo = 0, hi = 4 * qb;
      while (lo < hi) { const int mid = (lo + hi) >> 1; const bool ok = (64 * mid + 63 >= t0) || (f0 - Fend[h * 128 + mid] >= -TH); if (ok) hi = mid; else lo = mid + 1; }
      jlo_t[u] = lo; cost[u] = 4 * (qb + 1) - lo; }
    __syncthreads();
    { const int u = F.tid, cu = cost[u]; int rk = 0;
      for (int v = 0; v < 512; ++v) { const int cv = cost[v]; rk += (cv > cu || (cv == cu && v < u)) ? 1 : 0; }
      order[rk] = u; }
    __syncthreads();
    for (;;) {
        if (F.tid == 0) slot[0] = (int)__hip_atomic_fetch_add((unsigned*)(F.ctl + CW_QATT), 1u, RLX_AGENT);
        __syncthreads();
        const int k = slot[0];
        __syncthreads();
        if (k >= 512) break;
        const int u = order[k], h = u >> 5, qb = u & 31, jl = jlo_t[u];
        const ARef r0 = attn_ref(F, args, h, qb, jl);
        attn_fill_bias(F, args, h, qb, jl); __syncthreads();
        attn_body::attn_unit<bf16, bf16>(r0, S, lds_generic);
    }
}

__device__ __forceinline__ void p7_norm2(Frame& F, const Args& args) {
    const int gw = F.vcu * NWAVES + F.wave, NGW = F.G * NWAVES; const float* MOD = WSP(float, WS_MOD); bf16* HA = WSP(bf16, WS_HA);
    for (int m = gw; m < S; m += NGW) {
        const GAS f32x4* xr = (const GAS f32x4*)(WSP(float, WS_X1) + (size_t)m * DM) + F.lane; f32x4 v[16]; float ss = 0.f;
#pragma unroll
        for (int j = 0; j < 16; ++j) { v[j] = xr[64 * j]; ss += (v[j][0] * v[j][0] + v[j][1] * v[j][1]) + (v[j][2] * v[j][2] + v[j][3] * v[j][3]); }
        const float rstd = 1.0f / sqrtf(wave_sum(ss) * (1.0f / DM) + EPS);
#pragma unroll
        for (int j = 0; j < 16; ++j) { const int i4 = F.lane + 64 * j;
            const f32x4 g = ((const GAS f32x4*)args.in[5])[i4], scl = ((const GAS f32x4*)(MOD + 16384))[i4], sh = ((const GAS f32x4*)(MOD + 12288))[i4];
            const f32x4 hv = v[j] * rstd * (g * (scl + 1.0f)) + sh;
            v2u o; o.x = pk2(hv[0], hv[1]); o.y = pk2(hv[2], hv[3]); ((GAS v2u*)(HA + (size_t)m * DM))[i4] = o; }
    }
}

template <int CTRL> __device__ __forceinline__ unsigned dppu(unsigned x) { return (unsigned)__builtin_amdgcn_update_dpp(0, (int)x, CTRL, 0xF, 0xF, true); }
__device__ __forceinline__ unsigned rowmax_u32(unsigned x) { x = max(x, dppu<0xB1>(x)); x = max(x, dppu<0x4E>(x)); x = max(x, dppu<0x141>(x)); x = max(x, dppu<0x140>(x)); return x; }
__device__ __forceinline__ float rowsum_f32(float x) { x += __uint_as_float(dppu<0xB1>(__float_as_uint(x))); x += __uint_as_float(dppu<0x4E>(__float_as_uint(x)));
    x += __uint_as_float(dppu<0x141>(__float_as_uint(x))); x += __uint_as_float(dppu<0x140>(__float_as_uint(x))); return x; }
__device__ __forceinline__ unsigned ordk(float f) { const unsigned u = __float_as_uint(f); return u ^ ((unsigned)((int)u >> 31) | 0x80000000u); }
__device__ __forceinline__ float deck(unsigned k) { return __uint_as_float((k & 0x80000000u) ? (k ^ 0x80000000u) : ~k); }
#define CE_(x, y) do { const unsigned hi_ = max(x, y), lo_ = min(x, y); x = hi_; y = lo_; } while (0)
__device__ __forceinline__ unsigned row_pop16(unsigned (&a)[8], int i) {
    unsigned res = 0u;
#pragma unroll
    for (int r = 0; r < 16; ++r) { const unsigned m = rowmax_u32(a[0]); const bool win = a[0] == m;
#pragma unroll
        for (int s = 0; s < 7; ++s) a[s] = win ? a[s + 1] : a[s];
        a[7] = win ? 0u : a[7]; res = (i == r) ? m : res; }
    return res;
}
__device__ __forceinline__ void p9_topk(Frame& F, const Args& args) {
    const bf16* Q2 = WSP(bf16, WS_Q2); const bf16* SK = WSP(bf16, WS_SK); int* IDX = WSP(int, WS_IDX); float* GATE = WSP(float, WS_GATE);
    const int gw = F.vcu * NWAVES + F.wave, NGW = F.G * NWAVES; const int i = F.lane & 15, q = F.lane >> 4;
    const unsigned qlo = (unsigned)(i * 2048 + 8 * q) * 2u, klo = (unsigned)(i * 128 + 8 * q) * 2u;
#pragma unroll 1
    for (int u = gw; u < (S / 16) * PEER_H; u += NGW) {
        const int t0 = 16 * (u >> 3), h = u & 7;
        unsigned R[2][4];
#pragma unroll
        for (int p = 0; p < 2; ++p) {
            bf16x8 af[4];
            const char* qb_ = (const char*)Q2 + ((size_t)t0 * 2048 + h * 256 + p * 128) * 2;
            const char* kb_ = (const char*)SK + (size_t)((h * 2 + p) * 128) * 256;
#pragma unroll
            for (int ks = 0; ks < 4; ++ks) af[ks] = *(const GAS bf16x8*)(qb_ + 64 * ks + qlo);
            f32x4 acc[8]; bf16x8 bc[4], bn[4];
#pragma unroll
            for (int ks = 0; ks < 4; ++ks) bc[ks] = *(const GAS bf16x8*)(kb_ + 64 * ks + klo);
#pragma unroll
            for (int nt = 0; nt < 8; ++nt) { acc[nt] = (f32x4){0.f, 0.f, 0.f, 0.f};
                if (nt < 7) {
#pragma unroll
                    for (int ks = 0; ks < 4; ++ks) bn[ks] = *(const GAS bf16x8*)(kb_ + 4096 * (nt + 1) + 64 * ks + klo); }
#pragma unroll
                for (int ks = 0; ks < 4; ++ks) acc[nt] = __builtin_amdgcn_mfma_f32_16x16x32_bf16(af[ks], bc[ks], acc[nt], 0, 0, 0);
#pragma unroll
                for (int ks = 0; ks < 4; ++ks) bc[ks] = bn[ks];
                __builtin_amdgcn_sched_barrier(0); }
#pragma unroll
            for (int r = 0; r < 4; ++r) { unsigned a[8];
#pragma unroll
                for (int nt = 0; nt < 8; ++nt) a[nt] = (ordk(acc[nt][r]) & ~0x7Fu) | (unsigned)(16 * nt + i);
                CE_(a[0], a[1]); CE_(a[2], a[3]); CE_(a[4], a[5]); CE_(a[6], a[7]); CE_(a[0], a[2]); CE_(a[1], a[3]); CE_(a[4], a[6]); CE_(a[5], a[7]); CE_(a[1], a[2]); CE_(a[5], a[6]);
                CE_(a[0], a[4]); CE_(a[1], a[5]); CE_(a[2], a[6]); CE_(a[3], a[7]); CE_(a[2], a[4]); CE_(a[3], a[5]); CE_(a[1], a[2]); CE_(a[3], a[4]); CE_(a[5], a[6]);
                R[p][r] = row_pop16(a, i); __builtin_amdgcn_sched_barrier(0); }
        }
#pragma unroll
        for (int r = 0; r < 4; ++r) {
            const unsigned R0 = R[0][r], R1 = R[1][r]; const float f0 = deck(R0 & ~0x7Fu), f1 = deck(R1 & ~0x7Fu); const int n0 = (int)(R0 & 0x7Fu), n1 = (int)(R1 & 0x7Fu);
            const unsigned f1u = __float_as_uint(f1); unsigned c[8];
#define CAND_(b, lim) do { const unsigned t_ = (ordk(f0 + __uint_as_float(dppu<0x150 + (b)>(f1u))) & ~0xFFu) | (unsigned)(255 - (i * 16 + (b))); c[b] = (i < (lim)) ? t_ : 0u; } while (0)
            CAND_(0, 16); CAND_(1, 8); CAND_(2, 5); CAND_(3, 4); CAND_(4, 3); CAND_(5, 2); CAND_(6, 2); CAND_(7, 2);
#undef CAND_
            { const float ex = __uint_as_float(dppu<0x150>(__float_as_uint(f0))) + f1; const unsigned exk = (ordk(ex) & ~0xFFu) | (unsigned)(255 - i); c[1] = (i >= 8) ? exk : c[1]; }
            CE_(c[0], c[1]);
            const unsigned G = row_pop16(c, i);
            const float val = deck(G & ~0xFFu); const int id = 255 - (int)(G & 0xFFu); const int rb = F.lane & 48;
            const int ea = __shfl(n0, rb + (id >> 4)), eb = __shfl(n1, rb + (id & 15));
            const float mx = __uint_as_float(dppu<0x150>(__float_as_uint(val))); const float ex = __expf(val - mx); const float sm = rowsum_f32(ex);
            const size_t o = (size_t)(t0 + 4 * q + r) * 128 + h * 16 + i; IDX[o] = ea * 128 + eb; GATE[o] = ex / sm; __builtin_amdgcn_sched_barrier(0);
        }
    }
}
#undef CE_

constexpr float U_SCALE = 256.0f, V_SCALE = 1.0f;
#ifndef PEER_SORT
#define PEER_SORT 0
#endif
__device__ __forceinline__ float gelu_as(float v) {
    const float av = fabsf(v), tt = __builtin_amdgcn_rcpf(av * 0.2316418882f + 1.0f);
    float q = tt * 0.5307027145f + (-0.7265760135f); q = q * tt + 0.7107068705f; q = q * tt + (-0.142248368f); q = q * tt + 0.127414796f; q = q * tt;
    const float m = v * (q * __builtin_amdgcn_exp2f((v * v) * (-0.72134752044f)));
    return v < 0.f ? m : v - m;
}
__device__ __forceinline__ float wave_sum_dpp(float x) {
    x = rowsum_f32(x);
    return (__uint_as_float(__builtin_amdgcn_readlane(__float_as_uint(x), 0)) + __uint_as_float(__builtin_amdgcn_readlane(__float_as_uint(x), 16)))
         + (__uint_as_float(__builtin_amdgcn_readlane(__float_as_uint(x), 32)) + __uint_as_float(__builtin_amdgcn_readlane(__float_as_uint(x), 48)));
}
#define LOADROWS(T, ra_, rb_, ee) do { const int e2_ = (ee) & 127; const int ea_ = __builtin_amdgcn_readlane(e2_ < 64 ? id0 : id1, e2_ & 63), eb_ = __builtin_amdgcn_readlane(e2_ < 64 ? id0 : id1, (e2_ + 1) & 63); \
        const GAS v4u* pa_ = (const GAS v4u*)((T) + (size_t)ea_ * DM) + F.lane; const GAS v4u* pb_ = (const GAS v4u*)((T) + (size_t)eb_ * DM) + F.lane; \
        _Pragma("unroll") for (int c = 0; c < 4; ++c) { ra_[c] = pa_[64 * c]; rb_[c] = pb_[64 * c]; } } while (0)
#define UDOT(r_, out_) do { f32x2 s0_ = {0.f, 0.f}, s1_ = {0.f, 0.f}, s2_ = {0.f, 0.f}, s3_ = {0.f, 0.f}; \
        _Pragma("unroll") for (int c = 0; c < 4; ++c) _Pragma("unroll") for (int d = 0; d < 2; ++d) { \
            const f32x2 p0_ = __builtin_amdgcn_cvt_scalef32_pk_f32_fp4(r_[c][d], 1.0f, 0), p1_ = __builtin_amdgcn_cvt_scalef32_pk_f32_fp4(r_[c][d], 1.0f, 1), \
                        p2_ = __builtin_amdgcn_cvt_scalef32_pk_f32_fp4(r_[c][d], 1.0f, 2), p3_ = __builtin_amdgcn_cvt_scalef32_pk_f32_fp4(r_[c][d], 1.0f, 3); \
            s0_ = p0_ * hx[8 * c + 4 * d] + s0_; s1_ = p1_ * hx[8 * c + 4 * d + 1] + s1_; s2_ = p2_ * hx[8 * c + 4 * d + 2] + s2_; s3_ = p3_ * hx[8 * c + 4 * d + 3] + s3_; } \
        out_ = ((s0_.x + s0_.y) + (s1_.x + s1_.y)) + ((s2_.x + s2_.y) + (s3_.x + s3_.y)); } while (0)
#define UPAIR(ra_, rb_, ee) do { float sa_, sb_; UDOT(ra_, sa_); UDOT(rb_, sb_); sa_ = wave_sum_dpp(sa_); sb_ = wave_sum_dpp(sb_); \
        const int e2_ = (ee); const int ea_ = __builtin_amdgcn_readlane(e2_ < 64 ? id0 : id1, e2_ & 63), eb_ = __builtin_amdgcn_readlane(e2_ < 64 ? id0 : id1, (e2_ + 1) & 63); \
        const f32x2 a2_ = pg8::gelu_pk((f32x2){sa_ * RSU[ea_], sb_ * RSU[eb_]}); \
        if ((ee) < 64) { if (F.lane == (ee)) w0 = a2_.x * g0; if (F.lane == (ee) + 1) w0 = a2_.y * g0; } else { if (F.lane == (ee) - 64) w1 = a2_.x * g1; if (F.lane == (ee) - 63) w1 = a2_.y * g1; } } while (0)
#define LOADROWS4(T, ra_, rb_, ee) do { const int e2_ = (ee) & 127; const int ea_ = __builtin_amdgcn_readlane(e2_ < 64 ? id0 : id1, e2_ & 63), eb_ = __builtin_amdgcn_readlane(e2_ < 64 ? id0 : id1, (e2_ + 1) & 63); \
        const GAS v2u* pa_ = (const GAS v2u*)((T) + (size_t)ea_ * 2048) + F.lane; const GAS v2u* pb_ = (const GAS v2u*)((T) + (size_t)eb_ * 2048) + F.lane; \
        _Pragma("unroll") for (int c = 0; c < 4; ++c) { ra_[c] = pa_[64 * c]; rb_[c] = pb_[64 * c]; } } while (0)
#define VAXPY(r_, w_) do { const f32x2 w2_ = {w_, w_}; \
        _Pragma("unroll") for (int c = 0; c < 4; ++c) _Pragma("unroll") for (int d = 0; d < 2; ++d) { \
            const f32x2 p0_ = __builtin_amdgcn_cvt_scalef32_pk_f32_fp4(r_[c][d], 1.0f, 0), p1_ = __builtin_amdgcn_cvt_scalef32_pk_f32_fp4(r_[c][d], 1.0f, 1), \
                        p2_ = __builtin_amdgcn_cvt_scalef32_pk_f32_fp4(r_[c][d], 1.0f, 2), p3_ = __builtin_amdgcn_cvt_scalef32_pk_f32_fp4(r_[c][d], 1.0f, 3); \
            acc[8 * c + 4 * d] = p0_ * w2_ + acc[8 * c + 4 * d]; acc[8 * c + 4 * d + 1] = p1_ * w2_ + acc[8 * c + 4 * d + 1]; \
            acc[8 * c + 4 * d + 2] = p2_ * w2_ + acc[8 * c + 4 * d + 2]; acc[8 * c + 4 * d + 3] = p3_ * w2_ + acc[8 * c + 4 * d + 3]; } } while (0)
#define VPAIR(ra_, rb_, ee) do { const int e2_ = (ee); const int ea_ = __builtin_amdgcn_readlane(e2_ < 64 ? id0 : id1, e2_ & 63), eb_ = __builtin_amdgcn_readlane(e2_ < 64 ? id0 : id1, (e2_ + 1) & 63); \
        const float wa_ = __uint_as_float(__builtin_amdgcn_readlane(__float_as_uint((ee) < 64 ? w0 : w1), (ee) & 63)) * RS[ea_], wb_ = __uint_as_float(__builtin_amdgcn_readlane(__float_as_uint((ee) < 64 ? w0 : w1), ((ee) + 1) & 63)) * RS[eb_]; \
        VAXPY(ra_, wa_); VAXPY(rb_, wb_); } while (0)
template <int MODE> __device__ __forceinline__ void p10_peer(Frame& F, const Args& args) {
    const int gw = F.vcu * NWAVES + F.wave, NGW = F.G * NWAVES; const float* MOD = WSP(float, WS_MOD);
    const bf16* H2 = WSP(bf16, WS_HA); const unsigned char* U = WSP(unsigned char, WS_U); const unsigned char* V = WSP(unsigned char, WS_V); const int* IDX = WSP(int, WS_IDX); const float* GATE = WSP(float, WS_GATE); const float* RS = WSP(float, WS_RS); const float* RSU = WSP(float, WS_RSU);
#pragma unroll 1
    for (int t = gw; t < S; t += NGW) {
        const int id0 = IDX[(size_t)t * 128 + F.lane], id1 = IDX[(size_t)t * 128 + 64 + F.lane];
        const float g0 = GATE[(size_t)t * 128 + F.lane], g1 = GATE[(size_t)t * 128 + 64 + F.lane];
        float w0 = 0.f, w1 = 0.f;
        {   f32x2 hx[32];
#pragma unroll
            for (int c = 0; c < 4; ++c) { const GAS v4u* hp = (const GAS v4u*)(H2 + (size_t)t * DM + c * 1024 + F.lane * 16); const v4u a = hp[0], b = hp[1];
#pragma unroll
                for (int k = 0; k < 4; ++k) { hx[8 * c + k] = (f32x2){bflo(a[k]), bfhi(a[k])}; hx[8 * c + 4 + k] = (f32x2){bflo(b[k]), bfhi(b[k])}; } }
            v2u ra[4], rb[4], rc[4], rd[4], na[4], nb[4], nc[4], nd[4];
            if (MODE != 2) {
            LOADROWS4(U, ra, rb, 0); LOADROWS4(U, rc, rd, 2);
#pragma unroll 1
            for (int e = 0; e < 128; e += 8) {
                LOADROWS4(U, na, nb, e + 4); LOADROWS4(U, nc, nd, e + 6);
                UPAIR(ra, rb, e); UPAIR(rc, rd, e + 2);
                LOADROWS4(U, ra, rb, e + 8); LOADROWS4(U, rc, rd, e + 10);
                UPAIR(na, nb, e + 4); UPAIR(nc, nd, e + 6);
            } } }
        if (MODE == 1 || MODE == 3) { asm volatile("" :: "v"(w0), "v"(w1)); continue; }
        f32x2 acc[32];
#pragma unroll
        for (int j = 0; j < 32; ++j) acc[j] = (f32x2){0.f, 0.f};
        {   v2u ra[4], rb[4], rc[4], rd[4], na[4], nb[4], nc[4], nd[4];
            LOADROWS4(V, ra, rb, 0); LOADROWS4(V, rc, rd, 2);
#pragma unroll 1
            for (int e = 0; e < 128; e += 8) {
                LOADROWS4(V, na, nb, e + 4); LOADROWS4(V, nc, nd, e + 6);
                VPAIR(ra, rb, e); VPAIR(rc, rd, e + 2);
                LOADROWS4(V, ra, rb, e + 8); LOADROWS4(V, rc, rd, e + 10);
                VPAIR(na, nb, e + 4); VPAIR(nc, nd, e + 6);
            } }
        if (MODE == 2) {
#pragma unroll
            for (int j = 0; j < 32; ++j) asm volatile("" :: "v"(acc[j]));
            continue; }
#pragma unroll
        for (int c = 0; c < 4; ++c) { const int col = c * 1024 + F.lane * 16; GAS f32x4* op = (GAS f32x4*)(F.out + (size_t)t * DM + col);
            const GAS f32x4* xp = (const GAS f32x4*)(WSP(float, WS_X1) + (size_t)t * DM + col); const GAS f32x4* gp = (const GAS f32x4*)(MOD + 20480 + col);
#pragma unroll
            for (int q = 0; q < 4; ++q) op[q] = xp[q] + gp[q] * (f32x4){acc[8 * c + 2 * q].x, acc[8 * c + 2 * q].y, acc[8 * c + 2 * q + 1].x, acc[8 * c + 2 * q + 1].y}; }
    }
}
#undef LOADROWS
#undef UDOT
#undef UPAIR
#undef VAXPY
#undef VPAIR
#undef LOADROWS4
#ifndef MK_SINGLE
#define MK_SINGLE 1
#endif
constexpr int N_PHASES = 11;
__global__ void __launch_bounds__(NTHREADS, 2) fwd_kernel(Args args) {
    extern __shared__ __attribute__((aligned(16))) unsigned char lds[];
    Frame F;
    F.lds = (LAS unsigned char*)lds; F.MISC = (volatile LAS unsigned*)(F.lds + MISC_OFF);
    F.tid = threadIdx.x; F.lane = F.tid & 63; F.wave = __builtin_amdgcn_readfirstlane(F.tid >> 6);
    F.G = gridDim.x; { const int bx = blockIdx.x; F.vcu = (F.G % 8 == 0) ? (bx % 8) * (F.G / 8) + bx / 8 : bx; }
    F.ws = args.ws; F.out = args.out; F.ctl = (gu32*)(args.ws + WS_CTL);
    for (int u = F.tid; u < (LDS_BYTES - LDSCTL_OFF) / 4; u += NTHREADS) ((LAS unsigned*)(F.lds + LDSCTL_OFF))[u] = 0u;
    __syncthreads();
    const int lo = args.ph_lo, hi = args.ph_hi;
    XcdBarrier bar; bar.bar = (unsigned*)(F.ctl + CW_BAR); bar.x = 0; bar.st = nullptr;
    if (hi - lo > 1) bar = xcd_barrier_post((unsigned*)(F.ctl + CW_BAR), F.MISC + 8);
#ifndef PH_MASK
#define PH_MASK 0x7ff
#endif
#define IN(k) (((PH_MASK >> (k)) & 1) && lo <= (k) && (k) < hi)
#define SEAM(k) do { if (IN(k) && IN((k) + 1)) xcd_barrier(bar); } while (0)
#ifndef REP_PHASE
#define REP_PHASE -1
#endif
#define REPEAT(k) _Pragma("unroll") for (int rep = 0; rep < ((REP_PHASE) == (k) ? 2 : 1); ++rep)
#define REPBAR(k) do { if ((REP_PHASE) == (k) && rep == 0) xcd_barrier(bar); } while (0)
    const int bid = (int)blockIdx.x;
    if (IN(0)) { REPEAT(0) { p0_prologue(F, args); REPBAR(0); } SEAM(0); }
    if (IN(1)) { REPEAT(1) { p1_norm_forget(F, args); REPBAR(1); } SEAM(1); }
    if (IN(2)) { REPEAT(2) {
        pg8::Gemm g{WSP(bf16, WS_HA), WSP(bf16, WS_WIN), S, NINP, DM}; pg8::StaticOrder So; So.init(S, NINP, F.G, bid);
        pg8::EpiIn E{WSP(bf16, WS_QKV), WSP(bf16, WS_LX), WSP(bf16, WS_GY), WSP(bf16, WS_GA), WSP(bf16, WS_GL), WSP(float, WS_BIASR)};
        pg8::gemm_phase<pg8::EpiIn, pg8::StaticOrder, true, true>(F.lds, g, So, E);
        REPBAR(2); }
        SEAM(2);
    }
    if (IN(3)) {
        p3_qknorm(F, args);
        __syncthreads();
        REPEAT(3) {
        p3_cumsum(F, args);
        for (int w = bid; w < 256; w += F.G) lru_item<0>(F, args, w);
        REPBAR(3); }
        SEAM(3);
    }
    if (IN(4)) {
#pragma unroll 1
        for (int rep = 0; rep < args.rep_att; ++rep) p4_attention(F, args, (char*)lds);
#pragma unroll 1
        for (int rep = 0; rep < args.rep_lru; ++rep)
        for (int w = bid; w < 256; w += F.G) lru_item<1>(F, args, w);
        SEAM(4);
    }
    if (IN(5)) { REPEAT(5) {
        { pg8::Gemm g{WSP(bf16, WS_ATT), WSP(bf16, WS_WAO), S, DM, AW}; pg8::StaticOrder So; So.init(S, DM, F.G, bid);
          pg8::EpiGate<0> E{WSP(bf16, WS_T1), WSP(bf16, WS_GA), DM};
          pg8::gemm_phase<pg8::EpiGate<0>, pg8::StaticOrder, true, true>(F.lds, g, So, E); }
        { pg8::Gemm g{WSP(bf16, WS_LR), WSP(bf16, WS_WLO), S, DM, LW}; pg8::StaticOrder So; So.init(S, DM, F.G, bid);
          pg8::EpiGate<1> E{WSP(bf16, WS_T1), WSP(bf16, WS_GL), DM};
          pg8::gemm_phase<pg8::EpiGate<1>, pg8::StaticOrder, true, true>(F.lds, g, So, E); }
        REPBAR(5); }
        SEAM(5);
    }
    if (IN(6)) { REPEAT(6) {
        pg8::Gemm g{WSP(bf16, WS_T1), WSP(bf16, WS_WOUT), S, DM, DM}; pg8::StaticOrder So; So.init(S, DM, F.G, bid);
        pg8::EpiRes E{args.in[0], WSP(float, WS_X1), WSP(float, WS_MOD) + 8192, DM};
        pg8::gemm_phase<pg8::EpiRes, pg8::StaticOrder, true, true>(F.lds, g, So, E);
        REPBAR(6); }
        SEAM(6);
    }
    if (IN(7)) { REPEAT(7) { p7_norm2(F, args); REPBAR(7); } SEAM(7); }
    if (IN(8)) { REPEAT(8) {
        pg8::Gemm g{WSP(bf16, WS_HA), WSP(bf16, WS_WPQ), S, 2048, DM}; pg8::StaticOrder So; So.init(S, 2048, F.G, bid);
        pg8::EpiBf16<0> E{WSP(bf16, WS_Q2), 2048, nullptr, 0, 0, 1.f};
        pg8::gemm_phase<pg8::EpiBf16<0>, pg8::StaticOrder, true, true>(F.lds, g, So, E);
        REPBAR(8); }
        SEAM(8);
    }
    if (IN(9)) { REPEAT(9) { p9_topk(F, args); REPBAR(9); } SEAM(9); }
#ifndef P10_PROBE
#define P10_PROBE 0
#endif
    if (IN(10)) { if (P10_PROBE) { p10_peer<P10_PROBE>(F, args); xcd_barrier(bar); } REPEAT(10) { p10_peer<0>(F, args); REPBAR(10); } }
#undef IN
#undef SEAM
}

extern "C" void kernel_launch(void* const* d_in, const int* in_sizes, int n_in, void* d_out, int out_size, void* d_ws, size_t ws_size, hipStream_t stream) {
    static int grid = 0;
    if (grid == 0) {
        if (n_in != 24 || in_sizes[0] != S * DM || out_size != S * DM || ws_size < WS_END) { fprintf(stderr, "kernel_launch: unexpected shapes (n_in %d, in0 %d, out %d, ws %zu)\n", n_in, n_in > 0 ? in_sizes[0] : -1, out_size, ws_size); grid = -1; return; }
        int dev = 0, cus = 0, per_cu = 0;
        if (hipGetDevice(&dev) != hipSuccess || hipDeviceGetAttribute(&cus, hipDeviceAttributeMultiprocessorCount, dev) != hipSuccess) { grid = -1; return; }
        if (hipFuncSetAttribute((const void*)fwd_kernel, hipFuncAttributeMaxDynamicSharedMemorySize, LDS_BYTES) != hipSuccess) { fprintf(stderr, "kernel_launch: hipFuncSetAttribute failed\n"); grid = -1; return; }
        if (hipOccupancyMaxActiveBlocksPerMultiprocessor(&per_cu, (const void*)fwd_kernel, NTHREADS, LDS_BYTES) != hipSuccess || per_cu < 1) fprintf(stderr, "kernel_launch: occupancy query reports %d blocks per CU\n", per_cu);
        (void)hipGetLastError();
        grid = cus;
    }
    if (grid < 0) return;
    if (hipMemsetAsync((char*)d_ws + WS_CTL, 0, CTL_ZERO_BYTES, stream) != hipSuccess) return;
    Args a{};
    for (int i = 0; i < 24; ++i) a.in[i] = (const float*)d_in[i];
    a.out = (float*)d_out; a.ws = (unsigned char*)d_ws;
#ifndef REP_ATT
#define REP_ATT 1
#endif
#ifndef REP_LRU
#define REP_LRU 1
#endif
    a.rep_att = REP_ATT; a.rep_lru = REP_LRU;
#if MK_SINGLE
    a.ph_lo = 0; a.ph_hi = N_PHASES;
    hipLaunchKernelGGL(fwd_kernel, dim3(grid), dim3(NTHREADS), LDS_BYTES, stream, a);
#else
    for (int p = 0; p < N_PHASES; ++p) { a.ph_lo = p; a.ph_hi = p + 1; hipLaunchKernelGGL(fwd_kernel, dim3(grid), dim3(NTHREADS), LDS_BYTES, stream, a); }
#endif
}
```

```cpp
#define REP_PHASE -1
#include <hip/hip_runtime.h>
#include <cstdio>
#include <cstdint>
namespace pg8 {
#define PG8_LAS __attribute__((address_space(3)))
typedef unsigned short bf16_t;
typedef short bf16x8 __attribute__((ext_vector_type(8)));
typedef float f32x4 __attribute__((ext_vector_type(4)));
typedef unsigned u32x4 __attribute__((ext_vector_type(4)));
constexpr int BM = 256, BK = 64, HALF = 128, HTB = HALF * BK * 2  , STAGE_BYTES = 8 * HTB, NXCD = 8, WGM = 8;

__host__ __device__ __forceinline__ int lds_byte(int r, int c) { const int st = (r >> 4) * 2 + (c >> 5), rr = r & 15, cc = c & 31, ob = rr * 64 + cc * 2; return st * 1024 + (ob ^ (((ob >> 9) & 1) << 5)); }
__host__ __device__ __forceinline__ void stage_rc(int b, int& R, int& C) { const int st = b / 1024, sb = b % 1024, swz = sb ^ (((sb >> 9) & 1) << 5); R = (st >> 1) * 16 + swz / 64; C = (st & 1) * 32 + (swz % 64) / 2; }
__host__ __device__ __forceinline__ int perm32(int rho) { const int n = rho >> 4, i = rho & 15; return 8 * (i >> 2) + 4 * n + (i & 3); }

struct Unit { int pm, pn; };
struct Gemm { const bf16_t* A; const bf16_t* Bt; int M, N, K; };

struct StaticOrder {
    int nM, nN, nwg, G, c;
    __host__ __device__ void init(int M, int N, int G_, int c_) { nM = M / BM; nN = N / BM; nwg = nM * nN; G = G_; c = c_; }
    __host__ __device__ bool next(int i, Unit& u) const {
        const long L = (long)i * G + c; if (L >= nwg) return false;
        int wgid = (int)L; { const int q = nwg / NXCD, r = nwg % NXCD, xcd = wgid % NXCD, off = wgid / NXCD; wgid = (xcd < r ? xcd * (q + 1) : r * (q + 1) + (xcd - r) * q) + off; }
        const int nig = WGM * nN, gid = wgid / nig, fm = gid * WGM, gsz = (nM - fm) < WGM ? (nM - fm) : WGM;
        u.pm = fm + ((wgid % nig) % gsz); u.pn = (wgid % nig) / gsz; return true;
    }
    __device__ __forceinline__ void a_ready(const Unit&) const {}
    __device__ __forceinline__ void done(const Unit&) const {}
};

__device__ __forceinline__ unsigned cvt_pk_bf16(float lo, float hi) { unsigned r; asm volatile("v_cvt_pk_bf16_f32 %0, %1, %2" : "=v"(r) : "v"(lo), "v"(hi)); return r; }
typedef float f32x2 __attribute__((ext_vector_type(2)));
__device__ __forceinline__ f32x2 gelu_pk(f32x2 v) {
    const f32x2 av = __builtin_elementwise_abs(v), d = av * 0.2316418882f + 1.0f;
    f32x2 t; t.x = __builtin_amdgcn_rcpf(d.x); t.y = __builtin_amdgcn_rcpf(d.y);
    f32x2 q = t * 0.5307027145f + (-0.7265760135f); q = q * t + 0.7107068705f; q = q * t + (-0.142248368f); q = q * t + 0.127414796f; q = q * t;
    const f32x2 s = (v * v) * (-0.72134752044f);
    f32x2 e; e.x = __builtin_amdgcn_exp2f(s.x); e.y = __builtin_amdgcn_exp2f(s.y);
    const f32x2 m = v * (q * e), r = v - m;
    f32x2 o; o.x = v.x < 0.f ? m.x : r.x; o.y = v.y < 0.f ? m.y : r.y; return o;
}

template <int ACT  > struct EpiBf16 {
    static constexpr bool PERM = true, AFTER_DRAIN = false; static_assert(ACT == 0 || ACT == 1, "EpiBf16: ACT is 0 (none) or 1 (gelu_pk)");
    bf16_t* O; int ldc; const float* bias; int split_cols; size_t split_stride; float scale0;
    __device__ __forceinline__ void operator()(const f32x4 (&acc)[2][2][4][2], const Unit& u, int wr, int wc, int fr, int fq) const {
        const int row0 = u.pm * BM + wr * 64 + fr; int colt = u.pn * BM; bf16_t* base = O;
        float sc = 1.f; if (split_cols) { const int t = colt / split_cols; base += (size_t)t * split_stride; colt -= t * split_cols; if (t == 0) sc = scale0; }
        const int col0 = colt + wc * 32 + 8 * fq, bcol0 = u.pn * BM + wc * 32 + 8 * fq;
        f32x4 bv[2][2];
#pragma unroll
        for (int bj = 0; bj < 2; ++bj)
#pragma unroll
            for (int n = 0; n < 2; ++n) bv[bj][n] = bias ? *(const f32x4*)(bias + bcol0 + bj * HALF + 4 * n) : (f32x4){0.f, 0.f, 0.f, 0.f};
#pragma unroll
        for (int ai = 0; ai < 2; ++ai)
#pragma unroll
            for (int m = 0; m < 4; ++m) { bf16_t* rowp = base + (size_t)(row0 + ai * HALF + m * 16) * ldc + col0;
#pragma unroll
                for (int bj = 0; bj < 2; ++bj) { f32x4 v0 = acc[ai][bj][m][0] + bv[bj][0], v1 = acc[ai][bj][m][1] + bv[bj][1];
                    if (ACT == 1) { f32x2 a = gelu_pk((f32x2){v0[0], v0[1]}), b = gelu_pk((f32x2){v0[2], v0[3]}), c = gelu_pk((f32x2){v1[0], v1[1]}), d = gelu_pk((f32x2){v1[2], v1[3]});
                        v0 = (f32x4){a.x, a.y, b.x, b.y}; v1 = (f32x4){c.x, c.y, d.x, d.y}; }
                    v0 = v0 * sc; v1 = v1 * sc; u32x4 w; w.x = cvt_pk_bf16(v0[0], v0[1]); w.y = cvt_pk_bf16(v0[2], v0[3]); w.z = cvt_pk_bf16(v1[0], v1[1]); w.w = cvt_pk_bf16(v1[2], v1[3]);
                    *(u32x4*)(rowp + bj * HALF) = w; } }
    }
};
__device__ __forceinline__ f32x4 sigm4(f32x4 v) { f32x4 o;
#pragma unroll
    for (int j = 0; j < 4; ++j) o[j] = __builtin_amdgcn_rcpf(1.0f + __builtin_amdgcn_exp2f(-1.4426950408889634f * v[j]));
    return o; }
__device__ __forceinline__ f32x4 gelu4(f32x4 v) { const f32x2 a = gelu_pk((f32x2){v[0], v[1]}), b = gelu_pk((f32x2){v[2], v[3]}); return (f32x4){a.x, a.y, b.x, b.y}; }
__device__ __forceinline__ void unpack8(const u32x4 w, f32x4& lo, f32x4& hi) {
    lo = (f32x4){__uint_as_float(w.x << 16), __uint_as_float(w.x & 0xffff0000u), __uint_as_float(w.y << 16), __uint_as_float(w.y & 0xffff0000u)};
    hi = (f32x4){__uint_as_float(w.z << 16), __uint_as_float(w.z & 0xffff0000u), __uint_as_float(w.w << 16), __uint_as_float(w.w & 0xffff0000u)}; }
struct EpiIn {
    static constexpr bool PERM = true, AFTER_DRAIN = false;
    bf16_t* qkv; bf16_t* lx; bf16_t* gy; bf16_t* ga; bf16_t* gl; const float* bias;
    __device__ __forceinline__ void operator()(const f32x4 (&acc)[2][2][4][2], const Unit& u, int wr, int wc, int fr, int fq) const {
        const int pn = u.pn; bf16_t* base; int ldc, colt, act;
        if (pn < 24) { base = qkv + (size_t)(pn >> 3) * ((size_t)8192 * 2048); ldc = 2048; colt = (pn & 7) * 256; act = 0; }
        else if (pn < 32) { base = lx; ldc = 2048; colt = (pn - 24) * 256; act = 0; }
        else if (pn < 40) { base = gy; ldc = 2048; colt = (pn - 32) * 256; act = 1; }
        else if (pn < 56) { base = ga; ldc = 4096; colt = (pn - 40) * 256; act = 2; }
        else { base = gl; ldc = 4096; colt = (pn - 56) * 256; act = 2; }
        const int row0 = u.pm * BM + wr * 64 + fr, col0 = colt + wc * 32 + 8 * fq, bcol0 = pn * BM + wc * 32 + 8 * fq;
        f32x4 bv[2][2];
#pragma unroll
        for (int bj = 0; bj < 2; ++bj)
#pragma unroll
            for (int n = 0; n < 2; ++n) bv[bj][n] = *(const f32x4*)(bias + bcol0 + bj * HALF + 4 * n);
#pragma unroll
        for (int ai = 0; ai < 2; ++ai)
#pragma unroll
            for (int m = 0; m < 4; ++m) { bf16_t* rowp = base + (size_t)(row0 + ai * HALF + m * 16) * ldc + col0;
#pragma unroll
                for (int bj = 0; bj < 2; ++bj) { f32x4 v0 = acc[ai][bj][m][0] + bv[bj][0], v1 = acc[ai][bj][m][1] + bv[bj][1];
                    if (act == 1) { v0 = gelu4(v0); v1 = gelu4(v1); }
                    else if (act == 2) { v0 = sigm4(v0); v1 = sigm4(v1); }
                    u32x4 w; w.x = cvt_pk_bf16(v0[0], v0[1]); w.y = cvt_pk_bf16(v0[2], v0[3]); w.z = cvt_pk_bf16(v1[0], v1[1]); w.w = cvt_pk_bf16(v1[2], v1[3]);
                    *(u32x4*)(rowp + bj * HALF) = w; } }
    }
};
template <int MODE> struct EpiGate {
    static constexpr bool PERM = true, AFTER_DRAIN = false;
    bf16_t* O; const bf16_t* Gt; int ldc;
    __device__ __forceinline__ void operator()(const f32x4 (&acc)[2][2][4][2], const Unit& u, int wr, int wc, int fr, int fq) const {
        const int row0 = u.pm * BM + wr * 64 + fr, col0 = u.pn * BM + wc * 32 + 8 * fq;
#pragma unroll
        for (int ai = 0; ai < 2; ++ai)
#pragma unroll
            for (int m = 0; m < 4; ++m) { const size_t off = (size_t)(row0 + ai * HALF + m * 16) * ldc + col0;
#pragma unroll
                for (int bj = 0; bj < 2; ++bj) { f32x4 g0, g1; unpack8(*(const u32x4*)(Gt + off + bj * HALF), g0, g1);
                    f32x4 v0 = acc[ai][bj][m][0] * g0, v1 = acc[ai][bj][m][1] * g1;
                    if (MODE == 1) { f32x4 t0, t1; unpack8(*(const u32x4*)(O + off + bj * HALF), t0, t1); v0 += t0; v1 += t1; }
                    u32x4 w; w.x = cvt_pk_bf16(v0[0], v0[1]); w.y = cvt_pk_bf16(v0[2], v0[3]); w.z = cvt_pk_bf16(v1[0], v1[1]); w.w = cvt_pk_bf16(v1[2], v1[3]);
                    *(u32x4*)(O + off + bj * HALF) = w; } }
    }
};
struct EpiRes {
    static constexpr bool PERM = false, AFTER_DRAIN = false;
    const float* X; float* Out; const float* gate; int ldc;
    __device__ __forceinline__ void operator()(const f32x4 (&acc)[2][2][4][2], const Unit& u, int wr, int wc, int fr, int fq) const {
        const int row0 = u.pm * BM + wr * 64 + fr, col0 = u.pn * BM + wc * 32 + 4 * fq;
        f32x4 gv[2][2];
#pragma unroll
        for (int bj = 0; bj < 2; ++bj)
#pragma unroll
            for (int n = 0; n < 2; ++n) gv[bj][n] = *(const f32x4*)(gate + col0 + bj * HALF + n * 16);
#pragma unroll
        for (int ai = 0; ai < 2; ++ai)
#pragma unroll
            for (int m = 0; m < 4; ++m) { const size_t off = (size_t)(row0 + ai * HALF + m * 16) * ldc + col0;
#pragma unroll
                for (int bj = 0; bj < 2; ++bj)
#pragma unroll
                    for (int n = 0; n < 2; ++n) { const f32x4 xv = *(const f32x4*)(X + off + bj * HALF + n * 16);
                        *(f32x4*)(Out + off + bj * HALF + n * 16) = xv + gv[bj][n] * acc[ai][bj][m][n]; } }
    }
};
template <class Epi, class Sched, bool ALIGN_EPI = false, bool SP2 = false>
__device__ __forceinline__ void gemm_phase(PG8_LAS unsigned char* lds, const Gemm g, const Sched& S, const Epi& E) {
    const int tid = threadIdx.x, wid = __builtin_amdgcn_readfirstlane(tid >> 6), lane = tid & 63, wr = wid >> 2, wc = wid & 3, fr = lane & 15, fq = lane >> 4;
    const int K = g.K, nt = K / BK;
    unsigned voffA[2], voffB[2];
#pragma unroll
    for (int i = 0; i < 2; ++i) { int R, C; stage_rc(tid * 16 + i * 8192, R, C); const int Rb = Epi::PERM ? ((R & ~31) + perm32(R & 31)) : R;
        voffA[i] = (unsigned)(R * K + C) * 2u; voffB[i] = (unsigned)(Rb * K + C) * 2u; }
    const size_t kstep = (size_t)(BK * 2);
    const size_t hstep = (size_t)HALF * K * 2;
    const size_t tstep = 2 * hstep;
    const unsigned ldsw = (unsigned)wid * 1024u;
    const int aoff = lds_byte(wr * 64 + fr, fq * 8), boff = lds_byte(wc * 32 + fr, fq * 8);
#define PG8_SA(b, h) (((b) * 2 + (h)) * HTB)
#define PG8_SB(b, h) ((4 + (b) * 2 + (h)) * HTB)
#define PG8_STAGE(bufoff, gbase, voff) do { _Pragma("unroll") for (int _i = 0; _i < 2; ++_i) \
        __builtin_amdgcn_global_load_lds((const unsigned*)((const char*)(gbase) + (voff)[_i]), (PG8_LAS unsigned*)(lds + (bufoff) + ldsw + _i * 8192), 16, 0, 0); } while (0)
#define PG8_LDA(dst, b, h) do { _Pragma("unroll") for (int m = 0; m < 4; ++m) _Pragma("unroll") for (int k = 0; k < 2; ++k) dst[m][k] = *(const PG8_LAS bf16x8*)(lds + PG8_SA(b, h) + aoff + m * 2048 + k * 1024); } while (0)
#define PG8_LDB(dst, b, h) do { _Pragma("unroll") for (int n = 0; n < 2; ++n) _Pragma("unroll") for (int k = 0; k < 2; ++k) dst[n][k] = *(const PG8_LAS bf16x8*)(lds + PG8_SB(b, h) + boff + n * 2048 + k * 1024); } while (0)
#define PG8_MMA(ai, bj, At, Bt) do { __builtin_amdgcn_s_setprio(1); _Pragma("unroll") for (int m = 0; m < 4; ++m) _Pragma("unroll") for (int n = 0; n < 2; ++n) _Pragma("unroll") for (int k = 0; k < 2; ++k) \
        acc[ai][bj][m][n] = __builtin_amdgcn_mfma_f32_16x16x32_bf16(Bt[n][k], At[m][k], acc[ai][bj][m][n], 0, 0, 0); __builtin_amdgcn_s_setprio(0); } while (0)
#define PG8_WAIT_V(n) asm volatile("s_waitcnt vmcnt(" #n ")" ::: "memory")
#define PG8_WAIT_L(n) asm volatile("s_waitcnt lgkmcnt(" #n ")" ::: "memory")
#define PG8_BAR __builtin_amdgcn_s_barrier()
#define PG8_SCHED __builtin_amdgcn_sched_barrier(0)
    Unit cur, nxt; int ui = 0;
    if (!S.next(0, cur)) return;
    f32x4 acc[2][2][4][2];
#pragma unroll
    for (int a = 0; a < 2; ++a)
#pragma unroll
        for (int b = 0; b < 2; ++b)
#pragma unroll
            for (int m = 0; m < 4; ++m)
#pragma unroll
                for (int n = 0; n < 2; ++n) acc[a][b][m][n] = (f32x4){0.f, 0.f, 0.f, 0.f};
    bf16x8 At[4][2], B0[2][2], B1[2][2];
    const char* cA = (const char*)g.A + (size_t)cur.pm * tstep; const char* cB = (const char*)g.Bt + (size_t)cur.pn * tstep;
    S.a_ready(cur);
    if constexpr (SP2) {
        PG8_STAGE(PG8_SB(0, 0), cB, voffB); PG8_STAGE(PG8_SB(0, 1), cB + hstep, voffB); PG8_STAGE(PG8_SA(0, 0), cA, voffA); PG8_STAGE(PG8_SA(0, 1), cA + hstep, voffA);
        if (wr == 1) PG8_BAR;
        PG8_WAIT_V(2); PG8_BAR;
        PG8_STAGE(PG8_SB(1, 0), cB + kstep, voffB); PG8_STAGE(PG8_SA(1, 0), cA + kstep, voffA); PG8_STAGE(PG8_SB(1, 1), cB + hstep + kstep, voffB);
        PG8_WAIT_V(6); PG8_BAR;
    } else {
        PG8_STAGE(PG8_SB(0, 0), cB, voffB); PG8_STAGE(PG8_SA(0, 0), cA, voffA); PG8_STAGE(PG8_SB(0, 1), cB + hstep, voffB); PG8_STAGE(PG8_SA(0, 1), cA + hstep, voffA);
        if (wr == 1) PG8_BAR;
        PG8_WAIT_V(4); PG8_BAR;
        PG8_STAGE(PG8_SB(1, 0), cB + kstep, voffB); PG8_STAGE(PG8_SA(1, 0), cA + kstep, voffA); PG8_STAGE(PG8_SB(1, 1), cB + hstep + kstep, voffB);
        PG8_WAIT_V(6); PG8_BAR;
    }
    for (;;) {
        const bool has_next = S.next(ui + 1, nxt);
        const char* nA = has_next ? (const char*)g.A + (size_t)nxt.pm * tstep : cA; const char* nB = has_next ? (const char*)g.Bt + (size_t)nxt.pn * tstep : cB;
        for (int t = 0; t < nt; t += 2) {
            const bool last = (t == nt - 2);
            const char* a1 = cA + (size_t)(t + 1) * kstep;
            const char* a2 = last ? nA : cA + (size_t)(t + 2) * kstep; const char* b2 = last ? nB : cB + (size_t)(t + 2) * kstep;
            const char* a3 = a2 + kstep; const char* b3 = b2 + kstep;
            if (last && has_next) S.a_ready(nxt);
            if constexpr (SP2) {
            PG8_LDB(B0, 0, 0); PG8_LDB(B1, 0, 1); PG8_SCHED; PG8_LDA(At, 0, 0); PG8_STAGE(PG8_SA(1, 1), a1 + hstep, voffA);
            PG8_WAIT_V(8); PG8_WAIT_L(0); PG8_BAR; PG8_MMA(0, 0, At, B0); PG8_MMA(0, 1, At, B1); PG8_BAR; PG8_SCHED;
            PG8_LDA(At, 0, 1); PG8_STAGE(PG8_SB(0, 0), b2, voffB); PG8_STAGE(PG8_SB(0, 1), b2 + hstep, voffB); PG8_STAGE(PG8_SA(0, 0), a2, voffA);
            PG8_WAIT_V(8); PG8_WAIT_L(0); PG8_BAR; PG8_MMA(1, 0, At, B0); PG8_MMA(1, 1, At, B1); PG8_BAR; PG8_SCHED;
            PG8_LDB(B0, 1, 0); PG8_LDB(B1, 1, 1); PG8_SCHED; PG8_LDA(At, 1, 0); PG8_STAGE(PG8_SA(0, 1), a2 + hstep, voffA);
            PG8_WAIT_V(8); PG8_WAIT_L(0); PG8_BAR; PG8_MMA(0, 0, At, B0); PG8_MMA(0, 1, At, B1); PG8_BAR; PG8_SCHED;
            PG8_LDA(At, 1, 1); PG8_STAGE(PG8_SB(1, 0), b3, voffB); PG8_STAGE(PG8_SB(1, 1), b3 + hstep, voffB); PG8_STAGE(PG8_SA(1, 0), a3, voffA);
            PG8_WAIT_V(8); PG8_WAIT_L(0); PG8_BAR; PG8_MMA(1, 0, At, B0); PG8_MMA(1, 1, At, B1); PG8_BAR; PG8_SCHED;
            } else {
            PG8_LDB(B0, 0, 0); PG8_SCHED; PG8_LDA(At, 0, 0); PG8_STAGE(PG8_SA(1, 1), a1 + hstep, voffA);
            PG8_WAIT_L(8); PG8_BAR; PG8_WAIT_L(0); PG8_MMA(0, 0, At, B0); PG8_BAR; PG8_SCHED;
            PG8_LDB(B1, 0, 1); PG8_STAGE(PG8_SB(0, 0), b2, voffB);
            PG8_BAR; PG8_WAIT_L(0); PG8_MMA(0, 1, At, B1); PG8_BAR;
            PG8_LDA(At, 0, 1); PG8_STAGE(PG8_SA(0, 0), a2, voffA);
            PG8_BAR; PG8_WAIT_L(0); PG8_MMA(1, 0, At, B0); PG8_BAR; PG8_SCHED;
            PG8_STAGE(PG8_SB(0, 1), b2 + hstep, voffB);
            PG8_WAIT_V(6); PG8_BAR; PG8_MMA(1, 1, At, B1); PG8_BAR;
            PG8_LDB(B0, 1, 0); PG8_SCHED; PG8_LDA(At, 1, 0); PG8_STAGE(PG8_SA(0, 1), a2 + hstep, voffA);
            PG8_WAIT_L(8); PG8_BAR; PG8_WAIT_L(0); PG8_MMA(0, 0, At, B0); PG8_BAR; PG8_SCHED;
            PG8_LDB(B1, 1, 1); PG8_STAGE(PG8_SB(1, 0), b3, voffB);
            PG8_BAR; PG8_WAIT_L(0); PG8_MMA(0, 1, At, B1); PG8_BAR;
            PG8_LDA(At, 1, 1); PG8_STAGE(PG8_SA(1, 0), a3, voffA);
            PG8_BAR; PG8_WAIT_L(0); PG8_MMA(1, 0, At, B0); PG8_BAR; PG8_SCHED;
            PG8_STAGE(PG8_SB(1, 1), b3 + hstep, voffB);
            PG8_WAIT_V(6); PG8_BAR; PG8_MMA(1, 1, At, B1); PG8_BAR;
            }
        }
        if constexpr (ALIGN_EPI) { if (wr == 0) PG8_BAR; }
        if constexpr (!Epi::AFTER_DRAIN) { E(acc, cur, wr, wc, fr, fq); S.done(cur); }
        if (!has_next) break;
#pragma unroll
        for (int a = 0; a < 2; ++a)
#pragma unroll
            for (int b = 0; b < 2; ++b)
#pragma unroll
                for (int m = 0; m < 4; ++m)
#pragma unroll
                    for (int n = 0; n < 2; ++n) acc[a][b][m][n] = (f32x4){0.f, 0.f, 0.f, 0.f};
        cur = nxt; cA = nA; cB = nB; ++ui;
        if constexpr (ALIGN_EPI) { if (wr == 1) PG8_BAR; }
    }
    PG8_WAIT_V(0);
    if constexpr (!ALIGN_EPI) { if (wr == 0) PG8_BAR; }
    PG8_BAR;
    if constexpr (Epi::AFTER_DRAIN) { E.fused(acc, cur, wr, wc, fr, fq, lds, wid, lane); S.done(cur); }
#undef PG8_SA
#undef PG8_SB
#undef PG8_STAGE
#undef PG8_LDA
#undef PG8_LDB
#undef PG8_MMA
#undef PG8_WAIT_V
#undef PG8_WAIT_L
#undef PG8_BAR
#undef PG8_SCHED
}
}
namespace attn_body {
constexpr int D = 128, LD = 2048;
constexpr float THR = 8.f; constexpr bool WSKIP = false;
constexpr float SCALE = 0.08838834764831845f;
constexpr int NW = 8, QBLK = 32, KVBLK = 64, QB = NW * QBLK;
constexpr int SHM_V = KVBLK * D * 2, SHM_K = KVBLK * D * 2;
constexpr int LDS_BYTES = 2 * SHM_V + 2 * SHM_K + NW * 64 * 4;

typedef short bf16x8 __attribute__((ext_vector_type(8)));
typedef short s16x4 __attribute__((ext_vector_type(4)));
typedef float f32x16 __attribute__((ext_vector_type(16)));
typedef float f32x4 __attribute__((ext_vector_type(4)));
typedef unsigned u32x4 __attribute__((ext_vector_type(4)));
template <class A, class Bt> struct same_t { static constexpr bool v = false; };
template <class A> struct same_t<A, A> { static constexpr bool v = true; };

#define KSWZ(row, colB) ((row) * 256 + ((colB) ^ (((row) & 7) << 4)))
#define SBAR() __builtin_amdgcn_sched_barrier(0)
__device__ __forceinline__ int v_st(int k, int c) { const int kk = (k & ~0xC) | ((k & 4) << 1) | ((k & 8) >> 1); return ((kk >> 3) * 4 + (c >> 5)) * 512 + ((kk & 7) * 32 + (c & 31)) * 2; }
__device__ __forceinline__ int v_rd_base(int lane) { return ((lane & 3) << 3) | (((lane >> 2) & 3) << 6) | (((lane >> 4) & 1) << 5) | (((lane >> 5) & 1) << 8); }
constexpr int v_rd_off(int d0, int ks, int half) { return d0 * 512 + ks * 4096 + half * 2048; }
__device__ __forceinline__ int crow(int r, int hi) { return (r & 3) + 8 * (r >> 2) + 4 * hi; }
__device__ __forceinline__ unsigned cvtpk(float lo, float hi) {
    unsigned r; asm volatile("v_cvt_pk_bf16_f32 %0, %1, %2" : "=v"(r) : "v"(lo), "v"(hi)); return r;
}
__device__ __forceinline__ bf16x8 pack8(f32x4 a, f32x4 b) {
    u32x4 w = {cvtpk(a[0], a[1]), cvtpk(a[2], a[3]), cvtpk(b[0], b[1]), cvtpk(b[2], b[3])};
    return *reinterpret_cast<bf16x8*>(&w);
}
template <class T> __device__ __forceinline__ bf16x8 load8(const T* p) {
    if constexpr (same_t<T, float>::v) { return pack8(*(const f32x4*)p, *(const f32x4*)(p + 4)); }
    else { return *reinterpret_cast<const bf16x8*>(p); }
}
__device__ __forceinline__ void mask_tile(f32x16& p0, f32x16& p1, int dq, unsigned W) {
    const float NEG = -__builtin_inff();
#pragma unroll
    for (int r = 0; r < 16; ++r) {
        const int c = (r & 3) + 8 * (r >> 2);
        if ((unsigned)(dq - c) >= W) p0[r] = NEG;
        if ((unsigned)(dq - c - 32) >= W) p1[r] = NEG;
    }
}
__device__ __forceinline__ void partialSM(f32x16& p0, f32x16& p1, float& m_reg, float& mn, float& alpha) {
    float pmax = p0[0]; for (int r = 1; r < 16; ++r) pmax = fmaxf(pmax, p0[r]); for (int r = 0; r < 16; ++r) pmax = fmaxf(pmax, p1[r]);
    { auto rr = __builtin_amdgcn_permlane32_swap(__float_as_uint(pmax), __float_as_uint(pmax), false, false);
      pmax = fmaxf(__uint_as_float(rr[0]), __uint_as_float(rr[1])); }
    constexpr float C2 = 1.4426950408889634f * SCALE;
    if (__builtin_expect(__all((pmax - m_reg) * SCALE <= THR), 1)) { mn = m_reg; alpha = 1.f; }
    else { mn = fmaxf(m_reg, pmax); alpha = __builtin_amdgcn_exp2f((m_reg - mn) * C2); m_reg = mn; }
    const float mnL = -mn * C2;
    for (int r = 0; r < 16; ++r) p0[r] = fmaf(p0[r], C2, mnL); for (int r = 0; r < 16; ++r) p1[r] = fmaf(p1[r], C2, mnL);
    for (int r = 0; r < 16; ++r) p0[r] = __builtin_amdgcn_exp2f(p0[r]);
}
__device__ __forceinline__ void finishSM(f32x16& p0, f32x16& p1, float alpha, float& l_reg, bf16x8& pa0, bf16x8& pa1, bf16x8& pa2, bf16x8& pa3) {
    for (int r = 0; r < 16; ++r) p1[r] = __builtin_amdgcn_exp2f(p1[r]);
    float ps = 0; for (int r = 0; r < 16; ++r) ps += p0[r]; for (int r = 0; r < 16; ++r) ps += p1[r];
    { auto rr = __builtin_amdgcn_permlane32_swap(__float_as_uint(ps), __float_as_uint(ps), false, false);
      ps = __uint_as_float(rr[0]) + __uint_as_float(rr[1]); }
    l_reg = l_reg * alpha + ps;
#define PK4(P, B_, OUT) do { unsigned a0 = cvtpk(P[B_+0], P[B_+1]), a1 = cvtpk(P[B_+2], P[B_+3]);                          \
        unsigned b0 = cvtpk(P[B_+4], P[B_+5]), b1 = cvtpk(P[B_+6], P[B_+7]);                                             \
        auto r0 = __builtin_amdgcn_permlane32_swap(a0, b0, false, false); auto r1 = __builtin_amdgcn_permlane32_swap(a1, b1, false, false); \
        u32x4 w = {r0[0], r1[0], r0[1], r1[1]}; OUT = *reinterpret_cast<bf16x8*>(&w); } while (0)
    PK4(p0, 0, pa0); PK4(p0, 8, pa1); PK4(p1, 0, pa2); PK4(p1, 8, pa3);
#undef PK4
}
template <int KB, bool SK>
__device__ __forceinline__ void qkt(f32x16& p0, f32x16& p1, const char* K_lds, int r32, int hi, const bf16x8* qr, bool act, const float* bt) {
    if (SK && !act) { const float NEG = -__builtin_inff();
#pragma unroll
        for (int r = 0; r < 16; ++r) { p0[r] = NEG; p1[r] = NEG; } return; }
    { const f32x4 b0 = *(const f32x4*)(bt), b1 = *(const f32x4*)(bt + 8), b2 = *(const f32x4*)(bt + 16), b3 = *(const f32x4*)(bt + 24);
      const f32x4 c0 = *(const f32x4*)(bt + 32), c1 = *(const f32x4*)(bt + 40), c2 = *(const f32x4*)(bt + 48), c3 = *(const f32x4*)(bt + 56);
      p0 = (f32x16){b0[0], b0[1], b0[2], b0[3], b1[0], b1[1], b1[2], b1[3], b2[0], b2[1], b2[2], b2[3], b3[0], b3[1], b3[2], b3[3]};
      p1 = (f32x16){c0[0], c0[1], c0[2], c0[3], c1[0], c1[1], c1[2], c1[3], c2[0], c2[1], c2[2], c2[3], c3[0], c3[1], c3[2], c3[3]}; }
    const char* kb[4];
#pragma unroll
    for (int dd = 0; dd < 4; ++dd) kb[dd] = K_lds + KB * SHM_K + KSWZ(r32, (dd * 16 + hi * 8) * 2);
#pragma unroll
    for (int d0 = 0; d0 < 8; ++d0) { const char* a = kb[d0 & 3] + (d0 >> 2) * 128;
        bf16x8 b0 = *reinterpret_cast<const bf16x8*>(a);
        bf16x8 b1 = *reinterpret_cast<const bf16x8*>(a + 32 * 256);
        p0 = __builtin_amdgcn_mfma_f32_32x32x16_bf16(b0, qr[d0], p0, 0, 0, 0);
        p1 = __builtin_amdgcn_mfma_f32_32x32x16_bf16(b1, qr[d0], p1, 0, 0, 0); }
}
template <int VB, bool SK>
__device__ __forceinline__ void pv_tile(f32x16* o, int vb0, bf16x8 pa0, bf16x8 pa1, bf16x8 pa2, bf16x8 pa3, bool act) {
    if (SK && !act) return;
#define TRRD(dst, off) asm volatile("ds_read_b64_tr_b16 %0, %1 offset:%2" : "=&v"(dst) : "v"(vb0), "i"(off) : "memory")
#define PV_D0(d0) do { s16x4 l0, l1, l2, l3, h0, h1, h2, h3; constexpr int b_ = VB * SHM_V + v_rd_off(d0, 0, 0);     \
        TRRD(l0, b_); TRRD(h0, b_ + 2048); TRRD(l1, b_ + 4096); TRRD(h1, b_ + 6144); TRRD(l2, b_ + 8192); TRRD(h2, b_ + 10240); TRRD(l3, b_ + 12288); TRRD(h3, b_ + 14336); \
        asm volatile("s_waitcnt lgkmcnt(0)" ::: "memory"); SBAR();                 \
        o[d0] = __builtin_amdgcn_mfma_f32_32x32x16_bf16(pa0, (bf16x8){l0[0], l0[1], l0[2], l0[3], h0[0], h0[1], h0[2], h0[3]}, o[d0], 0, 0, 0);   \
        o[d0] = __builtin_amdgcn_mfma_f32_32x32x16_bf16(pa1, (bf16x8){l1[0], l1[1], l1[2], l1[3], h1[0], h1[1], h1[2], h1[3]}, o[d0], 0, 0, 0);   \
        o[d0] = __builtin_amdgcn_mfma_f32_32x32x16_bf16(pa2, (bf16x8){l2[0], l2[1], l2[2], l2[3], h2[0], h2[1], h2[2], h2[3]}, o[d0], 0, 0, 0);   \
        o[d0] = __builtin_amdgcn_mfma_f32_32x32x16_bf16(pa3, (bf16x8){l3[0], l3[1], l3[2], l3[3], h3[0], h3[1], h3[2], h3[3]}, o[d0], 0, 0, 0); } while (0)
    PV_D0(0); PV_D0(1); PV_D0(2); PV_D0(3);
#undef PV_D0
#undef TRRD
}


template <class TIn, class TOut> struct BlockRef { const TIn* Q; const TIn* K; const TIn* V; TOut* O; int P0; int jlo; };
#define ROW(p, k0, rr) ((p) + (size_t)((k0) + (rr)) * LD + sc)
#define VMW() asm volatile("s_waitcnt vmcnt(0)" ::: "memory")
#define SLOAD_H(Kp, Vp, k0) do { st_v0 = load8<TIn>(ROW(Vp, k0, sr)); st_v1 = load8<TIn>(ROW(Vp, k0, 32 + sr));              \
                         st_k0 = load8<TIn>(ROW(Kp, k0, sr)); st_k1 = load8<TIn>(ROW(Kp, k0, 32 + sr)); } while (0)
#define SWRITE_H(bf) do { *(bf16x8*)(V_lds + (bf) * SHM_V + vst0) = st_v0; *(bf16x8*)(V_lds + (bf) * SHM_V + vst1) = st_v1;   \
                          *(bf16x8*)(K_lds + (bf) * SHM_K + kws) = st_k0; *(bf16x8*)(K_lds + (bf) * SHM_K + kws + 32 * 256) = st_k1; } while (0)
template <class TIn, class TOut>
__device__ __forceinline__ void attn_unit(const BlockRef<TIn, TOut>& cur, int skv, char* lds) {
    const int tid = threadIdx.x, wid = __builtin_amdgcn_readfirstlane(tid >> 6), lane = tid & 63, r32 = lane & 31, hi = lane >> 5;
    const unsigned W = 0x40000000u;
    const int j_lo = cur.jlo;
    int j_hi = (cur.P0 + QB - 1) / KVBLK + 1; if (j_hi > skv / KVBLK) j_hi = skv / KVBLK;
    const int NT = j_hi - j_lo;
    const int qlo = cur.P0 + wid * QBLK, qm = qlo + r32 - 4 * hi;
    char* V_lds = lds; char* K_lds = lds + 2 * SHM_V;
    float* ws = (float*)(lds + 2 * SHM_V + 2 * SHM_K) + wid * 64; float* li_l = ws, * al_l = ws + 32;
    const float* bias_l = (const float*)(lds + LDS_BYTES) + 4 * hi;
    float m_reg = -1e30f, l_reg = 0; f32x16 o[4] = {};
    const int sr = tid >> 4, sc = (tid & 15) * 8, vst0 = v_st(sr, sc), vst1 = v_st(32 + sr, sc), kws = KSWZ(sr, sc * 2);
    const int vb0 = (int)(uintptr_t)V_lds + v_rd_base(lane);
    const TIn* Kh = cur.K; const TIn* Vh = cur.V;
    bf16x8 st_v0, st_v1, st_k0, st_k1; bf16x8 qr[8];
#define KBASE(t) ((j_lo + (t)) * KVBLK)
#define BT(t) (bias_l + (t) * KVBLK)
#define RESC(a) do { if (__any((a) < 1.f)) { if (hi == 0) al_l[r32] = (a); asm volatile("s_waitcnt lgkmcnt(0)" ::: "memory");              \
                     for (int d_ = 0; d_ < 4; ++d_) for (int r = 0; r < 16; ++r) o[d_][r] *= al_l[crow(r, hi)]; } } while (0)
#define MASKT(P0_, P1_, t) do { const int kb_ = KBASE(t); if (kb_ + KVBLK - 1 > qlo) mask_tile(P0_, P1_, qm - kb_, W); } while (0)
#pragma unroll
    for (int d0 = 0; d0 < 8; ++d0) qr[d0] = load8<TIn>(cur.Q + (size_t)(wid * QBLK + r32) * LD + d0 * 16 + hi * 8);
    SLOAD_H(Kh, Vh, KBASE(0)); VMW(); SWRITE_H(0); SBAR();
    if (NT > 1) SLOAD_H(Kh, Vh, KBASE(1));
    __syncthreads();
    f32x16 p0, p1; float mn, al; bf16x8 pa0, pa1, pa2, pa3;
#define TILE_STEP(t, BUF) do {                                                                                                 \
        SBAR(); qkt<BUF, false>(p0, p1, K_lds, r32, hi, qr, true, BT(t));                                                       \
        MASKT(p0, p1, (t)); partialSM(p0, p1, m_reg, mn, al); RESC(al);                                                          \
        finishSM(p0, p1, al, l_reg, pa0, pa1, pa2, pa3); SBAR();                                                                 \
        pv_tile<BUF, false>(o, vb0, pa0, pa1, pa2, pa3, true);                                                                    \
        if ((t) + 1 < NT) { VMW(); SWRITE_H(1 - (BUF)); SBAR(); if ((t) + 2 < NT) SLOAD_H(Kh, Vh, KBASE((t) + 2)); }              \
        __syncthreads(); } while (0)
    for (int t = 0; t < NT; t += 2) {
        TILE_STEP(t, 0);
        if (t + 1 < NT) TILE_STEP(t + 1, 1);
    }
    if (hi == 0) li_l[r32] = l_reg; asm volatile("s_waitcnt lgkmcnt(0)" ::: "memory");
    float rli[16];
#pragma unroll
    for (int r = 0; r < 16; ++r) rli[r] = __builtin_amdgcn_rcpf(li_l[crow(r, hi)]);
    TOut* Ow = cur.O + (size_t)(wid * QBLK) * LD;
#pragma unroll
    for (int r = 0; r < 16; ++r) { const int orow = crow(r, hi);
#pragma unroll
        for (int d0 = 0; d0 < 4; ++d0) { const float v = o[d0][r] * rli[r];
            const float vn = __shfl_xor(v, 1);
            if ((r32 & 1) == 0) *(unsigned*)(Ow + (size_t)orow * LD + d0 * 32 + r32) = cvtpk(v, vn); } }
    __syncthreads();
#undef TILE_STEP
#undef RESC
#undef KBASE
#undef BT
#undef MASKT
}
#undef ROW
#undef VMW
#undef SLOAD_H
#undef SWRITE_H
}
#define GAS __attribute__((address_space(1)))
#define LAS __attribute__((address_space(3)))
typedef unsigned short bf16;
typedef unsigned v4u __attribute__((ext_vector_type(4)));
typedef unsigned v2u __attribute__((ext_vector_type(2)));
typedef float f32x4 __attribute__((ext_vector_type(4)));
typedef float f32x2 __attribute__((ext_vector_type(2)));
typedef short bf16x8 __attribute__((ext_vector_type(8)));
typedef GAS unsigned gu32;
#define RLX_AGENT __ATOMIC_RELAXED, __HIP_MEMORY_SCOPE_AGENT

constexpr int S = 8192, DM = 4096, NH = 16, HD = 128, AW = 2048, LW = 2048, NG = 16, GD = 128;
constexpr int NIN = 18448, NINP = 18432;
constexpr int C_Q = 0, C_K = 2048, C_V = 4096, C_F = 6144, C_LX = 6160, C_LY = 8208, C_GA = 10256, C_GL = 14352;
constexpr int PEER_H = 8, PEER_NK = 128, PEER_K = 16, PEER_NE = 16384;
constexpr float EPS = 1e-6f;
constexpr size_t MiB = 1u << 20;
constexpr size_t WS_CTL = 0, CTL_ZERO_BYTES = 1 * MiB;
constexpr size_t WS_MOD = 512 * 1024;
constexpr size_t WS_WF = 2 * MiB;
constexpr size_t WS_LOGF = 3 * MiB;
constexpr size_t WS_FC = 4 * MiB;
constexpr size_t WS_AGGA = 5 * MiB, WS_AGGB = 6 * MiB;
constexpr size_t WS_BIASR = 7 * MiB;
constexpr size_t WS_WAT = 8 * MiB, WS_WXT = 9 * MiB;
constexpr size_t WS_SK = 10 * MiB, WS_RS = 11 * MiB, WS_RSU = 11 * MiB + 65536;
constexpr size_t WS_IDX = 12 * MiB, WS_GATE = 16 * MiB, WS_IDX2 = 20 * MiB, WS_GATE2 = 24 * MiB;
constexpr size_t WS_WIN = 32 * MiB, WS_WAO = 176 * MiB, WS_WLO = 192 * MiB, WS_WOUT = 208 * MiB, WS_WPQ = 240 * MiB;
constexpr size_t WS_U = 256 * MiB, WS_V = 384 * MiB;
constexpr size_t WS_HA = 512 * MiB;
constexpr size_t WS_QKV = 576 * MiB;
constexpr size_t WS_LX = 672 * MiB, WS_GY = 704 * MiB, WS_GA = 736 * MiB, WS_GL = 800 * MiB;
constexpr size_t WS_ATT = 864 * MiB, WS_LR = 896 * MiB, WS_T1 = 928 * MiB, WS_MG = 992 * MiB, WS_Q2 = 1056 * MiB, WS_X1 = 1088 * MiB, WS_END = 1216 * MiB;
constexpr int CW_BAR = 4096;
constexpr int CW_QATT = 256;
constexpr int RING_BYTES = 131072;
constexpr int LDSCTL_OFF = RING_BYTES, MISC_OFF = LDSCTL_OFF + 320;
constexpr int LDS_BYTES = 151552;
constexpr int NWAVES = 8, NTHREADS = 512;

__device__ __forceinline__ unsigned f2bf(float f) { unsigned u = __builtin_bit_cast(unsigned, f); return (u + 0x7fffu + ((u >> 16) & 1u)) >> 16; }
__device__ __forceinline__ unsigned pk2(float lo, float hi) { return f2bf(lo) | (f2bf(hi) << 16); }
__device__ __forceinline__ float bflo(unsigned w) { return __uint_as_float(w << 16); }
__device__ __forceinline__ float bfhi(unsigned w) { return __uint_as_float(w & 0xffff0000u); }
__device__ __forceinline__ float bf2f(bf16 b) { return __uint_as_float((unsigned)b << 16); }
__device__ __forceinline__ float wave_sum(float v) {
#pragma unroll
    for (int o = 1; o < 64; o <<= 1) v += __shfl_xor(v, o);
    return v;
}
__device__ __forceinline__ float wave_max(float v) {
#pragma unroll
    for (int o = 1; o < 64; o <<= 1) v = fmaxf(v, __shfl_xor(v, o));
    return v;
}
__device__ __forceinline__ float sigmoidf_(float v) { return __builtin_amdgcn_rcpf(1.0f + __builtin_amdgcn_exp2f(-1.4426950408889634f * v)); }
__device__ __forceinline__ float gelu_erf(float v) { return 0.5f * v * (1.0f + erff(v * 0.70710678118654752f)); }
#define XB_TMO      128
#define XB_XCNT(j)  (256  + 64 * (j))
#define XB_XSUB(j)  (1280 + 64 * (j))
#define XB_XGEN(j)  (2304 + 64 * (j))
#define XB_TOP      3328
#define XB_TOPGEN   3392
#define XCD_BAR_WORDS 3456
#define XB_SPIN_CAP (1u << 18)

__device__ __forceinline__ unsigned xb_ld(unsigned* p)              { return __hip_atomic_load(p, __ATOMIC_RELAXED, __HIP_MEMORY_SCOPE_AGENT); }
__device__ __forceinline__ unsigned xb_add(unsigned* p, unsigned v) { return __hip_atomic_fetch_add(p, v, __ATOMIC_RELAXED, __HIP_MEMORY_SCOPE_AGENT); }
__device__ __forceinline__ unsigned xb_xcc_id() { return (unsigned)__builtin_amdgcn_s_getreg((3 << 11) | 20) & 0xFu; }
#define XB_SPIN(cond, bar) do { unsigned _sp = 0; while (cond) { __builtin_amdgcn_s_sleep(1); \
    if ((++_sp & 255u) == 0u) { if (xb_ld(&(bar)[XB_TMO])) break; if (_sp > XB_SPIN_CAP) { atomicAdd(&(bar)[XB_TMO], 1u); break; } } } } while (0)

struct XcdBarrier {
    unsigned* bar; unsigned x;
    volatile LAS unsigned* st;
};

__device__ __forceinline__ XcdBarrier xcd_barrier_post(unsigned* bar, volatile LAS unsigned* st) {
    XcdBarrier b; b.bar = bar; b.x = xb_xcc_id(); b.st = st;
    if (threadIdx.x == 0) (void)xb_add(&bar[XB_XCNT(b.x)], 1u);
    return b;
}
__device__ __forceinline__ void xcd_barrier_complete(unsigned* bar, unsigned x, unsigned& nloc, unsigned& nx) {
    const unsigned G = gridDim.x * gridDim.y * gridDim.z;
    unsigned sum, cnt, mine, sp = 0u;
    for (;;) {
        sum = 0u; cnt = 0u; mine = 0u;
#pragma unroll
        for (unsigned j = 0; j < 16; ++j) { const unsigned c = xb_ld(&bar[XB_XCNT(j)]); sum += c; cnt += (c > 0u) ? 1u : 0u; mine = (j == x) ? c : mine; }
        if (sum == G) break;
        __builtin_amdgcn_s_sleep(1);
        if ((++sp & 255u) == 0u) { if (xb_ld(&bar[XB_TMO])) break; if (sp > XB_SPIN_CAP) { atomicAdd(&bar[XB_TMO], 1u); break; } }
    }
    nloc = mine > 0u ? mine : 1u; nx = cnt > 0u ? cnt : 1u;
}

__device__ __forceinline__ void xcd_barrier(const XcdBarrier& b) {
    asm volatile("s_waitcnt vmcnt(0)" ::: "memory");
    __syncthreads();
    if (threadIdx.x == 0) {
        unsigned* bar = b.bar;
        __builtin_amdgcn_s_waitcnt(0);
        unsigned nloc = b.st[0], nx = b.st[1];
        if (nloc == 0u) { xcd_barrier_complete(bar, b.x, nloc, nx); b.st[0] = nloc; b.st[1] = nx; }
        const unsigned old = xb_add(&bar[XB_XSUB(b.x)], 1u);
        const unsigned gen = old / nloc;
        if (old + 1u == (gen + 1u) * nloc) {
            __builtin_amdgcn_fence(__ATOMIC_RELEASE, "agent");
            asm volatile("s_waitcnt vmcnt(0)" ::: "memory");
            const unsigned og = xb_add(&bar[XB_TOP], 1u);
            const unsigned tg = og / nx;
            if (og + 1u == (tg + 1u) * nx) xb_add(&bar[XB_TOPGEN], 1u);
            else XB_SPIN(xb_ld(&bar[XB_TOPGEN]) == tg, bar);
            __builtin_amdgcn_fence(__ATOMIC_ACQUIRE, "agent");
            xb_add(&bar[XB_XGEN(b.x)], 1u);
            asm volatile("s_waitcnt vmcnt(0)" ::: "memory");
        } else {
            XB_SPIN(xb_ld(&bar[XB_XGEN(b.x)]) == gen, bar);
            __builtin_amdgcn_fence(__ATOMIC_ACQUIRE, "agent");
            asm volatile("s_waitcnt vmcnt(0)" ::: "memory");
        }
    }
    __syncthreads();
}
struct Args { const float* in[24]; float* out; unsigned char* ws; int ph_lo, ph_hi, rep_att, rep_lru; };
struct Frame {
    LAS unsigned char* lds; volatile LAS unsigned* MISC; gu32* ctl;
    int tid, lane, wave, vcu, G;
    unsigned char* ws; float* out;
};
#define WSP(T, off) ((T*)(F.ws + (off)))
#define LDS_WAIT() asm volatile("s_waitcnt lgkmcnt(0)" ::: "memory")

__device__ __forceinline__ void transpose_item(const float* W, int ldw, int K, bf16* WT, LAS float* scr, int k0, int nsrc0, int ndst0, int lane) {
    float v[32]; const float* wp = W + (size_t)(k0 + (lane >> 5)) * ldw + nsrc0 + (lane & 31);
#pragma unroll
    for (int i = 0; i < 32; ++i) v[i] = wp[(size_t)(2 * i) * ldw];
#pragma unroll
    for (int i = 0; i < 32; ++i) scr[(2 * i + (lane >> 5)) * 33 + (lane & 31)] = v[i];
    LDS_WAIT(); asm volatile("" ::: "memory");
    const int c = lane & 7;
#pragma unroll
    for (int j = 0; j < 4; ++j) { const int n = (lane >> 3) + 8 * j; const LAS float* s = scr + (8 * c) * 33 + n;
        v4u o; o.x = pk2(s[0 * 33], s[1 * 33]); o.y = pk2(s[2 * 33], s[3 * 33]); o.z = pk2(s[4 * 33], s[5 * 33]); o.w = pk2(s[6 * 33], s[7 * 33]);
        *(GAS v4u*)(WT + (size_t)(ndst0 + n) * K + k0 + 8 * c) = o; }
    LDS_WAIT(); asm volatile("" ::: "memory");
}
__device__ __forceinline__ void cvt_stream(const float* src, bf16* dst, size_t n8, size_t i0, size_t stride) {
    for (size_t i = i0; i < n8; i += stride) { const f32x4 a = ((const GAS f32x4*)src)[2 * i], b = ((const GAS f32x4*)src)[2 * i + 1];
        v4u o; o.x = pk2(a[0], a[1]); o.y = pk2(a[2], a[3]); o.z = pk2(b[0], b[1]); o.w = pk2(b[2], b[3]); ((GAS v4u*)dst)[i] = o; }
}
__device__ __forceinline__ void cvt_stream_fp8(const float* src, unsigned char* dst, size_t n16, float scale, size_t i0, size_t stride) {
    for (size_t i = i0; i < n16; i += stride) { v4u o;
#pragma unroll
        for (int q = 0; q < 4; ++q) { const f32x4 a = ((const GAS f32x4*)src)[4 * i + q] * scale; int w = 0;
            w = __builtin_amdgcn_cvt_pk_fp8_f32(a[0], a[1], w, false); w = __builtin_amdgcn_cvt_pk_fp8_f32(a[2], a[3], w, true); o[q] = (unsigned)w; }
        ((GAS v4u*)dst)[i] = o; }
}
__device__ __forceinline__ void cvt_table_fp4(Frame& F, const float* srcT, unsigned char* dstT, float* rsT, int gw, int NGW) {
    for (int row = gw; row < PEER_NE; row += NGW) {
        const GAS f32x4* src = (const GAS f32x4*)(srcT + (size_t)row * DM); f32x4 a[16]; float am = 0.f;
#pragma unroll
        for (int c = 0; c < 4; ++c)
#pragma unroll
            for (int q = 0; q < 4; ++q) { a[4 * c + q] = src[c * 256 + 4 * F.lane + q]; am = fmaxf(fmaxf(am, fmaxf(fabsf(a[4 * c + q][0]), fabsf(a[4 * c + q][1]))), fmaxf(fabsf(a[4 * c + q][2]), fabsf(a[4 * c + q][3]))); }
        am = wave_max(am); const float inv = am > 0.f ? 6.0f / am : 0.f;
#pragma unroll
        for (int c = 0; c < 4; ++c) { v2u o;
#pragma unroll
            for (int d = 0; d < 2; ++d) { unsigned w = 0u; const f32x4 x0 = a[4 * c + 2 * d] * inv, x1 = a[4 * c + 2 * d + 1] * inv;
                w = __builtin_amdgcn_cvt_scalef32_pk_fp4_f32(w, x0[0], x0[1], 1.0f, 0); w = __builtin_amdgcn_cvt_scalef32_pk_fp4_f32(w, x0[2], x0[3], 1.0f, 1);
                w = __builtin_amdgcn_cvt_scalef32_pk_fp4_f32(w, x1[0], x1[1], 1.0f, 2); w = __builtin_amdgcn_cvt_scalef32_pk_fp4_f32(w, x1[2], x1[3], 1.0f, 3); o[d] = w; }
            *((GAS v2u*)(dstT + (size_t)row * 2048 + c * 512) + F.lane) = o; }
        if (F.lane == 0) rsT[row] = am * (1.0f / 6.0f);
    }
}
__device__ __forceinline__ void p0_prologue(Frame& F, const Args& args) {
#ifndef P0_REP
#define P0_REP 0
#endif
    _Pragma("unroll") for (int rep_ = 0; rep_ < ((P0_REP & 1) ? 2 : 1); ++rep_)
    { LAS float* sc = (LAS float*)F.lds; LAS f32x4* red = (LAS f32x4*)(F.lds + 16384); float* MOD = WSP(float, WS_MOD);
      for (int cgi = blockIdx.x; cgi < 256; cgi += F.G) {
          for (int i = F.tid; i < DM; i += NTHREADS) { const float cv = args.in[1][i]; sc[i] = cv / (1.0f + __expf(-cv)); }
          __syncthreads();
          if (F.tid < 384) { const int cg = F.tid % 24, rg = F.tid / 24;
              const GAS f32x4* Wp = (const GAS f32x4*)args.in[2] + cgi * 24 + cg;
              f32x4 acc = {0.f, 0.f, 0.f, 0.f};
#pragma unroll 8
              for (int r = rg; r < DM; r += 16) acc += sc[r] * Wp[(size_t)r * 6144];
              red[rg * 24 + cg] = acc; }
          __syncthreads();
          if (F.tid < 24) { f32x4 s = red[F.tid];
#pragma unroll
              for (int rg = 1; rg < 16; ++rg) s += red[rg * 24 + F.tid];
              s += ((const GAS f32x4*)args.in[3])[cgi * 24 + F.tid]; ((GAS f32x4*)MOD)[cgi * 24 + F.tid] = s; }
          __syncthreads();
      } }
    LAS float* scr = (LAS float*)(F.lds + F.wave * 16384);
    const int gw = F.vcu * NWAVES + F.wave, NGW = F.G * NWAVES;
    constexpr int I_IN = 64 * 576, I_AO = 32 * 128, I_LO = 32 * 128, I_OUT = 64 * 128, I_PQ = 64 * 64, I_WA = 16 * 2 * 4, I_WX = I_WA;
    constexpr int NITEMS = I_IN + I_AO + I_LO + I_OUT + I_PQ + I_WA + I_WX;
    _Pragma("unroll") for (int rep_ = 0; rep_ < ((P0_REP & 2) ? 2 : 1); ++rep_)
    for (int it = gw; it < NITEMS; it += NGW) {
        int r = it;
        if (r < I_IN) { const int kb = r / 576, nb = r % 576; transpose_item(args.in[6], NIN, DM, WSP(bf16, WS_WIN), scr, 64 * kb, 32 * nb + (nb >= 192 ? 16 : 0), 32 * nb, F.lane); continue; } r -= I_IN;
        if (r < I_AO) { const int kb = r / 128, nb = r % 128; transpose_item(args.in[17], DM, AW, WSP(bf16, WS_WAO), scr, 64 * kb, 32 * nb, 32 * nb, F.lane); continue; } r -= I_AO;
        if (r < I_LO) { const int kb = r / 128, nb = r % 128; transpose_item(args.in[18], DM, LW, WSP(bf16, WS_WLO), scr, 64 * kb, 32 * nb, 32 * nb, F.lane); continue; } r -= I_LO;
        if (r < I_OUT) { const int kb = r / 128, nb = r % 128; transpose_item(args.in[19], DM, DM, WSP(bf16, WS_WOUT), scr, 64 * kb, 32 * nb, 32 * nb, F.lane); continue; } r -= I_OUT;
        if (r < I_PQ) { const int kb = r / 64, nb = r % 64; transpose_item(args.in[20], 2048, DM, WSP(bf16, WS_WPQ), scr, 64 * kb, 32 * nb, 32 * nb, F.lane); continue; } r -= I_PQ;
        { const bool isx = r >= I_WA; if (isx) r -= I_WA; const int g = r >> 3, kb = (r >> 2) & 1, nb = r & 3;
          transpose_item((isx ? args.in[14] : args.in[12]) + (size_t)g * GD * GD, GD, GD, WSP(bf16, isx ? WS_WXT : WS_WAT) + (size_t)g * GD * GD, scr, 64 * kb, 32 * nb, 32 * nb, F.lane); }
    }
    const size_t gt = (size_t)F.vcu * NTHREADS + F.tid, NGT = (size_t)F.G * NTHREADS;
    _Pragma("unroll") for (int rep_ = 0; rep_ < ((P0_REP & 4) ? 2 : 1); ++rep_) {
    cvt_table_fp4(F, args.in[23], WSP(unsigned char, WS_V), WSP(float, WS_RS), gw, NGW);
    cvt_table_fp4(F, args.in[22], WSP(unsigned char, WS_U), WSP(float, WS_RSU), gw, NGW); }
    cvt_stream(args.in[21], WSP(bf16, WS_SK), (size_t)PEER_H * 2 * 128 * 128 / 8, gt, NGT);
    for (size_t i = gt; i < (size_t)DM * 16; i += NGT) WSP(float, WS_WF)[i] = args.in[6][(i >> 4) * NIN + C_F + (i & 15)];
    for (size_t i = gt; i < (size_t)NINP; i += NGT) WSP(float, WS_BIASR)[i] = args.in[7][i + (i >= (size_t)C_F ? 16 : 0)];
}

__device__ __forceinline__ void p1_norm_forget(Frame& F, const Args& args) {
    const int gw = F.vcu * NWAVES + F.wave, NGW = F.G * NWAVES; const float* MOD = WSP(float, WS_MOD); const float* WF = WSP(float, WS_WF); bf16* HA = WSP(bf16, WS_HA);
    for (int rg = gw; rg < S / 4; rg += NGW) {
        const int r0 = rg * 4; float rstd[4];
#pragma unroll
        for (int r = 0; r < 4; ++r) { const GAS f32x4* xr = (const GAS f32x4*)(args.in[0] + (size_t)(r0 + r) * DM) + F.lane; float ss = 0.f;
#pragma unroll
            for (int j = 0; j < 16; ++j) { const f32x4 v = xr[64 * j]; ss += (v[0] * v[0] + v[1] * v[1]) + (v[2] * v[2] + v[3] * v[3]); }
            rstd[r] = 1.0f / sqrtf(wave_sum(ss) * (1.0f / DM) + EPS); }
        float acc[4][16];
#pragma unroll
        for (int r = 0; r < 4; ++r)
#pragma unroll
            for (int cc = 0; cc < 16; ++cc) acc[r][cc] = 0.f;
        for (int j = 0; j < 16; ++j) {
            const int i4 = F.lane + 64 * j;
            const f32x4 g = ((const GAS f32x4*)args.in[4])[i4], scl = ((const GAS f32x4*)(MOD + 4096))[i4], sh = ((const GAS f32x4*)MOD)[i4];
            const f32x4 mul = g * (scl + 1.0f);
            f32x4 wf[4][4];
#pragma unroll
            for (int i = 0; i < 4; ++i)
#pragma unroll
                for (int q = 0; q < 4; ++q) wf[i][q] = ((const GAS f32x4*)(WF + (size_t)(4 * i4 + i) * 16))[q];
#pragma unroll
            for (int r = 0; r < 4; ++r) {
                const f32x4 xv = ((const GAS f32x4*)(args.in[0] + (size_t)(r0 + r) * DM))[i4];
                const f32x4 hv = xv * rstd[r] * mul + sh;
                v2u o; o.x = pk2(hv[0], hv[1]); o.y = pk2(hv[2], hv[3]);
                ((GAS v2u*)(HA + (size_t)(r0 + r) * DM))[i4] = o;
#pragma unroll
                for (int i = 0; i < 4; ++i)
#pragma unroll
                    for (int q = 0; q < 4; ++q)
#pragma unroll
                        for (int e = 0; e < 4; ++e) acc[r][4 * q + e] += hv[i] * wf[i][q][e];
            }
        }
#pragma unroll
        for (int r = 0; r < 4; ++r)
#pragma unroll
            for (int cc = 0; cc < 16; ++cc) { const float tot = wave_sum(acc[r][cc]);
                if (F.lane == cc) { const float f = tot + args.in[7][C_F + cc]; WSP(float, WS_LOGF)[(size_t)(r0 + r) * 16 + cc] = fminf(f, 0.f) - log1pf(__expf(-fabsf(f))); } }
    }
}

__device__ __forceinline__ void p3_qknorm(Frame& F, const Args& args) {
    const int gw = F.vcu * NWAVES + F.wave, NGW = F.G * NWAVES; bf16* QK = WSP(bf16, WS_QKV);
    const int sub = F.lane & 15;
    f32x4 gq0 = ((const GAS f32x4*)args.in[8])[2 * sub], gq1 = ((const GAS f32x4*)args.in[8])[2 * sub + 1], gk0 = ((const GAS f32x4*)args.in[9])[2 * sub], gk1 = ((const GAS f32x4*)args.in[9])[2 * sub + 1];
    for (int it = gw; it < 2 * S * NH / 4; it += NGW) {
        const size_t unit = (size_t)it * 4 + (F.lane >> 4); const bool isk = unit >= (size_t)S * NH;
        GAS v4u* p = (GAS v4u*)(QK + unit * 128) + sub; const v4u w = *p;
        f32x4 a = {bflo(w.x), bfhi(w.x), bflo(w.y), bfhi(w.y)}, b = {bflo(w.z), bfhi(w.z), bflo(w.w), bfhi(w.w)};
        float ss = (a[0] * a[0] + a[1] * a[1]) + (a[2] * a[2] + a[3] * a[3]) + (b[0] * b[0] + b[1] * b[1]) + (b[2] * b[2] + b[3] * b[3]);
        ss += __shfl_xor(ss, 1); ss += __shfl_xor(ss, 2); ss += __shfl_xor(ss, 4); ss += __shfl_xor(ss, 8);
        const float rs = 1.0f / sqrtf(ss * (1.0f / HD) + EPS);
        a = a * rs * (isk ? gk0 : gq0); b = b * rs * (isk ? gk1 : gq1);
        v4u o; o.x = pk2(a[0], a[1]); o.y = pk2(a[2], a[3]); o.z = pk2(b[0], b[1]); o.w = pk2(b[2], b[3]); *p = o;
    }
}
__device__ __forceinline__ void p3_cumsum(Frame& F, const Args& args) {
    LAS float* wt = (LAS float*)F.lds;
    for (int h = blockIdx.x; h < NH; h += F.G) {
        const float* LF = WSP(float, WS_LOGF); float v[16]; float run = 0.f;
#pragma unroll
        for (int i = 0; i < 16; ++i) { run += LF[(size_t)(F.tid * 16 + i) * 16 + h]; v[i] = run; }
        float sc = run;
#pragma unroll
        for (int o = 1; o < 64; o <<= 1) { const float t = __shfl_up(sc, o); if (F.lane >= o) sc += t; }
        if (F.lane == 63) wt[F.wave] = sc;
        __syncthreads();
        float pre = sc - run;
        for (int w = 0; w < F.wave; ++w) pre += wt[w];
        float* Fo = WSP(float, WS_FC) + (size_t)h * S + F.tid * 16;
#pragma unroll
        for (int i = 0; i < 4; ++i) ((GAS f32x4*)Fo)[i] = (f32x4){v[4 * i] + pre, v[4 * i + 1] + pre, v[4 * i + 2] + pre, v[4 * i + 3] + pre};
        __syncthreads();
    }
}
constexpr int LRU_XCF = 0, LRU_XCB = 32768, LRU_AB = 49152, LRU_BB = 81920, LRU_QA = 114688, LRU_CAR = 118784, LRU_XR = 133120;
template <int PASS> __device__ __forceinline__ void lru_chunk(Frame& F, const Args& args, int c, int g) {
    LAS float* XCF = (LAS float*)(F.lds + LRU_XCF); LAS unsigned char* XCB = F.lds + LRU_XCB; LAS float* AB = (LAS float*)(F.lds + LRU_AB); LAS float* BB = (LAS float*)(F.lds + LRU_BB);
    LAS float* QA = (LAS float*)(F.lds + LRU_QA); LAS float* CAR = (LAS float*)(F.lds + LRU_CAR); LAS bf16* XR = (LAS bf16*)(F.lds + LRU_XR);
    const int t0 = 64 * c, ch0 = GD * g; const bf16* LX = WSP(bf16, WS_LX);
    for (int p = F.tid; p < 67 * 16; p += NTHREADS) { const int r = p >> 4, cc = p & 15, tg = t0 - 3 + r; v4u v = {0u, 0u, 0u, 0u};
        if (tg >= 0) v = *(const GAS v4u*)(LX + (size_t)tg * LW + ch0 + cc * 8);
        *(LAS v4u*)(XR + r * 128 + cc * 8) = v; }
    __syncthreads();
    { const int ch = F.tid & 127, tq = F.tid >> 7, gch = ch0 + ch;
      const float w0 = args.in[10][gch], w1 = args.in[10][LW + gch], w2 = args.in[10][2 * LW + gch], w3 = args.in[10][3 * LW + gch], cb = args.in[11][gch];
      float xm3 = bf2f(XR[(16 * tq + 0) * 128 + ch]), xm2 = bf2f(XR[(16 * tq + 1) * 128 + ch]), xm1 = bf2f(XR[(16 * tq + 2) * 128 + ch]);
#pragma unroll
      for (int i = 0; i < 16; ++i) { const int t = 16 * tq + i; const float x0 = bf2f(XR[(t + 3) * 128 + ch]);
          const float xc = w0 * xm3 + w1 * xm2 + w2 * xm1 + w3 * x0 + cb; xm3 = xm2; xm2 = xm1; xm1 = x0;
          XCF[t * 128 + ch] = xc; *(LAS bf16*)(XCB + t * 256 + ((ch * 2) ^ ((t & 7) << 4))) = (bf16)f2bf(xc); } }
    __syncthreads();
    { const int fr = F.lane & 15, fq = F.lane >> 4, j = 16 * F.wave + fr;
      const bf16* WA = WSP(bf16, WS_WAT) + (size_t)g * GD * GD + (size_t)j * GD + 8 * fq; const bf16* WX = WSP(bf16, WS_WXT) + (size_t)g * GD * GD + (size_t)j * GD + 8 * fq;
      bf16x8 ba[4], bx[4];
#pragma unroll
      for (int ks = 0; ks < 4; ++ks) { ba[ks] = *(const GAS bf16x8*)(WA + 32 * ks); bx[ks] = *(const GAS bf16x8*)(WX + 32 * ks); }
      const int gch = ch0 + j; const float bav = args.in[13][gch], bxv = args.in[15][gch], lam = args.in[16][gch];
      const float sp8 = -8.0f * 1.4426950408889634f * ((lam > 0.f ? 0.f : -lam) + log1pf(__expf(-fabsf(lam))));
#pragma unroll
      for (int mt = 0; mt < 4; ++mt) { f32x4 ar = {0.f, 0.f, 0.f, 0.f}, ax = {0.f, 0.f, 0.f, 0.f}; const int t = 16 * mt + fr;
#pragma unroll
          for (int ks = 0; ks < 4; ++ks) { const bf16x8 af = *(const LAS bf16x8*)(XCB + t * 256 + (((32 * ks + 8 * fq) * 2) ^ ((t & 7) << 4)));
              ar = __builtin_amdgcn_mfma_f32_16x16x32_bf16(af, ba[ks], ar, 0, 0, 0); ax = __builtin_amdgcn_mfma_f32_16x16x32_bf16(af, bx[ks], ax, 0, 0, 0); }
#pragma unroll
          for (int rg = 0; rg < 4; ++rg) { const int tt = 16 * mt + 4 * fq + rg; const float xcv = XCF[tt * 128 + j];
              const float rgt = sigmoidf_(ar[rg] + bav), igt = sigmoidf_(ax[rg] + bxv);
              const float a = __builtin_amdgcn_exp2f(rgt * sp8); const float om = fmaxf((1.0f - a) * (1.0f + a), 0.f);
              const float b = __builtin_amdgcn_sqrtf(om) * (igt * xcv);
              AB[tt * 128 + j] = a; BB[tt * 128 + j] = b; } } }
    __syncthreads();
    const int ch = F.tid & 127, q = F.tid >> 7;
    { float A = 1.f, B = 0.f;
#pragma unroll
      for (int i = 0; i < 16; ++i) { const int t = 16 * q + i; const float a = AB[t * 128 + ch]; B = a * B + BB[t * 128 + ch]; A *= a; }
      QA[(q * 128 + ch) * 2] = A; QA[(q * 128 + ch) * 2 + 1] = B; }
    __syncthreads();
    if (PASS == 0) {
        if (F.tid < 128) { float A = 1.f, B = 0.f;
#pragma unroll
            for (int qq = 0; qq < 4; ++qq) { const float a = QA[(qq * 128 + F.tid) * 2], b = QA[(qq * 128 + F.tid) * 2 + 1]; B = a * B + b; A *= a; }
            WSP(float, WS_AGGA)[(size_t)c * LW + ch0 + F.tid] = A; WSP(float, WS_AGGB)[(size_t)c * LW + ch0 + F.tid] = B; }
    } else {
        float h = CAR[ch];
        for (int qq = 0; qq < q; ++qq) h = QA[(qq * 128 + ch) * 2] * h + QA[(qq * 128 + ch) * 2 + 1];
#pragma unroll
        for (int i = 0; i < 16; ++i) { const int t = 16 * q + i; h = AB[t * 128 + ch] * h + BB[t * 128 + ch]; XCF[t * 128 + ch] = h; }
        __syncthreads();
        if (F.tid < 128) { float hc = CAR[F.tid];
#pragma unroll
            for (int qq = 0; qq < 4; ++qq) hc = QA[(qq * 128 + F.tid) * 2] * hc + QA[(qq * 128 + F.tid) * 2 + 1];
            CAR[F.tid] = hc; }
        const bf16* GY = WSP(bf16, WS_GY); bf16* LR = WSP(bf16, WS_LR);
        for (int p = F.tid; p < 64 * 16; p += NTHREADS) { const int r = p >> 4, cc = p & 15; const size_t o = (size_t)(t0 + r) * LW + ch0 + cc * 8;
            const v4u gy = *(const GAS v4u*)(GY + o); const f32x4 h0 = *(const LAS f32x4*)(XCF + r * 128 + cc * 8), h1 = *(const LAS f32x4*)(XCF + r * 128 + cc * 8 + 4);
            v4u ov; ov.x = pk2(h0[0] * bflo(gy.x), h0[1] * bfhi(gy.x)); ov.y = pk2(h0[2] * bflo(gy.y), h0[3] * bfhi(gy.y)); ov.z = pk2(h1[0] * bflo(gy.z), h1[1] * bfhi(gy.z)); ov.w = pk2(h1[2] * bflo(gy.w), h1[3] * bfhi(gy.w));
            *(GAS v4u*)(LR + o) = ov; }
    }
    __syncthreads();
}
template <int PASS> __device__ __forceinline__ void lru_item(Frame& F, const Args& args, int w) {
    const int g = w & 15, c0 = (w >> 4) * 8; LAS float* CAR = (LAS float*)(F.lds + LRU_CAR); LAS float* QA = (LAS float*)(F.lds + LRU_QA);
    if (PASS == 1) {
        const int ch = F.tid & 127, q = F.tid >> 7, n = c0 / 4;
        const float* GA_ = WSP(float, WS_AGGA) + GD * g + ch; const float* GB_ = WSP(float, WS_AGGB) + GD * g + ch; float A = 1.f, B = 0.f;
#pragma unroll 4
        for (int cc = q * n; cc < (q + 1) * n; ++cc) { const float a = GA_[(size_t)cc * LW], b = GB_[(size_t)cc * LW]; B = a * B + b; A *= a; }
        QA[(q * 128 + ch) * 2] = A; QA[(q * 128 + ch) * 2 + 1] = B;
        __syncthreads();
        if (F.tid < 128) { float hc = 0.f;
#pragma unroll
            for (int qq = 0; qq < 4; ++qq) hc = QA[(qq * 128 + F.tid) * 2] * hc + QA[(qq * 128 + F.tid) * 2 + 1];
            CAR[F.tid] = hc; }
        __syncthreads();
    }
    for (int c = c0; c < c0 + 8; ++c) lru_chunk<PASS>(F, args, c, g);
}
constexpr int ATT_BIAS_OFF = attn_body::LDS_BYTES;
typedef attn_body::BlockRef<bf16, bf16> ARef;
__device__ __forceinline__ int attn_jlo(const float* Fh, int qb, float TH, int lane) {
    const int t0 = qb * 256; const float f0 = Fh[t0];
    const int j0 = lane, j1 = lane + 64;
    const bool ok0 = (64 * j0 + 63 >= t0) || (f0 - Fh[64 * j0 + 63] >= -TH), ok1 = (64 * j1 + 63 >= t0) || (f0 - Fh[64 * j1 + 63] >= -TH);
    const unsigned long long m0 = __ballot(ok0), m1 = __ballot(ok1);
    return m0 ? (int)__builtin_ctzll(m0) : 64 + (int)__builtin_ctzll(m1);
}
__device__ __forceinline__ ARef attn_ref(Frame& F, const Args& args, int h, int qb, int jlo) {
    ARef r; const bf16* QK = WSP(bf16, WS_QKV);
    r.Q = QK + (size_t)(qb * 256) * AW + h * HD; r.K = QK + (size_t)S * AW + h * HD; r.V = QK + 2 * (size_t)S * AW + h * HD;
    r.O = WSP(bf16, WS_ATT) + (size_t)(qb * 256) * AW + h * HD; r.P0 = qb * 256; r.jlo = jlo; return r;
}
__device__ __forceinline__ void attn_fill_bias(Frame& F, const Args& args, int h, int qb, int jlo) {
    const float* Fh = WSP(float, WS_FC) + (size_t)h * S; LAS float* bl = (LAS float*)(F.lds + ATT_BIAS_OFF);
    const int k0 = jlo * 64, n = (qb + 1) * 256 - k0; const float fr = Fh[k0];
#pragma unroll 1
    for (int i = F.tid; i < n; i += NTHREADS) bl[i] = (fr - Fh[k0 + i]) * (1.0f / attn_body::SCALE);
}
constexpr int ATT_SCHED_OFF = 104448;
__device__ __forceinline__ void p4_attention(Frame& F, const Args& args, char* lds_generic, int rep) {
    float gq = fmaxf(fabsf(args.in[8][F.lane]), fabsf(args.in[8][F.lane + 64])), gk = fmaxf(fabsf(args.in[9][F.lane]), fabsf(args.in[9][F.lane + 64]));
    gq = wave_max(gq); gk = wave_max(gk);
    const float TH = 2.0f * (128.0f * gq * gk * attn_body::SCALE) + 40.0f;
    LAS float* Fend = (LAS float*)(F.lds + ATT_SCHED_OFF); LAS int* cost = (LAS int*)(F.lds + ATT_SCHED_OFF + 8192); LAS int* jlo_t = cost + 512; LAS int* order = cost + 1024; LAS int* slot = cost + 1536;
    const float* Fc = WSP(float, WS_FC);
    for (int p = F.tid; p < NH * 128; p += NTHREADS) Fend[p] = Fc[(size_t)(p >> 7) * S + 64 * (p & 127) + 63];
    __syncthreads();
    { const int u = F.tid, h = u >> 5, qb = u & 31, t0 = qb * 256; const float f0 = Fc[(size_t)h * S + t0];
      int lo = 0, hi = 4 * qb;
      while (lo < hi) { const int mid = (lo + hi) >> 1; const bool ok = (64 * mid + 63 >= t0) || (f0 - Fend[h * 128 + mid] >= -TH); if (ok) hi = mid; else lo = mid + 1; }
      jlo_t[u] = lo; cost[u] = 4 * (qb + 1) - lo; }
    __syncthreads();
    { const int u = F.tid, cu = cost[u]; int rk = 0;
      for (int v = 0; v < 512; ++v) { const int cv = cost[v]; rk += (cv > cu || (cv == cu && v < u)) ? 1 : 0; }
      order[rk] = u; }
    __syncthreads();
    for (;;) {
        if (F.tid == 0) slot[0] = (int)__hip_atomic_fetch_add((unsigned*)(F.ctl + CW_QATT + 64 * rep), 1u, RLX_AGENT);
        __syncthreads();
        const int k = slot[0];
        __syncthreads();
        if (k >= 512) break;
        const int u = order[k], h = u >> 5, qb = u & 31, jl = jlo_t[u];
        const ARef r0 = attn_ref(F, args, h, qb, jl);
        attn_fill_bias(F, args, h, qb, jl); __syncthreads();
        attn_body::attn_unit<bf16, bf16>(r0, S, lds_generic);
    }
}

__device__ __forceinline__ void p7_norm2(Frame& F, const Args& args) {
    const int gw = F.vcu * NWAVES + F.wave, NGW = F.G * NWAVES; const float* MOD = WSP(float, WS_MOD); bf16* HA = WSP(bf16, WS_HA);
    for (int m = gw; m < S; m += NGW) {
        const GAS f32x4* xr = (const GAS f32x4*)(WSP(float, WS_X1) + (size_t)m * DM) + F.lane; f32x4 v[16]; float ss = 0.f;
#pragma unroll
        for (int j = 0; j < 16; ++j) { v[j] = xr[64 * j]; ss += (v[j][0] * v[j][0] + v[j][1] * v[j][1]) + (v[j][2] * v[j][2] + v[j][3] * v[j][3]); }
        const float rstd = 1.0f / sqrtf(wave_sum(ss) * (1.0f / DM) + EPS);
#pragma unroll
        for (int j = 0; j < 16; ++j) { const int i4 = F.lane + 64 * j;
            const f32x4 g = ((const GAS f32x4*)args.in[5])[i4], scl = ((const GAS f32x4*)(MOD + 16384))[i4], sh = ((const GAS f32x4*)(MOD + 12288))[i4];
            const f32x4 hv = v[j] * rstd * (g * (scl + 1.0f)) + sh;
            v2u o; o.x = pk2(hv[0], hv[1]); o.y = pk2(hv[2], hv[3]); ((GAS v2u*)(HA + (size_t)m * DM))[i4] = o; }
    }
}

template <int CTRL> __device__ __forceinline__ unsigned dppu(unsigned x) { return (unsigned)__builtin_amdgcn_update_dpp(0, (int)x, CTRL, 0xF, 0xF, true); }
__device__ __forceinline__ unsigned rowmax_u32(unsigned x) { x = max(x, dppu<0xB1>(x)); x = max(x, dppu<0x4E>(x)); x = max(x, dppu<0x141>(x)); x = max(x, dppu<0x140>(x)); return x; }
__device__ __forceinline__ float rowsum_f32(float x) { x += __uint_as_float(dppu<0xB1>(__float_as_uint(x))); x += __uint_as_float(dppu<0x4E>(__float_as_uint(x)));
    x += __uint_as_float(dppu<0x141>(__float_as_uint(x))); x += __uint_as_float(dppu<0x140>(__float_as_uint(x))); return x; }
__device__ __forceinline__ unsigned ordk(float f) { const unsigned u = __float_as_uint(f); return u ^ ((unsigned)((int)u >> 31) | 0x80000000u); }
__device__ __forceinline__ float deck(unsigned k) { return __uint_as_float((k & 0x80000000u) ? (k ^ 0x80000000u) : ~k); }
#define CE_(x, y) do { const unsigned hi_ = max(x, y), lo_ = min(x, y); x = hi_; y = lo_; } while (0)
__device__ __forceinline__ unsigned row_pop16(unsigned (&a)[8], int i) {
    unsigned res = 0u;
#pragma unroll
    for (int r = 0; r < 16; ++r) { const unsigned m = rowmax_u32(a[0]); const bool win = a[0] == m;
#pragma unroll
        for (int s = 0; s < 7; ++s) a[s] = win ? a[s + 1] : a[s];
        a[7] = win ? 0u : a[7]; res = (i == r) ? m : res; }
    return res;
}
__device__ __forceinline__ void p9_topk(Frame& F, const Args& args) {
    const bf16* Q2 = WSP(bf16, WS_Q2); const bf16* SK = WSP(bf16, WS_SK); int* IDX = WSP(int, WS_IDX); float* GATE = WSP(float, WS_GATE);
    const int gw = F.vcu * NWAVES + F.wave, NGW = F.G * NWAVES; const int i = F.lane & 15, q = F.lane >> 4;
    const unsigned qlo = (unsigned)(i * 2048 + 8 * q) * 2u, klo = (unsigned)(i * 128 + 8 * q) * 2u;
#pragma unroll 1
    for (int u = gw; u < (S / 16) * PEER_H; u += NGW) {
        const int t0 = 16 * (u >> 3), h = u & 7;
        unsigned R[2][4];
#pragma unroll
        for (int p = 0; p < 2; ++p) {
            bf16x8 af[4];
            const char* qb_ = (const char*)Q2 + ((size_t)t0 * 2048 + h * 256 + p * 128) * 2;
            const char* kb_ = (const char*)SK + (size_t)((h * 2 + p) * 128) * 256;
#pragma unroll
            for (int ks = 0; ks < 4; ++ks) af[ks] = *(const GAS bf16x8*)(qb_ + 64 * ks + qlo);
            f32x4 acc[8]; bf16x8 bc[4], bn[4];
#pragma unroll
            for (int ks = 0; ks < 4; ++ks) bc[ks] = *(const GAS bf16x8*)(kb_ + 64 * ks + klo);
#pragma unroll
            for (int nt = 0; nt < 8; ++nt) { acc[nt] = (f32x4){0.f, 0.f, 0.f, 0.f};
                if (nt < 7) {
#pragma unroll
                    for (int ks = 0; ks < 4; ++ks) bn[ks] = *(const GAS bf16x8*)(kb_ + 4096 * (nt + 1) + 64 * ks + klo); }
#pragma unroll
                for (int ks = 0; ks < 4; ++ks) acc[nt] = __builtin_amdgcn_mfma_f32_16x16x32_bf16(af[ks], bc[ks], acc[nt], 0, 0, 0);
#pragma unroll
                for (int ks = 0; ks < 4; ++ks) bc[ks] = bn[ks];
                __builtin_amdgcn_sched_barrier(0); }
#pragma unroll
            for (int r = 0; r < 4; ++r) { unsigned a[8];
#pragma unroll
                for (int nt = 0; nt < 8; ++nt) a[nt] = (ordk(acc[nt][r]) & ~0x7Fu) | (unsigned)(16 * nt + i);
                CE_(a[0], a[1]); CE_(a[2], a[3]); CE_(a[4], a[5]); CE_(a[6], a[7]); CE_(a[0], a[2]); CE_(a[1], a[3]); CE_(a[4], a[6]); CE_(a[5], a[7]); CE_(a[1], a[2]); CE_(a[5], a[6]);
                CE_(a[0], a[4]); CE_(a[1], a[5]); CE_(a[2], a[6]); CE_(a[3], a[7]); CE_(a[2], a[4]); CE_(a[3], a[5]); CE_(a[1], a[2]); CE_(a[3], a[4]); CE_(a[5], a[6]);
                R[p][r] = row_pop16(a, i); __builtin_amdgcn_sched_barrier(0); }
        }
#pragma unroll
        for (int r = 0; r < 4; ++r) {
            const unsigned R0 = R[0][r], R1 = R[1][r]; const float f0 = deck(R0 & ~0x7Fu), f1 = deck(R1 & ~0x7Fu); const int n0 = (int)(R0 & 0x7Fu), n1 = (int)(R1 & 0x7Fu);
            const unsigned f1u = __float_as_uint(f1); unsigned c[8];
#define CAND_(b, lim) do { const unsigned t_ = (ordk(f0 + __uint_as_float(dppu<0x150 + (b)>(f1u))) & ~0xFFu) | (unsigned)(255 - (i * 16 + (b))); c[b] = (i < (lim)) ? t_ : 0u; } while (0)
            CAND_(0, 16); CAND_(1, 8); CAND_(2, 5); CAND_(3, 4); CAND_(4, 3); CAND_(5, 2); CAND_(6, 2); CAND_(7, 2);
#undef CAND_
            { const float ex = __uint_as_float(dppu<0x150>(__float_as_uint(f0))) + f1; const unsigned exk = (ordk(ex) & ~0xFFu) | (unsigned)(255 - i); c[1] = (i >= 8) ? exk : c[1]; }
            CE_(c[0], c[1]);
            const unsigned G = row_pop16(c, i);
            const float val = deck(G & ~0xFFu); const int id = 255 - (int)(G & 0xFFu); const int rb = F.lane & 48;
            const int ea = __shfl(n0, rb + (id >> 4)), eb = __shfl(n1, rb + (id & 15));
            const float mx = __uint_as_float(dppu<0x150>(__float_as_uint(val))); const float ex = __expf(val - mx); const float sm = rowsum_f32(ex);
            const size_t o = (size_t)(t0 + 4 * q + r) * 128 + h * 16 + i; IDX[o] = ea * 128 + eb; GATE[o] = ex / sm; __builtin_amdgcn_sched_barrier(0);
        }
    }
}
#undef CE_

constexpr float U_SCALE = 256.0f, V_SCALE = 1.0f;
#ifndef PEER_SORT
#define PEER_SORT 0
#endif
__device__ __forceinline__ float gelu_as(float v) {
    const float av = fabsf(v), tt = __builtin_amdgcn_rcpf(av * 0.2316418882f + 1.0f);
    float q = tt * 0.5307027145f + (-0.7265760135f); q = q * tt + 0.7107068705f; q = q * tt + (-0.142248368f); q = q * tt + 0.127414796f; q = q * tt;
    const float m = v * (q * __builtin_amdgcn_exp2f((v * v) * (-0.72134752044f)));
    return v < 0.f ? m : v - m;
}
#ifndef PEER_UMFMA
#define PEER_UMFMA 1
#endif
#ifndef HYP_A
#define HYP_A 1
#endif
#ifndef HYP_B
#define HYP_B 0
#endif
typedef int v8i __attribute__((ext_vector_type(8)));
typedef float f32x16 __attribute__((ext_vector_type(16)));
__device__ __forceinline__ float wave_sum_dpp(float x) {
    x = rowsum_f32(x);
    return (__uint_as_float(__builtin_amdgcn_readlane(__float_as_uint(x), 0)) + __uint_as_float(__builtin_amdgcn_readlane(__float_as_uint(x), 16)))
         + (__uint_as_float(__builtin_amdgcn_readlane(__float_as_uint(x), 32)) + __uint_as_float(__builtin_amdgcn_readlane(__float_as_uint(x), 48)));
}
#define LOADROWS(T, ra_, rb_, ee) do { const int e2_ = (ee) & 127; const int ea_ = __builtin_amdgcn_readlane(e2_ < 64 ? id0 : id1, e2_ & 63), eb_ = __builtin_amdgcn_readlane(e2_ < 64 ? id0 : id1, (e2_ + 1) & 63); \
        const GAS v4u* pa_ = (const GAS v4u*)((T) + (size_t)ea_ * DM) + F.lane; const GAS v4u* pb_ = (const GAS v4u*)((T) + (size_t)eb_ * DM) + F.lane; \
        _Pragma("unroll") for (int c = 0; c < 4; ++c) { ra_[c] = pa_[64 * c]; rb_[c] = pb_[64 * c]; } } while (0)
#define UDOT(r_, out_) do { f32x2 s0_ = {0.f, 0.f}, s1_ = {0.f, 0.f}, s2_ = {0.f, 0.f}, s3_ = {0.f, 0.f}; \
        _Pragma("unroll") for (int c = 0; c < 4; ++c) _Pragma("unroll") for (int d = 0; d < 2; ++d) { \
            const f32x2 p0_ = __builtin_amdgcn_cvt_scalef32_pk_f32_fp4(r_[c][d], 1.0f, 0), p1_ = __builtin_amdgcn_cvt_scalef32_pk_f32_fp4(r_[c][d], 1.0f, 1), \
                        p2_ = __builtin_amdgcn_cvt_scalef32_pk_f32_fp4(r_[c][d], 1.0f, 2), p3_ = __builtin_amdgcn_cvt_scalef32_pk_f32_fp4(r_[c][d], 1.0f, 3); \
            s0_ = p0_ * hx[8 * c + 4 * d] + s0_; s1_ = p1_ * hx[8 * c + 4 * d + 1] + s1_; s2_ = p2_ * hx[8 * c + 4 * d + 2] + s2_; s3_ = p3_ * hx[8 * c + 4 * d + 3] + s3_; } \
        out_ = ((s0_.x + s0_.y) + (s1_.x + s1_.y)) + ((s2_.x + s2_.y) + (s3_.x + s3_.y)); } while (0)
#define UPAIR(ra_, rb_, ee) do { float sa_, sb_; UDOT(ra_, sa_); UDOT(rb_, sb_); sa_ = wave_sum_dpp(sa_); sb_ = wave_sum_dpp(sb_); \
        const int e2_ = (ee); const int ea_ = __builtin_amdgcn_readlane(e2_ < 64 ? id0 : id1, e2_ & 63), eb_ = __builtin_amdgcn_readlane(e2_ < 64 ? id0 : id1, (e2_ + 1) & 63); \
        const f32x2 a2_ = pg8::gelu_pk((f32x2){sa_ * RSU[ea_], sb_ * RSU[eb_]}); \
        if ((ee) < 64) { if (F.lane == (ee)) w0 = a2_.x * g0; if (F.lane == (ee) + 1) w0 = a2_.y * g0; } else { if (F.lane == (ee) - 64) w1 = a2_.x * g1; if (F.lane == (ee) - 63) w1 = a2_.y * g1; } } while (0)
#define LOADROWS4(T, ra_, rb_, ee) do { const int e2_ = (ee) & 127; const int ea_ = __builtin_amdgcn_readlane(e2_ < 64 ? id0 : id1, e2_ & 63), eb_ = __builtin_amdgcn_readlane(e2_ < 64 ? id0 : id1, (e2_ + 1) & 63); \
        const GAS v2u* pa_ = (const GAS v2u*)((T) + (size_t)ea_ * 2048) + F.lane; const GAS v2u* pb_ = (const GAS v2u*)((T) + (size_t)eb_ * 2048) + F.lane; \
        _Pragma("unroll") for (int c = 0; c < 4; ++c) { ra_[c] = pa_[64 * c]; rb_[c] = pb_[64 * c]; } } while (0)
#define VAXPY(r_, w_) do { const f32x2 w2_ = {w_, w_}; \
        _Pragma("unroll") for (int c = 0; c < 4; ++c) _Pragma("unroll") for (int d = 0; d < 2; ++d) { \
            const f32x2 p0_ = __builtin_amdgcn_cvt_scalef32_pk_f32_fp4(r_[c][d], 1.0f, 0), p1_ = __builtin_amdgcn_cvt_scalef32_pk_f32_fp4(r_[c][d], 1.0f, 1), \
                        p2_ = __builtin_amdgcn_cvt_scalef32_pk_f32_fp4(r_[c][d], 1.0f, 2), p3_ = __builtin_amdgcn_cvt_scalef32_pk_f32_fp4(r_[c][d], 1.0f, 3); \
            acc[8 * c + 4 * d] = p0_ * w2_ + acc[8 * c + 4 * d]; acc[8 * c + 4 * d + 1] = p1_ * w2_ + acc[8 * c + 4 * d + 1]; \
            acc[8 * c + 4 * d + 2] = p2_ * w2_ + acc[8 * c + 4 * d + 2]; acc[8 * c + 4 * d + 3] = p3_ * w2_ + acc[8 * c + 4 * d + 3]; } } while (0)
#define VPAIR(ra_, rb_, ee) do { const int e2_ = (ee); const int ea_ = __builtin_amdgcn_readlane(e2_ < 64 ? id0 : id1, e2_ & 63), eb_ = __builtin_amdgcn_readlane(e2_ < 64 ? id0 : id1, (e2_ + 1) & 63); \
        const float wa_ = __uint_as_float(__builtin_amdgcn_readlane(__float_as_uint((ee) < 64 ? w0 : w1), (ee) & 63)) * RS[ea_], wb_ = __uint_as_float(__builtin_amdgcn_readlane(__float_as_uint((ee) < 64 ? w0 : w1), ((ee) + 1) & 63)) * RS[eb_]; \
        VAXPY(ra_, wa_); VAXPY(rb_, wb_); } while (0)
template <int MODE> __device__ __forceinline__ void p10_peer(Frame& F, const Args& args) {
    const int gw = F.vcu * NWAVES + F.wave, NGW = F.G * NWAVES; const float* MOD = WSP(float, WS_MOD);
    const bf16* H2 = WSP(bf16, WS_HA); const unsigned char* U = WSP(unsigned char, WS_U); const unsigned char* V = WSP(unsigned char, WS_V); const int* IDX = WSP(int, WS_IDX); const float* GATE = WSP(float, WS_GATE); const float* RS = WSP(float, WS_RS); const float* RSU = WSP(float, WS_RSU);
#if PEER_UMFMA
    if (F.lane < 8) *(LAS v4u*)(F.lds + F.wave * 13440 + 4096 + F.lane * 16) = (v4u){0u, 0u, 0u, 0u};
#endif
#pragma unroll 1
    for (int t = gw; t < S; t += NGW) {
        const int id0 = IDX[(size_t)t * 128 + F.lane], id1 = IDX[(size_t)t * 128 + 64 + F.lane];
        const float g0 = GATE[(size_t)t * 128 + F.lane], g1 = GATE[(size_t)t * 128 + 64 + F.lane];
        float w0 = 0.f, w1 = 0.f;
#if PEER_UMFMA
        {
            LAS unsigned char* h8 = F.lds + F.wave * 13440; LAS unsigned char* stg = h8 + 4224;
#pragma unroll
            for (int c = 0; c < 4; ++c) { const GAS v4u* hp = (const GAS v4u*)(H2 + (size_t)t * DM + c * 1024 + F.lane * 16); const v4u a = hp[0], b = hp[1]; v4u o;
                { int w = 0; w = __builtin_amdgcn_cvt_pk_fp8_f32(bflo(a[0]), bfhi(a[0]), w, false); w = __builtin_amdgcn_cvt_pk_fp8_f32(bflo(a[1]), bfhi(a[1]), w, true); o[0] = (unsigned)w; }
                { int w = 0; w = __builtin_amdgcn_cvt_pk_fp8_f32(bflo(a[2]), bfhi(a[2]), w, false); w = __builtin_amdgcn_cvt_pk_fp8_f32(bflo(a[3]), bfhi(a[3]), w, true); o[1] = (unsigned)w; }
                { int w = 0; w = __builtin_amdgcn_cvt_pk_fp8_f32(bflo(b[0]), bfhi(b[0]), w, false); w = __builtin_amdgcn_cvt_pk_fp8_f32(bflo(b[1]), bfhi(b[1]), w, true); o[2] = (unsigned)w; }
                { int w = 0; w = __builtin_amdgcn_cvt_pk_fp8_f32(bflo(b[2]), bfhi(b[2]), w, false); w = __builtin_amdgcn_cvt_pk_fp8_f32(bflo(b[3]), bfhi(b[3]), w, true); o[3] = (unsigned)w; }
                *(LAS v4u*)(h8 + c * 1024 + F.lane * 16) = o; }
            const int j = F.lane & 31, kh = F.lane >> 5, lr = F.lane >> 3, lp = F.lane & 7;
            unsigned so[4][4];
#pragma unroll
            for (int b = 0; b < 4; ++b)
#pragma unroll
                for (int i = 0; i < 4; ++i) so[b][i] = (unsigned)__shfl(b < 2 ? id0 : id1, 32 * (b & 1) + lr + 8 * i) * 2048u + (unsigned)lp * 16u;
            int eb[4];
#pragma unroll
            for (int b = 0; b < 4; ++b) eb[b] = __shfl(b < 2 ? id0 : id1, j + 32 * (b & 1));
            const unsigned aoff0 = (j == 0) ? (unsigned)(16 * kh) : 4096u, aoff1 = (j == 0) ? (unsigned)(32 + 16 * kh) : 4112u, astep = (j == 0) ? 64u : 0u;
            const unsigned wof = (unsigned)lr * 144u + (unsigned)lp * 16u, rof = (unsigned)j * 144u + (unsigned)kh * 16u;
            f32x16 ac[4];
#pragma unroll
            for (int b = 0; b < 4; ++b) ac[b] = (f32x16){};
            v4u R0[8], R1[8];
#define ULOAD(R_, kg_, bp_) do { _Pragma("unroll") for (int bb = 0; bb < 2; ++bb) _Pragma("unroll") for (int i = 0; i < 4; ++i) \
                R_[4 * bb + i] = *(const GAS v4u*)(U + (size_t)so[2 * (bp_) + bb][i] + (size_t)(kg_) * 128); } while (0)
#define USTAGE(R_, bp_) do { _Pragma("unroll") for (int bb = 0; bb < 2; ++bb) _Pragma("unroll") for (int i = 0; i < 4; ++i) *(LAS v4u*)(stg + bb * 4608 + i * 1152 + wof) = R_[4 * bb + i]; \
            _Pragma("unroll") for (int bb = 0; bb < 2; ++bb) { v4u B_[4]; _Pragma("unroll") for (int kk = 0; kk < 4; ++kk) B_[kk] = *(const LAS v4u*)(stg + bb * 4608 + rof + kk * 32); \
                _Pragma("unroll") for (int kk = 0; kk < 4; ++kk) ac[2 * (bp_) + bb] = __builtin_amdgcn_mfma_scale_f32_32x32x64_f8f6f4(A[kk], (v8i){(int)B_[kk][0], (int)B_[kk][1], (int)B_[kk][2], (int)B_[kk][3], 0, 0, 0, 0}, ac[2 * (bp_) + bb], 0, 4, 0, 0x7f7f7f7f, 0, 0x7f7f7f7f); } } while (0)
            ULOAD(R0, 0, 0);
#pragma unroll 1
            for (int kg = 0; kg < 16; ++kg) {
                v8i A[4];
#pragma unroll
                for (int kk = 0; kk < 4; ++kk) { const unsigned kb = (unsigned)(4 * kg + kk); const v4u x = *(const LAS v4u*)(h8 + aoff0 + kb * astep), y = *(const LAS v4u*)(h8 + aoff1 + kb * astep);
                    A[kk] = (v8i){(int)x[0], (int)x[1], (int)x[2], (int)x[3], (int)y[0], (int)y[1], (int)y[2], (int)y[3]}; }
                ULOAD(R1, kg, 1);
                USTAGE(R0, 0);
                ULOAD(R0, (kg + 1) & 15, 0);
                USTAGE(R1, 1);
            }
#undef ULOAD
#undef USTAGE
#pragma unroll
            for (int b = 0; b < 4; ++b) {
                const float av = pg8::gelu_pk((f32x2){ac[b][0] * RSU[eb[b]], 0.f}).x;
                const float gg = __shfl(b < 2 ? g0 : g1, j + 32 * (b & 1)); const float wv = av * gg;
                if ((b & 1) == 0) { if (b == 0) w0 = F.lane < 32 ? wv : w0; else w1 = F.lane < 32 ? wv : w1; }
                else { const float mv = __shfl(wv, j); if (b == 1) w0 = F.lane >= 32 ? mv : w0; else w1 = F.lane >= 32 ? mv : w1; } }
        }
#else
        {   f32x2 hx[32];
#pragma unroll
            for (int c = 0; c < 4; ++c) { const GAS v4u* hp = (const GAS v4u*)(H2 + (size_t)t * DM + c * 1024 + F.lane * 16); const v4u a = hp[0], b = hp[1];
#pragma unroll
                for (int k = 0; k < 4; ++k) { hx[8 * c + k] = (f32x2){bflo(a[k]), bfhi(a[k])}; hx[8 * c + 4 + k] = (f32x2){bflo(b[k]), bfhi(b[k])}; } }
            v2u ra[4], rb[4], rc[4], rd[4], na[4], nb[4], nc[4], nd[4];
            if (MODE != 2) {
            LOADROWS4(U, ra, rb, 0); LOADROWS4(U, rc, rd, 2);
#pragma unroll 1
            for (int e = 0; e < 128; e += 8) {
                LOADROWS4(U, na, nb, e + 4); LOADROWS4(U, nc, nd, e + 6);
                UPAIR(ra, rb, e); UPAIR(rc, rd, e + 2);
                LOADROWS4(U, ra, rb, e + 8); LOADROWS4(U, rc, rd, e + 10);
                UPAIR(na, nb, e + 4); UPAIR(nc, nd, e + 6);
            } } }
#endif
        if (MODE == 1 || MODE == 3) { asm volatile("" :: "v"(w0), "v"(w1)); continue; }
        f32x2 acc[32];
#pragma unroll
        for (int j = 0; j < 32; ++j) acc[j] = (f32x2){0.f, 0.f};
        {   v2u ra[4], rb[4], rc[4], rd[4], na[4], nb[4], nc[4], nd[4];
            LOADROWS4(V, ra, rb, 0); LOADROWS4(V, rc, rd, 2);
#pragma unroll 1
            for (int e = 0; e < 128; e += 8) {
                LOADROWS4(V, na, nb, e + 4); LOADROWS4(V, nc, nd, e + 6);
                VPAIR(ra, rb, e); VPAIR(rc, rd, e + 2);
                LOADROWS4(V, ra, rb, e + 8); LOADROWS4(V, rc, rd, e + 10);
                VPAIR(na, nb, e + 4); VPAIR(nc, nd, e + 6);
            } }
        if (MODE == 2) {
#pragma unroll
            for (int j = 0; j < 32; ++j) asm volatile("" :: "v"(acc[j]));
            continue; }
#pragma unroll
        for (int c = 0; c < 4; ++c) { const int col = c * 1024 + F.lane * 16; GAS f32x4* op = (GAS f32x4*)(F.out + (size_t)t * DM + col);
            const GAS f32x4* xp = (const GAS f32x4*)(WSP(float, WS_X1) + (size_t)t * DM + col); const GAS f32x4* gp = (const GAS f32x4*)(MOD + 20480 + col);
#pragma unroll
            for (int q = 0; q < 4; ++q) op[q] = xp[q] + gp[q] * (f32x4){acc[8 * c + 2 * q].x, acc[8 * c + 2 * q].y, acc[8 * c + 2 * q + 1].x, acc[8 * c + 2 * q + 1].y}; }
    }
}
#undef LOADROWS
#undef UDOT
#undef UPAIR
#undef VAXPY
#undef VPAIR
#undef LOADROWS4
#ifndef MK_SINGLE
#define MK_SINGLE 1
#endif
constexpr int N_PHASES = 11;
__global__ void __launch_bounds__(NTHREADS, 2) fwd_kernel(Args args) {
    extern __shared__ __attribute__((aligned(16))) unsigned char lds[];
    Frame F;
    F.lds = (LAS unsigned char*)lds; F.MISC = (volatile LAS unsigned*)(F.lds + MISC_OFF);
    F.tid = threadIdx.x; F.lane = F.tid & 63; F.wave = __builtin_amdgcn_readfirstlane(F.tid >> 6);
    F.G = gridDim.x; { const int bx = blockIdx.x; F.vcu = (F.G % 8 == 0) ? (bx % 8) * (F.G / 8) + bx / 8 : bx; }
    F.ws = args.ws; F.out = args.out; F.ctl = (gu32*)(args.ws + WS_CTL);
    for (int u = F.tid; u < (LDS_BYTES - LDSCTL_OFF) / 4; u += NTHREADS) ((LAS unsigned*)(F.lds + LDSCTL_OFF))[u] = 0u;
    __syncthreads();
    const int lo = args.ph_lo, hi = args.ph_hi;
    XcdBarrier bar; bar.bar = (unsigned*)(F.ctl + CW_BAR); bar.x = 0; bar.st = nullptr;
    if (hi - lo > 1) bar = xcd_barrier_post((unsigned*)(F.ctl + CW_BAR), F.MISC + 8);
#ifndef PH_MASK
#define PH_MASK 0x7ff
#endif
#define IN(k) (((PH_MASK >> (k)) & 1) && lo <= (k) && (k) < hi)
#define SEAM(k) do { if (IN(k) && IN((k) + 1)) xcd_barrier(bar); } while (0)
#ifndef REP_PHASE
#define REP_PHASE -1
#endif
#define REPEAT(k) _Pragma("unroll") for (int rep = 0; rep < ((REP_PHASE) == (k) ? 2 : 1); ++rep)
#define REPBAR(k) do { if ((REP_PHASE) == (k) && rep == 0) xcd_barrier(bar); } while (0)
    const int bid = (int)blockIdx.x;
    if (IN(0)) { REPEAT(0) { p0_prologue(F, args); REPBAR(0); } SEAM(0); }
    if (IN(1)) { REPEAT(1) { p1_norm_forget(F, args); REPBAR(1); } SEAM(1); }
    if (IN(2)) { REPEAT(2) {
        pg8::Gemm g{WSP(bf16, WS_HA), WSP(bf16, WS_WIN), S, NINP, DM}; pg8::StaticOrder So; So.init(S, NINP, F.G, bid);
        pg8::EpiIn E{WSP(bf16, WS_QKV), WSP(bf16, WS_LX), WSP(bf16, WS_GY), WSP(bf16, WS_GA), WSP(bf16, WS_GL), WSP(float, WS_BIASR)};
        pg8::gemm_phase<pg8::EpiIn, pg8::StaticOrder, true, true>(F.lds, g, So, E);
        REPBAR(2); }
        SEAM(2);
    }
    if (IN(3)) {
        p3_qknorm(F, args);
        __syncthreads();
        REPEAT(3) {
        p3_cumsum(F, args);
        for (int w = bid; w < 256; w += F.G) lru_item<0>(F, args, w);
        REPBAR(3); }
        SEAM(3);
    }
    if (IN(4)) {
#pragma unroll 1
        for (int rep = 0; rep < args.rep_att; ++rep) p4_attention(F, args, (char*)lds, rep);
#pragma unroll 1
        for (int rep = 0; rep < args.rep_lru; ++rep)
        for (int w = bid; w < 256; w += F.G) lru_item<1>(F, args, w);
        SEAM(4);
    }
    if (IN(5)) { REPEAT(5) {
        { pg8::Gemm g{WSP(bf16, WS_ATT), WSP(bf16, WS_WAO), S, DM, AW}; pg8::StaticOrder So; So.init(S, DM, F.G, bid);
          pg8::EpiGate<0> E{WSP(bf16, WS_T1), WSP(bf16, WS_GA), DM};
          pg8::gemm_phase<pg8::EpiGate<0>, pg8::StaticOrder, true, true>(F.lds, g, So, E); }
        { pg8::Gemm g{WSP(bf16, WS_LR), WSP(bf16, WS_WLO), S, DM, LW}; pg8::StaticOrder So; So.init(S, DM, F.G, bid);
          pg8::EpiGate<1> E{WSP(bf16, WS_T1), WSP(bf16, WS_GL), DM};
          pg8::gemm_phase<pg8::EpiGate<1>, pg8::StaticOrder, true, true>(F.lds, g, So, E); }
        REPBAR(5); }
        SEAM(5);
    }
    if (IN(6)) { REPEAT(6) {
        pg8::Gemm g{WSP(bf16, WS_T1), WSP(bf16, WS_WOUT), S, DM, DM}; pg8::StaticOrder So; So.init(S, DM, F.G, bid);
        pg8::EpiRes E{args.in[0], WSP(float, WS_X1), WSP(float, WS_MOD) + 8192, DM};
        pg8::gemm_phase<pg8::EpiRes, pg8::StaticOrder, true, true>(F.lds, g, So, E);
        REPBAR(6); }
        SEAM(6);
    }
    if (IN(7)) { REPEAT(7) { p7_norm2(F, args); REPBAR(7); } SEAM(7); }
    if (IN(8)) { REPEAT(8) {
        pg8::Gemm g{WSP(bf16, WS_HA), WSP(bf16, WS_WPQ), S, 2048, DM}; pg8::StaticOrder So; So.init(S, 2048, F.G, bid);
        pg8::EpiBf16<0> E{WSP(bf16, WS_Q2), 2048, nullptr, 0, 0, 1.f};
        pg8::gemm_phase<pg8::EpiBf16<0>, pg8::StaticOrder, true, true>(F.lds, g, So, E);
        REPBAR(8); }
        SEAM(8);
    }
    if (IN(9)) { REPEAT(9) { p9_topk(F, args); REPBAR(9); } SEAM(9); }
#ifndef P10_PROBE
#define P10_PROBE 0
#endif
    if (IN(10)) { if (P10_PROBE) { p10_peer<P10_PROBE>(F, args); xcd_barrier(bar); } REPEAT(10) { p10_peer<0>(F, args); REPBAR(10); } }
#undef IN
#undef SEAM
}

extern "C" void kernel_launch(void* const* d_in, const int* in_sizes, int n_in, void* d_out, int out_size, void* d_ws, size_t ws_size, hipStream_t stream) {
    static int grid = 0;
    if (grid == 0) {
        if (n_in != 24 || in_sizes[0] != S * DM || out_size != S * DM || ws_size < WS_END) { fprintf(stderr, "kernel_launch: unexpected shapes (n_in %d, in0 %d, out %d, ws %zu)\n", n_in, n_in > 0 ? in_sizes[0] : -1, out_size, ws_size); grid = -1; return; }
        int dev = 0, cus = 0, per_cu = 0;
        if (hipGetDevice(&dev) != hipSuccess || hipDeviceGetAttribute(&cus, hipDeviceAttributeMultiprocessorCount, dev) != hipSuccess) { grid = -1; return; }
        if (hipFuncSetAttribute((const void*)fwd_kernel, hipFuncAttributeMaxDynamicSharedMemorySize, LDS_BYTES) != hipSuccess) { fprintf(stderr, "kernel_launch: hipFuncSetAttribute failed\n"); grid = -1; return; }
        if (hipOccupancyMaxActiveBlocksPerMultiprocessor(&per_cu, (const void*)fwd_kernel, NTHREADS, LDS_BYTES) != hipSuccess || per_cu < 1) fprintf(stderr, "kernel_launch: occupancy query reports %d blocks per CU\n", per_cu);
        (void)hipGetLastError();
        grid = cus;
    }
    if (grid < 0) return;
    if (hipMemsetAsync((char*)d_ws + WS_CTL, 0, CTL_ZERO_BYTES, stream) != hipSuccess) return;
    Args a{};
    for (int i = 0; i < 24; ++i) a.in[i] = (const float*)d_in[i];
    a.out = (float*)d_out; a.ws = (unsigned char*)d_ws;
#ifndef REP_ATT
#define REP_ATT 1
#endif
#ifndef REP_LRU
#define REP_LRU 1
#endif
    a.rep_att = REP_ATT; a.rep_lru = REP_LRU;
#if MK_SINGLE
    a.ph_lo = 0; a.ph_hi = N_PHASES;
    hipLaunchKernelGGL(fwd_kernel, dim3(grid), dim3(NTHREADS), LDS_BYTES, stream, a);
#else
    for (int p = 0; p < N_PHASES; ++p) { a.ph_lo = p; a.ph_hi = p + 1; hipLaunchKernelGGL(fwd_kernel, dim3(grid), dim3(NTHREADS), LDS_BYTES, stream, a); }
#endif
}
```

```cpp
#define REP_PHASE -1
#include <hip/hip_runtime.h>
#include <cstdio>
#include <cstdint>
namespace pg8 {
#define PG8_LAS __attribute__((address_space(3)))
typedef unsigned short bf16_t;
typedef short bf16x8 __attribute__((ext_vector_type(8)));
typedef float f32x4 __attribute__((ext_vector_type(4)));
typedef unsigned u32x4 __attribute__((ext_vector_type(4)));
constexpr int BM = 256, BK = 64, HALF = 128, HTB = HALF * BK * 2  , STAGE_BYTES = 8 * HTB, NXCD = 8, WGM = 8;

__host__ __device__ __forceinline__ int lds_byte(int r, int c) { const int st = (r >> 4) * 2 + (c >> 5), rr = r & 15, cc = c & 31, ob = rr * 64 + cc * 2; return st * 1024 + (ob ^ (((ob >> 9) & 1) << 5)); }
__host__ __device__ __forceinline__ void stage_rc(int b, int& R, int& C) { const int st = b / 1024, sb = b % 1024, swz = sb ^ (((sb >> 9) & 1) << 5); R = (st >> 1) * 16 + swz / 64; C = (st & 1) * 32 + (swz % 64) / 2; }
__host__ __device__ __forceinline__ int perm32(int rho) { const int n = rho >> 4, i = rho & 15; return 8 * (i >> 2) + 4 * n + (i & 3); }

struct Unit { int pm, pn; };
struct Gemm { const bf16_t* A; const bf16_t* Bt; int M, N, K; };

struct StaticOrder {
    int nM, nN, nwg, G, c;
    __host__ __device__ void init(int M, int N, int G_, int c_) { nM = M / BM; nN = N / BM; nwg = nM * nN; G = G_; c = c_; }
    __host__ __device__ bool next(int i, Unit& u) const {
        const long L = (long)i * G + c; if (L >= nwg) return false;
        int wgid = (int)L; { const int q = nwg / NXCD, r = nwg % NXCD, xcd = wgid % NXCD, off = wgid / NXCD; wgid = (xcd < r ? xcd * (q + 1) : r * (q + 1) + (xcd - r) * q) + off; }
        const int nig = WGM * nN, gid = wgid / nig, fm = gid * WGM, gsz = (nM - fm) < WGM ? (nM - fm) : WGM;
        u.pm = fm + ((wgid % nig) % gsz); u.pn = (wgid % nig) / gsz; return true;
    }
    __device__ __forceinline__ void a_ready(const Unit&) const {}
    __device__ __forceinline__ void done(const Unit&) const {}
};

__device__ __forceinline__ unsigned cvt_pk_bf16(float lo, float hi) { unsigned r; asm volatile("v_cvt_pk_bf16_f32 %0, %1, %2" : "=v"(r) : "v"(lo), "v"(hi)); return r; }
typedef float f32x2 __attribute__((ext_vector_type(2)));
__device__ __forceinline__ f32x2 gelu_pk(f32x2 v) {
    const f32x2 av = __builtin_elementwise_abs(v), d = av * 0.2316418882f + 1.0f;
    f32x2 t; t.x = __builtin_amdgcn_rcpf(d.x); t.y = __builtin_amdgcn_rcpf(d.y);
    f32x2 q = t * 0.5307027145f + (-0.7265760135f); q = q * t + 0.7107068705f; q = q * t + (-0.142248368f); q = q * t + 0.127414796f; q = q * t;
    const f32x2 s = (v * v) * (-0.72134752044f);
    f32x2 e; e.x = __builtin_amdgcn_exp2f(s.x); e.y = __builtin_amdgcn_exp2f(s.y);
    const f32x2 m = v * (q * e), r = v - m;
    f32x2 o; o.x = v.x < 0.f ? m.x : r.x; o.y = v.y < 0.f ? m.y : r.y; return o;
}

template <int ACT  > struct EpiBf16 {
    static constexpr bool PERM = true, AFTER_DRAIN = false; static_assert(ACT == 0 || ACT == 1, "EpiBf16: ACT is 0 (none) or 1 (gelu_pk)");
    bf16_t* O; int ldc; const float* bias; int split_cols; size_t split_stride; float scale0;
    __device__ __forceinline__ void operator()(const f32x4 (&acc)[2][2][4][2], const Unit& u, int wr, int wc, int fr, int fq) const {
        const int row0 = u.pm * BM + wr * 64 + fr; int colt = u.pn * BM; bf16_t* base = O;
        float sc = 1.f; if (split_cols) { const int t = colt / split_cols; base += (size_t)t * split_stride; colt -= t * split_cols; if (t == 0) sc = scale0; }
        const int col0 = colt + wc * 32 + 8 * fq, bcol0 = u.pn * BM + wc * 32 + 8 * fq;
        f32x4 bv[2][2];
#pragma unroll
        for (int bj = 0; bj < 2; ++bj)
#pragma unroll
            for (int n = 0; n < 2; ++n) bv[bj][n] = bias ? *(const f32x4*)(bias + bcol0 + bj * HALF + 4 * n) : (f32x4){0.f, 0.f, 0.f, 0.f};
#pragma unroll
        for (int ai = 0; ai < 2; ++ai)
#pragma unroll
            for (int m = 0; m < 4; ++m) { bf16_t* rowp = base + (size_t)(row0 + ai * HALF + m * 16) * ldc + col0;
#pragma unroll
                for (int bj = 0; bj < 2; ++bj) { f32x4 v0 = acc[ai][bj][m][0] + bv[bj][0], v1 = acc[ai][bj][m][1] + bv[bj][1];
                    if (ACT == 1) { f32x2 a = gelu_pk((f32x2){v0[0], v0[1]}), b = gelu_pk((f32x2){v0[2], v0[3]}), c = gelu_pk((f32x2){v1[0], v1[1]}), d = gelu_pk((f32x2){v1[2], v1[3]});
                        v0 = (f32x4){a.x, a.y, b.x, b.y}; v1 = (f32x4){c.x, c.y, d.x, d.y}; }
                    v0 = v0 * sc; v1 = v1 * sc; u32x4 w; w.x = cvt_pk_bf16(v0[0], v0[1]); w.y = cvt_pk_bf16(v0[2], v0[3]); w.z = cvt_pk_bf16(v1[0], v1[1]); w.w = cvt_pk_bf16(v1[2], v1[3]);
                    *(u32x4*)(rowp + bj * HALF) = w; } }
    }
};
__device__ __forceinline__ f32x4 sigm4(f32x4 v) { f32x4 o;
#pragma unroll
    for (int j = 0; j < 4; ++j) o[j] = __builtin_amdgcn_rcpf(1.0f + __builtin_amdgcn_exp2f(-1.4426950408889634f * v[j]));
    return o; }
__device__ __forceinline__ f32x4 gelu4(f32x4 v) { const f32x2 a = gelu_pk((f32x2){v[0], v[1]}), b = gelu_pk((f32x2){v[2], v[3]}); return (f32x4){a.x, a.y, b.x, b.y}; }
__device__ __forceinline__ void unpack8(const u32x4 w, f32x4& lo, f32x4& hi) {
    lo = (f32x4){__uint_as_float(w.x << 16), __uint_as_float(w.x & 0xffff0000u), __uint_as_float(w.y << 16), __uint_as_float(w.y & 0xffff0000u)};
    hi = (f32x4){__uint_as_float(w.z << 16), __uint_as_float(w.z & 0xffff0000u), __uint_as_float(w.w << 16), __uint_as_float(w.w & 0xffff0000u)}; }
struct EpiIn {
    static constexpr bool PERM = true, AFTER_DRAIN = false;
    bf16_t* qkv; bf16_t* lx; bf16_t* gy; bf16_t* ga; bf16_t* gl; const float* bias;
    __device__ __forceinline__ void operator()(const f32x4 (&acc)[2][2][4][2], const Unit& u, int wr, int wc, int fr, int fq) const {
        const int pn = u.pn; bf16_t* base; int ldc, colt, act;
        if (pn < 24) { base = qkv + (size_t)(pn >> 3) * ((size_t)8192 * 2048); ldc = 2048; colt = (pn & 7) * 256; act = 0; }
        else if (pn < 32) { base = lx; ldc = 2048; colt = (pn - 24) * 256; act = 0; }
        else if (pn < 40) { base = gy; ldc = 2048; colt = (pn - 32) * 256; act = 1; }
        else if (pn < 56) { base = ga; ldc = 4096; colt = (pn - 40) * 256; act = 2; }
        else { base = gl; ldc = 4096; colt = (pn - 56) * 256; act = 2; }
        const int row0 = u.pm * BM + wr * 64 + fr, col0 = colt + wc * 32 + 8 * fq, bcol0 = pn * BM + wc * 32 + 8 * fq;
        f32x4 bv[2][2];
#pragma unroll
        for (int bj = 0; bj < 2; ++bj)
#pragma unroll
            for (int n = 0; n < 2; ++n) bv[bj][n] = *(const f32x4*)(bias + bcol0 + bj * HALF + 4 * n);
#pragma unroll
        for (int ai = 0; ai < 2; ++ai)
#pragma unroll
            for (int m = 0; m < 4; ++m) { bf16_t* rowp = base + (size_t)(row0 + ai * HALF + m * 16) * ldc + col0;
#pragma unroll
                for (int bj = 0; bj < 2; ++bj) { f32x4 v0 = acc[ai][bj][m][0] + bv[bj][0], v1 = acc[ai][bj][m][1] + bv[bj][1];
                    if (act == 1) { v0 = gelu4(v0); v1 = gelu4(v1); }
                    else if (act == 2) { v0 = sigm4(v0); v1 = sigm4(v1); }
                    u32x4 w; w.x = cvt_pk_bf16(v0[0], v0[1]); w.y = cvt_pk_bf16(v0[2], v0[3]); w.z = cvt_pk_bf16(v1[0], v1[1]); w.w = cvt_pk_bf16(v1[2], v1[3]);
                    *(u32x4*)(rowp + bj * HALF) = w; } }
    }
};
template <int MODE> struct EpiGate {
    static constexpr bool PERM = true, AFTER_DRAIN = false;
    bf16_t* O; const bf16_t* Gt; int ldc;
    __device__ __forceinline__ void operator()(const f32x4 (&acc)[2][2][4][2], const Unit& u, int wr, int wc, int fr, int fq) const {
        const int row0 = u.pm * BM + wr * 64 + fr, col0 = u.pn * BM + wc * 32 + 8 * fq;
#pragma unroll
        for (int ai = 0; ai < 2; ++ai)
#pragma unroll
            for (int m = 0; m < 4; ++m) { const size_t off = (size_t)(row0 + ai * HALF + m * 16) * ldc + col0;
#pragma unroll
                for (int bj = 0; bj < 2; ++bj) { f32x4 g0, g1; unpack8(*(const u32x4*)(Gt + off + bj * HALF), g0, g1);
                    f32x4 v0 = acc[ai][bj][m][0] * g0, v1 = acc[ai][bj][m][1] * g1;
                    if (MODE == 1) { f32x4 t0, t1; unpack8(*(const u32x4*)(O + off + bj * HALF), t0, t1); v0 += t0; v1 += t1; }
                    u32x4 w; w.x = cvt_pk_bf16(v0[0], v0[1]); w.y = cvt_pk_bf16(v0[2], v0[3]); w.z = cvt_pk_bf16(v1[0], v1[1]); w.w = cvt_pk_bf16(v1[2], v1[3]);
                    *(u32x4*)(O + off + bj * HALF) = w; } }
    }
};
struct EpiRes {
    static constexpr bool PERM = false, AFTER_DRAIN = false;
    const float* X; float* Out; const float* gate; int ldc;
    __device__ __forceinline__ void operator()(const f32x4 (&acc)[2][2][4][2], const Unit& u, int wr, int wc, int fr, int fq) const {
        const int row0 = u.pm * BM + wr * 64 + fr, col0 = u.pn * BM + wc * 32 + 4 * fq;
        f32x4 gv[2][2];
#pragma unroll
        for (int bj = 0; bj < 2; ++bj)
#pragma unroll
            for (int n = 0; n < 2; ++n) gv[bj][n] = *(const f32x4*)(gate + col0 + bj * HALF + n * 16);
#pragma unroll
        for (int ai = 0; ai < 2; ++ai)
#pragma unroll
            for (int m = 0; m < 4; ++m) { const size_t off = (size_t)(row0 + ai * HALF + m * 16) * ldc + col0;
#pragma unroll
                for (int bj = 0; bj < 2; ++bj)
#pragma unroll
                    for (int n = 0; n < 2; ++n) { const f32x4 xv = *(const f32x4*)(X + off + bj * HALF + n * 16);
                        *(f32x4*)(Out + off + bj * HALF + n * 16) = xv + gv[bj][n] * acc[ai][bj][m][n]; } }
    }
};
template <class Epi, class Sched, bool ALIGN_EPI = false, bool SP2 = false>
__device__ __forceinline__ void gemm_phase(PG8_LAS unsigned char* lds, const Gemm g, const Sched& S, const Epi& E) {
    const int tid = threadIdx.x, wid = __builtin_amdgcn_readfirstlane(tid >> 6), lane = tid & 63, wr = wid >> 2, wc = wid & 3, fr = lane & 15, fq = lane >> 4;
    const int K = g.K, nt = K / BK;
    unsigned voffA[2], voffB[2];
#pragma unroll
    for (int i = 0; i < 2; ++i) { int R, C; stage_rc(tid * 16 + i * 8192, R, C); const int Rb = Epi::PERM ? ((R & ~31) + perm32(R & 31)) : R;
        voffA[i] = (unsigned)(R * K + C) * 2u; voffB[i] = (unsigned)(Rb * K + C) * 2u; }
    const size_t kstep = (size_t)(BK * 2);
    const size_t hstep = (size_t)HALF * K * 2;
    const size_t tstep = 2 * hstep;
    const unsigned ldsw = (unsigned)wid * 1024u;
    const int aoff = lds_byte(wr * 64 + fr, fq * 8), boff = lds_byte(wc * 32 + fr, fq * 8);
#define PG8_SA(b, h) (((b) * 2 + (h)) * HTB)
#define PG8_SB(b, h) ((4 + (b) * 2 + (h)) * HTB)
#define PG8_STAGE(bufoff, gbase, voff) do { _Pragma("unroll") for (int _i = 0; _i < 2; ++_i) \
        __builtin_amdgcn_global_load_lds((const unsigned*)((const char*)(gbase) + (voff)[_i]), (PG8_LAS unsigned*)(lds + (bufoff) + ldsw + _i * 8192), 16, 0, 0); } while (0)
#define PG8_LDA(dst, b, h) do { _Pragma("unroll") for (int m = 0; m < 4; ++m) _Pragma("unroll") for (int k = 0; k < 2; ++k) dst[m][k] = *(const PG8_LAS bf16x8*)(lds + PG8_SA(b, h) + aoff + m * 2048 + k * 1024); } while (0)
#define PG8_LDB(dst, b, h) do { _Pragma("unroll") for (int n = 0; n < 2; ++n) _Pragma("unroll") for (int k = 0; k < 2; ++k) dst[n][k] = *(const PG8_LAS bf16x8*)(lds + PG8_SB(b, h) + boff + n * 2048 + k * 1024); } while (0)
#define PG8_MMA(ai, bj, At, Bt) do { __builtin_amdgcn_s_setprio(1); _Pragma("unroll") for (int m = 0; m < 4; ++m) _Pragma("unroll") for (int n = 0; n < 2; ++n) _Pragma("unroll") for (int k = 0; k < 2; ++k) \
        acc[ai][bj][m][n] = __builtin_amdgcn_mfma_f32_16x16x32_bf16(Bt[n][k], At[m][k], acc[ai][bj][m][n], 0, 0, 0); __builtin_amdgcn_s_setprio(0); } while (0)
#define PG8_WAIT_V(n) asm volatile("s_waitcnt vmcnt(" #n ")" ::: "memory")
#define PG8_WAIT_L(n) asm volatile("s_waitcnt lgkmcnt(" #n ")" ::: "memory")
#define PG8_BAR __builtin_amdgcn_s_barrier()
#define PG8_SCHED __builtin_amdgcn_sched_barrier(0)
    Unit cur, nxt; int ui = 0;
    if (!S.next(0, cur)) return;
    f32x4 acc[2][2][4][2];
#pragma unroll
    for (int a = 0; a < 2; ++a)
#pragma unroll
        for (int b = 0; b < 2; ++b)
#pragma unroll
            for (int m = 0; m < 4; ++m)
#pragma unroll
                for (int n = 0; n < 2; ++n) acc[a][b][m][n] = (f32x4){0.f, 0.f, 0.f, 0.f};
    bf16x8 At[4][2], B0[2][2], B1[2][2];
    const char* cA = (const char*)g.A + (size_t)cur.pm * tstep; const char* cB = (const char*)g.Bt + (size_t)cur.pn * tstep;
    S.a_ready(cur);
    if constexpr (SP2) {
        PG8_STAGE(PG8_SB(0, 0), cB, voffB); PG8_STAGE(PG8_SB(0, 1), cB + hstep, voffB); PG8_STAGE(PG8_SA(0, 0), cA, voffA); PG8_STAGE(PG8_SA(0, 1), cA + hstep, voffA);
        if (wr == 1) PG8_BAR;
        PG8_WAIT_V(2); PG8_BAR;
        PG8_STAGE(PG8_SB(1, 0), cB + kstep, voffB); PG8_STAGE(PG8_SA(1, 0), cA + kstep, voffA); PG8_STAGE(PG8_SB(1, 1), cB + hstep + kstep, voffB);
        PG8_WAIT_V(6); PG8_BAR;
    } else {
        PG8_STAGE(PG8_SB(0, 0), cB, voffB); PG8_STAGE(PG8_SA(0, 0), cA, voffA); PG8_STAGE(PG8_SB(0, 1), cB + hstep, voffB); PG8_STAGE(PG8_SA(0, 1), cA + hstep, voffA);
        if (wr == 1) PG8_BAR;
        PG8_WAIT_V(4); PG8_BAR;
        PG8_STAGE(PG8_SB(1, 0), cB + kstep, voffB); PG8_STAGE(PG8_SA(1, 0), cA + kstep, voffA); PG8_STAGE(PG8_SB(1, 1), cB + hstep + kstep, voffB);
        PG8_WAIT_V(6); PG8_BAR;
    }
    for (;;) {
        const bool has_next = S.next(ui + 1, nxt);
        const char* nA = has_next ? (const char*)g.A + (size_t)nxt.pm * tstep : cA; const char* nB = has_next ? (const char*)g.Bt + (size_t)nxt.pn * tstep : cB;
        for (int t = 0; t < nt; t += 2) {
            const bool last = (t == nt - 2);
            const char* a1 = cA + (size_t)(t + 1) * kstep;
            const char* a2 = last ? nA : cA + (size_t)(t + 2) * kstep; const char* b2 = last ? nB : cB + (size_t)(t + 2) * kstep;
            const char* a3 = a2 + kstep; const char* b3 = b2 + kstep;
            if (last && has_next) S.a_ready(nxt);
            if constexpr (SP2) {
            PG8_LDB(B0, 0, 0); PG8_LDB(B1, 0, 1); PG8_SCHED; PG8_LDA(At, 0, 0); PG8_STAGE(PG8_SA(1, 1), a1 + hstep, voffA);
            PG8_WAIT_V(8); PG8_WAIT_L(0); PG8_BAR; PG8_MMA(0, 0, At, B0); PG8_MMA(0, 1, At, B1); PG8_BAR; PG8_SCHED;
            PG8_LDA(At, 0, 1); PG8_STAGE(PG8_SB(0, 0), b2, voffB); PG8_STAGE(PG8_SB(0, 1), b2 + hstep, voffB); PG8_STAGE(PG8_SA(0, 0), a2, voffA);
            PG8_WAIT_V(8); PG8_WAIT_L(0); PG8_BAR; PG8_MMA(1, 0, At, B0); PG8_MMA(1, 1, At, B1); PG8_BAR; PG8_SCHED;
            PG8_LDB(B0, 1, 0); PG8_LDB(B1, 1, 1); PG8_SCHED; PG8_LDA(At, 1, 0); PG8_STAGE(PG8_SA(0, 1), a2 + hstep, voffA);
            PG8_WAIT_V(8); PG8_WAIT_L(0); PG8_BAR; PG8_MMA(0, 0, At, B0); PG8_MMA(0, 1, At, B1); PG8_BAR; PG8_SCHED;
            PG8_LDA(At, 1, 1); PG8_STAGE(PG8_SB(1, 0), b3, voffB); PG8_STAGE(PG8_SB(1, 1), b3 + hstep, voffB); PG8_STAGE(PG8_SA(1, 0), a3, voffA);
            PG8_WAIT_V(8); PG8_WAIT_L(0); PG8_BAR; PG8_MMA(1, 0, At, B0); PG8_MMA(1, 1, At, B1); PG8_BAR; PG8_SCHED;
            } else {
            PG8_LDB(B0, 0, 0); PG8_SCHED; PG8_LDA(At, 0, 0); PG8_STAGE(PG8_SA(1, 1), a1 + hstep, voffA);
            PG8_WAIT_L(8); PG8_BAR; PG8_WAIT_L(0); PG8_MMA(0, 0, At, B0); PG8_BAR; PG8_SCHED;
            PG8_LDB(B1, 0, 1); PG8_STAGE(PG8_SB(0, 0), b2, voffB);
            PG8_BAR; PG8_WAIT_L(0); PG8_MMA(0, 1, At, B1); PG8_BAR;
            PG8_LDA(At, 0, 1); PG8_STAGE(PG8_SA(0, 0), a2, voffA);
            PG8_BAR; PG8_WAIT_L(0); PG8_MMA(1, 0, At, B0); PG8_BAR; PG8_SCHED;
            PG8_STAGE(PG8_SB(0, 1), b2 + hstep, voffB);
            PG8_WAIT_V(6); PG8_BAR; PG8_MMA(1, 1, At, B1); PG8_BAR;
            PG8_LDB(B0, 1, 0); PG8_SCHED; PG8_LDA(At, 1, 0); PG8_STAGE(PG8_SA(0, 1), a2 + hstep, voffA);
            PG8_WAIT_L(8); PG8_BAR; PG8_WAIT_L(0); PG8_MMA(0, 0, At, B0); PG8_BAR; PG8_SCHED;
            PG8_LDB(B1, 1, 1); PG8_STAGE(PG8_SB(1, 0), b3, voffB);
            PG8_BAR; PG8_WAIT_L(0); PG8_MMA(0, 1, At, B1); PG8_BAR;
            PG8_LDA(At, 1, 1); PG8_STAGE(PG8_SA(1, 0), a3, voffA);
            PG8_BAR; PG8_WAIT_L(0); PG8_MMA(1, 0, At, B0); PG8_BAR; PG8_SCHED;
            PG8_STAGE(PG8_SB(1, 1), b3 + hstep, voffB);
            PG8_WAIT_V(6); PG8_BAR; PG8_MMA(1, 1, At, B1); PG8_BAR;
            }
        }
        if constexpr (ALIGN_EPI) { if (wr == 0) PG8_BAR; }
        if constexpr (!Epi::AFTER_DRAIN) { E(acc, cur, wr, wc, fr, fq); S.done(cur); }
        if (!has_next) break;
#pragma unroll
        for (int a = 0; a < 2; ++a)
#pragma unroll
            for (int b = 0; b < 2; ++b)
#pragma unroll
                for (int m = 0; m < 4; ++m)
#pragma unroll
                    for (int n = 0; n < 2; ++n) acc[a][b][m][n] = (f32x4){0.f, 0.f, 0.f, 0.f};
        cur = nxt; cA = nA; cB = nB; ++ui;
        if constexpr (ALIGN_EPI) { if (wr == 1) PG8_BAR; }
    }
    PG8_WAIT_V(0);
    if constexpr (!ALIGN_EPI) { if (wr == 0) PG8_BAR; }
    PG8_BAR;
    if constexpr (Epi::AFTER_DRAIN) { E.fused(acc, cur, wr, wc, fr, fq, lds, wid, lane); S.done(cur); }
#undef PG8_SA
#undef PG8_SB
#undef PG8_STAGE
#undef PG8_LDA
#undef PG8_LDB
#undef PG8_MMA
#undef PG8_WAIT_V
#undef PG8_WAIT_L
#undef PG8_BAR
#undef PG8_SCHED
}
}
namespace attn_body {
constexpr int D = 128, LD = 2048;
constexpr float THR = 8.f; constexpr bool WSKIP = false;
constexpr float SCALE = 0.08838834764831845f;
constexpr int NW = 8, QBLK = 32, KVBLK = 64, QB = NW * QBLK;
constexpr int SHM_V = KVBLK * D * 2, SHM_K = KVBLK * D * 2;
constexpr int LDS_BYTES = 2 * SHM_V + 2 * SHM_K + NW * 64 * 4;

typedef short bf16x8 __attribute__((ext_vector_type(8)));
typedef short s16x4 __attribute__((ext_vector_type(4)));
typedef float f32x16 __attribute__((ext_vector_type(16)));
typedef float f32x4 __attribute__((ext_vector_type(4)));
typedef unsigned u32x4 __attribute__((ext_vector_type(4)));
template <class A, class Bt> struct same_t { static constexpr bool v = false; };
template <class A> struct same_t<A, A> { static constexpr bool v = true; };

#define KSWZ(row, colB) ((row) * 256 + ((colB) ^ (((row) & 7) << 4)))
#define SBAR() __builtin_amdgcn_sched_barrier(0)
__device__ __forceinline__ int v_st(int k, int c) { const int kk = (k & ~0xC) | ((k & 4) << 1) | ((k & 8) >> 1); return ((kk >> 3) * 4 + (c >> 5)) * 512 + ((kk & 7) * 32 + (c & 31)) * 2; }
__device__ __forceinline__ int v_rd_base(int lane) { return ((lane & 3) << 3) | (((lane >> 2) & 3) << 6) | (((lane >> 4) & 1) << 5) | (((lane >> 5) & 1) << 8); }
constexpr int v_rd_off(int d0, int ks, int half) { return d0 * 512 + ks * 4096 + half * 2048; }
__device__ __forceinline__ int crow(int r, int hi) { return (r & 3) + 8 * (r >> 2) + 4 * hi; }
__device__ __forceinline__ unsigned cvtpk(float lo, float hi) {
    unsigned r; asm volatile("v_cvt_pk_bf16_f32 %0, %1, %2" : "=v"(r) : "v"(lo), "v"(hi)); return r;
}
__device__ __forceinline__ bf16x8 pack8(f32x4 a, f32x4 b) {
    u32x4 w = {cvtpk(a[0], a[1]), cvtpk(a[2], a[3]), cvtpk(b[0], b[1]), cvtpk(b[2], b[3])};
    return *reinterpret_cast<bf16x8*>(&w);
}
template <class T> __device__ __forceinline__ bf16x8 load8(const T* p) {
    if constexpr (same_t<T, float>::v) { return pack8(*(const f32x4*)p, *(const f32x4*)(p + 4)); }
    else { return *reinterpret_cast<const bf16x8*>(p); }
}
__device__ __forceinline__ void mask_tile(f32x16& p0, f32x16& p1, int dq, unsigned W) {
    const float NEG = -__builtin_inff();
#pragma unroll
    for (int r = 0; r < 16; ++r) {
        const int c = (r & 3) + 8 * (r >> 2);
        if ((unsigned)(dq - c) >= W) p0[r] = NEG;
        if ((unsigned)(dq - c - 32) >= W) p1[r] = NEG;
    }
}
__device__ __forceinline__ void partialSM(f32x16& p0, f32x16& p1, float& m_reg, float& mn, float& alpha) {
    float pmax = p0[0]; for (int r = 1; r < 16; ++r) pmax = fmaxf(pmax, p0[r]); for (int r = 0; r < 16; ++r) pmax = fmaxf(pmax, p1[r]);
    { auto rr = __builtin_amdgcn_permlane32_swap(__float_as_uint(pmax), __float_as_uint(pmax), false, false);
      pmax = fmaxf(__uint_as_float(rr[0]), __uint_as_float(rr[1])); }
    constexpr float C2 = 1.4426950408889634f * SCALE;
    if (__builtin_expect(__all((pmax - m_reg) * SCALE <= THR), 1)) { mn = m_reg; alpha = 1.f; }
    else { mn = fmaxf(m_reg, pmax); alpha = __builtin_amdgcn_exp2f((m_reg - mn) * C2); m_reg = mn; }
    const float mnL = -mn * C2;
    for (int r = 0; r < 16; ++r) p0[r] = fmaf(p0[r], C2, mnL); for (int r = 0; r < 16; ++r) p1[r] = fmaf(p1[r], C2, mnL);
    for (int r = 0; r < 16; ++r) p0[r] = __builtin_amdgcn_exp2f(p0[r]);
}
__device__ __forceinline__ void finishSM(f32x16& p0, f32x16& p1, float alpha, float& l_reg, bf16x8& pa0, bf16x8& pa1, bf16x8& pa2, bf16x8& pa3) {
    for (int r = 0; r < 16; ++r) p1[r] = __builtin_amdgcn_exp2f(p1[r]);
    float ps = 0; for (int r = 0; r < 16; ++r) ps += p0[r]; for (int r = 0; r < 16; ++r) ps += p1[r];
    { auto rr = __builtin_amdgcn_permlane32_swap(__float_as_uint(ps), __float_as_uint(ps), false, false);
      ps = __uint_as_float(rr[0]) + __uint_as_float(rr[1]); }
    l_reg = l_reg * alpha + ps;
#define PK4(P, B_, OUT) do { unsigned a0 = cvtpk(P[B_+0], P[B_+1]), a1 = cvtpk(P[B_+2], P[B_+3]);                          \
        unsigned b0 = cvtpk(P[B_+4], P[B_+5]), b1 = cvtpk(P[B_+6], P[B_+7]);                                             \
        auto r0 = __builtin_amdgcn_permlane32_swap(a0, b0, false, false); auto r1 = __builtin_amdgcn_permlane32_swap(a1, b1, false, false); \
        u32x4 w = {r0[0], r1[0], r0[1], r1[1]}; OUT = *reinterpret_cast<bf16x8*>(&w); } while (0)
    PK4(p0, 0, pa0); PK4(p0, 8, pa1); PK4(p1, 0, pa2); PK4(p1, 8, pa3);
#undef PK4
}
template <int KB, bool SK>
__device__ __forceinline__ void qkt(f32x16& p0, f32x16& p1, const char* K_lds, int r32, int hi, const bf16x8* qr, bool act, const float* bt) {
    if (SK && !act) { const float NEG = -__builtin_inff();
#pragma unroll
        for (int r = 0; r < 16; ++r) { p0[r] = NEG; p1[r] = NEG; } return; }
    { const f32x4 b0 = *(const f32x4*)(bt), b1 = *(const f32x4*)(bt + 8), b2 = *(const f32x4*)(bt + 16), b3 = *(const f32x4*)(bt + 24);
      const f32x4 c0 = *(const f32x4*)(bt + 32), c1 = *(const f32x4*)(bt + 40), c2 = *(const f32x4*)(bt + 48), c3 = *(const f32x4*)(bt + 56);
      p0 = (f32x16){b0[0], b0[1], b0[2], b0[3], b1[0], b1[1], b1[2], b1[3], b2[0], b2[1], b2[2], b2[3], b3[0], b3[1], b3[2], b3[3]};
      p1 = (f32x16){c0[0], c0[1], c0[2], c0[3], c1[0], c1[1], c1[2], c1[3], c2[0], c2[1], c2[2], c2[3], c3[0], c3[1], c3[2], c3[3]}; }
    const char* kb[4];
#pragma unroll
    for (int dd = 0; dd < 4; ++dd) kb[dd] = K_lds + KB * SHM_K + KSWZ(r32, (dd * 16 + hi * 8) * 2);
#pragma unroll
    for (int d0 = 0; d0 < 8; ++d0) { const char* a = kb[d0 & 3] + (d0 >> 2) * 128;
        bf16x8 b0 = *reinterpret_cast<const bf16x8*>(a);
        bf16x8 b1 = *reinterpret_cast<const bf16x8*>(a + 32 * 256);
        p0 = __builtin_amdgcn_mfma_f32_32x32x16_bf16(b0, qr[d0], p0, 0, 0, 0);
        p1 = __builtin_amdgcn_mfma_f32_32x32x16_bf16(b1, qr[d0], p1, 0, 0, 0); }
}
template <int VB, bool SK>
__device__ __forceinline__ void pv_tile(f32x16* o, int vb0, bf16x8 pa0, bf16x8 pa1, bf16x8 pa2, bf16x8 pa3, bool act) {
    if (SK && !act) return;
#define TRRD(dst, off) asm volatile("ds_read_b64_tr_b16 %0, %1 offset:%2" : "=&v"(dst) : "v"(vb0), "i"(off) : "memory")
#define PV_D0(d0) do { s16x4 l0, l1, l2, l3, h0, h1, h2, h3; constexpr int b_ = VB * SHM_V + v_rd_off(d0, 0, 0);     \
        TRRD(l0, b_); TRRD(h0, b_ + 2048); TRRD(l1, b_ + 4096); TRRD(h1, b_ + 6144); TRRD(l2, b_ + 8192); TRRD(h2, b_ + 10240); TRRD(l3, b_ + 12288); TRRD(h3, b_ + 14336); \
        asm volatile("s_waitcnt lgkmcnt(0)" ::: "memory"); SBAR();                 \
        o[d0] = __builtin_amdgcn_mfma_f32_32x32x16_bf16(pa0, (bf16x8){l0[0], l0[1], l0[2], l0[3], h0[0], h0[1], h0[2], h0[3]}, o[d0], 0, 0, 0);   \
        o[d0] = __builtin_amdgcn_mfma_f32_32x32x16_bf16(pa1, (bf16x8){l1[0], l1[1], l1[2], l1[3], h1[0], h1[1], h1[2], h1[3]}, o[d0], 0, 0, 0);   \
        o[d0] = __builtin_amdgcn_mfma_f32_32x32x16_bf16(pa2, (bf16x8){l2[0], l2[1], l2[2], l2[3], h2[0], h2[1], h2[2], h2[3]}, o[d0], 0, 0, 0);   \
        o[d0] = __builtin_amdgcn_mfma_f32_32x32x16_bf16(pa3, (bf16x8){l3[0], l3[1], l3[2], l3[3], h3[0], h3[1], h3[2], h3[3]}, o[d0], 0, 0, 0); } while (0)
    PV_D0(0); PV_D0(1); PV_D0(2); PV_D0(3);
#undef PV_D0
#undef TRRD
}


template <class TIn, class TOut> struct BlockRef { const TIn* Q; const TIn* K; const TIn* V; TOut* O; int P0; int jlo; };
#define ROW(p, k0, rr) ((p) + (size_t)((k0) + (rr)) * LD + sc)
#define VMW() asm volatile("s_waitcnt vmcnt(0)" ::: "memory")
#define SLOAD_H(Kp, Vp, k0) do { st_v0 = load8<TIn>(ROW(Vp, k0, sr)); st_v1 = load8<TIn>(ROW(Vp, k0, 32 + sr));              \
                         st_k0 = load8<TIn>(ROW(Kp, k0, sr)); st_k1 = load8<TIn>(ROW(Kp, k0, 32 + sr)); } while (0)
#define SWRITE_H(bf) do { *(bf16x8*)(V_lds + (bf) * SHM_V + vst0) = st_v0; *(bf16x8*)(V_lds + (bf) * SHM_V + vst1) = st_v1;   \
                          *(bf16x8*)(K_lds + (bf) * SHM_K + kws) = st_k0; *(bf16x8*)(K_lds + (bf) * SHM_K + kws + 32 * 256) = st_k1; } while (0)
template <class TIn, class TOut>
__device__ __forceinline__ void attn_unit(const BlockRef<TIn, TOut>& cur, int skv, char* lds) {
    const int tid = threadIdx.x, wid = __builtin_amdgcn_readfirstlane(tid >> 6), lane = tid & 63, r32 = lane & 31, hi = lane >> 5;
    const unsigned W = 0x40000000u;
    const int j_lo = cur.jlo;
    int j_hi = (cur.P0 + QB - 1) / KVBLK + 1; if (j_hi > skv / KVBLK) j_hi = skv / KVBLK;
    const int NT = j_hi - j_lo;
    const int qlo = cur.P0 + wid * QBLK, qm = qlo + r32 - 4 * hi;
    char* V_lds = lds; char* K_lds = lds + 2 * SHM_V;
    float* ws = (float*)(lds + 2 * SHM_V + 2 * SHM_K) + wid * 64; float* li_l = ws, * al_l = ws + 32;
    const float* bias_l = (const float*)(lds + LDS_BYTES) + 4 * hi;
    float m_reg = -1e30f, l_reg = 0; f32x16 o[4] = {};
    const int sr = tid >> 4, sc = (tid & 15) * 8, vst0 = v_st(sr, sc), vst1 = v_st(32 + sr, sc), kws = KSWZ(sr, sc * 2);
    const int vb0 = (int)(uintptr_t)V_lds + v_rd_base(lane);
    const TIn* Kh = cur.K; const TIn* Vh = cur.V;
    bf16x8 st_v0, st_v1, st_k0, st_k1; bf16x8 qr[8];
#define KBASE(t) ((j_lo + (t)) * KVBLK)
#define BT(t) (bias_l + (t) * KVBLK)
#define RESC(a) do { if (__any((a) < 1.f)) { if (hi == 0) al_l[r32] = (a); asm volatile("s_waitcnt lgkmcnt(0)" ::: "memory");              \
                     for (int d_ = 0; d_ < 4; ++d_) for (int r = 0; r < 16; ++r) o[d_][r] *= al_l[crow(r, hi)]; } } while (0)
#define MASKT(P0_, P1_, t) do { const int kb_ = KBASE(t); if (kb_ + KVBLK - 1 > qlo) mask_tile(P0_, P1_, qm - kb_, W); } while (0)
#pragma unroll
    for (int d0 = 0; d0 < 8; ++d0) qr[d0] = load8<TIn>(cur.Q + (size_t)(wid * QBLK + r32) * LD + d0 * 16 + hi * 8);
    SLOAD_H(Kh, Vh, KBASE(0)); VMW(); SWRITE_H(0); SBAR();
    if (NT > 1) SLOAD_H(Kh, Vh, KBASE(1));
    __syncthreads();
    f32x16 p0, p1; float mn, al; bf16x8 pa0, pa1, pa2, pa3;
#define TILE_STEP(t, BUF) do {                                                                                                 \
        SBAR(); qkt<BUF, false>(p0, p1, K_lds, r32, hi, qr, true, BT(t));                                                       \
        MASKT(p0, p1, (t)); partialSM(p0, p1, m_reg, mn, al); RESC(al);                                                          \
        finishSM(p0, p1, al, l_reg, pa0, pa1, pa2, pa3); SBAR();                                                                 \
        pv_tile<BUF, false>(o, vb0, pa0, pa1, pa2, pa3, true);                                                                    \
        if ((t) + 1 < NT) { VMW(); SWRITE_H(1 - (BUF)); SBAR(); if ((t) + 2 < NT) SLOAD_H(Kh, Vh, KBASE((t) + 2)); }              \
        __syncthreads(); } while (0)
    for (int t = 0; t < NT; t += 2) {
        TILE_STEP(t, 0);
        if (t + 1 < NT) TILE_STEP(t + 1, 1);
    }
    if (hi == 0) li_l[r32] = l_reg; asm volatile("s_waitcnt lgkmcnt(0)" ::: "memory");
    float rli[16];
#pragma unroll
    for (int r = 0; r < 16; ++r) rli[r] = __builtin_amdgcn_rcpf(li_l[crow(r, hi)]);
    TOut* Ow = cur.O + (size_t)(wid * QBLK) * LD;
#pragma unroll
    for (int r = 0; r < 16; ++r) { const int orow = crow(r, hi);
#pragma unroll
        for (int d0 = 0; d0 < 4; ++d0) { const float v = o[d0][r] * rli[r];
            const float vn = __shfl_xor(v, 1);
            if ((r32 & 1) == 0) *(unsigned*)(Ow + (size_t)orow * LD + d0 * 32 + r32) = cvtpk(v, vn); } }
    __syncthreads();
#undef TILE_STEP
#undef RESC
#undef KBASE
#undef BT
#undef MASKT
}
#undef ROW
#undef VMW
#undef SLOAD_H
#undef SWRITE_H
}
#define GAS __attribute__((address_space(1)))
#define LAS __attribute__((address_space(3)))
typedef unsigned short bf16;
typedef unsigned v4u __attribute__((ext_vector_type(4)));
typedef unsigned v2u __attribute__((ext_vector_type(2)));
typedef float f32x4 __attribute__((ext_vector_type(4)));
typedef float f32x2 __attribute__((ext_vector_type(2)));
typedef short bf16x8 __attribute__((ext_vector_type(8)));
typedef GAS unsigned gu32;
#define RLX_AGENT __ATOMIC_RELAXED, __HIP_MEMORY_SCOPE_AGENT

constexpr int S = 8192, DM = 4096, NH = 16, HD = 128, AW = 2048, LW = 2048, NG = 16, GD = 128;
constexpr int NIN = 18448, NINP = 18432;
constexpr int C_Q = 0, C_K = 2048, C_V = 4096, C_F = 6144, C_LX = 6160, C_LY = 8208, C_GA = 10256, C_GL = 14352;
constexpr int PEER_H = 8, PEER_NK = 128, PEER_K = 16, PEER_NE = 16384;
constexpr float EPS = 1e-6f;
constexpr size_t MiB = 1u << 20;
constexpr size_t WS_CTL = 0, CTL_ZERO_BYTES = 1 * MiB;
constexpr size_t WS_MOD = 512 * 1024;
constexpr size_t WS_WF = 2 * MiB;
constexpr size_t WS_LOGF = 3 * MiB;
constexpr size_t WS_FC = 4 * MiB;
constexpr size_t WS_AGGA = 5 * MiB, WS_AGGB = 6 * MiB;
constexpr size_t WS_BIASR = 7 * MiB;
constexpr size_t WS_WAT = 8 * MiB, WS_WXT = 9 * MiB;
constexpr size_t WS_SK = 10 * MiB, WS_RS = 11 * MiB, WS_RSU = 11 * MiB + 65536;
constexpr size_t WS_IDX = 12 * MiB, WS_GATE = 16 * MiB, WS_IDX2 = 20 * MiB, WS_GATE2 = 24 * MiB;
constexpr size_t WS_WIN = 32 * MiB, WS_WAO = 176 * MiB, WS_WLO = 192 * MiB, WS_WOUT = 208 * MiB, WS_WPQ = 240 * MiB;
constexpr size_t WS_U = 256 * MiB, WS_V = 384 * MiB;
constexpr size_t WS_HA = 512 * MiB;
constexpr size_t WS_QKV = 576 * MiB;
constexpr size_t WS_LX = 672 * MiB, WS_GY = 704 * MiB, WS_GA = 736 * MiB, WS_GL = 800 * MiB;
constexpr size_t WS_ATT = 864 * MiB, WS_LR = 896 * MiB, WS_T1 = 928 * MiB, WS_MG = 992 * MiB, WS_Q2 = 1056 * MiB, WS_X1 = 1088 * MiB, WS_END = 1216 * MiB;
constexpr int CW_BAR = 4096;
constexpr int CW_QATT = 256;
constexpr int RING_BYTES = 131072;
constexpr int LDSCTL_OFF = RING_BYTES, MISC_OFF = LDSCTL_OFF + 320;
constexpr int LDS_BYTES = 151552;
constexpr int NWAVES = 8, NTHREADS = 512;

__device__ __forceinline__ unsigned f2bf(float f) { unsigned u = __builtin_bit_cast(unsigned, f); return (u + 0x7fffu + ((u >> 16) & 1u)) >> 16; }
__device__ __forceinline__ unsigned pk2(float lo, float hi) { return f2bf(lo) | (f2bf(hi) << 16); }
__device__ __forceinline__ float bflo(unsigned w) { return __uint_as_float(w << 16); }
__device__ __forceinline__ float bfhi(unsigned w) { return __uint_as_float(w & 0xffff0000u); }
__device__ __forceinline__ float bf2f(bf16 b) { return __uint_as_float((unsigned)b << 16); }
__device__ __forceinline__ float wave_sum(float v) {
#pragma unroll
    for (int o = 1; o < 64; o <<= 1) v += __shfl_xor(v, o);
    return v;
}
__device__ __forceinline__ float wave_max(float v) {
#pragma unroll
    for (int o = 1; o < 64; o <<= 1) v = fmaxf(v, __shfl_xor(v, o));
    return v;
}
__device__ __forceinline__ float sigmoidf_(float v) { return __builtin_amdgcn_rcpf(1.0f + __builtin_amdgcn_exp2f(-1.4426950408889634f * v)); }
__device__ __forceinline__ float gelu_erf(float v) { return 0.5f * v * (1.0f + erff(v * 0.70710678118654752f)); }
#define XB_TMO      128
#define XB_XCNT(j)  (256  + 64 * (j))
#define XB_XSUB(j)  (1280 + 64 * (j))
#define XB_XGEN(j)  (2304 + 64 * (j))
#define XB_TOP      3328
#define XB_TOPGEN   3392
#define XCD_BAR_WORDS 3456
#define XB_SPIN_CAP (1u << 18)

__device__ __forceinline__ unsigned xb_ld(unsigned* p)              { return __hip_atomic_load(p, __ATOMIC_RELAXED, __HIP_MEMORY_SCOPE_AGENT); }
__device__ __forceinline__ unsigned xb_add(unsigned* p, unsigned v) { return __hip_atomic_fetch_add(p, v, __ATOMIC_RELAXED, __HIP_MEMORY_SCOPE_AGENT); }
__device__ __forceinline__ unsigned xb_xcc_id() { return (unsigned)__builtin_amdgcn_s_getreg((3 << 11) | 20) & 0xFu; }
#define XB_SPIN(cond, bar) do { unsigned _sp = 0; while (cond) { __builtin_amdgcn_s_sleep(1); \
    if ((++_sp & 255u) == 0u) { if (xb_ld(&(bar)[XB_TMO])) break; if (_sp > XB_SPIN_CAP) { atomicAdd(&(bar)[XB_TMO], 1u); break; } } } } while (0)

struct XcdBarrier {
    unsigned* bar; unsigned x;
    volatile LAS unsigned* st;
};

__device__ __forceinline__ XcdBarrier xcd_barrier_post(unsigned* bar, volatile LAS unsigned* st) {
    XcdBarrier b; b.bar = bar; b.x = xb_xcc_id(); b.st = st;
    if (threadIdx.x == 0) (void)xb_add(&bar[XB_XCNT(b.x)], 1u);
    return b;
}
__device__ __forceinline__ void xcd_barrier_complete(unsigned* bar, unsigned x, unsigned& nloc, unsigned& nx) {
    const unsigned G = gridDim.x * gridDim.y * gridDim.z;
    unsigned sum, cnt, mine, sp = 0u;
    for (;;) {
        sum = 0u; cnt = 0u; mine = 0u;
#pragma unroll
        for (unsigned j = 0; j < 16; ++j) { const unsigned c = xb_ld(&bar[XB_XCNT(j)]); sum += c; cnt += (c > 0u) ? 1u : 0u; mine = (j == x) ? c : mine; }
        if (sum == G) break;
        __builtin_amdgcn_s_sleep(1);
        if ((++sp & 255u) == 0u) { if (xb_ld(&bar[XB_TMO])) break; if (sp > XB_SPIN_CAP) { atomicAdd(&bar[XB_TMO], 1u); break; } }
    }
    nloc = mine > 0u ? mine : 1u; nx = cnt > 0u ? cnt : 1u;
}

__device__ __forceinline__ void xcd_barrier(const XcdBarrier& b) {
    asm volatile("s_waitcnt vmcnt(0)" ::: "memory");
    __syncthreads();
    if (threadIdx.x == 0) {
        unsigned* bar = b.bar;
        __builtin_amdgcn_s_waitcnt(0);
        unsigned nloc = b.st[0], nx = b.st[1];
        if (nloc == 0u) { xcd_barrier_complete(bar, b.x, nloc, nx); b.st[0] = nloc; b.st[1] = nx; }
        const unsigned old = xb_add(&bar[XB_XSUB(b.x)], 1u);
        const unsigned gen = old / nloc;
        if (old + 1u == (gen + 1u) * nloc) {
            __builtin_amdgcn_fence(__ATOMIC_RELEASE, "agent");
            asm volatile("s_waitcnt vmcnt(0)" ::: "memory");
            const unsigned og = xb_add(&bar[XB_TOP], 1u);
            const unsigned tg = og / nx;
            if (og + 1u == (tg + 1u) * nx) xb_add(&bar[XB_TOPGEN], 1u);
            else XB_SPIN(xb_ld(&bar[XB_TOPGEN]) == tg, bar);
            __builtin_amdgcn_fence(__ATOMIC_ACQUIRE, "agent");
            xb_add(&bar[XB_XGEN(b.x)], 1u);
            asm volatile("s_waitcnt vmcnt(0)" ::: "memory");
        } else {
            XB_SPIN(xb_ld(&bar[XB_XGEN(b.x)]) == gen, bar);
            __builtin_amdgcn_fence(__ATOMIC_ACQUIRE, "agent");
            asm volatile("s_waitcnt vmcnt(0)" ::: "memory");
        }
    }
    __syncthreads();
}
struct Args { const float* in[24]; float* out; unsigned char* ws; int ph_lo, ph_hi, rep_att, rep_lru; };
struct Frame {
    LAS unsigned char* lds; volatile LAS unsigned* MISC; gu32* ctl;
    int tid, lane, wave, vcu, G;
    unsigned char* ws; float* out;
};
#define WSP(T, off) ((T*)(F.ws + (off)))
#define LDS_WAIT() asm volatile("s_waitcnt lgkmcnt(0)" ::: "memory")

__device__ __forceinline__ void transpose_item(const float* W, int ldw, int K, bf16* WT, LAS float* scr, int k0, int nsrc0, int ndst0, int lane) {
    float v[32]; const float* wp = W + (size_t)(k0 + (lane >> 5)) * ldw + nsrc0 + (lane & 31);
#pragma unroll
    for (int i = 0; i < 32; ++i) v[i] = wp[(size_t)(2 * i) * ldw];
#pragma unroll
    for (int i = 0; i < 32; ++i) scr[(2 * i + (lane >> 5)) * 33 + (lane & 31)] = v[i];
    LDS_WAIT(); asm volatile("" ::: "memory");
    const int c = lane & 7;
#pragma unroll
    for (int j = 0; j < 4; ++j) { const int n = (lane >> 3) + 8 * j; const LAS float* s = scr + (8 * c) * 33 + n;
        v4u o; o.x = pk2(s[0 * 33], s[1 * 33]); o.y = pk2(s[2 * 33], s[3 * 33]); o.z = pk2(s[4 * 33], s[5 * 33]); o.w = pk2(s[6 * 33], s[7 * 33]);
        *(GAS v4u*)(WT + (size_t)(ndst0 + n) * K + k0 + 8 * c) = o; }
    LDS_WAIT(); asm volatile("" ::: "memory");
}
__device__ __forceinline__ void cvt_stream(const float* src, bf16* dst, size_t n8, size_t i0, size_t stride) {
    for (size_t i = i0; i < n8; i += stride) { const f32x4 a = ((const GAS f32x4*)src)[2 * i], b = ((const GAS f32x4*)src)[2 * i + 1];
        v4u o; o.x = pk2(a[0], a[1]); o.y = pk2(a[2], a[3]); o.z = pk2(b[0], b[1]); o.w = pk2(b[2], b[3]); ((GAS v4u*)dst)[i] = o; }
}
__device__ __forceinline__ void cvt_stream_fp8(const float* src, unsigned char* dst, size_t n16, float scale, size_t i0, size_t stride) {
    for (size_t i = i0; i < n16; i += stride) { v4u o;
#pragma unroll
        for (int q = 0; q < 4; ++q) { const f32x4 a = ((const GAS f32x4*)src)[4 * i + q] * scale; int w = 0;
            w = __builtin_amdgcn_cvt_pk_fp8_f32(a[0], a[1], w, false); w = __builtin_amdgcn_cvt_pk_fp8_f32(a[2], a[3], w, true); o[q] = (unsigned)w; }
        ((GAS v4u*)dst)[i] = o; }
}
__device__ __forceinline__ void cvt_table_fp4(Frame& F, const float* srcT, unsigned char* dstT, float* rsT, int gw, int NGW) {
    for (int row = gw; row < PEER_NE; row += NGW) {
        const GAS f32x4* src = (const GAS f32x4*)(srcT + (size_t)row * DM); f32x4 a[16]; float am = 0.f;
#pragma unroll
        for (int c = 0; c < 4; ++c)
#pragma unroll
            for (int q = 0; q < 4; ++q) { a[4 * c + q] = src[c * 256 + 4 * F.lane + q]; am = fmaxf(fmaxf(am, fmaxf(fabsf(a[4 * c + q][0]), fabsf(a[4 * c + q][1]))), fmaxf(fabsf(a[4 * c + q][2]), fabsf(a[4 * c + q][3]))); }
        am = wave_max(am); const float inv = am > 0.f ? 6.0f / am : 0.f;
#pragma unroll
        for (int c = 0; c < 4; ++c) { v2u o;
#pragma unroll
            for (int d = 0; d < 2; ++d) { unsigned w = 0u; const f32x4 x0 = a[4 * c + 2 * d] * inv, x1 = a[4 * c + 2 * d + 1] * inv;
                w = __builtin_amdgcn_cvt_scalef32_pk_fp4_f32(w, x0[0], x0[1], 1.0f, 0); w = __builtin_amdgcn_cvt_scalef32_pk_fp4_f32(w, x0[2], x0[3], 1.0f, 1);
                w = __builtin_amdgcn_cvt_scalef32_pk_fp4_f32(w, x1[0], x1[1], 1.0f, 2); w = __builtin_amdgcn_cvt_scalef32_pk_fp4_f32(w, x1[2], x1[3], 1.0f, 3); o[d] = w; }
            *((GAS v2u*)(dstT + (size_t)row * 2048 + c * 512) + F.lane) = o; }
        if (F.lane == 0) rsT[row] = am * (1.0f / 6.0f);
    }
}
__device__ __forceinline__ void p0_prologue(Frame& F, const Args& args) {
#ifndef P0_REP
#define P0_REP 0
#endif
    _Pragma("unroll") for (int rep_ = 0; rep_ < ((P0_REP & 1) ? 2 : 1); ++rep_)
    { LAS float* sc = (LAS float*)F.lds; LAS f32x4* red = (LAS f32x4*)(F.lds + 16384); float* MOD = WSP(float, WS_MOD);
      for (int cgi = blockIdx.x; cgi < 256; cgi += F.G) {
          for (int i = F.tid; i < DM; i += NTHREADS) { const float cv = args.in[1][i]; sc[i] = cv / (1.0f + __expf(-cv)); }
          __syncthreads();
          if (F.tid < 384) { const int cg = F.tid % 24, rg = F.tid / 24;
              const GAS f32x4* Wp = (const GAS f32x4*)args.in[2] + cgi * 24 + cg;
              f32x4 acc = {0.f, 0.f, 0.f, 0.f};
#pragma unroll 8
              for (int r = rg; r < DM; r += 16) acc += sc[r] * Wp[(size_t)r * 6144];
              red[rg * 24 + cg] = acc; }
          __syncthreads();
          if (F.tid < 24) { f32x4 s = red[F.tid];
#pragma unroll
              for (int rg = 1; rg < 16; ++rg) s += red[rg * 24 + F.tid];
              s += ((const GAS f32x4*)args.in[3])[cgi * 24 + F.tid]; ((GAS f32x4*)MOD)[cgi * 24 + F.tid] = s; }
          __syncthreads();
      } }
    LAS float* scr = (LAS float*)(F.lds + F.wave * 16384);
    const int gw = F.vcu * NWAVES + F.wave, NGW = F.G * NWAVES;
    constexpr int I_IN = 64 * 576, I_AO = 32 * 128, I_LO = 32 * 128, I_OUT = 64 * 128, I_PQ = 64 * 64, I_WA = 16 * 2 * 4, I_WX = I_WA;
    constexpr int NITEMS = I_IN + I_AO + I_LO + I_OUT + I_PQ + I_WA + I_WX;
    _Pragma("unroll") for (int rep_ = 0; rep_ < ((P0_REP & 2) ? 2 : 1); ++rep_)
    for (int it = gw; it < NITEMS; it += NGW) {
        int r = it;
        if (r < I_IN) { const int kb = r / 576, nb = r % 576; transpose_item(args.in[6], NIN, DM, WSP(bf16, WS_WIN), scr, 64 * kb, 32 * nb + (nb >= 192 ? 16 : 0), 32 * nb, F.lane); continue; } r -= I_IN;
        if (r < I_AO) { const int kb = r / 128, nb = r % 128; transpose_item(args.in[17], DM, AW, WSP(bf16, WS_WAO), scr, 64 * kb, 32 * nb, 32 * nb, F.lane); continue; } r -= I_AO;
        if (r < I_LO) { const int kb = r / 128, nb = r % 128; transpose_item(args.in[18], DM, LW, WSP(bf16, WS_WLO), scr, 64 * kb, 32 * nb, 32 * nb, F.lane); continue; } r -= I_LO;
        if (r < I_OUT) { const int kb = r / 128, nb = r % 128; transpose_item(args.in[19], DM, DM, WSP(bf16, WS_WOUT), scr, 64 * kb, 32 * nb, 32 * nb, F.lane); continue; } r -= I_OUT;
        if (r < I_PQ) { const int kb = r / 64, nb = r % 64; transpose_item(args.in[20], 2048, DM, WSP(bf16, WS_WPQ), scr, 64 * kb, 32 * nb, 32 * nb, F.lane); continue; } r -= I_PQ;
        { const bool isx = r >= I_WA; if (isx) r -= I_WA; const int g = r >> 3, kb = (r >> 2) & 1, nb = r & 3;
          transpose_item((isx ? args.in[14] : args.in[12]) + (size_t)g * GD * GD, GD, GD, WSP(bf16, isx ? WS_WXT : WS_WAT) + (size_t)g * GD * GD, scr, 64 * kb, 32 * nb, 32 * nb, F.lane); }
    }
    const size_t gt = (size_t)F.vcu * NTHREADS + F.tid, NGT = (size_t)F.G * NTHREADS;
    _Pragma("unroll") for (int rep_ = 0; rep_ < ((P0_REP & 4) ? 2 : 1); ++rep_) {
    cvt_table_fp4(F, args.in[23], WSP(unsigned char, WS_V), WSP(float, WS_RS), gw, NGW);
    cvt_table_fp4(F, args.in[22], WSP(unsigned char, WS_U), WSP(float, WS_RSU), gw, NGW); }
    cvt_stream(args.in[21], WSP(bf16, WS_SK), (size_t)PEER_H * 2 * 128 * 128 / 8, gt, NGT);
    for (size_t i = gt; i < (size_t)DM * 16; i += NGT) WSP(float, WS_WF)[i] = args.in[6][(i >> 4) * NIN + C_F + (i & 15)];
    for (size_t i = gt; i < (size_t)NINP; i += NGT) WSP(float, WS_BIASR)[i] = args.in[7][i + (i >= (size_t)C_F ? 16 : 0)];
}

__device__ __forceinline__ void p1_norm_forget(Frame& F, const Args& args) {
    const int gw = F.vcu * NWAVES + F.wave, NGW = F.G * NWAVES; const float* MOD = WSP(float, WS_MOD); const float* WF = WSP(float, WS_WF); bf16* HA = WSP(bf16, WS_HA);
    for (int rg = gw; rg < S / 4; rg += NGW) {
        const int r0 = rg * 4; float rstd[4];
#pragma unroll
        for (int r = 0; r < 4; ++r) { const GAS f32x4* xr = (const GAS f32x4*)(args.in[0] + (size_t)(r0 + r) * DM) + F.lane; float ss = 0.f;
#pragma unroll
            for (int j = 0; j < 16; ++j) { const f32x4 v = xr[64 * j]; ss += (v[0] * v[0] + v[1] * v[1]) + (v[2] * v[2] + v[3] * v[3]); }
            rstd[r] = 1.0f / sqrtf(wave_sum(ss) * (1.0f / DM) + EPS); }
        float acc[4][16];
#pragma unroll
        for (int r = 0; r < 4; ++r)
#pragma unroll
            for (int cc = 0; cc < 16; ++cc) acc[r][cc] = 0.f;
        for (int j = 0; j < 16; ++j) {
            const int i4 = F.lane + 64 * j;
            const f32x4 g = ((const GAS f32x4*)args.in[4])[i4], scl = ((const GAS f32x4*)(MOD + 4096))[i4], sh = ((const GAS f32x4*)MOD)[i4];
            const f32x4 mul = g * (scl + 1.0f);
            f32x4 wf[4][4];
#pragma unroll
            for (int i = 0; i < 4; ++i)
#pragma unroll
                for (int q = 0; q < 4; ++q) wf[i][q] = ((const GAS f32x4*)(WF + (size_t)(4 * i4 + i) * 16))[q];
#pragma unroll
            for (int r = 0; r < 4; ++r) {
                const f32x4 xv = ((const GAS f32x4*)(args.in[0] + (size_t)(r0 + r) * DM))[i4];
                const f32x4 hv = xv * rstd[r] * mul + sh;
                v2u o; o.x = pk2(hv[0], hv[1]); o.y = pk2(hv[2], hv[3]);
                ((GAS v2u*)(HA + (size_t)(r0 + r) * DM))[i4] = o;
#pragma unroll
                for (int i = 0; i < 4; ++i)
#pragma unroll
                    for (int q = 0; q < 4; ++q)
#pragma unroll
                        for (int e = 0; e < 4; ++e) acc[r][4 * q + e] += hv[i] * wf[i][q][e];
            }
        }
#pragma unroll
        for (int r = 0; r < 4; ++r)
#pragma unroll
            for (int cc = 0; cc < 16; ++cc) { const float tot = wave_sum(acc[r][cc]);
                if (F.lane == cc) { const float f = tot + args.in[7][C_F + cc]; WSP(float, WS_LOGF)[(size_t)(r0 + r) * 16 + cc] = fminf(f, 0.f) - log1pf(__expf(-fabsf(f))); } }
    }
}

__device__ __forceinline__ void p3_qknorm(Frame& F, const Args& args) {
    const int gw = F.vcu * NWAVES + F.wave, NGW = F.G * NWAVES; bf16* QK = WSP(bf16, WS_QKV);
    const int sub = F.lane & 15;
    f32x4 gq0 = ((const GAS f32x4*)args.in[8])[2 * sub], gq1 = ((const GAS f32x4*)args.in[8])[2 * sub + 1], gk0 = ((const GAS f32x4*)args.in[9])[2 * sub], gk1 = ((const GAS f32x4*)args.in[9])[2 * sub + 1];
    for (int it = gw; it < 2 * S * NH / 4; it += NGW) {
        const size_t unit = (size_t)it * 4 + (F.lane >> 4); const bool isk = unit >= (size_t)S * NH;
        GAS v4u* p = (GAS v4u*)(QK + unit * 128) + sub; const v4u w = *p;
        f32x4 a = {bflo(w.x), bfhi(w.x), bflo(w.y), bfhi(w.y)}, b = {bflo(w.z), bfhi(w.z), bflo(w.w), bfhi(w.w)};
        float ss = (a[0] * a[0] + a[1] * a[1]) + (a[2] * a[2] + a[3] * a[3]) + (b[0] * b[0] + b[1] * b[1]) + (b[2] * b[2] + b[3] * b[3]);
        ss += __shfl_xor(ss, 1); ss += __shfl_xor(ss, 2); ss += __shfl_xor(ss, 4); ss += __shfl_xor(ss, 8);
        const float rs = 1.0f / sqrtf(ss * (1.0f / HD) + EPS);
        a = a * rs * (isk ? gk0 : gq0); b = b * rs * (isk ? gk1 : gq1);
        v4u o; o.x = pk2(a[0], a[1]); o.y = pk2(a[2], a[3]); o.z = pk2(b[0], b[1]); o.w = pk2(b[2], b[3]); *p = o;
    }
}
__device__ __forceinline__ void p3_cumsum(Frame& F, const Args& args) {
    LAS float* wt = (LAS float*)F.lds;
    for (int h = blockIdx.x; h < NH; h += F.G) {
        const float* LF = WSP(float, WS_LOGF); float v[16]; float run = 0.f;
#pragma unroll
        for (int i = 0; i < 16; ++i) { run += LF[(size_t)(F.tid * 16 + i) * 16 + h]; v[i] = run; }
        float sc = run;
#pragma unroll
        for (int o = 1; o < 64; o <<= 1) { const float t = __shfl_up(sc, o); if (F.lane >= o) sc += t; }
        if (F.lane == 63) wt[F.wave] = sc;
        __syncthreads();
        float pre = sc - run;
        for (int w = 0; w < F.wave; ++w) pre += wt[w];
        float* Fo = WSP(float, WS_FC) + (size_t)h * S + F.tid * 16;
#pragma unroll
        for (int i = 0; i < 4; ++i) ((GAS f32x4*)Fo)[i] = (f32x4){v[4 * i] + pre, v[4 * i + 1] + pre, v[4 * i + 2] + pre, v[4 * i + 3] + pre};
        __syncthreads();
    }
}
constexpr int LRU_XCF = 0, LRU_XCB = 32768, LRU_AB = 49152, LRU_BB = 81920, LRU_QA = 114688, LRU_CAR = 118784, LRU_XR = 133120;
template <int PASS> __device__ __forceinline__ void lru_chunk(Frame& F, const Args& args, int c, int g) {
    LAS float* XCF = (LAS float*)(F.lds + LRU_XCF); LAS unsigned char* XCB = F.lds + LRU_XCB; LAS float* AB = (LAS float*)(F.lds + LRU_AB); LAS float* BB = (LAS float*)(F.lds + LRU_BB);
    LAS float* QA = (LAS float*)(F.lds + LRU_QA); LAS float* CAR = (LAS float*)(F.lds + LRU_CAR); LAS bf16* XR = (LAS bf16*)(F.lds + LRU_XR);
    const int t0 = 64 * c, ch0 = GD * g; const bf16* LX = WSP(bf16, WS_LX);
    for (int p = F.tid; p < 67 * 16; p += NTHREADS) { const int r = p >> 4, cc = p & 15, tg = t0 - 3 + r; v4u v = {0u, 0u, 0u, 0u};
        if (tg >= 0) v = *(const GAS v4u*)(LX + (size_t)tg * LW + ch0 + cc * 8);
        *(LAS v4u*)(XR + r * 128 + cc * 8) = v; }
    __syncthreads();
    { const int ch = F.tid & 127, tq = F.tid >> 7, gch = ch0 + ch;
      const float w0 = args.in[10][gch], w1 = args.in[10][LW + gch], w2 = args.in[10][2 * LW + gch], w3 = args.in[10][3 * LW + gch], cb = args.in[11][gch];
      float xm3 = bf2f(XR[(16 * tq + 0) * 128 + ch]), xm2 = bf2f(XR[(16 * tq + 1) * 128 + ch]), xm1 = bf2f(XR[(16 * tq + 2) * 128 + ch]);
#pragma unroll
      for (int i = 0; i < 16; ++i) { const int t = 16 * tq + i; const float x0 = bf2f(XR[(t + 3) * 128 + ch]);
          const float xc = w0 * xm3 + w1 * xm2 + w2 * xm1 + w3 * x0 + cb; xm3 = xm2; xm2 = xm1; xm1 = x0;
          XCF[t * 128 + ch] = xc; *(LAS bf16*)(XCB + t * 256 + ((ch * 2) ^ ((t & 7) << 4))) = (bf16)f2bf(xc); } }
    __syncthreads();
    { const int fr = F.lane & 15, fq = F.lane >> 4, j = 16 * F.wave + fr;
      const bf16* WA = WSP(bf16, WS_WAT) + (size_t)g * GD * GD + (size_t)j * GD + 8 * fq; const bf16* WX = WSP(bf16, WS_WXT) + (size_t)g * GD * GD + (size_t)j * GD + 8 * fq;
      bf16x8 ba[4], bx[4];
#pragma unroll
      for (int ks = 0; ks < 4; ++ks) { ba[ks] = *(const GAS bf16x8*)(WA + 32 * ks); bx[ks] = *(const GAS bf16x8*)(WX + 32 * ks); }
      const int gch = ch0 + j; const float bav = args.in[13][gch], bxv = args.in[15][gch], lam = args.in[16][gch];
      const float sp8 = -8.0f * 1.4426950408889634f * ((lam > 0.f ? 0.f : -lam) + log1pf(__expf(-fabsf(lam))));
#pragma unroll
      for (int mt = 0; mt < 4; ++mt) { f32x4 ar = {0.f, 0.f, 0.f, 0.f}, ax = {0.f, 0.f, 0.f, 0.f}; const int t = 16 * mt + fr;
#pragma unroll
          for (int ks = 0; ks < 4; ++ks) { const bf16x8 af = *(const LAS bf16x8*)(XCB + t * 256 + (((32 * ks + 8 * fq) * 2) ^ ((t & 7) << 4)));
              ar = __builtin_amdgcn_mfma_f32_16x16x32_bf16(af, ba[ks], ar, 0, 0, 0); ax = __builtin_amdgcn_mfma_f32_16x16x32_bf16(af, bx[ks], ax, 0, 0, 0); }
#pragma unroll
          for (int rg = 0; rg < 4; ++rg) { const int tt = 16 * mt + 4 * fq + rg; const float xcv = XCF[tt * 128 + j];
              const float rgt = sigmoidf_(ar[rg] + bav), igt = sigmoidf_(ax[rg] + bxv);
              const float a = __builtin_amdgcn_exp2f(rgt * sp8); const float om = fmaxf((1.0f - a) * (1.0f + a), 0.f);
              const float b = __builtin_amdgcn_sqrtf(om) * (igt * xcv);
              AB[tt * 128 + j] = a; BB[tt * 128 + j] = b; } } }
    __syncthreads();
    const int ch = F.tid & 127, q = F.tid >> 7;
    { float A = 1.f, B = 0.f;
#pragma unroll
      for (int i = 0; i < 16; ++i) { const int t = 16 * q + i; const float a = AB[t * 128 + ch]; B = a * B + BB[t * 128 + ch]; A *= a; }
      QA[(q * 128 + ch) * 2] = A; QA[(q * 128 + ch) * 2 + 1] = B; }
    __syncthreads();
    if (PASS == 0) {
        if (F.tid < 128) { float A = 1.f, B = 0.f;
#pragma unroll
            for (int qq = 0; qq < 4; ++qq) { const float a = QA[(qq * 128 + F.tid) * 2], b = QA[(qq * 128 + F.tid) * 2 + 1]; B = a * B + b; A *= a; }
            WSP(float, WS_AGGA)[(size_t)c * LW + ch0 + F.tid] = A; WSP(float, WS_AGGB)[(size_t)c * LW + ch0 + F.tid] = B; }
    } else {
        float h = CAR[ch];
        for (int qq = 0; qq < q; ++qq) h = QA[(qq * 128 + ch) * 2] * h + QA[(qq * 128 + ch) * 2 + 1];
#pragma unroll
        for (int i = 0; i < 16; ++i) { const int t = 16 * q + i; h = AB[t * 128 + ch] * h + BB[t * 128 + ch]; XCF[t * 128 + ch] = h; }
        __syncthreads();
        if (F.tid < 128) { float hc = CAR[F.tid];
#pragma unroll
            for (int qq = 0; qq < 4; ++qq) hc = QA[(qq * 128 + F.tid) * 2] * hc + QA[(qq * 128 + F.tid) * 2 + 1];
            CAR[F.tid] = hc; }
        const bf16* GY = WSP(bf16, WS_GY); bf16* LR = WSP(bf16, WS_LR);
        for (int p = F.tid; p < 64 * 16; p += NTHREADS) { const int r = p >> 4, cc = p & 15; const size_t o = (size_t)(t0 + r) * LW + ch0 + cc * 8;
            const v4u gy = *(const GAS v4u*)(GY + o); const f32x4 h0 = *(const LAS f32x4*)(XCF + r * 128 + cc * 8), h1 = *(const LAS f32x4*)(XCF + r * 128 + cc * 8 + 4);
            v4u ov; ov.x = pk2(h0[0] * bflo(gy.x), h0[1] * bfhi(gy.x)); ov.y = pk2(h0[2] * bflo(gy.y), h0[3] * bfhi(gy.y)); ov.z = pk2(h1[0] * bflo(gy.z), h1[1] * bfhi(gy.z)); ov.w = pk2(h1[2] * bflo(gy.w), h1[3] * bfhi(gy.w));
            *(GAS v4u*)(LR + o) = ov; }
    }
    __syncthreads();
}
template <int PASS> __device__ __forceinline__ void lru_item(Frame& F, const Args& args, int w) {
    const int g = w & 15, c0 = (w >> 4) * 8; LAS float* CAR = (LAS float*)(F.lds + LRU_CAR); LAS float* QA = (LAS float*)(F.lds + LRU_QA);
    if (PASS == 1) {
        const int ch = F.tid & 127, q = F.tid >> 7, n = c0 / 4;
        const float* GA_ = WSP(float, WS_AGGA) + GD * g + ch; const float* GB_ = WSP(float, WS_AGGB) + GD * g + ch; float A = 1.f, B = 0.f;
#pragma unroll 4
        for (int cc = q * n; cc < (q + 1) * n; ++cc) { const float a = GA_[(size_t)cc * LW], b = GB_[(size_t)cc * LW]; B = a * B + b; A *= a; }
        QA[(q * 128 + ch) * 2] = A; QA[(q * 128 + ch) * 2 + 1] = B;
        __syncthreads();
        if (F.tid < 128) { float hc = 0.f;
#pragma unroll
            for (int qq = 0; qq < 4; ++qq) hc = QA[(qq * 128 + F.tid) * 2] * hc + QA[(qq * 128 + F.tid) * 2 + 1];
            CAR[F.tid] = hc; }
        __syncthreads();
    }
    for (int c = c0; c < c0 + 8; ++c) lru_chunk<PASS>(F, args, c, g);
}
constexpr int ATT_BIAS_OFF = attn_body::LDS_BYTES;
typedef attn_body::BlockRef<bf16, bf16> ARef;
__device__ __forceinline__ int attn_jlo(const float* Fh, int qb, float TH, int lane) {
    const int t0 = qb * 256; const float f0 = Fh[t0];
    const int j0 = lane, j1 = lane + 64;
    const bool ok0 = (64 * j0 + 63 >= t0) || (f0 - Fh[64 * j0 + 63] >= -TH), ok1 = (64 * j1 + 63 >= t0) || (f0 - Fh[64 * j1 + 63] >= -TH);
    const unsigned long long m0 = __ballot(ok0), m1 = __ballot(ok1);
    return m0 ? (int)__builtin_ctzll(m0) : 64 + (int)__builtin_ctzll(m1);
}
__device__ __forceinline__ ARef attn_ref(Frame& F, const Args& args, int h, int qb, int jlo) {
    ARef r; const bf16* QK = WSP(bf16, WS_QKV);
    r.Q = QK + (size_t)(qb * 256) * AW + h * HD; r.K = QK + (size_t)S * AW + h * HD; r.V = QK + 2 * (size_t)S * AW + h * HD;
    r.O = WSP(bf16, WS_ATT) + (size_t)(qb * 256) * AW + h * HD; r.P0 = qb * 256; r.jlo = jlo; return r;
}
__device__ __forceinline__ void attn_fill_bias(Frame& F, const Args& args, int h, int qb, int jlo) {
    const float* Fh = WSP(float, WS_FC) + (size_t)h * S; LAS float* bl = (LAS float*)(F.lds + ATT_BIAS_OFF);
    const int k0 = jlo * 64, n = (qb + 1) * 256 - k0; const float fr = Fh[k0];
#pragma unroll 1
    for (int i = F.tid; i < n; i += NTHREADS) bl[i] = (fr - Fh[k0 + i]) * (1.0f / attn_body::SCALE);
}
#ifndef ATT_MARGIN
#define ATT_MARGIN 25.0f
#endif
constexpr int ATT_SCHED_OFF = 104448;
__device__ __forceinline__ void p4_attention(Frame& F, const Args& args, char* lds_generic, int rep) {
    float gq = fmaxf(fabsf(args.in[8][F.lane]), fabsf(args.in[8][F.lane + 64])), gk = fmaxf(fabsf(args.in[9][F.lane]), fabsf(args.in[9][F.lane + 64]));
    gq = wave_max(gq); gk = wave_max(gk);
    const float TH = 2.0f * (128.0f * gq * gk * attn_body::SCALE) + ATT_MARGIN;
    LAS float* Fend = (LAS float*)(F.lds + ATT_SCHED_OFF); LAS int* cost = (LAS int*)(F.lds + ATT_SCHED_OFF + 8192); LAS int* jlo_t = cost + 512; LAS int* order = cost + 1024; LAS int* slot = cost + 1536;
    const float* Fc = WSP(float, WS_FC);
    for (int p = F.tid; p < NH * 128; p += NTHREADS) Fend[p] = Fc[(size_t)(p >> 7) * S + 64 * (p & 127) + 63];
    __syncthreads();
    { const int u = F.tid, h = u >> 5, qb = u & 31, t0 = qb * 256; const float f0 = Fc[(size_t)h * S + t0];
      int lo = 0, hi = 4 * qb;
      while (lo < hi) { const int mid = (lo + hi) >> 1; const bool ok = (64 * mid + 63 >= t0) || (f0 - Fend[h * 128 + mid] >= -TH); if (ok) hi = mid; else lo = mid + 1; }
      jlo_t[u] = lo; cost[u] = 4 * (qb + 1) - lo; }
    __syncthreads();
    { const int u = F.tid, cu = cost[u]; int rk = 0;
      for (int v = 0; v < 512; ++v) { const int cv = cost[v]; rk += (cv > cu || (cv == cu && v < u)) ? 1 : 0; }
      order[rk] = u; }
    __syncthreads();
    for (;;) {
        if (F.tid == 0) slot[0] = (int)__hip_atomic_fetch_add((unsigned*)(F.ctl + CW_QATT + 64 * rep), 1u, RLX_AGENT);
        __syncthreads();
        const int k = slot[0];
        __syncthreads();
        if (k >= 512) break;
        const int u = order[k], h = u >> 5, qb = u & 31, jl = jlo_t[u];
        const ARef r0 = attn_ref(F, args, h, qb, jl);
        attn_fill_bias(F, args, h, qb, jl); __syncthreads();
        attn_body::attn_unit<bf16, bf16>(r0, S, lds_generic);
    }
}

__device__ __forceinline__ void p7_norm2(Frame& F, const Args& args) {
    const int gw = F.vcu * NWAVES + F.wave, NGW = F.G * NWAVES; const float* MOD = WSP(float, WS_MOD); bf16* HA = WSP(bf16, WS_HA);
    for (int m = gw; m < S; m += NGW) {
        const GAS f32x4* xr = (const GAS f32x4*)(WSP(float, WS_X1) + (size_t)m * DM) + F.lane; f32x4 v[16]; float ss = 0.f;
#pragma unroll
        for (int j = 0; j < 16; ++j) { v[j] = xr[64 * j]; ss += (v[j][0] * v[j][0] + v[j][1] * v[j][1]) + (v[j][2] * v[j][2] + v[j][3] * v[j][3]); }
        const float rstd = 1.0f / sqrtf(wave_sum(ss) * (1.0f / DM) + EPS);
#pragma unroll
        for (int j = 0; j < 16; ++j) { const int i4 = F.lane + 64 * j;
            const f32x4 g = ((const GAS f32x4*)args.in[5])[i4], scl = ((const GAS f32x4*)(MOD + 16384))[i4], sh = ((const GAS f32x4*)(MOD + 12288))[i4];
            const f32x4 hv = v[j] * rstd * (g * (scl + 1.0f)) + sh;
            v2u o; o.x = pk2(hv[0], hv[1]); o.y = pk2(hv[2], hv[3]); ((GAS v2u*)(HA + (size_t)m * DM))[i4] = o; }
    }
}

template <int CTRL> __device__ __forceinline__ unsigned dppu(unsigned x) { return (unsigned)__builtin_amdgcn_update_dpp(0, (int)x, CTRL, 0xF, 0xF, true); }
__device__ __forceinline__ unsigned rowmax_u32(unsigned x) { x = max(x, dppu<0xB1>(x)); x = max(x, dppu<0x4E>(x)); x = max(x, dppu<0x141>(x)); x = max(x, dppu<0x140>(x)); return x; }
__device__ __forceinline__ float rowsum_f32(float x) { x += __uint_as_float(dppu<0xB1>(__float_as_uint(x))); x += __uint_as_float(dppu<0x4E>(__float_as_uint(x)));
    x += __uint_as_float(dppu<0x141>(__float_as_uint(x))); x += __uint_as_float(dppu<0x140>(__float_as_uint(x))); return x; }
__device__ __forceinline__ unsigned ordk(float f) { const unsigned u = __float_as_uint(f); return u ^ ((unsigned)((int)u >> 31) | 0x80000000u); }
__device__ __forceinline__ float deck(unsigned k) { return __uint_as_float((k & 0x80000000u) ? (k ^ 0x80000000u) : ~k); }
#define CE_(x, y) do { const unsigned hi_ = max(x, y), lo_ = min(x, y); x = hi_; y = lo_; } while (0)
__device__ __forceinline__ unsigned row_pop16(unsigned (&a)[8], int i) {
    unsigned res = 0u;
#pragma unroll
    for (int r = 0; r < 16; ++r) { const unsigned m = rowmax_u32(a[0]); const bool win = a[0] == m;
#pragma unroll
        for (int s = 0; s < 7; ++s) a[s] = win ? a[s + 1] : a[s];
        a[7] = win ? 0u : a[7]; res = (i == r) ? m : res; }
    return res;
}
__device__ __forceinline__ void p9_topk(Frame& F, const Args& args) {
    const bf16* Q2 = WSP(bf16, WS_Q2); const bf16* SK = WSP(bf16, WS_SK); int* IDX = WSP(int, WS_IDX); float* GATE = WSP(float, WS_GATE);
    const int i = F.lane & 15, q = F.lane >> 4;
    const unsigned qlo = (unsigned)(i * 2048 + 8 * q) * 2u;
    const int h = (int)blockIdx.x & 7, ib = (int)blockIdx.x >> 3, nbh = ((int)F.G - h + 7) >> 3;
    for (int c = F.tid; c < 4096; c += NTHREADS) { const int pp = c >> 11, n = (c >> 4) & 127, ch = c & 15;
        *(LAS v4u*)(F.lds + pp * 32768 + n * 256 + ((ch * 16) ^ ((n & 7) << 4))) = *(const GAS v4u*)(SK + ((size_t)((h * 2 + pp) * 128 + n)) * 128 + ch * 8); }
    __syncthreads();
#pragma unroll 1
    for (int tg = ib * NWAVES + F.wave; tg < S / 16; tg += nbh * NWAVES) {
        const int t0 = 16 * tg;
        unsigned R[2][4];
        bf16x8 af[2][4];
#pragma unroll
        for (int p = 0; p < 2; ++p) { const char* qb_ = (const char*)Q2 + ((size_t)t0 * 2048 + h * 256 + p * 128) * 2;
#pragma unroll
            for (int ks = 0; ks < 4; ++ks) af[p][ks] = *(const GAS bf16x8*)(qb_ + 64 * ks + qlo); }
#pragma unroll
        for (int p = 0; p < 2; ++p) {
            f32x4 acc[8];
#pragma unroll
            for (int nt = 0; nt < 8; ++nt) { acc[nt] = (f32x4){0.f, 0.f, 0.f, 0.f}; const int n = 16 * nt + i;
#pragma unroll
                for (int ks = 0; ks < 4; ++ks) { const bf16x8 b = *(const LAS bf16x8*)(F.lds + p * 32768 + n * 256 + ((64 * ks + 16 * q) ^ ((n & 7) << 4)));
                    acc[nt] = __builtin_amdgcn_mfma_f32_16x16x32_bf16(af[p][ks], b, acc[nt], 0, 0, 0); } }
#pragma unroll
            for (int r = 0; r < 4; ++r) { unsigned a[8];
#pragma unroll
                for (int nt = 0; nt < 8; ++nt) a[nt] = (ordk(acc[nt][r]) & ~0x7Fu) | (unsigned)(16 * nt + i);
                CE_(a[0], a[1]); CE_(a[2], a[3]); CE_(a[4], a[5]); CE_(a[6], a[7]); CE_(a[0], a[2]); CE_(a[1], a[3]); CE_(a[4], a[6]); CE_(a[5], a[7]); CE_(a[1], a[2]); CE_(a[5], a[6]);
                CE_(a[0], a[4]); CE_(a[1], a[5]); CE_(a[2], a[6]); CE_(a[3], a[7]); CE_(a[2], a[4]); CE_(a[3], a[5]); CE_(a[1], a[2]); CE_(a[3], a[4]); CE_(a[5], a[6]);
                R[p][r] = row_pop16(a, i); __builtin_amdgcn_sched_barrier(0); }
        }
#pragma unroll
        for (int r = 0; r < 4; ++r) {
            const unsigned R0 = R[0][r], R1 = R[1][r]; const float f0 = deck(R0 & ~0x7Fu), f1 = deck(R1 & ~0x7Fu); const int n0 = (int)(R0 & 0x7Fu), n1 = (int)(R1 & 0x7Fu);
            const unsigned f1u = __float_as_uint(f1); unsigned c[8];
#define CAND_(b, lim) do { const unsigned t_ = (ordk(f0 + __uint_as_float(dppu<0x150 + (b)>(f1u))) & ~0xFFu) | (unsigned)(255 - (i * 16 + (b))); c[b] = (i < (lim)) ? t_ : 0u; } while (0)
            CAND_(0, 16); CAND_(1, 8); CAND_(2, 5); CAND_(3, 4); CAND_(4, 3); CAND_(5, 2); CAND_(6, 2); CAND_(7, 2);
#undef CAND_
            { const float ex = __uint_as_float(dppu<0x150>(__float_as_uint(f0))) + f1; const unsigned exk = (ordk(ex) & ~0xFFu) | (unsigned)(255 - i); c[1] = (i >= 8) ? exk : c[1]; }
            CE_(c[0], c[1]);
            const unsigned G = row_pop16(c, i);
            const float val = deck(G & ~0xFFu); const int id = 255 - (int)(G & 0xFFu); const int rb = F.lane & 48;
            const int ea = __shfl(n0, rb + (id >> 4)), eb = __shfl(n1, rb + (id & 15));
            const float mx = __uint_as_float(dppu<0x150>(__float_as_uint(val))); const float ex = __expf(val - mx); const float sm = rowsum_f32(ex);
            const size_t o = (size_t)(t0 + 4 * q + r) * 128 + h * 16 + i; IDX[o] = ea * 128 + eb; GATE[o] = ex / sm; __builtin_amdgcn_sched_barrier(0);
        }
    }
}
#undef CE_

constexpr float U_SCALE = 256.0f, V_SCALE = 1.0f;
#ifndef PEER_SORT
#define PEER_SORT 0
#endif
__device__ __forceinline__ float gelu_as(float v) {
    const float av = fabsf(v), tt = __builtin_amdgcn_rcpf(av * 0.2316418882f + 1.0f);
    float q = tt * 0.5307027145f + (-0.7265760135f); q = q * tt + 0.7107068705f; q = q * tt + (-0.142248368f); q = q * tt + 0.127414796f; q = q * tt;
    const float m = v * (q * __builtin_amdgcn_exp2f((v * v) * (-0.72134752044f)));
    return v < 0.f ? m : v - m;
}
#ifndef PEER_UMFMA
#define PEER_UMFMA 1
#endif
#ifndef HYP_A
#define HYP_A 1
#endif
#ifndef HYP_B
#define HYP_B 0
#endif
#ifndef PEER_VMFMA
#define PEER_VMFMA 1
#endif
typedef int v8i __attribute__((ext_vector_type(8)));
typedef int v2i __attribute__((ext_vector_type(2)));
typedef float f32x16 __attribute__((ext_vector_type(16)));
__device__ __forceinline__ float wave_sum_dpp(float x) {
    x = rowsum_f32(x);
    return (__uint_as_float(__builtin_amdgcn_readlane(__float_as_uint(x), 0)) + __uint_as_float(__builtin_amdgcn_readlane(__float_as_uint(x), 16)))
         + (__uint_as_float(__builtin_amdgcn_readlane(__float_as_uint(x), 32)) + __uint_as_float(__builtin_amdgcn_readlane(__float_as_uint(x), 48)));
}
#define LOADROWS(T, ra_, rb_, ee) do { const int e2_ = (ee) & 127; const int ea_ = __builtin_amdgcn_readlane(e2_ < 64 ? id0 : id1, e2_ & 63), eb_ = __builtin_amdgcn_readlane(e2_ < 64 ? id0 : id1, (e2_ + 1) & 63); \
        const GAS v4u* pa_ = (const GAS v4u*)((T) + (size_t)ea_ * DM) + F.lane; const GAS v4u* pb_ = (const GAS v4u*)((T) + (size_t)eb_ * DM) + F.lane; \
        _Pragma("unroll") for (int c = 0; c < 4; ++c) { ra_[c] = pa_[64 * c]; rb_[c] = pb_[64 * c]; } } while (0)
#define UDOT(r_, out_) do { f32x2 s0_ = {0.f, 0.f}, s1_ = {0.f, 0.f}, s2_ = {0.f, 0.f}, s3_ = {0.f, 0.f}; \
        _Pragma("unroll") for (int c = 0; c < 4; ++c) _Pragma("unroll") for (int d = 0; d < 2; ++d) { \
            const f32x2 p0_ = __builtin_amdgcn_cvt_scalef32_pk_f32_fp4(r_[c][d], 1.0f, 0), p1_ = __builtin_amdgcn_cvt_scalef32_pk_f32_fp4(r_[c][d], 1.0f, 1), \
                        p2_ = __builtin_amdgcn_cvt_scalef32_pk_f32_fp4(r_[c][d], 1.0f, 2), p3_ = __builtin_amdgcn_cvt_scalef32_pk_f32_fp4(r_[c][d], 1.0f, 3); \
            s0_ = p0_ * hx[8 * c + 4 * d] + s0_; s1_ = p1_ * hx[8 * c + 4 * d + 1] + s1_; s2_ = p2_ * hx[8 * c + 4 * d + 2] + s2_; s3_ = p3_ * hx[8 * c + 4 * d + 3] + s3_; } \
        out_ = ((s0_.x + s0_.y) + (s1_.x + s1_.y)) + ((s2_.x + s2_.y) + (s3_.x + s3_.y)); } while (0)
#define UPAIR(ra_, rb_, ee) do { float sa_, sb_; UDOT(ra_, sa_); UDOT(rb_, sb_); sa_ = wave_sum_dpp(sa_); sb_ = wave_sum_dpp(sb_); \
        const int e2_ = (ee); const int ea_ = __builtin_amdgcn_readlane(e2_ < 64 ? id0 : id1, e2_ & 63), eb_ = __builtin_amdgcn_readlane(e2_ < 64 ? id0 : id1, (e2_ + 1) & 63); \
        const f32x2 a2_ = pg8::gelu_pk((f32x2){sa_ * RSU[ea_], sb_ * RSU[eb_]}); \
        if ((ee) < 64) { if (F.lane == (ee)) w0 = a2_.x * g0; if (F.lane == (ee) + 1) w0 = a2_.y * g0; } else { if (F.lane == (ee) - 64) w1 = a2_.x * g1; if (F.lane == (ee) - 63) w1 = a2_.y * g1; } } while (0)
#define LOADROWS4(T, ra_, rb_, ee) do { const int e2_ = (ee) & 127; const int ea_ = __builtin_amdgcn_readlane(e2_ < 64 ? id0 : id1, e2_ & 63), eb_ = __builtin_amdgcn_readlane(e2_ < 64 ? id0 : id1, (e2_ + 1) & 63); \
        const GAS v2u* pa_ = (const GAS v2u*)((T) + (size_t)ea_ * 2048) + F.lane; const GAS v2u* pb_ = (const GAS v2u*)((T) + (size_t)eb_ * 2048) + F.lane; \
        _Pragma("unroll") for (int c = 0; c < 4; ++c) { ra_[c] = pa_[64 * c]; rb_[c] = pb_[64 * c]; } } while (0)
#define VAXPY(r_, w_) do { const f32x2 w2_ = {w_, w_}; \
        _Pragma("unroll") for (int c = 0; c < 4; ++c) _Pragma("unroll") for (int d = 0; d < 2; ++d) { \
            const f32x2 p0_ = __builtin_amdgcn_cvt_scalef32_pk_f32_fp4(r_[c][d], 1.0f, 0), p1_ = __builtin_amdgcn_cvt_scalef32_pk_f32_fp4(r_[c][d], 1.0f, 1), \
                        p2_ = __builtin_amdgcn_cvt_scalef32_pk_f32_fp4(r_[c][d], 1.0f, 2), p3_ = __builtin_amdgcn_cvt_scalef32_pk_f32_fp4(r_[c][d], 1.0f, 3); \
            acc[8 * c + 4 * d] = p0_ * w2_ + acc[8 * c + 4 * d]; acc[8 * c + 4 * d + 1] = p1_ * w2_ + acc[8 * c + 4 * d + 1]; \
            acc[8 * c + 4 * d + 2] = p2_ * w2_ + acc[8 * c + 4 * d + 2]; acc[8 * c + 4 * d + 3] = p3_ * w2_ + acc[8 * c + 4 * d + 3]; } } while (0)
#define VPAIR(ra_, rb_, ee) do { const int e2_ = (ee); const int ea_ = __builtin_amdgcn_readlane(e2_ < 64 ? id0 : id1, e2_ & 63), eb_ = __builtin_amdgcn_readlane(e2_ < 64 ? id0 : id1, (e2_ + 1) & 63); \
        const float wa_ = __uint_as_float(__builtin_amdgcn_readlane(__float_as_uint((ee) < 64 ? w0 : w1), (ee) & 63)) * RS[ea_], wb_ = __uint_as_float(__builtin_amdgcn_readlane(__float_as_uint((ee) < 64 ? w0 : w1), ((ee) + 1) & 63)) * RS[eb_]; \
        VAXPY(ra_, wa_); VAXPY(rb_, wb_); } while (0)
template <int MODE> __device__ __forceinline__ void p10_peer(Frame& F, const Args& args) {
    const int gw = F.vcu * NWAVES + F.wave, NGW = F.G * NWAVES; const float* MOD = WSP(float, WS_MOD);
    const bf16* H2 = WSP(bf16, WS_HA); const unsigned char* U = WSP(unsigned char, WS_U); const unsigned char* V = WSP(unsigned char, WS_V); const int* IDX = WSP(int, WS_IDX); const float* GATE = WSP(float, WS_GATE); const float* RS = WSP(float, WS_RS); const float* RSU = WSP(float, WS_RSU);
#if PEER_UMFMA
    if (F.lane < 8) *(LAS v4u*)(F.lds + F.wave * 13440 + 4096 + F.lane * 16) = (v4u){0u, 0u, 0u, 0u};
#endif
#pragma unroll 1
    for (int t = gw; t < S; t += NGW) {
        const int id0 = IDX[(size_t)t * 128 + F.lane], id1 = IDX[(size_t)t * 128 + 64 + F.lane];
        const float g0 = GATE[(size_t)t * 128 + F.lane], g1 = GATE[(size_t)t * 128 + 64 + F.lane];
        float w0 = 0.f, w1 = 0.f;
#if PEER_UMFMA
        if (MODE != 2) {
            LAS unsigned char* h8 = F.lds + F.wave * 13440; LAS unsigned char* stg = h8 + 4224;
#pragma unroll
            for (int c = 0; c < 4; ++c) { const GAS v4u* hp = (const GAS v4u*)(H2 + (size_t)t * DM + c * 1024 + F.lane * 16); const v4u a = hp[0], b = hp[1]; v4u o;
                { int w = 0; w = __builtin_amdgcn_cvt_pk_fp8_f32(bflo(a[0]), bfhi(a[0]), w, false); w = __builtin_amdgcn_cvt_pk_fp8_f32(bflo(a[1]), bfhi(a[1]), w, true); o[0] = (unsigned)w; }
                { int w = 0; w = __builtin_amdgcn_cvt_pk_fp8_f32(bflo(a[2]), bfhi(a[2]), w, false); w = __builtin_amdgcn_cvt_pk_fp8_f32(bflo(a[3]), bfhi(a[3]), w, true); o[1] = (unsigned)w; }
                { int w = 0; w = __builtin_amdgcn_cvt_pk_fp8_f32(bflo(b[0]), bfhi(b[0]), w, false); w = __builtin_amdgcn_cvt_pk_fp8_f32(bflo(b[1]), bfhi(b[1]), w, true); o[2] = (unsigned)w; }
                { int w = 0; w = __builtin_amdgcn_cvt_pk_fp8_f32(bflo(b[2]), bfhi(b[2]), w, false); w = __builtin_amdgcn_cvt_pk_fp8_f32(bflo(b[3]), bfhi(b[3]), w, true); o[3] = (unsigned)w; }
                *(LAS v4u*)(h8 + c * 1024 + F.lane * 16) = o; }
            const int j = F.lane & 31, kh = F.lane >> 5, lr = F.lane >> 3, lp = F.lane & 7;
            unsigned so[4][4];
#pragma unroll
            for (int b = 0; b < 4; ++b)
#pragma unroll
                for (int i = 0; i < 4; ++i) so[b][i] = (unsigned)__shfl(b < 2 ? id0 : id1, 32 * (b & 1) + lr + 8 * i) * 2048u + (unsigned)lp * 16u;
            int eb[4];
#pragma unroll
            for (int b = 0; b < 4; ++b) eb[b] = __shfl(b < 2 ? id0 : id1, j + 32 * (b & 1));
            const unsigned aoff0 = (j == 0) ? (unsigned)(16 * kh) : 4096u, aoff1 = (j == 0) ? (unsigned)(32 + 16 * kh) : 4112u, astep = (j == 0) ? 64u : 0u;
            const unsigned wof = (unsigned)lr * 144u + (unsigned)lp * 16u, rof = (unsigned)j * 144u + (unsigned)kh * 16u;
            f32x16 ac[4];
#pragma unroll
            for (int b = 0; b < 4; ++b) ac[b] = (f32x16){};
            v4u R0[8], R1[8];
#define ULOAD(R_, kg_, bp_) do { _Pragma("unroll") for (int bb = 0; bb < 2; ++bb) _Pragma("unroll") for (int i = 0; i < 4; ++i) \
                R_[4 * bb + i] = *(const GAS v4u*)(U + (size_t)so[2 * (bp_) + bb][i] + (size_t)(kg_) * 128); } while (0)
#define USTAGE(R_, bp_) do { _Pragma("unroll") for (int bb = 0; bb < 2; ++bb) _Pragma("unroll") for (int i = 0; i < 4; ++i) *(LAS v4u*)(stg + bb * 4608 + i * 1152 + wof) = R_[4 * bb + i]; \
            _Pragma("unroll") for (int bb = 0; bb < 2; ++bb) { v4u B_[4]; _Pragma("unroll") for (int kk = 0; kk < 4; ++kk) B_[kk] = *(const LAS v4u*)(stg + bb * 4608 + rof + kk * 32); \
                _Pragma("unroll") for (int kk = 0; kk < 4; ++kk) ac[2 * (bp_) + bb] = __builtin_amdgcn_mfma_scale_f32_32x32x64_f8f6f4(A[kk], (v8i){(int)B_[kk][0], (int)B_[kk][1], (int)B_[kk][2], (int)B_[kk][3], 0, 0, 0, 0}, ac[2 * (bp_) + bb], 0, 4, 0, 0x7f7f7f7f, 0, 0x7f7f7f7f); } } while (0)
            ULOAD(R0, 0, 0);
#pragma unroll 1
            for (int kg = 0; kg < 16; ++kg) {
                v8i A[4];
#pragma unroll
                for (int kk = 0; kk < 4; ++kk) { const unsigned kb = (unsigned)(4 * kg + kk); const v4u x = *(const LAS v4u*)(h8 + aoff0 + kb * astep), y = *(const LAS v4u*)(h8 + aoff1 + kb * astep);
                    A[kk] = (v8i){(int)x[0], (int)x[1], (int)x[2], (int)x[3], (int)y[0], (int)y[1], (int)y[2], (int)y[3]}; }
                ULOAD(R1, kg, 1);
                USTAGE(R0, 0);
                ULOAD(R0, (kg + 1) & 15, 0);
                USTAGE(R1, 1);
            }
#undef ULOAD
#undef USTAGE
#pragma unroll
            for (int b = 0; b < 4; ++b) {
                const float av = pg8::gelu_pk((f32x2){ac[b][0] * RSU[eb[b]], 0.f}).x;
                const float gg = __shfl(b < 2 ? g0 : g1, j + 32 * (b & 1)); const float wv = av * gg;
                if ((b & 1) == 0) { if (b == 0) w0 = F.lane < 32 ? wv : w0; else w1 = F.lane < 32 ? wv : w1; }
                else { const float mv = __shfl(wv, j); if (b == 1) w0 = F.lane >= 32 ? mv : w0; else w1 = F.lane >= 32 ? mv : w1; } }
        }
#else
        {   f32x2 hx[32];
#pragma unroll
            for (int c = 0; c < 4; ++c) { const GAS v4u* hp = (const GAS v4u*)(H2 + (size_t)t * DM + c * 1024 + F.lane * 16); const v4u a = hp[0], b = hp[1];
#pragma unroll
                for (int k = 0; k < 4; ++k) { hx[8 * c + k] = (f32x2){bflo(a[k]), bfhi(a[k])}; hx[8 * c + 4 + k] = (f32x2){bflo(b[k]), bfhi(b[k])}; } }
            v2u ra[4], rb[4], rc[4], rd[4], na[4], nb[4], nc[4], nd[4];
            if (MODE != 2) {
            LOADROWS4(U, ra, rb, 0); LOADROWS4(U, rc, rd, 2);
#pragma unroll 1
            for (int e = 0; e < 128; e += 8) {
                LOADROWS4(U, na, nb, e + 4); LOADROWS4(U, nc, nd, e + 6);
                UPAIR(ra, rb, e); UPAIR(rc, rd, e + 2);
                LOADROWS4(U, ra, rb, e + 8); LOADROWS4(U, rc, rd, e + 10);
                UPAIR(na, nb, e + 4); UPAIR(nc, nd, e + 6);
            } } }
#endif
        if (MODE == 1 || MODE == 3) { asm volatile("" :: "v"(w0), "v"(w1)); continue; }
#if PEER_VMFMA
        {
            LAS unsigned char* wreg = F.lds + F.wave * 13440; LAS unsigned char* w8 = wreg; LAS unsigned char* stg = wreg + 256;
            const int j = F.lane & 31, kh = F.lane >> 5;
            { const float q0 = w0 * RS[id0] * 16.0f, q1 = w1 * RS[id1] * 16.0f;
              const int b0 = __builtin_amdgcn_cvt_pk_fp8_f32(q0, q0, 0, false), b1 = __builtin_amdgcn_cvt_pk_fp8_f32(q1, q1, 0, false);
              w8[F.lane] = (unsigned char)(b0 & 0xff); w8[64 + F.lane] = (unsigned char)(b1 & 0xff); if (F.lane < 8) *(LAS v2u*)(w8 + 128 + 8 * F.lane) = (v2u){0u, 0u}; }
            v8i A[2];
#pragma unroll
            for (int kb = 0; kb < 2; ++kb) { const unsigned o0 = (j == 0) ? (unsigned)(64 * kb + 16 * kh) : 128u, o1 = (j == 0) ? (unsigned)(64 * kb + 32 + 16 * kh) : 144u;
                const v4u x = *(const LAS v4u*)(w8 + o0), y = *(const LAS v4u*)(w8 + o1);
                A[kb] = (v8i){(int)x[0], (int)x[1], (int)x[2], (int)x[3], (int)y[0], (int)y[1], (int)y[2], (int)y[3]}; }
            const int lr = F.lane >> 2, lp = F.lane & 3;
            unsigned so[8];
#pragma unroll
            for (int i = 0; i < 8; ++i) so[i] = (unsigned)__shfl(i < 4 ? id0 : id1, (16 * i + lr) & 63) * 2048u + (unsigned)lp * 16u;
            const unsigned wof = (unsigned)lr * 80u + (unsigned)lp * 16u;
            const unsigned rof = (unsigned)(32 * kh + (F.lane & 15)) * 80u + (unsigned)(8 * ((F.lane >> 4) & 1));
            const float* X1r = WSP(float, WS_X1) + (size_t)t * DM; const float* G2 = MOD + 20480; float* Or = F.out + (size_t)t * DM;
            v4u R0[8], R1[8];
#define VLOAD(R_, cg_) do { _Pragma("unroll") for (int i = 0; i < 8; ++i) R_[i] = *(const GAS v4u*)(V + (size_t)so[i] + (size_t)(cg_) * 64); } while (0)
#define VSTAGE(R_, cg_) do { _Pragma("unroll") for (int i = 0; i < 8; ++i) *(LAS v4u*)(stg + i * 1280 + wof) = R_[i]; \
            _Pragma("unroll") for (int tt = 0; tt < 4; ++tt) { f32x16 d_ = (f32x16){}; \
                _Pragma("unroll") for (int kb = 0; kb < 2; ++kb) { \
                    const v2i q0_ = __builtin_amdgcn_ds_read_tr4_b64_v2i32((LAS v2i*)(stg + kb * 5120 + rof + tt * 16)), q1_ = __builtin_amdgcn_ds_read_tr4_b64_v2i32((LAS v2i*)(stg + kb * 5120 + 1280 + rof + tt * 16)); \
                    d_ = __builtin_amdgcn_mfma_scale_f32_32x32x64_f8f6f4(A[kb], (v8i){q0_[0], q0_[1], q1_[0], q1_[1], 0, 0, 0, 0}, d_, 0, 4, 0, 0x7b7b7b7b, 0, 0x7f7f7f7f); } \
                if (MODE == 2) { asm volatile("" :: "v"(d_[0])); } else if (F.lane < 32) { const int col = (cg_) * 128 + tt * 32 + F.lane; Or[col] = X1r[col] + G2[col] * d_[0]; } } } while (0)
            VLOAD(R0, 0);
#pragma unroll 1
            for (int cg = 0; cg < 32; cg += 2) {
                VLOAD(R1, cg + 1);
                VSTAGE(R0, cg);
                VLOAD(R0, (cg + 2) & 31);
                VSTAGE(R1, cg + 1);
            }
#undef VLOAD
#undef VSTAGE
        }
#else
        f32x2 acc[32];
#pragma unroll
        for (int j = 0; j < 32; ++j) acc[j] = (f32x2){0.f, 0.f};
        {   v2u ra[4], rb[4], rc[4], rd[4], na[4], nb[4], nc[4], nd[4];
            LOADROWS4(V, ra, rb, 0); LOADROWS4(V, rc, rd, 2);
#pragma unroll 1
            for (int e = 0; e < 128; e += 8) {
                LOADROWS4(V, na, nb, e + 4); LOADROWS4(V, nc, nd, e + 6);
                VPAIR(ra, rb, e); VPAIR(rc, rd, e + 2);
                LOADROWS4(V, ra, rb, e + 8); LOADROWS4(V, rc, rd, e + 10);
                VPAIR(na, nb, e + 4); VPAIR(nc, nd, e + 6);
            } }
        if (MODE == 2) {
#pragma unroll
            for (int j = 0; j < 32; ++j) asm volatile("" :: "v"(acc[j]));
            continue; }
#pragma unroll
        for (int c = 0; c < 4; ++c) { const int col = c * 1024 + F.lane * 16; GAS f32x4* op = (GAS f32x4*)(F.out + (size_t)t * DM + col);
            const GAS f32x4* xp = (const GAS f32x4*)(WSP(float, WS_X1) + (size_t)t * DM + col); const GAS f32x4* gp = (const GAS f32x4*)(MOD + 20480 + col);
#pragma unroll
            for (int q = 0; q < 4; ++q) op[q] = xp[q] + gp[q] * (f32x4){acc[8 * c + 2 * q].x, acc[8 * c + 2 * q].y, acc[8 * c + 2 * q + 1].x, acc[8 * c + 2 * q + 1].y}; }
#endif
    }
}
#undef LOADROWS
#undef UDOT
#undef UPAIR
#undef VAXPY
#undef VPAIR
#undef LOADROWS4
#ifndef MK_SINGLE
#define MK_SINGLE 1
#endif
constexpr int N_PHASES = 11;
__global__ void __launch_bounds__(NTHREADS, 2) fwd_kernel(Args args) {
    extern __shared__ __attribute__((aligned(16))) unsigned char lds[];
    Frame F;
    F.lds = (LAS unsigned char*)lds; F.MISC = (volatile LAS unsigned*)(F.lds + MISC_OFF);
    F.tid = threadIdx.x; F.lane = F.tid & 63; F.wave = __builtin_amdgcn_readfirstlane(F.tid >> 6);
    F.G = gridDim.x; { const int bx = blockIdx.x; F.vcu = (F.G % 8 == 0) ? (bx % 8) * (F.G / 8) + bx / 8 : bx; }
    F.ws = args.ws; F.out = args.out; F.ctl = (gu32*)(args.ws + WS_CTL);
    for (int u = F.tid; u < (LDS_BYTES - LDSCTL_OFF) / 4; u += NTHREADS) ((LAS unsigned*)(F.lds + LDSCTL_OFF))[u] = 0u;
    __syncthreads();
    const int lo = args.ph_lo, hi = args.ph_hi;
    XcdBarrier bar; bar.bar = (unsigned*)(F.ctl + CW_BAR); bar.x = 0; bar.st = nullptr;
    if (hi - lo > 1) bar = xcd_barrier_post((unsigned*)(F.ctl + CW_BAR), F.MISC + 8);
#ifndef PH_MASK
#define PH_MASK 0x7ff
#endif
#define IN(k) (((PH_MASK >> (k)) & 1) && lo <= (k) && (k) < hi)
#define SEAM(k) do { if (IN(k) && IN((k) + 1)) xcd_barrier(bar); } while (0)
#ifndef G_ALIGN
#define G_ALIGN true
#endif
#ifndef G_SP2
#define G_SP2 true
#endif
#ifndef REP_PHASE
#define REP_PHASE -1
#endif
#define REPEAT(k) _Pragma("unroll") for (int rep = 0; rep < ((REP_PHASE) == (k) ? 2 : 1); ++rep)
#define REPBAR(k) do { if ((REP_PHASE) == (k) && rep == 0) xcd_barrier(bar); } while (0)
    const int bid = (int)blockIdx.x;
    if (IN(0)) { REPEAT(0) { p0_prologue(F, args); REPBAR(0); } SEAM(0); }
    if (IN(1)) { REPEAT(1) { p1_norm_forget(F, args); REPBAR(1); } SEAM(1); }
    if (IN(2)) { REPEAT(2) {
        pg8::Gemm g{WSP(bf16, WS_HA), WSP(bf16, WS_WIN), S, NINP, DM}; pg8::StaticOrder So; So.init(S, NINP, F.G, bid);
        pg8::EpiIn E{WSP(bf16, WS_QKV), WSP(bf16, WS_LX), WSP(bf16, WS_GY), WSP(bf16, WS_GA), WSP(bf16, WS_GL), WSP(float, WS_BIASR)};
        pg8::gemm_phase<pg8::EpiIn, pg8::StaticOrder, G_ALIGN, G_SP2>(F.lds, g, So, E);
        REPBAR(2); }
        SEAM(2);
    }
    if (IN(3)) {
        p3_qknorm(F, args);
        __syncthreads();
        REPEAT(3) {
        p3_cumsum(F, args);
        for (int w = bid; w < 256; w += F.G) lru_item<0>(F, args, w);
        REPBAR(3); }
        SEAM(3);
    }
    if (IN(4)) {
#pragma unroll 1
        for (int rep = 0; rep < args.rep_att; ++rep) p4_attention(F, args, (char*)lds, rep);
#pragma unroll 1
        for (int rep = 0; rep < args.rep_lru; ++rep)
        for (int w = bid; w < 256; w += F.G) lru_item<1>(F, args, w);
        SEAM(4);
    }
    if (IN(5)) { REPEAT(5) {
        { pg8::Gemm g{WSP(bf16, WS_ATT), WSP(bf16, WS_WAO), S, DM, AW}; pg8::StaticOrder So; So.init(S, DM, F.G, bid);
          pg8::EpiGate<0> E{WSP(bf16, WS_T1), WSP(bf16, WS_GA), DM};
          pg8::gemm_phase<pg8::EpiGate<0>, pg8::StaticOrder, true, true>(F.lds, g, So, E); }
        { pg8::Gemm g{WSP(bf16, WS_LR), WSP(bf16, WS_WLO), S, DM, LW}; pg8::StaticOrder So; So.init(S, DM, F.G, bid);
          pg8::EpiGate<1> E{WSP(bf16, WS_T1), WSP(bf16, WS_GL), DM};
          pg8::gemm_phase<pg8::EpiGate<1>, pg8::StaticOrder, true, true>(F.lds, g, So, E); }
        REPBAR(5); }
        SEAM(5);
    }
    if (IN(6)) { REPEAT(6) {
        pg8::Gemm g{WSP(bf16, WS_T1), WSP(bf16, WS_WOUT), S, DM, DM}; pg8::StaticOrder So; So.init(S, DM, F.G, bid);
        pg8::EpiRes E{args.in[0], WSP(float, WS_X1), WSP(float, WS_MOD) + 8192, DM};
        pg8::gemm_phase<pg8::EpiRes, pg8::StaticOrder, true, true>(F.lds, g, So, E);
        REPBAR(6); }
        SEAM(6);
    }
    if (IN(7)) { REPEAT(7) { p7_norm2(F, args); REPBAR(7); } SEAM(7); }
    if (IN(8)) { REPEAT(8) {
        pg8::Gemm g{WSP(bf16, WS_HA), WSP(bf16, WS_WPQ), S, 2048, DM}; pg8::StaticOrder So; So.init(S, 2048, F.G, bid);
        pg8::EpiBf16<0> E{WSP(bf16, WS_Q2), 2048, nullptr, 0, 0, 1.f};
        pg8::gemm_phase<pg8::EpiBf16<0>, pg8::StaticOrder, true, true>(F.lds, g, So, E);
        REPBAR(8); }
        SEAM(8);
    }
    if (IN(9)) { REPEAT(9) { p9_topk(F, args); REPBAR(9); } SEAM(9); }
#ifndef P10_PROBE
#define P10_PROBE 0
#endif
    if (IN(10)) { if (P10_PROBE) { p10_peer<P10_PROBE>(F, args); xcd_barrier(bar); } REPEAT(10) { p10_peer<0>(F, args); REPBAR(10); } }
#undef IN
#undef SEAM
}

extern "C" void kernel_launch(void* const* d_in, const int* in_sizes, int n_in, void* d_out, int out_size, void* d_ws, size_t ws_size, hipStream_t stream) {
    static int grid = 0;
    if (grid == 0) {
        if (n_in != 24 || in_sizes[0] != S * DM || out_size != S * DM || ws_size < WS_END) { fprintf(stderr, "kernel_launch: unexpected shapes (n_in %d, in0 %d, out %d, ws %zu)\n", n_in, n_in > 0 ? in_sizes[0] : -1, out_size, ws_size); grid = -1; return; }
        int dev = 0, cus = 0, per_cu = 0;
        if (hipGetDevice(&dev) != hipSuccess || hipDeviceGetAttribute(&cus, hipDeviceAttributeMultiprocessorCount, dev) != hipSuccess) { grid = -1; return; }
        if (hipFuncSetAttribute((const void*)fwd_kernel, hipFuncAttributeMaxDynamicSharedMemorySize, LDS_BYTES) != hipSuccess) { fprintf(stderr, "kernel_launch: hipFuncSetAttribute failed\n"); grid = -1; return; }
        if (hipOccupancyMaxActiveBlocksPerMultiprocessor(&per_cu, (const void*)fwd_kernel, NTHREADS, LDS_BYTES) != hipSuccess || per_cu < 1) fprintf(stderr, "kernel_launch: occupancy query reports %d blocks per CU\n", per_cu);
        (void)hipGetLastError();
        grid = cus;
    }
    if (grid < 0) return;
    if (hipMemsetAsync((char*)d_ws + WS_CTL, 0, CTL_ZERO_BYTES, stream) != hipSuccess) return;
    Args a{};
    for (int i = 0; i < 24; ++i) a.in[i] = (const float*)d_in[i];
    a.out = (float*)d_out; a.ws = (unsigned char*)d_ws;
#ifndef REP_ATT
#define REP_ATT 1
#endif
#ifndef REP_LRU
#define REP_LRU 1
#endif
    a.rep_att = REP_ATT; a.rep_lru = REP_LRU;
#if MK_SINGLE
    a.ph_lo = 0; a.ph_hi = N_PHASES;
    hipLaunchKernelGGL(fwd_kernel, dim3(grid), dim3(NTHREADS), LDS_BYTES, stream, a);
#else
    for (int p = 0; p < N_PHASES; ++p) { a.ph_lo = p; a.ph_hi = p + 1; hipLaunchKernelGGL(fwd_kernel, dim3(grid), dim3(NTHREADS), LDS_BYTES, stream, a); }
#endif
}
```

```cpp
#define REP_PHASE -1
#include <hip/hip_runtime.h>
#include <cstdio>
#include <cstdint>
namespace pg8 {
#define PG8_LAS __attribute__((address_space(3)))
typedef unsigned short bf16_t;
typedef short bf16x8 __attribute__((ext_vector_type(8)));
typedef float f32x4 __attribute__((ext_vector_type(4)));
typedef unsigned u32x4 __attribute__((ext_vector_type(4)));
constexpr int BM = 256, BK = 64, HALF = 128, HTB = HALF * BK * 2  , STAGE_BYTES = 8 * HTB, NXCD = 8, WGM = 8;

__host__ __device__ __forceinline__ int lds_byte(int r, int c) { const int st = (r >> 4) * 2 + (c >> 5), rr = r & 15, cc = c & 31, ob = rr * 64 + cc * 2; return st * 1024 + (ob ^ (((ob >> 9) & 1) << 5)); }
__host__ __device__ __forceinline__ void stage_rc(int b, int& R, int& C) { const int st = b / 1024, sb = b % 1024, swz = sb ^ (((sb >> 9) & 1) << 5); R = (st >> 1) * 16 + swz / 64; C = (st & 1) * 32 + (swz % 64) / 2; }
__host__ __device__ __forceinline__ int perm32(int rho) { const int n = rho >> 4, i = rho & 15; return 8 * (i >> 2) + 4 * n + (i & 3); }

struct Unit { int pm, pn; };
struct Gemm { const bf16_t* A; const bf16_t* Bt; int M, N, K; };

struct StaticOrder {
    int nM, nN, nwg, G, c;
    __host__ __device__ void init(int M, int N, int G_, int c_) { nM = M / BM; nN = N / BM; nwg = nM * nN; G = G_; c = c_; }
    __host__ __device__ bool next(int i, Unit& u) const {
        const long L = (long)i * G + c; if (L >= nwg) return false;
        int wgid = (int)L; { const int q = nwg / NXCD, r = nwg % NXCD, xcd = wgid % NXCD, off = wgid / NXCD; wgid = (xcd < r ? xcd * (q + 1) : r * (q + 1) + (xcd - r) * q) + off; }
        const int nig = WGM * nN, gid = wgid / nig, fm = gid * WGM, gsz = (nM - fm) < WGM ? (nM - fm) : WGM;
        u.pm = fm + ((wgid % nig) % gsz); u.pn = (wgid % nig) / gsz; return true;
    }
    __device__ __forceinline__ void a_ready(const Unit&) const {}
    __device__ __forceinline__ void done(const Unit&) const {}
};

__device__ __forceinline__ unsigned cvt_pk_bf16(float lo, float hi) { unsigned r; asm volatile("v_cvt_pk_bf16_f32 %0, %1, %2" : "=v"(r) : "v"(lo), "v"(hi)); return r; }
typedef float f32x2 __attribute__((ext_vector_type(2)));
__device__ __forceinline__ f32x2 gelu_pk(f32x2 v) {
    const f32x2 av = __builtin_elementwise_abs(v), d = av * 0.2316418882f + 1.0f;
    f32x2 t; t.x = __builtin_amdgcn_rcpf(d.x); t.y = __builtin_amdgcn_rcpf(d.y);
    f32x2 q = t * 0.5307027145f + (-0.7265760135f); q = q * t + 0.7107068705f; q = q * t + (-0.142248368f); q = q * t + 0.127414796f; q = q * t;
    const f32x2 s = (v * v) * (-0.72134752044f);
    f32x2 e; e.x = __builtin_amdgcn_exp2f(s.x); e.y = __builtin_amdgcn_exp2f(s.y);
    const f32x2 m = v * (q * e), r = v - m;
    f32x2 o; o.x = v.x < 0.f ? m.x : r.x; o.y = v.y < 0.f ? m.y : r.y; return o;
}

template <int ACT  > struct EpiBf16 {
    static constexpr bool PERM = true, AFTER_DRAIN = false; static_assert(ACT == 0 || ACT == 1, "EpiBf16: ACT is 0 (none) or 1 (gelu_pk)");
    bf16_t* O; int ldc; const float* bias; int split_cols; size_t split_stride; float scale0;
    __device__ __forceinline__ void operator()(const f32x4 (&acc)[2][2][4][2], const Unit& u, int wr, int wc, int fr, int fq) const {
        const int row0 = u.pm * BM + wr * 64 + fr; int colt = u.pn * BM; bf16_t* base = O;
        float sc = 1.f; if (split_cols) { const int t = colt / split_cols; base += (size_t)t * split_stride; colt -= t * split_cols; if (t == 0) sc = scale0; }
        const int col0 = colt + wc * 32 + 8 * fq, bcol0 = u.pn * BM + wc * 32 + 8 * fq;
        f32x4 bv[2][2];
#pragma unroll
        for (int bj = 0; bj < 2; ++bj)
#pragma unroll
            for (int n = 0; n < 2; ++n) bv[bj][n] = bias ? *(const f32x4*)(bias + bcol0 + bj * HALF + 4 * n) : (f32x4){0.f, 0.f, 0.f, 0.f};
#pragma unroll
        for (int ai = 0; ai < 2; ++ai)
#pragma unroll
            for (int m = 0; m < 4; ++m) { bf16_t* rowp = base + (size_t)(row0 + ai * HALF + m * 16) * ldc + col0;
#pragma unroll
                for (int bj = 0; bj < 2; ++bj) { f32x4 v0 = acc[ai][bj][m][0] + bv[bj][0], v1 = acc[ai][bj][m][1] + bv[bj][1];
                    if (ACT == 1) { f32x2 a = gelu_pk((f32x2){v0[0], v0[1]}), b = gelu_pk((f32x2){v0[2], v0[3]}), c = gelu_pk((f32x2){v1[0], v1[1]}), d = gelu_pk((f32x2){v1[2], v1[3]});
                        v0 = (f32x4){a.x, a.y, b.x, b.y}; v1 = (f32x4){c.x, c.y, d.x, d.y}; }
                    v0 = v0 * sc; v1 = v1 * sc; u32x4 w; w.x = cvt_pk_bf16(v0[0], v0[1]); w.y = cvt_pk_bf16(v0[2], v0[3]); w.z = cvt_pk_bf16(v1[0], v1[1]); w.w = cvt_pk_bf16(v1[2], v1[3]);
                    *(u32x4*)(rowp + bj * HALF) = w; } }
    }
};
__device__ __forceinline__ f32x4 sigm4(f32x4 v) { f32x4 o;
#pragma unroll
    for (int j = 0; j < 4; ++j) o[j] = __builtin_amdgcn_rcpf(1.0f + __builtin_amdgcn_exp2f(-1.4426950408889634f * v[j]));
    return o; }
__device__ __forceinline__ f32x4 gelu4(f32x4 v) { const f32x2 a = gelu_pk((f32x2){v[0], v[1]}), b = gelu_pk((f32x2){v[2], v[3]}); return (f32x4){a.x, a.y, b.x, b.y}; }
__device__ __forceinline__ void unpack8(const u32x4 w, f32x4& lo, f32x4& hi) {
    lo = (f32x4){__uint_as_float(w.x << 16), __uint_as_float(w.x & 0xffff0000u), __uint_as_float(w.y << 16), __uint_as_float(w.y & 0xffff0000u)};
    hi = (f32x4){__uint_as_float(w.z << 16), __uint_as_float(w.z & 0xffff0000u), __uint_as_float(w.w << 16), __uint_as_float(w.w & 0xffff0000u)}; }
struct EpiIn {
    static constexpr bool PERM = true, AFTER_DRAIN = false;
    bf16_t* qkv; bf16_t* lx; bf16_t* gy; bf16_t* ga; bf16_t* gl; const float* bias;
    __device__ __forceinline__ void operator()(const f32x4 (&acc)[2][2][4][2], const Unit& u, int wr, int wc, int fr, int fq) const {
        const int pn = u.pn; bf16_t* base; int ldc, colt, act;
        if (pn < 24) { base = qkv + (size_t)(pn >> 3) * ((size_t)8192 * 2048); ldc = 2048; colt = (pn & 7) * 256; act = 0; }
        else if (pn < 32) { base = lx; ldc = 2048; colt = (pn - 24) * 256; act = 0; }
        else if (pn < 40) { base = gy; ldc = 2048; colt = (pn - 32) * 256; act = 1; }
        else if (pn < 56) { base = ga; ldc = 4096; colt = (pn - 40) * 256; act = 2; }
        else { base = gl; ldc = 4096; colt = (pn - 56) * 256; act = 2; }
        const int row0 = u.pm * BM + wr * 64 + fr, col0 = colt + wc * 32 + 8 * fq, bcol0 = pn * BM + wc * 32 + 8 * fq;
        f32x4 bv[2][2];
#pragma unroll
        for (int bj = 0; bj < 2; ++bj)
#pragma unroll
            for (int n = 0; n < 2; ++n) bv[bj][n] = *(const f32x4*)(bias + bcol0 + bj * HALF + 4 * n);
#pragma unroll
        for (int ai = 0; ai < 2; ++ai)
#pragma unroll
            for (int m = 0; m < 4; ++m) { bf16_t* rowp = base + (size_t)(row0 + ai * HALF + m * 16) * ldc + col0;
#pragma unroll
                for (int bj = 0; bj < 2; ++bj) { f32x4 v0 = acc[ai][bj][m][0] + bv[bj][0], v1 = acc[ai][bj][m][1] + bv[bj][1];
                    if (act == 1) { v0 = gelu4(v0); v1 = gelu4(v1); }
                    else if (act == 2) { v0 = sigm4(v0); v1 = sigm4(v1); }
                    u32x4 w; w.x = cvt_pk_bf16(v0[0], v0[1]); w.y = cvt_pk_bf16(v0[2], v0[3]); w.z = cvt_pk_bf16(v1[0], v1[1]); w.w = cvt_pk_bf16(v1[2], v1[3]);
                    *(u32x4*)(rowp + bj * HALF) = w; } }
    }
};
template <int MODE> struct EpiGate {
    static constexpr bool PERM = true, AFTER_DRAIN = false;
    bf16_t* O; const bf16_t* Gt; int ldc;
    __device__ __forceinline__ void operator()(const f32x4 (&acc)[2][2][4][2], const Unit& u, int wr, int wc, int fr, int fq) const {
        const int row0 = u.pm * BM + wr * 64 + fr, col0 = u.pn * BM + wc * 32 + 8 * fq;
#pragma unroll
        for (int ai = 0; ai < 2; ++ai)
#pragma unroll
            for (int m = 0; m < 4; ++m) { const size_t off = (size_t)(row0 + ai * HALF + m * 16) * ldc + col0;
#pragma unroll
                for (int bj = 0; bj < 2; ++bj) { f32x4 g0, g1; unpack8(*(const u32x4*)(Gt + off + bj * HALF), g0, g1);
                    f32x4 v0 = acc[ai][bj][m][0] * g0, v1 = acc[ai][bj][m][1] * g1;
                    if (MODE == 1) { f32x4 t0, t1; unpack8(*(const u32x4*)(O + off + bj * HALF), t0, t1); v0 += t0; v1 += t1; }
                    u32x4 w; w.x = cvt_pk_bf16(v0[0], v0[1]); w.y = cvt_pk_bf16(v0[2], v0[3]); w.z = cvt_pk_bf16(v1[0], v1[1]); w.w = cvt_pk_bf16(v1[2], v1[3]);
                    *(u32x4*)(O + off + bj * HALF) = w; } }
    }
};
struct EpiRes {
    static constexpr bool PERM = false, AFTER_DRAIN = false;
    const float* X; float* Out; const float* gate; int ldc; const float* g2a; const float* g2b; bf16_t* XG; float* SSQ;
    __device__ __forceinline__ void operator()(const f32x4 (&acc)[2][2][4][2], const Unit& u, int wr, int wc, int fr, int fq) const {
        const int row0 = u.pm * BM + wr * 64 + fr, col0 = u.pn * BM + wc * 32 + 4 * fq;
        f32x4 gv[2][2], gp[2][2];
#pragma unroll
        for (int bj = 0; bj < 2; ++bj)
#pragma unroll
            for (int n = 0; n < 2; ++n) { gv[bj][n] = *(const f32x4*)(gate + col0 + bj * HALF + n * 16);
                gp[bj][n] = *(const f32x4*)(g2a + col0 + bj * HALF + n * 16) * (*(const f32x4*)(g2b + col0 + bj * HALF + n * 16) + 1.0f); }
#pragma unroll
        for (int ai = 0; ai < 2; ++ai)
#pragma unroll
            for (int m = 0; m < 4; ++m) { const int row = row0 + ai * HALF + m * 16; const size_t off = (size_t)row * ldc + col0; float ss = 0.f;
#pragma unroll
                for (int bj = 0; bj < 2; ++bj)
#pragma unroll
                    for (int n = 0; n < 2; ++n) { const f32x4 xv = *(const f32x4*)(X + off + bj * HALF + n * 16);
                        const f32x4 x1 = xv + gv[bj][n] * acc[ai][bj][m][n]; *(f32x4*)(Out + off + bj * HALF + n * 16) = x1;
                        ss += (x1[0] * x1[0] + x1[1] * x1[1]) + (x1[2] * x1[2] + x1[3] * x1[3]);
                        const f32x4 xg = x1 * gp[bj][n]; typedef unsigned u32x2_ __attribute__((ext_vector_type(2)));
                        u32x2_ w; w.x = cvt_pk_bf16(xg[0], xg[1]); w.y = cvt_pk_bf16(xg[2], xg[3]); *(u32x2_*)(XG + off + bj * HALF + n * 16) = w; }
                ss += __shfl_xor(ss, 16); ss += __shfl_xor(ss, 32);
                if (fq == 0) SSQ[(size_t)row * 64 + u.pn * 4 + wc] = ss; }
    }
};
struct EpiQ2 {
    static constexpr bool PERM = true, AFTER_DRAIN = false;
    bf16_t* O; int ldc; const float* sb; const PG8_LAS float* rs; mutable int ne;
    __device__ __forceinline__ void operator()(const f32x4 (&acc)[2][2][4][2], const Unit& u, int wr, int wc, int fr, int fq) const {
        const int rl0 = wr * 64 + fr, row0 = u.pm * BM + rl0, col0 = u.pn * BM + wc * 32 + 8 * fq; const PG8_LAS float* rsp = rs + ((ne++) & 1) * 256;
        f32x4 bv[2][2];
#pragma unroll
        for (int bj = 0; bj < 2; ++bj)
#pragma unroll
            for (int n = 0; n < 2; ++n) bv[bj][n] = *(const f32x4*)(sb + col0 + bj * HALF + 4 * n);
#pragma unroll
        for (int ai = 0; ai < 2; ++ai)
#pragma unroll
            for (int m = 0; m < 4; ++m) { const float r = rsp[rl0 + ai * HALF + m * 16]; bf16_t* rowp = O + (size_t)(row0 + ai * HALF + m * 16) * ldc + col0;
#pragma unroll
                for (int bj = 0; bj < 2; ++bj) { const f32x4 v0 = acc[ai][bj][m][0] * r + bv[bj][0], v1 = acc[ai][bj][m][1] * r + bv[bj][1];
                    u32x4 w; w.x = cvt_pk_bf16(v0[0], v0[1]); w.y = cvt_pk_bf16(v0[2], v0[3]); w.z = cvt_pk_bf16(v1[0], v1[1]); w.w = cvt_pk_bf16(v1[2], v1[3]);
                    *(u32x4*)(rowp + bj * HALF) = w; } }
    }
};
struct RstdOrder : StaticOrder {
    const float* SSQ; PG8_LAS float* rs; float inv_n, eps; mutable int na;
    __device__ __forceinline__ void a_ready(const Unit& u) const {
        const int tid = threadIdx.x, r = tid >> 1, hf = tid & 1; const f32x4* p = (const f32x4*)(SSQ + (size_t)(u.pm * BM + r) * 64 + hf * 32); float s = 0.f;
#pragma unroll
        for (int k = 0; k < 8; ++k) { const f32x4 v = p[k]; s += (v[0] + v[1]) + (v[2] + v[3]); }
        s += __shfl_xor(s, 1);
        if (hf == 0) rs[(na & 1) * 256 + r] = 1.0f / sqrtf(s * inv_n + eps);
        ++na;
    }
};
template <class Epi, class Sched, bool ALIGN_EPI = false, bool SP2 = false>
__device__ __forceinline__ void gemm_phase(PG8_LAS unsigned char* lds, const Gemm g, const Sched& S, const Epi& E) {
    const int tid = threadIdx.x, wid = __builtin_amdgcn_readfirstlane(tid >> 6), lane = tid & 63, wr = wid >> 2, wc = wid & 3, fr = lane & 15, fq = lane >> 4;
    const int K = g.K, nt = K / BK;
    unsigned voffA[2], voffB[2];
#pragma unroll
    for (int i = 0; i < 2; ++i) { int R, C; stage_rc(tid * 16 + i * 8192, R, C); const int Rb = Epi::PERM ? ((R & ~31) + perm32(R & 31)) : R;
        voffA[i] = (unsigned)(R * K + C) * 2u; voffB[i] = (unsigned)(Rb * K + C) * 2u; }
    const size_t kstep = (size_t)(BK * 2);
    const size_t hstep = (size_t)HALF * K * 2;
    const size_t tstep = 2 * hstep;
    const unsigned ldsw = (unsigned)wid * 1024u;
    const int aoff = lds_byte(wr * 64 + fr, fq * 8), boff = lds_byte(wc * 32 + fr, fq * 8);
#define PG8_SA(b, h) (((b) * 2 + (h)) * HTB)
#define PG8_SB(b, h) ((4 + (b) * 2 + (h)) * HTB)
#define PG8_STAGE(bufoff, gbase, voff) do { _Pragma("unroll") for (int _i = 0; _i < 2; ++_i) \
        __builtin_amdgcn_global_load_lds((const unsigned*)((const char*)(gbase) + (voff)[_i]), (PG8_LAS unsigned*)(lds + (bufoff) + ldsw + _i * 8192), 16, 0, 0); } while (0)
#define PG8_LDA(dst, b, h) do { _Pragma("unroll") for (int m = 0; m < 4; ++m) _Pragma("unroll") for (int k = 0; k < 2; ++k) dst[m][k] = *(const PG8_LAS bf16x8*)(lds + PG8_SA(b, h) + aoff + m * 2048 + k * 1024); } while (0)
#define PG8_LDB(dst, b, h) do { _Pragma("unroll") for (int n = 0; n < 2; ++n) _Pragma("unroll") for (int k = 0; k < 2; ++k) dst[n][k] = *(const PG8_LAS bf16x8*)(lds + PG8_SB(b, h) + boff + n * 2048 + k * 1024); } while (0)
#define PG8_MMA(ai, bj, At, Bt) do { __builtin_amdgcn_s_setprio(1); _Pragma("unroll") for (int m = 0; m < 4; ++m) _Pragma("unroll") for (int n = 0; n < 2; ++n) _Pragma("unroll") for (int k = 0; k < 2; ++k) \
        acc[ai][bj][m][n] = __builtin_amdgcn_mfma_f32_16x16x32_bf16(Bt[n][k], At[m][k], acc[ai][bj][m][n], 0, 0, 0); __builtin_amdgcn_s_setprio(0); } while (0)
#define PG8_WAIT_V(n) asm volatile("s_waitcnt vmcnt(" #n ")" ::: "memory")
#define PG8_WAIT_L(n) asm volatile("s_waitcnt lgkmcnt(" #n ")" ::: "memory")
#define PG8_BAR __builtin_amdgcn_s_barrier()
#define PG8_SCHED __builtin_amdgcn_sched_barrier(0)
    Unit cur, nxt; int ui = 0;
    if (!S.next(0, cur)) return;
    f32x4 acc[2][2][4][2];
#pragma unroll
    for (int a = 0; a < 2; ++a)
#pragma unroll
        for (int b = 0; b < 2; ++b)
#pragma unroll
            for (int m = 0; m < 4; ++m)
#pragma unroll
                for (int n = 0; n < 2; ++n) acc[a][b][m][n] = (f32x4){0.f, 0.f, 0.f, 0.f};
    bf16x8 At[4][2], B0[2][2], B1[2][2];
    const char* cA = (const char*)g.A + (size_t)cur.pm * tstep; const char* cB = (const char*)g.Bt + (size_t)cur.pn * tstep;
    S.a_ready(cur);
    if constexpr (SP2) {
        PG8_STAGE(PG8_SB(0, 0), cB, voffB); PG8_STAGE(PG8_SB(0, 1), cB + hstep, voffB); PG8_STAGE(PG8_SA(0, 0), cA, voffA); PG8_STAGE(PG8_SA(0, 1), cA + hstep, voffA);
        if (wr == 1) PG8_BAR;
        PG8_WAIT_V(2); PG8_BAR;
        PG8_STAGE(PG8_SB(1, 0), cB + kstep, voffB); PG8_STAGE(PG8_SA(1, 0), cA + kstep, voffA); PG8_STAGE(PG8_SB(1, 1), cB + hstep + kstep, voffB);
        PG8_WAIT_V(6); PG8_BAR;
    } else {
        PG8_STAGE(PG8_SB(0, 0), cB, voffB); PG8_STAGE(PG8_SA(0, 0), cA, voffA); PG8_STAGE(PG8_SB(0, 1), cB + hstep, voffB); PG8_STAGE(PG8_SA(0, 1), cA + hstep, voffA);
        if (wr == 1) PG8_BAR;
        PG8_WAIT_V(4); PG8_BAR;
        PG8_STAGE(PG8_SB(1, 0), cB + kstep, voffB); PG8_STAGE(PG8_SA(1, 0), cA + kstep, voffA); PG8_STAGE(PG8_SB(1, 1), cB + hstep + kstep, voffB);
        PG8_WAIT_V(6); PG8_BAR;
    }
    for (;;) {
        const bool has_next = S.next(ui + 1, nxt);
        const char* nA = has_next ? (const char*)g.A + (size_t)nxt.pm * tstep : cA; const char* nB = has_next ? (const char*)g.Bt + (size_t)nxt.pn * tstep : cB;
        for (int t = 0; t < nt; t += 2) {
            const bool last = (t == nt - 2);
            const char* a1 = cA + (size_t)(t + 1) * kstep;
            const char* a2 = last ? nA : cA + (size_t)(t + 2) * kstep; const char* b2 = last ? nB : cB + (size_t)(t + 2) * kstep;
            const char* a3 = a2 + kstep; const char* b3 = b2 + kstep;
            if (last && has_next) S.a_ready(nxt);
            if constexpr (SP2) {
            PG8_LDB(B0, 0, 0); PG8_LDB(B1, 0, 1); PG8_SCHED; PG8_LDA(At, 0, 0); PG8_STAGE(PG8_SA(1, 1), a1 + hstep, voffA);
            PG8_WAIT_V(8); PG8_WAIT_L(0); PG8_BAR; PG8_MMA(0, 0, At, B0); PG8_MMA(0, 1, At, B1); PG8_BAR; PG8_SCHED;
            PG8_LDA(At, 0, 1); PG8_STAGE(PG8_SB(0, 0), b2, voffB); PG8_STAGE(PG8_SB(0, 1), b2 + hstep, voffB); PG8_STAGE(PG8_SA(0, 0), a2, voffA);
            PG8_WAIT_V(8); PG8_WAIT_L(0); PG8_BAR; PG8_MMA(1, 0, At, B0); PG8_MMA(1, 1, At, B1); PG8_BAR; PG8_SCHED;
            PG8_LDB(B0, 1, 0); PG8_LDB(B1, 1, 1); PG8_SCHED; PG8_LDA(At, 1, 0); PG8_STAGE(PG8_SA(0, 1), a2 + hstep, voffA);
            PG8_WAIT_V(8); PG8_WAIT_L(0); PG8_BAR; PG8_MMA(0, 0, At, B0); PG8_MMA(0, 1, At, B1); PG8_BAR; PG8_SCHED;
            PG8_LDA(At, 1, 1); PG8_STAGE(PG8_SB(1, 0), b3, voffB); PG8_STAGE(PG8_SB(1, 1), b3 + hstep, voffB); PG8_STAGE(PG8_SA(1, 0), a3, voffA);
            PG8_WAIT_V(8); PG8_WAIT_L(0); PG8_BAR; PG8_MMA(1, 0, At, B0); PG8_MMA(1, 1, At, B1); PG8_BAR; PG8_SCHED;
            } else {
            PG8_LDB(B0, 0, 0); PG8_SCHED; PG8_LDA(At, 0, 0); PG8_STAGE(PG8_SA(1, 1), a1 + hstep, voffA);
            PG8_WAIT_L(8); PG8_BAR; PG8_WAIT_L(0); PG8_MMA(0, 0, At, B0); PG8_BAR; PG8_SCHED;
            PG8_LDB(B1, 0, 1); PG8_STAGE(PG8_SB(0, 0), b2, voffB);
            PG8_BAR; PG8_WAIT_L(0); PG8_MMA(0, 1, At, B1); PG8_BAR;
            PG8_LDA(At, 0, 1); PG8_STAGE(PG8_SA(0, 0), a2, voffA);
            PG8_BAR; PG8_WAIT_L(0); PG8_MMA(1, 0, At, B0); PG8_BAR; PG8_SCHED;
            PG8_STAGE(PG8_SB(0, 1), b2 + hstep, voffB);
            PG8_WAIT_V(6); PG8_BAR; PG8_MMA(1, 1, At, B1); PG8_BAR;
            PG8_LDB(B0, 1, 0); PG8_SCHED; PG8_LDA(At, 1, 0); PG8_STAGE(PG8_SA(0, 1), a2 + hstep, voffA);
            PG8_WAIT_L(8); PG8_BAR; PG8_WAIT_L(0); PG8_MMA(0, 0, At, B0); PG8_BAR; PG8_SCHED;
            PG8_LDB(B1, 1, 1); PG8_STAGE(PG8_SB(1, 0), b3, voffB);
            PG8_BAR; PG8_WAIT_L(0); PG8_MMA(0, 1, At, B1); PG8_BAR;
            PG8_LDA(At, 1, 1); PG8_STAGE(PG8_SA(1, 0), a3, voffA);
            PG8_BAR; PG8_WAIT_L(0); PG8_MMA(1, 0, At, B0); PG8_BAR; PG8_SCHED;
            PG8_STAGE(PG8_SB(1, 1), b3 + hstep, voffB);
            PG8_WAIT_V(6); PG8_BAR; PG8_MMA(1, 1, At, B1); PG8_BAR;
            }
        }
        if constexpr (ALIGN_EPI) { if (wr == 0) PG8_BAR; }
        if constexpr (!Epi::AFTER_DRAIN) { E(acc, cur, wr, wc, fr, fq); S.done(cur); }
        if (!has_next) break;
#pragma unroll
        for (int a = 0; a < 2; ++a)
#pragma unroll
            for (int b = 0; b < 2; ++b)
#pragma unroll
                for (int m = 0; m < 4; ++m)
#pragma unroll
                    for (int n = 0; n < 2; ++n) acc[a][b][m][n] = (f32x4){0.f, 0.f, 0.f, 0.f};
        cur = nxt; cA = nA; cB = nB; ++ui;
        if constexpr (ALIGN_EPI) { if (wr == 1) PG8_BAR; }
    }
    PG8_WAIT_V(0);
    if constexpr (!ALIGN_EPI) { if (wr == 0) PG8_BAR; }
    PG8_BAR;
    if constexpr (Epi::AFTER_DRAIN) { E.fused(acc, cur, wr, wc, fr, fq, lds, wid, lane); S.done(cur); }
#undef PG8_SA
#undef PG8_SB
#undef PG8_STAGE
#undef PG8_LDA
#undef PG8_LDB
#undef PG8_MMA
#undef PG8_WAIT_V
#undef PG8_WAIT_L
#undef PG8_BAR
#undef PG8_SCHED
}
}
namespace attn_body {
constexpr int D = 128, LD = 2048;
constexpr float THR = 8.f; constexpr bool WSKIP = false;
constexpr float SCALE = 0.08838834764831845f;
constexpr int NW = 8, QBLK = 32, KVBLK = 64, QB = NW * QBLK;
constexpr int SHM_V = KVBLK * D * 2, SHM_K = KVBLK * D * 2;
constexpr int LDS_BYTES = 2 * SHM_V + 2 * SHM_K + NW * 64 * 4;

typedef short bf16x8 __attribute__((ext_vector_type(8)));
typedef short s16x4 __attribute__((ext_vector_type(4)));
typedef float f32x16 __attribute__((ext_vector_type(16)));
typedef float f32x4 __attribute__((ext_vector_type(4)));
typedef unsigned u32x4 __attribute__((ext_vector_type(4)));
template <class A, class Bt> struct same_t { static constexpr bool v = false; };
template <class A> struct same_t<A, A> { static constexpr bool v = true; };

#define KSWZ(row, colB) ((row) * 256 + ((colB) ^ (((row) & 7) << 4)))
#define SBAR() __builtin_amdgcn_sched_barrier(0)
__device__ __forceinline__ int v_st(int k, int c) { const int kk = (k & ~0xC) | ((k & 4) << 1) | ((k & 8) >> 1); return ((kk >> 3) * 4 + (c >> 5)) * 512 + ((kk & 7) * 32 + (c & 31)) * 2; }
__device__ __forceinline__ int v_rd_base(int lane) { return ((lane & 3) << 3) | (((lane >> 2) & 3) << 6) | (((lane >> 4) & 1) << 5) | (((lane >> 5) & 1) << 8); }
constexpr int v_rd_off(int d0, int ks, int half) { return d0 * 512 + ks * 4096 + half * 2048; }
__device__ __forceinline__ int crow(int r, int hi) { return (r & 3) + 8 * (r >> 2) + 4 * hi; }
__device__ __forceinline__ unsigned cvtpk(float lo, float hi) {
    unsigned r; asm volatile("v_cvt_pk_bf16_f32 %0, %1, %2" : "=v"(r) : "v"(lo), "v"(hi)); return r;
}
__device__ __forceinline__ bf16x8 pack8(f32x4 a, f32x4 b) {
    u32x4 w = {cvtpk(a[0], a[1]), cvtpk(a[2], a[3]), cvtpk(b[0], b[1]), cvtpk(b[2], b[3])};
    return *reinterpret_cast<bf16x8*>(&w);
}
template <class T> __device__ __forceinline__ bf16x8 load8(const T* p) {
    if constexpr (same_t<T, float>::v) { return pack8(*(const f32x4*)p, *(const f32x4*)(p + 4)); }
    else { return *reinterpret_cast<const bf16x8*>(p); }
}
__device__ __forceinline__ void mask_tile(f32x16& p0, f32x16& p1, int dq, unsigned W) {
    const float NEG = -__builtin_inff();
#pragma unroll
    for (int r = 0; r < 16; ++r) {
        const int c = (r & 3) + 8 * (r >> 2);
        if ((unsigned)(dq - c) >= W) p0[r] = NEG;
        if ((unsigned)(dq - c - 32) >= W) p1[r] = NEG;
    }
}
__device__ __forceinline__ void partialSM(f32x16& p0, f32x16& p1, float& m_reg, float& mn, float& alpha) {
    float pmax = p0[0]; for (int r = 1; r < 16; ++r) pmax = fmaxf(pmax, p0[r]); for (int r = 0; r < 16; ++r) pmax = fmaxf(pmax, p1[r]);
    { auto rr = __builtin_amdgcn_permlane32_swap(__float_as_uint(pmax), __float_as_uint(pmax), false, false);
      pmax = fmaxf(__uint_as_float(rr[0]), __uint_as_float(rr[1])); }
    constexpr float C2 = 1.4426950408889634f * SCALE;
    if (__builtin_expect(__all((pmax - m_reg) * SCALE <= THR), 1)) { mn = m_reg; alpha = 1.f; }
    else { mn = fmaxf(m_reg, pmax); alpha = __builtin_amdgcn_exp2f((m_reg - mn) * C2); m_reg = mn; }
    const float mnL = -mn * C2;
    for (int r = 0; r < 16; ++r) p0[r] = fmaf(p0[r], C2, mnL); for (int r = 0; r < 16; ++r) p1[r] = fmaf(p1[r], C2, mnL);
    for (int r = 0; r < 16; ++r) p0[r] = __builtin_amdgcn_exp2f(p0[r]);
}
__device__ __forceinline__ void finishSM(f32x16& p0, f32x16& p1, float alpha, float& l_reg, bf16x8& pa0, bf16x8& pa1, bf16x8& pa2, bf16x8& pa3) {
    for (int r = 0; r < 16; ++r) p1[r] = __builtin_amdgcn_exp2f(p1[r]);
    float ps = 0; for (int r = 0; r < 16; ++r) ps += p0[r]; for (int r = 0; r < 16; ++r) ps += p1[r];
    { auto rr = __builtin_amdgcn_permlane32_swap(__float_as_uint(ps), __float_as_uint(ps), false, false);
      ps = __uint_as_float(rr[0]) + __uint_as_float(rr[1]); }
    l_reg = l_reg * alpha + ps;
#define PK4(P, B_, OUT) do { unsigned a0 = cvtpk(P[B_+0], P[B_+1]), a1 = cvtpk(P[B_+2], P[B_+3]);                          \
        unsigned b0 = cvtpk(P[B_+4], P[B_+5]), b1 = cvtpk(P[B_+6], P[B_+7]);                                             \
        auto r0 = __builtin_amdgcn_permlane32_swap(a0, b0, false, false); auto r1 = __builtin_amdgcn_permlane32_swap(a1, b1, false, false); \
        u32x4 w = {r0[0], r1[0], r0[1], r1[1]}; OUT = *reinterpret_cast<bf16x8*>(&w); } while (0)
    PK4(p0, 0, pa0); PK4(p0, 8, pa1); PK4(p1, 0, pa2); PK4(p1, 8, pa3);
#undef PK4
}
template <int KB, bool SK>
__device__ __forceinline__ void qkt(f32x16& p0, f32x16& p1, const char* K_lds, int r32, int hi, const bf16x8* qr, bool act, const float* bt) {
    if (SK && !act) { const float NEG = -__builtin_inff();
#pragma unroll
        for (int r = 0; r < 16; ++r) { p0[r] = NEG; p1[r] = NEG; } return; }
    { const f32x4 b0 = *(const f32x4*)(bt), b1 = *(const f32x4*)(bt + 8), b2 = *(const f32x4*)(bt + 16), b3 = *(const f32x4*)(bt + 24);
      const f32x4 c0 = *(const f32x4*)(bt + 32), c1 = *(const f32x4*)(bt + 40), c2 = *(const f32x4*)(bt + 48), c3 = *(const f32x4*)(bt + 56);
      p0 = (f32x16){b0[0], b0[1], b0[2], b0[3], b1[0], b1[1], b1[2], b1[3], b2[0], b2[1], b2[2], b2[3], b3[0], b3[1], b3[2], b3[3]};
      p1 = (f32x16){c0[0], c0[1], c0[2], c0[3], c1[0], c1[1], c1[2], c1[3], c2[0], c2[1], c2[2], c2[3], c3[0], c3[1], c3[2], c3[3]}; }
    const char* kb[4];
#pragma unroll
    for (int dd = 0; dd < 4; ++dd) kb[dd] = K_lds + KB * SHM_K + KSWZ(r32, (dd * 16 + hi * 8) * 2);
#pragma unroll
    for (int d0 = 0; d0 < 8; ++d0) { const char* a = kb[d0 & 3] + (d0 >> 2) * 128;
        bf16x8 b0 = *reinterpret_cast<const bf16x8*>(a);
        bf16x8 b1 = *reinterpret_cast<const bf16x8*>(a + 32 * 256);
        p0 = __builtin_amdgcn_mfma_f32_32x32x16_bf16(b0, qr[d0], p0, 0, 0, 0);
        p1 = __builtin_amdgcn_mfma_f32_32x32x16_bf16(b1, qr[d0], p1, 0, 0, 0); }
}
template <int VB, bool SK>
__device__ __forceinline__ void pv_tile(f32x16* o, int vb0, bf16x8 pa0, bf16x8 pa1, bf16x8 pa2, bf16x8 pa3, bool act) {
    if (SK && !act) return;
#define TRRD(dst, off) asm volatile("ds_read_b64_tr_b16 %0, %1 offset:%2" : "=&v"(dst) : "v"(vb0), "i"(off) : "memory")
#define PV_D0(d0) do { s16x4 l0, l1, l2, l3, h0, h1, h2, h3; constexpr int b_ = VB * SHM_V + v_rd_off(d0, 0, 0);     \
        TRRD(l0, b_); TRRD(h0, b_ + 2048); TRRD(l1, b_ + 4096); TRRD(h1, b_ + 6144); TRRD(l2, b_ + 8192); TRRD(h2, b_ + 10240); TRRD(l3, b_ + 12288); TRRD(h3, b_ + 14336); \
        asm volatile("s_waitcnt lgkmcnt(0)" ::: "memory"); SBAR();                 \
        o[d0] = __builtin_amdgcn_mfma_f32_32x32x16_bf16(pa0, (bf16x8){l0[0], l0[1], l0[2], l0[3], h0[0], h0[1], h0[2], h0[3]}, o[d0], 0, 0, 0);   \
        o[d0] = __builtin_amdgcn_mfma_f32_32x32x16_bf16(pa1, (bf16x8){l1[0], l1[1], l1[2], l1[3], h1[0], h1[1], h1[2], h1[3]}, o[d0], 0, 0, 0);   \
        o[d0] = __builtin_amdgcn_mfma_f32_32x32x16_bf16(pa2, (bf16x8){l2[0], l2[1], l2[2], l2[3], h2[0], h2[1], h2[2], h2[3]}, o[d0], 0, 0, 0);   \
        o[d0] = __builtin_amdgcn_mfma_f32_32x32x16_bf16(pa3, (bf16x8){l3[0], l3[1], l3[2], l3[3], h3[0], h3[1], h3[2], h3[3]}, o[d0], 0, 0, 0); } while (0)
    PV_D0(0); PV_D0(1); PV_D0(2); PV_D0(3);
#undef PV_D0
#undef TRRD
}


template <class TIn, class TOut> struct BlockRef { const TIn* Q; const TIn* K; const TIn* V; TOut* O; int P0; int jlo; };
#define ROW(p, k0, rr) ((p) + (size_t)((k0) + (rr)) * LD + sc)
#define VMW() asm volatile("s_waitcnt vmcnt(0)" ::: "memory")
#define SLOAD_H(Kp, Vp, k0) do { st_v0 = load8<TIn>(ROW(Vp, k0, sr)); st_v1 = load8<TIn>(ROW(Vp, k0, 32 + sr));              \
                         st_k0 = load8<TIn>(ROW(Kp, k0, sr)); st_k1 = load8<TIn>(ROW(Kp, k0, 32 + sr)); } while (0)
#define SWRITE_H(bf) do { *(bf16x8*)(V_lds + (bf) * SHM_V + vst0) = st_v0; *(bf16x8*)(V_lds + (bf) * SHM_V + vst1) = st_v1;   \
                          *(bf16x8*)(K_lds + (bf) * SHM_K + kws) = st_k0; *(bf16x8*)(K_lds + (bf) * SHM_K + kws + 32 * 256) = st_k1; } while (0)
template <class TIn, class TOut>
__device__ __forceinline__ void attn_unit(const BlockRef<TIn, TOut>& cur, int skv, char* lds) {
    const int tid = threadIdx.x, wid = __builtin_amdgcn_readfirstlane(tid >> 6), lane = tid & 63, r32 = lane & 31, hi = lane >> 5;
    const unsigned W = 0x40000000u;
    const int j_lo = cur.jlo;
    int j_hi = (cur.P0 + QB - 1) / KVBLK + 1; if (j_hi > skv / KVBLK) j_hi = skv / KVBLK;
    const int NT = j_hi - j_lo;
    const int qlo = cur.P0 + wid * QBLK, qm = qlo + r32 - 4 * hi;
    char* V_lds = lds; char* K_lds = lds + 2 * SHM_V;
    float* ws = (float*)(lds + 2 * SHM_V + 2 * SHM_K) + wid * 64; float* li_l = ws, * al_l = ws + 32;
    const float* bias_l = (const float*)(lds + LDS_BYTES) + 4 * hi;
    float m_reg = -1e30f, l_reg = 0; f32x16 o[4] = {};
    const int sr = tid >> 4, sc = (tid & 15) * 8, vst0 = v_st(sr, sc), vst1 = v_st(32 + sr, sc), kws = KSWZ(sr, sc * 2);
    const int vb0 = (int)(uintptr_t)V_lds + v_rd_base(lane);
    const TIn* Kh = cur.K; const TIn* Vh = cur.V;
    bf16x8 st_v0, st_v1, st_k0, st_k1; bf16x8 qr[8];
#define KBASE(t) ((j_lo + (t)) * KVBLK)
#define BT(t) (bias_l + (t) * KVBLK)
#define RESC(a) do { if (__any((a) < 1.f)) { if (hi == 0) al_l[r32] = (a); asm volatile("s_waitcnt lgkmcnt(0)" ::: "memory");              \
                     for (int d_ = 0; d_ < 4; ++d_) for (int r = 0; r < 16; ++r) o[d_][r] *= al_l[crow(r, hi)]; } } while (0)
#define MASKT(P0_, P1_, t) do { const int kb_ = KBASE(t); if (kb_ + KVBLK - 1 > qlo) mask_tile(P0_, P1_, qm - kb_, W); } while (0)
#pragma unroll
    for (int d0 = 0; d0 < 8; ++d0) qr[d0] = load8<TIn>(cur.Q + (size_t)(wid * QBLK + r32) * LD + d0 * 16 + hi * 8);
    SLOAD_H(Kh, Vh, KBASE(0)); VMW(); SWRITE_H(0); SBAR();
    if (NT > 1) SLOAD_H(Kh, Vh, KBASE(1));
    __syncthreads();
    f32x16 p0, p1; float mn, al; bf16x8 pa0, pa1, pa2, pa3;
#define TILE_STEP(t, BUF) do {                                                                                                 \
        SBAR(); qkt<BUF, false>(p0, p1, K_lds, r32, hi, qr, true, BT(t));                                                       \
        MASKT(p0, p1, (t)); partialSM(p0, p1, m_reg, mn, al); RESC(al);                                                          \
        finishSM(p0, p1, al, l_reg, pa0, pa1, pa2, pa3); SBAR();                                                                 \
        pv_tile<BUF, false>(o, vb0, pa0, pa1, pa2, pa3, true);                                                                    \
        if ((t) + 1 < NT) { VMW(); SWRITE_H(1 - (BUF)); SBAR(); if ((t) + 2 < NT) SLOAD_H(Kh, Vh, KBASE((t) + 2)); }              \
        __syncthreads(); } while (0)
    for (int t = 0; t < NT; t += 2) {
        TILE_STEP(t, 0);
        if (t + 1 < NT) TILE_STEP(t + 1, 1);
    }
    if (hi == 0) li_l[r32] = l_reg; asm volatile("s_waitcnt lgkmcnt(0)" ::: "memory");
    float rli[16];
#pragma unroll
    for (int r = 0; r < 16; ++r) rli[r] = __builtin_amdgcn_rcpf(li_l[crow(r, hi)]);
    TOut* Ow = cur.O + (size_t)(wid * QBLK) * LD;
#pragma unroll
    for (int r = 0; r < 16; ++r) { const int orow = crow(r, hi);
#pragma unroll
        for (int d0 = 0; d0 < 4; ++d0) { const float v = o[d0][r] * rli[r];
            const float vn = __shfl_xor(v, 1);
            if ((r32 & 1) == 0) *(unsigned*)(Ow + (size_t)orow * LD + d0 * 32 + r32) = cvtpk(v, vn); } }
    __syncthreads();
#undef TILE_STEP
#undef RESC
#undef KBASE
#undef BT
#undef MASKT
}
#undef ROW
#undef VMW
#undef SLOAD_H
#undef SWRITE_H
}
#define GAS __attribute__((address_space(1)))
#define LAS __attribute__((address_space(3)))
typedef unsigned short bf16;
typedef unsigned v4u __attribute__((ext_vector_type(4)));
typedef unsigned v2u __attribute__((ext_vector_type(2)));
typedef float f32x4 __attribute__((ext_vector_type(4)));
typedef float f32x2 __attribute__((ext_vector_type(2)));
typedef short bf16x8 __attribute__((ext_vector_type(8)));
typedef GAS unsigned gu32;
#define RLX_AGENT __ATOMIC_RELAXED, __HIP_MEMORY_SCOPE_AGENT

constexpr int S = 8192, DM = 4096, NH = 16, HD = 128, AW = 2048, LW = 2048, NG = 16, GD = 128;
constexpr int NIN = 18448, NINP = 18432;
constexpr int C_Q = 0, C_K = 2048, C_V = 4096, C_F = 6144, C_LX = 6160, C_LY = 8208, C_GA = 10256, C_GL = 14352;
constexpr int PEER_H = 8, PEER_NK = 128, PEER_K = 16, PEER_NE = 16384;
constexpr float EPS = 1e-6f;
constexpr size_t MiB = 1u << 20;
constexpr size_t WS_CTL = 0, CTL_ZERO_BYTES = 1 * MiB;
constexpr size_t WS_MOD = 512 * 1024;
constexpr size_t WS_WF = 2 * MiB;
constexpr size_t WS_LOGF = 3 * MiB;
constexpr size_t WS_FC = 4 * MiB;
constexpr size_t WS_AGGA = 5 * MiB, WS_AGGB = 6 * MiB;
constexpr size_t WS_BIASR = 7 * MiB, WS_SB = 7 * MiB + 262144;
constexpr size_t WS_SSQ = 28 * MiB;
constexpr size_t WS_WAT = 8 * MiB, WS_WXT = 9 * MiB;
constexpr size_t WS_SK = 10 * MiB, WS_RS = 11 * MiB, WS_RSU = 11 * MiB + 65536;
constexpr size_t WS_IDX = 12 * MiB, WS_GATE = 16 * MiB, WS_IDX2 = 20 * MiB, WS_GATE2 = 24 * MiB;
constexpr size_t WS_WIN = 32 * MiB, WS_WAO = 176 * MiB, WS_WLO = 192 * MiB, WS_WOUT = 208 * MiB, WS_WPQ = 240 * MiB;
constexpr size_t WS_U = 256 * MiB, WS_V = 384 * MiB;
constexpr size_t WS_HA = 512 * MiB;
constexpr size_t WS_QKV = 576 * MiB;
constexpr size_t WS_LX = 672 * MiB, WS_GY = 704 * MiB, WS_GA = 736 * MiB, WS_GL = 800 * MiB;
constexpr size_t WS_ATT = 864 * MiB, WS_LR = 896 * MiB, WS_T1 = 928 * MiB, WS_MG = 992 * MiB, WS_Q2 = 1056 * MiB, WS_X1 = 1088 * MiB, WS_END = 1216 * MiB;
constexpr int CW_BAR = 4096;
constexpr int CW_QATT = 256;
constexpr int RING_BYTES = 131072;
constexpr int LDSCTL_OFF = RING_BYTES, MISC_OFF = LDSCTL_OFF + 320;
constexpr int LDS_BYTES = 151552;
constexpr int NWAVES = 8, NTHREADS = 512;

__device__ __forceinline__ unsigned f2bf(float f) { unsigned u = __builtin_bit_cast(unsigned, f); return (u + 0x7fffu + ((u >> 16) & 1u)) >> 16; }
__device__ __forceinline__ unsigned pk2(float lo, float hi) { return f2bf(lo) | (f2bf(hi) << 16); }
__device__ __forceinline__ float bflo(unsigned w) { return __uint_as_float(w << 16); }
__device__ __forceinline__ float bfhi(unsigned w) { return __uint_as_float(w & 0xffff0000u); }
__device__ __forceinline__ float bf2f(bf16 b) { return __uint_as_float((unsigned)b << 16); }
__device__ __forceinline__ float wave_sum(float v) {
#pragma unroll
    for (int o = 1; o < 64; o <<= 1) v += __shfl_xor(v, o);
    return v;
}
__device__ __forceinline__ float wave_max(float v) {
#pragma unroll
    for (int o = 1; o < 64; o <<= 1) v = fmaxf(v, __shfl_xor(v, o));
    return v;
}
__device__ __forceinline__ float sigmoidf_(float v) { return __builtin_amdgcn_rcpf(1.0f + __builtin_amdgcn_exp2f(-1.4426950408889634f * v)); }
__device__ __forceinline__ float gelu_erf(float v) { return 0.5f * v * (1.0f + erff(v * 0.70710678118654752f)); }
#define XB_TMO      128
#define XB_XCNT(j)  (256  + 64 * (j))
#define XB_XSUB(j)  (1280 + 64 * (j))
#define XB_XGEN(j)  (2304 + 64 * (j))
#define XB_TOP      3328
#define XB_TOPGEN   3392
#define XCD_BAR_WORDS 3456
#define XB_SPIN_CAP (1u << 18)

__device__ __forceinline__ unsigned xb_ld(unsigned* p)              { return __hip_atomic_load(p, __ATOMIC_RELAXED, __HIP_MEMORY_SCOPE_AGENT); }
__device__ __forceinline__ unsigned xb_add(unsigned* p, unsigned v) { return __hip_atomic_fetch_add(p, v, __ATOMIC_RELAXED, __HIP_MEMORY_SCOPE_AGENT); }
__device__ __forceinline__ unsigned xb_xcc_id() { return (unsigned)__builtin_amdgcn_s_getreg((3 << 11) | 20) & 0xFu; }
#define XB_SPIN(cond, bar) do { unsigned _sp = 0; while (cond) { __builtin_amdgcn_s_sleep(1); \
    if ((++_sp & 255u) == 0u) { if (xb_ld(&(bar)[XB_TMO])) break; if (_sp > XB_SPIN_CAP) { atomicAdd(&(bar)[XB_TMO], 1u); break; } } } } while (0)

struct XcdBarrier {
    unsigned* bar; unsigned x;
    volatile LAS unsigned* st;
};

__device__ __forceinline__ XcdBarrier xcd_barrier_post(unsigned* bar, volatile LAS unsigned* st) {
    XcdBarrier b; b.bar = bar; b.x = xb_xcc_id(); b.st = st;
    if (threadIdx.x == 0) (void)xb_add(&bar[XB_XCNT(b.x)], 1u);
    return b;
}
__device__ __forceinline__ void xcd_barrier_complete(unsigned* bar, unsigned x, unsigned& nloc, unsigned& nx) {
    const unsigned G = gridDim.x * gridDim.y * gridDim.z;
    unsigned sum, cnt, mine, sp = 0u;
    for (;;) {
        sum = 0u; cnt = 0u; mine = 0u;
#pragma unroll
        for (unsigned j = 0; j < 16; ++j) { const unsigned c = xb_ld(&bar[XB_XCNT(j)]); sum += c; cnt += (c > 0u) ? 1u : 0u; mine = (j == x) ? c : mine; }
        if (sum == G) break;
        __builtin_amdgcn_s_sleep(1);
        if ((++sp & 255u) == 0u) { if (xb_ld(&bar[XB_TMO])) break; if (sp > XB_SPIN_CAP) { atomicAdd(&bar[XB_TMO], 1u); break; } }
    }
    nloc = mine > 0u ? mine : 1u; nx = cnt > 0u ? cnt : 1u;
}

__device__ __forceinline__ void xcd_barrier(const XcdBarrier& b) {
    asm volatile("s_waitcnt vmcnt(0)" ::: "memory");
    __syncthreads();
    if (threadIdx.x == 0) {
        unsigned* bar = b.bar;
        __builtin_amdgcn_s_waitcnt(0);
        unsigned nloc = b.st[0], nx = b.st[1];
        if (nloc == 0u) { xcd_barrier_complete(bar, b.x, nloc, nx); b.st[0] = nloc; b.st[1] = nx; }
        const unsigned old = xb_add(&bar[XB_XSUB(b.x)], 1u);
        const unsigned gen = old / nloc;
        if (old + 1u == (gen + 1u) * nloc) {
            __builtin_amdgcn_fence(__ATOMIC_RELEASE, "agent");
            asm volatile("s_waitcnt vmcnt(0)" ::: "memory");
            const unsigned og = xb_add(&bar[XB_TOP], 1u);
            const unsigned tg = og / nx;
            if (og + 1u == (tg + 1u) * nx) xb_add(&bar[XB_TOPGEN], 1u);
            else XB_SPIN(xb_ld(&bar[XB_TOPGEN]) == tg, bar);
            __builtin_amdgcn_fence(__ATOMIC_ACQUIRE, "agent");
            xb_add(&bar[XB_XGEN(b.x)], 1u);
            asm volatile("s_waitcnt vmcnt(0)" ::: "memory");
        } else {
            XB_SPIN(xb_ld(&bar[XB_XGEN(b.x)]) == gen, bar);
            __builtin_amdgcn_fence(__ATOMIC_ACQUIRE, "agent");
            asm volatile("s_waitcnt vmcnt(0)" ::: "memory");
        }
    }
    __syncthreads();
}
struct Args { const float* in[24]; float* out; unsigned char* ws; int ph_lo, ph_hi, rep_att, rep_lru; };
struct Frame {
    LAS unsigned char* lds; volatile LAS unsigned* MISC; gu32* ctl;
    int tid, lane, wave, vcu, G;
    unsigned char* ws; float* out;
};
#define WSP(T, off) ((T*)(F.ws + (off)))
#define LDS_WAIT() asm volatile("s_waitcnt lgkmcnt(0)" ::: "memory")

__device__ __forceinline__ void transpose_item(const float* W, int ldw, int K, bf16* WT, LAS float* scr, int k0, int nsrc0, int ndst0, int lane) {
    float v[32]; const float* wp = W + (size_t)(k0 + (lane >> 5)) * ldw + nsrc0 + (lane & 31);
#pragma unroll
    for (int i = 0; i < 32; ++i) v[i] = wp[(size_t)(2 * i) * ldw];
#pragma unroll
    for (int i = 0; i < 32; ++i) scr[(2 * i + (lane >> 5)) * 33 + (lane & 31)] = v[i];
    LDS_WAIT(); asm volatile("" ::: "memory");
    const int c = lane & 7;
#pragma unroll
    for (int j = 0; j < 4; ++j) { const int n = (lane >> 3) + 8 * j; const LAS float* s = scr + (8 * c) * 33 + n;
        v4u o; o.x = pk2(s[0 * 33], s[1 * 33]); o.y = pk2(s[2 * 33], s[3 * 33]); o.z = pk2(s[4 * 33], s[5 * 33]); o.w = pk2(s[6 * 33], s[7 * 33]);
        *(GAS v4u*)(WT + (size_t)(ndst0 + n) * K + k0 + 8 * c) = o; }
    LDS_WAIT(); asm volatile("" ::: "memory");
}
__device__ __forceinline__ void cvt_stream(const float* src, bf16* dst, size_t n8, size_t i0, size_t stride) {
    for (size_t i = i0; i < n8; i += stride) { const f32x4 a = ((const GAS f32x4*)src)[2 * i], b = ((const GAS f32x4*)src)[2 * i + 1];
        v4u o; o.x = pk2(a[0], a[1]); o.y = pk2(a[2], a[3]); o.z = pk2(b[0], b[1]); o.w = pk2(b[2], b[3]); ((GAS v4u*)dst)[i] = o; }
}
__device__ __forceinline__ void cvt_stream_fp8(const float* src, unsigned char* dst, size_t n16, float scale, size_t i0, size_t stride) {
    for (size_t i = i0; i < n16; i += stride) { v4u o;
#pragma unroll
        for (int q = 0; q < 4; ++q) { const f32x4 a = ((const GAS f32x4*)src)[4 * i + q] * scale; int w = 0;
            w = __builtin_amdgcn_cvt_pk_fp8_f32(a[0], a[1], w, false); w = __builtin_amdgcn_cvt_pk_fp8_f32(a[2], a[3], w, true); o[q] = (unsigned)w; }
        ((GAS v4u*)dst)[i] = o; }
}
__device__ __forceinline__ void cvt_table_fp4(Frame& F, const float* srcT, unsigned char* dstT, float* rsT, int gw, int NGW) {
    for (int row = gw; row < PEER_NE; row += NGW) {
        const GAS f32x4* src = (const GAS f32x4*)(srcT + (size_t)row * DM); f32x4 a[16]; float am = 0.f;
#pragma unroll
        for (int c = 0; c < 4; ++c)
#pragma unroll
            for (int q = 0; q < 4; ++q) { a[4 * c + q] = src[c * 256 + 4 * F.lane + q]; am = fmaxf(fmaxf(am, fmaxf(fabsf(a[4 * c + q][0]), fabsf(a[4 * c + q][1]))), fmaxf(fabsf(a[4 * c + q][2]), fabsf(a[4 * c + q][3]))); }
        am = wave_max(am); const float inv = am > 0.f ? 6.0f / am : 0.f;
#pragma unroll
        for (int c = 0; c < 4; ++c) { v2u o;
#pragma unroll
            for (int d = 0; d < 2; ++d) { unsigned w = 0u; const f32x4 x0 = a[4 * c + 2 * d] * inv, x1 = a[4 * c + 2 * d + 1] * inv;
                w = __builtin_amdgcn_cvt_scalef32_pk_fp4_f32(w, x0[0], x0[1], 1.0f, 0); w = __builtin_amdgcn_cvt_scalef32_pk_fp4_f32(w, x0[2], x0[3], 1.0f, 1);
                w = __builtin_amdgcn_cvt_scalef32_pk_fp4_f32(w, x1[0], x1[1], 1.0f, 2); w = __builtin_amdgcn_cvt_scalef32_pk_fp4_f32(w, x1[2], x1[3], 1.0f, 3); o[d] = w; }
            *((GAS v2u*)(dstT + (size_t)row * 2048 + c * 512) + F.lane) = o; }
        if (F.lane == 0) rsT[row] = am * (1.0f / 6.0f);
    }
}
__device__ __forceinline__ void p0_prologue(Frame& F, const Args& args) {
#ifndef P0_REP
#define P0_REP 0
#endif
    _Pragma("unroll") for (int rep_ = 0; rep_ < ((P0_REP & 1) ? 2 : 1); ++rep_)
    { LAS float* sc = (LAS float*)F.lds; LAS f32x4* red = (LAS f32x4*)(F.lds + 16384); float* MOD = WSP(float, WS_MOD);
      for (int cgi = blockIdx.x; cgi < 256; cgi += F.G) {
          for (int i = F.tid; i < DM; i += NTHREADS) { const float cv = args.in[1][i]; sc[i] = cv / (1.0f + __expf(-cv)); }
          __syncthreads();
          if (F.tid < 384) { const int cg = F.tid % 24, rg = F.tid / 24;
              const GAS f32x4* Wp = (const GAS f32x4*)args.in[2] + cgi * 24 + cg;
              f32x4 acc = {0.f, 0.f, 0.f, 0.f};
#pragma unroll 8
              for (int r = rg; r < DM; r += 16) acc += sc[r] * Wp[(size_t)r * 6144];
              red[rg * 24 + cg] = acc; }
          __syncthreads();
          if (F.tid < 24) { f32x4 s = red[F.tid];
#pragma unroll
              for (int rg = 1; rg < 16; ++rg) s += red[rg * 24 + F.tid];
              s += ((const GAS f32x4*)args.in[3])[cgi * 24 + F.tid]; ((GAS f32x4*)MOD)[cgi * 24 + F.tid] = s; }
          __syncthreads();
      } }
    LAS float* scr = (LAS float*)(F.lds + F.wave * 16384);
    const int gw = F.vcu * NWAVES + F.wave, NGW = F.G * NWAVES;
    constexpr int I_IN = 64 * 576, I_AO = 32 * 128, I_LO = 32 * 128, I_OUT = 64 * 128, I_PQ = 64 * 64, I_WA = 16 * 2 * 4, I_WX = I_WA;
    constexpr int NITEMS = I_IN + I_AO + I_LO + I_OUT + I_PQ + I_WA + I_WX;
    _Pragma("unroll") for (int rep_ = 0; rep_ < ((P0_REP & 2) ? 2 : 1); ++rep_)
    for (int it = gw; it < NITEMS; it += NGW) {
        int r = it;
        if (r < I_IN) { const int kb = r / 576, nb = r % 576; transpose_item(args.in[6], NIN, DM, WSP(bf16, WS_WIN), scr, 64 * kb, 32 * nb + (nb >= 192 ? 16 : 0), 32 * nb, F.lane); continue; } r -= I_IN;
        if (r < I_AO) { const int kb = r / 128, nb = r % 128; transpose_item(args.in[17], DM, AW, WSP(bf16, WS_WAO), scr, 64 * kb, 32 * nb, 32 * nb, F.lane); continue; } r -= I_AO;
        if (r < I_LO) { const int kb = r / 128, nb = r % 128; transpose_item(args.in[18], DM, LW, WSP(bf16, WS_WLO), scr, 64 * kb, 32 * nb, 32 * nb, F.lane); continue; } r -= I_LO;
        if (r < I_OUT) { const int kb = r / 128, nb = r % 128; transpose_item(args.in[19], DM, DM, WSP(bf16, WS_WOUT), scr, 64 * kb, 32 * nb, 32 * nb, F.lane); continue; } r -= I_OUT;
        if (r < I_PQ) { const int kb = r / 64, nb = r % 64; transpose_item(args.in[20], 2048, DM, WSP(bf16, WS_WPQ), scr, 64 * kb, 32 * nb, 32 * nb, F.lane); continue; } r -= I_PQ;
        { const bool isx = r >= I_WA; if (isx) r -= I_WA; const int g = r >> 3, kb = (r >> 2) & 1, nb = r & 3;
          transpose_item((isx ? args.in[14] : args.in[12]) + (size_t)g * GD * GD, GD, GD, WSP(bf16, isx ? WS_WXT : WS_WAT) + (size_t)g * GD * GD, scr, 64 * kb, 32 * nb, 32 * nb, F.lane); }
    }
    const size_t gt = (size_t)F.vcu * NTHREADS + F.tid, NGT = (size_t)F.G * NTHREADS;
    _Pragma("unroll") for (int rep_ = 0; rep_ < ((P0_REP & 4) ? 2 : 1); ++rep_) {
    cvt_table_fp4(F, args.in[23], WSP(unsigned char, WS_V), WSP(float, WS_RS), gw, NGW);
    cvt_table_fp4(F, args.in[22], WSP(unsigned char, WS_U), WSP(float, WS_RSU), gw, NGW); }
    cvt_stream(args.in[21], WSP(bf16, WS_SK), (size_t)PEER_H * 2 * 128 * 128 / 8, gt, NGT);
    for (size_t i = gt; i < (size_t)DM * 16; i += NGT) WSP(float, WS_WF)[i] = args.in[6][(i >> 4) * NIN + C_F + (i & 15)];
    for (size_t i = gt; i < (size_t)NINP; i += NGT) WSP(float, WS_BIASR)[i] = args.in[7][i + (i >= (size_t)C_F ? 16 : 0)];
}

__device__ __forceinline__ void p1_norm_forget(Frame& F, const Args& args) {
    const int gw = F.vcu * NWAVES + F.wave, NGW = F.G * NWAVES; const float* MOD = WSP(float, WS_MOD); const float* WF = WSP(float, WS_WF); bf16* HA = WSP(bf16, WS_HA);
    for (int rg = gw; rg < S / 4; rg += NGW) {
        const int r0 = rg * 4; float rstd[4];
#pragma unroll
        for (int r = 0; r < 4; ++r) { const GAS f32x4* xr = (const GAS f32x4*)(args.in[0] + (size_t)(r0 + r) * DM) + F.lane; float ss = 0.f;
#pragma unroll
            for (int j = 0; j < 16; ++j) { const f32x4 v = xr[64 * j]; ss += (v[0] * v[0] + v[1] * v[1]) + (v[2] * v[2] + v[3] * v[3]); }
            rstd[r] = 1.0f / sqrtf(wave_sum(ss) * (1.0f / DM) + EPS); }
        float acc[4][16];
#pragma unroll
        for (int r = 0; r < 4; ++r)
#pragma unroll
            for (int cc = 0; cc < 16; ++cc) acc[r][cc] = 0.f;
        for (int j = 0; j < 16; ++j) {
            const int i4 = F.lane + 64 * j;
            const f32x4 g = ((const GAS f32x4*)args.in[4])[i4], scl = ((const GAS f32x4*)(MOD + 4096))[i4], sh = ((const GAS f32x4*)MOD)[i4];
            const f32x4 mul = g * (scl + 1.0f);
            f32x4 wf[4][4];
#pragma unroll
            for (int i = 0; i < 4; ++i)
#pragma unroll
                for (int q = 0; q < 4; ++q) wf[i][q] = ((const GAS f32x4*)(WF + (size_t)(4 * i4 + i) * 16))[q];
#pragma unroll
            for (int r = 0; r < 4; ++r) {
                const f32x4 xv = ((const GAS f32x4*)(args.in[0] + (size_t)(r0 + r) * DM))[i4];
                const f32x4 hv = xv * rstd[r] * mul + sh;
                v2u o; o.x = pk2(hv[0], hv[1]); o.y = pk2(hv[2], hv[3]);
                ((GAS v2u*)(HA + (size_t)(r0 + r) * DM))[i4] = o;
#pragma unroll
                for (int i = 0; i < 4; ++i)
#pragma unroll
                    for (int q = 0; q < 4; ++q)
#pragma unroll
                        for (int e = 0; e < 4; ++e) acc[r][4 * q + e] += hv[i] * wf[i][q][e];
            }
        }
#pragma unroll
        for (int r = 0; r < 4; ++r)
#pragma unroll
            for (int cc = 0; cc < 16; ++cc) { const float tot = wave_sum(acc[r][cc]);
                if (F.lane == cc) { const float f = tot + args.in[7][C_F + cc]; WSP(float, WS_LOGF)[(size_t)cc * S + r0 + r] = fminf(f, 0.f) - log1pf(__expf(-fabsf(f))); } }
    }
}

__device__ __forceinline__ void p1_shift_proj(Frame& F, const Args& args) {
    const int gw = F.vcu * NWAVES + F.wave, NGW = F.G * NWAVES; const float* sh2 = WSP(float, WS_MOD) + 12288; const bf16* WT = WSP(bf16, WS_WPQ);
    for (int col = gw; col < 2048; col += NGW) { float s = 0.f;
#pragma unroll
        for (int c = 0; c < 8; ++c) { const v4u w = *((const GAS v4u*)(WT + (size_t)col * DM + c * 512) + F.lane); const GAS f32x4* sp = (const GAS f32x4*)(sh2 + c * 512 + F.lane * 8); const f32x4 a = sp[0], b = sp[1];
            s += (bflo(w.x) * a[0] + bfhi(w.x) * a[1]) + (bflo(w.y) * a[2] + bfhi(w.y) * a[3]) + (bflo(w.z) * b[0] + bfhi(w.z) * b[1]) + (bflo(w.w) * b[2] + bfhi(w.w) * b[3]); }
        s = wave_sum(s); if (F.lane == 0) WSP(float, WS_SB)[col] = s; }
}

__device__ __forceinline__ void p3_qknorm(Frame& F, const Args& args) {
    const int gw = F.vcu * NWAVES + F.wave, NGW = F.G * NWAVES; bf16* QK = WSP(bf16, WS_QKV);
    const int sub = F.lane & 15;
    f32x4 gq0 = ((const GAS f32x4*)args.in[8])[2 * sub], gq1 = ((const GAS f32x4*)args.in[8])[2 * sub + 1], gk0 = ((const GAS f32x4*)args.in[9])[2 * sub], gk1 = ((const GAS f32x4*)args.in[9])[2 * sub + 1];
    for (int it = gw; it < 2 * S * NH / 4; it += NGW) {
        const size_t unit = (size_t)it * 4 + (F.lane >> 4); const bool isk = unit >= (size_t)S * NH;
        GAS v4u* p = (GAS v4u*)(QK + unit * 128) + sub; const v4u w = *p;
        f32x4 a = {bflo(w.x), bfhi(w.x), bflo(w.y), bfhi(w.y)}, b = {bflo(w.z), bfhi(w.z), bflo(w.w), bfhi(w.w)};
        float ss = (a[0] * a[0] + a[1] * a[1]) + (a[2] * a[2] + a[3] * a[3]) + (b[0] * b[0] + b[1] * b[1]) + (b[2] * b[2] + b[3] * b[3]);
        ss += __shfl_xor(ss, 1); ss += __shfl_xor(ss, 2); ss += __shfl_xor(ss, 4); ss += __shfl_xor(ss, 8);
        const float rs = 1.0f / sqrtf(ss * (1.0f / HD) + EPS);
        a = a * rs * (isk ? gk0 : gq0); b = b * rs * (isk ? gk1 : gq1);
        v4u o; o.x = pk2(a[0], a[1]); o.y = pk2(a[2], a[3]); o.z = pk2(b[0], b[1]); o.w = pk2(b[2], b[3]); *p = o;
    }
}
__device__ __forceinline__ void p3_cumsum(Frame& F, const Args& args) {
    LAS float* wt = (LAS float*)F.lds;
    for (int h = blockIdx.x; h < NH; h += F.G) {
        const float* LF = WSP(float, WS_LOGF); float v[16]; float run = 0.f;
        { const GAS f32x4* lp = (const GAS f32x4*)(LF + (size_t)h * S + F.tid * 16); const f32x4 l0 = lp[0], l1 = lp[1], l2 = lp[2], l3 = lp[3];
          const float lv[16] = {l0[0], l0[1], l0[2], l0[3], l1[0], l1[1], l1[2], l1[3], l2[0], l2[1], l2[2], l2[3], l3[0], l3[1], l3[2], l3[3]};
#pragma unroll
          for (int i = 0; i < 16; ++i) { run += lv[i]; v[i] = run; } }
        float sc = run;
#pragma unroll
        for (int o = 1; o < 64; o <<= 1) { const float t = __shfl_up(sc, o); if (F.lane >= o) sc += t; }
        if (F.lane == 63) wt[F.wave] = sc;
        __syncthreads();
        float pre = sc - run;
        for (int w = 0; w < F.wave; ++w) pre += wt[w];
        float* Fo = WSP(float, WS_FC) + (size_t)h * S + F.tid * 16;
#pragma unroll
        for (int i = 0; i < 4; ++i) ((GAS f32x4*)Fo)[i] = (f32x4){v[4 * i] + pre, v[4 * i + 1] + pre, v[4 * i + 2] + pre, v[4 * i + 3] + pre};
        __syncthreads();
    }
}
constexpr int LRU_XCF = 0, LRU_XCB = 32768, LRU_AB = 49152, LRU_BB = 81920, LRU_QA = 114688, LRU_CAR = 118784, LRU_XR = 133120;
template <int PASS> __device__ __forceinline__ void lru_chunk(Frame& F, const Args& args, int c, int g) {
    LAS float* XCF = (LAS float*)(F.lds + LRU_XCF); LAS unsigned char* XCB = F.lds + LRU_XCB; LAS float* AB = (LAS float*)(F.lds + LRU_AB); LAS float* BB = (LAS float*)(F.lds + LRU_BB);
    LAS float* QA = (LAS float*)(F.lds + LRU_QA); LAS float* CAR = (LAS float*)(F.lds + LRU_CAR); LAS bf16* XR = (LAS bf16*)(F.lds + LRU_XR);
    const int t0 = 64 * c, ch0 = GD * g; const bf16* LX = WSP(bf16, WS_LX);
    for (int p = F.tid; p < 67 * 16; p += NTHREADS) { const int r = p >> 4, cc = p & 15, tg = t0 - 3 + r; v4u v = {0u, 0u, 0u, 0u};
        if (tg >= 0) v = *(const GAS v4u*)(LX + (size_t)tg * LW + ch0 + cc * 8);
        *(LAS v4u*)(XR + r * 128 + cc * 8) = v; }
    __syncthreads();
    { const int ch = F.tid & 127, tq = F.tid >> 7, gch = ch0 + ch;
      const float w0 = args.in[10][gch], w1 = args.in[10][LW + gch], w2 = args.in[10][2 * LW + gch], w3 = args.in[10][3 * LW + gch], cb = args.in[11][gch];
      float xm3 = bf2f(XR[(16 * tq + 0) * 128 + ch]), xm2 = bf2f(XR[(16 * tq + 1) * 128 + ch]), xm1 = bf2f(XR[(16 * tq + 2) * 128 + ch]);
#pragma unroll
      for (int i = 0; i < 16; ++i) { const int t = 16 * tq + i; const float x0 = bf2f(XR[(t + 3) * 128 + ch]);
          const float xc = w0 * xm3 + w1 * xm2 + w2 * xm1 + w3 * x0 + cb; xm3 = xm2; xm2 = xm1; xm1 = x0;
          XCF[t * 128 + ch] = xc; *(LAS bf16*)(XCB + t * 256 + ((ch * 2) ^ ((t & 7) << 4))) = (bf16)f2bf(xc); } }
    __syncthreads();
    { const int fr = F.lane & 15, fq = F.lane >> 4, j = 16 * F.wave + fr;
      const bf16* WA = WSP(bf16, WS_WAT) + (size_t)g * GD * GD + (size_t)j * GD + 8 * fq; const bf16* WX = WSP(bf16, WS_WXT) + (size_t)g * GD * GD + (size_t)j * GD + 8 * fq;
      bf16x8 ba[4], bx[4];
#pragma unroll
      for (int ks = 0; ks < 4; ++ks) { ba[ks] = *(const GAS bf16x8*)(WA + 32 * ks); bx[ks] = *(const GAS bf16x8*)(WX + 32 * ks); }
      const int gch = ch0 + j; const float bav = args.in[13][gch], bxv = args.in[15][gch], lam = args.in[16][gch];
      const float sp8 = -8.0f * 1.4426950408889634f * ((lam > 0.f ? 0.f : -lam) + log1pf(__expf(-fabsf(lam))));
#pragma unroll
      for (int mt = 0; mt < 4; ++mt) { f32x4 ar = {0.f, 0.f, 0.f, 0.f}, ax = {0.f, 0.f, 0.f, 0.f}; const int t = 16 * mt + fr;
#pragma unroll
          for (int ks = 0; ks < 4; ++ks) { const bf16x8 af = *(const LAS bf16x8*)(XCB + t * 256 + (((32 * ks + 8 * fq) * 2) ^ ((t & 7) << 4)));
              ar = __builtin_amdgcn_mfma_f32_16x16x32_bf16(af, ba[ks], ar, 0, 0, 0); ax = __builtin_amdgcn_mfma_f32_16x16x32_bf16(af, bx[ks], ax, 0, 0, 0); }
#pragma unroll
          for (int rg = 0; rg < 4; ++rg) { const int tt = 16 * mt + 4 * fq + rg; const float xcv = XCF[tt * 128 + j];
              const float rgt = sigmoidf_(ar[rg] + bav), igt = sigmoidf_(ax[rg] + bxv);
              const float a = __builtin_amdgcn_exp2f(rgt * sp8); const float om = fmaxf((1.0f - a) * (1.0f + a), 0.f);
              const float b = __builtin_amdgcn_sqrtf(om) * (igt * xcv);
              AB[tt * 128 + j] = a; BB[tt * 128 + j] = b; } } }
    __syncthreads();
    const int ch = F.tid & 127, q = F.tid >> 7;
    { float A = 1.f, B = 0.f;
#pragma unroll
      for (int i = 0; i < 16; ++i) { const int t = 16 * q + i; const float a = AB[t * 128 + ch]; B = a * B + BB[t * 128 + ch]; A *= a; }
      QA[(q * 128 + ch) * 2] = A; QA[(q * 128 + ch) * 2 + 1] = B; }
    __syncthreads();
    if (PASS == 0) {
        if (F.tid < 128) { float A = 1.f, B = 0.f;
#pragma unroll
            for (int qq = 0; qq < 4; ++qq) { const float a = QA[(qq * 128 + F.tid) * 2], b = QA[(qq * 128 + F.tid) * 2 + 1]; B = a * B + b; A *= a; }
            WSP(float, WS_AGGA)[(size_t)c * LW + ch0 + F.tid] = A; WSP(float, WS_AGGB)[(size_t)c * LW + ch0 + F.tid] = B; }
    } else {
        float h = CAR[ch];
        for (int qq = 0; qq < q; ++qq) h = QA[(qq * 128 + ch) * 2] * h + QA[(qq * 128 + ch) * 2 + 1];
#pragma unroll
        for (int i = 0; i < 16; ++i) { const int t = 16 * q + i; h = AB[t * 128 + ch] * h + BB[t * 128 + ch]; XCF[t * 128 + ch] = h; }
        __syncthreads();
        if (F.tid < 128) { float hc = CAR[F.tid];
#pragma unroll
            for (int qq = 0; qq < 4; ++qq) hc = QA[(qq * 128 + F.tid) * 2] * hc + QA[(qq * 128 + F.tid) * 2 + 1];
            CAR[F.tid] = hc; }
        const bf16* GY = WSP(bf16, WS_GY); bf16* LR = WSP(bf16, WS_LR);
        for (int p = F.tid; p < 64 * 16; p += NTHREADS) { const int r = p >> 4, cc = p & 15; const size_t o = (size_t)(t0 + r) * LW + ch0 + cc * 8;
            const v4u gy = *(const GAS v4u*)(GY + o); const f32x4 h0 = *(const LAS f32x4*)(XCF + r * 128 + cc * 8), h1 = *(const LAS f32x4*)(XCF + r * 128 + cc * 8 + 4);
            v4u ov; ov.x = pk2(h0[0] * bflo(gy.x), h0[1] * bfhi(gy.x)); ov.y = pk2(h0[2] * bflo(gy.y), h0[3] * bfhi(gy.y)); ov.z = pk2(h1[0] * bflo(gy.z), h1[1] * bfhi(gy.z)); ov.w = pk2(h1[2] * bflo(gy.w), h1[3] * bfhi(gy.w));
            *(GAS v4u*)(LR + o) = ov; }
    }
    __syncthreads();
}
template <int PASS> __device__ __forceinline__ void lru_item(Frame& F, const Args& args, int w) {
    const int g = w & 15, c0 = (w >> 4) * 8; LAS float* CAR = (LAS float*)(F.lds + LRU_CAR); LAS float* QA = (LAS float*)(F.lds + LRU_QA);
    if (PASS == 1) {
        const int ch = F.tid & 127, q = F.tid >> 7, n = c0 / 4;
        const float* GA_ = WSP(float, WS_AGGA) + GD * g + ch; const float* GB_ = WSP(float, WS_AGGB) + GD * g + ch; float A = 1.f, B = 0.f;
#pragma unroll 4
        for (int cc = q * n; cc < (q + 1) * n; ++cc) { const float a = GA_[(size_t)cc * LW], b = GB_[(size_t)cc * LW]; B = a * B + b; A *= a; }
        QA[(q * 128 + ch) * 2] = A; QA[(q * 128 + ch) * 2 + 1] = B;
        __syncthreads();
        if (F.tid < 128) { float hc = 0.f;
#pragma unroll
            for (int qq = 0; qq < 4; ++qq) hc = QA[(qq * 128 + F.tid) * 2] * hc + QA[(qq * 128 + F.tid) * 2 + 1];
            CAR[F.tid] = hc; }
        __syncthreads();
    }
    for (int c = c0; c < c0 + 8; ++c) lru_chunk<PASS>(F, args, c, g);
}
constexpr int ATT_BIAS_OFF = attn_body::LDS_BYTES;
typedef attn_body::BlockRef<bf16, bf16> ARef;
__device__ __forceinline__ int attn_jlo(const float* Fh, int qb, float TH, int lane) {
    const int t0 = qb * 256; const float f0 = Fh[t0];
    const int j0 = lane, j1 = lane + 64;
    const bool ok0 = (64 * j0 + 63 >= t0) || (f0 - Fh[64 * j0 + 63] >= -TH), ok1 = (64 * j1 + 63 >= t0) || (f0 - Fh[64 * j1 + 63] >= -TH);
    const unsigned long long m0 = __ballot(ok0), m1 = __ballot(ok1);
    return m0 ? (int)__builtin_ctzll(m0) : 64 + (int)__builtin_ctzll(m1);
}
__device__ __forceinline__ ARef attn_ref(Frame& F, const Args& args, int h, int qb, int jlo) {
    ARef r; const bf16* QK = WSP(bf16, WS_QKV);
    r.Q = QK + (size_t)(qb * 256) * AW + h * HD; r.K = QK + (size_t)S * AW + h * HD; r.V = QK + 2 * (size_t)S * AW + h * HD;
    r.O = WSP(bf16, WS_ATT) + (size_t)(qb * 256) * AW + h * HD; r.P0 = qb * 256; r.jlo = jlo; return r;
}
__device__ __forceinline__ void attn_fill_bias(Frame& F, const Args& args, int h, int qb, int jlo) {
    const float* Fh = WSP(float, WS_FC) + (size_t)h * S; LAS float* bl = (LAS float*)(F.lds + ATT_BIAS_OFF);
    const int k0 = jlo * 64, n = (qb + 1) * 256 - k0; const float fr = Fh[k0];
#pragma unroll 1
    for (int i = F.tid; i < n; i += NTHREADS) bl[i] = (fr - Fh[k0 + i]) * (1.0f / attn_body::SCALE);
}
#ifndef ATT_MARGIN
#define ATT_MARGIN 25.0f
#endif
constexpr int ATT_SCHED_OFF = 104448;
__device__ __forceinline__ void p4_attention(Frame& F, const Args& args, char* lds_generic, int rep) {
    float gq = fmaxf(fabsf(args.in[8][F.lane]), fabsf(args.in[8][F.lane + 64])), gk = fmaxf(fabsf(args.in[9][F.lane]), fabsf(args.in[9][F.lane + 64]));
    gq = wave_max(gq); gk = wave_max(gk);
    const float TH = 2.0f * (128.0f * gq * gk * attn_body::SCALE) + ATT_MARGIN;
    LAS float* Fend = (LAS float*)(F.lds + ATT_SCHED_OFF); LAS int* cost = (LAS int*)(F.lds + ATT_SCHED_OFF + 8192); LAS int* jlo_t = cost + 512; LAS int* order = cost + 1024; LAS int* slot = cost + 1536;
    const float* Fc = WSP(float, WS_FC);
    for (int p = F.tid; p < NH * 128; p += NTHREADS) Fend[p] = Fc[(size_t)(p >> 7) * S + 64 * (p & 127) + 63];
    __syncthreads();
    { const int u = F.tid, h = u >> 5, qb = u & 31, t0 = qb * 256; const float f0 = Fc[(size_t)h * S + t0];
      int lo = 0, hi = 4 * qb;
      while (lo < hi) { const int mid = (lo + hi) >> 1; const bool ok = (64 * mid + 63 >= t0) || (f0 - Fend[h * 128 + mid] >= -TH); if (ok) hi = mid; else lo = mid + 1; }
      jlo_t[u] = lo; cost[u] = 4 * (qb + 1) - lo; }
    __syncthreads();
    { const int u = F.tid, cu = cost[u]; int rk = 0;
      for (int v = 0; v < 512; ++v) { const int cv = cost[v]; rk += (cv > cu || (cv == cu && v < u)) ? 1 : 0; }
      order[rk] = u; }
    __syncthreads();
    for (;;) {
        if (F.tid == 0) slot[0] = (int)__hip_atomic_fetch_add((unsigned*)(F.ctl + CW_QATT + 64 * rep), 1u, RLX_AGENT);
        __syncthreads();
        const int k = slot[0];
        __syncthreads();
        if (k >= 512) break;
        const int u = order[k], h = u >> 5, qb = u & 31, jl = jlo_t[u];
        const ARef r0 = attn_ref(F, args, h, qb, jl);
        attn_fill_bias(F, args, h, qb, jl); __syncthreads();
        attn_body::attn_unit<bf16, bf16>(r0, S, lds_generic);
    }
}

__device__ __forceinline__ void p7_norm2(Frame& F, const Args& args) {
    const int gw = F.vcu * NWAVES + F.wave, NGW = F.G * NWAVES; const float* MOD = WSP(float, WS_MOD); bf16* HA = WSP(bf16, WS_HA);
    for (int m = gw; m < S; m += NGW) {
        const GAS f32x4* xr = (const GAS f32x4*)(WSP(float, WS_X1) + (size_t)m * DM) + F.lane; f32x4 v[16]; float ss = 0.f;
#pragma unroll
        for (int j = 0; j < 16; ++j) { v[j] = xr[64 * j]; ss += (v[j][0] * v[j][0] + v[j][1] * v[j][1]) + (v[j][2] * v[j][2] + v[j][3] * v[j][3]); }
        const float rstd = 1.0f / sqrtf(wave_sum(ss) * (1.0f / DM) + EPS);
#pragma unroll
        for (int j = 0; j < 16; ++j) { const int i4 = F.lane + 64 * j;
            const f32x4 g = ((const GAS f32x4*)args.in[5])[i4], scl = ((const GAS f32x4*)(MOD + 16384))[i4], sh = ((const GAS f32x4*)(MOD + 12288))[i4];
            const f32x4 hv = v[j] * rstd * (g * (scl + 1.0f)) + sh;
            v2u o; o.x = pk2(hv[0], hv[1]); o.y = pk2(hv[2], hv[3]); ((GAS v2u*)(HA + (size_t)m * DM))[i4] = o; }
    }
}

template <int CTRL> __device__ __forceinline__ unsigned dppu(unsigned x) { return (unsigned)__builtin_amdgcn_update_dpp(0, (int)x, CTRL, 0xF, 0xF, true); }
__device__ __forceinline__ unsigned rowmax_u32(unsigned x) { x = max(x, dppu<0xB1>(x)); x = max(x, dppu<0x4E>(x)); x = max(x, dppu<0x141>(x)); x = max(x, dppu<0x140>(x)); return x; }
__device__ __forceinline__ float rowsum_f32(float x) { x += __uint_as_float(dppu<0xB1>(__float_as_uint(x))); x += __uint_as_float(dppu<0x4E>(__float_as_uint(x)));
    x += __uint_as_float(dppu<0x141>(__float_as_uint(x))); x += __uint_as_float(dppu<0x140>(__float_as_uint(x))); return x; }
__device__ __forceinline__ unsigned ordk(float f) { const unsigned u = __float_as_uint(f); return u ^ ((unsigned)((int)u >> 31) | 0x80000000u); }
__device__ __forceinline__ float deck(unsigned k) { return __uint_as_float((k & 0x80000000u) ? (k ^ 0x80000000u) : ~k); }
#define CE_(x, y) do { const unsigned hi_ = max(x, y), lo_ = min(x, y); x = hi_; y = lo_; } while (0)
__device__ __forceinline__ unsigned row_pop16(unsigned (&a)[8], int i) {
    unsigned res = 0u;
#pragma unroll
    for (int r = 0; r < 16; ++r) { const unsigned m = rowmax_u32(a[0]); const bool win = a[0] == m;
#pragma unroll
        for (int s = 0; s < 7; ++s) a[s] = win ? a[s + 1] : a[s];
        a[7] = win ? 0u : a[7]; res = (i == r) ? m : res; }
    return res;
}
__device__ __forceinline__ void p9_topk(Frame& F, const Args& args) {
    const bf16* Q2 = WSP(bf16, WS_Q2); const bf16* SK = WSP(bf16, WS_SK); int* IDX = WSP(int, WS_IDX); float* GATE = WSP(float, WS_GATE);
    const int i = F.lane & 15, q = F.lane >> 4;
    const unsigned qlo = (unsigned)(i * 2048 + 8 * q) * 2u;
    const int h = (int)blockIdx.x & 7, ib = (int)blockIdx.x >> 3, nbh = ((int)F.G - h + 7) >> 3;
    for (int c = F.tid; c < 4096; c += NTHREADS) { const int pp = c >> 11, n = (c >> 4) & 127, ch = c & 15;
        *(LAS v4u*)(F.lds + pp * 32768 + n * 256 + ((ch * 16) ^ ((n & 7) << 4))) = *(const GAS v4u*)(SK + ((size_t)((h * 2 + pp) * 128 + n)) * 128 + ch * 8); }
    __syncthreads();
#pragma unroll 1
    for (int tg = ib * NWAVES + F.wave; tg < S / 16; tg += nbh * NWAVES) {
        const int t0 = 16 * tg;
        unsigned R[2][4];
        bf16x8 af[2][4];
#pragma unroll
        for (int p = 0; p < 2; ++p) { const char* qb_ = (const char*)Q2 + ((size_t)t0 * 2048 + h * 256 + p * 128) * 2;
#pragma unroll
            for (int ks = 0; ks < 4; ++ks) af[p][ks] = *(const GAS bf16x8*)(qb_ + 64 * ks + qlo); }
#pragma unroll
        for (int p = 0; p < 2; ++p) {
            f32x4 acc[8];
#pragma unroll
            for (int nt = 0; nt < 8; ++nt) { acc[nt] = (f32x4){0.f, 0.f, 0.f, 0.f}; const int n = 16 * nt + i;
#pragma unroll
                for (int ks = 0; ks < 4; ++ks) { const bf16x8 b = *(const LAS bf16x8*)(F.lds + p * 32768 + n * 256 + ((64 * ks + 16 * q) ^ ((n & 7) << 4)));
                    acc[nt] = __builtin_amdgcn_mfma_f32_16x16x32_bf16(af[p][ks], b, acc[nt], 0, 0, 0); } }
#pragma unroll
            for (int r = 0; r < 4; ++r) { unsigned a[8];
#pragma unroll
                for (int nt = 0; nt < 8; ++nt) a[nt] = (ordk(acc[nt][r]) & ~0x7Fu) | (unsigned)(16 * nt + i);
                CE_(a[0], a[1]); CE_(a[2], a[3]); CE_(a[4], a[5]); CE_(a[6], a[7]); CE_(a[0], a[2]); CE_(a[1], a[3]); CE_(a[4], a[6]); CE_(a[5], a[7]); CE_(a[1], a[2]); CE_(a[5], a[6]);
                CE_(a[0], a[4]); CE_(a[1], a[5]); CE_(a[2], a[6]); CE_(a[3], a[7]); CE_(a[2], a[4]); CE_(a[3], a[5]); CE_(a[1], a[2]); CE_(a[3], a[4]); CE_(a[5], a[6]);
                R[p][r] = row_pop16(a, i); __builtin_amdgcn_sched_barrier(0); }
        }
#pragma unroll
        for (int r = 0; r < 4; ++r) {
            const unsigned R0 = R[0][r], R1 = R[1][r]; const float f0 = deck(R0 & ~0x7Fu), f1 = deck(R1 & ~0x7Fu); const int n0 = (int)(R0 & 0x7Fu), n1 = (int)(R1 & 0x7Fu);
            const unsigned f1u = __float_as_uint(f1); unsigned c[8];
#define CAND_(b, lim) do { const unsigned t_ = (ordk(f0 + __uint_as_float(dppu<0x150 + (b)>(f1u))) & ~0xFFu) | (unsigned)(255 - (i * 16 + (b))); c[b] = (i < (lim)) ? t_ : 0u; } while (0)
            CAND_(0, 16); CAND_(1, 8); CAND_(2, 5); CAND_(3, 4); CAND_(4, 3); CAND_(5, 2); CAND_(6, 2); CAND_(7, 2);
#undef CAND_
            { const float ex = __uint_as_float(dppu<0x150>(__float_as_uint(f0))) + f1; const unsigned exk = (ordk(ex) & ~0xFFu) | (unsigned)(255 - i); c[1] = (i >= 8) ? exk : c[1]; }
            CE_(c[0], c[1]);
            const unsigned G = row_pop16(c, i);
            const float val = deck(G & ~0xFFu); const int id = 255 - (int)(G & 0xFFu); const int rb = F.lane & 48;
            const int ea = __shfl(n0, rb + (id >> 4)), eb = __shfl(n1, rb + (id & 15));
            const float mx = __uint_as_float(dppu<0x150>(__float_as_uint(val))); const float ex = __expf(val - mx); const float sm = rowsum_f32(ex);
            const size_t o = (size_t)(t0 + 4 * q + r) * 128 + h * 16 + i; IDX[o] = ea * 128 + eb; GATE[o] = ex / sm; __builtin_amdgcn_sched_barrier(0);
        }
    }
}
#undef CE_

constexpr float U_SCALE = 256.0f, V_SCALE = 1.0f;
#ifndef PEER_SORT
#define PEER_SORT 0
#endif
__device__ __forceinline__ float gelu_as(float v) {
    const float av = fabsf(v), tt = __builtin_amdgcn_rcpf(av * 0.2316418882f + 1.0f);
    float q = tt * 0.5307027145f + (-0.7265760135f); q = q * tt + 0.7107068705f; q = q * tt + (-0.142248368f); q = q * tt + 0.127414796f; q = q * tt;
    const float m = v * (q * __builtin_amdgcn_exp2f((v * v) * (-0.72134752044f)));
    return v < 0.f ? m : v - m;
}
#ifndef PEER_UMFMA
#define PEER_UMFMA 1
#endif
#ifndef HYP_A
#define HYP_A 1
#endif
#ifndef HYP_B
#define HYP_B 0
#endif
#ifndef PEER_VMFMA
#define PEER_VMFMA 1
#endif
typedef int v8i __attribute__((ext_vector_type(8)));
typedef int v2i __attribute__((ext_vector_type(2)));
typedef float f32x16 __attribute__((ext_vector_type(16)));
__device__ __forceinline__ float wave_sum_dpp(float x) {
    x = rowsum_f32(x);
    return (__uint_as_float(__builtin_amdgcn_readlane(__float_as_uint(x), 0)) + __uint_as_float(__builtin_amdgcn_readlane(__float_as_uint(x), 16)))
         + (__uint_as_float(__builtin_amdgcn_readlane(__float_as_uint(x), 32)) + __uint_as_float(__builtin_amdgcn_readlane(__float_as_uint(x), 48)));
}
#define LOADROWS(T, ra_, rb_, ee) do { const int e2_ = (ee) & 127; const int ea_ = __builtin_amdgcn_readlane(e2_ < 64 ? id0 : id1, e2_ & 63), eb_ = __builtin_amdgcn_readlane(e2_ < 64 ? id0 : id1, (e2_ + 1) & 63); \
        const GAS v4u* pa_ = (const GAS v4u*)((T) + (size_t)ea_ * DM) + F.lane; const GAS v4u* pb_ = (const GAS v4u*)((T) + (size_t)eb_ * DM) + F.lane; \
        _Pragma("unroll") for (int c = 0; c < 4; ++c) { ra_[c] = pa_[64 * c]; rb_[c] = pb_[64 * c]; } } while (0)
#define UDOT(r_, out_) do { f32x2 s0_ = {0.f, 0.f}, s1_ = {0.f, 0.f}, s2_ = {0.f, 0.f}, s3_ = {0.f, 0.f}; \
        _Pragma("unroll") for (int c = 0; c < 4; ++c) _Pragma("unroll") for (int d = 0; d < 2; ++d) { \
            const f32x2 p0_ = __builtin_amdgcn_cvt_scalef32_pk_f32_fp4(r_[c][d], 1.0f, 0), p1_ = __builtin_amdgcn_cvt_scalef32_pk_f32_fp4(r_[c][d], 1.0f, 1), \
                        p2_ = __builtin_amdgcn_cvt_scalef32_pk_f32_fp4(r_[c][d], 1.0f, 2), p3_ = __builtin_amdgcn_cvt_scalef32_pk_f32_fp4(r_[c][d], 1.0f, 3); \
            s0_ = p0_ * hx[8 * c + 4 * d] + s0_; s1_ = p1_ * hx[8 * c + 4 * d + 1] + s1_; s2_ = p2_ * hx[8 * c + 4 * d + 2] + s2_; s3_ = p3_ * hx[8 * c + 4 * d + 3] + s3_; } \
        out_ = ((s0_.x + s0_.y) + (s1_.x + s1_.y)) + ((s2_.x + s2_.y) + (s3_.x + s3_.y)); } while (0)
#define UPAIR(ra_, rb_, ee) do { float sa_, sb_; UDOT(ra_, sa_); UDOT(rb_, sb_); sa_ = wave_sum_dpp(sa_); sb_ = wave_sum_dpp(sb_); \
        const int e2_ = (ee); const int ea_ = __builtin_amdgcn_readlane(e2_ < 64 ? id0 : id1, e2_ & 63), eb_ = __builtin_amdgcn_readlane(e2_ < 64 ? id0 : id1, (e2_ + 1) & 63); \
        const f32x2 a2_ = pg8::gelu_pk((f32x2){sa_ * RSU[ea_], sb_ * RSU[eb_]}); \
        if ((ee) < 64) { if (F.lane == (ee)) w0 = a2_.x * g0; if (F.lane == (ee) + 1) w0 = a2_.y * g0; } else { if (F.lane == (ee) - 64) w1 = a2_.x * g1; if (F.lane == (ee) - 63) w1 = a2_.y * g1; } } while (0)
#define LOADROWS4(T, ra_, rb_, ee) do { const int e2_ = (ee) & 127; const int ea_ = __builtin_amdgcn_readlane(e2_ < 64 ? id0 : id1, e2_ & 63), eb_ = __builtin_amdgcn_readlane(e2_ < 64 ? id0 : id1, (e2_ + 1) & 63); \
        const GAS v2u* pa_ = (const GAS v2u*)((T) + (size_t)ea_ * 2048) + F.lane; const GAS v2u* pb_ = (const GAS v2u*)((T) + (size_t)eb_ * 2048) + F.lane; \
        _Pragma("unroll") for (int c = 0; c < 4; ++c) { ra_[c] = pa_[64 * c]; rb_[c] = pb_[64 * c]; } } while (0)
#define VAXPY(r_, w_) do { const f32x2 w2_ = {w_, w_}; \
        _Pragma("unroll") for (int c = 0; c < 4; ++c) _Pragma("unroll") for (int d = 0; d < 2; ++d) { \
            const f32x2 p0_ = __builtin_amdgcn_cvt_scalef32_pk_f32_fp4(r_[c][d], 1.0f, 0), p1_ = __builtin_amdgcn_cvt_scalef32_pk_f32_fp4(r_[c][d], 1.0f, 1), \
                        p2_ = __builtin_amdgcn_cvt_scalef32_pk_f32_fp4(r_[c][d], 1.0f, 2), p3_ = __builtin_amdgcn_cvt_scalef32_pk_f32_fp4(r_[c][d], 1.0f, 3); \
            acc[8 * c + 4 * d] = p0_ * w2_ + acc[8 * c + 4 * d]; acc[8 * c + 4 * d + 1] = p1_ * w2_ + acc[8 * c + 4 * d + 1]; \
            acc[8 * c + 4 * d + 2] = p2_ * w2_ + acc[8 * c + 4 * d + 2]; acc[8 * c + 4 * d + 3] = p3_ * w2_ + acc[8 * c + 4 * d + 3]; } } while (0)
#define VPAIR(ra_, rb_, ee) do { const int e2_ = (ee); const int ea_ = __builtin_amdgcn_readlane(e2_ < 64 ? id0 : id1, e2_ & 63), eb_ = __builtin_amdgcn_readlane(e2_ < 64 ? id0 : id1, (e2_ + 1) & 63); \
        const float wa_ = __uint_as_float(__builtin_amdgcn_readlane(__float_as_uint((ee) < 64 ? w0 : w1), (ee) & 63)) * RS[ea_], wb_ = __uint_as_float(__builtin_amdgcn_readlane(__float_as_uint((ee) < 64 ? w0 : w1), ((ee) + 1) & 63)) * RS[eb_]; \
        VAXPY(ra_, wa_); VAXPY(rb_, wb_); } while (0)
template <int MODE> __device__ __forceinline__ void p10_peer(Frame& F, const Args& args) {
    const int gw = F.vcu * NWAVES + F.wave, NGW = F.G * NWAVES; const float* MOD = WSP(float, WS_MOD);
    const bf16* H2 = WSP(bf16, WS_HA); const unsigned char* U = WSP(unsigned char, WS_U); const unsigned char* V = WSP(unsigned char, WS_V); const int* IDX = WSP(int, WS_IDX); const float* GATE = WSP(float, WS_GATE); const float* RS = WSP(float, WS_RS); const float* RSU = WSP(float, WS_RSU);
#if PEER_UMFMA
    if (F.lane < 8) *(LAS v4u*)(F.lds + F.wave * 13440 + 4096 + F.lane * 16) = (v4u){0u, 0u, 0u, 0u};
#endif
#pragma unroll 1
    for (int t = gw; t < S; t += NGW) {
        const int id0 = IDX[(size_t)t * 128 + F.lane], id1 = IDX[(size_t)t * 128 + 64 + F.lane];
        const float g0 = GATE[(size_t)t * 128 + F.lane], g1 = GATE[(size_t)t * 128 + 64 + F.lane];
        float w0 = 0.f, w1 = 0.f;
#if PEER_UMFMA
        if (MODE != 2) {
            LAS unsigned char* h8 = F.lds + F.wave * 13440; LAS unsigned char* stg = h8 + 4224;
            const float rstd = 1.0f / sqrtf(wave_sum_dpp(WSP(float, WS_SSQ)[(size_t)t * 64 + F.lane]) * (1.0f / DM) + EPS);
#pragma unroll
            for (int c = 0; c < 4; ++c) { const GAS v4u* hp = (const GAS v4u*)(H2 + (size_t)t * DM + c * 1024 + F.lane * 16); const v4u a = hp[0], b = hp[1]; v4u o;
                const GAS f32x4* sp = (const GAS f32x4*)(MOD + 12288 + c * 1024 + F.lane * 16); const f32x4 s0 = sp[0], s1 = sp[1], s2 = sp[2], s3 = sp[3];
                { int w = 0; w = __builtin_amdgcn_cvt_pk_fp8_f32(bflo(a[0]) * rstd + s0[0], bfhi(a[0]) * rstd + s0[1], w, false); w = __builtin_amdgcn_cvt_pk_fp8_f32(bflo(a[1]) * rstd + s0[2], bfhi(a[1]) * rstd + s0[3], w, true); o[0] = (unsigned)w; }
                { int w = 0; w = __builtin_amdgcn_cvt_pk_fp8_f32(bflo(a[2]) * rstd + s1[0], bfhi(a[2]) * rstd + s1[1], w, false); w = __builtin_amdgcn_cvt_pk_fp8_f32(bflo(a[3]) * rstd + s1[2], bfhi(a[3]) * rstd + s1[3], w, true); o[1] = (unsigned)w; }
                { int w = 0; w = __builtin_amdgcn_cvt_pk_fp8_f32(bflo(b[0]) * rstd + s2[0], bfhi(b[0]) * rstd + s2[1], w, false); w = __builtin_amdgcn_cvt_pk_fp8_f32(bflo(b[1]) * rstd + s2[2], bfhi(b[1]) * rstd + s2[3], w, true); o[2] = (unsigned)w; }
                { int w = 0; w = __builtin_amdgcn_cvt_pk_fp8_f32(bflo(b[2]) * rstd + s3[0], bfhi(b[2]) * rstd + s3[1], w, false); w = __builtin_amdgcn_cvt_pk_fp8_f32(bflo(b[3]) * rstd + s3[2], bfhi(b[3]) * rstd + s3[3], w, true); o[3] = (unsigned)w; }
                *(LAS v4u*)(h8 + c * 1024 + F.lane * 16) = o; }
            const int j = F.lane & 31, kh = F.lane >> 5, lr = F.lane >> 3, lp = F.lane & 7;
            unsigned so[4][4];
#pragma unroll
            for (int b = 0; b < 4; ++b)
#pragma unroll
                for (int i = 0; i < 4; ++i) so[b][i] = (unsigned)__shfl(b < 2 ? id0 : id1, 32 * (b & 1) + lr + 8 * i) * 2048u + (unsigned)lp * 16u;
            int eb[4];
#pragma unroll
            for (int b = 0; b < 4; ++b) eb[b] = __shfl(b < 2 ? id0 : id1, j + 32 * (b & 1));
            const unsigned aoff0 = (j == 0) ? (unsigned)(16 * kh) : 4096u, aoff1 = (j == 0) ? (unsigned)(32 + 16 * kh) : 4112u, astep = (j == 0) ? 64u : 0u;
            const unsigned wof = (unsigned)lr * 144u + (unsigned)lp * 16u, rof = (unsigned)j * 144u + (unsigned)kh * 16u;
            f32x16 ac[4];
#pragma unroll
            for (int b = 0; b < 4; ++b) ac[b] = (f32x16){};
            v4u R0[8], R1[8];
#define ULOAD(R_, kg_, bp_) do { _Pragma("unroll") for (int bb = 0; bb < 2; ++bb) _Pragma("unroll") for (int i = 0; i < 4; ++i) \
                R_[4 * bb + i] = *(const GAS v4u*)(U + (size_t)so[2 * (bp_) + bb][i] + (size_t)(kg_) * 128); } while (0)
#define USTAGE(R_, bp_) do { _Pragma("unroll") for (int bb = 0; bb < 2; ++bb) _Pragma("unroll") for (int i = 0; i < 4; ++i) *(LAS v4u*)(stg + bb * 4608 + i * 1152 + wof) = R_[4 * bb + i]; \
            _Pragma("unroll") for (int bb = 0; bb < 2; ++bb) { v4u B_[4]; _Pragma("unroll") for (int kk = 0; kk < 4; ++kk) B_[kk] = *(const LAS v4u*)(stg + bb * 4608 + rof + kk * 32); \
                _Pragma("unroll") for (int kk = 0; kk < 4; ++kk) ac[2 * (bp_) + bb] = __builtin_amdgcn_mfma_scale_f32_32x32x64_f8f6f4(A[kk], (v8i){(int)B_[kk][0], (int)B_[kk][1], (int)B_[kk][2], (int)B_[kk][3], 0, 0, 0, 0}, ac[2 * (bp_) + bb], 0, 4, 0, 0x7f7f7f7f, 0, 0x7f7f7f7f); } } while (0)
            ULOAD(R0, 0, 0);
#pragma unroll 1
            for (int kg = 0; kg < 16; ++kg) {
                v8i A[4];
#pragma unroll
                for (int kk = 0; kk < 4; ++kk) { const unsigned kb = (unsigned)(4 * kg + kk); const v4u x = *(const LAS v4u*)(h8 + aoff0 + kb * astep), y = *(const LAS v4u*)(h8 + aoff1 + kb * astep);
                    A[kk] = (v8i){(int)x[0], (int)x[1], (int)x[2], (int)x[3], (int)y[0], (int)y[1], (int)y[2], (int)y[3]}; }
                ULOAD(R1, kg, 1);
                USTAGE(R0, 0);
                ULOAD(R0, (kg + 1) & 15, 0);
                USTAGE(R1, 1);
            }
#undef ULOAD
#undef USTAGE
#pragma unroll
            for (int b = 0; b < 4; ++b) {
                const float av = pg8::gelu_pk((f32x2){ac[b][0] * RSU[eb[b]], 0.f}).x;
                const float gg = __shfl(b < 2 ? g0 : g1, j + 32 * (b & 1)); const float wv = av * gg;
                if ((b & 1) == 0) { if (b == 0) w0 = F.lane < 32 ? wv : w0; else w1 = F.lane < 32 ? wv : w1; }
                else { const float mv = __shfl(wv, j); if (b == 1) w0 = F.lane >= 32 ? mv : w0; else w1 = F.lane >= 32 ? mv : w1; } }
        }
#else
        {   f32x2 hx[32];
#pragma unroll
            for (int c = 0; c < 4; ++c) { const GAS v4u* hp = (const GAS v4u*)(H2 + (size_t)t * DM + c * 1024 + F.lane * 16); const v4u a = hp[0], b = hp[1];
#pragma unroll
                for (int k = 0; k < 4; ++k) { hx[8 * c + k] = (f32x2){bflo(a[k]), bfhi(a[k])}; hx[8 * c + 4 + k] = (f32x2){bflo(b[k]), bfhi(b[k])}; } }
            v2u ra[4], rb[4], rc[4], rd[4], na[4], nb[4], nc[4], nd[4];
            if (MODE != 2) {
            LOADROWS4(U, ra, rb, 0); LOADROWS4(U, rc, rd, 2);
#pragma unroll 1
            for (int e = 0; e < 128; e += 8) {
                LOADROWS4(U, na, nb, e + 4); LOADROWS4(U, nc, nd, e + 6);
                UPAIR(ra, rb, e); UPAIR(rc, rd, e + 2);
                LOADROWS4(U, ra, rb, e + 8); LOADROWS4(U, rc, rd, e + 10);
                UPAIR(na, nb, e + 4); UPAIR(nc, nd, e + 6);
            } } }
#endif
        if (MODE == 1 || MODE == 3) { asm volatile("" :: "v"(w0), "v"(w1)); continue; }
#if PEER_VMFMA
        {
            LAS unsigned char* wreg = F.lds + F.wave * 13440; LAS unsigned char* w8 = wreg; LAS unsigned char* stg = wreg + 256;
            const int j = F.lane & 31, kh = F.lane >> 5;
            { const float q0 = w0 * RS[id0] * 16.0f, q1 = w1 * RS[id1] * 16.0f;
              const int b0 = __builtin_amdgcn_cvt_pk_fp8_f32(q0, q0, 0, false), b1 = __builtin_amdgcn_cvt_pk_fp8_f32(q1, q1, 0, false);
              w8[F.lane] = (unsigned char)(b0 & 0xff); w8[64 + F.lane] = (unsigned char)(b1 & 0xff); if (F.lane < 8) *(LAS v2u*)(w8 + 128 + 8 * F.lane) = (v2u){0u, 0u}; }
            v8i A[2];
#pragma unroll
            for (int kb = 0; kb < 2; ++kb) { const unsigned o0 = (j == 0) ? (unsigned)(64 * kb + 16 * kh) : 128u, o1 = (j == 0) ? (unsigned)(64 * kb + 32 + 16 * kh) : 144u;
                const v4u x = *(const LAS v4u*)(w8 + o0), y = *(const LAS v4u*)(w8 + o1);
                A[kb] = (v8i){(int)x[0], (int)x[1], (int)x[2], (int)x[3], (int)y[0], (int)y[1], (int)y[2], (int)y[3]}; }
            const int lr = F.lane >> 2, lp = F.lane & 3;
            unsigned so[8];
#pragma unroll
            for (int i = 0; i < 8; ++i) so[i] = (unsigned)__shfl(i < 4 ? id0 : id1, (16 * i + lr) & 63) * 2048u + (unsigned)lp * 16u;
            const unsigned wof = (unsigned)lr * 80u + (unsigned)lp * 16u;
            const unsigned rof = (unsigned)(32 * kh + (F.lane & 15)) * 80u + (unsigned)(8 * ((F.lane >> 4) & 1));
            const float* X1r = WSP(float, WS_X1) + (size_t)t * DM; const float* G2 = MOD + 20480; float* Or = F.out + (size_t)t * DM;
            v4u R0[8], R1[8];
#define VLOAD(R_, cg_) do { _Pragma("unroll") for (int i = 0; i < 8; ++i) R_[i] = *(const GAS v4u*)(V + (size_t)so[i] + (size_t)(cg_) * 64); } while (0)
#define VSTAGE(R_, cg_) do { _Pragma("unroll") for (int i = 0; i < 8; ++i) *(LAS v4u*)(stg + i * 1280 + wof) = R_[i]; \
            _Pragma("unroll") for (int tt = 0; tt < 4; ++tt) { f32x16 d_ = (f32x16){}; \
                _Pragma("unroll") for (int kb = 0; kb < 2; ++kb) { \
                    const v2i q0_ = __builtin_amdgcn_ds_read_tr4_b64_v2i32((LAS v2i*)(stg + kb * 5120 + rof + tt * 16)), q1_ = __builtin_amdgcn_ds_read_tr4_b64_v2i32((LAS v2i*)(stg + kb * 5120 + 1280 + rof + tt * 16)); \
                    d_ = __builtin_amdgcn_mfma_scale_f32_32x32x64_f8f6f4(A[kb], (v8i){q0_[0], q0_[1], q1_[0], q1_[1], 0, 0, 0, 0}, d_, 0, 4, 0, 0x7b7b7b7b, 0, 0x7f7f7f7f); } \
                if (MODE == 2) { asm volatile("" :: "v"(d_[0])); } else if (F.lane < 32) { const int col = (cg_) * 128 + tt * 32 + F.lane; Or[col] = X1r[col] + G2[col] * d_[0]; } } } while (0)
            VLOAD(R0, 0);
#pragma unroll 1
            for (int cg = 0; cg < 32; cg += 2) {
                VLOAD(R1, cg + 1);
                VSTAGE(R0, cg);
                VLOAD(R0, (cg + 2) & 31);
                VSTAGE(R1, cg + 1);
            }
#undef VLOAD
#undef VSTAGE
        }
#else
        f32x2 acc[32];
#pragma unroll
        for (int j = 0; j < 32; ++j) acc[j] = (f32x2){0.f, 0.f};
        {   v2u ra[4], rb[4], rc[4], rd[4], na[4], nb[4], nc[4], nd[4];
            LOADROWS4(V, ra, rb, 0); LOADROWS4(V, rc, rd, 2);
#pragma unroll 1
            for (int e = 0; e < 128; e += 8) {
                LOADROWS4(V, na, nb, e + 4); LOADROWS4(V, nc, nd, e + 6);
                VPAIR(ra, rb, e); VPAIR(rc, rd, e + 2);
                LOADROWS4(V, ra, rb, e + 8); LOADROWS4(V, rc, rd, e + 10);
                VPAIR(na, nb, e + 4); VPAIR(nc, nd, e + 6);
            } }
        if (MODE == 2) {
#pragma unroll
            for (int j = 0; j < 32; ++j) asm volatile("" :: "v"(acc[j]));
            continue; }
#pragma unroll
        for (int c = 0; c < 4; ++c) { const int col = c * 1024 + F.lane * 16; GAS f32x4* op = (GAS f32x4*)(F.out + (size_t)t * DM + col);
            const GAS f32x4* xp = (const GAS f32x4*)(WSP(float, WS_X1) + (size_t)t * DM + col); const GAS f32x4* gp = (const GAS f32x4*)(MOD + 20480 + col);
#pragma unroll
            for (int q = 0; q < 4; ++q) op[q] = xp[q] + gp[q] * (f32x4){acc[8 * c + 2 * q].x, acc[8 * c + 2 * q].y, acc[8 * c + 2 * q + 1].x, acc[8 * c + 2 * q + 1].y}; }
#endif
    }
}
#undef LOADROWS
#undef UDOT
#undef UPAIR
#undef VAXPY
#undef VPAIR
#undef LOADROWS4
#ifndef MK_SINGLE
#define MK_SINGLE 1
#endif
constexpr int N_PHASES = 11;
__global__ void __launch_bounds__(NTHREADS, 2) fwd_kernel(Args args) {
    extern __shared__ __attribute__((aligned(16))) unsigned char lds[];
    Frame F;
    F.lds = (LAS unsigned char*)lds; F.MISC = (volatile LAS unsigned*)(F.lds + MISC_OFF);
    F.tid = threadIdx.x; F.lane = F.tid & 63; F.wave = __builtin_amdgcn_readfirstlane(F.tid >> 6);
    F.G = gridDim.x; { const int bx = blockIdx.x; F.vcu = (F.G % 8 == 0) ? (bx % 8) * (F.G / 8) + bx / 8 : bx; }
    F.ws = args.ws; F.out = args.out; F.ctl = (gu32*)(args.ws + WS_CTL);
    for (int u = F.tid; u < (LDS_BYTES - LDSCTL_OFF) / 4; u += NTHREADS) ((LAS unsigned*)(F.lds + LDSCTL_OFF))[u] = 0u;
    __syncthreads();
    const int lo = args.ph_lo, hi = args.ph_hi;
    XcdBarrier bar; bar.bar = (unsigned*)(F.ctl + CW_BAR); bar.x = 0; bar.st = nullptr;
    if (hi - lo > 1) bar = xcd_barrier_post((unsigned*)(F.ctl + CW_BAR), F.MISC + 8);
#ifndef PH_MASK
#define PH_MASK 0x7ff
#endif
#define IN(k) (((PH_MASK >> (k)) & 1) && lo <= (k) && (k) < hi)
#define SEAM(k) do { if (IN(k) && IN((k) + 1)) xcd_barrier(bar); } while (0)
#ifndef G_ALIGN
#define G_ALIGN true
#endif
#ifndef G_SP2
#define G_SP2 true
#endif
#ifndef REP_PHASE
#define REP_PHASE -1
#endif
#define REPEAT(k) _Pragma("unroll") for (int rep = 0; rep < ((REP_PHASE) == (k) ? 2 : 1); ++rep)
#define REPBAR(k) do { if ((REP_PHASE) == (k) && rep == 0) xcd_barrier(bar); } while (0)
    const int bid = (int)blockIdx.x;
    if (IN(0)) { REPEAT(0) { p0_prologue(F, args); REPBAR(0); } SEAM(0); }
    if (IN(1)) { REPEAT(1) { p1_norm_forget(F, args); p1_shift_proj(F, args); REPBAR(1); } SEAM(1); }
    if (IN(2)) { REPEAT(2) {
        pg8::Gemm g{WSP(bf16, WS_HA), WSP(bf16, WS_WIN), S, NINP, DM}; pg8::StaticOrder So; So.init(S, NINP, F.G, bid);
        pg8::EpiIn E{WSP(bf16, WS_QKV), WSP(bf16, WS_LX), WSP(bf16, WS_GY), WSP(bf16, WS_GA), WSP(bf16, WS_GL), WSP(float, WS_BIASR)};
        pg8::gemm_phase<pg8::EpiIn, pg8::StaticOrder, G_ALIGN, G_SP2>(F.lds, g, So, E);
        REPBAR(2); }
        SEAM(2);
    }
    if (IN(3)) {
        p3_qknorm(F, args);
        __syncthreads();
        REPEAT(3) {
        p3_cumsum(F, args);
        for (int w = bid; w < 256; w += F.G) lru_item<0>(F, args, w);
        REPBAR(3); }
        SEAM(3);
    }
    if (IN(4)) {
#pragma unroll 1
        for (int rep = 0; rep < args.rep_att; ++rep) p4_attention(F, args, (char*)lds, rep);
#pragma unroll 1
        for (int rep = 0; rep < args.rep_lru; ++rep)
        for (int w = bid; w < 256; w += F.G) lru_item<1>(F, args, w);
        SEAM(4);
    }
    if (IN(5)) { REPEAT(5) {
        { pg8::Gemm g{WSP(bf16, WS_ATT), WSP(bf16, WS_WAO), S, DM, AW}; pg8::StaticOrder So; So.init(S, DM, F.G, bid);
          pg8::EpiGate<0> E{WSP(bf16, WS_T1), WSP(bf16, WS_GA), DM};
          pg8::gemm_phase<pg8::EpiGate<0>, pg8::StaticOrder, true, true>(F.lds, g, So, E); }
        { pg8::Gemm g{WSP(bf16, WS_LR), WSP(bf16, WS_WLO), S, DM, LW}; pg8::StaticOrder So; So.init(S, DM, F.G, bid);
          pg8::EpiGate<1> E{WSP(bf16, WS_T1), WSP(bf16, WS_GL), DM};
          pg8::gemm_phase<pg8::EpiGate<1>, pg8::StaticOrder, true, true>(F.lds, g, So, E); }
        REPBAR(5); }
        SEAM(5);
    }
    if (IN(6)) { REPEAT(6) {
        pg8::Gemm g{WSP(bf16, WS_T1), WSP(bf16, WS_WOUT), S, DM, DM}; pg8::StaticOrder So; So.init(S, DM, F.G, bid);
        pg8::EpiRes E{args.in[0], WSP(float, WS_X1), WSP(float, WS_MOD) + 8192, DM, args.in[5], WSP(float, WS_MOD) + 16384, WSP(bf16, WS_HA), WSP(float, WS_SSQ)};
        pg8::gemm_phase<pg8::EpiRes, pg8::StaticOrder, true, true>(F.lds, g, So, E);
        REPBAR(6); }
        SEAM(6);
    }
    if (IN(8)) { REPEAT(8) {
        pg8::Gemm g{WSP(bf16, WS_HA), WSP(bf16, WS_WPQ), S, 2048, DM}; pg8::RstdOrder So; So.init(S, 2048, F.G, bid);
        So.SSQ = WSP(float, WS_SSQ); So.rs = (LAS float*)(F.lds + 133120); So.inv_n = 1.0f / DM; So.eps = EPS; So.na = 0;
        pg8::EpiQ2 E{WSP(bf16, WS_Q2), 2048, WSP(float, WS_SB), (const LAS float*)(F.lds + 133120), 0};
        pg8::gemm_phase<pg8::EpiQ2, pg8::RstdOrder, true, true>(F.lds, g, So, E);
        REPBAR(8); }
        SEAM(8);
    }
    if (IN(9)) { REPEAT(9) { p9_topk(F, args); REPBAR(9); } SEAM(9); }
#ifndef P10_PROBE
#define P10_PROBE 0
#endif
    if (IN(10)) { if (P10_PROBE) { p10_peer<P10_PROBE>(F, args); xcd_barrier(bar); } REPEAT(10) { p10_peer<0>(F, args); REPBAR(10); } }
#undef IN
#undef SEAM
}

extern "C" void kernel_launch(void* const* d_in, const int* in_sizes, int n_in, void* d_out, int out_size, void* d_ws, size_t ws_size, hipStream_t stream) {
    static int grid = 0;
    if (grid == 0) {
        if (n_in != 24 || in_sizes[0] != S * DM || out_size != S * DM || ws_size < WS_END) { fprintf(stderr, "kernel_launch: unexpected shapes (n_in %d, in0 %d, out %d, ws %zu)\n", n_in, n_in > 0 ? in_sizes[0] : -1, out_size, ws_size); grid = -1; return; }
        int dev = 0, cus = 0, per_cu = 0;
        if (hipGetDevice(&dev) != hipSuccess || hipDeviceGetAttribute(&cus, hipDeviceAttributeMultiprocessorCount, dev) != hipSuccess) { grid = -1; return; }
        if (hipFuncSetAttribute((const void*)fwd_kernel, hipFuncAttributeMaxDynamicSharedMemorySize, LDS_BYTES) != hipSuccess) { fprintf(stderr, "kernel_launch: hipFuncSetAttribute failed\n"); grid = -1; return; }
        if (hipOccupancyMaxActiveBlocksPerMultiprocessor(&per_cu, (const void*)fwd_kernel, NTHREADS, LDS_BYTES) != hipSuccess || per_cu < 1) fprintf(stderr, "kernel_launch: occupancy query reports %d blocks per CU\n", per_cu);
        (void)hipGetLastError();
        grid = cus;
    }
    if (grid < 0) return;
    if (hipMemsetAsync((char*)d_ws + WS_CTL, 0, CTL_ZERO_BYTES, stream) != hipSuccess) return;
    Args a{};
    for (int i = 0; i < 24; ++i) a.in[i] = (const float*)d_in[i];
    a.out = (float*)d_out; a.ws = (unsigned char*)d_ws;
#ifndef REP_ATT
#define REP_ATT 1
#endif
#ifndef REP_LRU
#define REP_LRU 1
#endif
    a.rep_att = REP_ATT; a.rep_lru = REP_LRU;
#if MK_SINGLE
    a.ph_lo = 0; a.ph_hi = N_PHASES;
    hipLaunchKernelGGL(fwd_kernel, dim3(grid), dim3(NTHREADS), LDS_BYTES, stream, a);
#else
    for (int p = 0; p < N_PHASES; ++p) { a.ph_lo = p; a.ph_hi = p + 1; hipLaunchKernelGGL(fwd_kernel, dim3(grid), dim3(NTHREADS), LDS_BYTES, stream, a); }
#endif
}
```

```cpp
#define REP_PHASE -1
#include <hip/hip_runtime.h>
#include <cstdio>
#include <cstdint>
namespace pg8 {
#define PG8_LAS __attribute__((address_space(3)))
typedef unsigned short bf16_t;
typedef short bf16x8 __attribute__((ext_vector_type(8)));
typedef float f32x4 __attribute__((ext_vector_type(4)));
typedef unsigned u32x4 __attribute__((ext_vector_type(4)));
constexpr int BM = 256, BK = 64, HALF = 128, HTB = HALF * BK * 2  , STAGE_BYTES = 8 * HTB, NXCD = 8, WGM = 8;

__host__ __device__ __forceinline__ int lds_byte(int r, int c) { const int st = (r >> 4) * 2 + (c >> 5), rr = r & 15, cc = c & 31, ob = rr * 64 + cc * 2; return st * 1024 + (ob ^ (((ob >> 9) & 1) << 5)); }
__host__ __device__ __forceinline__ void stage_rc(int b, int& R, int& C) { const int st = b / 1024, sb = b % 1024, swz = sb ^ (((sb >> 9) & 1) << 5); R = (st >> 1) * 16 + swz / 64; C = (st & 1) * 32 + (swz % 64) / 2; }
__host__ __device__ __forceinline__ int perm32(int rho) { const int n = rho >> 4, i = rho & 15; return 8 * (i >> 2) + 4 * n + (i & 3); }

struct Unit { int pm, pn; };
struct Gemm { const bf16_t* A; const bf16_t* Bt; int M, N, K; };

struct StaticOrder {
    int nM, nN, nwg, G, c;
    __host__ __device__ void init(int M, int N, int G_, int c_) { nM = M / BM; nN = N / BM; nwg = nM * nN; G = G_; c = c_; }
    __host__ __device__ bool next(int i, Unit& u) const {
        const long L = (long)i * G + c; if (L >= nwg) return false;
        int wgid = (int)L; { const int q = nwg / NXCD, r = nwg % NXCD, xcd = wgid % NXCD, off = wgid / NXCD; wgid = (xcd < r ? xcd * (q + 1) : r * (q + 1) + (xcd - r) * q) + off; }
        const int nig = WGM * nN, gid = wgid / nig, fm = gid * WGM, gsz = (nM - fm) < WGM ? (nM - fm) : WGM;
        u.pm = fm + ((wgid % nig) % gsz); u.pn = (wgid % nig) / gsz; return true;
    }
    __device__ __forceinline__ void a_ready(const Unit&) const {}
    __device__ __forceinline__ void done(const Unit&) const {}
};

__device__ __forceinline__ unsigned cvt_pk_bf16(float lo, float hi) { unsigned r; asm volatile("v_cvt_pk_bf16_f32 %0, %1, %2" : "=v"(r) : "v"(lo), "v"(hi)); return r; }
typedef float f32x2 __attribute__((ext_vector_type(2)));
__device__ __forceinline__ f32x2 gelu_pk(f32x2 v) {
    const f32x2 av = __builtin_elementwise_abs(v), d = av * 0.2316418882f + 1.0f;
    f32x2 t; t.x = __builtin_amdgcn_rcpf(d.x); t.y = __builtin_amdgcn_rcpf(d.y);
    f32x2 q = t * 0.5307027145f + (-0.7265760135f); q = q * t + 0.7107068705f; q = q * t + (-0.142248368f); q = q * t + 0.127414796f; q = q * t;
    const f32x2 s = (v * v) * (-0.72134752044f);
    f32x2 e; e.x = __builtin_amdgcn_exp2f(s.x); e.y = __builtin_amdgcn_exp2f(s.y);
    const f32x2 m = v * (q * e), r = v - m;
    f32x2 o; o.x = v.x < 0.f ? m.x : r.x; o.y = v.y < 0.f ? m.y : r.y; return o;
}

template <int ACT  > struct EpiBf16 {
    static constexpr bool PERM = true, AFTER_DRAIN = false; static_assert(ACT == 0 || ACT == 1, "EpiBf16: ACT is 0 (none) or 1 (gelu_pk)");
    bf16_t* O; int ldc; const float* bias; int split_cols; size_t split_stride; float scale0;
    __device__ __forceinline__ void operator()(const f32x4 (&acc)[2][2][4][2], const Unit& u, int wr, int wc, int fr, int fq) const {
        const int row0 = u.pm * BM + wr * 64 + fr; int colt = u.pn * BM; bf16_t* base = O;
        float sc = 1.f; if (split_cols) { const int t = colt / split_cols; base += (size_t)t * split_stride; colt -= t * split_cols; if (t == 0) sc = scale0; }
        const int col0 = colt + wc * 32 + 8 * fq, bcol0 = u.pn * BM + wc * 32 + 8 * fq;
        f32x4 bv[2][2];
#pragma unroll
        for (int bj = 0; bj < 2; ++bj)
#pragma unroll
            for (int n = 0; n < 2; ++n) bv[bj][n] = bias ? *(const f32x4*)(bias + bcol0 + bj * HALF + 4 * n) : (f32x4){0.f, 0.f, 0.f, 0.f};
#pragma unroll
        for (int ai = 0; ai < 2; ++ai)
#pragma unroll
            for (int m = 0; m < 4; ++m) { bf16_t* rowp = base + (size_t)(row0 + ai * HALF + m * 16) * ldc + col0;
#pragma unroll
                for (int bj = 0; bj < 2; ++bj) { f32x4 v0 = acc[ai][bj][m][0] + bv[bj][0], v1 = acc[ai][bj][m][1] + bv[bj][1];
                    if (ACT == 1) { f32x2 a = gelu_pk((f32x2){v0[0], v0[1]}), b = gelu_pk((f32x2){v0[2], v0[3]}), c = gelu_pk((f32x2){v1[0], v1[1]}), d = gelu_pk((f32x2){v1[2], v1[3]});
                        v0 = (f32x4){a.x, a.y, b.x, b.y}; v1 = (f32x4){c.x, c.y, d.x, d.y}; }
                    v0 = v0 * sc; v1 = v1 * sc; u32x4 w; w.x = cvt_pk_bf16(v0[0], v0[1]); w.y = cvt_pk_bf16(v0[2], v0[3]); w.z = cvt_pk_bf16(v1[0], v1[1]); w.w = cvt_pk_bf16(v1[2], v1[3]);
                    *(u32x4*)(rowp + bj * HALF) = w; } }
    }
};
__device__ __forceinline__ f32x4 sigm4(f32x4 v) { f32x4 o;
#pragma unroll
    for (int j = 0; j < 4; ++j) o[j] = __builtin_amdgcn_rcpf(1.0f + __builtin_amdgcn_exp2f(-1.4426950408889634f * v[j]));
    return o; }
__device__ __forceinline__ f32x4 gelu4(f32x4 v) { const f32x2 a = gelu_pk((f32x2){v[0], v[1]}), b = gelu_pk((f32x2){v[2], v[3]}); return (f32x4){a.x, a.y, b.x, b.y}; }
__device__ __forceinline__ void unpack8(const u32x4 w, f32x4& lo, f32x4& hi) {
    lo = (f32x4){__uint_as_float(w.x << 16), __uint_as_float(w.x & 0xffff0000u), __uint_as_float(w.y << 16), __uint_as_float(w.y & 0xffff0000u)};
    hi = (f32x4){__uint_as_float(w.z << 16), __uint_as_float(w.z & 0xffff0000u), __uint_as_float(w.w << 16), __uint_as_float(w.w & 0xffff0000u)}; }
struct EpiIn {
    static constexpr bool PERM = true, AFTER_DRAIN = false;
    bf16_t* qkv; bf16_t* lx; bf16_t* gy; bf16_t* ga; bf16_t* gl; const float* bias;
    __device__ __forceinline__ void operator()(const f32x4 (&acc)[2][2][4][2], const Unit& u, int wr, int wc, int fr, int fq) const {
        const int pn = u.pn; bf16_t* base; int ldc, colt, act;
        if (pn < 24) { base = qkv + (size_t)(pn >> 3) * ((size_t)8192 * 2048); ldc = 2048; colt = (pn & 7) * 256; act = 0; }
        else if (pn < 32) { base = lx; ldc = 2048; colt = (pn - 24) * 256; act = 0; }
        else if (pn < 40) { base = gy; ldc = 2048; colt = (pn - 32) * 256; act = 1; }
        else if (pn < 56) { base = ga; ldc = 4096; colt = (pn - 40) * 256; act = 2; }
        else { base = gl; ldc = 4096; colt = (pn - 56) * 256; act = 2; }
        const int row0 = u.pm * BM + wr * 64 + fr, col0 = colt + wc * 32 + 8 * fq, bcol0 = pn * BM + wc * 32 + 8 * fq;
        f32x4 bv[2][2];
#pragma unroll
        for (int bj = 0; bj < 2; ++bj)
#pragma unroll
            for (int n = 0; n < 2; ++n) bv[bj][n] = *(const f32x4*)(bias + bcol0 + bj * HALF + 4 * n);
#pragma unroll
        for (int ai = 0; ai < 2; ++ai)
#pragma unroll
            for (int m = 0; m < 4; ++m) { bf16_t* rowp = base + (size_t)(row0 + ai * HALF + m * 16) * ldc + col0;
#pragma unroll
                for (int bj = 0; bj < 2; ++bj) { f32x4 v0 = acc[ai][bj][m][0] + bv[bj][0], v1 = acc[ai][bj][m][1] + bv[bj][1];
                    if (act == 1) { v0 = gelu4(v0); v1 = gelu4(v1); }
                    else if (act == 2) { v0 = sigm4(v0); v1 = sigm4(v1); }
                    u32x4 w; w.x = cvt_pk_bf16(v0[0], v0[1]); w.y = cvt_pk_bf16(v0[2], v0[3]); w.z = cvt_pk_bf16(v1[0], v1[1]); w.w = cvt_pk_bf16(v1[2], v1[3]);
                    *(u32x4*)(rowp + bj * HALF) = w; } }
    }
};
template <int MODE> struct EpiGate {
    static constexpr bool PERM = true, AFTER_DRAIN = false;
    bf16_t* O; const bf16_t* Gt; int ldc;
    __device__ __forceinline__ void operator()(const f32x4 (&acc)[2][2][4][2], const Unit& u, int wr, int wc, int fr, int fq) const {
        const int row0 = u.pm * BM + wr * 64 + fr, col0 = u.pn * BM + wc * 32 + 8 * fq;
#pragma unroll
        for (int ai = 0; ai < 2; ++ai)
#pragma unroll
            for (int m = 0; m < 4; ++m) { const size_t off = (size_t)(row0 + ai * HALF + m * 16) * ldc + col0;
#pragma unroll
                for (int bj = 0; bj < 2; ++bj) { f32x4 g0, g1; unpack8(*(const u32x4*)(Gt + off + bj * HALF), g0, g1);
                    f32x4 v0 = acc[ai][bj][m][0] * g0, v1 = acc[ai][bj][m][1] * g1;
                    if (MODE == 1) { f32x4 t0, t1; unpack8(*(const u32x4*)(O + off + bj * HALF), t0, t1); v0 += t0; v1 += t1; }
                    u32x4 w; w.x = cvt_pk_bf16(v0[0], v0[1]); w.y = cvt_pk_bf16(v0[2], v0[3]); w.z = cvt_pk_bf16(v1[0], v1[1]); w.w = cvt_pk_bf16(v1[2], v1[3]);
                    *(u32x4*)(O + off + bj * HALF) = w; } }
    }
};
struct EpiRes {
    static constexpr bool PERM = false, AFTER_DRAIN = false;
    const float* X; float* Out; const float* gate; int ldc; const float* g2a; const float* g2b; bf16_t* XG; float* SSQ;
    __device__ __forceinline__ void operator()(const f32x4 (&acc)[2][2][4][2], const Unit& u, int wr, int wc, int fr, int fq) const {
        const int row0 = u.pm * BM + wr * 64 + fr, col0 = u.pn * BM + wc * 32 + 4 * fq;
        f32x4 gv[2][2], gp[2][2];
#pragma unroll
        for (int bj = 0; bj < 2; ++bj)
#pragma unroll
            for (int n = 0; n < 2; ++n) { gv[bj][n] = *(const f32x4*)(gate + col0 + bj * HALF + n * 16);
                gp[bj][n] = *(const f32x4*)(g2a + col0 + bj * HALF + n * 16) * (*(const f32x4*)(g2b + col0 + bj * HALF + n * 16) + 1.0f); }
#pragma unroll
        for (int ai = 0; ai < 2; ++ai)
#pragma unroll
            for (int m = 0; m < 4; ++m) { const int row = row0 + ai * HALF + m * 16; const size_t off = (size_t)row * ldc + col0; float ss = 0.f;
#pragma unroll
                for (int bj = 0; bj < 2; ++bj)
#pragma unroll
                    for (int n = 0; n < 2; ++n) { const f32x4 xv = *(const f32x4*)(X + off + bj * HALF + n * 16);
                        const f32x4 x1 = xv + gv[bj][n] * acc[ai][bj][m][n]; *(f32x4*)(Out + off + bj * HALF + n * 16) = x1;
                        ss += (x1[0] * x1[0] + x1[1] * x1[1]) + (x1[2] * x1[2] + x1[3] * x1[3]);
                        const f32x4 xg = x1 * gp[bj][n]; typedef unsigned u32x2_ __attribute__((ext_vector_type(2)));
                        u32x2_ w; w.x = cvt_pk_bf16(xg[0], xg[1]); w.y = cvt_pk_bf16(xg[2], xg[3]); *(u32x2_*)(XG + off + bj * HALF + n * 16) = w; }
                ss += __shfl_xor(ss, 16); ss += __shfl_xor(ss, 32);
                if (fq == 0) SSQ[(size_t)row * 64 + u.pn * 4 + wc] = ss; }
    }
};
struct EpiQ2 {
    static constexpr bool PERM = true, AFTER_DRAIN = false;
    bf16_t* O; int ldc; const float* sb; const PG8_LAS float* rs; mutable int ne;
    __device__ __forceinline__ void operator()(const f32x4 (&acc)[2][2][4][2], const Unit& u, int wr, int wc, int fr, int fq) const {
        const int rl0 = wr * 64 + fr, row0 = u.pm * BM + rl0, col0 = u.pn * BM + wc * 32 + 8 * fq; const PG8_LAS float* rsp = rs + ((ne++) & 1) * 256;
        f32x4 bv[2][2];
#pragma unroll
        for (int bj = 0; bj < 2; ++bj)
#pragma unroll
            for (int n = 0; n < 2; ++n) bv[bj][n] = *(const f32x4*)(sb + col0 + bj * HALF + 4 * n);
#pragma unroll
        for (int ai = 0; ai < 2; ++ai)
#pragma unroll
            for (int m = 0; m < 4; ++m) { const float r = rsp[rl0 + ai * HALF + m * 16]; bf16_t* rowp = O + (size_t)(row0 + ai * HALF + m * 16) * ldc + col0;
#pragma unroll
                for (int bj = 0; bj < 2; ++bj) { const f32x4 v0 = acc[ai][bj][m][0] * r + bv[bj][0], v1 = acc[ai][bj][m][1] * r + bv[bj][1];
                    u32x4 w; w.x = cvt_pk_bf16(v0[0], v0[1]); w.y = cvt_pk_bf16(v0[2], v0[3]); w.z = cvt_pk_bf16(v1[0], v1[1]); w.w = cvt_pk_bf16(v1[2], v1[3]);
                    *(u32x4*)(rowp + bj * HALF) = w; } }
    }
};
struct RstdOrder : StaticOrder {
    const float* SSQ; PG8_LAS float* rs; float inv_n, eps; mutable int na;
    __device__ __forceinline__ void a_ready(const Unit& u) const {
        const int tid = threadIdx.x, r = tid >> 1, hf = tid & 1; const f32x4* p = (const f32x4*)(SSQ + (size_t)(u.pm * BM + r) * 64 + hf * 32); float s = 0.f;
#pragma unroll
        for (int k = 0; k < 8; ++k) { const f32x4 v = p[k]; s += (v[0] + v[1]) + (v[2] + v[3]); }
        s += __shfl_xor(s, 1);
        if (hf == 0) rs[(na & 1) * 256 + r] = 1.0f / sqrtf(s * inv_n + eps);
        ++na;
    }
};
template <class Epi, class Sched, bool ALIGN_EPI = false, bool SP2 = false>
__device__ __forceinline__ void gemm_phase(PG8_LAS unsigned char* lds, const Gemm g, const Sched& S, const Epi& E) {
    const int tid = threadIdx.x, wid = __builtin_amdgcn_readfirstlane(tid >> 6), lane = tid & 63, wr = wid >> 2, wc = wid & 3, fr = lane & 15, fq = lane >> 4;
    const int K = g.K, nt = K / BK;
    unsigned voffA[2], voffB[2];
#pragma unroll
    for (int i = 0; i < 2; ++i) { int R, C; stage_rc(tid * 16 + i * 8192, R, C); const int Rb = Epi::PERM ? ((R & ~31) + perm32(R & 31)) : R;
        voffA[i] = (unsigned)(R * K + C) * 2u; voffB[i] = (unsigned)(Rb * K + C) * 2u; }
    const size_t kstep = (size_t)(BK * 2);
    const size_t hstep = (size_t)HALF * K * 2;
    const size_t tstep = 2 * hstep;
    const unsigned ldsw = (unsigned)wid * 1024u;
    const int aoff = lds_byte(wr * 64 + fr, fq * 8), boff = lds_byte(wc * 32 + fr, fq * 8);
#define PG8_SA(b, h) (((b) * 2 + (h)) * HTB)
#define PG8_SB(b, h) ((4 + (b) * 2 + (h)) * HTB)
#define PG8_STAGE(bufoff, gbase, voff) do { _Pragma("unroll") for (int _i = 0; _i < 2; ++_i) \
        __builtin_amdgcn_global_load_lds((const unsigned*)((const char*)(gbase) + (voff)[_i]), (PG8_LAS unsigned*)(lds + (bufoff) + ldsw + _i * 8192), 16, 0, 0); } while (0)
#define PG8_LDA(dst, b, h) do { _Pragma("unroll") for (int m = 0; m < 4; ++m) _Pragma("unroll") for (int k = 0; k < 2; ++k) dst[m][k] = *(const PG8_LAS bf16x8*)(lds + PG8_SA(b, h) + aoff + m * 2048 + k * 1024); } while (0)
#define PG8_LDB(dst, b, h) do { _Pragma("unroll") for (int n = 0; n < 2; ++n) _Pragma("unroll") for (int k = 0; k < 2; ++k) dst[n][k] = *(const PG8_LAS bf16x8*)(lds + PG8_SB(b, h) + boff + n * 2048 + k * 1024); } while (0)
#define PG8_MMA(ai, bj, At, Bt) do { __builtin_amdgcn_s_setprio(1); _Pragma("unroll") for (int m = 0; m < 4; ++m) _Pragma("unroll") for (int n = 0; n < 2; ++n) _Pragma("unroll") for (int k = 0; k < 2; ++k) \
        acc[ai][bj][m][n] = __builtin_amdgcn_mfma_f32_16x16x32_bf16(Bt[n][k], At[m][k], acc[ai][bj][m][n], 0, 0, 0); __builtin_amdgcn_s_setprio(0); } while (0)
#define PG8_WAIT_V(n) asm volatile("s_waitcnt vmcnt(" #n ")" ::: "memory")
#define PG8_WAIT_L(n) asm volatile("s_waitcnt lgkmcnt(" #n ")" ::: "memory")
#define PG8_BAR __builtin_amdgcn_s_barrier()
#define PG8_SCHED __builtin_amdgcn_sched_barrier(0)
    Unit cur, nxt; int ui = 0;
    if (!S.next(0, cur)) return;
    f32x4 acc[2][2][4][2];
#pragma unroll
    for (int a = 0; a < 2; ++a)
#pragma unroll
        for (int b = 0; b < 2; ++b)
#pragma unroll
            for (int m = 0; m < 4; ++m)
#pragma unroll
                for (int n = 0; n < 2; ++n) acc[a][b][m][n] = (f32x4){0.f, 0.f, 0.f, 0.f};
    bf16x8 At[4][2], B0[2][2], B1[2][2];
    const char* cA = (const char*)g.A + (size_t)cur.pm * tstep; const char* cB = (const char*)g.Bt + (size_t)cur.pn * tstep;
    S.a_ready(cur);
    if constexpr (SP2) {
        PG8_STAGE(PG8_SB(0, 0), cB, voffB); PG8_STAGE(PG8_SB(0, 1), cB + hstep, voffB); PG8_STAGE(PG8_SA(0, 0), cA, voffA); PG8_STAGE(PG8_SA(0, 1), cA + hstep, voffA);
        if (wr == 1) PG8_BAR;
        PG8_WAIT_V(2); PG8_BAR;
        PG8_STAGE(PG8_SB(1, 0), cB + kstep, voffB); PG8_STAGE(PG8_SA(1, 0), cA + kstep, voffA); PG8_STAGE(PG8_SB(1, 1), cB + hstep + kstep, voffB);
        PG8_WAIT_V(6); PG8_BAR;
    } else {
        PG8_STAGE(PG8_SB(0, 0), cB, voffB); PG8_STAGE(PG8_SA(0, 0), cA, voffA); PG8_STAGE(PG8_SB(0, 1), cB + hstep, voffB); PG8_STAGE(PG8_SA(0, 1), cA + hstep, voffA);
        if (wr == 1) PG8_BAR;
        PG8_WAIT_V(4); PG8_BAR;
        PG8_STAGE(PG8_SB(1, 0), cB + kstep, voffB); PG8_STAGE(PG8_SA(1, 0), cA + kstep, voffA); PG8_STAGE(PG8_SB(1, 1), cB + hstep + kstep, voffB);
        PG8_WAIT_V(6); PG8_BAR;
    }
    for (;;) {
        const bool has_next = S.next(ui + 1, nxt);
        const char* nA = has_next ? (const char*)g.A + (size_t)nxt.pm * tstep : cA; const char* nB = has_next ? (const char*)g.Bt + (size_t)nxt.pn * tstep : cB;
        for (int t = 0; t < nt; t += 2) {
            const bool last = (t == nt - 2);
            const char* a1 = cA + (size_t)(t + 1) * kstep;
            const char* a2 = last ? nA : cA + (size_t)(t + 2) * kstep; const char* b2 = last ? nB : cB + (size_t)(t + 2) * kstep;
            const char* a3 = a2 + kstep; const char* b3 = b2 + kstep;
            if (last && has_next) S.a_ready(nxt);
            if constexpr (SP2) {
            PG8_LDB(B0, 0, 0); PG8_LDB(B1, 0, 1); PG8_SCHED; PG8_LDA(At, 0, 0); PG8_STAGE(PG8_SA(1, 1), a1 + hstep, voffA);
            PG8_WAIT_V(8); PG8_WAIT_L(0); PG8_BAR; PG8_MMA(0, 0, At, B0); PG8_MMA(0, 1, At, B1); PG8_BAR; PG8_SCHED;
            PG8_LDA(At, 0, 1); PG8_STAGE(PG8_SB(0, 0), b2, voffB); PG8_STAGE(PG8_SB(0, 1), b2 + hstep, voffB); PG8_STAGE(PG8_SA(0, 0), a2, voffA);
            PG8_WAIT_V(8); PG8_WAIT_L(0); PG8_BAR; PG8_MMA(1, 0, At, B0); PG8_MMA(1, 1, At, B1); PG8_BAR; PG8_SCHED;
            PG8_LDB(B0, 1, 0); PG8_LDB(B1, 1, 1); PG8_SCHED; PG8_LDA(At, 1, 0); PG8_STAGE(PG8_SA(0, 1), a2 + hstep, voffA);
            PG8_WAIT_V(8); PG8_WAIT_L(0); PG8_BAR; PG8_MMA(0, 0, At, B0); PG8_MMA(0, 1, At, B1); PG8_BAR; PG8_SCHED;
            PG8_LDA(At, 1, 1); PG8_STAGE(PG8_SB(1, 0), b3, voffB); PG8_STAGE(PG8_SB(1, 1), b3 + hstep, voffB); PG8_STAGE(PG8_SA(1, 0), a3, voffA);
            PG8_WAIT_V(8); PG8_WAIT_L(0); PG8_BAR; PG8_MMA(1, 0, At, B0); PG8_MMA(1, 1, At, B1); PG8_BAR; PG8_SCHED;
            } else {
            PG8_LDB(B0, 0, 0); PG8_SCHED; PG8_LDA(At, 0, 0); PG8_STAGE(PG8_SA(1, 1), a1 + hstep, voffA);
            PG8_WAIT_L(8); PG8_BAR; PG8_WAIT_L(0); PG8_MMA(0, 0, At, B0); PG8_BAR; PG8_SCHED;
            PG8_LDB(B1, 0, 1); PG8_STAGE(PG8_SB(0, 0), b2, voffB);
            PG8_BAR; PG8_WAIT_L(0); PG8_MMA(0, 1, At, B1); PG8_BAR;
            PG8_LDA(At, 0, 1); PG8_STAGE(PG8_SA(0, 0), a2, voffA);
            PG8_BAR; PG8_WAIT_L(0); PG8_MMA(1, 0, At, B0); PG8_BAR; PG8_SCHED;
            PG8_STAGE(PG8_SB(0, 1), b2 + hstep, voffB);
            PG8_WAIT_V(6); PG8_BAR; PG8_MMA(1, 1, At, B1); PG8_BAR;
            PG8_LDB(B0, 1, 0); PG8_SCHED; PG8_LDA(At, 1, 0); PG8_STAGE(PG8_SA(0, 1), a2 + hstep, voffA);
            PG8_WAIT_L(8); PG8_BAR; PG8_WAIT_L(0); PG8_MMA(0, 0, At, B0); PG8_BAR; PG8_SCHED;
            PG8_LDB(B1, 1, 1); PG8_STAGE(PG8_SB(1, 0), b3, voffB);
            PG8_BAR; PG8_WAIT_L(0); PG8_MMA(0, 1, At, B1); PG8_BAR;
            PG8_LDA(At, 1, 1); PG8_STAGE(PG8_SA(1, 0), a3, voffA);
            PG8_BAR; PG8_WAIT_L(0); PG8_MMA(1, 0, At, B0); PG8_BAR; PG8_SCHED;
            PG8_STAGE(PG8_SB(1, 1), b3 + hstep, voffB);
            PG8_WAIT_V(6); PG8_BAR; PG8_MMA(1, 1, At, B1); PG8_BAR;
            }
        }
        if constexpr (ALIGN_EPI) { if (wr == 0) PG8_BAR; }
        if constexpr (!Epi::AFTER_DRAIN) { E(acc, cur, wr, wc, fr, fq); S.done(cur); }
        if (!has_next) break;
#pragma unroll
        for (int a = 0; a < 2; ++a)
#pragma unroll
            for (int b = 0; b < 2; ++b)
#pragma unroll
                for (int m = 0; m < 4; ++m)
#pragma unroll
                    for (int n = 0; n < 2; ++n) acc[a][b][m][n] = (f32x4){0.f, 0.f, 0.f, 0.f};
        cur = nxt; cA = nA; cB = nB; ++ui;
        if constexpr (ALIGN_EPI) { if (wr == 1) PG8_BAR; }
    }
    PG8_WAIT_V(0);
    if constexpr (!ALIGN_EPI) { if (wr == 0) PG8_BAR; }
    PG8_BAR;
    if constexpr (Epi::AFTER_DRAIN) { E.fused(acc, cur, wr, wc, fr, fq, lds, wid, lane); S.done(cur); }
#undef PG8_SA
#undef PG8_SB
#undef PG8_STAGE
#undef PG8_LDA
#undef PG8_LDB
#undef PG8_MMA
#undef PG8_WAIT_V
#undef PG8_WAIT_L
#undef PG8_BAR
#undef PG8_SCHED
}
}
namespace attn_body {
constexpr int D = 128, LD = 2048;
constexpr float THR = 8.f; constexpr bool WSKIP = false;
constexpr float SCALE = 0.08838834764831845f;
constexpr int NW = 8, QBLK = 32, KVBLK = 64, QB = NW * QBLK;
constexpr int SHM_V = KVBLK * D * 2, SHM_K = KVBLK * D * 2;
constexpr int LDS_BYTES = 2 * SHM_V + 2 * SHM_K + NW * 64 * 4;

typedef short bf16x8 __attribute__((ext_vector_type(8)));
typedef short s16x4 __attribute__((ext_vector_type(4)));
typedef float f32x16 __attribute__((ext_vector_type(16)));
typedef float f32x4 __attribute__((ext_vector_type(4)));
typedef unsigned u32x4 __attribute__((ext_vector_type(4)));
template <class A, class Bt> struct same_t { static constexpr bool v = false; };
template <class A> struct same_t<A, A> { static constexpr bool v = true; };

#define KSWZ(row, colB) ((row) * 256 + ((colB) ^ (((row) & 7) << 4)))
#define SBAR() __builtin_amdgcn_sched_barrier(0)
__device__ __forceinline__ int v_st(int k, int c) { const int kk = (k & ~0xC) | ((k & 4) << 1) | ((k & 8) >> 1); return ((kk >> 3) * 4 + (c >> 5)) * 512 + ((kk & 7) * 32 + (c & 31)) * 2; }
__device__ __forceinline__ int v_rd_base(int lane) { return ((lane & 3) << 3) | (((lane >> 2) & 3) << 6) | (((lane >> 4) & 1) << 5) | (((lane >> 5) & 1) << 8); }
constexpr int v_rd_off(int d0, int ks, int half) { return d0 * 512 + ks * 4096 + half * 2048; }
__device__ __forceinline__ int crow(int r, int hi) { return (r & 3) + 8 * (r >> 2) + 4 * hi; }
__device__ __forceinline__ unsigned cvtpk(float lo, float hi) {
    unsigned r; asm volatile("v_cvt_pk_bf16_f32 %0, %1, %2" : "=v"(r) : "v"(lo), "v"(hi)); return r;
}
__device__ __forceinline__ bf16x8 pack8(f32x4 a, f32x4 b) {
    u32x4 w = {cvtpk(a[0], a[1]), cvtpk(a[2], a[3]), cvtpk(b[0], b[1]), cvtpk(b[2], b[3])};
    return *reinterpret_cast<bf16x8*>(&w);
}
template <class T> __device__ __forceinline__ bf16x8 load8(const T* p) {
    if constexpr (same_t<T, float>::v) { return pack8(*(const f32x4*)p, *(const f32x4*)(p + 4)); }
    else { return *reinterpret_cast<const bf16x8*>(p); }
}
__device__ __forceinline__ void mask_tile(f32x16& p0, f32x16& p1, int dq, unsigned W) {
    const float NEG = -__builtin_inff();
#pragma unroll
    for (int r = 0; r < 16; ++r) {
        const int c = (r & 3) + 8 * (r >> 2);
        if ((unsigned)(dq - c) >= W) p0[r] = NEG;
        if ((unsigned)(dq - c - 32) >= W) p1[r] = NEG;
    }
}
__device__ __forceinline__ void partialSM(f32x16& p0, f32x16& p1, float& m_reg, float& mn, float& alpha) {
    float pmax = p0[0]; for (int r = 1; r < 16; ++r) pmax = fmaxf(pmax, p0[r]); for (int r = 0; r < 16; ++r) pmax = fmaxf(pmax, p1[r]);
    { auto rr = __builtin_amdgcn_permlane32_swap(__float_as_uint(pmax), __float_as_uint(pmax), false, false);
      pmax = fmaxf(__uint_as_float(rr[0]), __uint_as_float(rr[1])); }
    constexpr float C2 = 1.4426950408889634f * SCALE;
    if (__builtin_expect(__all((pmax - m_reg) * SCALE <= THR), 1)) { mn = m_reg; alpha = 1.f; }
    else { mn = fmaxf(m_reg, pmax); alpha = __builtin_amdgcn_exp2f((m_reg - mn) * C2); m_reg = mn; }
    const float mnL = -mn * C2;
    for (int r = 0; r < 16; ++r) p0[r] = fmaf(p0[r], C2, mnL); for (int r = 0; r < 16; ++r) p1[r] = fmaf(p1[r], C2, mnL);
    for (int r = 0; r < 16; ++r) p0[r] = __builtin_amdgcn_exp2f(p0[r]);
}
__device__ __forceinline__ void finishSM(f32x16& p0, f32x16& p1, float alpha, float& l_reg, bf16x8& pa0, bf16x8& pa1, bf16x8& pa2, bf16x8& pa3) {
    for (int r = 0; r < 16; ++r) p1[r] = __builtin_amdgcn_exp2f(p1[r]);
    float ps = 0; for (int r = 0; r < 16; ++r) ps += p0[r]; for (int r = 0; r < 16; ++r) ps += p1[r];
    { auto rr = __builtin_amdgcn_permlane32_swap(__float_as_uint(ps), __float_as_uint(ps), false, false);
      ps = __uint_as_float(rr[0]) + __uint_as_float(rr[1]); }
    l_reg = l_reg * alpha + ps;
#define PK4(P, B_, OUT) do { unsigned a0 = cvtpk(P[B_+0], P[B_+1]), a1 = cvtpk(P[B_+2], P[B_+3]);                          \
        unsigned b0 = cvtpk(P[B_+4], P[B_+5]), b1 = cvtpk(P[B_+6], P[B_+7]);                                             \
        auto r0 = __builtin_amdgcn_permlane32_swap(a0, b0, false, false); auto r1 = __builtin_amdgcn_permlane32_swap(a1, b1, false, false); \
        u32x4 w = {r0[0], r1[0], r0[1], r1[1]}; OUT = *reinterpret_cast<bf16x8*>(&w); } while (0)
    PK4(p0, 0, pa0); PK4(p0, 8, pa1); PK4(p1, 0, pa2); PK4(p1, 8, pa3);
#undef PK4
}
template <int KB, bool SK>
__device__ __forceinline__ void qkt(f32x16& p0, f32x16& p1, const char* K_lds, int r32, int hi, const bf16x8* qr, bool act, const float* bt) {
    if (SK && !act) { const float NEG = -__builtin_inff();
#pragma unroll
        for (int r = 0; r < 16; ++r) { p0[r] = NEG; p1[r] = NEG; } return; }
    { const f32x4 b0 = *(const f32x4*)(bt), b1 = *(const f32x4*)(bt + 8), b2 = *(const f32x4*)(bt + 16), b3 = *(const f32x4*)(bt + 24);
      const f32x4 c0 = *(const f32x4*)(bt + 32), c1 = *(const f32x4*)(bt + 40), c2 = *(const f32x4*)(bt + 48), c3 = *(const f32x4*)(bt + 56);
      p0 = (f32x16){b0[0], b0[1], b0[2], b0[3], b1[0], b1[1], b1[2], b1[3], b2[0], b2[1], b2[2], b2[3], b3[0], b3[1], b3[2], b3[3]};
      p1 = (f32x16){c0[0], c0[1], c0[2], c0[3], c1[0], c1[1], c1[2], c1[3], c2[0], c2[1], c2[2], c2[3], c3[0], c3[1], c3[2], c3[3]}; }
    const char* kb[4];
#pragma unroll
    for (int dd = 0; dd < 4; ++dd) kb[dd] = K_lds + KB * SHM_K + KSWZ(r32, (dd * 16 + hi * 8) * 2);
#pragma unroll
    for (int d0 = 0; d0 < 8; ++d0) { const char* a = kb[d0 & 3] + (d0 >> 2) * 128;
        bf16x8 b0 = *reinterpret_cast<const bf16x8*>(a);
        bf16x8 b1 = *reinterpret_cast<const bf16x8*>(a + 32 * 256);
        p0 = __builtin_amdgcn_mfma_f32_32x32x16_bf16(b0, qr[d0], p0, 0, 0, 0);
        p1 = __builtin_amdgcn_mfma_f32_32x32x16_bf16(b1, qr[d0], p1, 0, 0, 0); }
}
template <int VB, bool SK>
__device__ __forceinline__ void pv_tile(f32x16* o, int vb0, bf16x8 pa0, bf16x8 pa1, bf16x8 pa2, bf16x8 pa3, bool act) {
    if (SK && !act) return;
#define TRRD(dst, off) asm volatile("ds_read_b64_tr_b16 %0, %1 offset:%2" : "=&v"(dst) : "v"(vb0), "i"(off) : "memory")
#define PV_D0(d0) do { s16x4 l0, l1, l2, l3, h0, h1, h2, h3; constexpr int b_ = VB * SHM_V + v_rd_off(d0, 0, 0);     \
        TRRD(l0, b_); TRRD(h0, b_ + 2048); TRRD(l1, b_ + 4096); TRRD(h1, b_ + 6144); TRRD(l2, b_ + 8192); TRRD(h2, b_ + 10240); TRRD(l3, b_ + 12288); TRRD(h3, b_ + 14336); \
        asm volatile("s_waitcnt lgkmcnt(0)" ::: "memory"); SBAR();                 \
        o[d0] = __builtin_amdgcn_mfma_f32_32x32x16_bf16(pa0, (bf16x8){l0[0], l0[1], l0[2], l0[3], h0[0], h0[1], h0[2], h0[3]}, o[d0], 0, 0, 0);   \
        o[d0] = __builtin_amdgcn_mfma_f32_32x32x16_bf16(pa1, (bf16x8){l1[0], l1[1], l1[2], l1[3], h1[0], h1[1], h1[2], h1[3]}, o[d0], 0, 0, 0);   \
        o[d0] = __builtin_amdgcn_mfma_f32_32x32x16_bf16(pa2, (bf16x8){l2[0], l2[1], l2[2], l2[3], h2[0], h2[1], h2[2], h2[3]}, o[d0], 0, 0, 0);   \
        o[d0] = __builtin_amdgcn_mfma_f32_32x32x16_bf16(pa3, (bf16x8){l3[0], l3[1], l3[2], l3[3], h3[0], h3[1], h3[2], h3[3]}, o[d0], 0, 0, 0); } while (0)
    PV_D0(0); PV_D0(1); PV_D0(2); PV_D0(3);
#undef PV_D0
#undef TRRD
}


template <class TIn, class TOut> struct BlockRef { const TIn* Q; const TIn* K; const TIn* V; TOut* O; int P0; int jlo; };
#define ROW(p, k0, rr) ((p) + (size_t)((k0) + (rr)) * LD + sc)
#define VMW() asm volatile("s_waitcnt vmcnt(0)" ::: "memory")
#define SLOAD_H(Kp, Vp, k0) do { st_v0 = load8<TIn>(ROW(Vp, k0, sr)); st_v1 = load8<TIn>(ROW(Vp, k0, 32 + sr));              \
                         st_k0 = load8<TIn>(ROW(Kp, k0, sr)); st_k1 = load8<TIn>(ROW(Kp, k0, 32 + sr)); } while (0)
#define SWRITE_H(bf) do { *(bf16x8*)(V_lds + (bf) * SHM_V + vst0) = st_v0; *(bf16x8*)(V_lds + (bf) * SHM_V + vst1) = st_v1;   \
                          *(bf16x8*)(K_lds + (bf) * SHM_K + kws) = st_k0; *(bf16x8*)(K_lds + (bf) * SHM_K + kws + 32 * 256) = st_k1; } while (0)
template <class TIn, class TOut>
__device__ __forceinline__ void attn_unit(const BlockRef<TIn, TOut>& cur, int skv, char* lds) {
    const int tid = threadIdx.x, wid = __builtin_amdgcn_readfirstlane(tid >> 6), lane = tid & 63, r32 = lane & 31, hi = lane >> 5;
    const unsigned W = 0x40000000u;
    const int j_lo = cur.jlo;
    int j_hi = (cur.P0 + QB - 1) / KVBLK + 1; if (j_hi > skv / KVBLK) j_hi = skv / KVBLK;
    const int NT = j_hi - j_lo;
    const int qlo = cur.P0 + wid * QBLK, qm = qlo + r32 - 4 * hi;
    char* V_lds = lds; char* K_lds = lds + 2 * SHM_V;
    float* ws = (float*)(lds + 2 * SHM_V + 2 * SHM_K) + wid * 64; float* li_l = ws, * al_l = ws + 32;
    const float* bias_l = (const float*)(lds + LDS_BYTES) + 4 * hi;
    float m_reg = -1e30f, l_reg = 0; f32x16 o[4] = {};
    const int sr = tid >> 4, sc = (tid & 15) * 8, vst0 = v_st(sr, sc), vst1 = v_st(32 + sr, sc), kws = KSWZ(sr, sc * 2);
    const int vb0 = (int)(uintptr_t)V_lds + v_rd_base(lane);
    const TIn* Kh = cur.K; const TIn* Vh = cur.V;
    bf16x8 st_v0, st_v1, st_k0, st_k1; bf16x8 qr[8];
#define KBASE(t) ((j_lo + (t)) * KVBLK)
#define BT(t) (bias_l + (t) * KVBLK)
#define RESC(a) do { if (__any((a) < 1.f)) { if (hi == 0) al_l[r32] = (a); asm volatile("s_waitcnt lgkmcnt(0)" ::: "memory");              \
                     for (int d_ = 0; d_ < 4; ++d_) for (int r = 0; r < 16; ++r) o[d_][r] *= al_l[crow(r, hi)]; } } while (0)
#define MASKT(P0_, P1_, t) do { const int kb_ = KBASE(t); if (kb_ + KVBLK - 1 > qlo) mask_tile(P0_, P1_, qm - kb_, W); } while (0)
#pragma unroll
    for (int d0 = 0; d0 < 8; ++d0) qr[d0] = load8<TIn>(cur.Q + (size_t)(wid * QBLK + r32) * LD + d0 * 16 + hi * 8);
    SLOAD_H(Kh, Vh, KBASE(0)); VMW(); SWRITE_H(0); SBAR();
    if (NT > 1) SLOAD_H(Kh, Vh, KBASE(1));
    __syncthreads();
    f32x16 p0, p1; float mn, al; bf16x8 pa0, pa1, pa2, pa3;
#define TILE_STEP(t, BUF) do {                                                                                                 \
        SBAR(); qkt<BUF, false>(p0, p1, K_lds, r32, hi, qr, true, BT(t));                                                       \
        MASKT(p0, p1, (t)); partialSM(p0, p1, m_reg, mn, al); RESC(al);                                                          \
        finishSM(p0, p1, al, l_reg, pa0, pa1, pa2, pa3); SBAR();                                                                 \
        pv_tile<BUF, false>(o, vb0, pa0, pa1, pa2, pa3, true);                                                                    \
        if ((t) + 1 < NT) { VMW(); SWRITE_H(1 - (BUF)); SBAR(); if ((t) + 2 < NT) SLOAD_H(Kh, Vh, KBASE((t) + 2)); }              \
        __syncthreads(); } while (0)
    for (int t = 0; t < NT; t += 2) {
        TILE_STEP(t, 0);
        if (t + 1 < NT) TILE_STEP(t + 1, 1);
    }
    if (hi == 0) li_l[r32] = l_reg; asm volatile("s_waitcnt lgkmcnt(0)" ::: "memory");
    float rli[16];
#pragma unroll
    for (int r = 0; r < 16; ++r) rli[r] = __builtin_amdgcn_rcpf(li_l[crow(r, hi)]);
    TOut* Ow = cur.O + (size_t)(wid * QBLK) * LD;
#pragma unroll
    for (int r = 0; r < 16; ++r) { const int orow = crow(r, hi);
#pragma unroll
        for (int d0 = 0; d0 < 4; ++d0) { const float v = o[d0][r] * rli[r];
            const float vn = __shfl_xor(v, 1);
            if ((r32 & 1) == 0) *(unsigned*)(Ow + (size_t)orow * LD + d0 * 32 + r32) = cvtpk(v, vn); } }
    __syncthreads();
#undef TILE_STEP
#undef RESC
#undef KBASE
#undef BT
#undef MASKT
}
#undef ROW
#undef VMW
#undef SLOAD_H
#undef SWRITE_H
}
#define GAS __attribute__((address_space(1)))
#define LAS __attribute__((address_space(3)))
typedef unsigned short bf16;
typedef unsigned v4u __attribute__((ext_vector_type(4)));
typedef unsigned v2u __attribute__((ext_vector_type(2)));
typedef float f32x4 __attribute__((ext_vector_type(4)));
typedef float f32x2 __attribute__((ext_vector_type(2)));
typedef short bf16x8 __attribute__((ext_vector_type(8)));
typedef GAS unsigned gu32;
#define RLX_AGENT __ATOMIC_RELAXED, __HIP_MEMORY_SCOPE_AGENT

constexpr int S = 8192, DM = 4096, NH = 16, HD = 128, AW = 2048, LW = 2048, NG = 16, GD = 128;
constexpr int NIN = 18448, NINP = 18432;
constexpr int C_Q = 0, C_K = 2048, C_V = 4096, C_F = 6144, C_LX = 6160, C_LY = 8208, C_GA = 10256, C_GL = 14352;
constexpr int PEER_H = 8, PEER_NK = 128, PEER_K = 16, PEER_NE = 16384;
constexpr float EPS = 1e-6f;
constexpr size_t MiB = 1u << 20;
constexpr size_t WS_CTL = 0, CTL_ZERO_BYTES = 1 * MiB;
constexpr size_t WS_MOD = 512 * 1024;
constexpr size_t WS_WF = 2 * MiB;
constexpr size_t WS_LOGF = 3 * MiB;
constexpr size_t WS_FC = 4 * MiB;
constexpr size_t WS_AGGA = 5 * MiB, WS_AGGB = 6 * MiB;
constexpr size_t WS_BIASR = 7 * MiB, WS_SB = 7 * MiB + 262144;
constexpr size_t WS_SSQ = 28 * MiB;
constexpr size_t WS_WAT = 8 * MiB, WS_WXT = 9 * MiB;
constexpr size_t WS_SK = 10 * MiB, WS_RS = 11 * MiB, WS_RSU = 11 * MiB + 65536;
constexpr size_t WS_IDX = 12 * MiB, WS_GATE = 16 * MiB, WS_IDX2 = 20 * MiB, WS_GATE2 = 24 * MiB;
constexpr size_t WS_WIN = 32 * MiB, WS_WAO = 176 * MiB, WS_WLO = 192 * MiB, WS_WOUT = 208 * MiB, WS_WPQ = 240 * MiB;
constexpr size_t WS_U = 256 * MiB, WS_V = 384 * MiB;
constexpr size_t WS_HA = 512 * MiB;
constexpr size_t WS_QKV = 576 * MiB;
constexpr size_t WS_LX = 672 * MiB, WS_GY = 704 * MiB, WS_GA = 736 * MiB, WS_GL = 800 * MiB;
constexpr size_t WS_ATT = 864 * MiB, WS_LR = 896 * MiB, WS_T1 = 928 * MiB, WS_MG = 992 * MiB, WS_Q2 = 1056 * MiB, WS_X1 = 1088 * MiB, WS_END = 1216 * MiB;
constexpr int CW_BAR = 4096;
constexpr int CW_QATT = 256;
constexpr int RING_BYTES = 131072;
constexpr int LDSCTL_OFF = RING_BYTES, MISC_OFF = LDSCTL_OFF + 320;
constexpr int LDS_BYTES = 151552;
constexpr int NWAVES = 8, NTHREADS = 512;

__device__ __forceinline__ unsigned f2bf(float f) { unsigned u = __builtin_bit_cast(unsigned, f); return (u + 0x7fffu + ((u >> 16) & 1u)) >> 16; }
__device__ __forceinline__ unsigned pk2(float lo, float hi) { return f2bf(lo) | (f2bf(hi) << 16); }
__device__ __forceinline__ float bflo(unsigned w) { return __uint_as_float(w << 16); }
__device__ __forceinline__ float bfhi(unsigned w) { return __uint_as_float(w & 0xffff0000u); }
__device__ __forceinline__ float bf2f(bf16 b) { return __uint_as_float((unsigned)b << 16); }
__device__ __forceinline__ float wave_sum(float v) {
#pragma unroll
    for (int o = 1; o < 64; o <<= 1) v += __shfl_xor(v, o);
    return v;
}
__device__ __forceinline__ float wave_max(float v) {
#pragma unroll
    for (int o = 1; o < 64; o <<= 1) v = fmaxf(v, __shfl_xor(v, o));
    return v;
}
__device__ __forceinline__ float sigmoidf_(float v) { return __builtin_amdgcn_rcpf(1.0f + __builtin_amdgcn_exp2f(-1.4426950408889634f * v)); }
__device__ __forceinline__ float gelu_erf(float v) { return 0.5f * v * (1.0f + erff(v * 0.70710678118654752f)); }
#define XB_TMO      128
#define XB_XCNT(j)  (256  + 64 * (j))
#define XB_XSUB(j)  (1280 + 64 * (j))
#define XB_XGEN(j)  (2304 + 64 * (j))
#define XB_TOP      3328
#define XB_TOPGEN   3392
#define XCD_BAR_WORDS 3456
#define XB_SPIN_CAP (1u << 18)

__device__ __forceinline__ unsigned xb_ld(unsigned* p)              { return __hip_atomic_load(p, __ATOMIC_RELAXED, __HIP_MEMORY_SCOPE_AGENT); }
__device__ __forceinline__ unsigned xb_add(unsigned* p, unsigned v) { return __hip_atomic_fetch_add(p, v, __ATOMIC_RELAXED, __HIP_MEMORY_SCOPE_AGENT); }
__device__ __forceinline__ unsigned xb_xcc_id() { return (unsigned)__builtin_amdgcn_s_getreg((3 << 11) | 20) & 0xFu; }
#define XB_SPIN(cond, bar) do { unsigned _sp = 0; while (cond) { __builtin_amdgcn_s_sleep(1); \
    if ((++_sp & 255u) == 0u) { if (xb_ld(&(bar)[XB_TMO])) break; if (_sp > XB_SPIN_CAP) { atomicAdd(&(bar)[XB_TMO], 1u); break; } } } } while (0)

struct XcdBarrier {
    unsigned* bar; unsigned x;
    volatile LAS unsigned* st;
};

__device__ __forceinline__ XcdBarrier xcd_barrier_post(unsigned* bar, volatile LAS unsigned* st) {
    XcdBarrier b; b.bar = bar; b.x = xb_xcc_id(); b.st = st;
    if (threadIdx.x == 0) (void)xb_add(&bar[XB_XCNT(b.x)], 1u);
    return b;
}
__device__ __forceinline__ void xcd_barrier_complete(unsigned* bar, unsigned x, unsigned& nloc, unsigned& nx) {
    const unsigned G = gridDim.x * gridDim.y * gridDim.z;
    unsigned sum, cnt, mine, sp = 0u;
    for (;;) {
        sum = 0u; cnt = 0u; mine = 0u;
#pragma unroll
        for (unsigned j = 0; j < 16; ++j) { const unsigned c = xb_ld(&bar[XB_XCNT(j)]); sum += c; cnt += (c > 0u) ? 1u : 0u; mine = (j == x) ? c : mine; }
        if (sum == G) break;
        __builtin_amdgcn_s_sleep(1);
        if ((++sp & 255u) == 0u) { if (xb_ld(&bar[XB_TMO])) break; if (sp > XB_SPIN_CAP) { atomicAdd(&bar[XB_TMO], 1u); break; } }
    }
    nloc = mine > 0u ? mine : 1u; nx = cnt > 0u ? cnt : 1u;
}

__device__ __forceinline__ void xcd_barrier(const XcdBarrier& b) {
    asm volatile("s_waitcnt vmcnt(0)" ::: "memory");
    __syncthreads();
    if (threadIdx.x == 0) {
        unsigned* bar = b.bar;
        __builtin_amdgcn_s_waitcnt(0);
        unsigned nloc = b.st[0], nx = b.st[1];
        if (nloc == 0u) { xcd_barrier_complete(bar, b.x, nloc, nx); b.st[0] = nloc; b.st[1] = nx; }
        const unsigned old = xb_add(&bar[XB_XSUB(b.x)], 1u);
        const unsigned gen = old / nloc;
        if (old + 1u == (gen + 1u) * nloc) {
            __builtin_amdgcn_fence(__ATOMIC_RELEASE, "agent");
            asm volatile("s_waitcnt vmcnt(0)" ::: "memory");
            const unsigned og = xb_add(&bar[XB_TOP], 1u);
            const unsigned tg = og / nx;
            if (og + 1u == (tg + 1u) * nx) xb_add(&bar[XB_TOPGEN], 1u);
            else XB_SPIN(xb_ld(&bar[XB_TOPGEN]) == tg, bar);
            __builtin_amdgcn_fence(__ATOMIC_ACQUIRE, "agent");
            xb_add(&bar[XB_XGEN(b.x)], 1u);
            asm volatile("s_waitcnt vmcnt(0)" ::: "memory");
        } else {
            XB_SPIN(xb_ld(&bar[XB_XGEN(b.x)]) == gen, bar);
            __builtin_amdgcn_fence(__ATOMIC_ACQUIRE, "agent");
            asm volatile("s_waitcnt vmcnt(0)" ::: "memory");
        }
    }
    __syncthreads();
}
struct Args { const float* in[24]; float* out; unsigned char* ws; int ph_lo, ph_hi, rep_att, rep_lru; };
struct Frame {
    LAS unsigned char* lds; volatile LAS unsigned* MISC; gu32* ctl;
    int tid, lane, wave, vcu, G;
    unsigned char* ws; float* out;
};
#define WSP(T, off) ((T*)(F.ws + (off)))
#define LDS_WAIT() asm volatile("s_waitcnt lgkmcnt(0)" ::: "memory")

__device__ __forceinline__ void transpose_item(const float* W, int ldw, int K, bf16* WT, LAS float* scr, int k0, int nsrc0, int ndst0, int lane) {
    float v[32]; const float* wp = W + (size_t)(k0 + (lane >> 5)) * ldw + nsrc0 + (lane & 31);
#pragma unroll
    for (int i = 0; i < 32; ++i) v[i] = wp[(size_t)(2 * i) * ldw];
#pragma unroll
    for (int i = 0; i < 32; ++i) scr[(2 * i + (lane >> 5)) * 33 + (lane & 31)] = v[i];
    LDS_WAIT(); asm volatile("" ::: "memory");
    const int c = lane & 7;
#pragma unroll
    for (int j = 0; j < 4; ++j) { const int n = (lane >> 3) + 8 * j; const LAS float* s = scr + (8 * c) * 33 + n;
        v4u o; o.x = pk2(s[0 * 33], s[1 * 33]); o.y = pk2(s[2 * 33], s[3 * 33]); o.z = pk2(s[4 * 33], s[5 * 33]); o.w = pk2(s[6 * 33], s[7 * 33]);
        *(GAS v4u*)(WT + (size_t)(ndst0 + n) * K + k0 + 8 * c) = o; }
    LDS_WAIT(); asm volatile("" ::: "memory");
}
__device__ __forceinline__ void cvt_stream(const float* src, bf16* dst, size_t n8, size_t i0, size_t stride) {
    for (size_t i = i0; i < n8; i += stride) { const f32x4 a = ((const GAS f32x4*)src)[2 * i], b = ((const GAS f32x4*)src)[2 * i + 1];
        v4u o; o.x = pk2(a[0], a[1]); o.y = pk2(a[2], a[3]); o.z = pk2(b[0], b[1]); o.w = pk2(b[2], b[3]); ((GAS v4u*)dst)[i] = o; }
}
__device__ __forceinline__ void cvt_stream_fp8(const float* src, unsigned char* dst, size_t n16, float scale, size_t i0, size_t stride) {
    for (size_t i = i0; i < n16; i += stride) { v4u o;
#pragma unroll
        for (int q = 0; q < 4; ++q) { const f32x4 a = ((const GAS f32x4*)src)[4 * i + q] * scale; int w = 0;
            w = __builtin_amdgcn_cvt_pk_fp8_f32(a[0], a[1], w, false); w = __builtin_amdgcn_cvt_pk_fp8_f32(a[2], a[3], w, true); o[q] = (unsigned)w; }
        ((GAS v4u*)dst)[i] = o; }
}
__device__ __forceinline__ void cvt_table_fp4(Frame& F, const float* srcT, unsigned char* dstT, float* rsT, int gw, int NGW) {
    for (int row = gw; row < PEER_NE; row += NGW) {
        const GAS f32x4* src = (const GAS f32x4*)(srcT + (size_t)row * DM); f32x4 a[16]; float am = 0.f;
#pragma unroll
        for (int c = 0; c < 4; ++c)
#pragma unroll
            for (int q = 0; q < 4; ++q) { a[4 * c + q] = src[c * 256 + 4 * F.lane + q]; am = fmaxf(fmaxf(am, fmaxf(fabsf(a[4 * c + q][0]), fabsf(a[4 * c + q][1]))), fmaxf(fabsf(a[4 * c + q][2]), fabsf(a[4 * c + q][3]))); }
        am = wave_max(am); const float inv = am > 0.f ? 6.0f / am : 0.f;
#pragma unroll
        for (int c = 0; c < 4; ++c) { v2u o;
#pragma unroll
            for (int d = 0; d < 2; ++d) { unsigned w = 0u; const f32x4 x0 = a[4 * c + 2 * d] * inv, x1 = a[4 * c + 2 * d + 1] * inv;
                w = __builtin_amdgcn_cvt_scalef32_pk_fp4_f32(w, x0[0], x0[1], 1.0f, 0); w = __builtin_amdgcn_cvt_scalef32_pk_fp4_f32(w, x0[2], x0[3], 1.0f, 1);
                w = __builtin_amdgcn_cvt_scalef32_pk_fp4_f32(w, x1[0], x1[1], 1.0f, 2); w = __builtin_amdgcn_cvt_scalef32_pk_fp4_f32(w, x1[2], x1[3], 1.0f, 3); o[d] = w; }
            *((GAS v2u*)(dstT + (size_t)row * 2048 + c * 512) + F.lane) = o; }
        if (F.lane == 0) rsT[row] = am * (1.0f / 6.0f);
    }
}
__device__ __forceinline__ void p0_prologue(Frame& F, const Args& args) {
#ifndef P0_REP
#define P0_REP 0
#endif
    _Pragma("unroll") for (int rep_ = 0; rep_ < ((P0_REP & 1) ? 2 : 1); ++rep_)
    { LAS float* sc = (LAS float*)F.lds; LAS f32x4* red = (LAS f32x4*)(F.lds + 16384); float* MOD = WSP(float, WS_MOD);
      for (int cgi = blockIdx.x; cgi < 256; cgi += F.G) {
          for (int i = F.tid; i < DM; i += NTHREADS) { const float cv = args.in[1][i]; sc[i] = cv / (1.0f + __expf(-cv)); }
          __syncthreads();
          if (F.tid < 384) { const int cg = F.tid % 24, rg = F.tid / 24;
              const GAS f32x4* Wp = (const GAS f32x4*)args.in[2] + cgi * 24 + cg;
              f32x4 acc = {0.f, 0.f, 0.f, 0.f};
#pragma unroll 8
              for (int r = rg; r < DM; r += 16) acc += sc[r] * Wp[(size_t)r * 6144];
              red[rg * 24 + cg] = acc; }
          __syncthreads();
          if (F.tid < 24) { f32x4 s = red[F.tid];
#pragma unroll
              for (int rg = 1; rg < 16; ++rg) s += red[rg * 24 + F.tid];
              s += ((const GAS f32x4*)args.in[3])[cgi * 24 + F.tid]; ((GAS f32x4*)MOD)[cgi * 24 + F.tid] = s; }
          __syncthreads();
      } }
    LAS float* scr = (LAS float*)(F.lds + F.wave * 16384);
    const int gw = F.vcu * NWAVES + F.wave, NGW = F.G * NWAVES;
    constexpr int I_IN = 64 * 576, I_AO = 32 * 128, I_LO = 32 * 128, I_OUT = 64 * 128, I_PQ = 64 * 64, I_WA = 16 * 2 * 4, I_WX = I_WA;
    constexpr int NITEMS = I_IN + I_AO + I_LO + I_OUT + I_PQ + I_WA + I_WX;
    _Pragma("unroll") for (int rep_ = 0; rep_ < ((P0_REP & 2) ? 2 : 1); ++rep_)
    for (int it = gw; it < NITEMS; it += NGW) {
        int r = it;
        if (r < I_IN) { const int kb = r / 576, nb = r % 576; transpose_item(args.in[6], NIN, DM, WSP(bf16, WS_WIN), scr, 64 * kb, 32 * nb + (nb >= 192 ? 16 : 0), 32 * nb, F.lane); continue; } r -= I_IN;
        if (r < I_AO) { const int kb = r / 128, nb = r % 128; transpose_item(args.in[17], DM, AW, WSP(bf16, WS_WAO), scr, 64 * kb, 32 * nb, 32 * nb, F.lane); continue; } r -= I_AO;
        if (r < I_LO) { const int kb = r / 128, nb = r % 128; transpose_item(args.in[18], DM, LW, WSP(bf16, WS_WLO), scr, 64 * kb, 32 * nb, 32 * nb, F.lane); continue; } r -= I_LO;
        if (r < I_OUT) { const int kb = r / 128, nb = r % 128; transpose_item(args.in[19], DM, DM, WSP(bf16, WS_WOUT), scr, 64 * kb, 32 * nb, 32 * nb, F.lane); continue; } r -= I_OUT;
        if (r < I_PQ) { const int kb = r / 64, nb = r % 64; transpose_item(args.in[20], 2048, DM, WSP(bf16, WS_WPQ), scr, 64 * kb, 32 * nb, 32 * nb, F.lane); continue; } r -= I_PQ;
        { const bool isx = r >= I_WA; if (isx) r -= I_WA; const int g = r >> 3, kb = (r >> 2) & 1, nb = r & 3;
          transpose_item((isx ? args.in[14] : args.in[12]) + (size_t)g * GD * GD, GD, GD, WSP(bf16, isx ? WS_WXT : WS_WAT) + (size_t)g * GD * GD, scr, 64 * kb, 32 * nb, 32 * nb, F.lane); }
    }
    const size_t gt = (size_t)F.vcu * NTHREADS + F.tid, NGT = (size_t)F.G * NTHREADS;
    _Pragma("unroll") for (int rep_ = 0; rep_ < ((P0_REP & 4) ? 2 : 1); ++rep_) {
    cvt_table_fp4(F, args.in[23], WSP(unsigned char, WS_V), WSP(float, WS_RS), gw, NGW);
    cvt_table_fp4(F, args.in[22], WSP(unsigned char, WS_U), WSP(float, WS_RSU), gw, NGW); }
    cvt_stream(args.in[21], WSP(bf16, WS_SK), (size_t)PEER_H * 2 * 128 * 128 / 8, gt, NGT);
    for (size_t i = gt; i < (size_t)DM * 16; i += NGT) WSP(float, WS_WF)[(i & 15) * DM + (i >> 4)] = args.in[6][(i >> 4) * NIN + C_F + (i & 15)];
    for (size_t i = gt; i < (size_t)NINP; i += NGT) WSP(float, WS_BIASR)[i] = args.in[7][i + (i >= (size_t)C_F ? 16 : 0)];
}

__device__ __forceinline__ void p1_norm_forget(Frame& F, const Args& args) {
    const float* MOD = WSP(float, WS_MOD); const float* WFT = WSP(float, WS_WF); bf16* HA = WSP(bf16, WS_HA);
    LAS f32x4* MUL4 = (LAS f32x4*)F.lds; LAS f32x4* SH4 = (LAS f32x4*)(F.lds + 16384); LAS f32x4* WB4 = (LAS f32x4*)(F.lds + 32768);
    for (int i4 = F.tid; i4 < DM / 4; i4 += NTHREADS) { MUL4[i4] = ((const GAS f32x4*)args.in[4])[i4] * (((const GAS f32x4*)(MOD + 4096))[i4] + 1.0f); SH4[i4] = ((const GAS f32x4*)MOD)[i4]; }
    __syncthreads();
    const int cw = F.tid >> 6, dw = F.tid & 63;
    const unsigned wo0 = (unsigned)(cw * DM + dw * 4) * 4u, wo1 = (unsigned)((cw + 8) * DM + dw * 4) * 4u, lo16 = (unsigned)F.lane * 16u, lo8 = (unsigned)F.lane * 8u;
#pragma unroll 1
    for (int step = blockIdx.x; step < S / 32; step += F.G) {
        const int ra = step * 32 + F.wave * 4; const char* xb0 = (const char*)(args.in[0] + (size_t)ra * DM); char* hb0 = (char*)(HA + (size_t)ra * DM);
        float rs[4];
#pragma unroll
        for (int r = 0; r < 4; ++r) { f32x4 xa[16]; float ss = 0.f;
#pragma unroll
            for (int j = 0; j < 16; ++j) xa[j] = *(const GAS f32x4*)(xb0 + (size_t)r * (DM * 4) + 1024 * j + lo16);
#pragma unroll
            for (int j = 0; j < 16; ++j) ss += (xa[j][0] * xa[j][0] + xa[j][1] * xa[j][1]) + (xa[j][2] * xa[j][2] + xa[j][3] * xa[j][3]);
            rs[r] = 1.0f / sqrtf(wave_sum(ss) * (1.0f / DM) + EPS); }
        float acc[4][16];
#pragma unroll
        for (int r = 0; r < 4; ++r)
#pragma unroll
            for (int c = 0; c < 16; ++c) acc[r][c] = 0.f;
        f32x4 w0 = *(const GAS f32x4*)((const char*)WFT + wo0), w1 = *(const GAS f32x4*)((const char*)WFT + wo1), xn[4];
#pragma unroll
        for (int r = 0; r < 4; ++r) xn[r] = *(const GAS f32x4*)(xb0 + (size_t)r * (DM * 4) + lo16);
#pragma unroll 1
        for (int j = 0; j < 16; ++j) {
            LAS f32x4* wb = WB4 + (j & 1) * 1024;
            wb[F.tid] = w0; wb[F.tid + 512] = w1;
            __syncthreads();
            f32x4 xc[4]; const int jn = (j + 1) & 15;
#pragma unroll
            for (int r = 0; r < 4; ++r) xc[r] = xn[r];
            { const char* wbase = (const char*)WFT + 1024 * jn; w0 = *(const GAS f32x4*)(wbase + wo0); w1 = *(const GAS f32x4*)(wbase + wo1); }
#pragma unroll
            for (int r = 0; r < 4; ++r) xn[r] = *(const GAS f32x4*)(xb0 + (size_t)r * (DM * 4) + 1024 * jn + lo16);
            const f32x4 mul = MUL4[F.lane + 64 * j], sh = SH4[F.lane + 64 * j];
            f32x4 h[4];
#pragma unroll
            for (int r = 0; r < 4; ++r) { h[r] = xc[r] * rs[r] * mul + sh; v2u o; o.x = pk2(h[r][0], h[r][1]); o.y = pk2(h[r][2], h[r][3]); *(GAS v2u*)(hb0 + (size_t)r * (DM * 2) + 512 * j + lo8) = o; }
#pragma unroll
            for (int c = 0; c < 16; ++c) { const f32x4 wf = wb[c * 64 + F.lane];
#pragma unroll
                for (int r = 0; r < 4; ++r) acc[r][c] += (h[r][0] * wf[0] + h[r][1] * wf[1]) + (h[r][2] * wf[2] + h[r][3] * wf[3]); }
        }
#pragma unroll
        for (int c = 0; c < 16; ++c) { float tt[4];
#pragma unroll
            for (int r = 0; r < 4; ++r) tt[r] = wave_sum(acc[r][c]);
            if (F.lane == c) { const float bia = args.in[7][C_F + c];
#pragma unroll
                for (int r = 0; r < 4; ++r) { const float f = tt[r] + bia; WSP(float, WS_LOGF)[(size_t)c * S + ra + r] = fminf(f, 0.f) - log1pf(__expf(-fabsf(f))); } } }
        __syncthreads();
    }
}
__device__ __forceinline__ void p1_shift_proj(Frame& F, const Args& args) {
    const int gw = F.vcu * NWAVES + F.wave, NGW = F.G * NWAVES; const float* sh2 = WSP(float, WS_MOD) + 12288; const bf16* WT = WSP(bf16, WS_WPQ);
    for (int col = gw; col < 2048; col += NGW) { float s = 0.f;
#pragma unroll
        for (int c = 0; c < 8; ++c) { const v4u w = *((const GAS v4u*)(WT + (size_t)col * DM + c * 512) + F.lane); const GAS f32x4* sp = (const GAS f32x4*)(sh2 + c * 512 + F.lane * 8); const f32x4 a = sp[0], b = sp[1];
            s += (bflo(w.x) * a[0] + bfhi(w.x) * a[1]) + (bflo(w.y) * a[2] + bfhi(w.y) * a[3]) + (bflo(w.z) * b[0] + bfhi(w.z) * b[1]) + (bflo(w.w) * b[2] + bfhi(w.w) * b[3]); }
        s = wave_sum(s); if (F.lane == 0) WSP(float, WS_SB)[col] = s; }
}

__device__ __forceinline__ void p3_qknorm(Frame& F, const Args& args) {
    const int gw = F.vcu * NWAVES + F.wave, NGW = F.G * NWAVES; bf16* QK = WSP(bf16, WS_QKV);
    const int sub = F.lane & 15;
    f32x4 gq0 = ((const GAS f32x4*)args.in[8])[2 * sub], gq1 = ((const GAS f32x4*)args.in[8])[2 * sub + 1], gk0 = ((const GAS f32x4*)args.in[9])[2 * sub], gk1 = ((const GAS f32x4*)args.in[9])[2 * sub + 1];
    for (int it0 = gw; it0 < 2 * S * NH / 4; it0 += 4 * NGW) {
        v4u w[4]; GAS v4u* pp[4];
#pragma unroll
        for (int k = 0; k < 4; ++k) { const int it = it0 + k * NGW; const size_t unit = (size_t)(it < 2 * S * NH / 4 ? it : it0) * 4 + (F.lane >> 4); pp[k] = (GAS v4u*)(QK + unit * 128) + sub; w[k] = *pp[k]; }
#pragma unroll
        for (int k = 0; k < 4; ++k) { const int it = it0 + k * NGW; const size_t unit = (size_t)(it < 2 * S * NH / 4 ? it : it0) * 4 + (F.lane >> 4); const bool isk = unit >= (size_t)S * NH;
            f32x4 a = {bflo(w[k].x), bfhi(w[k].x), bflo(w[k].y), bfhi(w[k].y)}, b = {bflo(w[k].z), bfhi(w[k].z), bflo(w[k].w), bfhi(w[k].w)};
            float ss = (a[0] * a[0] + a[1] * a[1]) + (a[2] * a[2] + a[3] * a[3]) + (b[0] * b[0] + b[1] * b[1]) + (b[2] * b[2] + b[3] * b[3]);
            ss += __shfl_xor(ss, 1); ss += __shfl_xor(ss, 2); ss += __shfl_xor(ss, 4); ss += __shfl_xor(ss, 8);
            const float rs = 1.0f / sqrtf(ss * (1.0f / HD) + EPS);
            a = a * rs * (isk ? gk0 : gq0); b = b * rs * (isk ? gk1 : gq1);
            v4u o; o.x = pk2(a[0], a[1]); o.y = pk2(a[2], a[3]); o.z = pk2(b[0], b[1]); o.w = pk2(b[2], b[3]);
            if (it < 2 * S * NH / 4) *pp[k] = o; }
    }
}
__device__ __forceinline__ void p3_cumsum(Frame& F, const Args& args) {
    LAS float* wt = (LAS float*)F.lds;
    for (int h = blockIdx.x; h < NH; h += F.G) {
        const float* LF = WSP(float, WS_LOGF); float v[16]; float run = 0.f;
        { const GAS f32x4* lp = (const GAS f32x4*)(LF + (size_t)h * S + F.tid * 16); const f32x4 l0 = lp[0], l1 = lp[1], l2 = lp[2], l3 = lp[3];
          const float lv[16] = {l0[0], l0[1], l0[2], l0[3], l1[0], l1[1], l1[2], l1[3], l2[0], l2[1], l2[2], l2[3], l3[0], l3[1], l3[2], l3[3]};
#pragma unroll
          for (int i = 0; i < 16; ++i) { run += lv[i]; v[i] = run; } }
        float sc = run;
#pragma unroll
        for (int o = 1; o < 64; o <<= 1) { const float t = __shfl_up(sc, o); if (F.lane >= o) sc += t; }
        if (F.lane == 63) wt[F.wave] = sc;
        __syncthreads();
        float pre = sc - run;
        for (int w = 0; w < F.wave; ++w) pre += wt[w];
        float* Fo = WSP(float, WS_FC) + (size_t)h * S + F.tid * 16;
#pragma unroll
        for (int i = 0; i < 4; ++i) ((GAS f32x4*)Fo)[i] = (f32x4){v[4 * i] + pre, v[4 * i + 1] + pre, v[4 * i + 2] + pre, v[4 * i + 3] + pre};
        __syncthreads();
    }
}
constexpr int LRU_XCF = 0, LRU_XCB = 32768, LRU_AB = 49152, LRU_BB = 81920, LRU_QA = 114688, LRU_CAR = 118784, LRU_XR = 133120;
struct LruConst { float w0, w1, w2, w3, cb, bav, bxv, sp8; };
template <int PASS> __device__ __forceinline__ void lru_chunk(Frame& F, const Args& args, int c, int g, v4u (&raw)[3], const bf16x8 (&ba)[4], const bf16x8 (&bx)[4], bool more, const LruConst& K) {
    LAS float* XCF = (LAS float*)(F.lds + LRU_XCF); LAS unsigned char* XCB = F.lds + LRU_XCB; LAS float* AB = (LAS float*)(F.lds + LRU_AB); LAS float* BB = (LAS float*)(F.lds + LRU_BB);
    LAS float* QA = (LAS float*)(F.lds + LRU_QA); LAS float* CAR = (LAS float*)(F.lds + LRU_CAR); LAS bf16* XR = (LAS bf16*)(F.lds + LRU_XR);
    const int t0 = 64 * c, ch0 = GD * g; const bf16* LX = WSP(bf16, WS_LX);
#pragma unroll
    for (int k = 0; k < 3; ++k) { const int p = F.tid + k * NTHREADS; if (p < 67 * 16) *(LAS v4u*)(XR + (p >> 4) * 128 + (p & 15) * 8) = raw[k]; }
    if (more) {
#pragma unroll
        for (int k = 0; k < 3; ++k) { const int p = F.tid + k * NTHREADS; const int r = p >> 4, cc = p & 15, tg = t0 + 64 - 3 + r; raw[k] = (v4u){0u, 0u, 0u, 0u};
            if (p < 67 * 16 && tg >= 0) raw[k] = *(const GAS v4u*)(LX + (size_t)tg * LW + ch0 + cc * 8); } }
    __syncthreads();
    { const int ch = F.tid & 127, tq = F.tid >> 7, gch = ch0 + ch;
      const float w0 = K.w0, w1 = K.w1, w2 = K.w2, w3 = K.w3, cb = K.cb; (void)gch;
      float xm3 = bf2f(XR[(16 * tq + 0) * 128 + ch]), xm2 = bf2f(XR[(16 * tq + 1) * 128 + ch]), xm1 = bf2f(XR[(16 * tq + 2) * 128 + ch]);
#pragma unroll
      for (int i = 0; i < 16; ++i) { const int t = 16 * tq + i; const float x0 = bf2f(XR[(t + 3) * 128 + ch]);
          const float xc = w0 * xm3 + w1 * xm2 + w2 * xm1 + w3 * x0 + cb; xm3 = xm2; xm2 = xm1; xm1 = x0;
          XCF[t * 128 + ch] = xc; *(LAS bf16*)(XCB + t * 256 + ((ch * 2) ^ ((t & 7) << 4))) = (bf16)f2bf(xc); } }
    __syncthreads();
    { const int fr = F.lane & 15, fq = F.lane >> 4, j = 16 * F.wave + fr;
      const float bav = K.bav, bxv = K.bxv, sp8 = K.sp8;
#pragma unroll
      for (int mt = 0; mt < 4; ++mt) { f32x4 ar = {0.f, 0.f, 0.f, 0.f}, ax = {0.f, 0.f, 0.f, 0.f}; const int t = 16 * mt + fr;
#pragma unroll
          for (int ks = 0; ks < 4; ++ks) { const bf16x8 af = *(const LAS bf16x8*)(XCB + t * 256 + (((32 * ks + 8 * fq) * 2) ^ ((t & 7) << 4)));
              ar = __builtin_amdgcn_mfma_f32_16x16x32_bf16(af, ba[ks], ar, 0, 0, 0); ax = __builtin_amdgcn_mfma_f32_16x16x32_bf16(af, bx[ks], ax, 0, 0, 0); }
#pragma unroll
          for (int rg = 0; rg < 4; ++rg) { const int tt = 16 * mt + 4 * fq + rg; const float xcv = XCF[tt * 128 + j];
              const float rgt = sigmoidf_(ar[rg] + bav), igt = sigmoidf_(ax[rg] + bxv);
              const float a = __builtin_amdgcn_exp2f(rgt * sp8); const float om = fmaxf((1.0f - a) * (1.0f + a), 0.f);
              const float b = __builtin_amdgcn_sqrtf(om) * (igt * xcv);
              AB[tt * 128 + j] = a; BB[tt * 128 + j] = b; } } }
    __syncthreads();
    const int ch = F.tid & 127, q = F.tid >> 7;
    { float A = 1.f, B = 0.f;
#pragma unroll
      for (int i = 0; i < 16; ++i) { const int t = 16 * q + i; const float a = AB[t * 128 + ch]; B = a * B + BB[t * 128 + ch]; A *= a; }
      QA[(q * 128 + ch) * 2] = A; QA[(q * 128 + ch) * 2 + 1] = B; }
    __syncthreads();
    if (PASS == 0) {
        if (F.tid < 128) { float A = 1.f, B = 0.f;
#pragma unroll
            for (int qq = 0; qq < 4; ++qq) { const float a = QA[(qq * 128 + F.tid) * 2], b = QA[(qq * 128 + F.tid) * 2 + 1]; B = a * B + b; A *= a; }
            WSP(float, WS_AGGA)[(size_t)c * LW + ch0 + F.tid] = A; WSP(float, WS_AGGB)[(size_t)c * LW + ch0 + F.tid] = B; }
    } else {
        float h = CAR[ch];
        for (int qq = 0; qq < q; ++qq) h = QA[(qq * 128 + ch) * 2] * h + QA[(qq * 128 + ch) * 2 + 1];
#pragma unroll
        for (int i = 0; i < 16; ++i) { const int t = 16 * q + i; h = AB[t * 128 + ch] * h + BB[t * 128 + ch]; XCF[t * 128 + ch] = h; }
        __syncthreads();
        if (F.tid < 128) { float hc = CAR[F.tid];
#pragma unroll
            for (int qq = 0; qq < 4; ++qq) hc = QA[(qq * 128 + F.tid) * 2] * hc + QA[(qq * 128 + F.tid) * 2 + 1];
            CAR[F.tid] = hc; }
        const bf16* GY = WSP(bf16, WS_GY); bf16* LR = WSP(bf16, WS_LR);
        for (int p = F.tid; p < 64 * 16; p += NTHREADS) { const int r = p >> 4, cc = p & 15; const size_t o = (size_t)(t0 + r) * LW + ch0 + cc * 8;
            const v4u gy = *(const GAS v4u*)(GY + o); const f32x4 h0 = *(const LAS f32x4*)(XCF + r * 128 + cc * 8), h1 = *(const LAS f32x4*)(XCF + r * 128 + cc * 8 + 4);
            v4u ov; ov.x = pk2(h0[0] * bflo(gy.x), h0[1] * bfhi(gy.x)); ov.y = pk2(h0[2] * bflo(gy.y), h0[3] * bfhi(gy.y)); ov.z = pk2(h1[0] * bflo(gy.z), h1[1] * bfhi(gy.z)); ov.w = pk2(h1[2] * bflo(gy.w), h1[3] * bfhi(gy.w));
            *(GAS v4u*)(LR + o) = ov; }
    }
    __syncthreads();
}
template <int PASS> __device__ __forceinline__ void lru_item(Frame& F, const Args& args, int w) {
    const int g = w & 15, c0 = (w >> 4) * 8; LAS float* CAR = (LAS float*)(F.lds + LRU_CAR); LAS float* QA = (LAS float*)(F.lds + LRU_QA);
    if (PASS == 1) {
        const int ch = F.tid & 127, q = F.tid >> 7, n = c0 / 4;
        const float* GA_ = WSP(float, WS_AGGA) + GD * g + ch; const float* GB_ = WSP(float, WS_AGGB) + GD * g + ch; float A = 1.f, B = 0.f;
#pragma unroll 4
        for (int cc = q * n; cc < (q + 1) * n; ++cc) { const float a = GA_[(size_t)cc * LW], b = GB_[(size_t)cc * LW]; B = a * B + b; A *= a; }
        QA[(q * 128 + ch) * 2] = A; QA[(q * 128 + ch) * 2 + 1] = B;
        __syncthreads();
        if (F.tid < 128) { float hc = 0.f;
#pragma unroll
            for (int qq = 0; qq < 4; ++qq) hc = QA[(qq * 128 + F.tid) * 2] * hc + QA[(qq * 128 + F.tid) * 2 + 1];
            CAR[F.tid] = hc; }
        __syncthreads();
    }
    bf16x8 ba[4], bx[4];
    { const int fr = F.lane & 15, fq = F.lane >> 4, j = 16 * F.wave + fr;
      const bf16* WA = WSP(bf16, WS_WAT) + (size_t)g * GD * GD + (size_t)j * GD + 8 * fq; const bf16* WX = WSP(bf16, WS_WXT) + (size_t)g * GD * GD + (size_t)j * GD + 8 * fq;
#pragma unroll
      for (int ks = 0; ks < 4; ++ks) { ba[ks] = *(const GAS bf16x8*)(WA + 32 * ks); bx[ks] = *(const GAS bf16x8*)(WX + 32 * ks); } }
    v4u raw[3];
    { const bf16* LX = WSP(bf16, WS_LX); const int t0 = 64 * c0, ch0 = GD * g;
#pragma unroll
      for (int k = 0; k < 3; ++k) { const int p = F.tid + k * NTHREADS; const int r = p >> 4, cc = p & 15, tg = t0 - 3 + r; raw[k] = (v4u){0u, 0u, 0u, 0u};
          if (p < 67 * 16 && tg >= 0) raw[k] = *(const GAS v4u*)(LX + (size_t)tg * LW + ch0 + cc * 8); } }
    LruConst K;
    { const int gch = GD * g + (F.tid & 127); K.w0 = args.in[10][gch]; K.w1 = args.in[10][LW + gch]; K.w2 = args.in[10][2 * LW + gch]; K.w3 = args.in[10][3 * LW + gch]; K.cb = args.in[11][gch];
      const int gcj = GD * g + 16 * F.wave + (F.lane & 15); K.bav = args.in[13][gcj]; K.bxv = args.in[15][gcj]; const float lam = args.in[16][gcj];
      K.sp8 = -8.0f * 1.4426950408889634f * ((lam > 0.f ? 0.f : -lam) + log1pf(__expf(-fabsf(lam)))); }
#pragma unroll 1
    for (int c = c0; c < c0 + 8; ++c) lru_chunk<PASS>(F, args, c, g, raw, ba, bx, c + 1 < c0 + 8, K);
}
constexpr int ATT_BIAS_OFF = attn_body::LDS_BYTES;
typedef attn_body::BlockRef<bf16, bf16> ARef;
__device__ __forceinline__ int attn_jlo(const float* Fh, int qb, float TH, int lane) {
    const int t0 = qb * 256; const float f0 = Fh[t0];
    const int j0 = lane, j1 = lane + 64;
    const bool ok0 = (64 * j0 + 63 >= t0) || (f0 - Fh[64 * j0 + 63] >= -TH), ok1 = (64 * j1 + 63 >= t0) || (f0 - Fh[64 * j1 + 63] >= -TH);
    const unsigned long long m0 = __ballot(ok0), m1 = __ballot(ok1);
    return m0 ? (int)__builtin_ctzll(m0) : 64 + (int)__builtin_ctzll(m1);
}
__device__ __forceinline__ ARef attn_ref(Frame& F, const Args& args, int h, int qb, int jlo) {
    ARef r; const bf16* QK = WSP(bf16, WS_QKV);
    r.Q = QK + (size_t)(qb * 256) * AW + h * HD; r.K = QK + (size_t)S * AW + h * HD; r.V = QK + 2 * (size_t)S * AW + h * HD;
    r.O = WSP(bf16, WS_ATT) + (size_t)(qb * 256) * AW + h * HD; r.P0 = qb * 256; r.jlo = jlo; return r;
}
__device__ __forceinline__ void attn_fill_bias(Frame& F, const Args& args, int h, int qb, int jlo) {
    const float* Fh = WSP(float, WS_FC) + (size_t)h * S; LAS float* bl = (LAS float*)(F.lds + ATT_BIAS_OFF);
    const int k0 = jlo * 64, n = (qb + 1) * 256 - k0; const float fr = Fh[k0];
#pragma unroll 1
    for (int i = F.tid; i < n; i += NTHREADS) bl[i] = (fr - Fh[k0 + i]) * (1.0f / attn_body::SCALE);
}
#ifndef ATT_MARGIN
#define ATT_MARGIN 25.0f
#endif
constexpr int ATT_SCHED_OFF = 104448;
__device__ __forceinline__ void p4_attention(Frame& F, const Args& args, char* lds_generic, int rep) {
    float gq = fmaxf(fabsf(args.in[8][F.lane]), fabsf(args.in[8][F.lane + 64])), gk = fmaxf(fabsf(args.in[9][F.lane]), fabsf(args.in[9][F.lane + 64]));
    gq = wave_max(gq); gk = wave_max(gk);
    const float TH = 2.0f * (128.0f * gq * gk * attn_body::SCALE) + ATT_MARGIN;
    LAS float* Fend = (LAS float*)(F.lds + ATT_SCHED_OFF); LAS int* cost = (LAS int*)(F.lds + ATT_SCHED_OFF + 8192); LAS int* jlo_t = cost + 512; LAS int* order = cost + 1024; LAS int* slot = cost + 1536;
    const float* Fc = WSP(float, WS_FC);
    for (int p = F.tid; p < NH * 128; p += NTHREADS) Fend[p] = Fc[(size_t)(p >> 7) * S + 64 * (p & 127) + 63];
    __syncthreads();
    { const int u = F.tid, h = u >> 5, qb = u & 31, t0 = qb * 256; const float f0 = Fc[(size_t)h * S + t0];
      int lo = 0, hi = 4 * qb;
      while (lo < hi) { const int mid = (lo + hi) >> 1; const bool ok = (64 * mid + 63 >= t0) || (f0 - Fend[h * 128 + mid] >= -TH); if (ok) hi = mid; else lo = mid + 1; }
      jlo_t[u] = lo; cost[u] = 4 * (qb + 1) - lo; }
    __syncthreads();
    { const int u = F.tid, cu = cost[u]; int rk = 0;
      for (int v = 0; v < 512; ++v) { const int cv = cost[v]; rk += (cv > cu || (cv == cu && v < u)) ? 1 : 0; }
      order[rk] = u; }
    __syncthreads();
    for (;;) {
        if (F.tid == 0) slot[0] = (int)__hip_atomic_fetch_add((unsigned*)(F.ctl + CW_QATT + 64 * rep), 1u, RLX_AGENT);
        __syncthreads();
        const int k = slot[0];
        __syncthreads();
        if (k >= 512) break;
        const int u = order[k], h = u >> 5, qb = u & 31, jl = jlo_t[u];
        const ARef r0 = attn_ref(F, args, h, qb, jl);
        attn_fill_bias(F, args, h, qb, jl); __syncthreads();
        attn_body::attn_unit<bf16, bf16>(r0, S, lds_generic);
    }
}

__device__ __forceinline__ void p7_norm2(Frame& F, const Args& args) {
    const int gw = F.vcu * NWAVES + F.wave, NGW = F.G * NWAVES; const float* MOD = WSP(float, WS_MOD); bf16* HA = WSP(bf16, WS_HA);
    for (int m = gw; m < S; m += NGW) {
        const GAS f32x4* xr = (const GAS f32x4*)(WSP(float, WS_X1) + (size_t)m * DM) + F.lane; f32x4 v[16]; float ss = 0.f;
#pragma unroll
        for (int j = 0; j < 16; ++j) { v[j] = xr[64 * j]; ss += (v[j][0] * v[j][0] + v[j][1] * v[j][1]) + (v[j][2] * v[j][2] + v[j][3] * v[j][3]); }
        const float rstd = 1.0f / sqrtf(wave_sum(ss) * (1.0f / DM) + EPS);
#pragma unroll
        for (int j = 0; j < 16; ++j) { const int i4 = F.lane + 64 * j;
            const f32x4 g = ((const GAS f32x4*)args.in[5])[i4], scl = ((const GAS f32x4*)(MOD + 16384))[i4], sh = ((const GAS f32x4*)(MOD + 12288))[i4];
            const f32x4 hv = v[j] * rstd * (g * (scl + 1.0f)) + sh;
            v2u o; o.x = pk2(hv[0], hv[1]); o.y = pk2(hv[2], hv[3]); ((GAS v2u*)(HA + (size_t)m * DM))[i4] = o; }
    }
}

template <int CTRL> __device__ __forceinline__ unsigned dppu(unsigned x) { return (unsigned)__builtin_amdgcn_update_dpp(0, (int)x, CTRL, 0xF, 0xF, true); }
__device__ __forceinline__ unsigned rowmax_u32(unsigned x) { x = max(x, dppu<0xB1>(x)); x = max(x, dppu<0x4E>(x)); x = max(x, dppu<0x141>(x)); x = max(x, dppu<0x140>(x)); return x; }
__device__ __forceinline__ float rowsum_f32(float x) { x += __uint_as_float(dppu<0xB1>(__float_as_uint(x))); x += __uint_as_float(dppu<0x4E>(__float_as_uint(x)));
    x += __uint_as_float(dppu<0x141>(__float_as_uint(x))); x += __uint_as_float(dppu<0x140>(__float_as_uint(x))); return x; }
__device__ __forceinline__ unsigned ordk(float f) { const unsigned u = __float_as_uint(f); return u ^ ((unsigned)((int)u >> 31) | 0x80000000u); }
__device__ __forceinline__ float deck(unsigned k) { return __uint_as_float((k & 0x80000000u) ? (k ^ 0x80000000u) : ~k); }
#define CE_(x, y) do { const unsigned hi_ = max(x, y), lo_ = min(x, y); x = hi_; y = lo_; } while (0)
__device__ __forceinline__ unsigned row_pop16(unsigned (&a)[8], int i) {
    unsigned res = 0u;
#pragma unroll
    for (int r = 0; r < 16; ++r) { const unsigned m = rowmax_u32(a[0]); const bool win = a[0] == m;
#pragma unroll
        for (int s = 0; s < 7; ++s) a[s] = win ? a[s + 1] : a[s];
        a[7] = win ? 0u : a[7]; res = (i == r) ? m : res; }
    return res;
}
__device__ __forceinline__ void p9_topk(Frame& F, const Args& args) {
    const bf16* Q2 = WSP(bf16, WS_Q2); const bf16* SK = WSP(bf16, WS_SK); int* IDX = WSP(int, WS_IDX); float* GATE = WSP(float, WS_GATE);
    const int i = F.lane & 15, q = F.lane >> 4;
    const unsigned qlo = (unsigned)(i * 2048 + 8 * q) * 2u;
    const int h = (int)blockIdx.x & 7, ib = (int)blockIdx.x >> 3, nbh = ((int)F.G - h + 7) >> 3;
    for (int c = F.tid; c < 4096; c += NTHREADS) { const int pp = c >> 11, n = (c >> 4) & 127, ch = c & 15;
        *(LAS v4u*)(F.lds + pp * 32768 + n * 256 + ((ch * 16) ^ ((n & 7) << 4))) = *(const GAS v4u*)(SK + ((size_t)((h * 2 + pp) * 128 + n)) * 128 + ch * 8); }
    __syncthreads();
#pragma unroll 1
    for (int tg = ib * NWAVES + F.wave; tg < S / 16; tg += nbh * NWAVES) {
        const int t0 = 16 * tg;
        unsigned R[2][4];
        bf16x8 af[2][4];
#pragma unroll
        for (int p = 0; p < 2; ++p) { const char* qb_ = (const char*)Q2 + ((size_t)t0 * 2048 + h * 256 + p * 128) * 2;
#pragma unroll
            for (int ks = 0; ks < 4; ++ks) af[p][ks] = *(const GAS bf16x8*)(qb_ + 64 * ks + qlo); }
#pragma unroll
        for (int p = 0; p < 2; ++p) {
            f32x4 acc[8];
#pragma unroll
            for (int nt = 0; nt < 8; ++nt) { acc[nt] = (f32x4){0.f, 0.f, 0.f, 0.f}; const int n = 16 * nt + i;
#pragma unroll
                for (int ks = 0; ks < 4; ++ks) { const bf16x8 b = *(const LAS bf16x8*)(F.lds + p * 32768 + n * 256 + ((64 * ks + 16 * q) ^ ((n & 7) << 4)));
                    acc[nt] = __builtin_amdgcn_mfma_f32_16x16x32_bf16(af[p][ks], b, acc[nt], 0, 0, 0); } }
#pragma unroll
            for (int r = 0; r < 4; ++r) { unsigned a[8];
#pragma unroll
                for (int nt = 0; nt < 8; ++nt) a[nt] = (ordk(acc[nt][r]) & ~0x7Fu) | (unsigned)(16 * nt + i);
                CE_(a[0], a[1]); CE_(a[2], a[3]); CE_(a[4], a[5]); CE_(a[6], a[7]); CE_(a[0], a[2]); CE_(a[1], a[3]); CE_(a[4], a[6]); CE_(a[5], a[7]); CE_(a[1], a[2]); CE_(a[5], a[6]);
                CE_(a[0], a[4]); CE_(a[1], a[5]); CE_(a[2], a[6]); CE_(a[3], a[7]); CE_(a[2], a[4]); CE_(a[3], a[5]); CE_(a[1], a[2]); CE_(a[3], a[4]); CE_(a[5], a[6]);
                R[p][r] = row_pop16(a, i); __builtin_amdgcn_sched_barrier(0); }
        }
#pragma unroll
        for (int r = 0; r < 4; ++r) {
            const unsigned R0 = R[0][r], R1 = R[1][r]; const float f0 = deck(R0 & ~0x7Fu), f1 = deck(R1 & ~0x7Fu); const int n0 = (int)(R0 & 0x7Fu), n1 = (int)(R1 & 0x7Fu);
            const unsigned f1u = __float_as_uint(f1); unsigned c[8];
#define CAND_(b, lim) do { const unsigned t_ = (ordk(f0 + __uint_as_float(dppu<0x150 + (b)>(f1u))) & ~0xFFu) | (unsigned)(255 - (i * 16 + (b))); c[b] = (i < (lim)) ? t_ : 0u; } while (0)
            CAND_(0, 16); CAND_(1, 8); CAND_(2, 5); CAND_(3, 4); CAND_(4, 3); CAND_(5, 2); CAND_(6, 2); CAND_(7, 2);
#undef CAND_
            { const float ex = __uint_as_float(dppu<0x150>(__float_as_uint(f0))) + f1; const unsigned exk = (ordk(ex) & ~0xFFu) | (unsigned)(255 - i); c[1] = (i >= 8) ? exk : c[1]; }
            CE_(c[0], c[1]);
            const unsigned G = row_pop16(c, i);
            const float val = deck(G & ~0xFFu); const int id = 255 - (int)(G & 0xFFu); const int rb = F.lane & 48;
            const int ea = __shfl(n0, rb + (id >> 4)), eb = __shfl(n1, rb + (id & 15));
            const float mx = __uint_as_float(dppu<0x150>(__float_as_uint(val))); const float ex = __expf(val - mx); const float sm = rowsum_f32(ex);
            const size_t o = (size_t)(t0 + 4 * q + r) * 128 + h * 16 + i; IDX[o] = ea * 128 + eb; GATE[o] = ex / sm; __builtin_amdgcn_sched_barrier(0);
        }
    }
}
#undef CE_

constexpr float U_SCALE = 256.0f, V_SCALE = 1.0f;
#ifndef PEER_SORT
#define PEER_SORT 0
#endif
__device__ __forceinline__ float gelu_as(float v) {
    const float av = fabsf(v), tt = __builtin_amdgcn_rcpf(av * 0.2316418882f + 1.0f);
    float q = tt * 0.5307027145f + (-0.7265760135f); q = q * tt + 0.7107068705f; q = q * tt + (-0.142248368f); q = q * tt + 0.127414796f; q = q * tt;
    const float m = v * (q * __builtin_amdgcn_exp2f((v * v) * (-0.72134752044f)));
    return v < 0.f ? m : v - m;
}
#ifndef PEER_UMFMA
#define PEER_UMFMA 1
#endif
#ifndef HYP_A
#define HYP_A 1
#endif
#ifndef HYP_B
#define HYP_B 0
#endif
#ifndef PEER_VMFMA
#define PEER_VMFMA 1
#endif
typedef int v8i __attribute__((ext_vector_type(8)));
typedef int v2i __attribute__((ext_vector_type(2)));
typedef float f32x16 __attribute__((ext_vector_type(16)));
__device__ __forceinline__ float wave_sum_dpp(float x) {
    x = rowsum_f32(x);
    return (__uint_as_float(__builtin_amdgcn_readlane(__float_as_uint(x), 0)) + __uint_as_float(__builtin_amdgcn_readlane(__float_as_uint(x), 16)))
         + (__uint_as_float(__builtin_amdgcn_readlane(__float_as_uint(x), 32)) + __uint_as_float(__builtin_amdgcn_readlane(__float_as_uint(x), 48)));
}
#define LOADROWS(T, ra_, rb_, ee) do { const int e2_ = (ee) & 127; const int ea_ = __builtin_amdgcn_readlane(e2_ < 64 ? id0 : id1, e2_ & 63), eb_ = __builtin_amdgcn_readlane(e2_ < 64 ? id0 : id1, (e2_ + 1) & 63); \
        const GAS v4u* pa_ = (const GAS v4u*)((T) + (size_t)ea_ * DM) + F.lane; const GAS v4u* pb_ = (const GAS v4u*)((T) + (size_t)eb_ * DM) + F.lane; \
        _Pragma("unroll") for (int c = 0; c < 4; ++c) { ra_[c] = pa_[64 * c]; rb_[c] = pb_[64 * c]; } } while (0)
#define UDOT(r_, out_) do { f32x2 s0_ = {0.f, 0.f}, s1_ = {0.f, 0.f}, s2_ = {0.f, 0.f}, s3_ = {0.f, 0.f}; \
        _Pragma("unroll") for (int c = 0; c < 4; ++c) _Pragma("unroll") for (int d = 0; d < 2; ++d) { \
            const f32x2 p0_ = __builtin_amdgcn_cvt_scalef32_pk_f32_fp4(r_[c][d], 1.0f, 0), p1_ = __builtin_amdgcn_cvt_scalef32_pk_f32_fp4(r_[c][d], 1.0f, 1), \
                        p2_ = __builtin_amdgcn_cvt_scalef32_pk_f32_fp4(r_[c][d], 1.0f, 2), p3_ = __builtin_amdgcn_cvt_scalef32_pk_f32_fp4(r_[c][d], 1.0f, 3); \
            s0_ = p0_ * hx[8 * c + 4 * d] + s0_; s1_ = p1_ * hx[8 * c + 4 * d + 1] + s1_; s2_ = p2_ * hx[8 * c + 4 * d + 2] + s2_; s3_ = p3_ * hx[8 * c + 4 * d + 3] + s3_; } \
        out_ = ((s0_.x + s0_.y) + (s1_.x + s1_.y)) + ((s2_.x + s2_.y) + (s3_.x + s3_.y)); } while (0)
#define UPAIR(ra_, rb_, ee) do { float sa_, sb_; UDOT(ra_, sa_); UDOT(rb_, sb_); sa_ = wave_sum_dpp(sa_); sb_ = wave_sum_dpp(sb_); \
        const int e2_ = (ee); const int ea_ = __builtin_amdgcn_readlane(e2_ < 64 ? id0 : id1, e2_ & 63), eb_ = __builtin_amdgcn_readlane(e2_ < 64 ? id0 : id1, (e2_ + 1) & 63); \
        const f32x2 a2_ = pg8::gelu_pk((f32x2){sa_ * RSU[ea_], sb_ * RSU[eb_]}); \
        if ((ee) < 64) { if (F.lane == (ee)) w0 = a2_.x * g0; if (F.lane == (ee) + 1) w0 = a2_.y * g0; } else { if (F.lane == (ee) - 64) w1 = a2_.x * g1; if (F.lane == (ee) - 63) w1 = a2_.y * g1; } } while (0)
#define LOADROWS4(T, ra_, rb_, ee) do { const int e2_ = (ee) & 127; const int ea_ = __builtin_amdgcn_readlane(e2_ < 64 ? id0 : id1, e2_ & 63), eb_ = __builtin_amdgcn_readlane(e2_ < 64 ? id0 : id1, (e2_ + 1) & 63); \
        const GAS v2u* pa_ = (const GAS v2u*)((T) + (size_t)ea_ * 2048) + F.lane; const GAS v2u* pb_ = (const GAS v2u*)((T) + (size_t)eb_ * 2048) + F.lane; \
        _Pragma("unroll") for (int c = 0; c < 4; ++c) { ra_[c] = pa_[64 * c]; rb_[c] = pb_[64 * c]; } } while (0)
#define VAXPY(r_, w_) do { const f32x2 w2_ = {w_, w_}; \
        _Pragma("unroll") for (int c = 0; c < 4; ++c) _Pragma("unroll") for (int d = 0; d < 2; ++d) { \
            const f32x2 p0_ = __builtin_amdgcn_cvt_scalef32_pk_f32_fp4(r_[c][d], 1.0f, 0), p1_ = __builtin_amdgcn_cvt_scalef32_pk_f32_fp4(r_[c][d], 1.0f, 1), \
                        p2_ = __builtin_amdgcn_cvt_scalef32_pk_f32_fp4(r_[c][d], 1.0f, 2), p3_ = __builtin_amdgcn_cvt_scalef32_pk_f32_fp4(r_[c][d], 1.0f, 3); \
            acc[8 * c + 4 * d] = p0_ * w2_ + acc[8 * c + 4 * d]; acc[8 * c + 4 * d + 1] = p1_ * w2_ + acc[8 * c + 4 * d + 1]; \
            acc[8 * c + 4 * d + 2] = p2_ * w2_ + acc[8 * c + 4 * d + 2]; acc[8 * c + 4 * d + 3] = p3_ * w2_ + acc[8 * c + 4 * d + 3]; } } while (0)
#define VPAIR(ra_, rb_, ee) do { const int e2_ = (ee); const int ea_ = __builtin_amdgcn_readlane(e2_ < 64 ? id0 : id1, e2_ & 63), eb_ = __builtin_amdgcn_readlane(e2_ < 64 ? id0 : id1, (e2_ + 1) & 63); \
        const float wa_ = __uint_as_float(__builtin_amdgcn_readlane(__float_as_uint((ee) < 64 ? w0 : w1), (ee) & 63)) * RS[ea_], wb_ = __uint_as_float(__builtin_amdgcn_readlane(__float_as_uint((ee) < 64 ? w0 : w1), ((ee) + 1) & 63)) * RS[eb_]; \
        VAXPY(ra_, wa_); VAXPY(rb_, wb_); } while (0)
template <int MODE> __device__ __forceinline__ void p10_peer(Frame& F, const Args& args) {
    const int gw = F.vcu * NWAVES + F.wave, NGW = F.G * NWAVES; const float* MOD = WSP(float, WS_MOD);
    const bf16* H2 = WSP(bf16, WS_HA); const unsigned char* U = WSP(unsigned char, WS_U); const unsigned char* V = WSP(unsigned char, WS_V); const int* IDX = WSP(int, WS_IDX); const float* GATE = WSP(float, WS_GATE); const float* RS = WSP(float, WS_RS); const float* RSU = WSP(float, WS_RSU);
#if PEER_UMFMA
    if (F.lane < 8) *(LAS v4u*)(F.lds + F.wave * 13440 + 4096 + F.lane * 16) = (v4u){0u, 0u, 0u, 0u};
#endif
#pragma unroll 1
    for (int t = gw; t < S; t += NGW) {
        const int id0 = IDX[(size_t)t * 128 + F.lane], id1 = IDX[(size_t)t * 128 + 64 + F.lane];
        const float g0 = GATE[(size_t)t * 128 + F.lane], g1 = GATE[(size_t)t * 128 + 64 + F.lane];
        float w0 = 0.f, w1 = 0.f;
#if PEER_UMFMA
        if (MODE != 2) {
            LAS unsigned char* h8 = F.lds + F.wave * 13440; LAS unsigned char* stg = h8 + 4224;
            const float rstd = 1.0f / sqrtf(wave_sum_dpp(WSP(float, WS_SSQ)[(size_t)t * 64 + F.lane]) * (1.0f / DM) + EPS);
#pragma unroll
            for (int c = 0; c < 4; ++c) { const GAS v4u* hp = (const GAS v4u*)(H2 + (size_t)t * DM + c * 1024 + F.lane * 16); const v4u a = hp[0], b = hp[1]; v4u o;
                const GAS f32x4* sp = (const GAS f32x4*)(MOD + 12288 + c * 1024 + F.lane * 16); const f32x4 s0 = sp[0], s1 = sp[1], s2 = sp[2], s3 = sp[3];
                { int w = 0; w = __builtin_amdgcn_cvt_pk_fp8_f32(bflo(a[0]) * rstd + s0[0], bfhi(a[0]) * rstd + s0[1], w, false); w = __builtin_amdgcn_cvt_pk_fp8_f32(bflo(a[1]) * rstd + s0[2], bfhi(a[1]) * rstd + s0[3], w, true); o[0] = (unsigned)w; }
                { int w = 0; w = __builtin_amdgcn_cvt_pk_fp8_f32(bflo(a[2]) * rstd + s1[0], bfhi(a[2]) * rstd + s1[1], w, false); w = __builtin_amdgcn_cvt_pk_fp8_f32(bflo(a[3]) * rstd + s1[2], bfhi(a[3]) * rstd + s1[3], w, true); o[1] = (unsigned)w; }
                { int w = 0; w = __builtin_amdgcn_cvt_pk_fp8_f32(bflo(b[0]) * rstd + s2[0], bfhi(b[0]) * rstd + s2[1], w, false); w = __builtin_amdgcn_cvt_pk_fp8_f32(bflo(b[1]) * rstd + s2[2], bfhi(b[1]) * rstd + s2[3], w, true); o[2] = (unsigned)w; }
                { int w = 0; w = __builtin_amdgcn_cvt_pk_fp8_f32(bflo(b[2]) * rstd + s3[0], bfhi(b[2]) * rstd + s3[1], w, false); w = __builtin_amdgcn_cvt_pk_fp8_f32(bflo(b[3]) * rstd + s3[2], bfhi(b[3]) * rstd + s3[3], w, true); o[3] = (unsigned)w; }
                *(LAS v4u*)(h8 + c * 1024 + F.lane * 16) = o; }
            const int j = F.lane & 31, kh = F.lane >> 5, lr = F.lane >> 3, lp = F.lane & 7;
            unsigned so[4][4];
#pragma unroll
            for (int b = 0; b < 4; ++b)
#pragma unroll
                for (int i = 0; i < 4; ++i) so[b][i] = (unsigned)__shfl(b < 2 ? id0 : id1, 32 * (b & 1) + lr + 8 * i) * 2048u + (unsigned)lp * 16u;
            int eb[4];
#pragma unroll
            for (int b = 0; b < 4; ++b) eb[b] = __shfl(b < 2 ? id0 : id1, j + 32 * (b & 1));
            const unsigned aoff0 = (j == 0) ? (unsigned)(16 * kh) : 4096u, aoff1 = (j == 0) ? (unsigned)(32 + 16 * kh) : 4112u, astep = (j == 0) ? 64u : 0u;
            const unsigned wof = (unsigned)lr * 144u + (unsigned)lp * 16u, rof = (unsigned)j * 144u + (unsigned)kh * 16u;
            f32x16 ac[4];
#pragma unroll
            for (int b = 0; b < 4; ++b) ac[b] = (f32x16){};
            v4u R0[8], R1[8];
#define ULOAD(R_, kg_, bp_) do { _Pragma("unroll") for (int bb = 0; bb < 2; ++bb) _Pragma("unroll") for (int i = 0; i < 4; ++i) \
                R_[4 * bb + i] = *(const GAS v4u*)(U + (size_t)so[2 * (bp_) + bb][i] + (size_t)(kg_) * 128); } while (0)
#define USTAGE(R_, bp_) do { _Pragma("unroll") for (int bb = 0; bb < 2; ++bb) _Pragma("unroll") for (int i = 0; i < 4; ++i) *(LAS v4u*)(stg + bb * 4608 + i * 1152 + wof) = R_[4 * bb + i]; \
            _Pragma("unroll") for (int bb = 0; bb < 2; ++bb) { v4u B_[4]; _Pragma("unroll") for (int kk = 0; kk < 4; ++kk) B_[kk] = *(const LAS v4u*)(stg + bb * 4608 + rof + kk * 32); \
                _Pragma("unroll") for (int kk = 0; kk < 4; ++kk) ac[2 * (bp_) + bb] = __builtin_amdgcn_mfma_scale_f32_32x32x64_f8f6f4(A[kk], (v8i){(int)B_[kk][0], (int)B_[kk][1], (int)B_[kk][2], (int)B_[kk][3], 0, 0, 0, 0}, ac[2 * (bp_) + bb], 0, 4, 0, 0x7f7f7f7f, 0, 0x7f7f7f7f); } } while (0)
            ULOAD(R0, 0, 0);
#pragma unroll 1
            for (int kg = 0; kg < 16; ++kg) {
                v8i A[4];
#pragma unroll
                for (int kk = 0; kk < 4; ++kk) { const unsigned kb = (unsigned)(4 * kg + kk); const v4u x = *(const LAS v4u*)(h8 + aoff0 + kb * astep), y = *(const LAS v4u*)(h8 + aoff1 + kb * astep);
                    A[kk] = (v8i){(int)x[0], (int)x[1], (int)x[2], (int)x[3], (int)y[0], (int)y[1], (int)y[2], (int)y[3]}; }
                ULOAD(R1, kg, 1);
                USTAGE(R0, 0);
                ULOAD(R0, (kg + 1) & 15, 0);
                USTAGE(R1, 1);
            }
#undef ULOAD
#undef USTAGE
#pragma unroll
            for (int b = 0; b < 4; ++b) {
                const float av = pg8::gelu_pk((f32x2){ac[b][0] * RSU[eb[b]], 0.f}).x;
                const float gg = __shfl(b < 2 ? g0 : g1, j + 32 * (b & 1)); const float wv = av * gg;
                if ((b & 1) == 0) { if (b == 0) w0 = F.lane < 32 ? wv : w0; else w1 = F.lane < 32 ? wv : w1; }
                else { const float mv = __shfl(wv, j); if (b == 1) w0 = F.lane >= 32 ? mv : w0; else w1 = F.lane >= 32 ? mv : w1; } }
        }
#else
        {   f32x2 hx[32];
#pragma unroll
            for (int c = 0; c < 4; ++c) { const GAS v4u* hp = (const GAS v4u*)(H2 + (size_t)t * DM + c * 1024 + F.lane * 16); const v4u a = hp[0], b = hp[1];
#pragma unroll
                for (int k = 0; k < 4; ++k) { hx[8 * c + k] = (f32x2){bflo(a[k]), bfhi(a[k])}; hx[8 * c + 4 + k] = (f32x2){bflo(b[k]), bfhi(b[k])}; } }
            v2u ra[4], rb[4], rc[4], rd[4], na[4], nb[4], nc[4], nd[4];
            if (MODE != 2) {
            LOADROWS4(U, ra, rb, 0); LOADROWS4(U, rc, rd, 2);
#pragma unroll 1
            for (int e = 0; e < 128; e += 8) {
                LOADROWS4(U, na, nb, e + 4); LOADROWS4(U, nc, nd, e + 6);
                UPAIR(ra, rb, e); UPAIR(rc, rd, e + 2);
                LOADROWS4(U, ra, rb, e + 8); LOADROWS4(U, rc, rd, e + 10);
                UPAIR(na, nb, e + 4); UPAIR(nc, nd, e + 6);
            } } }
#endif
        if (MODE == 1 || MODE == 3) { asm volatile("" :: "v"(w0), "v"(w1)); continue; }
#if PEER_VMFMA
        {
            LAS unsigned char* wreg = F.lds + F.wave * 13440; LAS unsigned char* w8 = wreg; LAS unsigned char* stg = wreg + 256;
            const int j = F.lane & 31, kh = F.lane >> 5;
            { const float q0 = w0 * RS[id0] * 16.0f, q1 = w1 * RS[id1] * 16.0f;
              const int b0 = __builtin_amdgcn_cvt_pk_fp8_f32(q0, q0, 0, false), b1 = __builtin_amdgcn_cvt_pk_fp8_f32(q1, q1, 0, false);
              w8[F.lane] = (unsigned char)(b0 & 0xff); w8[64 + F.lane] = (unsigned char)(b1 & 0xff); if (F.lane < 8) *(LAS v2u*)(w8 + 128 + 8 * F.lane) = (v2u){0u, 0u}; }
            v8i A[2];
#pragma unroll
            for (int kb = 0; kb < 2; ++kb) { const unsigned o0 = (j == 0) ? (unsigned)(64 * kb + 16 * kh) : 128u, o1 = (j == 0) ? (unsigned)(64 * kb + 32 + 16 * kh) : 144u;
                const v4u x = *(const LAS v4u*)(w8 + o0), y = *(const LAS v4u*)(w8 + o1);
                A[kb] = (v8i){(int)x[0], (int)x[1], (int)x[2], (int)x[3], (int)y[0], (int)y[1], (int)y[2], (int)y[3]}; }
            const int lr = F.lane >> 2, lp = F.lane & 3;
            unsigned so[8];
#pragma unroll
            for (int i = 0; i < 8; ++i) so[i] = (unsigned)__shfl(i < 4 ? id0 : id1, (16 * i + lr) & 63) * 2048u + (unsigned)lp * 16u;
            const unsigned wof = (unsigned)lr * 80u + (unsigned)lp * 16u;
            const unsigned rof = (unsigned)(32 * kh + (F.lane & 15)) * 80u + (unsigned)(8 * ((F.lane >> 4) & 1));
            const float* X1r = WSP(float, WS_X1) + (size_t)t * DM; const float* G2 = MOD + 20480; float* Or = F.out + (size_t)t * DM;
            v4u R0[8], R1[8];
#define VLOAD(R_, cg_) do { _Pragma("unroll") for (int i = 0; i < 8; ++i) R_[i] = *(const GAS v4u*)(V + (size_t)so[i] + (size_t)(cg_) * 64); } while (0)
#define VSTAGE(R_, cg_) do { _Pragma("unroll") for (int i = 0; i < 8; ++i) *(LAS v4u*)(stg + i * 1280 + wof) = R_[i]; \
            _Pragma("unroll") for (int tt = 0; tt < 4; ++tt) { f32x16 d_ = (f32x16){}; \
                _Pragma("unroll") for (int kb = 0; kb < 2; ++kb) { \
                    const v2i q0_ = __builtin_amdgcn_ds_read_tr4_b64_v2i32((LAS v2i*)(stg + kb * 5120 + rof + tt * 16)), q1_ = __builtin_amdgcn_ds_read_tr4_b64_v2i32((LAS v2i*)(stg + kb * 5120 + 1280 + rof + tt * 16)); \
                    d_ = __builtin_amdgcn_mfma_scale_f32_32x32x64_f8f6f4(A[kb], (v8i){q0_[0], q0_[1], q1_[0], q1_[1], 0, 0, 0, 0}, d_, 0, 4, 0, 0x7b7b7b7b, 0, 0x7f7f7f7f); } \
                if (MODE == 2) { asm volatile("" :: "v"(d_[0])); } else if (F.lane < 32) { const int col = (cg_) * 128 + tt * 32 + F.lane; Or[col] = X1r[col] + G2[col] * d_[0]; } } } while (0)
            VLOAD(R0, 0);
#pragma unroll 1
            for (int cg = 0; cg < 32; cg += 2) {
                VLOAD(R1, cg + 1);
                VSTAGE(R0, cg);
                VLOAD(R0, (cg + 2) & 31);
                VSTAGE(R1, cg + 1);
            }
#undef VLOAD
#undef VSTAGE
        }
#else
        f32x2 acc[32];
#pragma unroll
        for (int j = 0; j < 32; ++j) acc[j] = (f32x2){0.f, 0.f};
        {   v2u ra[4], rb[4], rc[4], rd[4], na[4], nb[4], nc[4], nd[4];
            LOADROWS4(V, ra, rb, 0); LOADROWS4(V, rc, rd, 2);
#pragma unroll 1
            for (int e = 0; e < 128; e += 8) {
                LOADROWS4(V, na, nb, e + 4); LOADROWS4(V, nc, nd, e + 6);
                VPAIR(ra, rb, e); VPAIR(rc, rd, e + 2);
                LOADROWS4(V, ra, rb, e + 8); LOADROWS4(V, rc, rd, e + 10);
                VPAIR(na, nb, e + 4); VPAIR(nc, nd, e + 6);
            } }
        if (MODE == 2) {
#pragma unroll
            for (int j = 0; j < 32; ++j) asm volatile("" :: "v"(acc[j]));
            continue; }
#pragma unroll
        for (int c = 0; c < 4; ++c) { const int col = c * 1024 + F.lane * 16; GAS f32x4* op = (GAS f32x4*)(F.out + (size_t)t * DM + col);
            const GAS f32x4* xp = (const GAS f32x4*)(WSP(float, WS_X1) + (size_t)t * DM + col); const GAS f32x4* gp = (const GAS f32x4*)(MOD + 20480 + col);
#pragma unroll
            for (int q = 0; q < 4; ++q) op[q] = xp[q] + gp[q] * (f32x4){acc[8 * c + 2 * q].x, acc[8 * c + 2 * q].y, acc[8 * c + 2 * q + 1].x, acc[8 * c + 2 * q + 1].y}; }
#endif
    }
}
#undef LOADROWS
#undef UDOT
#undef UPAIR
#undef VAXPY
#undef VPAIR
#undef LOADROWS4
#ifndef MK_SINGLE
#define MK_SINGLE 1
#endif
constexpr int N_PHASES = 11;
__global__ void __launch_bounds__(NTHREADS, 2) fwd_kernel(Args args) {
    extern __shared__ __attribute__((aligned(16))) unsigned char lds[];
    Frame F;
    F.lds = (LAS unsigned char*)lds; F.MISC = (volatile LAS unsigned*)(F.lds + MISC_OFF);
    F.tid = threadIdx.x; F.lane = F.tid & 63; F.wave = __builtin_amdgcn_readfirstlane(F.tid >> 6);
    F.G = gridDim.x; { const int bx = blockIdx.x; F.vcu = (F.G % 8 == 0) ? (bx % 8) * (F.G / 8) + bx / 8 : bx; }
    F.ws = args.ws; F.out = args.out; F.ctl = (gu32*)(args.ws + WS_CTL);
    for (int u = F.tid; u < (LDS_BYTES - LDSCTL_OFF) / 4; u += NTHREADS) ((LAS unsigned*)(F.lds + LDSCTL_OFF))[u] = 0u;
    __syncthreads();
    const int lo = args.ph_lo, hi = args.ph_hi;
    XcdBarrier bar; bar.bar = (unsigned*)(F.ctl + CW_BAR); bar.x = 0; bar.st = nullptr;
    if (hi - lo > 1) bar = xcd_barrier_post((unsigned*)(F.ctl + CW_BAR), F.MISC + 8);
#ifndef PH_MASK
#define PH_MASK 0x7ff
#endif
#define IN(k) (((PH_MASK >> (k)) & 1) && lo <= (k) && (k) < hi)
#define SEAM(k) do { if (IN(k) && IN((k) + 1)) xcd_barrier(bar); } while (0)
#ifndef G_ALIGN
#define G_ALIGN true
#endif
#ifndef G_SP2
#define G_SP2 true
#endif
#ifndef REP_PHASE
#define REP_PHASE -1
#endif
#define REPEAT(k) _Pragma("unroll") for (int rep = 0; rep < ((REP_PHASE) == (k) ? 2 : 1); ++rep)
#define REPBAR(k) do { if ((REP_PHASE) == (k) && rep == 0) xcd_barrier(bar); } while (0)
    const int bid = (int)blockIdx.x;
    if (IN(0)) { REPEAT(0) { p0_prologue(F, args); REPBAR(0); } SEAM(0); }
    if (IN(1)) { REPEAT(1) { p1_norm_forget(F, args); p1_shift_proj(F, args); REPBAR(1); } SEAM(1); }
    if (IN(2)) { REPEAT(2) {
        pg8::Gemm g{WSP(bf16, WS_HA), WSP(bf16, WS_WIN), S, NINP, DM}; pg8::StaticOrder So; So.init(S, NINP, F.G, bid);
        pg8::EpiIn E{WSP(bf16, WS_QKV), WSP(bf16, WS_LX), WSP(bf16, WS_GY), WSP(bf16, WS_GA), WSP(bf16, WS_GL), WSP(float, WS_BIASR)};
        pg8::gemm_phase<pg8::EpiIn, pg8::StaticOrder, G_ALIGN, G_SP2>(F.lds, g, So, E);
        REPBAR(2); }
        SEAM(2);
    }
    if (IN(3)) {
        p3_qknorm(F, args);
        __syncthreads();
        REPEAT(3) {
        p3_cumsum(F, args);
        for (int w = bid; w < 256; w += F.G) lru_item<0>(F, args, w);
        REPBAR(3); }
        SEAM(3);
    }
    if (IN(4)) {
#pragma unroll 1
        for (int rep = 0; rep < args.rep_att; ++rep) p4_attention(F, args, (char*)lds, rep);
#pragma unroll 1
        for (int rep = 0; rep < args.rep_lru; ++rep)
        for (int w = bid; w < 256; w += F.G) lru_item<1>(F, args, w);
        SEAM(4);
    }
    if (IN(5)) { REPEAT(5) {
        { pg8::Gemm g{WSP(bf16, WS_ATT), WSP(bf16, WS_WAO), S, DM, AW}; pg8::StaticOrder So; So.init(S, DM, F.G, bid);
          pg8::EpiGate<0> E{WSP(bf16, WS_T1), WSP(bf16, WS_GA), DM};
          pg8::gemm_phase<pg8::EpiGate<0>, pg8::StaticOrder, true, true>(F.lds, g, So, E); }
        { pg8::Gemm g{WSP(bf16, WS_LR), WSP(bf16, WS_WLO), S, DM, LW}; pg8::StaticOrder So; So.init(S, DM, F.G, bid);
          pg8::EpiGate<1> E{WSP(bf16, WS_T1), WSP(bf16, WS_GL), DM};
          pg8::gemm_phase<pg8::EpiGate<1>, pg8::StaticOrder, true, true>(F.lds, g, So, E); }
        REPBAR(5); }
        SEAM(5);
    }
    if (IN(6)) { REPEAT(6) {
        pg8::Gemm g{WSP(bf16, WS_T1), WSP(bf16, WS_WOUT), S, DM, DM}; pg8::StaticOrder So; So.init(S, DM, F.G, bid);
        pg8::EpiRes E{args.in[0], WSP(float, WS_X1), WSP(float, WS_MOD) + 8192, DM, args.in[5], WSP(float, WS_MOD) + 16384, WSP(bf16, WS_HA), WSP(float, WS_SSQ)};
        pg8::gemm_phase<pg8::EpiRes, pg8::StaticOrder, true, true>(F.lds, g, So, E);
        REPBAR(6); }
        SEAM(6);
    }
    if (IN(8)) { REPEAT(8) {
        pg8::Gemm g{WSP(bf16, WS_HA), WSP(bf16, WS_WPQ), S, 2048, DM}; pg8::RstdOrder So; So.init(S, 2048, F.G, bid);
        So.SSQ = WSP(float, WS_SSQ); So.rs = (LAS float*)(F.lds + 133120); So.inv_n = 1.0f / DM; So.eps = EPS; So.na = 0;
        pg8::EpiQ2 E{WSP(bf16, WS_Q2), 2048, WSP(float, WS_SB), (const LAS float*)(F.lds + 133120), 0};
        pg8::gemm_phase<pg8::EpiQ2, pg8::RstdOrder, true, true>(F.lds, g, So, E);
        REPBAR(8); }
        SEAM(8);
    }
    if (IN(9)) { REPEAT(9) { p9_topk(F, args); REPBAR(9); } SEAM(9); }
#ifndef P10_PROBE
#define P10_PROBE 0
#endif
    if (IN(10)) { if (P10_PROBE) { p10_peer<P10_PROBE>(F, args); xcd_barrier(bar); } REPEAT(10) { p10_peer<0>(F, args); REPBAR(10); } }
#undef IN
#undef SEAM
}

extern "C" void kernel_launch(void* const* d_in, const int* in_sizes, int n_in, void* d_out, int out_size, void* d_ws, size_t ws_size, hipStream_t stream) {
    static int grid = 0;
    if (grid == 0) {
        if (n_in != 24 || in_sizes[0] != S * DM || out_size != S * DM || ws_size < WS_END) { fprintf(stderr, "kernel_launch: unexpected shapes (n_in %d, in0 %d, out %d, ws %zu)\n", n_in, n_in > 0 ? in_sizes[0] : -1, out_size, ws_size); grid = -1; return; }
        int dev = 0, cus = 0, per_cu = 0;
        if (hipGetDevice(&dev) != hipSuccess || hipDeviceGetAttribute(&cus, hipDeviceAttributeMultiprocessorCount, dev) != hipSuccess) { grid = -1; return; }
        if (hipFuncSetAttribute((const void*)fwd_kernel, hipFuncAttributeMaxDynamicSharedMemorySize, LDS_BYTES) != hipSuccess) { fprintf(stderr, "kernel_launch: hipFuncSetAttribute failed\n"); grid = -1; return; }
        if (hipOccupancyMaxActiveBlocksPerMultiprocessor(&per_cu, (const void*)fwd_kernel, NTHREADS, LDS_BYTES) != hipSuccess || per_cu < 1) fprintf(stderr, "kernel_launch: occupancy query reports %d blocks per CU\n", per_cu);
        (void)hipGetLastError();
        grid = cus;
    }
    if (grid < 0) return;
    if (hipMemsetAsync((char*)d_ws + WS_CTL, 0, CTL_ZERO_BYTES, stream) != hipSuccess) return;
    Args a{};
    for (int i = 0; i < 24; ++i) a.in[i] = (const float*)d_in[i];
    a.out = (float*)d_out; a.ws = (unsigned char*)d_ws;
#ifndef REP_ATT
#define REP_ATT 1
#endif
#ifndef REP_LRU
#define REP_LRU 1
#endif
    a.rep_att = REP_ATT; a.rep_lru = REP_LRU;
#if MK_SINGLE
    a.ph_lo = 0; a.ph_hi = N_PHASES;
    hipLaunchKernelGGL(fwd_kernel, dim3(grid), dim3(NTHREADS), LDS_BYTES, stream, a);
#else
    for (int p = 0; p < N_PHASES; ++p) { a.ph_lo = p; a.ph_hi = p + 1; hipLaunchKernelGGL(fwd_kernel, dim3(grid), dim3(NTHREADS), LDS_BYTES, stream, a); }
#endif
}
```

```cpp
#define REP_PHASE -1
#include <hip/hip_runtime.h>
#include <cstdio>
#include <cstdint>
namespace pg8 {
#define PG8_LAS __attribute__((address_space(3)))
typedef unsigned short bf16_t;
typedef short bf16x8 __attribute__((ext_vector_type(8)));
typedef float f32x4 __attribute__((ext_vector_type(4)));
typedef unsigned u32x4 __attribute__((ext_vector_type(4)));
constexpr int BM = 256, BK = 64, HALF = 128, HTB = HALF * BK * 2  , STAGE_BYTES = 8 * HTB, NXCD = 8, WGM = 8;

__host__ __device__ __forceinline__ int lds_byte(int r, int c) { const int st = (r >> 4) * 2 + (c >> 5), rr = r & 15, cc = c & 31, ob = rr * 64 + cc * 2; return st * 1024 + (ob ^ (((ob >> 9) & 1) << 5)); }
__host__ __device__ __forceinline__ void stage_rc(int b, int& R, int& C) { const int st = b / 1024, sb = b % 1024, swz = sb ^ (((sb >> 9) & 1) << 5); R = (st >> 1) * 16 + swz / 64; C = (st & 1) * 32 + (swz % 64) / 2; }
__host__ __device__ __forceinline__ int perm32(int rho) { const int n = rho >> 4, i = rho & 15; return 8 * (i >> 2) + 4 * n + (i & 3); }

struct Unit { int pm, pn; };
struct Gemm { const bf16_t* A; const bf16_t* Bt; int M, N, K; };

struct StaticOrder {
    int nM, nN, nwg, G, c;
    __host__ __device__ void init(int M, int N, int G_, int c_) { nM = M / BM; nN = N / BM; nwg = nM * nN; G = G_; c = c_; }
    __host__ __device__ bool next(int i, Unit& u) const {
        const long L = (long)i * G + c; if (L >= nwg) return false;
        int wgid = (int)L; { const int q = nwg / NXCD, r = nwg % NXCD, xcd = wgid % NXCD, off = wgid / NXCD; wgid = (xcd < r ? xcd * (q + 1) : r * (q + 1) + (xcd - r) * q) + off; }
        const int nig = WGM * nN, gid = wgid / nig, fm = gid * WGM, gsz = (nM - fm) < WGM ? (nM - fm) : WGM;
        u.pm = fm + ((wgid % nig) % gsz); u.pn = (wgid % nig) / gsz; return true;
    }
    __device__ __forceinline__ void a_ready(const Unit&) const {}
    __device__ __forceinline__ void done(const Unit&) const {}
};

__device__ __forceinline__ unsigned cvt_pk_bf16(float lo, float hi) { unsigned r; asm volatile("v_cvt_pk_bf16_f32 %0, %1, %2" : "=v"(r) : "v"(lo), "v"(hi)); return r; }
typedef float f32x2 __attribute__((ext_vector_type(2)));
__device__ __forceinline__ f32x2 gelu_pk(f32x2 v) {
    const f32x2 av = __builtin_elementwise_abs(v), d = av * 0.2316418882f + 1.0f;
    f32x2 t; t.x = __builtin_amdgcn_rcpf(d.x); t.y = __builtin_amdgcn_rcpf(d.y);
    f32x2 q = t * 0.5307027145f + (-0.7265760135f); q = q * t + 0.7107068705f; q = q * t + (-0.142248368f); q = q * t + 0.127414796f; q = q * t;
    const f32x2 s = (v * v) * (-0.72134752044f);
    f32x2 e; e.x = __builtin_amdgcn_exp2f(s.x); e.y = __builtin_amdgcn_exp2f(s.y);
    const f32x2 m = v * (q * e), r = v - m;
    f32x2 o; o.x = v.x < 0.f ? m.x : r.x; o.y = v.y < 0.f ? m.y : r.y; return o;
}

template <int ACT  > struct EpiBf16 {
    static constexpr bool PERM = true, AFTER_DRAIN = false; static_assert(ACT == 0 || ACT == 1, "EpiBf16: ACT is 0 (none) or 1 (gelu_pk)");
    bf16_t* O; int ldc; const float* bias; int split_cols; size_t split_stride; float scale0;
    __device__ __forceinline__ void operator()(const f32x4 (&acc)[2][2][4][2], const Unit& u, int wr, int wc, int fr, int fq) const {
        const int row0 = u.pm * BM + wr * 64 + fr; int colt = u.pn * BM; bf16_t* base = O;
        float sc = 1.f; if (split_cols) { const int t = colt / split_cols; base += (size_t)t * split_stride; colt -= t * split_cols; if (t == 0) sc = scale0; }
        const int col0 = colt + wc * 32 + 8 * fq, bcol0 = u.pn * BM + wc * 32 + 8 * fq;
        f32x4 bv[2][2];
#pragma unroll
        for (int bj = 0; bj < 2; ++bj)
#pragma unroll
            for (int n = 0; n < 2; ++n) bv[bj][n] = bias ? *(const f32x4*)(bias + bcol0 + bj * HALF + 4 * n) : (f32x4){0.f, 0.f, 0.f, 0.f};
#pragma unroll
        for (int ai = 0; ai < 2; ++ai)
#pragma unroll
            for (int m = 0; m < 4; ++m) { bf16_t* rowp = base + (size_t)(row0 + ai * HALF + m * 16) * ldc + col0;
#pragma unroll
                for (int bj = 0; bj < 2; ++bj) { f32x4 v0 = acc[ai][bj][m][0] + bv[bj][0], v1 = acc[ai][bj][m][1] + bv[bj][1];
                    if (ACT == 1) { f32x2 a = gelu_pk((f32x2){v0[0], v0[1]}), b = gelu_pk((f32x2){v0[2], v0[3]}), c = gelu_pk((f32x2){v1[0], v1[1]}), d = gelu_pk((f32x2){v1[2], v1[3]});
                        v0 = (f32x4){a.x, a.y, b.x, b.y}; v1 = (f32x4){c.x, c.y, d.x, d.y}; }
                    v0 = v0 * sc; v1 = v1 * sc; u32x4 w; w.x = cvt_pk_bf16(v0[0], v0[1]); w.y = cvt_pk_bf16(v0[2], v0[3]); w.z = cvt_pk_bf16(v1[0], v1[1]); w.w = cvt_pk_bf16(v1[2], v1[3]);
                    *(u32x4*)(rowp + bj * HALF) = w; } }
    }
};
__device__ __forceinline__ f32x4 sigm4(f32x4 v) { f32x4 o;
#pragma unroll
    for (int j = 0; j < 4; ++j) o[j] = __builtin_amdgcn_rcpf(1.0f + __builtin_amdgcn_exp2f(-1.4426950408889634f * v[j]));
    return o; }
__device__ __forceinline__ f32x4 gelu4(f32x4 v) { const f32x2 a = gelu_pk((f32x2){v[0], v[1]}), b = gelu_pk((f32x2){v[2], v[3]}); return (f32x4){a.x, a.y, b.x, b.y}; }
__device__ __forceinline__ void unpack8(const u32x4 w, f32x4& lo, f32x4& hi) {
    lo = (f32x4){__uint_as_float(w.x << 16), __uint_as_float(w.x & 0xffff0000u), __uint_as_float(w.y << 16), __uint_as_float(w.y & 0xffff0000u)};
    hi = (f32x4){__uint_as_float(w.z << 16), __uint_as_float(w.z & 0xffff0000u), __uint_as_float(w.w << 16), __uint_as_float(w.w & 0xffff0000u)}; }
struct EpiIn {
    static constexpr bool PERM = true, AFTER_DRAIN = false;
    bf16_t* qkv; bf16_t* lx; bf16_t* gy; bf16_t* ga; bf16_t* gl; const float* bias;
    __device__ __forceinline__ void operator()(const f32x4 (&acc)[2][2][4][2], const Unit& u, int wr, int wc, int fr, int fq) const {
        const int pn = u.pn; bf16_t* base; int ldc, colt, act;
        if (pn < 24) { base = qkv + (size_t)(pn >> 3) * ((size_t)8192 * 2048); ldc = 2048; colt = (pn & 7) * 256; act = 0; }
        else if (pn < 32) { base = lx; ldc = 2048; colt = (pn - 24) * 256; act = 0; }
        else if (pn < 40) { base = gy; ldc = 2048; colt = (pn - 32) * 256; act = 1; }
        else if (pn < 56) { base = ga; ldc = 4096; colt = (pn - 40) * 256; act = 2; }
        else { base = gl; ldc = 4096; colt = (pn - 56) * 256; act = 2; }
        const int row0 = u.pm * BM + wr * 64 + fr, col0 = colt + wc * 32 + 8 * fq, bcol0 = pn * BM + wc * 32 + 8 * fq;
        f32x4 bv[2][2];
#pragma unroll
        for (int bj = 0; bj < 2; ++bj)
#pragma unroll
            for (int n = 0; n < 2; ++n) bv[bj][n] = *(const f32x4*)(bias + bcol0 + bj * HALF + 4 * n);
#pragma unroll
        for (int ai = 0; ai < 2; ++ai)
#pragma unroll
            for (int m = 0; m < 4; ++m) { bf16_t* rowp = base + (size_t)(row0 + ai * HALF + m * 16) * ldc + col0;
#pragma unroll
                for (int bj = 0; bj < 2; ++bj) { f32x4 v0 = acc[ai][bj][m][0] + bv[bj][0], v1 = acc[ai][bj][m][1] + bv[bj][1];
                    if (act == 1) { v0 = gelu4(v0); v1 = gelu4(v1); }
                    else if (act == 2) { v0 = sigm4(v0); v1 = sigm4(v1); }
                    u32x4 w; w.x = cvt_pk_bf16(v0[0], v0[1]); w.y = cvt_pk_bf16(v0[2], v0[3]); w.z = cvt_pk_bf16(v1[0], v1[1]); w.w = cvt_pk_bf16(v1[2], v1[3]);
                    *(u32x4*)(rowp + bj * HALF) = w; } }
    }
};
template <int MODE> struct EpiGate {
    static constexpr bool PERM = true, AFTER_DRAIN = false;
    bf16_t* O; const bf16_t* Gt; int ldc;
    __device__ __forceinline__ void operator()(const f32x4 (&acc)[2][2][4][2], const Unit& u, int wr, int wc, int fr, int fq) const {
        const int row0 = u.pm * BM + wr * 64 + fr, col0 = u.pn * BM + wc * 32 + 8 * fq;
#pragma unroll
        for (int ai = 0; ai < 2; ++ai)
#pragma unroll
            for (int m = 0; m < 4; ++m) { const size_t off = (size_t)(row0 + ai * HALF + m * 16) * ldc + col0;
#pragma unroll
                for (int bj = 0; bj < 2; ++bj) { f32x4 g0, g1; unpack8(*(const u32x4*)(Gt + off + bj * HALF), g0, g1);
                    f32x4 v0 = acc[ai][bj][m][0] * g0, v1 = acc[ai][bj][m][1] * g1;
                    if (MODE == 1) { f32x4 t0, t1; unpack8(*(const u32x4*)(O + off + bj * HALF), t0, t1); v0 += t0; v1 += t1; }
                    u32x4 w; w.x = cvt_pk_bf16(v0[0], v0[1]); w.y = cvt_pk_bf16(v0[2], v0[3]); w.z = cvt_pk_bf16(v1[0], v1[1]); w.w = cvt_pk_bf16(v1[2], v1[3]);
                    *(u32x4*)(O + off + bj * HALF) = w; } }
    }
};
struct EpiRes {
    static constexpr bool PERM = false, AFTER_DRAIN = false;
    const float* X; float* Out; const float* gate; int ldc; const float* g2a; const float* g2b; bf16_t* XG; float* SSQ;
    __device__ __forceinline__ void operator()(const f32x4 (&acc)[2][2][4][2], const Unit& u, int wr, int wc, int fr, int fq) const {
        const int row0 = u.pm * BM + wr * 64 + fr, col0 = u.pn * BM + wc * 32 + 4 * fq;
        f32x4 gv[2][2], gp[2][2];
#pragma unroll
        for (int bj = 0; bj < 2; ++bj)
#pragma unroll
            for (int n = 0; n < 2; ++n) { gv[bj][n] = *(const f32x4*)(gate + col0 + bj * HALF + n * 16);
                gp[bj][n] = *(const f32x4*)(g2a + col0 + bj * HALF + n * 16) * (*(const f32x4*)(g2b + col0 + bj * HALF + n * 16) + 1.0f); }
#pragma unroll
        for (int ai = 0; ai < 2; ++ai)
#pragma unroll
            for (int m = 0; m < 4; ++m) { const int row = row0 + ai * HALF + m * 16; const size_t off = (size_t)row * ldc + col0; float ss = 0.f;
#pragma unroll
                for (int bj = 0; bj < 2; ++bj)
#pragma unroll
                    for (int n = 0; n < 2; ++n) { const f32x4 xv = *(const f32x4*)(X + off + bj * HALF + n * 16);
                        const f32x4 x1 = xv + gv[bj][n] * acc[ai][bj][m][n]; *(f32x4*)(Out + off + bj * HALF + n * 16) = x1;
                        ss += (x1[0] * x1[0] + x1[1] * x1[1]) + (x1[2] * x1[2] + x1[3] * x1[3]);
                        const f32x4 xg = x1 * gp[bj][n]; typedef unsigned u32x2_ __attribute__((ext_vector_type(2)));
                        u32x2_ w; w.x = cvt_pk_bf16(xg[0], xg[1]); w.y = cvt_pk_bf16(xg[2], xg[3]); *(u32x2_*)(XG + off + bj * HALF + n * 16) = w; }
                ss += __shfl_xor(ss, 16); ss += __shfl_xor(ss, 32);
                if (fq == 0) SSQ[(size_t)row * 64 + u.pn * 4 + wc] = ss; }
    }
};
struct EpiQ2 {
    static constexpr bool PERM = true, AFTER_DRAIN = false;
    bf16_t* O; int ldc; const float* sb; const PG8_LAS float* rs; mutable int ne;
    __device__ __forceinline__ void operator()(const f32x4 (&acc)[2][2][4][2], const Unit& u, int wr, int wc, int fr, int fq) const {
        const int rl0 = wr * 64 + fr, row0 = u.pm * BM + rl0, col0 = u.pn * BM + wc * 32 + 8 * fq; const PG8_LAS float* rsp = rs + ((ne++) & 1) * 256;
        f32x4 bv[2][2];
#pragma unroll
        for (int bj = 0; bj < 2; ++bj)
#pragma unroll
            for (int n = 0; n < 2; ++n) bv[bj][n] = *(const f32x4*)(sb + col0 + bj * HALF + 4 * n);
#pragma unroll
        for (int ai = 0; ai < 2; ++ai)
#pragma unroll
            for (int m = 0; m < 4; ++m) { const float r = rsp[rl0 + ai * HALF + m * 16]; bf16_t* rowp = O + (size_t)(row0 + ai * HALF + m * 16) * ldc + col0;
#pragma unroll
                for (int bj = 0; bj < 2; ++bj) { const f32x4 v0 = acc[ai][bj][m][0] * r + bv[bj][0], v1 = acc[ai][bj][m][1] * r + bv[bj][1];
                    u32x4 w; w.x = cvt_pk_bf16(v0[0], v0[1]); w.y = cvt_pk_bf16(v0[2], v0[3]); w.z = cvt_pk_bf16(v1[0], v1[1]); w.w = cvt_pk_bf16(v1[2], v1[3]);
                    *(u32x4*)(rowp + bj * HALF) = w; } }
    }
};
struct RstdOrder : StaticOrder {
    const float* SSQ; PG8_LAS float* rs; float inv_n, eps; mutable int na;
    __device__ __forceinline__ void a_ready(const Unit& u) const {
        const int tid = threadIdx.x, r = tid >> 1, hf = tid & 1; const f32x4* p = (const f32x4*)(SSQ + (size_t)(u.pm * BM + r) * 64 + hf * 32); float s = 0.f;
#pragma unroll
        for (int k = 0; k < 8; ++k) { const f32x4 v = p[k]; s += (v[0] + v[1]) + (v[2] + v[3]); }
        s += __shfl_xor(s, 1);
        if (hf == 0) rs[(na & 1) * 256 + r] = 1.0f / sqrtf(s * inv_n + eps);
        ++na;
    }
};
template <class Epi, class Sched, bool ALIGN_EPI = false, bool SP2 = false>
__device__ __forceinline__ void gemm_phase(PG8_LAS unsigned char* lds, const Gemm g, const Sched& S, const Epi& E) {
    const int tid = threadIdx.x, wid = __builtin_amdgcn_readfirstlane(tid >> 6), lane = tid & 63, wr = wid >> 2, wc = wid & 3, fr = lane & 15, fq = lane >> 4;
    const int K = g.K, nt = K / BK;
    unsigned voffA[2], voffB[2];
#pragma unroll
    for (int i = 0; i < 2; ++i) { int R, C; stage_rc(tid * 16 + i * 8192, R, C); const int Rb = Epi::PERM ? ((R & ~31) + perm32(R & 31)) : R;
        voffA[i] = (unsigned)(R * K + C) * 2u; voffB[i] = (unsigned)(Rb * K + C) * 2u; }
    const size_t kstep = (size_t)(BK * 2);
    const size_t hstep = (size_t)HALF * K * 2;
    const size_t tstep = 2 * hstep;
    const unsigned ldsw = (unsigned)wid * 1024u;
    const int aoff = lds_byte(wr * 64 + fr, fq * 8), boff = lds_byte(wc * 32 + fr, fq * 8);
#define PG8_SA(b, h) (((b) * 2 + (h)) * HTB)
#define PG8_SB(b, h) ((4 + (b) * 2 + (h)) * HTB)
#define PG8_STAGE(bufoff, gbase, voff) do { _Pragma("unroll") for (int _i = 0; _i < 2; ++_i) \
        __builtin_amdgcn_global_load_lds((const unsigned*)((const char*)(gbase) + (voff)[_i]), (PG8_LAS unsigned*)(lds + (bufoff) + ldsw + _i * 8192), 16, 0, 0); } while (0)
#define PG8_LDA(dst, b, h) do { _Pragma("unroll") for (int m = 0; m < 4; ++m) _Pragma("unroll") for (int k = 0; k < 2; ++k) dst[m][k] = *(const PG8_LAS bf16x8*)(lds + PG8_SA(b, h) + aoff + m * 2048 + k * 1024); } while (0)
#define PG8_LDB(dst, b, h) do { _Pragma("unroll") for (int n = 0; n < 2; ++n) _Pragma("unroll") for (int k = 0; k < 2; ++k) dst[n][k] = *(const PG8_LAS bf16x8*)(lds + PG8_SB(b, h) + boff + n * 2048 + k * 1024); } while (0)
#define PG8_MMA(ai, bj, At, Bt) do { __builtin_amdgcn_s_setprio(1); _Pragma("unroll") for (int m = 0; m < 4; ++m) _Pragma("unroll") for (int n = 0; n < 2; ++n) _Pragma("unroll") for (int k = 0; k < 2; ++k) \
        acc[ai][bj][m][n] = __builtin_amdgcn_mfma_f32_16x16x32_bf16(Bt[n][k], At[m][k], acc[ai][bj][m][n], 0, 0, 0); __builtin_amdgcn_s_setprio(0); } while (0)
#define PG8_WAIT_V(n) asm volatile("s_waitcnt vmcnt(" #n ")" ::: "memory")
#define PG8_WAIT_L(n) asm volatile("s_waitcnt lgkmcnt(" #n ")" ::: "memory")
#define PG8_BAR __builtin_amdgcn_s_barrier()
#define PG8_SCHED __builtin_amdgcn_sched_barrier(0)
    Unit cur, nxt; int ui = 0;
    if (!S.next(0, cur)) return;
    f32x4 acc[2][2][4][2];
#pragma unroll
    for (int a = 0; a < 2; ++a)
#pragma unroll
        for (int b = 0; b < 2; ++b)
#pragma unroll
            for (int m = 0; m < 4; ++m)
#pragma unroll
                for (int n = 0; n < 2; ++n) acc[a][b][m][n] = (f32x4){0.f, 0.f, 0.f, 0.f};
    bf16x8 At[4][2], B0[2][2], B1[2][2];
    const char* cA = (const char*)g.A + (size_t)cur.pm * tstep; const char* cB = (const char*)g.Bt + (size_t)cur.pn * tstep;
    S.a_ready(cur);
    if constexpr (SP2) {
        PG8_STAGE(PG8_SB(0, 0), cB, voffB); PG8_STAGE(PG8_SB(0, 1), cB + hstep, voffB); PG8_STAGE(PG8_SA(0, 0), cA, voffA); PG8_STAGE(PG8_SA(0, 1), cA + hstep, voffA);
        if (wr == 1) PG8_BAR;
        PG8_WAIT_V(2); PG8_BAR;
        PG8_STAGE(PG8_SB(1, 0), cB + kstep, voffB); PG8_STAGE(PG8_SA(1, 0), cA + kstep, voffA); PG8_STAGE(PG8_SB(1, 1), cB + hstep + kstep, voffB);
        PG8_WAIT_V(6); PG8_BAR;
    } else {
        PG8_STAGE(PG8_SB(0, 0), cB, voffB); PG8_STAGE(PG8_SA(0, 0), cA, voffA); PG8_STAGE(PG8_SB(0, 1), cB + hstep, voffB); PG8_STAGE(PG8_SA(0, 1), cA + hstep, voffA);
        if (wr == 1) PG8_BAR;
        PG8_WAIT_V(4); PG8_BAR;
        PG8_STAGE(PG8_SB(1, 0), cB + kstep, voffB); PG8_STAGE(PG8_SA(1, 0), cA + kstep, voffA); PG8_STAGE(PG8_SB(1, 1), cB + hstep + kstep, voffB);
        PG8_WAIT_V(6); PG8_BAR;
    }
    for (;;) {
        const bool has_next = S.next(ui + 1, nxt);
        const char* nA = has_next ? (const char*)g.A + (size_t)nxt.pm * tstep : cA; const char* nB = has_next ? (const char*)g.Bt + (size_t)nxt.pn * tstep : cB;
        for (int t = 0; t < nt; t += 2) {
            const bool last = (t == nt - 2);
            const char* a1 = cA + (size_t)(t + 1) * kstep;
            const char* a2 = last ? nA : cA + (size_t)(t + 2) * kstep; const char* b2 = last ? nB : cB + (size_t)(t + 2) * kstep;
            const char* a3 = a2 + kstep; const char* b3 = b2 + kstep;
            if (last && has_next) S.a_ready(nxt);
            if constexpr (SP2) {
            PG8_LDB(B0, 0, 0); PG8_LDB(B1, 0, 1); PG8_SCHED; PG8_LDA(At, 0, 0); PG8_STAGE(PG8_SA(1, 1), a1 + hstep, voffA);
            PG8_WAIT_V(8); PG8_WAIT_L(0); PG8_BAR; PG8_MMA(0, 0, At, B0); PG8_MMA(0, 1, At, B1); PG8_BAR; PG8_SCHED;
            PG8_LDA(At, 0, 1); PG8_STAGE(PG8_SB(0, 0), b2, voffB); PG8_STAGE(PG8_SB(0, 1), b2 + hstep, voffB); PG8_STAGE(PG8_SA(0, 0), a2, voffA);
            PG8_WAIT_V(8); PG8_WAIT_L(0); PG8_BAR; PG8_MMA(1, 0, At, B0); PG8_MMA(1, 1, At, B1); PG8_BAR; PG8_SCHED;
            PG8_LDB(B0, 1, 0); PG8_LDB(B1, 1, 1); PG8_SCHED; PG8_LDA(At, 1, 0); PG8_STAGE(PG8_SA(0, 1), a2 + hstep, voffA);
            PG8_WAIT_V(8); PG8_WAIT_L(0); PG8_BAR; PG8_MMA(0, 0, At, B0); PG8_MMA(0, 1, At, B1); PG8_BAR; PG8_SCHED;
            PG8_LDA(At, 1, 1); PG8_STAGE(PG8_SB(1, 0), b3, voffB); PG8_STAGE(PG8_SB(1, 1), b3 + hstep, voffB); PG8_STAGE(PG8_SA(1, 0), a3, voffA);
            PG8_WAIT_V(8); PG8_WAIT_L(0); PG8_BAR; PG8_MMA(1, 0, At, B0); PG8_MMA(1, 1, At, B1); PG8_BAR; PG8_SCHED;
            } else {
            PG8_LDB(B0, 0, 0); PG8_SCHED; PG8_LDA(At, 0, 0); PG8_STAGE(PG8_SA(1, 1), a1 + hstep, voffA);
            PG8_WAIT_L(8); PG8_BAR; PG8_WAIT_L(0); PG8_MMA(0, 0, At, B0); PG8_BAR; PG8_SCHED;
            PG8_LDB(B1, 0, 1); PG8_STAGE(PG8_SB(0, 0), b2, voffB);
            PG8_BAR; PG8_WAIT_L(0); PG8_MMA(0, 1, At, B1); PG8_BAR;
            PG8_LDA(At, 0, 1); PG8_STAGE(PG8_SA(0, 0), a2, voffA);
            PG8_BAR; PG8_WAIT_L(0); PG8_MMA(1, 0, At, B0); PG8_BAR; PG8_SCHED;
            PG8_STAGE(PG8_SB(0, 1), b2 + hstep, voffB);
            PG8_WAIT_V(6); PG8_BAR; PG8_MMA(1, 1, At, B1); PG8_BAR;
            PG8_LDB(B0, 1, 0); PG8_SCHED; PG8_LDA(At, 1, 0); PG8_STAGE(PG8_SA(0, 1), a2 + hstep, voffA);
            PG8_WAIT_L(8); PG8_BAR; PG8_WAIT_L(0); PG8_MMA(0, 0, At, B0); PG8_BAR; PG8_SCHED;
            PG8_LDB(B1, 1, 1); PG8_STAGE(PG8_SB(1, 0), b3, voffB);
            PG8_BAR; PG8_WAIT_L(0); PG8_MMA(0, 1, At, B1); PG8_BAR;
            PG8_LDA(At, 1, 1); PG8_STAGE(PG8_SA(1, 0), a3, voffA);
            PG8_BAR; PG8_WAIT_L(0); PG8_MMA(1, 0, At, B0); PG8_BAR; PG8_SCHED;
            PG8_STAGE(PG8_SB(1, 1), b3 + hstep, voffB);
            PG8_WAIT_V(6); PG8_BAR; PG8_MMA(1, 1, At, B1); PG8_BAR;
            }
        }
        if constexpr (ALIGN_EPI) { if (wr == 0) PG8_BAR; }
        if constexpr (!Epi::AFTER_DRAIN) { E(acc, cur, wr, wc, fr, fq); S.done(cur); }
        if (!has_next) break;
#pragma unroll
        for (int a = 0; a < 2; ++a)
#pragma unroll
            for (int b = 0; b < 2; ++b)
#pragma unroll
                for (int m = 0; m < 4; ++m)
#pragma unroll
                    for (int n = 0; n < 2; ++n) acc[a][b][m][n] = (f32x4){0.f, 0.f, 0.f, 0.f};
        cur = nxt; cA = nA; cB = nB; ++ui;
        if constexpr (ALIGN_EPI) { if (wr == 1) PG8_BAR; }
    }
    PG8_WAIT_V(0);
    if constexpr (!ALIGN_EPI) { if (wr == 0) PG8_BAR; }
    PG8_BAR;
    if constexpr (Epi::AFTER_DRAIN) { E.fused(acc, cur, wr, wc, fr, fq, lds, wid, lane); S.done(cur); }
#undef PG8_SA
#undef PG8_SB
#undef PG8_STAGE
#undef PG8_LDA
#undef PG8_LDB
#undef PG8_MMA
#undef PG8_WAIT_V
#undef PG8_WAIT_L
#undef PG8_BAR
#undef PG8_SCHED
}
}
namespace attn_body {
constexpr int D = 128, LD = 2048;
constexpr float THR = 8.f; constexpr bool WSKIP = false;
constexpr float SCALE = 0.08838834764831845f;
constexpr int NW = 8, QBLK = 32, KVBLK = 64, QB = NW * QBLK;
constexpr int SHM_V = KVBLK * D * 2, SHM_K = KVBLK * D * 2;
constexpr int LDS_BYTES = 2 * SHM_V + 2 * SHM_K + NW * 64 * 4;

typedef short bf16x8 __attribute__((ext_vector_type(8)));
typedef short s16x4 __attribute__((ext_vector_type(4)));
typedef float f32x16 __attribute__((ext_vector_type(16)));
typedef float f32x4 __attribute__((ext_vector_type(4)));
typedef unsigned u32x4 __attribute__((ext_vector_type(4)));
template <class A, class Bt> struct same_t { static constexpr bool v = false; };
template <class A> struct same_t<A, A> { static constexpr bool v = true; };

#define KSWZ(row, colB) ((row) * 256 + ((colB) ^ (((row) & 7) << 4)))
#define SBAR() __builtin_amdgcn_sched_barrier(0)
__device__ __forceinline__ int v_st(int k, int c) { const int kk = (k & ~0xC) | ((k & 4) << 1) | ((k & 8) >> 1); return ((kk >> 3) * 4 + (c >> 5)) * 512 + ((kk & 7) * 32 + (c & 31)) * 2; }
__device__ __forceinline__ int v_rd_base(int lane) { return ((lane & 3) << 3) | (((lane >> 2) & 3) << 6) | (((lane >> 4) & 1) << 5) | (((lane >> 5) & 1) << 8); }
constexpr int v_rd_off(int d0, int ks, int half) { return d0 * 512 + ks * 4096 + half * 2048; }
__device__ __forceinline__ int crow(int r, int hi) { return (r & 3) + 8 * (r >> 2) + 4 * hi; }
__device__ __forceinline__ unsigned cvtpk(float lo, float hi) {
    unsigned r; asm volatile("v_cvt_pk_bf16_f32 %0, %1, %2" : "=v"(r) : "v"(lo), "v"(hi)); return r;
}
__device__ __forceinline__ bf16x8 pack8(f32x4 a, f32x4 b) {
    u32x4 w = {cvtpk(a[0], a[1]), cvtpk(a[2], a[3]), cvtpk(b[0], b[1]), cvtpk(b[2], b[3])};
    return *reinterpret_cast<bf16x8*>(&w);
}
template <class T> __device__ __forceinline__ bf16x8 load8(const T* p) {
    if constexpr (same_t<T, float>::v) { return pack8(*(const f32x4*)p, *(const f32x4*)(p + 4)); }
    else { return *reinterpret_cast<const bf16x8*>(p); }
}
__device__ __forceinline__ void mask_tile(f32x16& p0, f32x16& p1, int dq, unsigned W) {
    const float NEG = -__builtin_inff();
#pragma unroll
    for (int r = 0; r < 16; ++r) {
        const int c = (r & 3) + 8 * (r >> 2);
        if ((unsigned)(dq - c) >= W) p0[r] = NEG;
        if ((unsigned)(dq - c - 32) >= W) p1[r] = NEG;
    }
}
__device__ __forceinline__ void partialSM(f32x16& p0, f32x16& p1, float& m_reg, float& mn, float& alpha) {
    float pmax = p0[0]; for (int r = 1; r < 16; ++r) pmax = fmaxf(pmax, p0[r]); for (int r = 0; r < 16; ++r) pmax = fmaxf(pmax, p1[r]);
    { auto rr = __builtin_amdgcn_permlane32_swap(__float_as_uint(pmax), __float_as_uint(pmax), false, false);
      pmax = fmaxf(__uint_as_float(rr[0]), __uint_as_float(rr[1])); }
    constexpr float C2 = 1.4426950408889634f * SCALE;
    if (__builtin_expect(__all((pmax - m_reg) * SCALE <= THR), 1)) { mn = m_reg; alpha = 1.f; }
    else { mn = fmaxf(m_reg, pmax); alpha = __builtin_amdgcn_exp2f((m_reg - mn) * C2); m_reg = mn; }
    const float mnL = -mn * C2;
    for (int r = 0; r < 16; ++r) p0[r] = fmaf(p0[r], C2, mnL); for (int r = 0; r < 16; ++r) p1[r] = fmaf(p1[r], C2, mnL);
    for (int r = 0; r < 16; ++r) p0[r] = __builtin_amdgcn_exp2f(p0[r]);
}
__device__ __forceinline__ void finishSM(f32x16& p0, f32x16& p1, float alpha, float& l_reg, bf16x8& pa0, bf16x8& pa1, bf16x8& pa2, bf16x8& pa3) {
    for (int r = 0; r < 16; ++r) p1[r] = __builtin_amdgcn_exp2f(p1[r]);
    float ps = 0; for (int r = 0; r < 16; ++r) ps += p0[r]; for (int r = 0; r < 16; ++r) ps += p1[r];
    { auto rr = __builtin_amdgcn_permlane32_swap(__float_as_uint(ps), __float_as_uint(ps), false, false);
      ps = __uint_as_float(rr[0]) + __uint_as_float(rr[1]); }
    l_reg = l_reg * alpha + ps;
#define PK4(P, B_, OUT) do { unsigned a0 = cvtpk(P[B_+0], P[B_+1]), a1 = cvtpk(P[B_+2], P[B_+3]);                          \
        unsigned b0 = cvtpk(P[B_+4], P[B_+5]), b1 = cvtpk(P[B_+6], P[B_+7]);                                             \
        auto r0 = __builtin_amdgcn_permlane32_swap(a0, b0, false, false); auto r1 = __builtin_amdgcn_permlane32_swap(a1, b1, false, false); \
        u32x4 w = {r0[0], r1[0], r0[1], r1[1]}; OUT = *reinterpret_cast<bf16x8*>(&w); } while (0)
    PK4(p0, 0, pa0); PK4(p0, 8, pa1); PK4(p1, 0, pa2); PK4(p1, 8, pa3);
#undef PK4
}
template <int KB, bool SK>
__device__ __forceinline__ void qkt(f32x16& p0, f32x16& p1, const char* K_lds, int r32, int hi, const bf16x8* qr, bool act, const float* bt) {
    if (SK && !act) { const float NEG = -__builtin_inff();
#pragma unroll
        for (int r = 0; r < 16; ++r) { p0[r] = NEG; p1[r] = NEG; } return; }
    { const f32x4 b0 = *(const f32x4*)(bt), b1 = *(const f32x4*)(bt + 8), b2 = *(const f32x4*)(bt + 16), b3 = *(const f32x4*)(bt + 24);
      const f32x4 c0 = *(const f32x4*)(bt + 32), c1 = *(const f32x4*)(bt + 40), c2 = *(const f32x4*)(bt + 48), c3 = *(const f32x4*)(bt + 56);
      p0 = (f32x16){b0[0], b0[1], b0[2], b0[3], b1[0], b1[1], b1[2], b1[3], b2[0], b2[1], b2[2], b2[3], b3[0], b3[1], b3[2], b3[3]};
      p1 = (f32x16){c0[0], c0[1], c0[2], c0[3], c1[0], c1[1], c1[2], c1[3], c2[0], c2[1], c2[2], c2[3], c3[0], c3[1], c3[2], c3[3]}; }
    const char* kb[4];
#pragma unroll
    for (int dd = 0; dd < 4; ++dd) kb[dd] = K_lds + KB * SHM_K + KSWZ(r32, (dd * 16 + hi * 8) * 2);
#pragma unroll
    for (int d0 = 0; d0 < 8; ++d0) { const char* a = kb[d0 & 3] + (d0 >> 2) * 128;
        bf16x8 b0 = *reinterpret_cast<const bf16x8*>(a);
        bf16x8 b1 = *reinterpret_cast<const bf16x8*>(a + 32 * 256);
        p0 = __builtin_amdgcn_mfma_f32_32x32x16_bf16(b0, qr[d0], p0, 0, 0, 0);
        p1 = __builtin_amdgcn_mfma_f32_32x32x16_bf16(b1, qr[d0], p1, 0, 0, 0); }
}
template <int VB, bool SK>
__device__ __forceinline__ void pv_tile(f32x16* o, int vb0, bf16x8 pa0, bf16x8 pa1, bf16x8 pa2, bf16x8 pa3, bool act) {
    if (SK && !act) return;
#define TRRD(dst, off) asm volatile("ds_read_b64_tr_b16 %0, %1 offset:%2" : "=&v"(dst) : "v"(vb0), "i"(off) : "memory")
#define PV_D0(d0) do { s16x4 l0, l1, l2, l3, h0, h1, h2, h3; constexpr int b_ = VB * SHM_V + v_rd_off(d0, 0, 0);     \
        TRRD(l0, b_); TRRD(h0, b_ + 2048); TRRD(l1, b_ + 4096); TRRD(h1, b_ + 6144); TRRD(l2, b_ + 8192); TRRD(h2, b_ + 10240); TRRD(l3, b_ + 12288); TRRD(h3, b_ + 14336); \
        asm volatile("s_waitcnt lgkmcnt(0)" ::: "memory"); SBAR();                 \
        o[d0] = __builtin_amdgcn_mfma_f32_32x32x16_bf16(pa0, (bf16x8){l0[0], l0[1], l0[2], l0[3], h0[0], h0[1], h0[2], h0[3]}, o[d0], 0, 0, 0);   \
        o[d0] = __builtin_amdgcn_mfma_f32_32x32x16_bf16(pa1, (bf16x8){l1[0], l1[1], l1[2], l1[3], h1[0], h1[1], h1[2], h1[3]}, o[d0], 0, 0, 0);   \
        o[d0] = __builtin_amdgcn_mfma_f32_32x32x16_bf16(pa2, (bf16x8){l2[0], l2[1], l2[2], l2[3], h2[0], h2[1], h2[2], h2[3]}, o[d0], 0, 0, 0);   \
        o[d0] = __builtin_amdgcn_mfma_f32_32x32x16_bf16(pa3, (bf16x8){l3[0], l3[1], l3[2], l3[3], h3[0], h3[1], h3[2], h3[3]}, o[d0], 0, 0, 0); } while (0)
    PV_D0(0); PV_D0(1); PV_D0(2); PV_D0(3);
#undef PV_D0
#undef TRRD
}


template <class TIn, class TOut> struct BlockRef { const TIn* Q; const TIn* K; const TIn* V; TOut* O; int P0; int jlo; };
#define ROW(p, k0, rr) ((p) + (size_t)((k0) + (rr)) * LD + sc)
#define VMW() asm volatile("s_waitcnt vmcnt(0)" ::: "memory")
#define SLOAD_H(Kp, Vp, k0) do { st_v0 = load8<TIn>(ROW(Vp, k0, sr)); st_v1 = load8<TIn>(ROW(Vp, k0, 32 + sr));              \
                         st_k0 = load8<TIn>(ROW(Kp, k0, sr)); st_k1 = load8<TIn>(ROW(Kp, k0, 32 + sr)); } while (0)
#define SWRITE_H(bf) do { *(bf16x8*)(V_lds + (bf) * SHM_V + vst0) = st_v0; *(bf16x8*)(V_lds + (bf) * SHM_V + vst1) = st_v1;   \
                          *(bf16x8*)(K_lds + (bf) * SHM_K + kws) = st_k0; *(bf16x8*)(K_lds + (bf) * SHM_K + kws + 32 * 256) = st_k1; } while (0)
template <class TIn, class TOut>
__device__ __forceinline__ void attn_unit(const BlockRef<TIn, TOut>& cur, int skv, char* lds) {
    const int tid = threadIdx.x, wid = __builtin_amdgcn_readfirstlane(tid >> 6), lane = tid & 63, r32 = lane & 31, hi = lane >> 5;
    const unsigned W = 0x40000000u;
    const int j_lo = cur.jlo;
    int j_hi = (cur.P0 + QB - 1) / KVBLK + 1; if (j_hi > skv / KVBLK) j_hi = skv / KVBLK;
    const int NT = j_hi - j_lo;
    const int qlo = cur.P0 + wid * QBLK, qm = qlo + r32 - 4 * hi;
    char* V_lds = lds; char* K_lds = lds + 2 * SHM_V;
    float* ws = (float*)(lds + 2 * SHM_V + 2 * SHM_K) + wid * 64; float* li_l = ws, * al_l = ws + 32;
    const float* bias_l = (const float*)(lds + LDS_BYTES) + 4 * hi;
    float m_reg = -1e30f, l_reg = 0; f32x16 o[4] = {};
    const int sr = tid >> 4, sc = (tid & 15) * 8, vst0 = v_st(sr, sc), vst1 = v_st(32 + sr, sc), kws = KSWZ(sr, sc * 2);
    const int vb0 = (int)(uintptr_t)V_lds + v_rd_base(lane);
    const TIn* Kh = cur.K; const TIn* Vh = cur.V;
    bf16x8 st_v0, st_v1, st_k0, st_k1; bf16x8 qr[8];
#define KBASE(t) ((j_lo + (t)) * KVBLK)
#define BT(t) (bias_l + (t) * KVBLK)
#define RESC(a) do { if (__any((a) < 1.f)) { if (hi == 0) al_l[r32] = (a); asm volatile("s_waitcnt lgkmcnt(0)" ::: "memory");              \
                     for (int d_ = 0; d_ < 4; ++d_) for (int r = 0; r < 16; ++r) o[d_][r] *= al_l[crow(r, hi)]; } } while (0)
#define MASKT(P0_, P1_, t) do { const int kb_ = KBASE(t); if (kb_ + KVBLK - 1 > qlo) mask_tile(P0_, P1_, qm - kb_, W); } while (0)
#pragma unroll
    for (int d0 = 0; d0 < 8; ++d0) qr[d0] = load8<TIn>(cur.Q + (size_t)(wid * QBLK + r32) * LD + d0 * 16 + hi * 8);
    SLOAD_H(Kh, Vh, KBASE(0)); VMW(); SWRITE_H(0); SBAR();
    if (NT > 1) SLOAD_H(Kh, Vh, KBASE(1));
    __syncthreads();
    f32x16 p0, p1; float mn, al; bf16x8 pa0, pa1, pa2, pa3;
#define TILE_STEP(t, BUF) do {                                                                                                 \
        SBAR(); qkt<BUF, false>(p0, p1, K_lds, r32, hi, qr, true, BT(t));                                                       \
        MASKT(p0, p1, (t)); partialSM(p0, p1, m_reg, mn, al); RESC(al);                                                          \
        finishSM(p0, p1, al, l_reg, pa0, pa1, pa2, pa3); SBAR();                                                                 \
        pv_tile<BUF, false>(o, vb0, pa0, pa1, pa2, pa3, true);                                                                    \
        if ((t) + 1 < NT) { VMW(); SWRITE_H(1 - (BUF)); SBAR(); if ((t) + 2 < NT) SLOAD_H(Kh, Vh, KBASE((t) + 2)); }              \
        __syncthreads(); } while (0)
    for (int t = 0; t < NT; t += 2) {
        TILE_STEP(t, 0);
        if (t + 1 < NT) TILE_STEP(t + 1, 1);
    }
    if (hi == 0) li_l[r32] = l_reg; asm volatile("s_waitcnt lgkmcnt(0)" ::: "memory");
    float rli[16];
#pragma unroll
    for (int r = 0; r < 16; ++r) rli[r] = __builtin_amdgcn_rcpf(li_l[crow(r, hi)]);
    TOut* Ow = cur.O + (size_t)(wid * QBLK) * LD;
#pragma unroll
    for (int r = 0; r < 16; ++r) { const int orow = crow(r, hi);
#pragma unroll
        for (int d0 = 0; d0 < 4; ++d0) { const float v = o[d0][r] * rli[r];
            const float vn = __shfl_xor(v, 1);
            if ((r32 & 1) == 0) *(unsigned*)(Ow + (size_t)orow * LD + d0 * 32 + r32) = cvtpk(v, vn); } }
    __syncthreads();
#undef TILE_STEP
#undef RESC
#undef KBASE
#undef BT
#undef MASKT
}
#undef ROW
#undef VMW
#undef SLOAD_H
#undef SWRITE_H
}
#define GAS __attribute__((address_space(1)))
#define LAS __attribute__((address_space(3)))
typedef unsigned short bf16;
typedef unsigned v4u __attribute__((ext_vector_type(4)));
typedef unsigned v2u __attribute__((ext_vector_type(2)));
typedef float f32x4 __attribute__((ext_vector_type(4)));
typedef float f32x2 __attribute__((ext_vector_type(2)));
typedef short bf16x8 __attribute__((ext_vector_type(8)));
typedef GAS unsigned gu32;
#define RLX_AGENT __ATOMIC_RELAXED, __HIP_MEMORY_SCOPE_AGENT

constexpr int S = 8192, DM = 4096, NH = 16, HD = 128, AW = 2048, LW = 2048, NG = 16, GD = 128;
constexpr int NIN = 18448, NINP = 18432;
constexpr int C_Q = 0, C_K = 2048, C_V = 4096, C_F = 6144, C_LX = 6160, C_LY = 8208, C_GA = 10256, C_GL = 14352;
constexpr int PEER_H = 8, PEER_NK = 128, PEER_K = 16, PEER_NE = 16384;
constexpr float EPS = 1e-6f;
constexpr size_t MiB = 1u << 20;
constexpr size_t WS_CTL = 0, CTL_ZERO_BYTES = 32768;
constexpr size_t WS_MOD = 512 * 1024;
constexpr size_t WS_WF = 2 * MiB;
constexpr size_t WS_LOGF = 3 * MiB;
constexpr size_t WS_FC = 4 * MiB;
constexpr size_t WS_AGGA = 5 * MiB, WS_AGGB = 6 * MiB;
constexpr size_t WS_BIASR = 7 * MiB, WS_SB = 7 * MiB + 262144;
constexpr size_t WS_SSQ = 28 * MiB;
constexpr size_t WS_WAT = 8 * MiB, WS_WXT = 9 * MiB;
constexpr size_t WS_SK = 10 * MiB, WS_RS = 11 * MiB, WS_RSU = 11 * MiB + 65536;
constexpr size_t WS_IDX = 12 * MiB, WS_GATE = 16 * MiB, WS_IDX2 = 20 * MiB, WS_GATE2 = 24 * MiB;
constexpr size_t WS_WIN = 32 * MiB, WS_WAO = 176 * MiB, WS_WLO = 192 * MiB, WS_WOUT = 208 * MiB, WS_WPQ = 240 * MiB;
constexpr size_t WS_U = 256 * MiB, WS_V = 384 * MiB;
constexpr size_t WS_HA = 512 * MiB;
constexpr size_t WS_QKV = 576 * MiB;
constexpr size_t WS_LX = 672 * MiB, WS_GY = 704 * MiB, WS_GA = 736 * MiB, WS_GL = 800 * MiB;
constexpr size_t WS_ATT = 864 * MiB, WS_LR = 896 * MiB, WS_T1 = 928 * MiB, WS_MG = 992 * MiB, WS_Q2 = 1056 * MiB, WS_X1 = 1088 * MiB, WS_END = 1216 * MiB;
constexpr int CW_BAR = 4096;
constexpr int CW_QATT = 256;
constexpr int RING_BYTES = 131072;
constexpr int LDSCTL_OFF = 150528, MISC_OFF = LDSCTL_OFF + 320;
constexpr int LDS_BYTES = 151552;
constexpr int NWAVES = 8, NTHREADS = 512;

__device__ __forceinline__ unsigned f2bf(float f) { unsigned u = __builtin_bit_cast(unsigned, f); return (u + 0x7fffu + ((u >> 16) & 1u)) >> 16; }
__device__ __forceinline__ unsigned pk2(float lo, float hi) { return f2bf(lo) | (f2bf(hi) << 16); }
__device__ __forceinline__ float bflo(unsigned w) { return __uint_as_float(w << 16); }
__device__ __forceinline__ float bfhi(unsigned w) { return __uint_as_float(w & 0xffff0000u); }
__device__ __forceinline__ float bf2f(bf16 b) { return __uint_as_float((unsigned)b << 16); }
__device__ __forceinline__ float wave_sum(float v) {
#pragma unroll
    for (int o = 1; o < 64; o <<= 1) v += __shfl_xor(v, o);
    return v;
}
__device__ __forceinline__ float wave_max(float v) {
#pragma unroll
    for (int o = 1; o < 64; o <<= 1) v = fmaxf(v, __shfl_xor(v, o));
    return v;
}
__device__ __forceinline__ float sigmoidf_(float v) { return __builtin_amdgcn_rcpf(1.0f + __builtin_amdgcn_exp2f(-1.4426950408889634f * v)); }
__device__ __forceinline__ float gelu_erf(float v) { return 0.5f * v * (1.0f + erff(v * 0.70710678118654752f)); }
#define XB_TMO      128
#define XB_XCNT(j)  (256  + 64 * (j))
#define XB_XSUB(j)  (1280 + 64 * (j))
#define XB_XGEN(j)  (2304 + 64 * (j))
#define XB_TOP      3328
#define XB_TOPGEN   3392
#define XCD_BAR_WORDS 3456
#define XB_SPIN_CAP (1u << 18)

__device__ __forceinline__ unsigned xb_ld(unsigned* p)              { return __hip_atomic_load(p, __ATOMIC_RELAXED, __HIP_MEMORY_SCOPE_AGENT); }
__device__ __forceinline__ unsigned xb_add(unsigned* p, unsigned v) { return __hip_atomic_fetch_add(p, v, __ATOMIC_RELAXED, __HIP_MEMORY_SCOPE_AGENT); }
__device__ __forceinline__ unsigned xb_xcc_id() { return (unsigned)__builtin_amdgcn_s_getreg((3 << 11) | 20) & 0xFu; }
#define XB_SPIN(cond, bar) do { unsigned _sp = 0; while (cond) { __builtin_amdgcn_s_sleep(1); \
    if ((++_sp & 255u) == 0u) { if (xb_ld(&(bar)[XB_TMO])) break; if (_sp > XB_SPIN_CAP) { atomicAdd(&(bar)[XB_TMO], 1u); break; } } } } while (0)

struct XcdBarrier {
    unsigned* bar; unsigned x;
    volatile LAS unsigned* st;
};

__device__ __forceinline__ XcdBarrier xcd_barrier_post(unsigned* bar, volatile LAS unsigned* st) {
    XcdBarrier b; b.bar = bar; b.x = xb_xcc_id(); b.st = st;
    if (threadIdx.x == 0) (void)xb_add(&bar[XB_XCNT(b.x)], 1u);
    return b;
}
__device__ __forceinline__ void xcd_barrier_complete(unsigned* bar, unsigned x, unsigned& nloc, unsigned& nx) {
    const unsigned G = gridDim.x * gridDim.y * gridDim.z;
    unsigned sum, cnt, mine, sp = 0u;
    for (;;) {
        sum = 0u; cnt = 0u; mine = 0u;
#pragma unroll
        for (unsigned j = 0; j < 16; ++j) { const unsigned c = xb_ld(&bar[XB_XCNT(j)]); sum += c; cnt += (c > 0u) ? 1u : 0u; mine = (j == x) ? c : mine; }
        if (sum == G) break;
        __builtin_amdgcn_s_sleep(1);
        if ((++sp & 255u) == 0u) { if (xb_ld(&bar[XB_TMO])) break; if (sp > XB_SPIN_CAP) { atomicAdd(&bar[XB_TMO], 1u); break; } }
    }
    nloc = mine > 0u ? mine : 1u; nx = cnt > 0u ? cnt : 1u;
}

__device__ __forceinline__ void xcd_barrier(const XcdBarrier& b) {
    asm volatile("s_waitcnt vmcnt(0)" ::: "memory");
    __syncthreads();
    if (threadIdx.x == 0) {
        unsigned* bar = b.bar;
        __builtin_amdgcn_s_waitcnt(0);
        unsigned nloc = b.st[0], nx = b.st[1];
        if (nloc == 0u) { xcd_barrier_complete(bar, b.x, nloc, nx); b.st[0] = nloc; b.st[1] = nx; }
        const unsigned old = xb_add(&bar[XB_XSUB(b.x)], 1u);
        const unsigned gen = old / nloc;
        if (old + 1u == (gen + 1u) * nloc) {
            __builtin_amdgcn_fence(__ATOMIC_RELEASE, "agent");
            asm volatile("s_waitcnt vmcnt(0)" ::: "memory");
            const unsigned og = xb_add(&bar[XB_TOP], 1u);
            const unsigned tg = og / nx;
            if (og + 1u == (tg + 1u) * nx) xb_add(&bar[XB_TOPGEN], 1u);
            else XB_SPIN(xb_ld(&bar[XB_TOPGEN]) == tg, bar);
            __builtin_amdgcn_fence(__ATOMIC_ACQUIRE, "agent");
            xb_add(&bar[XB_XGEN(b.x)], 1u);
            asm volatile("s_waitcnt vmcnt(0)" ::: "memory");
        } else {
            XB_SPIN(xb_ld(&bar[XB_XGEN(b.x)]) == gen, bar);
            __builtin_amdgcn_fence(__ATOMIC_ACQUIRE, "agent");
            asm volatile("s_waitcnt vmcnt(0)" ::: "memory");
        }
    }
    __syncthreads();
}
struct Args { const float* in[24]; float* out; unsigned char* ws; int ph_lo, ph_hi, rep_att, rep_lru; };
struct Frame {
    LAS unsigned char* lds; volatile LAS unsigned* MISC; gu32* ctl;
    int tid, lane, wave, vcu, G;
    unsigned char* ws; float* out;
};
#define WSP(T, off) ((T*)(F.ws + (off)))
#define LDS_WAIT() asm volatile("s_waitcnt lgkmcnt(0)" ::: "memory")

struct TrItem { const float* W; bf16* WT; int ldw, K, k0, nsrc0, ndst0; };
__device__ __forceinline__ void tr_load(const TrItem& I, float (&v)[32], int lane) {
    const float* wp = I.W + (size_t)(I.k0 + (lane >> 5)) * I.ldw + I.nsrc0 + (lane & 31);
#pragma unroll
    for (int i = 0; i < 32; ++i) v[i] = wp[(size_t)(2 * i) * I.ldw];
}
__device__ __forceinline__ void tr_store(const TrItem& I, const float (&v)[32], LAS float* scr, int lane) {
#pragma unroll
    for (int i = 0; i < 32; ++i) scr[(2 * i + (lane >> 5)) * 33 + (lane & 31)] = v[i];
    LDS_WAIT(); asm volatile("" ::: "memory");
    const int c = lane & 7;
#pragma unroll
    for (int j = 0; j < 4; ++j) { const int n = (lane >> 3) + 8 * j; const LAS float* s = scr + (8 * c) * 33 + n;
        v4u o; o.x = pk2(s[0 * 33], s[1 * 33]); o.y = pk2(s[2 * 33], s[3 * 33]); o.z = pk2(s[4 * 33], s[5 * 33]); o.w = pk2(s[6 * 33], s[7 * 33]);
        *(GAS v4u*)(I.WT + (size_t)(I.ndst0 + n) * I.K + I.k0 + 8 * c) = o; }
    LDS_WAIT(); asm volatile("" ::: "memory");
}
__device__ __forceinline__ void cvt_stream(const float* src, bf16* dst, size_t n8, size_t i0, size_t stride) {
    for (size_t i = i0; i < n8; i += stride) { const f32x4 a = ((const GAS f32x4*)src)[2 * i], b = ((const GAS f32x4*)src)[2 * i + 1];
        v4u o; o.x = pk2(a[0], a[1]); o.y = pk2(a[2], a[3]); o.z = pk2(b[0], b[1]); o.w = pk2(b[2], b[3]); ((GAS v4u*)dst)[i] = o; }
}
__device__ __forceinline__ void cvt_stream_fp8(const float* src, unsigned char* dst, size_t n16, float scale, size_t i0, size_t stride) {
    for (size_t i = i0; i < n16; i += stride) { v4u o;
#pragma unroll
        for (int q = 0; q < 4; ++q) { const f32x4 a = ((const GAS f32x4*)src)[4 * i + q] * scale; int w = 0;
            w = __builtin_amdgcn_cvt_pk_fp8_f32(a[0], a[1], w, false); w = __builtin_amdgcn_cvt_pk_fp8_f32(a[2], a[3], w, true); o[q] = (unsigned)w; }
        ((GAS v4u*)dst)[i] = o; }
}
__device__ __forceinline__ void cvt_table_fp4(Frame& F, const float* srcT, unsigned char* dstT, float* rsT, int gw, int NGW) {
    for (int row = gw; row < PEER_NE; row += NGW) {
        const GAS f32x4* src = (const GAS f32x4*)(srcT + (size_t)row * DM); f32x4 a[16]; float am = 0.f;
#pragma unroll
        for (int c = 0; c < 4; ++c)
#pragma unroll
            for (int q = 0; q < 4; ++q) { a[4 * c + q] = src[c * 256 + 4 * F.lane + q]; am = fmaxf(fmaxf(am, fmaxf(fabsf(a[4 * c + q][0]), fabsf(a[4 * c + q][1]))), fmaxf(fabsf(a[4 * c + q][2]), fabsf(a[4 * c + q][3]))); }
        am = wave_max(am); const float inv = am > 0.f ? 6.0f / am : 0.f;
#pragma unroll
        for (int c = 0; c < 4; ++c) { v2u o;
#pragma unroll
            for (int d = 0; d < 2; ++d) { unsigned w = 0u; const f32x4 x0 = a[4 * c + 2 * d] * inv, x1 = a[4 * c + 2 * d + 1] * inv;
                w = __builtin_amdgcn_cvt_scalef32_pk_fp4_f32(w, x0[0], x0[1], 1.0f, 0); w = __builtin_amdgcn_cvt_scalef32_pk_fp4_f32(w, x0[2], x0[3], 1.0f, 1);
                w = __builtin_amdgcn_cvt_scalef32_pk_fp4_f32(w, x1[0], x1[1], 1.0f, 2); w = __builtin_amdgcn_cvt_scalef32_pk_fp4_f32(w, x1[2], x1[3], 1.0f, 3); o[d] = w; }
            *((GAS v2u*)(dstT + (size_t)row * 2048 + c * 512) + F.lane) = o; }
        if (F.lane == 0) rsT[row] = am * (1.0f / 6.0f);
    }
}
__device__ __forceinline__ void p0_prologue(Frame& F, const Args& args) {
#ifndef P0_REP
#define P0_REP 0
#endif
    _Pragma("unroll") for (int rep_ = 0; rep_ < ((P0_REP & 1) ? 2 : 1); ++rep_)
    { LAS float* sc = (LAS float*)F.lds; LAS f32x4* red = (LAS f32x4*)(F.lds + 16384); float* MOD = WSP(float, WS_MOD);
      for (int cgi = blockIdx.x; cgi < 256; cgi += F.G) {
          for (int i = F.tid; i < DM; i += NTHREADS) { const float cv = args.in[1][i]; sc[i] = cv / (1.0f + __expf(-cv)); }
          __syncthreads();
          if (F.tid < 384) { const int cg = F.tid % 24, rg = F.tid / 24;
              const GAS f32x4* Wp = (const GAS f32x4*)args.in[2] + cgi * 24 + cg;
              f32x4 acc = {0.f, 0.f, 0.f, 0.f};
#pragma unroll 8
              for (int r = rg; r < DM; r += 16) acc += sc[r] * Wp[(size_t)r * 6144];
              red[rg * 24 + cg] = acc; }
          __syncthreads();
          if (F.tid < 24) { f32x4 s = red[F.tid];
#pragma unroll
              for (int rg = 1; rg < 16; ++rg) s += red[rg * 24 + F.tid];
              s += ((const GAS f32x4*)args.in[3])[cgi * 24 + F.tid]; ((GAS f32x4*)MOD)[cgi * 24 + F.tid] = s; }
          __syncthreads();
      } }
    LAS float* scr = (LAS float*)(F.lds + F.wave * 16384);
    const int gw = F.vcu * NWAVES + F.wave, NGW = F.G * NWAVES;
    constexpr int I_IN = 64 * 576, I_AO = 32 * 128, I_LO = 32 * 128, I_OUT = 64 * 128, I_PQ = 64 * 64, I_WA = 16 * 2 * 4, I_WX = I_WA;
    constexpr int NITEMS = I_IN + I_AO + I_LO + I_OUT + I_PQ + I_WA + I_WX;
    auto decode = [&](int r) -> TrItem { TrItem I;
        if (r < I_IN) { const int kb = r / 576, nb = r % 576; I = TrItem{args.in[6], WSP(bf16, WS_WIN), NIN, DM, 64 * kb, 32 * nb + (nb >= 192 ? 16 : 0), 32 * nb}; return I; } r -= I_IN;
        if (r < I_AO) { const int kb = r / 128, nb = r % 128; I = TrItem{args.in[17], WSP(bf16, WS_WAO), DM, AW, 64 * kb, 32 * nb, 32 * nb}; return I; } r -= I_AO;
        if (r < I_LO) { const int kb = r / 128, nb = r % 128; I = TrItem{args.in[18], WSP(bf16, WS_WLO), DM, LW, 64 * kb, 32 * nb, 32 * nb}; return I; } r -= I_LO;
        if (r < I_OUT) { const int kb = r / 128, nb = r % 128; I = TrItem{args.in[19], WSP(bf16, WS_WOUT), DM, DM, 64 * kb, 32 * nb, 32 * nb}; return I; } r -= I_OUT;
        if (r < I_PQ) { const int kb = r / 64, nb = r % 64; I = TrItem{args.in[20], WSP(bf16, WS_WPQ), 2048, DM, 64 * kb, 32 * nb, 32 * nb}; return I; } r -= I_PQ;
        { const bool isx = r >= I_WA; if (isx) r -= I_WA; const int g = r >> 3, kb = (r >> 2) & 1, nb = r & 3;
          I = TrItem{(isx ? args.in[14] : args.in[12]) + (size_t)g * GD * GD, WSP(bf16, isx ? WS_WXT : WS_WAT) + (size_t)g * GD * GD, GD, GD, 64 * kb, 32 * nb, 32 * nb}; return I; } };
    _Pragma("unroll") for (int rep_ = 0; rep_ < ((P0_REP & 2) ? 2 : 1); ++rep_)
    if (gw < NITEMS) {
        float va[32], vb[32]; TrItem Ia = decode(gw); tr_load(Ia, va, F.lane);
#pragma unroll 1
        for (int it = gw; it < NITEMS; it += NGW) {
            const int nx = it + NGW; TrItem Ib = Ia;
            if (nx < NITEMS) { Ib = decode(nx); tr_load(Ib, vb, F.lane); }
            tr_store(Ia, va, scr, F.lane);
#pragma unroll
            for (int i = 0; i < 32; ++i) va[i] = vb[i];
            Ia = Ib;
        }
    }
    const size_t gt = (size_t)F.vcu * NTHREADS + F.tid, NGT = (size_t)F.G * NTHREADS;
    _Pragma("unroll") for (int rep_ = 0; rep_ < ((P0_REP & 4) ? 2 : 1); ++rep_) {
    cvt_table_fp4(F, args.in[23], WSP(unsigned char, WS_V), WSP(float, WS_RS), gw, NGW);
    cvt_table_fp4(F, args.in[22], WSP(unsigned char, WS_U), WSP(float, WS_RSU), gw, NGW); }
    cvt_stream(args.in[21], WSP(bf16, WS_SK), (size_t)PEER_H * 2 * 128 * 128 / 8, gt, NGT);
    for (size_t i = gt; i < (size_t)DM * 16; i += NGT) WSP(float, WS_WF)[(i & 15) * DM + (i >> 4)] = args.in[6][(i >> 4) * NIN + C_F + (i & 15)];
    for (size_t i = gt; i < (size_t)NINP; i += NGT) WSP(float, WS_BIASR)[i] = args.in[7][i + (i >= (size_t)C_F ? 16 : 0)];
}

__device__ __forceinline__ void p1_norm_forget(Frame& F, const Args& args) {
    const float* MOD = WSP(float, WS_MOD); const float* WFT = WSP(float, WS_WF); bf16* HA = WSP(bf16, WS_HA);
    LAS f32x4* MUL4 = (LAS f32x4*)F.lds; LAS f32x4* SH4 = (LAS f32x4*)(F.lds + 16384); LAS f32x4* WB4 = (LAS f32x4*)(F.lds + 32768);
    for (int i4 = F.tid; i4 < DM / 4; i4 += NTHREADS) { MUL4[i4] = ((const GAS f32x4*)args.in[4])[i4] * (((const GAS f32x4*)(MOD + 4096))[i4] + 1.0f); SH4[i4] = ((const GAS f32x4*)MOD)[i4]; }
    __syncthreads();
    const int cw = F.tid >> 6, dw = F.tid & 63;
    const unsigned wo0 = (unsigned)(cw * DM + dw * 4) * 4u, wo1 = (unsigned)((cw + 8) * DM + dw * 4) * 4u, lo16 = (unsigned)F.lane * 16u, lo8 = (unsigned)F.lane * 8u;
#pragma unroll 1
    for (int step = blockIdx.x; step < S / 32; step += F.G) {
        const int ra = step * 32 + F.wave * 4; const char* xb0 = (const char*)(args.in[0] + (size_t)ra * DM); char* hb0 = (char*)(HA + (size_t)ra * DM);
        float rs[4];
#pragma unroll
        for (int r = 0; r < 4; ++r) { f32x4 xa[16]; float ss = 0.f;
#pragma unroll
            for (int j = 0; j < 16; ++j) xa[j] = *(const GAS f32x4*)(xb0 + (size_t)r * (DM * 4) + 1024 * j + lo16);
#pragma unroll
            for (int j = 0; j < 16; ++j) ss += (xa[j][0] * xa[j][0] + xa[j][1] * xa[j][1]) + (xa[j][2] * xa[j][2] + xa[j][3] * xa[j][3]);
            rs[r] = 1.0f / sqrtf(wave_sum(ss) * (1.0f / DM) + EPS); }
        float acc[4][16];
#pragma unroll
        for (int r = 0; r < 4; ++r)
#pragma unroll
            for (int c = 0; c < 16; ++c) acc[r][c] = 0.f;
        f32x4 w0 = *(const GAS f32x4*)((const char*)WFT + wo0), w1 = *(const GAS f32x4*)((const char*)WFT + wo1), xn[4];
#pragma unroll
        for (int r = 0; r < 4; ++r) xn[r] = *(const GAS f32x4*)(xb0 + (size_t)r * (DM * 4) + lo16);
#pragma unroll 1
        for (int j = 0; j < 16; ++j) {
            LAS f32x4* wb = WB4 + (j & 1) * 1024;
            wb[F.tid] = w0; wb[F.tid + 512] = w1;
            __syncthreads();
            f32x4 xc[4]; const int jn = (j + 1) & 15;
#pragma unroll
            for (int r = 0; r < 4; ++r) xc[r] = xn[r];
            { const char* wbase = (const char*)WFT + 1024 * jn; w0 = *(const GAS f32x4*)(wbase + wo0); w1 = *(const GAS f32x4*)(wbase + wo1); }
#pragma unroll
            for (int r = 0; r < 4; ++r) xn[r] = *(const GAS f32x4*)(xb0 + (size_t)r * (DM * 4) + 1024 * jn + lo16);
            const f32x4 mul = MUL4[F.lane + 64 * j], sh = SH4[F.lane + 64 * j];
            f32x4 h[4];
#pragma unroll
            for (int r = 0; r < 4; ++r) { h[r] = xc[r] * rs[r] * mul + sh; v2u o; o.x = pk2(h[r][0], h[r][1]); o.y = pk2(h[r][2], h[r][3]); *(GAS v2u*)(hb0 + (size_t)r * (DM * 2) + 512 * j + lo8) = o; }
#pragma unroll
            for (int c = 0; c < 16; ++c) { const f32x4 wf = wb[c * 64 + F.lane];
#pragma unroll
                for (int r = 0; r < 4; ++r) acc[r][c] += (h[r][0] * wf[0] + h[r][1] * wf[1]) + (h[r][2] * wf[2] + h[r][3] * wf[3]); }
        }
#pragma unroll
        for (int c = 0; c < 16; ++c) { float tt[4];
#pragma unroll
            for (int r = 0; r < 4; ++r) tt[r] = wave_sum(acc[r][c]);
            if (F.lane == c) { const float bia = args.in[7][C_F + c];
#pragma unroll
                for (int r = 0; r < 4; ++r) { const float f = tt[r] + bia; WSP(float, WS_LOGF)[(size_t)c * S + ra + r] = fminf(f, 0.f) - log1pf(__expf(-fabsf(f))); } } }
        __syncthreads();
    }
}
__device__ __forceinline__ void p1_shift_proj(Frame& F, const Args& args) {
    const int gw = F.vcu * NWAVES + F.wave, NGW = F.G * NWAVES; const float* sh2 = WSP(float, WS_MOD) + 12288; const bf16* WT = WSP(bf16, WS_WPQ);
    for (int col = gw; col < 2048; col += NGW) { float s = 0.f;
#pragma unroll
        for (int c = 0; c < 8; ++c) { const v4u w = *((const GAS v4u*)(WT + (size_t)col * DM + c * 512) + F.lane); const GAS f32x4* sp = (const GAS f32x4*)(sh2 + c * 512 + F.lane * 8); const f32x4 a = sp[0], b = sp[1];
            s += (bflo(w.x) * a[0] + bfhi(w.x) * a[1]) + (bflo(w.y) * a[2] + bfhi(w.y) * a[3]) + (bflo(w.z) * b[0] + bfhi(w.z) * b[1]) + (bflo(w.w) * b[2] + bfhi(w.w) * b[3]); }
        s = wave_sum(s); if (F.lane == 0) WSP(float, WS_SB)[col] = s; }
}

__device__ __forceinline__ void p3_qknorm(Frame& F, const Args& args) {
    const int gw = F.vcu * NWAVES + F.wave, NGW = F.G * NWAVES; bf16* QK = WSP(bf16, WS_QKV);
    const int sub = F.lane & 15;
    f32x4 gq0 = ((const GAS f32x4*)args.in[8])[2 * sub], gq1 = ((const GAS f32x4*)args.in[8])[2 * sub + 1], gk0 = ((const GAS f32x4*)args.in[9])[2 * sub], gk1 = ((const GAS f32x4*)args.in[9])[2 * sub + 1];
    for (int it0 = gw; it0 < 2 * S * NH / 4; it0 += 4 * NGW) {
        v4u w[4]; GAS v4u* pp[4];
#pragma unroll
        for (int k = 0; k < 4; ++k) { const int it = it0 + k * NGW; const size_t unit = (size_t)(it < 2 * S * NH / 4 ? it : it0) * 4 + (F.lane >> 4); pp[k] = (GAS v4u*)(QK + unit * 128) + sub; w[k] = *pp[k]; }
#pragma unroll
        for (int k = 0; k < 4; ++k) { const int it = it0 + k * NGW; const size_t unit = (size_t)(it < 2 * S * NH / 4 ? it : it0) * 4 + (F.lane >> 4); const bool isk = unit >= (size_t)S * NH;
            f32x4 a = {bflo(w[k].x), bfhi(w[k].x), bflo(w[k].y), bfhi(w[k].y)}, b = {bflo(w[k].z), bfhi(w[k].z), bflo(w[k].w), bfhi(w[k].w)};
            float ss = (a[0] * a[0] + a[1] * a[1]) + (a[2] * a[2] + a[3] * a[3]) + (b[0] * b[0] + b[1] * b[1]) + (b[2] * b[2] + b[3] * b[3]);
            ss += __shfl_xor(ss, 1); ss += __shfl_xor(ss, 2); ss += __shfl_xor(ss, 4); ss += __shfl_xor(ss, 8);
            const float rs = 1.0f / sqrtf(ss * (1.0f / HD) + EPS);
            a = a * rs * (isk ? gk0 : gq0); b = b * rs * (isk ? gk1 : gq1);
            v4u o; o.x = pk2(a[0], a[1]); o.y = pk2(a[2], a[3]); o.z = pk2(b[0], b[1]); o.w = pk2(b[2], b[3]);
            if (it < 2 * S * NH / 4) *pp[k] = o; }
    }
}
__device__ __forceinline__ void p3_cumsum(Frame& F, const Args& args) {
    LAS float* wt = (LAS float*)F.lds;
    for (int h = blockIdx.x; h < NH; h += F.G) {
        const float* LF = WSP(float, WS_LOGF); float v[16]; float run = 0.f;
        { const GAS f32x4* lp = (const GAS f32x4*)(LF + (size_t)h * S + F.tid * 16); const f32x4 l0 = lp[0], l1 = lp[1], l2 = lp[2], l3 = lp[3];
          const float lv[16] = {l0[0], l0[1], l0[2], l0[3], l1[0], l1[1], l1[2], l1[3], l2[0], l2[1], l2[2], l2[3], l3[0], l3[1], l3[2], l3[3]};
#pragma unroll
          for (int i = 0; i < 16; ++i) { run += lv[i]; v[i] = run; } }
        float sc = run;
#pragma unroll
        for (int o = 1; o < 64; o <<= 1) { const float t = __shfl_up(sc, o); if (F.lane >= o) sc += t; }
        if (F.lane == 63) wt[F.wave] = sc;
        __syncthreads();
        float pre = sc - run;
        for (int w = 0; w < F.wave; ++w) pre += wt[w];
        float* Fo = WSP(float, WS_FC) + (size_t)h * S + F.tid * 16;
#pragma unroll
        for (int i = 0; i < 4; ++i) ((GAS f32x4*)Fo)[i] = (f32x4){v[4 * i] + pre, v[4 * i + 1] + pre, v[4 * i + 2] + pre, v[4 * i + 3] + pre};
        __syncthreads();
    }
}
constexpr int LRU_XCF = 0, LRU_XCB = 32768, LRU_AB = 49152, LRU_BB = 81920, LRU_QA = 114688, LRU_CAR = 118784, LRU_XR = 133120;
struct LruConst { float w0, w1, w2, w3, cb, bav, bxv, sp8; };
template <int PASS> __device__ __forceinline__ void lru_chunk(Frame& F, const Args& args, int c, int g, v4u (&raw)[3], const bf16x8 (&ba)[4], const bf16x8 (&bx)[4], bool more, const LruConst& K) {
    LAS float* XCF = (LAS float*)(F.lds + LRU_XCF); LAS unsigned char* XCB = F.lds + LRU_XCB; LAS float* AB = (LAS float*)(F.lds + LRU_AB); LAS float* BB = (LAS float*)(F.lds + LRU_BB);
    LAS float* QA = (LAS float*)(F.lds + LRU_QA); LAS float* CAR = (LAS float*)(F.lds + LRU_CAR); LAS bf16* XR = (LAS bf16*)(F.lds + LRU_XR);
    const int t0 = 64 * c, ch0 = GD * g; const bf16* LX = WSP(bf16, WS_LX);
#pragma unroll
    for (int k = 0; k < 3; ++k) { const int p = F.tid + k * NTHREADS; if (p < 67 * 16) *(LAS v4u*)(XR + (p >> 4) * 128 + (p & 15) * 8) = raw[k]; }
    if (more) {
#pragma unroll
        for (int k = 0; k < 3; ++k) { const int p = F.tid + k * NTHREADS; const int r = p >> 4, cc = p & 15, tg = t0 + 64 - 3 + r; raw[k] = (v4u){0u, 0u, 0u, 0u};
            if (p < 67 * 16 && tg >= 0) raw[k] = *(const GAS v4u*)(LX + (size_t)tg * LW + ch0 + cc * 8); } }
    __syncthreads();
    { const int ch = F.tid & 127, tq = F.tid >> 7, gch = ch0 + ch;
      const float w0 = K.w0, w1 = K.w1, w2 = K.w2, w3 = K.w3, cb = K.cb; (void)gch;
      float xm3 = bf2f(XR[(16 * tq + 0) * 128 + ch]), xm2 = bf2f(XR[(16 * tq + 1) * 128 + ch]), xm1 = bf2f(XR[(16 * tq + 2) * 128 + ch]);
#pragma unroll
      for (int i = 0; i < 16; ++i) { const int t = 16 * tq + i; const float x0 = bf2f(XR[(t + 3) * 128 + ch]);
          const float xc = w0 * xm3 + w1 * xm2 + w2 * xm1 + w3 * x0 + cb; xm3 = xm2; xm2 = xm1; xm1 = x0;
          XCF[t * 128 + ch] = xc; *(LAS bf16*)(XCB + t * 256 + ((ch * 2) ^ ((t & 7) << 4))) = (bf16)f2bf(xc); } }
    __syncthreads();
    { const int fr = F.lane & 15, fq = F.lane >> 4, j = 16 * F.wave + fr;
      const float bav = K.bav, bxv = K.bxv, sp8 = K.sp8;
#pragma unroll
      for (int mt = 0; mt < 4; ++mt) { f32x4 ar = {0.f, 0.f, 0.f, 0.f}, ax = {0.f, 0.f, 0.f, 0.f}; const int t = 16 * mt + fr;
#pragma unroll
          for (int ks = 0; ks < 4; ++ks) { const bf16x8 af = *(const LAS bf16x8*)(XCB + t * 256 + (((32 * ks + 8 * fq) * 2) ^ ((t & 7) << 4)));
              ar = __builtin_amdgcn_mfma_f32_16x16x32_bf16(af, ba[ks], ar, 0, 0, 0); ax = __builtin_amdgcn_mfma_f32_16x16x32_bf16(af, bx[ks], ax, 0, 0, 0); }
#pragma unroll
          for (int rg = 0; rg < 4; ++rg) { const int tt = 16 * mt + 4 * fq + rg; const float xcv = XCF[tt * 128 + j];
              const float rgt = sigmoidf_(ar[rg] + bav), igt = sigmoidf_(ax[rg] + bxv);
              const float a = __builtin_amdgcn_exp2f(rgt * sp8); const float om = fmaxf((1.0f - a) * (1.0f + a), 0.f);
              const float b = __builtin_amdgcn_sqrtf(om) * (igt * xcv);
              AB[tt * 128 + j] = a; BB[tt * 128 + j] = b; } } }
    __syncthreads();
    const int ch = F.tid & 127, q = F.tid >> 7;
    { float A = 1.f, B = 0.f;
#pragma unroll
      for (int i = 0; i < 16; ++i) { const int t = 16 * q + i; const float a = AB[t * 128 + ch]; B = a * B + BB[t * 128 + ch]; A *= a; }
      QA[(q * 128 + ch) * 2] = A; QA[(q * 128 + ch) * 2 + 1] = B; }
    __syncthreads();
    if (PASS == 0) {
        if (F.tid < 128) { float A = 1.f, B = 0.f;
#pragma unroll
            for (int qq = 0; qq < 4; ++qq) { const float a = QA[(qq * 128 + F.tid) * 2], b = QA[(qq * 128 + F.tid) * 2 + 1]; B = a * B + b; A *= a; }
            WSP(float, WS_AGGA)[(size_t)c * LW + ch0 + F.tid] = A; WSP(float, WS_AGGB)[(size_t)c * LW + ch0 + F.tid] = B; }
    } else {
        float h = CAR[ch];
        for (int qq = 0; qq < q; ++qq) h = QA[(qq * 128 + ch) * 2] * h + QA[(qq * 128 + ch) * 2 + 1];
#pragma unroll
        for (int i = 0; i < 16; ++i) { const int t = 16 * q + i; h = AB[t * 128 + ch] * h + BB[t * 128 + ch]; XCF[t * 128 + ch] = h; }
        __syncthreads();
        if (F.tid < 128) { float hc = CAR[F.tid];
#pragma unroll
            for (int qq = 0; qq < 4; ++qq) hc = QA[(qq * 128 + F.tid) * 2] * hc + QA[(qq * 128 + F.tid) * 2 + 1];
            CAR[F.tid] = hc; }
        const bf16* GY = WSP(bf16, WS_GY); bf16* LR = WSP(bf16, WS_LR);
        for (int p = F.tid; p < 64 * 16; p += NTHREADS) { const int r = p >> 4, cc = p & 15; const size_t o = (size_t)(t0 + r) * LW + ch0 + cc * 8;
            const v4u gy = *(const GAS v4u*)(GY + o); const f32x4 h0 = *(const LAS f32x4*)(XCF + r * 128 + cc * 8), h1 = *(const LAS f32x4*)(XCF + r * 128 + cc * 8 + 4);
            v4u ov; ov.x = pk2(h0[0] * bflo(gy.x), h0[1] * bfhi(gy.x)); ov.y = pk2(h0[2] * bflo(gy.y), h0[3] * bfhi(gy.y)); ov.z = pk2(h1[0] * bflo(gy.z), h1[1] * bfhi(gy.z)); ov.w = pk2(h1[2] * bflo(gy.w), h1[3] * bfhi(gy.w));
            *(GAS v4u*)(LR + o) = ov; }
    }
    __syncthreads();
}
template <int PASS> __device__ __forceinline__ void lru_item(Frame& F, const Args& args, int w) {
    const int g = w & 15, c0 = (w >> 4) * 8; LAS float* CAR = (LAS float*)(F.lds + LRU_CAR); LAS float* QA = (LAS float*)(F.lds + LRU_QA);
    if (PASS == 1) {
        const int ch = F.tid & 127, q = F.tid >> 7, n = c0 / 4;
        const float* GA_ = WSP(float, WS_AGGA) + GD * g + ch; const float* GB_ = WSP(float, WS_AGGB) + GD * g + ch; float A = 1.f, B = 0.f;
#pragma unroll 4
        for (int cc = q * n; cc < (q + 1) * n; ++cc) { const float a = GA_[(size_t)cc * LW], b = GB_[(size_t)cc * LW]; B = a * B + b; A *= a; }
        QA[(q * 128 + ch) * 2] = A; QA[(q * 128 + ch) * 2 + 1] = B;
        __syncthreads();
        if (F.tid < 128) { float hc = 0.f;
#pragma unroll
            for (int qq = 0; qq < 4; ++qq) hc = QA[(qq * 128 + F.tid) * 2] * hc + QA[(qq * 128 + F.tid) * 2 + 1];
            CAR[F.tid] = hc; }
        __syncthreads();
    }
    bf16x8 ba[4], bx[4];
    { const int fr = F.lane & 15, fq = F.lane >> 4, j = 16 * F.wave + fr;
      const bf16* WA = WSP(bf16, WS_WAT) + (size_t)g * GD * GD + (size_t)j * GD + 8 * fq; const bf16* WX = WSP(bf16, WS_WXT) + (size_t)g * GD * GD + (size_t)j * GD + 8 * fq;
#pragma unroll
      for (int ks = 0; ks < 4; ++ks) { ba[ks] = *(const GAS bf16x8*)(WA + 32 * ks); bx[ks] = *(const GAS bf16x8*)(WX + 32 * ks); } }
    v4u raw[3];
    { const bf16* LX = WSP(bf16, WS_LX); const int t0 = 64 * c0, ch0 = GD * g;
#pragma unroll
      for (int k = 0; k < 3; ++k) { const int p = F.tid + k * NTHREADS; const int r = p >> 4, cc = p & 15, tg = t0 - 3 + r; raw[k] = (v4u){0u, 0u, 0u, 0u};
          if (p < 67 * 16 && tg >= 0) raw[k] = *(const GAS v4u*)(LX + (size_t)tg * LW + ch0 + cc * 8); } }
    LruConst K;
    { const int gch = GD * g + (F.tid & 127); K.w0 = args.in[10][gch]; K.w1 = args.in[10][LW + gch]; K.w2 = args.in[10][2 * LW + gch]; K.w3 = args.in[10][3 * LW + gch]; K.cb = args.in[11][gch];
      const int gcj = GD * g + 16 * F.wave + (F.lane & 15); K.bav = args.in[13][gcj]; K.bxv = args.in[15][gcj]; const float lam = args.in[16][gcj];
      K.sp8 = -8.0f * 1.4426950408889634f * ((lam > 0.f ? 0.f : -lam) + log1pf(__expf(-fabsf(lam)))); }
#pragma unroll 1
    for (int c = c0; c < c0 + 8; ++c) lru_chunk<PASS>(F, args, c, g, raw, ba, bx, c + 1 < c0 + 8, K);
}
constexpr int ATT_BIAS_OFF = attn_body::LDS_BYTES;
typedef attn_body::BlockRef<bf16, bf16> ARef;
__device__ __forceinline__ int attn_jlo(const float* Fh, int qb, float TH, int lane) {
    const int t0 = qb * 256; const float f0 = Fh[t0];
    const int j0 = lane, j1 = lane + 64;
    const bool ok0 = (64 * j0 + 63 >= t0) || (f0 - Fh[64 * j0 + 63] >= -TH), ok1 = (64 * j1 + 63 >= t0) || (f0 - Fh[64 * j1 + 63] >= -TH);
    const unsigned long long m0 = __ballot(ok0), m1 = __ballot(ok1);
    return m0 ? (int)__builtin_ctzll(m0) : 64 + (int)__builtin_ctzll(m1);
}
__device__ __forceinline__ ARef attn_ref(Frame& F, const Args& args, int h, int qb, int jlo) {
    ARef r; const bf16* QK = WSP(bf16, WS_QKV);
    r.Q = QK + (size_t)(qb * 256) * AW + h * HD; r.K = QK + (size_t)S * AW + h * HD; r.V = QK + 2 * (size_t)S * AW + h * HD;
    r.O = WSP(bf16, WS_ATT) + (size_t)(qb * 256) * AW + h * HD; r.P0 = qb * 256; r.jlo = jlo; return r;
}
__device__ __forceinline__ void attn_fill_bias(Frame& F, const Args& args, int h, int qb, int jlo) {
    const float* Fh = WSP(float, WS_FC) + (size_t)h * S; LAS float* bl = (LAS float*)(F.lds + ATT_BIAS_OFF);
    const int k0 = jlo * 64, n = (qb + 1) * 256 - k0; const float fr = Fh[k0];
#pragma unroll 1
    for (int i = F.tid; i < n; i += NTHREADS) bl[i] = (fr - Fh[k0 + i]) * (1.0f / attn_body::SCALE);
}
#ifndef ATT_MARGIN
#define ATT_MARGIN 25.0f
#endif
constexpr int ATT_SCHED_OFF = 104448;
__device__ __forceinline__ void p4_attention(Frame& F, const Args& args, char* lds_generic, int rep) {
    float gq = fmaxf(fabsf(args.in[8][F.lane]), fabsf(args.in[8][F.lane + 64])), gk = fmaxf(fabsf(args.in[9][F.lane]), fabsf(args.in[9][F.lane + 64]));
    gq = wave_max(gq); gk = wave_max(gk);
    const float TH = 2.0f * (128.0f * gq * gk * attn_body::SCALE) + ATT_MARGIN;
    LAS float* Fend = (LAS float*)(F.lds + ATT_SCHED_OFF); LAS int* cost = (LAS int*)(F.lds + ATT_SCHED_OFF + 8192); LAS int* jlo_t = cost + 512; LAS int* order = cost + 1024; LAS int* slot = cost + 1536;
    const float* Fc = WSP(float, WS_FC);
    for (int p = F.tid; p < NH * 128; p += NTHREADS) Fend[p] = Fc[(size_t)(p >> 7) * S + 64 * (p & 127) + 63];
    __syncthreads();
    { const int u = F.tid, h = u >> 5, qb = u & 31, t0 = qb * 256; const float f0 = Fc[(size_t)h * S + t0];
      int lo = 0, hi = 4 * qb;
      while (lo < hi) { const int mid = (lo + hi) >> 1; const bool ok = (64 * mid + 63 >= t0) || (f0 - Fend[h * 128 + mid] >= -TH); if (ok) hi = mid; else lo = mid + 1; }
      jlo_t[u] = lo; cost[u] = 4 * (qb + 1) - lo; }
    __syncthreads();
    { const int u = F.tid, cu = cost[u]; int rk = 0;
      for (int v = 0; v < 512; ++v) { const int cv = cost[v]; rk += (cv > cu || (cv == cu && v < u)) ? 1 : 0; }
      order[rk] = u; }
    __syncthreads();
    for (;;) {
        if (F.tid == 0) slot[0] = (int)__hip_atomic_fetch_add((unsigned*)(F.ctl + CW_QATT + 64 * rep), 1u, RLX_AGENT);
        __syncthreads();
        const int k = slot[0];
        __syncthreads();
        if (k >= 512) break;
        const int u = order[k], h = u >> 5, qb = u & 31, jl = jlo_t[u];
        const ARef r0 = attn_ref(F, args, h, qb, jl);
        attn_fill_bias(F, args, h, qb, jl); __syncthreads();
        attn_body::attn_unit<bf16, bf16>(r0, S, lds_generic);
    }
}

__device__ __forceinline__ void p7_norm2(Frame& F, const Args& args) {
    const int gw = F.vcu * NWAVES + F.wave, NGW = F.G * NWAVES; const float* MOD = WSP(float, WS_MOD); bf16* HA = WSP(bf16, WS_HA);
    for (int m = gw; m < S; m += NGW) {
        const GAS f32x4* xr = (const GAS f32x4*)(WSP(float, WS_X1) + (size_t)m * DM) + F.lane; f32x4 v[16]; float ss = 0.f;
#pragma unroll
        for (int j = 0; j < 16; ++j) { v[j] = xr[64 * j]; ss += (v[j][0] * v[j][0] + v[j][1] * v[j][1]) + (v[j][2] * v[j][2] + v[j][3] * v[j][3]); }
        const float rstd = 1.0f / sqrtf(wave_sum(ss) * (1.0f / DM) + EPS);
#pragma unroll
        for (int j = 0; j < 16; ++j) { const int i4 = F.lane + 64 * j;
            const f32x4 g = ((const GAS f32x4*)args.in[5])[i4], scl = ((const GAS f32x4*)(MOD + 16384))[i4], sh = ((const GAS f32x4*)(MOD + 12288))[i4];
            const f32x4 hv = v[j] * rstd * (g * (scl + 1.0f)) + sh;
            v2u o; o.x = pk2(hv[0], hv[1]); o.y = pk2(hv[2], hv[3]); ((GAS v2u*)(HA + (size_t)m * DM))[i4] = o; }
    }
}

template <int CTRL> __device__ __forceinline__ unsigned dppu(unsigned x) { return (unsigned)__builtin_amdgcn_update_dpp(0, (int)x, CTRL, 0xF, 0xF, true); }
__device__ __forceinline__ unsigned rowmax_u32(unsigned x) { x = max(x, dppu<0xB1>(x)); x = max(x, dppu<0x4E>(x)); x = max(x, dppu<0x141>(x)); x = max(x, dppu<0x140>(x)); return x; }
__device__ __forceinline__ float rowsum_f32(float x) { x += __uint_as_float(dppu<0xB1>(__float_as_uint(x))); x += __uint_as_float(dppu<0x4E>(__float_as_uint(x)));
    x += __uint_as_float(dppu<0x141>(__float_as_uint(x))); x += __uint_as_float(dppu<0x140>(__float_as_uint(x))); return x; }
__device__ __forceinline__ unsigned ordk(float f) { const unsigned u = __float_as_uint(f); return u ^ ((unsigned)((int)u >> 31) | 0x80000000u); }
__device__ __forceinline__ float deck(unsigned k) { return __uint_as_float((k & 0x80000000u) ? (k ^ 0x80000000u) : ~k); }
#define CE_(x, y) do { const unsigned hi_ = max(x, y), lo_ = min(x, y); x = hi_; y = lo_; } while (0)
__device__ __forceinline__ unsigned row_pop16(unsigned (&a)[8], int i) {
    unsigned res = 0u;
#pragma unroll
    for (int r = 0; r < 16; ++r) { const unsigned m = rowmax_u32(a[0]); const bool win = a[0] == m;
#pragma unroll
        for (int s = 0; s < 7; ++s) a[s] = win ? a[s + 1] : a[s];
        a[7] = win ? 0u : a[7]; res = (i == r) ? m : res; }
    return res;
}
__device__ __forceinline__ void p9_topk(Frame& F, const Args& args) {
    const bf16* Q2 = WSP(bf16, WS_Q2); const bf16* SK = WSP(bf16, WS_SK); int* IDX = WSP(int, WS_IDX); float* GATE = WSP(float, WS_GATE);
    const int i = F.lane & 15, q = F.lane >> 4;
    const unsigned qlo = (unsigned)(i * 2048 + 8 * q) * 2u;
    const int h = (int)blockIdx.x & 7, ib = (int)blockIdx.x >> 3, nbh = ((int)F.G - h + 7) >> 3;
    for (int c = F.tid; c < 4096; c += NTHREADS) { const int pp = c >> 11, n = (c >> 4) & 127, ch = c & 15;
        *(LAS v4u*)(F.lds + pp * 32768 + n * 256 + ((ch * 16) ^ ((n & 7) << 4))) = *(const GAS v4u*)(SK + ((size_t)((h * 2 + pp) * 128 + n)) * 128 + ch * 8); }
    __syncthreads();
#pragma unroll 1
    for (int tg = ib * NWAVES + F.wave; tg < S / 16; tg += nbh * NWAVES) {
        const int t0 = 16 * tg;
        unsigned R[2][4];
        bf16x8 af[2][4];
#pragma unroll
        for (int p = 0; p < 2; ++p) { const char* qb_ = (const char*)Q2 + ((size_t)t0 * 2048 + h * 256 + p * 128) * 2;
#pragma unroll
            for (int ks = 0; ks < 4; ++ks) af[p][ks] = *(const GAS bf16x8*)(qb_ + 64 * ks + qlo); }
#pragma unroll
        for (int p = 0; p < 2; ++p) {
            f32x4 acc[8];
#pragma unroll
            for (int nt = 0; nt < 8; ++nt) { acc[nt] = (f32x4){0.f, 0.f, 0.f, 0.f}; const int n = 16 * nt + i;
#pragma unroll
                for (int ks = 0; ks < 4; ++ks) { const bf16x8 b = *(const LAS bf16x8*)(F.lds + p * 32768 + n * 256 + ((64 * ks + 16 * q) ^ ((n & 7) << 4)));
                    acc[nt] = __builtin_amdgcn_mfma_f32_16x16x32_bf16(af[p][ks], b, acc[nt], 0, 0, 0); } }
#pragma unroll
            for (int r = 0; r < 4; ++r) { unsigned a[8];
#pragma unroll
                for (int nt = 0; nt < 8; ++nt) a[nt] = (ordk(acc[nt][r]) & ~0x7Fu) | (unsigned)(16 * nt + i);
                CE_(a[0], a[1]); CE_(a[2], a[3]); CE_(a[4], a[5]); CE_(a[6], a[7]); CE_(a[0], a[2]); CE_(a[1], a[3]); CE_(a[4], a[6]); CE_(a[5], a[7]); CE_(a[1], a[2]); CE_(a[5], a[6]);
                CE_(a[0], a[4]); CE_(a[1], a[5]); CE_(a[2], a[6]); CE_(a[3], a[7]); CE_(a[2], a[4]); CE_(a[3], a[5]); CE_(a[1], a[2]); CE_(a[3], a[4]); CE_(a[5], a[6]);
                R[p][r] = row_pop16(a, i); __builtin_amdgcn_sched_barrier(0); }
        }
#pragma unroll
        for (int r = 0; r < 4; ++r) {
            const unsigned R0 = R[0][r], R1 = R[1][r]; const float f0 = deck(R0 & ~0x7Fu), f1 = deck(R1 & ~0x7Fu); const int n0 = (int)(R0 & 0x7Fu), n1 = (int)(R1 & 0x7Fu);
            const unsigned f1u = __float_as_uint(f1); unsigned c[8];
#define CAND_(b, lim) do { const unsigned t_ = (ordk(f0 + __uint_as_float(dppu<0x150 + (b)>(f1u))) & ~0xFFu) | (unsigned)(255 - (i * 16 + (b))); c[b] = (i < (lim)) ? t_ : 0u; } while (0)
            CAND_(0, 16); CAND_(1, 8); CAND_(2, 5); CAND_(3, 4); CAND_(4, 3); CAND_(5, 2); CAND_(6, 2); CAND_(7, 2);
#undef CAND_
            { const float ex = __uint_as_float(dppu<0x150>(__float_as_uint(f0))) + f1; const unsigned exk = (ordk(ex) & ~0xFFu) | (unsigned)(255 - i); c[1] = (i >= 8) ? exk : c[1]; }
            CE_(c[0], c[1]);
            const unsigned G = row_pop16(c, i);
            const float val = deck(G & ~0xFFu); const int id = 255 - (int)(G & 0xFFu); const int rb = F.lane & 48;
            const int ea = __shfl(n0, rb + (id >> 4)), eb = __shfl(n1, rb + (id & 15));
            const float mx = __uint_as_float(dppu<0x150>(__float_as_uint(val))); const float ex = __expf(val - mx); const float sm = rowsum_f32(ex);
            const size_t o = (size_t)(t0 + 4 * q + r) * 128 + h * 16 + i; IDX[o] = ea * 128 + eb; GATE[o] = ex / sm; __builtin_amdgcn_sched_barrier(0);
        }
    }
}
#undef CE_

constexpr float U_SCALE = 256.0f, V_SCALE = 1.0f;
#ifndef PEER_SORT
#define PEER_SORT 0
#endif
__device__ __forceinline__ float gelu_as(float v) {
    const float av = fabsf(v), tt = __builtin_amdgcn_rcpf(av * 0.2316418882f + 1.0f);
    float q = tt * 0.5307027145f + (-0.7265760135f); q = q * tt + 0.7107068705f; q = q * tt + (-0.142248368f); q = q * tt + 0.127414796f; q = q * tt;
    const float m = v * (q * __builtin_amdgcn_exp2f((v * v) * (-0.72134752044f)));
    return v < 0.f ? m : v - m;
}
#ifndef PEER_UMFMA
#define PEER_UMFMA 1
#endif
#ifndef HYP_A
#define HYP_A 1
#endif
#ifndef HYP_B
#define HYP_B 0
#endif
#ifndef PEER_VMFMA
#define PEER_VMFMA 1
#endif
typedef int v8i __attribute__((ext_vector_type(8)));
typedef int v2i __attribute__((ext_vector_type(2)));
typedef float f32x16 __attribute__((ext_vector_type(16)));
__device__ __forceinline__ float wave_sum_dpp(float x) {
    x = rowsum_f32(x);
    return (__uint_as_float(__builtin_amdgcn_readlane(__float_as_uint(x), 0)) + __uint_as_float(__builtin_amdgcn_readlane(__float_as_uint(x), 16)))
         + (__uint_as_float(__builtin_amdgcn_readlane(__float_as_uint(x), 32)) + __uint_as_float(__builtin_amdgcn_readlane(__float_as_uint(x), 48)));
}
#define LOADROWS(T, ra_, rb_, ee) do { const int e2_ = (ee) & 127; const int ea_ = __builtin_amdgcn_readlane(e2_ < 64 ? id0 : id1, e2_ & 63), eb_ = __builtin_amdgcn_readlane(e2_ < 64 ? id0 : id1, (e2_ + 1) & 63); \
        const GAS v4u* pa_ = (const GAS v4u*)((T) + (size_t)ea_ * DM) + F.lane; const GAS v4u* pb_ = (const GAS v4u*)((T) + (size_t)eb_ * DM) + F.lane; \
        _Pragma("unroll") for (int c = 0; c < 4; ++c) { ra_[c] = pa_[64 * c]; rb_[c] = pb_[64 * c]; } } while (0)
#define UDOT(r_, out_) do { f32x2 s0_ = {0.f, 0.f}, s1_ = {0.f, 0.f}, s2_ = {0.f, 0.f}, s3_ = {0.f, 0.f}; \
        _Pragma("unroll") for (int c = 0; c < 4; ++c) _Pragma("unroll") for (int d = 0; d < 2; ++d) { \
            const f32x2 p0_ = __builtin_amdgcn_cvt_scalef32_pk_f32_fp4(r_[c][d], 1.0f, 0), p1_ = __builtin_amdgcn_cvt_scalef32_pk_f32_fp4(r_[c][d], 1.0f, 1), \
                        p2_ = __builtin_amdgcn_cvt_scalef32_pk_f32_fp4(r_[c][d], 1.0f, 2), p3_ = __builtin_amdgcn_cvt_scalef32_pk_f32_fp4(r_[c][d], 1.0f, 3); \
            s0_ = p0_ * hx[8 * c + 4 * d] + s0_; s1_ = p1_ * hx[8 * c + 4 * d + 1] + s1_; s2_ = p2_ * hx[8 * c + 4 * d + 2] + s2_; s3_ = p3_ * hx[8 * c + 4 * d + 3] + s3_; } \
        out_ = ((s0_.x + s0_.y) + (s1_.x + s1_.y)) + ((s2_.x + s2_.y) + (s3_.x + s3_.y)); } while (0)
#define UPAIR(ra_, rb_, ee) do { float sa_, sb_; UDOT(ra_, sa_); UDOT(rb_, sb_); sa_ = wave_sum_dpp(sa_); sb_ = wave_sum_dpp(sb_); \
        const int e2_ = (ee); const int ea_ = __builtin_amdgcn_readlane(e2_ < 64 ? id0 : id1, e2_ & 63), eb_ = __builtin_amdgcn_readlane(e2_ < 64 ? id0 : id1, (e2_ + 1) & 63); \
        const f32x2 a2_ = pg8::gelu_pk((f32x2){sa_ * RSU[ea_], sb_ * RSU[eb_]}); \
        if ((ee) < 64) { if (F.lane == (ee)) w0 = a2_.x * g0; if (F.lane == (ee) + 1) w0 = a2_.y * g0; } else { if (F.lane == (ee) - 64) w1 = a2_.x * g1; if (F.lane == (ee) - 63) w1 = a2_.y * g1; } } while (0)
#define LOADROWS4(T, ra_, rb_, ee) do { const int e2_ = (ee) & 127; const int ea_ = __builtin_amdgcn_readlane(e2_ < 64 ? id0 : id1, e2_ & 63), eb_ = __builtin_amdgcn_readlane(e2_ < 64 ? id0 : id1, (e2_ + 1) & 63); \
        const GAS v2u* pa_ = (const GAS v2u*)((T) + (size_t)ea_ * 2048) + F.lane; const GAS v2u* pb_ = (const GAS v2u*)((T) + (size_t)eb_ * 2048) + F.lane; \
        _Pragma("unroll") for (int c = 0; c < 4; ++c) { ra_[c] = pa_[64 * c]; rb_[c] = pb_[64 * c]; } } while (0)
#define VAXPY(r_, w_) do { const f32x2 w2_ = {w_, w_}; \
        _Pragma("unroll") for (int c = 0; c < 4; ++c) _Pragma("unroll") for (int d = 0; d < 2; ++d) { \
            const f32x2 p0_ = __builtin_amdgcn_cvt_scalef32_pk_f32_fp4(r_[c][d], 1.0f, 0), p1_ = __builtin_amdgcn_cvt_scalef32_pk_f32_fp4(r_[c][d], 1.0f, 1), \
                        p2_ = __builtin_amdgcn_cvt_scalef32_pk_f32_fp4(r_[c][d], 1.0f, 2), p3_ = __builtin_amdgcn_cvt_scalef32_pk_f32_fp4(r_[c][d], 1.0f, 3); \
            acc[8 * c + 4 * d] = p0_ * w2_ + acc[8 * c + 4 * d]; acc[8 * c + 4 * d + 1] = p1_ * w2_ + acc[8 * c + 4 * d + 1]; \
            acc[8 * c + 4 * d + 2] = p2_ * w2_ + acc[8 * c + 4 * d + 2]; acc[8 * c + 4 * d + 3] = p3_ * w2_ + acc[8 * c + 4 * d + 3]; } } while (0)
#define VPAIR(ra_, rb_, ee) do { const int e2_ = (ee); const int ea_ = __builtin_amdgcn_readlane(e2_ < 64 ? id0 : id1, e2_ & 63), eb_ = __builtin_amdgcn_readlane(e2_ < 64 ? id0 : id1, (e2_ + 1) & 63); \
        const float wa_ = __uint_as_float(__builtin_amdgcn_readlane(__float_as_uint((ee) < 64 ? w0 : w1), (ee) & 63)) * RS[ea_], wb_ = __uint_as_float(__builtin_amdgcn_readlane(__float_as_uint((ee) < 64 ? w0 : w1), ((ee) + 1) & 63)) * RS[eb_]; \
        VAXPY(ra_, wa_); VAXPY(rb_, wb_); } while (0)
template <int MODE> __device__ __forceinline__ void p10_peer(Frame& F, const Args& args) {
    const int gw = F.vcu * NWAVES + F.wave, NGW = F.G * NWAVES; const float* MOD = WSP(float, WS_MOD);
    const bf16* H2 = WSP(bf16, WS_HA); const unsigned char* U = WSP(unsigned char, WS_U); const unsigned char* V = WSP(unsigned char, WS_V); const int* IDX = WSP(int, WS_IDX); const float* GATE = WSP(float, WS_GATE); const float* RS = WSP(float, WS_RS); const float* RSU = WSP(float, WS_RSU);
#if PEER_UMFMA
    if (F.lane < 8) *(LAS v4u*)(F.lds + F.wave * 18688 + 4096 + F.lane * 16) = (v4u){0u, 0u, 0u, 0u};
#endif
#pragma unroll 1
    for (int t = gw; t < S; t += NGW) {
        const int id0 = IDX[(size_t)t * 128 + F.lane], id1 = IDX[(size_t)t * 128 + 64 + F.lane];
        const float g0 = GATE[(size_t)t * 128 + F.lane], g1 = GATE[(size_t)t * 128 + 64 + F.lane];
        float w0 = 0.f, w1 = 0.f;
#if PEER_UMFMA
        if (MODE != 2) {
            LAS unsigned char* h8 = F.lds + F.wave * 18688; LAS unsigned char* stg = h8 + 4224;
            const float rstd = 1.0f / sqrtf(wave_sum_dpp(WSP(float, WS_SSQ)[(size_t)t * 64 + F.lane]) * (1.0f / DM) + EPS);
#pragma unroll
            for (int c = 0; c < 4; ++c) { const GAS v4u* hp = (const GAS v4u*)(H2 + (size_t)t * DM + c * 1024 + F.lane * 16); const v4u a = hp[0], b = hp[1]; v4u o;
                const GAS f32x4* sp = (const GAS f32x4*)(MOD + 12288 + c * 1024 + F.lane * 16); const f32x4 s0 = sp[0], s1 = sp[1], s2 = sp[2], s3 = sp[3];
                { int w = 0; w = __builtin_amdgcn_cvt_pk_fp8_f32(bflo(a[0]) * rstd + s0[0], bfhi(a[0]) * rstd + s0[1], w, false); w = __builtin_amdgcn_cvt_pk_fp8_f32(bflo(a[1]) * rstd + s0[2], bfhi(a[1]) * rstd + s0[3], w, true); o[0] = (unsigned)w; }
                { int w = 0; w = __builtin_amdgcn_cvt_pk_fp8_f32(bflo(a[2]) * rstd + s1[0], bfhi(a[2]) * rstd + s1[1], w, false); w = __builtin_amdgcn_cvt_pk_fp8_f32(bflo(a[3]) * rstd + s1[2], bfhi(a[3]) * rstd + s1[3], w, true); o[1] = (unsigned)w; }
                { int w = 0; w = __builtin_amdgcn_cvt_pk_fp8_f32(bflo(b[0]) * rstd + s2[0], bfhi(b[0]) * rstd + s2[1], w, false); w = __builtin_amdgcn_cvt_pk_fp8_f32(bflo(b[1]) * rstd + s2[2], bfhi(b[1]) * rstd + s2[3], w, true); o[2] = (unsigned)w; }
                { int w = 0; w = __builtin_amdgcn_cvt_pk_fp8_f32(bflo(b[2]) * rstd + s3[0], bfhi(b[2]) * rstd + s3[1], w, false); w = __builtin_amdgcn_cvt_pk_fp8_f32(bflo(b[3]) * rstd + s3[2], bfhi(b[3]) * rstd + s3[3], w, true); o[3] = (unsigned)w; }
                *(LAS v4u*)(h8 + c * 1024 + F.lane * 16) = o; }
            const int j = F.lane & 31, kh = F.lane >> 5, lr = F.lane >> 3, lp = F.lane & 7;
            unsigned so[4][4];
#pragma unroll
            for (int b = 0; b < 4; ++b)
#pragma unroll
                for (int i = 0; i < 4; ++i) so[b][i] = (unsigned)__shfl(b < 2 ? id0 : id1, 32 * (b & 1) + lr + 8 * i) * 2048u + (unsigned)lp * 16u;
            int eb[4];
#pragma unroll
            for (int b = 0; b < 4; ++b) eb[b] = __shfl(b < 2 ? id0 : id1, j + 32 * (b & 1));
            const unsigned aoff0 = (j == 0) ? (unsigned)(16 * kh) : 4096u, aoff1 = (j == 0) ? (unsigned)(32 + 16 * kh) : 4112u, astep = (j == 0) ? 64u : 0u;
            const unsigned wof = (unsigned)lr * 144u + (unsigned)lp * 16u, rof = (unsigned)j * 144u + (unsigned)kh * 16u;
            f32x16 ac[4];
#pragma unroll
            for (int b = 0; b < 4; ++b) ac[b] = (f32x16){};
            v4u R0[8], R1[8];
#define ULOAD(R_, kg_, bp_) do { _Pragma("unroll") for (int bb = 0; bb < 2; ++bb) _Pragma("unroll") for (int i = 0; i < 4; ++i) \
                R_[4 * bb + i] = *(const GAS v4u*)(U + (size_t)so[2 * (bp_) + bb][i] + (size_t)(kg_) * 128); } while (0)
#define USTAGE(R_, bp_) do { _Pragma("unroll") for (int bb = 0; bb < 2; ++bb) _Pragma("unroll") for (int i = 0; i < 4; ++i) *(LAS v4u*)(stg + bb * 4608 + i * 1152 + wof) = R_[4 * bb + i]; \
            _Pragma("unroll") for (int bb = 0; bb < 2; ++bb) { v4u B_[4]; _Pragma("unroll") for (int kk = 0; kk < 4; ++kk) B_[kk] = *(const LAS v4u*)(stg + bb * 4608 + rof + kk * 32); \
                _Pragma("unroll") for (int kk = 0; kk < 4; ++kk) ac[2 * (bp_) + bb] = __builtin_amdgcn_mfma_scale_f32_32x32x64_f8f6f4(A[kk], (v8i){(int)B_[kk][0], (int)B_[kk][1], (int)B_[kk][2], (int)B_[kk][3], 0, 0, 0, 0}, ac[2 * (bp_) + bb], 0, 4, 0, 0x7f7f7f7f, 0, 0x7f7f7f7f); } } while (0)
            ULOAD(R0, 0, 0);
#pragma unroll 1
            for (int kg = 0; kg < 16; ++kg) {
                v8i A[4];
#pragma unroll
                for (int kk = 0; kk < 4; ++kk) { const unsigned kb = (unsigned)(4 * kg + kk); const v4u x = *(const LAS v4u*)(h8 + aoff0 + kb * astep), y = *(const LAS v4u*)(h8 + aoff1 + kb * astep);
                    A[kk] = (v8i){(int)x[0], (int)x[1], (int)x[2], (int)x[3], (int)y[0], (int)y[1], (int)y[2], (int)y[3]}; }
                ULOAD(R1, kg, 1);
                USTAGE(R0, 0);
                ULOAD(R0, (kg + 1) & 15, 0);
                USTAGE(R1, 1);
            }
#undef ULOAD
#undef USTAGE
#pragma unroll
            for (int b = 0; b < 4; ++b) {
                const float av = pg8::gelu_pk((f32x2){ac[b][0] * RSU[eb[b]], 0.f}).x;
                const float gg = __shfl(b < 2 ? g0 : g1, j + 32 * (b & 1)); const float wv = av * gg;
                if ((b & 1) == 0) { if (b == 0) w0 = F.lane < 32 ? wv : w0; else w1 = F.lane < 32 ? wv : w1; }
                else { const float mv = __shfl(wv, j); if (b == 1) w0 = F.lane >= 32 ? mv : w0; else w1 = F.lane >= 32 ? mv : w1; } }
        }
#else
        {   f32x2 hx[32];
#pragma unroll
            for (int c = 0; c < 4; ++c) { const GAS v4u* hp = (const GAS v4u*)(H2 + (size_t)t * DM + c * 1024 + F.lane * 16); const v4u a = hp[0], b = hp[1];
#pragma unroll
                for (int k = 0; k < 4; ++k) { hx[8 * c + k] = (f32x2){bflo(a[k]), bfhi(a[k])}; hx[8 * c + 4 + k] = (f32x2){bflo(b[k]), bfhi(b[k])}; } }
            v2u ra[4], rb[4], rc[4], rd[4], na[4], nb[4], nc[4], nd[4];
            if (MODE != 2) {
            LOADROWS4(U, ra, rb, 0); LOADROWS4(U, rc, rd, 2);
#pragma unroll 1
            for (int e = 0; e < 128; e += 8) {
                LOADROWS4(U, na, nb, e + 4); LOADROWS4(U, nc, nd, e + 6);
                UPAIR(ra, rb, e); UPAIR(rc, rd, e + 2);
                LOADROWS4(U, ra, rb, e + 8); LOADROWS4(U, rc, rd, e + 10);
                UPAIR(na, nb, e + 4); UPAIR(nc, nd, e + 6);
            } } }
#endif
        if (MODE == 1 || MODE == 3) { asm volatile("" :: "v"(w0), "v"(w1)); continue; }
#if PEER_VMFMA
        {
            LAS unsigned char* wreg = F.lds + F.wave * 18688; LAS unsigned char* w8 = wreg; LAS unsigned char* stg = wreg + 256;
            const int j = F.lane & 31, kh = F.lane >> 5;
            { const float q0 = w0 * RS[id0] * 16.0f, q1 = w1 * RS[id1] * 16.0f;
              const int b0 = __builtin_amdgcn_cvt_pk_fp8_f32(q0, q0, 0, false), b1 = __builtin_amdgcn_cvt_pk_fp8_f32(q1, q1, 0, false);
              w8[F.lane] = (unsigned char)(b0 & 0xff); w8[64 + F.lane] = (unsigned char)(b1 & 0xff); if (F.lane < 8) *(LAS v2u*)(w8 + 128 + 8 * F.lane) = (v2u){0u, 0u}; }
            v8i A[2];
#pragma unroll
            for (int kb = 0; kb < 2; ++kb) { const unsigned o0 = (j == 0) ? (unsigned)(64 * kb + 16 * kh) : 128u, o1 = (j == 0) ? (unsigned)(64 * kb + 32 + 16 * kh) : 144u;
                const v4u x = *(const LAS v4u*)(w8 + o0), y = *(const LAS v4u*)(w8 + o1);
                A[kb] = (v8i){(int)x[0], (int)x[1], (int)x[2], (int)x[3], (int)y[0], (int)y[1], (int)y[2], (int)y[3]}; }
            const int lr = F.lane >> 3, lp = F.lane & 7;
            unsigned so[2][8];
#pragma unroll
            for (int kb = 0; kb < 2; ++kb)
#pragma unroll
                for (int i = 0; i < 8; ++i) so[kb][i] = (unsigned)__shfl(kb == 0 ? id0 : id1, 8 * i + lr) * 2048u + (unsigned)lp * 16u;
            const unsigned wof = (unsigned)lr * 144u + (unsigned)lp * 16u;
            const unsigned rof = (unsigned)(32 * kh + (F.lane & 15)) * 144u + (unsigned)(8 * ((F.lane >> 4) & 1));
            const float* X1r = WSP(float, WS_X1) + (size_t)t * DM; const float* G2 = MOD + 20480; float* Or = F.out + (size_t)t * DM;
            v4u R0[8], R1[8];
#define VLOAD(R_, cg_, kb_) do { _Pragma("unroll") for (int i = 0; i < 8; ++i) R_[i] = *(const GAS v4u*)(V + (size_t)so[kb_][i] + (size_t)(cg_) * 128); } while (0)
            VLOAD(R0, 0, 0); VLOAD(R1, 0, 1);
#pragma unroll 1
            for (int cg = 0; cg < 16; ++cg) {
#pragma unroll
                for (int i = 0; i < 8; ++i) { *(LAS v4u*)(stg + i * 1152 + wof) = R0[i]; *(LAS v4u*)(stg + 9216 + i * 1152 + wof) = R1[i]; }
                VLOAD(R0, (cg + 1) & 15, 0); VLOAD(R1, (cg + 1) & 15, 1);
#pragma unroll
                for (int tt = 0; tt < 8; ++tt) { f32x16 d_ = (f32x16){};
#pragma unroll
                    for (int kb = 0; kb < 2; ++kb) {
                        const v2i q0_ = __builtin_amdgcn_ds_read_tr4_b64_v2i32((LAS v2i*)(stg + kb * 9216 + rof + tt * 16)), q1_ = __builtin_amdgcn_ds_read_tr4_b64_v2i32((LAS v2i*)(stg + kb * 9216 + 2304 + rof + tt * 16));
                        d_ = __builtin_amdgcn_mfma_scale_f32_32x32x64_f8f6f4(A[kb], (v8i){q0_[0], q0_[1], q1_[0], q1_[1], 0, 0, 0, 0}, d_, 0, 4, 0, 0x7b7b7b7b, 0, 0x7f7f7f7f); }
                    if (MODE == 2) { asm volatile("" :: "v"(d_[0])); } else if (F.lane < 32) { const int col = cg * 256 + tt * 32 + F.lane; Or[col] = X1r[col] + G2[col] * d_[0]; } }
            }
#undef VLOAD
        }
#else
        f32x2 acc[32];
#pragma unroll
        for (int j = 0; j < 32; ++j) acc[j] = (f32x2){0.f, 0.f};
        {   v2u ra[4], rb[4], rc[4], rd[4], na[4], nb[4], nc[4], nd[4];
            LOADROWS4(V, ra, rb, 0); LOADROWS4(V, rc, rd, 2);
#pragma unroll 1
            for (int e = 0; e < 128; e += 8) {
                LOADROWS4(V, na, nb, e + 4); LOADROWS4(V, nc, nd, e + 6);
                VPAIR(ra, rb, e); VPAIR(rc, rd, e + 2);
                LOADROWS4(V, ra, rb, e + 8); LOADROWS4(V, rc, rd, e + 10);
                VPAIR(na, nb, e + 4); VPAIR(nc, nd, e + 6);
            } }
        if (MODE == 2) {
#pragma unroll
            for (int j = 0; j < 32; ++j) asm volatile("" :: "v"(acc[j]));
            continue; }
#pragma unroll
        for (int c = 0; c < 4; ++c) { const int col = c * 1024 + F.lane * 16; GAS f32x4* op = (GAS f32x4*)(F.out + (size_t)t * DM + col);
            const GAS f32x4* xp = (const GAS f32x4*)(WSP(float, WS_X1) + (size_t)t * DM + col); const GAS f32x4* gp = (const GAS f32x4*)(MOD + 20480 + col);
#pragma unroll
            for (int q = 0; q < 4; ++q) op[q] = xp[q] + gp[q] * (f32x4){acc[8 * c + 2 * q].x, acc[8 * c + 2 * q].y, acc[8 * c + 2 * q + 1].x, acc[8 * c + 2 * q + 1].y}; }
#endif
    }
}
#undef LOADROWS
#undef UDOT
#undef UPAIR
#undef VAXPY
#undef VPAIR
#undef LOADROWS4
#ifndef MK_SINGLE
#define MK_SINGLE 1
#endif
constexpr int N_PHASES = 11;
__global__ void __launch_bounds__(NTHREADS, 2) fwd_kernel(Args args) {
    extern __shared__ __attribute__((aligned(16))) unsigned char lds[];
    Frame F;
    F.lds = (LAS unsigned char*)lds; F.MISC = (volatile LAS unsigned*)(F.lds + MISC_OFF);
    F.tid = threadIdx.x; F.lane = F.tid & 63; F.wave = __builtin_amdgcn_readfirstlane(F.tid >> 6);
    F.G = gridDim.x; { const int bx = blockIdx.x; F.vcu = (F.G % 8 == 0) ? (bx % 8) * (F.G / 8) + bx / 8 : bx; }
    F.ws = args.ws; F.out = args.out; F.ctl = (gu32*)(args.ws + WS_CTL);
    for (int u = F.tid; u < (LDS_BYTES - LDSCTL_OFF) / 4; u += NTHREADS) ((LAS unsigned*)(F.lds + LDSCTL_OFF))[u] = 0u;
    __syncthreads();
    const int lo = args.ph_lo, hi = args.ph_hi;
    XcdBarrier bar; bar.bar = (unsigned*)(F.ctl + CW_BAR); bar.x = 0; bar.st = nullptr;
    if (hi - lo > 1) bar = xcd_barrier_post((unsigned*)(F.ctl + CW_BAR), F.MISC + 8);
#ifndef PH_MASK
#define PH_MASK 0x7ff
#endif
#define IN(k) (((PH_MASK >> (k)) & 1) && lo <= (k) && (k) < hi)
#define SEAM(k) do { if (IN(k) && IN((k) + 1)) xcd_barrier(bar); } while (0)
#ifndef G_ALIGN
#define G_ALIGN true
#endif
#ifndef G_SP2
#define G_SP2 true
#endif
#ifndef REP_PHASE
#define REP_PHASE -1
#endif
#define REPEAT(k) _Pragma("unroll") for (int rep = 0; rep < ((REP_PHASE) == (k) ? 2 : 1); ++rep)
#define REPBAR(k) do { if ((REP_PHASE) == (k) && rep == 0) xcd_barrier(bar); } while (0)
    const int bid = (int)blockIdx.x;
    if (IN(0)) { REPEAT(0) { p0_prologue(F, args); REPBAR(0); } SEAM(0); }
    if (IN(1)) { REPEAT(1) { p1_norm_forget(F, args); p1_shift_proj(F, args); REPBAR(1); } SEAM(1); }
    if (IN(2)) { REPEAT(2) {
        pg8::Gemm g{WSP(bf16, WS_HA), WSP(bf16, WS_WIN), S, NINP, DM}; pg8::StaticOrder So; So.init(S, NINP, F.G, bid);
        pg8::EpiIn E{WSP(bf16, WS_QKV), WSP(bf16, WS_LX), WSP(bf16, WS_GY), WSP(bf16, WS_GA), WSP(bf16, WS_GL), WSP(float, WS_BIASR)};
        pg8::gemm_phase<pg8::EpiIn, pg8::StaticOrder, G_ALIGN, G_SP2>(F.lds, g, So, E);
        REPBAR(2); }
        SEAM(2);
    }
    if (IN(3)) {
        p3_qknorm(F, args);
        __syncthreads();
        REPEAT(3) {
        p3_cumsum(F, args);
        for (int w = bid; w < 256; w += F.G) lru_item<0>(F, args, w);
        REPBAR(3); }
        SEAM(3);
    }
    if (IN(4)) {
#pragma unroll 1
        for (int rep = 0; rep < args.rep_att; ++rep) p4_attention(F, args, (char*)lds, rep);
#pragma unroll 1
        for (int rep = 0; rep < args.rep_lru; ++rep)
        for (int w = bid; w < 256; w += F.G) lru_item<1>(F, args, w);
        SEAM(4);
    }
    if (IN(5)) { REPEAT(5) {
        { pg8::Gemm g{WSP(bf16, WS_ATT), WSP(bf16, WS_WAO), S, DM, AW}; pg8::StaticOrder So; So.init(S, DM, F.G, bid);
          pg8::EpiGate<0> E{WSP(bf16, WS_T1), WSP(bf16, WS_GA), DM};
          pg8::gemm_phase<pg8::EpiGate<0>, pg8::StaticOrder, true, true>(F.lds, g, So, E); }
        { pg8::Gemm g{WSP(bf16, WS_LR), WSP(bf16, WS_WLO), S, DM, LW}; pg8::StaticOrder So; So.init(S, DM, F.G, bid);
          pg8::EpiGate<1> E{WSP(bf16, WS_T1), WSP(bf16, WS_GL), DM};
          pg8::gemm_phase<pg8::EpiGate<1>, pg8::StaticOrder, true, true>(F.lds, g, So, E); }
        REPBAR(5); }
        SEAM(5);
    }
    if (IN(6)) { REPEAT(6) {
        pg8::Gemm g{WSP(bf16, WS_T1), WSP(bf16, WS_WOUT), S, DM, DM}; pg8::StaticOrder So; So.init(S, DM, F.G, bid);
        pg8::EpiRes E{args.in[0], WSP(float, WS_X1), WSP(float, WS_MOD) + 8192, DM, args.in[5], WSP(float, WS_MOD) + 16384, WSP(bf16, WS_HA), WSP(float, WS_SSQ)};
        pg8::gemm_phase<pg8::EpiRes, pg8::StaticOrder, true, true>(F.lds, g, So, E);
        REPBAR(6); }
        SEAM(6);
    }
    if (IN(8)) { REPEAT(8) {
        pg8::Gemm g{WSP(bf16, WS_HA), WSP(bf16, WS_WPQ), S, 2048, DM}; pg8::RstdOrder So; So.init(S, 2048, F.G, bid);
        So.SSQ = WSP(float, WS_SSQ); So.rs = (LAS float*)(F.lds + 133120); So.inv_n = 1.0f / DM; So.eps = EPS; So.na = 0;
        pg8::EpiQ2 E{WSP(bf16, WS_Q2), 2048, WSP(float, WS_SB), (const LAS float*)(F.lds + 133120), 0};
        pg8::gemm_phase<pg8::EpiQ2, pg8::RstdOrder, true, true>(F.lds, g, So, E);
        REPBAR(8); }
        SEAM(8);
    }
    if (IN(9)) { REPEAT(9) { p9_topk(F, args); REPBAR(9); } SEAM(9); }
#ifndef P10_PROBE
#define P10_PROBE 0
#endif
    if (IN(10)) { if (P10_PROBE) { p10_peer<P10_PROBE>(F, args); xcd_barrier(bar); } REPEAT(10) { p10_peer<0>(F, args); REPBAR(10); } }
#undef IN
#undef SEAM
}

extern "C" void kernel_launch(void* const* d_in, const int* in_sizes, int n_in, void* d_out, int out_size, void* d_ws, size_t ws_size, hipStream_t stream) {
    static int grid = 0;
    if (grid == 0) {
        if (n_in != 24 || in_sizes[0] != S * DM || out_size != S * DM || ws_size < WS_END) { fprintf(stderr, "kernel_launch: unexpected shapes (n_in %d, in0 %d, out %d, ws %zu)\n", n_in, n_in > 0 ? in_sizes[0] : -1, out_size, ws_size); grid = -1; return; }
        int dev = 0, cus = 0, per_cu = 0;
        if (hipGetDevice(&dev) != hipSuccess || hipDeviceGetAttribute(&cus, hipDeviceAttributeMultiprocessorCount, dev) != hipSuccess) { grid = -1; return; }
        if (hipFuncSetAttribute((const void*)fwd_kernel, hipFuncAttributeMaxDynamicSharedMemorySize, LDS_BYTES) != hipSuccess) { fprintf(stderr, "kernel_launch: hipFuncSetAttribute failed\n"); grid = -1; return; }
        if (hipOccupancyMaxActiveBlocksPerMultiprocessor(&per_cu, (const void*)fwd_kernel, NTHREADS, LDS_BYTES) != hipSuccess || per_cu < 1) fprintf(stderr, "kernel_launch: occupancy query reports %d blocks per CU\n", per_cu);
        (void)hipGetLastError();
        grid = cus;
    }
    if (grid < 0) return;
    if (hipMemsetAsync((char*)d_ws + WS_CTL, 0, CTL_ZERO_BYTES, stream) != hipSuccess) return;
    Args a{};
    for (int i = 0; i < 24; ++i) a.in[i] = (const float*)d_in[i];
    a.out = (float*)d_out; a.ws = (unsigned char*)d_ws;
#ifndef REP_ATT
#define REP_ATT 1
#endif
#ifndef REP_LRU
#define REP_LRU 1
#endif
    a.rep_att = REP_ATT; a.rep_lru = REP_LRU;
#if MK_SINGLE
    a.ph_lo = 0; a.ph_hi = N_PHASES;
    hipLaunchKernelGGL(fwd_kernel, dim3(grid), dim3(NTHREADS), LDS_BYTES, stream, a);
#else
    for (int p = 0; p < N_PHASES; ++p) { a.ph_lo = p; a.ph_hi = p + 1; hipLaunchKernelGGL(fwd_kernel, dim3(grid), dim3(NTHREADS), LDS_BYTES, stream, a); }
#endif
}
```

```cpp
#define REP_PHASE -1
#include <hip/hip_runtime.h>
#include <cstdio>
#include <cstdint>
namespace pg8 {
#define PG8_LAS __attribute__((address_space(3)))
typedef unsigned short bf16_t;
typedef short bf16x8 __attribute__((ext_vector_type(8)));
typedef float f32x4 __attribute__((ext_vector_type(4)));
typedef unsigned u32x4 __attribute__((ext_vector_type(4)));
constexpr int BM = 256, BK = 64, HALF = 128, HTB = HALF * BK * 2  , STAGE_BYTES = 8 * HTB, NXCD = 8, WGM = 8;

__host__ __device__ __forceinline__ int lds_byte(int r, int c) { const int st = (r >> 4) * 2 + (c >> 5), rr = r & 15, cc = c & 31, ob = rr * 64 + cc * 2; return st * 1024 + (ob ^ (((ob >> 9) & 1) << 5)); }
__host__ __device__ __forceinline__ void stage_rc(int b, int& R, int& C) { const int st = b / 1024, sb = b % 1024, swz = sb ^ (((sb >> 9) & 1) << 5); R = (st >> 1) * 16 + swz / 64; C = (st & 1) * 32 + (swz % 64) / 2; }
__host__ __device__ __forceinline__ int perm32(int rho) { const int n = rho >> 4, i = rho & 15; return 8 * (i >> 2) + 4 * n + (i & 3); }

struct Unit { int pm, pn; };
struct Gemm { const bf16_t* A; const bf16_t* Bt; int M, N, K; };

struct StaticOrder {
    int nM, nN, nwg, G, c;
    __host__ __device__ void init(int M, int N, int G_, int c_) { nM = M / BM; nN = N / BM; nwg = nM * nN; G = G_; c = c_; }
    __host__ __device__ bool next(int i, Unit& u) const {
        const long L = (long)i * G + c; if (L >= nwg) return false;
        int wgid = (int)L; { const int q = nwg / NXCD, r = nwg % NXCD, xcd = wgid % NXCD, off = wgid / NXCD; wgid = (xcd < r ? xcd * (q + 1) : r * (q + 1) + (xcd - r) * q) + off; }
        const int nig = WGM * nN, gid = wgid / nig, fm = gid * WGM, gsz = (nM - fm) < WGM ? (nM - fm) : WGM;
        u.pm = fm + ((wgid % nig) % gsz); u.pn = (wgid % nig) / gsz; return true;
    }
    __device__ __forceinline__ void a_ready(const Unit&) const {}
    __device__ __forceinline__ void done(const Unit&) const {}
};

__device__ __forceinline__ unsigned cvt_pk_bf16(float lo, float hi) { unsigned r; asm volatile("v_cvt_pk_bf16_f32 %0, %1, %2" : "=v"(r) : "v"(lo), "v"(hi)); return r; }
typedef float f32x2 __attribute__((ext_vector_type(2)));
__device__ __forceinline__ f32x2 gelu_pk(f32x2 v) {
    const f32x2 av = __builtin_elementwise_abs(v), d = av * 0.2316418882f + 1.0f;
    f32x2 t; t.x = __builtin_amdgcn_rcpf(d.x); t.y = __builtin_amdgcn_rcpf(d.y);
    f32x2 q = t * 0.5307027145f + (-0.7265760135f); q = q * t + 0.7107068705f; q = q * t + (-0.142248368f); q = q * t + 0.127414796f; q = q * t;
    const f32x2 s = (v * v) * (-0.72134752044f);
    f32x2 e; e.x = __builtin_amdgcn_exp2f(s.x); e.y = __builtin_amdgcn_exp2f(s.y);
    const f32x2 m = v * (q * e), r = v - m;
    f32x2 o; o.x = v.x < 0.f ? m.x : r.x; o.y = v.y < 0.f ? m.y : r.y; return o;
}

template <int ACT  > struct EpiBf16 {
    static constexpr bool PERM = true, AFTER_DRAIN = false; static_assert(ACT == 0 || ACT == 1, "EpiBf16: ACT is 0 (none) or 1 (gelu_pk)");
    bf16_t* O; int ldc; const float* bias; int split_cols; size_t split_stride; float scale0;
    __device__ __forceinline__ void operator()(const f32x4 (&acc)[2][2][4][2], const Unit& u, int wr, int wc, int fr, int fq) const {
        const int row0 = u.pm * BM + wr * 64 + fr; int colt = u.pn * BM; bf16_t* base = O;
        float sc = 1.f; if (split_cols) { const int t = colt / split_cols; base += (size_t)t * split_stride; colt -= t * split_cols; if (t == 0) sc = scale0; }
        const int col0 = colt + wc * 32 + 8 * fq, bcol0 = u.pn * BM + wc * 32 + 8 * fq;
        f32x4 bv[2][2];
#pragma unroll
        for (int bj = 0; bj < 2; ++bj)
#pragma unroll
            for (int n = 0; n < 2; ++n) bv[bj][n] = bias ? *(const f32x4*)(bias + bcol0 + bj * HALF + 4 * n) : (f32x4){0.f, 0.f, 0.f, 0.f};
#pragma unroll
        for (int ai = 0; ai < 2; ++ai)
#pragma unroll
            for (int m = 0; m < 4; ++m) { bf16_t* rowp = base + (size_t)(row0 + ai * HALF + m * 16) * ldc + col0;
#pragma unroll
                for (int bj = 0; bj < 2; ++bj) { f32x4 v0 = acc[ai][bj][m][0] + bv[bj][0], v1 = acc[ai][bj][m][1] + bv[bj][1];
                    if (ACT == 1) { f32x2 a = gelu_pk((f32x2){v0[0], v0[1]}), b = gelu_pk((f32x2){v0[2], v0[3]}), c = gelu_pk((f32x2){v1[0], v1[1]}), d = gelu_pk((f32x2){v1[2], v1[3]});
                        v0 = (f32x4){a.x, a.y, b.x, b.y}; v1 = (f32x4){c.x, c.y, d.x, d.y}; }
                    v0 = v0 * sc; v1 = v1 * sc; u32x4 w; w.x = cvt_pk_bf16(v0[0], v0[1]); w.y = cvt_pk_bf16(v0[2], v0[3]); w.z = cvt_pk_bf16(v1[0], v1[1]); w.w = cvt_pk_bf16(v1[2], v1[3]);
                    *(u32x4*)(rowp + bj * HALF) = w; } }
    }
};
__device__ __forceinline__ f32x4 sigm4(f32x4 v) { f32x4 o;
#pragma unroll
    for (int j = 0; j < 4; ++j) o[j] = __builtin_amdgcn_rcpf(1.0f + __builtin_amdgcn_exp2f(-1.4426950408889634f * v[j]));
    return o; }
__device__ __forceinline__ f32x4 gelu4(f32x4 v) { const f32x2 a = gelu_pk((f32x2){v[0], v[1]}), b = gelu_pk((f32x2){v[2], v[3]}); return (f32x4){a.x, a.y, b.x, b.y}; }
__device__ __forceinline__ void unpack8(const u32x4 w, f32x4& lo, f32x4& hi) {
    lo = (f32x4){__uint_as_float(w.x << 16), __uint_as_float(w.x & 0xffff0000u), __uint_as_float(w.y << 16), __uint_as_float(w.y & 0xffff0000u)};
    hi = (f32x4){__uint_as_float(w.z << 16), __uint_as_float(w.z & 0xffff0000u), __uint_as_float(w.w << 16), __uint_as_float(w.w & 0xffff0000u)}; }
struct EpiIn {
    static constexpr bool PERM = true, AFTER_DRAIN = false;
    bf16_t* qkv; bf16_t* lx; bf16_t* gy; bf16_t* ga; bf16_t* gl; const float* bias;
    __device__ __forceinline__ void operator()(const f32x4 (&acc)[2][2][4][2], const Unit& u, int wr, int wc, int fr, int fq) const {
        const int pn = u.pn; bf16_t* base; int ldc, colt, act;
        if (pn < 24) { base = qkv + (size_t)(pn >> 3) * ((size_t)8192 * 2048); ldc = 2048; colt = (pn & 7) * 256; act = 0; }
        else if (pn < 32) { base = lx; ldc = 2048; colt = (pn - 24) * 256; act = 0; }
        else if (pn < 40) { base = gy; ldc = 2048; colt = (pn - 32) * 256; act = 1; }
        else if (pn < 56) { base = ga; ldc = 4096; colt = (pn - 40) * 256; act = 2; }
        else { base = gl; ldc = 4096; colt = (pn - 56) * 256; act = 2; }
        const int row0 = u.pm * BM + wr * 64 + fr, col0 = colt + wc * 32 + 8 * fq, bcol0 = pn * BM + wc * 32 + 8 * fq;
        f32x4 bv[2][2];
#pragma unroll
        for (int bj = 0; bj < 2; ++bj)
#pragma unroll
            for (int n = 0; n < 2; ++n) bv[bj][n] = *(const f32x4*)(bias + bcol0 + bj * HALF + 4 * n);
#pragma unroll
        for (int ai = 0; ai < 2; ++ai)
#pragma unroll
            for (int m = 0; m < 4; ++m) { bf16_t* rowp = base + (size_t)(row0 + ai * HALF + m * 16) * ldc + col0;
#pragma unroll
                for (int bj = 0; bj < 2; ++bj) { f32x4 v0 = acc[ai][bj][m][0] + bv[bj][0], v1 = acc[ai][bj][m][1] + bv[bj][1];
                    if (act == 1) { v0 = gelu4(v0); v1 = gelu4(v1); }
                    else if (act == 2) { v0 = sigm4(v0); v1 = sigm4(v1); }
                    u32x4 w; w.x = cvt_pk_bf16(v0[0], v0[1]); w.y = cvt_pk_bf16(v0[2], v0[3]); w.z = cvt_pk_bf16(v1[0], v1[1]); w.w = cvt_pk_bf16(v1[2], v1[3]);
                    *(u32x4*)(rowp + bj * HALF) = w; } }
    }
};
template <int MODE> struct EpiGate {
    static constexpr bool PERM = true, AFTER_DRAIN = false;
    bf16_t* O; const bf16_t* Gt; int ldc;
    __device__ __forceinline__ void operator()(const f32x4 (&acc)[2][2][4][2], const Unit& u, int wr, int wc, int fr, int fq) const {
        const int row0 = u.pm * BM + wr * 64 + fr, col0 = u.pn * BM + wc * 32 + 8 * fq;
#pragma unroll
        for (int ai = 0; ai < 2; ++ai)
#pragma unroll
            for (int m = 0; m < 4; ++m) { const size_t off = (size_t)(row0 + ai * HALF + m * 16) * ldc + col0;
#pragma unroll
                for (int bj = 0; bj < 2; ++bj) { f32x4 g0, g1; unpack8(*(const u32x4*)(Gt + off + bj * HALF), g0, g1);
                    f32x4 v0 = acc[ai][bj][m][0] * g0, v1 = acc[ai][bj][m][1] * g1;
                    if (MODE == 1) { f32x4 t0, t1; unpack8(*(const u32x4*)(O + off + bj * HALF), t0, t1); v0 += t0; v1 += t1; }
                    u32x4 w; w.x = cvt_pk_bf16(v0[0], v0[1]); w.y = cvt_pk_bf16(v0[2], v0[3]); w.z = cvt_pk_bf16(v1[0], v1[1]); w.w = cvt_pk_bf16(v1[2], v1[3]);
                    *(u32x4*)(O + off + bj * HALF) = w; } }
    }
};
struct EpiRes {
    static constexpr bool PERM = false, AFTER_DRAIN = false;
    const float* X; bf16_t* Out; const float* gate; int ldc; const float* g2a; const float* g2b; bf16_t* XG; float* SSQ;
    __device__ __forceinline__ void operator()(const f32x4 (&acc)[2][2][4][2], const Unit& u, int wr, int wc, int fr, int fq) const {
        const int row0 = u.pm * BM + wr * 64 + fr, col0 = u.pn * BM + wc * 32 + 4 * fq;
        f32x4 gv[2][2], gp[2][2];
#pragma unroll
        for (int bj = 0; bj < 2; ++bj)
#pragma unroll
            for (int n = 0; n < 2; ++n) { gv[bj][n] = *(const f32x4*)(gate + col0 + bj * HALF + n * 16);
                gp[bj][n] = *(const f32x4*)(g2a + col0 + bj * HALF + n * 16) * (*(const f32x4*)(g2b + col0 + bj * HALF + n * 16) + 1.0f); }
#pragma unroll
        for (int ai = 0; ai < 2; ++ai)
#pragma unroll
            for (int m = 0; m < 4; ++m) { const int row = row0 + ai * HALF + m * 16; const size_t off = (size_t)row * ldc + col0; float ss = 0.f;
#pragma unroll
                for (int bj = 0; bj < 2; ++bj)
#pragma unroll
                    for (int n = 0; n < 2; ++n) { const f32x4 xv = *(const f32x4*)(X + off + bj * HALF + n * 16);
                        const f32x4 x1 = xv + gv[bj][n] * acc[ai][bj][m][n]; typedef unsigned u32x2_ __attribute__((ext_vector_type(2)));
                        { u32x2_ wx; wx.x = cvt_pk_bf16(x1[0], x1[1]); wx.y = cvt_pk_bf16(x1[2], x1[3]); *(u32x2_*)(Out + off + bj * HALF + n * 16) = wx; }
                        ss += (x1[0] * x1[0] + x1[1] * x1[1]) + (x1[2] * x1[2] + x1[3] * x1[3]);
                        const f32x4 xg = x1 * gp[bj][n];
                        u32x2_ w; w.x = cvt_pk_bf16(xg[0], xg[1]); w.y = cvt_pk_bf16(xg[2], xg[3]); *(u32x2_*)(XG + off + bj * HALF + n * 16) = w; }
                ss += __shfl_xor(ss, 16); ss += __shfl_xor(ss, 32);
                if (fq == 0) SSQ[(size_t)row * 64 + u.pn * 4 + wc] = ss; }
    }
};
struct EpiQ2 {
    static constexpr bool PERM = true, AFTER_DRAIN = false;
    bf16_t* O; int ldc; const float* sb; const PG8_LAS float* rs; mutable int ne;
    __device__ __forceinline__ void operator()(const f32x4 (&acc)[2][2][4][2], const Unit& u, int wr, int wc, int fr, int fq) const {
        const int rl0 = wr * 64 + fr, row0 = u.pm * BM + rl0, col0 = u.pn * BM + wc * 32 + 8 * fq; const PG8_LAS float* rsp = rs + ((ne++) & 1) * 256;
        f32x4 bv[2][2];
#pragma unroll
        for (int bj = 0; bj < 2; ++bj)
#pragma unroll
            for (int n = 0; n < 2; ++n) bv[bj][n] = *(const f32x4*)(sb + col0 + bj * HALF + 4 * n);
#pragma unroll
        for (int ai = 0; ai < 2; ++ai)
#pragma unroll
            for (int m = 0; m < 4; ++m) { const float r = rsp[rl0 + ai * HALF + m * 16]; bf16_t* rowp = O + (size_t)(row0 + ai * HALF + m * 16) * ldc + col0;
#pragma unroll
                for (int bj = 0; bj < 2; ++bj) { const f32x4 v0 = acc[ai][bj][m][0] * r + bv[bj][0], v1 = acc[ai][bj][m][1] * r + bv[bj][1];
                    u32x4 w; w.x = cvt_pk_bf16(v0[0], v0[1]); w.y = cvt_pk_bf16(v0[2], v0[3]); w.z = cvt_pk_bf16(v1[0], v1[1]); w.w = cvt_pk_bf16(v1[2], v1[3]);
                    *(u32x4*)(rowp + bj * HALF) = w; } }
    }
};
struct RstdOrder : StaticOrder {
    const float* SSQ; PG8_LAS float* rs; float inv_n, eps; mutable int na;
    __device__ __forceinline__ void a_ready(const Unit& u) const {
        const int tid = threadIdx.x, r = tid >> 1, hf = tid & 1; const f32x4* p = (const f32x4*)(SSQ + (size_t)(u.pm * BM + r) * 64 + hf * 32); float s = 0.f;
#pragma unroll
        for (int k = 0; k < 8; ++k) { const f32x4 v = p[k]; s += (v[0] + v[1]) + (v[2] + v[3]); }
        s += __shfl_xor(s, 1);
        if (hf == 0) rs[(na & 1) * 256 + r] = 1.0f / sqrtf(s * inv_n + eps);
        ++na;
    }
};
template <class Epi, class Sched, bool ALIGN_EPI = false, bool SP2 = false>
__device__ __forceinline__ void gemm_phase(PG8_LAS unsigned char* lds, const Gemm g, const Sched& S, const Epi& E) {
    const int tid = threadIdx.x, wid = __builtin_amdgcn_readfirstlane(tid >> 6), lane = tid & 63, wr = wid >> 2, wc = wid & 3, fr = lane & 15, fq = lane >> 4;
    const int K = g.K, nt = K / BK;
    unsigned voffA[2], voffB[2];
#pragma unroll
    for (int i = 0; i < 2; ++i) { int R, C; stage_rc(tid * 16 + i * 8192, R, C); const int Rb = Epi::PERM ? ((R & ~31) + perm32(R & 31)) : R;
        voffA[i] = (unsigned)(R * K + C) * 2u; voffB[i] = (unsigned)(Rb * K + C) * 2u; }
    const size_t kstep = (size_t)(BK * 2);
    const size_t hstep = (size_t)HALF * K * 2;
    const size_t tstep = 2 * hstep;
    const unsigned ldsw = (unsigned)wid * 1024u;
    const int aoff = lds_byte(wr * 64 + fr, fq * 8), boff = lds_byte(wc * 32 + fr, fq * 8);
#define PG8_SA(b, h) (((b) * 2 + (h)) * HTB)
#define PG8_SB(b, h) ((4 + (b) * 2 + (h)) * HTB)
#define PG8_STAGE(bufoff, gbase, voff) do { _Pragma("unroll") for (int _i = 0; _i < 2; ++_i) \
        __builtin_amdgcn_global_load_lds((const unsigned*)((const char*)(gbase) + (voff)[_i]), (PG8_LAS unsigned*)(lds + (bufoff) + ldsw + _i * 8192), 16, 0, 0); } while (0)
#define PG8_LDA(dst, b, h) do { _Pragma("unroll") for (int m = 0; m < 4; ++m) _Pragma("unroll") for (int k = 0; k < 2; ++k) dst[m][k] = *(const PG8_LAS bf16x8*)(lds + PG8_SA(b, h) + aoff + m * 2048 + k * 1024); } while (0)
#define PG8_LDB(dst, b, h) do { _Pragma("unroll") for (int n = 0; n < 2; ++n) _Pragma("unroll") for (int k = 0; k < 2; ++k) dst[n][k] = *(const PG8_LAS bf16x8*)(lds + PG8_SB(b, h) + boff + n * 2048 + k * 1024); } while (0)
#define PG8_MMA(ai, bj, At, Bt) do { __builtin_amdgcn_s_setprio(1); _Pragma("unroll") for (int m = 0; m < 4; ++m) _Pragma("unroll") for (int n = 0; n < 2; ++n) _Pragma("unroll") for (int k = 0; k < 2; ++k) \
        acc[ai][bj][m][n] = __builtin_amdgcn_mfma_f32_16x16x32_bf16(Bt[n][k], At[m][k], acc[ai][bj][m][n], 0, 0, 0); __builtin_amdgcn_s_setprio(0); } while (0)
#define PG8_WAIT_V(n) asm volatile("s_waitcnt vmcnt(" #n ")" ::: "memory")
#define PG8_WAIT_L(n) asm volatile("s_waitcnt lgkmcnt(" #n ")" ::: "memory")
#define PG8_BAR __builtin_amdgcn_s_barrier()
#define PG8_SCHED __builtin_amdgcn_sched_barrier(0)
    Unit cur, nxt; int ui = 0;
    if (!S.next(0, cur)) return;
    f32x4 acc[2][2][4][2];
#pragma unroll
    for (int a = 0; a < 2; ++a)
#pragma unroll
        for (int b = 0; b < 2; ++b)
#pragma unroll
            for (int m = 0; m < 4; ++m)
#pragma unroll
                for (int n = 0; n < 2; ++n) acc[a][b][m][n] = (f32x4){0.f, 0.f, 0.f, 0.f};
    bf16x8 At[4][2], B0[2][2], B1[2][2];
    const char* cA = (const char*)g.A + (size_t)cur.pm * tstep; const char* cB = (const char*)g.Bt + (size_t)cur.pn * tstep;
    S.a_ready(cur);
    if constexpr (SP2) {
        PG8_STAGE(PG8_SB(0, 0), cB, voffB); PG8_STAGE(PG8_SB(0, 1), cB + hstep, voffB); PG8_STAGE(PG8_SA(0, 0), cA, voffA); PG8_STAGE(PG8_SA(0, 1), cA + hstep, voffA);
        if (wr == 1) PG8_BAR;
        PG8_WAIT_V(2); PG8_BAR;
        PG8_STAGE(PG8_SB(1, 0), cB + kstep, voffB); PG8_STAGE(PG8_SA(1, 0), cA + kstep, voffA); PG8_STAGE(PG8_SB(1, 1), cB + hstep + kstep, voffB);
        PG8_WAIT_V(6); PG8_BAR;
    } else {
        PG8_STAGE(PG8_SB(0, 0), cB, voffB); PG8_STAGE(PG8_SA(0, 0), cA, voffA); PG8_STAGE(PG8_SB(0, 1), cB + hstep, voffB); PG8_STAGE(PG8_SA(0, 1), cA + hstep, voffA);
        if (wr == 1) PG8_BAR;
        PG8_WAIT_V(4); PG8_BAR;
        PG8_STAGE(PG8_SB(1, 0), cB + kstep, voffB); PG8_STAGE(PG8_SA(1, 0), cA + kstep, voffA); PG8_STAGE(PG8_SB(1, 1), cB + hstep + kstep, voffB);
        PG8_WAIT_V(6); PG8_BAR;
    }
    for (;;) {
        const bool has_next = S.next(ui + 1, nxt);
        const char* nA = has_next ? (const char*)g.A + (size_t)nxt.pm * tstep : cA; const char* nB = has_next ? (const char*)g.Bt + (size_t)nxt.pn * tstep : cB;
        for (int t = 0; t < nt; t += 2) {
            const bool last = (t == nt - 2);
            const char* a1 = cA + (size_t)(t + 1) * kstep;
            const char* a2 = last ? nA : cA + (size_t)(t + 2) * kstep; const char* b2 = last ? nB : cB + (size_t)(t + 2) * kstep;
            const char* a3 = a2 + kstep; const char* b3 = b2 + kstep;
            if (last && has_next) S.a_ready(nxt);
            if constexpr (SP2) {
            PG8_LDB(B0, 0, 0); PG8_LDB(B1, 0, 1); PG8_SCHED; PG8_LDA(At, 0, 0); PG8_STAGE(PG8_SA(1, 1), a1 + hstep, voffA);
            PG8_WAIT_V(8); PG8_WAIT_L(0); PG8_BAR; PG8_MMA(0, 0, At, B0); PG8_MMA(0, 1, At, B1); PG8_BAR; PG8_SCHED;
            PG8_LDA(At, 0, 1); PG8_STAGE(PG8_SB(0, 0), b2, voffB); PG8_STAGE(PG8_SB(0, 1), b2 + hstep, voffB); PG8_STAGE(PG8_SA(0, 0), a2, voffA);
            PG8_WAIT_V(8); PG8_WAIT_L(0); PG8_BAR; PG8_MMA(1, 0, At, B0); PG8_MMA(1, 1, At, B1); PG8_BAR; PG8_SCHED;
            PG8_LDB(B0, 1, 0); PG8_LDB(B1, 1, 1); PG8_SCHED; PG8_LDA(At, 1, 0); PG8_STAGE(PG8_SA(0, 1), a2 + hstep, voffA);
            PG8_WAIT_V(8); PG8_WAIT_L(0); PG8_BAR; PG8_MMA(0, 0, At, B0); PG8_MMA(0, 1, At, B1); PG8_BAR; PG8_SCHED;
            PG8_LDA(At, 1, 1); PG8_STAGE(PG8_SB(1, 0), b3, voffB); PG8_STAGE(PG8_SB(1, 1), b3 + hstep, voffB); PG8_STAGE(PG8_SA(1, 0), a3, voffA);
            PG8_WAIT_V(8); PG8_WAIT_L(0); PG8_BAR; PG8_MMA(1, 0, At, B0); PG8_MMA(1, 1, At, B1); PG8_BAR; PG8_SCHED;
            } else {
            PG8_LDB(B0, 0, 0); PG8_SCHED; PG8_LDA(At, 0, 0); PG8_STAGE(PG8_SA(1, 1), a1 + hstep, voffA);
            PG8_WAIT_L(8); PG8_BAR; PG8_WAIT_L(0); PG8_MMA(0, 0, At, B0); PG8_BAR; PG8_SCHED;
            PG8_LDB(B1, 0, 1); PG8_STAGE(PG8_SB(0, 0), b2, voffB);
            PG8_BAR; PG8_WAIT_L(0); PG8_MMA(0, 1, At, B1); PG8_BAR;
            PG8_LDA(At, 0, 1); PG8_STAGE(PG8_SA(0, 0), a2, voffA);
            PG8_BAR; PG8_WAIT_L(0); PG8_MMA(1, 0, At, B0); PG8_BAR; PG8_SCHED;
            PG8_STAGE(PG8_SB(0, 1), b2 + hstep, voffB);
            PG8_WAIT_V(6); PG8_BAR; PG8_MMA(1, 1, At, B1); PG8_BAR;
            PG8_LDB(B0, 1, 0); PG8_SCHED; PG8_LDA(At, 1, 0); PG8_STAGE(PG8_SA(0, 1), a2 + hstep, voffA);
            PG8_WAIT_L(8); PG8_BAR; PG8_WAIT_L(0); PG8_MMA(0, 0, At, B0); PG8_BAR; PG8_SCHED;
            PG8_LDB(B1, 1, 1); PG8_STAGE(PG8_SB(1, 0), b3, voffB);
            PG8_BAR; PG8_WAIT_L(0); PG8_MMA(0, 1, At, B1); PG8_BAR;
            PG8_LDA(At, 1, 1); PG8_STAGE(PG8_SA(1, 0), a3, voffA);
            PG8_BAR; PG8_WAIT_L(0); PG8_MMA(1, 0, At, B0); PG8_BAR; PG8_SCHED;
            PG8_STAGE(PG8_SB(1, 1), b3 + hstep, voffB);
            PG8_WAIT_V(6); PG8_BAR; PG8_MMA(1, 1, At, B1); PG8_BAR;
            }
        }
        if constexpr (ALIGN_EPI) { if (wr == 0) PG8_BAR; }
        if constexpr (!Epi::AFTER_DRAIN) { E(acc, cur, wr, wc, fr, fq); S.done(cur); }
        if (!has_next) break;
#pragma unroll
        for (int a = 0; a < 2; ++a)
#pragma unroll
            for (int b = 0; b < 2; ++b)
#pragma unroll
                for (int m = 0; m < 4; ++m)
#pragma unroll
                    for (int n = 0; n < 2; ++n) acc[a][b][m][n] = (f32x4){0.f, 0.f, 0.f, 0.f};
        cur = nxt; cA = nA; cB = nB; ++ui;
        if constexpr (ALIGN_EPI) { if (wr == 1) PG8_BAR; }
    }
    PG8_WAIT_V(0);
    if constexpr (!ALIGN_EPI) { if (wr == 0) PG8_BAR; }
    PG8_BAR;
    if constexpr (Epi::AFTER_DRAIN) { E.fused(acc, cur, wr, wc, fr, fq, lds, wid, lane); S.done(cur); }
#undef PG8_SA
#undef PG8_SB
#undef PG8_STAGE
#undef PG8_LDA
#undef PG8_LDB
#undef PG8_MMA
#undef PG8_WAIT_V
#undef PG8_WAIT_L
#undef PG8_BAR
#undef PG8_SCHED
}
}
namespace attn_body {
constexpr int D = 128, LD = 2048;
constexpr float THR = 8.f; constexpr bool WSKIP = false;
constexpr float SCALE = 0.08838834764831845f;
constexpr int NW = 8, QBLK = 32, KVBLK = 64, QB = NW * QBLK;
constexpr int SHM_V = KVBLK * D * 2, SHM_K = KVBLK * D * 2;
constexpr int LDS_BYTES = 2 * SHM_V + 2 * SHM_K + NW * 64 * 4;

typedef short bf16x8 __attribute__((ext_vector_type(8)));
typedef short s16x4 __attribute__((ext_vector_type(4)));
typedef float f32x16 __attribute__((ext_vector_type(16)));
typedef float f32x4 __attribute__((ext_vector_type(4)));
typedef unsigned u32x4 __attribute__((ext_vector_type(4)));
template <class A, class Bt> struct same_t { static constexpr bool v = false; };
template <class A> struct same_t<A, A> { static constexpr bool v = true; };

#define KSWZ(row, colB) ((row) * 256 + ((colB) ^ (((row) & 7) << 4)))
#define SBAR() __builtin_amdgcn_sched_barrier(0)
__device__ __forceinline__ int v_st(int k, int c) { const int kk = (k & ~0xC) | ((k & 4) << 1) | ((k & 8) >> 1); return ((kk >> 3) * 4 + (c >> 5)) * 512 + ((kk & 7) * 32 + (c & 31)) * 2; }
__device__ __forceinline__ int v_rd_base(int lane) { return ((lane & 3) << 3) | (((lane >> 2) & 3) << 6) | (((lane >> 4) & 1) << 5) | (((lane >> 5) & 1) << 8); }
constexpr int v_rd_off(int d0, int ks, int half) { return d0 * 512 + ks * 4096 + half * 2048; }
__device__ __forceinline__ int crow(int r, int hi) { return (r & 3) + 8 * (r >> 2) + 4 * hi; }
__device__ __forceinline__ unsigned cvtpk(float lo, float hi) {
    unsigned r; asm volatile("v_cvt_pk_bf16_f32 %0, %1, %2" : "=v"(r) : "v"(lo), "v"(hi)); return r;
}
__device__ __forceinline__ bf16x8 pack8(f32x4 a, f32x4 b) {
    u32x4 w = {cvtpk(a[0], a[1]), cvtpk(a[2], a[3]), cvtpk(b[0], b[1]), cvtpk(b[2], b[3])};
    return *reinterpret_cast<bf16x8*>(&w);
}
template <class T> __device__ __forceinline__ bf16x8 load8(const T* p) {
    if constexpr (same_t<T, float>::v) { return pack8(*(const f32x4*)p, *(const f32x4*)(p + 4)); }
    else { return *reinterpret_cast<const bf16x8*>(p); }
}
__device__ __forceinline__ void mask_tile(f32x16& p0, f32x16& p1, int dq, unsigned W) {
    const float NEG = -__builtin_inff();
#pragma unroll
    for (int r = 0; r < 16; ++r) {
        const int c = (r & 3) + 8 * (r >> 2);
        if ((unsigned)(dq - c) >= W) p0[r] = NEG;
        if ((unsigned)(dq - c - 32) >= W) p1[r] = NEG;
    }
}
__device__ __forceinline__ void partialSM(f32x16& p0, f32x16& p1, float& m_reg, float& mn, float& alpha) {
    float pmax = p0[0]; for (int r = 1; r < 16; ++r) pmax = fmaxf(pmax, p0[r]); for (int r = 0; r < 16; ++r) pmax = fmaxf(pmax, p1[r]);
    { auto rr = __builtin_amdgcn_permlane32_swap(__float_as_uint(pmax), __float_as_uint(pmax), false, false);
      pmax = fmaxf(__uint_as_float(rr[0]), __uint_as_float(rr[1])); }
    constexpr float C2 = 1.4426950408889634f * SCALE;
    if (__builtin_expect(__all((pmax - m_reg) * SCALE <= THR), 1)) { mn = m_reg; alpha = 1.f; }
    else { mn = fmaxf(m_reg, pmax); alpha = __builtin_amdgcn_exp2f((m_reg - mn) * C2); m_reg = mn; }
    const float mnL = -mn * C2;
    for (int r = 0; r < 16; ++r) p0[r] = fmaf(p0[r], C2, mnL); for (int r = 0; r < 16; ++r) p1[r] = fmaf(p1[r], C2, mnL);
    for (int r = 0; r < 16; ++r) p0[r] = __builtin_amdgcn_exp2f(p0[r]);
}
__device__ __forceinline__ void finishSM(f32x16& p0, f32x16& p1, float alpha, float& l_reg, bf16x8& pa0, bf16x8& pa1, bf16x8& pa2, bf16x8& pa3) {
    for (int r = 0; r < 16; ++r) p1[r] = __builtin_amdgcn_exp2f(p1[r]);
    float ps = 0; for (int r = 0; r < 16; ++r) ps += p0[r]; for (int r = 0; r < 16; ++r) ps += p1[r];
    { auto rr = __builtin_amdgcn_permlane32_swap(__float_as_uint(ps), __float_as_uint(ps), false, false);
      ps = __uint_as_float(rr[0]) + __uint_as_float(rr[1]); }
    l_reg = l_reg * alpha + ps;
#define PK4(P, B_, OUT) do { unsigned a0 = cvtpk(P[B_+0], P[B_+1]), a1 = cvtpk(P[B_+2], P[B_+3]);                          \
        unsigned b0 = cvtpk(P[B_+4], P[B_+5]), b1 = cvtpk(P[B_+6], P[B_+7]);                                             \
        auto r0 = __builtin_amdgcn_permlane32_swap(a0, b0, false, false); auto r1 = __builtin_amdgcn_permlane32_swap(a1, b1, false, false); \
        u32x4 w = {r0[0], r1[0], r0[1], r1[1]}; OUT = *reinterpret_cast<bf16x8*>(&w); } while (0)
    PK4(p0, 0, pa0); PK4(p0, 8, pa1); PK4(p1, 0, pa2); PK4(p1, 8, pa3);
#undef PK4
}
template <int KB, bool SK>
__device__ __forceinline__ void qkt(f32x16& p0, f32x16& p1, const char* K_lds, int r32, int hi, const bf16x8* qr, bool act, const float* bt) {
    if (SK && !act) { const float NEG = -__builtin_inff();
#pragma unroll
        for (int r = 0; r < 16; ++r) { p0[r] = NEG; p1[r] = NEG; } return; }
    { const f32x4 b0 = *(const f32x4*)(bt), b1 = *(const f32x4*)(bt + 8), b2 = *(const f32x4*)(bt + 16), b3 = *(const f32x4*)(bt + 24);
      const f32x4 c0 = *(const f32x4*)(bt + 32), c1 = *(const f32x4*)(bt + 40), c2 = *(const f32x4*)(bt + 48), c3 = *(const f32x4*)(bt + 56);
      p0 = (f32x16){b0[0], b0[1], b0[2], b0[3], b1[0], b1[1], b1[2], b1[3], b2[0], b2[1], b2[2], b2[3], b3[0], b3[1], b3[2], b3[3]};
      p1 = (f32x16){c0[0], c0[1], c0[2], c0[3], c1[0], c1[1], c1[2], c1[3], c2[0], c2[1], c2[2], c2[3], c3[0], c3[1], c3[2], c3[3]}; }
    const char* kb[4];
#pragma unroll
    for (int dd = 0; dd < 4; ++dd) kb[dd] = K_lds + KB * SHM_K + KSWZ(r32, (dd * 16 + hi * 8) * 2);
#pragma unroll
    for (int d0 = 0; d0 < 8; ++d0) { const char* a = kb[d0 & 3] + (d0 >> 2) * 128;
        bf16x8 b0 = *reinterpret_cast<const bf16x8*>(a);
        bf16x8 b1 = *reinterpret_cast<const bf16x8*>(a + 32 * 256);
        p0 = __builtin_amdgcn_mfma_f32_32x32x16_bf16(b0, qr[d0], p0, 0, 0, 0);
        p1 = __builtin_amdgcn_mfma_f32_32x32x16_bf16(b1, qr[d0], p1, 0, 0, 0); }
}
template <int VB, bool SK>
__device__ __forceinline__ void pv_tile(f32x16* o, int vb0, bf16x8 pa0, bf16x8 pa1, bf16x8 pa2, bf16x8 pa3, bool act) {
    if (SK && !act) return;
#define TRRD(dst, off) asm volatile("ds_read_b64_tr_b16 %0, %1 offset:%2" : "=&v"(dst) : "v"(vb0), "i"(off) : "memory")
#define PV_D0(d0) do { s16x4 l0, l1, l2, l3, h0, h1, h2, h3; constexpr int b_ = VB * SHM_V + v_rd_off(d0, 0, 0);     \
        TRRD(l0, b_); TRRD(h0, b_ + 2048); TRRD(l1, b_ + 4096); TRRD(h1, b_ + 6144); TRRD(l2, b_ + 8192); TRRD(h2, b_ + 10240); TRRD(l3, b_ + 12288); TRRD(h3, b_ + 14336); \
        asm volatile("s_waitcnt lgkmcnt(0)" ::: "memory"); SBAR();                 \
        o[d0] = __builtin_amdgcn_mfma_f32_32x32x16_bf16(pa0, (bf16x8){l0[0], l0[1], l0[2], l0[3], h0[0], h0[1], h0[2], h0[3]}, o[d0], 0, 0, 0);   \
        o[d0] = __builtin_amdgcn_mfma_f32_32x32x16_bf16(pa1, (bf16x8){l1[0], l1[1], l1[2], l1[3], h1[0], h1[1], h1[2], h1[3]}, o[d0], 0, 0, 0);   \
        o[d0] = __builtin_amdgcn_mfma_f32_32x32x16_bf16(pa2, (bf16x8){l2[0], l2[1], l2[2], l2[3], h2[0], h2[1], h2[2], h2[3]}, o[d0], 0, 0, 0);   \
        o[d0] = __builtin_amdgcn_mfma_f32_32x32x16_bf16(pa3, (bf16x8){l3[0], l3[1], l3[2], l3[3], h3[0], h3[1], h3[2], h3[3]}, o[d0], 0, 0, 0); } while (0)
    PV_D0(0); PV_D0(1); PV_D0(2); PV_D0(3);
#undef PV_D0
#undef TRRD
}


template <class TIn, class TOut> struct BlockRef { const TIn* Q; const TIn* K; const TIn* V; TOut* O; int P0; int jlo; };
#define ROW(p, k0, rr) ((p) + (size_t)((k0) + (rr)) * LD + sc)
#define VMW() asm volatile("s_waitcnt vmcnt(0)" ::: "memory")
#define SLOAD_H(Kp, Vp, k0) do { st_v0 = load8<TIn>(ROW(Vp, k0, sr)); st_v1 = load8<TIn>(ROW(Vp, k0, 32 + sr));              \
                         st_k0 = load8<TIn>(ROW(Kp, k0, sr)); st_k1 = load8<TIn>(ROW(Kp, k0, 32 + sr)); } while (0)
#define SWRITE_H(bf) do { *(bf16x8*)(V_lds + (bf) * SHM_V + vst0) = st_v0; *(bf16x8*)(V_lds + (bf) * SHM_V + vst1) = st_v1;   \
                          *(bf16x8*)(K_lds + (bf) * SHM_K + kws) = st_k0; *(bf16x8*)(K_lds + (bf) * SHM_K + kws + 32 * 256) = st_k1; } while (0)
template <class TIn, class TOut>
__device__ __forceinline__ void attn_unit(const BlockRef<TIn, TOut>& cur, int skv, char* lds) {
    const int tid = threadIdx.x, wid = __builtin_amdgcn_readfirstlane(tid >> 6), lane = tid & 63, r32 = lane & 31, hi = lane >> 5;
    const unsigned W = 0x40000000u;
    const int j_lo = cur.jlo;
    int j_hi = (cur.P0 + QB - 1) / KVBLK + 1; if (j_hi > skv / KVBLK) j_hi = skv / KVBLK;
    const int NT = j_hi - j_lo;
    const int qlo = cur.P0 + wid * QBLK, qm = qlo + r32 - 4 * hi;
    char* V_lds = lds; char* K_lds = lds + 2 * SHM_V;
    float* ws = (float*)(lds + 2 * SHM_V + 2 * SHM_K) + wid * 64; float* li_l = ws, * al_l = ws + 32;
    const float* bias_l = (const float*)(lds + LDS_BYTES) + 4 * hi;
    float m_reg = -1e30f, l_reg = 0; f32x16 o[4] = {};
    const int sr = tid >> 4, sc = (tid & 15) * 8, vst0 = v_st(sr, sc), vst1 = v_st(32 + sr, sc), kws = KSWZ(sr, sc * 2);
    const int vb0 = (int)(uintptr_t)V_lds + v_rd_base(lane);
    const TIn* Kh = cur.K; const TIn* Vh = cur.V;
    bf16x8 st_v0, st_v1, st_k0, st_k1; bf16x8 qr[8];
#define KBASE(t) ((j_lo + (t)) * KVBLK)
#define BT(t) (bias_l + (t) * KVBLK)
#define RESC(a) do { if (__any((a) < 1.f)) { if (hi == 0) al_l[r32] = (a); asm volatile("s_waitcnt lgkmcnt(0)" ::: "memory");              \
                     for (int d_ = 0; d_ < 4; ++d_) for (int r = 0; r < 16; ++r) o[d_][r] *= al_l[crow(r, hi)]; } } while (0)
#define MASKT(P0_, P1_, t) do { const int kb_ = KBASE(t); if (kb_ + KVBLK - 1 > qlo) mask_tile(P0_, P1_, qm - kb_, W); } while (0)
#pragma unroll
    for (int d0 = 0; d0 < 8; ++d0) qr[d0] = load8<TIn>(cur.Q + (size_t)(wid * QBLK + r32) * LD + d0 * 16 + hi * 8);
    SLOAD_H(Kh, Vh, KBASE(0)); VMW(); SWRITE_H(0); SBAR();
    if (NT > 1) SLOAD_H(Kh, Vh, KBASE(1));
    __syncthreads();
    f32x16 p0, p1; float mn, al; bf16x8 pa0, pa1, pa2, pa3;
#define TILE_STEP(t, BUF) do {                                                                                                 \
        SBAR(); qkt<BUF, false>(p0, p1, K_lds, r32, hi, qr, true, BT(t));                                                       \
        MASKT(p0, p1, (t)); partialSM(p0, p1, m_reg, mn, al); RESC(al);                                                          \
        finishSM(p0, p1, al, l_reg, pa0, pa1, pa2, pa3); SBAR();                                                                 \
        pv_tile<BUF, false>(o, vb0, pa0, pa1, pa2, pa3, true);                                                                    \
        if ((t) + 1 < NT) { VMW(); SWRITE_H(1 - (BUF)); SBAR(); if ((t) + 2 < NT) SLOAD_H(Kh, Vh, KBASE((t) + 2)); }              \
        __syncthreads(); } while (0)
    for (int t = 0; t < NT; t += 2) {
        TILE_STEP(t, 0);
        if (t + 1 < NT) TILE_STEP(t + 1, 1);
    }
    if (hi == 0) li_l[r32] = l_reg; asm volatile("s_waitcnt lgkmcnt(0)" ::: "memory");
    float rli[16];
#pragma unroll
    for (int r = 0; r < 16; ++r) rli[r] = __builtin_amdgcn_rcpf(li_l[crow(r, hi)]);
    TOut* Ow = cur.O + (size_t)(wid * QBLK) * LD;
#pragma unroll
    for (int r = 0; r < 16; ++r) { const int orow = crow(r, hi);
#pragma unroll
        for (int d0 = 0; d0 < 4; ++d0) { const float v = o[d0][r] * rli[r];
            const float vn = __shfl_xor(v, 1);
            if ((r32 & 1) == 0) *(unsigned*)(Ow + (size_t)orow * LD + d0 * 32 + r32) = cvtpk(v, vn); } }
    __syncthreads();
#undef TILE_STEP
#undef RESC
#undef KBASE
#undef BT
#undef MASKT
}
#undef ROW
#undef VMW
#undef SLOAD_H
#undef SWRITE_H
}
#define GAS __attribute__((address_space(1)))
#define LAS __attribute__((address_space(3)))
typedef unsigned short bf16;
typedef unsigned v4u __attribute__((ext_vector_type(4)));
typedef unsigned v2u __attribute__((ext_vector_type(2)));
typedef float f32x4 __attribute__((ext_vector_type(4)));
typedef float f32x2 __attribute__((ext_vector_type(2)));
typedef short bf16x8 __attribute__((ext_vector_type(8)));
typedef GAS unsigned gu32;
#define RLX_AGENT __ATOMIC_RELAXED, __HIP_MEMORY_SCOPE_AGENT

constexpr int S = 8192, DM = 4096, NH = 16, HD = 128, AW = 2048, LW = 2048, NG = 16, GD = 128;
constexpr int NIN = 18448, NINP = 18432;
constexpr int C_Q = 0, C_K = 2048, C_V = 4096, C_F = 6144, C_LX = 6160, C_LY = 8208, C_GA = 10256, C_GL = 14352;
constexpr int PEER_H = 8, PEER_NK = 128, PEER_K = 16, PEER_NE = 16384;
constexpr float EPS = 1e-6f;
constexpr size_t MiB = 1u << 20;
constexpr size_t WS_CTL = 0, CTL_ZERO_BYTES = 32768;
constexpr size_t WS_MOD = 512 * 1024;
constexpr size_t WS_WF = 2 * MiB;
constexpr size_t WS_LOGF = 3 * MiB;
constexpr size_t WS_FC = 4 * MiB;
constexpr size_t WS_AGGA = 5 * MiB, WS_AGGB = 6 * MiB;
constexpr size_t WS_BIASR = 7 * MiB, WS_SB = 7 * MiB + 262144;
constexpr size_t WS_SSQ = 28 * MiB;
constexpr size_t WS_WAT = 8 * MiB, WS_WXT = 9 * MiB;
constexpr size_t WS_SK = 10 * MiB, WS_RS = 11 * MiB, WS_RSU = 11 * MiB + 65536;
constexpr size_t WS_IDX = 12 * MiB, WS_GATE = 16 * MiB, WS_IDX2 = 20 * MiB, WS_GATE2 = 24 * MiB;
constexpr size_t WS_WIN = 32 * MiB, WS_WAO = 176 * MiB, WS_WLO = 192 * MiB, WS_WOUT = 208 * MiB, WS_WPQ = 240 * MiB;
constexpr size_t WS_U = 256 * MiB, WS_V = 384 * MiB;
constexpr size_t WS_HA = 512 * MiB;
constexpr size_t WS_QKV = 576 * MiB;
constexpr size_t WS_LX = 672 * MiB, WS_GY = 704 * MiB, WS_GA = 736 * MiB, WS_GL = 800 * MiB;
constexpr size_t WS_ATT = 864 * MiB, WS_LR = 896 * MiB, WS_T1 = 928 * MiB, WS_MG = 992 * MiB, WS_Q2 = 1056 * MiB, WS_X1 = 1088 * MiB, WS_END = 1216 * MiB;
constexpr int CW_BAR = 4096;
constexpr int CW_QATT = 256;
constexpr int RING_BYTES = 131072;
constexpr int LDSCTL_OFF = 150528, MISC_OFF = LDSCTL_OFF + 320;
constexpr int LDS_BYTES = 151552;
constexpr int NWAVES = 8, NTHREADS = 512;

__device__ __forceinline__ unsigned f2bf(float f) { unsigned u = __builtin_bit_cast(unsigned, f); return (u + 0x7fffu + ((u >> 16) & 1u)) >> 16; }
__device__ __forceinline__ unsigned pk2(float lo, float hi) { return f2bf(lo) | (f2bf(hi) << 16); }
__device__ __forceinline__ float bflo(unsigned w) { return __uint_as_float(w << 16); }
__device__ __forceinline__ float bfhi(unsigned w) { return __uint_as_float(w & 0xffff0000u); }
__device__ __forceinline__ float bf2f(bf16 b) { return __uint_as_float((unsigned)b << 16); }
__device__ __forceinline__ float wave_sum(float v) {
#pragma unroll
    for (int o = 1; o < 64; o <<= 1) v += __shfl_xor(v, o);
    return v;
}
__device__ __forceinline__ float wave_max(float v) {
#pragma unroll
    for (int o = 1; o < 64; o <<= 1) v = fmaxf(v, __shfl_xor(v, o));
    return v;
}
__device__ __forceinline__ float sigmoidf_(float v) { return __builtin_amdgcn_rcpf(1.0f + __builtin_amdgcn_exp2f(-1.4426950408889634f * v)); }
__device__ __forceinline__ float gelu_erf(float v) { return 0.5f * v * (1.0f + erff(v * 0.70710678118654752f)); }
#define XB_TMO      128
#define XB_XCNT(j)  (256  + 64 * (j))
#define XB_XSUB(j)  (1280 + 64 * (j))
#define XB_XGEN(j)  (2304 + 64 * (j))
#define XB_TOP      3328
#define XB_TOPGEN   3392
#define XCD_BAR_WORDS 3456
#define XB_SPIN_CAP (1u << 18)

__device__ __forceinline__ unsigned xb_ld(unsigned* p)              { return __hip_atomic_load(p, __ATOMIC_RELAXED, __HIP_MEMORY_SCOPE_AGENT); }
__device__ __forceinline__ unsigned xb_add(unsigned* p, unsigned v) { return __hip_atomic_fetch_add(p, v, __ATOMIC_RELAXED, __HIP_MEMORY_SCOPE_AGENT); }
__device__ __forceinline__ unsigned xb_xcc_id() { return (unsigned)__builtin_amdgcn_s_getreg((3 << 11) | 20) & 0xFu; }
#define XB_SPIN(cond, bar) do { unsigned _sp = 0; while (cond) { __builtin_amdgcn_s_sleep(1); \
    if ((++_sp & 255u) == 0u) { if (xb_ld(&(bar)[XB_TMO])) break; if (_sp > XB_SPIN_CAP) { atomicAdd(&(bar)[XB_TMO], 1u); break; } } } } while (0)

struct XcdBarrier {
    unsigned* bar; unsigned x;
    volatile LAS unsigned* st;
};

__device__ __forceinline__ XcdBarrier xcd_barrier_post(unsigned* bar, volatile LAS unsigned* st) {
    XcdBarrier b; b.bar = bar; b.x = xb_xcc_id(); b.st = st;
    if (threadIdx.x == 0) (void)xb_add(&bar[XB_XCNT(b.x)], 1u);
    return b;
}
__device__ __forceinline__ void xcd_barrier_complete(unsigned* bar, unsigned x, unsigned& nloc, unsigned& nx) {
    const unsigned G = gridDim.x * gridDim.y * gridDim.z;
    unsigned sum, cnt, mine, sp = 0u;
    for (;;) {
        sum = 0u; cnt = 0u; mine = 0u;
#pragma unroll
        for (unsigned j = 0; j < 16; ++j) { const unsigned c = xb_ld(&bar[XB_XCNT(j)]); sum += c; cnt += (c > 0u) ? 1u : 0u; mine = (j == x) ? c : mine; }
        if (sum == G) break;
        __builtin_amdgcn_s_sleep(1);
        if ((++sp & 255u) == 0u) { if (xb_ld(&bar[XB_TMO])) break; if (sp > XB_SPIN_CAP) { atomicAdd(&bar[XB_TMO], 1u); break; } }
    }
    nloc = mine > 0u ? mine : 1u; nx = cnt > 0u ? cnt : 1u;
}

__device__ __forceinline__ void xcd_barrier(const XcdBarrier& b) {
    asm volatile("s_waitcnt vmcnt(0)" ::: "memory");
    __syncthreads();
    if (threadIdx.x == 0) {
        unsigned* bar = b.bar;
        __builtin_amdgcn_s_waitcnt(0);
        unsigned nloc = b.st[0], nx = b.st[1];
        if (nloc == 0u) { xcd_barrier_complete(bar, b.x, nloc, nx); b.st[0] = nloc; b.st[1] = nx; }
        const unsigned old = xb_add(&bar[XB_XSUB(b.x)], 1u);
        const unsigned gen = old / nloc;
        if (old + 1u == (gen + 1u) * nloc) {
            __builtin_amdgcn_fence(__ATOMIC_RELEASE, "agent");
            asm volatile("s_waitcnt vmcnt(0)" ::: "memory");
            const unsigned og = xb_add(&bar[XB_TOP], 1u);
            const unsigned tg = og / nx;
            if (og + 1u == (tg + 1u) * nx) xb_add(&bar[XB_TOPGEN], 1u);
            else XB_SPIN(xb_ld(&bar[XB_TOPGEN]) == tg, bar);
            __builtin_amdgcn_fence(__ATOMIC_ACQUIRE, "agent");
            xb_add(&bar[XB_XGEN(b.x)], 1u);
            asm volatile("s_waitcnt vmcnt(0)" ::: "memory");
        } else {
            XB_SPIN(xb_ld(&bar[XB_XGEN(b.x)]) == gen, bar);
            __builtin_amdgcn_fence(__ATOMIC_ACQUIRE, "agent");
            asm volatile("s_waitcnt vmcnt(0)" ::: "memory");
        }
    }
    __syncthreads();
}
struct Args { const float* in[24]; float* out; unsigned char* ws; int ph_lo, ph_hi, rep_att, rep_lru; };
struct Frame {
    LAS unsigned char* lds; volatile LAS unsigned* MISC; gu32* ctl;
    int tid, lane, wave, vcu, G;
    unsigned char* ws; float* out;
};
#define WSP(T, off) ((T*)(F.ws + (off)))
#define LDS_WAIT() asm volatile("s_waitcnt lgkmcnt(0)" ::: "memory")

struct TrItem { const float* W; bf16* WT; int ldw, K, k0, nsrc0, ndst0; };
__device__ __forceinline__ void tr_load(const TrItem& I, float (&v)[32], int lane) {
    const float* wp = I.W + (size_t)(I.k0 + (lane >> 5)) * I.ldw + I.nsrc0 + (lane & 31);
#pragma unroll
    for (int i = 0; i < 32; ++i) v[i] = wp[(size_t)(2 * i) * I.ldw];
}
__device__ __forceinline__ void tr_store(const TrItem& I, const float (&v)[32], LAS float* scr, int lane) {
#pragma unroll
    for (int i = 0; i < 32; ++i) scr[(2 * i + (lane >> 5)) * 33 + (lane & 31)] = v[i];
    LDS_WAIT(); asm volatile("" ::: "memory");
    const int c = lane & 7;
#pragma unroll
    for (int j = 0; j < 4; ++j) { const int n = (lane >> 3) + 8 * j; const LAS float* s = scr + (8 * c) * 33 + n;
        v4u o; o.x = pk2(s[0 * 33], s[1 * 33]); o.y = pk2(s[2 * 33], s[3 * 33]); o.z = pk2(s[4 * 33], s[5 * 33]); o.w = pk2(s[6 * 33], s[7 * 33]);
        *(GAS v4u*)(I.WT + (size_t)(I.ndst0 + n) * I.K + I.k0 + 8 * c) = o; }
    LDS_WAIT(); asm volatile("" ::: "memory");
}
__device__ __forceinline__ void cvt_stream(const float* src, bf16* dst, size_t n8, size_t i0, size_t stride) {
    for (size_t i = i0; i < n8; i += stride) { const f32x4 a = ((const GAS f32x4*)src)[2 * i], b = ((const GAS f32x4*)src)[2 * i + 1];
        v4u o; o.x = pk2(a[0], a[1]); o.y = pk2(a[2], a[3]); o.z = pk2(b[0], b[1]); o.w = pk2(b[2], b[3]); ((GAS v4u*)dst)[i] = o; }
}
__device__ __forceinline__ void cvt_stream_fp8(const float* src, unsigned char* dst, size_t n16, float scale, size_t i0, size_t stride) {
    for (size_t i = i0; i < n16; i += stride) { v4u o;
#pragma unroll
        for (int q = 0; q < 4; ++q) { const f32x4 a = ((const GAS f32x4*)src)[4 * i + q] * scale; int w = 0;
            w = __builtin_amdgcn_cvt_pk_fp8_f32(a[0], a[1], w, false); w = __builtin_amdgcn_cvt_pk_fp8_f32(a[2], a[3], w, true); o[q] = (unsigned)w; }
        ((GAS v4u*)dst)[i] = o; }
}
__device__ __forceinline__ void cvt_table_fp4(Frame& F, const float* srcT, unsigned char* dstT, float* rsT, int gw, int NGW) {
    for (int row = gw; row < PEER_NE; row += NGW) {
        const GAS f32x4* src = (const GAS f32x4*)(srcT + (size_t)row * DM); f32x4 a[16]; float am = 0.f;
#pragma unroll
        for (int c = 0; c < 4; ++c)
#pragma unroll
            for (int q = 0; q < 4; ++q) { a[4 * c + q] = src[c * 256 + 4 * F.lane + q]; am = fmaxf(fmaxf(am, fmaxf(fabsf(a[4 * c + q][0]), fabsf(a[4 * c + q][1]))), fmaxf(fabsf(a[4 * c + q][2]), fabsf(a[4 * c + q][3]))); }
        am = wave_max(am); const float inv = am > 0.f ? 6.0f / am : 0.f;
#pragma unroll
        for (int c = 0; c < 4; ++c) { v2u o;
#pragma unroll
            for (int d = 0; d < 2; ++d) { unsigned w = 0u; const f32x4 x0 = a[4 * c + 2 * d] * inv, x1 = a[4 * c + 2 * d + 1] * inv;
                w = __builtin_amdgcn_cvt_scalef32_pk_fp4_f32(w, x0[0], x0[1], 1.0f, 0); w = __builtin_amdgcn_cvt_scalef32_pk_fp4_f32(w, x0[2], x0[3], 1.0f, 1);
                w = __builtin_amdgcn_cvt_scalef32_pk_fp4_f32(w, x1[0], x1[1], 1.0f, 2); w = __builtin_amdgcn_cvt_scalef32_pk_fp4_f32(w, x1[2], x1[3], 1.0f, 3); o[d] = w; }
            *((GAS v2u*)(dstT + (size_t)row * 2048 + c * 512) + F.lane) = o; }
        if (F.lane == 0) rsT[row] = am * (1.0f / 6.0f);
    }
}
__device__ __forceinline__ void p0_prologue(Frame& F, const Args& args) {
#ifndef P0_REP
#define P0_REP 0
#endif
    _Pragma("unroll") for (int rep_ = 0; rep_ < ((P0_REP & 1) ? 2 : 1); ++rep_)
    { LAS float* sc = (LAS float*)F.lds; LAS f32x4* red = (LAS f32x4*)(F.lds + 16384); float* MOD = WSP(float, WS_MOD);
      for (int cgi = blockIdx.x; cgi < 256; cgi += F.G) {
          for (int i = F.tid; i < DM; i += NTHREADS) { const float cv = args.in[1][i]; sc[i] = cv / (1.0f + __expf(-cv)); }
          __syncthreads();
          if (F.tid < 384) { const int cg = F.tid % 24, rg = F.tid / 24;
              const GAS f32x4* Wp = (const GAS f32x4*)args.in[2] + cgi * 24 + cg;
              f32x4 acc = {0.f, 0.f, 0.f, 0.f};
#pragma unroll 8
              for (int r = rg; r < DM; r += 16) acc += sc[r] * Wp[(size_t)r * 6144];
              red[rg * 24 + cg] = acc; }
          __syncthreads();
          if (F.tid < 24) { f32x4 s = red[F.tid];
#pragma unroll
              for (int rg = 1; rg < 16; ++rg) s += red[rg * 24 + F.tid];
              s += ((const GAS f32x4*)args.in[3])[cgi * 24 + F.tid]; ((GAS f32x4*)MOD)[cgi * 24 + F.tid] = s; }
          __syncthreads();
      } }
    LAS float* scr = (LAS float*)(F.lds + F.wave * 16384);
    const int gw = F.vcu * NWAVES + F.wave, NGW = F.G * NWAVES;
    constexpr int I_IN = 64 * 576, I_AO = 32 * 128, I_LO = 32 * 128, I_OUT = 64 * 128, I_PQ = 64 * 64, I_WA = 16 * 2 * 4, I_WX = I_WA;
    constexpr int NITEMS = I_IN + I_AO + I_LO + I_OUT + I_PQ + I_WA + I_WX;
    auto decode = [&](int r) -> TrItem { TrItem I;
        if (r < I_IN) { const int kb = r / 576, nb = r % 576; I = TrItem{args.in[6], WSP(bf16, WS_WIN), NIN, DM, 64 * kb, 32 * nb + (nb >= 192 ? 16 : 0), 32 * nb}; return I; } r -= I_IN;
        if (r < I_AO) { const int kb = r / 128, nb = r % 128; I = TrItem{args.in[17], WSP(bf16, WS_WAO), DM, AW, 64 * kb, 32 * nb, 32 * nb}; return I; } r -= I_AO;
        if (r < I_LO) { const int kb = r / 128, nb = r % 128; I = TrItem{args.in[18], WSP(bf16, WS_WLO), DM, LW, 64 * kb, 32 * nb, 32 * nb}; return I; } r -= I_LO;
        if (r < I_OUT) { const int kb = r / 128, nb = r % 128; I = TrItem{args.in[19], WSP(bf16, WS_WOUT), DM, DM, 64 * kb, 32 * nb, 32 * nb}; return I; } r -= I_OUT;
        if (r < I_PQ) { const int kb = r / 64, nb = r % 64; I = TrItem{args.in[20], WSP(bf16, WS_WPQ), 2048, DM, 64 * kb, 32 * nb, 32 * nb}; return I; } r -= I_PQ;
        { const bool isx = r >= I_WA; if (isx) r -= I_WA; const int g = r >> 3, kb = (r >> 2) & 1, nb = r & 3;
          I = TrItem{(isx ? args.in[14] : args.in[12]) + (size_t)g * GD * GD, WSP(bf16, isx ? WS_WXT : WS_WAT) + (size_t)g * GD * GD, GD, GD, 64 * kb, 32 * nb, 32 * nb}; return I; } };
    _Pragma("unroll") for (int rep_ = 0; rep_ < ((P0_REP & 2) ? 2 : 1); ++rep_)
    if (gw < NITEMS) {
        float va[32], vb[32]; TrItem Ia = decode(gw); tr_load(Ia, va, F.lane);
#pragma unroll 1
        for (int it = gw; it < NITEMS; it += NGW) {
            const int nx = it + NGW; TrItem Ib = Ia;
            if (nx < NITEMS) { Ib = decode(nx); tr_load(Ib, vb, F.lane); }
            tr_store(Ia, va, scr, F.lane);
#pragma unroll
            for (int i = 0; i < 32; ++i) va[i] = vb[i];
            Ia = Ib;
        }
    }
    const size_t gt = (size_t)F.vcu * NTHREADS + F.tid, NGT = (size_t)F.G * NTHREADS;
    _Pragma("unroll") for (int rep_ = 0; rep_ < ((P0_REP & 4) ? 2 : 1); ++rep_) {
    cvt_table_fp4(F, args.in[23], WSP(unsigned char, WS_V), WSP(float, WS_RS), gw, NGW);
    cvt_table_fp4(F, args.in[22], WSP(unsigned char, WS_U), WSP(float, WS_RSU), gw, NGW); }
    cvt_stream(args.in[21], WSP(bf16, WS_SK), (size_t)PEER_H * 2 * 128 * 128 / 8, gt, NGT);
    for (size_t i = gt; i < (size_t)DM * 16; i += NGT) WSP(float, WS_WF)[(i & 15) * DM + (i >> 4)] = args.in[6][(i >> 4) * NIN + C_F + (i & 15)];
    for (size_t i = gt; i < (size_t)NINP; i += NGT) WSP(float, WS_BIASR)[i] = args.in[7][i + (i >= (size_t)C_F ? 16 : 0)];
}

__device__ __forceinline__ void p1_norm_forget(Frame& F, const Args& args) {
    const float* MOD = WSP(float, WS_MOD); const float* WFT = WSP(float, WS_WF); bf16* HA = WSP(bf16, WS_HA);
    LAS f32x4* MUL4 = (LAS f32x4*)F.lds; LAS f32x4* SH4 = (LAS f32x4*)(F.lds + 16384); LAS f32x4* WB4 = (LAS f32x4*)(F.lds + 32768);
    for (int i4 = F.tid; i4 < DM / 4; i4 += NTHREADS) { MUL4[i4] = ((const GAS f32x4*)args.in[4])[i4] * (((const GAS f32x4*)(MOD + 4096))[i4] + 1.0f); SH4[i4] = ((const GAS f32x4*)MOD)[i4]; }
    __syncthreads();
    const int cw = F.tid >> 6, dw = F.tid & 63;
    const unsigned wo0 = (unsigned)(cw * DM + dw * 4) * 4u, wo1 = (unsigned)((cw + 8) * DM + dw * 4) * 4u, lo16 = (unsigned)F.lane * 16u, lo8 = (unsigned)F.lane * 8u;
#pragma unroll 1
    for (int step = blockIdx.x; step < S / 32; step += F.G) {
        const int ra = step * 32 + F.wave * 4; const char* xb0 = (const char*)(args.in[0] + (size_t)ra * DM); char* hb0 = (char*)(HA + (size_t)ra * DM);
        float rs[4];
#pragma unroll
        for (int r = 0; r < 4; ++r) { f32x4 xa[16]; float ss = 0.f;
#pragma unroll
            for (int j = 0; j < 16; ++j) xa[j] = *(const GAS f32x4*)(xb0 + (size_t)r * (DM * 4) + 1024 * j + lo16);
#pragma unroll
            for (int j = 0; j < 16; ++j) ss += (xa[j][0] * xa[j][0] + xa[j][1] * xa[j][1]) + (xa[j][2] * xa[j][2] + xa[j][3] * xa[j][3]);
            rs[r] = 1.0f / sqrtf(wave_sum(ss) * (1.0f / DM) + EPS); }
        float acc[4][16];
#pragma unroll
        for (int r = 0; r < 4; ++r)
#pragma unroll
            for (int c = 0; c < 16; ++c) acc[r][c] = 0.f;
        f32x4 w0 = *(const GAS f32x4*)((const char*)WFT + wo0), w1 = *(const GAS f32x4*)((const char*)WFT + wo1), xn[4];
#pragma unroll
        for (int r = 0; r < 4; ++r) xn[r] = *(const GAS f32x4*)(xb0 + (size_t)r * (DM * 4) + lo16);
#pragma unroll 1
        for (int j = 0; j < 16; ++j) {
            LAS f32x4* wb = WB4 + (j & 1) * 1024;
            wb[F.tid] = w0; wb[F.tid + 512] = w1;
            __syncthreads();
            f32x4 xc[4]; const int jn = (j + 1) & 15;
#pragma unroll
            for (int r = 0; r < 4; ++r) xc[r] = xn[r];
            { const char* wbase = (const char*)WFT + 1024 * jn; w0 = *(const GAS f32x4*)(wbase + wo0); w1 = *(const GAS f32x4*)(wbase + wo1); }
#pragma unroll
            for (int r = 0; r < 4; ++r) xn[r] = *(const GAS f32x4*)(xb0 + (size_t)r * (DM * 4) + 1024 * jn + lo16);
            const f32x4 mul = MUL4[F.lane + 64 * j], sh = SH4[F.lane + 64 * j];
            f32x4 h[4];
#pragma unroll
            for (int r = 0; r < 4; ++r) { h[r] = xc[r] * rs[r] * mul + sh; v2u o; o.x = pk2(h[r][0], h[r][1]); o.y = pk2(h[r][2], h[r][3]); *(GAS v2u*)(hb0 + (size_t)r * (DM * 2) + 512 * j + lo8) = o; }
#pragma unroll
            for (int c = 0; c < 16; ++c) { const f32x4 wf = wb[c * 64 + F.lane];
#pragma unroll
                for (int r = 0; r < 4; ++r) acc[r][c] += (h[r][0] * wf[0] + h[r][1] * wf[1]) + (h[r][2] * wf[2] + h[r][3] * wf[3]); }
        }
#pragma unroll
        for (int c = 0; c < 16; ++c) { float tt[4];
#pragma unroll
            for (int r = 0; r < 4; ++r) tt[r] = wave_sum(acc[r][c]);
            if (F.lane == c) { const float bia = args.in[7][C_F + c];
#pragma unroll
                for (int r = 0; r < 4; ++r) { const float f = tt[r] + bia; WSP(float, WS_LOGF)[(size_t)c * S + ra + r] = fminf(f, 0.f) - log1pf(__expf(-fabsf(f))); } } }
        __syncthreads();
    }
}
__device__ __forceinline__ void p1_shift_proj(Frame& F, const Args& args) {
    const int gw = F.vcu * NWAVES + F.wave, NGW = F.G * NWAVES; const float* sh2 = WSP(float, WS_MOD) + 12288; const bf16* WT = WSP(bf16, WS_WPQ);
    for (int col = gw; col < 2048; col += NGW) { float s = 0.f;
#pragma unroll
        for (int c = 0; c < 8; ++c) { const v4u w = *((const GAS v4u*)(WT + (size_t)col * DM + c * 512) + F.lane); const GAS f32x4* sp = (const GAS f32x4*)(sh2 + c * 512 + F.lane * 8); const f32x4 a = sp[0], b = sp[1];
            s += (bflo(w.x) * a[0] + bfhi(w.x) * a[1]) + (bflo(w.y) * a[2] + bfhi(w.y) * a[3]) + (bflo(w.z) * b[0] + bfhi(w.z) * b[1]) + (bflo(w.w) * b[2] + bfhi(w.w) * b[3]); }
        s = wave_sum(s); if (F.lane == 0) WSP(float, WS_SB)[col] = s; }
}

__device__ __forceinline__ void p3_qknorm(Frame& F, const Args& args) {
    const int gw = F.vcu * NWAVES + F.wave, NGW = F.G * NWAVES; bf16* QK = WSP(bf16, WS_QKV);
    const int sub = F.lane & 15;
    f32x4 gq0 = ((const GAS f32x4*)args.in[8])[2 * sub], gq1 = ((const GAS f32x4*)args.in[8])[2 * sub + 1], gk0 = ((const GAS f32x4*)args.in[9])[2 * sub], gk1 = ((const GAS f32x4*)args.in[9])[2 * sub + 1];
    for (int it0 = gw; it0 < 2 * S * NH / 4; it0 += 4 * NGW) {
        v4u w[4]; GAS v4u* pp[4];
#pragma unroll
        for (int k = 0; k < 4; ++k) { const int it = it0 + k * NGW; const size_t unit = (size_t)(it < 2 * S * NH / 4 ? it : it0) * 4 + (F.lane >> 4); pp[k] = (GAS v4u*)(QK + unit * 128) + sub; w[k] = *pp[k]; }
#pragma unroll
        for (int k = 0; k < 4; ++k) { const int it = it0 + k * NGW; const size_t unit = (size_t)(it < 2 * S * NH / 4 ? it : it0) * 4 + (F.lane >> 4); const bool isk = unit >= (size_t)S * NH;
            f32x4 a = {bflo(w[k].x), bfhi(w[k].x), bflo(w[k].y), bfhi(w[k].y)}, b = {bflo(w[k].z), bfhi(w[k].z), bflo(w[k].w), bfhi(w[k].w)};
            float ss = (a[0] * a[0] + a[1] * a[1]) + (a[2] * a[2] + a[3] * a[3]) + (b[0] * b[0] + b[1] * b[1]) + (b[2] * b[2] + b[3] * b[3]);
            ss += __shfl_xor(ss, 1); ss += __shfl_xor(ss, 2); ss += __shfl_xor(ss, 4); ss += __shfl_xor(ss, 8);
            const float rs = 1.0f / sqrtf(ss * (1.0f / HD) + EPS);
            a = a * rs * (isk ? gk0 : gq0); b = b * rs * (isk ? gk1 : gq1);
            v4u o; o.x = pk2(a[0], a[1]); o.y = pk2(a[2], a[3]); o.z = pk2(b[0], b[1]); o.w = pk2(b[2], b[3]);
            if (it < 2 * S * NH / 4) *pp[k] = o; }
    }
}
__device__ __forceinline__ void p3_cumsum(Frame& F, const Args& args) {
    LAS float* wt = (LAS float*)F.lds;
    for (int h = blockIdx.x; h < NH; h += F.G) {
        const float* LF = WSP(float, WS_LOGF); float v[16]; float run = 0.f;
        { const GAS f32x4* lp = (const GAS f32x4*)(LF + (size_t)h * S + F.tid * 16); const f32x4 l0 = lp[0], l1 = lp[1], l2 = lp[2], l3 = lp[3];
          const float lv[16] = {l0[0], l0[1], l0[2], l0[3], l1[0], l1[1], l1[2], l1[3], l2[0], l2[1], l2[2], l2[3], l3[0], l3[1], l3[2], l3[3]};
#pragma unroll
          for (int i = 0; i < 16; ++i) { run += lv[i]; v[i] = run; } }
        float sc = run;
#pragma unroll
        for (int o = 1; o < 64; o <<= 1) { const float t = __shfl_up(sc, o); if (F.lane >= o) sc += t; }
        if (F.lane == 63) wt[F.wave] = sc;
        __syncthreads();
        float pre = sc - run;
        for (int w = 0; w < F.wave; ++w) pre += wt[w];
        float* Fo = WSP(float, WS_FC) + (size_t)h * S + F.tid * 16;
#pragma unroll
        for (int i = 0; i < 4; ++i) ((GAS f32x4*)Fo)[i] = (f32x4){v[4 * i] + pre, v[4 * i + 1] + pre, v[4 * i + 2] + pre, v[4 * i + 3] + pre};
        __syncthreads();
    }
}
constexpr int LRU_XCF = 0, LRU_XCB = 32768, LRU_AB = 49152, LRU_BB = 81920, LRU_QA = 114688, LRU_CAR = 118784, LRU_XR = 133120;
struct LruConst { float w0, w1, w2, w3, cb, bav, bxv, sp8; };
template <int PASS> __device__ __forceinline__ void lru_chunk(Frame& F, const Args& args, int c, int g, v4u (&raw)[3], const bf16x8 (&ba)[4], const bf16x8 (&bx)[4], bool more, const LruConst& K) {
    LAS float* XCF = (LAS float*)(F.lds + LRU_XCF); LAS unsigned char* XCB = F.lds + LRU_XCB; LAS float* AB = (LAS float*)(F.lds + LRU_AB); LAS float* BB = (LAS float*)(F.lds + LRU_BB);
    LAS float* QA = (LAS float*)(F.lds + LRU_QA); LAS float* CAR = (LAS float*)(F.lds + LRU_CAR); LAS bf16* XR = (LAS bf16*)(F.lds + LRU_XR);
    const int t0 = 64 * c, ch0 = GD * g; const bf16* LX = WSP(bf16, WS_LX);
#pragma unroll
    for (int k = 0; k < 3; ++k) { const int p = F.tid + k * NTHREADS; if (p < 67 * 16) *(LAS v4u*)(XR + (p >> 4) * 128 + (p & 15) * 8) = raw[k]; }
    if (more) {
#pragma unroll
        for (int k = 0; k < 3; ++k) { const int p = F.tid + k * NTHREADS; const int r = p >> 4, cc = p & 15, tg = t0 + 64 - 3 + r; raw[k] = (v4u){0u, 0u, 0u, 0u};
            if (p < 67 * 16 && tg >= 0) raw[k] = *(const GAS v4u*)(LX + (size_t)tg * LW + ch0 + cc * 8); } }
    __syncthreads();
    { const int ch = F.tid & 127, tq = F.tid >> 7, gch = ch0 + ch;
      const float w0 = K.w0, w1 = K.w1, w2 = K.w2, w3 = K.w3, cb = K.cb; (void)gch;
      float xm3 = bf2f(XR[(16 * tq + 0) * 128 + ch]), xm2 = bf2f(XR[(16 * tq + 1) * 128 + ch]), xm1 = bf2f(XR[(16 * tq + 2) * 128 + ch]);
#pragma unroll
      for (int i = 0; i < 16; ++i) { const int t = 16 * tq + i; const float x0 = bf2f(XR[(t + 3) * 128 + ch]);
          const float xc = w0 * xm3 + w1 * xm2 + w2 * xm1 + w3 * x0 + cb; xm3 = xm2; xm2 = xm1; xm1 = x0;
          XCF[t * 128 + ch] = xc; *(LAS bf16*)(XCB + t * 256 + ((ch * 2) ^ ((t & 7) << 4))) = (bf16)f2bf(xc); } }
    __syncthreads();
    { const int fr = F.lane & 15, fq = F.lane >> 4, j = 16 * F.wave + fr;
      const float bav = K.bav, bxv = K.bxv, sp8 = K.sp8;
#pragma unroll
      for (int mt = 0; mt < 4; ++mt) { f32x4 ar = {0.f, 0.f, 0.f, 0.f}, ax = {0.f, 0.f, 0.f, 0.f}; const int t = 16 * mt + fr;
#pragma unroll
          for (int ks = 0; ks < 4; ++ks) { const bf16x8 af = *(const LAS bf16x8*)(XCB + t * 256 + (((32 * ks + 8 * fq) * 2) ^ ((t & 7) << 4)));
              ar = __builtin_amdgcn_mfma_f32_16x16x32_bf16(af, ba[ks], ar, 0, 0, 0); ax = __builtin_amdgcn_mfma_f32_16x16x32_bf16(af, bx[ks], ax, 0, 0, 0); }
#pragma unroll
          for (int rg = 0; rg < 4; ++rg) { const int tt = 16 * mt + 4 * fq + rg; const float xcv = XCF[tt * 128 + j];
              const float rgt = sigmoidf_(ar[rg] + bav), igt = sigmoidf_(ax[rg] + bxv);
              const float a = __builtin_amdgcn_exp2f(rgt * sp8); const float om = fmaxf((1.0f - a) * (1.0f + a), 0.f);
              const float b = __builtin_amdgcn_sqrtf(om) * (igt * xcv);
              AB[tt * 128 + j] = a; BB[tt * 128 + j] = b; } } }
    __syncthreads();
    const int ch = F.tid & 127, q = F.tid >> 7;
    { float A = 1.f, B = 0.f;
#pragma unroll
      for (int i = 0; i < 16; ++i) { const int t = 16 * q + i; const float a = AB[t * 128 + ch]; B = a * B + BB[t * 128 + ch]; A *= a; }
      QA[(q * 128 + ch) * 2] = A; QA[(q * 128 + ch) * 2 + 1] = B; }
    __syncthreads();
    if (PASS == 0) {
        if (F.tid < 128) { float A = 1.f, B = 0.f;
#pragma unroll
            for (int qq = 0; qq < 4; ++qq) { const float a = QA[(qq * 128 + F.tid) * 2], b = QA[(qq * 128 + F.tid) * 2 + 1]; B = a * B + b; A *= a; }
            WSP(float, WS_AGGA)[(size_t)c * LW + ch0 + F.tid] = A; WSP(float, WS_AGGB)[(size_t)c * LW + ch0 + F.tid] = B; }
    } else {
        float h = CAR[ch];
        for (int qq = 0; qq < q; ++qq) h = QA[(qq * 128 + ch) * 2] * h + QA[(qq * 128 + ch) * 2 + 1];
#pragma unroll
        for (int i = 0; i < 16; ++i) { const int t = 16 * q + i; h = AB[t * 128 + ch] * h + BB[t * 128 + ch]; XCF[t * 128 + ch] = h; }
        __syncthreads();
        if (F.tid < 128) { float hc = CAR[F.tid];
#pragma unroll
            for (int qq = 0; qq < 4; ++qq) hc = QA[(qq * 128 + F.tid) * 2] * hc + QA[(qq * 128 + F.tid) * 2 + 1];
            CAR[F.tid] = hc; }
        const bf16* GY = WSP(bf16, WS_GY); bf16* LR = WSP(bf16, WS_LR);
        for (int p = F.tid; p < 64 * 16; p += NTHREADS) { const int r = p >> 4, cc = p & 15; const size_t o = (size_t)(t0 + r) * LW + ch0 + cc * 8;
            const v4u gy = *(const GAS v4u*)(GY + o); const f32x4 h0 = *(const LAS f32x4*)(XCF + r * 128 + cc * 8), h1 = *(const LAS f32x4*)(XCF + r * 128 + cc * 8 + 4);
            v4u ov; ov.x = pk2(h0[0] * bflo(gy.x), h0[1] * bfhi(gy.x)); ov.y = pk2(h0[2] * bflo(gy.y), h0[3] * bfhi(gy.y)); ov.z = pk2(h1[0] * bflo(gy.z), h1[1] * bfhi(gy.z)); ov.w = pk2(h1[2] * bflo(gy.w), h1[3] * bfhi(gy.w));
            *(GAS v4u*)(LR + o) = ov; }
    }
    __syncthreads();
}
template <int PASS> __device__ __forceinline__ void lru_item(Frame& F, const Args& args, int w) {
    const int g = w & 15, c0 = (w >> 4) * 8; LAS float* CAR = (LAS float*)(F.lds + LRU_CAR); LAS float* QA = (LAS float*)(F.lds + LRU_QA);
    if (PASS == 1) {
        const int ch = F.tid & 127, q = F.tid >> 7, n = c0 / 4;
        const float* GA_ = WSP(float, WS_AGGA) + GD * g + ch; const float* GB_ = WSP(float, WS_AGGB) + GD * g + ch; float A = 1.f, B = 0.f;
#pragma unroll 4
        for (int cc = q * n; cc < (q + 1) * n; ++cc) { const float a = GA_[(size_t)cc * LW], b = GB_[(size_t)cc * LW]; B = a * B + b; A *= a; }
        QA[(q * 128 + ch) * 2] = A; QA[(q * 128 + ch) * 2 + 1] = B;
        __syncthreads();
        if (F.tid < 128) { float hc = 0.f;
#pragma unroll
            for (int qq = 0; qq < 4; ++qq) hc = QA[(qq * 128 + F.tid) * 2] * hc + QA[(qq * 128 + F.tid) * 2 + 1];
            CAR[F.tid] = hc; }
        __syncthreads();
    }
    bf16x8 ba[4], bx[4];
    { const int fr = F.lane & 15, fq = F.lane >> 4, j = 16 * F.wave + fr;
      const bf16* WA = WSP(bf16, WS_WAT) + (size_t)g * GD * GD + (size_t)j * GD + 8 * fq; const bf16* WX = WSP(bf16, WS_WXT) + (size_t)g * GD * GD + (size_t)j * GD + 8 * fq;
#pragma unroll
      for (int ks = 0; ks < 4; ++ks) { ba[ks] = *(const GAS bf16x8*)(WA + 32 * ks); bx[ks] = *(const GAS bf16x8*)(WX + 32 * ks); } }
    v4u raw[3];
    { const bf16* LX = WSP(bf16, WS_LX); const int t0 = 64 * c0, ch0 = GD * g;
#pragma unroll
      for (int k = 0; k < 3; ++k) { const int p = F.tid + k * NTHREADS; const int r = p >> 4, cc = p & 15, tg = t0 - 3 + r; raw[k] = (v4u){0u, 0u, 0u, 0u};
          if (p < 67 * 16 && tg >= 0) raw[k] = *(const GAS v4u*)(LX + (size_t)tg * LW + ch0 + cc * 8); } }
    LruConst K;
    { const int gch = GD * g + (F.tid & 127); K.w0 = args.in[10][gch]; K.w1 = args.in[10][LW + gch]; K.w2 = args.in[10][2 * LW + gch]; K.w3 = args.in[10][3 * LW + gch]; K.cb = args.in[11][gch];
      const int gcj = GD * g + 16 * F.wave + (F.lane & 15); K.bav = args.in[13][gcj]; K.bxv = args.in[15][gcj]; const float lam = args.in[16][gcj];
      K.sp8 = -8.0f * 1.4426950408889634f * ((lam > 0.f ? 0.f : -lam) + log1pf(__expf(-fabsf(lam)))); }
#pragma unroll 1
    for (int c = c0; c < c0 + 8; ++c) lru_chunk<PASS>(F, args, c, g, raw, ba, bx, c + 1 < c0 + 8, K);
}
constexpr int ATT_BIAS_OFF = attn_body::LDS_BYTES;
typedef attn_body::BlockRef<bf16, bf16> ARef;
__device__ __forceinline__ int attn_jlo(const float* Fh, int qb, float TH, int lane) {
    const int t0 = qb * 256; const float f0 = Fh[t0];
    const int j0 = lane, j1 = lane + 64;
    const bool ok0 = (64 * j0 + 63 >= t0) || (f0 - Fh[64 * j0 + 63] >= -TH), ok1 = (64 * j1 + 63 >= t0) || (f0 - Fh[64 * j1 + 63] >= -TH);
    const unsigned long long m0 = __ballot(ok0), m1 = __ballot(ok1);
    return m0 ? (int)__builtin_ctzll(m0) : 64 + (int)__builtin_ctzll(m1);
}
__device__ __forceinline__ ARef attn_ref(Frame& F, const Args& args, int h, int qb, int jlo) {
    ARef r; const bf16* QK = WSP(bf16, WS_QKV);
    r.Q = QK + (size_t)(qb * 256) * AW + h * HD; r.K = QK + (size_t)S * AW + h * HD; r.V = QK + 2 * (size_t)S * AW + h * HD;
    r.O = WSP(bf16, WS_ATT) + (size_t)(qb * 256) * AW + h * HD; r.P0 = qb * 256; r.jlo = jlo; return r;
}
__device__ __forceinline__ void attn_fill_bias(Frame& F, const Args& args, int h, int qb, int jlo) {
    const float* Fh = WSP(float, WS_FC) + (size_t)h * S; LAS float* bl = (LAS float*)(F.lds + ATT_BIAS_OFF);
    const int k0 = jlo * 64, n = (qb + 1) * 256 - k0; const float fr = Fh[k0];
#pragma unroll 1
    for (int i = F.tid; i < n; i += NTHREADS) bl[i] = (fr - Fh[k0 + i]) * (1.0f / attn_body::SCALE);
}
#ifndef ATT_MARGIN
#define ATT_MARGIN 25.0f
#endif
constexpr int ATT_SCHED_OFF = 104448;
__device__ __forceinline__ void p4_attention(Frame& F, const Args& args, char* lds_generic, int rep) {
    float gq = fmaxf(fabsf(args.in[8][F.lane]), fabsf(args.in[8][F.lane + 64])), gk = fmaxf(fabsf(args.in[9][F.lane]), fabsf(args.in[9][F.lane + 64]));
    gq = wave_max(gq); gk = wave_max(gk);
    const float TH = 2.0f * (128.0f * gq * gk * attn_body::SCALE) + ATT_MARGIN;
    LAS float* Fend = (LAS float*)(F.lds + ATT_SCHED_OFF); LAS int* cost = (LAS int*)(F.lds + ATT_SCHED_OFF + 8192); LAS int* jlo_t = cost + 512; LAS int* order = cost + 1024; LAS int* slot = cost + 1536;
    const float* Fc = WSP(float, WS_FC);
    for (int p = F.tid; p < NH * 128; p += NTHREADS) Fend[p] = Fc[(size_t)(p >> 7) * S + 64 * (p & 127) + 63];
    __syncthreads();
    { const int u = F.tid, h = u >> 5, qb = u & 31, t0 = qb * 256; const float f0 = Fc[(size_t)h * S + t0];
      int lo = 0, hi = 4 * qb;
      while (lo < hi) { const int mid = (lo + hi) >> 1; const bool ok = (64 * mid + 63 >= t0) || (f0 - Fend[h * 128 + mid] >= -TH); if (ok) hi = mid; else lo = mid + 1; }
      jlo_t[u] = lo; cost[u] = 4 * (qb + 1) - lo; }
    __syncthreads();
    { const int u = F.tid, cu = cost[u]; int rk = 0;
      for (int v = 0; v < 512; ++v) { const int cv = cost[v]; rk += (cv > cu || (cv == cu && v < u)) ? 1 : 0; }
      order[rk] = u; }
    __syncthreads();
    for (;;) {
        if (F.tid == 0) slot[0] = (int)__hip_atomic_fetch_add((unsigned*)(F.ctl + CW_QATT + 64 * rep), 1u, RLX_AGENT);
        __syncthreads();
        const int k = slot[0];
        __syncthreads();
        if (k >= 512) break;
        const int u = order[k], h = u >> 5, qb = u & 31, jl = jlo_t[u];
        const ARef r0 = attn_ref(F, args, h, qb, jl);
        attn_fill_bias(F, args, h, qb, jl); __syncthreads();
        attn_body::attn_unit<bf16, bf16>(r0, S, lds_generic);
    }
}

__device__ __forceinline__ void p7_norm2(Frame& F, const Args& args) {
    const int gw = F.vcu * NWAVES + F.wave, NGW = F.G * NWAVES; const float* MOD = WSP(float, WS_MOD); bf16* HA = WSP(bf16, WS_HA);
    for (int m = gw; m < S; m += NGW) {
        const GAS f32x4* xr = (const GAS f32x4*)(WSP(float, WS_X1) + (size_t)m * DM) + F.lane; f32x4 v[16]; float ss = 0.f;
#pragma unroll
        for (int j = 0; j < 16; ++j) { v[j] = xr[64 * j]; ss += (v[j][0] * v[j][0] + v[j][1] * v[j][1]) + (v[j][2] * v[j][2] + v[j][3] * v[j][3]); }
        const float rstd = 1.0f / sqrtf(wave_sum(ss) * (1.0f / DM) + EPS);
#pragma unroll
        for (int j = 0; j < 16; ++j) { const int i4 = F.lane + 64 * j;
            const f32x4 g = ((const GAS f32x4*)args.in[5])[i4], scl = ((const GAS f32x4*)(MOD + 16384))[i4], sh = ((const GAS f32x4*)(MOD + 12288))[i4];
            const f32x4 hv = v[j] * rstd * (g * (scl + 1.0f)) + sh;
            v2u o; o.x = pk2(hv[0], hv[1]); o.y = pk2(hv[2], hv[3]); ((GAS v2u*)(HA + (size_t)m * DM))[i4] = o; }
    }
}

template <int CTRL> __device__ __forceinline__ unsigned dppu(unsigned x) { return (unsigned)__builtin_amdgcn_update_dpp(0, (int)x, CTRL, 0xF, 0xF, true); }
__device__ __forceinline__ unsigned rowmax_u32(unsigned x) { x = max(x, dppu<0xB1>(x)); x = max(x, dppu<0x4E>(x)); x = max(x, dppu<0x141>(x)); x = max(x, dppu<0x140>(x)); return x; }
__device__ __forceinline__ float rowsum_f32(float x) { x += __uint_as_float(dppu<0xB1>(__float_as_uint(x))); x += __uint_as_float(dppu<0x4E>(__float_as_uint(x)));
    x += __uint_as_float(dppu<0x141>(__float_as_uint(x))); x += __uint_as_float(dppu<0x140>(__float_as_uint(x))); return x; }
__device__ __forceinline__ unsigned ordk(float f) { const unsigned u = __float_as_uint(f); return u ^ ((unsigned)((int)u >> 31) | 0x80000000u); }
__device__ __forceinline__ float deck(unsigned k) { return __uint_as_float((k & 0x80000000u) ? (k ^ 0x80000000u) : ~k); }
#define CE_(x, y) do { const unsigned hi_ = max(x, y), lo_ = min(x, y); x = hi_; y = lo_; } while (0)
__device__ __forceinline__ unsigned row_pop16(unsigned (&a)[8], int i) {
    unsigned res = 0u;
#pragma unroll
    for (int r = 0; r < 16; ++r) { const unsigned m = rowmax_u32(a[0]); const bool win = a[0] == m;
#pragma unroll
        for (int s = 0; s < 7; ++s) a[s] = win ? a[s + 1] : a[s];
        a[7] = win ? 0u : a[7]; res = (i == r) ? m : res; }
    return res;
}
__device__ __forceinline__ void p9_topk(Frame& F, const Args& args) {
    const bf16* Q2 = WSP(bf16, WS_Q2); const bf16* SK = WSP(bf16, WS_SK); int* IDX = WSP(int, WS_IDX); float* GATE = WSP(float, WS_GATE);
    const int i = F.lane & 15, q = F.lane >> 4;
    const unsigned qlo = (unsigned)(i * 2048 + 8 * q) * 2u;
    const int h = (int)blockIdx.x & 7, ib = (int)blockIdx.x >> 3, nbh = ((int)F.G - h + 7) >> 3;
    for (int c = F.tid; c < 4096; c += NTHREADS) { const int pp = c >> 11, n = (c >> 4) & 127, ch = c & 15;
        *(LAS v4u*)(F.lds + pp * 32768 + n * 256 + ((ch * 16) ^ ((n & 7) << 4))) = *(const GAS v4u*)(SK + ((size_t)((h * 2 + pp) * 128 + n)) * 128 + ch * 8); }
    __syncthreads();
#pragma unroll 1
    for (int tg = ib * NWAVES + F.wave; tg < S / 16; tg += nbh * NWAVES) {
        const int t0 = 16 * tg;
        unsigned R[2][4];
        bf16x8 af[2][4];
#pragma unroll
        for (int p = 0; p < 2; ++p) { const char* qb_ = (const char*)Q2 + ((size_t)t0 * 2048 + h * 256 + p * 128) * 2;
#pragma unroll
            for (int ks = 0; ks < 4; ++ks) af[p][ks] = *(const GAS bf16x8*)(qb_ + 64 * ks + qlo); }
#pragma unroll
        for (int p = 0; p < 2; ++p) {
            f32x4 acc[8];
#pragma unroll
            for (int nt = 0; nt < 8; ++nt) { acc[nt] = (f32x4){0.f, 0.f, 0.f, 0.f}; const int n = 16 * nt + i;
#pragma unroll
                for (int ks = 0; ks < 4; ++ks) { const bf16x8 b = *(const LAS bf16x8*)(F.lds + p * 32768 + n * 256 + ((64 * ks + 16 * q) ^ ((n & 7) << 4)));
                    acc[nt] = __builtin_amdgcn_mfma_f32_16x16x32_bf16(af[p][ks], b, acc[nt], 0, 0, 0); } }
#pragma unroll
            for (int r = 0; r < 4; ++r) { unsigned a[8];
#pragma unroll
                for (int nt = 0; nt < 8; ++nt) a[nt] = (ordk(acc[nt][r]) & ~0x7Fu) | (unsigned)(16 * nt + i);
                CE_(a[0], a[1]); CE_(a[2], a[3]); CE_(a[4], a[5]); CE_(a[6], a[7]); CE_(a[0], a[2]); CE_(a[1], a[3]); CE_(a[4], a[6]); CE_(a[5], a[7]); CE_(a[1], a[2]); CE_(a[5], a[6]);
                CE_(a[0], a[4]); CE_(a[1], a[5]); CE_(a[2], a[6]); CE_(a[3], a[7]); CE_(a[2], a[4]); CE_(a[3], a[5]); CE_(a[1], a[2]); CE_(a[3], a[4]); CE_(a[5], a[6]);
                R[p][r] = row_pop16(a, i); __builtin_amdgcn_sched_barrier(0); }
        }
#pragma unroll
        for (int r = 0; r < 4; ++r) {
            const unsigned R0 = R[0][r], R1 = R[1][r]; const float f0 = deck(R0 & ~0x7Fu), f1 = deck(R1 & ~0x7Fu); const int n0 = (int)(R0 & 0x7Fu), n1 = (int)(R1 & 0x7Fu);
            const unsigned f1u = __float_as_uint(f1); unsigned c[8];
#define CAND_(b, lim) do { const unsigned t_ = (ordk(f0 + __uint_as_float(dppu<0x150 + (b)>(f1u))) & ~0xFFu) | (unsigned)(255 - (i * 16 + (b))); c[b] = (i < (lim)) ? t_ : 0u; } while (0)
            CAND_(0, 16); CAND_(1, 8); CAND_(2, 5); CAND_(3, 4); CAND_(4, 3); CAND_(5, 2); CAND_(6, 2); CAND_(7, 2);
#undef CAND_
            { const float ex = __uint_as_float(dppu<0x150>(__float_as_uint(f0))) + f1; const unsigned exk = (ordk(ex) & ~0xFFu) | (unsigned)(255 - i); c[1] = (i >= 8) ? exk : c[1]; }
            CE_(c[0], c[1]);
            const unsigned G = row_pop16(c, i);
            const float val = deck(G & ~0xFFu); const int id = 255 - (int)(G & 0xFFu); const int rb = F.lane & 48;
            const int ea = __shfl(n0, rb + (id >> 4)), eb = __shfl(n1, rb + (id & 15));
            const float mx = __uint_as_float(dppu<0x150>(__float_as_uint(val))); const float ex = __expf(val - mx); const float sm = rowsum_f32(ex);
            const size_t o = (size_t)(t0 + 4 * q + r) * 128 + h * 16 + i; IDX[o] = ea * 128 + eb; GATE[o] = ex / sm; __builtin_amdgcn_sched_barrier(0);
        }
    }
}
#undef CE_

constexpr float U_SCALE = 256.0f, V_SCALE = 1.0f;
#ifndef PEER_SORT
#define PEER_SORT 0
#endif
__device__ __forceinline__ float gelu_as(float v) {
    const float av = fabsf(v), tt = __builtin_amdgcn_rcpf(av * 0.2316418882f + 1.0f);
    float q = tt * 0.5307027145f + (-0.7265760135f); q = q * tt + 0.7107068705f; q = q * tt + (-0.142248368f); q = q * tt + 0.127414796f; q = q * tt;
    const float m = v * (q * __builtin_amdgcn_exp2f((v * v) * (-0.72134752044f)));
    return v < 0.f ? m : v - m;
}
#ifndef PEER_UMFMA
#define PEER_UMFMA 1
#endif
#ifndef HYP_A
#define HYP_A 1
#endif
#ifndef HYP_B
#define HYP_B 0
#endif
#ifndef PEER_VMFMA
#define PEER_VMFMA 1
#endif
typedef int v8i __attribute__((ext_vector_type(8)));
typedef int v2i __attribute__((ext_vector_type(2)));
typedef float f32x16 __attribute__((ext_vector_type(16)));
__device__ __forceinline__ float wave_sum_dpp(float x) {
    x = rowsum_f32(x);
    return (__uint_as_float(__builtin_amdgcn_readlane(__float_as_uint(x), 0)) + __uint_as_float(__builtin_amdgcn_readlane(__float_as_uint(x), 16)))
         + (__uint_as_float(__builtin_amdgcn_readlane(__float_as_uint(x), 32)) + __uint_as_float(__builtin_amdgcn_readlane(__float_as_uint(x), 48)));
}
#define LOADROWS(T, ra_, rb_, ee) do { const int e2_ = (ee) & 127; const int ea_ = __builtin_amdgcn_readlane(e2_ < 64 ? id0 : id1, e2_ & 63), eb_ = __builtin_amdgcn_readlane(e2_ < 64 ? id0 : id1, (e2_ + 1) & 63); \
        const GAS v4u* pa_ = (const GAS v4u*)((T) + (size_t)ea_ * DM) + F.lane; const GAS v4u* pb_ = (const GAS v4u*)((T) + (size_t)eb_ * DM) + F.lane; \
        _Pragma("unroll") for (int c = 0; c < 4; ++c) { ra_[c] = pa_[64 * c]; rb_[c] = pb_[64 * c]; } } while (0)
#define UDOT(r_, out_) do { f32x2 s0_ = {0.f, 0.f}, s1_ = {0.f, 0.f}, s2_ = {0.f, 0.f}, s3_ = {0.f, 0.f}; \
        _Pragma("unroll") for (int c = 0; c < 4; ++c) _Pragma("unroll") for (int d = 0; d < 2; ++d) { \
            const f32x2 p0_ = __builtin_amdgcn_cvt_scalef32_pk_f32_fp4(r_[c][d], 1.0f, 0), p1_ = __builtin_amdgcn_cvt_scalef32_pk_f32_fp4(r_[c][d], 1.0f, 1), \
                        p2_ = __builtin_amdgcn_cvt_scalef32_pk_f32_fp4(r_[c][d], 1.0f, 2), p3_ = __builtin_amdgcn_cvt_scalef32_pk_f32_fp4(r_[c][d], 1.0f, 3); \
            s0_ = p0_ * hx[8 * c + 4 * d] + s0_; s1_ = p1_ * hx[8 * c + 4 * d + 1] + s1_; s2_ = p2_ * hx[8 * c + 4 * d + 2] + s2_; s3_ = p3_ * hx[8 * c + 4 * d + 3] + s3_; } \
        out_ = ((s0_.x + s0_.y) + (s1_.x + s1_.y)) + ((s2_.x + s2_.y) + (s3_.x + s3_.y)); } while (0)
#define UPAIR(ra_, rb_, ee) do { float sa_, sb_; UDOT(ra_, sa_); UDOT(rb_, sb_); sa_ = wave_sum_dpp(sa_); sb_ = wave_sum_dpp(sb_); \
        const int e2_ = (ee); const int ea_ = __builtin_amdgcn_readlane(e2_ < 64 ? id0 : id1, e2_ & 63), eb_ = __builtin_amdgcn_readlane(e2_ < 64 ? id0 : id1, (e2_ + 1) & 63); \
        const f32x2 a2_ = pg8::gelu_pk((f32x2){sa_ * RSU[ea_], sb_ * RSU[eb_]}); \
        if ((ee) < 64) { if (F.lane == (ee)) w0 = a2_.x * g0; if (F.lane == (ee) + 1) w0 = a2_.y * g0; } else { if (F.lane == (ee) - 64) w1 = a2_.x * g1; if (F.lane == (ee) - 63) w1 = a2_.y * g1; } } while (0)
#define LOADROWS4(T, ra_, rb_, ee) do { const int e2_ = (ee) & 127; const int ea_ = __builtin_amdgcn_readlane(e2_ < 64 ? id0 : id1, e2_ & 63), eb_ = __builtin_amdgcn_readlane(e2_ < 64 ? id0 : id1, (e2_ + 1) & 63); \
        const GAS v2u* pa_ = (const GAS v2u*)((T) + (size_t)ea_ * 2048) + F.lane; const GAS v2u* pb_ = (const GAS v2u*)((T) + (size_t)eb_ * 2048) + F.lane; \
        _Pragma("unroll") for (int c = 0; c < 4; ++c) { ra_[c] = pa_[64 * c]; rb_[c] = pb_[64 * c]; } } while (0)
#define VAXPY(r_, w_) do { const f32x2 w2_ = {w_, w_}; \
        _Pragma("unroll") for (int c = 0; c < 4; ++c) _Pragma("unroll") for (int d = 0; d < 2; ++d) { \
            const f32x2 p0_ = __builtin_amdgcn_cvt_scalef32_pk_f32_fp4(r_[c][d], 1.0f, 0), p1_ = __builtin_amdgcn_cvt_scalef32_pk_f32_fp4(r_[c][d], 1.0f, 1), \
                        p2_ = __builtin_amdgcn_cvt_scalef32_pk_f32_fp4(r_[c][d], 1.0f, 2), p3_ = __builtin_amdgcn_cvt_scalef32_pk_f32_fp4(r_[c][d], 1.0f, 3); \
            acc[8 * c + 4 * d] = p0_ * w2_ + acc[8 * c + 4 * d]; acc[8 * c + 4 * d + 1] = p1_ * w2_ + acc[8 * c + 4 * d + 1]; \
            acc[8 * c + 4 * d + 2] = p2_ * w2_ + acc[8 * c + 4 * d + 2]; acc[8 * c + 4 * d + 3] = p3_ * w2_ + acc[8 * c + 4 * d + 3]; } } while (0)
#define VPAIR(ra_, rb_, ee) do { const int e2_ = (ee); const int ea_ = __builtin_amdgcn_readlane(e2_ < 64 ? id0 : id1, e2_ & 63), eb_ = __builtin_amdgcn_readlane(e2_ < 64 ? id0 : id1, (e2_ + 1) & 63); \
        const float wa_ = __uint_as_float(__builtin_amdgcn_readlane(__float_as_uint((ee) < 64 ? w0 : w1), (ee) & 63)) * RS[ea_], wb_ = __uint_as_float(__builtin_amdgcn_readlane(__float_as_uint((ee) < 64 ? w0 : w1), ((ee) + 1) & 63)) * RS[eb_]; \
        VAXPY(ra_, wa_); VAXPY(rb_, wb_); } while (0)
template <int MODE> __device__ __forceinline__ void p10_peer(Frame& F, const Args& args) {
    const int gw = F.vcu * NWAVES + F.wave, NGW = F.G * NWAVES; const float* MOD = WSP(float, WS_MOD);
    const bf16* H2 = WSP(bf16, WS_HA); const unsigned char* U = WSP(unsigned char, WS_U); const unsigned char* V = WSP(unsigned char, WS_V); const int* IDX = WSP(int, WS_IDX); const float* GATE = WSP(float, WS_GATE); const float* RS = WSP(float, WS_RS); const float* RSU = WSP(float, WS_RSU);
#if PEER_UMFMA
    if (F.lane < 8) *(LAS v4u*)(F.lds + F.wave * 18688 + 4096 + F.lane * 16) = (v4u){0u, 0u, 0u, 0u};
#endif
#pragma unroll 1
    for (int t = gw; t < S; t += NGW) {
        const int id0 = IDX[(size_t)t * 128 + F.lane], id1 = IDX[(size_t)t * 128 + 64 + F.lane];
        const float g0 = GATE[(size_t)t * 128 + F.lane], g1 = GATE[(size_t)t * 128 + 64 + F.lane];
        float w0 = 0.f, w1 = 0.f;
#if PEER_UMFMA
        if (MODE != 2) {
            LAS unsigned char* h8 = F.lds + F.wave * 18688; LAS unsigned char* stg = h8 + 4224;
            const float rstd = 1.0f / sqrtf(wave_sum_dpp(WSP(float, WS_SSQ)[(size_t)t * 64 + F.lane]) * (1.0f / DM) + EPS);
#pragma unroll
            for (int c = 0; c < 4; ++c) { const GAS v4u* hp = (const GAS v4u*)(H2 + (size_t)t * DM + c * 1024 + F.lane * 16); const v4u a = hp[0], b = hp[1]; v4u o;
                const GAS f32x4* sp = (const GAS f32x4*)(MOD + 12288 + c * 1024 + F.lane * 16); const f32x4 s0 = sp[0], s1 = sp[1], s2 = sp[2], s3 = sp[3];
                { int w = 0; w = __builtin_amdgcn_cvt_pk_fp8_f32(bflo(a[0]) * rstd + s0[0], bfhi(a[0]) * rstd + s0[1], w, false); w = __builtin_amdgcn_cvt_pk_fp8_f32(bflo(a[1]) * rstd + s0[2], bfhi(a[1]) * rstd + s0[3], w, true); o[0] = (unsigned)w; }
                { int w = 0; w = __builtin_amdgcn_cvt_pk_fp8_f32(bflo(a[2]) * rstd + s1[0], bfhi(a[2]) * rstd + s1[1], w, false); w = __builtin_amdgcn_cvt_pk_fp8_f32(bflo(a[3]) * rstd + s1[2], bfhi(a[3]) * rstd + s1[3], w, true); o[1] = (unsigned)w; }
                { int w = 0; w = __builtin_amdgcn_cvt_pk_fp8_f32(bflo(b[0]) * rstd + s2[0], bfhi(b[0]) * rstd + s2[1], w, false); w = __builtin_amdgcn_cvt_pk_fp8_f32(bflo(b[1]) * rstd + s2[2], bfhi(b[1]) * rstd + s2[3], w, true); o[2] = (unsigned)w; }
                { int w = 0; w = __builtin_amdgcn_cvt_pk_fp8_f32(bflo(b[2]) * rstd + s3[0], bfhi(b[2]) * rstd + s3[1], w, false); w = __builtin_amdgcn_cvt_pk_fp8_f32(bflo(b[3]) * rstd + s3[2], bfhi(b[3]) * rstd + s3[3], w, true); o[3] = (unsigned)w; }
                *(LAS v4u*)(h8 + c * 1024 + F.lane * 16) = o; }
            const int j = F.lane & 31, kh = F.lane >> 5, lr = F.lane >> 3, lp = F.lane & 7;
            unsigned so[4][4];
#pragma unroll
            for (int b = 0; b < 4; ++b)
#pragma unroll
                for (int i = 0; i < 4; ++i) so[b][i] = (unsigned)__shfl(b < 2 ? id0 : id1, 32 * (b & 1) + lr + 8 * i) * 2048u + (unsigned)lp * 16u;
            int eb[4];
#pragma unroll
            for (int b = 0; b < 4; ++b) eb[b] = __shfl(b < 2 ? id0 : id1, j + 32 * (b & 1));
            const unsigned aoff0 = (j == 0) ? (unsigned)(16 * kh) : 4096u, aoff1 = (j == 0) ? (unsigned)(32 + 16 * kh) : 4112u, astep = (j == 0) ? 64u : 0u;
            const unsigned wof = (unsigned)lr * 144u + (unsigned)lp * 16u, rof = (unsigned)j * 144u + (unsigned)kh * 16u;
            f32x16 ac[4];
#pragma unroll
            for (int b = 0; b < 4; ++b) ac[b] = (f32x16){};
            v4u R0[8], R1[8];
#define ULOAD(R_, kg_, bp_) do { _Pragma("unroll") for (int bb = 0; bb < 2; ++bb) _Pragma("unroll") for (int i = 0; i < 4; ++i) \
                R_[4 * bb + i] = *(const GAS v4u*)(U + (size_t)so[2 * (bp_) + bb][i] + (size_t)(kg_) * 128); } while (0)
#define USTAGE(R_, bp_) do { _Pragma("unroll") for (int bb = 0; bb < 2; ++bb) _Pragma("unroll") for (int i = 0; i < 4; ++i) *(LAS v4u*)(stg + bb * 4608 + i * 1152 + wof) = R_[4 * bb + i]; \
            _Pragma("unroll") for (int bb = 0; bb < 2; ++bb) { v4u B_[4]; _Pragma("unroll") for (int kk = 0; kk < 4; ++kk) B_[kk] = *(const LAS v4u*)(stg + bb * 4608 + rof + kk * 32); \
                _Pragma("unroll") for (int kk = 0; kk < 4; ++kk) ac[2 * (bp_) + bb] = __builtin_amdgcn_mfma_scale_f32_32x32x64_f8f6f4(A[kk], (v8i){(int)B_[kk][0], (int)B_[kk][1], (int)B_[kk][2], (int)B_[kk][3], 0, 0, 0, 0}, ac[2 * (bp_) + bb], 0, 4, 0, 0x7f7f7f7f, 0, 0x7f7f7f7f); } } while (0)
            ULOAD(R0, 0, 0);
#pragma unroll 1
            for (int kg = 0; kg < 16; ++kg) {
                v8i A[4];
#pragma unroll
                for (int kk = 0; kk < 4; ++kk) { const unsigned kb = (unsigned)(4 * kg + kk); const v4u x = *(const LAS v4u*)(h8 + aoff0 + kb * astep), y = *(const LAS v4u*)(h8 + aoff1 + kb * astep);
                    A[kk] = (v8i){(int)x[0], (int)x[1], (int)x[2], (int)x[3], (int)y[0], (int)y[1], (int)y[2], (int)y[3]}; }
                ULOAD(R1, kg, 1);
                USTAGE(R0, 0);
                ULOAD(R0, (kg + 1) & 15, 0);
                USTAGE(R1, 1);
            }
#undef ULOAD
#undef USTAGE
#pragma unroll
            for (int b = 0; b < 4; ++b) {
                const float av = pg8::gelu_pk((f32x2){ac[b][0] * RSU[eb[b]], 0.f}).x;
                const float gg = __shfl(b < 2 ? g0 : g1, j + 32 * (b & 1)); const float wv = av * gg;
                if ((b & 1) == 0) { if (b == 0) w0 = F.lane < 32 ? wv : w0; else w1 = F.lane < 32 ? wv : w1; }
                else { const float mv = __shfl(wv, j); if (b == 1) w0 = F.lane >= 32 ? mv : w0; else w1 = F.lane >= 32 ? mv : w1; } }
        }
#else
        {   f32x2 hx[32];
#pragma unroll
            for (int c = 0; c < 4; ++c) { const GAS v4u* hp = (const GAS v4u*)(H2 + (size_t)t * DM + c * 1024 + F.lane * 16); const v4u a = hp[0], b = hp[1];
#pragma unroll
                for (int k = 0; k < 4; ++k) { hx[8 * c + k] = (f32x2){bflo(a[k]), bfhi(a[k])}; hx[8 * c + 4 + k] = (f32x2){bflo(b[k]), bfhi(b[k])}; } }
            v2u ra[4], rb[4], rc[4], rd[4], na[4], nb[4], nc[4], nd[4];
            if (MODE != 2) {
            LOADROWS4(U, ra, rb, 0); LOADROWS4(U, rc, rd, 2);
#pragma unroll 1
            for (int e = 0; e < 128; e += 8) {
                LOADROWS4(U, na, nb, e + 4); LOADROWS4(U, nc, nd, e + 6);
                UPAIR(ra, rb, e); UPAIR(rc, rd, e + 2);
                LOADROWS4(U, ra, rb, e + 8); LOADROWS4(U, rc, rd, e + 10);
                UPAIR(na, nb, e + 4); UPAIR(nc, nd, e + 6);
            } } }
#endif
        if (MODE == 1 || MODE == 3) { asm volatile("" :: "v"(w0), "v"(w1)); continue; }
#if PEER_VMFMA
        {
            LAS unsigned char* wreg = F.lds + F.wave * 18688; LAS unsigned char* w8 = wreg; LAS unsigned char* stg = wreg + 256;
            const int j = F.lane & 31, kh = F.lane >> 5;
            { const float q0 = w0 * RS[id0] * 16.0f, q1 = w1 * RS[id1] * 16.0f;
              const int b0 = __builtin_amdgcn_cvt_pk_fp8_f32(q0, q0, 0, false), b1 = __builtin_amdgcn_cvt_pk_fp8_f32(q1, q1, 0, false);
              w8[F.lane] = (unsigned char)(b0 & 0xff); w8[64 + F.lane] = (unsigned char)(b1 & 0xff); if (F.lane < 8) *(LAS v2u*)(w8 + 128 + 8 * F.lane) = (v2u){0u, 0u}; }
            v8i A[2];
#pragma unroll
            for (int kb = 0; kb < 2; ++kb) { const unsigned o0 = (j == 0) ? (unsigned)(64 * kb + 16 * kh) : 128u, o1 = (j == 0) ? (unsigned)(64 * kb + 32 + 16 * kh) : 144u;
                const v4u x = *(const LAS v4u*)(w8 + o0), y = *(const LAS v4u*)(w8 + o1);
                A[kb] = (v8i){(int)x[0], (int)x[1], (int)x[2], (int)x[3], (int)y[0], (int)y[1], (int)y[2], (int)y[3]}; }
            const int lr = F.lane >> 3, lp = F.lane & 7;
            unsigned so[2][8];
#pragma unroll
            for (int kb = 0; kb < 2; ++kb)
#pragma unroll
                for (int i = 0; i < 8; ++i) so[kb][i] = (unsigned)__shfl(kb == 0 ? id0 : id1, 8 * i + lr) * 2048u + (unsigned)lp * 16u;
            const unsigned wof = (unsigned)lr * 144u + (unsigned)lp * 16u;
            const unsigned rof = (unsigned)(32 * kh + (F.lane & 15)) * 144u + (unsigned)(8 * ((F.lane >> 4) & 1));
            const bf16* X1r = WSP(bf16, WS_X1) + (size_t)t * DM; const float* G2 = MOD + 20480; float* Or = F.out + (size_t)t * DM;
            v4u R0[8], R1[8];
#define VLOAD(R_, cg_, kb_) do { _Pragma("unroll") for (int i = 0; i < 8; ++i) R_[i] = *(const GAS v4u*)(V + (size_t)so[kb_][i] + (size_t)(cg_) * 128); } while (0)
            VLOAD(R0, 0, 0); VLOAD(R1, 0, 1);
#pragma unroll 1
            for (int cg = 0; cg < 16; ++cg) {
#pragma unroll
                for (int i = 0; i < 8; ++i) { *(LAS v4u*)(stg + i * 1152 + wof) = R0[i]; *(LAS v4u*)(stg + 9216 + i * 1152 + wof) = R1[i]; }
                VLOAD(R0, (cg + 1) & 15, 0); VLOAD(R1, (cg + 1) & 15, 1);
#pragma unroll
                for (int tp = 0; tp < 4; ++tp) { float dv[2];
#pragma unroll
                    for (int th = 0; th < 2; ++th) { const int tt = 2 * tp + th; f32x16 d_ = (f32x16){};
#pragma unroll
                        for (int kb = 0; kb < 2; ++kb) {
                            const v2i q0_ = __builtin_amdgcn_ds_read_tr4_b64_v2i32((LAS v2i*)(stg + kb * 9216 + rof + tt * 16)), q1_ = __builtin_amdgcn_ds_read_tr4_b64_v2i32((LAS v2i*)(stg + kb * 9216 + 2304 + rof + tt * 16));
                            d_ = __builtin_amdgcn_mfma_scale_f32_32x32x64_f8f6f4(A[kb], (v8i){q0_[0], q0_[1], q1_[0], q1_[1], 0, 0, 0, 0}, d_, 0, 4, 0, 0x7b7b7b7b, 0, 0x7f7f7f7f); }
                        dv[th] = d_[0]; }
                    const auto sw = __builtin_amdgcn_permlane32_swap(__float_as_uint(dv[0]), __float_as_uint(dv[1]), false, false);
                    const float dd = __uint_as_float(sw[0]);
                    if (MODE == 2) { asm volatile("" :: "v"(dd)); } else { const int col = cg * 256 + tp * 64 + F.lane; Or[col] = bf2f(X1r[col]) + G2[col] * dd; } }
            }
#undef VLOAD
        }
#else
        f32x2 acc[32];
#pragma unroll
        for (int j = 0; j < 32; ++j) acc[j] = (f32x2){0.f, 0.f};
        {   v2u ra[4], rb[4], rc[4], rd[4], na[4], nb[4], nc[4], nd[4];
            LOADROWS4(V, ra, rb, 0); LOADROWS4(V, rc, rd, 2);
#pragma unroll 1
            for (int e = 0; e < 128; e += 8) {
                LOADROWS4(V, na, nb, e + 4); LOADROWS4(V, nc, nd, e + 6);
                VPAIR(ra, rb, e); VPAIR(rc, rd, e + 2);
                LOADROWS4(V, ra, rb, e + 8); LOADROWS4(V, rc, rd, e + 10);
                VPAIR(na, nb, e + 4); VPAIR(nc, nd, e + 6);
            } }
        if (MODE == 2) {
#pragma unroll
            for (int j = 0; j < 32; ++j) asm volatile("" :: "v"(acc[j]));
            continue; }
#pragma unroll
        for (int c = 0; c < 4; ++c) { const int col = c * 1024 + F.lane * 16; GAS f32x4* op = (GAS f32x4*)(F.out + (size_t)t * DM + col);
            const GAS f32x4* xp = (const GAS f32x4*)(WSP(float, WS_X1) + (size_t)t * DM + col); const GAS f32x4* gp = (const GAS f32x4*)(MOD + 20480 + col);
#pragma unroll
            for (int q = 0; q < 4; ++q) op[q] = xp[q] + gp[q] * (f32x4){acc[8 * c + 2 * q].x, acc[8 * c + 2 * q].y, acc[8 * c + 2 * q + 1].x, acc[8 * c + 2 * q + 1].y}; }
#endif
    }
}
#undef LOADROWS
#undef UDOT
#undef UPAIR
#undef VAXPY
#undef VPAIR
#undef LOADROWS4
#ifndef MK_SINGLE
#define MK_SINGLE 1
#endif
constexpr int N_PHASES = 11;
__global__ void __launch_bounds__(NTHREADS, 2) fwd_kernel(Args args) {
    extern __shared__ __attribute__((aligned(16))) unsigned char lds[];
    Frame F;
    F.lds = (LAS unsigned char*)lds; F.MISC = (volatile LAS unsigned*)(F.lds + MISC_OFF);
    F.tid = threadIdx.x; F.lane = F.tid & 63; F.wave = __builtin_amdgcn_readfirstlane(F.tid >> 6);
    F.G = gridDim.x; { const int bx = blockIdx.x; F.vcu = (F.G % 8 == 0) ? (bx % 8) * (F.G / 8) + bx / 8 : bx; }
    F.ws = args.ws; F.out = args.out; F.ctl = (gu32*)(args.ws + WS_CTL);
    for (int u = F.tid; u < (LDS_BYTES - LDSCTL_OFF) / 4; u += NTHREADS) ((LAS unsigned*)(F.lds + LDSCTL_OFF))[u] = 0u;
    __syncthreads();
    const int lo = args.ph_lo, hi = args.ph_hi;
    XcdBarrier bar; bar.bar = (unsigned*)(F.ctl + CW_BAR); bar.x = 0; bar.st = nullptr;
    if (hi - lo > 1) bar = xcd_barrier_post((unsigned*)(F.ctl + CW_BAR), F.MISC + 8);
#ifndef PH_MASK
#define PH_MASK 0x7ff
#endif
#define IN(k) (((PH_MASK >> (k)) & 1) && lo <= (k) && (k) < hi)
#define SEAM(k) do { if (IN(k) && IN((k) + 1)) xcd_barrier(bar); } while (0)
#ifndef G_ALIGN
#define G_ALIGN true
#endif
#ifndef G_SP2
#define G_SP2 true
#endif
#ifndef REP_PHASE
#define REP_PHASE -1
#endif
#define REPEAT(k) _Pragma("unroll") for (int rep = 0; rep < ((REP_PHASE) == (k) ? 2 : 1); ++rep)
#define REPBAR(k) do { if ((REP_PHASE) == (k) && rep == 0) xcd_barrier(bar); } while (0)
    const int bid = (int)blockIdx.x;
    if (IN(0)) { REPEAT(0) { p0_prologue(F, args); REPBAR(0); } SEAM(0); }
    if (IN(1)) { REPEAT(1) { p1_norm_forget(F, args); p1_shift_proj(F, args); REPBAR(1); } SEAM(1); }
    if (IN(2)) { REPEAT(2) {
        pg8::Gemm g{WSP(bf16, WS_HA), WSP(bf16, WS_WIN), S, NINP, DM}; pg8::StaticOrder So; So.init(S, NINP, F.G, bid);
        pg8::EpiIn E{WSP(bf16, WS_QKV), WSP(bf16, WS_LX), WSP(bf16, WS_GY), WSP(bf16, WS_GA), WSP(bf16, WS_GL), WSP(float, WS_BIASR)};
        pg8::gemm_phase<pg8::EpiIn, pg8::StaticOrder, G_ALIGN, G_SP2>(F.lds, g, So, E);
        REPBAR(2); }
        SEAM(2);
    }
    if (IN(3)) {
        p3_qknorm(F, args);
        __syncthreads();
        REPEAT(3) {
        p3_cumsum(F, args);
        for (int w = bid; w < 256; w += F.G) lru_item<0>(F, args, w);
        REPBAR(3); }
        SEAM(3);
    }
    if (IN(4)) {
#pragma unroll 1
        for (int rep = 0; rep < args.rep_att; ++rep) p4_attention(F, args, (char*)lds, rep);
#pragma unroll 1
        for (int rep = 0; rep < args.rep_lru; ++rep)
        for (int w = bid; w < 256; w += F.G) lru_item<1>(F, args, w);
        SEAM(4);
    }
    if (IN(5)) { REPEAT(5) {
        { pg8::Gemm g{WSP(bf16, WS_ATT), WSP(bf16, WS_WAO), S, DM, AW}; pg8::StaticOrder So; So.init(S, DM, F.G, bid);
          pg8::EpiGate<0> E{WSP(bf16, WS_T1), WSP(bf16, WS_GA), DM};
          pg8::gemm_phase<pg8::EpiGate<0>, pg8::StaticOrder, true, true>(F.lds, g, So, E); }
        { pg8::Gemm g{WSP(bf16, WS_LR), WSP(bf16, WS_WLO), S, DM, LW}; pg8::StaticOrder So; So.init(S, DM, F.G, bid);
          pg8::EpiGate<1> E{WSP(bf16, WS_T1), WSP(bf16, WS_GL), DM};
          pg8::gemm_phase<pg8::EpiGate<1>, pg8::StaticOrder, true, true>(F.lds, g, So, E); }
        REPBAR(5); }
        SEAM(5);
    }
    if (IN(6)) { REPEAT(6) {
        pg8::Gemm g{WSP(bf16, WS_T1), WSP(bf16, WS_WOUT), S, DM, DM}; pg8::StaticOrder So; So.init(S, DM, F.G, bid);
        pg8::EpiRes E{args.in[0], WSP(bf16, WS_X1), WSP(float, WS_MOD) + 8192, DM, args.in[5], WSP(float, WS_MOD) + 16384, WSP(bf16, WS_HA), WSP(float, WS_SSQ)};
        pg8::gemm_phase<pg8::EpiRes, pg8::StaticOrder, true, true>(F.lds, g, So, E);
        REPBAR(6); }
        SEAM(6);
    }
    if (IN(8)) { REPEAT(8) {
        pg8::Gemm g{WSP(bf16, WS_HA), WSP(bf16, WS_WPQ), S, 2048, DM}; pg8::RstdOrder So; So.init(S, 2048, F.G, bid);
        So.SSQ = WSP(float, WS_SSQ); So.rs = (LAS float*)(F.lds + 133120); So.inv_n = 1.0f / DM; So.eps = EPS; So.na = 0;
        pg8::EpiQ2 E{WSP(bf16, WS_Q2), 2048, WSP(float, WS_SB), (const LAS float*)(F.lds + 133120), 0};
        pg8::gemm_phase<pg8::EpiQ2, pg8::RstdOrder, true, true>(F.lds, g, So, E);
        REPBAR(8); }
        SEAM(8);
    }
    if (IN(9)) { REPEAT(9) { p9_topk(F, args); REPBAR(9); } SEAM(9); }
#ifndef P10_PROBE
#define P10_PROBE 0
#endif
    if (IN(10)) { if (P10_PROBE) { p10_peer<P10_PROBE>(F, args); xcd_barrier(bar); } REPEAT(10) { p10_peer<0>(F, args); REPBAR(10); } }
#undef IN
#undef SEAM
}

extern "C" void kernel_launch(void* const* d_in, const int* in_sizes, int n_in, void* d_out, int out_size, void* d_ws, size_t ws_size, hipStream_t stream) {
    static int grid = 0;
    if (grid == 0) {
        if (n_in != 24 || in_sizes[0] != S * DM || out_size != S * DM || ws_size < WS_END) { fprintf(stderr, "kernel_launch: unexpected shapes (n_in %d, in0 %d, out %d, ws %zu)\n", n_in, n_in > 0 ? in_sizes[0] : -1, out_size, ws_size); grid = -1; return; }
        int dev = 0, cus = 0, per_cu = 0;
        if (hipGetDevice(&dev) != hipSuccess || hipDeviceGetAttribute(&cus, hipDeviceAttributeMultiprocessorCount, dev) != hipSuccess) { grid = -1; return; }
        if (hipFuncSetAttribute((const void*)fwd_kernel, hipFuncAttributeMaxDynamicSharedMemorySize, LDS_BYTES) != hipSuccess) { fprintf(stderr, "kernel_launch: hipFuncSetAttribute failed\n"); grid = -1; return; }
        if (hipOccupancyMaxActiveBlocksPerMultiprocessor(&per_cu, (const void*)fwd_kernel, NTHREADS, LDS_BYTES) != hipSuccess || per_cu < 1) fprintf(stderr, "kernel_launch: occupancy query reports %d blocks per CU\n", per_cu);
        (void)hipGetLastError();
        grid = cus;
    }
    if (grid < 0) return;
    if (hipMemsetAsync((char*)d_ws + WS_CTL, 0, CTL_ZERO_BYTES, stream) != hipSuccess) return;
    Args a{};
    for (int i = 0; i < 24; ++i) a.in[i] = (const float*)d_in[i];
    a.out = (float*)d_out; a.ws = (unsigned char*)d_ws;
#ifndef REP_ATT
#define REP_ATT 1
#endif
#ifndef REP_LRU
#define REP_LRU 1
#endif
    a.rep_att = REP_ATT; a.rep_lru = REP_LRU;
#if MK_SINGLE
    a.ph_lo = 0; a.ph_hi = N_PHASES;
    hipLaunchKernelGGL(fwd_kernel, dim3(grid), dim3(NTHREADS), LDS_BYTES, stream, a);
#else
    for (int p = 0; p < N_PHASES; ++p) { a.ph_lo = p; a.ph_hi = p + 1; hipLaunchKernelGGL(fwd_kernel, dim3(grid), dim3(NTHREADS), LDS_BYTES, stream, a); }
#endif
}
```

```cpp
#define REP_PHASE -1
#include <hip/hip_runtime.h>
#include <cstdio>
#include <cstdint>
namespace pg8 {
#define PG8_LAS __attribute__((address_space(3)))
typedef unsigned short bf16_t;
typedef short bf16x8 __attribute__((ext_vector_type(8)));
typedef float f32x4 __attribute__((ext_vector_type(4)));
typedef unsigned u32x4 __attribute__((ext_vector_type(4)));
constexpr int BM = 256, BK = 64, HALF = 128, HTB = HALF * BK * 2  , STAGE_BYTES = 8 * HTB, NXCD = 8, WGM = 8;

__host__ __device__ __forceinline__ int lds_byte(int r, int c) { const int st = (r >> 4) * 2 + (c >> 5), rr = r & 15, cc = c & 31, ob = rr * 64 + cc * 2; return st * 1024 + (ob ^ (((ob >> 9) & 1) << 5)); }
__host__ __device__ __forceinline__ void stage_rc(int b, int& R, int& C) { const int st = b / 1024, sb = b % 1024, swz = sb ^ (((sb >> 9) & 1) << 5); R = (st >> 1) * 16 + swz / 64; C = (st & 1) * 32 + (swz % 64) / 2; }
__host__ __device__ __forceinline__ int perm32(int rho) { const int n = rho >> 4, i = rho & 15; return 8 * (i >> 2) + 4 * n + (i & 3); }

struct Unit { int pm, pn; };
struct Gemm { const bf16_t* A; const bf16_t* Bt; int M, N, K; };

struct StaticOrder {
    int nM, nN, nwg, G, c;
    __host__ __device__ void init(int M, int N, int G_, int c_) { nM = M / BM; nN = N / BM; nwg = nM * nN; G = G_; c = c_; }
    __host__ __device__ bool next(int i, Unit& u) const {
        const long L = (long)i * G + c; if (L >= nwg) return false;
        int wgid = (int)L; { const int q = nwg / NXCD, r = nwg % NXCD, xcd = wgid % NXCD, off = wgid / NXCD; wgid = (xcd < r ? xcd * (q + 1) : r * (q + 1) + (xcd - r) * q) + off; }
        const int nig = WGM * nN, gid = wgid / nig, fm = gid * WGM, gsz = (nM - fm) < WGM ? (nM - fm) : WGM;
        u.pm = fm + ((wgid % nig) % gsz); u.pn = (wgid % nig) / gsz; return true;
    }
    __device__ __forceinline__ void a_ready(const Unit&) const {}
    __device__ __forceinline__ void done(const Unit&) const {}
};

__device__ __forceinline__ unsigned cvt_pk_bf16(float lo, float hi) { unsigned r; asm volatile("v_cvt_pk_bf16_f32 %0, %1, %2" : "=v"(r) : "v"(lo), "v"(hi)); return r; }
typedef float f32x2 __attribute__((ext_vector_type(2)));
__device__ __forceinline__ f32x2 gelu_pk(f32x2 v) {
    const f32x2 av = __builtin_elementwise_abs(v), d = av * 0.2316418882f + 1.0f;
    f32x2 t; t.x = __builtin_amdgcn_rcpf(d.x); t.y = __builtin_amdgcn_rcpf(d.y);
    f32x2 q = t * 0.5307027145f + (-0.7265760135f); q = q * t + 0.7107068705f; q = q * t + (-0.142248368f); q = q * t + 0.127414796f; q = q * t;
    const f32x2 s = (v * v) * (-0.72134752044f);
    f32x2 e; e.x = __builtin_amdgcn_exp2f(s.x); e.y = __builtin_amdgcn_exp2f(s.y);
    const f32x2 m = v * (q * e), r = v - m;
    f32x2 o; o.x = v.x < 0.f ? m.x : r.x; o.y = v.y < 0.f ? m.y : r.y; return o;
}

template <int ACT  > struct EpiBf16 {
    static constexpr bool PERM = true, AFTER_DRAIN = false; static_assert(ACT == 0 || ACT == 1, "EpiBf16: ACT is 0 (none) or 1 (gelu_pk)");
    bf16_t* O; int ldc; const float* bias; int split_cols; size_t split_stride; float scale0;
    __device__ __forceinline__ void operator()(const f32x4 (&acc)[2][2][4][2], const Unit& u, int wr, int wc, int fr, int fq) const {
        const int row0 = u.pm * BM + wr * 64 + fr; int colt = u.pn * BM; bf16_t* base = O;
        float sc = 1.f; if (split_cols) { const int t = colt / split_cols; base += (size_t)t * split_stride; colt -= t * split_cols; if (t == 0) sc = scale0; }
        const int col0 = colt + wc * 32 + 8 * fq, bcol0 = u.pn * BM + wc * 32 + 8 * fq;
        f32x4 bv[2][2];
#pragma unroll
        for (int bj = 0; bj < 2; ++bj)
#pragma unroll
            for (int n = 0; n < 2; ++n) bv[bj][n] = bias ? *(const f32x4*)(bias + bcol0 + bj * HALF + 4 * n) : (f32x4){0.f, 0.f, 0.f, 0.f};
#pragma unroll
        for (int ai = 0; ai < 2; ++ai)
#pragma unroll
            for (int m = 0; m < 4; ++m) { bf16_t* rowp = base + (size_t)(row0 + ai * HALF + m * 16) * ldc + col0;
#pragma unroll
                for (int bj = 0; bj < 2; ++bj) { f32x4 v0 = acc[ai][bj][m][0] + bv[bj][0], v1 = acc[ai][bj][m][1] + bv[bj][1];
                    if (ACT == 1) { f32x2 a = gelu_pk((f32x2){v0[0], v0[1]}), b = gelu_pk((f32x2){v0[2], v0[3]}), c = gelu_pk((f32x2){v1[0], v1[1]}), d = gelu_pk((f32x2){v1[2], v1[3]});
                        v0 = (f32x4){a.x, a.y, b.x, b.y}; v1 = (f32x4){c.x, c.y, d.x, d.y}; }
                    v0 = v0 * sc; v1 = v1 * sc; u32x4 w; w.x = cvt_pk_bf16(v0[0], v0[1]); w.y = cvt_pk_bf16(v0[2], v0[3]); w.z = cvt_pk_bf16(v1[0], v1[1]); w.w = cvt_pk_bf16(v1[2], v1[3]);
                    *(u32x4*)(rowp + bj * HALF) = w; } }
    }
};
__device__ __forceinline__ f32x4 sigm4(f32x4 v) { f32x4 o;
#pragma unroll
    for (int j = 0; j < 4; ++j) o[j] = __builtin_amdgcn_rcpf(1.0f + __builtin_amdgcn_exp2f(-1.4426950408889634f * v[j]));
    return o; }
__device__ __forceinline__ f32x4 gelu4(f32x4 v) { const f32x2 a = gelu_pk((f32x2){v[0], v[1]}), b = gelu_pk((f32x2){v[2], v[3]}); return (f32x4){a.x, a.y, b.x, b.y}; }
__device__ __forceinline__ void unpack8(const u32x4 w, f32x4& lo, f32x4& hi) {
    lo = (f32x4){__uint_as_float(w.x << 16), __uint_as_float(w.x & 0xffff0000u), __uint_as_float(w.y << 16), __uint_as_float(w.y & 0xffff0000u)};
    hi = (f32x4){__uint_as_float(w.z << 16), __uint_as_float(w.z & 0xffff0000u), __uint_as_float(w.w << 16), __uint_as_float(w.w & 0xffff0000u)}; }
struct EpiIn {
    static constexpr bool PERM = true, AFTER_DRAIN = false;
    bf16_t* qkv; bf16_t* lx; bf16_t* gy; bf16_t* ga; bf16_t* gl; const float* bias;
    __device__ __forceinline__ void operator()(const f32x4 (&acc)[2][2][4][2], const Unit& u, int wr, int wc, int fr, int fq) const {
        const int pn = u.pn; bf16_t* base; int ldc, colt, act;
        if (pn < 24) { base = qkv + (size_t)(pn >> 3) * ((size_t)8192 * 2048); ldc = 2048; colt = (pn & 7) * 256; act = 0; }
        else if (pn < 32) { base = lx; ldc = 2048; colt = (pn - 24) * 256; act = 0; }
        else if (pn < 40) { base = gy; ldc = 2048; colt = (pn - 32) * 256; act = 1; }
        else if (pn < 56) { base = ga; ldc = 4096; colt = (pn - 40) * 256; act = 2; }
        else { base = gl; ldc = 4096; colt = (pn - 56) * 256; act = 2; }
        const int row0 = u.pm * BM + wr * 64 + fr, col0 = colt + wc * 32 + 8 * fq, bcol0 = pn * BM + wc * 32 + 8 * fq;
        f32x4 bv[2][2];
#pragma unroll
        for (int bj = 0; bj < 2; ++bj)
#pragma unroll
            for (int n = 0; n < 2; ++n) bv[bj][n] = *(const f32x4*)(bias + bcol0 + bj * HALF + 4 * n);
#pragma unroll
        for (int ai = 0; ai < 2; ++ai)
#pragma unroll
            for (int m = 0; m < 4; ++m) { bf16_t* rowp = base + (size_t)(row0 + ai * HALF + m * 16) * ldc + col0;
#pragma unroll
                for (int bj = 0; bj < 2; ++bj) { f32x4 v0 = acc[ai][bj][m][0] + bv[bj][0], v1 = acc[ai][bj][m][1] + bv[bj][1];
                    if (act == 1) { v0 = gelu4(v0); v1 = gelu4(v1); }
                    else if (act == 2) { v0 = sigm4(v0); v1 = sigm4(v1); }
                    u32x4 w; w.x = cvt_pk_bf16(v0[0], v0[1]); w.y = cvt_pk_bf16(v0[2], v0[3]); w.z = cvt_pk_bf16(v1[0], v1[1]); w.w = cvt_pk_bf16(v1[2], v1[3]);
                    *(u32x4*)(rowp + bj * HALF) = w; } }
    }
};
template <int MODE> struct EpiGate {
    static constexpr bool PERM = true, AFTER_DRAIN = false;
    bf16_t* O; const bf16_t* Gt; int ldc;
    __device__ __forceinline__ void operator()(const f32x4 (&acc)[2][2][4][2], const Unit& u, int wr, int wc, int fr, int fq) const {
        const int row0 = u.pm * BM + wr * 64 + fr, col0 = u.pn * BM + wc * 32 + 8 * fq;
#pragma unroll
        for (int ai = 0; ai < 2; ++ai)
#pragma unroll
            for (int m = 0; m < 4; ++m) { const size_t off = (size_t)(row0 + ai * HALF + m * 16) * ldc + col0;
#pragma unroll
                for (int bj = 0; bj < 2; ++bj) { f32x4 g0, g1; unpack8(*(const u32x4*)(Gt + off + bj * HALF), g0, g1);
                    f32x4 v0 = acc[ai][bj][m][0] * g0, v1 = acc[ai][bj][m][1] * g1;
                    if (MODE == 1) { f32x4 t0, t1; unpack8(*(const u32x4*)(O + off + bj * HALF), t0, t1); v0 += t0; v1 += t1; }
                    u32x4 w; w.x = cvt_pk_bf16(v0[0], v0[1]); w.y = cvt_pk_bf16(v0[2], v0[3]); w.z = cvt_pk_bf16(v1[0], v1[1]); w.w = cvt_pk_bf16(v1[2], v1[3]);
                    *(u32x4*)(O + off + bj * HALF) = w; } }
    }
};
struct EpiRes {
    static constexpr bool PERM = true, AFTER_DRAIN = false;
    const float* X; bf16_t* Out; const float* gate; int ldc; const float* g2a; const float* g2b; bf16_t* XG; float* SSQ;
    __device__ __forceinline__ void operator()(const f32x4 (&acc)[2][2][4][2], const Unit& u, int wr, int wc, int fr, int fq) const {
        const int row0 = u.pm * BM + wr * 64 + fr, col0 = u.pn * BM + wc * 32 + 8 * fq;
        f32x4 gv[2][2], gp[2][2];
#pragma unroll
        for (int bj = 0; bj < 2; ++bj)
#pragma unroll
            for (int n = 0; n < 2; ++n) { gv[bj][n] = *(const f32x4*)(gate + col0 + bj * HALF + 4 * n);
                gp[bj][n] = *(const f32x4*)(g2a + col0 + bj * HALF + 4 * n) * (*(const f32x4*)(g2b + col0 + bj * HALF + 4 * n) + 1.0f); }
#pragma unroll
        for (int ai = 0; ai < 2; ++ai)
#pragma unroll
            for (int m = 0; m < 4; ++m) { const int row = row0 + ai * HALF + m * 16; const size_t off = (size_t)row * ldc + col0; float ss = 0.f;
#pragma unroll
                for (int bj = 0; bj < 2; ++bj) { const f32x4 xa = *(const f32x4*)(X + off + bj * HALF), xb = *(const f32x4*)(X + off + bj * HALF + 4);
                    const f32x4 y0 = xa + gv[bj][0] * acc[ai][bj][m][0], y1 = xb + gv[bj][1] * acc[ai][bj][m][1];
                    ss += ((y0[0] * y0[0] + y0[1] * y0[1]) + (y0[2] * y0[2] + y0[3] * y0[3])) + ((y1[0] * y1[0] + y1[1] * y1[1]) + (y1[2] * y1[2] + y1[3] * y1[3]));
                    u32x4 w; w.x = cvt_pk_bf16(y0[0], y0[1]); w.y = cvt_pk_bf16(y0[2], y0[3]); w.z = cvt_pk_bf16(y1[0], y1[1]); w.w = cvt_pk_bf16(y1[2], y1[3]); *(u32x4*)(Out + off + bj * HALF) = w;
                    const f32x4 g0 = y0 * gp[bj][0], g1 = y1 * gp[bj][1];
                    u32x4 wg; wg.x = cvt_pk_bf16(g0[0], g0[1]); wg.y = cvt_pk_bf16(g0[2], g0[3]); wg.z = cvt_pk_bf16(g1[0], g1[1]); wg.w = cvt_pk_bf16(g1[2], g1[3]); *(u32x4*)(XG + off + bj * HALF) = wg; }
                ss += __shfl_xor(ss, 16); ss += __shfl_xor(ss, 32);
                if (fq == 0) SSQ[(size_t)row * 64 + u.pn * 4 + wc] = ss; }
    }
};
struct EpiQ2 {
    static constexpr bool PERM = true, AFTER_DRAIN = false;
    bf16_t* O; int ldc; const float* sb; const PG8_LAS float* rs; mutable int ne;
    __device__ __forceinline__ void operator()(const f32x4 (&acc)[2][2][4][2], const Unit& u, int wr, int wc, int fr, int fq) const {
        const int rl0 = wr * 64 + fr, row0 = u.pm * BM + rl0, col0 = u.pn * BM + wc * 32 + 8 * fq; const PG8_LAS float* rsp = rs + ((ne++) & 1) * 256;
        f32x4 bv[2][2];
#pragma unroll
        for (int bj = 0; bj < 2; ++bj)
#pragma unroll
            for (int n = 0; n < 2; ++n) bv[bj][n] = *(const f32x4*)(sb + col0 + bj * HALF + 4 * n);
#pragma unroll
        for (int ai = 0; ai < 2; ++ai)
#pragma unroll
            for (int m = 0; m < 4; ++m) { const float r = rsp[rl0 + ai * HALF + m * 16]; bf16_t* rowp = O + (size_t)(row0 + ai * HALF + m * 16) * ldc + col0;
#pragma unroll
                for (int bj = 0; bj < 2; ++bj) { const f32x4 v0 = acc[ai][bj][m][0] * r + bv[bj][0], v1 = acc[ai][bj][m][1] * r + bv[bj][1];
                    u32x4 w; w.x = cvt_pk_bf16(v0[0], v0[1]); w.y = cvt_pk_bf16(v0[2], v0[3]); w.z = cvt_pk_bf16(v1[0], v1[1]); w.w = cvt_pk_bf16(v1[2], v1[3]);
                    *(u32x4*)(rowp + bj * HALF) = w; } }
    }
};
struct RstdOrder : StaticOrder {
    const float* SSQ; PG8_LAS float* rs; float inv_n, eps; mutable int na;
    __device__ __forceinline__ void a_ready(const Unit& u) const {
        const int tid = threadIdx.x, r = tid >> 1, hf = tid & 1; const f32x4* p = (const f32x4*)(SSQ + (size_t)(u.pm * BM + r) * 64 + hf * 32); float s = 0.f;
#pragma unroll
        for (int k = 0; k < 8; ++k) { const f32x4 v = p[k]; s += (v[0] + v[1]) + (v[2] + v[3]); }
        s += __shfl_xor(s, 1);
        if (hf == 0) rs[(na & 1) * 256 + r] = 1.0f / sqrtf(s * inv_n + eps);
        ++na;
    }
};
template <class Epi, class Sched, bool ALIGN_EPI = false, bool SP2 = false>
__device__ __forceinline__ void gemm_phase(PG8_LAS unsigned char* lds, const Gemm g, const Sched& S, const Epi& E) {
    const int tid = threadIdx.x, wid = __builtin_amdgcn_readfirstlane(tid >> 6), lane = tid & 63, wr = wid >> 2, wc = wid & 3, fr = lane & 15, fq = lane >> 4;
    const int K = g.K, nt = K / BK;
    unsigned voffA[2], voffB[2];
#pragma unroll
    for (int i = 0; i < 2; ++i) { int R, C; stage_rc(tid * 16 + i * 8192, R, C); const int Rb = Epi::PERM ? ((R & ~31) + perm32(R & 31)) : R;
        voffA[i] = (unsigned)(R * K + C) * 2u; voffB[i] = (unsigned)(Rb * K + C) * 2u; }
    const size_t kstep = (size_t)(BK * 2);
    const size_t hstep = (size_t)HALF * K * 2;
    const size_t tstep = 2 * hstep;
    const unsigned ldsw = (unsigned)wid * 1024u;
    const int aoff = lds_byte(wr * 64 + fr, fq * 8), boff = lds_byte(wc * 32 + fr, fq * 8);
#define PG8_SA(b, h) (((b) * 2 + (h)) * HTB)
#define PG8_SB(b, h) ((4 + (b) * 2 + (h)) * HTB)
#define PG8_STAGE(bufoff, gbase, voff) do { _Pragma("unroll") for (int _i = 0; _i < 2; ++_i) \
        __builtin_amdgcn_global_load_lds((const unsigned*)((const char*)(gbase) + (voff)[_i]), (PG8_LAS unsigned*)(lds + (bufoff) + ldsw + _i * 8192), 16, 0, 0); } while (0)
#define PG8_LDA(dst, b, h) do { _Pragma("unroll") for (int m = 0; m < 4; ++m) _Pragma("unroll") for (int k = 0; k < 2; ++k) dst[m][k] = *(const PG8_LAS bf16x8*)(lds + PG8_SA(b, h) + aoff + m * 2048 + k * 1024); } while (0)
#define PG8_LDB(dst, b, h) do { _Pragma("unroll") for (int n = 0; n < 2; ++n) _Pragma("unroll") for (int k = 0; k < 2; ++k) dst[n][k] = *(const PG8_LAS bf16x8*)(lds + PG8_SB(b, h) + boff + n * 2048 + k * 1024); } while (0)
#define PG8_MMA(ai, bj, At, Bt) do { __builtin_amdgcn_s_setprio(1); _Pragma("unroll") for (int m = 0; m < 4; ++m) _Pragma("unroll") for (int n = 0; n < 2; ++n) _Pragma("unroll") for (int k = 0; k < 2; ++k) \
        acc[ai][bj][m][n] = __builtin_amdgcn_mfma_f32_16x16x32_bf16(Bt[n][k], At[m][k], acc[ai][bj][m][n], 0, 0, 0); __builtin_amdgcn_s_setprio(0); } while (0)
#define PG8_WAIT_V(n) asm volatile("s_waitcnt vmcnt(" #n ")" ::: "memory")
#define PG8_WAIT_L(n) asm volatile("s_waitcnt lgkmcnt(" #n ")" ::: "memory")
#define PG8_BAR __builtin_amdgcn_s_barrier()
#define PG8_SCHED __builtin_amdgcn_sched_barrier(0)
    Unit cur, nxt; int ui = 0;
    if (!S.next(0, cur)) return;
    f32x4 acc[2][2][4][2];
#pragma unroll
    for (int a = 0; a < 2; ++a)
#pragma unroll
        for (int b = 0; b < 2; ++b)
#pragma unroll
            for (int m = 0; m < 4; ++m)
#pragma unroll
                for (int n = 0; n < 2; ++n) acc[a][b][m][n] = (f32x4){0.f, 0.f, 0.f, 0.f};
    bf16x8 At[4][2], B0[2][2], B1[2][2];
    const char* cA = (const char*)g.A + (size_t)cur.pm * tstep; const char* cB = (const char*)g.Bt + (size_t)cur.pn * tstep;
    S.a_ready(cur);
    if constexpr (SP2) {
        PG8_STAGE(PG8_SB(0, 0), cB, voffB); PG8_STAGE(PG8_SB(0, 1), cB + hstep, voffB); PG8_STAGE(PG8_SA(0, 0), cA, voffA); PG8_STAGE(PG8_SA(0, 1), cA + hstep, voffA);
        if (wr == 1) PG8_BAR;
        PG8_WAIT_V(2); PG8_BAR;
        PG8_STAGE(PG8_SB(1, 0), cB + kstep, voffB); PG8_STAGE(PG8_SA(1, 0), cA + kstep, voffA); PG8_STAGE(PG8_SB(1, 1), cB + hstep + kstep, voffB);
        PG8_WAIT_V(6); PG8_BAR;
    } else {
        PG8_STAGE(PG8_SB(0, 0), cB, voffB); PG8_STAGE(PG8_SA(0, 0), cA, voffA); PG8_STAGE(PG8_SB(0, 1), cB + hstep, voffB); PG8_STAGE(PG8_SA(0, 1), cA + hstep, voffA);
        if (wr == 1) PG8_BAR;
        PG8_WAIT_V(4); PG8_BAR;
        PG8_STAGE(PG8_SB(1, 0), cB + kstep, voffB); PG8_STAGE(PG8_SA(1, 0), cA + kstep, voffA); PG8_STAGE(PG8_SB(1, 1), cB + hstep + kstep, voffB);
        PG8_WAIT_V(6); PG8_BAR;
    }
    for (;;) {
        const bool has_next = S.next(ui + 1, nxt);
        const char* nA = has_next ? (const char*)g.A + (size_t)nxt.pm * tstep : cA; const char* nB = has_next ? (const char*)g.Bt + (size_t)nxt.pn * tstep : cB;
        for (int t = 0; t < nt; t += 2) {
            const bool last = (t == nt - 2);
            const char* a1 = cA + (size_t)(t + 1) * kstep;
            const char* a2 = last ? nA : cA + (size_t)(t + 2) * kstep; const char* b2 = last ? nB : cB + (size_t)(t + 2) * kstep;
            const char* a3 = a2 + kstep; const char* b3 = b2 + kstep;
            if (last && has_next) S.a_ready(nxt);
            if constexpr (SP2) {
            PG8_LDB(B0, 0, 0); PG8_LDB(B1, 0, 1); PG8_SCHED; PG8_LDA(At, 0, 0); PG8_STAGE(PG8_SA(1, 1), a1 + hstep, voffA);
            PG8_WAIT_V(8); PG8_WAIT_L(0); PG8_BAR; PG8_MMA(0, 0, At, B0); PG8_MMA(0, 1, At, B1); PG8_BAR; PG8_SCHED;
            PG8_LDA(At, 0, 1); PG8_STAGE(PG8_SB(0, 0), b2, voffB); PG8_STAGE(PG8_SB(0, 1), b2 + hstep, voffB); PG8_STAGE(PG8_SA(0, 0), a2, voffA);
            PG8_WAIT_V(8); PG8_WAIT_L(0); PG8_BAR; PG8_MMA(1, 0, At, B0); PG8_MMA(1, 1, At, B1); PG8_BAR; PG8_SCHED;
            PG8_LDB(B0, 1, 0); PG8_LDB(B1, 1, 1); PG8_SCHED; PG8_LDA(At, 1, 0); PG8_STAGE(PG8_SA(0, 1), a2 + hstep, voffA);
            PG8_WAIT_V(8); PG8_WAIT_L(0); PG8_BAR; PG8_MMA(0, 0, At, B0); PG8_MMA(0, 1, At, B1); PG8_BAR; PG8_SCHED;
            PG8_LDA(At, 1, 1); PG8_STAGE(PG8_SB(1, 0), b3, voffB); PG8_STAGE(PG8_SB(1, 1), b3 + hstep, voffB); PG8_STAGE(PG8_SA(1, 0), a3, voffA);
            PG8_WAIT_V(8); PG8_WAIT_L(0); PG8_BAR; PG8_MMA(1, 0, At, B0); PG8_MMA(1, 1, At, B1); PG8_BAR; PG8_SCHED;
            } else {
            PG8_LDB(B0, 0, 0); PG8_SCHED; PG8_LDA(At, 0, 0); PG8_STAGE(PG8_SA(1, 1), a1 + hstep, voffA);
            PG8_WAIT_L(8); PG8_BAR; PG8_WAIT_L(0); PG8_MMA(0, 0, At, B0); PG8_BAR; PG8_SCHED;
            PG8_LDB(B1, 0, 1); PG8_STAGE(PG8_SB(0, 0), b2, voffB);
            PG8_BAR; PG8_WAIT_L(0); PG8_MMA(0, 1, At, B1); PG8_BAR;
            PG8_LDA(At, 0, 1); PG8_STAGE(PG8_SA(0, 0), a2, voffA);
            PG8_BAR; PG8_WAIT_L(0); PG8_MMA(1, 0, At, B0); PG8_BAR; PG8_SCHED;
            PG8_STAGE(PG8_SB(0, 1), b2 + hstep, voffB);
            PG8_WAIT_V(6); PG8_BAR; PG8_MMA(1, 1, At, B1); PG8_BAR;
            PG8_LDB(B0, 1, 0); PG8_SCHED; PG8_LDA(At, 1, 0); PG8_STAGE(PG8_SA(0, 1), a2 + hstep, voffA);
            PG8_WAIT_L(8); PG8_BAR; PG8_WAIT_L(0); PG8_MMA(0, 0, At, B0); PG8_BAR; PG8_SCHED;
            PG8_LDB(B1, 1, 1); PG8_STAGE(PG8_SB(1, 0), b3, voffB);
            PG8_BAR; PG8_WAIT_L(0); PG8_MMA(0, 1, At, B1); PG8_BAR;
            PG8_LDA(At, 1, 1); PG8_STAGE(PG8_SA(1, 0), a3, voffA);
            PG8_BAR; PG8_WAIT_L(0); PG8_MMA(1, 0, At, B0); PG8_BAR; PG8_SCHED;
            PG8_STAGE(PG8_SB(1, 1), b3 + hstep, voffB);
            PG8_WAIT_V(6); PG8_BAR; PG8_MMA(1, 1, At, B1); PG8_BAR;
            }
        }
        if constexpr (ALIGN_EPI) { if (wr == 0) PG8_BAR; }
        if constexpr (!Epi::AFTER_DRAIN) { E(acc, cur, wr, wc, fr, fq); S.done(cur); }
        if (!has_next) break;
#pragma unroll
        for (int a = 0; a < 2; ++a)
#pragma unroll
            for (int b = 0; b < 2; ++b)
#pragma unroll
                for (int m = 0; m < 4; ++m)
#pragma unroll
                    for (int n = 0; n < 2; ++n) acc[a][b][m][n] = (f32x4){0.f, 0.f, 0.f, 0.f};
        cur = nxt; cA = nA; cB = nB; ++ui;
        if constexpr (ALIGN_EPI) { if (wr == 1) PG8_BAR; }
    }
    PG8_WAIT_V(0);
    if constexpr (!ALIGN_EPI) { if (wr == 0) PG8_BAR; }
    PG8_BAR;
    if constexpr (Epi::AFTER_DRAIN) { E.fused(acc, cur, wr, wc, fr, fq, lds, wid, lane); S.done(cur); }
#undef PG8_SA
#undef PG8_SB
#undef PG8_STAGE
#undef PG8_LDA
#undef PG8_LDB
#undef PG8_MMA
#undef PG8_WAIT_V
#undef PG8_WAIT_L
#undef PG8_BAR
#undef PG8_SCHED
}
}
namespace attn_body {
constexpr int D = 128, LD = 2048;
constexpr float THR = 8.f; constexpr bool WSKIP = false;
constexpr float SCALE = 0.08838834764831845f;
constexpr int NW = 8, QBLK = 32, KVBLK = 64, QB = NW * QBLK;
constexpr int SHM_V = KVBLK * D * 2, SHM_K = KVBLK * D * 2;
constexpr int LDS_BYTES = 2 * SHM_V + 2 * SHM_K + NW * 64 * 4;

typedef short bf16x8 __attribute__((ext_vector_type(8)));
typedef short s16x4 __attribute__((ext_vector_type(4)));
typedef float f32x16 __attribute__((ext_vector_type(16)));
typedef float f32x4 __attribute__((ext_vector_type(4)));
typedef unsigned u32x4 __attribute__((ext_vector_type(4)));
template <class A, class Bt> struct same_t { static constexpr bool v = false; };
template <class A> struct same_t<A, A> { static constexpr bool v = true; };

#define KSWZ(row, colB) ((row) * 256 + ((colB) ^ (((row) & 7) << 4)))
#define SBAR() __builtin_amdgcn_sched_barrier(0)
__device__ __forceinline__ int v_st(int k, int c) { const int kk = (k & ~0xC) | ((k & 4) << 1) | ((k & 8) >> 1); return ((kk >> 3) * 4 + (c >> 5)) * 512 + ((kk & 7) * 32 + (c & 31)) * 2; }
__device__ __forceinline__ int v_rd_base(int lane) { return ((lane & 3) << 3) | (((lane >> 2) & 3) << 6) | (((lane >> 4) & 1) << 5) | (((lane >> 5) & 1) << 8); }
constexpr int v_rd_off(int d0, int ks, int half) { return d0 * 512 + ks * 4096 + half * 2048; }
__device__ __forceinline__ int crow(int r, int hi) { return (r & 3) + 8 * (r >> 2) + 4 * hi; }
__device__ __forceinline__ unsigned cvtpk(float lo, float hi) {
    unsigned r; asm volatile("v_cvt_pk_bf16_f32 %0, %1, %2" : "=v"(r) : "v"(lo), "v"(hi)); return r;
}
__device__ __forceinline__ bf16x8 pack8(f32x4 a, f32x4 b) {
    u32x4 w = {cvtpk(a[0], a[1]), cvtpk(a[2], a[3]), cvtpk(b[0], b[1]), cvtpk(b[2], b[3])};
    return *reinterpret_cast<bf16x8*>(&w);
}
template <class T> __device__ __forceinline__ bf16x8 load8(const T* p) {
    if constexpr (same_t<T, float>::v) { return pack8(*(const f32x4*)p, *(const f32x4*)(p + 4)); }
    else { return *reinterpret_cast<const bf16x8*>(p); }
}
__device__ __forceinline__ void mask_tile(f32x16& p0, f32x16& p1, int dq, unsigned W) {
    const float NEG = -__builtin_inff();
#pragma unroll
    for (int r = 0; r < 16; ++r) {
        const int c = (r & 3) + 8 * (r >> 2);
        if ((unsigned)(dq - c) >= W) p0[r] = NEG;
        if ((unsigned)(dq - c - 32) >= W) p1[r] = NEG;
    }
}
__device__ __forceinline__ void partialSM(f32x16& p0, f32x16& p1, float& m_reg, float& mn, float& alpha) {
    float pmax = p0[0]; for (int r = 1; r < 16; ++r) pmax = fmaxf(pmax, p0[r]); for (int r = 0; r < 16; ++r) pmax = fmaxf(pmax, p1[r]);
    { auto rr = __builtin_amdgcn_permlane32_swap(__float_as_uint(pmax), __float_as_uint(pmax), false, false);
      pmax = fmaxf(__uint_as_float(rr[0]), __uint_as_float(rr[1])); }
    constexpr float C2 = 1.4426950408889634f * SCALE;
    if (__builtin_expect(__all((pmax - m_reg) * SCALE <= THR), 1)) { mn = m_reg; alpha = 1.f; }
    else { mn = fmaxf(m_reg, pmax); alpha = __builtin_amdgcn_exp2f((m_reg - mn) * C2); m_reg = mn; }
    const float mnL = -mn * C2;
    for (int r = 0; r < 16; ++r) p0[r] = fmaf(p0[r], C2, mnL); for (int r = 0; r < 16; ++r) p1[r] = fmaf(p1[r], C2, mnL);
    for (int r = 0; r < 16; ++r) p0[r] = __builtin_amdgcn_exp2f(p0[r]);
}
__device__ __forceinline__ void finishSM(f32x16& p0, f32x16& p1, float alpha, float& l_reg, bf16x8& pa0, bf16x8& pa1, bf16x8& pa2, bf16x8& pa3) {
    for (int r = 0; r < 16; ++r) p1[r] = __builtin_amdgcn_exp2f(p1[r]);
    float ps = 0; for (int r = 0; r < 16; ++r) ps += p0[r]; for (int r = 0; r < 16; ++r) ps += p1[r];
    { auto rr = __builtin_amdgcn_permlane32_swap(__float_as_uint(ps), __float_as_uint(ps), false, false);
      ps = __uint_as_float(rr[0]) + __uint_as_float(rr[1]); }
    l_reg = l_reg * alpha + ps;
#define PK4(P, B_, OUT) do { unsigned a0 = cvtpk(P[B_+0], P[B_+1]), a1 = cvtpk(P[B_+2], P[B_+3]);                          \
        unsigned b0 = cvtpk(P[B_+4], P[B_+5]), b1 = cvtpk(P[B_+6], P[B_+7]);                                             \
        auto r0 = __builtin_amdgcn_permlane32_swap(a0, b0, false, false); auto r1 = __builtin_amdgcn_permlane32_swap(a1, b1, false, false); \
        u32x4 w = {r0[0], r1[0], r0[1], r1[1]}; OUT = *reinterpret_cast<bf16x8*>(&w); } while (0)
    PK4(p0, 0, pa0); PK4(p0, 8, pa1); PK4(p1, 0, pa2); PK4(p1, 8, pa3);
#undef PK4
}
template <int KB, bool SK>
__device__ __forceinline__ void qkt(f32x16& p0, f32x16& p1, const char* K_lds, int r32, int hi, const bf16x8* qr, bool act, const float* bt) {
    if (SK && !act) { const float NEG = -__builtin_inff();
#pragma unroll
        for (int r = 0; r < 16; ++r) { p0[r] = NEG; p1[r] = NEG; } return; }
    { const f32x4 b0 = *(const f32x4*)(bt), b1 = *(const f32x4*)(bt + 8), b2 = *(const f32x4*)(bt + 16), b3 = *(const f32x4*)(bt + 24);
      const f32x4 c0 = *(const f32x4*)(bt + 32), c1 = *(const f32x4*)(bt + 40), c2 = *(const f32x4*)(bt + 48), c3 = *(const f32x4*)(bt + 56);
      p0 = (f32x16){b0[0], b0[1], b0[2], b0[3], b1[0], b1[1], b1[2], b1[3], b2[0], b2[1], b2[2], b2[3], b3[0], b3[1], b3[2], b3[3]};
      p1 = (f32x16){c0[0], c0[1], c0[2], c0[3], c1[0], c1[1], c1[2], c1[3], c2[0], c2[1], c2[2], c2[3], c3[0], c3[1], c3[2], c3[3]}; }
    const char* kb[4];
#pragma unroll
    for (int dd = 0; dd < 4; ++dd) kb[dd] = K_lds + KB * SHM_K + KSWZ(r32, (dd * 16 + hi * 8) * 2);
#pragma unroll
    for (int d0 = 0; d0 < 8; ++d0) { const char* a = kb[d0 & 3] + (d0 >> 2) * 128;
        bf16x8 b0 = *reinterpret_cast<const bf16x8*>(a);
        bf16x8 b1 = *reinterpret_cast<const bf16x8*>(a + 32 * 256);
        p0 = __builtin_amdgcn_mfma_f32_32x32x16_bf16(b0, qr[d0], p0, 0, 0, 0);
        p1 = __builtin_amdgcn_mfma_f32_32x32x16_bf16(b1, qr[d0], p1, 0, 0, 0); }
}
template <int VB, bool SK>
__device__ __forceinline__ void pv_tile(f32x16* o, int vb0, bf16x8 pa0, bf16x8 pa1, bf16x8 pa2, bf16x8 pa3, bool act) {
    if (SK && !act) return;
#define TRRD(dst, off) asm volatile("ds_read_b64_tr_b16 %0, %1 offset:%2" : "=&v"(dst) : "v"(vb0), "i"(off) : "memory")
#define PV_D0(d0) do { s16x4 l0, l1, l2, l3, h0, h1, h2, h3; constexpr int b_ = VB * SHM_V + v_rd_off(d0, 0, 0);     \
        TRRD(l0, b_); TRRD(h0, b_ + 2048); TRRD(l1, b_ + 4096); TRRD(h1, b_ + 6144); TRRD(l2, b_ + 8192); TRRD(h2, b_ + 10240); TRRD(l3, b_ + 12288); TRRD(h3, b_ + 14336); \
        asm volatile("s_waitcnt lgkmcnt(0)" ::: "memory"); SBAR();                 \
        o[d0] = __builtin_amdgcn_mfma_f32_32x32x16_bf16(pa0, (bf16x8){l0[0], l0[1], l0[2], l0[3], h0[0], h0[1], h0[2], h0[3]}, o[d0], 0, 0, 0);   \
        o[d0] = __builtin_amdgcn_mfma_f32_32x32x16_bf16(pa1, (bf16x8){l1[0], l1[1], l1[2], l1[3], h1[0], h1[1], h1[2], h1[3]}, o[d0], 0, 0, 0);   \
        o[d0] = __builtin_amdgcn_mfma_f32_32x32x16_bf16(pa2, (bf16x8){l2[0], l2[1], l2[2], l2[3], h2[0], h2[1], h2[2], h2[3]}, o[d0], 0, 0, 0);   \
        o[d0] = __builtin_amdgcn_mfma_f32_32x32x16_bf16(pa3, (bf16x8){l3[0], l3[1], l3[2], l3[3], h3[0], h3[1], h3[2], h3[3]}, o[d0], 0, 0, 0); } while (0)
    PV_D0(0); PV_D0(1); PV_D0(2); PV_D0(3);
#undef PV_D0
#undef TRRD
}


template <class TIn, class TOut> struct BlockRef { const TIn* Q; const TIn* K; const TIn* V; TOut* O; int P0; int jlo; };
#define ROW(p, k0, rr) ((p) + (size_t)((k0) + (rr)) * LD + sc)
#define VMW() asm volatile("s_waitcnt vmcnt(0)" ::: "memory")
#define SLOAD_H(Kp, Vp, k0) do { st_v0 = load8<TIn>(ROW(Vp, k0, sr)); st_v1 = load8<TIn>(ROW(Vp, k0, 32 + sr));              \
                         st_k0 = load8<TIn>(ROW(Kp, k0, sr)); st_k1 = load8<TIn>(ROW(Kp, k0, 32 + sr)); } while (0)
#define SWRITE_H(bf) do { *(bf16x8*)(V_lds + (bf) * SHM_V + vst0) = st_v0; *(bf16x8*)(V_lds + (bf) * SHM_V + vst1) = st_v1;   \
                          *(bf16x8*)(K_lds + (bf) * SHM_K + kws) = st_k0; *(bf16x8*)(K_lds + (bf) * SHM_K + kws + 32 * 256) = st_k1; } while (0)
template <class TIn, class TOut>
__device__ __forceinline__ void attn_unit(const BlockRef<TIn, TOut>& cur, int skv, char* lds) {
    const int tid = threadIdx.x, wid = __builtin_amdgcn_readfirstlane(tid >> 6), lane = tid & 63, r32 = lane & 31, hi = lane >> 5;
    const unsigned W = 0x40000000u;
    const int j_lo = cur.jlo;
    int j_hi = (cur.P0 + QB - 1) / KVBLK + 1; if (j_hi > skv / KVBLK) j_hi = skv / KVBLK;
    const int NT = j_hi - j_lo;
    const int qlo = cur.P0 + wid * QBLK, qm = qlo + r32 - 4 * hi;
    char* V_lds = lds; char* K_lds = lds + 2 * SHM_V;
    float* ws = (float*)(lds + 2 * SHM_V + 2 * SHM_K) + wid * 64; float* li_l = ws, * al_l = ws + 32;
    const float* bias_l = (const float*)(lds + LDS_BYTES) + 4 * hi;
    float m_reg = -1e30f, l_reg = 0; f32x16 o[4] = {};
    const int sr = tid >> 4, sc = (tid & 15) * 8, vst0 = v_st(sr, sc), vst1 = v_st(32 + sr, sc), kws = KSWZ(sr, sc * 2);
    const int vb0 = (int)(uintptr_t)V_lds + v_rd_base(lane);
    const TIn* Kh = cur.K; const TIn* Vh = cur.V;
    bf16x8 st_v0, st_v1, st_k0, st_k1; bf16x8 qr[8];
#define KBASE(t) ((j_lo + (t)) * KVBLK)
#define BT(t) (bias_l + (t) * KVBLK)
#define RESC(a) do { if (__any((a) < 1.f)) { if (hi == 0) al_l[r32] = (a); asm volatile("s_waitcnt lgkmcnt(0)" ::: "memory");              \
                     for (int d_ = 0; d_ < 4; ++d_) for (int r = 0; r < 16; ++r) o[d_][r] *= al_l[crow(r, hi)]; } } while (0)
#define MASKT(P0_, P1_, t) do { const int kb_ = KBASE(t); if (kb_ + KVBLK - 1 > qlo) mask_tile(P0_, P1_, qm - kb_, W); } while (0)
#pragma unroll
    for (int d0 = 0; d0 < 8; ++d0) qr[d0] = load8<TIn>(cur.Q + (size_t)(wid * QBLK + r32) * LD + d0 * 16 + hi * 8);
    SLOAD_H(Kh, Vh, KBASE(0)); VMW(); SWRITE_H(0); SBAR();
    if (NT > 1) SLOAD_H(Kh, Vh, KBASE(1));
    __syncthreads();
    f32x16 p0, p1; float mn, al; bf16x8 pa0, pa1, pa2, pa3;
#define TILE_STEP(t, BUF) do {                                                                                                 \
        SBAR(); qkt<BUF, false>(p0, p1, K_lds, r32, hi, qr, true, BT(t));                                                       \
        MASKT(p0, p1, (t)); partialSM(p0, p1, m_reg, mn, al); RESC(al);                                                          \
        finishSM(p0, p1, al, l_reg, pa0, pa1, pa2, pa3); SBAR();                                                                 \
        pv_tile<BUF, false>(o, vb0, pa0, pa1, pa2, pa3, true);                                                                    \
        if ((t) + 1 < NT) { VMW(); SWRITE_H(1 - (BUF)); SBAR(); if ((t) + 2 < NT) SLOAD_H(Kh, Vh, KBASE((t) + 2)); }              \
        __syncthreads(); } while (0)
    for (int t = 0; t < NT; t += 2) {
        TILE_STEP(t, 0);
        if (t + 1 < NT) TILE_STEP(t + 1, 1);
    }
    if (hi == 0) li_l[r32] = l_reg; asm volatile("s_waitcnt lgkmcnt(0)" ::: "memory");
    float rli[16];
#pragma unroll
    for (int r = 0; r < 16; ++r) rli[r] = __builtin_amdgcn_rcpf(li_l[crow(r, hi)]);
    TOut* Ow = cur.O + (size_t)(wid * QBLK) * LD;
#pragma unroll
    for (int r = 0; r < 16; ++r) { const int orow = crow(r, hi);
#pragma unroll
        for (int d0 = 0; d0 < 4; ++d0) { const float v = o[d0][r] * rli[r];
            const float vn = __shfl_xor(v, 1);
            if ((r32 & 1) == 0) *(unsigned*)(Ow + (size_t)orow * LD + d0 * 32 + r32) = cvtpk(v, vn); } }
    __syncthreads();
#undef TILE_STEP
#undef RESC
#undef KBASE
#undef BT
#undef MASKT
}
#undef ROW
#undef VMW
#undef SLOAD_H
#undef SWRITE_H
}
#define GAS __attribute__((address_space(1)))
#define LAS __attribute__((address_space(3)))
typedef unsigned short bf16;
typedef unsigned v4u __attribute__((ext_vector_type(4)));
typedef unsigned v2u __attribute__((ext_vector_type(2)));
typedef float f32x4 __attribute__((ext_vector_type(4)));
typedef float f32x2 __attribute__((ext_vector_type(2)));
typedef short bf16x8 __attribute__((ext_vector_type(8)));
typedef GAS unsigned gu32;
#define RLX_AGENT __ATOMIC_RELAXED, __HIP_MEMORY_SCOPE_AGENT

constexpr int S = 8192, DM = 4096, NH = 16, HD = 128, AW = 2048, LW = 2048, NG = 16, GD = 128;
constexpr int NIN = 18448, NINP = 18432;
constexpr int C_Q = 0, C_K = 2048, C_V = 4096, C_F = 6144, C_LX = 6160, C_LY = 8208, C_GA = 10256, C_GL = 14352;
constexpr int PEER_H = 8, PEER_NK = 128, PEER_K = 16, PEER_NE = 16384;
constexpr float EPS = 1e-6f;
constexpr size_t MiB = 1u << 20;
constexpr size_t WS_CTL = 0, CTL_ZERO_BYTES = 32768;
constexpr size_t WS_MOD = 512 * 1024;
constexpr size_t WS_WF = 2 * MiB;
constexpr size_t WS_LOGF = 3 * MiB;
constexpr size_t WS_FC = 4 * MiB;
constexpr size_t WS_AGGA = 5 * MiB, WS_AGGB = 6 * MiB;
constexpr size_t WS_BIASR = 7 * MiB, WS_SB = 7 * MiB + 262144;
constexpr size_t WS_SSQ = 28 * MiB;
constexpr size_t WS_WAT = 8 * MiB, WS_WXT = 9 * MiB;
constexpr size_t WS_SK = 10 * MiB, WS_RS = 11 * MiB, WS_RSU = 11 * MiB + 65536;
constexpr size_t WS_IDX = 12 * MiB, WS_GATE = 16 * MiB, WS_IDX2 = 20 * MiB, WS_GATE2 = 24 * MiB;
constexpr size_t WS_WIN = 32 * MiB, WS_WAO = 176 * MiB, WS_WLO = 192 * MiB, WS_WOUT = 208 * MiB, WS_WPQ = 240 * MiB;
constexpr size_t WS_U = 256 * MiB, WS_V = 384 * MiB;
constexpr size_t WS_HA = 512 * MiB;
constexpr size_t WS_QKV = 576 * MiB;
constexpr size_t WS_LX = 672 * MiB, WS_GY = 704 * MiB, WS_GA = 736 * MiB, WS_GL = 800 * MiB;
constexpr size_t WS_ATT = 864 * MiB, WS_LR = 896 * MiB, WS_T1 = 928 * MiB, WS_MG = 992 * MiB, WS_Q2 = 1056 * MiB, WS_X1 = 1088 * MiB, WS_END = 1216 * MiB;
constexpr int CW_BAR = 4096;
constexpr int CW_QATT = 256;
constexpr int RING_BYTES = 131072;
constexpr int LDSCTL_OFF = 150528, MISC_OFF = LDSCTL_OFF + 320;
constexpr int LDS_BYTES = 151552;
constexpr int NWAVES = 8, NTHREADS = 512;

__device__ __forceinline__ unsigned f2bf(float f) { unsigned u = __builtin_bit_cast(unsigned, f); return (u + 0x7fffu + ((u >> 16) & 1u)) >> 16; }
__device__ __forceinline__ unsigned pk2(float lo, float hi) { return f2bf(lo) | (f2bf(hi) << 16); }
__device__ __forceinline__ float bflo(unsigned w) { return __uint_as_float(w << 16); }
__device__ __forceinline__ float bfhi(unsigned w) { return __uint_as_float(w & 0xffff0000u); }
__device__ __forceinline__ float bf2f(bf16 b) { return __uint_as_float((unsigned)b << 16); }
__device__ __forceinline__ float wave_sum(float v) {
#pragma unroll
    for (int o = 1; o < 64; o <<= 1) v += __shfl_xor(v, o);
    return v;
}
__device__ __forceinline__ float wave_max(float v) {
#pragma unroll
    for (int o = 1; o < 64; o <<= 1) v = fmaxf(v, __shfl_xor(v, o));
    return v;
}
__device__ __forceinline__ float sigmoidf_(float v) { return __builtin_amdgcn_rcpf(1.0f + __builtin_amdgcn_exp2f(-1.4426950408889634f * v)); }
__device__ __forceinline__ float gelu_erf(float v) { return 0.5f * v * (1.0f + erff(v * 0.70710678118654752f)); }
#define XB_TMO      128
#define XB_XCNT(j)  (256  + 64 * (j))
#define XB_XSUB(j)  (1280 + 64 * (j))
#define XB_XGEN(j)  (2304 + 64 * (j))
#define XB_TOP      3328
#define XB_TOPGEN   3392
#define XCD_BAR_WORDS 3456
#define XB_SPIN_CAP (1u << 18)

__device__ __forceinline__ unsigned xb_ld(unsigned* p)              { return __hip_atomic_load(p, __ATOMIC_RELAXED, __HIP_MEMORY_SCOPE_AGENT); }
__device__ __forceinline__ unsigned xb_add(unsigned* p, unsigned v) { return __hip_atomic_fetch_add(p, v, __ATOMIC_RELAXED, __HIP_MEMORY_SCOPE_AGENT); }
__device__ __forceinline__ unsigned xb_xcc_id() { return (unsigned)__builtin_amdgcn_s_getreg((3 << 11) | 20) & 0xFu; }
#define XB_SPIN(cond, bar) do { unsigned _sp = 0; while (cond) { __builtin_amdgcn_s_sleep(1); \
    if ((++_sp & 255u) == 0u) { if (xb_ld(&(bar)[XB_TMO])) break; if (_sp > XB_SPIN_CAP) { atomicAdd(&(bar)[XB_TMO], 1u); break; } } } } while (0)

struct XcdBarrier {
    unsigned* bar; unsigned x;
    volatile LAS unsigned* st;
};

__device__ __forceinline__ XcdBarrier xcd_barrier_post(unsigned* bar, volatile LAS unsigned* st) {
    XcdBarrier b; b.bar = bar; b.x = xb_xcc_id(); b.st = st;
    if (threadIdx.x == 0) (void)xb_add(&bar[XB_XCNT(b.x)], 1u);
    return b;
}
__device__ __forceinline__ void xcd_barrier_complete(unsigned* bar, unsigned x, unsigned& nloc, unsigned& nx) {
    const unsigned G = gridDim.x * gridDim.y * gridDim.z;
    unsigned sum, cnt, mine, sp = 0u;
    for (;;) {
        sum = 0u; cnt = 0u; mine = 0u;
#pragma unroll
        for (unsigned j = 0; j < 16; ++j) { const unsigned c = xb_ld(&bar[XB_XCNT(j)]); sum += c; cnt += (c > 0u) ? 1u : 0u; mine = (j == x) ? c : mine; }
        if (sum == G) break;
        __builtin_amdgcn_s_sleep(1);
        if ((++sp & 255u) == 0u) { if (xb_ld(&bar[XB_TMO])) break; if (sp > XB_SPIN_CAP) { atomicAdd(&bar[XB_TMO], 1u); break; } }
    }
    nloc = mine > 0u ? mine : 1u; nx = cnt > 0u ? cnt : 1u;
}

__device__ __forceinline__ void xcd_barrier(const XcdBarrier& b) {
    asm volatile("s_waitcnt vmcnt(0)" ::: "memory");
    __syncthreads();
    if (threadIdx.x == 0) {
        unsigned* bar = b.bar;
        __builtin_amdgcn_s_waitcnt(0);
        unsigned nloc = b.st[0], nx = b.st[1];
        if (nloc == 0u) { xcd_barrier_complete(bar, b.x, nloc, nx); b.st[0] = nloc; b.st[1] = nx; }
        const unsigned old = xb_add(&bar[XB_XSUB(b.x)], 1u);
        const unsigned gen = old / nloc;
        if (old + 1u == (gen + 1u) * nloc) {
            __builtin_amdgcn_fence(__ATOMIC_RELEASE, "agent");
            asm volatile("s_waitcnt vmcnt(0)" ::: "memory");
            const unsigned og = xb_add(&bar[XB_TOP], 1u);
            const unsigned tg = og / nx;
            if (og + 1u == (tg + 1u) * nx) xb_add(&bar[XB_TOPGEN], 1u);
            else XB_SPIN(xb_ld(&bar[XB_TOPGEN]) == tg, bar);
            __builtin_amdgcn_fence(__ATOMIC_ACQUIRE, "agent");
            xb_add(&bar[XB_XGEN(b.x)], 1u);
            asm volatile("s_waitcnt vmcnt(0)" ::: "memory");
        } else {
            XB_SPIN(xb_ld(&bar[XB_XGEN(b.x)]) == gen, bar);
            __builtin_amdgcn_fence(__ATOMIC_ACQUIRE, "agent");
            asm volatile("s_waitcnt vmcnt(0)" ::: "memory");
        }
    }
    __syncthreads();
}
struct Args { const float* in[24]; float* out; unsigned char* ws; int ph_lo, ph_hi, rep_att, rep_lru; };
struct Frame {
    LAS unsigned char* lds; volatile LAS unsigned* MISC; gu32* ctl;
    int tid, lane, wave, vcu, G;
    unsigned char* ws; float* out;
};
#define WSP(T, off) ((T*)(F.ws + (off)))
#define LDS_WAIT() asm volatile("s_waitcnt lgkmcnt(0)" ::: "memory")

struct TrItem { const float* W; bf16* WT; int ldw, K, k0, nsrc0, ndst0; };
__device__ __forceinline__ void tr_load(const TrItem& I, float (&v)[32], int lane) {
    const float* wp = I.W + (size_t)(I.k0 + (lane >> 5)) * I.ldw + I.nsrc0 + (lane & 31);
#pragma unroll
    for (int i = 0; i < 32; ++i) v[i] = wp[(size_t)(2 * i) * I.ldw];
}
__device__ __forceinline__ void tr_store(const TrItem& I, const float (&v)[32], LAS float* scr, int lane) {
#pragma unroll
    for (int i = 0; i < 32; ++i) scr[(2 * i + (lane >> 5)) * 33 + (lane & 31)] = v[i];
    LDS_WAIT(); asm volatile("" ::: "memory");
    const int c = lane & 7;
#pragma unroll
    for (int j = 0; j < 4; ++j) { const int n = (lane >> 3) + 8 * j; const LAS float* s = scr + (8 * c) * 33 + n;
        v4u o; o.x = pk2(s[0 * 33], s[1 * 33]); o.y = pk2(s[2 * 33], s[3 * 33]); o.z = pk2(s[4 * 33], s[5 * 33]); o.w = pk2(s[6 * 33], s[7 * 33]);
        *(GAS v4u*)(I.WT + (size_t)(I.ndst0 + n) * I.K + I.k0 + 8 * c) = o; }
    LDS_WAIT(); asm volatile("" ::: "memory");
}
__device__ __forceinline__ void cvt_stream(const float* src, bf16* dst, size_t n8, size_t i0, size_t stride) {
    for (size_t i = i0; i < n8; i += stride) { const f32x4 a = ((const GAS f32x4*)src)[2 * i], b = ((const GAS f32x4*)src)[2 * i + 1];
        v4u o; o.x = pk2(a[0], a[1]); o.y = pk2(a[2], a[3]); o.z = pk2(b[0], b[1]); o.w = pk2(b[2], b[3]); ((GAS v4u*)dst)[i] = o; }
}
__device__ __forceinline__ void cvt_stream_fp8(const float* src, unsigned char* dst, size_t n16, float scale, size_t i0, size_t stride) {
    for (size_t i = i0; i < n16; i += stride) { v4u o;
#pragma unroll
        for (int q = 0; q < 4; ++q) { const f32x4 a = ((const GAS f32x4*)src)[4 * i + q] * scale; int w = 0;
            w = __builtin_amdgcn_cvt_pk_fp8_f32(a[0], a[1], w, false); w = __builtin_amdgcn_cvt_pk_fp8_f32(a[2], a[3], w, true); o[q] = (unsigned)w; }
        ((GAS v4u*)dst)[i] = o; }
}
__device__ __forceinline__ void cvt_table_fp4(Frame& F, const float* srcT, unsigned char* dstT, float* rsT, int gw, int NGW) {
    for (int row = gw; row < PEER_NE; row += NGW) {
        const GAS f32x4* src = (const GAS f32x4*)(srcT + (size_t)row * DM); f32x4 a[16]; float am = 0.f;
#pragma unroll
        for (int c = 0; c < 4; ++c)
#pragma unroll
            for (int q = 0; q < 4; ++q) { a[4 * c + q] = src[c * 256 + 4 * F.lane + q]; am = fmaxf(fmaxf(am, fmaxf(fabsf(a[4 * c + q][0]), fabsf(a[4 * c + q][1]))), fmaxf(fabsf(a[4 * c + q][2]), fabsf(a[4 * c + q][3]))); }
        am = wave_max(am); const float inv = am > 0.f ? 6.0f / am : 0.f;
#pragma unroll
        for (int c = 0; c < 4; ++c) { v2u o;
#pragma unroll
            for (int d = 0; d < 2; ++d) { unsigned w = 0u; const f32x4 x0 = a[4 * c + 2 * d] * inv, x1 = a[4 * c + 2 * d + 1] * inv;
                w = __builtin_amdgcn_cvt_scalef32_pk_fp4_f32(w, x0[0], x0[1], 1.0f, 0); w = __builtin_amdgcn_cvt_scalef32_pk_fp4_f32(w, x0[2], x0[3], 1.0f, 1);
                w = __builtin_amdgcn_cvt_scalef32_pk_fp4_f32(w, x1[0], x1[1], 1.0f, 2); w = __builtin_amdgcn_cvt_scalef32_pk_fp4_f32(w, x1[2], x1[3], 1.0f, 3); o[d] = w; }
            *((GAS v2u*)(dstT + (size_t)row * 2048 + c * 512) + F.lane) = o; }
        if (F.lane == 0) rsT[row] = am * (1.0f / 6.0f);
    }
}
__device__ __forceinline__ void p0_prologue(Frame& F, const Args& args) {
#ifndef P0_REP
#define P0_REP 0
#endif
    _Pragma("unroll") for (int rep_ = 0; rep_ < ((P0_REP & 1) ? 2 : 1); ++rep_)
    { LAS float* sc = (LAS float*)F.lds; LAS f32x4* red = (LAS f32x4*)(F.lds + 16384); float* MOD = WSP(float, WS_MOD);
      for (int cgi = blockIdx.x; cgi < 256; cgi += F.G) {
          for (int i = F.tid; i < DM; i += NTHREADS) { const float cv = args.in[1][i]; sc[i] = cv / (1.0f + __expf(-cv)); }
          __syncthreads();
          if (F.tid < 384) { const int cg = F.tid % 24, rg = F.tid / 24;
              const GAS f32x4* Wp = (const GAS f32x4*)args.in[2] + cgi * 24 + cg;
              f32x4 acc = {0.f, 0.f, 0.f, 0.f};
#pragma unroll 8
              for (int r = rg; r < DM; r += 16) acc += sc[r] * Wp[(size_t)r * 6144];
              red[rg * 24 + cg] = acc; }
          __syncthreads();
          if (F.tid < 24) { f32x4 s = red[F.tid];
#pragma unroll
              for (int rg = 1; rg < 16; ++rg) s += red[rg * 24 + F.tid];
              s += ((const GAS f32x4*)args.in[3])[cgi * 24 + F.tid]; ((GAS f32x4*)MOD)[cgi * 24 + F.tid] = s; }
          __syncthreads();
      } }
    LAS float* scr = (LAS float*)(F.lds + F.wave * 16384);
    const int gw = F.vcu * NWAVES + F.wave, NGW = F.G * NWAVES;
    constexpr int I_IN = 64 * 576, I_AO = 32 * 128, I_LO = 32 * 128, I_OUT = 64 * 128, I_PQ = 64 * 64, I_WA = 16 * 2 * 4, I_WX = I_WA;
    constexpr int NITEMS = I_IN + I_AO + I_LO + I_OUT + I_PQ + I_WA + I_WX;
    auto decode = [&](int r) -> TrItem { TrItem I;
        if (r < I_IN) { const int kb = r / 576, nb = r % 576; I = TrItem{args.in[6], WSP(bf16, WS_WIN), NIN, DM, 64 * kb, 32 * nb + (nb >= 192 ? 16 : 0), 32 * nb}; return I; } r -= I_IN;
        if (r < I_AO) { const int kb = r / 128, nb = r % 128; I = TrItem{args.in[17], WSP(bf16, WS_WAO), DM, AW, 64 * kb, 32 * nb, 32 * nb}; return I; } r -= I_AO;
        if (r < I_LO) { const int kb = r / 128, nb = r % 128; I = TrItem{args.in[18], WSP(bf16, WS_WLO), DM, LW, 64 * kb, 32 * nb, 32 * nb}; return I; } r -= I_LO;
        if (r < I_OUT) { const int kb = r / 128, nb = r % 128; I = TrItem{args.in[19], WSP(bf16, WS_WOUT), DM, DM, 64 * kb, 32 * nb, 32 * nb}; return I; } r -= I_OUT;
        if (r < I_PQ) { const int kb = r / 64, nb = r % 64; I = TrItem{args.in[20], WSP(bf16, WS_WPQ), 2048, DM, 64 * kb, 32 * nb, 32 * nb}; return I; } r -= I_PQ;
        { const bool isx = r >= I_WA; if (isx) r -= I_WA; const int g = r >> 3, kb = (r >> 2) & 1, nb = r & 3;
          I = TrItem{(isx ? args.in[14] : args.in[12]) + (size_t)g * GD * GD, WSP(bf16, isx ? WS_WXT : WS_WAT) + (size_t)g * GD * GD, GD, GD, 64 * kb, 32 * nb, 32 * nb}; return I; } };
    _Pragma("unroll") for (int rep_ = 0; rep_ < ((P0_REP & 2) ? 2 : 1); ++rep_)
    if (gw < NITEMS) {
        float va[32], vb[32]; TrItem Ia = decode(gw); tr_load(Ia, va, F.lane);
#pragma unroll 1
        for (int it = gw; it < NITEMS; it += NGW) {
            const int nx = it + NGW; TrItem Ib = Ia;
            if (nx < NITEMS) { Ib = decode(nx); tr_load(Ib, vb, F.lane); }
            tr_store(Ia, va, scr, F.lane);
#pragma unroll
            for (int i = 0; i < 32; ++i) va[i] = vb[i];
            Ia = Ib;
        }
    }
    const size_t gt = (size_t)F.vcu * NTHREADS + F.tid, NGT = (size_t)F.G * NTHREADS;
    _Pragma("unroll") for (int rep_ = 0; rep_ < ((P0_REP & 4) ? 2 : 1); ++rep_) {
    cvt_table_fp4(F, args.in[23], WSP(unsigned char, WS_V), WSP(float, WS_RS), gw, NGW);
    cvt_table_fp4(F, args.in[22], WSP(unsigned char, WS_U), WSP(float, WS_RSU), gw, NGW); }
    cvt_stream(args.in[21], WSP(bf16, WS_SK), (size_t)PEER_H * 2 * 128 * 128 / 8, gt, NGT);
    for (size_t i = gt; i < (size_t)DM * 16; i += NGT) WSP(float, WS_WF)[(i & 15) * DM + (i >> 4)] = args.in[6][(i >> 4) * NIN + C_F + (i & 15)];
    for (size_t i = gt; i < (size_t)NINP; i += NGT) WSP(float, WS_BIASR)[i] = args.in[7][i + (i >= (size_t)C_F ? 16 : 0)];
}

__device__ __forceinline__ void p1_norm_forget(Frame& F, const Args& args) {
    const float* MOD = WSP(float, WS_MOD); const float* WFT = WSP(float, WS_WF); bf16* HA = WSP(bf16, WS_HA);
    LAS f32x4* MUL4 = (LAS f32x4*)F.lds; LAS f32x4* SH4 = (LAS f32x4*)(F.lds + 16384); LAS f32x4* WB4 = (LAS f32x4*)(F.lds + 32768);
    for (int i4 = F.tid; i4 < DM / 4; i4 += NTHREADS) { MUL4[i4] = ((const GAS f32x4*)args.in[4])[i4] * (((const GAS f32x4*)(MOD + 4096))[i4] + 1.0f); SH4[i4] = ((const GAS f32x4*)MOD)[i4]; }
    __syncthreads();
    const int cw = F.tid >> 6, dw = F.tid & 63;
    const unsigned wo0 = (unsigned)(cw * DM + dw * 4) * 4u, wo1 = (unsigned)((cw + 8) * DM + dw * 4) * 4u, lo16 = (unsigned)F.lane * 16u, lo8 = (unsigned)F.lane * 8u;
#pragma unroll 1
    for (int step = blockIdx.x; step < S / 32; step += F.G) {
        const int ra = step * 32 + F.wave * 4; const char* xb0 = (const char*)(args.in[0] + (size_t)ra * DM); char* hb0 = (char*)(HA + (size_t)ra * DM);
        float rs[4];
#pragma unroll
        for (int r = 0; r < 4; ++r) { f32x4 xa[16]; float ss = 0.f;
#pragma unroll
            for (int j = 0; j < 16; ++j) xa[j] = *(const GAS f32x4*)(xb0 + (size_t)r * (DM * 4) + 1024 * j + lo16);
#pragma unroll
            for (int j = 0; j < 16; ++j) ss += (xa[j][0] * xa[j][0] + xa[j][1] * xa[j][1]) + (xa[j][2] * xa[j][2] + xa[j][3] * xa[j][3]);
            rs[r] = 1.0f / sqrtf(wave_sum(ss) * (1.0f / DM) + EPS); }
        float acc[4][16];
#pragma unroll
        for (int r = 0; r < 4; ++r)
#pragma unroll
            for (int c = 0; c < 16; ++c) acc[r][c] = 0.f;
        f32x4 w0 = *(const GAS f32x4*)((const char*)WFT + wo0), w1 = *(const GAS f32x4*)((const char*)WFT + wo1), xn[4];
#pragma unroll
        for (int r = 0; r < 4; ++r) xn[r] = *(const GAS f32x4*)(xb0 + (size_t)r * (DM * 4) + lo16);
#pragma unroll 1
        for (int j = 0; j < 16; ++j) {
            LAS f32x4* wb = WB4 + (j & 1) * 1024;
            wb[F.tid] = w0; wb[F.tid + 512] = w1;
            __syncthreads();
            f32x4 xc[4]; const int jn = (j + 1) & 15;
#pragma unroll
            for (int r = 0; r < 4; ++r) xc[r] = xn[r];
            { const char* wbase = (const char*)WFT + 1024 * jn; w0 = *(const GAS f32x4*)(wbase + wo0); w1 = *(const GAS f32x4*)(wbase + wo1); }
#pragma unroll
            for (int r = 0; r < 4; ++r) xn[r] = *(const GAS f32x4*)(xb0 + (size_t)r * (DM * 4) + 1024 * jn + lo16);
            const f32x4 mul = MUL4[F.lane + 64 * j], sh = SH4[F.lane + 64 * j];
            f32x4 h[4];
#pragma unroll
            for (int r = 0; r < 4; ++r) { h[r] = xc[r] * rs[r] * mul + sh; v2u o; o.x = pk2(h[r][0], h[r][1]); o.y = pk2(h[r][2], h[r][3]); *(GAS v2u*)(hb0 + (size_t)r * (DM * 2) + 512 * j + lo8) = o; }
#pragma unroll
            for (int c = 0; c < 16; ++c) { const f32x4 wf = wb[c * 64 + F.lane];
#pragma unroll
                for (int r = 0; r < 4; ++r) acc[r][c] += (h[r][0] * wf[0] + h[r][1] * wf[1]) + (h[r][2] * wf[2] + h[r][3] * wf[3]); }
        }
#pragma unroll
        for (int c = 0; c < 16; ++c) { float tt[4];
#pragma unroll
            for (int r = 0; r < 4; ++r) tt[r] = wave_sum(acc[r][c]);
            if (F.lane == c) { const float bia = args.in[7][C_F + c];
#pragma unroll
                for (int r = 0; r < 4; ++r) { const float f = tt[r] + bia; WSP(float, WS_LOGF)[(size_t)c * S + ra + r] = fminf(f, 0.f) - log1pf(__expf(-fabsf(f))); } } }
        __syncthreads();
    }
}
__device__ __forceinline__ void p1_shift_proj(Frame& F, const Args& args) {
    const int gw = F.vcu * NWAVES + F.wave, NGW = F.G * NWAVES; const float* sh2 = WSP(float, WS_MOD) + 12288; const bf16* WT = WSP(bf16, WS_WPQ);
    for (int col = gw; col < 2048; col += NGW) { float s = 0.f;
#pragma unroll
        for (int c = 0; c < 8; ++c) { const v4u w = *((const GAS v4u*)(WT + (size_t)col * DM + c * 512) + F.lane); const GAS f32x4* sp = (const GAS f32x4*)(sh2 + c * 512 + F.lane * 8); const f32x4 a = sp[0], b = sp[1];
            s += (bflo(w.x) * a[0] + bfhi(w.x) * a[1]) + (bflo(w.y) * a[2] + bfhi(w.y) * a[3]) + (bflo(w.z) * b[0] + bfhi(w.z) * b[1]) + (bflo(w.w) * b[2] + bfhi(w.w) * b[3]); }
        s = wave_sum(s); if (F.lane == 0) WSP(float, WS_SB)[col] = s; }
}

__device__ __forceinline__ void p3_qknorm(Frame& F, const Args& args) {
    const int gw = F.vcu * NWAVES + F.wave, NGW = F.G * NWAVES; bf16* QK = WSP(bf16, WS_QKV);
    const int sub = F.lane & 15;
    f32x4 gq0 = ((const GAS f32x4*)args.in[8])[2 * sub], gq1 = ((const GAS f32x4*)args.in[8])[2 * sub + 1], gk0 = ((const GAS f32x4*)args.in[9])[2 * sub], gk1 = ((const GAS f32x4*)args.in[9])[2 * sub + 1];
    for (int it0 = gw; it0 < 2 * S * NH / 4; it0 += 4 * NGW) {
        v4u w[4]; GAS v4u* pp[4];
#pragma unroll
        for (int k = 0; k < 4; ++k) { const int it = it0 + k * NGW; const size_t unit = (size_t)(it < 2 * S * NH / 4 ? it : it0) * 4 + (F.lane >> 4); pp[k] = (GAS v4u*)(QK + unit * 128) + sub; w[k] = *pp[k]; }
#pragma unroll
        for (int k = 0; k < 4; ++k) { const int it = it0 + k * NGW; const size_t unit = (size_t)(it < 2 * S * NH / 4 ? it : it0) * 4 + (F.lane >> 4); const bool isk = unit >= (size_t)S * NH;
            f32x4 a = {bflo(w[k].x), bfhi(w[k].x), bflo(w[k].y), bfhi(w[k].y)}, b = {bflo(w[k].z), bfhi(w[k].z), bflo(w[k].w), bfhi(w[k].w)};
            float ss = (a[0] * a[0] + a[1] * a[1]) + (a[2] * a[2] + a[3] * a[3]) + (b[0] * b[0] + b[1] * b[1]) + (b[2] * b[2] + b[3] * b[3]);
            ss += __shfl_xor(ss, 1); ss += __shfl_xor(ss, 2); ss += __shfl_xor(ss, 4); ss += __shfl_xor(ss, 8);
            const float rs = 1.0f / sqrtf(ss * (1.0f / HD) + EPS);
            a = a * rs * (isk ? gk0 : gq0); b = b * rs * (isk ? gk1 : gq1);
            v4u o; o.x = pk2(a[0], a[1]); o.y = pk2(a[2], a[3]); o.z = pk2(b[0], b[1]); o.w = pk2(b[2], b[3]);
            if (it < 2 * S * NH / 4) *pp[k] = o; }
    }
}
__device__ __forceinline__ void p3_cumsum(Frame& F, const Args& args) {
    LAS float* wt = (LAS float*)F.lds;
    for (int h = blockIdx.x; h < NH; h += F.G) {
        const float* LF = WSP(float, WS_LOGF); float v[16]; float run = 0.f;
        { const GAS f32x4* lp = (const GAS f32x4*)(LF + (size_t)h * S + F.tid * 16); const f32x4 l0 = lp[0], l1 = lp[1], l2 = lp[2], l3 = lp[3];
          const float lv[16] = {l0[0], l0[1], l0[2], l0[3], l1[0], l1[1], l1[2], l1[3], l2[0], l2[1], l2[2], l2[3], l3[0], l3[1], l3[2], l3[3]};
#pragma unroll
          for (int i = 0; i < 16; ++i) { run += lv[i]; v[i] = run; } }
        float sc = run;
#pragma unroll
        for (int o = 1; o < 64; o <<= 1) { const float t = __shfl_up(sc, o); if (F.lane >= o) sc += t; }
        if (F.lane == 63) wt[F.wave] = sc;
        __syncthreads();
        float pre = sc - run;
        for (int w = 0; w < F.wave; ++w) pre += wt[w];
        float* Fo = WSP(float, WS_FC) + (size_t)h * S + F.tid * 16;
#pragma unroll
        for (int i = 0; i < 4; ++i) ((GAS f32x4*)Fo)[i] = (f32x4){v[4 * i] + pre, v[4 * i + 1] + pre, v[4 * i + 2] + pre, v[4 * i + 3] + pre};
        __syncthreads();
    }
}
constexpr int LRU_XCF = 0, LRU_XCB = 32768, LRU_AB = 49152, LRU_BB = 81920, LRU_QA = 114688, LRU_CAR = 118784, LRU_XR = 133120;
struct LruConst { float w0, w1, w2, w3, cb, bav, bxv, sp8; };
template <int PASS> __device__ __forceinline__ void lru_chunk(Frame& F, const Args& args, int c, int g, v4u (&raw)[3], const bf16x8 (&ba)[4], const bf16x8 (&bx)[4], bool more, const LruConst& K) {
    LAS float* XCF = (LAS float*)(F.lds + LRU_XCF); LAS unsigned char* XCB = F.lds + LRU_XCB; LAS float* AB = (LAS float*)(F.lds + LRU_AB); LAS float* BB = (LAS float*)(F.lds + LRU_BB);
    LAS float* QA = (LAS float*)(F.lds + LRU_QA); LAS float* CAR = (LAS float*)(F.lds + LRU_CAR); LAS bf16* XR = (LAS bf16*)(F.lds + LRU_XR);
    const int t0 = 64 * c, ch0 = GD * g; const bf16* LX = WSP(bf16, WS_LX);
#pragma unroll
    for (int k = 0; k < 3; ++k) { const int p = F.tid + k * NTHREADS; if (p < 67 * 16) *(LAS v4u*)(XR + (p >> 4) * 128 + (p & 15) * 8) = raw[k]; }
    if (more) {
#pragma unroll
        for (int k = 0; k < 3; ++k) { const int p = F.tid + k * NTHREADS; const int r = p >> 4, cc = p & 15, tg = t0 + 64 - 3 + r; raw[k] = (v4u){0u, 0u, 0u, 0u};
            if (p < 67 * 16 && tg >= 0) raw[k] = *(const GAS v4u*)(LX + (size_t)tg * LW + ch0 + cc * 8); } }
    __syncthreads();
    { const int ch = F.tid & 127, tq = F.tid >> 7, gch = ch0 + ch;
      const float w0 = K.w0, w1 = K.w1, w2 = K.w2, w3 = K.w3, cb = K.cb; (void)gch;
      float xm3 = bf2f(XR[(16 * tq + 0) * 128 + ch]), xm2 = bf2f(XR[(16 * tq + 1) * 128 + ch]), xm1 = bf2f(XR[(16 * tq + 2) * 128 + ch]);
#pragma unroll
      for (int i = 0; i < 16; ++i) { const int t = 16 * tq + i; const float x0 = bf2f(XR[(t + 3) * 128 + ch]);
          const float xc = w0 * xm3 + w1 * xm2 + w2 * xm1 + w3 * x0 + cb; xm3 = xm2; xm2 = xm1; xm1 = x0;
          XCF[t * 128 + ch] = xc; *(LAS bf16*)(XCB + t * 256 + ((ch * 2) ^ ((t & 7) << 4))) = (bf16)f2bf(xc); } }
    __syncthreads();
    { const int fr = F.lane & 15, fq = F.lane >> 4, j = 16 * F.wave + fr;
      const float bav = K.bav, bxv = K.bxv, sp8 = K.sp8;
#pragma unroll
      for (int mt = 0; mt < 4; ++mt) { f32x4 ar = {0.f, 0.f, 0.f, 0.f}, ax = {0.f, 0.f, 0.f, 0.f}; const int t = 16 * mt + fr;
#pragma unroll
          for (int ks = 0; ks < 4; ++ks) { const bf16x8 af = *(const LAS bf16x8*)(XCB + t * 256 + (((32 * ks + 8 * fq) * 2) ^ ((t & 7) << 4)));
              ar = __builtin_amdgcn_mfma_f32_16x16x32_bf16(af, ba[ks], ar, 0, 0, 0); ax = __builtin_amdgcn_mfma_f32_16x16x32_bf16(af, bx[ks], ax, 0, 0, 0); }
#pragma unroll
          for (int rg = 0; rg < 4; ++rg) { const int tt = 16 * mt + 4 * fq + rg; const float xcv = XCF[tt * 128 + j];
              const float rgt = sigmoidf_(ar[rg] + bav), igt = sigmoidf_(ax[rg] + bxv);
              const float a = __builtin_amdgcn_exp2f(rgt * sp8); const float om = fmaxf((1.0f - a) * (1.0f + a), 0.f);
              const float b = __builtin_amdgcn_sqrtf(om) * (igt * xcv);
              AB[tt * 128 + j] = a; BB[tt * 128 + j] = b; } } }
    __syncthreads();
    const int ch = F.tid & 127, q = F.tid >> 7;
    { float A = 1.f, B = 0.f;
#pragma unroll
      for (int i = 0; i < 16; ++i) { const int t = 16 * q + i; const float a = AB[t * 128 + ch]; B = a * B + BB[t * 128 + ch]; A *= a; }
      QA[(q * 128 + ch) * 2] = A; QA[(q * 128 + ch) * 2 + 1] = B; }
    __syncthreads();
    if (PASS == 0) {
        if (F.tid < 128) { float A = 1.f, B = 0.f;
#pragma unroll
            for (int qq = 0; qq < 4; ++qq) { const float a = QA[(qq * 128 + F.tid) * 2], b = QA[(qq * 128 + F.tid) * 2 + 1]; B = a * B + b; A *= a; }
            WSP(float, WS_AGGA)[(size_t)c * LW + ch0 + F.tid] = A; WSP(float, WS_AGGB)[(size_t)c * LW + ch0 + F.tid] = B; }
    } else {
        float h = CAR[ch];
        for (int qq = 0; qq < q; ++qq) h = QA[(qq * 128 + ch) * 2] * h + QA[(qq * 128 + ch) * 2 + 1];
#pragma unroll
        for (int i = 0; i < 16; ++i) { const int t = 16 * q + i; h = AB[t * 128 + ch] * h + BB[t * 128 + ch]; XCF[t * 128 + ch] = h; }
        __syncthreads();
        if (F.tid < 128) { float hc = CAR[F.tid];
#pragma unroll
            for (int qq = 0; qq < 4; ++qq) hc = QA[(qq * 128 + F.tid) * 2] * hc + QA[(qq * 128 + F.tid) * 2 + 1];
            CAR[F.tid] = hc; }
        const bf16* GY = WSP(bf16, WS_GY); bf16* LR = WSP(bf16, WS_LR);
        for (int p = F.tid; p < 64 * 16; p += NTHREADS) { const int r = p >> 4, cc = p & 15; const size_t o = (size_t)(t0 + r) * LW + ch0 + cc * 8;
            const v4u gy = *(const GAS v4u*)(GY + o); const f32x4 h0 = *(const LAS f32x4*)(XCF + r * 128 + cc * 8), h1 = *(const LAS f32x4*)(XCF + r * 128 + cc * 8 + 4);
            v4u ov; ov.x = pk2(h0[0] * bflo(gy.x), h0[1] * bfhi(gy.x)); ov.y = pk2(h0[2] * bflo(gy.y), h0[3] * bfhi(gy.y)); ov.z = pk2(h1[0] * bflo(gy.z), h1[1] * bfhi(gy.z)); ov.w = pk2(h1[2] * bflo(gy.w), h1[3] * bfhi(gy.w));
            *(GAS v4u*)(LR + o) = ov; }
    }
    __syncthreads();
}
template <int PASS> __device__ __forceinline__ void lru_item(Frame& F, const Args& args, int w) {
    const int g = w & 15, c0 = (w >> 4) * 8; LAS float* CAR = (LAS float*)(F.lds + LRU_CAR); LAS float* QA = (LAS float*)(F.lds + LRU_QA);
    if (PASS == 1) {
        const int ch = F.tid & 127, q = F.tid >> 7, n = c0 / 4;
        const float* GA_ = WSP(float, WS_AGGA) + GD * g + ch; const float* GB_ = WSP(float, WS_AGGB) + GD * g + ch; float A = 1.f, B = 0.f;
#pragma unroll 4
        for (int cc = q * n; cc < (q + 1) * n; ++cc) { const float a = GA_[(size_t)cc * LW], b = GB_[(size_t)cc * LW]; B = a * B + b; A *= a; }
        QA[(q * 128 + ch) * 2] = A; QA[(q * 128 + ch) * 2 + 1] = B;
        __syncthreads();
        if (F.tid < 128) { float hc = 0.f;
#pragma unroll
            for (int qq = 0; qq < 4; ++qq) hc = QA[(qq * 128 + F.tid) * 2] * hc + QA[(qq * 128 + F.tid) * 2 + 1];
            CAR[F.tid] = hc; }
        __syncthreads();
    }
    bf16x8 ba[4], bx[4];
    { const int fr = F.lane & 15, fq = F.lane >> 4, j = 16 * F.wave + fr;
      const bf16* WA = WSP(bf16, WS_WAT) + (size_t)g * GD * GD + (size_t)j * GD + 8 * fq; const bf16* WX = WSP(bf16, WS_WXT) + (size_t)g * GD * GD + (size_t)j * GD + 8 * fq;
#pragma unroll
      for (int ks = 0; ks < 4; ++ks) { ba[ks] = *(const GAS bf16x8*)(WA + 32 * ks); bx[ks] = *(const GAS bf16x8*)(WX + 32 * ks); } }
    v4u raw[3];
    { const bf16* LX = WSP(bf16, WS_LX); const int t0 = 64 * c0, ch0 = GD * g;
#pragma unroll
      for (int k = 0; k < 3; ++k) { const int p = F.tid + k * NTHREADS; const int r = p >> 4, cc = p & 15, tg = t0 - 3 + r; raw[k] = (v4u){0u, 0u, 0u, 0u};
          if (p < 67 * 16 && tg >= 0) raw[k] = *(const GAS v4u*)(LX + (size_t)tg * LW + ch0 + cc * 8); } }
    LruConst K;
    { const int gch = GD * g + (F.tid & 127); K.w0 = args.in[10][gch]; K.w1 = args.in[10][LW + gch]; K.w2 = args.in[10][2 * LW + gch]; K.w3 = args.in[10][3 * LW + gch]; K.cb = args.in[11][gch];
      const int gcj = GD * g + 16 * F.wave + (F.lane & 15); K.bav = args.in[13][gcj]; K.bxv = args.in[15][gcj]; const float lam = args.in[16][gcj];
      K.sp8 = -8.0f * 1.4426950408889634f * ((lam > 0.f ? 0.f : -lam) + log1pf(__expf(-fabsf(lam)))); }
#pragma unroll 1
    for (int c = c0; c < c0 + 8; ++c) lru_chunk<PASS>(F, args, c, g, raw, ba, bx, c + 1 < c0 + 8, K);
}
constexpr int ATT_BIAS_OFF = attn_body::LDS_BYTES;
typedef attn_body::BlockRef<bf16, bf16> ARef;
__device__ __forceinline__ int attn_jlo(const float* Fh, int qb, float TH, int lane) {
    const int t0 = qb * 256; const float f0 = Fh[t0];
    const int j0 = lane, j1 = lane + 64;
    const bool ok0 = (64 * j0 + 63 >= t0) || (f0 - Fh[64 * j0 + 63] >= -TH), ok1 = (64 * j1 + 63 >= t0) || (f0 - Fh[64 * j1 + 63] >= -TH);
    const unsigned long long m0 = __ballot(ok0), m1 = __ballot(ok1);
    return m0 ? (int)__builtin_ctzll(m0) : 64 + (int)__builtin_ctzll(m1);
}
__device__ __forceinline__ ARef attn_ref(Frame& F, const Args& args, int h, int qb, int jlo) {
    ARef r; const bf16* QK = WSP(bf16, WS_QKV);
    r.Q = QK + (size_t)(qb * 256) * AW + h * HD; r.K = QK + (size_t)S * AW + h * HD; r.V = QK + 2 * (size_t)S * AW + h * HD;
    r.O = WSP(bf16, WS_ATT) + (size_t)(qb * 256) * AW + h * HD; r.P0 = qb * 256; r.jlo = jlo; return r;
}
__device__ __forceinline__ void attn_fill_bias(Frame& F, const Args& args, int h, int qb, int jlo) {
    const float* Fh = WSP(float, WS_FC) + (size_t)h * S; LAS float* bl = (LAS float*)(F.lds + ATT_BIAS_OFF);
    const int k0 = jlo * 64, n = (qb + 1) * 256 - k0; const float fr = Fh[k0];
#pragma unroll 1
    for (int i = F.tid; i < n; i += NTHREADS) bl[i] = (fr - Fh[k0 + i]) * (1.0f / attn_body::SCALE);
}
#ifndef ATT_MARGIN
#define ATT_MARGIN 25.0f
#endif
constexpr int ATT_SCHED_OFF = 104448;
__device__ __forceinline__ void p4_attention(Frame& F, const Args& args, char* lds_generic, int rep) {
    float gq = fmaxf(fabsf(args.in[8][F.lane]), fabsf(args.in[8][F.lane + 64])), gk = fmaxf(fabsf(args.in[9][F.lane]), fabsf(args.in[9][F.lane + 64]));
    gq = wave_max(gq); gk = wave_max(gk);
    const float TH = 2.0f * (128.0f * gq * gk * attn_body::SCALE) + ATT_MARGIN;
    LAS float* Fend = (LAS float*)(F.lds + ATT_SCHED_OFF); LAS int* cost = (LAS int*)(F.lds + ATT_SCHED_OFF + 8192); LAS int* jlo_t = cost + 512; LAS int* order = cost + 1024; LAS int* slot = cost + 1536;
    const float* Fc = WSP(float, WS_FC);
    for (int p = F.tid; p < NH * 128; p += NTHREADS) Fend[p] = Fc[(size_t)(p >> 7) * S + 64 * (p & 127) + 63];
    __syncthreads();
    { const int u = F.tid, h = u >> 5, qb = u & 31, t0 = qb * 256; const float f0 = Fc[(size_t)h * S + t0];
      int lo = 0, hi = 4 * qb;
      while (lo < hi) { const int mid = (lo + hi) >> 1; const bool ok = (64 * mid + 63 >= t0) || (f0 - Fend[h * 128 + mid] >= -TH); if (ok) hi = mid; else lo = mid + 1; }
      jlo_t[u] = lo; cost[u] = 4 * (qb + 1) - lo; }
    __syncthreads();
    { const int u = F.tid, cu = cost[u]; int rk = 0;
      for (int v = 0; v < 512; ++v) { const int cv = cost[v]; rk += (cv > cu || (cv == cu && v < u)) ? 1 : 0; }
      order[rk] = u; }
    __syncthreads();
    for (;;) {
        if (F.tid == 0) slot[0] = (int)__hip_atomic_fetch_add((unsigned*)(F.ctl + CW_QATT + 64 * rep), 1u, RLX_AGENT);
        __syncthreads();
        const int k = slot[0];
        __syncthreads();
        if (k >= 512) break;
        const int u = order[k], h = u >> 5, qb = u & 31, jl = jlo_t[u];
        const ARef r0 = attn_ref(F, args, h, qb, jl);
        attn_fill_bias(F, args, h, qb, jl); __syncthreads();
        attn_body::attn_unit<bf16, bf16>(r0, S, lds_generic);
    }
}

__device__ __forceinline__ void p7_norm2(Frame& F, const Args& args) {
    const int gw = F.vcu * NWAVES + F.wave, NGW = F.G * NWAVES; const float* MOD = WSP(float, WS_MOD); bf16* HA = WSP(bf16, WS_HA);
    for (int m = gw; m < S; m += NGW) {
        const GAS f32x4* xr = (const GAS f32x4*)(WSP(float, WS_X1) + (size_t)m * DM) + F.lane; f32x4 v[16]; float ss = 0.f;
#pragma unroll
        for (int j = 0; j < 16; ++j) { v[j] = xr[64 * j]; ss += (v[j][0] * v[j][0] + v[j][1] * v[j][1]) + (v[j][2] * v[j][2] + v[j][3] * v[j][3]); }
        const float rstd = 1.0f / sqrtf(wave_sum(ss) * (1.0f / DM) + EPS);
#pragma unroll
        for (int j = 0; j < 16; ++j) { const int i4 = F.lane + 64 * j;
            const f32x4 g = ((const GAS f32x4*)args.in[5])[i4], scl = ((const GAS f32x4*)(MOD + 16384))[i4], sh = ((const GAS f32x4*)(MOD + 12288))[i4];
            const f32x4 hv = v[j] * rstd * (g * (scl + 1.0f)) + sh;
            v2u o; o.x = pk2(hv[0], hv[1]); o.y = pk2(hv[2], hv[3]); ((GAS v2u*)(HA + (size_t)m * DM))[i4] = o; }
    }
}

template <int CTRL> __device__ __forceinline__ unsigned dppu(unsigned x) { return (unsigned)__builtin_amdgcn_update_dpp(0, (int)x, CTRL, 0xF, 0xF, true); }
__device__ __forceinline__ unsigned rowmax_u32(unsigned x) { x = max(x, dppu<0xB1>(x)); x = max(x, dppu<0x4E>(x)); x = max(x, dppu<0x141>(x)); x = max(x, dppu<0x140>(x)); return x; }
__device__ __forceinline__ float rowsum_f32(float x) { x += __uint_as_float(dppu<0xB1>(__float_as_uint(x))); x += __uint_as_float(dppu<0x4E>(__float_as_uint(x)));
    x += __uint_as_float(dppu<0x141>(__float_as_uint(x))); x += __uint_as_float(dppu<0x140>(__float_as_uint(x))); return x; }
__device__ __forceinline__ unsigned ordk(float f) { const unsigned u = __float_as_uint(f); return u ^ ((unsigned)((int)u >> 31) | 0x80000000u); }
__device__ __forceinline__ float deck(unsigned k) { return __uint_as_float((k & 0x80000000u) ? (k ^ 0x80000000u) : ~k); }
#define CE_(x, y) do { const unsigned hi_ = max(x, y), lo_ = min(x, y); x = hi_; y = lo_; } while (0)
__device__ __forceinline__ unsigned row_pop16(unsigned (&a)[8], int i) {
    unsigned res = 0u;
#pragma unroll
    for (int r = 0; r < 16; ++r) { const unsigned m = rowmax_u32(a[0]); const bool win = a[0] == m;
#pragma unroll
        for (int s = 0; s < 7; ++s) a[s] = win ? a[s + 1] : a[s];
        a[7] = win ? 0u : a[7]; res = (i == r) ? m : res; }
    return res;
}
__device__ __forceinline__ void p9_topk(Frame& F, const Args& args) {
    const bf16* Q2 = WSP(bf16, WS_Q2); const bf16* SK = WSP(bf16, WS_SK); int* IDX = WSP(int, WS_IDX); float* GATE = WSP(float, WS_GATE);
    const int i = F.lane & 15, q = F.lane >> 4;
    const unsigned qlo = (unsigned)(i * 2048 + 8 * q) * 2u;
    const int h = (int)blockIdx.x & 7, ib = (int)blockIdx.x >> 3, nbh = ((int)F.G - h + 7) >> 3;
    for (int c = F.tid; c < 4096; c += NTHREADS) { const int pp = c >> 11, n = (c >> 4) & 127, ch = c & 15;
        *(LAS v4u*)(F.lds + pp * 32768 + n * 256 + ((ch * 16) ^ ((n & 7) << 4))) = *(const GAS v4u*)(SK + ((size_t)((h * 2 + pp) * 128 + n)) * 128 + ch * 8); }
    __syncthreads();
#pragma unroll 1
    for (int tg = ib * NWAVES + F.wave; tg < S / 16; tg += nbh * NWAVES) {
        const int t0 = 16 * tg;
        unsigned R[2][4];
        bf16x8 af[2][4];
#pragma unroll
        for (int p = 0; p < 2; ++p) { const char* qb_ = (const char*)Q2 + ((size_t)t0 * 2048 + h * 256 + p * 128) * 2;
#pragma unroll
            for (int ks = 0; ks < 4; ++ks) af[p][ks] = *(const GAS bf16x8*)(qb_ + 64 * ks + qlo); }
#pragma unroll
        for (int p = 0; p < 2; ++p) {
            f32x4 acc[8];
#pragma unroll
            for (int nt = 0; nt < 8; ++nt) { acc[nt] = (f32x4){0.f, 0.f, 0.f, 0.f}; const int n = 16 * nt + i;
#pragma unroll
                for (int ks = 0; ks < 4; ++ks) { const bf16x8 b = *(const LAS bf16x8*)(F.lds + p * 32768 + n * 256 + ((64 * ks + 16 * q) ^ ((n & 7) << 4)));
                    acc[nt] = __builtin_amdgcn_mfma_f32_16x16x32_bf16(af[p][ks], b, acc[nt], 0, 0, 0); } }
#pragma unroll
            for (int r = 0; r < 4; ++r) { unsigned a[8];
#pragma unroll
                for (int nt = 0; nt < 8; ++nt) a[nt] = (ordk(acc[nt][r]) & ~0x7Fu) | (unsigned)(16 * nt + i);
                CE_(a[0], a[1]); CE_(a[2], a[3]); CE_(a[4], a[5]); CE_(a[6], a[7]); CE_(a[0], a[2]); CE_(a[1], a[3]); CE_(a[4], a[6]); CE_(a[5], a[7]); CE_(a[1], a[2]); CE_(a[5], a[6]);
                CE_(a[0], a[4]); CE_(a[1], a[5]); CE_(a[2], a[6]); CE_(a[3], a[7]); CE_(a[2], a[4]); CE_(a[3], a[5]); CE_(a[1], a[2]); CE_(a[3], a[4]); CE_(a[5], a[6]);
                R[p][r] = row_pop16(a, i); __builtin_amdgcn_sched_barrier(0); }
        }
#pragma unroll
        for (int r = 0; r < 4; ++r) {
            const unsigned R0 = R[0][r], R1 = R[1][r]; const float f0 = deck(R0 & ~0x7Fu), f1 = deck(R1 & ~0x7Fu); const int n0 = (int)(R0 & 0x7Fu), n1 = (int)(R1 & 0x7Fu);
            const unsigned f1u = __float_as_uint(f1); unsigned c[8];
#define CAND_(b, lim) do { const unsigned t_ = (ordk(f0 + __uint_as_float(dppu<0x150 + (b)>(f1u))) & ~0xFFu) | (unsigned)(255 - (i * 16 + (b))); c[b] = (i < (lim)) ? t_ : 0u; } while (0)
            CAND_(0, 16); CAND_(1, 8); CAND_(2, 5); CAND_(3, 4); CAND_(4, 3); CAND_(5, 2); CAND_(6, 2); CAND_(7, 2);
#undef CAND_
            { const float ex = __uint_as_float(dppu<0x150>(__float_as_uint(f0))) + f1; const unsigned exk = (ordk(ex) & ~0xFFu) | (unsigned)(255 - i); c[1] = (i >= 8) ? exk : c[1]; }
            CE_(c[0], c[1]);
            const unsigned G = row_pop16(c, i);
            const float val = deck(G & ~0xFFu); const int id = 255 - (int)(G & 0xFFu); const int rb = F.lane & 48;
            const int ea = __shfl(n0, rb + (id >> 4)), eb = __shfl(n1, rb + (id & 15));
            const float mx = __uint_as_float(dppu<0x150>(__float_as_uint(val))); const float ex = __expf(val - mx); const float sm = rowsum_f32(ex);
            const size_t o = (size_t)(t0 + 4 * q + r) * 128 + h * 16 + i; IDX[o] = ea * 128 + eb; GATE[o] = ex / sm; __builtin_amdgcn_sched_barrier(0);
        }
    }
}
#undef CE_

constexpr float U_SCALE = 256.0f, V_SCALE = 1.0f;
#ifndef PEER_SORT
#define PEER_SORT 0
#endif
__device__ __forceinline__ float gelu_as(float v) {
    const float av = fabsf(v), tt = __builtin_amdgcn_rcpf(av * 0.2316418882f + 1.0f);
    float q = tt * 0.5307027145f + (-0.7265760135f); q = q * tt + 0.7107068705f; q = q * tt + (-0.142248368f); q = q * tt + 0.127414796f; q = q * tt;
    const float m = v * (q * __builtin_amdgcn_exp2f((v * v) * (-0.72134752044f)));
    return v < 0.f ? m : v - m;
}
#ifndef PEER_UMFMA
#define PEER_UMFMA 1
#endif
#ifndef HYP_A
#define HYP_A 1
#endif
#ifndef HYP_B
#define HYP_B 0
#endif
#ifndef PEER_VMFMA
#define PEER_VMFMA 1
#endif
typedef int v8i __attribute__((ext_vector_type(8)));
typedef int v2i __attribute__((ext_vector_type(2)));
typedef float f32x16 __attribute__((ext_vector_type(16)));
__device__ __forceinline__ float wave_sum_dpp(float x) {
    x = rowsum_f32(x);
    return (__uint_as_float(__builtin_amdgcn_readlane(__float_as_uint(x), 0)) + __uint_as_float(__builtin_amdgcn_readlane(__float_as_uint(x), 16)))
         + (__uint_as_float(__builtin_amdgcn_readlane(__float_as_uint(x), 32)) + __uint_as_float(__builtin_amdgcn_readlane(__float_as_uint(x), 48)));
}
#define LOADROWS(T, ra_, rb_, ee) do { const int e2_ = (ee) & 127; const int ea_ = __builtin_amdgcn_readlane(e2_ < 64 ? id0 : id1, e2_ & 63), eb_ = __builtin_amdgcn_readlane(e2_ < 64 ? id0 : id1, (e2_ + 1) & 63); \
        const GAS v4u* pa_ = (const GAS v4u*)((T) + (size_t)ea_ * DM) + F.lane; const GAS v4u* pb_ = (const GAS v4u*)((T) + (size_t)eb_ * DM) + F.lane; \
        _Pragma("unroll") for (int c = 0; c < 4; ++c) { ra_[c] = pa_[64 * c]; rb_[c] = pb_[64 * c]; } } while (0)
#define UDOT(r_, out_) do { f32x2 s0_ = {0.f, 0.f}, s1_ = {0.f, 0.f}, s2_ = {0.f, 0.f}, s3_ = {0.f, 0.f}; \
        _Pragma("unroll") for (int c = 0; c < 4; ++c) _Pragma("unroll") for (int d = 0; d < 2; ++d) { \
            const f32x2 p0_ = __builtin_amdgcn_cvt_scalef32_pk_f32_fp4(r_[c][d], 1.0f, 0), p1_ = __builtin_amdgcn_cvt_scalef32_pk_f32_fp4(r_[c][d], 1.0f, 1), \
                        p2_ = __builtin_amdgcn_cvt_scalef32_pk_f32_fp4(r_[c][d], 1.0f, 2), p3_ = __builtin_amdgcn_cvt_scalef32_pk_f32_fp4(r_[c][d], 1.0f, 3); \
            s0_ = p0_ * hx[8 * c + 4 * d] + s0_; s1_ = p1_ * hx[8 * c + 4 * d + 1] + s1_; s2_ = p2_ * hx[8 * c + 4 * d + 2] + s2_; s3_ = p3_ * hx[8 * c + 4 * d + 3] + s3_; } \
        out_ = ((s0_.x + s0_.y) + (s1_.x + s1_.y)) + ((s2_.x + s2_.y) + (s3_.x + s3_.y)); } while (0)
#define UPAIR(ra_, rb_, ee) do { float sa_, sb_; UDOT(ra_, sa_); UDOT(rb_, sb_); sa_ = wave_sum_dpp(sa_); sb_ = wave_sum_dpp(sb_); \
        const int e2_ = (ee); const int ea_ = __builtin_amdgcn_readlane(e2_ < 64 ? id0 : id1, e2_ & 63), eb_ = __builtin_amdgcn_readlane(e2_ < 64 ? id0 : id1, (e2_ + 1) & 63); \
        const f32x2 a2_ = pg8::gelu_pk((f32x2){sa_ * RSU[ea_], sb_ * RSU[eb_]}); \
        if ((ee) < 64) { if (F.lane == (ee)) w0 = a2_.x * g0; if (F.lane == (ee) + 1) w0 = a2_.y * g0; } else { if (F.lane == (ee) - 64) w1 = a2_.x * g1; if (F.lane == (ee) - 63) w1 = a2_.y * g1; } } while (0)
#define LOADROWS4(T, ra_, rb_, ee) do { const int e2_ = (ee) & 127; const int ea_ = __builtin_amdgcn_readlane(e2_ < 64 ? id0 : id1, e2_ & 63), eb_ = __builtin_amdgcn_readlane(e2_ < 64 ? id0 : id1, (e2_ + 1) & 63); \
        const GAS v2u* pa_ = (const GAS v2u*)((T) + (size_t)ea_ * 2048) + F.lane; const GAS v2u* pb_ = (const GAS v2u*)((T) + (size_t)eb_ * 2048) + F.lane; \
        _Pragma("unroll") for (int c = 0; c < 4; ++c) { ra_[c] = pa_[64 * c]; rb_[c] = pb_[64 * c]; } } while (0)
#define VAXPY(r_, w_) do { const f32x2 w2_ = {w_, w_}; \
        _Pragma("unroll") for (int c = 0; c < 4; ++c) _Pragma("unroll") for (int d = 0; d < 2; ++d) { \
            const f32x2 p0_ = __builtin_amdgcn_cvt_scalef32_pk_f32_fp4(r_[c][d], 1.0f, 0), p1_ = __builtin_amdgcn_cvt_scalef32_pk_f32_fp4(r_[c][d], 1.0f, 1), \
                        p2_ = __builtin_amdgcn_cvt_scalef32_pk_f32_fp4(r_[c][d], 1.0f, 2), p3_ = __builtin_amdgcn_cvt_scalef32_pk_f32_fp4(r_[c][d], 1.0f, 3); \
            acc[8 * c + 4 * d] = p0_ * w2_ + acc[8 * c + 4 * d]; acc[8 * c + 4 * d + 1] = p1_ * w2_ + acc[8 * c + 4 * d + 1]; \
            acc[8 * c + 4 * d + 2] = p2_ * w2_ + acc[8 * c + 4 * d + 2]; acc[8 * c + 4 * d + 3] = p3_ * w2_ + acc[8 * c + 4 * d + 3]; } } while (0)
#define VPAIR(ra_, rb_, ee) do { const int e2_ = (ee); const int ea_ = __builtin_amdgcn_readlane(e2_ < 64 ? id0 : id1, e2_ & 63), eb_ = __builtin_amdgcn_readlane(e2_ < 64 ? id0 : id1, (e2_ + 1) & 63); \
        const float wa_ = __uint_as_float(__builtin_amdgcn_readlane(__float_as_uint((ee) < 64 ? w0 : w1), (ee) & 63)) * RS[ea_], wb_ = __uint_as_float(__builtin_amdgcn_readlane(__float_as_uint((ee) < 64 ? w0 : w1), ((ee) + 1) & 63)) * RS[eb_]; \
        VAXPY(ra_, wa_); VAXPY(rb_, wb_); } while (0)
template <int MODE> __device__ __forceinline__ void p10_peer(Frame& F, const Args& args) {
    const int gw = F.vcu * NWAVES + F.wave, NGW = F.G * NWAVES; const float* MOD = WSP(float, WS_MOD);
    const bf16* H2 = WSP(bf16, WS_HA); const unsigned char* U = WSP(unsigned char, WS_U); const unsigned char* V = WSP(unsigned char, WS_V); const int* IDX = WSP(int, WS_IDX); const float* GATE = WSP(float, WS_GATE); const float* RS = WSP(float, WS_RS); const float* RSU = WSP(float, WS_RSU);
#if PEER_UMFMA
    if (F.lane < 8) *(LAS v4u*)(F.lds + F.wave * 18688 + 4096 + F.lane * 16) = (v4u){0u, 0u, 0u, 0u};
#endif
#pragma unroll 1
    for (int t = gw; t < S; t += NGW) {
        const int id0 = IDX[(size_t)t * 128 + F.lane], id1 = IDX[(size_t)t * 128 + 64 + F.lane];
        const float g0 = GATE[(size_t)t * 128 + F.lane], g1 = GATE[(size_t)t * 128 + 64 + F.lane];
        float w0 = 0.f, w1 = 0.f;
#if PEER_UMFMA
        if (MODE != 2) {
            LAS unsigned char* h8 = F.lds + F.wave * 18688; LAS unsigned char* stg = h8 + 4224;
            const float rstd = 1.0f / sqrtf(wave_sum_dpp(WSP(float, WS_SSQ)[(size_t)t * 64 + F.lane]) * (1.0f / DM) + EPS);
#pragma unroll
            for (int c = 0; c < 4; ++c) { const GAS v4u* hp = (const GAS v4u*)(H2 + (size_t)t * DM + c * 1024 + F.lane * 16); const v4u a = hp[0], b = hp[1]; v4u o;
                const GAS f32x4* sp = (const GAS f32x4*)(MOD + 12288 + c * 1024 + F.lane * 16); const f32x4 s0 = sp[0], s1 = sp[1], s2 = sp[2], s3 = sp[3];
                { int w = 0; w = __builtin_amdgcn_cvt_pk_fp8_f32(bflo(a[0]) * rstd + s0[0], bfhi(a[0]) * rstd + s0[1], w, false); w = __builtin_amdgcn_cvt_pk_fp8_f32(bflo(a[1]) * rstd + s0[2], bfhi(a[1]) * rstd + s0[3], w, true); o[0] = (unsigned)w; }
                { int w = 0; w = __builtin_amdgcn_cvt_pk_fp8_f32(bflo(a[2]) * rstd + s1[0], bfhi(a[2]) * rstd + s1[1], w, false); w = __builtin_amdgcn_cvt_pk_fp8_f32(bflo(a[3]) * rstd + s1[2], bfhi(a[3]) * rstd + s1[3], w, true); o[1] = (unsigned)w; }
                { int w = 0; w = __builtin_amdgcn_cvt_pk_fp8_f32(bflo(b[0]) * rstd + s2[0], bfhi(b[0]) * rstd + s2[1], w, false); w = __builtin_amdgcn_cvt_pk_fp8_f32(bflo(b[1]) * rstd + s2[2], bfhi(b[1]) * rstd + s2[3], w, true); o[2] = (unsigned)w; }
                { int w = 0; w = __builtin_amdgcn_cvt_pk_fp8_f32(bflo(b[2]) * rstd + s3[0], bfhi(b[2]) * rstd + s3[1], w, false); w = __builtin_amdgcn_cvt_pk_fp8_f32(bflo(b[3]) * rstd + s3[2], bfhi(b[3]) * rstd + s3[3], w, true); o[3] = (unsigned)w; }
                *(LAS v4u*)(h8 + c * 1024 + F.lane * 16) = o; }
            const int j = F.lane & 31, kh = F.lane >> 5, lr = F.lane >> 3, lp = F.lane & 7;
            unsigned so[4][4];
#pragma unroll
            for (int b = 0; b < 4; ++b)
#pragma unroll
                for (int i = 0; i < 4; ++i) so[b][i] = (unsigned)__shfl(b < 2 ? id0 : id1, 32 * (b & 1) + lr + 8 * i) * 2048u + (unsigned)lp * 16u;
            int eb[4];
#pragma unroll
            for (int b = 0; b < 4; ++b) eb[b] = __shfl(b < 2 ? id0 : id1, j + 32 * (b & 1));
            const unsigned aoff0 = (j == 0) ? (unsigned)(16 * kh) : 4096u, aoff1 = (j == 0) ? (unsigned)(32 + 16 * kh) : 4112u, astep = (j == 0) ? 64u : 0u;
            const unsigned wof = (unsigned)lr * 144u + (unsigned)lp * 16u, rof = (unsigned)j * 144u + (unsigned)kh * 16u;
            f32x16 ac[4];
#pragma unroll
            for (int b = 0; b < 4; ++b) ac[b] = (f32x16){};
            v4u R0[8], R1[8];
#define ULOAD(R_, kg_, bp_) do { _Pragma("unroll") for (int bb = 0; bb < 2; ++bb) _Pragma("unroll") for (int i = 0; i < 4; ++i) \
                R_[4 * bb + i] = *(const GAS v4u*)(U + (size_t)so[2 * (bp_) + bb][i] + (size_t)(kg_) * 128); } while (0)
#define USTAGE(R_, bp_) do { _Pragma("unroll") for (int bb = 0; bb < 2; ++bb) _Pragma("unroll") for (int i = 0; i < 4; ++i) *(LAS v4u*)(stg + bb * 4608 + i * 1152 + wof) = R_[4 * bb + i]; \
            _Pragma("unroll") for (int bb = 0; bb < 2; ++bb) { v4u B_[4]; _Pragma("unroll") for (int kk = 0; kk < 4; ++kk) B_[kk] = *(const LAS v4u*)(stg + bb * 4608 + rof + kk * 32); \
                _Pragma("unroll") for (int kk = 0; kk < 4; ++kk) ac[2 * (bp_) + bb] = __builtin_amdgcn_mfma_scale_f32_32x32x64_f8f6f4(A[kk], (v8i){(int)B_[kk][0], (int)B_[kk][1], (int)B_[kk][2], (int)B_[kk][3], 0, 0, 0, 0}, ac[2 * (bp_) + bb], 0, 4, 0, 0x7f7f7f7f, 0, 0x7f7f7f7f); } } while (0)
            ULOAD(R0, 0, 0);
#pragma unroll 1
            for (int kg = 0; kg < 16; ++kg) {
                v8i A[4];
#pragma unroll
                for (int kk = 0; kk < 4; ++kk) { const unsigned kb = (unsigned)(4 * kg + kk); const v4u x = *(const LAS v4u*)(h8 + aoff0 + kb * astep), y = *(const LAS v4u*)(h8 + aoff1 + kb * astep);
                    A[kk] = (v8i){(int)x[0], (int)x[1], (int)x[2], (int)x[3], (int)y[0], (int)y[1], (int)y[2], (int)y[3]}; }
                ULOAD(R1, kg, 1);
                USTAGE(R0, 0);
                ULOAD(R0, (kg + 1) & 15, 0);
                USTAGE(R1, 1);
            }
#undef ULOAD
#undef USTAGE
#pragma unroll
            for (int b = 0; b < 4; ++b) {
                const float av = pg8::gelu_pk((f32x2){ac[b][0] * RSU[eb[b]], 0.f}).x;
                const float gg = __shfl(b < 2 ? g0 : g1, j + 32 * (b & 1)); const float wv = av * gg;
                if ((b & 1) == 0) { if (b == 0) w0 = F.lane < 32 ? wv : w0; else w1 = F.lane < 32 ? wv : w1; }
                else { const float mv = __shfl(wv, j); if (b == 1) w0 = F.lane >= 32 ? mv : w0; else w1 = F.lane >= 32 ? mv : w1; } }
        }
#else
        {   f32x2 hx[32];
#pragma unroll
            for (int c = 0; c < 4; ++c) { const GAS v4u* hp = (const GAS v4u*)(H2 + (size_t)t * DM + c * 1024 + F.lane * 16); const v4u a = hp[0], b = hp[1];
#pragma unroll
                for (int k = 0; k < 4; ++k) { hx[8 * c + k] = (f32x2){bflo(a[k]), bfhi(a[k])}; hx[8 * c + 4 + k] = (f32x2){bflo(b[k]), bfhi(b[k])}; } }
            v2u ra[4], rb[4], rc[4], rd[4], na[4], nb[4], nc[4], nd[4];
            if (MODE != 2) {
            LOADROWS4(U, ra, rb, 0); LOADROWS4(U, rc, rd, 2);
#pragma unroll 1
            for (int e = 0; e < 128; e += 8) {
                LOADROWS4(U, na, nb, e + 4); LOADROWS4(U, nc, nd, e + 6);
                UPAIR(ra, rb, e); UPAIR(rc, rd, e + 2);
                LOADROWS4(U, ra, rb, e + 8); LOADROWS4(U, rc, rd, e + 10);
                UPAIR(na, nb, e + 4); UPAIR(nc, nd, e + 6);
            } } }
#endif
        if (MODE == 1 || MODE == 3) { asm volatile("" :: "v"(w0), "v"(w1)); continue; }
#if PEER_VMFMA
        {
            LAS unsigned char* wreg = F.lds + F.wave * 18688; LAS unsigned char* w8 = wreg; LAS unsigned char* stg = wreg + 256;
            const int j = F.lane & 31, kh = F.lane >> 5;
            { const float q0 = w0 * RS[id0] * 16.0f, q1 = w1 * RS[id1] * 16.0f;
              const int b0 = __builtin_amdgcn_cvt_pk_fp8_f32(q0, q0, 0, false), b1 = __builtin_amdgcn_cvt_pk_fp8_f32(q1, q1, 0, false);
              w8[F.lane] = (unsigned char)(b0 & 0xff); w8[64 + F.lane] = (unsigned char)(b1 & 0xff); if (F.lane < 8) *(LAS v2u*)(w8 + 128 + 8 * F.lane) = (v2u){0u, 0u}; }
            v8i A[2];
#pragma unroll
            for (int kb = 0; kb < 2; ++kb) { const unsigned o0 = (j == 0) ? (unsigned)(64 * kb + 16 * kh) : 128u, o1 = (j == 0) ? (unsigned)(64 * kb + 32 + 16 * kh) : 144u;
                const v4u x = *(const LAS v4u*)(w8 + o0), y = *(const LAS v4u*)(w8 + o1);
                A[kb] = (v8i){(int)x[0], (int)x[1], (int)x[2], (int)x[3], (int)y[0], (int)y[1], (int)y[2], (int)y[3]}; }
            const int lr = F.lane >> 3, lp = F.lane & 7;
            unsigned so[2][8];
#pragma unroll
            for (int kb = 0; kb < 2; ++kb)
#pragma unroll
                for (int i = 0; i < 8; ++i) so[kb][i] = (unsigned)__shfl(kb == 0 ? id0 : id1, 8 * i + lr) * 2048u + (unsigned)lp * 16u;
            const unsigned wof = (unsigned)lr * 144u + (unsigned)lp * 16u;
            const unsigned rof = (unsigned)(32 * kh + (F.lane & 15)) * 144u + (unsigned)(8 * ((F.lane >> 4) & 1));
            const bf16* X1r = WSP(bf16, WS_X1) + (size_t)t * DM; const float* G2 = MOD + 20480; float* Or = F.out + (size_t)t * DM;
            v4u R0[8], R1[8];
#define VLOAD(R_, cg_, kb_) do { _Pragma("unroll") for (int i = 0; i < 8; ++i) R_[i] = *(const GAS v4u*)(V + (size_t)so[kb_][i] + (size_t)(cg_) * 128); } while (0)
            VLOAD(R0, 0, 0); VLOAD(R1, 0, 1);
#pragma unroll 1
            for (int cg = 0; cg < 16; ++cg) {
#pragma unroll
                for (int i = 0; i < 8; ++i) { *(LAS v4u*)(stg + i * 1152 + wof) = R0[i]; *(LAS v4u*)(stg + 9216 + i * 1152 + wof) = R1[i]; }
                VLOAD(R0, (cg + 1) & 15, 0); VLOAD(R1, (cg + 1) & 15, 1);
#pragma unroll
                for (int tp = 0; tp < 4; ++tp) { float dv[2];
#pragma unroll
                    for (int th = 0; th < 2; ++th) { const int tt = 2 * tp + th; f32x16 d_ = (f32x16){};
#pragma unroll
                        for (int kb = 0; kb < 2; ++kb) {
                            const v2i q0_ = __builtin_amdgcn_ds_read_tr4_b64_v2i32((LAS v2i*)(stg + kb * 9216 + rof + tt * 16)), q1_ = __builtin_amdgcn_ds_read_tr4_b64_v2i32((LAS v2i*)(stg + kb * 9216 + 2304 + rof + tt * 16));
                            d_ = __builtin_amdgcn_mfma_scale_f32_32x32x64_f8f6f4(A[kb], (v8i){q0_[0], q0_[1], q1_[0], q1_[1], 0, 0, 0, 0}, d_, 0, 4, 0, 0x7b7b7b7b, 0, 0x7f7f7f7f); }
                        dv[th] = d_[0]; }
                    const auto sw = __builtin_amdgcn_permlane32_swap(__float_as_uint(dv[0]), __float_as_uint(dv[1]), false, false);
                    const float dd = __uint_as_float(sw[0]);
                    if (MODE == 2) { asm volatile("" :: "v"(dd)); } else { const int col = cg * 256 + tp * 64 + F.lane; Or[col] = bf2f(X1r[col]) + G2[col] * dd; } }
            }
#undef VLOAD
        }
#else
        f32x2 acc[32];
#pragma unroll
        for (int j = 0; j < 32; ++j) acc[j] = (f32x2){0.f, 0.f};
        {   v2u ra[4], rb[4], rc[4], rd[4], na[4], nb[4], nc[4], nd[4];
            LOADROWS4(V, ra, rb, 0); LOADROWS4(V, rc, rd, 2);
#pragma unroll 1
            for (int e = 0; e < 128; e += 8) {
                LOADROWS4(V, na, nb, e + 4); LOADROWS4(V, nc, nd, e + 6);
                VPAIR(ra, rb, e); VPAIR(rc, rd, e + 2);
                LOADROWS4(V, ra, rb, e + 8); LOADROWS4(V, rc, rd, e + 10);
                VPAIR(na, nb, e + 4); VPAIR(nc, nd, e + 6);
            } }
        if (MODE == 2) {
#pragma unroll
            for (int j = 0; j < 32; ++j) asm volatile("" :: "v"(acc[j]));
            continue; }
#pragma unroll
        for (int c = 0; c < 4; ++c) { const int col = c * 1024 + F.lane * 16; GAS f32x4* op = (GAS f32x4*)(F.out + (size_t)t * DM + col);
            const GAS f32x4* xp = (const GAS f32x4*)(WSP(float, WS_X1) + (size_t)t * DM + col); const GAS f32x4* gp = (const GAS f32x4*)(MOD + 20480 + col);
#pragma unroll
            for (int q = 0; q < 4; ++q) op[q] = xp[q] + gp[q] * (f32x4){acc[8 * c + 2 * q].x, acc[8 * c + 2 * q].y, acc[8 * c + 2 * q + 1].x, acc[8 * c + 2 * q + 1].y}; }
#endif
    }
}
#undef LOADROWS
#undef UDOT
#undef UPAIR
#undef VAXPY
#undef VPAIR
#undef LOADROWS4
#ifndef MK_SINGLE
#define MK_SINGLE 1
#endif
constexpr int N_PHASES = 11;
__global__ void __launch_bounds__(NTHREADS, 2) fwd_kernel(Args args) {
    extern __shared__ __attribute__((aligned(16))) unsigned char lds[];
    Frame F;
    F.lds = (LAS unsigned char*)lds; F.MISC = (volatile LAS unsigned*)(F.lds + MISC_OFF);
    F.tid = threadIdx.x; F.lane = F.tid & 63; F.wave = __builtin_amdgcn_readfirstlane(F.tid >> 6);
    F.G = gridDim.x; { const int bx = blockIdx.x; F.vcu = (F.G % 8 == 0) ? (bx % 8) * (F.G / 8) + bx / 8 : bx; }
    F.ws = args.ws; F.out = args.out; F.ctl = (gu32*)(args.ws + WS_CTL);
    for (int u = F.tid; u < (LDS_BYTES - LDSCTL_OFF) / 4; u += NTHREADS) ((LAS unsigned*)(F.lds + LDSCTL_OFF))[u] = 0u;
    __syncthreads();
    const int lo = args.ph_lo, hi = args.ph_hi;
    XcdBarrier bar; bar.bar = (unsigned*)(F.ctl + CW_BAR); bar.x = 0; bar.st = nullptr;
    if (hi - lo > 1) bar = xcd_barrier_post((unsigned*)(F.ctl + CW_BAR), F.MISC + 8);
#ifndef PH_MASK
#define PH_MASK 0x7ff
#endif
#define IN(k) (((PH_MASK >> (k)) & 1) && lo <= (k) && (k) < hi)
#define SEAM(k) do { if (IN(k) && IN((k) + 1)) xcd_barrier(bar); } while (0)
#ifndef G_ALIGN
#define G_ALIGN true
#endif
#ifndef G_SP2
#define G_SP2 true
#endif
#ifndef REP_PHASE
#define REP_PHASE -1
#endif
#define REPEAT(k) _Pragma("unroll") for (int rep = 0; rep < ((REP_PHASE) == (k) ? 2 : 1); ++rep)
#define REPBAR(k) do { if ((REP_PHASE) == (k) && rep == 0) xcd_barrier(bar); } while (0)
    const int bid = (int)blockIdx.x;
    if (IN(0)) { REPEAT(0) { p0_prologue(F, args); REPBAR(0); } SEAM(0); }
    if (IN(1)) { REPEAT(1) { p1_norm_forget(F, args); p1_shift_proj(F, args); REPBAR(1); } SEAM(1); }
    if (IN(2)) { REPEAT(2) {
        pg8::Gemm g{WSP(bf16, WS_HA), WSP(bf16, WS_WIN), S, NINP, DM}; pg8::StaticOrder So; So.init(S, NINP, F.G, bid);
        pg8::EpiIn E{WSP(bf16, WS_QKV), WSP(bf16, WS_LX), WSP(bf16, WS_GY), WSP(bf16, WS_GA), WSP(bf16, WS_GL), WSP(float, WS_BIASR)};
        pg8::gemm_phase<pg8::EpiIn, pg8::StaticOrder, G_ALIGN, G_SP2>(F.lds, g, So, E);
        REPBAR(2); }
        SEAM(2);
    }
    if (IN(3)) {
        p3_qknorm(F, args);
        __syncthreads();
        REPEAT(3) {
        p3_cumsum(F, args);
        for (int w = bid; w < 256; w += F.G) lru_item<0>(F, args, w);
        REPBAR(3); }
        SEAM(3);
    }
    if (IN(4)) {
#pragma unroll 1
        for (int rep = 0; rep < args.rep_att; ++rep) p4_attention(F, args, (char*)lds, rep);
#pragma unroll 1
        for (int rep = 0; rep < args.rep_lru; ++rep)
        for (int w = bid; w < 256; w += F.G) lru_item<1>(F, args, w);
        SEAM(4);
    }
    if (IN(5)) { REPEAT(5) {
        { pg8::Gemm g{WSP(bf16, WS_ATT), WSP(bf16, WS_WAO), S, DM, AW}; pg8::StaticOrder So; So.init(S, DM, F.G, bid);
          pg8::EpiGate<0> E{WSP(bf16, WS_T1), WSP(bf16, WS_GA), DM};
          pg8::gemm_phase<pg8::EpiGate<0>, pg8::StaticOrder, true, true>(F.lds, g, So, E); }
        { pg8::Gemm g{WSP(bf16, WS_LR), WSP(bf16, WS_WLO), S, DM, LW}; pg8::StaticOrder So; So.init(S, DM, F.G, bid);
          pg8::EpiGate<1> E{WSP(bf16, WS_T1), WSP(bf16, WS_GL), DM};
          pg8::gemm_phase<pg8::EpiGate<1>, pg8::StaticOrder, true, true>(F.lds, g, So, E); }
        REPBAR(5); }
        SEAM(5);
    }
    if (IN(6)) { REPEAT(6) {
        pg8::Gemm g{WSP(bf16, WS_T1), WSP(bf16, WS_WOUT), S, DM, DM}; pg8::StaticOrder So; So.init(S, DM, F.G, bid);
        pg8::EpiRes E{args.in[0], WSP(bf16, WS_X1), WSP(float, WS_MOD) + 8192, DM, args.in[5], WSP(float, WS_MOD) + 16384, WSP(bf16, WS_HA), WSP(float, WS_SSQ)};
        pg8::gemm_phase<pg8::EpiRes, pg8::StaticOrder, true, true>(F.lds, g, So, E);
        REPBAR(6); }
        SEAM(6);
    }
    if (IN(8)) { REPEAT(8) {
        pg8::Gemm g{WSP(bf16, WS_HA), WSP(bf16, WS_WPQ), S, 2048, DM}; pg8::RstdOrder So; So.init(S, 2048, F.G, bid);
        So.SSQ = WSP(float, WS_SSQ); So.rs = (LAS float*)(F.lds + 133120); So.inv_n = 1.0f / DM; So.eps = EPS; So.na = 0;
        pg8::EpiQ2 E{WSP(bf16, WS_Q2), 2048, WSP(float, WS_SB), (const LAS float*)(F.lds + 133120), 0};
        pg8::gemm_phase<pg8::EpiQ2, pg8::RstdOrder, true, true>(F.lds, g, So, E);
        REPBAR(8); }
        SEAM(8);
    }
    if (IN(9)) { REPEAT(9) { p9_topk(F, args); REPBAR(9); } SEAM(9); }
#ifndef P10_PROBE
#define P10_PROBE 0
#endif
    if (IN(10)) { if (P10_PROBE) { p10_peer<P10_PROBE>(F, args); xcd_barrier(bar); } REPEAT(10) { p10_peer<0>(F, args); REPBAR(10); } }
#undef IN
#undef SEAM
}

extern "C" void kernel_launch(void* const* d_in, const int* in_sizes, int n_in, void* d_out, int out_size, void* d_ws, size_t ws_size, hipStream_t stream) {
    static int grid = 0;
    if (grid == 0) {
        if (n_in != 24 || in_sizes[0] != S * DM || out_size != S * DM || ws_size < WS_END) { fprintf(stderr, "kernel_launch: unexpected shapes (n_in %d, in0 %d, out %d, ws %zu)\n", n_in, n_in > 0 ? in_sizes[0] : -1, out_size, ws_size); grid = -1; return; }
        int dev = 0, cus = 0, per_cu = 0;
        if (hipGetDevice(&dev) != hipSuccess || hipDeviceGetAttribute(&cus, hipDeviceAttributeMultiprocessorCount, dev) != hipSuccess) { grid = -1; return; }
        if (hipFuncSetAttribute((const void*)fwd_kernel, hipFuncAttributeMaxDynamicSharedMemorySize, LDS_BYTES) != hipSuccess) { fprintf(stderr, "kernel_launch: hipFuncSetAttribute failed\n"); grid = -1; return; }
        if (hipOccupancyMaxActiveBlocksPerMultiprocessor(&per_cu, (const void*)fwd_kernel, NTHREADS, LDS_BYTES) != hipSuccess || per_cu < 1) fprintf(stderr, "kernel_launch: occupancy query reports %d blocks per CU\n", per_cu);
        (void)hipGetLastError();
        grid = cus;
    }
    if (grid < 0) return;
    if (hipMemsetAsync((char*)d_ws + WS_CTL, 0, CTL_ZERO_BYTES, stream) != hipSuccess) return;
    Args a{};
    for (int i = 0; i < 24; ++i) a.in[i] = (const float*)d_in[i];
    a.out = (float*)d_out; a.ws = (unsigned char*)d_ws;
#ifndef REP_ATT
#define REP_ATT 1
#endif
#ifndef REP_LRU
#define REP_LRU 1
#endif
    a.rep_att = REP_ATT; a.rep_lru = REP_LRU;
#if MK_SINGLE
    a.ph_lo = 0; a.ph_hi = N_PHASES;
    hipLaunchKernelGGL(fwd_kernel, dim3(grid), dim3(NTHREADS), LDS_BYTES, stream, a);
#else
    for (int p = 0; p < N_PHASES; ++p) { a.ph_lo = p; a.ph_hi = p + 1; hipLaunchKernelGGL(fwd_kernel, dim3(grid), dim3(NTHREADS), LDS_BYTES, stream, a); }
#endif
}
```

```cpp
#include <hip/hip_runtime.h>
#include <cstdio>
#include <cstdint>
namespace pg8 {
#define PG8_LAS __attribute__((address_space(3)))
typedef unsigned short bf16_t;
typedef short bf16x8 __attribute__((ext_vector_type(8)));
typedef float f32x4 __attribute__((ext_vector_type(4)));
typedef unsigned u32x4 __attribute__((ext_vector_type(4)));
constexpr int BM = 256, BK = 64, HALF = 128, HTB = HALF * BK * 2  , STAGE_BYTES = 8 * HTB, NXCD = 8, WGM = 8;

__host__ __device__ __forceinline__ int lds_byte(int r, int c) { const int st = (r >> 4) * 2 + (c >> 5), rr = r & 15, cc = c & 31, ob = rr * 64 + cc * 2; return st * 1024 + (ob ^ (((ob >> 9) & 1) << 5)); }
__host__ __device__ __forceinline__ void stage_rc(int b, int& R, int& C) { const int st = b / 1024, sb = b % 1024, swz = sb ^ (((sb >> 9) & 1) << 5); R = (st >> 1) * 16 + swz / 64; C = (st & 1) * 32 + (swz % 64) / 2; }
__host__ __device__ __forceinline__ int perm32(int rho) { const int n = rho >> 4, i = rho & 15; return 8 * (i >> 2) + 4 * n + (i & 3); }

struct Unit { int pm, pn; };
struct Gemm { const bf16_t* A; const bf16_t* Bt; int M, N, K; int lda = 0, ldb = 0; const bf16_t* A2 = nullptr; const bf16_t* Bt2 = nullptr; int ksplit = 0; };

struct StaticOrder {
    int nM, nN, nwg, G, c;
    __host__ __device__ void init(int M, int N, int G_, int c_) { nM = M / BM; nN = N / BM; nwg = nM * nN; G = G_; c = c_; }
    __host__ __device__ bool next(int i, Unit& u) const {
        const long L = (long)i * G + c; if (L >= nwg) return false;
        int wgid = (int)L; { const int q = nwg / NXCD, r = nwg % NXCD, xcd = wgid % NXCD, off = wgid / NXCD; wgid = (xcd < r ? xcd * (q + 1) : r * (q + 1) + (xcd - r) * q) + off; }
        const int nig = WGM * nN, gid = wgid / nig, fm = gid * WGM, gsz = (nM - fm) < WGM ? (nM - fm) : WGM;
        u.pm = fm + ((wgid % nig) % gsz); u.pn = (wgid % nig) / gsz; return true;
    }
    __device__ __forceinline__ void a_ready(const Unit&) const {}
    __device__ __forceinline__ void done(const Unit&) const {}
};

__device__ __forceinline__ unsigned cvt_pk_bf16(float lo, float hi) { unsigned r; asm volatile("v_cvt_pk_bf16_f32 %0, %1, %2" : "=v"(r) : "v"(lo), "v"(hi)); return r; }
typedef float f32x2 __attribute__((ext_vector_type(2)));
__device__ __forceinline__ f32x2 gelu_pk(f32x2 v) {
    const f32x2 av = __builtin_elementwise_abs(v), d = av * 0.2316418882f + 1.0f;
    f32x2 t; t.x = __builtin_amdgcn_rcpf(d.x); t.y = __builtin_amdgcn_rcpf(d.y);
    f32x2 q = t * 0.5307027145f + (-0.7265760135f); q = q * t + 0.7107068705f; q = q * t + (-0.142248368f); q = q * t + 0.127414796f; q = q * t;
    const f32x2 s = (v * v) * (-0.72134752044f);
    f32x2 e; e.x = __builtin_amdgcn_exp2f(s.x); e.y = __builtin_amdgcn_exp2f(s.y);
    const f32x2 m = v * (q * e), r = v - m;
    f32x2 o; o.x = v.x < 0.f ? m.x : r.x; o.y = v.y < 0.f ? m.y : r.y; return o;
}


__device__ __forceinline__ const char* sgpr_ptr(const char* p) { const unsigned long long v = (unsigned long long)p; unsigned lo = (unsigned)v, hi = (unsigned)(v >> 32);
    asm volatile("" : "+s"(lo), "+s"(hi)); return (const char*)(((unsigned long long)hi << 32) | lo); }
template <int ACT  > struct EpiBf16 {
    static constexpr bool PERM = true, AFTER_DRAIN = false, EPI_LOADS = false; static_assert(ACT == 0 || ACT == 1, "EpiBf16: ACT is 0 (none) or 1 (gelu_pk)");
    bf16_t* O; int ldc; const float* bias; int split_cols; size_t split_stride; float scale0;
    __device__ __forceinline__ void operator()(const f32x4 (&acc)[2][2][4][2], const Unit& u, int wr, int wc, int fr, int fq) const {
        const int row0 = u.pm * BM + wr * 64 + fr; int colt = u.pn * BM; bf16_t* base = O;
        float sc = 1.f; if (split_cols) { const int t = colt / split_cols; base += (size_t)t * split_stride; colt -= t * split_cols; if (t == 0) sc = scale0; }
        const int col0 = colt + wc * 32 + 8 * fq, bcol0 = u.pn * BM + wc * 32 + 8 * fq;
        f32x4 bv[2][2];
#pragma unroll
        for (int bj = 0; bj < 2; ++bj)
#pragma unroll
            for (int n = 0; n < 2; ++n) bv[bj][n] = bias ? *(const f32x4*)(bias + bcol0 + bj * HALF + 4 * n) : (f32x4){0.f, 0.f, 0.f, 0.f};
#pragma unroll
        for (int ai = 0; ai < 2; ++ai)
#pragma unroll
            for (int m = 0; m < 4; ++m) { bf16_t* rowp = base + (size_t)(row0 + ai * HALF + m * 16) * ldc + col0;
#pragma unroll
                for (int bj = 0; bj < 2; ++bj) { f32x4 v0 = acc[ai][bj][m][0] + bv[bj][0], v1 = acc[ai][bj][m][1] + bv[bj][1];
                    if (ACT == 1) { f32x2 a = gelu_pk((f32x2){v0[0], v0[1]}), b = gelu_pk((f32x2){v0[2], v0[3]}), c = gelu_pk((f32x2){v1[0], v1[1]}), d = gelu_pk((f32x2){v1[2], v1[3]});
                        v0 = (f32x4){a.x, a.y, b.x, b.y}; v1 = (f32x4){c.x, c.y, d.x, d.y}; }
                    v0 = v0 * sc; v1 = v1 * sc; u32x4 w; w.x = cvt_pk_bf16(v0[0], v0[1]); w.y = cvt_pk_bf16(v0[2], v0[3]); w.z = cvt_pk_bf16(v1[0], v1[1]); w.w = cvt_pk_bf16(v1[2], v1[3]);
                    *(u32x4*)(rowp + bj * HALF) = w; } }
    }
};
__device__ __forceinline__ f32x4 sigm4(f32x4 v) { f32x4 o;
#pragma unroll
    for (int j = 0; j < 4; ++j) o[j] = __builtin_amdgcn_rcpf(1.0f + __builtin_amdgcn_exp2f(-1.4426950408889634f * v[j]));
    return o; }
__device__ __forceinline__ f32x4 gelu4(f32x4 v) { const f32x2 a = gelu_pk((f32x2){v[0], v[1]}), b = gelu_pk((f32x2){v[2], v[3]}); return (f32x4){a.x, a.y, b.x, b.y}; }
__device__ __forceinline__ void unpack8(const u32x4 w, f32x4& lo, f32x4& hi) {
    lo = (f32x4){__uint_as_float(w.x << 16), __uint_as_float(w.x & 0xffff0000u), __uint_as_float(w.y << 16), __uint_as_float(w.y & 0xffff0000u)};
    hi = (f32x4){__uint_as_float(w.z << 16), __uint_as_float(w.z & 0xffff0000u), __uint_as_float(w.w << 16), __uint_as_float(w.w & 0xffff0000u)}; }
#ifdef EPI_NT
#define EPI_ST(p, v) __builtin_nontemporal_store((v), (p))
#else
#define EPI_ST(p, v) (*(p) = (v))
#endif
struct EpiIn {
    static constexpr bool PERM = true, AFTER_DRAIN = false, EPI_LOADS = true;
    bf16_t* qkv; bf16_t* lx; bf16_t* gy; bf16_t* ga; bf16_t* gl; const float* bias;
    __device__ __forceinline__ void operator()(const f32x4 (&acc)[2][2][4][2], const Unit& u, int wr, int wc, int fr, int fq) const {
        const int pn = u.pn; bf16_t* base; int ldc, colt, act;
        if (pn < 24) { base = qkv + (size_t)(pn >> 3) * ((size_t)8192 * 2048); ldc = 2048; colt = (pn & 7) * 256; act = 0; }
        else if (pn < 32) { base = lx; ldc = 2048; colt = (pn - 24) * 256; act = 0; }
        else if (pn < 40) { base = gy; ldc = 2048; colt = (pn - 32) * 256; act = 1; }
        else if (pn < 56) { base = ga; ldc = 4096; colt = (pn - 40) * 256; act = 2; }
        else { base = gl; ldc = 4096; colt = (pn - 56) * 256; act = 2; }
        const int row0 = u.pm * BM + wr * 64 + fr, col0 = colt + wc * 32 + 8 * fq, bcol0 = pn * BM + wc * 32 + 8 * fq;
        f32x4 bv[2][2];
#pragma unroll
        for (int bj = 0; bj < 2; ++bj)
#pragma unroll
            for (int n = 0; n < 2; ++n) bv[bj][n] = *(const f32x4*)(bias + bcol0 + bj * HALF + 4 * n);
#pragma unroll
        for (int ai = 0; ai < 2; ++ai)
#pragma unroll
            for (int m = 0; m < 4; ++m) { bf16_t* rowp = base + (size_t)(row0 + ai * HALF + m * 16) * ldc + col0;
#pragma unroll
                for (int bj = 0; bj < 2; ++bj) { f32x4 v0 = acc[ai][bj][m][0] + bv[bj][0], v1 = acc[ai][bj][m][1] + bv[bj][1];
                    if (act == 1) { v0 = gelu4(v0); v1 = gelu4(v1); }
                    else if (act == 2) { v0 = sigm4(v0); v1 = sigm4(v1); }
                    u32x4 w; w.x = cvt_pk_bf16(v0[0], v0[1]); w.y = cvt_pk_bf16(v0[2], v0[3]); w.z = cvt_pk_bf16(v1[0], v1[1]); w.w = cvt_pk_bf16(v1[2], v1[3]);
                    EPI_ST((u32x4*)(rowp + bj * HALF), w); } }
    }
};
#ifndef EPI_PROBE
#define EPI_PROBE 0
#endif
struct EpiInProbe {
    static constexpr bool PERM = true, AFTER_DRAIN = false, EPI_LOADS = true;
    bf16_t* qkv; bf16_t* lx; bf16_t* gy; bf16_t* ga; bf16_t* gl; const float* bias;
    __device__ __forceinline__ void operator()(const f32x4 (&acc)[2][2][4][2], const Unit& u, int wr, int wc, int fr, int fq) const {
        const int pn = u.pn; bf16_t* base; int ldc, colt, act;
        if (pn < 24) { base = qkv + (size_t)(pn >> 3) * ((size_t)8192 * 2048); ldc = 2048; colt = (pn & 7) * 256; act = 0; }
        else if (pn < 32) { base = lx; ldc = 2048; colt = (pn - 24) * 256; act = 0; }
        else if (pn < 40) { base = gy; ldc = 2048; colt = (pn - 32) * 256; act = 1; }
        else if (pn < 56) { base = ga; ldc = 4096; colt = (pn - 40) * 256; act = 2; }
        else { base = gl; ldc = 4096; colt = (pn - 56) * 256; act = 2; }
        const int row0 = u.pm * BM + wr * 64 + fr, col0 = colt + wc * 32 + 8 * fq, bcol0 = pn * BM + wc * 32 + 8 * fq;
        f32x4 bv[2][2];
#pragma unroll
        for (int bj = 0; bj < 2; ++bj)
#pragma unroll
            for (int n = 0; n < 2; ++n) bv[bj][n] = (EPI_PROBE == 2) ? (f32x4){0.f, 0.f, 0.f, 0.f} : *(const f32x4*)(bias + bcol0 + bj * HALF + 4 * n);
#pragma unroll
        for (int ai = 0; ai < 2; ++ai)
#pragma unroll
            for (int m = 0; m < 4; ++m) { bf16_t* rowp = base + (size_t)(row0 + ai * HALF + m * 16) * ldc + col0;
#pragma unroll
                for (int bj = 0; bj < 2; ++bj) { f32x4 v0 = acc[ai][bj][m][0] + bv[bj][0], v1 = acc[ai][bj][m][1] + bv[bj][1];
                    if (act == 1) { v0 = gelu4(v0); v1 = gelu4(v1); }
                    else if (act == 2) { v0 = sigm4(v0); v1 = sigm4(v1); }
                    u32x4 w; w.x = cvt_pk_bf16(v0[0], v0[1]); w.y = cvt_pk_bf16(v0[2], v0[3]); w.z = cvt_pk_bf16(v1[0], v1[1]); w.w = cvt_pk_bf16(v1[2], v1[3]);
                    if (EPI_PROBE != 1 || w.x == 0x12345678u) EPI_ST((u32x4*)(rowp + bj * HALF), w); } }
    }
};
template <int MODE> struct EpiGate {
    static constexpr bool PERM = true, AFTER_DRAIN = false, EPI_LOADS = true;
    bf16_t* O; const bf16_t* Gt; int ldc;
    __device__ __forceinline__ void operator()(const f32x4 (&acc)[2][2][4][2], const Unit& u, int wr, int wc, int fr, int fq) const {
        const int row0 = u.pm * BM + wr * 64 + fr, col0 = u.pn * BM + wc * 32 + 8 * fq;
#pragma unroll
        for (int ai = 0; ai < 2; ++ai)
#pragma unroll
            for (int m = 0; m < 4; ++m) { const size_t off = (size_t)(row0 + ai * HALF + m * 16) * ldc + col0;
#pragma unroll
                for (int bj = 0; bj < 2; ++bj) { f32x4 g0, g1; unpack8(*(const u32x4*)(Gt + off + bj * HALF), g0, g1);
                    f32x4 v0 = acc[ai][bj][m][0] * g0, v1 = acc[ai][bj][m][1] * g1;
                    if (MODE == 1) { f32x4 t0, t1; unpack8(*(const u32x4*)(O + off + bj * HALF), t0, t1); v0 += t0; v1 += t1; }
                    u32x4 w; w.x = cvt_pk_bf16(v0[0], v0[1]); w.y = cvt_pk_bf16(v0[2], v0[3]); w.z = cvt_pk_bf16(v1[0], v1[1]); w.w = cvt_pk_bf16(v1[2], v1[3]);
                    *(u32x4*)(O + off + bj * HALF) = w; } }
    }
};
struct EpiGate2 {
    static constexpr bool PERM = true, AFTER_DRAIN = false, EPI_LOADS = true;
    bf16_t* O; const bf16_t* Ga; const bf16_t* Gl; int ldc;
    __device__ __forceinline__ void mid(f32x4 (&acc)[2][2][4][2], const Unit& u, int wr, int wc, int fr, int fq) const {
        const unsigned lb = (unsigned)(fr * ldc + 8 * fq) * 2u;
        const size_t ub = ((size_t)(u.pm * BM + wr * 64) * ldc + (size_t)(u.pn * BM + wc * 32)) * 2u;
        const char* ga = (const char*)Ga + ub; const char* gl = (const char*)Gl + ub;
#pragma unroll
        for (int ai = 0; ai < 2; ++ai)
#pragma unroll
            for (int m = 0; m < 4; ++m)
#pragma unroll
                for (int bj = 0; bj < 2; ++bj) { const size_t o = ((size_t)(ai * HALF + m * 16) * ldc + bj * HALF) * 2u;
                    f32x4 a0, a1, l0, l1; unpack8(*(const u32x4*)(sgpr_ptr(ga + o) + lb), a0, a1); unpack8(*(const u32x4*)(sgpr_ptr(gl + o) + lb), l0, l1);
#pragma unroll
                    for (int j = 0; j < 4; ++j) { acc[ai][bj][m][0][j] *= a0[j] * __builtin_amdgcn_rcpf(l0[j]); acc[ai][bj][m][1][j] *= a1[j] * __builtin_amdgcn_rcpf(l1[j]); }
                    __builtin_amdgcn_sched_barrier(0); }
    }
    __device__ __forceinline__ void operator()(const f32x4 (&acc)[2][2][4][2], const Unit& u, int wr, int wc, int fr, int fq) const {
        const int row0 = u.pm * BM + wr * 64 + fr, col0 = u.pn * BM + wc * 32 + 8 * fq;
#pragma unroll
        for (int ai = 0; ai < 2; ++ai)
#pragma unroll
            for (int m = 0; m < 4; ++m) { const size_t off = (size_t)(row0 + ai * HALF + m * 16) * ldc + col0;
#pragma unroll
                for (int bj = 0; bj < 2; ++bj) { f32x4 g0, g1; unpack8(*(const u32x4*)(Gl + off + bj * HALF), g0, g1);
                    const f32x4 v0 = acc[ai][bj][m][0] * g0, v1 = acc[ai][bj][m][1] * g1;
                    u32x4 w; w.x = cvt_pk_bf16(v0[0], v0[1]); w.y = cvt_pk_bf16(v0[2], v0[3]); w.z = cvt_pk_bf16(v1[0], v1[1]); w.w = cvt_pk_bf16(v1[2], v1[3]);
                    *(u32x4*)(O + off + bj * HALF) = w; } }
    }
};
struct EpiRes {
    static constexpr bool PERM = true, AFTER_DRAIN = false, EPI_LOADS = true;
    const float* X; bf16_t* Out; const float* gate; int ldc; const float* g2a; const float* g2b; bf16_t* XG; float* SSQ;
    __device__ __forceinline__ void operator()(const f32x4 (&acc)[2][2][4][2], const Unit& u, int wr, int wc, int fr, int fq) const {
        const int row0 = u.pm * BM + wr * 64 + fr, col0 = u.pn * BM + wc * 32 + 8 * fq;
        f32x4 gv[2][2], gp[2][2];
#pragma unroll
        for (int bj = 0; bj < 2; ++bj)
#pragma unroll
            for (int n = 0; n < 2; ++n) { gv[bj][n] = *(const f32x4*)(gate + col0 + bj * HALF + 4 * n);
                gp[bj][n] = *(const f32x4*)(g2a + col0 + bj * HALF + 4 * n) * (*(const f32x4*)(g2b + col0 + bj * HALF + 4 * n) + 1.0f); }
#pragma unroll
        for (int ai = 0; ai < 2; ++ai)
#pragma unroll
            for (int m = 0; m < 4; ++m) { const int row = row0 + ai * HALF + m * 16; const size_t off = (size_t)row * ldc + col0; float ss = 0.f;
#pragma unroll
                for (int bj = 0; bj < 2; ++bj) { const f32x4 xa = *(const f32x4*)(X + off + bj * HALF), xb = *(const f32x4*)(X + off + bj * HALF + 4);
                    const f32x4 y0 = xa + gv[bj][0] * acc[ai][bj][m][0], y1 = xb + gv[bj][1] * acc[ai][bj][m][1];
                    ss += ((y0[0] * y0[0] + y0[1] * y0[1]) + (y0[2] * y0[2] + y0[3] * y0[3])) + ((y1[0] * y1[0] + y1[1] * y1[1]) + (y1[2] * y1[2] + y1[3] * y1[3]));
                    u32x4 w; w.x = cvt_pk_bf16(y0[0], y0[1]); w.y = cvt_pk_bf16(y0[2], y0[3]); w.z = cvt_pk_bf16(y1[0], y1[1]); w.w = cvt_pk_bf16(y1[2], y1[3]); *(u32x4*)(Out + off + bj * HALF) = w;
                    const f32x4 g0 = y0 * gp[bj][0], g1 = y1 * gp[bj][1];
                    u32x4 wg; wg.x = cvt_pk_bf16(g0[0], g0[1]); wg.y = cvt_pk_bf16(g0[2], g0[3]); wg.z = cvt_pk_bf16(g1[0], g1[1]); wg.w = cvt_pk_bf16(g1[2], g1[3]); *(u32x4*)(XG + off + bj * HALF) = wg; }
                ss += __shfl_xor(ss, 16); ss += __shfl_xor(ss, 32);
                if (fq == 0) SSQ[(size_t)row * 64 + u.pn * 4 + wc] = ss; }
    }
};
struct EpiQ2 {
    static constexpr bool PERM = true, AFTER_DRAIN = false, EPI_LOADS = true;
    bf16_t* O; int ldc; const float* sb; const PG8_LAS float* rs; mutable int ne;
    __device__ __forceinline__ void operator()(const f32x4 (&acc)[2][2][4][2], const Unit& u, int wr, int wc, int fr, int fq) const {
        const int rl0 = wr * 64 + fr, row0 = u.pm * BM + rl0, col0 = u.pn * BM + wc * 32 + 8 * fq; const PG8_LAS float* rsp = rs + ((ne++) & 1) * 256;
        f32x4 bv[2][2];
#pragma unroll
        for (int bj = 0; bj < 2; ++bj)
#pragma unroll
            for (int n = 0; n < 2; ++n) bv[bj][n] = *(const f32x4*)(sb + col0 + bj * HALF + 4 * n);
#pragma unroll
        for (int ai = 0; ai < 2; ++ai)
#pragma unroll
            for (int m = 0; m < 4; ++m) { const float r = rsp[rl0 + ai * HALF + m * 16]; bf16_t* rowp = O + (size_t)(row0 + ai * HALF + m * 16) * ldc + col0;
#pragma unroll
                for (int bj = 0; bj < 2; ++bj) { const f32x4 v0 = acc[ai][bj][m][0] * r + bv[bj][0], v1 = acc[ai][bj][m][1] * r + bv[bj][1];
                    u32x4 w; w.x = cvt_pk_bf16(v0[0], v0[1]); w.y = cvt_pk_bf16(v0[2], v0[3]); w.z = cvt_pk_bf16(v1[0], v1[1]); w.w = cvt_pk_bf16(v1[2], v1[3]);
                    EPI_ST((u32x4*)(rowp + bj * HALF), w); } }
    }
};
struct RstdOrder : StaticOrder {
    const float* SSQ; PG8_LAS float* rs; float inv_n, eps; mutable int na;
    __device__ __forceinline__ void a_ready(const Unit& u) const {
        const int tid = threadIdx.x, r = tid >> 1, hf = tid & 1; const f32x4* p = (const f32x4*)(SSQ + (size_t)(u.pm * BM + r) * 64 + hf * 32); float s = 0.f;
#pragma unroll
        for (int k = 0; k < 8; ++k) { const f32x4 v = p[k]; s += (v[0] + v[1]) + (v[2] + v[3]); }
        s += __shfl_xor(s, 1);
        if (hf == 0) rs[(na & 1) * 256 + r] = 1.0f / sqrtf(s * inv_n + eps);
        ++na;
    }
};

struct EpiNullKeep {
    static constexpr bool PERM = true, AFTER_DRAIN = false, EPI_LOADS = false;
    float* sink;
    __device__ __forceinline__ void operator()(const f32x4 (&acc)[2][2][4][2], const Unit& u, int wr, int wc, int fr, int fq) const {
        f32x4 s = (f32x4){0.f, 0.f, 0.f, 0.f};
#pragma unroll
        for (int ai = 0; ai < 2; ++ai)
#pragma unroll
            for (int bj = 0; bj < 2; ++bj)
#pragma unroll
                for (int m = 0; m < 4; ++m) { s += acc[ai][bj][m][0]; s += acc[ai][bj][m][1]; }
        if (s[0] + s[1] + s[2] + s[3] == 1.2345e33f) sink[0] = 1.0f;
    }
};

#ifndef P2_MASKM
#define P2_MASKM 0xffff
#define P2_MASKN 0xffff
#endif
struct MaskOrder : StaticOrder {
    __host__ __device__ bool next(int i, Unit& u) const { const bool r = StaticOrder::next(i, u); u.pm &= P2_MASKM; u.pn &= P2_MASKN; return r; }
};

struct BalOrder : StaticOrder {
    bool on;
    __host__ __device__ bool next(int i, Unit& u) const { const bool r = StaticOrder::next(i, u);
        if (on) { const int p = u.pn / 36, k = u.pn % 36, ii = k >> 2, j = k & 3, idx = (ii >> 1) * 4 + j;
            u.pn = (p == 0) ? ((ii & 1) ? 36 + idx : idx) : ((ii & 1) ? 20 + idx : 52 + idx); }
        return r; }
};
template <class Epi, class Sched, bool ALIGN_EPI = false, bool SP2 = false, int DBG = 0, bool DUAL = false>
__device__ __forceinline__ void gemm_phase(PG8_LAS unsigned char* lds, const Gemm g, const Sched& S, const Epi& E) {
    const int tid = threadIdx.x, wid = __builtin_amdgcn_readfirstlane(tid >> 6), lane = tid & 63, wr = wid >> 2, wc = wid & 3, fr = lane & 15, fq = lane >> 4;
    const int K = g.K, nt = K / BK, LDA = g.lda ? g.lda : K, LDB = g.ldb ? g.ldb : K;
    unsigned voffA[2], voffB[2];
#pragma unroll
    for (int i = 0; i < 2; ++i) { int R, C; stage_rc(tid * 16 + i * 8192, R, C); const int Rb = Epi::PERM ? ((R & ~31) + perm32(R & 31)) : R;
        voffA[i] = (unsigned)(R * LDA + C) * 2u; voffB[i] = (unsigned)(Rb * LDB + C) * 2u; }
    const size_t kstep = (size_t)(BK * 2);
    const size_t hstepA = (size_t)HALF * LDA * 2, hstepB = (size_t)HALF * LDB * 2;
    const size_t tstepA = 2 * hstepA, tstepB = 2 * hstepB;
    const unsigned ldsw = (unsigned)wid * 1024u;
    const int aoff = lds_byte(wr * 64 + fr, fq * 8), boff = lds_byte(wc * 32 + fr, fq * 8);
#define PG8_SA(b, h) (((b) * 2 + (h)) * HTB)
#define PG8_SB(b, h) ((4 + (b) * 2 + (h)) * HTB)
#define PG8_STAGE(bufoff, gbase, voff) do { if constexpr (DBG != 1 && DBG != 3) _Pragma("unroll") for (int _i = 0; _i < 2; ++_i) \
        __builtin_amdgcn_global_load_lds((const unsigned*)((const char*)(gbase) + (voff)[_i]), (PG8_LAS unsigned*)(lds + (bufoff) + ldsw + _i * 8192), 16, 0, 0); } while (0)
#define PG8_LDA(dst, b, h) do { if constexpr (DBG < 2) _Pragma("unroll") for (int m = 0; m < 4; ++m) _Pragma("unroll") for (int k = 0; k < 2; ++k) dst[m][k] = *(const PG8_LAS bf16x8*)(lds + PG8_SA(b, h) + aoff + m * 2048 + k * 1024); } while (0)
#define PG8_LDB(dst, b, h) do { if constexpr (DBG < 2) _Pragma("unroll") for (int n = 0; n < 2; ++n) _Pragma("unroll") for (int k = 0; k < 2; ++k) dst[n][k] = *(const PG8_LAS bf16x8*)(lds + PG8_SB(b, h) + boff + n * 2048 + k * 1024); } while (0)
#define PG8_MMA(ai, bj, At, Bt) do { __builtin_amdgcn_s_setprio(PG8_PRIO_MMA); _Pragma("unroll") for (int m = 0; m < 4; ++m) _Pragma("unroll") for (int n = 0; n < 2; ++n) _Pragma("unroll") for (int k = 0; k < 2; ++k) \
        acc[ai][bj][m][n] = __builtin_amdgcn_mfma_f32_16x16x32_bf16(Bt[n][k], At[m][k], acc[ai][bj][m][n], 0, 0, 0); __builtin_amdgcn_s_setprio(PG8_PRIO_LD); } while (0)
#define PG8_MMAK(ai, bj, At, Bt, k) do { _Pragma("unroll") for (int m = 0; m < 4; ++m) _Pragma("unroll") for (int n = 0; n < 2; ++n) \
        acc[ai][bj][m][n] = __builtin_amdgcn_mfma_f32_16x16x32_bf16(Bt[n][k], At[m][k], acc[ai][bj][m][n], 0, 0, 0); } while (0)
#ifndef PG8_PRIO_MMA
#define PG8_PRIO_MMA 1
#define PG8_PRIO_LD 0
#endif
#ifndef PG8_NOMID
#define PG8_NOMID 0
#endif
#ifndef PG8_RELAX
#define PG8_RELAX 0
#endif
#ifndef PG8_EARLY
#define PG8_EARLY 0
#endif
#define PG8_MMA2(ai, At, B0, B1) do { if constexpr (PG8_EARLY) { PG8_BAR; __builtin_amdgcn_s_setprio(1); PG8_MMAK(ai, 0, At, B0, 0); PG8_MMAK(ai, 0, At, B0, 1); PG8_MMAK(ai, 1, At, B1, 0); PG8_SCHED; \
        PG8_BAR; PG8_SCHED; PG8_MMAK(ai, 1, At, B1, 1); __builtin_amdgcn_s_setprio(0); PG8_SCHED; } \
    else { PG8_BAR; PG8_MMA(ai, 0, At, B0); PG8_MMA(ai, 1, At, B1); PG8_BAR; PG8_SCHED; } } while (0)
#define PG8_WAIT_V(n) asm volatile("s_waitcnt vmcnt(" #n ")" ::: "memory")
#define PG8_WAIT_L(n) asm volatile("s_waitcnt lgkmcnt(" #n ")" ::: "memory")
#define PG8_BAR __builtin_amdgcn_s_barrier()
#define PG8_SCHED __builtin_amdgcn_sched_barrier(0)
    Unit cur, nxt; int ui = 0;
    if (!S.next(0, cur)) return;
    f32x4 acc[2][2][4][2];
#pragma unroll
    for (int a = 0; a < 2; ++a)
#pragma unroll
        for (int b = 0; b < 2; ++b)
#pragma unroll
            for (int m = 0; m < 4; ++m)
#pragma unroll
                for (int n = 0; n < 2; ++n) acc[a][b][m][n] = (f32x4){0.f, 0.f, 0.f, 0.f};
    bf16x8 At[4][2], B0[2][2], B1[2][2];
    if constexpr (DBG >= 2) { _Pragma("unroll") for (int m = 0; m < 4; ++m) _Pragma("unroll") for (int k = 0; k < 2; ++k) { At[m][k] = *(const PG8_LAS bf16x8*)(lds + aoff + m * 2048 + k * 1024); }
        _Pragma("unroll") for (int n = 0; n < 2; ++n) _Pragma("unroll") for (int k = 0; k < 2; ++k) { B0[n][k] = *(const PG8_LAS bf16x8*)(lds + boff + n * 2048 + k * 1024); B1[n][k] = *(const PG8_LAS bf16x8*)(lds + boff + 8192 + n * 2048 + k * 1024); } }
    const char* cA = (const char*)g.A + (size_t)cur.pm * tstepA; const char* cB = (const char*)g.Bt + (size_t)cur.pn * tstepB;
    const int ns = DUAL ? g.ksplit / BK : 0; const char* cA2 = DUAL ? (const char*)g.A2 + (size_t)cur.pm * tstepA : cA; const char* cB2 = DUAL ? (const char*)g.Bt2 + (size_t)cur.pn * tstepB : cB;
    S.a_ready(cur);
    if constexpr (SP2) {
        PG8_STAGE(PG8_SB(0, 0), cB, voffB); PG8_STAGE(PG8_SB(0, 1), cB + hstepB, voffB); PG8_STAGE(PG8_SA(0, 0), cA, voffA); PG8_STAGE(PG8_SA(0, 1), cA + hstepA, voffA);
        if (wr == 1) PG8_BAR;
        PG8_WAIT_V(2); PG8_BAR;
        PG8_STAGE(PG8_SB(1, 0), cB + kstep, voffB); PG8_STAGE(PG8_SA(1, 0), cA + kstep, voffA); PG8_STAGE(PG8_SB(1, 1), cB + hstepB + kstep, voffB);
        PG8_WAIT_V(6); PG8_BAR;
    } else {
        PG8_STAGE(PG8_SB(0, 0), cB, voffB); PG8_STAGE(PG8_SA(0, 0), cA, voffA); PG8_STAGE(PG8_SB(0, 1), cB + hstepB, voffB); PG8_STAGE(PG8_SA(0, 1), cA + hstepA, voffA);
        if (wr == 1) PG8_BAR;
        PG8_WAIT_V(4); PG8_BAR;
        PG8_STAGE(PG8_SB(1, 0), cB + kstep, voffB); PG8_STAGE(PG8_SA(1, 0), cA + kstep, voffA); PG8_STAGE(PG8_SB(1, 1), cB + hstepB + kstep, voffB);
        PG8_WAIT_V(6); PG8_BAR;
    }
    for (;;) {
        const bool has_next = S.next(ui + 1, nxt);
        const char* nA = has_next ? (const char*)g.A + (size_t)nxt.pm * tstepA : cA; const char* nB = has_next ? (const char*)g.Bt + (size_t)nxt.pn * tstepB : cB;
#pragma unroll 1
        for (int hf = 0; hf < (DUAL ? 2 : 1); ++hf) {
        const char* hA = (DUAL && hf) ? cA2 : cA; const char* hB = (DUAL && hf) ? cB2 : cB;
        const char* xA = (DUAL && !hf) ? cA2 : nA; const char* xB = (DUAL && !hf) ? cB2 : nB;
        const int ntl = DUAL ? (hf ? nt - ns : ns) : nt; const bool ulast = !DUAL || hf == 1;
        for (int t = 0; t < ntl; t += 2) {
            const bool last = (t == ntl - 2);
            const char* a1 = hA + (size_t)(t + 1) * kstep;
            const char* a2 = last ? xA : hA + (size_t)(t + 2) * kstep; const char* b2 = last ? xB : hB + (size_t)(t + 2) * kstep;
            const char* a3 = a2 + kstep; const char* b3 = b2 + kstep;
            if (last && ulast && has_next) S.a_ready(nxt);
            if constexpr (SP2) {
            const int relax_i = __builtin_amdgcn_readfirstlane((PG8_RELAX && Epi::EPI_LOADS && t == 0 && hf == 0 && ui > 0) ? 1 : 0);
#define PG8_WAIT_V0 asm volatile("s_cmp_lg_u32 %0, 0\n\ts_cbranch_scc1 1\n\ts_waitcnt vmcnt(8)" :: "s"(relax_i) : "memory", "scc")

#ifdef PG8_DMAFIRST
            PG8_STAGE(PG8_SA(1, 1), a1 + hstepA, voffA); PG8_SCHED; PG8_LDB(B0, 0, 0); PG8_LDB(B1, 0, 1); PG8_SCHED; PG8_LDA(At, 0, 0);
#else
            PG8_LDB(B0, 0, 0); PG8_LDB(B1, 0, 1); PG8_SCHED; PG8_LDA(At, 0, 0); PG8_STAGE(PG8_SA(1, 1), a1 + hstepA, voffA);
#endif

            PG8_WAIT_V0; PG8_WAIT_L(0); PG8_MMA2(0, At, B0, B1);

#ifdef PG8_DMAFIRST
            PG8_STAGE(PG8_SB(0, 0), b2, voffB); PG8_STAGE(PG8_SB(0, 1), b2 + hstepB, voffB); PG8_STAGE(PG8_SA(0, 0), a2, voffA); PG8_SCHED; PG8_LDA(At, 0, 1);
#else
            PG8_LDA(At, 0, 1); PG8_STAGE(PG8_SB(0, 0), b2, voffB); PG8_STAGE(PG8_SB(0, 1), b2 + hstepB, voffB); PG8_STAGE(PG8_SA(0, 0), a2, voffA);
#endif

            PG8_WAIT_V0; PG8_WAIT_L(0); PG8_MMA2(1, At, B0, B1);

#ifdef PG8_DMAFIRST
            PG8_STAGE(PG8_SA(0, 1), a2 + hstepA, voffA); PG8_SCHED; PG8_LDB(B0, 1, 0); PG8_LDB(B1, 1, 1); PG8_SCHED; PG8_LDA(At, 1, 0);
#else
            PG8_LDB(B0, 1, 0); PG8_LDB(B1, 1, 1); PG8_SCHED; PG8_LDA(At, 1, 0); PG8_STAGE(PG8_SA(0, 1), a2 + hstepA, voffA);
#endif

            PG8_WAIT_V(8); PG8_WAIT_L(0); PG8_MMA2(0, At, B0, B1);

#ifdef PG8_DMAFIRST
            PG8_STAGE(PG8_SB(1, 0), b3, voffB); PG8_STAGE(PG8_SB(1, 1), b3 + hstepB, voffB); PG8_STAGE(PG8_SA(1, 0), a3, voffA); PG8_SCHED; PG8_LDA(At, 1, 1);
#else
            PG8_LDA(At, 1, 1); PG8_STAGE(PG8_SB(1, 0), b3, voffB); PG8_STAGE(PG8_SB(1, 1), b3 + hstepB, voffB); PG8_STAGE(PG8_SA(1, 0), a3, voffA);
#endif

            PG8_WAIT_V(8); PG8_WAIT_L(0); PG8_MMA2(1, At, B0, B1);
            } else {
            PG8_LDB(B0, 0, 0); PG8_SCHED; PG8_LDA(At, 0, 0); PG8_STAGE(PG8_SA(1, 1), a1 + hstepA, voffA);
            PG8_WAIT_L(8); PG8_BAR; PG8_WAIT_L(0); PG8_MMA(0, 0, At, B0); PG8_BAR; PG8_SCHED;
            PG8_LDB(B1, 0, 1); PG8_STAGE(PG8_SB(0, 0), b2, voffB);
            PG8_BAR; PG8_WAIT_L(0); PG8_MMA(0, 1, At, B1); PG8_BAR;
            PG8_LDA(At, 0, 1); PG8_STAGE(PG8_SA(0, 0), a2, voffA);
            PG8_BAR; PG8_WAIT_L(0); PG8_MMA(1, 0, At, B0); PG8_BAR; PG8_SCHED;
            PG8_STAGE(PG8_SB(0, 1), b2 + hstepB, voffB);
            PG8_WAIT_V(6); PG8_BAR; PG8_MMA(1, 1, At, B1); PG8_BAR;
            PG8_LDB(B0, 1, 0); PG8_SCHED; PG8_LDA(At, 1, 0); PG8_STAGE(PG8_SA(0, 1), a2 + hstepA, voffA);
            PG8_WAIT_L(8); PG8_BAR; PG8_WAIT_L(0); PG8_MMA(0, 0, At, B0); PG8_BAR; PG8_SCHED;
            PG8_LDB(B1, 1, 1); PG8_STAGE(PG8_SB(1, 0), b3, voffB);
            PG8_BAR; PG8_WAIT_L(0); PG8_MMA(0, 1, At, B1); PG8_BAR;
            PG8_LDA(At, 1, 1); PG8_STAGE(PG8_SA(1, 0), a3, voffA);
            PG8_BAR; PG8_WAIT_L(0); PG8_MMA(1, 0, At, B0); PG8_BAR; PG8_SCHED;
            PG8_STAGE(PG8_SB(1, 1), b3 + hstepB, voffB);
            PG8_WAIT_V(6); PG8_BAR; PG8_MMA(1, 1, At, B1); PG8_BAR;
            }
        }
        if constexpr (DUAL) { if (hf == 0) { if (wr == 0) PG8_BAR; E.mid(acc, cur, wr, wc, fr, fq); if (wr == 1) PG8_BAR; } }
        }
        if constexpr (ALIGN_EPI) { if (wr == 0) PG8_BAR; }
        if constexpr (!Epi::AFTER_DRAIN) { E(acc, cur, wr, wc, fr, fq); S.done(cur); }
        if (!has_next) break;
#pragma unroll
        for (int a = 0; a < 2; ++a)
#pragma unroll
            for (int b = 0; b < 2; ++b)
#pragma unroll
                for (int m = 0; m < 4; ++m)
#pragma unroll
                    for (int n = 0; n < 2; ++n) acc[a][b][m][n] = (f32x4){0.f, 0.f, 0.f, 0.f};
        cur = nxt; cA = nA; cB = nB; ++ui;
        if constexpr (DUAL) { cA2 = (const char*)g.A2 + (size_t)cur.pm * tstepA; cB2 = (const char*)g.Bt2 + (size_t)cur.pn * tstepB; }
        if constexpr (ALIGN_EPI) { if (wr == 1) PG8_BAR; }
    }
    PG8_WAIT_V(0);
    if constexpr (!ALIGN_EPI) { if (wr == 0) PG8_BAR; }
    PG8_BAR;
    if constexpr (Epi::AFTER_DRAIN) { E.fused(acc, cur, wr, wc, fr, fq, lds, wid, lane); S.done(cur); }
#undef PG8_SA
#undef PG8_SB
#undef PG8_STAGE
#undef PG8_LDA
#undef PG8_LDB
#undef PG8_MMA
#undef PG8_MMAK
#undef PG8_MMA2
#undef PG8_WAIT_V
#undef PG8_WAIT_V0
#undef PG8_WAIT_L
#undef PG8_BAR
#undef PG8_SCHED
}
}
namespace attn_body {
constexpr int D = 128, LD = 2048;
constexpr float THR = 8.f; constexpr bool WSKIP = false;
constexpr float SCALE = 0.08838834764831845f;
constexpr int NW = 8, QBLK = 32, KVBLK = 64, QB = NW * QBLK;
constexpr int SHM_V = KVBLK * D * 2, SHM_K = KVBLK * D * 2;
constexpr int LDS_BYTES = 2 * SHM_V + 2 * SHM_K + NW * 64 * 4;

typedef short bf16x8 __attribute__((ext_vector_type(8)));
typedef short s16x4 __attribute__((ext_vector_type(4)));
typedef float f32x16 __attribute__((ext_vector_type(16)));
typedef float f32x4 __attribute__((ext_vector_type(4)));
typedef unsigned u32x4 __attribute__((ext_vector_type(4)));
template <class A, class Bt> struct same_t { static constexpr bool v = false; };
template <class A> struct same_t<A, A> { static constexpr bool v = true; };

#define KSWZ(row, colB) ((row) * 256 + ((colB) ^ (((row) & 7) << 4)))
#define SBAR() __builtin_amdgcn_sched_barrier(0)
__device__ __forceinline__ int v_st(int k, int c) { const int kk = (k & ~0xC) | ((k & 4) << 1) | ((k & 8) >> 1); return ((kk >> 3) * 4 + (c >> 5)) * 512 + ((kk & 7) * 32 + (c & 31)) * 2; }
__device__ __forceinline__ int v_rd_base(int lane) { return ((lane & 3) << 3) | (((lane >> 2) & 3) << 6) | (((lane >> 4) & 1) << 5) | (((lane >> 5) & 1) << 8); }
constexpr int v_rd_off(int d0, int ks, int half) { return d0 * 512 + ks * 4096 + half * 2048; }
__device__ __forceinline__ int crow(int r, int hi) { return (r & 3) + 8 * (r >> 2) + 4 * hi; }
__device__ __forceinline__ unsigned cvtpk(float lo, float hi) {
    unsigned r; asm volatile("v_cvt_pk_bf16_f32 %0, %1, %2" : "=v"(r) : "v"(lo), "v"(hi)); return r;
}
__device__ __forceinline__ bf16x8 pack8(f32x4 a, f32x4 b) {
    u32x4 w = {cvtpk(a[0], a[1]), cvtpk(a[2], a[3]), cvtpk(b[0], b[1]), cvtpk(b[2], b[3])};
    return *reinterpret_cast<bf16x8*>(&w);
}
template <class T> __device__ __forceinline__ bf16x8 load8(const T* p) {
    if constexpr (same_t<T, float>::v) { return pack8(*(const f32x4*)p, *(const f32x4*)(p + 4)); }
    else { return *reinterpret_cast<const bf16x8*>(p); }
}
__device__ __forceinline__ void mask_tile(f32x16& p0, f32x16& p1, int dq, unsigned W) {
    const float NEG = -__builtin_inff();
#pragma unroll
    for (int r = 0; r < 16; ++r) {
        const int c = (r & 3) + 8 * (r >> 2);
        if ((unsigned)(dq - c) >= W) p0[r] = NEG;
        if ((unsigned)(dq - c - 32) >= W) p1[r] = NEG;
    }
}
__device__ __forceinline__ void partialSM(f32x16& p0, f32x16& p1, float& m_reg, float& mn, float& alpha) {
    float pmax = p0[0]; for (int r = 1; r < 16; ++r) pmax = fmaxf(pmax, p0[r]); for (int r = 0; r < 16; ++r) pmax = fmaxf(pmax, p1[r]);
    { auto rr = __builtin_amdgcn_permlane32_swap(__float_as_uint(pmax), __float_as_uint(pmax), false, false);
      pmax = fmaxf(__uint_as_float(rr[0]), __uint_as_float(rr[1])); }
    constexpr float C2 = 1.4426950408889634f * SCALE;
    if (__builtin_expect(__all((pmax - m_reg) * SCALE <= THR), 1)) { mn = m_reg; alpha = 1.f; }
    else { mn = fmaxf(m_reg, pmax); alpha = __builtin_amdgcn_exp2f((m_reg - mn) * C2); m_reg = mn; }
    const float mnL = -mn * C2;
    for (int r = 0; r < 16; ++r) p0[r] = fmaf(p0[r], C2, mnL); for (int r = 0; r < 16; ++r) p1[r] = fmaf(p1[r], C2, mnL);
    for (int r = 0; r < 16; ++r) p0[r] = __builtin_amdgcn_exp2f(p0[r]);
}
__device__ __forceinline__ void finishSM(f32x16& p0, f32x16& p1, float alpha, float& l_reg, bf16x8& pa0, bf16x8& pa1, bf16x8& pa2, bf16x8& pa3) {
    for (int r = 0; r < 16; ++r) p1[r] = __builtin_amdgcn_exp2f(p1[r]);
    float ps = 0; for (int r = 0; r < 16; ++r) ps += p0[r]; for (int r = 0; r < 16; ++r) ps += p1[r];
    { auto rr = __builtin_amdgcn_permlane32_swap(__float_as_uint(ps), __float_as_uint(ps), false, false);
      ps = __uint_as_float(rr[0]) + __uint_as_float(rr[1]); }
    l_reg = l_reg * alpha + ps;
#define PK4(P, B_, OUT) do { unsigned a0 = cvtpk(P[B_+0], P[B_+1]), a1 = cvtpk(P[B_+2], P[B_+3]);                          \
        unsigned b0 = cvtpk(P[B_+4], P[B_+5]), b1 = cvtpk(P[B_+6], P[B_+7]);                                             \
        auto r0 = __builtin_amdgcn_permlane32_swap(a0, b0, false, false); auto r1 = __builtin_amdgcn_permlane32_swap(a1, b1, false, false); \
        u32x4 w = {r0[0], r1[0], r0[1], r1[1]}; OUT = *reinterpret_cast<bf16x8*>(&w); } while (0)
    PK4(p0, 0, pa0); PK4(p0, 8, pa1); PK4(p1, 0, pa2); PK4(p1, 8, pa3);
#undef PK4
}
template <int KB, bool SK>
__device__ __forceinline__ void qkt(f32x16& p0, f32x16& p1, const char* K_lds, int r32, int hi, const bf16x8* qr, bool act, const float* bt) {
    if (SK && !act) { const float NEG = -__builtin_inff();
#pragma unroll
        for (int r = 0; r < 16; ++r) { p0[r] = NEG; p1[r] = NEG; } return; }
    { const f32x4 b0 = *(const f32x4*)(bt), b1 = *(const f32x4*)(bt + 8), b2 = *(const f32x4*)(bt + 16), b3 = *(const f32x4*)(bt + 24);
      const f32x4 c0 = *(const f32x4*)(bt + 32), c1 = *(const f32x4*)(bt + 40), c2 = *(const f32x4*)(bt + 48), c3 = *(const f32x4*)(bt + 56);
      p0 = (f32x16){b0[0], b0[1], b0[2], b0[3], b1[0], b1[1], b1[2], b1[3], b2[0], b2[1], b2[2], b2[3], b3[0], b3[1], b3[2], b3[3]};
      p1 = (f32x16){c0[0], c0[1], c0[2], c0[3], c1[0], c1[1], c1[2], c1[3], c2[0], c2[1], c2[2], c2[3], c3[0], c3[1], c3[2], c3[3]}; }
    const char* kb[4];
#pragma unroll
    for (int dd = 0; dd < 4; ++dd) kb[dd] = K_lds + KB * SHM_K + KSWZ(r32, (dd * 16 + hi * 8) * 2);
#pragma unroll
    for (int d0 = 0; d0 < 8; ++d0) { const char* a = kb[d0 & 3] + (d0 >> 2) * 128;
        bf16x8 b0 = *reinterpret_cast<const bf16x8*>(a);
        bf16x8 b1 = *reinterpret_cast<const bf16x8*>(a + 32 * 256);
        p0 = __builtin_amdgcn_mfma_f32_32x32x16_bf16(b0, qr[d0], p0, 0, 0, 0);
        p1 = __builtin_amdgcn_mfma_f32_32x32x16_bf16(b1, qr[d0], p1, 0, 0, 0); }
}
template <int VB, bool SK>
__device__ __forceinline__ void pv_tile(f32x16* o, int vb0, bf16x8 pa0, bf16x8 pa1, bf16x8 pa2, bf16x8 pa3, bool act) {
    if (SK && !act) return;
#define TRRD(dst, off) asm volatile("ds_read_b64_tr_b16 %0, %1 offset:%2" : "=&v"(dst) : "v"(vb0), "i"(off) : "memory")
#define PV_D0(d0) do { s16x4 l0, l1, l2, l3, h0, h1, h2, h3; constexpr int b_ = VB * SHM_V + v_rd_off(d0, 0, 0);     \
        TRRD(l0, b_); TRRD(h0, b_ + 2048); TRRD(l1, b_ + 4096); TRRD(h1, b_ + 6144); TRRD(l2, b_ + 8192); TRRD(h2, b_ + 10240); TRRD(l3, b_ + 12288); TRRD(h3, b_ + 14336); \
        asm volatile("s_waitcnt lgkmcnt(0)" ::: "memory"); SBAR();                 \
        o[d0] = __builtin_amdgcn_mfma_f32_32x32x16_bf16(pa0, (bf16x8){l0[0], l0[1], l0[2], l0[3], h0[0], h0[1], h0[2], h0[3]}, o[d0], 0, 0, 0);   \
        o[d0] = __builtin_amdgcn_mfma_f32_32x32x16_bf16(pa1, (bf16x8){l1[0], l1[1], l1[2], l1[3], h1[0], h1[1], h1[2], h1[3]}, o[d0], 0, 0, 0);   \
        o[d0] = __builtin_amdgcn_mfma_f32_32x32x16_bf16(pa2, (bf16x8){l2[0], l2[1], l2[2], l2[3], h2[0], h2[1], h2[2], h2[3]}, o[d0], 0, 0, 0);   \
        o[d0] = __builtin_amdgcn_mfma_f32_32x32x16_bf16(pa3, (bf16x8){l3[0], l3[1], l3[2], l3[3], h3[0], h3[1], h3[2], h3[3]}, o[d0], 0, 0, 0); } while (0)
    PV_D0(0); PV_D0(1); PV_D0(2); PV_D0(3);
#undef PV_D0
#undef TRRD
}


template <class TIn, class TOut> struct BlockRef { const TIn* Q; const TIn* K; const TIn* V; TOut* O; int P0; int jlo; };
#define ROW(p, k0, rr) ((p) + (size_t)((k0) + (rr)) * LD + sc)
#define VMW() asm volatile("s_waitcnt vmcnt(0)" ::: "memory")
#define SLOAD_H(Kp, Vp, k0) do { st_v0 = load8<TIn>(ROW(Vp, k0, sr)); st_v1 = load8<TIn>(ROW(Vp, k0, 32 + sr));              \
                         st_k0 = load8<TIn>(ROW(Kp, k0, sr)); st_k1 = load8<TIn>(ROW(Kp, k0, 32 + sr)); } while (0)
#define SWRITE_H(bf) do { *(bf16x8*)(V_lds + (bf) * SHM_V + vst0) = st_v0; *(bf16x8*)(V_lds + (bf) * SHM_V + vst1) = st_v1;   \
                          *(bf16x8*)(K_lds + (bf) * SHM_K + kws) = st_k0; *(bf16x8*)(K_lds + (bf) * SHM_K + kws + 32 * 256) = st_k1; } while (0)
template <class TIn, class TOut>
__device__ __forceinline__ void attn_unit(const BlockRef<TIn, TOut>& cur, int skv, char* lds) {
    const int tid = threadIdx.x, wid = __builtin_amdgcn_readfirstlane(tid >> 6), lane = tid & 63, r32 = lane & 31, hi = lane >> 5;
    const unsigned W = 0x40000000u;
    const int j_lo = cur.jlo;
    int j_hi = (cur.P0 + QB - 1) / KVBLK + 1; if (j_hi > skv / KVBLK) j_hi = skv / KVBLK;
    const int NT = j_hi - j_lo;
    const int qlo = cur.P0 + wid * QBLK, qm = qlo + r32 - 4 * hi;
    char* V_lds = lds; char* K_lds = lds + 2 * SHM_V;
    float* ws = (float*)(lds + 2 * SHM_V + 2 * SHM_K) + wid * 64; float* li_l = ws, * al_l = ws + 32;
    const float* bias_l = (const float*)(lds + LDS_BYTES) + 4 * hi;
    float m_reg = -1e30f, l_reg = 0; f32x16 o[4] = {};
    const int sr = tid >> 4, sc = (tid & 15) * 8, vst0 = v_st(sr, sc), vst1 = v_st(32 + sr, sc), kws = KSWZ(sr, sc * 2);
    const int vb0 = (int)(uintptr_t)V_lds + v_rd_base(lane);
    const TIn* Kh = cur.K; const TIn* Vh = cur.V;
    bf16x8 st_v0, st_v1, st_k0, st_k1; bf16x8 qr[8];
#define KBASE(t) ((j_lo + (t)) * KVBLK)
#define BT(t) (bias_l + (t) * KVBLK)
#define RESC(a) do { if (__any((a) < 1.f)) { if (hi == 0) al_l[r32] = (a); asm volatile("s_waitcnt lgkmcnt(0)" ::: "memory");              \
                     for (int d_ = 0; d_ < 4; ++d_) for (int r = 0; r < 16; ++r) o[d_][r] *= al_l[crow(r, hi)]; } } while (0)
#define MASKT(P0_, P1_, t) do { const int kb_ = KBASE(t); if (kb_ + KVBLK - 1 > qlo) mask_tile(P0_, P1_, qm - kb_, W); } while (0)
#pragma unroll
    for (int d0 = 0; d0 < 8; ++d0) qr[d0] = load8<TIn>(cur.Q + (size_t)(wid * QBLK + r32) * LD + d0 * 16 + hi * 8);
    SLOAD_H(Kh, Vh, KBASE(0)); VMW(); SWRITE_H(0); SBAR();
    if (NT > 1) SLOAD_H(Kh, Vh, KBASE(1));
    __syncthreads();
    f32x16 p0, p1; float mn, al; bf16x8 pa0, pa1, pa2, pa3;
#define TILE_STEP(t, BUF) do {                                                                                                 \
        SBAR(); qkt<BUF, false>(p0, p1, K_lds, r32, hi, qr, true, BT(t));                                                       \
        MASKT(p0, p1, (t)); partialSM(p0, p1, m_reg, mn, al); RESC(al);                                                          \
        finishSM(p0, p1, al, l_reg, pa0, pa1, pa2, pa3); SBAR();                                                                 \
        pv_tile<BUF, false>(o, vb0, pa0, pa1, pa2, pa3, true);                                                                    \
        if ((t) + 1 < NT) { VMW(); SWRITE_H(1 - (BUF)); SBAR(); if ((t) + 2 < NT) SLOAD_H(Kh, Vh, KBASE((t) + 2)); }              \
        __syncthreads(); } while (0)
    for (int t = 0; t < NT; t += 2) {
        TILE_STEP(t, 0);
        if (t + 1 < NT) TILE_STEP(t + 1, 1);
    }
    if (hi == 0) li_l[r32] = l_reg; asm volatile("s_waitcnt lgkmcnt(0)" ::: "memory");
    float rli[16];
#pragma unroll
    for (int r = 0; r < 16; ++r) rli[r] = __builtin_amdgcn_rcpf(li_l[crow(r, hi)]);
    TOut* Ow = cur.O + (size_t)(wid * QBLK) * LD;
#pragma unroll
    for (int r = 0; r < 16; ++r) { const int orow = crow(r, hi);
#pragma unroll
        for (int d0 = 0; d0 < 4; ++d0) { const float v = o[d0][r] * rli[r];
            const float vn = __shfl_xor(v, 1);
            if ((r32 & 1) == 0) *(unsigned*)(Ow + (size_t)orow * LD + d0 * 32 + r32) = cvtpk(v, vn); } }
    __syncthreads();
#undef TILE_STEP
#undef RESC
#undef KBASE
#undef BT
#undef MASKT
}
#undef ROW
#undef VMW
#undef SLOAD_H
#undef SWRITE_H
}
#define GAS __attribute__((address_space(1)))
#define LAS __attribute__((address_space(3)))
typedef unsigned short bf16;
typedef unsigned v4u __attribute__((ext_vector_type(4)));
typedef unsigned v2u __attribute__((ext_vector_type(2)));
typedef float f32x4 __attribute__((ext_vector_type(4)));
typedef float f32x2 __attribute__((ext_vector_type(2)));
typedef short bf16x8 __attribute__((ext_vector_type(8)));
typedef GAS unsigned gu32;
#define RLX_AGENT __ATOMIC_RELAXED, __HIP_MEMORY_SCOPE_AGENT

constexpr int S = 8192, DM = 4096, NH = 16, HD = 128, AW = 2048, LW = 2048, NG = 16, GD = 128;
constexpr int NIN = 18448, NINP = 18432;
constexpr int C_Q = 0, C_K = 2048, C_V = 4096, C_F = 6144, C_LX = 6160, C_LY = 8208, C_GA = 10256, C_GL = 14352;
constexpr int PEER_H = 8, PEER_NK = 128, PEER_K = 16, PEER_NE = 16384;
constexpr float EPS = 1e-6f;
constexpr size_t MiB = 1u << 20;
constexpr size_t WS_CTL = 0, CTL_ZERO_BYTES = 32768;
constexpr size_t WS_MOD = 512 * 1024;
constexpr size_t WS_WF = 2 * MiB;
constexpr size_t WS_LOGF = 3 * MiB;
constexpr size_t WS_FC = 4 * MiB;
constexpr size_t WS_AGGA = 5 * MiB, WS_AGGB = 6 * MiB;
constexpr size_t WS_BIASR = 7 * MiB, WS_SB = 7 * MiB + 262144;
constexpr size_t WS_SSQ = 28 * MiB;
constexpr size_t WS_WAT = 8 * MiB, WS_WXT = 9 * MiB;
constexpr size_t WS_SK = 10 * MiB, WS_RS = 11 * MiB, WS_RSU = 11 * MiB + 65536;
constexpr size_t WS_IDX = 12 * MiB, WS_GATE = 16 * MiB, WS_IDX2 = 20 * MiB, WS_GATE2 = 24 * MiB;
constexpr size_t WS_WIN = 32 * MiB, WS_WAO = 176 * MiB, WS_WLO = 192 * MiB, WS_WOUT = 208 * MiB, WS_WPQ = 240 * MiB;
constexpr size_t WS_U = 256 * MiB, WS_V = 384 * MiB;
constexpr size_t WS_HA = 512 * MiB;
constexpr size_t WS_QKV = 576 * MiB;
constexpr size_t WS_LX = 672 * MiB, WS_GY = 704 * MiB, WS_GA = 736 * MiB, WS_GL = 800 * MiB;
constexpr size_t WS_ATT = 864 * MiB, WS_LR = 896 * MiB, WS_T1 = 928 * MiB, WS_MG = 992 * MiB, WS_Q2 = 1056 * MiB, WS_X1 = 1088 * MiB, WS_END = 1216 * MiB;
constexpr int CW_BAR = 4096;
constexpr int CW_QATT = 256;
constexpr int RING_BYTES = 131072;
constexpr int LDSCTL_OFF = 150528, MISC_OFF = LDSCTL_OFF + 320;
constexpr int LDS_BYTES = 151552;
constexpr int NWAVES = 8, NTHREADS = 512;

__device__ __forceinline__ unsigned f2bf(float f) { unsigned u = __builtin_bit_cast(unsigned, f); return (u + 0x7fffu + ((u >> 16) & 1u)) >> 16; }
__device__ __forceinline__ unsigned pk2(float lo, float hi) { return f2bf(lo) | (f2bf(hi) << 16); }
__device__ __forceinline__ float bflo(unsigned w) { return __uint_as_float(w << 16); }
__device__ __forceinline__ float bfhi(unsigned w) { return __uint_as_float(w & 0xffff0000u); }
__device__ __forceinline__ float bf2f(bf16 b) { return __uint_as_float((unsigned)b << 16); }
__device__ __forceinline__ float wave_sum(float v) {
#pragma unroll
    for (int o = 1; o < 64; o <<= 1) v += __shfl_xor(v, o);
    return v;
}
__device__ __forceinline__ float wave_max(float v) {
#pragma unroll
    for (int o = 1; o < 64; o <<= 1) v = fmaxf(v, __shfl_xor(v, o));
    return v;
}
__device__ __forceinline__ float sigmoidf_(float v) { return __builtin_amdgcn_rcpf(1.0f + __builtin_amdgcn_exp2f(-1.4426950408889634f * v)); }
__device__ __forceinline__ float gelu_erf(float v) { return 0.5f * v * (1.0f + erff(v * 0.70710678118654752f)); }
#define XB_TMO      128
#define XB_XCNT(j)  (256  + 64 * (j))
#define XB_XSUB(j)  (1280 + 64 * (j))
#define XB_XGEN(j)  (2304 + 64 * (j))
#define XB_TOP      3328
#define XB_TOPGEN   3392
#define XCD_BAR_WORDS 3456
#define XB_SPIN_CAP (1u << 18)

__device__ __forceinline__ unsigned xb_ld(unsigned* p)              { return __hip_atomic_load(p, __ATOMIC_RELAXED, __HIP_MEMORY_SCOPE_AGENT); }
__device__ __forceinline__ unsigned xb_add(unsigned* p, unsigned v) { return __hip_atomic_fetch_add(p, v, __ATOMIC_RELAXED, __HIP_MEMORY_SCOPE_AGENT); }
__device__ __forceinline__ unsigned xb_xcc_id() { return (unsigned)__builtin_amdgcn_s_getreg((3 << 11) | 20) & 0xFu; }
#define XB_SPIN(cond, bar) do { unsigned _sp = 0; while (cond) { __builtin_amdgcn_s_sleep(1); \
    if ((++_sp & 255u) == 0u) { if (xb_ld(&(bar)[XB_TMO])) break; if (_sp > XB_SPIN_CAP) { atomicAdd(&(bar)[XB_TMO], 1u); break; } } } } while (0)

struct XcdBarrier {
    unsigned* bar; unsigned x;
    volatile LAS unsigned* st;
};

__device__ __forceinline__ XcdBarrier xcd_barrier_post(unsigned* bar, volatile LAS unsigned* st) {
    XcdBarrier b; b.bar = bar; b.x = xb_xcc_id(); b.st = st;
    if (threadIdx.x == 0) (void)xb_add(&bar[XB_XCNT(b.x)], 1u);
    return b;
}
__device__ __forceinline__ void xcd_barrier_complete(unsigned* bar, unsigned x, unsigned& nloc, unsigned& nx) {
    const unsigned G = gridDim.x * gridDim.y * gridDim.z;
    unsigned sum, cnt, mine, sp = 0u;
    for (;;) {
        sum = 0u; cnt = 0u; mine = 0u;
#pragma unroll
        for (unsigned j = 0; j < 16; ++j) { const unsigned c = xb_ld(&bar[XB_XCNT(j)]); sum += c; cnt += (c > 0u) ? 1u : 0u; mine = (j == x) ? c : mine; }
        if (sum == G) break;
        __builtin_amdgcn_s_sleep(1);
        if ((++sp & 255u) == 0u) { if (xb_ld(&bar[XB_TMO])) break; if (sp > XB_SPIN_CAP) { atomicAdd(&bar[XB_TMO], 1u); break; } }
    }
    nloc = mine > 0u ? mine : 1u; nx = cnt > 0u ? cnt : 1u;
}

__device__ __forceinline__ void xcd_barrier(const XcdBarrier& b) {
    asm volatile("s_waitcnt vmcnt(0)" ::: "memory");
    __syncthreads();
    if (threadIdx.x == 0) {
        unsigned* bar = b.bar;
        __builtin_amdgcn_s_waitcnt(0);
        unsigned nloc = b.st[0], nx = b.st[1];
        if (nloc == 0u) { xcd_barrier_complete(bar, b.x, nloc, nx); b.st[0] = nloc; b.st[1] = nx; }
        const unsigned old = xb_add(&bar[XB_XSUB(b.x)], 1u);
        const unsigned gen = old / nloc;
        if (old + 1u == (gen + 1u) * nloc) {
            __builtin_amdgcn_fence(__ATOMIC_RELEASE, "agent");
            asm volatile("s_waitcnt vmcnt(0)" ::: "memory");
            const unsigned og = xb_add(&bar[XB_TOP], 1u);
            const unsigned tg = og / nx;
            if (og + 1u == (tg + 1u) * nx) xb_add(&bar[XB_TOPGEN], 1u);
            else XB_SPIN(xb_ld(&bar[XB_TOPGEN]) == tg, bar);
            __builtin_amdgcn_fence(__ATOMIC_ACQUIRE, "agent");
            xb_add(&bar[XB_XGEN(b.x)], 1u);
            asm volatile("s_waitcnt vmcnt(0)" ::: "memory");
        } else {
            XB_SPIN(xb_ld(&bar[XB_XGEN(b.x)]) == gen, bar);
            __builtin_amdgcn_fence(__ATOMIC_ACQUIRE, "agent");
            asm volatile("s_waitcnt vmcnt(0)" ::: "memory");
        }
    }
    __syncthreads();
}
struct Args { const float* in[24]; float* out; unsigned char* ws; int ph_lo, ph_hi, rep_att, rep_lru; };
struct Frame {
    LAS unsigned char* lds; volatile LAS unsigned* MISC; gu32* ctl;
    int tid, lane, wave, vcu, G;
    unsigned char* ws; float* out;
};
#define WSP(T, off) ((T*)(F.ws + (off)))
#define LDS_WAIT() asm volatile("s_waitcnt lgkmcnt(0)" ::: "memory")

struct TrItem { const float* W; bf16* WT; int ldw, K, k0, nsrc0, ndst0; };
__device__ __forceinline__ void tr_load(const TrItem& I, float (&v)[32], int lane) {
    const float* wp = I.W + (size_t)(I.k0 + (lane >> 5)) * I.ldw + I.nsrc0 + (lane & 31);
#pragma unroll
    for (int i = 0; i < 32; ++i) v[i] = wp[(size_t)(2 * i) * I.ldw];
}
__device__ __forceinline__ void tr_store(const TrItem& I, const float (&v)[32], LAS float* scr, int lane) {
#pragma unroll
    for (int i = 0; i < 32; ++i) scr[(2 * i + (lane >> 5)) * 33 + (lane & 31)] = v[i];
    LDS_WAIT(); asm volatile("" ::: "memory");
    const int c = lane & 7;
#pragma unroll
    for (int j = 0; j < 4; ++j) { const int n = (lane >> 3) + 8 * j; const LAS float* s = scr + (8 * c) * 33 + n;
        v4u o; o.x = pk2(s[0 * 33], s[1 * 33]); o.y = pk2(s[2 * 33], s[3 * 33]); o.z = pk2(s[4 * 33], s[5 * 33]); o.w = pk2(s[6 * 33], s[7 * 33]);
        *(GAS v4u*)(I.WT + (size_t)(I.ndst0 + n) * I.K + I.k0 + 8 * c) = o; }
    LDS_WAIT(); asm volatile("" ::: "memory");
}
__device__ __forceinline__ void cvt_stream(const float* src, bf16* dst, size_t n8, size_t i0, size_t stride) {
    for (size_t i = i0; i < n8; i += stride) { const f32x4 a = ((const GAS f32x4*)src)[2 * i], b = ((const GAS f32x4*)src)[2 * i + 1];
        v4u o; o.x = pk2(a[0], a[1]); o.y = pk2(a[2], a[3]); o.z = pk2(b[0], b[1]); o.w = pk2(b[2], b[3]); ((GAS v4u*)dst)[i] = o; }
}
__device__ __forceinline__ void cvt_stream_fp8(const float* src, unsigned char* dst, size_t n16, float scale, size_t i0, size_t stride) {
    for (size_t i = i0; i < n16; i += stride) { v4u o;
#pragma unroll
        for (int q = 0; q < 4; ++q) { const f32x4 a = ((const GAS f32x4*)src)[4 * i + q] * scale; int w = 0;
            w = __builtin_amdgcn_cvt_pk_fp8_f32(a[0], a[1], w, false); w = __builtin_amdgcn_cvt_pk_fp8_f32(a[2], a[3], w, true); o[q] = (unsigned)w; }
        ((GAS v4u*)dst)[i] = o; }
}
#ifndef SKEW_TR
#define SKEW_TR 1
#endif
#ifndef SKEW_TABLES
#define SKEW_TABLES 1
#endif
__device__ __forceinline__ void cvt_row_fp4(const f32x4 (&a)[16], float am, unsigned char* dstT, float* rsT, int row, int lane) {
    am = wave_max(am); const float inv = am > 0.f ? 6.0f / am : 0.f;
#pragma unroll
    for (int c = 0; c < 4; ++c) { v2u o;
#pragma unroll
        for (int d = 0; d < 2; ++d) { unsigned w = 0u; const f32x4 x0 = a[4 * c + 2 * d] * inv, x1 = a[4 * c + 2 * d + 1] * inv;
            w = __builtin_amdgcn_cvt_scalef32_pk_fp4_f32(w, x0[0], x0[1], 1.0f, 0); w = __builtin_amdgcn_cvt_scalef32_pk_fp4_f32(w, x0[2], x0[3], 1.0f, 1);
            w = __builtin_amdgcn_cvt_scalef32_pk_fp4_f32(w, x1[0], x1[1], 1.0f, 2); w = __builtin_amdgcn_cvt_scalef32_pk_fp4_f32(w, x1[2], x1[3], 1.0f, 3); o[d] = w; }
        *((GAS v2u*)(dstT + (size_t)row * 2048 + c * 512) + lane) = o; }
    if (lane == 0) rsT[row] = am * (1.0f / 6.0f);
}
__device__ __forceinline__ void cvt_table_fp4(Frame& F, const float* srcT, unsigned char* dstT, float* rsT, int gw, int NGW) {
#pragma unroll 1
    for (int row = gw; row < PEER_NE; row += 2 * NGW) { const int row2 = row + NGW; const bool two = row2 < PEER_NE;
        const GAS f32x4* src = (const GAS f32x4*)(srcT + (size_t)row * DM); const GAS f32x4* src2 = (const GAS f32x4*)(srcT + (size_t)(two ? row2 : row) * DM); f32x4 a[16], b[16]; float am = 0.f, bm = 0.f;
#pragma unroll
        for (int c = 0; c < 4; ++c)
#pragma unroll
            for (int q = 0; q < 4; ++q) a[4 * c + q] = src[c * 256 + 4 * F.lane + q];
#pragma unroll
        for (int c = 0; c < 4; ++c)
#pragma unroll
            for (int q = 0; q < 4; ++q) b[4 * c + q] = src2[c * 256 + 4 * F.lane + q];
#pragma unroll
        for (int k = 0; k < 16; ++k) am = fmaxf(fmaxf(am, fmaxf(fabsf(a[k][0]), fabsf(a[k][1]))), fmaxf(fabsf(a[k][2]), fabsf(a[k][3])));
        cvt_row_fp4(a, am, dstT, rsT, row, F.lane);
#pragma unroll
        for (int k = 0; k < 16; ++k) bm = fmaxf(fmaxf(bm, fmaxf(fabsf(b[k][0]), fabsf(b[k][1]))), fmaxf(fabsf(b[k][2]), fabsf(b[k][3])));
        if (two) cvt_row_fp4(b, bm, dstT, rsT, row2, F.lane);
    }
}
constexpr int I_IN = 64 * 576, I_AO = 32 * 128, I_LO = 32 * 128, I_OUT = 64 * 128, I_PQ = 64 * 64, I_WA = 16 * 2 * 4, I_WX = I_WA;
constexpr int NITEMS = I_IN + I_AO + I_LO + I_OUT + I_PQ + I_WA + I_WX;
constexpr int TR_LATE_LO = I_IN, TR_LATE_HI = I_IN + I_AO + I_LO + I_OUT;
__device__ __forceinline__ TrItem tr_decode(const Args& args, unsigned char* ws_, int r) { TrItem I;
#define WSQ(T, off) ((T*)(ws_ + (off)))
    if (r < I_IN) { const int kb = r / 576, nb = r % 576; I = TrItem{args.in[6], WSQ(bf16, WS_WIN), NIN, DM, 64 * kb, 32 * nb + (nb >= 192 ? 16 : 0), 32 * nb}; return I; } r -= I_IN;
    if (r < I_AO) { const int kb = r / 128, nb = r % 128; I = TrItem{args.in[17], WSQ(bf16, WS_WAO), DM, AW, 64 * kb, 32 * nb, 32 * nb}; return I; } r -= I_AO;
    if (r < I_LO) { const int kb = r / 128, nb = r % 128; I = TrItem{args.in[18], WSQ(bf16, WS_WLO), DM, LW, 64 * kb, 32 * nb, 32 * nb}; return I; } r -= I_LO;
    if (r < I_OUT) { const int kb = r / 128, nb = r % 128; I = TrItem{args.in[19], WSQ(bf16, WS_WOUT), DM, DM, 64 * kb, 32 * nb, 32 * nb}; return I; } r -= I_OUT;
    if (r < I_PQ) { const int kb = r / 64, nb = r % 64; I = TrItem{args.in[20], WSQ(bf16, WS_WPQ), 2048, DM, 64 * kb, 32 * nb, 32 * nb}; return I; } r -= I_PQ;
    { const bool isx = r >= I_WA; if (isx) r -= I_WA; const int g = r >> 3, kb = (r >> 2) & 1, nb = r & 3;
      I = TrItem{(isx ? args.in[14] : args.in[12]) + (size_t)g * GD * GD, WSQ(bf16, isx ? WS_WXT : WS_WAT) + (size_t)g * GD * GD, GD, GD, 64 * kb, 32 * nb, 32 * nb}; return I; }
#undef WSQ
}
__device__ __forceinline__ void tr_run(Frame& F, const Args& args, int lo, int hi) {
    LAS float* scr = (LAS float*)(F.lds + F.wave * 16384);
    const int gw = F.vcu * NWAVES + F.wave, NGW = F.G * NWAVES;
    if (lo + gw < hi) {
        float va[32], vb[32], vc[32]; TrItem Ia = tr_decode(args, F.ws, lo + gw), Ib = Ia; tr_load(Ia, va, F.lane);
        if (lo + gw + NGW < hi) { Ib = tr_decode(args, F.ws, lo + gw + NGW); tr_load(Ib, vb, F.lane); }
#pragma unroll 1
        for (int it = lo + gw; it < hi; it += NGW) {
            const int nx = it + 2 * NGW; TrItem Ic = Ib;
            if (nx < hi) { Ic = tr_decode(args, F.ws, nx); tr_load(Ic, vc, F.lane); }
            tr_store(Ia, va, scr, F.lane);
#pragma unroll
            for (int i = 0; i < 32; ++i) { va[i] = vb[i]; vb[i] = vc[i]; }
            Ia = Ib; Ib = Ic;
        }
    }
}
__device__ __forceinline__ void p0_prologue(Frame& F, const Args& args) {
#ifndef P0_REP
#define P0_REP 0
#endif
    _Pragma("unroll") for (int rep_ = 0; rep_ < ((P0_REP & 1) ? 2 : 1); ++rep_)
    { LAS float* sc = (LAS float*)F.lds; LAS f32x4* red = (LAS f32x4*)(F.lds + 16384); float* MOD = WSP(float, WS_MOD);
      for (int cgi = blockIdx.x; cgi < 256; cgi += F.G) {
          for (int i = F.tid; i < DM; i += NTHREADS) { const float cv = args.in[1][i]; sc[i] = cv / (1.0f + __expf(-cv)); }
          __syncthreads();
          if (F.tid < 384) { const int cg = F.tid % 24, rg = F.tid / 24;
              const GAS f32x4* Wp = (const GAS f32x4*)args.in[2] + cgi * 24 + cg;
              f32x4 acc = {0.f, 0.f, 0.f, 0.f};
#pragma unroll 8
              for (int r = rg; r < DM; r += 16) acc += sc[r] * Wp[(size_t)r * 6144];
              red[rg * 24 + cg] = acc; }
          __syncthreads();
          if (F.tid < 24) { f32x4 s = red[F.tid];
#pragma unroll
              for (int rg = 1; rg < 16; ++rg) s += red[rg * 24 + F.tid];
              s += ((const GAS f32x4*)args.in[3])[cgi * 24 + F.tid]; ((GAS f32x4*)MOD)[cgi * 24 + F.tid] = s; }
          __syncthreads();
      } }
    const int gw = F.vcu * NWAVES + F.wave, NGW = F.G * NWAVES; (void)gw; (void)NGW;
    _Pragma("unroll") for (int rep_ = 0; rep_ < ((P0_REP & 2) ? 2 : 1); ++rep_) {
#if SKEW_TABLES && SKEW_TR
        tr_run(F, args, 0, TR_LATE_LO); tr_run(F, args, TR_LATE_HI, NITEMS);
#else
        tr_run(F, args, 0, NITEMS);
#endif
    }
    const size_t gt = (size_t)F.vcu * NTHREADS + F.tid, NGT = (size_t)F.G * NTHREADS;
#if !SKEW_TABLES
    _Pragma("unroll") for (int rep_ = 0; rep_ < ((P0_REP & 4) ? 2 : 1); ++rep_) {
    cvt_table_fp4(F, args.in[23], WSP(unsigned char, WS_V), WSP(float, WS_RS), gw, NGW);
    cvt_table_fp4(F, args.in[22], WSP(unsigned char, WS_U), WSP(float, WS_RSU), gw, NGW); }
#endif
    cvt_stream(args.in[21], WSP(bf16, WS_SK), (size_t)PEER_H * 2 * 128 * 128 / 8, gt, NGT);
    for (size_t i = gt; i < (size_t)DM * 16; i += NGT) WSP(float, WS_WF)[(i & 15) * DM + (i >> 4)] = args.in[6][(i >> 4) * NIN + C_F + (i & 15)];
    for (size_t i = gt; i < (size_t)NINP; i += NGT) WSP(float, WS_BIASR)[i] = args.in[7][i + (i >= (size_t)C_F ? 16 : 0)];
}

__device__ __forceinline__ void p1_norm_forget(Frame& F, const Args& args) {
    const float* MOD = WSP(float, WS_MOD); const float* WFT = WSP(float, WS_WF); bf16* HA = WSP(bf16, WS_HA);
    LAS f32x4* MUL4 = (LAS f32x4*)F.lds; LAS f32x4* SH4 = (LAS f32x4*)(F.lds + 16384); LAS float* RS = (LAS float*)(F.lds + 32768); LAS float* PART = (LAS float*)(F.lds + 33280);
    for (int i4 = F.tid; i4 < DM / 4; i4 += NTHREADS) { MUL4[i4] = ((const GAS f32x4*)args.in[4])[i4] * (((const GAS f32x4*)(MOD + 4096))[i4] + 1.0f); SH4[i4] = ((const GAS f32x4*)MOD)[i4]; }
    __syncthreads();
    const int fr = F.lane & 15, fq = F.lane >> 4;
    const unsigned lo16 = (unsigned)F.lane * 16u, lof = (unsigned)(fr * DM + fq * 8) * 4u, loh = (unsigned)(fr * DM + fq * 8) * 2u;
#pragma unroll 1
    for (int step = blockIdx.x; step < S / 32; step += F.G) {
        const int r0 = step * 32;
        { const char* xb0 = (const char*)(args.in[0] + (size_t)(r0 + F.wave * 4) * DM);
#pragma unroll 1
          for (int rp = 0; rp < 2; ++rp) { f32x4 xa[2][16];
#pragma unroll
            for (int q = 0; q < 2; ++q)
#pragma unroll
                for (int j = 0; j < 16; ++j) xa[q][j] = *(const GAS f32x4*)(xb0 + (size_t)(2 * rp + q) * (DM * 4) + 1024 * j + lo16);
#pragma unroll
            for (int q = 0; q < 2; ++q) { float ss = 0.f;
#pragma unroll
                for (int j = 0; j < 16; ++j) ss += (xa[q][j][0] * xa[q][j][0] + xa[q][j][1] * xa[q][j][1]) + (xa[q][j][2] * xa[q][j][2] + xa[q][j][3] * xa[q][j][3]);
                const float rsv = 1.0f / sqrtf(wave_sum(ss) * (1.0f / DM) + EPS); if (F.lane == 0) RS[F.wave * 4 + 2 * rp + q] = rsv; } } }
        __syncthreads();
        const float rs0 = RS[fr], rs1 = RS[16 + fr];
        const char* xk = (const char*)(args.in[0] + (size_t)r0 * DM) + F.wave * 2048; const char* wk = (const char*)WFT + F.wave * 2048; char* hk = (char*)(HA + (size_t)r0 * DM) + F.wave * 1024;
        f32x4 acc0 = (f32x4){0.f, 0.f, 0.f, 0.f}, acc1 = acc0;
        f32x4 nx[4], nw[2];
        nx[0] = *(const GAS f32x4*)(xk + lof); nx[1] = *(const GAS f32x4*)(xk + lof + 16); nx[2] = *(const GAS f32x4*)(xk + 16 * DM * 4 + lof); nx[3] = *(const GAS f32x4*)(xk + 16 * DM * 4 + lof + 16);
        nw[0] = *(const GAS f32x4*)(wk + lof); nw[1] = *(const GAS f32x4*)(wk + lof + 16);
#pragma unroll 1
        for (int ks = 0; ks < 16; ++ks) {
            f32x4 cx[4], cw[2];
#pragma unroll
            for (int q = 0; q < 4; ++q) cx[q] = nx[q];
            cw[0] = nw[0]; cw[1] = nw[1];
            { const int kn = ((ks + 1) & 15) * 128; const char* xn_ = xk + kn; const char* wn_ = wk + kn;
              nx[0] = *(const GAS f32x4*)(xn_ + lof); nx[1] = *(const GAS f32x4*)(xn_ + lof + 16); nx[2] = *(const GAS f32x4*)(xn_ + 16 * DM * 4 + lof); nx[3] = *(const GAS f32x4*)(xn_ + 16 * DM * 4 + lof + 16);
              nw[0] = *(const GAS f32x4*)(wn_ + lof); nw[1] = *(const GAS f32x4*)(wn_ + lof + 16); }
            const int c4 = F.wave * 128 + ks * 8 + fq * 2;
            const f32x4 m0 = MUL4[c4], m1 = MUL4[c4 + 1], s0 = SH4[c4], s1 = SH4[c4 + 1];
            const f32x4 ha0 = cx[0] * rs0 * m0 + s0, ha1 = cx[1] * rs0 * m1 + s1, hb0 = cx[2] * rs1 * m0 + s0, hb1 = cx[3] * rs1 * m1 + s1;
            v4u ahi, alo, bhi, blo, whi, wlo;
#define P1_SPLIT(hi_, lo_, v0_, v1_) do { hi_.x = pg8::cvt_pk_bf16(v0_[0], v0_[1]); hi_.y = pg8::cvt_pk_bf16(v0_[2], v0_[3]); hi_.z = pg8::cvt_pk_bf16(v1_[0], v1_[1]); hi_.w = pg8::cvt_pk_bf16(v1_[2], v1_[3]); \
            lo_.x = pg8::cvt_pk_bf16(v0_[0] - bflo(hi_.x), v0_[1] - bfhi(hi_.x)); lo_.y = pg8::cvt_pk_bf16(v0_[2] - bflo(hi_.y), v0_[3] - bfhi(hi_.y)); \
            lo_.z = pg8::cvt_pk_bf16(v1_[0] - bflo(hi_.z), v1_[1] - bfhi(hi_.z)); lo_.w = pg8::cvt_pk_bf16(v1_[2] - bflo(hi_.w), v1_[3] - bfhi(hi_.w)); } while (0)
            P1_SPLIT(ahi, alo, ha0, ha1); P1_SPLIT(bhi, blo, hb0, hb1); P1_SPLIT(whi, wlo, cw[0], cw[1]);
#undef P1_SPLIT
            *(GAS v4u*)(hk + ks * 64 + loh) = ahi; *(GAS v4u*)(hk + 16 * DM * 2 + ks * 64 + loh) = bhi;
            const bf16x8 Ah = __builtin_bit_cast(bf16x8, ahi), Al = __builtin_bit_cast(bf16x8, alo), Bh = __builtin_bit_cast(bf16x8, bhi), Bl = __builtin_bit_cast(bf16x8, blo), Wh = __builtin_bit_cast(bf16x8, whi), Wl = __builtin_bit_cast(bf16x8, wlo);
            acc0 = __builtin_amdgcn_mfma_f32_16x16x32_bf16(Ah, Wh, acc0, 0, 0, 0); acc1 = __builtin_amdgcn_mfma_f32_16x16x32_bf16(Bh, Wh, acc1, 0, 0, 0);
            acc0 = __builtin_amdgcn_mfma_f32_16x16x32_bf16(Ah, Wl, acc0, 0, 0, 0); acc1 = __builtin_amdgcn_mfma_f32_16x16x32_bf16(Bh, Wl, acc1, 0, 0, 0);
            acc0 = __builtin_amdgcn_mfma_f32_16x16x32_bf16(Al, Wh, acc0, 0, 0, 0); acc1 = __builtin_amdgcn_mfma_f32_16x16x32_bf16(Bl, Wh, acc1, 0, 0, 0);
        }
#pragma unroll
        for (int r = 0; r < 4; ++r) { PART[(F.wave * 32 + 4 * fq + r) * 16 + fr] = acc0[r]; PART[(F.wave * 32 + 16 + 4 * fq + r) * 16 + fr] = acc1[r]; }
        __syncthreads();
        { const int head = F.tid >> 5, row = F.tid & 31; float s = 0.f;
#pragma unroll
          for (int w = 0; w < 8; ++w) s += PART[(w * 32 + row) * 16 + head];
          const float f = s + args.in[7][C_F + head]; WSP(float, WS_LOGF)[(size_t)head * S + r0 + row] = fminf(f, 0.f) - log1pf(__expf(-fabsf(f))); }
        __syncthreads();
    }
}
__device__ __forceinline__ void p1_shift_proj(Frame& F, const Args& args) {
    const int gw = F.vcu * NWAVES + F.wave, NGW = F.G * NWAVES; const float* sh2 = WSP(float, WS_MOD) + 12288; const bf16* WT = WSP(bf16, WS_WPQ);
    for (int col = gw; col < 2048; col += NGW) { float s = 0.f;
#pragma unroll
        for (int c = 0; c < 8; ++c) { const v4u w = *((const GAS v4u*)(WT + (size_t)col * DM + c * 512) + F.lane); const GAS f32x4* sp = (const GAS f32x4*)(sh2 + c * 512 + F.lane * 8); const f32x4 a = sp[0], b = sp[1];
            s += (bflo(w.x) * a[0] + bfhi(w.x) * a[1]) + (bflo(w.y) * a[2] + bfhi(w.y) * a[3]) + (bflo(w.z) * b[0] + bfhi(w.z) * b[1]) + (bflo(w.w) * b[2] + bfhi(w.w) * b[3]); }
        s = wave_sum(s); if (F.lane == 0) WSP(float, WS_SB)[col] = s; }
}

#ifndef QKN_PIECES
#define QKN_PIECES 4
#endif
__device__ __forceinline__ void p3_qknorm(Frame& F, const Args& args) {
    const int gw = F.vcu * NWAVES + F.wave, NGW = F.G * NWAVES; bf16* QK = WSP(bf16, WS_QKV);
    const int sub = F.lane & 15;
    f32x4 gq0 = ((const GAS f32x4*)args.in[8])[2 * sub], gq1 = ((const GAS f32x4*)args.in[8])[2 * sub + 1], gk0 = ((const GAS f32x4*)args.in[9])[2 * sub], gk1 = ((const GAS f32x4*)args.in[9])[2 * sub + 1];
    for (int it0 = gw; it0 < 2 * S * NH / 4; it0 += QKN_PIECES * NGW) {
        v4u w[QKN_PIECES]; GAS v4u* pp[QKN_PIECES];
#pragma unroll
        for (int k = 0; k < QKN_PIECES; ++k) { const int it = it0 + k * NGW; const size_t unit = (size_t)(it < 2 * S * NH / 4 ? it : it0) * 4 + (F.lane >> 4); pp[k] = (GAS v4u*)(QK + unit * 128) + sub; w[k] = *pp[k]; }
#pragma unroll
        for (int k = 0; k < QKN_PIECES; ++k) { const int it = it0 + k * NGW; const size_t unit = (size_t)(it < 2 * S * NH / 4 ? it : it0) * 4 + (F.lane >> 4); const bool isk = unit >= (size_t)S * NH;
            f32x4 a = {bflo(w[k].x), bfhi(w[k].x), bflo(w[k].y), bfhi(w[k].y)}, b = {bflo(w[k].z), bfhi(w[k].z), bflo(w[k].w), bfhi(w[k].w)};
            float ss = (a[0] * a[0] + a[1] * a[1]) + (a[2] * a[2] + a[3] * a[3]) + (b[0] * b[0] + b[1] * b[1]) + (b[2] * b[2] + b[3] * b[3]);
            ss += __shfl_xor(ss, 1); ss += __shfl_xor(ss, 2); ss += __shfl_xor(ss, 4); ss += __shfl_xor(ss, 8);
            const float rs = 1.0f / sqrtf(ss * (1.0f / HD) + EPS);
            a = a * rs * (isk ? gk0 : gq0); b = b * rs * (isk ? gk1 : gq1);
            v4u o; o.x = pk2(a[0], a[1]); o.y = pk2(a[2], a[3]); o.z = pk2(b[0], b[1]); o.w = pk2(b[2], b[3]);
            if (it < 2 * S * NH / 4) *pp[k] = o; }
    }
}
__device__ __forceinline__ void p3_cumsum(Frame& F, const Args& args) {
    LAS float* wt = (LAS float*)F.lds;
    for (int h = blockIdx.x; h < NH; h += F.G) {
        const float* LF = WSP(float, WS_LOGF); float v[16]; float run = 0.f;
        { const GAS f32x4* lp = (const GAS f32x4*)(LF + (size_t)h * S + F.tid * 16); const f32x4 l0 = lp[0], l1 = lp[1], l2 = lp[2], l3 = lp[3];
          const float lv[16] = {l0[0], l0[1], l0[2], l0[3], l1[0], l1[1], l1[2], l1[3], l2[0], l2[1], l2[2], l2[3], l3[0], l3[1], l3[2], l3[3]};
#pragma unroll
          for (int i = 0; i < 16; ++i) { run += lv[i]; v[i] = run; } }
        float sc = run;
#pragma unroll
        for (int o = 1; o < 64; o <<= 1) { const float t = __shfl_up(sc, o); if (F.lane >= o) sc += t; }
        if (F.lane == 63) wt[F.wave] = sc;
        __syncthreads();
        float pre = sc - run;
        for (int w = 0; w < F.wave; ++w) pre += wt[w];
        float* Fo = WSP(float, WS_FC) + (size_t)h * S + F.tid * 16;
#pragma unroll
        for (int i = 0; i < 4; ++i) ((GAS f32x4*)Fo)[i] = (f32x4){v[4 * i] + pre, v[4 * i + 1] + pre, v[4 * i + 2] + pre, v[4 * i + 3] + pre};
        __syncthreads();
    }
}
#ifndef LRU_STORE_AB
#define LRU_STORE_AB 1
#endif
constexpr int LRU_XCF = 0, LRU_XCB = 32768, LRU_AB = 49152, LRU_BB = 81920, LRU_QA = 114688, LRU_CAR = 118784, LRU_XR = 133120;
struct LruConst { float w0, w1, w2, w3, cb, bav, bxv, sp8; };
template <int PASS> __device__ __forceinline__ void lru_chunk(Frame& F, const Args& args, int c, int g, v4u (&raw)[3], const bf16x8 (&ba)[4], const bf16x8 (&bx)[4], bool more, const LruConst& K) {
    LAS float* XCF = (LAS float*)(F.lds + LRU_XCF); LAS unsigned char* XCB = F.lds + LRU_XCB; LAS float* AB = (LAS float*)(F.lds + LRU_AB); LAS float* BB = (LAS float*)(F.lds + LRU_BB);
    LAS float* QA = (LAS float*)(F.lds + LRU_QA); LAS float* CAR = (LAS float*)(F.lds + LRU_CAR); LAS bf16* XR = (LAS bf16*)(F.lds + LRU_XR);
    const int t0 = 64 * c, ch0 = GD * g; const bf16* LX = WSP(bf16, WS_LX);
#pragma unroll
    for (int k = 0; k < 3; ++k) { const int p = F.tid + k * NTHREADS; if (p < 67 * 16) *(LAS v4u*)(XR + (p >> 4) * 128 + (p & 15) * 8) = raw[k]; }
    if (more) {
#pragma unroll
        for (int k = 0; k < 3; ++k) { const int p = F.tid + k * NTHREADS; const int r = p >> 4, cc = p & 15, tg = t0 + 64 - 3 + r; raw[k] = (v4u){0u, 0u, 0u, 0u};
            if (p < 67 * 16 && tg >= 0) raw[k] = *(const GAS v4u*)(LX + (size_t)tg * LW + ch0 + cc * 8); } }
    v4u gyv[2];
    if (PASS == 1) {
#pragma unroll
        for (int k = 0; k < 2; ++k) { const int p = F.tid + k * NTHREADS; gyv[k] = *(const GAS v4u*)(WSP(bf16, WS_GY) + (size_t)(t0 + (p >> 4)) * LW + ch0 + (p & 15) * 8); } }
    __syncthreads();
    { const int ch = F.tid & 127, tq = F.tid >> 7, gch = ch0 + ch;
      const float w0 = K.w0, w1 = K.w1, w2 = K.w2, w3 = K.w3, cb = K.cb; (void)gch;
      float xm3 = bf2f(XR[(16 * tq + 0) * 128 + ch]), xm2 = bf2f(XR[(16 * tq + 1) * 128 + ch]), xm1 = bf2f(XR[(16 * tq + 2) * 128 + ch]);
#pragma unroll
      for (int i = 0; i < 16; ++i) { const int t = 16 * tq + i; const float x0 = bf2f(XR[(t + 3) * 128 + ch]);
          const float xc = w0 * xm3 + w1 * xm2 + w2 * xm1 + w3 * x0 + cb; xm3 = xm2; xm2 = xm1; xm1 = x0;
          XCF[t * 128 + ch] = xc; *(LAS bf16*)(XCB + t * 256 + ((ch * 2) ^ ((t & 7) << 4))) = (bf16)f2bf(xc); } }
    __syncthreads();
    { const int fr = F.lane & 15, fq = F.lane >> 4, j = 16 * F.wave + fr;
      const float bav = K.bav, bxv = K.bxv, sp8 = K.sp8;
#pragma unroll
      for (int mt = 0; mt < 4; ++mt) { f32x4 ar = {0.f, 0.f, 0.f, 0.f}, ax = {0.f, 0.f, 0.f, 0.f}; const int t = 16 * mt + fr;
#pragma unroll
          for (int ks = 0; ks < 4; ++ks) { const bf16x8 af = *(const LAS bf16x8*)(XCB + t * 256 + (((32 * ks + 8 * fq) * 2) ^ ((t & 7) << 4)));
              ar = __builtin_amdgcn_mfma_f32_16x16x32_bf16(af, ba[ks], ar, 0, 0, 0); ax = __builtin_amdgcn_mfma_f32_16x16x32_bf16(af, bx[ks], ax, 0, 0, 0); }
#pragma unroll
          for (int rg = 0; rg < 4; ++rg) { const int tt = 16 * mt + 4 * fq + rg; const float xcv = XCF[tt * 128 + j];
              const float rgt = sigmoidf_(ar[rg] + bav), igt = sigmoidf_(ax[rg] + bxv);
              const float a = __builtin_amdgcn_exp2f(rgt * sp8); const float om = fmaxf((1.0f - a) * (1.0f + a), 0.f);
              const float b = __builtin_amdgcn_sqrtf(om) * (igt * xcv);
              AB[tt * 128 + j] = a; BB[tt * 128 + j] = LRU_STORE_AB ? bflo(pg8::cvt_pk_bf16(b, 0.f)) : b; } } }
    __syncthreads();
    if (LRU_STORE_AB && PASS == 0) {
        float* GA2 = WSP(float, WS_T1); bf16* GB2 = WSP(bf16, WS_MG);
#pragma unroll
        for (int k = 0; k < 4; ++k) { const int p = F.tid + k * NTHREADS, r = p >> 5, c4 = p & 31; *(GAS f32x4*)(GA2 + (size_t)(t0 + r) * LW + ch0 + c4 * 4) = *(const LAS f32x4*)(AB + r * 128 + c4 * 4); }
#pragma unroll
        for (int k = 0; k < 2; ++k) { const int p = F.tid + k * NTHREADS, r = p >> 4, cc = p & 15; const f32x4 b0 = *(const LAS f32x4*)(BB + r * 128 + cc * 8), b1 = *(const LAS f32x4*)(BB + r * 128 + cc * 8 + 4);
            v4u o; o.x = pg8::cvt_pk_bf16(b0[0], b0[1]); o.y = pg8::cvt_pk_bf16(b0[2], b0[3]); o.z = pg8::cvt_pk_bf16(b1[0], b1[1]); o.w = pg8::cvt_pk_bf16(b1[2], b1[3]);
            *(GAS v4u*)(GB2 + (size_t)(t0 + r) * LW + ch0 + cc * 8) = o; }
    }
    const int ch = F.tid & 127, q = F.tid >> 7;
    { float A = 1.f, B = 0.f;
#pragma unroll
      for (int i = 0; i < 16; ++i) { const int t = 16 * q + i; const float a = AB[t * 128 + ch]; B = a * B + BB[t * 128 + ch]; A *= a; }
      QA[(q * 128 + ch) * 2] = A; QA[(q * 128 + ch) * 2 + 1] = B; }
    __syncthreads();
    if (PASS == 0) {
        if (F.tid < 128) { float A = 1.f, B = 0.f;
#pragma unroll
            for (int qq = 0; qq < 4; ++qq) { const float a = QA[(qq * 128 + F.tid) * 2], b = QA[(qq * 128 + F.tid) * 2 + 1]; B = a * B + b; A *= a; }
            WSP(float, WS_AGGA)[(size_t)c * LW + ch0 + F.tid] = A; WSP(float, WS_AGGB)[(size_t)c * LW + ch0 + F.tid] = B; }
    } else {
        float h = CAR[ch];
        for (int qq = 0; qq < q; ++qq) h = QA[(qq * 128 + ch) * 2] * h + QA[(qq * 128 + ch) * 2 + 1];
#pragma unroll
        for (int i = 0; i < 16; ++i) { const int t = 16 * q + i; h = AB[t * 128 + ch] * h + BB[t * 128 + ch]; XCF[t * 128 + ch] = h; }
        __syncthreads();
        if (F.tid < 128) { float hc = CAR[F.tid];
#pragma unroll
            for (int qq = 0; qq < 4; ++qq) hc = QA[(qq * 128 + F.tid) * 2] * hc + QA[(qq * 128 + F.tid) * 2 + 1];
            CAR[F.tid] = hc; }
        bf16* LR = WSP(bf16, WS_LR);
#pragma unroll
        for (int k = 0; k < 2; ++k) { const int p = F.tid + k * NTHREADS; const int r = p >> 4, cc = p & 15; const size_t o = (size_t)(t0 + r) * LW + ch0 + cc * 8;
            const v4u gy = gyv[k]; const f32x4 h0 = *(const LAS f32x4*)(XCF + r * 128 + cc * 8), h1 = *(const LAS f32x4*)(XCF + r * 128 + cc * 8 + 4);
            v4u ov; ov.x = pk2(h0[0] * bflo(gy.x), h0[1] * bfhi(gy.x)); ov.y = pk2(h0[2] * bflo(gy.y), h0[3] * bfhi(gy.y)); ov.z = pk2(h1[0] * bflo(gy.z), h1[1] * bfhi(gy.z)); ov.w = pk2(h1[2] * bflo(gy.w), h1[3] * bfhi(gy.w));
            *(GAS v4u*)(LR + o) = ov; }
    }
    __syncthreads();
}
__device__ __forceinline__ void lru_item1_ab(Frame& F, const Args& args, int w) {
    const int g = w & 15, c0 = (w >> 4) * 8, ch0 = GD * g; LAS float* CAR = (LAS float*)(F.lds + LRU_CAR); LAS float* QA = (LAS float*)(F.lds + LRU_QA);
    LAS float* XCF = (LAS float*)(F.lds + LRU_XCF); LAS float* AB = (LAS float*)(F.lds + LRU_AB); LAS float* BB = (LAS float*)(F.lds + LRU_BB);
    const float* GA2 = WSP(float, WS_T1); const bf16* GB2 = WSP(bf16, WS_MG); const bf16* GY = WSP(bf16, WS_GY); bf16* LR = WSP(bf16, WS_LR);
    f32x4 pa[4]; v4u pb[2], pg[2];
#define LRU1_LOAD(c_) do { const int t0_ = 64 * (c_); \
        _Pragma("unroll") for (int k = 0; k < 4; ++k) { const int p = F.tid + k * NTHREADS, r = p >> 5, c4 = p & 31; pa[k] = *(const GAS f32x4*)(GA2 + (size_t)(t0_ + r) * LW + ch0 + c4 * 4); } \
        _Pragma("unroll") for (int k = 0; k < 2; ++k) { const int p = F.tid + k * NTHREADS, r = p >> 4, cc = p & 15; const size_t o = (size_t)(t0_ + r) * LW + ch0 + cc * 8; pb[k] = *(const GAS v4u*)(GB2 + o); pg[k] = *(const GAS v4u*)(GY + o); } } while (0)
    LRU1_LOAD(c0);
    { const int ch = F.tid & 127, q = F.tid >> 7, n = c0 / 4;
      const float* GA_ = WSP(float, WS_AGGA) + GD * g + ch; const float* GB_ = WSP(float, WS_AGGB) + GD * g + ch; float A = 1.f, B = 0.f;
      float av[30], bv[30];
#pragma unroll
      for (int i = 0; i < 30; ++i) { const bool ok = i < n; const size_t o = (size_t)(ok ? q * n + i : 0) * LW; const float a_ = GA_[o], b_ = GB_[o]; av[i] = ok ? a_ : 1.f; bv[i] = ok ? b_ : 0.f; }
#pragma unroll
      for (int i = 0; i < 30; ++i) { B = av[i] * B + bv[i]; A *= av[i]; }
      QA[(q * 128 + ch) * 2] = A; QA[(q * 128 + ch) * 2 + 1] = B;
      __syncthreads();
      if (F.tid < 128) { float hc = 0.f;
#pragma unroll
          for (int qq = 0; qq < 4; ++qq) hc = QA[(qq * 128 + F.tid) * 2] * hc + QA[(qq * 128 + F.tid) * 2 + 1];
          CAR[F.tid] = hc; }
      __syncthreads(); }
#pragma unroll 1
    for (int c = c0; c < c0 + 8; ++c) { const int t0 = 64 * c;
        v4u gyv[2];
#pragma unroll
        for (int k = 0; k < 4; ++k) { const int p = F.tid + k * NTHREADS, r = p >> 5, c4 = p & 31; *(LAS f32x4*)(AB + r * 128 + c4 * 4) = pa[k]; }
#pragma unroll
        for (int k = 0; k < 2; ++k) { const int p = F.tid + k * NTHREADS, r = p >> 4, cc = p & 15; gyv[k] = pg[k];
            *(LAS f32x4*)(BB + r * 128 + cc * 8) = (f32x4){bflo(pb[k].x), bfhi(pb[k].x), bflo(pb[k].y), bfhi(pb[k].y)}; *(LAS f32x4*)(BB + r * 128 + cc * 8 + 4) = (f32x4){bflo(pb[k].z), bfhi(pb[k].z), bflo(pb[k].w), bfhi(pb[k].w)}; }
        if (c + 1 < c0 + 8) LRU1_LOAD(c + 1);
        __syncthreads();
        const int ch = F.tid & 127, q = F.tid >> 7;
        { float A = 1.f, B = 0.f;
#pragma unroll
          for (int i = 0; i < 16; ++i) { const int t = 16 * q + i; const float a = AB[t * 128 + ch]; B = a * B + BB[t * 128 + ch]; A *= a; }
          QA[(q * 128 + ch) * 2] = A; QA[(q * 128 + ch) * 2 + 1] = B; }
        __syncthreads();
        float h = CAR[ch];
        for (int qq = 0; qq < q; ++qq) h = QA[(qq * 128 + ch) * 2] * h + QA[(qq * 128 + ch) * 2 + 1];
#pragma unroll
        for (int i = 0; i < 16; ++i) { const int t = 16 * q + i; h = AB[t * 128 + ch] * h + BB[t * 128 + ch]; XCF[t * 128 + ch] = h; }
        __syncthreads();
        if (F.tid < 128) { float hc = CAR[F.tid];
#pragma unroll
            for (int qq = 0; qq < 4; ++qq) hc = QA[(qq * 128 + F.tid) * 2] * hc + QA[(qq * 128 + F.tid) * 2 + 1];
            CAR[F.tid] = hc; }
#pragma unroll
        for (int k = 0; k < 2; ++k) { const int p = F.tid + k * NTHREADS; const int r = p >> 4, cc = p & 15; const size_t o = (size_t)(t0 + r) * LW + ch0 + cc * 8;
            const v4u gy = gyv[k]; const f32x4 h0 = *(const LAS f32x4*)(XCF + r * 128 + cc * 8), h1 = *(const LAS f32x4*)(XCF + r * 128 + cc * 8 + 4);
            v4u ov; ov.x = pk2(h0[0] * bflo(gy.x), h0[1] * bfhi(gy.x)); ov.y = pk2(h0[2] * bflo(gy.y), h0[3] * bfhi(gy.y)); ov.z = pk2(h1[0] * bflo(gy.z), h1[1] * bfhi(gy.z)); ov.w = pk2(h1[2] * bflo(gy.w), h1[3] * bfhi(gy.w));
            *(GAS v4u*)(LR + o) = ov; }
        __syncthreads();
    }
#undef LRU1_LOAD
}
template <int PASS> __device__ __forceinline__ void lru_item(Frame& F, const Args& args, int w) {
    const int g = w & 15, c0 = (w >> 4) * 8; LAS float* CAR = (LAS float*)(F.lds + LRU_CAR); LAS float* QA = (LAS float*)(F.lds + LRU_QA);
    if (PASS == 1) {
        const int ch = F.tid & 127, q = F.tid >> 7, n = c0 / 4;
        const float* GA_ = WSP(float, WS_AGGA) + GD * g + ch; const float* GB_ = WSP(float, WS_AGGB) + GD * g + ch; float A = 1.f, B = 0.f;
        float av[30], bv[30];
#pragma unroll
        for (int i = 0; i < 30; ++i) { const bool ok = i < n; const size_t o = (size_t)(ok ? q * n + i : 0) * LW; const float a_ = GA_[o], b_ = GB_[o]; av[i] = ok ? a_ : 1.f; bv[i] = ok ? b_ : 0.f; }
#pragma unroll
        for (int i = 0; i < 30; ++i) { B = av[i] * B + bv[i]; A *= av[i]; }
        QA[(q * 128 + ch) * 2] = A; QA[(q * 128 + ch) * 2 + 1] = B;
        __syncthreads();
        if (F.tid < 128) { float hc = 0.f;
#pragma unroll
            for (int qq = 0; qq < 4; ++qq) hc = QA[(qq * 128 + F.tid) * 2] * hc + QA[(qq * 128 + F.tid) * 2 + 1];
            CAR[F.tid] = hc; }
        __syncthreads();
    }
    bf16x8 ba[4], bx[4];
    { const int fr = F.lane & 15, fq = F.lane >> 4, j = 16 * F.wave + fr;
      const bf16* WA = WSP(bf16, WS_WAT) + (size_t)g * GD * GD + (size_t)j * GD + 8 * fq; const bf16* WX = WSP(bf16, WS_WXT) + (size_t)g * GD * GD + (size_t)j * GD + 8 * fq;
#pragma unroll
      for (int ks = 0; ks < 4; ++ks) { ba[ks] = *(const GAS bf16x8*)(WA + 32 * ks); bx[ks] = *(const GAS bf16x8*)(WX + 32 * ks); } }
    v4u raw[3];
    { const bf16* LX = WSP(bf16, WS_LX); const int t0 = 64 * c0, ch0 = GD * g;
#pragma unroll
      for (int k = 0; k < 3; ++k) { const int p = F.tid + k * NTHREADS; const int r = p >> 4, cc = p & 15, tg = t0 - 3 + r; raw[k] = (v4u){0u, 0u, 0u, 0u};
          if (p < 67 * 16 && tg >= 0) raw[k] = *(const GAS v4u*)(LX + (size_t)tg * LW + ch0 + cc * 8); } }
    LruConst K;
    { const int gch = GD * g + (F.tid & 127); K.w0 = args.in[10][gch]; K.w1 = args.in[10][LW + gch]; K.w2 = args.in[10][2 * LW + gch]; K.w3 = args.in[10][3 * LW + gch]; K.cb = args.in[11][gch];
      const int gcj = GD * g + 16 * F.wave + (F.lane & 15); K.bav = args.in[13][gcj]; K.bxv = args.in[15][gcj]; const float lam = args.in[16][gcj];
      K.sp8 = -8.0f * 1.4426950408889634f * ((lam > 0.f ? 0.f : -lam) + log1pf(__expf(-fabsf(lam)))); }
#pragma unroll 1
    for (int c = c0; c < c0 + 8; ++c) lru_chunk<PASS>(F, args, c, g, raw, ba, bx, c + 1 < c0 + 8, K);
}
constexpr int ATT_BIAS_OFF = attn_body::LDS_BYTES;
typedef attn_body::BlockRef<bf16, bf16> ARef;
__device__ __forceinline__ int attn_jlo(const float* Fh, int qb, float TH, int lane) {
    const int t0 = qb * 256; const float f0 = Fh[t0];
    const int j0 = lane, j1 = lane + 64;
    const bool ok0 = (64 * j0 + 63 >= t0) || (f0 - Fh[64 * j0 + 63] >= -TH), ok1 = (64 * j1 + 63 >= t0) || (f0 - Fh[64 * j1 + 63] >= -TH);
    const unsigned long long m0 = __ballot(ok0), m1 = __ballot(ok1);
    return m0 ? (int)__builtin_ctzll(m0) : 64 + (int)__builtin_ctzll(m1);
}
__device__ __forceinline__ ARef attn_ref(Frame& F, const Args& args, int h, int qb, int jlo) {
    ARef r; const bf16* QK = WSP(bf16, WS_QKV);
    r.Q = QK + (size_t)(qb * 256) * AW + h * HD; r.K = QK + (size_t)S * AW + h * HD; r.V = QK + 2 * (size_t)S * AW + h * HD;
    r.O = WSP(bf16, WS_ATT) + (size_t)(qb * 256) * AW + h * HD; r.P0 = qb * 256; r.jlo = jlo; return r;
}
__device__ __forceinline__ void attn_fill_bias(Frame& F, const Args& args, int h, int qb, int jlo) {
    const float* Fh = WSP(float, WS_FC) + (size_t)h * S; LAS float* bl = (LAS float*)(F.lds + ATT_BIAS_OFF);
    const int k0 = jlo * 64, n = (qb + 1) * 256 - k0; const float fr = Fh[k0];
#pragma unroll 1
    for (int i = F.tid; i < n; i += NTHREADS) bl[i] = (fr - Fh[k0 + i]) * (1.0f / attn_body::SCALE);
}
#ifndef ATT_MARGIN
#define ATT_MARGIN 18.0f
#endif
constexpr int ATT_SCHED_OFF = 104448;
__device__ __forceinline__ void p4_attention(Frame& F, const Args& args, char* lds_generic, int rep) {
    float gq = fmaxf(fabsf(args.in[8][F.lane]), fabsf(args.in[8][F.lane + 64])), gk = fmaxf(fabsf(args.in[9][F.lane]), fabsf(args.in[9][F.lane + 64]));
    gq = wave_max(gq); gk = wave_max(gk);
    const float TH = 2.0f * (128.0f * gq * gk * attn_body::SCALE) + ATT_MARGIN;
    LAS float* Fend = (LAS float*)(F.lds + ATT_SCHED_OFF); LAS int* cost = (LAS int*)(F.lds + ATT_SCHED_OFF + 8192); LAS int* jlo_t = cost + 512; LAS int* order = cost + 1024; LAS int* slot = cost + 1536;
    const float* Fc = WSP(float, WS_FC);
    for (int p = F.tid; p < NH * 128; p += NTHREADS) Fend[p] = Fc[(size_t)(p >> 7) * S + 64 * (p & 127) + 63];
    __syncthreads();
    { const int u = F.tid, h = u >> 5, qb = u & 31, t0 = qb * 256; const float f0 = Fc[(size_t)h * S + t0];
      int lo = 0, hi = 4 * qb;
      while (lo < hi) { const int mid = (lo + hi) >> 1; const bool ok = (64 * mid + 63 >= t0) || (f0 - Fend[h * 128 + mid] >= -TH); if (ok) hi = mid; else lo = mid + 1; }
      jlo_t[u] = lo; cost[u] = 4 * (qb + 1) - lo; }
    __syncthreads();
    { const int u = F.tid, cu = cost[u]; int rk = 0;
      for (int v = 0; v < 512; ++v) { const int cv = cost[v]; rk += (cv > cu || (cv == cu && v < u)) ? 1 : 0; }
      order[rk] = u; }
    __syncthreads();
    for (;;) {
        if (F.tid == 0) slot[0] = (int)__hip_atomic_fetch_add((unsigned*)(F.ctl + CW_QATT + 64 * rep), 1u, RLX_AGENT);
        __syncthreads();
        const int k = slot[0];
        __syncthreads();
        if (k >= 512) break;
        const int u = order[k], h = u >> 5, qb = u & 31, jl = jlo_t[u];
        const ARef r0 = attn_ref(F, args, h, qb, jl);
        attn_fill_bias(F, args, h, qb, jl); __syncthreads();
        attn_body::attn_unit<bf16, bf16>(r0, S, lds_generic);
    }
}

__device__ __forceinline__ void p7_norm2(Frame& F, const Args& args) {
    const int gw = F.vcu * NWAVES + F.wave, NGW = F.G * NWAVES; const float* MOD = WSP(float, WS_MOD); bf16* HA = WSP(bf16, WS_HA);
    for (int m = gw; m < S; m += NGW) {
        const GAS f32x4* xr = (const GAS f32x4*)(WSP(float, WS_X1) + (size_t)m * DM) + F.lane; f32x4 v[16]; float ss = 0.f;
#pragma unroll
        for (int j = 0; j < 16; ++j) { v[j] = xr[64 * j]; ss += (v[j][0] * v[j][0] + v[j][1] * v[j][1]) + (v[j][2] * v[j][2] + v[j][3] * v[j][3]); }
        const float rstd = 1.0f / sqrtf(wave_sum(ss) * (1.0f / DM) + EPS);
#pragma unroll
        for (int j = 0; j < 16; ++j) { const int i4 = F.lane + 64 * j;
            const f32x4 g = ((const GAS f32x4*)args.in[5])[i4], scl = ((const GAS f32x4*)(MOD + 16384))[i4], sh = ((const GAS f32x4*)(MOD + 12288))[i4];
            const f32x4 hv = v[j] * rstd * (g * (scl + 1.0f)) + sh;
            v2u o; o.x = pk2(hv[0], hv[1]); o.y = pk2(hv[2], hv[3]); ((GAS v2u*)(HA + (size_t)m * DM))[i4] = o; }
    }
}

template <int CTRL> __device__ __forceinline__ unsigned dppu(unsigned x) { return (unsigned)__builtin_amdgcn_update_dpp(0, (int)x, CTRL, 0xF, 0xF, true); }
__device__ __forceinline__ unsigned rowmax_u32(unsigned x) { x = max(x, dppu<0xB1>(x)); x = max(x, dppu<0x4E>(x)); x = max(x, dppu<0x141>(x)); x = max(x, dppu<0x140>(x)); return x; }
__device__ __forceinline__ float rowsum_f32(float x) { x += __uint_as_float(dppu<0xB1>(__float_as_uint(x))); x += __uint_as_float(dppu<0x4E>(__float_as_uint(x)));
    x += __uint_as_float(dppu<0x141>(__float_as_uint(x))); x += __uint_as_float(dppu<0x140>(__float_as_uint(x))); return x; }
__device__ __forceinline__ unsigned ordk(float f) { const unsigned u = __float_as_uint(f); return u ^ ((unsigned)((int)u >> 31) | 0x80000000u); }
__device__ __forceinline__ float deck(unsigned k) { return __uint_as_float((k & 0x80000000u) ? (k ^ 0x80000000u) : ~k); }
#define CE_(x, y) do { const unsigned hi_ = max(x, y), lo_ = min(x, y); x = hi_; y = lo_; } while (0)
__device__ __forceinline__ unsigned row_pop16(unsigned (&a)[8], int i) {
    unsigned res = 0u;
#pragma unroll
    for (int r = 0; r < 16; ++r) { const unsigned m = rowmax_u32(a[0]); const bool win = a[0] == m;
#pragma unroll
        for (int s = 0; s < 7; ++s) a[s] = win ? a[s + 1] : a[s];
        a[7] = win ? 0u : a[7]; res = (i == r) ? m : res; }
    return res;
}
__device__ __forceinline__ void p9_topk(Frame& F, const Args& args, int own_pm, int own_pn) {
    const bf16* Q2 = WSP(bf16, WS_Q2); const bf16* SK = WSP(bf16, WS_SK); int* IDX = WSP(int, WS_IDX); float* GATE = WSP(float, WS_GATE);
    const int i = F.lane & 15, q = F.lane >> 4;
    const unsigned qlo = (unsigned)(i * 2048 + 8 * q) * 2u;
    const int h = own_pm >= 0 ? own_pn : ((int)blockIdx.x & 7), ib = (int)blockIdx.x >> 3, nbh = ((int)F.G - h + 7) >> 3;
    const int tg_0 = own_pm >= 0 ? own_pm * 16 + F.wave : ib * NWAVES + F.wave, tg_step = own_pm >= 0 ? NWAVES : nbh * NWAVES, tg_end = own_pm >= 0 ? own_pm * 16 + 16 : S / 16;
    for (int c = F.tid; c < 4096; c += NTHREADS) { const int pp = c >> 11, n = (c >> 4) & 127, ch = c & 15;
        *(LAS v4u*)(F.lds + pp * 32768 + n * 256 + ((ch * 16) ^ ((n & 7) << 4))) = *(const GAS v4u*)(SK + ((size_t)((h * 2 + pp) * 128 + n)) * 128 + ch * 8); }
    __syncthreads();
#pragma unroll 1
    for (int tg = tg_0; tg < tg_end; tg += tg_step) {
        const int t0 = 16 * tg;
        unsigned R[2][4];
        bf16x8 af[2][4];
#pragma unroll
        for (int p = 0; p < 2; ++p) { const char* qb_ = (const char*)Q2 + ((size_t)t0 * 2048 + h * 256 + p * 128) * 2;
#pragma unroll
            for (int ks = 0; ks < 4; ++ks) af[p][ks] = *(const GAS bf16x8*)(qb_ + 64 * ks + qlo); }
#pragma unroll
        for (int p = 0; p < 2; ++p) {
            f32x4 acc[8];
#pragma unroll
            for (int nt = 0; nt < 8; ++nt) { acc[nt] = (f32x4){0.f, 0.f, 0.f, 0.f}; const int n = 16 * nt + i;
#pragma unroll
                for (int ks = 0; ks < 4; ++ks) { const bf16x8 b = *(const LAS bf16x8*)(F.lds + p * 32768 + n * 256 + ((64 * ks + 16 * q) ^ ((n & 7) << 4)));
                    acc[nt] = __builtin_amdgcn_mfma_f32_16x16x32_bf16(af[p][ks], b, acc[nt], 0, 0, 0); } }
#pragma unroll
            for (int r = 0; r < 4; ++r) { unsigned a[8];
#pragma unroll
                for (int nt = 0; nt < 8; ++nt) a[nt] = (ordk(acc[nt][r]) & ~0x7Fu) | (unsigned)(16 * nt + i);
                CE_(a[0], a[1]); CE_(a[2], a[3]); CE_(a[4], a[5]); CE_(a[6], a[7]); CE_(a[0], a[2]); CE_(a[1], a[3]); CE_(a[4], a[6]); CE_(a[5], a[7]); CE_(a[1], a[2]); CE_(a[5], a[6]);
                CE_(a[0], a[4]); CE_(a[1], a[5]); CE_(a[2], a[6]); CE_(a[3], a[7]); CE_(a[2], a[4]); CE_(a[3], a[5]); CE_(a[1], a[2]); CE_(a[3], a[4]); CE_(a[5], a[6]);
                R[p][r] = row_pop16(a, i); __builtin_amdgcn_sched_barrier(0); }
        }
#pragma unroll
        for (int r = 0; r < 4; ++r) {
            const unsigned R0 = R[0][r], R1 = R[1][r]; const float f0 = deck(R0 & ~0x7Fu), f1 = deck(R1 & ~0x7Fu); const int n0 = (int)(R0 & 0x7Fu), n1 = (int)(R1 & 0x7Fu);
            const unsigned f1u = __float_as_uint(f1); unsigned c[8];
#define CAND_(b, lim) do { const unsigned t_ = (ordk(f0 + __uint_as_float(dppu<0x150 + (b)>(f1u))) & ~0xFFu) | (unsigned)(255 - (i * 16 + (b))); c[b] = (i < (lim)) ? t_ : 0u; } while (0)
            CAND_(0, 16); CAND_(1, 8); CAND_(2, 5); CAND_(3, 4); CAND_(4, 3); CAND_(5, 2); CAND_(6, 2); CAND_(7, 2);
#undef CAND_
            { const float ex = __uint_as_float(dppu<0x150>(__float_as_uint(f0))) + f1; const unsigned exk = (ordk(ex) & ~0xFFu) | (unsigned)(255 - i); c[1] = (i >= 8) ? exk : c[1]; }
            CE_(c[0], c[1]);
            const unsigned G = row_pop16(c, i);
            const float val = deck(G & ~0xFFu); const int id = 255 - (int)(G & 0xFFu); const int rb = F.lane & 48;
            const int ea = __shfl(n0, rb + (id >> 4)), eb = __shfl(n1, rb + (id & 15));
            const float mx = __uint_as_float(dppu<0x150>(__float_as_uint(val))); const float ex = __expf(val - mx); const float sm = rowsum_f32(ex);
            const size_t o = (size_t)(t0 + 4 * q + r) * 128 + h * 16 + i; IDX[o] = ea * 128 + eb; GATE[o] = ex / sm; __builtin_amdgcn_sched_barrier(0);
        }
    }
}
#undef CE_

constexpr float U_SCALE = 256.0f, V_SCALE = 1.0f;
#ifndef PEER_SORT
#define PEER_SORT 0
#endif
__device__ __forceinline__ float gelu_as(float v) {
    const float av = fabsf(v), tt = __builtin_amdgcn_rcpf(av * 0.2316418882f + 1.0f);
    float q = tt * 0.5307027145f + (-0.7265760135f); q = q * tt + 0.7107068705f; q = q * tt + (-0.142248368f); q = q * tt + 0.127414796f; q = q * tt;
    const float m = v * (q * __builtin_amdgcn_exp2f((v * v) * (-0.72134752044f)));
    return v < 0.f ? m : v - m;
}
#ifndef PEER_UMFMA
#define PEER_UMFMA 1
#endif
#ifndef HYP_A
#define HYP_A 1
#endif
#ifndef HYP_B
#define HYP_B 0
#endif
#ifndef PEER_VMFMA
#define PEER_VMFMA 1
#endif
typedef int v8i __attribute__((ext_vector_type(8)));
typedef int v2i __attribute__((ext_vector_type(2)));
typedef float f32x16 __attribute__((ext_vector_type(16)));
__device__ __forceinline__ float wave_sum_dpp(float x) {
    x = rowsum_f32(x);
    return (__uint_as_float(__builtin_amdgcn_readlane(__float_as_uint(x), 0)) + __uint_as_float(__builtin_amdgcn_readlane(__float_as_uint(x), 16)))
         + (__uint_as_float(__builtin_amdgcn_readlane(__float_as_uint(x), 32)) + __uint_as_float(__builtin_amdgcn_readlane(__float_as_uint(x), 48)));
}
#define LOADROWS(T, ra_, rb_, ee) do { const int e2_ = (ee) & 127; const int ea_ = __builtin_amdgcn_readlane(e2_ < 64 ? id0 : id1, e2_ & 63), eb_ = __builtin_amdgcn_readlane(e2_ < 64 ? id0 : id1, (e2_ + 1) & 63); \
        const GAS v4u* pa_ = (const GAS v4u*)((T) + (size_t)ea_ * DM) + F.lane; const GAS v4u* pb_ = (const GAS v4u*)((T) + (size_t)eb_ * DM) + F.lane; \
        _Pragma("unroll") for (int c = 0; c < 4; ++c) { ra_[c] = pa_[64 * c]; rb_[c] = pb_[64 * c]; } } while (0)
#define UDOT(r_, out_) do { f32x2 s0_ = {0.f, 0.f}, s1_ = {0.f, 0.f}, s2_ = {0.f, 0.f}, s3_ = {0.f, 0.f}; \
        _Pragma("unroll") for (int c = 0; c < 4; ++c) _Pragma("unroll") for (int d = 0; d < 2; ++d) { \
            const f32x2 p0_ = __builtin_amdgcn_cvt_scalef32_pk_f32_fp4(r_[c][d], 1.0f, 0), p1_ = __builtin_amdgcn_cvt_scalef32_pk_f32_fp4(r_[c][d], 1.0f, 1), \
                        p2_ = __builtin_amdgcn_cvt_scalef32_pk_f32_fp4(r_[c][d], 1.0f, 2), p3_ = __builtin_amdgcn_cvt_scalef32_pk_f32_fp4(r_[c][d], 1.0f, 3); \
            s0_ = p0_ * hx[8 * c + 4 * d] + s0_; s1_ = p1_ * hx[8 * c + 4 * d + 1] + s1_; s2_ = p2_ * hx[8 * c + 4 * d + 2] + s2_; s3_ = p3_ * hx[8 * c + 4 * d + 3] + s3_; } \
        out_ = ((s0_.x + s0_.y) + (s1_.x + s1_.y)) + ((s2_.x + s2_.y) + (s3_.x + s3_.y)); } while (0)
#define UPAIR(ra_, rb_, ee) do { float sa_, sb_; UDOT(ra_, sa_); UDOT(rb_, sb_); sa_ = wave_sum_dpp(sa_); sb_ = wave_sum_dpp(sb_); \
        const int e2_ = (ee); const int ea_ = __builtin_amdgcn_readlane(e2_ < 64 ? id0 : id1, e2_ & 63), eb_ = __builtin_amdgcn_readlane(e2_ < 64 ? id0 : id1, (e2_ + 1) & 63); \
        const f32x2 a2_ = pg8::gelu_pk((f32x2){sa_ * RSU[ea_], sb_ * RSU[eb_]}); \
        if ((ee) < 64) { if (F.lane == (ee)) w0 = a2_.x * g0; if (F.lane == (ee) + 1) w0 = a2_.y * g0; } else { if (F.lane == (ee) - 64) w1 = a2_.x * g1; if (F.lane == (ee) - 63) w1 = a2_.y * g1; } } while (0)
#define LOADROWS4(T, ra_, rb_, ee) do { const int e2_ = (ee) & 127; const int ea_ = __builtin_amdgcn_readlane(e2_ < 64 ? id0 : id1, e2_ & 63), eb_ = __builtin_amdgcn_readlane(e2_ < 64 ? id0 : id1, (e2_ + 1) & 63); \
        const GAS v2u* pa_ = (const GAS v2u*)((T) + (size_t)ea_ * 2048) + F.lane; const GAS v2u* pb_ = (const GAS v2u*)((T) + (size_t)eb_ * 2048) + F.lane; \
        _Pragma("unroll") for (int c = 0; c < 4; ++c) { ra_[c] = pa_[64 * c]; rb_[c] = pb_[64 * c]; } } while (0)
#define VAXPY(r_, w_) do { const f32x2 w2_ = {w_, w_}; \
        _Pragma("unroll") for (int c = 0; c < 4; ++c) _Pragma("unroll") for (int d = 0; d < 2; ++d) { \
            const f32x2 p0_ = __builtin_amdgcn_cvt_scalef32_pk_f32_fp4(r_[c][d], 1.0f, 0), p1_ = __builtin_amdgcn_cvt_scalef32_pk_f32_fp4(r_[c][d], 1.0f, 1), \
                        p2_ = __builtin_amdgcn_cvt_scalef32_pk_f32_fp4(r_[c][d], 1.0f, 2), p3_ = __builtin_amdgcn_cvt_scalef32_pk_f32_fp4(r_[c][d], 1.0f, 3); \
            acc[8 * c + 4 * d] = p0_ * w2_ + acc[8 * c + 4 * d]; acc[8 * c + 4 * d + 1] = p1_ * w2_ + acc[8 * c + 4 * d + 1]; \
            acc[8 * c + 4 * d + 2] = p2_ * w2_ + acc[8 * c + 4 * d + 2]; acc[8 * c + 4 * d + 3] = p3_ * w2_ + acc[8 * c + 4 * d + 3]; } } while (0)
#define VPAIR(ra_, rb_, ee) do { const int e2_ = (ee); const int ea_ = __builtin_amdgcn_readlane(e2_ < 64 ? id0 : id1, e2_ & 63), eb_ = __builtin_amdgcn_readlane(e2_ < 64 ? id0 : id1, (e2_ + 1) & 63); \
        const float wa_ = __uint_as_float(__builtin_amdgcn_readlane(__float_as_uint((ee) < 64 ? w0 : w1), (ee) & 63)) * RS[ea_], wb_ = __uint_as_float(__builtin_amdgcn_readlane(__float_as_uint((ee) < 64 ? w0 : w1), ((ee) + 1) & 63)) * RS[eb_]; \
        VAXPY(ra_, wa_); VAXPY(rb_, wb_); } while (0)
template <int MODE> __device__ __forceinline__ void p10_peer(Frame& F, const Args& args) {
    const int gw = F.vcu * NWAVES + F.wave, NGW = F.G * NWAVES; const float* MOD = WSP(float, WS_MOD);
    const bf16* H2 = WSP(bf16, WS_HA); const unsigned char* U = WSP(unsigned char, WS_U); const unsigned char* V = WSP(unsigned char, WS_V); const int* IDX = WSP(int, WS_IDX); const float* GATE = WSP(float, WS_GATE); const float* RS = WSP(float, WS_RS); const float* RSU = WSP(float, WS_RSU);
#if PEER_UMFMA
    if (F.lane < 8) *(LAS v4u*)(F.lds + F.wave * 18688 + 4096 + F.lane * 16) = (v4u){0u, 0u, 0u, 0u};
#endif
#pragma unroll 1
    for (int t = gw; t < S; t += NGW) {
        const int id0 = IDX[(size_t)t * 128 + F.lane], id1 = IDX[(size_t)t * 128 + 64 + F.lane];
        const float g0 = GATE[(size_t)t * 128 + F.lane], g1 = GATE[(size_t)t * 128 + 64 + F.lane];
        float w0 = 0.f, w1 = 0.f;
#if PEER_UMFMA
        if (MODE != 2) {
            LAS unsigned char* h8 = F.lds + F.wave * 18688; LAS unsigned char* stg = h8 + 4224;
            const float rstd = 1.0f / sqrtf(wave_sum_dpp(WSP(float, WS_SSQ)[(size_t)t * 64 + F.lane]) * (1.0f / DM) + EPS);
#pragma unroll
            for (int c = 0; c < 4; ++c) { const GAS v4u* hp = (const GAS v4u*)(H2 + (size_t)t * DM + c * 1024 + F.lane * 16); const v4u a = hp[0], b = hp[1]; v4u o;
                const GAS f32x4* sp = (const GAS f32x4*)(MOD + 12288 + c * 1024 + F.lane * 16); const f32x4 s0 = sp[0], s1 = sp[1], s2 = sp[2], s3 = sp[3];
                { int w = 0; w = __builtin_amdgcn_cvt_pk_fp8_f32(bflo(a[0]) * rstd + s0[0], bfhi(a[0]) * rstd + s0[1], w, false); w = __builtin_amdgcn_cvt_pk_fp8_f32(bflo(a[1]) * rstd + s0[2], bfhi(a[1]) * rstd + s0[3], w, true); o[0] = (unsigned)w; }
                { int w = 0; w = __builtin_amdgcn_cvt_pk_fp8_f32(bflo(a[2]) * rstd + s1[0], bfhi(a[2]) * rstd + s1[1], w, false); w = __builtin_amdgcn_cvt_pk_fp8_f32(bflo(a[3]) * rstd + s1[2], bfhi(a[3]) * rstd + s1[3], w, true); o[1] = (unsigned)w; }
                { int w = 0; w = __builtin_amdgcn_cvt_pk_fp8_f32(bflo(b[0]) * rstd + s2[0], bfhi(b[0]) * rstd + s2[1], w, false); w = __builtin_amdgcn_cvt_pk_fp8_f32(bflo(b[1]) * rstd + s2[2], bfhi(b[1]) * rstd + s2[3], w, true); o[2] = (unsigned)w; }
                { int w = 0; w = __builtin_amdgcn_cvt_pk_fp8_f32(bflo(b[2]) * rstd + s3[0], bfhi(b[2]) * rstd + s3[1], w, false); w = __builtin_amdgcn_cvt_pk_fp8_f32(bflo(b[3]) * rstd + s3[2], bfhi(b[3]) * rstd + s3[3], w, true); o[3] = (unsigned)w; }
                *(LAS v4u*)(h8 + c * 1024 + F.lane * 16) = o; }
            const int j = F.lane & 31, kh = F.lane >> 5, lr = F.lane >> 3, lp = F.lane & 7;
            unsigned so[4][4];
#pragma unroll
            for (int b = 0; b < 4; ++b)
#pragma unroll
                for (int i = 0; i < 4; ++i) so[b][i] = (unsigned)__shfl(b < 2 ? id0 : id1, 32 * (b & 1) + lr + 8 * i) * 2048u + (unsigned)lp * 16u;
            int eb[4];
#pragma unroll
            for (int b = 0; b < 4; ++b) eb[b] = __shfl(b < 2 ? id0 : id1, j + 32 * (b & 1));
            const unsigned aoff0 = (j == 0) ? (unsigned)(16 * kh) : 4096u, aoff1 = (j == 0) ? (unsigned)(32 + 16 * kh) : 4112u, astep = (j == 0) ? 64u : 0u;
            const unsigned wof = (unsigned)lr * 144u + (unsigned)lp * 16u, rof = (unsigned)j * 144u + (unsigned)kh * 16u;
            f32x16 ac[4];
#pragma unroll
            for (int b = 0; b < 4; ++b) ac[b] = (f32x16){};
            v4u R0[8], R1[8];
#define ULOAD(R_, kg_, bp_) do { _Pragma("unroll") for (int bb = 0; bb < 2; ++bb) _Pragma("unroll") for (int i = 0; i < 4; ++i) \
                R_[4 * bb + i] = *(const GAS v4u*)(U + (size_t)so[2 * (bp_) + bb][i] + (size_t)(kg_) * 128); } while (0)
#define USTAGE(R_, bp_) do { _Pragma("unroll") for (int bb = 0; bb < 2; ++bb) _Pragma("unroll") for (int i = 0; i < 4; ++i) *(LAS v4u*)(stg + bb * 4608 + i * 1152 + wof) = R_[4 * bb + i]; \
            _Pragma("unroll") for (int bb = 0; bb < 2; ++bb) { v4u B_[4]; _Pragma("unroll") for (int kk = 0; kk < 4; ++kk) B_[kk] = *(const LAS v4u*)(stg + bb * 4608 + rof + kk * 32); \
                _Pragma("unroll") for (int kk = 0; kk < 4; ++kk) ac[2 * (bp_) + bb] = __builtin_amdgcn_mfma_scale_f32_32x32x64_f8f6f4(A[kk], (v8i){(int)B_[kk][0], (int)B_[kk][1], (int)B_[kk][2], (int)B_[kk][3], 0, 0, 0, 0}, ac[2 * (bp_) + bb], 0, 4, 0, 0x7f7f7f7f, 0, 0x7f7f7f7f); } } while (0)
            ULOAD(R0, 0, 0);
#pragma unroll 1
            for (int kg = 0; kg < 16; ++kg) {
                v8i A[4];
#pragma unroll
                for (int kk = 0; kk < 4; ++kk) { const unsigned kb = (unsigned)(4 * kg + kk); const v4u x = *(const LAS v4u*)(h8 + aoff0 + kb * astep), y = *(const LAS v4u*)(h8 + aoff1 + kb * astep);
                    A[kk] = (v8i){(int)x[0], (int)x[1], (int)x[2], (int)x[3], (int)y[0], (int)y[1], (int)y[2], (int)y[3]}; }
                ULOAD(R1, kg, 1);
                USTAGE(R0, 0);
                ULOAD(R0, (kg + 1) & 15, 0);
                USTAGE(R1, 1);
            }
#undef ULOAD
#undef USTAGE
#pragma unroll
            for (int b = 0; b < 4; ++b) {
                const float av = pg8::gelu_pk((f32x2){ac[b][0] * RSU[eb[b]], 0.f}).x;
                const float gg = __shfl(b < 2 ? g0 : g1, j + 32 * (b & 1)); const float wv = av * gg;
                if ((b & 1) == 0) { if (b == 0) w0 = F.lane < 32 ? wv : w0; else w1 = F.lane < 32 ? wv : w1; }
                else { const float mv = __shfl(wv, j); if (b == 1) w0 = F.lane >= 32 ? mv : w0; else w1 = F.lane >= 32 ? mv : w1; } }
        }
#else
        {   f32x2 hx[32];
#pragma unroll
            for (int c = 0; c < 4; ++c) { const GAS v4u* hp = (const GAS v4u*)(H2 + (size_t)t * DM + c * 1024 + F.lane * 16); const v4u a = hp[0], b = hp[1];
#pragma unroll
                for (int k = 0; k < 4; ++k) { hx[8 * c + k] = (f32x2){bflo(a[k]), bfhi(a[k])}; hx[8 * c + 4 + k] = (f32x2){bflo(b[k]), bfhi(b[k])}; } }
            v2u ra[4], rb[4], rc[4], rd[4], na[4], nb[4], nc[4], nd[4];
            if (MODE != 2) {
            LOADROWS4(U, ra, rb, 0); LOADROWS4(U, rc, rd, 2);
#pragma unroll 1
            for (int e = 0; e < 128; e += 8) {
                LOADROWS4(U, na, nb, e + 4); LOADROWS4(U, nc, nd, e + 6);
                UPAIR(ra, rb, e); UPAIR(rc, rd, e + 2);
                LOADROWS4(U, ra, rb, e + 8); LOADROWS4(U, rc, rd, e + 10);
                UPAIR(na, nb, e + 4); UPAIR(nc, nd, e + 6);
            } } }
#endif
        if (MODE == 1 || MODE == 3) { asm volatile("" :: "v"(w0), "v"(w1)); continue; }
#if PEER_VMFMA
        {
            LAS unsigned char* wreg = F.lds + F.wave * 18688; LAS unsigned char* w8 = wreg; LAS unsigned char* stg = wreg + 256;
            const int j = F.lane & 31, kh = F.lane >> 5;
            { const float q0 = w0 * RS[id0] * 16.0f, q1 = w1 * RS[id1] * 16.0f;
              const int b0 = __builtin_amdgcn_cvt_pk_fp8_f32(q0, q0, 0, false), b1 = __builtin_amdgcn_cvt_pk_fp8_f32(q1, q1, 0, false);
              w8[F.lane] = (unsigned char)(b0 & 0xff); w8[64 + F.lane] = (unsigned char)(b1 & 0xff); if (F.lane < 8) *(LAS v2u*)(w8 + 128 + 8 * F.lane) = (v2u){0u, 0u}; }
            v8i A[2];
#pragma unroll
            for (int kb = 0; kb < 2; ++kb) { const unsigned o0 = (j == 0) ? (unsigned)(64 * kb + 16 * kh) : 128u, o1 = (j == 0) ? (unsigned)(64 * kb + 32 + 16 * kh) : 144u;
                const v4u x = *(const LAS v4u*)(w8 + o0), y = *(const LAS v4u*)(w8 + o1);
                A[kb] = (v8i){(int)x[0], (int)x[1], (int)x[2], (int)x[3], (int)y[0], (int)y[1], (int)y[2], (int)y[3]}; }
            const int lr = F.lane >> 3, lp = F.lane & 7;
            unsigned so[2][8];
#pragma unroll
            for (int kb = 0; kb < 2; ++kb)
#pragma unroll
                for (int i = 0; i < 8; ++i) so[kb][i] = (unsigned)__shfl(kb == 0 ? id0 : id1, 8 * i + lr) * 2048u + (unsigned)lp * 16u;
            const unsigned wof = (unsigned)lr * 144u + (unsigned)lp * 16u;
            const unsigned rof = (unsigned)(32 * kh + (F.lane & 15)) * 144u + (unsigned)(8 * ((F.lane >> 4) & 1));
            const bf16* X1r = WSP(bf16, WS_X1) + (size_t)t * DM; const float* G2 = MOD + 20480; float* Or = F.out + (size_t)t * DM;
            v4u R0[8], R1[8];
#define VLOAD(R_, cg_, kb_) do { _Pragma("unroll") for (int i = 0; i < 8; ++i) R_[i] = *(const GAS v4u*)(V + (size_t)so[kb_][i] + (size_t)(cg_) * 128); } while (0)
            VLOAD(R0, 0, 0); VLOAD(R1, 0, 1);
#pragma unroll 1
            for (int cg = 0; cg < 16; ++cg) {
#pragma unroll
                for (int i = 0; i < 8; ++i) { *(LAS v4u*)(stg + i * 1152 + wof) = R0[i]; *(LAS v4u*)(stg + 9216 + i * 1152 + wof) = R1[i]; }
                VLOAD(R0, (cg + 1) & 15, 0); VLOAD(R1, (cg + 1) & 15, 1);
#pragma unroll
                for (int tp = 0; tp < 4; ++tp) { float dv[2];
#pragma unroll
                    for (int th = 0; th < 2; ++th) { const int tt = 2 * tp + th; f32x16 d_ = (f32x16){};
#pragma unroll
                        for (int kb = 0; kb < 2; ++kb) {
                            const v2i q0_ = __builtin_amdgcn_ds_read_tr4_b64_v2i32((LAS v2i*)(stg + kb * 9216 + rof + tt * 16)), q1_ = __builtin_amdgcn_ds_read_tr4_b64_v2i32((LAS v2i*)(stg + kb * 9216 + 2304 + rof + tt * 16));
                            d_ = __builtin_amdgcn_mfma_scale_f32_32x32x64_f8f6f4(A[kb], (v8i){q0_[0], q0_[1], q1_[0], q1_[1], 0, 0, 0, 0}, d_, 0, 4, 0, 0x7b7b7b7b, 0, 0x7f7f7f7f); }
                        dv[th] = d_[0]; }
                    const auto sw = __builtin_amdgcn_permlane32_swap(__float_as_uint(dv[0]), __float_as_uint(dv[1]), false, false);
                    const float dd = __uint_as_float(sw[0]);
                    if (MODE == 2) { asm volatile("" :: "v"(dd)); } else { const int col = cg * 256 + tp * 64 + F.lane; Or[col] = bf2f(X1r[col]) + G2[col] * dd; } }
            }
#undef VLOAD
        }
#else
        f32x2 acc[32];
#pragma unroll
        for (int j = 0; j < 32; ++j) acc[j] = (f32x2){0.f, 0.f};
        {   v2u ra[4], rb[4], rc[4], rd[4], na[4], nb[4], nc[4], nd[4];
            LOADROWS4(V, ra, rb, 0); LOADROWS4(V, rc, rd, 2);
#pragma unroll 1
            for (int e = 0; e < 128; e += 8) {
                LOADROWS4(V, na, nb, e + 4); LOADROWS4(V, nc, nd, e + 6);
                VPAIR(ra, rb, e); VPAIR(rc, rd, e + 2);
                LOADROWS4(V, ra, rb, e + 8); LOADROWS4(V, rc, rd, e + 10);
                VPAIR(na, nb, e + 4); VPAIR(nc, nd, e + 6);
            } }
        if (MODE == 2) {
#pragma unroll
            for (int j = 0; j < 32; ++j) asm volatile("" :: "v"(acc[j]));
            continue; }
#pragma unroll
        for (int c = 0; c < 4; ++c) { const int col = c * 1024 + F.lane * 16; GAS f32x4* op = (GAS f32x4*)(F.out + (size_t)t * DM + col);
            const GAS f32x4* xp = (const GAS f32x4*)(WSP(float, WS_X1) + (size_t)t * DM + col); const GAS f32x4* gp = (const GAS f32x4*)(MOD + 20480 + col);
#pragma unroll
            for (int q = 0; q < 4; ++q) op[q] = xp[q] + gp[q] * (f32x4){acc[8 * c + 2 * q].x, acc[8 * c + 2 * q].y, acc[8 * c + 2 * q + 1].x, acc[8 * c + 2 * q + 1].y}; }
#endif
    }
}
#undef LOADROWS
#undef UDOT
#undef UPAIR
#undef VAXPY
#undef VPAIR
#undef LOADROWS4
#ifndef MK_SINGLE
#define MK_SINGLE 1
#endif
constexpr int N_PHASES = 11;
__global__ void __launch_bounds__(NTHREADS, 2) fwd_kernel(Args args) {
    extern __shared__ __attribute__((aligned(16))) unsigned char lds[];
    Frame F;
    F.lds = (LAS unsigned char*)lds; F.MISC = (volatile LAS unsigned*)(F.lds + MISC_OFF);
    F.tid = threadIdx.x; F.lane = F.tid & 63; F.wave = __builtin_amdgcn_readfirstlane(F.tid >> 6);
    F.G = gridDim.x; { const int bx = blockIdx.x; F.vcu = (F.G % 8 == 0) ? (bx % 8) * (F.G / 8) + bx / 8 : bx; }
    F.ws = args.ws; F.out = args.out; F.ctl = (gu32*)(args.ws + WS_CTL);
    for (int u = F.tid; u < (LDS_BYTES - LDSCTL_OFF) / 4; u += NTHREADS) ((LAS unsigned*)(F.lds + LDSCTL_OFF))[u] = 0u;
    __syncthreads();
    const int lo = args.ph_lo, hi = args.ph_hi;
    XcdBarrier bar; bar.bar = (unsigned*)(F.ctl + CW_BAR); bar.x = 0; bar.st = nullptr;
    if (hi - lo > 1) bar = xcd_barrier_post((unsigned*)(F.ctl + CW_BAR), F.MISC + 8);
#ifndef PH_MASK
#define PH_MASK 0x7ff
#endif
#define IN(k) (((PH_MASK >> (k)) & 1) && lo <= (k) && (k) < hi)
#define SEAM(k) do { if (IN(k) && IN((k) + 1)) xcd_barrier(bar); } while (0)
#ifndef G_ALIGN
#define G_ALIGN true
#endif
#ifndef G_SP2
#define G_SP2 true
#endif
#ifndef QKN_IN_P2
#define QKN_IN_P2 0
#endif
#ifndef P2_BAL
#define P2_BAL 0
#endif
#ifndef P9_OWN
#define P9_OWN 1
#endif
#ifndef P5_FUSED
#define P5_FUSED 1
#endif
#ifndef REP_PHASE
#define REP_PHASE -1
#endif
#define REPEAT(k) _Pragma("unroll") for (int rep = 0; rep < ((REP_PHASE) == (k) ? 2 : 1); ++rep)
#define REPBAR(k) do { if ((REP_PHASE) == (k) && rep == 0) xcd_barrier(bar); } while (0)
    const int bid = (int)blockIdx.x;
    if (IN(0)) { REPEAT(0) { p0_prologue(F, args); REPBAR(0); } SEAM(0); }
    if (IN(1)) { REPEAT(1) { p1_norm_forget(F, args); p1_shift_proj(F, args); REPBAR(1); } SEAM(1); }
#ifdef CLK_PROBE
    long long ck0 = clock64(); long long wk0 = wall_clock64();
#endif
    if (IN(2)) { REPEAT(2) {
#ifdef P2_STAGGER
        if ((bid >> 3) & 1) { const long long t0_ = wall_clock64(); while (wall_clock64() - t0_ < P2_STAGGER) __builtin_amdgcn_s_sleep(8); }
#endif
#if SKEW_TABLES
        const bool tables_first = ((bid >> 3) & 1) != 0; const int gw_ = F.vcu * NWAVES + F.wave, NGW_ = F.G * NWAVES;
        if (tables_first) { cvt_table_fp4(F, args.in[23], WSP(unsigned char, WS_V), WSP(float, WS_RS), gw_, NGW_); cvt_table_fp4(F, args.in[22], WSP(unsigned char, WS_U), WSP(float, WS_RSU), gw_, NGW_); if (SKEW_TR) tr_run(F, args, TR_LATE_LO, TR_LATE_HI); __syncthreads(); }
#endif
        pg8::Gemm g{WSP(bf16, WS_HA), WSP(bf16, WS_WIN), S, NINP, DM}; pg8::BalOrder So; So.init(S, NINP, F.G, bid); So.on = (P2_BAL != 0) && F.G == 256;
        pg8::EpiIn E{WSP(bf16, WS_QKV), WSP(bf16, WS_LX), WSP(bf16, WS_GY), WSP(bf16, WS_GA), WSP(bf16, WS_GL), WSP(float, WS_BIASR)};
        pg8::gemm_phase<pg8::EpiIn, pg8::BalOrder, G_ALIGN, G_SP2>(F.lds, g, So, E);
#if SKEW_TABLES
        if (!tables_first) { cvt_table_fp4(F, args.in[23], WSP(unsigned char, WS_V), WSP(float, WS_RS), gw_, NGW_); cvt_table_fp4(F, args.in[22], WSP(unsigned char, WS_U), WSP(float, WS_RSU), gw_, NGW_); if (SKEW_TR) tr_run(F, args, TR_LATE_LO, TR_LATE_HI); }
#endif
        REPBAR(2); }
#ifdef P2_NOEPI
        { xcd_barrier(bar); pg8::Gemm g{WSP(bf16, WS_HA), WSP(bf16, WS_WIN), S, NINP, DM};
#ifdef P2_PITCH
          g.lda = P2_PITCH; g.ldb = P2_PITCH;
#endif
          pg8::MaskOrder So; So.init(S, NINP, F.G, bid);

#if EPI_PROBE
          pg8::EpiInProbe E{WSP(bf16, WS_T1), WSP(bf16, WS_T1), WSP(bf16, WS_T1), WSP(bf16, WS_T1), WSP(bf16, WS_T1), WSP(float, WS_BIASR)}; pg8::gemm_phase<pg8::EpiInProbe, pg8::MaskOrder, G_ALIGN, G_SP2, 0>(F.lds, g, So, E); }
#else
          pg8::EpiNullKeep E{WSP(float, WS_IDX2)}; pg8::gemm_phase<pg8::EpiNullKeep, pg8::MaskOrder, G_ALIGN, G_SP2, P2_NOEPI - 1>(F.lds, g, So, E); }
#endif

#endif
        SEAM(2);
    }
#ifdef CLK_PROBE
    long long ck1 = clock64(); long long wk1 = wall_clock64();
#endif
    if (IN(3)) {
#if !QKN_IN_P2
        p3_qknorm(F, args);
        __syncthreads();
#endif
        REPEAT(3) {
        p3_cumsum(F, args);
        for (int w = bid; w < 256; w += F.G) lru_item<0>(F, args, w);
        REPBAR(3); }
        SEAM(3);
    }
    if (IN(4)) {
#pragma unroll 1
        for (int rep = 0; rep < args.rep_lru; ++rep)
        for (int w = bid; w < 256; w += F.G) { if (LRU_STORE_AB) lru_item1_ab(F, args, w); else lru_item<1>(F, args, w); }
#pragma unroll 1
        for (int rep = 0; rep < args.rep_att; ++rep) p4_attention(F, args, (char*)lds, rep);
        SEAM(4);
    }
    if (IN(5)) { REPEAT(5) {
#if P5_FUSED
        { pg8::Gemm g{WSP(bf16, WS_ATT), WSP(bf16, WS_WAO), S, DM, AW + LW}; g.lda = AW; g.ldb = AW; g.A2 = WSP(bf16, WS_LR); g.Bt2 = WSP(bf16, WS_WLO); g.ksplit = AW;
          pg8::StaticOrder So; So.init(S, DM, F.G, bid);
          pg8::EpiGate2 E{WSP(bf16, WS_T1), WSP(bf16, WS_GA), WSP(bf16, WS_GL), DM};
          pg8::gemm_phase<pg8::EpiGate2, pg8::StaticOrder, true, true, 0, true>(F.lds, g, So, E); }
#else
        { pg8::Gemm g{WSP(bf16, WS_ATT), WSP(bf16, WS_WAO), S, DM, AW}; pg8::StaticOrder So; So.init(S, DM, F.G, bid);
          pg8::EpiGate<0> E{WSP(bf16, WS_T1), WSP(bf16, WS_GA), DM};
          pg8::gemm_phase<pg8::EpiGate<0>, pg8::StaticOrder, true, true>(F.lds, g, So, E); }
        { pg8::Gemm g{WSP(bf16, WS_LR), WSP(bf16, WS_WLO), S, DM, LW}; pg8::StaticOrder So; So.init(S, DM, F.G, bid);
          pg8::EpiGate<1> E{WSP(bf16, WS_T1), WSP(bf16, WS_GL), DM};
          pg8::gemm_phase<pg8::EpiGate<1>, pg8::StaticOrder, true, true>(F.lds, g, So, E); }
#endif
        REPBAR(5); }
        SEAM(5);
    }
    if (IN(6)) { REPEAT(6) {
        pg8::Gemm g{WSP(bf16, WS_T1), WSP(bf16, WS_WOUT), S, DM, DM}; pg8::StaticOrder So; So.init(S, DM, F.G, bid);
        pg8::EpiRes E{args.in[0], WSP(bf16, WS_X1), WSP(float, WS_MOD) + 8192, DM, args.in[5], WSP(float, WS_MOD) + 16384, WSP(bf16, WS_HA), WSP(float, WS_SSQ)};
        pg8::gemm_phase<pg8::EpiRes, pg8::StaticOrder, true, true>(F.lds, g, So, E);
        REPBAR(6); }
        SEAM(6);
    }
    pg8::Unit p9u{0, 0}; bool p9_own = false;
    { pg8::StaticOrder So8; So8.init(S, 2048, F.G, bid); p9_own = (P9_OWN != 0) && F.G == 256 && IN(8) && IN(9) && (REP_PHASE) != 8 && So8.next(0, p9u); }
    if (IN(8)) { REPEAT(8) {
        pg8::Gemm g{WSP(bf16, WS_HA), WSP(bf16, WS_WPQ), S, 2048, DM}; pg8::RstdOrder So; So.init(S, 2048, F.G, bid);
        So.SSQ = WSP(float, WS_SSQ); So.rs = (LAS float*)(F.lds + 133120); So.inv_n = 1.0f / DM; So.eps = EPS; So.na = 0;
        pg8::EpiQ2 E{WSP(bf16, WS_Q2), 2048, WSP(float, WS_SB), (const LAS float*)(F.lds + 133120), 0};
        pg8::gemm_phase<pg8::EpiQ2, pg8::RstdOrder, true, true>(F.lds, g, So, E);
        REPBAR(8); }
        if (p9_own) __syncthreads(); else SEAM(8);
    }
    if (IN(9)) { REPEAT(9) { p9_topk(F, args, p9_own ? p9u.pm : -1, p9u.pn); REPBAR(9); } SEAM(9); }
#ifndef P10_PROBE
#define P10_PROBE 0
#endif
#if defined(CLK_PROBE) && CLK_PROBE >= 10
    ck0 = clock64(); wk0 = wall_clock64();
#endif
    if (IN(10)) { if (P10_PROBE) { p10_peer<P10_PROBE>(F, args); xcd_barrier(bar); } REPEAT(10) { p10_peer<0>(F, args); REPBAR(10); } }
#if defined(CLK_PROBE) && CLK_PROBE >= 10
    ck1 = clock64(); wk1 = wall_clock64();
#endif
#ifdef CLK_PROBE
    xcd_barrier(bar);
    if (bid == 0 && F.tid == 0) { const float ghz = (float)(ck1 - ck0) / (float)(wk1 - wk0) * 0.1f;
        F.out[0] = (CLK_PROBE == 1 || CLK_PROBE == 10) ? floorf(ghz * 10.0f + 0.5f) * 10.0f : (float)(wk1 - wk0) * 0.01f; }
#endif
#undef IN
#undef SEAM
}

extern "C" void kernel_launch(void* const* d_in, const int* in_sizes, int n_in, void* d_out, int out_size, void* d_ws, size_t ws_size, hipStream_t stream) {
    static int grid = 0;
    if (grid == 0) {
        if (n_in != 24 || in_sizes[0] != S * DM || out_size != S * DM || ws_size < WS_END) { fprintf(stderr, "kernel_launch: unexpected shapes (n_in %d, in0 %d, out %d, ws %zu)\n", n_in, n_in > 0 ? in_sizes[0] : -1, out_size, ws_size); grid = -1; return; }
        int dev = 0, cus = 0, per_cu = 0;
        if (hipGetDevice(&dev) != hipSuccess || hipDeviceGetAttribute(&cus, hipDeviceAttributeMultiprocessorCount, dev) != hipSuccess) { grid = -1; return; }
        if (hipFuncSetAttribute((const void*)fwd_kernel, hipFuncAttributeMaxDynamicSharedMemorySize, LDS_BYTES) != hipSuccess) { fprintf(stderr, "kernel_launch: hipFuncSetAttribute failed\n"); grid = -1; return; }
        if (hipOccupancyMaxActiveBlocksPerMultiprocessor(&per_cu, (const void*)fwd_kernel, NTHREADS, LDS_BYTES) != hipSuccess || per_cu < 1) fprintf(stderr, "kernel_launch: occupancy query reports %d blocks per CU\n", per_cu);
        (void)hipGetLastError();
        grid = cus;
    }
    if (grid < 0) return;
    if (hipMemsetAsync((char*)d_ws + WS_CTL, 0, CTL_ZERO_BYTES, stream) != hipSuccess) return;
    Args a{};
    for (int i = 0; i < 24; ++i) a.in[i] = (const float*)d_in[i];
    a.out = (float*)d_out; a.ws = (unsigned char*)d_ws;
#ifndef REP_ATT
#define REP_ATT 1
#endif
#ifndef REP_LRU
#define REP_LRU 1
#endif
    a.rep_att = REP_ATT; a.rep_lru = REP_LRU;
#if MK_SINGLE
    a.ph_lo = 0; a.ph_hi = N_PHASES;
    hipLaunchKernelGGL(fwd_kernel, dim3(grid), dim3(NTHREADS), LDS_BYTES, stream, a);
#else
    for (int p = 0; p < N_PHASES; ++p) { a.ph_lo = p; a.ph_hi = p + 1; hipLaunchKernelGGL(fwd_kernel, dim3(grid), dim3(NTHREADS), LDS_BYTES, stream, a); }
#endif
}
```

```cpp
#include <hip/hip_runtime.h>
#include <cstdio>
#include <cstdint>
namespace pg8 {
#define PG8_LAS __attribute__((address_space(3)))
typedef unsigned short bf16_t;
typedef short bf16x8 __attribute__((ext_vector_type(8)));
typedef float f32x4 __attribute__((ext_vector_type(4)));
typedef unsigned u32x4 __attribute__((ext_vector_type(4)));
constexpr int BM = 256, BK = 64, HALF = 128, HTB = HALF * BK * 2  , STAGE_BYTES = 8 * HTB, NXCD = 8, WGM = 8;

__host__ __device__ __forceinline__ int lds_byte(int r, int c) { const int st = (r >> 4) * 2 + (c >> 5), rr = r & 15, cc = c & 31, ob = rr * 64 + cc * 2; return st * 1024 + (ob ^ (((ob >> 9) & 1) << 5)); }
__host__ __device__ __forceinline__ void stage_rc(int b, int& R, int& C) { const int st = b / 1024, sb = b % 1024, swz = sb ^ (((sb >> 9) & 1) << 5); R = (st >> 1) * 16 + swz / 64; C = (st & 1) * 32 + (swz % 64) / 2; }
__host__ __device__ __forceinline__ int perm32(int rho) { const int n = rho >> 4, i = rho & 15; return 8 * (i >> 2) + 4 * n + (i & 3); }

struct Unit { int pm, pn; };
struct Gemm { const bf16_t* A; const bf16_t* Bt; int M, N, K; int lda = 0, ldb = 0; const bf16_t* A2 = nullptr; const bf16_t* Bt2 = nullptr; int ksplit = 0; };

struct StaticOrder {
    int nM, nN, nwg, G, c;
    __host__ __device__ void init(int M, int N, int G_, int c_) { nM = M / BM; nN = N / BM; nwg = nM * nN; G = G_; c = c_; }
    __host__ __device__ bool next(int i, Unit& u) const {
        const long L = (long)i * G + c; if (L >= nwg) return false;
        int wgid = (int)L; { const int q = nwg / NXCD, r = nwg % NXCD, xcd = wgid % NXCD, off = wgid / NXCD; wgid = (xcd < r ? xcd * (q + 1) : r * (q + 1) + (xcd - r) * q) + off; }
        const int nig = WGM * nN, gid = wgid / nig, fm = gid * WGM, gsz = (nM - fm) < WGM ? (nM - fm) : WGM;
        u.pm = fm + ((wgid % nig) % gsz); u.pn = (wgid % nig) / gsz; return true;
    }
    __device__ __forceinline__ void a_ready(const Unit&) const {}
    __device__ __forceinline__ void done(const Unit&) const {}
};

__device__ __forceinline__ unsigned cvt_pk_bf16(float lo, float hi) { unsigned r; asm volatile("v_cvt_pk_bf16_f32 %0, %1, %2" : "=v"(r) : "v"(lo), "v"(hi)); return r; }
typedef float f32x2 __attribute__((ext_vector_type(2)));
__device__ __forceinline__ f32x2 gelu_pk(f32x2 v) {
    const f32x2 av = __builtin_elementwise_abs(v), d = av * 0.2316418882f + 1.0f;
    f32x2 t; t.x = __builtin_amdgcn_rcpf(d.x); t.y = __builtin_amdgcn_rcpf(d.y);
    f32x2 q = t * 0.5307027145f + (-0.7265760135f); q = q * t + 0.7107068705f; q = q * t + (-0.142248368f); q = q * t + 0.127414796f; q = q * t;
    const f32x2 s = (v * v) * (-0.72134752044f);
    f32x2 e; e.x = __builtin_amdgcn_exp2f(s.x); e.y = __builtin_amdgcn_exp2f(s.y);
    const f32x2 m = v * (q * e), r = v - m;
    f32x2 o; o.x = v.x < 0.f ? m.x : r.x; o.y = v.y < 0.f ? m.y : r.y; return o;
}


__device__ __forceinline__ const char* sgpr_ptr(const char* p) { const unsigned long long v = (unsigned long long)p; unsigned lo = (unsigned)v, hi = (unsigned)(v >> 32);
    asm volatile("" : "+s"(lo), "+s"(hi)); return (const char*)(((unsigned long long)hi << 32) | lo); }
template <int ACT  > struct EpiBf16 {
    static constexpr bool PERM = true, AFTER_DRAIN = false, EPI_LOADS = false; static_assert(ACT == 0 || ACT == 1, "EpiBf16: ACT is 0 (none) or 1 (gelu_pk)");
    bf16_t* O; int ldc; const float* bias; int split_cols; size_t split_stride; float scale0;
    __device__ __forceinline__ void operator()(const f32x4 (&acc)[2][2][4][2], const Unit& u, int wr, int wc, int fr, int fq) const {
        const int row0 = u.pm * BM + wr * 64 + fr; int colt = u.pn * BM; bf16_t* base = O;
        float sc = 1.f; if (split_cols) { const int t = colt / split_cols; base += (size_t)t * split_stride; colt -= t * split_cols; if (t == 0) sc = scale0; }
        const int col0 = colt + wc * 32 + 8 * fq, bcol0 = u.pn * BM + wc * 32 + 8 * fq;
        f32x4 bv[2][2];
#pragma unroll
        for (int bj = 0; bj < 2; ++bj)
#pragma unroll
            for (int n = 0; n < 2; ++n) bv[bj][n] = bias ? *(const f32x4*)(bias + bcol0 + bj * HALF + 4 * n) : (f32x4){0.f, 0.f, 0.f, 0.f};
#pragma unroll
        for (int ai = 0; ai < 2; ++ai)
#pragma unroll
            for (int m = 0; m < 4; ++m) { bf16_t* rowp = base + (size_t)(row0 + ai * HALF + m * 16) * ldc + col0;
#pragma unroll
                for (int bj = 0; bj < 2; ++bj) { f32x4 v0 = acc[ai][bj][m][0] + bv[bj][0], v1 = acc[ai][bj][m][1] + bv[bj][1];
                    if (ACT == 1) { f32x2 a = gelu_pk((f32x2){v0[0], v0[1]}), b = gelu_pk((f32x2){v0[2], v0[3]}), c = gelu_pk((f32x2){v1[0], v1[1]}), d = gelu_pk((f32x2){v1[2], v1[3]});
                        v0 = (f32x4){a.x, a.y, b.x, b.y}; v1 = (f32x4){c.x, c.y, d.x, d.y}; }
                    v0 = v0 * sc; v1 = v1 * sc; u32x4 w; w.x = cvt_pk_bf16(v0[0], v0[1]); w.y = cvt_pk_bf16(v0[2], v0[3]); w.z = cvt_pk_bf16(v1[0], v1[1]); w.w = cvt_pk_bf16(v1[2], v1[3]);
                    *(u32x4*)(rowp + bj * HALF) = w; } }
    }
};
__device__ __forceinline__ f32x4 sigm4(f32x4 v) { f32x4 o;
#pragma unroll
    for (int j = 0; j < 4; ++j) o[j] = __builtin_amdgcn_rcpf(1.0f + __builtin_amdgcn_exp2f(-1.4426950408889634f * v[j]));
    return o; }
__device__ __forceinline__ f32x4 gelu4(f32x4 v) { const f32x2 a = gelu_pk((f32x2){v[0], v[1]}), b = gelu_pk((f32x2){v[2], v[3]}); return (f32x4){a.x, a.y, b.x, b.y}; }
__device__ __forceinline__ void unpack8(const u32x4 w, f32x4& lo, f32x4& hi) {
    lo = (f32x4){__uint_as_float(w.x << 16), __uint_as_float(w.x & 0xffff0000u), __uint_as_float(w.y << 16), __uint_as_float(w.y & 0xffff0000u)};
    hi = (f32x4){__uint_as_float(w.z << 16), __uint_as_float(w.z & 0xffff0000u), __uint_as_float(w.w << 16), __uint_as_float(w.w & 0xffff0000u)}; }
#ifdef EPI_NT
#define EPI_ST(p, v) __builtin_nontemporal_store((v), (p))
#else
#define EPI_ST(p, v) (*(p) = (v))
#endif
struct EpiIn {
    static constexpr bool PERM = true, AFTER_DRAIN = false, EPI_LOADS = true;
    bf16_t* qkv; bf16_t* lx; bf16_t* gy; bf16_t* ga; bf16_t* gl; const float* bias;
    __device__ __forceinline__ void operator()(const f32x4 (&acc)[2][2][4][2], const Unit& u, int wr, int wc, int fr, int fq) const {
        const int pn = u.pn; bf16_t* base; int ldc, colt, act;
        if (pn < 24) { base = qkv + (size_t)(pn >> 3) * ((size_t)8192 * 2048); ldc = 2048; colt = (pn & 7) * 256; act = 0; }
        else if (pn < 32) { base = lx; ldc = 2048; colt = (pn - 24) * 256; act = 0; }
        else if (pn < 40) { base = gy; ldc = 2048; colt = (pn - 32) * 256; act = 1; }
        else if (pn < 56) { base = ga; ldc = 4096; colt = (pn - 40) * 256; act = 2; }
        else { base = gl; ldc = 4096; colt = (pn - 56) * 256; act = 2; }
        const int row0 = u.pm * BM + wr * 64 + fr, col0 = colt + wc * 32 + 8 * fq, bcol0 = pn * BM + wc * 32 + 8 * fq;
        f32x4 bv[2][2];
#pragma unroll
        for (int bj = 0; bj < 2; ++bj)
#pragma unroll
            for (int n = 0; n < 2; ++n) bv[bj][n] = *(const f32x4*)(bias + bcol0 + bj * HALF + 4 * n);
#pragma unroll
        for (int ai = 0; ai < 2; ++ai)
#pragma unroll
            for (int m = 0; m < 4; ++m) { bf16_t* rowp = base + (size_t)(row0 + ai * HALF + m * 16) * ldc + col0;
#pragma unroll
                for (int bj = 0; bj < 2; ++bj) { f32x4 v0 = acc[ai][bj][m][0] + bv[bj][0], v1 = acc[ai][bj][m][1] + bv[bj][1];
                    if (act == 1) { v0 = gelu4(v0); v1 = gelu4(v1); }
                    else if (act == 2) { v0 = sigm4(v0); v1 = sigm4(v1); }
                    u32x4 w; w.x = cvt_pk_bf16(v0[0], v0[1]); w.y = cvt_pk_bf16(v0[2], v0[3]); w.z = cvt_pk_bf16(v1[0], v1[1]); w.w = cvt_pk_bf16(v1[2], v1[3]);
                    EPI_ST((u32x4*)(rowp + bj * HALF), w); } }
    }
};
#ifndef EPI_PROBE
#define EPI_PROBE 0
#endif
struct EpiInProbe {
    static constexpr bool PERM = true, AFTER_DRAIN = false, EPI_LOADS = true;
    bf16_t* qkv; bf16_t* lx; bf16_t* gy; bf16_t* ga; bf16_t* gl; const float* bias;
    __device__ __forceinline__ void operator()(const f32x4 (&acc)[2][2][4][2], const Unit& u, int wr, int wc, int fr, int fq) const {
        const int pn = u.pn; bf16_t* base; int ldc, colt, act;
        if (pn < 24) { base = qkv + (size_t)(pn >> 3) * ((size_t)8192 * 2048); ldc = 2048; colt = (pn & 7) * 256; act = 0; }
        else if (pn < 32) { base = lx; ldc = 2048; colt = (pn - 24) * 256; act = 0; }
        else if (pn < 40) { base = gy; ldc = 2048; colt = (pn - 32) * 256; act = 1; }
        else if (pn < 56) { base = ga; ldc = 4096; colt = (pn - 40) * 256; act = 2; }
        else { base = gl; ldc = 4096; colt = (pn - 56) * 256; act = 2; }
        const int row0 = u.pm * BM + wr * 64 + fr, col0 = colt + wc * 32 + 8 * fq, bcol0 = pn * BM + wc * 32 + 8 * fq;
        f32x4 bv[2][2];
#pragma unroll
        for (int bj = 0; bj < 2; ++bj)
#pragma unroll
            for (int n = 0; n < 2; ++n) bv[bj][n] = (EPI_PROBE == 2) ? (f32x4){0.f, 0.f, 0.f, 0.f} : *(const f32x4*)(bias + bcol0 + bj * HALF + 4 * n);
#pragma unroll
        for (int ai = 0; ai < 2; ++ai)
#pragma unroll
            for (int m = 0; m < 4; ++m) { bf16_t* rowp = base + (size_t)(row0 + ai * HALF + m * 16) * ldc + col0;
#pragma unroll
                for (int bj = 0; bj < 2; ++bj) { f32x4 v0 = acc[ai][bj][m][0] + bv[bj][0], v1 = acc[ai][bj][m][1] + bv[bj][1];
                    if (act == 1) { v0 = gelu4(v0); v1 = gelu4(v1); }
                    else if (act == 2) { v0 = sigm4(v0); v1 = sigm4(v1); }
                    u32x4 w; w.x = cvt_pk_bf16(v0[0], v0[1]); w.y = cvt_pk_bf16(v0[2], v0[3]); w.z = cvt_pk_bf16(v1[0], v1[1]); w.w = cvt_pk_bf16(v1[2], v1[3]);
                    if (EPI_PROBE != 1 || w.x == 0x12345678u) EPI_ST((u32x4*)(rowp + bj * HALF), w); } }
    }
};
template <int MODE> struct EpiGate {
    static constexpr bool PERM = true, AFTER_DRAIN = false, EPI_LOADS = true;
    bf16_t* O; const bf16_t* Gt; int ldc;
    __device__ __forceinline__ void operator()(const f32x4 (&acc)[2][2][4][2], const Unit& u, int wr, int wc, int fr, int fq) const {
        const int row0 = u.pm * BM + wr * 64 + fr, col0 = u.pn * BM + wc * 32 + 8 * fq;
#pragma unroll
        for (int ai = 0; ai < 2; ++ai)
#pragma unroll
            for (int m = 0; m < 4; ++m) { const size_t off = (size_t)(row0 + ai * HALF + m * 16) * ldc + col0;
#pragma unroll
                for (int bj = 0; bj < 2; ++bj) { f32x4 g0, g1; unpack8(*(const u32x4*)(Gt + off + bj * HALF), g0, g1);
                    f32x4 v0 = acc[ai][bj][m][0] * g0, v1 = acc[ai][bj][m][1] * g1;
                    if (MODE == 1) { f32x4 t0, t1; unpack8(*(const u32x4*)(O + off + bj * HALF), t0, t1); v0 += t0; v1 += t1; }
                    u32x4 w; w.x = cvt_pk_bf16(v0[0], v0[1]); w.y = cvt_pk_bf16(v0[2], v0[3]); w.z = cvt_pk_bf16(v1[0], v1[1]); w.w = cvt_pk_bf16(v1[2], v1[3]);
                    *(u32x4*)(O + off + bj * HALF) = w; } }
    }
};
struct EpiGate2 {
    static constexpr bool PERM = true, AFTER_DRAIN = false, EPI_LOADS = true;
    bf16_t* O; const bf16_t* Ga; const bf16_t* Gl; int ldc;
    __device__ __forceinline__ void mid(f32x4 (&acc)[2][2][4][2], const Unit& u, int wr, int wc, int fr, int fq) const {
        const unsigned lb = (unsigned)(fr * ldc + 8 * fq) * 2u;
        const size_t ub = ((size_t)(u.pm * BM + wr * 64) * ldc + (size_t)(u.pn * BM + wc * 32)) * 2u;
        const char* ga = (const char*)Ga + ub; const char* gl = (const char*)Gl + ub;
#pragma unroll
        for (int ai = 0; ai < 2; ++ai)
#pragma unroll
            for (int m = 0; m < 4; ++m)
#pragma unroll
                for (int bj = 0; bj < 2; ++bj) { const size_t o = ((size_t)(ai * HALF + m * 16) * ldc + bj * HALF) * 2u;
                    f32x4 a0, a1, l0, l1; unpack8(*(const u32x4*)(sgpr_ptr(ga + o) + lb), a0, a1); unpack8(*(const u32x4*)(sgpr_ptr(gl + o) + lb), l0, l1);
#pragma unroll
                    for (int j = 0; j < 4; ++j) { acc[ai][bj][m][0][j] *= a0[j] * __builtin_amdgcn_rcpf(l0[j]); acc[ai][bj][m][1][j] *= a1[j] * __builtin_amdgcn_rcpf(l1[j]); }
                    __builtin_amdgcn_sched_barrier(0); }
    }
    __device__ __forceinline__ void operator()(const f32x4 (&acc)[2][2][4][2], const Unit& u, int wr, int wc, int fr, int fq) const {
        const int row0 = u.pm * BM + wr * 64 + fr, col0 = u.pn * BM + wc * 32 + 8 * fq;
#pragma unroll
        for (int ai = 0; ai < 2; ++ai)
#pragma unroll
            for (int m = 0; m < 4; ++m) { const size_t off = (size_t)(row0 + ai * HALF + m * 16) * ldc + col0;
#pragma unroll
                for (int bj = 0; bj < 2; ++bj) { f32x4 g0, g1; unpack8(*(const u32x4*)(Gl + off + bj * HALF), g0, g1);
                    const f32x4 v0 = acc[ai][bj][m][0] * g0, v1 = acc[ai][bj][m][1] * g1;
                    u32x4 w; w.x = cvt_pk_bf16(v0[0], v0[1]); w.y = cvt_pk_bf16(v0[2], v0[3]); w.z = cvt_pk_bf16(v1[0], v1[1]); w.w = cvt_pk_bf16(v1[2], v1[3]);
                    *(u32x4*)(O + off + bj * HALF) = w; } }
    }
};
struct EpiRes {
    static constexpr bool PERM = true, AFTER_DRAIN = false, EPI_LOADS = true;
    const float* X; bf16_t* Out; const float* gate; int ldc; const float* g2a; const float* g2b; bf16_t* XG; float* SSQ;
    __device__ __forceinline__ void operator()(const f32x4 (&acc)[2][2][4][2], const Unit& u, int wr, int wc, int fr, int fq) const {
        const int row0 = u.pm * BM + wr * 64 + fr, col0 = u.pn * BM + wc * 32 + 8 * fq;
        f32x4 gv[2][2], gp[2][2];
#pragma unroll
        for (int bj = 0; bj < 2; ++bj)
#pragma unroll
            for (int n = 0; n < 2; ++n) { gv[bj][n] = *(const f32x4*)(gate + col0 + bj * HALF + 4 * n);
                gp[bj][n] = *(const f32x4*)(g2a + col0 + bj * HALF + 4 * n) * (*(const f32x4*)(g2b + col0 + bj * HALF + 4 * n) + 1.0f); }
#pragma unroll
        for (int ai = 0; ai < 2; ++ai)
#pragma unroll
            for (int m = 0; m < 4; ++m) { const int row = row0 + ai * HALF + m * 16; const size_t off = (size_t)row * ldc + col0; float ss = 0.f;
#pragma unroll
                for (int bj = 0; bj < 2; ++bj) { const f32x4 xa = *(const f32x4*)(X + off + bj * HALF), xb = *(const f32x4*)(X + off + bj * HALF + 4);
                    const f32x4 y0 = xa + gv[bj][0] * acc[ai][bj][m][0], y1 = xb + gv[bj][1] * acc[ai][bj][m][1];
                    ss += ((y0[0] * y0[0] + y0[1] * y0[1]) + (y0[2] * y0[2] + y0[3] * y0[3])) + ((y1[0] * y1[0] + y1[1] * y1[1]) + (y1[2] * y1[2] + y1[3] * y1[3]));
                    u32x4 w; w.x = cvt_pk_bf16(y0[0], y0[1]); w.y = cvt_pk_bf16(y0[2], y0[3]); w.z = cvt_pk_bf16(y1[0], y1[1]); w.w = cvt_pk_bf16(y1[2], y1[3]); *(u32x4*)(Out + off + bj * HALF) = w;
                    const f32x4 g0 = y0 * gp[bj][0], g1 = y1 * gp[bj][1];
                    u32x4 wg; wg.x = cvt_pk_bf16(g0[0], g0[1]); wg.y = cvt_pk_bf16(g0[2], g0[3]); wg.z = cvt_pk_bf16(g1[0], g1[1]); wg.w = cvt_pk_bf16(g1[2], g1[3]); *(u32x4*)(XG + off + bj * HALF) = wg; }
                ss += __shfl_xor(ss, 16); ss += __shfl_xor(ss, 32);
                if (fq == 0) SSQ[(size_t)row * 64 + u.pn * 4 + wc] = ss; }
    }
};
struct EpiQ2 {
    static constexpr bool PERM = true, AFTER_DRAIN = false, EPI_LOADS = true;
    bf16_t* O; int ldc; const float* sb; const PG8_LAS float* rs; mutable int ne;
    __device__ __forceinline__ void operator()(const f32x4 (&acc)[2][2][4][2], const Unit& u, int wr, int wc, int fr, int fq) const {
        const int rl0 = wr * 64 + fr, row0 = u.pm * BM + rl0, col0 = u.pn * BM + wc * 32 + 8 * fq; const PG8_LAS float* rsp = rs + ((ne++) & 1) * 256;
        f32x4 bv[2][2];
#pragma unroll
        for (int bj = 0; bj < 2; ++bj)
#pragma unroll
            for (int n = 0; n < 2; ++n) bv[bj][n] = *(const f32x4*)(sb + col0 + bj * HALF + 4 * n);
#pragma unroll
        for (int ai = 0; ai < 2; ++ai)
#pragma unroll
            for (int m = 0; m < 4; ++m) { const float r = rsp[rl0 + ai * HALF + m * 16]; bf16_t* rowp = O + (size_t)(row0 + ai * HALF + m * 16) * ldc + col0;
#pragma unroll
                for (int bj = 0; bj < 2; ++bj) { const f32x4 v0 = acc[ai][bj][m][0] * r + bv[bj][0], v1 = acc[ai][bj][m][1] * r + bv[bj][1];
                    u32x4 w; w.x = cvt_pk_bf16(v0[0], v0[1]); w.y = cvt_pk_bf16(v0[2], v0[3]); w.z = cvt_pk_bf16(v1[0], v1[1]); w.w = cvt_pk_bf16(v1[2], v1[3]);
                    EPI_ST((u32x4*)(rowp + bj * HALF), w); } }
    }
};
struct RstdOrder : StaticOrder {
    const float* SSQ; PG8_LAS float* rs; float inv_n, eps; mutable int na;
    __device__ __forceinline__ void a_ready(const Unit& u) const {
        const int tid = threadIdx.x, r = tid >> 1, hf = tid & 1; const f32x4* p = (const f32x4*)(SSQ + (size_t)(u.pm * BM + r) * 64 + hf * 32); float s = 0.f;
#pragma unroll
        for (int k = 0; k < 8; ++k) { const f32x4 v = p[k]; s += (v[0] + v[1]) + (v[2] + v[3]); }
        s += __shfl_xor(s, 1);
        if (hf == 0) rs[(na & 1) * 256 + r] = 1.0f / sqrtf(s * inv_n + eps);
        ++na;
    }
};

struct EpiNullKeep {
    static constexpr bool PERM = true, AFTER_DRAIN = false, EPI_LOADS = false;
    float* sink;
    __device__ __forceinline__ void operator()(const f32x4 (&acc)[2][2][4][2], const Unit& u, int wr, int wc, int fr, int fq) const {
        f32x4 s = (f32x4){0.f, 0.f, 0.f, 0.f};
#pragma unroll
        for (int ai = 0; ai < 2; ++ai)
#pragma unroll
            for (int bj = 0; bj < 2; ++bj)
#pragma unroll
                for (int m = 0; m < 4; ++m) { s += acc[ai][bj][m][0]; s += acc[ai][bj][m][1]; }
        if (s[0] + s[1] + s[2] + s[3] == 1.2345e33f) sink[0] = 1.0f;
    }
};

#ifndef P2_MASKM
#define P2_MASKM 0xffff
#define P2_MASKN 0xffff
#endif
struct MaskOrder : StaticOrder {
    __host__ __device__ bool next(int i, Unit& u) const { const bool r = StaticOrder::next(i, u); u.pm &= P2_MASKM; u.pn &= P2_MASKN; return r; }
};

struct BalOrder : StaticOrder {
    bool on;
    __host__ __device__ bool next(int i, Unit& u) const { const bool r = StaticOrder::next(i, u);
        if (on) { const int p = u.pn / 36, k = u.pn % 36, ii = k >> 2, j = k & 3, idx = (ii >> 1) * 4 + j;
            u.pn = (p == 0) ? ((ii & 1) ? 36 + idx : idx) : ((ii & 1) ? 20 + idx : 52 + idx); }
        return r; }
};
template <class Epi, class Sched, bool ALIGN_EPI = false, bool SP2 = false, int DBG = 0, bool DUAL = false>
__device__ __forceinline__ void gemm_phase(PG8_LAS unsigned char* lds, const Gemm g, const Sched& S, const Epi& E) {
    const int tid = threadIdx.x, wid = __builtin_amdgcn_readfirstlane(tid >> 6), lane = tid & 63, wr = wid >> 2, wc = wid & 3, fr = lane & 15, fq = lane >> 4;
    const int K = g.K, nt = K / BK, LDA = g.lda ? g.lda : K, LDB = g.ldb ? g.ldb : K;
    unsigned voffA[2], voffB[2];
#pragma unroll
    for (int i = 0; i < 2; ++i) { int R, C; stage_rc(tid * 16 + i * 8192, R, C); const int Rb = Epi::PERM ? ((R & ~31) + perm32(R & 31)) : R;
        voffA[i] = (unsigned)(R * LDA + C) * 2u; voffB[i] = (unsigned)(Rb * LDB + C) * 2u; }
    const size_t kstep = (size_t)(BK * 2);
    const size_t hstepA = (size_t)HALF * LDA * 2, hstepB = (size_t)HALF * LDB * 2;
    const size_t tstepA = 2 * hstepA, tstepB = 2 * hstepB;
    const unsigned ldsw = (unsigned)wid * 1024u;
    const int aoff = lds_byte(wr * 64 + fr, fq * 8), boff = lds_byte(wc * 32 + fr, fq * 8);
#define PG8_SA(b, h) (((b) * 2 + (h)) * HTB)
#define PG8_SB(b, h) ((4 + (b) * 2 + (h)) * HTB)
#define PG8_STAGE(bufoff, gbase, voff) do { if constexpr (DBG != 1 && DBG != 3) _Pragma("unroll") for (int _i = 0; _i < 2; ++_i) \
        __builtin_amdgcn_global_load_lds((const unsigned*)((const char*)(gbase) + (voff)[_i]), (PG8_LAS unsigned*)(lds + (bufoff) + ldsw + _i * 8192), 16, 0, 0); } while (0)
#define PG8_LDA(dst, b, h) do { if constexpr (DBG < 2) _Pragma("unroll") for (int m = 0; m < 4; ++m) _Pragma("unroll") for (int k = 0; k < 2; ++k) dst[m][k] = *(const PG8_LAS bf16x8*)(lds + PG8_SA(b, h) + aoff + m * 2048 + k * 1024); } while (0)
#define PG8_LDB(dst, b, h) do { if constexpr (DBG < 2) _Pragma("unroll") for (int n = 0; n < 2; ++n) _Pragma("unroll") for (int k = 0; k < 2; ++k) dst[n][k] = *(const PG8_LAS bf16x8*)(lds + PG8_SB(b, h) + boff + n * 2048 + k * 1024); } while (0)
#define PG8_MMA(ai, bj, At, Bt) do { __builtin_amdgcn_s_setprio(PG8_PRIO_MMA); _Pragma("unroll") for (int m = 0; m < 4; ++m) _Pragma("unroll") for (int n = 0; n < 2; ++n) _Pragma("unroll") for (int k = 0; k < 2; ++k) \
        acc[ai][bj][m][n] = __builtin_amdgcn_mfma_f32_16x16x32_bf16(Bt[n][k], At[m][k], acc[ai][bj][m][n], 0, 0, 0); __builtin_amdgcn_s_setprio(PG8_PRIO_LD); } while (0)
#define PG8_MMAK(ai, bj, At, Bt, k) do { _Pragma("unroll") for (int m = 0; m < 4; ++m) _Pragma("unroll") for (int n = 0; n < 2; ++n) \
        acc[ai][bj][m][n] = __builtin_amdgcn_mfma_f32_16x16x32_bf16(Bt[n][k], At[m][k], acc[ai][bj][m][n], 0, 0, 0); } while (0)
#ifndef PG8_PRIO_MMA
#define PG8_PRIO_MMA 1
#define PG8_PRIO_LD 0
#endif
#ifndef PG8_NOMID
#define PG8_NOMID 0
#endif
#ifndef PG8_RELAX
#define PG8_RELAX 0
#endif
#ifndef PG8_EARLY
#define PG8_EARLY 0
#endif
#define PG8_MMA2(ai, At, B0, B1) do { if constexpr (PG8_EARLY) { PG8_BAR; __builtin_amdgcn_s_setprio(1); PG8_MMAK(ai, 0, At, B0, 0); PG8_MMAK(ai, 0, At, B0, 1); PG8_MMAK(ai, 1, At, B1, 0); PG8_SCHED; \
        PG8_BAR; PG8_SCHED; PG8_MMAK(ai, 1, At, B1, 1); __builtin_amdgcn_s_setprio(0); PG8_SCHED; } \
    else { PG8_BAR; PG8_MMA(ai, 0, At, B0); PG8_MMA(ai, 1, At, B1); PG8_BAR; PG8_SCHED; } } while (0)
#define PG8_WAIT_V(n) asm volatile("s_waitcnt vmcnt(" #n ")" ::: "memory")
#define PG8_WAIT_L(n) asm volatile("s_waitcnt lgkmcnt(" #n ")" ::: "memory")
#define PG8_BAR __builtin_amdgcn_s_barrier()
#define PG8_SCHED __builtin_amdgcn_sched_barrier(0)
    Unit cur, nxt; int ui = 0;
    if (!S.next(0, cur)) return;
    f32x4 acc[2][2][4][2];
#pragma unroll
    for (int a = 0; a < 2; ++a)
#pragma unroll
        for (int b = 0; b < 2; ++b)
#pragma unroll
            for (int m = 0; m < 4; ++m)
#pragma unroll
                for (int n = 0; n < 2; ++n) acc[a][b][m][n] = (f32x4){0.f, 0.f, 0.f, 0.f};
    bf16x8 At[4][2], B0[2][2], B1[2][2];
    if constexpr (DBG >= 2) { _Pragma("unroll") for (int m = 0; m < 4; ++m) _Pragma("unroll") for (int k = 0; k < 2; ++k) { At[m][k] = *(const PG8_LAS bf16x8*)(lds + aoff + m * 2048 + k * 1024); }
        _Pragma("unroll") for (int n = 0; n < 2; ++n) _Pragma("unroll") for (int k = 0; k < 2; ++k) { B0[n][k] = *(const PG8_LAS bf16x8*)(lds + boff + n * 2048 + k * 1024); B1[n][k] = *(const PG8_LAS bf16x8*)(lds + boff + 8192 + n * 2048 + k * 1024); } }
    const char* cA = (const char*)g.A + (size_t)cur.pm * tstepA; const char* cB = (const char*)g.Bt + (size_t)cur.pn * tstepB;
    const int ns = DUAL ? g.ksplit / BK : 0; const char* cA2 = DUAL ? (const char*)g.A2 + (size_t)cur.pm * tstepA : cA; const char* cB2 = DUAL ? (const char*)g.Bt2 + (size_t)cur.pn * tstepB : cB;
    S.a_ready(cur);
    if constexpr (SP2) {
        PG8_STAGE(PG8_SB(0, 0), cB, voffB); PG8_STAGE(PG8_SB(0, 1), cB + hstepB, voffB); PG8_STAGE(PG8_SA(0, 0), cA, voffA); PG8_STAGE(PG8_SA(0, 1), cA + hstepA, voffA);
        if (wr == 1) PG8_BAR;
        PG8_WAIT_V(2); PG8_BAR;
        PG8_STAGE(PG8_SB(1, 0), cB + kstep, voffB); PG8_STAGE(PG8_SA(1, 0), cA + kstep, voffA); PG8_STAGE(PG8_SB(1, 1), cB + hstepB + kstep, voffB);
        PG8_WAIT_V(6); PG8_BAR;
    } else {
        PG8_STAGE(PG8_SB(0, 0), cB, voffB); PG8_STAGE(PG8_SA(0, 0), cA, voffA); PG8_STAGE(PG8_SB(0, 1), cB + hstepB, voffB); PG8_STAGE(PG8_SA(0, 1), cA + hstepA, voffA);
        if (wr == 1) PG8_BAR;
        PG8_WAIT_V(4); PG8_BAR;
        PG8_STAGE(PG8_SB(1, 0), cB + kstep, voffB); PG8_STAGE(PG8_SA(1, 0), cA + kstep, voffA); PG8_STAGE(PG8_SB(1, 1), cB + hstepB + kstep, voffB);
        PG8_WAIT_V(6); PG8_BAR;
    }
    for (;;) {
        const bool has_next = S.next(ui + 1, nxt);
        const char* nA = has_next ? (const char*)g.A + (size_t)nxt.pm * tstepA : cA; const char* nB = has_next ? (const char*)g.Bt + (size_t)nxt.pn * tstepB : cB;
#pragma unroll 1
        for (int hf = 0; hf < (DUAL ? 2 : 1); ++hf) {
        const char* hA = (DUAL && hf) ? cA2 : cA; const char* hB = (DUAL && hf) ? cB2 : cB;
        const char* xA = (DUAL && !hf) ? cA2 : nA; const char* xB = (DUAL && !hf) ? cB2 : nB;
        const int ntl = DUAL ? (hf ? nt - ns : ns) : nt; const bool ulast = !DUAL || hf == 1;
        for (int t = 0; t < ntl; t += 2) {
            const bool last = (t == ntl - 2);
            const char* a1 = hA + (size_t)(t + 1) * kstep;
            const char* a2 = last ? xA : hA + (size_t)(t + 2) * kstep; const char* b2 = last ? xB : hB + (size_t)(t + 2) * kstep;
            const char* a3 = a2 + kstep; const char* b3 = b2 + kstep;
            if (last && ulast && has_next) S.a_ready(nxt);
            if constexpr (SP2) {
            const int relax_i = __builtin_amdgcn_readfirstlane((PG8_RELAX && Epi::EPI_LOADS && t == 0 && hf == 0 && ui > 0) ? 1 : 0);
#define PG8_WAIT_V0 asm volatile("s_cmp_lg_u32 %0, 0\n\ts_cbranch_scc1 1\n\ts_waitcnt vmcnt(8)" :: "s"(relax_i) : "memory", "scc")

#ifdef PG8_DMAFIRST
            PG8_STAGE(PG8_SA(1, 1), a1 + hstepA, voffA); PG8_SCHED; PG8_LDB(B0, 0, 0); PG8_LDB(B1, 0, 1); PG8_SCHED; PG8_LDA(At, 0, 0);
#else
            PG8_LDB(B0, 0, 0); PG8_LDB(B1, 0, 1); PG8_SCHED; PG8_LDA(At, 0, 0); PG8_STAGE(PG8_SA(1, 1), a1 + hstepA, voffA);
#endif

            PG8_WAIT_V0; PG8_WAIT_L(0); PG8_MMA2(0, At, B0, B1);

#ifdef PG8_DMAFIRST
            PG8_STAGE(PG8_SB(0, 0), b2, voffB); PG8_STAGE(PG8_SB(0, 1), b2 + hstepB, voffB); PG8_STAGE(PG8_SA(0, 0), a2, voffA); PG8_SCHED; PG8_LDA(At, 0, 1);
#else
            PG8_LDA(At, 0, 1); PG8_STAGE(PG8_SB(0, 0), b2, voffB); PG8_STAGE(PG8_SB(0, 1), b2 + hstepB, voffB); PG8_STAGE(PG8_SA(0, 0), a2, voffA);
#endif

            PG8_WAIT_V0; PG8_WAIT_L(0); PG8_MMA2(1, At, B0, B1);

#ifdef PG8_DMAFIRST
            PG8_STAGE(PG8_SA(0, 1), a2 + hstepA, voffA); PG8_SCHED; PG8_LDB(B0, 1, 0); PG8_LDB(B1, 1, 1); PG8_SCHED; PG8_LDA(At, 1, 0);
#else
            PG8_LDB(B0, 1, 0); PG8_LDB(B1, 1, 1); PG8_SCHED; PG8_LDA(At, 1, 0); PG8_STAGE(PG8_SA(0, 1), a2 + hstepA, voffA);
#endif

            PG8_WAIT_V(8); PG8_WAIT_L(0); PG8_MMA2(0, At, B0, B1);

#ifdef PG8_DMAFIRST
            PG8_STAGE(PG8_SB(1, 0), b3, voffB); PG8_STAGE(PG8_SB(1, 1), b3 + hstepB, voffB); PG8_STAGE(PG8_SA(1, 0), a3, voffA); PG8_SCHED; PG8_LDA(At, 1, 1);
#else
            PG8_LDA(At, 1, 1); PG8_STAGE(PG8_SB(1, 0), b3, voffB); PG8_STAGE(PG8_SB(1, 1), b3 + hstepB, voffB); PG8_STAGE(PG8_SA(1, 0), a3, voffA);
#endif

            PG8_WAIT_V(8); PG8_WAIT_L(0); PG8_MMA2(1, At, B0, B1);
            } else {
            PG8_LDB(B0, 0, 0); PG8_SCHED; PG8_LDA(At, 0, 0); PG8_STAGE(PG8_SA(1, 1), a1 + hstepA, voffA);
            PG8_WAIT_L(8); PG8_BAR; PG8_WAIT_L(0); PG8_MMA(0, 0, At, B0); PG8_BAR; PG8_SCHED;
            PG8_LDB(B1, 0, 1); PG8_STAGE(PG8_SB(0, 0), b2, voffB);
            PG8_BAR; PG8_WAIT_L(0); PG8_MMA(0, 1, At, B1); PG8_BAR;
            PG8_LDA(At, 0, 1); PG8_STAGE(PG8_SA(0, 0), a2, voffA);
            PG8_BAR; PG8_WAIT_L(0); PG8_MMA(1, 0, At, B0); PG8_BAR; PG8_SCHED;
            PG8_STAGE(PG8_SB(0, 1), b2 + hstepB, voffB);
            PG8_WAIT_V(6); PG8_BAR; PG8_MMA(1, 1, At, B1); PG8_BAR;
            PG8_LDB(B0, 1, 0); PG8_SCHED; PG8_LDA(At, 1, 0); PG8_STAGE(PG8_SA(0, 1), a2 + hstepA, voffA);
            PG8_WAIT_L(8); PG8_BAR; PG8_WAIT_L(0); PG8_MMA(0, 0, At, B0); PG8_BAR; PG8_SCHED;
            PG8_LDB(B1, 1, 1); PG8_STAGE(PG8_SB(1, 0), b3, voffB);
            PG8_BAR; PG8_WAIT_L(0); PG8_MMA(0, 1, At, B1); PG8_BAR;
            PG8_LDA(At, 1, 1); PG8_STAGE(PG8_SA(1, 0), a3, voffA);
            PG8_BAR; PG8_WAIT_L(0); PG8_MMA(1, 0, At, B0); PG8_BAR; PG8_SCHED;
            PG8_STAGE(PG8_SB(1, 1), b3 + hstepB, voffB);
            PG8_WAIT_V(6); PG8_BAR; PG8_MMA(1, 1, At, B1); PG8_BAR;
            }
        }
        if constexpr (DUAL) { if (hf == 0) { if (wr == 0) PG8_BAR; E.mid(acc, cur, wr, wc, fr, fq); if (wr == 1) PG8_BAR; } }
        }
        if constexpr (ALIGN_EPI) { if (wr == 0) PG8_BAR; }
        if constexpr (!Epi::AFTER_DRAIN) { E(acc, cur, wr, wc, fr, fq); S.done(cur); }
        if (!has_next) break;
#pragma unroll
        for (int a = 0; a < 2; ++a)
#pragma unroll
            for (int b = 0; b < 2; ++b)
#pragma unroll
                for (int m = 0; m < 4; ++m)
#pragma unroll
                    for (int n = 0; n < 2; ++n) acc[a][b][m][n] = (f32x4){0.f, 0.f, 0.f, 0.f};
        cur = nxt; cA = nA; cB = nB; ++ui;
        if constexpr (DUAL) { cA2 = (const char*)g.A2 + (size_t)cur.pm * tstepA; cB2 = (const char*)g.Bt2 + (size_t)cur.pn * tstepB; }
        if constexpr (ALIGN_EPI) { if (wr == 1) PG8_BAR; }
    }
    PG8_WAIT_V(0);
    if constexpr (!ALIGN_EPI) { if (wr == 0) PG8_BAR; }
    PG8_BAR;
    if constexpr (Epi::AFTER_DRAIN) { E.fused(acc, cur, wr, wc, fr, fq, lds, wid, lane); S.done(cur); }
#undef PG8_SA
#undef PG8_SB
#undef PG8_STAGE
#undef PG8_LDA
#undef PG8_LDB
#undef PG8_MMA
#undef PG8_MMAK
#undef PG8_MMA2
#undef PG8_WAIT_V
#undef PG8_WAIT_V0
#undef PG8_WAIT_L
#undef PG8_BAR
#undef PG8_SCHED
}
}
namespace attn_body {
constexpr int D = 128, LD = 2048;
constexpr float THR = 8.f; constexpr bool WSKIP = false;
constexpr float SCALE = 0.08838834764831845f;
constexpr int NW = 8, QBLK = 32, KVBLK = 64, QB = NW * QBLK;
constexpr int SHM_V = KVBLK * D * 2, SHM_K = KVBLK * D * 2;
constexpr int LDS_BYTES = 2 * SHM_V + 2 * SHM_K + NW * 64 * 4;

typedef short bf16x8 __attribute__((ext_vector_type(8)));
typedef short s16x4 __attribute__((ext_vector_type(4)));
typedef float f32x16 __attribute__((ext_vector_type(16)));
typedef float f32x4 __attribute__((ext_vector_type(4)));
typedef unsigned u32x4 __attribute__((ext_vector_type(4)));
template <class A, class Bt> struct same_t { static constexpr bool v = false; };
template <class A> struct same_t<A, A> { static constexpr bool v = true; };

#define KSWZ(row, colB) ((row) * 256 + ((colB) ^ (((row) & 7) << 4)))
#define SBAR() __builtin_amdgcn_sched_barrier(0)
__device__ __forceinline__ int v_st(int k, int c) { const int kk = (k & ~0xC) | ((k & 4) << 1) | ((k & 8) >> 1); return ((kk >> 3) * 4 + (c >> 5)) * 512 + ((kk & 7) * 32 + (c & 31)) * 2; }
__device__ __forceinline__ int v_rd_base(int lane) { return ((lane & 3) << 3) | (((lane >> 2) & 3) << 6) | (((lane >> 4) & 1) << 5) | (((lane >> 5) & 1) << 8); }
constexpr int v_rd_off(int d0, int ks, int half) { return d0 * 512 + ks * 4096 + half * 2048; }
__device__ __forceinline__ int crow(int r, int hi) { return (r & 3) + 8 * (r >> 2) + 4 * hi; }
__device__ __forceinline__ unsigned cvtpk(float lo, float hi) {
    unsigned r; asm volatile("v_cvt_pk_bf16_f32 %0, %1, %2" : "=v"(r) : "v"(lo), "v"(hi)); return r;
}
__device__ __forceinline__ bf16x8 pack8(f32x4 a, f32x4 b) {
    u32x4 w = {cvtpk(a[0], a[1]), cvtpk(a[2], a[3]), cvtpk(b[0], b[1]), cvtpk(b[2], b[3])};
    return *reinterpret_cast<bf16x8*>(&w);
}
template <class T> __device__ __forceinline__ bf16x8 load8(const T* p) {
    if constexpr (same_t<T, float>::v) { return pack8(*(const f32x4*)p, *(const f32x4*)(p + 4)); }
    else { return *reinterpret_cast<const bf16x8*>(p); }
}
__device__ __forceinline__ void mask_tile(f32x16& p0, f32x16& p1, int dq, unsigned W) {
    const float NEG = -__builtin_inff();
#pragma unroll
    for (int r = 0; r < 16; ++r) {
        const int c = (r & 3) + 8 * (r >> 2);
        if ((unsigned)(dq - c) >= W) p0[r] = NEG;
        if ((unsigned)(dq - c - 32) >= W) p1[r] = NEG;
    }
}
__device__ __forceinline__ void partialSM(f32x16& p0, f32x16& p1, float& m_reg, float& mn, float& alpha) {
    float pmax = p0[0]; for (int r = 1; r < 16; ++r) pmax = fmaxf(pmax, p0[r]); for (int r = 0; r < 16; ++r) pmax = fmaxf(pmax, p1[r]);
    { auto rr = __builtin_amdgcn_permlane32_swap(__float_as_uint(pmax), __float_as_uint(pmax), false, false);
      pmax = fmaxf(__uint_as_float(rr[0]), __uint_as_float(rr[1])); }
    constexpr float C2 = 1.4426950408889634f * SCALE;
    if (__builtin_expect(__all((pmax - m_reg) * SCALE <= THR), 1)) { mn = m_reg; alpha = 1.f; }
    else { mn = fmaxf(m_reg, pmax); alpha = __builtin_amdgcn_exp2f((m_reg - mn) * C2); m_reg = mn; }
    const float mnL = -mn * C2;
    for (int r = 0; r < 16; ++r) p0[r] = fmaf(p0[r], C2, mnL); for (int r = 0; r < 16; ++r) p1[r] = fmaf(p1[r], C2, mnL);
    for (int r = 0; r < 16; ++r) p0[r] = __builtin_amdgcn_exp2f(p0[r]);
}
__device__ __forceinline__ void finishSM(f32x16& p0, f32x16& p1, float alpha, float& l_reg, bf16x8& pa0, bf16x8& pa1, bf16x8& pa2, bf16x8& pa3) {
    for (int r = 0; r < 16; ++r) p1[r] = __builtin_amdgcn_exp2f(p1[r]);
    float ps = 0; for (int r = 0; r < 16; ++r) ps += p0[r]; for (int r = 0; r < 16; ++r) ps += p1[r];
    { auto rr = __builtin_amdgcn_permlane32_swap(__float_as_uint(ps), __float_as_uint(ps), false, false);
      ps = __uint_as_float(rr[0]) + __uint_as_float(rr[1]); }
    l_reg = l_reg * alpha + ps;
#define PK4(P, B_, OUT) do { unsigned a0 = cvtpk(P[B_+0], P[B_+1]), a1 = cvtpk(P[B_+2], P[B_+3]);                          \
        unsigned b0 = cvtpk(P[B_+4], P[B_+5]), b1 = cvtpk(P[B_+6], P[B_+7]);                                             \
        auto r0 = __builtin_amdgcn_permlane32_swap(a0, b0, false, false); auto r1 = __builtin_amdgcn_permlane32_swap(a1, b1, false, false); \
        u32x4 w = {r0[0], r1[0], r0[1], r1[1]}; OUT = *reinterpret_cast<bf16x8*>(&w); } while (0)
    PK4(p0, 0, pa0); PK4(p0, 8, pa1); PK4(p1, 0, pa2); PK4(p1, 8, pa3);
#undef PK4
}
template <int KB, bool SK>
__device__ __forceinline__ void qkt(f32x16& p0, f32x16& p1, const char* K_lds, int r32, int hi, const bf16x8* qr, bool act, const float* bt) {
    if (SK && !act) { const float NEG = -__builtin_inff();
#pragma unroll
        for (int r = 0; r < 16; ++r) { p0[r] = NEG; p1[r] = NEG; } return; }
    { const f32x4 b0 = *(const f32x4*)(bt), b1 = *(const f32x4*)(bt + 8), b2 = *(const f32x4*)(bt + 16), b3 = *(const f32x4*)(bt + 24);
      const f32x4 c0 = *(const f32x4*)(bt + 32), c1 = *(const f32x4*)(bt + 40), c2 = *(const f32x4*)(bt + 48), c3 = *(const f32x4*)(bt + 56);
      p0 = (f32x16){b0[0], b0[1], b0[2], b0[3], b1[0], b1[1], b1[2], b1[3], b2[0], b2[1], b2[2], b2[3], b3[0], b3[1], b3[2], b3[3]};
      p1 = (f32x16){c0[0], c0[1], c0[2], c0[3], c1[0], c1[1], c1[2], c1[3], c2[0], c2[1], c2[2], c2[3], c3[0], c3[1], c3[2], c3[3]}; }
    const char* kb[4];
#pragma unroll
    for (int dd = 0; dd < 4; ++dd) kb[dd] = K_lds + KB * SHM_K + KSWZ(r32, (dd * 16 + hi * 8) * 2);
#pragma unroll
    for (int d0 = 0; d0 < 8; ++d0) { const char* a = kb[d0 & 3] + (d0 >> 2) * 128;
        bf16x8 b0 = *reinterpret_cast<const bf16x8*>(a);
        bf16x8 b1 = *reinterpret_cast<const bf16x8*>(a + 32 * 256);
        p0 = __builtin_amdgcn_mfma_f32_32x32x16_bf16(b0, qr[d0], p0, 0, 0, 0);
        p1 = __builtin_amdgcn_mfma_f32_32x32x16_bf16(b1, qr[d0], p1, 0, 0, 0); }
}
template <int VB, bool SK>
__device__ __forceinline__ void pv_tile(f32x16* o, int vb0, bf16x8 pa0, bf16x8 pa1, bf16x8 pa2, bf16x8 pa3, bool act) {
    if (SK && !act) return;
#define TRRD(dst, off) asm volatile("ds_read_b64_tr_b16 %0, %1 offset:%2" : "=&v"(dst) : "v"(vb0), "i"(off) : "memory")
#define PV_D0(d0) do { s16x4 l0, l1, l2, l3, h0, h1, h2, h3; constexpr int b_ = VB * SHM_V + v_rd_off(d0, 0, 0);     \
        TRRD(l0, b_); TRRD(h0, b_ + 2048); TRRD(l1, b_ + 4096); TRRD(h1, b_ + 6144); TRRD(l2, b_ + 8192); TRRD(h2, b_ + 10240); TRRD(l3, b_ + 12288); TRRD(h3, b_ + 14336); \
        asm volatile("s_waitcnt lgkmcnt(0)" ::: "memory"); SBAR();                 \
        o[d0] = __builtin_amdgcn_mfma_f32_32x32x16_bf16(pa0, (bf16x8){l0[0], l0[1], l0[2], l0[3], h0[0], h0[1], h0[2], h0[3]}, o[d0], 0, 0, 0);   \
        o[d0] = __builtin_amdgcn_mfma_f32_32x32x16_bf16(pa1, (bf16x8){l1[0], l1[1], l1[2], l1[3], h1[0], h1[1], h1[2], h1[3]}, o[d0], 0, 0, 0);   \
        o[d0] = __builtin_amdgcn_mfma_f32_32x32x16_bf16(pa2, (bf16x8){l2[0], l2[1], l2[2], l2[3], h2[0], h2[1], h2[2], h2[3]}, o[d0], 0, 0, 0);   \
        o[d0] = __builtin_amdgcn_mfma_f32_32x32x16_bf16(pa3, (bf16x8){l3[0], l3[1], l3[2], l3[3], h3[0], h3[1], h3[2], h3[3]}, o[d0], 0, 0, 0); } while (0)
    PV_D0(0); PV_D0(1); PV_D0(2); PV_D0(3);
#undef PV_D0
#undef TRRD
}


template <class TIn, class TOut> struct BlockRef { const TIn* Q; const TIn* K; const TIn* V; TOut* O; int P0; int jlo; };
#define ROW(p, k0, rr) ((p) + (size_t)((k0) + (rr)) * LD + sc)
#define VMW() asm volatile("s_waitcnt vmcnt(0)" ::: "memory")
#define SLOAD_H(Kp, Vp, k0) do { st_v0 = load8<TIn>(ROW(Vp, k0, sr)); st_v1 = load8<TIn>(ROW(Vp, k0, 32 + sr));              \
                         st_k0 = load8<TIn>(ROW(Kp, k0, sr)); st_k1 = load8<TIn>(ROW(Kp, k0, 32 + sr)); } while (0)
#define SWRITE_H(bf) do { *(bf16x8*)(V_lds + (bf) * SHM_V + vst0) = st_v0; *(bf16x8*)(V_lds + (bf) * SHM_V + vst1) = st_v1;   \
                          *(bf16x8*)(K_lds + (bf) * SHM_K + kws) = st_k0; *(bf16x8*)(K_lds + (bf) * SHM_K + kws + 32 * 256) = st_k1; } while (0)
template <class TIn, class TOut>
__device__ __forceinline__ void attn_unit(const BlockRef<TIn, TOut>& cur, int skv, char* lds) {
    const int tid = threadIdx.x, wid = __builtin_amdgcn_readfirstlane(tid >> 6), lane = tid & 63, r32 = lane & 31, hi = lane >> 5;
    const unsigned W = 0x40000000u;
    const int j_lo = cur.jlo;
    int j_hi = (cur.P0 + QB - 1) / KVBLK + 1; if (j_hi > skv / KVBLK) j_hi = skv / KVBLK;
    const int NT = j_hi - j_lo;
    const int qlo = cur.P0 + wid * QBLK, qm = qlo + r32 - 4 * hi;
    char* V_lds = lds; char* K_lds = lds + 2 * SHM_V;
    float* ws = (float*)(lds + 2 * SHM_V + 2 * SHM_K) + wid * 64; float* li_l = ws, * al_l = ws + 32;
    const float* bias_l = (const float*)(lds + LDS_BYTES) + 4 * hi;
    float m_reg = -1e30f, l_reg = 0; f32x16 o[4] = {};
    const int sr = tid >> 4, sc = (tid & 15) * 8, vst0 = v_st(sr, sc), vst1 = v_st(32 + sr, sc), kws = KSWZ(sr, sc * 2);
    const int vb0 = (int)(uintptr_t)V_lds + v_rd_base(lane);
    const TIn* Kh = cur.K; const TIn* Vh = cur.V;
    bf16x8 st_v0, st_v1, st_k0, st_k1; bf16x8 qr[8];
#define KBASE(t) ((j_lo + (t)) * KVBLK)
#define BT(t) (bias_l + (t) * KVBLK)
#define RESC(a) do { if (__any((a) < 1.f)) { if (hi == 0) al_l[r32] = (a); asm volatile("s_waitcnt lgkmcnt(0)" ::: "memory");              \
                     for (int d_ = 0; d_ < 4; ++d_) for (int r = 0; r < 16; ++r) o[d_][r] *= al_l[crow(r, hi)]; } } while (0)
#define MASKT(P0_, P1_, t) do { const int kb_ = KBASE(t); if (kb_ + KVBLK - 1 > qlo) mask_tile(P0_, P1_, qm - kb_, W); } while (0)
#pragma unroll
    for (int d0 = 0; d0 < 8; ++d0) qr[d0] = load8<TIn>(cur.Q + (size_t)(wid * QBLK + r32) * LD + d0 * 16 + hi * 8);
    SLOAD_H(Kh, Vh, KBASE(0)); VMW(); SWRITE_H(0); SBAR();
    if (NT > 1) SLOAD_H(Kh, Vh, KBASE(1));
    __syncthreads();
    f32x16 p0, p1; float mn, al; bf16x8 pa0, pa1, pa2, pa3;
#define TILE_STEP(t, BUF) do {                                                                                                 \
        SBAR(); qkt<BUF, false>(p0, p1, K_lds, r32, hi, qr, true, BT(t));                                                       \
        MASKT(p0, p1, (t)); partialSM(p0, p1, m_reg, mn, al); RESC(al);                                                          \
        finishSM(p0, p1, al, l_reg, pa0, pa1, pa2, pa3); SBAR();                                                                 \
        pv_tile<BUF, false>(o, vb0, pa0, pa1, pa2, pa3, true);                                                                    \
        if ((t) + 1 < NT) { VMW(); SWRITE_H(1 - (BUF)); SBAR(); if ((t) + 2 < NT) SLOAD_H(Kh, Vh, KBASE((t) + 2)); }              \
        __syncthreads(); } while (0)
    for (int t = 0; t < NT; t += 2) {
        TILE_STEP(t, 0);
        if (t + 1 < NT) TILE_STEP(t + 1, 1);
    }
    if (hi == 0) li_l[r32] = l_reg; asm volatile("s_waitcnt lgkmcnt(0)" ::: "memory");
    float rli[16];
#pragma unroll
    for (int r = 0; r < 16; ++r) rli[r] = __builtin_amdgcn_rcpf(li_l[crow(r, hi)]);
    TOut* Ow = cur.O + (size_t)(wid * QBLK) * LD;
#pragma unroll
    for (int r = 0; r < 16; ++r) { const int orow = crow(r, hi);
#pragma unroll
        for (int d0 = 0; d0 < 4; ++d0) { const float v = o[d0][r] * rli[r];
            const float vn = __shfl_xor(v, 1);
            if ((r32 & 1) == 0) *(unsigned*)(Ow + (size_t)orow * LD + d0 * 32 + r32) = cvtpk(v, vn); } }
    __syncthreads();
#undef TILE_STEP
#undef RESC
#undef KBASE
#undef BT
#undef MASKT
}
#undef ROW
#undef VMW
#undef SLOAD_H
#undef SWRITE_H
}
#define GAS __attribute__((address_space(1)))
#define LAS __attribute__((address_space(3)))
typedef unsigned short bf16;
typedef unsigned v4u __attribute__((ext_vector_type(4)));
typedef unsigned v2u __attribute__((ext_vector_type(2)));
typedef float f32x4 __attribute__((ext_vector_type(4)));
typedef float f32x2 __attribute__((ext_vector_type(2)));
typedef short bf16x8 __attribute__((ext_vector_type(8)));
typedef GAS unsigned gu32;
#define RLX_AGENT __ATOMIC_RELAXED, __HIP_MEMORY_SCOPE_AGENT

constexpr int S = 8192, DM = 4096, NH = 16, HD = 128, AW = 2048, LW = 2048, NG = 16, GD = 128;
constexpr int NIN = 18448, NINP = 18432;
constexpr int C_Q = 0, C_K = 2048, C_V = 4096, C_F = 6144, C_LX = 6160, C_LY = 8208, C_GA = 10256, C_GL = 14352;
constexpr int PEER_H = 8, PEER_NK = 128, PEER_K = 16, PEER_NE = 16384;
constexpr float EPS = 1e-6f;
constexpr size_t MiB = 1u << 20;
constexpr size_t WS_CTL = 0, CTL_ZERO_BYTES = 32768;
constexpr size_t WS_MOD = 512 * 1024;
constexpr size_t WS_WF = 2 * MiB;
constexpr size_t WS_LOGF = 3 * MiB;
constexpr size_t WS_FC = 4 * MiB;
constexpr size_t WS_AGGA = 5 * MiB, WS_AGGB = 6 * MiB;
constexpr size_t WS_BIASR = 7 * MiB, WS_SB = 7 * MiB + 262144;
constexpr size_t WS_SSQ = 28 * MiB;
constexpr size_t WS_WAT = 8 * MiB, WS_WXT = 9 * MiB;
constexpr size_t WS_SK = 10 * MiB, WS_RS = 11 * MiB, WS_RSU = 11 * MiB + 65536;
constexpr size_t WS_IDX = 12 * MiB, WS_GATE = 16 * MiB, WS_IDX2 = 20 * MiB, WS_GATE2 = 24 * MiB;
constexpr size_t WS_WIN = 32 * MiB, WS_WAO = 176 * MiB, WS_WLO = 192 * MiB, WS_WOUT = 208 * MiB, WS_WPQ = 240 * MiB;
constexpr size_t WS_U = 256 * MiB, WS_V = 384 * MiB;
constexpr size_t WS_HA = 512 * MiB;
constexpr size_t WS_QKV = 576 * MiB;
constexpr size_t WS_LX = 672 * MiB, WS_GY = 704 * MiB, WS_GA = 736 * MiB, WS_GL = 800 * MiB;
constexpr size_t WS_ATT = 864 * MiB, WS_LR = 896 * MiB, WS_T1 = 928 * MiB, WS_MG = 992 * MiB, WS_Q2 = 1056 * MiB, WS_X1 = 1088 * MiB, WS_END = 1216 * MiB;
constexpr int CW_BAR = 4096;
constexpr int CW_QATT = 256;
constexpr int RING_BYTES = 131072;
constexpr int LDSCTL_OFF = 150528, MISC_OFF = LDSCTL_OFF + 320;
constexpr int LDS_BYTES = 151552;
constexpr int NWAVES = 8, NTHREADS = 512;

__device__ __forceinline__ unsigned f2bf(float f) { unsigned u = __builtin_bit_cast(unsigned, f); return (u + 0x7fffu + ((u >> 16) & 1u)) >> 16; }
__device__ __forceinline__ unsigned pk2(float lo, float hi) { return f2bf(lo) | (f2bf(hi) << 16); }
__device__ __forceinline__ float bflo(unsigned w) { return __uint_as_float(w << 16); }
__device__ __forceinline__ float bfhi(unsigned w) { return __uint_as_float(w & 0xffff0000u); }
__device__ __forceinline__ float bf2f(bf16 b) { return __uint_as_float((unsigned)b << 16); }
__device__ __forceinline__ float wave_sum(float v) {
#pragma unroll
    for (int o = 1; o < 64; o <<= 1) v += __shfl_xor(v, o);
    return v;
}
__device__ __forceinline__ float wave_max(float v) {
#pragma unroll
    for (int o = 1; o < 64; o <<= 1) v = fmaxf(v, __shfl_xor(v, o));
    return v;
}
__device__ __forceinline__ float sigmoidf_(float v) { return __builtin_amdgcn_rcpf(1.0f + __builtin_amdgcn_exp2f(-1.4426950408889634f * v)); }
__device__ __forceinline__ float gelu_erf(float v) { return 0.5f * v * (1.0f + erff(v * 0.70710678118654752f)); }
#define XB_TMO      128
#define XB_XCNT(j)  (256  + 64 * (j))
#define XB_XSUB(j)  (1280 + 64 * (j))
#define XB_XGEN(j)  (2304 + 64 * (j))
#define XB_TOP      3328
#define XB_TOPGEN   3392
#define XCD_BAR_WORDS 3456
#define XB_SPIN_CAP (1u << 18)

__device__ __forceinline__ unsigned xb_ld(unsigned* p)              { return __hip_atomic_load(p, __ATOMIC_RELAXED, __HIP_MEMORY_SCOPE_AGENT); }
__device__ __forceinline__ unsigned xb_add(unsigned* p, unsigned v) { return __hip_atomic_fetch_add(p, v, __ATOMIC_RELAXED, __HIP_MEMORY_SCOPE_AGENT); }
__device__ __forceinline__ unsigned xb_xcc_id() { return (unsigned)__builtin_amdgcn_s_getreg((3 << 11) | 20) & 0xFu; }
#define XB_SPIN(cond, bar) do { unsigned _sp = 0; while (cond) { __builtin_amdgcn_s_sleep(1); \
    if ((++_sp & 255u) == 0u) { if (xb_ld(&(bar)[XB_TMO])) break; if (_sp > XB_SPIN_CAP) { atomicAdd(&(bar)[XB_TMO], 1u); break; } } } } while (0)

struct XcdBarrier {
    unsigned* bar; unsigned x;
    volatile LAS unsigned* st;
};

__device__ __forceinline__ XcdBarrier xcd_barrier_post(unsigned* bar, volatile LAS unsigned* st) {
    XcdBarrier b; b.bar = bar; b.x = xb_xcc_id(); b.st = st;
    if (threadIdx.x == 0) (void)xb_add(&bar[XB_XCNT(b.x)], 1u);
    return b;
}
__device__ __forceinline__ void xcd_barrier_complete(unsigned* bar, unsigned x, unsigned& nloc, unsigned& nx) {
    const unsigned G = gridDim.x * gridDim.y * gridDim.z;
    unsigned sum, cnt, mine, sp = 0u;
    for (;;) {
        sum = 0u; cnt = 0u; mine = 0u;
#pragma unroll
        for (unsigned j = 0; j < 16; ++j) { const unsigned c = xb_ld(&bar[XB_XCNT(j)]); sum += c; cnt += (c > 0u) ? 1u : 0u; mine = (j == x) ? c : mine; }
        if (sum == G) break;
        __builtin_amdgcn_s_sleep(1);
        if ((++sp & 255u) == 0u) { if (xb_ld(&bar[XB_TMO])) break; if (sp > XB_SPIN_CAP) { atomicAdd(&bar[XB_TMO], 1u); break; } }
    }
    nloc = mine > 0u ? mine : 1u; nx = cnt > 0u ? cnt : 1u;
}

__device__ __forceinline__ void xcd_barrier(const XcdBarrier& b) {
    asm volatile("s_waitcnt vmcnt(0)" ::: "memory");
    __syncthreads();
    if (threadIdx.x == 0) {
        unsigned* bar = b.bar;
        __builtin_amdgcn_s_waitcnt(0);
        unsigned nloc = b.st[0], nx = b.st[1];
        if (nloc == 0u) { xcd_barrier_complete(bar, b.x, nloc, nx); b.st[0] = nloc; b.st[1] = nx; }
        const unsigned old = xb_add(&bar[XB_XSUB(b.x)], 1u);
        const unsigned gen = old / nloc;
        if (old + 1u == (gen + 1u) * nloc) {
            __builtin_amdgcn_fence(__ATOMIC_RELEASE, "agent");
            asm volatile("s_waitcnt vmcnt(0)" ::: "memory");
            const unsigned og = xb_add(&bar[XB_TOP], 1u);
            const unsigned tg = og / nx;
            if (og + 1u == (tg + 1u) * nx) xb_add(&bar[XB_TOPGEN], 1u);
            else XB_SPIN(xb_ld(&bar[XB_TOPGEN]) == tg, bar);
            __builtin_amdgcn_fence(__ATOMIC_ACQUIRE, "agent");
            xb_add(&bar[XB_XGEN(b.x)], 1u);
            asm volatile("s_waitcnt vmcnt(0)" ::: "memory");
        } else {
            XB_SPIN(xb_ld(&bar[XB_XGEN(b.x)]) == gen, bar);
            __builtin_amdgcn_fence(__ATOMIC_ACQUIRE, "agent");
            asm volatile("s_waitcnt vmcnt(0)" ::: "memory");
        }
    }
    __syncthreads();
}
struct Args { const float* in[24]; float* out; unsigned char* ws; int ph_lo, ph_hi, rep_att, rep_lru; };
struct Frame {
    LAS unsigned char* lds; volatile LAS unsigned* MISC; gu32* ctl;
    int tid, lane, wave, vcu, G;
    unsigned char* ws; float* out;
};
#define WSP(T, off) ((T*)(F.ws + (off)))
#define LDS_WAIT() asm volatile("s_waitcnt lgkmcnt(0)" ::: "memory")

struct TrItem { const float* W; bf16* WT; int ldw, K, k0, nsrc0, ndst0; };
__device__ __forceinline__ void tr_load(const TrItem& I, float (&v)[32], int lane) {
    const float* wp = I.W + (size_t)(I.k0 + (lane >> 5)) * I.ldw + I.nsrc0 + (lane & 31);
#pragma unroll
    for (int i = 0; i < 32; ++i) v[i] = wp[(size_t)(2 * i) * I.ldw];
}
__device__ __forceinline__ void tr_store(const TrItem& I, const float (&v)[32], LAS float* scr, int lane) {
#pragma unroll
    for (int i = 0; i < 32; ++i) scr[(2 * i + (lane >> 5)) * 33 + (lane & 31)] = v[i];
    LDS_WAIT(); asm volatile("" ::: "memory");
    const int c = lane & 7;
#pragma unroll
    for (int j = 0; j < 4; ++j) { const int n = (lane >> 3) + 8 * j; const LAS float* s = scr + (8 * c) * 33 + n;
        v4u o; o.x = pk2(s[0 * 33], s[1 * 33]); o.y = pk2(s[2 * 33], s[3 * 33]); o.z = pk2(s[4 * 33], s[5 * 33]); o.w = pk2(s[6 * 33], s[7 * 33]);
        *(GAS v4u*)(I.WT + (size_t)(I.ndst0 + n) * I.K + I.k0 + 8 * c) = o; }
    LDS_WAIT(); asm volatile("" ::: "memory");
}
__device__ __forceinline__ void cvt_stream(const float* src, bf16* dst, size_t n8, size_t i0, size_t stride) {
    for (size_t i = i0; i < n8; i += stride) { const f32x4 a = ((const GAS f32x4*)src)[2 * i], b = ((const GAS f32x4*)src)[2 * i + 1];
        v4u o; o.x = pk2(a[0], a[1]); o.y = pk2(a[2], a[3]); o.z = pk2(b[0], b[1]); o.w = pk2(b[2], b[3]); ((GAS v4u*)dst)[i] = o; }
}
__device__ __forceinline__ void cvt_stream_fp8(const float* src, unsigned char* dst, size_t n16, float scale, size_t i0, size_t stride) {
    for (size_t i = i0; i < n16; i += stride) { v4u o;
#pragma unroll
        for (int q = 0; q < 4; ++q) { const f32x4 a = ((const GAS f32x4*)src)[4 * i + q] * scale; int w = 0;
            w = __builtin_amdgcn_cvt_pk_fp8_f32(a[0], a[1], w, false); w = __builtin_amdgcn_cvt_pk_fp8_f32(a[2], a[3], w, true); o[q] = (unsigned)w; }
        ((GAS v4u*)dst)[i] = o; }
}
#ifndef SKEW_TR
#define SKEW_TR 1
#endif
#ifndef SKEW_TABLES
#define SKEW_TABLES 1
#endif
__device__ __forceinline__ void cvt_row_fp4(const f32x4 (&a)[16], float am, unsigned char* dstT, float* rsT, int row, int lane) {
    am = wave_max(am); const float inv = am > 0.f ? 6.0f / am : 0.f;
#pragma unroll
    for (int c = 0; c < 4; ++c) { v2u o;
#pragma unroll
        for (int d = 0; d < 2; ++d) { unsigned w = 0u; const f32x4 x0 = a[4 * c + 2 * d] * inv, x1 = a[4 * c + 2 * d + 1] * inv;
            w = __builtin_amdgcn_cvt_scalef32_pk_fp4_f32(w, x0[0], x0[1], 1.0f, 0); w = __builtin_amdgcn_cvt_scalef32_pk_fp4_f32(w, x0[2], x0[3], 1.0f, 1);
            w = __builtin_amdgcn_cvt_scalef32_pk_fp4_f32(w, x1[0], x1[1], 1.0f, 2); w = __builtin_amdgcn_cvt_scalef32_pk_fp4_f32(w, x1[2], x1[3], 1.0f, 3); o[d] = w; }
        *((GAS v2u*)(dstT + (size_t)row * 2048 + c * 512) + lane) = o; }
    if (lane == 0) rsT[row] = am * (1.0f / 6.0f);
}
__device__ __forceinline__ void cvt_table_fp4(Frame& F, const float* srcT, unsigned char* dstT, float* rsT, int gw, int NGW) {
#pragma unroll 1
    for (int row = gw; row < PEER_NE; row += 2 * NGW) { const int row2 = row + NGW; const bool two = row2 < PEER_NE;
        const GAS f32x4* src = (const GAS f32x4*)(srcT + (size_t)row * DM); const GAS f32x4* src2 = (const GAS f32x4*)(srcT + (size_t)(two ? row2 : row) * DM); f32x4 a[16], b[16]; float am = 0.f, bm = 0.f;
#pragma unroll
        for (int c = 0; c < 4; ++c)
#pragma unroll
            for (int q = 0; q < 4; ++q) a[4 * c + q] = src[c * 256 + 4 * F.lane + q];
#pragma unroll
        for (int c = 0; c < 4; ++c)
#pragma unroll
            for (int q = 0; q < 4; ++q) b[4 * c + q] = src2[c * 256 + 4 * F.lane + q];
#pragma unroll
        for (int k = 0; k < 16; ++k) am = fmaxf(fmaxf(am, fmaxf(fabsf(a[k][0]), fabsf(a[k][1]))), fmaxf(fabsf(a[k][2]), fabsf(a[k][3])));
        cvt_row_fp4(a, am, dstT, rsT, row, F.lane);
#pragma unroll
        for (int k = 0; k < 16; ++k) bm = fmaxf(fmaxf(bm, fmaxf(fabsf(b[k][0]), fabsf(b[k][1]))), fmaxf(fabsf(b[k][2]), fabsf(b[k][3])));
        if (two) cvt_row_fp4(b, bm, dstT, rsT, row2, F.lane);
    }
}
constexpr int I_IN = 64 * 576, I_AO = 32 * 128, I_LO = 32 * 128, I_OUT = 64 * 128, I_PQ = 64 * 64, I_WA = 16 * 2 * 4, I_WX = I_WA;
constexpr int NITEMS = I_IN + I_AO + I_LO + I_OUT + I_PQ + I_WA + I_WX;
constexpr int TR_LATE_LO = I_IN, TR_LATE_HI = I_IN + I_AO + I_LO + I_OUT;
__device__ __forceinline__ TrItem tr_decode(const Args& args, unsigned char* ws_, int r) { TrItem I;
#define WSQ(T, off) ((T*)(ws_ + (off)))
    if (r < I_IN) { const int kb = r / 576, nb = r % 576; I = TrItem{args.in[6], WSQ(bf16, WS_WIN), NIN, DM, 64 * kb, 32 * nb + (nb >= 192 ? 16 : 0), 32 * nb}; return I; } r -= I_IN;
    if (r < I_AO) { const int kb = r / 128, nb = r % 128; I = TrItem{args.in[17], WSQ(bf16, WS_WAO), DM, AW, 64 * kb, 32 * nb, 32 * nb}; return I; } r -= I_AO;
    if (r < I_LO) { const int kb = r / 128, nb = r % 128; I = TrItem{args.in[18], WSQ(bf16, WS_WLO), DM, LW, 64 * kb, 32 * nb, 32 * nb}; return I; } r -= I_LO;
    if (r < I_OUT) { const int kb = r / 128, nb = r % 128; I = TrItem{args.in[19], WSQ(bf16, WS_WOUT), DM, DM, 64 * kb, 32 * nb, 32 * nb}; return I; } r -= I_OUT;
    if (r < I_PQ) { const int kb = r / 64, nb = r % 64; I = TrItem{args.in[20], WSQ(bf16, WS_WPQ), 2048, DM, 64 * kb, 32 * nb, 32 * nb}; return I; } r -= I_PQ;
    { const bool isx = r >= I_WA; if (isx) r -= I_WA; const int g = r >> 3, kb = (r >> 2) & 1, nb = r & 3;
      I = TrItem{(isx ? args.in[14] : args.in[12]) + (size_t)g * GD * GD, WSQ(bf16, isx ? WS_WXT : WS_WAT) + (size_t)g * GD * GD, GD, GD, 64 * kb, 32 * nb, 32 * nb}; return I; }
#undef WSQ
}
__device__ __forceinline__ void tr_run(Frame& F, const Args& args, int lo, int hi) {
    LAS float* scr = (LAS float*)(F.lds + F.wave * 16384);
    const int gw = F.vcu * NWAVES + F.wave, NGW = F.G * NWAVES;
    if (lo + gw < hi) {
        float va[32], vb[32], vc[32]; TrItem Ia = tr_decode(args, F.ws, lo + gw), Ib = Ia; tr_load(Ia, va, F.lane);
        if (lo + gw + NGW < hi) { Ib = tr_decode(args, F.ws, lo + gw + NGW); tr_load(Ib, vb, F.lane); }
#pragma unroll 1
        for (int it = lo + gw; it < hi; it += NGW) {
            const int nx = it + 2 * NGW; TrItem Ic = Ib;
            if (nx < hi) { Ic = tr_decode(args, F.ws, nx); tr_load(Ic, vc, F.lane); }
            tr_store(Ia, va, scr, F.lane);
#pragma unroll
            for (int i = 0; i < 32; ++i) { va[i] = vb[i]; vb[i] = vc[i]; }
            Ia = Ib; Ib = Ic;
        }
    }
}
__device__ __forceinline__ void p0_prologue(Frame& F, const Args& args) {
#ifndef P0_REP
#define P0_REP 0
#endif
    _Pragma("unroll") for (int rep_ = 0; rep_ < ((P0_REP & 1) ? 2 : 1); ++rep_)
    { LAS float* sc = (LAS float*)F.lds; LAS f32x4* red = (LAS f32x4*)(F.lds + 16384); float* MOD = WSP(float, WS_MOD);
      for (int cgi = blockIdx.x; cgi < 256; cgi += F.G) {
          for (int i = F.tid; i < DM; i += NTHREADS) { const float cv = args.in[1][i]; sc[i] = cv / (1.0f + __expf(-cv)); }
          __syncthreads();
          if (F.tid < 384) { const int cg = F.tid % 24, rg = F.tid / 24;
              const GAS f32x4* Wp = (const GAS f32x4*)args.in[2] + cgi * 24 + cg;
              f32x4 acc = {0.f, 0.f, 0.f, 0.f};
#pragma unroll 8
              for (int r = rg; r < DM; r += 16) acc += sc[r] * Wp[(size_t)r * 6144];
              red[rg * 24 + cg] = acc; }
          __syncthreads();
          if (F.tid < 24) { f32x4 s = red[F.tid];
#pragma unroll
              for (int rg = 1; rg < 16; ++rg) s += red[rg * 24 + F.tid];
              s += ((const GAS f32x4*)args.in[3])[cgi * 24 + F.tid]; ((GAS f32x4*)MOD)[cgi * 24 + F.tid] = s; }
          __syncthreads();
      } }
    const int gw = F.vcu * NWAVES + F.wave, NGW = F.G * NWAVES; (void)gw; (void)NGW;
    _Pragma("unroll") for (int rep_ = 0; rep_ < ((P0_REP & 2) ? 2 : 1); ++rep_) {
#if SKEW_TABLES && SKEW_TR
        tr_run(F, args, 0, TR_LATE_LO); tr_run(F, args, TR_LATE_HI, NITEMS);
#else
        tr_run(F, args, 0, NITEMS);
#endif
    }
    const size_t gt = (size_t)F.vcu * NTHREADS + F.tid, NGT = (size_t)F.G * NTHREADS;
#if !SKEW_TABLES
    _Pragma("unroll") for (int rep_ = 0; rep_ < ((P0_REP & 4) ? 2 : 1); ++rep_) {
    cvt_table_fp4(F, args.in[23], WSP(unsigned char, WS_V), WSP(float, WS_RS), gw, NGW);
    cvt_table_fp4(F, args.in[22], WSP(unsigned char, WS_U), WSP(float, WS_RSU), gw, NGW); }
#endif
    cvt_stream(args.in[21], WSP(bf16, WS_SK), (size_t)PEER_H * 2 * 128 * 128 / 8, gt, NGT);
    for (size_t i = gt; i < (size_t)DM * 16; i += NGT) WSP(float, WS_WF)[(i & 15) * DM + (i >> 4)] = args.in[6][(i >> 4) * NIN + C_F + (i & 15)];
    for (size_t i = gt; i < (size_t)NINP; i += NGT) WSP(float, WS_BIASR)[i] = args.in[7][i + (i >= (size_t)C_F ? 16 : 0)];
}

__device__ __forceinline__ void p1_norm_forget(Frame& F, const Args& args) {
    const float* MOD = WSP(float, WS_MOD); const float* WFT = WSP(float, WS_WF); bf16* HA = WSP(bf16, WS_HA);
    LAS f32x4* MUL4 = (LAS f32x4*)F.lds; LAS f32x4* SH4 = (LAS f32x4*)(F.lds + 16384); LAS float* RS = (LAS float*)(F.lds + 32768); LAS float* PART = (LAS float*)(F.lds + 33280);
    for (int i4 = F.tid; i4 < DM / 4; i4 += NTHREADS) { MUL4[i4] = ((const GAS f32x4*)args.in[4])[i4] * (((const GAS f32x4*)(MOD + 4096))[i4] + 1.0f); SH4[i4] = ((const GAS f32x4*)MOD)[i4]; }
    __syncthreads();
    const int fr = F.lane & 15, fq = F.lane >> 4;
    const unsigned lo16 = (unsigned)F.lane * 16u, lof = (unsigned)(fr * DM + fq * 8) * 4u, loh = (unsigned)(fr * DM + fq * 8) * 2u;
#pragma unroll 1
    for (int step = blockIdx.x; step < S / 32; step += F.G) {
        const int r0 = step * 32;
        { const char* xb0 = (const char*)(args.in[0] + (size_t)(r0 + F.wave * 4) * DM);
#pragma unroll 1
          for (int rp = 0; rp < 2; ++rp) { f32x4 xa[2][16];
#pragma unroll
            for (int q = 0; q < 2; ++q)
#pragma unroll
                for (int j = 0; j < 16; ++j) xa[q][j] = *(const GAS f32x4*)(xb0 + (size_t)(2 * rp + q) * (DM * 4) + 1024 * j + lo16);
#pragma unroll
            for (int q = 0; q < 2; ++q) { float ss = 0.f;
#pragma unroll
                for (int j = 0; j < 16; ++j) ss += (xa[q][j][0] * xa[q][j][0] + xa[q][j][1] * xa[q][j][1]) + (xa[q][j][2] * xa[q][j][2] + xa[q][j][3] * xa[q][j][3]);
                const float rsv = 1.0f / sqrtf(wave_sum(ss) * (1.0f / DM) + EPS); if (F.lane == 0) RS[F.wave * 4 + 2 * rp + q] = rsv; } } }
        __syncthreads();
        const float rs0 = RS[fr], rs1 = RS[16 + fr];
        const char* xk = (const char*)(args.in[0] + (size_t)r0 * DM) + F.wave * 2048; const char* wk = (const char*)WFT + F.wave * 2048; char* hk = (char*)(HA + (size_t)r0 * DM) + F.wave * 1024;
        f32x4 acc0 = (f32x4){0.f, 0.f, 0.f, 0.f}, acc1 = acc0;
        f32x4 nx[4], nw[2];
        nx[0] = *(const GAS f32x4*)(xk + lof); nx[1] = *(const GAS f32x4*)(xk + lof + 16); nx[2] = *(const GAS f32x4*)(xk + 16 * DM * 4 + lof); nx[3] = *(const GAS f32x4*)(xk + 16 * DM * 4 + lof + 16);
        nw[0] = *(const GAS f32x4*)(wk + lof); nw[1] = *(const GAS f32x4*)(wk + lof + 16);
#pragma unroll 1
        for (int ks = 0; ks < 16; ++ks) {
            f32x4 cx[4], cw[2];
#pragma unroll
            for (int q = 0; q < 4; ++q) cx[q] = nx[q];
            cw[0] = nw[0]; cw[1] = nw[1];
            { const int kn = ((ks + 1) & 15) * 128; const char* xn_ = xk + kn; const char* wn_ = wk + kn;
              nx[0] = *(const GAS f32x4*)(xn_ + lof); nx[1] = *(const GAS f32x4*)(xn_ + lof + 16); nx[2] = *(const GAS f32x4*)(xn_ + 16 * DM * 4 + lof); nx[3] = *(const GAS f32x4*)(xn_ + 16 * DM * 4 + lof + 16);
              nw[0] = *(const GAS f32x4*)(wn_ + lof); nw[1] = *(const GAS f32x4*)(wn_ + lof + 16); }
            const int c4 = F.wave * 128 + ks * 8 + fq * 2;
            const f32x4 m0 = MUL4[c4], m1 = MUL4[c4 + 1], s0 = SH4[c4], s1 = SH4[c4 + 1];
            const f32x4 ha0 = cx[0] * rs0 * m0 + s0, ha1 = cx[1] * rs0 * m1 + s1, hb0 = cx[2] * rs1 * m0 + s0, hb1 = cx[3] * rs1 * m1 + s1;
            v4u ahi, alo, bhi, blo, whi, wlo;
#define P1_SPLIT(hi_, lo_, v0_, v1_) do { hi_.x = pg8::cvt_pk_bf16(v0_[0], v0_[1]); hi_.y = pg8::cvt_pk_bf16(v0_[2], v0_[3]); hi_.z = pg8::cvt_pk_bf16(v1_[0], v1_[1]); hi_.w = pg8::cvt_pk_bf16(v1_[2], v1_[3]); \
            lo_.x = pg8::cvt_pk_bf16(v0_[0] - bflo(hi_.x), v0_[1] - bfhi(hi_.x)); lo_.y = pg8::cvt_pk_bf16(v0_[2] - bflo(hi_.y), v0_[3] - bfhi(hi_.y)); \
            lo_.z = pg8::cvt_pk_bf16(v1_[0] - bflo(hi_.z), v1_[1] - bfhi(hi_.z)); lo_.w = pg8::cvt_pk_bf16(v1_[2] - bflo(hi_.w), v1_[3] - bfhi(hi_.w)); } while (0)
            P1_SPLIT(ahi, alo, ha0, ha1); P1_SPLIT(bhi, blo, hb0, hb1); P1_SPLIT(whi, wlo, cw[0], cw[1]);
#undef P1_SPLIT
            *(GAS v4u*)(hk + ks * 64 + loh) = ahi; *(GAS v4u*)(hk + 16 * DM * 2 + ks * 64 + loh) = bhi;
            const bf16x8 Ah = __builtin_bit_cast(bf16x8, ahi), Al = __builtin_bit_cast(bf16x8, alo), Bh = __builtin_bit_cast(bf16x8, bhi), Bl = __builtin_bit_cast(bf16x8, blo), Wh = __builtin_bit_cast(bf16x8, whi), Wl = __builtin_bit_cast(bf16x8, wlo);
            acc0 = __builtin_amdgcn_mfma_f32_16x16x32_bf16(Ah, Wh, acc0, 0, 0, 0); acc1 = __builtin_amdgcn_mfma_f32_16x16x32_bf16(Bh, Wh, acc1, 0, 0, 0);
            acc0 = __builtin_amdgcn_mfma_f32_16x16x32_bf16(Ah, Wl, acc0, 0, 0, 0); acc1 = __builtin_amdgcn_mfma_f32_16x16x32_bf16(Bh, Wl, acc1, 0, 0, 0);
            acc0 = __builtin_amdgcn_mfma_f32_16x16x32_bf16(Al, Wh, acc0, 0, 0, 0); acc1 = __builtin_amdgcn_mfma_f32_16x16x32_bf16(Bl, Wh, acc1, 0, 0, 0);
        }
#pragma unroll
        for (int r = 0; r < 4; ++r) { PART[(F.wave * 32 + 4 * fq + r) * 16 + fr] = acc0[r]; PART[(F.wave * 32 + 16 + 4 * fq + r) * 16 + fr] = acc1[r]; }
        __syncthreads();
        { const int head = F.tid >> 5, row = F.tid & 31; float s = 0.f;
#pragma unroll
          for (int w = 0; w < 8; ++w) s += PART[(w * 32 + row) * 16 + head];
          const float f = s + args.in[7][C_F + head]; WSP(float, WS_LOGF)[(size_t)head * S + r0 + row] = fminf(f, 0.f) - log1pf(__expf(-fabsf(f))); }
        __syncthreads();
    }
}
__device__ __forceinline__ void p1_shift_proj(Frame& F, const Args& args) {
    const int gw = F.vcu * NWAVES + F.wave, NGW = F.G * NWAVES; const float* sh2 = WSP(float, WS_MOD) + 12288; const bf16* WT = WSP(bf16, WS_WPQ);
    for (int col = gw; col < 2048; col += NGW) { float s = 0.f;
#pragma unroll
        for (int c = 0; c < 8; ++c) { const v4u w = *((const GAS v4u*)(WT + (size_t)col * DM + c * 512) + F.lane); const GAS f32x4* sp = (const GAS f32x4*)(sh2 + c * 512 + F.lane * 8); const f32x4 a = sp[0], b = sp[1];
            s += (bflo(w.x) * a[0] + bfhi(w.x) * a[1]) + (bflo(w.y) * a[2] + bfhi(w.y) * a[3]) + (bflo(w.z) * b[0] + bfhi(w.z) * b[1]) + (bflo(w.w) * b[2] + bfhi(w.w) * b[3]); }
        s = wave_sum(s); if (F.lane == 0) WSP(float, WS_SB)[col] = s; }
}

#ifndef QKN_PIECES
#define QKN_PIECES 4
#endif
__device__ __forceinline__ void p3_qknorm(Frame& F, const Args& args) {
    const int gw = F.vcu * NWAVES + F.wave, NGW = F.G * NWAVES; bf16* QK = WSP(bf16, WS_QKV);
    const int sub = F.lane & 15;
    f32x4 gq0 = ((const GAS f32x4*)args.in[8])[2 * sub], gq1 = ((const GAS f32x4*)args.in[8])[2 * sub + 1], gk0 = ((const GAS f32x4*)args.in[9])[2 * sub], gk1 = ((const GAS f32x4*)args.in[9])[2 * sub + 1];
    for (int it0 = gw; it0 < 2 * S * NH / 4; it0 += QKN_PIECES * NGW) {
        v4u w[QKN_PIECES]; GAS v4u* pp[QKN_PIECES];
#pragma unroll
        for (int k = 0; k < QKN_PIECES; ++k) { const int it = it0 + k * NGW; const size_t unit = (size_t)(it < 2 * S * NH / 4 ? it : it0) * 4 + (F.lane >> 4); pp[k] = (GAS v4u*)(QK + unit * 128) + sub; w[k] = *pp[k]; }
#pragma unroll
        for (int k = 0; k < QKN_PIECES; ++k) { const int it = it0 + k * NGW; const size_t unit = (size_t)(it < 2 * S * NH / 4 ? it : it0) * 4 + (F.lane >> 4); const bool isk = unit >= (size_t)S * NH;
            f32x4 a = {bflo(w[k].x), bfhi(w[k].x), bflo(w[k].y), bfhi(w[k].y)}, b = {bflo(w[k].z), bfhi(w[k].z), bflo(w[k].w), bfhi(w[k].w)};
            float ss = (a[0] * a[0] + a[1] * a[1]) + (a[2] * a[2] + a[3] * a[3]) + (b[0] * b[0] + b[1] * b[1]) + (b[2] * b[2] + b[3] * b[3]);
            ss += __shfl_xor(ss, 1); ss += __shfl_xor(ss, 2); ss += __shfl_xor(ss, 4); ss += __shfl_xor(ss, 8);
            const float rs = 1.0f / sqrtf(ss * (1.0f / HD) + EPS);
            a = a * rs * (isk ? gk0 : gq0); b = b * rs * (isk ? gk1 : gq1);
            v4u o; o.x = pk2(a[0], a[1]); o.y = pk2(a[2], a[3]); o.z = pk2(b[0], b[1]); o.w = pk2(b[2], b[3]);
            if (it < 2 * S * NH / 4) *pp[k] = o; }
    }
}
__device__ __forceinline__ void p3_cumsum(Frame& F, const Args& args) {
    LAS float* wt = (LAS float*)F.lds;
    for (int h = blockIdx.x; h < NH; h += F.G) {
        const float* LF = WSP(float, WS_LOGF); float v[16]; float run = 0.f;
        { const GAS f32x4* lp = (const GAS f32x4*)(LF + (size_t)h * S + F.tid * 16); const f32x4 l0 = lp[0], l1 = lp[1], l2 = lp[2], l3 = lp[3];
          const float lv[16] = {l0[0], l0[1], l0[2], l0[3], l1[0], l1[1], l1[2], l1[3], l2[0], l2[1], l2[2], l2[3], l3[0], l3[1], l3[2], l3[3]};
#pragma unroll
          for (int i = 0; i < 16; ++i) { run += lv[i]; v[i] = run; } }
        float sc = run;
#pragma unroll
        for (int o = 1; o < 64; o <<= 1) { const float t = __shfl_up(sc, o); if (F.lane >= o) sc += t; }
        if (F.lane == 63) wt[F.wave] = sc;
        __syncthreads();
        float pre = sc - run;
        for (int w = 0; w < F.wave; ++w) pre += wt[w];
        float* Fo = WSP(float, WS_FC) + (size_t)h * S + F.tid * 16;
#pragma unroll
        for (int i = 0; i < 4; ++i) ((GAS f32x4*)Fo)[i] = (f32x4){v[4 * i] + pre, v[4 * i + 1] + pre, v[4 * i + 2] + pre, v[4 * i + 3] + pre};
        __syncthreads();
    }
}
#ifndef LRU_STORE_AB
#define LRU_STORE_AB 1
#endif
constexpr int LRU_XCF = 0, LRU_XCB = 32768, LRU_AB = 49152, LRU_BB = 81920, LRU_QA = 114688, LRU_CAR = 118784, LRU_XR = 133120;
struct LruConst { float w0, w1, w2, w3, cb, bav, bxv, sp8; };
template <int PASS> __device__ __forceinline__ void lru_chunk(Frame& F, const Args& args, int c, int g, v4u (&raw)[3], const bf16x8 (&ba)[4], const bf16x8 (&bx)[4], bool more, const LruConst& K) {
    LAS float* XCF = (LAS float*)(F.lds + LRU_XCF); LAS unsigned char* XCB = F.lds + LRU_XCB; LAS float* AB = (LAS float*)(F.lds + LRU_AB); LAS float* BB = (LAS float*)(F.lds + LRU_BB);
    LAS float* QA = (LAS float*)(F.lds + LRU_QA); LAS float* CAR = (LAS float*)(F.lds + LRU_CAR); LAS bf16* XR = (LAS bf16*)(F.lds + LRU_XR);
    const int t0 = 64 * c, ch0 = GD * g; const bf16* LX = WSP(bf16, WS_LX);
#pragma unroll
    for (int k = 0; k < 3; ++k) { const int p = F.tid + k * NTHREADS; if (p < 67 * 16) *(LAS v4u*)(XR + (p >> 4) * 128 + (p & 15) * 8) = raw[k]; }
    if (more) {
#pragma unroll
        for (int k = 0; k < 3; ++k) { const int p = F.tid + k * NTHREADS; const int r = p >> 4, cc = p & 15, tg = t0 + 64 - 3 + r; raw[k] = (v4u){0u, 0u, 0u, 0u};
            if (p < 67 * 16 && tg >= 0) raw[k] = *(const GAS v4u*)(LX + (size_t)tg * LW + ch0 + cc * 8); } }
    v4u gyv[2];
    if (PASS == 1) {
#pragma unroll
        for (int k = 0; k < 2; ++k) { const int p = F.tid + k * NTHREADS; gyv[k] = *(const GAS v4u*)(WSP(bf16, WS_GY) + (size_t)(t0 + (p >> 4)) * LW + ch0 + (p & 15) * 8); } }
    __syncthreads();
    { const int ch = F.tid & 127, tq = F.tid >> 7, gch = ch0 + ch;
      const float w0 = K.w0, w1 = K.w1, w2 = K.w2, w3 = K.w3, cb = K.cb; (void)gch;
      float xm3 = bf2f(XR[(16 * tq + 0) * 128 + ch]), xm2 = bf2f(XR[(16 * tq + 1) * 128 + ch]), xm1 = bf2f(XR[(16 * tq + 2) * 128 + ch]);
#pragma unroll
      for (int i = 0; i < 16; ++i) { const int t = 16 * tq + i; const float x0 = bf2f(XR[(t + 3) * 128 + ch]);
          const float xc = w0 * xm3 + w1 * xm2 + w2 * xm1 + w3 * x0 + cb; xm3 = xm2; xm2 = xm1; xm1 = x0;
          XCF[t * 128 + ch] = xc; *(LAS bf16*)(XCB + t * 256 + ((ch * 2) ^ ((t & 7) << 4))) = (bf16)f2bf(xc); } }
    __syncthreads();
    { const int fr = F.lane & 15, fq = F.lane >> 4, j = 16 * F.wave + fr;
      const float bav = K.bav, bxv = K.bxv, sp8 = K.sp8;
#pragma unroll
      for (int mt = 0; mt < 4; ++mt) { f32x4 ar = {0.f, 0.f, 0.f, 0.f}, ax = {0.f, 0.f, 0.f, 0.f}; const int t = 16 * mt + fr;
#pragma unroll
          for (int ks = 0; ks < 4; ++ks) { const bf16x8 af = *(const LAS bf16x8*)(XCB + t * 256 + (((32 * ks + 8 * fq) * 2) ^ ((t & 7) << 4)));
              ar = __builtin_amdgcn_mfma_f32_16x16x32_bf16(af, ba[ks], ar, 0, 0, 0); ax = __builtin_amdgcn_mfma_f32_16x16x32_bf16(af, bx[ks], ax, 0, 0, 0); }
#pragma unroll
          for (int rg = 0; rg < 4; ++rg) { const int tt = 16 * mt + 4 * fq + rg; const float xcv = XCF[tt * 128 + j];
              const float rgt = sigmoidf_(ar[rg] + bav), igt = sigmoidf_(ax[rg] + bxv);
              const float a = __builtin_amdgcn_exp2f(rgt * sp8); const float om = fmaxf((1.0f - a) * (1.0f + a), 0.f);
              const float b = __builtin_amdgcn_sqrtf(om) * (igt * xcv);
              AB[tt * 128 + j] = a; BB[tt * 128 + j] = LRU_STORE_AB ? bflo(pg8::cvt_pk_bf16(b, 0.f)) : b; } } }
    __syncthreads();
    if (LRU_STORE_AB && PASS == 0) {
        float* GA2 = WSP(float, WS_T1); bf16* GB2 = WSP(bf16, WS_MG);
#pragma unroll
        for (int k = 0; k < 4; ++k) { const int p = F.tid + k * NTHREADS, r = p >> 5, c4 = p & 31; *(GAS f32x4*)(GA2 + (size_t)(t0 + r) * LW + ch0 + c4 * 4) = *(const LAS f32x4*)(AB + r * 128 + c4 * 4); }
#pragma unroll
        for (int k = 0; k < 2; ++k) { const int p = F.tid + k * NTHREADS, r = p >> 4, cc = p & 15; const f32x4 b0 = *(const LAS f32x4*)(BB + r * 128 + cc * 8), b1 = *(const LAS f32x4*)(BB + r * 128 + cc * 8 + 4);
            v4u o; o.x = pg8::cvt_pk_bf16(b0[0], b0[1]); o.y = pg8::cvt_pk_bf16(b0[2], b0[3]); o.z = pg8::cvt_pk_bf16(b1[0], b1[1]); o.w = pg8::cvt_pk_bf16(b1[2], b1[3]);
            *(GAS v4u*)(GB2 + (size_t)(t0 + r) * LW + ch0 + cc * 8) = o; }
    }
    const int ch = F.tid & 127, q = F.tid >> 7;
    { float A = 1.f, B = 0.f;
#pragma unroll
      for (int i = 0; i < 16; ++i) { const int t = 16 * q + i; const float a = AB[t * 128 + ch]; B = a * B + BB[t * 128 + ch]; A *= a; }
      QA[(q * 128 + ch) * 2] = A; QA[(q * 128 + ch) * 2 + 1] = B; }
    __syncthreads();
    if (PASS == 0) {
        if (F.tid < 128) { float A = 1.f, B = 0.f;
#pragma unroll
            for (int qq = 0; qq < 4; ++qq) { const float a = QA[(qq * 128 + F.tid) * 2], b = QA[(qq * 128 + F.tid) * 2 + 1]; B = a * B + b; A *= a; }
            WSP(float, WS_AGGA)[(size_t)c * LW + ch0 + F.tid] = A; WSP(float, WS_AGGB)[(size_t)c * LW + ch0 + F.tid] = B; }
    } else {
        float h = CAR[ch];
        for (int qq = 0; qq < q; ++qq) h = QA[(qq * 128 + ch) * 2] * h + QA[(qq * 128 + ch) * 2 + 1];
#pragma unroll
        for (int i = 0; i < 16; ++i) { const int t = 16 * q + i; h = AB[t * 128 + ch] * h + BB[t * 128 + ch]; XCF[t * 128 + ch] = h; }
        __syncthreads();
        if (F.tid < 128) { float hc = CAR[F.tid];
#pragma unroll
            for (int qq = 0; qq < 4; ++qq) hc = QA[(qq * 128 + F.tid) * 2] * hc + QA[(qq * 128 + F.tid) * 2 + 1];
            CAR[F.tid] = hc; }
        bf16* LR = WSP(bf16, WS_LR);
#pragma unroll
        for (int k = 0; k < 2; ++k) { const int p = F.tid + k * NTHREADS; const int r = p >> 4, cc = p & 15; const size_t o = (size_t)(t0 + r) * LW + ch0 + cc * 8;
            const v4u gy = gyv[k]; const f32x4 h0 = *(const LAS f32x4*)(XCF + r * 128 + cc * 8), h1 = *(const LAS f32x4*)(XCF + r * 128 + cc * 8 + 4);
            v4u ov; ov.x = pk2(h0[0] * bflo(gy.x), h0[1] * bfhi(gy.x)); ov.y = pk2(h0[2] * bflo(gy.y), h0[3] * bfhi(gy.y)); ov.z = pk2(h1[0] * bflo(gy.z), h1[1] * bfhi(gy.z)); ov.w = pk2(h1[2] * bflo(gy.w), h1[3] * bfhi(gy.w));
            *(GAS v4u*)(LR + o) = ov; }
    }
    __syncthreads();
}
__device__ __forceinline__ void lru_item1_ab(Frame& F, const Args& args, int w) {
    const int g = w & 15, c0 = (w >> 4) * 8, ch0 = GD * g; LAS float* CAR = (LAS float*)(F.lds + LRU_CAR); LAS float* QA = (LAS float*)(F.lds + LRU_QA);
    LAS float* XCF = (LAS float*)(F.lds + LRU_XCF); LAS float* AB = (LAS float*)(F.lds + LRU_AB); LAS float* BB = (LAS float*)(F.lds + LRU_BB);
    const float* GA2 = WSP(float, WS_T1); const bf16* GB2 = WSP(bf16, WS_MG); const bf16* GY = WSP(bf16, WS_GY); bf16* LR = WSP(bf16, WS_LR);
    f32x4 pa[4]; v4u pb[2], pg[2];
#define LRU1_LOAD(c_) do { const int t0_ = 64 * (c_); \
        _Pragma("unroll") for (int k = 0; k < 4; ++k) { const int p = F.tid + k * NTHREADS, r = p >> 5, c4 = p & 31; pa[k] = *(const GAS f32x4*)(GA2 + (size_t)(t0_ + r) * LW + ch0 + c4 * 4); } \
        _Pragma("unroll") for (int k = 0; k < 2; ++k) { const int p = F.tid + k * NTHREADS, r = p >> 4, cc = p & 15; const size_t o = (size_t)(t0_ + r) * LW + ch0 + cc * 8; pb[k] = *(const GAS v4u*)(GB2 + o); pg[k] = *(const GAS v4u*)(GY + o); } } while (0)
    LRU1_LOAD(c0);
    { const int ch = F.tid & 127, q = F.tid >> 7, n = c0 / 4;
      const float* GA_ = WSP(float, WS_AGGA) + GD * g + ch; const float* GB_ = WSP(float, WS_AGGB) + GD * g + ch; float A = 1.f, B = 0.f;
      float av[30], bv[30];
#pragma unroll
      for (int i = 0; i < 30; ++i) { const bool ok = i < n; const size_t o = (size_t)(ok ? q * n + i : 0) * LW; const float a_ = GA_[o], b_ = GB_[o]; av[i] = ok ? a_ : 1.f; bv[i] = ok ? b_ : 0.f; }
#pragma unroll
      for (int i = 0; i < 30; ++i) { B = av[i] * B + bv[i]; A *= av[i]; }
      QA[(q * 128 + ch) * 2] = A; QA[(q * 128 + ch) * 2 + 1] = B;
      __syncthreads();
      if (F.tid < 128) { float hc = 0.f;
#pragma unroll
          for (int qq = 0; qq < 4; ++qq) hc = QA[(qq * 128 + F.tid) * 2] * hc + QA[(qq * 128 + F.tid) * 2 + 1];
          CAR[F.tid] = hc; }
      __syncthreads(); }
#pragma unroll 1
    for (int c = c0; c < c0 + 8; ++c) { const int t0 = 64 * c;
        v4u gyv[2];
#pragma unroll
        for (int k = 0; k < 4; ++k) { const int p = F.tid + k * NTHREADS, r = p >> 5, c4 = p & 31; *(LAS f32x4*)(AB + r * 128 + c4 * 4) = pa[k]; }
#pragma unroll
        for (int k = 0; k < 2; ++k) { const int p = F.tid + k * NTHREADS, r = p >> 4, cc = p & 15; gyv[k] = pg[k];
            *(LAS f32x4*)(BB + r * 128 + cc * 8) = (f32x4){bflo(pb[k].x), bfhi(pb[k].x), bflo(pb[k].y), bfhi(pb[k].y)}; *(LAS f32x4*)(BB + r * 128 + cc * 8 + 4) = (f32x4){bflo(pb[k].z), bfhi(pb[k].z), bflo(pb[k].w), bfhi(pb[k].w)}; }
        if (c + 1 < c0 + 8) LRU1_LOAD(c + 1);
        __syncthreads();
        const int ch = F.tid & 127, q = F.tid >> 7;
        { float A = 1.f, B = 0.f;
#pragma unroll
          for (int i = 0; i < 16; ++i) { const int t = 16 * q + i; const float a = AB[t * 128 + ch]; B = a * B + BB[t * 128 + ch]; A *= a; }
          QA[(q * 128 + ch) * 2] = A; QA[(q * 128 + ch) * 2 + 1] = B; }
        __syncthreads();
        float h = CAR[ch];
        for (int qq = 0; qq < q; ++qq) h = QA[(qq * 128 + ch) * 2] * h + QA[(qq * 128 + ch) * 2 + 1];
#pragma unroll
        for (int i = 0; i < 16; ++i) { const int t = 16 * q + i; h = AB[t * 128 + ch] * h + BB[t * 128 + ch]; XCF[t * 128 + ch] = h; }
        __syncthreads();
        if (F.tid < 128) { float hc = CAR[F.tid];
#pragma unroll
            for (int qq = 0; qq < 4; ++qq) hc = QA[(qq * 128 + F.tid) * 2] * hc + QA[(qq * 128 + F.tid) * 2 + 1];
            CAR[F.tid] = hc; }
#pragma unroll
        for (int k = 0; k < 2; ++k) { const int p = F.tid + k * NTHREADS; const int r = p >> 4, cc = p & 15; const size_t o = (size_t)(t0 + r) * LW + ch0 + cc * 8;
            const v4u gy = gyv[k]; const f32x4 h0 = *(const LAS f32x4*)(XCF + r * 128 + cc * 8), h1 = *(const LAS f32x4*)(XCF + r * 128 + cc * 8 + 4);
            v4u ov; ov.x = pk2(h0[0] * bflo(gy.x), h0[1] * bfhi(gy.x)); ov.y = pk2(h0[2] * bflo(gy.y), h0[3] * bfhi(gy.y)); ov.z = pk2(h1[0] * bflo(gy.z), h1[1] * bfhi(gy.z)); ov.w = pk2(h1[2] * bflo(gy.w), h1[3] * bfhi(gy.w));
            *(GAS v4u*)(LR + o) = ov; }
        __syncthreads();
    }
#undef LRU1_LOAD
}
template <int PASS> __device__ __forceinline__ void lru_item(Frame& F, const Args& args, int w) {
    const int g = w & 15, c0 = (w >> 4) * 8; LAS float* CAR = (LAS float*)(F.lds + LRU_CAR); LAS float* QA = (LAS float*)(F.lds + LRU_QA);
    if (PASS == 1) {
        const int ch = F.tid & 127, q = F.tid >> 7, n = c0 / 4;
        const float* GA_ = WSP(float, WS_AGGA) + GD * g + ch; const float* GB_ = WSP(float, WS_AGGB) + GD * g + ch; float A = 1.f, B = 0.f;
        float av[30], bv[30];
#pragma unroll
        for (int i = 0; i < 30; ++i) { const bool ok = i < n; const size_t o = (size_t)(ok ? q * n + i : 0) * LW; const float a_ = GA_[o], b_ = GB_[o]; av[i] = ok ? a_ : 1.f; bv[i] = ok ? b_ : 0.f; }
#pragma unroll
        for (int i = 0; i < 30; ++i) { B = av[i] * B + bv[i]; A *= av[i]; }
        QA[(q * 128 + ch) * 2] = A; QA[(q * 128 + ch) * 2 + 1] = B;
        __syncthreads();
        if (F.tid < 128) { float hc = 0.f;
#pragma unroll
            for (int qq = 0; qq < 4; ++qq) hc = QA[(qq * 128 + F.tid) * 2] * hc + QA[(qq * 128 + F.tid) * 2 + 1];
            CAR[F.tid] = hc; }
        __syncthreads();
    }
    bf16x8 ba[4], bx[4];
    { const int fr = F.lane & 15, fq = F.lane >> 4, j = 16 * F.wave + fr;
      const bf16* WA = WSP(bf16, WS_WAT) + (size_t)g * GD * GD + (size_t)j * GD + 8 * fq; const bf16* WX = WSP(bf16, WS_WXT) + (size_t)g * GD * GD + (size_t)j * GD + 8 * fq;
#pragma unroll
      for (int ks = 0; ks < 4; ++ks) { ba[ks] = *(const GAS bf16x8*)(WA + 32 * ks); bx[ks] = *(const GAS bf16x8*)(WX + 32 * ks); } }
    v4u raw[3];
    { const bf16* LX = WSP(bf16, WS_LX); const int t0 = 64 * c0, ch0 = GD * g;
#pragma unroll
      for (int k = 0; k < 3; ++k) { const int p = F.tid + k * NTHREADS; const int r = p >> 4, cc = p & 15, tg = t0 - 3 + r; raw[k] = (v4u){0u, 0u, 0u, 0u};
          if (p < 67 * 16 && tg >= 0) raw[k] = *(const GAS v4u*)(LX + (size_t)tg * LW + ch0 + cc * 8); } }
    LruConst K;
    { const int gch = GD * g + (F.tid & 127); K.w0 = args.in[10][gch]; K.w1 = args.in[10][LW + gch]; K.w2 = args.in[10][2 * LW + gch]; K.w3 = args.in[10][3 * LW + gch]; K.cb = args.in[11][gch];
      const int gcj = GD * g + 16 * F.wave + (F.lane & 15); K.bav = args.in[13][gcj]; K.bxv = args.in[15][gcj]; const float lam = args.in[16][gcj];
      K.sp8 = -8.0f * 1.4426950408889634f * ((lam > 0.f ? 0.f : -lam) + log1pf(__expf(-fabsf(lam)))); }
#pragma unroll 1
    for (int c = c0; c < c0 + 8; ++c) lru_chunk<PASS>(F, args, c, g, raw, ba, bx, c + 1 < c0 + 8, K);
}
constexpr int ATT_BIAS_OFF = attn_body::LDS_BYTES;
typedef attn_body::BlockRef<bf16, bf16> ARef;
__device__ __forceinline__ int attn_jlo(const float* Fh, int qb, float TH, int lane) {
    const int t0 = qb * 256; const float f0 = Fh[t0];
    const int j0 = lane, j1 = lane + 64;
    const bool ok0 = (64 * j0 + 63 >= t0) || (f0 - Fh[64 * j0 + 63] >= -TH), ok1 = (64 * j1 + 63 >= t0) || (f0 - Fh[64 * j1 + 63] >= -TH);
    const unsigned long long m0 = __ballot(ok0), m1 = __ballot(ok1);
    return m0 ? (int)__builtin_ctzll(m0) : 64 + (int)__builtin_ctzll(m1);
}
__device__ __forceinline__ ARef attn_ref(Frame& F, const Args& args, int h, int qb, int jlo) {
    ARef r; const bf16* QK = WSP(bf16, WS_QKV);
    r.Q = QK + (size_t)(qb * 256) * AW + h * HD; r.K = QK + (size_t)S * AW + h * HD; r.V = QK + 2 * (size_t)S * AW + h * HD;
    r.O = WSP(bf16, WS_ATT) + (size_t)(qb * 256) * AW + h * HD; r.P0 = qb * 256; r.jlo = jlo; return r;
}
__device__ __forceinline__ void attn_fill_bias(Frame& F, const Args& args, int h, int qb, int jlo) {
    const float* Fh = WSP(float, WS_FC) + (size_t)h * S; LAS float* bl = (LAS float*)(F.lds + ATT_BIAS_OFF);
    const int k0 = jlo * 64, n = (qb + 1) * 256 - k0; const float fr = Fh[k0];
#pragma unroll 1
    for (int i = F.tid; i < n; i += NTHREADS) bl[i] = (fr - Fh[k0 + i]) * (1.0f / attn_body::SCALE);
}
#ifndef ATT_MARGIN
#define ATT_MARGIN 18.0f
#endif
constexpr int ATT_SCHED_OFF = 104448;
__device__ __forceinline__ void p4_attention(Frame& F, const Args& args, char* lds_generic, int rep) {
    float gq = fmaxf(fabsf(args.in[8][F.lane]), fabsf(args.in[8][F.lane + 64])), gk = fmaxf(fabsf(args.in[9][F.lane]), fabsf(args.in[9][F.lane + 64]));
    gq = wave_max(gq); gk = wave_max(gk);
    const float TH = 2.0f * (128.0f * gq * gk * attn_body::SCALE) + ATT_MARGIN;
    LAS float* Fend = (LAS float*)(F.lds + ATT_SCHED_OFF); LAS int* cost = (LAS int*)(F.lds + ATT_SCHED_OFF + 8192); LAS int* jlo_t = cost + 512; LAS int* order = cost + 1024; LAS int* slot = cost + 1536;
    const float* Fc = WSP(float, WS_FC);
    for (int p = F.tid; p < NH * 128; p += NTHREADS) Fend[p] = Fc[(size_t)(p >> 7) * S + 64 * (p & 127) + 63];
    __syncthreads();
    { const int u = F.tid, h = u >> 5, qb = u & 31, t0 = qb * 256; const float f0 = Fc[(size_t)h * S + t0];
      int lo = 0, hi = 4 * qb;
      while (lo < hi) { const int mid = (lo + hi) >> 1; const bool ok = (64 * mid + 63 >= t0) || (f0 - Fend[h * 128 + mid] >= -TH); if (ok) hi = mid; else lo = mid + 1; }
      jlo_t[u] = lo; cost[u] = 4 * (qb + 1) - lo; }
    __syncthreads();
    { const int u = F.tid, cu = cost[u]; int rk = 0;
      for (int v = 0; v < 512; ++v) { const int cv = cost[v]; rk += (cv > cu || (cv == cu && v < u)) ? 1 : 0; }
      order[rk] = u; }
    __syncthreads();
    for (;;) {
        if (F.tid == 0) slot[0] = (int)__hip_atomic_fetch_add((unsigned*)(F.ctl + CW_QATT + 64 * rep), 1u, RLX_AGENT);
        __syncthreads();
        const int k = slot[0];
        __syncthreads();
        if (k >= 512) break;
        const int u = order[k], h = u >> 5, qb = u & 31, jl = jlo_t[u];
        const ARef r0 = attn_ref(F, args, h, qb, jl);
        attn_fill_bias(F, args, h, qb, jl); __syncthreads();
        attn_body::attn_unit<bf16, bf16>(r0, S, lds_generic);
    }
}

__device__ __forceinline__ void p7_norm2(Frame& F, const Args& args) {
    const int gw = F.vcu * NWAVES + F.wave, NGW = F.G * NWAVES; const float* MOD = WSP(float, WS_MOD); bf16* HA = WSP(bf16, WS_HA);
    for (int m = gw; m < S; m += NGW) {
        const GAS f32x4* xr = (const GAS f32x4*)(WSP(float, WS_X1) + (size_t)m * DM) + F.lane; f32x4 v[16]; float ss = 0.f;
#pragma unroll
        for (int j = 0; j < 16; ++j) { v[j] = xr[64 * j]; ss += (v[j][0] * v[j][0] + v[j][1] * v[j][1]) + (v[j][2] * v[j][2] + v[j][3] * v[j][3]); }
        const float rstd = 1.0f / sqrtf(wave_sum(ss) * (1.0f / DM) + EPS);
#pragma unroll
        for (int j = 0; j < 16; ++j) { const int i4 = F.lane + 64 * j;
            const f32x4 g = ((const GAS f32x4*)args.in[5])[i4], scl = ((const GAS f32x4*)(MOD + 16384))[i4], sh = ((const GAS f32x4*)(MOD + 12288))[i4];
            const f32x4 hv = v[j] * rstd * (g * (scl + 1.0f)) + sh;
            v2u o; o.x = pk2(hv[0], hv[1]); o.y = pk2(hv[2], hv[3]); ((GAS v2u*)(HA + (size_t)m * DM))[i4] = o; }
    }
}

template <int CTRL> __device__ __forceinline__ unsigned dppu(unsigned x) { return (unsigned)__builtin_amdgcn_update_dpp(0, (int)x, CTRL, 0xF, 0xF, true); }
__device__ __forceinline__ unsigned rowmax_u32(unsigned x) { x = max(x, dppu<0xB1>(x)); x = max(x, dppu<0x4E>(x)); x = max(x, dppu<0x141>(x)); x = max(x, dppu<0x140>(x)); return x; }
__device__ __forceinline__ float rowsum_f32(float x) { x += __uint_as_float(dppu<0xB1>(__float_as_uint(x))); x += __uint_as_float(dppu<0x4E>(__float_as_uint(x)));
    x += __uint_as_float(dppu<0x141>(__float_as_uint(x))); x += __uint_as_float(dppu<0x140>(__float_as_uint(x))); return x; }
__device__ __forceinline__ unsigned ordk(float f) { const unsigned u = __float_as_uint(f); return u ^ ((unsigned)((int)u >> 31) | 0x80000000u); }
__device__ __forceinline__ float deck(unsigned k) { return __uint_as_float((k & 0x80000000u) ? (k ^ 0x80000000u) : ~k); }
#define CE_(x, y) do { const unsigned hi_ = max(x, y), lo_ = min(x, y); x = hi_; y = lo_; } while (0)
__device__ __forceinline__ unsigned row_pop16(unsigned (&a)[8], int i) {
    unsigned res = 0u;
#pragma unroll
    for (int r = 0; r < 16; ++r) { const unsigned m = rowmax_u32(a[0]); const bool win = a[0] == m;
#pragma unroll
        for (int s = 0; s < 7; ++s) a[s] = win ? a[s + 1] : a[s];
        a[7] = win ? 0u : a[7]; res = (i == r) ? m : res; }
    return res;
}
__device__ __forceinline__ void p9_topk(Frame& F, const Args& args, int own_pm, int own_pn) {
    const bf16* Q2 = WSP(bf16, WS_Q2); const bf16* SK = WSP(bf16, WS_SK); int* IDX = WSP(int, WS_IDX); float* GATE = WSP(float, WS_GATE);
    const int i = F.lane & 15, q = F.lane >> 4;
    const unsigned qlo = (unsigned)(i * 2048 + 8 * q) * 2u;
    const int h = own_pm >= 0 ? own_pn : ((int)blockIdx.x & 7), ib = (int)blockIdx.x >> 3, nbh = ((int)F.G - h + 7) >> 3;
    const int tg_0 = own_pm >= 0 ? own_pm * 16 + F.wave : ib * NWAVES + F.wave, tg_step = own_pm >= 0 ? NWAVES : nbh * NWAVES, tg_end = own_pm >= 0 ? own_pm * 16 + 16 : S / 16;
    for (int c = F.tid; c < 4096; c += NTHREADS) { const int pp = c >> 11, n = (c >> 4) & 127, ch = c & 15;
        *(LAS v4u*)(F.lds + pp * 32768 + n * 256 + ((ch * 16) ^ ((n & 7) << 4))) = *(const GAS v4u*)(SK + ((size_t)((h * 2 + pp) * 128 + n)) * 128 + ch * 8); }
    __syncthreads();
#pragma unroll 1
    for (int tg = tg_0; tg < tg_end; tg += tg_step) {
        const int t0 = 16 * tg;
        unsigned R[2][4];
        bf16x8 af[2][4];
#pragma unroll
        for (int p = 0; p < 2; ++p) { const char* qb_ = (const char*)Q2 + ((size_t)t0 * 2048 + h * 256 + p * 128) * 2;
#pragma unroll
            for (int ks = 0; ks < 4; ++ks) af[p][ks] = *(const GAS bf16x8*)(qb_ + 64 * ks + qlo); }
#pragma unroll
        for (int p = 0; p < 2; ++p) {
            f32x4 acc[8];
#pragma unroll
            for (int nt = 0; nt < 8; ++nt) { acc[nt] = (f32x4){0.f, 0.f, 0.f, 0.f}; const int n = 16 * nt + i;
#pragma unroll
                for (int ks = 0; ks < 4; ++ks) { const bf16x8 b = *(const LAS bf16x8*)(F.lds + p * 32768 + n * 256 + ((64 * ks + 16 * q) ^ ((n & 7) << 4)));
                    acc[nt] = __builtin_amdgcn_mfma_f32_16x16x32_bf16(af[p][ks], b, acc[nt], 0, 0, 0); } }
#pragma unroll
            for (int r = 0; r < 4; ++r) { unsigned a[8];
#pragma unroll
                for (int nt = 0; nt < 8; ++nt) a[nt] = (ordk(acc[nt][r]) & ~0x7Fu) | (unsigned)(16 * nt + i);
                CE_(a[0], a[1]); CE_(a[2], a[3]); CE_(a[4], a[5]); CE_(a[6], a[7]); CE_(a[0], a[2]); CE_(a[1], a[3]); CE_(a[4], a[6]); CE_(a[5], a[7]); CE_(a[1], a[2]); CE_(a[5], a[6]);
                CE_(a[0], a[4]); CE_(a[1], a[5]); CE_(a[2], a[6]); CE_(a[3], a[7]); CE_(a[2], a[4]); CE_(a[3], a[5]); CE_(a[1], a[2]); CE_(a[3], a[4]); CE_(a[5], a[6]);
                R[p][r] = row_pop16(a, i); __builtin_amdgcn_sched_barrier(0); }
        }
#pragma unroll
        for (int r = 0; r < 4; ++r) {
            const unsigned R0 = R[0][r], R1 = R[1][r]; const float f0 = deck(R0 & ~0x7Fu), f1 = deck(R1 & ~0x7Fu); const int n0 = (int)(R0 & 0x7Fu), n1 = (int)(R1 & 0x7Fu);
            const unsigned f1u = __float_as_uint(f1); unsigned c[8];
#define CAND_(b, lim) do { const unsigned t_ = (ordk(f0 + __uint_as_float(dppu<0x150 + (b)>(f1u))) & ~0xFFu) | (unsigned)(255 - (i * 16 + (b))); c[b] = (i < (lim)) ? t_ : 0u; } while (0)
            CAND_(0, 16); CAND_(1, 8); CAND_(2, 5); CAND_(3, 4); CAND_(4, 3); CAND_(5, 2); CAND_(6, 2); CAND_(7, 2);
#undef CAND_
            { const float ex = __uint_as_float(dppu<0x150>(__float_as_uint(f0))) + f1; const unsigned exk = (ordk(ex) & ~0xFFu) | (unsigned)(255 - i); c[1] = (i >= 8) ? exk : c[1]; }
            CE_(c[0], c[1]);
            const unsigned G = row_pop16(c, i);
            const float val = deck(G & ~0xFFu); const int id = 255 - (int)(G & 0xFFu); const int rb = F.lane & 48;
            const int ea = __shfl(n0, rb + (id >> 4)), eb = __shfl(n1, rb + (id & 15));
            const float mx = __uint_as_float(dppu<0x150>(__float_as_uint(val))); const float ex = __expf(val - mx); const float sm = rowsum_f32(ex);
            const size_t o = (size_t)(t0 + 4 * q + r) * 128 + h * 16 + i; IDX[o] = ea * 128 + eb; GATE[o] = ex / sm; __builtin_amdgcn_sched_barrier(0);
        }
    }
}
#undef CE_

constexpr float U_SCALE = 256.0f, V_SCALE = 1.0f;
#ifndef PEER_SORT
#define PEER_SORT 0
#endif
__device__ __forceinline__ float gelu_as(float v) {
    const float av = fabsf(v), tt = __builtin_amdgcn_rcpf(av * 0.2316418882f + 1.0f);
    float q = tt * 0.5307027145f + (-0.7265760135f); q = q * tt + 0.7107068705f; q = q * tt + (-0.142248368f); q = q * tt + 0.127414796f; q = q * tt;
    const float m = v * (q * __builtin_amdgcn_exp2f((v * v) * (-0.72134752044f)));
    return v < 0.f ? m : v - m;
}
#ifndef PEER_UMFMA
#define PEER_UMFMA 1
#endif
#ifndef HYP_A
#define HYP_A 1
#endif
#ifndef HYP_B
#define HYP_B 0
#endif
#ifndef PEER_VMFMA
#define PEER_VMFMA 1
#endif
typedef int v8i __attribute__((ext_vector_type(8)));
typedef int v2i __attribute__((ext_vector_type(2)));
typedef float f32x16 __attribute__((ext_vector_type(16)));
__device__ __forceinline__ float wave_sum_dpp(float x) {
    x = rowsum_f32(x);
    return (__uint_as_float(__builtin_amdgcn_readlane(__float_as_uint(x), 0)) + __uint_as_float(__builtin_amdgcn_readlane(__float_as_uint(x), 16)))
         + (__uint_as_float(__builtin_amdgcn_readlane(__float_as_uint(x), 32)) + __uint_as_float(__builtin_amdgcn_readlane(__float_as_uint(x), 48)));
}
#define LOADROWS(T, ra_, rb_, ee) do { const int e2_ = (ee) & 127; const int ea_ = __builtin_amdgcn_readlane(e2_ < 64 ? id0 : id1, e2_ & 63), eb_ = __builtin_amdgcn_readlane(e2_ < 64 ? id0 : id1, (e2_ + 1) & 63); \
        const GAS v4u* pa_ = (const GAS v4u*)((T) + (size_t)ea_ * DM) + F.lane; const GAS v4u* pb_ = (const GAS v4u*)((T) + (size_t)eb_ * DM) + F.lane; \
        _Pragma("unroll") for (int c = 0; c < 4; ++c) { ra_[c] = pa_[64 * c]; rb_[c] = pb_[64 * c]; } } while (0)
#define UDOT(r_, out_) do { f32x2 s0_ = {0.f, 0.f}, s1_ = {0.f, 0.f}, s2_ = {0.f, 0.f}, s3_ = {0.f, 0.f}; \
        _Pragma("unroll") for (int c = 0; c < 4; ++c) _Pragma("unroll") for (int d = 0; d < 2; ++d) { \
            const f32x2 p0_ = __builtin_amdgcn_cvt_scalef32_pk_f32_fp4(r_[c][d], 1.0f, 0), p1_ = __builtin_amdgcn_cvt_scalef32_pk_f32_fp4(r_[c][d], 1.0f, 1), \
                        p2_ = __builtin_amdgcn_cvt_scalef32_pk_f32_fp4(r_[c][d], 1.0f, 2), p3_ = __builtin_amdgcn_cvt_scalef32_pk_f32_fp4(r_[c][d], 1.0f, 3); \
            s0_ = p0_ * hx[8 * c + 4 * d] + s0_; s1_ = p1_ * hx[8 * c + 4 * d + 1] + s1_; s2_ = p2_ * hx[8 * c + 4 * d + 2] + s2_; s3_ = p3_ * hx[8 * c + 4 * d + 3] + s3_; } \
        out_ = ((s0_.x + s0_.y) + (s1_.x + s1_.y)) + ((s2_.x + s2_.y) + (s3_.x + s3_.y)); } while (0)
#define UPAIR(ra_, rb_, ee) do { float sa_, sb_; UDOT(ra_, sa_); UDOT(rb_, sb_); sa_ = wave_sum_dpp(sa_); sb_ = wave_sum_dpp(sb_); \
        const int e2_ = (ee); const int ea_ = __builtin_amdgcn_readlane(e2_ < 64 ? id0 : id1, e2_ & 63), eb_ = __builtin_amdgcn_readlane(e2_ < 64 ? id0 : id1, (e2_ + 1) & 63); \
        const f32x2 a2_ = pg8::gelu_pk((f32x2){sa_ * RSU[ea_], sb_ * RSU[eb_]}); \
        if ((ee) < 64) { if (F.lane == (ee)) w0 = a2_.x * g0; if (F.lane == (ee) + 1) w0 = a2_.y * g0; } else { if (F.lane == (ee) - 64) w1 = a2_.x * g1; if (F.lane == (ee) - 63) w1 = a2_.y * g1; } } while (0)
#define LOADROWS4(T, ra_, rb_, ee) do { const int e2_ = (ee) & 127; const int ea_ = __builtin_amdgcn_readlane(e2_ < 64 ? id0 : id1, e2_ & 63), eb_ = __builtin_amdgcn_readlane(e2_ < 64 ? id0 : id1, (e2_ + 1) & 63); \
        const GAS v2u* pa_ = (const GAS v2u*)((T) + (size_t)ea_ * 2048) + F.lane; const GAS v2u* pb_ = (const GAS v2u*)((T) + (size_t)eb_ * 2048) + F.lane; \
        _Pragma("unroll") for (int c = 0; c < 4; ++c) { ra_[c] = pa_[64 * c]; rb_[c] = pb_[64 * c]; } } while (0)
#define VAXPY(r_, w_) do { const f32x2 w2_ = {w_, w_}; \
        _Pragma("unroll") for (int c = 0; c < 4; ++c) _Pragma("unroll") for (int d = 0; d < 2; ++d) { \
            const f32x2 p0_ = __builtin_amdgcn_cvt_scalef32_pk_f32_fp4(r_[c][d], 1.0f, 0), p1_ = __builtin_amdgcn_cvt_scalef32_pk_f32_fp4(r_[c][d], 1.0f, 1), \
                        p2_ = __builtin_amdgcn_cvt_scalef32_pk_f32_fp4(r_[c][d], 1.0f, 2), p3_ = __builtin_amdgcn_cvt_scalef32_pk_f32_fp4(r_[c][d], 1.0f, 3); \
            acc[8 * c + 4 * d] = p0_ * w2_ + acc[8 * c + 4 * d]; acc[8 * c + 4 * d + 1] = p1_ * w2_ + acc[8 * c + 4 * d + 1]; \
            acc[8 * c + 4 * d + 2] = p2_ * w2_ + acc[8 * c + 4 * d + 2]; acc[8 * c + 4 * d + 3] = p3_ * w2_ + acc[8 * c + 4 * d + 3]; } } while (0)
#define VPAIR(ra_, rb_, ee) do { const int e2_ = (ee); const int ea_ = __builtin_amdgcn_readlane(e2_ < 64 ? id0 : id1, e2_ & 63), eb_ = __builtin_amdgcn_readlane(e2_ < 64 ? id0 : id1, (e2_ + 1) & 63); \
        const float wa_ = __uint_as_float(__builtin_amdgcn_readlane(__float_as_uint((ee) < 64 ? w0 : w1), (ee) & 63)) * RS[ea_], wb_ = __uint_as_float(__builtin_amdgcn_readlane(__float_as_uint((ee) < 64 ? w0 : w1), ((ee) + 1) & 63)) * RS[eb_]; \
        VAXPY(ra_, wa_); VAXPY(rb_, wb_); } while (0)
#ifndef P10_NT
#define P10_NT 1
#endif
#if P10_NT
#define P10_OUT_ST(p, v) __builtin_nontemporal_store((v), (p))
#else
#define P10_OUT_ST(p, v) (*(p) = (v))
#endif
template <int MODE> __device__ __forceinline__ void p10_peer(Frame& F, const Args& args) {
    const int gw = F.vcu * NWAVES + F.wave, NGW = F.G * NWAVES; const float* MOD = WSP(float, WS_MOD);
    const bf16* H2 = WSP(bf16, WS_HA); const unsigned char* U = WSP(unsigned char, WS_U); const unsigned char* V = WSP(unsigned char, WS_V); const int* IDX = WSP(int, WS_IDX); const float* GATE = WSP(float, WS_GATE); const float* RS = WSP(float, WS_RS); const float* RSU = WSP(float, WS_RSU);
#if PEER_UMFMA
    if (F.lane < 8) *(LAS v4u*)(F.lds + F.wave * 18688 + 4096 + F.lane * 16) = (v4u){0u, 0u, 0u, 0u};
#endif
#pragma unroll 1
    for (int t = gw; t < S; t += NGW) {
        const int id0 = IDX[(size_t)t * 128 + F.lane], id1 = IDX[(size_t)t * 128 + 64 + F.lane];
        const float g0 = GATE[(size_t)t * 128 + F.lane], g1 = GATE[(size_t)t * 128 + 64 + F.lane];
        float w0 = 0.f, w1 = 0.f;
#if PEER_UMFMA
        if (MODE != 2) {
            LAS unsigned char* h8 = F.lds + F.wave * 18688; LAS unsigned char* stg = h8 + 4224;
            const float rstd = 1.0f / sqrtf(wave_sum_dpp(WSP(float, WS_SSQ)[(size_t)t * 64 + F.lane]) * (1.0f / DM) + EPS);
#pragma unroll
            for (int c = 0; c < 4; ++c) { const GAS v4u* hp = (const GAS v4u*)(H2 + (size_t)t * DM + c * 1024 + F.lane * 16); const v4u a = hp[0], b = hp[1]; v4u o;
                const GAS f32x4* sp = (const GAS f32x4*)(MOD + 12288 + c * 1024 + F.lane * 16); const f32x4 s0 = sp[0], s1 = sp[1], s2 = sp[2], s3 = sp[3];
                { int w = 0; w = __builtin_amdgcn_cvt_pk_fp8_f32(bflo(a[0]) * rstd + s0[0], bfhi(a[0]) * rstd + s0[1], w, false); w = __builtin_amdgcn_cvt_pk_fp8_f32(bflo(a[1]) * rstd + s0[2], bfhi(a[1]) * rstd + s0[3], w, true); o[0] = (unsigned)w; }
                { int w = 0; w = __builtin_amdgcn_cvt_pk_fp8_f32(bflo(a[2]) * rstd + s1[0], bfhi(a[2]) * rstd + s1[1], w, false); w = __builtin_amdgcn_cvt_pk_fp8_f32(bflo(a[3]) * rstd + s1[2], bfhi(a[3]) * rstd + s1[3], w, true); o[1] = (unsigned)w; }
                { int w = 0; w = __builtin_amdgcn_cvt_pk_fp8_f32(bflo(b[0]) * rstd + s2[0], bfhi(b[0]) * rstd + s2[1], w, false); w = __builtin_amdgcn_cvt_pk_fp8_f32(bflo(b[1]) * rstd + s2[2], bfhi(b[1]) * rstd + s2[3], w, true); o[2] = (unsigned)w; }
                { int w = 0; w = __builtin_amdgcn_cvt_pk_fp8_f32(bflo(b[2]) * rstd + s3[0], bfhi(b[2]) * rstd + s3[1], w, false); w = __builtin_amdgcn_cvt_pk_fp8_f32(bflo(b[3]) * rstd + s3[2], bfhi(b[3]) * rstd + s3[3], w, true); o[3] = (unsigned)w; }
                *(LAS v4u*)(h8 + c * 1024 + F.lane * 16) = o; }
            const int j = F.lane & 31, kh = F.lane >> 5, lr = F.lane >> 3, lp = F.lane & 7;
            unsigned so[4][4];
#pragma unroll
            for (int b = 0; b < 4; ++b)
#pragma unroll
                for (int i = 0; i < 4; ++i) so[b][i] = (unsigned)__shfl(b < 2 ? id0 : id1, 32 * (b & 1) + lr + 8 * i) * 2048u + (unsigned)lp * 16u;
            int eb[4];
#pragma unroll
            for (int b = 0; b < 4; ++b) eb[b] = __shfl(b < 2 ? id0 : id1, j + 32 * (b & 1));
            const unsigned aoff0 = (j == 0) ? (unsigned)(16 * kh) : 4096u, aoff1 = (j == 0) ? (unsigned)(32 + 16 * kh) : 4112u, astep = (j == 0) ? 64u : 0u;
            const unsigned wof = (unsigned)lr * 144u + (unsigned)lp * 16u, rof = (unsigned)j * 144u + (unsigned)kh * 16u;
            f32x16 ac[4];
#pragma unroll
            for (int b = 0; b < 4; ++b) ac[b] = (f32x16){};
            v4u R0[8], R1[8];
#define ULOAD(R_, kg_, bp_) do { _Pragma("unroll") for (int bb = 0; bb < 2; ++bb) _Pragma("unroll") for (int i = 0; i < 4; ++i) \
                R_[4 * bb + i] = *(const GAS v4u*)(U + (size_t)so[2 * (bp_) + bb][i] + (size_t)(kg_) * 128); } while (0)
#define USTAGE(R_, bp_) do { _Pragma("unroll") for (int bb = 0; bb < 2; ++bb) _Pragma("unroll") for (int i = 0; i < 4; ++i) *(LAS v4u*)(stg + bb * 4608 + i * 1152 + wof) = R_[4 * bb + i]; \
            _Pragma("unroll") for (int bb = 0; bb < 2; ++bb) { v4u B_[4]; _Pragma("unroll") for (int kk = 0; kk < 4; ++kk) B_[kk] = *(const LAS v4u*)(stg + bb * 4608 + rof + kk * 32); \
                _Pragma("unroll") for (int kk = 0; kk < 4; ++kk) ac[2 * (bp_) + bb] = __builtin_amdgcn_mfma_scale_f32_32x32x64_f8f6f4(A[kk], (v8i){(int)B_[kk][0], (int)B_[kk][1], (int)B_[kk][2], (int)B_[kk][3], 0, 0, 0, 0}, ac[2 * (bp_) + bb], 0, 4, 0, 0x7f7f7f7f, 0, 0x7f7f7f7f); } } while (0)
            ULOAD(R0, 0, 0);
#pragma unroll 1
            for (int kg = 0; kg < 16; ++kg) {
                v8i A[4];
#pragma unroll
                for (int kk = 0; kk < 4; ++kk) { const unsigned kb = (unsigned)(4 * kg + kk); const v4u x = *(const LAS v4u*)(h8 + aoff0 + kb * astep), y = *(const LAS v4u*)(h8 + aoff1 + kb * astep);
                    A[kk] = (v8i){(int)x[0], (int)x[1], (int)x[2], (int)x[3], (int)y[0], (int)y[1], (int)y[2], (int)y[3]}; }
                ULOAD(R1, kg, 1);
                USTAGE(R0, 0);
                ULOAD(R0, (kg + 1) & 15, 0);
                USTAGE(R1, 1);
            }
#undef ULOAD
#undef USTAGE
#pragma unroll
            for (int b = 0; b < 4; ++b) {
                const float av = pg8::gelu_pk((f32x2){ac[b][0] * RSU[eb[b]], 0.f}).x;
                const float gg = __shfl(b < 2 ? g0 : g1, j + 32 * (b & 1)); const float wv = av * gg;
                if ((b & 1) == 0) { if (b == 0) w0 = F.lane < 32 ? wv : w0; else w1 = F.lane < 32 ? wv : w1; }
                else { const float mv = __shfl(wv, j); if (b == 1) w0 = F.lane >= 32 ? mv : w0; else w1 = F.lane >= 32 ? mv : w1; } }
        }
#else
        {   f32x2 hx[32];
#pragma unroll
            for (int c = 0; c < 4; ++c) { const GAS v4u* hp = (const GAS v4u*)(H2 + (size_t)t * DM + c * 1024 + F.lane * 16); const v4u a = hp[0], b = hp[1];
#pragma unroll
                for (int k = 0; k < 4; ++k) { hx[8 * c + k] = (f32x2){bflo(a[k]), bfhi(a[k])}; hx[8 * c + 4 + k] = (f32x2){bflo(b[k]), bfhi(b[k])}; } }
            v2u ra[4], rb[4], rc[4], rd[4], na[4], nb[4], nc[4], nd[4];
            if (MODE != 2) {
            LOADROWS4(U, ra, rb, 0); LOADROWS4(U, rc, rd, 2);
#pragma unroll 1
            for (int e = 0; e < 128; e += 8) {
                LOADROWS4(U, na, nb, e + 4); LOADROWS4(U, nc, nd, e + 6);
                UPAIR(ra, rb, e); UPAIR(rc, rd, e + 2);
                LOADROWS4(U, ra, rb, e + 8); LOADROWS4(U, rc, rd, e + 10);
                UPAIR(na, nb, e + 4); UPAIR(nc, nd, e + 6);
            } } }
#endif
        if (MODE == 1 || MODE == 3) { asm volatile("" :: "v"(w0), "v"(w1)); continue; }
#if PEER_VMFMA
        {
            LAS unsigned char* wreg = F.lds + F.wave * 18688; LAS unsigned char* w8 = wreg; LAS unsigned char* stg = wreg + 256;
            const int j = F.lane & 31, kh = F.lane >> 5;
            { const float q0 = w0 * RS[id0] * 16.0f, q1 = w1 * RS[id1] * 16.0f;
              const int b0 = __builtin_amdgcn_cvt_pk_fp8_f32(q0, q0, 0, false), b1 = __builtin_amdgcn_cvt_pk_fp8_f32(q1, q1, 0, false);
              w8[F.lane] = (unsigned char)(b0 & 0xff); w8[64 + F.lane] = (unsigned char)(b1 & 0xff); if (F.lane < 8) *(LAS v2u*)(w8 + 128 + 8 * F.lane) = (v2u){0u, 0u}; }
            v8i A[2];
#pragma unroll
            for (int kb = 0; kb < 2; ++kb) { const unsigned o0 = (j == 0) ? (unsigned)(64 * kb + 16 * kh) : 128u, o1 = (j == 0) ? (unsigned)(64 * kb + 32 + 16 * kh) : 144u;
                const v4u x = *(const LAS v4u*)(w8 + o0), y = *(const LAS v4u*)(w8 + o1);
                A[kb] = (v8i){(int)x[0], (int)x[1], (int)x[2], (int)x[3], (int)y[0], (int)y[1], (int)y[2], (int)y[3]}; }
            const int lr = F.lane >> 3, lp = F.lane & 7;
            unsigned so[2][8];
#pragma unroll
            for (int kb = 0; kb < 2; ++kb)
#pragma unroll
                for (int i = 0; i < 8; ++i) so[kb][i] = (unsigned)__shfl(kb == 0 ? id0 : id1, 8 * i + lr) * 2048u + (unsigned)lp * 16u;
            const unsigned wof = (unsigned)lr * 144u + (unsigned)lp * 16u;
            const unsigned rof = (unsigned)(32 * kh + (F.lane & 15)) * 144u + (unsigned)(8 * ((F.lane >> 4) & 1));
            const bf16* X1r = WSP(bf16, WS_X1) + (size_t)t * DM; const float* G2 = MOD + 20480; float* Or = F.out + (size_t)t * DM;
            v4u R0[8], R1[8];
#define VLOAD(R_, cg_, kb_) do { _Pragma("unroll") for (int i = 0; i < 8; ++i) R_[i] = *(const GAS v4u*)(V + (size_t)so[kb_][i] + (size_t)(cg_) * 128); } while (0)
            VLOAD(R0, 0, 0); VLOAD(R1, 0, 1);
#pragma unroll 1
            for (int cg = 0; cg < 16; ++cg) {
#pragma unroll
                for (int i = 0; i < 8; ++i) { *(LAS v4u*)(stg + i * 1152 + wof) = R0[i]; *(LAS v4u*)(stg + 9216 + i * 1152 + wof) = R1[i]; }
                VLOAD(R0, (cg + 1) & 15, 0); VLOAD(R1, (cg + 1) & 15, 1);
#pragma unroll
                for (int tp = 0; tp < 4; ++tp) { float dv[2];
#pragma unroll
                    for (int th = 0; th < 2; ++th) { const int tt = 2 * tp + th; f32x16 d_ = (f32x16){};
#pragma unroll
                        for (int kb = 0; kb < 2; ++kb) {
                            const v2i q0_ = __builtin_amdgcn_ds_read_tr4_b64_v2i32((LAS v2i*)(stg + kb * 9216 + rof + tt * 16)), q1_ = __builtin_amdgcn_ds_read_tr4_b64_v2i32((LAS v2i*)(stg + kb * 9216 + 2304 + rof + tt * 16));
                            d_ = __builtin_amdgcn_mfma_scale_f32_32x32x64_f8f6f4(A[kb], (v8i){q0_[0], q0_[1], q1_[0], q1_[1], 0, 0, 0, 0}, d_, 0, 4, 0, 0x7b7b7b7b, 0, 0x7f7f7f7f); }
                        dv[th] = d_[0]; }
                    const auto sw = __builtin_amdgcn_permlane32_swap(__float_as_uint(dv[0]), __float_as_uint(dv[1]), false, false);
                    const float dd = __uint_as_float(sw[0]);
                    if (MODE == 2) { asm volatile("" :: "v"(dd)); } else { const int col = cg * 256 + tp * 64 + F.lane; P10_OUT_ST(&Or[col], bf2f(X1r[col]) + G2[col] * dd); } }
            }
#undef VLOAD
        }
#else
        f32x2 acc[32];
#pragma unroll
        for (int j = 0; j < 32; ++j) acc[j] = (f32x2){0.f, 0.f};
        {   v2u ra[4], rb[4], rc[4], rd[4], na[4], nb[4], nc[4], nd[4];
            LOADROWS4(V, ra, rb, 0); LOADROWS4(V, rc, rd, 2);
#pragma unroll 1
            for (int e = 0; e < 128; e += 8) {
                LOADROWS4(V, na, nb, e + 4); LOADROWS4(V, nc, nd, e + 6);
                VPAIR(ra, rb, e); VPAIR(rc, rd, e + 2);
                LOADROWS4(V, ra, rb, e + 8); LOADROWS4(V, rc, rd, e + 10);
                VPAIR(na, nb, e + 4); VPAIR(nc, nd, e + 6);
            } }
        if (MODE == 2) {
#pragma unroll
            for (int j = 0; j < 32; ++j) asm volatile("" :: "v"(acc[j]));
            continue; }
#pragma unroll
        for (int c = 0; c < 4; ++c) { const int col = c * 1024 + F.lane * 16; GAS f32x4* op = (GAS f32x4*)(F.out + (size_t)t * DM + col);
            const GAS f32x4* xp = (const GAS f32x4*)(WSP(float, WS_X1) + (size_t)t * DM + col); const GAS f32x4* gp = (const GAS f32x4*)(MOD + 20480 + col);
#pragma unroll
            for (int q = 0; q < 4; ++q) op[q] = xp[q] + gp[q] * (f32x4){acc[8 * c + 2 * q].x, acc[8 * c + 2 * q].y, acc[8 * c + 2 * q + 1].x, acc[8 * c + 2 * q + 1].y}; }
#endif
    }
}
#undef LOADROWS
#undef UDOT
#undef UPAIR
#undef VAXPY
#undef VPAIR
#undef LOADROWS4
#ifndef MK_SINGLE
#define MK_SINGLE 1
#endif
constexpr int N_PHASES = 11;
__global__ void __launch_bounds__(NTHREADS, 2) fwd_kernel(Args args) {
    extern __shared__ __attribute__((aligned(16))) unsigned char lds[];
    Frame F;
    F.lds = (LAS unsigned char*)lds; F.MISC = (volatile LAS unsigned*)(F.lds + MISC_OFF);
    F.tid = threadIdx.x; F.lane = F.tid & 63; F.wave = __builtin_amdgcn_readfirstlane(F.tid >> 6);
    F.G = gridDim.x; { const int bx = blockIdx.x; F.vcu = (F.G % 8 == 0) ? (bx % 8) * (F.G / 8) + bx / 8 : bx; }
    F.ws = args.ws; F.out = args.out; F.ctl = (gu32*)(args.ws + WS_CTL);
    for (int u = F.tid; u < (LDS_BYTES - LDSCTL_OFF) / 4; u += NTHREADS) ((LAS unsigned*)(F.lds + LDSCTL_OFF))[u] = 0u;
    __syncthreads();
    const int lo = args.ph_lo, hi = args.ph_hi;
    XcdBarrier bar; bar.bar = (unsigned*)(F.ctl + CW_BAR); bar.x = 0; bar.st = nullptr;
    if (hi - lo > 1) bar = xcd_barrier_post((unsigned*)(F.ctl + CW_BAR), F.MISC + 8);
#ifndef PH_MASK
#define PH_MASK 0x7ff
#endif
#define IN(k) (((PH_MASK >> (k)) & 1) && lo <= (k) && (k) < hi)
#define SEAM(k) do { if (IN(k) && IN((k) + 1)) xcd_barrier(bar); } while (0)
#ifndef G_ALIGN
#define G_ALIGN true
#endif
#ifndef G_SP2
#define G_SP2 true
#endif
#ifndef QKN_IN_P2
#define QKN_IN_P2 0
#endif
#ifndef P2_BAL
#define P2_BAL 0
#endif
#ifndef P9_OWN
#define P9_OWN 1
#endif
#ifndef P5_FUSED
#define P5_FUSED 1
#endif
#ifndef REP_PHASE
#define REP_PHASE -1
#endif
#define REPEAT(k) _Pragma("unroll") for (int rep = 0; rep < ((REP_PHASE) == (k) ? 2 : 1); ++rep)
#define REPBAR(k) do { if ((REP_PHASE) == (k) && rep == 0) xcd_barrier(bar); } while (0)
    const int bid = (int)blockIdx.x;
    if (IN(0)) { REPEAT(0) { p0_prologue(F, args); REPBAR(0); } SEAM(0); }
    if (IN(1)) { REPEAT(1) { p1_norm_forget(F, args); p1_shift_proj(F, args); REPBAR(1); } SEAM(1); }
#ifdef CLK_PROBE
    long long ck0 = clock64(); long long wk0 = wall_clock64();
#endif
    if (IN(2)) { REPEAT(2) {
#ifdef P2_STAGGER
        if ((bid >> 3) & 1) { const long long t0_ = wall_clock64(); while (wall_clock64() - t0_ < P2_STAGGER) __builtin_amdgcn_s_sleep(8); }
#endif
#if SKEW_TABLES
        const bool tables_first = ((bid >> 3) & 1) != 0; const int gw_ = F.vcu * NWAVES + F.wave, NGW_ = F.G * NWAVES;
        if (tables_first) { cvt_table_fp4(F, args.in[23], WSP(unsigned char, WS_V), WSP(float, WS_RS), gw_, NGW_); cvt_table_fp4(F, args.in[22], WSP(unsigned char, WS_U), WSP(float, WS_RSU), gw_, NGW_); if (SKEW_TR) tr_run(F, args, TR_LATE_LO, TR_LATE_HI); __syncthreads(); }
#endif
        pg8::Gemm g{WSP(bf16, WS_HA), WSP(bf16, WS_WIN), S, NINP, DM}; pg8::BalOrder So; So.init(S, NINP, F.G, bid); So.on = (P2_BAL != 0) && F.G == 256;
        pg8::EpiIn E{WSP(bf16, WS_QKV), WSP(bf16, WS_LX), WSP(bf16, WS_GY), WSP(bf16, WS_GA), WSP(bf16, WS_GL), WSP(float, WS_BIASR)};
        pg8::gemm_phase<pg8::EpiIn, pg8::BalOrder, G_ALIGN, G_SP2>(F.lds, g, So, E);
#if SKEW_TABLES
        if (!tables_first) { cvt_table_fp4(F, args.in[23], WSP(unsigned char, WS_V), WSP(float, WS_RS), gw_, NGW_); cvt_table_fp4(F, args.in[22], WSP(unsigned char, WS_U), WSP(float, WS_RSU), gw_, NGW_); if (SKEW_TR) tr_run(F, args, TR_LATE_LO, TR_LATE_HI); }
#endif
        REPBAR(2); }
#ifdef P2_NOEPI
        { xcd_barrier(bar); pg8::Gemm g{WSP(bf16, WS_HA), WSP(bf16, WS_WIN), S, NINP, DM};
#ifdef P2_PITCH
          g.lda = P2_PITCH; g.ldb = P2_PITCH;
#endif
          pg8::MaskOrder So; So.init(S, NINP, F.G, bid);

#if EPI_PROBE
          pg8::EpiInProbe E{WSP(bf16, WS_T1), WSP(bf16, WS_T1), WSP(bf16, WS_T1), WSP(bf16, WS_T1), WSP(bf16, WS_T1), WSP(float, WS_BIASR)}; pg8::gemm_phase<pg8::EpiInProbe, pg8::MaskOrder, G_ALIGN, G_SP2, 0>(F.lds, g, So, E); }
#else
          pg8::EpiNullKeep E{WSP(float, WS_IDX2)}; pg8::gemm_phase<pg8::EpiNullKeep, pg8::MaskOrder, G_ALIGN, G_SP2, P2_NOEPI - 1>(F.lds, g, So, E); }
#endif

#endif
        SEAM(2);
    }
#ifdef CLK_PROBE
    long long ck1 = clock64(); long long wk1 = wall_clock64();
#endif
    if (IN(3)) {
#if !QKN_IN_P2
        p3_qknorm(F, args);
        __syncthreads();
#endif
        REPEAT(3) {
        p3_cumsum(F, args);
        for (int w = bid; w < 256; w += F.G) lru_item<0>(F, args, w);
        REPBAR(3); }
        SEAM(3);
    }
    if (IN(4)) {
#pragma unroll 1
        for (int rep = 0; rep < args.rep_lru; ++rep)
        for (int w = bid; w < 256; w += F.G) { if (LRU_STORE_AB) lru_item1_ab(F, args, w); else lru_item<1>(F, args, w); }
#pragma unroll 1
        for (int rep = 0; rep < args.rep_att; ++rep) p4_attention(F, args, (char*)lds, rep);
        SEAM(4);
    }
    if (IN(5)) { REPEAT(5) {
#if P5_FUSED
        { pg8::Gemm g{WSP(bf16, WS_ATT), WSP(bf16, WS_WAO), S, DM, AW + LW}; g.lda = AW; g.ldb = AW; g.A2 = WSP(bf16, WS_LR); g.Bt2 = WSP(bf16, WS_WLO); g.ksplit = AW;
          pg8::StaticOrder So; So.init(S, DM, F.G, bid);
          pg8::EpiGate2 E{WSP(bf16, WS_T1), WSP(bf16, WS_GA), WSP(bf16, WS_GL), DM};
          pg8::gemm_phase<pg8::EpiGate2, pg8::StaticOrder, true, true, 0, true>(F.lds, g, So, E); }
#else
        { pg8::Gemm g{WSP(bf16, WS_ATT), WSP(bf16, WS_WAO), S, DM, AW}; pg8::StaticOrder So; So.init(S, DM, F.G, bid);
          pg8::EpiGate<0> E{WSP(bf16, WS_T1), WSP(bf16, WS_GA), DM};
          pg8::gemm_phase<pg8::EpiGate<0>, pg8::StaticOrder, true, true>(F.lds, g, So, E); }
        { pg8::Gemm g{WSP(bf16, WS_LR), WSP(bf16, WS_WLO), S, DM, LW}; pg8::StaticOrder So; So.init(S, DM, F.G, bid);
          pg8::EpiGate<1> E{WSP(bf16, WS_T1), WSP(bf16, WS_GL), DM};
          pg8::gemm_phase<pg8::EpiGate<1>, pg8::StaticOrder, true, true>(F.lds, g, So, E); }
#endif
        REPBAR(5); }
        SEAM(5);
    }
    if (IN(6)) { REPEAT(6) {
        pg8::Gemm g{WSP(bf16, WS_T1), WSP(bf16, WS_WOUT), S, DM, DM}; pg8::StaticOrder So; So.init(S, DM, F.G, bid);
        pg8::EpiRes E{args.in[0], WSP(bf16, WS_X1), WSP(float, WS_MOD) + 8192, DM, args.in[5], WSP(float, WS_MOD) + 16384, WSP(bf16, WS_HA), WSP(float, WS_SSQ)};
        pg8::gemm_phase<pg8::EpiRes, pg8::StaticOrder, true, true>(F.lds, g, So, E);
        REPBAR(6); }
        SEAM(6);
    }
    pg8::Unit p9u{0, 0}; bool p9_own = false;
    { pg8::StaticOrder So8; So8.init(S, 2048, F.G, bid); p9_own = (P9_OWN != 0) && F.G == 256 && IN(8) && IN(9) && (REP_PHASE) != 8 && So8.next(0, p9u); }
    if (IN(8)) { REPEAT(8) {
        pg8::Gemm g{WSP(bf16, WS_HA), WSP(bf16, WS_WPQ), S, 2048, DM}; pg8::RstdOrder So; So.init(S, 2048, F.G, bid);
        So.SSQ = WSP(float, WS_SSQ); So.rs = (LAS float*)(F.lds + 133120); So.inv_n = 1.0f / DM; So.eps = EPS; So.na = 0;
        pg8::EpiQ2 E{WSP(bf16, WS_Q2), 2048, WSP(float, WS_SB), (const LAS float*)(F.lds + 133120), 0};
        pg8::gemm_phase<pg8::EpiQ2, pg8::RstdOrder, true, true>(F.lds, g, So, E);
        REPBAR(8); }
        if (p9_own) __syncthreads(); else SEAM(8);
    }
    if (IN(9)) { REPEAT(9) { p9_topk(F, args, p9_own ? p9u.pm : -1, p9u.pn); REPBAR(9); } SEAM(9); }
#ifndef P10_PROBE
#define P10_PROBE 0
#endif
#if defined(CLK_PROBE) && CLK_PROBE >= 10
    ck0 = clock64(); wk0 = wall_clock64();
#endif
    if (IN(10)) { if (P10_PROBE) { p10_peer<P10_PROBE>(F, args); xcd_barrier(bar); } REPEAT(10) { p10_peer<0>(F, args); REPBAR(10); } }
#if defined(CLK_PROBE) && CLK_PROBE >= 10
    ck1 = clock64(); wk1 = wall_clock64();
#endif
#ifdef CLK_PROBE
    xcd_barrier(bar);
    if (bid == 0 && F.tid == 0) { const float ghz = (float)(ck1 - ck0) / (float)(wk1 - wk0) * 0.1f;
        F.out[0] = (CLK_PROBE == 1 || CLK_PROBE == 10) ? floorf(ghz * 10.0f + 0.5f) * 10.0f : (float)(wk1 - wk0) * 0.01f; }
#endif
#undef IN
#undef SEAM
}

extern "C" void kernel_launch(void* const* d_in, const int* in_sizes, int n_in, void* d_out, int out_size, void* d_ws, size_t ws_size, hipStream_t stream) {
    static int grid = 0;
    if (grid == 0) {
        if (n_in != 24 || in_sizes[0] != S * DM || out_size != S * DM || ws_size < WS_END) { fprintf(stderr, "kernel_launch: unexpected shapes (n_in %d, in0 %d, out %d, ws %zu)\n", n_in, n_in > 0 ? in_sizes[0] : -1, out_size, ws_size); grid = -1; return; }
        int dev = 0, cus = 0, per_cu = 0;
        if (hipGetDevice(&dev) != hipSuccess || hipDeviceGetAttribute(&cus, hipDeviceAttributeMultiprocessorCount, dev) != hipSuccess) { grid = -1; return; }
        if (hipFuncSetAttribute((const void*)fwd_kernel, hipFuncAttributeMaxDynamicSharedMemorySize, LDS_BYTES) != hipSuccess) { fprintf(stderr, "kernel_launch: hipFuncSetAttribute failed\n"); grid = -1; return; }
        if (hipOccupancyMaxActiveBlocksPerMultiprocessor(&per_cu, (const void*)fwd_kernel, NTHREADS, LDS_BYTES) != hipSuccess || per_cu < 1) fprintf(stderr, "kernel_launch: occupancy query reports %d blocks per CU\n", per_cu);
        (void)hipGetLastError();
        grid = cus;
    }
    if (grid < 0) return;
    if (hipMemsetAsync((char*)d_ws + WS_CTL, 0, CTL_ZERO_BYTES, stream) != hipSuccess) return;
    Args a{};
    for (int i = 0; i < 24; ++i) a.in[i] = (const float*)d_in[i];
    a.out = (float*)d_out; a.ws = (unsigned char*)d_ws;
#ifndef REP_ATT
#define REP_ATT 1
#endif
#ifndef REP_LRU
#define REP_LRU 1
#endif
    a.rep_att = REP_ATT; a.rep_lru = REP_LRU;
#if MK_SINGLE
    a.ph_lo = 0; a.ph_hi = N_PHASES;
    hipLaunchKernelGGL(fwd_kernel, dim3(grid), dim3(NTHREADS), LDS_BYTES, stream, a);
#else
    for (int p = 0; p < N_PHASES; ++p) { a.ph_lo = p; a.ph_hi = p + 1; hipLaunchKernelGGL(fwd_kernel, dim3(grid), dim3(NTHREADS), LDS_BYTES, stream, a); }
#endif
}
```

```cpp
#include <hip/hip_runtime.h>
#include <cstdio>
#include <cstdint>
namespace pg8 {
#define PG8_LAS __attribute__((address_space(3)))
typedef unsigned short bf16_t;
typedef short bf16x8 __attribute__((ext_vector_type(8)));
typedef float f32x4 __attribute__((ext_vector_type(4)));
typedef unsigned u32x4 __attribute__((ext_vector_type(4)));
constexpr int BM = 256, BK = 64, HALF = 128, HTB = HALF * BK * 2  , STAGE_BYTES = 8 * HTB, NXCD = 8, WGM = 8;

__host__ __device__ __forceinline__ int lds_byte(int r, int c) { const int st = (r >> 4) * 2 + (c >> 5), rr = r & 15, cc = c & 31, ob = rr * 64 + cc * 2; return st * 1024 + (ob ^ (((ob >> 9) & 1) << 5)); }
__host__ __device__ __forceinline__ void stage_rc(int b, int& R, int& C) { const int st = b / 1024, sb = b % 1024, swz = sb ^ (((sb >> 9) & 1) << 5); R = (st >> 1) * 16 + swz / 64; C = (st & 1) * 32 + (swz % 64) / 2; }
__host__ __device__ __forceinline__ int perm32(int rho) { const int n = rho >> 4, i = rho & 15; return 8 * (i >> 2) + 4 * n + (i & 3); }

struct Unit { int pm, pn; };
struct Gemm { const bf16_t* A; const bf16_t* Bt; int M, N, K; int lda = 0, ldb = 0; const bf16_t* A2 = nullptr; const bf16_t* Bt2 = nullptr; int ksplit = 0; };

struct StaticOrder {
    int nM, nN, nwg, G, c;
    __host__ __device__ void init(int M, int N, int G_, int c_) { nM = M / BM; nN = N / BM; nwg = nM * nN; G = G_; c = c_; }
    __host__ __device__ bool next(int i, Unit& u) const {
        const long L = (long)i * G + c; if (L >= nwg) return false;
        int wgid = (int)L; { const int q = nwg / NXCD, r = nwg % NXCD, xcd = wgid % NXCD, off = wgid / NXCD; wgid = (xcd < r ? xcd * (q + 1) : r * (q + 1) + (xcd - r) * q) + off; }
        const int nig = WGM * nN, gid = wgid / nig, fm = gid * WGM, gsz = (nM - fm) < WGM ? (nM - fm) : WGM;
        u.pm = fm + ((wgid % nig) % gsz); u.pn = (wgid % nig) / gsz; return true;
    }
    __device__ __forceinline__ void a_ready(const Unit&) const {}
    __device__ __forceinline__ void done(const Unit&) const {}
};

__device__ __forceinline__ unsigned cvt_pk_bf16(float lo, float hi) { unsigned r; asm volatile("v_cvt_pk_bf16_f32 %0, %1, %2" : "=v"(r) : "v"(lo), "v"(hi)); return r; }
typedef float f32x2 __attribute__((ext_vector_type(2)));
__device__ __forceinline__ f32x2 gelu_pk(f32x2 v) {
    const f32x2 av = __builtin_elementwise_abs(v), d = av * 0.2316418882f + 1.0f;
    f32x2 t; t.x = __builtin_amdgcn_rcpf(d.x); t.y = __builtin_amdgcn_rcpf(d.y);
    f32x2 q = t * 0.5307027145f + (-0.7265760135f); q = q * t + 0.7107068705f; q = q * t + (-0.142248368f); q = q * t + 0.127414796f; q = q * t;
    const f32x2 s = (v * v) * (-0.72134752044f);
    f32x2 e; e.x = __builtin_amdgcn_exp2f(s.x); e.y = __builtin_amdgcn_exp2f(s.y);
    const f32x2 m = v * (q * e), r = v - m;
    f32x2 o; o.x = v.x < 0.f ? m.x : r.x; o.y = v.y < 0.f ? m.y : r.y; return o;
}


__device__ __forceinline__ const char* sgpr_ptr(const char* p) { const unsigned long long v = (unsigned long long)p; unsigned lo = (unsigned)v, hi = (unsigned)(v >> 32);
    asm volatile("" : "+s"(lo), "+s"(hi)); return (const char*)(((unsigned long long)hi << 32) | lo); }
template <int ACT  > struct EpiBf16 {
    static constexpr bool PERM = true, AFTER_DRAIN = false, EPI_LOADS = false; static_assert(ACT == 0 || ACT == 1, "EpiBf16: ACT is 0 (none) or 1 (gelu_pk)");
    bf16_t* O; int ldc; const float* bias; int split_cols; size_t split_stride; float scale0;
    __device__ __forceinline__ void operator()(const f32x4 (&acc)[2][2][4][2], const Unit& u, int wr, int wc, int fr, int fq) const {
        const int row0 = u.pm * BM + wr * 64 + fr; int colt = u.pn * BM; bf16_t* base = O;
        float sc = 1.f; if (split_cols) { const int t = colt / split_cols; base += (size_t)t * split_stride; colt -= t * split_cols; if (t == 0) sc = scale0; }
        const int col0 = colt + wc * 32 + 8 * fq, bcol0 = u.pn * BM + wc * 32 + 8 * fq;
        f32x4 bv[2][2];
#pragma unroll
        for (int bj = 0; bj < 2; ++bj)
#pragma unroll
            for (int n = 0; n < 2; ++n) bv[bj][n] = bias ? *(const f32x4*)(bias + bcol0 + bj * HALF + 4 * n) : (f32x4){0.f, 0.f, 0.f, 0.f};
#pragma unroll
        for (int ai = 0; ai < 2; ++ai)
#pragma unroll
            for (int m = 0; m < 4; ++m) { bf16_t* rowp = base + (size_t)(row0 + ai * HALF + m * 16) * ldc + col0;
#pragma unroll
                for (int bj = 0; bj < 2; ++bj) { f32x4 v0 = acc[ai][bj][m][0] + bv[bj][0], v1 = acc[ai][bj][m][1] + bv[bj][1];
                    if (ACT == 1) { f32x2 a = gelu_pk((f32x2){v0[0], v0[1]}), b = gelu_pk((f32x2){v0[2], v0[3]}), c = gelu_pk((f32x2){v1[0], v1[1]}), d = gelu_pk((f32x2){v1[2], v1[3]});
                        v0 = (f32x4){a.x, a.y, b.x, b.y}; v1 = (f32x4){c.x, c.y, d.x, d.y}; }
                    v0 = v0 * sc; v1 = v1 * sc; u32x4 w; w.x = cvt_pk_bf16(v0[0], v0[1]); w.y = cvt_pk_bf16(v0[2], v0[3]); w.z = cvt_pk_bf16(v1[0], v1[1]); w.w = cvt_pk_bf16(v1[2], v1[3]);
                    *(u32x4*)(rowp + bj * HALF) = w; } }
    }
};
__device__ __forceinline__ f32x4 sigm4(f32x4 v) { f32x4 o;
#pragma unroll
    for (int j = 0; j < 4; ++j) o[j] = __builtin_amdgcn_rcpf(1.0f + __builtin_amdgcn_exp2f(-1.4426950408889634f * v[j]));
    return o; }
__device__ __forceinline__ f32x4 gelu4(f32x4 v) { const f32x2 a = gelu_pk((f32x2){v[0], v[1]}), b = gelu_pk((f32x2){v[2], v[3]}); return (f32x4){a.x, a.y, b.x, b.y}; }
__device__ __forceinline__ void unpack8(const u32x4 w, f32x4& lo, f32x4& hi) {
    lo = (f32x4){__uint_as_float(w.x << 16), __uint_as_float(w.x & 0xffff0000u), __uint_as_float(w.y << 16), __uint_as_float(w.y & 0xffff0000u)};
    hi = (f32x4){__uint_as_float(w.z << 16), __uint_as_float(w.z & 0xffff0000u), __uint_as_float(w.w << 16), __uint_as_float(w.w & 0xffff0000u)}; }
#ifdef EPI_NT
#define EPI_ST(p, v) __builtin_nontemporal_store((v), (p))
#else
#define EPI_ST(p, v) (*(p) = (v))
#endif
struct EpiIn {
    static constexpr bool PERM = true, AFTER_DRAIN = false, EPI_LOADS = true;
    bf16_t* qkv; bf16_t* lx; bf16_t* gy; bf16_t* ga; bf16_t* gl; const float* bias;
    __device__ __forceinline__ void operator()(const f32x4 (&acc)[2][2][4][2], const Unit& u, int wr, int wc, int fr, int fq) const {
        const int pn = u.pn; bf16_t* base; int ldc, colt, act;
        if (pn < 24) { base = qkv + (size_t)(pn >> 3) * ((size_t)8192 * 2048); ldc = 2048; colt = (pn & 7) * 256; act = 0; }
        else if (pn < 32) { base = lx; ldc = 2048; colt = (pn - 24) * 256; act = 0; }
        else if (pn < 40) { base = gy; ldc = 2048; colt = (pn - 32) * 256; act = 1; }
        else if (pn < 56) { base = ga; ldc = 4096; colt = (pn - 40) * 256; act = 2; }
        else { base = gl; ldc = 4096; colt = (pn - 56) * 256; act = 2; }
        const int row0 = u.pm * BM + wr * 64 + fr, col0 = colt + wc * 32 + 8 * fq, bcol0 = pn * BM + wc * 32 + 8 * fq;
        f32x4 bv[2][2];
#pragma unroll
        for (int bj = 0; bj < 2; ++bj)
#pragma unroll
            for (int n = 0; n < 2; ++n) bv[bj][n] = *(const f32x4*)(bias + bcol0 + bj * HALF + 4 * n);
#pragma unroll
        for (int ai = 0; ai < 2; ++ai)
#pragma unroll
            for (int m = 0; m < 4; ++m) { bf16_t* rowp = base + (size_t)(row0 + ai * HALF + m * 16) * ldc + col0;
#pragma unroll
                for (int bj = 0; bj < 2; ++bj) { f32x4 v0 = acc[ai][bj][m][0] + bv[bj][0], v1 = acc[ai][bj][m][1] + bv[bj][1];
                    if (act == 1) { v0 = gelu4(v0); v1 = gelu4(v1); }
                    else if (act == 2) { v0 = sigm4(v0); v1 = sigm4(v1); }
                    u32x4 w; w.x = cvt_pk_bf16(v0[0], v0[1]); w.y = cvt_pk_bf16(v0[2], v0[3]); w.z = cvt_pk_bf16(v1[0], v1[1]); w.w = cvt_pk_bf16(v1[2], v1[3]);
                    EPI_ST((u32x4*)(rowp + bj * HALF), w); } }
    }
};
#ifndef EPI_PROBE
#define EPI_PROBE 0
#endif
struct EpiInProbe {
    static constexpr bool PERM = true, AFTER_DRAIN = false, EPI_LOADS = true;
    bf16_t* qkv; bf16_t* lx; bf16_t* gy; bf16_t* ga; bf16_t* gl; const float* bias;
    __device__ __forceinline__ void operator()(const f32x4 (&acc)[2][2][4][2], const Unit& u, int wr, int wc, int fr, int fq) const {
        const int pn = u.pn; bf16_t* base; int ldc, colt, act;
        if (pn < 24) { base = qkv + (size_t)(pn >> 3) * ((size_t)8192 * 2048); ldc = 2048; colt = (pn & 7) * 256; act = 0; }
        else if (pn < 32) { base = lx; ldc = 2048; colt = (pn - 24) * 256; act = 0; }
        else if (pn < 40) { base = gy; ldc = 2048; colt = (pn - 32) * 256; act = 1; }
        else if (pn < 56) { base = ga; ldc = 4096; colt = (pn - 40) * 256; act = 2; }
        else { base = gl; ldc = 4096; colt = (pn - 56) * 256; act = 2; }
        const int row0 = u.pm * BM + wr * 64 + fr, col0 = colt + wc * 32 + 8 * fq, bcol0 = pn * BM + wc * 32 + 8 * fq;
        f32x4 bv[2][2];
#pragma unroll
        for (int bj = 0; bj < 2; ++bj)
#pragma unroll
            for (int n = 0; n < 2; ++n) bv[bj][n] = (EPI_PROBE == 2) ? (f32x4){0.f, 0.f, 0.f, 0.f} : *(const f32x4*)(bias + bcol0 + bj * HALF + 4 * n);
#pragma unroll
        for (int ai = 0; ai < 2; ++ai)
#pragma unroll
            for (int m = 0; m < 4; ++m) { bf16_t* rowp = base + (size_t)(row0 + ai * HALF + m * 16) * ldc + col0;
#pragma unroll
                for (int bj = 0; bj < 2; ++bj) { f32x4 v0 = acc[ai][bj][m][0] + bv[bj][0], v1 = acc[ai][bj][m][1] + bv[bj][1];
                    if (act == 1) { v0 = gelu4(v0); v1 = gelu4(v1); }
                    else if (act == 2) { v0 = sigm4(v0); v1 = sigm4(v1); }
                    u32x4 w; w.x = cvt_pk_bf16(v0[0], v0[1]); w.y = cvt_pk_bf16(v0[2], v0[3]); w.z = cvt_pk_bf16(v1[0], v1[1]); w.w = cvt_pk_bf16(v1[2], v1[3]);
                    if (EPI_PROBE != 1 || w.x == 0x12345678u) EPI_ST((u32x4*)(rowp + bj * HALF), w); } }
    }
};
template <int MODE> struct EpiGate {
    static constexpr bool PERM = true, AFTER_DRAIN = false, EPI_LOADS = true;
    bf16_t* O; const bf16_t* Gt; int ldc;
    __device__ __forceinline__ void operator()(const f32x4 (&acc)[2][2][4][2], const Unit& u, int wr, int wc, int fr, int fq) const {
        const int row0 = u.pm * BM + wr * 64 + fr, col0 = u.pn * BM + wc * 32 + 8 * fq;
#pragma unroll
        for (int ai = 0; ai < 2; ++ai)
#pragma unroll
            for (int m = 0; m < 4; ++m) { const size_t off = (size_t)(row0 + ai * HALF + m * 16) * ldc + col0;
#pragma unroll
                for (int bj = 0; bj < 2; ++bj) { f32x4 g0, g1; unpack8(*(const u32x4*)(Gt + off + bj * HALF), g0, g1);
                    f32x4 v0 = acc[ai][bj][m][0] * g0, v1 = acc[ai][bj][m][1] * g1;
                    if (MODE == 1) { f32x4 t0, t1; unpack8(*(const u32x4*)(O + off + bj * HALF), t0, t1); v0 += t0; v1 += t1; }
                    u32x4 w; w.x = cvt_pk_bf16(v0[0], v0[1]); w.y = cvt_pk_bf16(v0[2], v0[3]); w.z = cvt_pk_bf16(v1[0], v1[1]); w.w = cvt_pk_bf16(v1[2], v1[3]);
                    *(u32x4*)(O + off + bj * HALF) = w; } }
    }
};
struct EpiGate2 {
    static constexpr bool PERM = true, AFTER_DRAIN = false, EPI_LOADS = true;
    bf16_t* O; const bf16_t* Ga; const bf16_t* Gl; int ldc;
    __device__ __forceinline__ void mid(f32x4 (&acc)[2][2][4][2], const Unit& u, int wr, int wc, int fr, int fq) const {
        const unsigned lb = (unsigned)(fr * ldc + 8 * fq) * 2u;
        const size_t ub = ((size_t)(u.pm * BM + wr * 64) * ldc + (size_t)(u.pn * BM + wc * 32)) * 2u;
        const char* ga = (const char*)Ga + ub; const char* gl = (const char*)Gl + ub;
#pragma unroll
        for (int ai = 0; ai < 2; ++ai)
#pragma unroll
            for (int m = 0; m < 4; ++m)
#pragma unroll
                for (int bj = 0; bj < 2; ++bj) { const size_t o = ((size_t)(ai * HALF + m * 16) * ldc + bj * HALF) * 2u;
                    f32x4 a0, a1, l0, l1; unpack8(*(const u32x4*)(sgpr_ptr(ga + o) + lb), a0, a1); unpack8(*(const u32x4*)(sgpr_ptr(gl + o) + lb), l0, l1);
#pragma unroll
                    for (int j = 0; j < 4; ++j) { acc[ai][bj][m][0][j] *= a0[j] * __builtin_amdgcn_rcpf(l0[j]); acc[ai][bj][m][1][j] *= a1[j] * __builtin_amdgcn_rcpf(l1[j]); }
                    __builtin_amdgcn_sched_barrier(0); }
    }
    __device__ __forceinline__ void operator()(const f32x4 (&acc)[2][2][4][2], const Unit& u, int wr, int wc, int fr, int fq) const {
        const int row0 = u.pm * BM + wr * 64 + fr, col0 = u.pn * BM + wc * 32 + 8 * fq;
#pragma unroll
        for (int ai = 0; ai < 2; ++ai)
#pragma unroll
            for (int m = 0; m < 4; ++m) { const size_t off = (size_t)(row0 + ai * HALF + m * 16) * ldc + col0;
#pragma unroll
                for (int bj = 0; bj < 2; ++bj) { f32x4 g0, g1; unpack8(*(const u32x4*)(Gl + off + bj * HALF), g0, g1);
                    const f32x4 v0 = acc[ai][bj][m][0] * g0, v1 = acc[ai][bj][m][1] * g1;
                    u32x4 w; w.x = cvt_pk_bf16(v0[0], v0[1]); w.y = cvt_pk_bf16(v0[2], v0[3]); w.z = cvt_pk_bf16(v1[0], v1[1]); w.w = cvt_pk_bf16(v1[2], v1[3]);
                    *(u32x4*)(O + off + bj * HALF) = w; } }
    }
};
struct EpiRes {
    static constexpr bool PERM = true, AFTER_DRAIN = false, EPI_LOADS = true;
    const float* X; bf16_t* Out; const float* gate; int ldc; const float* g2a; const float* g2b; bf16_t* XG; float* SSQ;
    __device__ __forceinline__ void operator()(const f32x4 (&acc)[2][2][4][2], const Unit& u, int wr, int wc, int fr, int fq) const {
        const int row0 = u.pm * BM + wr * 64 + fr, col0 = u.pn * BM + wc * 32 + 8 * fq;
        f32x4 gv[2][2], gp[2][2];
#pragma unroll
        for (int bj = 0; bj < 2; ++bj)
#pragma unroll
            for (int n = 0; n < 2; ++n) { gv[bj][n] = *(const f32x4*)(gate + col0 + bj * HALF + 4 * n);
                gp[bj][n] = *(const f32x4*)(g2a + col0 + bj * HALF + 4 * n) * (*(const f32x4*)(g2b + col0 + bj * HALF + 4 * n) + 1.0f); }
#pragma unroll
        for (int ai = 0; ai < 2; ++ai)
#pragma unroll
            for (int m = 0; m < 4; ++m) { const int row = row0 + ai * HALF + m * 16; const size_t off = (size_t)row * ldc + col0; float ss = 0.f;
#pragma unroll
                for (int bj = 0; bj < 2; ++bj) { const f32x4 xa = *(const f32x4*)(X + off + bj * HALF), xb = *(const f32x4*)(X + off + bj * HALF + 4);
                    const f32x4 y0 = xa + gv[bj][0] * acc[ai][bj][m][0], y1 = xb + gv[bj][1] * acc[ai][bj][m][1];
                    ss += ((y0[0] * y0[0] + y0[1] * y0[1]) + (y0[2] * y0[2] + y0[3] * y0[3])) + ((y1[0] * y1[0] + y1[1] * y1[1]) + (y1[2] * y1[2] + y1[3] * y1[3]));
                    u32x4 w; w.x = cvt_pk_bf16(y0[0], y0[1]); w.y = cvt_pk_bf16(y0[2], y0[3]); w.z = cvt_pk_bf16(y1[0], y1[1]); w.w = cvt_pk_bf16(y1[2], y1[3]); *(u32x4*)(Out + off + bj * HALF) = w;
                    const f32x4 g0 = y0 * gp[bj][0], g1 = y1 * gp[bj][1];
                    u32x4 wg; wg.x = cvt_pk_bf16(g0[0], g0[1]); wg.y = cvt_pk_bf16(g0[2], g0[3]); wg.z = cvt_pk_bf16(g1[0], g1[1]); wg.w = cvt_pk_bf16(g1[2], g1[3]); *(u32x4*)(XG + off + bj * HALF) = wg; }
                ss += __shfl_xor(ss, 16); ss += __shfl_xor(ss, 32);
                if (fq == 0) SSQ[(size_t)row * 64 + u.pn * 4 + wc] = ss; }
    }
};
struct EpiQ2 {
    static constexpr bool PERM = true, AFTER_DRAIN = false, EPI_LOADS = true;
    bf16_t* O; int ldc; const float* sb; const PG8_LAS float* rs; mutable int ne;
    __device__ __forceinline__ void operator()(const f32x4 (&acc)[2][2][4][2], const Unit& u, int wr, int wc, int fr, int fq) const {
        const int rl0 = wr * 64 + fr, row0 = u.pm * BM + rl0, col0 = u.pn * BM + wc * 32 + 8 * fq; const PG8_LAS float* rsp = rs + ((ne++) & 1) * 256;
        f32x4 bv[2][2];
#pragma unroll
        for (int bj = 0; bj < 2; ++bj)
#pragma unroll
            for (int n = 0; n < 2; ++n) bv[bj][n] = *(const f32x4*)(sb + col0 + bj * HALF + 4 * n);
#pragma unroll
        for (int ai = 0; ai < 2; ++ai)
#pragma unroll
            for (int m = 0; m < 4; ++m) { const float r = rsp[rl0 + ai * HALF + m * 16]; bf16_t* rowp = O + (size_t)(row0 + ai * HALF + m * 16) * ldc + col0;
#pragma unroll
                for (int bj = 0; bj < 2; ++bj) { const f32x4 v0 = acc[ai][bj][m][0] * r + bv[bj][0], v1 = acc[ai][bj][m][1] * r + bv[bj][1];
                    u32x4 w; w.x = cvt_pk_bf16(v0[0], v0[1]); w.y = cvt_pk_bf16(v0[2], v0[3]); w.z = cvt_pk_bf16(v1[0], v1[1]); w.w = cvt_pk_bf16(v1[2], v1[3]);
                    EPI_ST((u32x4*)(rowp + bj * HALF), w); } }
    }
};
struct RstdOrder : StaticOrder {
    const float* SSQ; PG8_LAS float* rs; float inv_n, eps; mutable int na;
    __device__ __forceinline__ void a_ready(const Unit& u) const {
        const int tid = threadIdx.x, r = tid >> 1, hf = tid & 1; const f32x4* p = (const f32x4*)(SSQ + (size_t)(u.pm * BM + r) * 64 + hf * 32); float s = 0.f;
#pragma unroll
        for (int k = 0; k < 8; ++k) { const f32x4 v = p[k]; s += (v[0] + v[1]) + (v[2] + v[3]); }
        s += __shfl_xor(s, 1);
        if (hf == 0) rs[(na & 1) * 256 + r] = 1.0f / sqrtf(s * inv_n + eps);
        ++na;
    }
};

struct EpiNullKeep {
    static constexpr bool PERM = true, AFTER_DRAIN = false, EPI_LOADS = false;
    float* sink;
    __device__ __forceinline__ void operator()(const f32x4 (&acc)[2][2][4][2], const Unit& u, int wr, int wc, int fr, int fq) const {
        f32x4 s = (f32x4){0.f, 0.f, 0.f, 0.f};
#pragma unroll
        for (int ai = 0; ai < 2; ++ai)
#pragma unroll
            for (int bj = 0; bj < 2; ++bj)
#pragma unroll
                for (int m = 0; m < 4; ++m) { s += acc[ai][bj][m][0]; s += acc[ai][bj][m][1]; }
        if (s[0] + s[1] + s[2] + s[3] == 1.2345e33f) sink[0] = 1.0f;
    }
};

#ifndef P2_MASKM
#define P2_MASKM 0xffff
#define P2_MASKN 0xffff
#endif
struct MaskOrder : StaticOrder {
    __host__ __device__ bool next(int i, Unit& u) const { const bool r = StaticOrder::next(i, u); u.pm &= P2_MASKM; u.pn &= P2_MASKN; return r; }
};

struct BalOrder : StaticOrder {
    bool on;
    __host__ __device__ bool next(int i, Unit& u) const { const bool r = StaticOrder::next(i, u);
        if (on) { const int p = u.pn / 36, k = u.pn % 36, ii = k >> 2, j = k & 3, idx = (ii >> 1) * 4 + j;
            u.pn = (p == 0) ? ((ii & 1) ? 36 + idx : idx) : ((ii & 1) ? 20 + idx : 52 + idx); }
        return r; }
};
template <class Epi, class Sched, bool ALIGN_EPI = false, bool SP2 = false, int DBG = 0, bool DUAL = false>
__device__ __forceinline__ void gemm_phase(PG8_LAS unsigned char* lds, const Gemm g, const Sched& S, const Epi& E) {
    const int tid = threadIdx.x, wid = __builtin_amdgcn_readfirstlane(tid >> 6), lane = tid & 63, wr = wid >> 2, wc = wid & 3, fr = lane & 15, fq = lane >> 4;
    const int K = g.K, nt = K / BK, LDA = g.lda ? g.lda : K, LDB = g.ldb ? g.ldb : K;
    unsigned voffA[2], voffB[2];
#pragma unroll
    for (int i = 0; i < 2; ++i) { int R, C; stage_rc(tid * 16 + i * 8192, R, C); const int Rb = Epi::PERM ? ((R & ~31) + perm32(R & 31)) : R;
        voffA[i] = (unsigned)(R * LDA + C) * 2u; voffB[i] = (unsigned)(Rb * LDB + C) * 2u; }
    const size_t kstep = (size_t)(BK * 2);
    const size_t hstepA = (size_t)HALF * LDA * 2, hstepB = (size_t)HALF * LDB * 2;
    const size_t tstepA = 2 * hstepA, tstepB = 2 * hstepB;
    const unsigned ldsw = (unsigned)wid * 1024u;
    const int aoff = lds_byte(wr * 64 + fr, fq * 8), boff = lds_byte(wc * 32 + fr, fq * 8);
#define PG8_SA(b, h) (((b) * 2 + (h)) * HTB)
#define PG8_SB(b, h) ((4 + (b) * 2 + (h)) * HTB)
#define PG8_STAGE(bufoff, gbase, voff) do { if constexpr (DBG != 1 && DBG != 3) _Pragma("unroll") for (int _i = 0; _i < 2; ++_i) \
        __builtin_amdgcn_global_load_lds((const unsigned*)((const char*)(gbase) + (voff)[_i]), (PG8_LAS unsigned*)(lds + (bufoff) + ldsw + _i * 8192), 16, 0, 0); } while (0)
#define PG8_LDA(dst, b, h) do { if constexpr (DBG < 2) _Pragma("unroll") for (int m = 0; m < 4; ++m) _Pragma("unroll") for (int k = 0; k < 2; ++k) dst[m][k] = *(const PG8_LAS bf16x8*)(lds + PG8_SA(b, h) + aoff + m * 2048 + k * 1024); } while (0)
#define PG8_LDB(dst, b, h) do { if constexpr (DBG < 2) _Pragma("unroll") for (int n = 0; n < 2; ++n) _Pragma("unroll") for (int k = 0; k < 2; ++k) dst[n][k] = *(const PG8_LAS bf16x8*)(lds + PG8_SB(b, h) + boff + n * 2048 + k * 1024); } while (0)
#define PG8_MMA(ai, bj, At, Bt) do { __builtin_amdgcn_s_setprio(PG8_PRIO_MMA); _Pragma("unroll") for (int m = 0; m < 4; ++m) _Pragma("unroll") for (int n = 0; n < 2; ++n) _Pragma("unroll") for (int k = 0; k < 2; ++k) \
        acc[ai][bj][m][n] = __builtin_amdgcn_mfma_f32_16x16x32_bf16(Bt[n][k], At[m][k], acc[ai][bj][m][n], 0, 0, 0); __builtin_amdgcn_s_setprio(PG8_PRIO_LD); } while (0)
#define PG8_MMAK(ai, bj, At, Bt, k) do { _Pragma("unroll") for (int m = 0; m < 4; ++m) _Pragma("unroll") for (int n = 0; n < 2; ++n) \
        acc[ai][bj][m][n] = __builtin_amdgcn_mfma_f32_16x16x32_bf16(Bt[n][k], At[m][k], acc[ai][bj][m][n], 0, 0, 0); } while (0)
#ifndef PG8_PRIO_MMA
#define PG8_PRIO_MMA 1
#define PG8_PRIO_LD 0
#endif
#ifndef PG8_NOMID
#define PG8_NOMID 0
#endif
#ifndef PG8_RELAX
#define PG8_RELAX 0
#endif
#ifndef PG8_EARLY
#define PG8_EARLY 0
#endif
#define PG8_MMA2(ai, At, B0, B1) do { if constexpr (PG8_EARLY) { PG8_BAR; __builtin_amdgcn_s_setprio(1); PG8_MMAK(ai, 0, At, B0, 0); PG8_MMAK(ai, 0, At, B0, 1); PG8_MMAK(ai, 1, At, B1, 0); PG8_SCHED; \
        PG8_BAR; PG8_SCHED; PG8_MMAK(ai, 1, At, B1, 1); __builtin_amdgcn_s_setprio(0); PG8_SCHED; } \
    else { PG8_BAR; PG8_MMA(ai, 0, At, B0); PG8_MMA(ai, 1, At, B1); PG8_BAR; PG8_SCHED; } } while (0)
#define PG8_WAIT_V(n) asm volatile("s_waitcnt vmcnt(" #n ")" ::: "memory")
#define PG8_WAIT_L(n) asm volatile("s_waitcnt lgkmcnt(" #n ")" ::: "memory")
#define PG8_BAR __builtin_amdgcn_s_barrier()
#define PG8_SCHED __builtin_amdgcn_sched_barrier(0)
    Unit cur, nxt; int ui = 0;
    if (!S.next(0, cur)) return;
    f32x4 acc[2][2][4][2];
#pragma unroll
    for (int a = 0; a < 2; ++a)
#pragma unroll
        for (int b = 0; b < 2; ++b)
#pragma unroll
            for (int m = 0; m < 4; ++m)
#pragma unroll
                for (int n = 0; n < 2; ++n) acc[a][b][m][n] = (f32x4){0.f, 0.f, 0.f, 0.f};
    bf16x8 At[4][2], B0[2][2], B1[2][2];
    if constexpr (DBG >= 2) { _Pragma("unroll") for (int m = 0; m < 4; ++m) _Pragma("unroll") for (int k = 0; k < 2; ++k) { At[m][k] = *(const PG8_LAS bf16x8*)(lds + aoff + m * 2048 + k * 1024); }
        _Pragma("unroll") for (int n = 0; n < 2; ++n) _Pragma("unroll") for (int k = 0; k < 2; ++k) { B0[n][k] = *(const PG8_LAS bf16x8*)(lds + boff + n * 2048 + k * 1024); B1[n][k] = *(const PG8_LAS bf16x8*)(lds + boff + 8192 + n * 2048 + k * 1024); } }
    const char* cA = (const char*)g.A + (size_t)cur.pm * tstepA; const char* cB = (const char*)g.Bt + (size_t)cur.pn * tstepB;
    const int ns = DUAL ? g.ksplit / BK : 0; const char* cA2 = DUAL ? (const char*)g.A2 + (size_t)cur.pm * tstepA : cA; const char* cB2 = DUAL ? (const char*)g.Bt2 + (size_t)cur.pn * tstepB : cB;
    S.a_ready(cur);
    if constexpr (SP2) {
        PG8_STAGE(PG8_SB(0, 0), cB, voffB); PG8_STAGE(PG8_SB(0, 1), cB + hstepB, voffB); PG8_STAGE(PG8_SA(0, 0), cA, voffA); PG8_STAGE(PG8_SA(0, 1), cA + hstepA, voffA);
        if (wr == 1) PG8_BAR;
        PG8_WAIT_V(2); PG8_BAR;
        PG8_STAGE(PG8_SB(1, 0), cB + kstep, voffB); PG8_STAGE(PG8_SA(1, 0), cA + kstep, voffA); PG8_STAGE(PG8_SB(1, 1), cB + hstepB + kstep, voffB);
        PG8_WAIT_V(6); PG8_BAR;
    } else {
        PG8_STAGE(PG8_SB(0, 0), cB, voffB); PG8_STAGE(PG8_SA(0, 0), cA, voffA); PG8_STAGE(PG8_SB(0, 1), cB + hstepB, voffB); PG8_STAGE(PG8_SA(0, 1), cA + hstepA, voffA);
        if (wr == 1) PG8_BAR;
        PG8_WAIT_V(4); PG8_BAR;
        PG8_STAGE(PG8_SB(1, 0), cB + kstep, voffB); PG8_STAGE(PG8_SA(1, 0), cA + kstep, voffA); PG8_STAGE(PG8_SB(1, 1), cB + hstepB + kstep, voffB);
        PG8_WAIT_V(6); PG8_BAR;
    }
    for (;;) {
        const bool has_next = S.next(ui + 1, nxt);
        const char* nA = has_next ? (const char*)g.A + (size_t)nxt.pm * tstepA : cA; const char* nB = has_next ? (const char*)g.Bt + (size_t)nxt.pn * tstepB : cB;
#pragma unroll 1
        for (int hf = 0; hf < (DUAL ? 2 : 1); ++hf) {
        const char* hA = (DUAL && hf) ? cA2 : cA; const char* hB = (DUAL && hf) ? cB2 : cB;
        const char* xA = (DUAL && !hf) ? cA2 : nA; const char* xB = (DUAL && !hf) ? cB2 : nB;
        const int ntl = DUAL ? (hf ? nt - ns : ns) : nt; const bool ulast = !DUAL || hf == 1;
        for (int t = 0; t < ntl; t += 2) {
            const bool last = (t == ntl - 2);
            const char* a1 = hA + (size_t)(t + 1) * kstep;
            const char* a2 = last ? xA : hA + (size_t)(t + 2) * kstep; const char* b2 = last ? xB : hB + (size_t)(t + 2) * kstep;
            const char* a3 = a2 + kstep; const char* b3 = b2 + kstep;
            if (last && ulast && has_next) S.a_ready(nxt);
            if constexpr (SP2) {
            const int relax_i = __builtin_amdgcn_readfirstlane((PG8_RELAX && Epi::EPI_LOADS && t == 0 && hf == 0 && ui > 0) ? 1 : 0);
#define PG8_WAIT_V0 asm volatile("s_cmp_lg_u32 %0, 0\n\ts_cbranch_scc1 1\n\ts_waitcnt vmcnt(8)" :: "s"(relax_i) : "memory", "scc")

#ifdef PG8_DMAFIRST
            PG8_STAGE(PG8_SA(1, 1), a1 + hstepA, voffA); PG8_SCHED; PG8_LDB(B0, 0, 0); PG8_LDB(B1, 0, 1); PG8_SCHED; PG8_LDA(At, 0, 0);
#else
            PG8_LDB(B0, 0, 0); PG8_LDB(B1, 0, 1); PG8_SCHED; PG8_LDA(At, 0, 0); PG8_STAGE(PG8_SA(1, 1), a1 + hstepA, voffA);
#endif

            PG8_WAIT_V0; PG8_WAIT_L(0); PG8_MMA2(0, At, B0, B1);

#ifdef PG8_DMAFIRST
            PG8_STAGE(PG8_SB(0, 0), b2, voffB); PG8_STAGE(PG8_SB(0, 1), b2 + hstepB, voffB); PG8_STAGE(PG8_SA(0, 0), a2, voffA); PG8_SCHED; PG8_LDA(At, 0, 1);
#else
            PG8_LDA(At, 0, 1); PG8_STAGE(PG8_SB(0, 0), b2, voffB); PG8_STAGE(PG8_SB(0, 1), b2 + hstepB, voffB); PG8_STAGE(PG8_SA(0, 0), a2, voffA);
#endif

            PG8_WAIT_V0; PG8_WAIT_L(0); PG8_MMA2(1, At, B0, B1);

#ifdef PG8_DMAFIRST
            PG8_STAGE(PG8_SA(0, 1), a2 + hstepA, voffA); PG8_SCHED; PG8_LDB(B0, 1, 0); PG8_LDB(B1, 1, 1); PG8_SCHED; PG8_LDA(At, 1, 0);
#else
            PG8_LDB(B0, 1, 0); PG8_LDB(B1, 1, 1); PG8_SCHED; PG8_LDA(At, 1, 0); PG8_STAGE(PG8_SA(0, 1), a2 + hstepA, voffA);
#endif

            PG8_WAIT_V(8); PG8_WAIT_L(0); PG8_MMA2(0, At, B0, B1);

#ifdef PG8_DMAFIRST
            PG8_STAGE(PG8_SB(1, 0), b3, voffB); PG8_STAGE(PG8_SB(1, 1), b3 + hstepB, voffB); PG8_STAGE(PG8_SA(1, 0), a3, voffA); PG8_SCHED; PG8_LDA(At, 1, 1);
#else
            PG8_LDA(At, 1, 1); PG8_STAGE(PG8_SB(1, 0), b3, voffB); PG8_STAGE(PG8_SB(1, 1), b3 + hstepB, voffB); PG8_STAGE(PG8_SA(1, 0), a3, voffA);
#endif

            PG8_WAIT_V(8); PG8_WAIT_L(0); PG8_MMA2(1, At, B0, B1);
            } else {
            PG8_LDB(B0, 0, 0); PG8_SCHED; PG8_LDA(At, 0, 0); PG8_STAGE(PG8_SA(1, 1), a1 + hstepA, voffA);
            PG8_WAIT_L(8); PG8_BAR; PG8_WAIT_L(0); PG8_MMA(0, 0, At, B0); PG8_BAR; PG8_SCHED;
            PG8_LDB(B1, 0, 1); PG8_STAGE(PG8_SB(0, 0), b2, voffB);
            PG8_BAR; PG8_WAIT_L(0); PG8_MMA(0, 1, At, B1); PG8_BAR;
            PG8_LDA(At, 0, 1); PG8_STAGE(PG8_SA(0, 0), a2, voffA);
            PG8_BAR; PG8_WAIT_L(0); PG8_MMA(1, 0, At, B0); PG8_BAR; PG8_SCHED;
            PG8_STAGE(PG8_SB(0, 1), b2 + hstepB, voffB);
            PG8_WAIT_V(6); PG8_BAR; PG8_MMA(1, 1, At, B1); PG8_BAR;
            PG8_LDB(B0, 1, 0); PG8_SCHED; PG8_LDA(At, 1, 0); PG8_STAGE(PG8_SA(0, 1), a2 + hstepA, voffA);
            PG8_WAIT_L(8); PG8_BAR; PG8_WAIT_L(0); PG8_MMA(0, 0, At, B0); PG8_BAR; PG8_SCHED;
            PG8_LDB(B1, 1, 1); PG8_STAGE(PG8_SB(1, 0), b3, voffB);
            PG8_BAR; PG8_WAIT_L(0); PG8_MMA(0, 1, At, B1); PG8_BAR;
            PG8_LDA(At, 1, 1); PG8_STAGE(PG8_SA(1, 0), a3, voffA);
            PG8_BAR; PG8_WAIT_L(0); PG8_MMA(1, 0, At, B0); PG8_BAR; PG8_SCHED;
            PG8_STAGE(PG8_SB(1, 1), b3 + hstepB, voffB);
            PG8_WAIT_V(6); PG8_BAR; PG8_MMA(1, 1, At, B1); PG8_BAR;
            }
        }
        if constexpr (DUAL) { if (hf == 0) { if (wr == 0) PG8_BAR; E.mid(acc, cur, wr, wc, fr, fq); if (wr == 1) PG8_BAR; } }
        }
        if constexpr (ALIGN_EPI) { if (wr == 0) PG8_BAR; }
        if constexpr (!Epi::AFTER_DRAIN) { E(acc, cur, wr, wc, fr, fq); S.done(cur); }
        if (!has_next) break;
#pragma unroll
        for (int a = 0; a < 2; ++a)
#pragma unroll
            for (int b = 0; b < 2; ++b)
#pragma unroll
                for (int m = 0; m < 4; ++m)
#pragma unroll
                    for (int n = 0; n < 2; ++n) acc[a][b][m][n] = (f32x4){0.f, 0.f, 0.f, 0.f};
        cur = nxt; cA = nA; cB = nB; ++ui;
        if constexpr (DUAL) { cA2 = (const char*)g.A2 + (size_t)cur.pm * tstepA; cB2 = (const char*)g.Bt2 + (size_t)cur.pn * tstepB; }
        if constexpr (ALIGN_EPI) { if (wr == 1) PG8_BAR; }
    }
    PG8_WAIT_V(0);
    if constexpr (!ALIGN_EPI) { if (wr == 0) PG8_BAR; }
    PG8_BAR;
    if constexpr (Epi::AFTER_DRAIN) { E.fused(acc, cur, wr, wc, fr, fq, lds, wid, lane); S.done(cur); }
#undef PG8_SA
#undef PG8_SB
#undef PG8_STAGE
#undef PG8_LDA
#undef PG8_LDB
#undef PG8_MMA
#undef PG8_MMAK
#undef PG8_MMA2
#undef PG8_WAIT_V
#undef PG8_WAIT_V0
#undef PG8_WAIT_L
#undef PG8_BAR
#undef PG8_SCHED
}
}
namespace attn_body {
constexpr int D = 128, LD = 2048;
constexpr float THR = 8.f; constexpr bool WSKIP = false;
constexpr float SCALE = 0.08838834764831845f;
constexpr int NW = 8, QBLK = 32, KVBLK = 64, QB = NW * QBLK;
constexpr int SHM_V = KVBLK * D * 2, SHM_K = KVBLK * D * 2;
constexpr int LDS_BYTES = 2 * SHM_V + 2 * SHM_K + NW * 64 * 4;

typedef short bf16x8 __attribute__((ext_vector_type(8)));
typedef short s16x4 __attribute__((ext_vector_type(4)));
typedef float f32x16 __attribute__((ext_vector_type(16)));
typedef float f32x4 __attribute__((ext_vector_type(4)));
typedef unsigned u32x4 __attribute__((ext_vector_type(4)));
template <class A, class Bt> struct same_t { static constexpr bool v = false; };
template <class A> struct same_t<A, A> { static constexpr bool v = true; };

#define KSWZ(row, colB) ((row) * 256 + ((colB) ^ (((row) & 7) << 4)))
#define SBAR() __builtin_amdgcn_sched_barrier(0)
__device__ __forceinline__ int v_st(int k, int c) { const int kk = (k & ~0xC) | ((k & 4) << 1) | ((k & 8) >> 1); return ((kk >> 3) * 4 + (c >> 5)) * 512 + ((kk & 7) * 32 + (c & 31)) * 2; }
__device__ __forceinline__ int v_rd_base(int lane) { return ((lane & 3) << 3) | (((lane >> 2) & 3) << 6) | (((lane >> 4) & 1) << 5) | (((lane >> 5) & 1) << 8); }
constexpr int v_rd_off(int d0, int ks, int half) { return d0 * 512 + ks * 4096 + half * 2048; }
__device__ __forceinline__ int crow(int r, int hi) { return (r & 3) + 8 * (r >> 2) + 4 * hi; }
__device__ __forceinline__ unsigned cvtpk(float lo, float hi) {
    unsigned r; asm volatile("v_cvt_pk_bf16_f32 %0, %1, %2" : "=v"(r) : "v"(lo), "v"(hi)); return r;
}
__device__ __forceinline__ bf16x8 pack8(f32x4 a, f32x4 b) {
    u32x4 w = {cvtpk(a[0], a[1]), cvtpk(a[2], a[3]), cvtpk(b[0], b[1]), cvtpk(b[2], b[3])};
    return *reinterpret_cast<bf16x8*>(&w);
}
template <class T> __device__ __forceinline__ bf16x8 load8(const T* p) {
    if constexpr (same_t<T, float>::v) { return pack8(*(const f32x4*)p, *(const f32x4*)(p + 4)); }
    else { return *reinterpret_cast<const bf16x8*>(p); }
}
__device__ __forceinline__ void mask_tile(f32x16& p0, f32x16& p1, int dq, unsigned W) {
    const float NEG = -__builtin_inff();
#pragma unroll
    for (int r = 0; r < 16; ++r) {
        const int c = (r & 3) + 8 * (r >> 2);
        if ((unsigned)(dq - c) >= W) p0[r] = NEG;
        if ((unsigned)(dq - c - 32) >= W) p1[r] = NEG;
    }
}
__device__ __forceinline__ void partialSM(f32x16& p0, f32x16& p1, float& m_reg, float& mn, float& alpha) {
    float pmax = p0[0]; for (int r = 1; r < 16; ++r) pmax = fmaxf(pmax, p0[r]); for (int r = 0; r < 16; ++r) pmax = fmaxf(pmax, p1[r]);
    { auto rr = __builtin_amdgcn_permlane32_swap(__float_as_uint(pmax), __float_as_uint(pmax), false, false);
      pmax = fmaxf(__uint_as_float(rr[0]), __uint_as_float(rr[1])); }
    constexpr float C2 = 1.4426950408889634f * SCALE;
    if (__builtin_expect(__all((pmax - m_reg) * SCALE <= THR), 1)) { mn = m_reg; alpha = 1.f; }
    else { mn = fmaxf(m_reg, pmax); alpha = __builtin_amdgcn_exp2f((m_reg - mn) * C2); m_reg = mn; }
    const float mnL = -mn * C2;
    for (int r = 0; r < 16; ++r) p0[r] = fmaf(p0[r], C2, mnL); for (int r = 0; r < 16; ++r) p1[r] = fmaf(p1[r], C2, mnL);
    for (int r = 0; r < 16; ++r) p0[r] = __builtin_amdgcn_exp2f(p0[r]);
}
__device__ __forceinline__ void finishSM(f32x16& p0, f32x16& p1, float alpha, float& l_reg, bf16x8& pa0, bf16x8& pa1, bf16x8& pa2, bf16x8& pa3) {
    for (int r = 0; r < 16; ++r) p1[r] = __builtin_amdgcn_exp2f(p1[r]);
    float ps = 0; for (int r = 0; r < 16; ++r) ps += p0[r]; for (int r = 0; r < 16; ++r) ps += p1[r];
    { auto rr = __builtin_amdgcn_permlane32_swap(__float_as_uint(ps), __float_as_uint(ps), false, false);
      ps = __uint_as_float(rr[0]) + __uint_as_float(rr[1]); }
    l_reg = l_reg * alpha + ps;
#define PK4(P, B_, OUT) do { unsigned a0 = cvtpk(P[B_+0], P[B_+1]), a1 = cvtpk(P[B_+2], P[B_+3]);                          \
        unsigned b0 = cvtpk(P[B_+4], P[B_+5]), b1 = cvtpk(P[B_+6], P[B_+7]);                                             \
        auto r0 = __builtin_amdgcn_permlane32_swap(a0, b0, false, false); auto r1 = __builtin_amdgcn_permlane32_swap(a1, b1, false, false); \
        u32x4 w = {r0[0], r1[0], r0[1], r1[1]}; OUT = *reinterpret_cast<bf16x8*>(&w); } while (0)
    PK4(p0, 0, pa0); PK4(p0, 8, pa1); PK4(p1, 0, pa2); PK4(p1, 8, pa3);
#undef PK4
}
template <int KB, bool SK>
__device__ __forceinline__ void qkt(f32x16& p0, f32x16& p1, const char* K_lds, int r32, int hi, const bf16x8* qr, bool act, const float* bt) {
    if (SK && !act) { const float NEG = -__builtin_inff();
#pragma unroll
        for (int r = 0; r < 16; ++r) { p0[r] = NEG; p1[r] = NEG; } return; }
    { const f32x4 b0 = *(const f32x4*)(bt), b1 = *(const f32x4*)(bt + 8), b2 = *(const f32x4*)(bt + 16), b3 = *(const f32x4*)(bt + 24);
      const f32x4 c0 = *(const f32x4*)(bt + 32), c1 = *(const f32x4*)(bt + 40), c2 = *(const f32x4*)(bt + 48), c3 = *(const f32x4*)(bt + 56);
      p0 = (f32x16){b0[0], b0[1], b0[2], b0[3], b1[0], b1[1], b1[2], b1[3], b2[0], b2[1], b2[2], b2[3], b3[0], b3[1], b3[2], b3[3]};
      p1 = (f32x16){c0[0], c0[1], c0[2], c0[3], c1[0], c1[1], c1[2], c1[3], c2[0], c2[1], c2[2], c2[3], c3[0], c3[1], c3[2], c3[3]}; }
    const char* kb[4];
#pragma unroll
    for (int dd = 0; dd < 4; ++dd) kb[dd] = K_lds + KB * SHM_K + KSWZ(r32, (dd * 16 + hi * 8) * 2);
#pragma unroll
    for (int d0 = 0; d0 < 8; ++d0) { const char* a = kb[d0 & 3] + (d0 >> 2) * 128;
        bf16x8 b0 = *reinterpret_cast<const bf16x8*>(a);
        bf16x8 b1 = *reinterpret_cast<const bf16x8*>(a + 32 * 256);
        p0 = __builtin_amdgcn_mfma_f32_32x32x16_bf16(b0, qr[d0], p0, 0, 0, 0);
        p1 = __builtin_amdgcn_mfma_f32_32x32x16_bf16(b1, qr[d0], p1, 0, 0, 0); }
}
template <int VB, bool SK>
__device__ __forceinline__ void pv_tile(f32x16* o, int vb0, bf16x8 pa0, bf16x8 pa1, bf16x8 pa2, bf16x8 pa3, bool act) {
    if (SK && !act) return;
#define TRRD(dst, off) asm volatile("ds_read_b64_tr_b16 %0, %1 offset:%2" : "=&v"(dst) : "v"(vb0), "i"(off) : "memory")
#define PV_D0(d0) do { s16x4 l0, l1, l2, l3, h0, h1, h2, h3; constexpr int b_ = VB * SHM_V + v_rd_off(d0, 0, 0);     \
        TRRD(l0, b_); TRRD(h0, b_ + 2048); TRRD(l1, b_ + 4096); TRRD(h1, b_ + 6144); TRRD(l2, b_ + 8192); TRRD(h2, b_ + 10240); TRRD(l3, b_ + 12288); TRRD(h3, b_ + 14336); \
        asm volatile("s_waitcnt lgkmcnt(0)" ::: "memory"); SBAR();                 \
        o[d0] = __builtin_amdgcn_mfma_f32_32x32x16_bf16(pa0, (bf16x8){l0[0], l0[1], l0[2], l0[3], h0[0], h0[1], h0[2], h0[3]}, o[d0], 0, 0, 0);   \
        o[d0] = __builtin_amdgcn_mfma_f32_32x32x16_bf16(pa1, (bf16x8){l1[0], l1[1], l1[2], l1[3], h1[0], h1[1], h1[2], h1[3]}, o[d0], 0, 0, 0);   \
        o[d0] = __builtin_amdgcn_mfma_f32_32x32x16_bf16(pa2, (bf16x8){l2[0], l2[1], l2[2], l2[3], h2[0], h2[1], h2[2], h2[3]}, o[d0], 0, 0, 0);   \
        o[d0] = __builtin_amdgcn_mfma_f32_32x32x16_bf16(pa3, (bf16x8){l3[0], l3[1], l3[2], l3[3], h3[0], h3[1], h3[2], h3[3]}, o[d0], 0, 0, 0); } while (0)
    PV_D0(0); PV_D0(1); PV_D0(2); PV_D0(3);
#undef PV_D0
#undef TRRD
}


template <class TIn, class TOut> struct BlockRef { const TIn* Q; const TIn* K; const TIn* V; TOut* O; int P0; int jlo; };
#define ROW(p, k0, rr) ((p) + (size_t)((k0) + (rr)) * LD + sc)
#define VMW() asm volatile("s_waitcnt vmcnt(0)" ::: "memory")
#define SLOAD_H(Kp, Vp, k0) do { st_v0 = load8<TIn>(ROW(Vp, k0, sr)); st_v1 = load8<TIn>(ROW(Vp, k0, 32 + sr));              \
                         st_k0 = load8<TIn>(ROW(Kp, k0, sr)); st_k1 = load8<TIn>(ROW(Kp, k0, 32 + sr)); } while (0)
#define SWRITE_H(bf) do { *(bf16x8*)(V_lds + (bf) * SHM_V + vst0) = st_v0; *(bf16x8*)(V_lds + (bf) * SHM_V + vst1) = st_v1;   \
                          *(bf16x8*)(K_lds + (bf) * SHM_K + kws) = st_k0; *(bf16x8*)(K_lds + (bf) * SHM_K + kws + 32 * 256) = st_k1; } while (0)
template <class TIn, class TOut>
__device__ __forceinline__ void attn_unit(const BlockRef<TIn, TOut>& cur, int skv, char* lds) {
    const int tid = threadIdx.x, wid = __builtin_amdgcn_readfirstlane(tid >> 6), lane = tid & 63, r32 = lane & 31, hi = lane >> 5;
    const unsigned W = 0x40000000u;
    const int j_lo = cur.jlo;
    int j_hi = (cur.P0 + QB - 1) / KVBLK + 1; if (j_hi > skv / KVBLK) j_hi = skv / KVBLK;
    const int NT = j_hi - j_lo;
    const int qlo = cur.P0 + wid * QBLK, qm = qlo + r32 - 4 * hi;
    char* V_lds = lds; char* K_lds = lds + 2 * SHM_V;
    float* ws = (float*)(lds + 2 * SHM_V + 2 * SHM_K) + wid * 64; float* li_l = ws, * al_l = ws + 32;
    const float* bias_l = (const float*)(lds + LDS_BYTES) + 4 * hi;
    float m_reg = -1e30f, l_reg = 0; f32x16 o[4] = {};
    const int sr = tid >> 4, sc = (tid & 15) * 8, vst0 = v_st(sr, sc), vst1 = v_st(32 + sr, sc), kws = KSWZ(sr, sc * 2);
    const int vb0 = (int)(uintptr_t)V_lds + v_rd_base(lane);
    const TIn* Kh = cur.K; const TIn* Vh = cur.V;
    bf16x8 st_v0, st_v1, st_k0, st_k1; bf16x8 qr[8];
#define KBASE(t) ((j_lo + (t)) * KVBLK)
#define BT(t) (bias_l + (t) * KVBLK)
#define RESC(a) do { if (__any((a) < 1.f)) { if (hi == 0) al_l[r32] = (a); asm volatile("s_waitcnt lgkmcnt(0)" ::: "memory");              \
                     for (int d_ = 0; d_ < 4; ++d_) for (int r = 0; r < 16; ++r) o[d_][r] *= al_l[crow(r, hi)]; } } while (0)
#define MASKT(P0_, P1_, t) do { const int kb_ = KBASE(t); if (kb_ + KVBLK - 1 > qlo) mask_tile(P0_, P1_, qm - kb_, W); } while (0)
#pragma unroll
    for (int d0 = 0; d0 < 8; ++d0) qr[d0] = load8<TIn>(cur.Q + (size_t)(wid * QBLK + r32) * LD + d0 * 16 + hi * 8);
    SLOAD_H(Kh, Vh, KBASE(0)); VMW(); SWRITE_H(0); SBAR();
    if (NT > 1) SLOAD_H(Kh, Vh, KBASE(1));
    __syncthreads();
    f32x16 p0, p1; float mn, al; bf16x8 pa0, pa1, pa2, pa3;
#define TILE_STEP(t, BUF) do {                                                                                                 \
        SBAR(); qkt<BUF, false>(p0, p1, K_lds, r32, hi, qr, true, BT(t));                                                       \
        MASKT(p0, p1, (t)); partialSM(p0, p1, m_reg, mn, al); RESC(al);                                                          \
        finishSM(p0, p1, al, l_reg, pa0, pa1, pa2, pa3); SBAR();                                                                 \
        pv_tile<BUF, false>(o, vb0, pa0, pa1, pa2, pa3, true);                                                                    \
        if ((t) + 1 < NT) { VMW(); SWRITE_H(1 - (BUF)); SBAR(); if ((t) + 2 < NT) SLOAD_H(Kh, Vh, KBASE((t) + 2)); }              \
        __syncthreads(); } while (0)
    for (int t = 0; t < NT; t += 2) {
        TILE_STEP(t, 0);
        if (t + 1 < NT) TILE_STEP(t + 1, 1);
    }
    if (hi == 0) li_l[r32] = l_reg; asm volatile("s_waitcnt lgkmcnt(0)" ::: "memory");
    float rli[16];
#pragma unroll
    for (int r = 0; r < 16; ++r) rli[r] = __builtin_amdgcn_rcpf(li_l[crow(r, hi)]);
    TOut* Ow = cur.O + (size_t)(wid * QBLK) * LD;
#pragma unroll
    for (int r = 0; r < 16; ++r) { const int orow = crow(r, hi);
#pragma unroll
        for (int d0 = 0; d0 < 4; ++d0) { const float v = o[d0][r] * rli[r];
            const float vn = __shfl_xor(v, 1);
            if ((r32 & 1) == 0) *(unsigned*)(Ow + (size_t)orow * LD + d0 * 32 + r32) = cvtpk(v, vn); } }
    __syncthreads();
#undef TILE_STEP
#undef RESC
#undef KBASE
#undef BT
#undef MASKT
}
#undef ROW
#undef VMW
#undef SLOAD_H
#undef SWRITE_H
}
#define GAS __attribute__((address_space(1)))
#define LAS __attribute__((address_space(3)))
typedef unsigned short bf16;
typedef unsigned v4u __attribute__((ext_vector_type(4)));
typedef unsigned v2u __attribute__((ext_vector_type(2)));
typedef float f32x4 __attribute__((ext_vector_type(4)));
typedef float f32x2 __attribute__((ext_vector_type(2)));
typedef short bf16x8 __attribute__((ext_vector_type(8)));
typedef GAS unsigned gu32;
#define RLX_AGENT __ATOMIC_RELAXED, __HIP_MEMORY_SCOPE_AGENT

constexpr int S = 8192, DM = 4096, NH = 16, HD = 128, AW = 2048, LW = 2048, NG = 16, GD = 128;
constexpr int NIN = 18448, NINP = 18432;
constexpr int C_Q = 0, C_K = 2048, C_V = 4096, C_F = 6144, C_LX = 6160, C_LY = 8208, C_GA = 10256, C_GL = 14352;
constexpr int PEER_H = 8, PEER_NK = 128, PEER_K = 16, PEER_NE = 16384;
constexpr float EPS = 1e-6f;
constexpr size_t MiB = 1u << 20;
constexpr size_t WS_CTL = 0, CTL_ZERO_BYTES = 32768;
constexpr size_t WS_MOD = 512 * 1024;
constexpr size_t WS_WF = 2 * MiB;
constexpr size_t WS_LOGF = 3 * MiB;
constexpr size_t WS_FC = 4 * MiB;
constexpr size_t WS_AGGA = 5 * MiB, WS_AGGB = 6 * MiB;
constexpr size_t WS_BIASR = 7 * MiB, WS_SB = 7 * MiB + 262144;
constexpr size_t WS_SSQ = 28 * MiB;
constexpr size_t WS_WAT = 8 * MiB, WS_WXT = 9 * MiB;
constexpr size_t WS_SK = 10 * MiB, WS_RS = 11 * MiB, WS_RSU = 11 * MiB + 65536;
constexpr size_t WS_IDX = 12 * MiB, WS_GATE = 16 * MiB, WS_IDX2 = 20 * MiB, WS_GATE2 = 24 * MiB;
constexpr size_t WS_WIN = 32 * MiB, WS_WAO = 176 * MiB, WS_WLO = 192 * MiB, WS_WOUT = 208 * MiB, WS_WPQ = 240 * MiB;
constexpr size_t WS_U = 256 * MiB, WS_V = 384 * MiB;
constexpr size_t WS_HA = 512 * MiB;
constexpr size_t WS_QKV = 576 * MiB;
constexpr size_t WS_LX = 672 * MiB, WS_GY = 704 * MiB, WS_GA = 736 * MiB, WS_GL = 800 * MiB;
constexpr size_t WS_ATT = 864 * MiB, WS_LR = 896 * MiB, WS_T1 = 928 * MiB, WS_MG = 992 * MiB, WS_Q2 = 1056 * MiB, WS_X1 = 1088 * MiB, WS_END = 1216 * MiB;
constexpr int CW_BAR = 4096;
constexpr int CW_QATT = 256;
constexpr int RING_BYTES = 131072;
constexpr int LDSCTL_OFF = 150528, MISC_OFF = LDSCTL_OFF + 320;
constexpr int LDS_BYTES = 151552;
constexpr int NWAVES = 8, NTHREADS = 512;

__device__ __forceinline__ unsigned f2bf(float f) { unsigned u = __builtin_bit_cast(unsigned, f); return (u + 0x7fffu + ((u >> 16) & 1u)) >> 16; }
__device__ __forceinline__ unsigned pk2(float lo, float hi) { return f2bf(lo) | (f2bf(hi) << 16); }
__device__ __forceinline__ float bflo(unsigned w) { return __uint_as_float(w << 16); }
__device__ __forceinline__ float bfhi(unsigned w) { return __uint_as_float(w & 0xffff0000u); }
__device__ __forceinline__ float bf2f(bf16 b) { return __uint_as_float((unsigned)b << 16); }
__device__ __forceinline__ float wave_sum(float v) {
#pragma unroll
    for (int o = 1; o < 64; o <<= 1) v += __shfl_xor(v, o);
    return v;
}
__device__ __forceinline__ float wave_max(float v) {
#pragma unroll
    for (int o = 1; o < 64; o <<= 1) v = fmaxf(v, __shfl_xor(v, o));
    return v;
}
__device__ __forceinline__ float sigmoidf_(float v) { return __builtin_amdgcn_rcpf(1.0f + __builtin_amdgcn_exp2f(-1.4426950408889634f * v)); }
__device__ __forceinline__ float gelu_erf(float v) { return 0.5f * v * (1.0f + erff(v * 0.70710678118654752f)); }
#define XB_TMO      128
#define XB_XCNT(j)  (256  + 64 * (j))
#define XB_XSUB(j)  (1280 + 64 * (j))
#define XB_XGEN(j)  (2304 + 64 * (j))
#define XB_TOP      3328
#define XB_TOPGEN   3392
#define XCD_BAR_WORDS 3456
#define XB_SPIN_CAP (1u << 18)

__device__ __forceinline__ unsigned xb_ld(unsigned* p)              { return __hip_atomic_load(p, __ATOMIC_RELAXED, __HIP_MEMORY_SCOPE_AGENT); }
__device__ __forceinline__ unsigned xb_add(unsigned* p, unsigned v) { return __hip_atomic_fetch_add(p, v, __ATOMIC_RELAXED, __HIP_MEMORY_SCOPE_AGENT); }
__device__ __forceinline__ unsigned xb_xcc_id() { return (unsigned)__builtin_amdgcn_s_getreg((3 << 11) | 20) & 0xFu; }
#define XB_SPIN(cond, bar) do { unsigned _sp = 0; while (cond) { __builtin_amdgcn_s_sleep(1); \
    if ((++_sp & 255u) == 0u) { if (xb_ld(&(bar)[XB_TMO])) break; if (_sp > XB_SPIN_CAP) { atomicAdd(&(bar)[XB_TMO], 1u); break; } } } } while (0)

struct XcdBarrier {
    unsigned* bar; unsigned x;
    volatile LAS unsigned* st;
};

__device__ __forceinline__ XcdBarrier xcd_barrier_post(unsigned* bar, volatile LAS unsigned* st) {
    XcdBarrier b; b.bar = bar; b.x = xb_xcc_id(); b.st = st;
    if (threadIdx.x == 0) (void)xb_add(&bar[XB_XCNT(b.x)], 1u);
    return b;
}
__device__ __forceinline__ void xcd_barrier_complete(unsigned* bar, unsigned x, unsigned& nloc, unsigned& nx) {
    const unsigned G = gridDim.x * gridDim.y * gridDim.z;
    unsigned sum, cnt, mine, sp = 0u;
    for (;;) {
        sum = 0u; cnt = 0u; mine = 0u;
#pragma unroll
        for (unsigned j = 0; j < 16; ++j) { const unsigned c = xb_ld(&bar[XB_XCNT(j)]); sum += c; cnt += (c > 0u) ? 1u : 0u; mine = (j == x) ? c : mine; }
        if (sum == G) break;
        __builtin_amdgcn_s_sleep(1);
        if ((++sp & 255u) == 0u) { if (xb_ld(&bar[XB_TMO])) break; if (sp > XB_SPIN_CAP) { atomicAdd(&bar[XB_TMO], 1u); break; } }
    }
    nloc = mine > 0u ? mine : 1u; nx = cnt > 0u ? cnt : 1u;
}

__device__ __forceinline__ void xcd_barrier(const XcdBarrier& b) {
    asm volatile("s_waitcnt vmcnt(0)" ::: "memory");
    __syncthreads();
    if (threadIdx.x == 0) {
        unsigned* bar = b.bar;
        __builtin_amdgcn_s_waitcnt(0);
        unsigned nloc = b.st[0], nx = b.st[1];
        if (nloc == 0u) { xcd_barrier_complete(bar, b.x, nloc, nx); b.st[0] = nloc; b.st[1] = nx; }
        const unsigned old = xb_add(&bar[XB_XSUB(b.x)], 1u);
        const unsigned gen = old / nloc;
        if (old + 1u == (gen + 1u) * nloc) {
            __builtin_amdgcn_fence(__ATOMIC_RELEASE, "agent");
            asm volatile("s_waitcnt vmcnt(0)" ::: "memory");
            const unsigned og = xb_add(&bar[XB_TOP], 1u);
            const unsigned tg = og / nx;
            if (og + 1u == (tg + 1u) * nx) xb_add(&bar[XB_TOPGEN], 1u);
            else XB_SPIN(xb_ld(&bar[XB_TOPGEN]) == tg, bar);
            __builtin_amdgcn_fence(__ATOMIC_ACQUIRE, "agent");
            xb_add(&bar[XB_XGEN(b.x)], 1u);
            asm volatile("s_waitcnt vmcnt(0)" ::: "memory");
        } else {
            XB_SPIN(xb_ld(&bar[XB_XGEN(b.x)]) == gen, bar);
            __builtin_amdgcn_fence(__ATOMIC_ACQUIRE, "agent");
            asm volatile("s_waitcnt vmcnt(0)" ::: "memory");
        }
    }
    __syncthreads();
}
struct Args { const float* in[24]; float* out; unsigned char* ws; int ph_lo, ph_hi, rep_att, rep_lru; };
struct Frame {
    LAS unsigned char* lds; volatile LAS unsigned* MISC; gu32* ctl;
    int tid, lane, wave, vcu, G;
    unsigned char* ws; float* out;
};
#define WSP(T, off) ((T*)(F.ws + (off)))
#define LDS_WAIT() asm volatile("s_waitcnt lgkmcnt(0)" ::: "memory")

struct TrItem { const float* W; bf16* WT; int ldw, K, k0, nsrc0, ndst0; };
__device__ __forceinline__ void tr_load(const TrItem& I, float (&v)[32], int lane) {
    const float* wp = I.W + (size_t)(I.k0 + (lane >> 5)) * I.ldw + I.nsrc0 + (lane & 31);
#pragma unroll
    for (int i = 0; i < 32; ++i) v[i] = wp[(size_t)(2 * i) * I.ldw];
}
__device__ __forceinline__ void tr_store(const TrItem& I, const float (&v)[32], LAS float* scr, int lane) {
#pragma unroll
    for (int i = 0; i < 32; ++i) scr[(2 * i + (lane >> 5)) * 33 + (lane & 31)] = v[i];
    LDS_WAIT(); asm volatile("" ::: "memory");
    const int c = lane & 7;
#pragma unroll
    for (int j = 0; j < 4; ++j) { const int n = (lane >> 3) + 8 * j; const LAS float* s = scr + (8 * c) * 33 + n;
        v4u o; o.x = pk2(s[0 * 33], s[1 * 33]); o.y = pk2(s[2 * 33], s[3 * 33]); o.z = pk2(s[4 * 33], s[5 * 33]); o.w = pk2(s[6 * 33], s[7 * 33]);
        *(GAS v4u*)(I.WT + (size_t)(I.ndst0 + n) * I.K + I.k0 + 8 * c) = o; }
    LDS_WAIT(); asm volatile("" ::: "memory");
}
__device__ __forceinline__ void cvt_stream(const float* src, bf16* dst, size_t n8, size_t i0, size_t stride) {
    for (size_t i = i0; i < n8; i += stride) { const f32x4 a = ((const GAS f32x4*)src)[2 * i], b = ((const GAS f32x4*)src)[2 * i + 1];
        v4u o; o.x = pk2(a[0], a[1]); o.y = pk2(a[2], a[3]); o.z = pk2(b[0], b[1]); o.w = pk2(b[2], b[3]); ((GAS v4u*)dst)[i] = o; }
}
__device__ __forceinline__ void cvt_stream_fp8(const float* src, unsigned char* dst, size_t n16, float scale, size_t i0, size_t stride) {
    for (size_t i = i0; i < n16; i += stride) { v4u o;
#pragma unroll
        for (int q = 0; q < 4; ++q) { const f32x4 a = ((const GAS f32x4*)src)[4 * i + q] * scale; int w = 0;
            w = __builtin_amdgcn_cvt_pk_fp8_f32(a[0], a[1], w, false); w = __builtin_amdgcn_cvt_pk_fp8_f32(a[2], a[3], w, true); o[q] = (unsigned)w; }
        ((GAS v4u*)dst)[i] = o; }
}
#ifndef SKEW_TR
#define SKEW_TR 1
#endif
#ifndef SKEW_TABLES
#define SKEW_TABLES 1
#endif
__device__ __forceinline__ void cvt_row_fp4(const f32x4 (&a)[16], float am, unsigned char* dstT, float* rsT, int row, int lane) {
    am = wave_max(am); const float inv = am > 0.f ? 6.0f / am : 0.f;
#pragma unroll
    for (int c = 0; c < 4; ++c) { v2u o;
#pragma unroll
        for (int d = 0; d < 2; ++d) { unsigned w = 0u; const f32x4 x0 = a[4 * c + 2 * d] * inv, x1 = a[4 * c + 2 * d + 1] * inv;
            w = __builtin_amdgcn_cvt_scalef32_pk_fp4_f32(w, x0[0], x0[1], 1.0f, 0); w = __builtin_amdgcn_cvt_scalef32_pk_fp4_f32(w, x0[2], x0[3], 1.0f, 1);
            w = __builtin_amdgcn_cvt_scalef32_pk_fp4_f32(w, x1[0], x1[1], 1.0f, 2); w = __builtin_amdgcn_cvt_scalef32_pk_fp4_f32(w, x1[2], x1[3], 1.0f, 3); o[d] = w; }
        *((GAS v2u*)(dstT + (size_t)row * 2048 + c * 512) + lane) = o; }
    if (lane == 0) rsT[row] = am * (1.0f / 6.0f);
}
__device__ __forceinline__ void cvt_table_fp4(Frame& F, const float* srcT, unsigned char* dstT, float* rsT, int gw, int NGW) {
#pragma unroll 1
    for (int row = gw; row < PEER_NE; row += 2 * NGW) { const int row2 = row + NGW; const bool two = row2 < PEER_NE;
        const GAS f32x4* src = (const GAS f32x4*)(srcT + (size_t)row * DM); const GAS f32x4* src2 = (const GAS f32x4*)(srcT + (size_t)(two ? row2 : row) * DM); f32x4 a[16], b[16]; float am = 0.f, bm = 0.f;
#pragma unroll
        for (int c = 0; c < 4; ++c)
#pragma unroll
            for (int q = 0; q < 4; ++q) a[4 * c + q] = src[c * 256 + 4 * F.lane + q];
#pragma unroll
        for (int c = 0; c < 4; ++c)
#pragma unroll
            for (int q = 0; q < 4; ++q) b[4 * c + q] = src2[c * 256 + 4 * F.lane + q];
#pragma unroll
        for (int k = 0; k < 16; ++k) am = fmaxf(fmaxf(am, fmaxf(fabsf(a[k][0]), fabsf(a[k][1]))), fmaxf(fabsf(a[k][2]), fabsf(a[k][3])));
        cvt_row_fp4(a, am, dstT, rsT, row, F.lane);
#pragma unroll
        for (int k = 0; k < 16; ++k) bm = fmaxf(fmaxf(bm, fmaxf(fabsf(b[k][0]), fabsf(b[k][1]))), fmaxf(fabsf(b[k][2]), fabsf(b[k][3])));
        if (two) cvt_row_fp4(b, bm, dstT, rsT, row2, F.lane);
    }
}
constexpr int I_IN = 64 * 576, I_AO = 32 * 128, I_LO = 32 * 128, I_OUT = 64 * 128, I_PQ = 64 * 64, I_WA = 16 * 2 * 4, I_WX = I_WA;
constexpr int NITEMS = I_IN + I_AO + I_LO + I_OUT + I_PQ + I_WA + I_WX;
constexpr int TR_LATE_LO = I_IN, TR_LATE_HI = I_IN + I_AO + I_LO + I_OUT;
__device__ __forceinline__ TrItem tr_decode(const Args& args, unsigned char* ws_, int r) { TrItem I;
#define WSQ(T, off) ((T*)(ws_ + (off)))
    if (r < I_IN) { const int kb = r / 576, nb = r % 576; I = TrItem{args.in[6], WSQ(bf16, WS_WIN), NIN, DM, 64 * kb, 32 * nb + (nb >= 192 ? 16 : 0), 32 * nb}; return I; } r -= I_IN;
    if (r < I_AO) { const int kb = r / 128, nb = r % 128; I = TrItem{args.in[17], WSQ(bf16, WS_WAO), DM, AW, 64 * kb, 32 * nb, 32 * nb}; return I; } r -= I_AO;
    if (r < I_LO) { const int kb = r / 128, nb = r % 128; I = TrItem{args.in[18], WSQ(bf16, WS_WLO), DM, LW, 64 * kb, 32 * nb, 32 * nb}; return I; } r -= I_LO;
    if (r < I_OUT) { const int kb = r / 128, nb = r % 128; I = TrItem{args.in[19], WSQ(bf16, WS_WOUT), DM, DM, 64 * kb, 32 * nb, 32 * nb}; return I; } r -= I_OUT;
    if (r < I_PQ) { const int kb = r / 64, nb = r % 64; I = TrItem{args.in[20], WSQ(bf16, WS_WPQ), 2048, DM, 64 * kb, 32 * nb, 32 * nb}; return I; } r -= I_PQ;
    { const bool isx = r >= I_WA; if (isx) r -= I_WA; const int g = r >> 3, kb = (r >> 2) & 1, nb = r & 3;
      I = TrItem{(isx ? args.in[14] : args.in[12]) + (size_t)g * GD * GD, WSQ(bf16, isx ? WS_WXT : WS_WAT) + (size_t)g * GD * GD, GD, GD, 64 * kb, 32 * nb, 32 * nb}; return I; }
#undef WSQ
}
__device__ __forceinline__ void tr_run(Frame& F, const Args& args, int lo, int hi) {
    LAS float* scr = (LAS float*)(F.lds + F.wave * 16384);
    const int gw = F.vcu * NWAVES + F.wave, NGW = F.G * NWAVES;
    if (lo + gw < hi) {
        float va[32], vb[32], vc[32]; TrItem Ia = tr_decode(args, F.ws, lo + gw), Ib = Ia; tr_load(Ia, va, F.lane);
        if (lo + gw + NGW < hi) { Ib = tr_decode(args, F.ws, lo + gw + NGW); tr_load(Ib, vb, F.lane); }
#pragma unroll 1
        for (int it = lo + gw; it < hi; it += NGW) {
            const int nx = it + 2 * NGW; TrItem Ic = Ib;
            if (nx < hi) { Ic = tr_decode(args, F.ws, nx); tr_load(Ic, vc, F.lane); }
            tr_store(Ia, va, scr, F.lane);
#pragma unroll
            for (int i = 0; i < 32; ++i) { va[i] = vb[i]; vb[i] = vc[i]; }
            Ia = Ib; Ib = Ic;
        }
    }
}
__device__ __forceinline__ void p0_prologue(Frame& F, const Args& args) {
#ifndef P0_REP
#define P0_REP 0
#endif
    _Pragma("unroll") for (int rep_ = 0; rep_ < ((P0_REP & 1) ? 2 : 1); ++rep_)
    { LAS float* sc = (LAS float*)F.lds; LAS f32x4* red = (LAS f32x4*)(F.lds + 16384); float* MOD = WSP(float, WS_MOD);
      for (int cgi = blockIdx.x; cgi < 256; cgi += F.G) {
          for (int i = F.tid; i < DM; i += NTHREADS) { const float cv = args.in[1][i]; sc[i] = cv / (1.0f + __expf(-cv)); }
          __syncthreads();
          if (F.tid < 384) { const int cg = F.tid % 24, rg = F.tid / 24;
              const GAS f32x4* Wp = (const GAS f32x4*)args.in[2] + cgi * 24 + cg;
              f32x4 acc = {0.f, 0.f, 0.f, 0.f};
#pragma unroll 8
              for (int r = rg; r < DM; r += 16) acc += sc[r] * Wp[(size_t)r * 6144];
              red[rg * 24 + cg] = acc; }
          __syncthreads();
          if (F.tid < 24) { f32x4 s = red[F.tid];
#pragma unroll
              for (int rg = 1; rg < 16; ++rg) s += red[rg * 24 + F.tid];
              s += ((const GAS f32x4*)args.in[3])[cgi * 24 + F.tid]; ((GAS f32x4*)MOD)[cgi * 24 + F.tid] = s; }
          __syncthreads();
      } }
    const int gw = F.vcu * NWAVES + F.wave, NGW = F.G * NWAVES; (void)gw; (void)NGW;
    _Pragma("unroll") for (int rep_ = 0; rep_ < ((P0_REP & 2) ? 2 : 1); ++rep_) {
#if SKEW_TABLES && SKEW_TR
        tr_run(F, args, 0, TR_LATE_LO); tr_run(F, args, TR_LATE_HI, NITEMS);
#else
        tr_run(F, args, 0, NITEMS);
#endif
    }
    const size_t gt = (size_t)F.vcu * NTHREADS + F.tid, NGT = (size_t)F.G * NTHREADS;
#if !SKEW_TABLES
    _Pragma("unroll") for (int rep_ = 0; rep_ < ((P0_REP & 4) ? 2 : 1); ++rep_) {
    cvt_table_fp4(F, args.in[23], WSP(unsigned char, WS_V), WSP(float, WS_RS), gw, NGW);
    cvt_table_fp4(F, args.in[22], WSP(unsigned char, WS_U), WSP(float, WS_RSU), gw, NGW); }
#endif
    cvt_stream(args.in[21], WSP(bf16, WS_SK), (size_t)PEER_H * 2 * 128 * 128 / 8, gt, NGT);
    for (size_t i = gt; i < (size_t)DM * 16; i += NGT) WSP(float, WS_WF)[(i & 15) * DM + (i >> 4)] = args.in[6][(i >> 4) * NIN + C_F + (i & 15)];
    for (size_t i = gt; i < (size_t)NINP; i += NGT) WSP(float, WS_BIASR)[i] = args.in[7][i + (i >= (size_t)C_F ? 16 : 0)];
}

__device__ __forceinline__ void p1_norm_forget(Frame& F, const Args& args) {
    const float* MOD = WSP(float, WS_MOD); const float* WFT = WSP(float, WS_WF); bf16* HA = WSP(bf16, WS_HA);
    LAS f32x4* MUL4 = (LAS f32x4*)F.lds; LAS f32x4* SH4 = (LAS f32x4*)(F.lds + 16384); LAS float* RS = (LAS float*)(F.lds + 32768); LAS float* PART = (LAS float*)(F.lds + 33280);
    for (int i4 = F.tid; i4 < DM / 4; i4 += NTHREADS) { MUL4[i4] = ((const GAS f32x4*)args.in[4])[i4] * (((const GAS f32x4*)(MOD + 4096))[i4] + 1.0f); SH4[i4] = ((const GAS f32x4*)MOD)[i4]; }
    __syncthreads();
    const int fr = F.lane & 15, fq = F.lane >> 4;
    const unsigned lo16 = (unsigned)F.lane * 16u, lof = (unsigned)(fr * DM + fq * 8) * 4u, loh = (unsigned)(fr * DM + fq * 8) * 2u;
#pragma unroll 1
    for (int step = blockIdx.x; step < S / 32; step += F.G) {
        const int r0 = step * 32;
        { const char* xb0 = (const char*)(args.in[0] + (size_t)(r0 + F.wave * 4) * DM);
#pragma unroll 1
          for (int rp = 0; rp < 2; ++rp) { f32x4 xa[2][16];
#pragma unroll
            for (int q = 0; q < 2; ++q)
#pragma unroll
                for (int j = 0; j < 16; ++j) xa[q][j] = *(const GAS f32x4*)(xb0 + (size_t)(2 * rp + q) * (DM * 4) + 1024 * j + lo16);
#pragma unroll
            for (int q = 0; q < 2; ++q) { float ss = 0.f;
#pragma unroll
                for (int j = 0; j < 16; ++j) ss += (xa[q][j][0] * xa[q][j][0] + xa[q][j][1] * xa[q][j][1]) + (xa[q][j][2] * xa[q][j][2] + xa[q][j][3] * xa[q][j][3]);
                const float rsv = 1.0f / sqrtf(wave_sum(ss) * (1.0f / DM) + EPS); if (F.lane == 0) RS[F.wave * 4 + 2 * rp + q] = rsv; } } }
        __syncthreads();
        const float rs0 = RS[fr], rs1 = RS[16 + fr];
        const char* xk = (const char*)(args.in[0] + (size_t)r0 * DM) + F.wave * 2048; const char* wk = (const char*)WFT + F.wave * 2048; char* hk = (char*)(HA + (size_t)r0 * DM) + F.wave * 1024;
        f32x4 acc0 = (f32x4){0.f, 0.f, 0.f, 0.f}, acc1 = acc0;
        f32x4 nx[4], nw[2];
        nx[0] = *(const GAS f32x4*)(xk + lof); nx[1] = *(const GAS f32x4*)(xk + lof + 16); nx[2] = *(const GAS f32x4*)(xk + 16 * DM * 4 + lof); nx[3] = *(const GAS f32x4*)(xk + 16 * DM * 4 + lof + 16);
        nw[0] = *(const GAS f32x4*)(wk + lof); nw[1] = *(const GAS f32x4*)(wk + lof + 16);
#pragma unroll 1
        for (int ks = 0; ks < 16; ++ks) {
            f32x4 cx[4], cw[2];
#pragma unroll
            for (int q = 0; q < 4; ++q) cx[q] = nx[q];
            cw[0] = nw[0]; cw[1] = nw[1];
            { const int kn = ((ks + 1) & 15) * 128; const char* xn_ = xk + kn; const char* wn_ = wk + kn;
              nx[0] = *(const GAS f32x4*)(xn_ + lof); nx[1] = *(const GAS f32x4*)(xn_ + lof + 16); nx[2] = *(const GAS f32x4*)(xn_ + 16 * DM * 4 + lof); nx[3] = *(const GAS f32x4*)(xn_ + 16 * DM * 4 + lof + 16);
              nw[0] = *(const GAS f32x4*)(wn_ + lof); nw[1] = *(const GAS f32x4*)(wn_ + lof + 16); }
            const int c4 = F.wave * 128 + ks * 8 + fq * 2;
            const f32x4 m0 = MUL4[c4], m1 = MUL4[c4 + 1], s0 = SH4[c4], s1 = SH4[c4 + 1];
            const f32x4 ha0 = cx[0] * rs0 * m0 + s0, ha1 = cx[1] * rs0 * m1 + s1, hb0 = cx[2] * rs1 * m0 + s0, hb1 = cx[3] * rs1 * m1 + s1;
            v4u ahi, alo, bhi, blo, whi, wlo;
#define P1_SPLIT(hi_, lo_, v0_, v1_) do { hi_.x = pg8::cvt_pk_bf16(v0_[0], v0_[1]); hi_.y = pg8::cvt_pk_bf16(v0_[2], v0_[3]); hi_.z = pg8::cvt_pk_bf16(v1_[0], v1_[1]); hi_.w = pg8::cvt_pk_bf16(v1_[2], v1_[3]); \
            lo_.x = pg8::cvt_pk_bf16(v0_[0] - bflo(hi_.x), v0_[1] - bfhi(hi_.x)); lo_.y = pg8::cvt_pk_bf16(v0_[2] - bflo(hi_.y), v0_[3] - bfhi(hi_.y)); \
            lo_.z = pg8::cvt_pk_bf16(v1_[0] - bflo(hi_.z), v1_[1] - bfhi(hi_.z)); lo_.w = pg8::cvt_pk_bf16(v1_[2] - bflo(hi_.w), v1_[3] - bfhi(hi_.w)); } while (0)
            P1_SPLIT(ahi, alo, ha0, ha1); P1_SPLIT(bhi, blo, hb0, hb1); P1_SPLIT(whi, wlo, cw[0], cw[1]);
#undef P1_SPLIT
            *(GAS v4u*)(hk + ks * 64 + loh) = ahi; *(GAS v4u*)(hk + 16 * DM * 2 + ks * 64 + loh) = bhi;
            const bf16x8 Ah = __builtin_bit_cast(bf16x8, ahi), Al = __builtin_bit_cast(bf16x8, alo), Bh = __builtin_bit_cast(bf16x8, bhi), Bl = __builtin_bit_cast(bf16x8, blo), Wh = __builtin_bit_cast(bf16x8, whi), Wl = __builtin_bit_cast(bf16x8, wlo);
            acc0 = __builtin_amdgcn_mfma_f32_16x16x32_bf16(Ah, Wh, acc0, 0, 0, 0); acc1 = __builtin_amdgcn_mfma_f32_16x16x32_bf16(Bh, Wh, acc1, 0, 0, 0);
            acc0 = __builtin_amdgcn_mfma_f32_16x16x32_bf16(Ah, Wl, acc0, 0, 0, 0); acc1 = __builtin_amdgcn_mfma_f32_16x16x32_bf16(Bh, Wl, acc1, 0, 0, 0);
            acc0 = __builtin_amdgcn_mfma_f32_16x16x32_bf16(Al, Wh, acc0, 0, 0, 0); acc1 = __builtin_amdgcn_mfma_f32_16x16x32_bf16(Bl, Wh, acc1, 0, 0, 0);
        }
#pragma unroll
        for (int r = 0; r < 4; ++r) { PART[(F.wave * 32 + 4 * fq + r) * 16 + fr] = acc0[r]; PART[(F.wave * 32 + 16 + 4 * fq + r) * 16 + fr] = acc1[r]; }
        __syncthreads();
        { const int head = F.tid >> 5, row = F.tid & 31; float s = 0.f;
#pragma unroll
          for (int w = 0; w < 8; ++w) s += PART[(w * 32 + row) * 16 + head];
          const float f = s + args.in[7][C_F + head]; WSP(float, WS_LOGF)[(size_t)head * S + r0 + row] = fminf(f, 0.f) - log1pf(__expf(-fabsf(f))); }
        __syncthreads();
    }
}
__device__ __forceinline__ void p1_shift_proj(Frame& F, const Args& args) {
    const int gw = F.vcu * NWAVES + F.wave, NGW = F.G * NWAVES; const float* sh2 = WSP(float, WS_MOD) + 12288; const bf16* WT = WSP(bf16, WS_WPQ);
    for (int col = gw; col < 2048; col += NGW) { float s = 0.f;
#pragma unroll
        for (int c = 0; c < 8; ++c) { const v4u w = *((const GAS v4u*)(WT + (size_t)col * DM + c * 512) + F.lane); const GAS f32x4* sp = (const GAS f32x4*)(sh2 + c * 512 + F.lane * 8); const f32x4 a = sp[0], b = sp[1];
            s += (bflo(w.x) * a[0] + bfhi(w.x) * a[1]) + (bflo(w.y) * a[2] + bfhi(w.y) * a[3]) + (bflo(w.z) * b[0] + bfhi(w.z) * b[1]) + (bflo(w.w) * b[2] + bfhi(w.w) * b[3]); }
        s = wave_sum(s); if (F.lane == 0) WSP(float, WS_SB)[col] = s; }
}

#ifndef QKN_PIECES
#define QKN_PIECES 4
#endif
__device__ __forceinline__ void p3_qknorm(Frame& F, const Args& args) {
    const int gw = F.vcu * NWAVES + F.wave, NGW = F.G * NWAVES; bf16* QK = WSP(bf16, WS_QKV);
    const int sub = F.lane & 15;
    f32x4 gq0 = ((const GAS f32x4*)args.in[8])[2 * sub], gq1 = ((const GAS f32x4*)args.in[8])[2 * sub + 1], gk0 = ((const GAS f32x4*)args.in[9])[2 * sub], gk1 = ((const GAS f32x4*)args.in[9])[2 * sub + 1];
    for (int it0 = gw; it0 < 2 * S * NH / 4; it0 += QKN_PIECES * NGW) {
        v4u w[QKN_PIECES]; GAS v4u* pp[QKN_PIECES];
#pragma unroll
        for (int k = 0; k < QKN_PIECES; ++k) { const int it = it0 + k * NGW; const size_t unit = (size_t)(it < 2 * S * NH / 4 ? it : it0) * 4 + (F.lane >> 4); pp[k] = (GAS v4u*)(QK + unit * 128) + sub; w[k] = *pp[k]; }
#pragma unroll
        for (int k = 0; k < QKN_PIECES; ++k) { const int it = it0 + k * NGW; const size_t unit = (size_t)(it < 2 * S * NH / 4 ? it : it0) * 4 + (F.lane >> 4); const bool isk = unit >= (size_t)S * NH;
            f32x4 a = {bflo(w[k].x), bfhi(w[k].x), bflo(w[k].y), bfhi(w[k].y)}, b = {bflo(w[k].z), bfhi(w[k].z), bflo(w[k].w), bfhi(w[k].w)};
            float ss = (a[0] * a[0] + a[1] * a[1]) + (a[2] * a[2] + a[3] * a[3]) + (b[0] * b[0] + b[1] * b[1]) + (b[2] * b[2] + b[3] * b[3]);
            ss += __shfl_xor(ss, 1); ss += __shfl_xor(ss, 2); ss += __shfl_xor(ss, 4); ss += __shfl_xor(ss, 8);
            const float rs = 1.0f / sqrtf(ss * (1.0f / HD) + EPS);
            a = a * rs * (isk ? gk0 : gq0); b = b * rs * (isk ? gk1 : gq1);
            v4u o; o.x = pk2(a[0], a[1]); o.y = pk2(a[2], a[3]); o.z = pk2(b[0], b[1]); o.w = pk2(b[2], b[3]);
            if (it < 2 * S * NH / 4) *pp[k] = o; }
    }
}
__device__ __forceinline__ void p3_cumsum(Frame& F, const Args& args) {
    LAS float* wt = (LAS float*)F.lds;
    for (int h = blockIdx.x; h < NH; h += F.G) {
        const float* LF = WSP(float, WS_LOGF); float v[16]; float run = 0.f;
        { const GAS f32x4* lp = (const GAS f32x4*)(LF + (size_t)h * S + F.tid * 16); const f32x4 l0 = lp[0], l1 = lp[1], l2 = lp[2], l3 = lp[3];
          const float lv[16] = {l0[0], l0[1], l0[2], l0[3], l1[0], l1[1], l1[2], l1[3], l2[0], l2[1], l2[2], l2[3], l3[0], l3[1], l3[2], l3[3]};
#pragma unroll
          for (int i = 0; i < 16; ++i) { run += lv[i]; v[i] = run; } }
        float sc = run;
#pragma unroll
        for (int o = 1; o < 64; o <<= 1) { const float t = __shfl_up(sc, o); if (F.lane >= o) sc += t; }
        if (F.lane == 63) wt[F.wave] = sc;
        __syncthreads();
        float pre = sc - run;
        for (int w = 0; w < F.wave; ++w) pre += wt[w];
        float* Fo = WSP(float, WS_FC) + (size_t)h * S + F.tid * 16;
#pragma unroll
        for (int i = 0; i < 4; ++i) ((GAS f32x4*)Fo)[i] = (f32x4){v[4 * i] + pre, v[4 * i + 1] + pre, v[4 * i + 2] + pre, v[4 * i + 3] + pre};
        __syncthreads();
    }
}
#ifndef LRU_STORE_AB
#define LRU_STORE_AB 1
#endif
constexpr int LRU_XCF = 0, LRU_XCB = 32768, LRU_AB = 49152, LRU_BB = 81920, LRU_QA = 114688, LRU_CAR = 118784, LRU_XR = 133120;
struct LruConst { float w0, w1, w2, w3, cb, bav, bxv, sp8; };
template <int PASS> __device__ __forceinline__ void lru_chunk(Frame& F, const Args& args, int c, int g, v4u (&raw)[3], const bf16x8 (&ba)[4], const bf16x8 (&bx)[4], bool more, const LruConst& K) {
    LAS float* XCF = (LAS float*)(F.lds + LRU_XCF); LAS unsigned char* XCB = F.lds + LRU_XCB; LAS float* AB = (LAS float*)(F.lds + LRU_AB); LAS float* BB = (LAS float*)(F.lds + LRU_BB);
    LAS float* QA = (LAS float*)(F.lds + LRU_QA); LAS float* CAR = (LAS float*)(F.lds + LRU_CAR); LAS bf16* XR = (LAS bf16*)(F.lds + LRU_XR);
    const int t0 = 64 * c, ch0 = GD * g; const bf16* LX = WSP(bf16, WS_LX);
#pragma unroll
    for (int k = 0; k < 3; ++k) { const int p = F.tid + k * NTHREADS; if (p < 67 * 16) *(LAS v4u*)(XR + (p >> 4) * 128 + (p & 15) * 8) = raw[k]; }
    if (more) {
#pragma unroll
        for (int k = 0; k < 3; ++k) { const int p = F.tid + k * NTHREADS; const int r = p >> 4, cc = p & 15, tg = t0 + 64 - 3 + r; raw[k] = (v4u){0u, 0u, 0u, 0u};
            if (p < 67 * 16 && tg >= 0) raw[k] = *(const GAS v4u*)(LX + (size_t)tg * LW + ch0 + cc * 8); } }
    v4u gyv[2];
    if (PASS == 1) {
#pragma unroll
        for (int k = 0; k < 2; ++k) { const int p = F.tid + k * NTHREADS; gyv[k] = *(const GAS v4u*)(WSP(bf16, WS_GY) + (size_t)(t0 + (p >> 4)) * LW + ch0 + (p & 15) * 8); } }
    __syncthreads();
    { const int ch = F.tid & 127, tq = F.tid >> 7, gch = ch0 + ch;
      const float w0 = K.w0, w1 = K.w1, w2 = K.w2, w3 = K.w3, cb = K.cb; (void)gch;
      float xm3 = bf2f(XR[(16 * tq + 0) * 128 + ch]), xm2 = bf2f(XR[(16 * tq + 1) * 128 + ch]), xm1 = bf2f(XR[(16 * tq + 2) * 128 + ch]);
#pragma unroll
      for (int i = 0; i < 16; ++i) { const int t = 16 * tq + i; const float x0 = bf2f(XR[(t + 3) * 128 + ch]);
          const float xc = w0 * xm3 + w1 * xm2 + w2 * xm1 + w3 * x0 + cb; xm3 = xm2; xm2 = xm1; xm1 = x0;
          XCF[t * 128 + ch] = xc; *(LAS bf16*)(XCB + t * 256 + ((ch * 2) ^ ((t & 7) << 4))) = (bf16)f2bf(xc); } }
    __syncthreads();
    { const int fr = F.lane & 15, fq = F.lane >> 4, j = 16 * F.wave + fr;
      const float bav = K.bav, bxv = K.bxv, sp8 = K.sp8;
#pragma unroll
      for (int mt = 0; mt < 4; ++mt) { f32x4 ar = {0.f, 0.f, 0.f, 0.f}, ax = {0.f, 0.f, 0.f, 0.f}; const int t = 16 * mt + fr;
#pragma unroll
          for (int ks = 0; ks < 4; ++ks) { const bf16x8 af = *(const LAS bf16x8*)(XCB + t * 256 + (((32 * ks + 8 * fq) * 2) ^ ((t & 7) << 4)));
              ar = __builtin_amdgcn_mfma_f32_16x16x32_bf16(af, ba[ks], ar, 0, 0, 0); ax = __builtin_amdgcn_mfma_f32_16x16x32_bf16(af, bx[ks], ax, 0, 0, 0); }
#pragma unroll
          for (int rg = 0; rg < 4; ++rg) { const int tt = 16 * mt + 4 * fq + rg; const float xcv = XCF[tt * 128 + j];
              const float rgt = sigmoidf_(ar[rg] + bav), igt = sigmoidf_(ax[rg] + bxv);
              const float a = __builtin_amdgcn_exp2f(rgt * sp8); const float om = fmaxf((1.0f - a) * (1.0f + a), 0.f);
              const float b = __builtin_amdgcn_sqrtf(om) * (igt * xcv);
              AB[tt * 128 + j] = a; BB[tt * 128 + j] = LRU_STORE_AB ? bflo(pg8::cvt_pk_bf16(b, 0.f)) : b; } } }
    __syncthreads();
    if (LRU_STORE_AB && PASS == 0) {
        float* GA2 = WSP(float, WS_T1); bf16* GB2 = WSP(bf16, WS_MG);
#pragma unroll
        for (int k = 0; k < 4; ++k) { const int p = F.tid + k * NTHREADS, r = p >> 5, c4 = p & 31; *(GAS f32x4*)(GA2 + (size_t)(t0 + r) * LW + ch0 + c4 * 4) = *(const LAS f32x4*)(AB + r * 128 + c4 * 4); }
#pragma unroll
        for (int k = 0; k < 2; ++k) { const int p = F.tid + k * NTHREADS, r = p >> 4, cc = p & 15; const f32x4 b0 = *(const LAS f32x4*)(BB + r * 128 + cc * 8), b1 = *(const LAS f32x4*)(BB + r * 128 + cc * 8 + 4);
            v4u o; o.x = pg8::cvt_pk_bf16(b0[0], b0[1]); o.y = pg8::cvt_pk_bf16(b0[2], b0[3]); o.z = pg8::cvt_pk_bf16(b1[0], b1[1]); o.w = pg8::cvt_pk_bf16(b1[2], b1[3]);
            *(GAS v4u*)(GB2 + (size_t)(t0 + r) * LW + ch0 + cc * 8) = o; }
    }
    const int ch = F.tid & 127, q = F.tid >> 7;
    { float A = 1.f, B = 0.f;
#pragma unroll
      for (int i = 0; i < 16; ++i) { const int t = 16 * q + i; const float a = AB[t * 128 + ch]; B = a * B + BB[t * 128 + ch]; A *= a; }
      QA[(q * 128 + ch) * 2] = A; QA[(q * 128 + ch) * 2 + 1] = B; }
    __syncthreads();
    if (PASS == 0) {
        if (F.tid < 128) { float A = 1.f, B = 0.f;
#pragma unroll
            for (int qq = 0; qq < 4; ++qq) { const float a = QA[(qq * 128 + F.tid) * 2], b = QA[(qq * 128 + F.tid) * 2 + 1]; B = a * B + b; A *= a; }
            WSP(float, WS_AGGA)[(size_t)c * LW + ch0 + F.tid] = A; WSP(float, WS_AGGB)[(size_t)c * LW + ch0 + F.tid] = B; }
    } else {
        float h = CAR[ch];
        for (int qq = 0; qq < q; ++qq) h = QA[(qq * 128 + ch) * 2] * h + QA[(qq * 128 + ch) * 2 + 1];
#pragma unroll
        for (int i = 0; i < 16; ++i) { const int t = 16 * q + i; h = AB[t * 128 + ch] * h + BB[t * 128 + ch]; XCF[t * 128 + ch] = h; }
        __syncthreads();
        if (F.tid < 128) { float hc = CAR[F.tid];
#pragma unroll
            for (int qq = 0; qq < 4; ++qq) hc = QA[(qq * 128 + F.tid) * 2] * hc + QA[(qq * 128 + F.tid) * 2 + 1];
            CAR[F.tid] = hc; }
        bf16* LR = WSP(bf16, WS_LR);
#pragma unroll
        for (int k = 0; k < 2; ++k) { const int p = F.tid + k * NTHREADS; const int r = p >> 4, cc = p & 15; const size_t o = (size_t)(t0 + r) * LW + ch0 + cc * 8;
            const v4u gy = gyv[k]; const f32x4 h0 = *(const LAS f32x4*)(XCF + r * 128 + cc * 8), h1 = *(const LAS f32x4*)(XCF + r * 128 + cc * 8 + 4);
            v4u ov; ov.x = pk2(h0[0] * bflo(gy.x), h0[1] * bfhi(gy.x)); ov.y = pk2(h0[2] * bflo(gy.y), h0[3] * bfhi(gy.y)); ov.z = pk2(h1[0] * bflo(gy.z), h1[1] * bfhi(gy.z)); ov.w = pk2(h1[2] * bflo(gy.w), h1[3] * bfhi(gy.w));
            *(GAS v4u*)(LR + o) = ov; }
    }
    __syncthreads();
}
__device__ __forceinline__ void lru_item1_ab(Frame& F, const Args& args, int w) {
    const int g = w & 15, c0 = (w >> 4) * 8, ch0 = GD * g; LAS float* CAR = (LAS float*)(F.lds + LRU_CAR); LAS float* QA = (LAS float*)(F.lds + LRU_QA);
    LAS float* XCF = (LAS float*)(F.lds + LRU_XCF); LAS float* AB = (LAS float*)(F.lds + LRU_AB); LAS float* BB = (LAS float*)(F.lds + LRU_BB);
    const float* GA2 = WSP(float, WS_T1); const bf16* GB2 = WSP(bf16, WS_MG); const bf16* GY = WSP(bf16, WS_GY); bf16* LR = WSP(bf16, WS_LR);
    f32x4 pa[4]; v4u pb[2], pg[2];
#define LRU1_LOAD(c_) do { const int t0_ = 64 * (c_); \
        _Pragma("unroll") for (int k = 0; k < 4; ++k) { const int p = F.tid + k * NTHREADS, r = p >> 5, c4 = p & 31; pa[k] = *(const GAS f32x4*)(GA2 + (size_t)(t0_ + r) * LW + ch0 + c4 * 4); } \
        _Pragma("unroll") for (int k = 0; k < 2; ++k) { const int p = F.tid + k * NTHREADS, r = p >> 4, cc = p & 15; const size_t o = (size_t)(t0_ + r) * LW + ch0 + cc * 8; pb[k] = *(const GAS v4u*)(GB2 + o); pg[k] = *(const GAS v4u*)(GY + o); } } while (0)
    LRU1_LOAD(c0);
    { const int ch = F.tid & 127, q = F.tid >> 7, n = c0 / 4;
      const float* GA_ = WSP(float, WS_AGGA) + GD * g + ch; const float* GB_ = WSP(float, WS_AGGB) + GD * g + ch; float A = 1.f, B = 0.f;
      float av[30], bv[30];
#pragma unroll
      for (int i = 0; i < 30; ++i) { const bool ok = i < n; const size_t o = (size_t)(ok ? q * n + i : 0) * LW; const float a_ = GA_[o], b_ = GB_[o]; av[i] = ok ? a_ : 1.f; bv[i] = ok ? b_ : 0.f; }
#pragma unroll
      for (int i = 0; i < 30; ++i) { B = av[i] * B + bv[i]; A *= av[i]; }
      QA[(q * 128 + ch) * 2] = A; QA[(q * 128 + ch) * 2 + 1] = B;
      __syncthreads();
      if (F.tid < 128) { float hc = 0.f;
#pragma unroll
          for (int qq = 0; qq < 4; ++qq) hc = QA[(qq * 128 + F.tid) * 2] * hc + QA[(qq * 128 + F.tid) * 2 + 1];
          CAR[F.tid] = hc; }
      __syncthreads(); }
#pragma unroll 1
    for (int c = c0; c < c0 + 8; ++c) { const int t0 = 64 * c;
        v4u gyv[2];
#pragma unroll
        for (int k = 0; k < 4; ++k) { const int p = F.tid + k * NTHREADS, r = p >> 5, c4 = p & 31; *(LAS f32x4*)(AB + r * 128 + c4 * 4) = pa[k]; }
#pragma unroll
        for (int k = 0; k < 2; ++k) { const int p = F.tid + k * NTHREADS, r = p >> 4, cc = p & 15; gyv[k] = pg[k];
            *(LAS f32x4*)(BB + r * 128 + cc * 8) = (f32x4){bflo(pb[k].x), bfhi(pb[k].x), bflo(pb[k].y), bfhi(pb[k].y)}; *(LAS f32x4*)(BB + r * 128 + cc * 8 + 4) = (f32x4){bflo(pb[k].z), bfhi(pb[k].z), bflo(pb[k].w), bfhi(pb[k].w)}; }
        if (c + 1 < c0 + 8) LRU1_LOAD(c + 1);
        __syncthreads();
        const int ch = F.tid & 127, q = F.tid >> 7;
        { float A = 1.f, B = 0.f;
#pragma unroll
          for (int i = 0; i < 16; ++i) { const int t = 16 * q + i; const float a = AB[t * 128 + ch]; B = a * B + BB[t * 128 + ch]; A *= a; }
          QA[(q * 128 + ch) * 2] = A; QA[(q * 128 + ch) * 2 + 1] = B; }
        __syncthreads();
        float h = CAR[ch];
        for (int qq = 0; qq < q; ++qq) h = QA[(qq * 128 + ch) * 2] * h + QA[(qq * 128 + ch) * 2 + 1];
#pragma unroll
        for (int i = 0; i < 16; ++i) { const int t = 16 * q + i; h = AB[t * 128 + ch] * h + BB[t * 128 + ch]; XCF[t * 128 + ch] = h; }
        __syncthreads();
        if (F.tid < 128) { float hc = CAR[F.tid];
#pragma unroll
            for (int qq = 0; qq < 4; ++qq) hc = QA[(qq * 128 + F.tid) * 2] * hc + QA[(qq * 128 + F.tid) * 2 + 1];
            CAR[F.tid] = hc; }
#pragma unroll
        for (int k = 0; k < 2; ++k) { const int p = F.tid + k * NTHREADS; const int r = p >> 4, cc = p & 15; const size_t o = (size_t)(t0 + r) * LW + ch0 + cc * 8;
            const v4u gy = gyv[k]; const f32x4 h0 = *(const LAS f32x4*)(XCF + r * 128 + cc * 8), h1 = *(const LAS f32x4*)(XCF + r * 128 + cc * 8 + 4);
            v4u ov; ov.x = pk2(h0[0] * bflo(gy.x), h0[1] * bfhi(gy.x)); ov.y = pk2(h0[2] * bflo(gy.y), h0[3] * bfhi(gy.y)); ov.z = pk2(h1[0] * bflo(gy.z), h1[1] * bfhi(gy.z)); ov.w = pk2(h1[2] * bflo(gy.w), h1[3] * bfhi(gy.w));
            *(GAS v4u*)(LR + o) = ov; }
        __syncthreads();
    }
#undef LRU1_LOAD
}
template <int PASS> __device__ __forceinline__ void lru_item(Frame& F, const Args& args, int w) {
    const int g = w & 15, c0 = (w >> 4) * 8; LAS float* CAR = (LAS float*)(F.lds + LRU_CAR); LAS float* QA = (LAS float*)(F.lds + LRU_QA);
    if (PASS == 1) {
        const int ch = F.tid & 127, q = F.tid >> 7, n = c0 / 4;
        const float* GA_ = WSP(float, WS_AGGA) + GD * g + ch; const float* GB_ = WSP(float, WS_AGGB) + GD * g + ch; float A = 1.f, B = 0.f;
        float av[30], bv[30];
#pragma unroll
        for (int i = 0; i < 30; ++i) { const bool ok = i < n; const size_t o = (size_t)(ok ? q * n + i : 0) * LW; const float a_ = GA_[o], b_ = GB_[o]; av[i] = ok ? a_ : 1.f; bv[i] = ok ? b_ : 0.f; }
#pragma unroll
        for (int i = 0; i < 30; ++i) { B = av[i] * B + bv[i]; A *= av[i]; }
        QA[(q * 128 + ch) * 2] = A; QA[(q * 128 + ch) * 2 + 1] = B;
        __syncthreads();
        if (F.tid < 128) { float hc = 0.f;
#pragma unroll
            for (int qq = 0; qq < 4; ++qq) hc = QA[(qq * 128 + F.tid) * 2] * hc + QA[(qq * 128 + F.tid) * 2 + 1];
            CAR[F.tid] = hc; }
        __syncthreads();
    }
    bf16x8 ba[4], bx[4];
    { const int fr = F.lane & 15, fq = F.lane >> 4, j = 16 * F.wave + fr;
      const bf16* WA = WSP(bf16, WS_WAT) + (size_t)g * GD * GD + (size_t)j * GD + 8 * fq; const bf16* WX = WSP(bf16, WS_WXT) + (size_t)g * GD * GD + (size_t)j * GD + 8 * fq;
#pragma unroll
      for (int ks = 0; ks < 4; ++ks) { ba[ks] = *(const GAS bf16x8*)(WA + 32 * ks); bx[ks] = *(const GAS bf16x8*)(WX + 32 * ks); } }
    v4u raw[3];
    { const bf16* LX = WSP(bf16, WS_LX); const int t0 = 64 * c0, ch0 = GD * g;
#pragma unroll
      for (int k = 0; k < 3; ++k) { const int p = F.tid + k * NTHREADS; const int r = p >> 4, cc = p & 15, tg = t0 - 3 + r; raw[k] = (v4u){0u, 0u, 0u, 0u};
          if (p < 67 * 16 && tg >= 0) raw[k] = *(const GAS v4u*)(LX + (size_t)tg * LW + ch0 + cc * 8); } }
    LruConst K;
    { const int gch = GD * g + (F.tid & 127); K.w0 = args.in[10][gch]; K.w1 = args.in[10][LW + gch]; K.w2 = args.in[10][2 * LW + gch]; K.w3 = args.in[10][3 * LW + gch]; K.cb = args.in[11][gch];
      const int gcj = GD * g + 16 * F.wave + (F.lane & 15); K.bav = args.in[13][gcj]; K.bxv = args.in[15][gcj]; const float lam = args.in[16][gcj];
      K.sp8 = -8.0f * 1.4426950408889634f * ((lam > 0.f ? 0.f : -lam) + log1pf(__expf(-fabsf(lam)))); }
#pragma unroll 1
    for (int c = c0; c < c0 + 8; ++c) lru_chunk<PASS>(F, args, c, g, raw, ba, bx, c + 1 < c0 + 8, K);
}
constexpr int ATT_BIAS_OFF = attn_body::LDS_BYTES;
typedef attn_body::BlockRef<bf16, bf16> ARef;
__device__ __forceinline__ int attn_jlo(const float* Fh, int qb, float TH, int lane) {
    const int t0 = qb * 256; const float f0 = Fh[t0];
    const int j0 = lane, j1 = lane + 64;
    const bool ok0 = (64 * j0 + 63 >= t0) || (f0 - Fh[64 * j0 + 63] >= -TH), ok1 = (64 * j1 + 63 >= t0) || (f0 - Fh[64 * j1 + 63] >= -TH);
    const unsigned long long m0 = __ballot(ok0), m1 = __ballot(ok1);
    return m0 ? (int)__builtin_ctzll(m0) : 64 + (int)__builtin_ctzll(m1);
}
__device__ __forceinline__ ARef attn_ref(Frame& F, const Args& args, int h, int qb, int jlo) {
    ARef r; const bf16* QK = WSP(bf16, WS_QKV);
    r.Q = QK + (size_t)(qb * 256) * AW + h * HD; r.K = QK + (size_t)S * AW + h * HD; r.V = QK + 2 * (size_t)S * AW + h * HD;
    r.O = WSP(bf16, WS_ATT) + (size_t)(qb * 256) * AW + h * HD; r.P0 = qb * 256; r.jlo = jlo; return r;
}
__device__ __forceinline__ void attn_fill_bias(Frame& F, const Args& args, int h, int qb, int jlo) {
    const float* Fh = WSP(float, WS_FC) + (size_t)h * S; LAS float* bl = (LAS float*)(F.lds + ATT_BIAS_OFF);
    const int k0 = jlo * 64, n = (qb + 1) * 256 - k0; const float fr = Fh[k0];
#pragma unroll 1
    for (int i = F.tid; i < n; i += NTHREADS) bl[i] = (fr - Fh[k0 + i]) * (1.0f / attn_body::SCALE);
}
#ifndef ATT_MARGIN
#define ATT_MARGIN 18.0f
#endif
constexpr int ATT_SCHED_OFF = 104448;
__device__ __forceinline__ void p4_attention(Frame& F, const Args& args, char* lds_generic, int rep) {
    float gq = fmaxf(fabsf(args.in[8][F.lane]), fabsf(args.in[8][F.lane + 64])), gk = fmaxf(fabsf(args.in[9][F.lane]), fabsf(args.in[9][F.lane + 64]));
    gq = wave_max(gq); gk = wave_max(gk);
    const float TH = 2.0f * (128.0f * gq * gk * attn_body::SCALE) + ATT_MARGIN;
    LAS float* Fend = (LAS float*)(F.lds + ATT_SCHED_OFF); LAS int* cost = (LAS int*)(F.lds + ATT_SCHED_OFF + 8192); LAS int* jlo_t = cost + 512; LAS int* order = cost + 1024; LAS int* slot = cost + 1536;
    const float* Fc = WSP(float, WS_FC);
    for (int p = F.tid; p < NH * 128; p += NTHREADS) Fend[p] = Fc[(size_t)(p >> 7) * S + 64 * (p & 127) + 63];
    __syncthreads();
    { const int u = F.tid, h = u >> 5, qb = u & 31, t0 = qb * 256; const float f0 = Fc[(size_t)h * S + t0];
      int lo = 0, hi = 4 * qb;
      while (lo < hi) { const int mid = (lo + hi) >> 1; const bool ok = (64 * mid + 63 >= t0) || (f0 - Fend[h * 128 + mid] >= -TH); if (ok) hi = mid; else lo = mid + 1; }
      jlo_t[u] = lo; cost[u] = 4 * (qb + 1) - lo; }
    __syncthreads();
    { const int u = F.tid, cu = cost[u]; int rk = 0;
      for (int v = 0; v < 512; ++v) { const int cv = cost[v]; rk += (cv > cu || (cv == cu && v < u)) ? 1 : 0; }
      order[rk] = u; }
    __syncthreads();
    for (;;) {
        if (F.tid == 0) slot[0] = (int)__hip_atomic_fetch_add((unsigned*)(F.ctl + CW_QATT + 64 * rep), 1u, RLX_AGENT);
        __syncthreads();
        const int k = slot[0];
        __syncthreads();
        if (k >= 512) break;
        const int u = order[k], h = u >> 5, qb = u & 31, jl = jlo_t[u];
        const ARef r0 = attn_ref(F, args, h, qb, jl);
        attn_fill_bias(F, args, h, qb, jl); __syncthreads();
        attn_body::attn_unit<bf16, bf16>(r0, S, lds_generic);
    }
}

__device__ __forceinline__ void p7_norm2(Frame& F, const Args& args) {
    const int gw = F.vcu * NWAVES + F.wave, NGW = F.G * NWAVES; const float* MOD = WSP(float, WS_MOD); bf16* HA = WSP(bf16, WS_HA);
    for (int m = gw; m < S; m += NGW) {
        const GAS f32x4* xr = (const GAS f32x4*)(WSP(float, WS_X1) + (size_t)m * DM) + F.lane; f32x4 v[16]; float ss = 0.f;
#pragma unroll
        for (int j = 0; j < 16; ++j) { v[j] = xr[64 * j]; ss += (v[j][0] * v[j][0] + v[j][1] * v[j][1]) + (v[j][2] * v[j][2] + v[j][3] * v[j][3]); }
        const float rstd = 1.0f / sqrtf(wave_sum(ss) * (1.0f / DM) + EPS);
#pragma unroll
        for (int j = 0; j < 16; ++j) { const int i4 = F.lane + 64 * j;
            const f32x4 g = ((const GAS f32x4*)args.in[5])[i4], scl = ((const GAS f32x4*)(MOD + 16384))[i4], sh = ((const GAS f32x4*)(MOD + 12288))[i4];
            const f32x4 hv = v[j] * rstd * (g * (scl + 1.0f)) + sh;
            v2u o; o.x = pk2(hv[0], hv[1]); o.y = pk2(hv[2], hv[3]); ((GAS v2u*)(HA + (size_t)m * DM))[i4] = o; }
    }
}

template <int CTRL> __device__ __forceinline__ unsigned dppu(unsigned x) { return (unsigned)__builtin_amdgcn_update_dpp(0, (int)x, CTRL, 0xF, 0xF, true); }
__device__ __forceinline__ unsigned rowmax_u32(unsigned x) { x = max(x, dppu<0xB1>(x)); x = max(x, dppu<0x4E>(x)); x = max(x, dppu<0x141>(x)); x = max(x, dppu<0x140>(x)); return x; }
__device__ __forceinline__ float rowsum_f32(float x) { x += __uint_as_float(dppu<0xB1>(__float_as_uint(x))); x += __uint_as_float(dppu<0x4E>(__float_as_uint(x)));
    x += __uint_as_float(dppu<0x141>(__float_as_uint(x))); x += __uint_as_float(dppu<0x140>(__float_as_uint(x))); return x; }
__device__ __forceinline__ unsigned ordk(float f) { const unsigned u = __float_as_uint(f); return u ^ ((unsigned)((int)u >> 31) | 0x80000000u); }
__device__ __forceinline__ float deck(unsigned k) { return __uint_as_float((k & 0x80000000u) ? (k ^ 0x80000000u) : ~k); }
#define CE_(x, y) do { const unsigned hi_ = max(x, y), lo_ = min(x, y); x = hi_; y = lo_; } while (0)
__device__ __forceinline__ unsigned row_pop16(unsigned (&a)[8], int i) {
    unsigned res = 0u;
#pragma unroll
    for (int r = 0; r < 16; ++r) { const unsigned m = rowmax_u32(a[0]); const bool win = a[0] == m;
#pragma unroll
        for (int s = 0; s < 7; ++s) a[s] = win ? a[s + 1] : a[s];
        a[7] = win ? 0u : a[7]; res = (i == r) ? m : res; }
    return res;
}
__device__ __forceinline__ void p9_topk(Frame& F, const Args& args, int own_pm, int own_pn) {
    const bf16* Q2 = WSP(bf16, WS_Q2); const bf16* SK = WSP(bf16, WS_SK); int* IDX = WSP(int, WS_IDX); float* GATE = WSP(float, WS_GATE);
    const int i = F.lane & 15, q = F.lane >> 4;
    const unsigned qlo = (unsigned)(i * 2048 + 8 * q) * 2u;
    const int h = own_pm >= 0 ? own_pn : ((int)blockIdx.x & 7), ib = (int)blockIdx.x >> 3, nbh = ((int)F.G - h + 7) >> 3;
    const int tg_0 = own_pm >= 0 ? own_pm * 16 + F.wave : ib * NWAVES + F.wave, tg_step = own_pm >= 0 ? NWAVES : nbh * NWAVES, tg_end = own_pm >= 0 ? own_pm * 16 + 16 : S / 16;
    for (int c = F.tid; c < 4096; c += NTHREADS) { const int pp = c >> 11, n = (c >> 4) & 127, ch = c & 15;
        *(LAS v4u*)(F.lds + pp * 32768 + n * 256 + ((ch * 16) ^ ((n & 7) << 4))) = *(const GAS v4u*)(SK + ((size_t)((h * 2 + pp) * 128 + n)) * 128 + ch * 8); }
    __syncthreads();
#pragma unroll 1
    for (int tg = tg_0; tg < tg_end; tg += tg_step) {
        const int t0 = 16 * tg;
        unsigned R[2][4];
        bf16x8 af[2][4];
#pragma unroll
        for (int p = 0; p < 2; ++p) { const char* qb_ = (const char*)Q2 + ((size_t)t0 * 2048 + h * 256 + p * 128) * 2;
#pragma unroll
            for (int ks = 0; ks < 4; ++ks) af[p][ks] = *(const GAS bf16x8*)(qb_ + 64 * ks + qlo); }
#pragma unroll
        for (int p = 0; p < 2; ++p) {
            f32x4 acc[8];
#pragma unroll
            for (int nt = 0; nt < 8; ++nt) { acc[nt] = (f32x4){0.f, 0.f, 0.f, 0.f}; const int n = 16 * nt + i;
#pragma unroll
                for (int ks = 0; ks < 4; ++ks) { const bf16x8 b = *(const LAS bf16x8*)(F.lds + p * 32768 + n * 256 + ((64 * ks + 16 * q) ^ ((n & 7) << 4)));
                    acc[nt] = __builtin_amdgcn_mfma_f32_16x16x32_bf16(af[p][ks], b, acc[nt], 0, 0, 0); } }
#pragma unroll
            for (int r = 0; r < 4; ++r) { unsigned a[8];
#pragma unroll
                for (int nt = 0; nt < 8; ++nt) a[nt] = (ordk(acc[nt][r]) & ~0x7Fu) | (unsigned)(16 * nt + i);
                CE_(a[0], a[1]); CE_(a[2], a[3]); CE_(a[4], a[5]); CE_(a[6], a[7]); CE_(a[0], a[2]); CE_(a[1], a[3]); CE_(a[4], a[6]); CE_(a[5], a[7]); CE_(a[1], a[2]); CE_(a[5], a[6]);
                CE_(a[0], a[4]); CE_(a[1], a[5]); CE_(a[2], a[6]); CE_(a[3], a[7]); CE_(a[2], a[4]); CE_(a[3], a[5]); CE_(a[1], a[2]); CE_(a[3], a[4]); CE_(a[5], a[6]);
                R[p][r] = row_pop16(a, i); __builtin_amdgcn_sched_barrier(0); }
        }
#pragma unroll
        for (int r = 0; r < 4; ++r) {
            const unsigned R0 = R[0][r], R1 = R[1][r]; const float f0 = deck(R0 & ~0x7Fu), f1 = deck(R1 & ~0x7Fu); const int n0 = (int)(R0 & 0x7Fu), n1 = (int)(R1 & 0x7Fu);
            const unsigned f1u = __float_as_uint(f1); unsigned c[8];
#define CAND_(b, lim) do { const unsigned t_ = (ordk(f0 + __uint_as_float(dppu<0x150 + (b)>(f1u))) & ~0xFFu) | (unsigned)(255 - (i * 16 + (b))); c[b] = (i < (lim)) ? t_ : 0u; } while (0)
            CAND_(0, 16); CAND_(1, 8); CAND_(2, 5); CAND_(3, 4); CAND_(4, 3); CAND_(5, 2); CAND_(6, 2); CAND_(7, 2);
#undef CAND_
            { const float ex = __uint_as_float(dppu<0x150>(__float_as_uint(f0))) + f1; const unsigned exk = (ordk(ex) & ~0xFFu) | (unsigned)(255 - i); c[1] = (i >= 8) ? exk : c[1]; }
            CE_(c[0], c[1]);
            const unsigned G = row_pop16(c, i);
            const float val = deck(G & ~0xFFu); const int id = 255 - (int)(G & 0xFFu); const int rb = F.lane & 48;
            const int ea = __shfl(n0, rb + (id >> 4)), eb = __shfl(n1, rb + (id & 15));
            const float mx = __uint_as_float(dppu<0x150>(__float_as_uint(val))); const float ex = __expf(val - mx); const float sm = rowsum_f32(ex);
            const size_t o = (size_t)(t0 + 4 * q + r) * 128 + h * 16 + i; IDX[o] = ea * 128 + eb; GATE[o] = ex / sm; __builtin_amdgcn_sched_barrier(0);
        }
    }
}
#undef CE_

constexpr float U_SCALE = 256.0f, V_SCALE = 1.0f;
#ifndef PEER_SORT
#define PEER_SORT 0
#endif
__device__ __forceinline__ float gelu_as(float v) {
    const float av = fabsf(v), tt = __builtin_amdgcn_rcpf(av * 0.2316418882f + 1.0f);
    float q = tt * 0.5307027145f + (-0.7265760135f); q = q * tt + 0.7107068705f; q = q * tt + (-0.142248368f); q = q * tt + 0.127414796f; q = q * tt;
    const float m = v * (q * __builtin_amdgcn_exp2f((v * v) * (-0.72134752044f)));
    return v < 0.f ? m : v - m;
}
#ifndef PEER_UMFMA
#define PEER_UMFMA 1
#endif
#ifndef HYP_A
#define HYP_A 1
#endif
#ifndef HYP_B
#define HYP_B 0
#endif
#ifndef PEER_VMFMA
#define PEER_VMFMA 1
#endif
typedef int v8i __attribute__((ext_vector_type(8)));
typedef int v2i __attribute__((ext_vector_type(2)));
typedef float f32x16 __attribute__((ext_vector_type(16)));
__device__ __forceinline__ float wave_sum_dpp(float x) {
    x = rowsum_f32(x);
    return (__uint_as_float(__builtin_amdgcn_readlane(__float_as_uint(x), 0)) + __uint_as_float(__builtin_amdgcn_readlane(__float_as_uint(x), 16)))
         + (__uint_as_float(__builtin_amdgcn_readlane(__float_as_uint(x), 32)) + __uint_as_float(__builtin_amdgcn_readlane(__float_as_uint(x), 48)));
}
#define LOADROWS(T, ra_, rb_, ee) do { const int e2_ = (ee) & 127; const int ea_ = __builtin_amdgcn_readlane(e2_ < 64 ? id0 : id1, e2_ & 63), eb_ = __builtin_amdgcn_readlane(e2_ < 64 ? id0 : id1, (e2_ + 1) & 63); \
        const GAS v4u* pa_ = (const GAS v4u*)((T) + (size_t)ea_ * DM) + F.lane; const GAS v4u* pb_ = (const GAS v4u*)((T) + (size_t)eb_ * DM) + F.lane; \
        _Pragma("unroll") for (int c = 0; c < 4; ++c) { ra_[c] = pa_[64 * c]; rb_[c] = pb_[64 * c]; } } while (0)
#define UDOT(r_, out_) do { f32x2 s0_ = {0.f, 0.f}, s1_ = {0.f, 0.f}, s2_ = {0.f, 0.f}, s3_ = {0.f, 0.f}; \
        _Pragma("unroll") for (int c = 0; c < 4; ++c) _Pragma("unroll") for (int d = 0; d < 2; ++d) { \
            const f32x2 p0_ = __builtin_amdgcn_cvt_scalef32_pk_f32_fp4(r_[c][d], 1.0f, 0), p1_ = __builtin_amdgcn_cvt_scalef32_pk_f32_fp4(r_[c][d], 1.0f, 1), \
                        p2_ = __builtin_amdgcn_cvt_scalef32_pk_f32_fp4(r_[c][d], 1.0f, 2), p3_ = __builtin_amdgcn_cvt_scalef32_pk_f32_fp4(r_[c][d], 1.0f, 3); \
            s0_ = p0_ * hx[8 * c + 4 * d] + s0_; s1_ = p1_ * hx[8 * c + 4 * d + 1] + s1_; s2_ = p2_ * hx[8 * c + 4 * d + 2] + s2_; s3_ = p3_ * hx[8 * c + 4 * d + 3] + s3_; } \
        out_ = ((s0_.x + s0_.y) + (s1_.x + s1_.y)) + ((s2_.x + s2_.y) + (s3_.x + s3_.y)); } while (0)
#define UPAIR(ra_, rb_, ee) do { float sa_, sb_; UDOT(ra_, sa_); UDOT(rb_, sb_); sa_ = wave_sum_dpp(sa_); sb_ = wave_sum_dpp(sb_); \
        const int e2_ = (ee); const int ea_ = __builtin_amdgcn_readlane(e2_ < 64 ? id0 : id1, e2_ & 63), eb_ = __builtin_amdgcn_readlane(e2_ < 64 ? id0 : id1, (e2_ + 1) & 63); \
        const f32x2 a2_ = pg8::gelu_pk((f32x2){sa_ * RSU[ea_], sb_ * RSU[eb_]}); \
        if ((ee) < 64) { if (F.lane == (ee)) w0 = a2_.x * g0; if (F.lane == (ee) + 1) w0 = a2_.y * g0; } else { if (F.lane == (ee) - 64) w1 = a2_.x * g1; if (F.lane == (ee) - 63) w1 = a2_.y * g1; } } while (0)
#define LOADROWS4(T, ra_, rb_, ee) do { const int e2_ = (ee) & 127; const int ea_ = __builtin_amdgcn_readlane(e2_ < 64 ? id0 : id1, e2_ & 63), eb_ = __builtin_amdgcn_readlane(e2_ < 64 ? id0 : id1, (e2_ + 1) & 63); \
        const GAS v2u* pa_ = (const GAS v2u*)((T) + (size_t)ea_ * 2048) + F.lane; const GAS v2u* pb_ = (const GAS v2u*)((T) + (size_t)eb_ * 2048) + F.lane; \
        _Pragma("unroll") for (int c = 0; c < 4; ++c) { ra_[c] = pa_[64 * c]; rb_[c] = pb_[64 * c]; } } while (0)
#define VAXPY(r_, w_) do { const f32x2 w2_ = {w_, w_}; \
        _Pragma("unroll") for (int c = 0; c < 4; ++c) _Pragma("unroll") for (int d = 0; d < 2; ++d) { \
            const f32x2 p0_ = __builtin_amdgcn_cvt_scalef32_pk_f32_fp4(r_[c][d], 1.0f, 0), p1_ = __builtin_amdgcn_cvt_scalef32_pk_f32_fp4(r_[c][d], 1.0f, 1), \
                        p2_ = __builtin_amdgcn_cvt_scalef32_pk_f32_fp4(r_[c][d], 1.0f, 2), p3_ = __builtin_amdgcn_cvt_scalef32_pk_f32_fp4(r_[c][d], 1.0f, 3); \
            acc[8 * c + 4 * d] = p0_ * w2_ + acc[8 * c + 4 * d]; acc[8 * c + 4 * d + 1] = p1_ * w2_ + acc[8 * c + 4 * d + 1]; \
            acc[8 * c + 4 * d + 2] = p2_ * w2_ + acc[8 * c + 4 * d + 2]; acc[8 * c + 4 * d + 3] = p3_ * w2_ + acc[8 * c + 4 * d + 3]; } } while (0)
#define VPAIR(ra_, rb_, ee) do { const int e2_ = (ee); const int ea_ = __builtin_amdgcn_readlane(e2_ < 64 ? id0 : id1, e2_ & 63), eb_ = __builtin_amdgcn_readlane(e2_ < 64 ? id0 : id1, (e2_ + 1) & 63); \
        const float wa_ = __uint_as_float(__builtin_amdgcn_readlane(__float_as_uint((ee) < 64 ? w0 : w1), (ee) & 63)) * RS[ea_], wb_ = __uint_as_float(__builtin_amdgcn_readlane(__float_as_uint((ee) < 64 ? w0 : w1), ((ee) + 1) & 63)) * RS[eb_]; \
        VAXPY(ra_, wa_); VAXPY(rb_, wb_); } while (0)
#ifndef P10_NT
#define P10_NT 1
#endif
#if P10_NT
#define P10_OUT_ST(p, v) __builtin_nontemporal_store((v), (p))
#else
#define P10_OUT_ST(p, v) (*(p) = (v))
#endif
template <int MODE> __device__ __forceinline__ void p10_peer(Frame& F, const Args& args) {
    const int gw = F.vcu * NWAVES + F.wave, NGW = F.G * NWAVES; const float* MOD = WSP(float, WS_MOD);
    const bf16* H2 = WSP(bf16, WS_HA); const unsigned char* U = WSP(unsigned char, WS_U); const unsigned char* V = WSP(unsigned char, WS_V); const int* IDX = WSP(int, WS_IDX); const float* GATE = WSP(float, WS_GATE); const float* RS = WSP(float, WS_RS); const float* RSU = WSP(float, WS_RSU);
#if PEER_UMFMA
    if (F.lane < 8) *(LAS v4u*)(F.lds + F.wave * 18688 + 4096 + F.lane * 16) = (v4u){0u, 0u, 0u, 0u};
#endif
#pragma unroll 1
    for (int t = gw; t < S; t += NGW) {
        const int id0 = IDX[(size_t)t * 128 + F.lane], id1 = IDX[(size_t)t * 128 + 64 + F.lane];
        const float g0 = GATE[(size_t)t * 128 + F.lane], g1 = GATE[(size_t)t * 128 + 64 + F.lane];
        float w0 = 0.f, w1 = 0.f;
#if PEER_UMFMA
        if (MODE != 2) {
            LAS unsigned char* h8 = F.lds + F.wave * 18688; LAS unsigned char* stg = h8 + 4224;
            const float rstd = 1.0f / sqrtf(wave_sum_dpp(WSP(float, WS_SSQ)[(size_t)t * 64 + F.lane]) * (1.0f / DM) + EPS);
#pragma unroll
            for (int c = 0; c < 4; ++c) { const GAS v4u* hp = (const GAS v4u*)(H2 + (size_t)t * DM + c * 1024 + F.lane * 16); const v4u a = P10_NT ? __builtin_nontemporal_load(hp) : hp[0], b = P10_NT ? __builtin_nontemporal_load(hp + 1) : hp[1]; v4u o;
                const GAS f32x4* sp = (const GAS f32x4*)(MOD + 12288 + c * 1024 + F.lane * 16); const f32x4 s0 = sp[0], s1 = sp[1], s2 = sp[2], s3 = sp[3];
                { int w = 0; w = __builtin_amdgcn_cvt_pk_fp8_f32(bflo(a[0]) * rstd + s0[0], bfhi(a[0]) * rstd + s0[1], w, false); w = __builtin_amdgcn_cvt_pk_fp8_f32(bflo(a[1]) * rstd + s0[2], bfhi(a[1]) * rstd + s0[3], w, true); o[0] = (unsigned)w; }
                { int w = 0; w = __builtin_amdgcn_cvt_pk_fp8_f32(bflo(a[2]) * rstd + s1[0], bfhi(a[2]) * rstd + s1[1], w, false); w = __builtin_amdgcn_cvt_pk_fp8_f32(bflo(a[3]) * rstd + s1[2], bfhi(a[3]) * rstd + s1[3], w, true); o[1] = (unsigned)w; }
                { int w = 0; w = __builtin_amdgcn_cvt_pk_fp8_f32(bflo(b[0]) * rstd + s2[0], bfhi(b[0]) * rstd + s2[1], w, false); w = __builtin_amdgcn_cvt_pk_fp8_f32(bflo(b[1]) * rstd + s2[2], bfhi(b[1]) * rstd + s2[3], w, true); o[2] = (unsigned)w; }
                { int w = 0; w = __builtin_amdgcn_cvt_pk_fp8_f32(bflo(b[2]) * rstd + s3[0], bfhi(b[2]) * rstd + s3[1], w, false); w = __builtin_amdgcn_cvt_pk_fp8_f32(bflo(b[3]) * rstd + s3[2], bfhi(b[3]) * rstd + s3[3], w, true); o[3] = (unsigned)w; }
                *(LAS v4u*)(h8 + c * 1024 + F.lane * 16) = o; }
            const int j = F.lane & 31, kh = F.lane >> 5, lr = F.lane >> 3, lp = F.lane & 7;
            unsigned so[4][4];
#pragma unroll
            for (int b = 0; b < 4; ++b)
#pragma unroll
                for (int i = 0; i < 4; ++i) so[b][i] = (unsigned)__shfl(b < 2 ? id0 : id1, 32 * (b & 1) + lr + 8 * i) * 2048u + (unsigned)lp * 16u;
            int eb[4];
#pragma unroll
            for (int b = 0; b < 4; ++b) eb[b] = __shfl(b < 2 ? id0 : id1, j + 32 * (b & 1));
            const unsigned aoff0 = (j == 0) ? (unsigned)(16 * kh) : 4096u, aoff1 = (j == 0) ? (unsigned)(32 + 16 * kh) : 4112u, astep = (j == 0) ? 64u : 0u;
            const unsigned wof = (unsigned)lr * 144u + (unsigned)lp * 16u, rof = (unsigned)j * 144u + (unsigned)kh * 16u;
            f32x16 ac[4];
#pragma unroll
            for (int b = 0; b < 4; ++b) ac[b] = (f32x16){};
            v4u R0[8], R1[8];
#define ULOAD(R_, kg_, bp_) do { _Pragma("unroll") for (int bb = 0; bb < 2; ++bb) _Pragma("unroll") for (int i = 0; i < 4; ++i) \
                R_[4 * bb + i] = *(const GAS v4u*)(U + (size_t)so[2 * (bp_) + bb][i] + (size_t)(kg_) * 128); } while (0)
#define USTAGE(R_, bp_) do { _Pragma("unroll") for (int bb = 0; bb < 2; ++bb) _Pragma("unroll") for (int i = 0; i < 4; ++i) *(LAS v4u*)(stg + bb * 4608 + i * 1152 + wof) = R_[4 * bb + i]; \
            _Pragma("unroll") for (int bb = 0; bb < 2; ++bb) { v4u B_[4]; _Pragma("unroll") for (int kk = 0; kk < 4; ++kk) B_[kk] = *(const LAS v4u*)(stg + bb * 4608 + rof + kk * 32); \
                _Pragma("unroll") for (int kk = 0; kk < 4; ++kk) ac[2 * (bp_) + bb] = __builtin_amdgcn_mfma_scale_f32_32x32x64_f8f6f4(A[kk], (v8i){(int)B_[kk][0], (int)B_[kk][1], (int)B_[kk][2], (int)B_[kk][3], 0, 0, 0, 0}, ac[2 * (bp_) + bb], 0, 4, 0, 0x7f7f7f7f, 0, 0x7f7f7f7f); } } while (0)
            ULOAD(R0, 0, 0);
#pragma unroll 1
            for (int kg = 0; kg < 16; ++kg) {
                v8i A[4];
#pragma unroll
                for (int kk = 0; kk < 4; ++kk) { const unsigned kb = (unsigned)(4 * kg + kk); const v4u x = *(const LAS v4u*)(h8 + aoff0 + kb * astep), y = *(const LAS v4u*)(h8 + aoff1 + kb * astep);
                    A[kk] = (v8i){(int)x[0], (int)x[1], (int)x[2], (int)x[3], (int)y[0], (int)y[1], (int)y[2], (int)y[3]}; }
                ULOAD(R1, kg, 1);
                USTAGE(R0, 0);
                ULOAD(R0, (kg + 1) & 15, 0);
                USTAGE(R1, 1);
            }
#undef ULOAD
#undef USTAGE
#pragma unroll
            for (int b = 0; b < 4; ++b) {
                const float av = pg8::gelu_pk((f32x2){ac[b][0] * RSU[eb[b]], 0.f}).x;
                const float gg = __shfl(b < 2 ? g0 : g1, j + 32 * (b & 1)); const float wv = av * gg;
                if ((b & 1) == 0) { if (b == 0) w0 = F.lane < 32 ? wv : w0; else w1 = F.lane < 32 ? wv : w1; }
                else { const float mv = __shfl(wv, j); if (b == 1) w0 = F.lane >= 32 ? mv : w0; else w1 = F.lane >= 32 ? mv : w1; } }
        }
#else
        {   f32x2 hx[32];
#pragma unroll
            for (int c = 0; c < 4; ++c) { const GAS v4u* hp = (const GAS v4u*)(H2 + (size_t)t * DM + c * 1024 + F.lane * 16); const v4u a = hp[0], b = hp[1];
#pragma unroll
                for (int k = 0; k < 4; ++k) { hx[8 * c + k] = (f32x2){bflo(a[k]), bfhi(a[k])}; hx[8 * c + 4 + k] = (f32x2){bflo(b[k]), bfhi(b[k])}; } }
            v2u ra[4], rb[4], rc[4], rd[4], na[4], nb[4], nc[4], nd[4];
            if (MODE != 2) {
            LOADROWS4(U, ra, rb, 0); LOADROWS4(U, rc, rd, 2);
#pragma unroll 1
            for (int e = 0; e < 128; e += 8) {
                LOADROWS4(U, na, nb, e + 4); LOADROWS4(U, nc, nd, e + 6);
                UPAIR(ra, rb, e); UPAIR(rc, rd, e + 2);
                LOADROWS4(U, ra, rb, e + 8); LOADROWS4(U, rc, rd, e + 10);
                UPAIR(na, nb, e + 4); UPAIR(nc, nd, e + 6);
            } } }
#endif
        if (MODE == 1 || MODE == 3) { asm volatile("" :: "v"(w0), "v"(w1)); continue; }
#if PEER_VMFMA
        {
            LAS unsigned char* wreg = F.lds + F.wave * 18688; LAS unsigned char* w8 = wreg; LAS unsigned char* stg = wreg + 256;
            const int j = F.lane & 31, kh = F.lane >> 5;
            { const float q0 = w0 * RS[id0] * 16.0f, q1 = w1 * RS[id1] * 16.0f;
              const int b0 = __builtin_amdgcn_cvt_pk_fp8_f32(q0, q0, 0, false), b1 = __builtin_amdgcn_cvt_pk_fp8_f32(q1, q1, 0, false);
              w8[F.lane] = (unsigned char)(b0 & 0xff); w8[64 + F.lane] = (unsigned char)(b1 & 0xff); if (F.lane < 8) *(LAS v2u*)(w8 + 128 + 8 * F.lane) = (v2u){0u, 0u}; }
            v8i A[2];
#pragma unroll
            for (int kb = 0; kb < 2; ++kb) { const unsigned o0 = (j == 0) ? (unsigned)(64 * kb + 16 * kh) : 128u, o1 = (j == 0) ? (unsigned)(64 * kb + 32 + 16 * kh) : 144u;
                const v4u x = *(const LAS v4u*)(w8 + o0), y = *(const LAS v4u*)(w8 + o1);
                A[kb] = (v8i){(int)x[0], (int)x[1], (int)x[2], (int)x[3], (int)y[0], (int)y[1], (int)y[2], (int)y[3]}; }
            const int lr = F.lane >> 3, lp = F.lane & 7;
            unsigned so[2][8];
#pragma unroll
            for (int kb = 0; kb < 2; ++kb)
#pragma unroll
                for (int i = 0; i < 8; ++i) so[kb][i] = (unsigned)__shfl(kb == 0 ? id0 : id1, 8 * i + lr) * 2048u + (unsigned)lp * 16u;
            const unsigned wof = (unsigned)lr * 144u + (unsigned)lp * 16u;
            const unsigned rof = (unsigned)(32 * kh + (F.lane & 15)) * 144u + (unsigned)(8 * ((F.lane >> 4) & 1));
            const bf16* X1r = WSP(bf16, WS_X1) + (size_t)t * DM; const float* G2 = MOD + 20480; float* Or = F.out + (size_t)t * DM;
            v4u R0[8], R1[8];
#define VLOAD(R_, cg_, kb_) do { _Pragma("unroll") for (int i = 0; i < 8; ++i) R_[i] = *(const GAS v4u*)(V + (size_t)so[kb_][i] + (size_t)(cg_) * 128); } while (0)
            VLOAD(R0, 0, 0); VLOAD(R1, 0, 1);
#pragma unroll 1
            for (int cg = 0; cg < 16; ++cg) {
#pragma unroll
                for (int i = 0; i < 8; ++i) { *(LAS v4u*)(stg + i * 1152 + wof) = R0[i]; *(LAS v4u*)(stg + 9216 + i * 1152 + wof) = R1[i]; }
                VLOAD(R0, (cg + 1) & 15, 0); VLOAD(R1, (cg + 1) & 15, 1);
#pragma unroll
                for (int tp = 0; tp < 4; ++tp) { float dv[2];
#pragma unroll
                    for (int th = 0; th < 2; ++th) { const int tt = 2 * tp + th; f32x16 d_ = (f32x16){};
#pragma unroll
                        for (int kb = 0; kb < 2; ++kb) {
                            const v2i q0_ = __builtin_amdgcn_ds_read_tr4_b64_v2i32((LAS v2i*)(stg + kb * 9216 + rof + tt * 16)), q1_ = __builtin_amdgcn_ds_read_tr4_b64_v2i32((LAS v2i*)(stg + kb * 9216 + 2304 + rof + tt * 16));
                            d_ = __builtin_amdgcn_mfma_scale_f32_32x32x64_f8f6f4(A[kb], (v8i){q0_[0], q0_[1], q1_[0], q1_[1], 0, 0, 0, 0}, d_, 0, 4, 0, 0x7b7b7b7b, 0, 0x7f7f7f7f); }
                        dv[th] = d_[0]; }
                    const auto sw = __builtin_amdgcn_permlane32_swap(__float_as_uint(dv[0]), __float_as_uint(dv[1]), false, false);
                    const float dd = __uint_as_float(sw[0]);
                    if (MODE == 2) { asm volatile("" :: "v"(dd)); } else { const int col = cg * 256 + tp * 64 + F.lane; P10_OUT_ST(&Or[col], bf2f(P10_NT ? __builtin_nontemporal_load(X1r + col) : X1r[col]) + G2[col] * dd); } }
            }
#undef VLOAD
        }
#else
        f32x2 acc[32];
#pragma unroll
        for (int j = 0; j < 32; ++j) acc[j] = (f32x2){0.f, 0.f};
        {   v2u ra[4], rb[4], rc[4], rd[4], na[4], nb[4], nc[4], nd[4];
            LOADROWS4(V, ra, rb, 0); LOADROWS4(V, rc, rd, 2);
#pragma unroll 1
            for (int e = 0; e < 128; e += 8) {
                LOADROWS4(V, na, nb, e + 4); LOADROWS4(V, nc, nd, e + 6);
                VPAIR(ra, rb, e); VPAIR(rc, rd, e + 2);
                LOADROWS4(V, ra, rb, e + 8); LOADROWS4(V, rc, rd, e + 10);
                VPAIR(na, nb, e + 4); VPAIR(nc, nd, e + 6);
            } }
        if (MODE == 2) {
#pragma unroll
            for (int j = 0; j < 32; ++j) asm volatile("" :: "v"(acc[j]));
            continue; }
#pragma unroll
        for (int c = 0; c < 4; ++c) { const int col = c * 1024 + F.lane * 16; GAS f32x4* op = (GAS f32x4*)(F.out + (size_t)t * DM + col);
            const GAS f32x4* xp = (const GAS f32x4*)(WSP(float, WS_X1) + (size_t)t * DM + col); const GAS f32x4* gp = (const GAS f32x4*)(MOD + 20480 + col);
#pragma unroll
            for (int q = 0; q < 4; ++q) op[q] = xp[q] + gp[q] * (f32x4){acc[8 * c + 2 * q].x, acc[8 * c + 2 * q].y, acc[8 * c + 2 * q + 1].x, acc[8 * c + 2 * q + 1].y}; }
#endif
    }
}
#undef LOADROWS
#undef UDOT
#undef UPAIR
#undef VAXPY
#undef VPAIR
#undef LOADROWS4
#ifndef MK_SINGLE
#define MK_SINGLE 1
#endif
constexpr int N_PHASES = 11;
__global__ void __launch_bounds__(NTHREADS, 2) fwd_kernel(Args args) {
    extern __shared__ __attribute__((aligned(16))) unsigned char lds[];
    Frame F;
    F.lds = (LAS unsigned char*)lds; F.MISC = (volatile LAS unsigned*)(F.lds + MISC_OFF);
    F.tid = threadIdx.x; F.lane = F.tid & 63; F.wave = __builtin_amdgcn_readfirstlane(F.tid >> 6);
    F.G = gridDim.x; { const int bx = blockIdx.x; F.vcu = (F.G % 8 == 0) ? (bx % 8) * (F.G / 8) + bx / 8 : bx; }
    F.ws = args.ws; F.out = args.out; F.ctl = (gu32*)(args.ws + WS_CTL);
    for (int u = F.tid; u < (LDS_BYTES - LDSCTL_OFF) / 4; u += NTHREADS) ((LAS unsigned*)(F.lds + LDSCTL_OFF))[u] = 0u;
    __syncthreads();
    const int lo = args.ph_lo, hi = args.ph_hi;
    XcdBarrier bar; bar.bar = (unsigned*)(F.ctl + CW_BAR); bar.x = 0; bar.st = nullptr;
    if (hi - lo > 1) bar = xcd_barrier_post((unsigned*)(F.ctl + CW_BAR), F.MISC + 8);
#ifndef PH_MASK
#define PH_MASK 0x7ff
#endif
#define IN(k) (((PH_MASK >> (k)) & 1) && lo <= (k) && (k) < hi)
#define SEAM(k) do { if (IN(k) && IN((k) + 1)) xcd_barrier(bar); } while (0)
#ifndef G_ALIGN
#define G_ALIGN true
#endif
#ifndef G_SP2
#define G_SP2 true
#endif
#ifndef QKN_IN_P2
#define QKN_IN_P2 0
#endif
#ifndef P2_BAL
#define P2_BAL 0
#endif
#ifndef P9_OWN
#define P9_OWN 1
#endif
#ifndef P5_FUSED
#define P5_FUSED 1
#endif
#ifndef REP_PHASE
#define REP_PHASE -1
#endif
#define REPEAT(k) _Pragma("unroll") for (int rep = 0; rep < ((REP_PHASE) == (k) ? 2 : 1); ++rep)
#define REPBAR(k) do { if ((REP_PHASE) == (k) && rep == 0) xcd_barrier(bar); } while (0)
    const int bid = (int)blockIdx.x;
    if (IN(0)) { REPEAT(0) { p0_prologue(F, args); REPBAR(0); } SEAM(0); }
    if (IN(1)) { REPEAT(1) { p1_norm_forget(F, args); p1_shift_proj(F, args); REPBAR(1); } SEAM(1); }
#ifdef CLK_PROBE
    long long ck0 = clock64(); long long wk0 = wall_clock64();
#endif
    if (IN(2)) { REPEAT(2) {
#ifdef P2_STAGGER
        if ((bid >> 3) & 1) { const long long t0_ = wall_clock64(); while (wall_clock64() - t0_ < P2_STAGGER) __builtin_amdgcn_s_sleep(8); }
#endif
#if SKEW_TABLES
        const bool tables_first = ((bid >> 3) & 1) != 0; const int gw_ = F.vcu * NWAVES + F.wave, NGW_ = F.G * NWAVES;
        if (tables_first) { cvt_table_fp4(F, args.in[23], WSP(unsigned char, WS_V), WSP(float, WS_RS), gw_, NGW_); cvt_table_fp4(F, args.in[22], WSP(unsigned char, WS_U), WSP(float, WS_RSU), gw_, NGW_); if (SKEW_TR) tr_run(F, args, TR_LATE_LO, TR_LATE_HI); __syncthreads(); }
#endif
        pg8::Gemm g{WSP(bf16, WS_HA), WSP(bf16, WS_WIN), S, NINP, DM}; pg8::BalOrder So; So.init(S, NINP, F.G, bid); So.on = (P2_BAL != 0) && F.G == 256;
        pg8::EpiIn E{WSP(bf16, WS_QKV), WSP(bf16, WS_LX), WSP(bf16, WS_GY), WSP(bf16, WS_GA), WSP(bf16, WS_GL), WSP(float, WS_BIASR)};
        pg8::gemm_phase<pg8::EpiIn, pg8::BalOrder, G_ALIGN, G_SP2>(F.lds, g, So, E);
#if SKEW_TABLES
        if (!tables_first) { cvt_table_fp4(F, args.in[23], WSP(unsigned char, WS_V), WSP(float, WS_RS), gw_, NGW_); cvt_table_fp4(F, args.in[22], WSP(unsigned char, WS_U), WSP(float, WS_RSU), gw_, NGW_); if (SKEW_TR) tr_run(F, args, TR_LATE_LO, TR_LATE_HI); }
#endif
        REPBAR(2); }
#ifdef P2_NOEPI
        { xcd_barrier(bar); pg8::Gemm g{WSP(bf16, WS_HA), WSP(bf16, WS_WIN), S, NINP, DM};
#ifdef P2_PITCH
          g.lda = P2_PITCH; g.ldb = P2_PITCH;
#endif
          pg8::MaskOrder So; So.init(S, NINP, F.G, bid);

#if EPI_PROBE
          pg8::EpiInProbe E{WSP(bf16, WS_T1), WSP(bf16, WS_T1), WSP(bf16, WS_T1), WSP(bf16, WS_T1), WSP(bf16, WS_T1), WSP(float, WS_BIASR)}; pg8::gemm_phase<pg8::EpiInProbe, pg8::MaskOrder, G_ALIGN, G_SP2, 0>(F.lds, g, So, E); }
#else
          pg8::EpiNullKeep E{WSP(float, WS_IDX2)}; pg8::gemm_phase<pg8::EpiNullKeep, pg8::MaskOrder, G_ALIGN, G_SP2, P2_NOEPI - 1>(F.lds, g, So, E); }
#endif

#endif
        SEAM(2);
    }
#ifdef CLK_PROBE
    long long ck1 = clock64(); long long wk1 = wall_clock64();
#endif
    if (IN(3)) {
#if !QKN_IN_P2
        p3_qknorm(F, args);
        __syncthreads();
#endif
        REPEAT(3) {
        p3_cumsum(F, args);
        for (int w = bid; w < 256; w += F.G) lru_item<0>(F, args, w);
        REPBAR(3); }
        SEAM(3);
    }
    if (IN(4)) {
#pragma unroll 1
        for (int rep = 0; rep < args.rep_lru; ++rep)
        for (int w = bid; w < 256; w += F.G) { if (LRU_STORE_AB) lru_item1_ab(F, args, w); else lru_item<1>(F, args, w); }
#pragma unroll 1
        for (int rep = 0; rep < args.rep_att; ++rep) p4_attention(F, args, (char*)lds, rep);
        SEAM(4);
    }
    if (IN(5)) { REPEAT(5) {
#if P5_FUSED
        { pg8::Gemm g{WSP(bf16, WS_ATT), WSP(bf16, WS_WAO), S, DM, AW + LW}; g.lda = AW; g.ldb = AW; g.A2 = WSP(bf16, WS_LR); g.Bt2 = WSP(bf16, WS_WLO); g.ksplit = AW;
          pg8::StaticOrder So; So.init(S, DM, F.G, bid);
          pg8::EpiGate2 E{WSP(bf16, WS_T1), WSP(bf16, WS_GA), WSP(bf16, WS_GL), DM};
          pg8::gemm_phase<pg8::EpiGate2, pg8::StaticOrder, true, true, 0, true>(F.lds, g, So, E); }
#else
        { pg8::Gemm g{WSP(bf16, WS_ATT), WSP(bf16, WS_WAO), S, DM, AW}; pg8::StaticOrder So; So.init(S, DM, F.G, bid);
          pg8::EpiGate<0> E{WSP(bf16, WS_T1), WSP(bf16, WS_GA), DM};
          pg8::gemm_phase<pg8::EpiGate<0>, pg8::StaticOrder, true, true>(F.lds, g, So, E); }
        { pg8::Gemm g{WSP(bf16, WS_LR), WSP(bf16, WS_WLO), S, DM, LW}; pg8::StaticOrder So; So.init(S, DM, F.G, bid);
          pg8::EpiGate<1> E{WSP(bf16, WS_T1), WSP(bf16, WS_GL), DM};
          pg8::gemm_phase<pg8::EpiGate<1>, pg8::StaticOrder, true, true>(F.lds, g, So, E); }
#endif
        REPBAR(5); }
        SEAM(5);
    }
    if (IN(6)) { REPEAT(6) {
        pg8::Gemm g{WSP(bf16, WS_T1), WSP(bf16, WS_WOUT), S, DM, DM}; pg8::StaticOrder So; So.init(S, DM, F.G, bid);
        pg8::EpiRes E{args.in[0], WSP(bf16, WS_X1), WSP(float, WS_MOD) + 8192, DM, args.in[5], WSP(float, WS_MOD) + 16384, WSP(bf16, WS_HA), WSP(float, WS_SSQ)};
        pg8::gemm_phase<pg8::EpiRes, pg8::StaticOrder, true, true>(F.lds, g, So, E);
        REPBAR(6); }
        SEAM(6);
    }
    pg8::Unit p9u{0, 0}; bool p9_own = false;
    { pg8::StaticOrder So8; So8.init(S, 2048, F.G, bid); p9_own = (P9_OWN != 0) && F.G == 256 && IN(8) && IN(9) && (REP_PHASE) != 8 && So8.next(0, p9u); }
    if (IN(8)) { REPEAT(8) {
        pg8::Gemm g{WSP(bf16, WS_HA), WSP(bf16, WS_WPQ), S, 2048, DM}; pg8::RstdOrder So; So.init(S, 2048, F.G, bid);
        So.SSQ = WSP(float, WS_SSQ); So.rs = (LAS float*)(F.lds + 133120); So.inv_n = 1.0f / DM; So.eps = EPS; So.na = 0;
        pg8::EpiQ2 E{WSP(bf16, WS_Q2), 2048, WSP(float, WS_SB), (const LAS float*)(F.lds + 133120), 0};
        pg8::gemm_phase<pg8::EpiQ2, pg8::RstdOrder, true, true>(F.lds, g, So, E);
        REPBAR(8); }
        if (p9_own) __syncthreads(); else SEAM(8);
    }
    if (IN(9)) { REPEAT(9) { p9_topk(F, args, p9_own ? p9u.pm : -1, p9u.pn); REPBAR(9); } SEAM(9); }
#ifndef P10_PROBE
#define P10_PROBE 0
#endif
#if defined(CLK_PROBE) && CLK_PROBE >= 10
    ck0 = clock64(); wk0 = wall_clock64();
#endif
    if (IN(10)) { if (P10_PROBE) { p10_peer<P10_PROBE>(F, args); xcd_barrier(bar); } REPEAT(10) { p10_peer<0>(F, args); REPBAR(10); } }
#if defined(CLK_PROBE) && CLK_PROBE >= 10
    ck1 = clock64(); wk1 = wall_clock64();
#endif
#ifdef CLK_PROBE
    xcd_barrier(bar);
    if (bid == 0 && F.tid == 0) { const float ghz = (float)(ck1 - ck0) / (float)(wk1 - wk0) * 0.1f;
        F.out[0] = (CLK_PROBE == 1 || CLK_PROBE == 10) ? floorf(ghz * 10.0f + 0.5f) * 10.0f : (float)(wk1 - wk0) * 0.01f; }
#endif
#undef IN
#undef SEAM
}

extern "C" void kernel_launch(void* const* d_in, const int* in_sizes, int n_in, void* d_out, int out_size, void* d_ws, size_t ws_size, hipStream_t stream) {
    static int grid = 0;
    if (grid == 0) {
        if (n_in != 24 || in_sizes[0] != S * DM || out_size != S * DM || ws_size < WS_END) { fprintf(stderr, "kernel_launch: unexpected shapes (n_in %d, in0 %d, out %d, ws %zu)\n", n_in, n_in > 0 ? in_sizes[0] : -1, out_size, ws_size); grid = -1; return; }
        int dev = 0, cus = 0, per_cu = 0;
        if (hipGetDevice(&dev) != hipSuccess || hipDeviceGetAttribute(&cus, hipDeviceAttributeMultiprocessorCount, dev) != hipSuccess) { grid = -1; return; }
        if (hipFuncSetAttribute((const void*)fwd_kernel, hipFuncAttributeMaxDynamicSharedMemorySize, LDS_BYTES) != hipSuccess) { fprintf(stderr, "kernel_launch: hipFuncSetAttribute failed\n"); grid = -1; return; }
        if (hipOccupancyMaxActiveBlocksPerMultiprocessor(&per_cu, (const void*)fwd_kernel, NTHREADS, LDS_BYTES) != hipSuccess || per_cu < 1) fprintf(stderr, "kernel_launch: occupancy query reports %d blocks per CU\n", per_cu);
        (void)hipGetLastError();
        grid = cus;
    }
    if (grid < 0) return;
    if (hipMemsetAsync((char*)d_ws + WS_CTL, 0, CTL_ZERO_BYTES, stream) != hipSuccess) return;
    Args a{};
    for (int i = 0; i < 24; ++i) a.in[i] = (const float*)d_in[i];
    a.out = (float*)d_out; a.ws = (unsigned char*)d_ws;
#ifndef REP_ATT
#define REP_ATT 1
#endif
#ifndef REP_LRU
#define REP_LRU 1
#endif
    a.rep_att = REP_ATT; a.rep_lru = REP_LRU;
#if MK_SINGLE
    a.ph_lo = 0; a.ph_hi = N_PHASES;
    hipLaunchKernelGGL(fwd_kernel, dim3(grid), dim3(NTHREADS), LDS_BYTES, stream, a);
#else
    for (int p = 0; p < N_PHASES; ++p) { a.ph_lo = p; a.ph_hi = p + 1; hipLaunchKernelGGL(fwd_kernel, dim3(grid), dim3(NTHREADS), LDS_BYTES, stream, a); }
#endif
}
```
